# Optimizing an MI355X kernel written in HIP

```python
import math
import jax, jax.numpy as jnp
from jax import lax
import numpy as np

D_MODEL = 2048
BATCH = 4
SEQ = 4096
DEPTH = 4

MEM_LEN = 256
ROPE_THETA = 500000.0
ROPE_FRAC = 4
NORM_EPS = 1e-6

GLA_HEADS = 4
GLA_DK = 64
GLA_DV = 128
GLA_GATE_RANK = 16
GLA_TAU = 16.0
GLA_CHUNK = 64

S5_GROUPS = 32
S5_CH = 16
S5_STATE = 64
S5_WIDTH = S5_GROUPS * S5_CH

DSA_HEADS = 4
DSA_HD = 128
DSA_IDX_HEADS = 16
DSA_IDX_DIM = 64
DSA_TOPK = 256
DSA_QBLOCK = 128

MEM_HEADS = 4
MEM_HD = 128

GLA_WIDTH = GLA_HEADS * GLA_DV
DSA_WIDTH = DSA_HEADS * DSA_HD
MEM_WIDTH = MEM_HEADS * MEM_HD
MIX_WIDTH = GLA_WIDTH + S5_WIDTH + DSA_WIDTH + MEM_WIDTH
OUT_HEAD_DIM = 128

IN_SPLITS = (GLA_HEADS * GLA_DK, GLA_HEADS * GLA_DK, GLA_WIDTH, GLA_GATE_RANK, GLA_WIDTH,
             S5_WIDTH, S5_WIDTH,
             DSA_WIDTH, DSA_HD, DSA_HD, DSA_IDX_HEADS * DSA_IDX_DIM, DSA_IDX_DIM, DSA_IDX_HEADS, DSA_WIDTH,
             MEM_WIDTH, MEM_WIDTH)
IN_WIDTH = sum(IN_SPLITS)

kernel_name = "hybrid_gla_s5_dsa_memxattn_trunk"

F32 = jnp.float32


def rms_norm(x, g):
    xf = x.astype(F32)
    y = xf * lax.rsqrt(jnp.mean(xf * xf, axis=-1, keepdims=True) + NORM_EPS)
    return y.astype(x.dtype) * g


def split_cols(p):
    idx, acc = [], 0
    for w in IN_SPLITS[:-1]:
        acc += w
        idx.append(acc)
    return jnp.split(p, idx, axis=-1)


def partial_rope(x, pos):
    d = x.shape[-1]
    rd = d // ROPE_FRAC
    half = rd // 2
    inv_freq = ROPE_THETA ** (-jnp.arange(half, dtype=F32) * 2.0 / rd)
    ang = pos.astype(F32)[:, :, None] * inv_freq
    cos = jnp.cos(ang)[:, :, None, :]
    sin = jnp.sin(ang)[:, :, None, :]
    xr = x[..., :rd].astype(F32)
    x1, x2 = xr[..., :half], xr[..., half:]
    rot = jnp.concatenate([x1 * cos - x2 * sin, x2 * cos + x1 * sin], axis=-1).astype(x.dtype)
    return jnp.concatenate([rot, x[..., rd:]], axis=-1)


def gla_chunked(q, k, v, log_a):
    B, S, H, dk = q.shape
    dv = v.shape[-1]
    C = GLA_CHUNK
    N = S // C
    q, k, v, log_a = (t.astype(F32).reshape(B, N, C, H, -1) for t in (q, k, v, log_a))
    b = jnp.cumsum(log_a, axis=2)
    b_last = b[:, :, -1]
    m = b[:, :, C // 2:C // 2 + 1]
    attn = jnp.einsum('bnthd,bnshd->bnhts', q * jnp.exp(b - m), k * jnp.exp(m - b))
    tril = jnp.tril(jnp.ones((C, C), dtype=bool))
    attn = jnp.where(tril, attn, 0.0)
    o_intra = jnp.einsum('bnhts,bnshe->bnthe', attn, v)
    d_state = jnp.einsum('bnshd,bnshe->bnhde', k * jnp.exp(b_last[:, :, None] - b), v)
    chunk_decay = jnp.exp(b_last)

    def step(state, inp):
        ds, dec = inp
        return dec[..., None] * state + ds, state

    _, s_prev = lax.scan(step, jnp.zeros((B, H, dk, dv), F32),
                         (jnp.moveaxis(d_state, 1, 0), jnp.moveaxis(chunk_decay, 1, 0)))
    s_prev = jnp.moveaxis(s_prev, 0, 1)
    o_inter = jnp.einsum('bnthd,bnhde->bnthe', q * jnp.exp(b), s_prev)
    return (o_intra + o_inter).reshape(B, S, H, dv)


def gla_branch(gq, gk, gv, glr, w_up, b_up):
    B, S, _ = gq.shape
    q = gq.reshape(B, S, GLA_HEADS, GLA_DK) * (GLA_DK ** -0.5)
    k = gk.reshape(B, S, GLA_HEADS, GLA_DK)
    v = gv.reshape(B, S, GLA_HEADS, GLA_DV)
    log_a = jax.nn.log_sigmoid((glr @ w_up + b_up).astype(F32)) / GLA_TAU
    log_a = log_a.reshape(B, S, GLA_HEADS, GLA_DK)
    o = gla_chunked(q, k, v, log_a)
    return o.reshape(B, S, GLA_WIDTH).astype(gq.dtype)


def s5_branch(u, a_re, a_im, log_step, b_re, b_im, c_re, c_im, d_skip, w_glu):
    B, S, _ = u.shape
    uf = u.astype(F32).reshape(B, S, S5_GROUPS, S5_CH)
    lam = lax.complex(a_re.astype(F32), a_im.astype(F32))
    step = jnp.exp(log_step.astype(F32))[:, None]
    lam_bar = jnp.exp(lam * step)
    b_bar = ((lam_bar - 1.0) / lam)[..., None] * lax.complex(b_re.astype(F32), b_im.astype(F32))
    bu = jnp.einsum('bsgc,gpc->bsgp', uf.astype(jnp.complex64), b_bar)
    a = jnp.broadcast_to(lam_bar, bu.shape)

    def combine(e1, e2):
        a1, b1 = e1
        a2, b2 = e2
        return a1 * a2, a2 * b1 + b2

    _, xs = lax.associative_scan(combine, (a, bu), axis=1)
    c = lax.complex(c_re.astype(F32), c_im.astype(F32))
    y = jnp.real(jnp.einsum('gcp,bsgp->bsgc', c, xs)) + d_skip.astype(F32).reshape(S5_GROUPS, S5_CH) * uf
    y = jax.nn.gelu(y.reshape(B, S, S5_WIDTH))
    y = y * jax.nn.sigmoid(y @ w_glu.astype(F32))
    return y.astype(u.dtype)


def dsa_branch(dq, dk, dv, diq, dik, diw, q_gain, k_gain, pos):
    B, S, _ = dq.shape
    k_sel = min(DSA_TOPK, S // 4)
    q = partial_rope(rms_norm(dq.reshape(B, S, DSA_HEADS, DSA_HD), q_gain), pos)
    k = partial_rope(rms_norm(dk.reshape(B, S, 1, DSA_HD), k_gain), pos)[:, :, 0]
    kv = jnp.concatenate([k, dv], axis=-1)
    iq = partial_rope(diq.reshape(B, S, DSA_IDX_HEADS, DSA_IDX_DIM), pos)
    ik = partial_rope(dik.reshape(B, S, 1, DSA_IDX_DIM), pos)[:, :, 0]
    iw = diw * (DSA_IDX_HEADS ** -0.5 * DSA_IDX_DIM ** -0.5)
    s_pos = jnp.arange(S)
    scale = DSA_HD ** -0.5

    def block(i):
        t0 = i * DSA_QBLOCK
        qb = lax.dynamic_slice_in_dim(q, t0, DSA_QBLOCK, axis=1)
        iqb = lax.dynamic_slice_in_dim(iq, t0, DSA_QBLOCK, axis=1)
        iwb = lax.dynamic_slice_in_dim(iw, t0, DSA_QBLOCK, axis=1)
        t_pos = t0 + jnp.arange(DSA_QBLOCK)
        rel = jax.nn.relu(jnp.einsum('bthd,bsd->bths', iqb, ik))
        score = jnp.einsum('bths,bth->bts', rel, iwb).astype(F32)
        causal = s_pos[None, :] <= t_pos[:, None]
        score = jnp.where(causal[None], score, -jnp.inf)
        _, idx = lax.top_k(score, k_sel)
        kv_sel = jax.vmap(lambda kk, ii: kk[ii])(kv, idx)
        ks, vs = kv_sel[..., :DSA_HD], kv_sel[..., DSA_HD:]
        valid = idx <= t_pos[None, :, None]
        logits = jnp.einsum('bthd,btkd->bhtk', qb, ks).astype(F32) * scale
        logits = jnp.where(valid[:, None], logits, -jnp.inf)
        p = jax.nn.softmax(logits, axis=-1).astype(vs.dtype)
        return jnp.einsum('bhtk,btkd->bthd', p, vs)

    out = lax.map(block, jnp.arange(S // DSA_QBLOCK))
    return jnp.moveaxis(out, 0, 1).reshape(B, S, DSA_WIDTH)


def mem_branch(mq, mem, mem_gain, w_kv, q_gain, k_gain):
    B, S, _ = mq.shape
    q = rms_norm(mq.reshape(B, S, MEM_HEADS, MEM_HD), q_gain)
    kv = rms_norm(mem, mem_gain) @ w_kv
    mk, mv = jnp.split(kv, 2, axis=-1)
    mk = rms_norm(mk.reshape(B, -1, MEM_HEADS, MEM_HD), k_gain)
    mv = mv.reshape(B, -1, MEM_HEADS, MEM_HD)
    logits = jnp.einsum('bthd,bmhd->bhtm', q, mk).astype(F32) * (MEM_HD ** -0.5)
    p = jax.nn.softmax(logits, axis=-1).astype(mv.dtype)
    return jnp.einsum('bhtm,bmhd->bthd', p, mv).reshape(B, S, MEM_WIDTH)


def setup_inputs(seed: int = 0) -> dict:
    key = jax.random.key(seed)
    ks = iter(jax.random.split(key, 40))
    L = DEPTH
    G, P, CH = S5_GROUPS, S5_STATE, S5_CH

    def nrm(shape, scale):
        return jax.random.normal(next(ks), shape, F32) * scale

    def gain(shape):
        return 1.0 + nrm(shape, 0.02)

    x = nrm((BATCH, SEQ, D_MODEL), 1.0)
    mem = nrm((BATCH, MEM_LEN, D_MODEL), 1.0)
    offset = jax.random.randint(next(ks), (BATCH, 1), 0, 4096, dtype=jnp.int32)
    positions = offset + jnp.arange(SEQ, dtype=jnp.int32)[None, :]
    ln_gain = gain((L, D_MODEL))
    w_in = nrm((L, D_MODEL, IN_WIDTH), D_MODEL ** -0.5)
    gla_w_up = nrm((L, GLA_GATE_RANK, GLA_HEADS * GLA_DK), GLA_GATE_RANK ** -0.5)
    gla_b_up = nrm((L, GLA_HEADS * GLA_DK), 0.1)
    s5_a_re = -0.5 + nrm((L, G, P), 0.01)
    s5_a_im = jnp.pi * jnp.arange(P, dtype=F32) + nrm((L, G, P), 0.01)
    s5_log_step = jax.random.uniform(next(ks), (L, G), F32, math.log(1e-3), math.log(1e-1))
    s5_b_re = nrm((L, G, P, CH), (2.0 * CH) ** -0.5)
    s5_b_im = nrm((L, G, P, CH), (2.0 * CH) ** -0.5)
    s5_c_re = nrm((L, G, CH, P), (2.0 * P) ** -0.5)
    s5_c_im = nrm((L, G, CH, P), (2.0 * P) ** -0.5)
    s5_d = nrm((L, S5_WIDTH), 1.0)
    s5_w_glu = nrm((L, S5_WIDTH, S5_WIDTH), S5_WIDTH ** -0.5)
    dsa_q_norm = gain((L, DSA_HD))
    dsa_k_norm = gain((L, DSA_HD))
    mem_norm = gain((L, D_MODEL))
    w_mem_kv = nrm((L, D_MODEL, 2 * MEM_WIDTH), D_MODEL ** -0.5)
    mem_q_norm = gain((L, MEM_HD))
    mem_k_norm = gain((L, MEM_HD))
    out_norm = gain((L, MIX_WIDTH))
    w_out = nrm((L, MIX_WIDTH, D_MODEL), (2.0 * DEPTH * MIX_WIDTH) ** -0.5)
    return {"x": x, "mem": mem, "positions": positions, "ln_gain": ln_gain, "w_in": w_in,
            "gla_w_up": gla_w_up, "gla_b_up": gla_b_up,
            "s5_a_re": s5_a_re, "s5_a_im": s5_a_im, "s5_log_step": s5_log_step,
            "s5_b_re": s5_b_re, "s5_b_im": s5_b_im, "s5_c_re": s5_c_re, "s5_c_im": s5_c_im,
            "s5_d": s5_d, "s5_w_glu": s5_w_glu,
            "dsa_q_norm": dsa_q_norm, "dsa_k_norm": dsa_k_norm,
            "mem_norm": mem_norm, "w_mem_kv": w_mem_kv, "mem_q_norm": mem_q_norm, "mem_k_norm": mem_k_norm,
            "out_norm": out_norm, "w_out": w_out}


def reference(x, mem, positions, ln_gain, w_in, gla_w_up, gla_b_up,
              s5_a_re, s5_a_im, s5_log_step, s5_b_re, s5_b_im, s5_c_re, s5_c_im, s5_d, s5_w_glu,
              dsa_q_norm, dsa_k_norm, mem_norm, w_mem_kv, mem_q_norm, mem_k_norm,
              out_norm, w_out):
    B, S, _ = x.shape
    n_out_heads = MIX_WIDTH // OUT_HEAD_DIM
    for l in range(DEPTH):
        h = rms_norm(x, ln_gain[l])
        p = h @ w_in[l]
        (gq, gk, gv, glr, gz, su, sz, dq, dk, dv, diq, dik, diw, dz, mq, mz) = split_cols(p)
        o_gla = gla_branch(gq, gk, gv, glr, gla_w_up[l], gla_b_up[l])
        o_s5 = s5_branch(su, s5_a_re[l], s5_a_im[l], s5_log_step[l], s5_b_re[l], s5_b_im[l],
                         s5_c_re[l], s5_c_im[l], s5_d[l], s5_w_glu[l])
        o_dsa = dsa_branch(dq, dk, dv, diq, dik, diw, dsa_q_norm[l], dsa_k_norm[l], positions)
        o_mem = mem_branch(mq, mem, mem_norm[l], w_mem_kv[l], mem_q_norm[l], mem_k_norm[l])
        o = jnp.concatenate([o_gla, o_s5, o_dsa, o_mem], axis=-1)
        o = rms_norm(o.reshape(B, S, n_out_heads, OUT_HEAD_DIM),
                     out_norm[l].reshape(n_out_heads, OUT_HEAD_DIM)).reshape(B, S, MIX_WIDTH)
        z = jnp.concatenate([gz, sz, dz, mz], axis=-1)
        x = x + (o * jax.nn.silu(z)) @ w_out[l]
    return x
```

```cpp
#include <hip/hip_runtime.h>
#include <stdint.h>
#include <stdio.h>
#include <string.h>

constexpr int NB = 4, SEQ = 4096, NTOK = NB * SEQ, DM = 2048, DEPTH = 4, MEML = 256;
constexpr int NIN = 5984, NPAD = 6144, MIX = 2048;
constexpr int C_GQ = 0, C_GK = 256, C_GV = 512, C_GLR = 1024, C_GZ = 1040, C_SU = 1552, C_SZ = 2064, C_DQ = 2576, C_DK = 3088, C_DV = 3216,
              C_DIQ = 3344, C_DIK = 4368, C_DIW = 4432, C_DZ = 4448, C_MQ = 4960, C_MZ = 5472;
constexpr float EPS = 1e-6f;
constexpr int NTHR = 512;
constexpr int LDS_BYTES = 147456;

typedef unsigned short bf16_t;
typedef short bf16x8 __attribute__((ext_vector_type(8)));
typedef short s16x4 __attribute__((ext_vector_type(4)));
typedef float f32x4 __attribute__((ext_vector_type(4)));
typedef float f32x8 __attribute__((ext_vector_type(8)));
typedef float f32x16 __attribute__((ext_vector_type(16)));
typedef unsigned u32x4 __attribute__((ext_vector_type(4)));
typedef unsigned u32x2 __attribute__((ext_vector_type(2)));
#define LAS __attribute__((address_space(3)))

__device__ __forceinline__ float bf2f(bf16_t b) { return __uint_as_float(((unsigned)b) << 16); }
__device__ __forceinline__ bf16_t f2bf(float f) { unsigned u = __float_as_uint(f); u += 0x7FFFu + ((u >> 16) & 1u); return (bf16_t)(u >> 16); }
__device__ __forceinline__ unsigned pk2bf(float lo, float hi) { return (unsigned)f2bf(lo) | ((unsigned)f2bf(hi) << 16); }
__device__ __forceinline__ float wave_sum(float v) {
#pragma unroll
    for (int o = 32; o >= 1; o >>= 1) v += __shfl_xor(v, o, 64);
    return v;
}
__device__ __forceinline__ float sigmoidf_(float x) { return 1.f / (1.f + __expf(-x)); }
__device__ __forceinline__ float siluf_(float x) { return x / (1.f + __expf(-x)); }

__device__ __forceinline__ int TIDX() { int t = (int)threadIdx.x; asm volatile("" : "+v"(t)); return t; }
#define XB_TMO      128
#define XB_XCNT(j)  (256  + 64 * (j))
#define XB_XSUB(j)  (1280 + 64 * (j))
#define XB_XGEN(j)  (2304 + 64 * (j))
#define XB_TOP      3328
#define XB_TOPGEN   3392
#define XCD_BAR_WORDS 3456
#define XB_SPIN_CAP (1u << 18)

__device__ __forceinline__ unsigned xb_ld(unsigned* p)              { return __hip_atomic_load(p, __ATOMIC_RELAXED, __HIP_MEMORY_SCOPE_AGENT); }
__device__ __forceinline__ unsigned xb_add(unsigned* p, unsigned v) { return __hip_atomic_fetch_add(p, v, __ATOMIC_RELAXED, __HIP_MEMORY_SCOPE_AGENT); }
__device__ __forceinline__ unsigned xb_xcc_id() { return (unsigned)__builtin_amdgcn_s_getreg((3 << 11) | 20) & 0xFu; }
#define XB_SPIN(cond, bar) do { unsigned _sp = 0; while (cond) { __builtin_amdgcn_s_sleep(1); \
    if ((++_sp & 255u) == 0u) { if (xb_ld(&(bar)[XB_TMO])) break; if (_sp > XB_SPIN_CAP) { atomicAdd(&(bar)[XB_TMO], 1u); break; } } } } while (0)

struct XcdBarrier {
    unsigned* bar; unsigned x;
    volatile LAS unsigned* st;
};

__device__ __forceinline__ XcdBarrier xcd_barrier_post(unsigned* bar, volatile LAS unsigned* st) {
    XcdBarrier b; b.bar = bar; b.x = xb_xcc_id(); b.st = st;
    if (TIDX() == 0) (void)xb_add(&bar[XB_XCNT(b.x)], 1u);
    return b;
}
__device__ __forceinline__ void xcd_barrier_complete(unsigned* bar, unsigned x, unsigned& nloc, unsigned& nx) {
    const unsigned G = gridDim.x * gridDim.y * gridDim.z;
    unsigned sum, cnt, mine, sp = 0u;
    for (;;) {
        sum = 0u; cnt = 0u; mine = 0u;
#pragma unroll
        for (unsigned j = 0; j < 16; ++j) { const unsigned c = xb_ld(&bar[XB_XCNT(j)]); sum += c; cnt += (c > 0u) ? 1u : 0u; mine = (j == x) ? c : mine; }
        if (sum == G) break;
        __builtin_amdgcn_s_sleep(1);
        if ((++sp & 255u) == 0u) { if (xb_ld(&bar[XB_TMO])) break; if (sp > XB_SPIN_CAP) { atomicAdd(&bar[XB_TMO], 1u); break; } }
    }
    nloc = mine > 0u ? mine : 1u; nx = cnt > 0u ? cnt : 1u;
}

__device__ __forceinline__ void xcd_barrier(const XcdBarrier& b) {
    asm volatile("s_waitcnt vmcnt(0)" ::: "memory");
    __syncthreads();
    if (TIDX() == 0) {
        unsigned* bar = b.bar; const unsigned bx = xb_xcc_id();
        __builtin_amdgcn_s_waitcnt(0);
        unsigned nloc = b.st[0], nx = b.st[1];
        if (nloc == 0u) { xcd_barrier_complete(bar, bx, nloc, nx); b.st[0] = nloc; b.st[1] = nx; }
        const unsigned old = xb_add(&bar[XB_XSUB(bx)], 1u);
        const unsigned gen = old / nloc;
        if (old + 1u == (gen + 1u) * nloc) {
            __builtin_amdgcn_fence(__ATOMIC_RELEASE, "agent");
            asm volatile("s_waitcnt vmcnt(0)" ::: "memory");
            const unsigned og = xb_add(&bar[XB_TOP], 1u);
            const unsigned tg = og / nx;
            if (og + 1u == (tg + 1u) * nx) xb_add(&bar[XB_TOPGEN], 1u);
            else XB_SPIN(xb_ld(&bar[XB_TOPGEN]) == tg, bar);
            __builtin_amdgcn_fence(__ATOMIC_ACQUIRE, "agent");
            xb_add(&bar[XB_XGEN(bx)], 1u);
            asm volatile("s_waitcnt vmcnt(0)" ::: "memory");
        } else {
            XB_SPIN(xb_ld(&bar[XB_XGEN(bx)]) == gen, bar);
            __builtin_amdgcn_fence(__ATOMIC_ACQUIRE, "agent");
            asm volatile("s_waitcnt vmcnt(0)" ::: "memory");
        }
    }
    __syncthreads();
}
namespace pg8 {
#define PG8_LAS __attribute__((address_space(3)))
typedef float f32x2 __attribute__((ext_vector_type(2)));
typedef unsigned u32x4 __attribute__((ext_vector_type(4)));
constexpr int BM = 256, BK = 64, HALF = 128, HTB = HALF * BK * 2  , STAGE_BYTES = 8 * HTB, NXCD = 8, WGM = 8;

__host__ __device__ __forceinline__ int lds_byte(int r, int c) { const int st = (r >> 4) * 2 + (c >> 5), rr = r & 15, cc = c & 31, ob = rr * 64 + cc * 2; return st * 1024 + (ob ^ (((ob >> 9) & 1) << 5)); }
__host__ __device__ __forceinline__ void stage_rc(int b, int& R, int& C) { const int st = b / 1024, sb = b % 1024, swz = sb ^ (((sb >> 9) & 1) << 5); R = (st >> 1) * 16 + swz / 64; C = (st & 1) * 32 + (swz % 64) / 2; }
__host__ __device__ __forceinline__ int perm32(int rho) { const int n = rho >> 4, i = rho & 15; return 8 * (i >> 2) + 4 * n + (i & 3); }

struct Unit { int pm, pn; };
struct Gemm { const bf16_t* A; const bf16_t* Bt; int M, N, K; };

struct StaticOrder {
    int nM, nN, nwg, G, c;
    __host__ __device__ void init(int M, int N, int G_, int c_) { nM = M / BM; nN = N / BM; nwg = nM * nN; G = G_; c = c_; }
    __host__ __device__ bool next(int i, Unit& u) const {
        const long L = (long)i * G + c; if (L >= nwg) return false;
        int wgid = (int)L; { const int q = nwg / NXCD, r = nwg % NXCD, xcd = wgid % NXCD, off = wgid / NXCD; wgid = (xcd < r ? xcd * (q + 1) : r * (q + 1) + (xcd - r) * q) + off; }
        const int nig = WGM * nN, gid = wgid / nig, fm = gid * WGM, gsz = (nM - fm) < WGM ? (nM - fm) : WGM;
        u.pm = fm + ((wgid % nig) % gsz); u.pn = (wgid % nig) / gsz; return true;
    }
    __device__ __forceinline__ void a_ready(const Unit&) const {}
    __device__ __forceinline__ void done(const Unit&) const {}
};
__device__ __forceinline__ unsigned cvt_pk_bf16(float lo, float hi) { unsigned r; asm volatile("v_cvt_pk_bf16_f32 %0, %1, %2" : "=v"(r) : "v"(lo), "v"(hi)); return r; }
struct EpiBf16Plain {
    static constexpr bool PERM = true, AFTER_DRAIN = false;
    bf16_t* O; int ldc;
    __device__ __forceinline__ void operator()(const f32x4 (&acc)[2][2][4][2], const Unit& u, int wr, int wc, int fr, int fq) const {
        const int row0 = u.pm * BM + wr * 64 + fr, col0 = u.pn * BM + wc * 32 + 8 * fq;
#pragma unroll
        for (int ai = 0; ai < 2; ++ai)
#pragma unroll
            for (int m = 0; m < 4; ++m) { bf16_t* rowp = O + (size_t)(row0 + ai * HALF + m * 16) * ldc + col0;
#pragma unroll
                for (int bj = 0; bj < 2; ++bj) { const f32x4 v0 = acc[ai][bj][m][0], v1 = acc[ai][bj][m][1];
                    u32x4 w; w.x = cvt_pk_bf16(v0[0], v0[1]); w.y = cvt_pk_bf16(v0[2], v0[3]); w.z = cvt_pk_bf16(v1[0], v1[1]); w.w = cvt_pk_bf16(v1[2], v1[3]);
                    *(u32x4*)(rowp + bj * HALF) = w; } }
    }
};
struct EpiResid {
    static constexpr bool PERM = false, AFTER_DRAIN = false;
    const float* R; float* C; int ldc;
    __device__ __forceinline__ void operator()(const f32x4 (&acc)[2][2][4][2], const Unit& u, int wr, int wc, int fr, int fq) const {
        const int row0 = u.pm * BM + wr * 64 + fr, col0 = u.pn * BM + wc * 32 + 4 * fq;
#pragma unroll
        for (int ai = 0; ai < 2; ++ai)
#pragma unroll
            for (int m = 0; m < 4; ++m) { const size_t off = (size_t)(row0 + ai * HALF + m * 16) * ldc + col0;
#pragma unroll
                for (int bj = 0; bj < 2; ++bj)
#pragma unroll
                    for (int n = 0; n < 2; ++n) { const f32x4 r = *(const f32x4*)(R + off + bj * HALF + n * 16); *(f32x4*)(C + off + bj * HALF + n * 16) = acc[ai][bj][m][n] + r; } }
    }
};
struct EpiGlu {
    static constexpr bool PERM = true, AFTER_DRAIN = false;
    const bf16_t* Y; int ldy; bf16_t* O; int ldo; int ooff;
    __device__ __forceinline__ void operator()(const f32x4 (&acc)[2][2][4][2], const Unit& u, int wr, int wc, int fr, int fq) const {
        const int row0 = u.pm * BM + wr * 64 + fr, col0 = u.pn * BM + wc * 32 + 8 * fq;
#pragma unroll
        for (int ai = 0; ai < 2; ++ai)
#pragma unroll
            for (int m = 0; m < 4; ++m) { const int row = row0 + ai * HALF + m * 16;
#pragma unroll
                for (int bj = 0; bj < 2; ++bj) { const f32x4 v0 = acc[ai][bj][m][0], v1 = acc[ai][bj][m][1];
                    const u32x4 yw = *(const u32x4*)(Y + (size_t)row * ldy + col0 + bj * HALF);
                    float y[8], g[8];
#pragma unroll
                    for (int j = 0; j < 4; ++j) { y[2 * j] = __uint_as_float(yw[j] << 16); y[2 * j + 1] = __uint_as_float(yw[j] & 0xffff0000u); }
#pragma unroll
                    for (int j = 0; j < 4; ++j) { g[j] = 1.f / (1.f + __expf(-v0[j])); g[4 + j] = 1.f / (1.f + __expf(-v1[j])); }
                    u32x4 w; w.x = cvt_pk_bf16(y[0] * g[0], y[1] * g[1]); w.y = cvt_pk_bf16(y[2] * g[2], y[3] * g[3]); w.z = cvt_pk_bf16(y[4] * g[4], y[5] * g[5]); w.w = cvt_pk_bf16(y[6] * g[6], y[7] * g[7]);
                    *(u32x4*)(O + (size_t)row * ldo + ooff + col0 + bj * HALF) = w; } }
    }
};
template <class Epi, class Sched, bool STAMP = false>
__device__ __forceinline__ void gemm_phase(PG8_LAS unsigned char* lds, const Gemm g, const Sched& S, const Epi& E, unsigned long long* stamps) {
    const int tid = TIDX(), wid = __builtin_amdgcn_readfirstlane(tid >> 6), lane = tid & 63, wr = wid >> 2, wc = wid & 3, fr = lane & 15, fq = lane >> 4;
    const int K = g.K, nt = K / BK;
    int ts_lo = 0, ts_hi = 0, nts = 0; const unsigned long long rt_entry = STAMP ? (unsigned long long)wall_clock64() : 0ull;
#define PG8_STAMP() do { if (STAMP && wid == 0 && nts < 64) { const unsigned long long _c = (unsigned long long)clock64(); \
        ts_lo = (lane == nts) ? (int)(unsigned)_c : ts_lo; ts_hi = (lane == nts) ? (int)(unsigned)(_c >> 32) : ts_hi; ++nts; } } while (0)
    PG8_STAMP();
    unsigned voffA[2], voffB[2];
#pragma unroll
    for (int i = 0; i < 2; ++i) { int R, C; stage_rc(tid * 16 + i * 8192, R, C); const int Rb = Epi::PERM ? ((R & ~31) + perm32(R & 31)) : R;
        voffA[i] = (unsigned)(R * K + C) * 2u; voffB[i] = (unsigned)(Rb * K + C) * 2u; }
    const size_t kstep = (size_t)(BK * 2);
    const size_t hstep = (size_t)HALF * K * 2;
    const size_t tstep = 2 * hstep;
    const unsigned ldsw = (unsigned)wid * 1024u;
    const int aoff = lds_byte(wr * 64 + fr, fq * 8), boff = lds_byte(wc * 32 + fr, fq * 8);
#define PG8_SA(b, h) (((b) * 2 + (h)) * HTB)
#define PG8_SB(b, h) ((4 + (b) * 2 + (h)) * HTB)
#define PG8_STAGE(bufoff, gbase, voff) do { _Pragma("unroll") for (int _i = 0; _i < 2; ++_i) \
        __builtin_amdgcn_global_load_lds((const unsigned*)((const char*)(gbase) + (voff)[_i]), (PG8_LAS unsigned*)(lds + (bufoff) + ldsw + _i * 8192), 16, 0, 0); } while (0)
#define PG8_LDA(dst, b, h) do { _Pragma("unroll") for (int m = 0; m < 4; ++m) _Pragma("unroll") for (int k = 0; k < 2; ++k) dst[m][k] = *(const PG8_LAS bf16x8*)(lds + PG8_SA(b, h) + aoff + m * 2048 + k * 1024); } while (0)
#define PG8_LDB(dst, b, h) do { _Pragma("unroll") for (int n = 0; n < 2; ++n) _Pragma("unroll") for (int k = 0; k < 2; ++k) dst[n][k] = *(const PG8_LAS bf16x8*)(lds + PG8_SB(b, h) + boff + n * 2048 + k * 1024); } while (0)
#define PG8_MMA(ai, bj, At, Bt) do { __builtin_amdgcn_s_setprio(1); _Pragma("unroll") for (int m = 0; m < 4; ++m) _Pragma("unroll") for (int n = 0; n < 2; ++n) _Pragma("unroll") for (int k = 0; k < 2; ++k) \
        acc[ai][bj][m][n] = __builtin_amdgcn_mfma_f32_16x16x32_bf16(Bt[n][k], At[m][k], acc[ai][bj][m][n], 0, 0, 0); __builtin_amdgcn_s_setprio(0); } while (0)
#define PG8_WAIT_V(n) asm volatile("s_waitcnt vmcnt(" #n ")" ::: "memory")
#define PG8_WAIT_L(n) asm volatile("s_waitcnt lgkmcnt(" #n ")" ::: "memory")
#define PG8_BAR __builtin_amdgcn_s_barrier()
#define PG8_SCHED __builtin_amdgcn_sched_barrier(0)
    Unit cur, nxt; int ui = 0;
    if (!S.next(0, cur)) return;
    f32x4 acc[2][2][4][2];
#pragma unroll
    for (int a = 0; a < 2; ++a)
#pragma unroll
        for (int b = 0; b < 2; ++b)
#pragma unroll
            for (int m = 0; m < 4; ++m)
#pragma unroll
                for (int n = 0; n < 2; ++n) acc[a][b][m][n] = (f32x4){0.f, 0.f, 0.f, 0.f};
    bf16x8 At[4][2], B0[2][2], B1[2][2];
    const char* cA = (const char*)g.A + (size_t)cur.pm * tstep; const char* cB = (const char*)g.Bt + (size_t)cur.pn * tstep;
    S.a_ready(cur);
    PG8_STAGE(PG8_SB(0, 0), cB, voffB); PG8_STAGE(PG8_SA(0, 0), cA, voffA); PG8_STAGE(PG8_SB(0, 1), cB + hstep, voffB); PG8_STAGE(PG8_SA(0, 1), cA + hstep, voffA);
    if (wr == 1) PG8_BAR;
    PG8_WAIT_V(4); PG8_BAR;
    PG8_STAGE(PG8_SB(1, 0), cB + kstep, voffB); PG8_STAGE(PG8_SA(1, 0), cA + kstep, voffA); PG8_STAGE(PG8_SB(1, 1), cB + hstep + kstep, voffB);
    PG8_WAIT_V(6); PG8_BAR;
    PG8_STAMP();
    for (;;) {
        const bool has_next = S.next(ui + 1, nxt);
        const char* nA = has_next ? (const char*)g.A + (size_t)nxt.pm * tstep : cA; const char* nB = has_next ? (const char*)g.Bt + (size_t)nxt.pn * tstep : cB;
        for (int t = 0; t < nt; t += 2) {
            const bool last = (t == nt - 2);
            const char* a1 = cA + (size_t)(t + 1) * kstep;
            const char* a2 = last ? nA : cA + (size_t)(t + 2) * kstep; const char* b2 = last ? nB : cB + (size_t)(t + 2) * kstep;
            const char* a3 = a2 + kstep; const char* b3 = b2 + kstep;
            if (last && has_next) S.a_ready(nxt);
            PG8_LDB(B0, 0, 0); PG8_SCHED; PG8_LDA(At, 0, 0); PG8_STAGE(PG8_SA(1, 1), a1 + hstep, voffA);
            PG8_WAIT_L(8); PG8_BAR; PG8_WAIT_L(0); PG8_MMA(0, 0, At, B0); PG8_BAR; PG8_SCHED;
            PG8_LDB(B1, 0, 1); PG8_STAGE(PG8_SB(0, 0), b2, voffB);
            PG8_BAR; PG8_WAIT_L(0); PG8_MMA(0, 1, At, B1); PG8_BAR;
            PG8_LDA(At, 0, 1); PG8_STAGE(PG8_SA(0, 0), a2, voffA);
            PG8_BAR; PG8_WAIT_L(0); PG8_MMA(1, 0, At, B0); PG8_BAR; PG8_SCHED;
            PG8_STAGE(PG8_SB(0, 1), b2 + hstep, voffB);
            PG8_WAIT_V(6); PG8_BAR; PG8_MMA(1, 1, At, B1); PG8_BAR;
            PG8_LDB(B0, 1, 0); PG8_SCHED; PG8_LDA(At, 1, 0); PG8_STAGE(PG8_SA(0, 1), a2 + hstep, voffA);
            PG8_WAIT_L(8); PG8_BAR; PG8_WAIT_L(0); PG8_MMA(0, 0, At, B0); PG8_BAR; PG8_SCHED;
            PG8_LDB(B1, 1, 1); PG8_STAGE(PG8_SB(1, 0), b3, voffB);
            PG8_BAR; PG8_WAIT_L(0); PG8_MMA(0, 1, At, B1); PG8_BAR;
            PG8_LDA(At, 1, 1); PG8_STAGE(PG8_SA(1, 0), a3, voffA);
            PG8_BAR; PG8_WAIT_L(0); PG8_MMA(1, 0, At, B0); PG8_BAR; PG8_SCHED;
            PG8_STAGE(PG8_SB(1, 1), b3 + hstep, voffB);
            PG8_WAIT_V(6); PG8_BAR; PG8_MMA(1, 1, At, B1); PG8_BAR;
        }
        PG8_STAMP();
        if constexpr (!Epi::AFTER_DRAIN) { E(acc, cur, wr, wc, fr, fq); S.done(cur); }
        PG8_STAMP();
        if (!has_next) break;
#pragma unroll
        for (int a = 0; a < 2; ++a)
#pragma unroll
            for (int b = 0; b < 2; ++b)
#pragma unroll
                for (int m = 0; m < 4; ++m)
#pragma unroll
                    for (int n = 0; n < 2; ++n) acc[a][b][m][n] = (f32x4){0.f, 0.f, 0.f, 0.f};
        cur = nxt; cA = nA; cB = nB; ++ui;
    }
    PG8_WAIT_V(0);
    if (wr == 0) PG8_BAR;
    PG8_BAR;
    if constexpr (Epi::AFTER_DRAIN) { E.fused(acc, cur, wr, wc, fr, fq, lds, wid, lane); S.done(cur); }
    PG8_STAMP();
    if (STAMP && wid == 0) { stamps[lane] = lane < nts ? (((unsigned long long)(unsigned)ts_hi << 32) | (unsigned)ts_lo) : 0ull;
        if (lane == 62) stamps[62] = rt_entry; if (lane == 63) stamps[63] = (unsigned long long)wall_clock64(); }
#undef PG8_STAMP
#undef PG8_SA
#undef PG8_SB
#undef PG8_STAGE
#undef PG8_LDA
#undef PG8_LDB
#undef PG8_MMA
#undef PG8_WAIT_V
#undef PG8_WAIT_L
#undef PG8_BAR
#undef PG8_SCHED
}
}
namespace att {
constexpr int D = 128, NW = 8, QBLK = 32, KVBLK = 64;
constexpr float SCALE = 0.088388347648318440f, THR = 8.f;
constexpr int SHM_V = KVBLK * D * 2, SHM_K = KVBLK * D * 2, SHM_ATTN = 2 * SHM_V + 2 * SHM_K + NW * 64 * 4;
#define KSWZ(row, colB) ((row) * 256 + ((colB) ^ (((row) & 7) << 4)))
#define SBAR() __builtin_amdgcn_sched_barrier(0)
__device__ __forceinline__ int crow(int r, int hi) { return (r & 3) + 8 * (r >> 2) + 4 * hi; }
__device__ __forceinline__ unsigned cvtpk(float lo, float hi) { unsigned r; asm volatile("v_cvt_pk_bf16_f32 %0, %1, %2" : "=v"(r) : "v"(lo), "v"(hi)); return r; }

template <bool MASKED>
__device__ __forceinline__ void partialSM(f32x16& p0, f32x16& p1, float& m_reg, float& mn, float& alpha, unsigned long long mw, int hi) {
  constexpr float C = SCALE * 1.4426950408889634f;
  if (MASKED) {
    const unsigned w0 = (unsigned)mw >> (4 * hi), w1 = (unsigned)(mw >> 32) >> (4 * hi);
    const float ninf = -__builtin_inff();
#pragma unroll
    for (int r = 0; r < 16; ++r) { const int bit = (r & 3) + 8 * (r >> 2);
      p0[r] = ((w0 >> bit) & 1u) ? p0[r] : ninf; p1[r] = ((w1 >> bit) & 1u) ? p1[r] : ninf; }
  }
  float pmax = p0[0];
#pragma unroll
  for (int r = 1; r < 16; ++r) pmax = fmaxf(pmax, p0[r]);
#pragma unroll
  for (int r = 0; r < 16; ++r) pmax = fmaxf(pmax, p1[r]);
  { auto rr = __builtin_amdgcn_permlane32_swap(__float_as_uint(pmax), __float_as_uint(pmax), false, false);
    pmax = fmaxf(__uint_as_float(rr[0]), __uint_as_float(rr[1])); }
  if (__builtin_expect(__all(pmax - m_reg <= THR / SCALE), 1)) { mn = m_reg; alpha = 1.f; }
  else { mn = fmaxf(m_reg, pmax); alpha = __builtin_amdgcn_exp2f((m_reg - mn) * C); m_reg = mn; }
  const float mnC = -mn * C;
#pragma unroll
  for (int r = 0; r < 16; ++r) p0[r] = fmaf(p0[r], C, mnC);
#pragma unroll
  for (int r = 0; r < 16; ++r) p1[r] = fmaf(p1[r], C, mnC);
#pragma unroll
  for (int r = 0; r < 16; ++r) p0[r] = __builtin_amdgcn_exp2f(p0[r]);
}
__device__ __forceinline__ void finishSM(f32x16& p0, f32x16& p1, float alpha, float& l_reg, bf16x8& pa0, bf16x8& pa1, bf16x8& pa2, bf16x8& pa3) {
#pragma unroll
  for (int r = 0; r < 16; ++r) p1[r] = __builtin_amdgcn_exp2f(p1[r]);
  float ps = 0;
#pragma unroll
  for (int r = 0; r < 16; ++r) ps += p0[r];
#pragma unroll
  for (int r = 0; r < 16; ++r) ps += p1[r];
  { auto rr = __builtin_amdgcn_permlane32_swap(__float_as_uint(ps), __float_as_uint(ps), false, false);
    ps = __uint_as_float(rr[0]) + __uint_as_float(rr[1]); }
  l_reg = l_reg * alpha + ps;
#define PK4(P, BASE, OUT) do { unsigned a0 = cvtpk(P[BASE + 0], P[BASE + 1]), a1 = cvtpk(P[BASE + 2], P[BASE + 3]);   \
    unsigned b0 = cvtpk(P[BASE + 4], P[BASE + 5]), b1 = cvtpk(P[BASE + 6], P[BASE + 7]);                              \
    auto r0 = __builtin_amdgcn_permlane32_swap(a0, b0, false, false); auto r1 = __builtin_amdgcn_permlane32_swap(a1, b1, false, false); \
    u32x4 w = {r0[0], r1[0], r0[1], r1[1]}; OUT = *reinterpret_cast<bf16x8*>(&w); } while (0)
  PK4(p0, 0, pa0); PK4(p0, 8, pa1); PK4(p1, 0, pa2); PK4(p1, 8, pa3);
#undef PK4
}
__device__ __forceinline__ void qkt(f32x16& p0, f32x16& p1, const char* Ks, const bf16x8* qr, int r32, int hi) {
  p0 = f32x16{}; p1 = f32x16{};
#pragma unroll
  for (int d0 = 0; d0 < 8; ++d0) { const int cb = (d0 * 16 + hi * 8) * 2;
    bf16x8 b0 = *reinterpret_cast<const bf16x8*>(Ks + KSWZ(r32, cb));
    bf16x8 b1 = *reinterpret_cast<const bf16x8*>(Ks + KSWZ(32 + r32, cb));
    p0 = __builtin_amdgcn_mfma_f32_32x32x16_bf16(b0, qr[d0], p0, 0, 0, 0);
    p1 = __builtin_amdgcn_mfma_f32_32x32x16_bf16(b1, qr[d0], p1, 0, 0, 0); }
}
__device__ __forceinline__ int v_st(int k, int c) { const int kk = (k & ~0xC) | ((k & 4) << 1) | ((k & 8) >> 1); return ((kk >> 3) * 4 + (c >> 5)) * 512 + ((kk & 7) * 32 + (c & 31)) * 2; }
__device__ __forceinline__ int v_rd_base(int lane) { return ((lane & 3) << 3) | (((lane >> 2) & 3) << 6) | (((lane >> 4) & 1) << 5) | (((lane >> 5) & 1) << 8); }
constexpr int v_rd_off(int d0, int ks, int half) { return d0 * 512 + ks * 4096 + half * 2048; }
template <int OFF> __device__ __forceinline__ s16x4 tr_read(int vb) {
  s16x4 r; asm volatile("ds_read_b64_tr_b16 %0, %1 offset:%2" : "=&v"(r) : "v"(vb), "i"(OFF) : "memory"); return r;
}
template <int D0> __device__ __forceinline__ void pv_one(f32x16& od, int vb, bf16x8 pa0, bf16x8 pa1, bf16x8 pa2, bf16x8 pa3) {
  const s16x4 l0 = tr_read<v_rd_off(D0, 0, 0)>(vb), h0 = tr_read<v_rd_off(D0, 0, 1)>(vb), l1 = tr_read<v_rd_off(D0, 1, 0)>(vb), h1 = tr_read<v_rd_off(D0, 1, 1)>(vb);
  const s16x4 l2 = tr_read<v_rd_off(D0, 2, 0)>(vb), h2 = tr_read<v_rd_off(D0, 2, 1)>(vb), l3 = tr_read<v_rd_off(D0, 3, 0)>(vb), h3 = tr_read<v_rd_off(D0, 3, 1)>(vb);
  asm volatile("s_waitcnt lgkmcnt(0)" ::: "memory"); SBAR();
#define PK(L, H) (bf16x8){L[0], L[1], L[2], L[3], H[0], H[1], H[2], H[3]}
  od = __builtin_amdgcn_mfma_f32_32x32x16_bf16(pa0, PK(l0, h0), od, 0, 0, 0);
  od = __builtin_amdgcn_mfma_f32_32x32x16_bf16(pa1, PK(l1, h1), od, 0, 0, 0);
  od = __builtin_amdgcn_mfma_f32_32x32x16_bf16(pa2, PK(l2, h2), od, 0, 0, 0);
  od = __builtin_amdgcn_mfma_f32_32x32x16_bf16(pa3, PK(l3, h3), od, 0, 0, 0);
#undef PK
}
__device__ __forceinline__ void pv_d0(f32x16* o, int vb, bf16x8 pa0, bf16x8 pa1, bf16x8 pa2, bf16x8 pa3) {
  pv_one<0>(o[0], vb, pa0, pa1, pa2, pa3); pv_one<1>(o[1], vb, pa0, pa1, pa2, pa3); pv_one<2>(o[2], vb, pa0, pa1, pa2, pa3); pv_one<3>(o[3], vb, pa0, pa1, pa2, pa3);
}

template <bool MASKED, int LDK, class OutRow>
__device__ __forceinline__ void attn_body(const bf16_t* __restrict__ Qw, const bf16_t* __restrict__ Kh, const bf16_t* __restrict__ Vh, int NT,
                                          const unsigned long long* __restrict__ mrow, const OutRow& Ow, char* lds) {
  const int tid = TIDX(), wid = tid >> 6, lane = tid & 63, r32 = lane & 31, hi = lane >> 5;
  char* V_lds = lds; char* K_lds = lds + 2 * SHM_V;
  float* ws = (float*)(lds + 2 * SHM_V + 2 * SHM_K) + wid * 64; float* li_l = ws; float* al_l = ws + 32;
  float m_reg = -1e30f, l_reg = 0; f32x16 o[4] = {}; bf16x8 qr[8];
#pragma unroll
  for (int d0 = 0; d0 < 8; ++d0) qr[d0] = *reinterpret_cast<const bf16x8*>(Qw + d0 * 16);
  const int sr = tid >> 4, sc = (tid & 15) * 8, vst0 = v_st(sr, sc), vst1 = v_st(32 + sr, sc);
  const int vb0 = (int)(uintptr_t)V_lds + v_rd_base(lane);
  struct { bf16x8 vs0, vs1, ks0, ks1; } sr_[2];
#define SLOAD(i, k0) do { sr_[i].vs0 = *reinterpret_cast<const bf16x8*>(&Vh[(long)((k0) + sr) * LDK + sc]); sr_[i].vs1 = *reinterpret_cast<const bf16x8*>(&Vh[(long)((k0) + 32 + sr) * LDK + sc]); \
    sr_[i].ks0 = *reinterpret_cast<const bf16x8*>(&Kh[(long)((k0) + sr) * LDK + sc]); sr_[i].ks1 = *reinterpret_cast<const bf16x8*>(&Kh[(long)((k0) + 32 + sr) * LDK + sc]); } while (0)
#define SWRITE(b, i) do { *(bf16x8*)(V_lds + (b) * SHM_V + vst0) = sr_[i].vs0;          \
    *(bf16x8*)(V_lds + (b) * SHM_V + vst1) = sr_[i].vs1; int kc = sc * 2;               \
    *(bf16x8*)(K_lds + (b) * SHM_K + KSWZ(sr, kc)) = sr_[i].ks0;                       \
    *(bf16x8*)(K_lds + (b) * SHM_K + KSWZ(32 + sr, kc)) = sr_[i].ks1; } while (0)
#define SWAIT() asm volatile("s_waitcnt vmcnt(4)" ::: "memory")
#define RESC(a) do { if (__any((a) < 1.f)) { if (hi == 0) al_l[r32] = (a); asm volatile("s_waitcnt lgkmcnt(0)" ::: "memory"); \
    _Pragma("unroll") for (int d = 0; d < 4; ++d) _Pragma("unroll") for (int r = 0; r < 16; ++r) o[d][r] *= al_l[crow(r, hi)]; } } while (0)
  f32x16 pA0, pA1, pB0, pB1; float mnA, mnB, alA, alB; bf16x8 pa0, pa1, pa2, pa3;
  unsigned long long mwA = 0ull, mwB = 0ull;
  constexpr int SE = 0, SO = 1;
  SLOAD(SE, 0); asm volatile("s_waitcnt vmcnt(0)" ::: "memory"); SWRITE(0, SE); __syncthreads();
  if (MASKED) mwA = mrow[0];
  qkt(pA0, pA1, K_lds, qr, r32, hi); partialSM<MASKED>(pA0, pA1, m_reg, mnA, alA, mwA, hi);
  SLOAD(SO, KVBLK); if (2 < NT) SLOAD(SE, 2 * KVBLK);
  if (2 < NT) SWAIT(); else asm volatile("s_waitcnt vmcnt(0)" ::: "memory");
  SWRITE(1, SO); __syncthreads();
  for (int j = 1; j + 1 < NT; j += 2) {
    if (MASKED) { mwB = mrow[j]; mwA = mrow[j + 1]; }
    SBAR(); qkt(pB0, pB1, K_lds + SHM_K, qr, r32, hi);
    finishSM(pA0, pA1, alA, l_reg, pa0, pa1, pa2, pa3); SBAR();
    SLOAD(SO, (j + 2) * KVBLK); SBAR();
    pv_d0(o, vb0, pa0, pa1, pa2, pa3); partialSM<MASKED>(pB0, pB1, m_reg, mnB, alB, mwB, hi);
    __syncthreads(); SWAIT(); SWRITE(0, SE);
    RESC(alB); __syncthreads();
    SBAR(); qkt(pA0, pA1, K_lds, qr, r32, hi);
    finishSM(pB0, pB1, alB, l_reg, pa0, pa1, pa2, pa3); SBAR();
    if (j + 3 < NT) SLOAD(SE, (j + 3) * KVBLK); SBAR();
    pv_d0(o, vb0 + SHM_V, pa0, pa1, pa2, pa3); partialSM<MASKED>(pA0, pA1, m_reg, mnA, alA, mwA, hi);
    __syncthreads(); if (j + 3 < NT) SWAIT(); else asm volatile("s_waitcnt vmcnt(0)" ::: "memory");
    SWRITE(1, SO);
    RESC(alA); __syncthreads();
  }
  if (MASKED) mwB = mrow[NT - 1];
  SBAR(); qkt(pB0, pB1, K_lds + SHM_K, qr, r32, hi);
  finishSM(pA0, pA1, alA, l_reg, pa0, pa1, pa2, pa3); SBAR();
  pv_d0(o, vb0, pa0, pa1, pa2, pa3); partialSM<MASKED>(pB0, pB1, m_reg, mnB, alB, mwB, hi);
  __syncthreads(); RESC(alB);
  finishSM(pB0, pB1, alB, l_reg, pa0, pa1, pa2, pa3); SBAR();
  pv_d0(o, vb0 + SHM_V, pa0, pa1, pa2, pa3);
  if (hi == 0) li_l[r32] = l_reg; asm volatile("s_waitcnt lgkmcnt(0)" ::: "memory");
  float rli[16];
#pragma unroll
  for (int r = 0; r < 16; ++r) rli[r] = __builtin_amdgcn_rcpf(li_l[crow(r, hi)]);
#pragma unroll
  for (int r = 0; r < 16; ++r) { bf16_t* orow = Ow(crow(r, hi));
#pragma unroll
    for (int d0 = 0; d0 < 4; ++d0) orow[d0 * 32 + r32] = f2bf(o[d0][r] * rli[r]); }
  __syncthreads();
#undef SLOAD
#undef SWRITE
#undef SWAIT
#undef RESC
}
}
constexpr size_t al256(size_t x) { return (x + 255) / 256 * 256; }
constexpr size_t WS_CTL   = 0;
constexpr size_t CTL_BYTES = 65536;
constexpr size_t WS_WINT  = WS_CTL + CTL_BYTES;
constexpr size_t WS_WOUTT = WS_WINT + al256((size_t)DEPTH * NPAD * DM * 2);
constexpr size_t WS_WKVT  = WS_WOUTT + al256((size_t)DEPTH * DM * MIX * 2);
constexpr size_t WS_WGLUT = WS_WKVT + al256((size_t)DEPTH * 1024 * DM * 2);
constexpr size_t WS_MEMN  = WS_WGLUT + al256((size_t)DEPTH * 512 * 512 * 2);
constexpr size_t WS_KVMEM = WS_MEMN + al256((size_t)NB * MEML * DM * 2);
constexpr size_t WS_XN    = WS_KVMEM + al256((size_t)NB * MEML * DEPTH * 1024 * 2);
constexpr size_t WS_P     = WS_XN + al256((size_t)NTOK * DM * 2);
constexpr size_t WS_XBUF  = WS_P + al256((size_t)NTOK * NPAD * 2);
constexpr size_t WS_OCAT  = WS_XBUF + al256((size_t)NTOK * DM * 4);
constexpr size_t WS_MASK  = WS_OCAT + al256((size_t)NTOK * MIX * 2);
constexpr size_t WS_IW    = WS_MASK + al256((size_t)NTOK * 64 * 8);
constexpr size_t WS_YBUF  = WS_IW + al256((size_t)NTOK * 16 * 4);
constexpr size_t WS_ROPE  = WS_YBUF + al256((size_t)NTOK * 512 * 2);
constexpr size_t WS_S5P   = WS_ROPE + al256((size_t)NTOK * 48 * 4);
constexpr size_t S5P_BYTES = (size_t)DEPTH * 32 * (64 * 2 + 64 * 2 + 64 * 16 * 2) * 4;
constexpr size_t WS_GLAS  = WS_S5P + al256(S5P_BYTES);
constexpr size_t WS_GLAD  = WS_GLAS + al256((size_t)NB * 64 * 4 * 64 * 128 * 4);
constexpr size_t WS_END   = WS_GLAD + al256((size_t)NB * 64 * 4 * 64 * 4);

struct Params {
    const float* x; const float* mem; const int* pos; const float* ln_gain; const float* w_in; const float* gla_w_up; const float* gla_b_up;
    const float* s5_a_re; const float* s5_a_im; const float* s5_log_step; const float* s5_b_re; const float* s5_b_im; const float* s5_c_re; const float* s5_c_im;
    const float* s5_d; const float* s5_w_glu; const float* dsa_q_norm; const float* dsa_k_norm; const float* mem_norm; const float* w_mem_kv;
    const float* mem_q_norm; const float* mem_k_norm; const float* out_norm; const float* w_out;
    float* out;
    unsigned* ctl; bf16_t* WinT; bf16_t* WoutT; bf16_t* WkvT; bf16_t* WgluT; bf16_t* memn; bf16_t* kvmem; bf16_t* xn; bf16_t* p; float* xbuf; bf16_t* ocat;
    unsigned long long* mask; float* iw; bf16_t* ybuf; float* rope; float* s5p; float* glas; float* glad;
};

__device__ __forceinline__ void transpose_tiles(const float* __restrict__ src, int K, int Nsrc, int Ndst, const float* __restrict__ scale, bf16_t* __restrict__ dst,
                                                int tile, float* lds_tile  ) {
    const int tid = TIDX(), ntn = Ndst / 64;
    const int tk = tile / ntn, tn = tile % ntn, k0 = tk * 64, n0 = tn * 64;
    __syncthreads();
    { const int ty = tid >> 4, tx = tid & 15;
#pragma unroll
      for (int i = 0; i < 2; ++i) { const int k = k0 + ty + 32 * i, n = n0 + 4 * tx;
        f32x4 v = (f32x4){0.f, 0.f, 0.f, 0.f};
        if (n < Nsrc) v = *(const f32x4*)(src + (size_t)k * Nsrc + n);
        const float s = scale ? scale[k] : 1.f;
        float* t = lds_tile + (ty + 32 * i) * 65 + 4 * tx; t[0] = v[0] * s; t[1] = v[1] * s; t[2] = v[2] * s; t[3] = v[3] * s; } }
    __syncthreads();
    { const int n = tid >> 3, kq = tid & 7;
      u32x4 w;
      w.x = pk2bf(lds_tile[(8 * kq + 0) * 65 + n], lds_tile[(8 * kq + 1) * 65 + n]); w.y = pk2bf(lds_tile[(8 * kq + 2) * 65 + n], lds_tile[(8 * kq + 3) * 65 + n]);
      w.z = pk2bf(lds_tile[(8 * kq + 4) * 65 + n], lds_tile[(8 * kq + 5) * 65 + n]); w.w = pk2bf(lds_tile[(8 * kq + 6) * 65 + n], lds_tile[(8 * kq + 7) * 65 + n]);
      *(u32x4*)(dst + (size_t)(n0 + n) * K + k0 + 8 * kq) = w; }
}

__device__ __forceinline__ void rmsnorm_rows(const float* __restrict__ X, bf16_t* __restrict__ Y, int nrows) {
    const int wid = TIDX() >> 6, lane = TIDX() & 63;
    for (int row = blockIdx.x * 8 + wid; row < nrows; row += gridDim.x * 8) {
        const float* xr = X + (size_t)row * DM; f32x4 v[8]; float ss = 0.f;
#pragma unroll
        for (int i = 0; i < 8; ++i) { v[i] = *(const f32x4*)(xr + 4 * lane + 256 * i); ss += v[i][0] * v[i][0] + v[i][1] * v[i][1] + v[i][2] * v[i][2] + v[i][3] * v[i][3]; }
        ss = wave_sum(ss); const float r = rsqrtf(ss * (1.f / DM) + EPS);
        bf16_t* yr = Y + (size_t)row * DM;
#pragma unroll
        for (int i = 0; i < 8; ++i) { u32x2 w; w.x = pk2bf(v[i][0] * r, v[i][1] * r); w.y = pk2bf(v[i][2] * r, v[i][3] * r); *(u32x2*)(yr + 4 * lane + 256 * i) = w; }
    }
}

__device__ __forceinline__ void phase_prologue1(const Params& P, char* lds) {
    float* tile = (float*)lds;
    constexpr int T_IN = (DM / 64) * (NPAD / 64), T_OUT = (MIX / 64) * (DM / 64), T_KV = (DM / 64) * (1024 / 64), T_GLU = 8 * 8;
    constexpr int TOT = DEPTH * (T_IN + T_OUT + T_KV + T_GLU);
    for (int u = blockIdx.x; u < TOT; u += gridDim.x) {
        int l = u / (T_IN + T_OUT + T_KV + T_GLU), r = u % (T_IN + T_OUT + T_KV + T_GLU);
        if (r < T_IN) transpose_tiles(P.w_in + (size_t)l * DM * NIN, DM, NIN, NPAD, P.ln_gain + l * DM, P.WinT + (size_t)l * NPAD * DM, r, tile);
        else if ((r -= T_IN) < T_OUT) transpose_tiles(P.w_out + (size_t)l * MIX * DM, MIX, DM, DM, P.out_norm + l * MIX, P.WoutT + (size_t)l * DM * MIX, r, tile);
        else if ((r -= T_OUT) < T_KV) transpose_tiles(P.w_mem_kv + (size_t)l * DM * 1024, DM, 1024, 1024, P.mem_norm + l * DM, P.WkvT + (size_t)l * 1024 * DM, r, tile);
        else { r -= T_KV; transpose_tiles(P.s5_w_glu + (size_t)l * 512 * 512, 512, 512, 512, nullptr, P.WgluT + (size_t)l * 512 * 512, r, tile); }
    }
    rmsnorm_rows(P.mem, P.memn, NB * MEML);
}
__device__ __forceinline__ void phase_rope_table(const Params& P) {
    for (int idx = blockIdx.x * NTHR + TIDX(); idx < NTOK * 24; idx += gridDim.x * NTHR) {
        const int tok = idx / 24, i = idx % 24;
        const float e = (i < 16) ? -((float)i * 2.0f / 32.0f) : -((float)(i - 16) * 2.0f / 16.0f);
        const float inv_freq = exp2f(e * 18.931568569324174f);
        const float ang = (float)P.pos[tok] * inv_freq;
        const double a = (double)ang; const double k = rint(a * 0.15915494309189535); const float rf = (float)fma(-k, 6.283185307179586, a);
        P.rope[(size_t)idx * 2] = cosf(rf); P.rope[(size_t)idx * 2 + 1] = sinf(rf);
    }
}

__device__ __forceinline__ void phase_rmsnorm_x(const Params& P, int layer) { rmsnorm_rows(layer == 0 ? P.x : P.xbuf, P.xn, NTOK); }

__device__ __forceinline__ void phase_memk_norm(const Params& P) {
    const int wid = TIDX() >> 6, lane = TIDX() & 63;
    for (int it = blockIdx.x * 8 + wid; it < NB * MEML * DEPTH * 4; it += gridDim.x * 8) {
        const int row = it / (DEPTH * 4), l = (it / 4) % DEPTH, h = it % 4;
        bf16_t* kp = P.kvmem + (size_t)row * (DEPTH * 1024) + l * 1024 + h * 128 + 2 * lane;
        const unsigned w = *(const unsigned*)kp; const float a = __uint_as_float(w << 16), b = __uint_as_float(w & 0xffff0000u);
        const float ss = wave_sum(a * a + b * b), r = rsqrtf(ss * (1.f / 128.f) + EPS);
        const float* g = P.mem_k_norm + l * 128 + 2 * lane;
        *(unsigned*)kp = pk2bf(a * r * g[0], b * r * g[1]);
    }
}

__device__ __forceinline__ void ld8f(const bf16_t* p, float (&v)[8]) { const u32x4 w = *(const u32x4*)p;
#pragma unroll
    for (int j = 0; j < 4; ++j) { v[2 * j] = __uint_as_float(w[j] << 16); v[2 * j + 1] = __uint_as_float(w[j] & 0xffff0000u); } }
__device__ __forceinline__ void st8f(bf16_t* p, const float (&v)[8]) { u32x4 w; w.x = pk2bf(v[0], v[1]); w.y = pk2bf(v[2], v[3]); w.z = pk2bf(v[4], v[5]); w.w = pk2bf(v[6], v[7]); *(u32x4*)p = w; }
__device__ __forceinline__ float sum16(float v) { v += __shfl_xor(v, 1, 64); v += __shfl_xor(v, 2, 64); v += __shfl_xor(v, 4, 64); v += __shfl_xor(v, 8, 64); return v; }

__device__ __forceinline__ void head128_norm_rope(bf16_t* hp, int l16, const float* __restrict__ gain, const float* __restrict__ cs, bool rope, bool do_store) {
    float v[8]; ld8f(hp + 8 * l16, v);
    float ss = 0.f;
#pragma unroll
    for (int j = 0; j < 8; ++j) ss += v[j] * v[j];
    ss = sum16(ss); const float r = rsqrtf(ss * (1.f / 128.f) + EPS);
#pragma unroll
    for (int j = 0; j < 8; ++j) v[j] = v[j] * r * gain[8 * l16 + j];
    if (rope) {
        float o[8];
#pragma unroll
        for (int j = 0; j < 8; ++j) o[j] = __shfl_xor(v[j], 2, 64);
        if (l16 < 4) { const int fi = (l16 & 1) * 8;
#pragma unroll
            for (int j = 0; j < 8; ++j) { const float c = cs[(fi + j) * 2], s = cs[(fi + j) * 2 + 1];
                v[j] = (l16 < 2) ? (v[j] * c - o[j] * s) : (v[j] * c + o[j] * s); } }
    }
    if (do_store) st8f(hp + 8 * l16, v);
}
__device__ __forceinline__ void rope16_inplace(bf16_t* ip, const float* __restrict__ cs) {
    float a[8], b[8]; ld8f(ip, a); ld8f(ip + 8, b);
#pragma unroll
    for (int j = 0; j < 8; ++j) { const float c = cs[2 * j], s = cs[2 * j + 1], x1 = a[j], x2 = b[j]; a[j] = x1 * c - x2 * s; b[j] = x2 * c + x1 * s; }
    st8f(ip, a); st8f(ip + 8, b);
}
__device__ __forceinline__ void phase_prep(const Params& P, int layer) {
    const int wid = TIDX() >> 6, lane = TIDX() & 63, l16 = lane & 15, grp = lane >> 4;
    for (int tok = blockIdx.x * 8 + wid; tok < NTOK; tok += gridDim.x * 8) {
        bf16_t* row = P.p + (size_t)tok * NPAD;
        const float* cs32 = P.rope + (size_t)tok * 48; const float* cs16 = cs32 + 32;
        head128_norm_rope(row + C_DQ + grp * 128, l16, P.dsa_q_norm + layer * 128, cs32, true, true);
        head128_norm_rope(row + C_DK, l16, P.dsa_k_norm + layer * 128, cs32, true, grp == 0);
        head128_norm_rope(row + C_MQ + grp * 128, l16, P.mem_q_norm + layer * 128, cs32, false, true);
        if ((lane & 3) == 0) rope16_inplace(row + C_DIQ + lane * 16, cs16);
        if (lane == 0) rope16_inplace(row + C_DIK, cs16);
        if (lane < 16) P.iw[(size_t)tok * 16 + lane] = bf2f(row[C_DIW + lane]) * (1.f / 32.f);
    }
}
struct MemOutRow { bf16_t* base; __device__ __forceinline__ bf16_t* operator()(int r) const { return base + (size_t)r * MIX; } };
__device__ __forceinline__ void unit_mem_attn(const Params& P, int layer, int u, char* lds) {
    const int b = u >> 6, h = (u >> 4) & 3, qb = u & 15, tok0 = b * SEQ + qb * 256;
    const int wid = TIDX() >> 6, lane = TIDX() & 63, r32 = lane & 31, hi = lane >> 5;
    const bf16_t* Qw = P.p + (size_t)(tok0 + wid * 32 + r32) * NPAD + C_MQ + h * 128 + hi * 8;
    const bf16_t* Kh = P.kvmem + (size_t)(b * MEML) * (DEPTH * 1024) + layer * 1024 + h * 128;
    MemOutRow ow; ow.base = P.ocat + (size_t)(tok0 + wid * 32) * MIX + 1536 + h * 128;
    att::attn_body<false, DEPTH * 1024, MemOutRow>(Qw, Kh, Kh + 512, MEML / 64, nullptr, ow, lds);
}

__device__ __forceinline__ void phase_gate(const Params& P, int c_lo, int c_hi) {
    const int wid = TIDX() >> 6, lane = TIDX() & 63;
    const int c0 = lane * 32;
    const int seg = c0 >> 9, zc = (seg == 0 ? C_GZ : seg == 1 ? C_SZ : seg == 2 ? C_DZ : C_MZ) + (c0 & 511);
    const bool act = (c0 >= c_lo) && (c0 < c_hi);
    for (int tok = blockIdx.x * 8 + wid; tok < NTOK; tok += gridDim.x * 8) {
        if (!act) { bf16_t* gz_ = P.xn + (size_t)tok * MIX + c0; const u32x4 zz = {0u, 0u, 0u, 0u};
#pragma unroll
            for (int i = 0; i < 4; ++i) *(u32x4*)(gz_ + 8 * i) = zz;
            continue; }
        const bf16_t* op = P.ocat + (size_t)tok * MIX + c0; const bf16_t* zp = P.p + (size_t)tok * NPAD + zc; bf16_t* gp = P.xn + (size_t)tok * MIX + c0;
        float o[32]; float ss = 0.f;
#pragma unroll
        for (int i = 0; i < 4; ++i) { float v[8]; ld8f(op + 8 * i, v);
#pragma unroll
            for (int j = 0; j < 8; ++j) { o[8 * i + j] = v[j]; ss += v[j] * v[j]; } }
        ss += __shfl_xor(ss, 1, 64); ss += __shfl_xor(ss, 2, 64);
        const float r = rsqrtf(ss * (1.f / 128.f) + EPS);
#pragma unroll
        for (int i = 0; i < 4; ++i) { float z[8], g[8]; ld8f(zp + 8 * i, z);
#pragma unroll
            for (int j = 0; j < 8; ++j) g[j] = o[8 * i + j] * r * siluf_(z[j]);
            st8f(gp + 8 * i, g); }
    }
}

__device__ __forceinline__ void phase_gemm_in(const Params& P, int layer, char* lds) {
    pg8::Gemm g; g.A = P.xn; g.Bt = P.WinT + (size_t)layer * NPAD * DM; g.M = NTOK; g.N = NPAD; g.K = DM;
    pg8::StaticOrder S; S.init(g.M, g.N, (int)gridDim.x, (int)blockIdx.x);
    pg8::EpiBf16Plain E; E.O = P.p; E.ldc = NPAD;
    pg8::gemm_phase<pg8::EpiBf16Plain, pg8::StaticOrder, false>((PG8_LAS unsigned char*)lds, g, S, E, nullptr);
}
__device__ __forceinline__ void phase_gemm_out(const Params& P, int layer, char* lds) {
    pg8::Gemm g; g.A = P.xn; g.Bt = P.WoutT + (size_t)layer * DM * MIX; g.M = NTOK; g.N = DM; g.K = MIX;
    pg8::StaticOrder S; S.init(g.M, g.N, (int)gridDim.x, (int)blockIdx.x);
    pg8::EpiResid E; E.R = (layer == 0) ? P.x : P.xbuf; E.C = (layer == DEPTH - 1) ? P.out : P.xbuf; E.ldc = DM;
    pg8::gemm_phase<pg8::EpiResid, pg8::StaticOrder, false>((PG8_LAS unsigned char*)lds, g, S, E, nullptr);
}
__device__ __forceinline__ void phase_gemm_kv(const Params& P, char* lds) {
    pg8::Gemm g; g.A = P.memn; g.Bt = P.WkvT; g.M = NB * MEML; g.N = DEPTH * 1024; g.K = DM;
    pg8::StaticOrder S; S.init(g.M, g.N, (int)gridDim.x, (int)blockIdx.x);
    pg8::EpiBf16Plain E; E.O = P.kvmem; E.ldc = DEPTH * 1024;
    pg8::gemm_phase<pg8::EpiBf16Plain, pg8::StaticOrder, false>((PG8_LAS unsigned char*)lds, g, S, E, nullptr);
}
__device__ __forceinline__ void mma_tile(f32x16& acc, const char* A, int lda, const char* B, int ldb, int K, int lane) {
    const int r = lane & 31, kh = lane >> 5;
    const char* ap = A + r * lda + kh * 16; const char* bp = B + r * ldb + kh * 16;
    for (int k = 0; k < K; k += 16) {
        const bf16x8 a = *(const bf16x8*)(ap + k * 2); const bf16x8 b = *(const bf16x8*)(bp + k * 2);
        acc = __builtin_amdgcn_mfma_f32_32x32x16_bf16(a, b, acc, 0, 0, 0);
    }
}
__device__ __forceinline__ int crow32(int r, int hi) { return (r & 3) + 8 * (r >> 2) + 4 * hi; }
__device__ __forceinline__ float log_sigmoid_(float x) { return fminf(x, 0.f) - log1pf(__expf(-fabsf(x))); }

constexpr int GLA_ST = 144;
constexpr int GLA_ST2 = 272;
__device__ __forceinline__ void gla_front(const Params& P, int layer, int tok0, int h, float (&bv)[8], float* glr_s  , float* tot_s  , float* bm_s  , float* bl_s  ) {
    const int tid = TIDX(), d = tid & 63, tg = tid >> 6;
    __syncthreads();
    if (tid < 128) { const int t = tid >> 1, half = tid & 1; float v[8]; ld8f(P.p + (size_t)(tok0 + t) * NPAD + C_GLR + half * 8, v);
#pragma unroll
        for (int j = 0; j < 8; ++j) glr_s[t * 16 + half * 8 + j] = v[j]; }
    float wu[16];
#pragma unroll
    for (int r = 0; r < 16; ++r) wu[r] = P.gla_w_up[((size_t)layer * 16 + r) * 256 + h * 64 + d];
    const float bias = P.gla_b_up[layer * 256 + h * 64 + d];
    __syncthreads();
    float run = 0.f;
#pragma unroll
    for (int i = 0; i < 8; ++i) { const int t = tg * 8 + i; float a = bias;
#pragma unroll
        for (int r = 0; r < 16; ++r) a = fmaf(glr_s[t * 16 + r], wu[r], a);
        run += log_sigmoid_(a) * (1.f / 16.f); bv[i] = run; }
    tot_s[tg * 64 + d] = run;
    __syncthreads();
    float off = 0.f, all = 0.f;
#pragma unroll
    for (int g = 0; g < 8; ++g) { const float v = tot_s[g * 64 + d]; off += (g < tg) ? v : 0.f; all += v; }
#pragma unroll
    for (int i = 0; i < 8; ++i) bv[i] += off;
    if (tg == 4) bm_s[d] = bv[0];
    if (tg == 0) bl_s[d] = all;
    __syncthreads();
}

__device__ __forceinline__ void unit_gla_a(const Params& P, int layer, int u, char* lds) {
    const int b = u >> 8, n = (u >> 2) & 63, h = u & 3, tok0 = b * SEQ + n * 64;
    const int tid = TIDX(), wid = tid >> 6, lane = tid & 63, d = tid & 63, tg = tid >> 6;
    char* kdT = lds;
    char* vT = lds + 64 * GLA_ST;
    float* glr_s = (float*)(lds + 64 * GLA_ST + 128 * GLA_ST); float* tot_s = glr_s + 1024; float* bm_s = tot_s + 512; float* bl_s = bm_s + 64;
    float bv[8]; gla_front(P, layer, tok0, h, bv, glr_s, tot_s, bm_s, bl_s);
    const float bl = bl_s[d];
#pragma unroll
    for (int i = 0; i < 8; ++i) { const int t = tg * 8 + i; const float k = bf2f(P.p[(size_t)(tok0 + t) * NPAD + C_GK + h * 64 + d]);
        *(bf16_t*)(kdT + d * GLA_ST + t * 2) = f2bf(k * __expf(bl - bv[i])); }
    { const int e = tid & 127, sg = tid >> 7;
#pragma unroll
      for (int i = 0; i < 16; ++i) { const int s = sg * 16 + i; *(bf16_t*)(vT + e * GLA_ST + s * 2) = P.p[(size_t)(tok0 + s) * NPAD + C_GV + h * 128 + e]; } }
    __syncthreads();
    const int mt = wid >> 2, nt = wid & 3, hi = lane >> 5;
    f32x16 acc = {}; mma_tile(acc, kdT + mt * 32 * GLA_ST, GLA_ST, vT + nt * 32 * GLA_ST, GLA_ST, 64, lane);
    float* dst = P.glas + ((size_t)((b * 64 + n) * 4 + h)) * 64 * 128;
#pragma unroll
    for (int r = 0; r < 16; ++r) dst[(mt * 32 + crow32(r, hi)) * 128 + nt * 32 + (lane & 31)] = acc[r];
    if (tid < 64) P.glad[((size_t)((b * 64 + n) * 4 + h)) * 64 + tid] = __expf(bl_s[tid]);
}

__device__ __forceinline__ void phase_gla_scan(const Params& P) {
    for (int idx = blockIdx.x * NTHR + TIDX(); idx < NB * 4 * 64 * 128; idx += gridDim.x * NTHR) {
        const int e = idx & 127, d = (idx >> 7) & 63, h = (idx >> 13) & 3, b = idx >> 15;
        float S = 0.f;
        for (int n0 = 0; n0 < 64; n0 += 8) {
            float ds[8], dc[8];
#pragma unroll
            for (int i = 0; i < 8; ++i) { const size_t cu = (size_t)((b * 64 + n0 + i) * 4 + h); ds[i] = P.glas[cu * 8192 + d * 128 + e]; dc[i] = P.glad[cu * 64 + d]; }
#pragma unroll
            for (int i = 0; i < 8; ++i) { const size_t cu = (size_t)((b * 64 + n0 + i) * 4 + h); P.glas[cu * 8192 + d * 128 + e] = S; S = fmaf(dc[i], S, ds[i]); }
        }
    }
}

__device__ __forceinline__ void unit_gla_c(const Params& P, int layer, int u, char* lds) {
    const int b = u >> 8, n = (u >> 2) & 63, h = u & 3, tok0 = b * SEQ + n * 64;
    const int tid = TIDX(), wid = tid >> 6, lane = tid & 63, d = tid & 63, tg = tid >> 6, hi = lane >> 5;
    char* Acat = lds;
    char* Bcat = Acat + 64 * GLA_ST2;
    char* qe = Bcat + 128 * GLA_ST2;
    char* ke = qe + 64 * GLA_ST;
    float* glr_s = (float*)(ke + 64 * GLA_ST); float* tot_s = glr_s + 1024; float* bm_s = tot_s + 512; float* bl_s = bm_s + 64;
    float bv[8]; gla_front(P, layer, tok0, h, bv, glr_s, tot_s, bm_s, bl_s);
    const float m = bm_s[d];
#pragma unroll
    for (int i = 0; i < 8; ++i) { const int t = tg * 8 + i; const bf16_t* row = P.p + (size_t)(tok0 + t) * NPAD;
        const float q = bf2f(row[C_GQ + h * 64 + d]) * 0.125f, k = bf2f(row[C_GK + h * 64 + d]);
        *(bf16_t*)(qe + t * GLA_ST + d * 2) = f2bf(q * __expf(bv[i] - m));
        *(bf16_t*)(ke + t * GLA_ST + d * 2) = f2bf(k * __expf(m - bv[i]));
        *(bf16_t*)(Acat + t * GLA_ST2 + (64 + d) * 2) = f2bf(q * __expf(bv[i])); }
    { const int e = tid & 127, sg = tid >> 7;
      const float* sp = P.glas + ((size_t)((b * 64 + n) * 4 + h)) * 64 * 128;
#pragma unroll
      for (int i = 0; i < 16; ++i) { const int s = sg * 16 + i;
          *(bf16_t*)(Bcat + e * GLA_ST2 + s * 2) = P.p[(size_t)(tok0 + s) * NPAD + C_GV + h * 128 + e];
          *(bf16_t*)(Bcat + e * GLA_ST2 + (64 + s) * 2) = f2bf(sp[s * 128 + e]); } }
    __syncthreads();
    if (wid < 4) { const int mt = wid >> 1, nt = wid & 1;
        f32x16 acc = {}; mma_tile(acc, qe + mt * 32 * GLA_ST, GLA_ST, ke + nt * 32 * GLA_ST, GLA_ST, 64, lane);
#pragma unroll
        for (int r = 0; r < 16; ++r) { const int t = mt * 32 + crow32(r, hi), s = nt * 32 + (lane & 31);
            *(bf16_t*)(Acat + t * GLA_ST2 + s * 2) = f2bf(s <= t ? acc[r] : 0.f); } }
    __syncthreads();
    { const int mt = wid >> 2, nt = wid & 3;
      f32x16 acc = {}; mma_tile(acc, Acat + mt * 32 * GLA_ST2, GLA_ST2, Bcat + nt * 32 * GLA_ST2, GLA_ST2, 128, lane);
#pragma unroll
      for (int r = 0; r < 16; ++r) { const int t = mt * 32 + crow32(r, hi);
          P.ocat[(size_t)(tok0 + t) * MIX + h * 128 + nt * 32 + (lane & 31)] = f2bf(acc[r]); } }
}
constexpr int S5P_STRIDE = 2304;
__device__ __forceinline__ void phase_s5_params(const Params& P) {
    for (int idx = blockIdx.x * NTHR + TIDX(); idx < DEPTH * 32 * 64; idx += gridDim.x * NTHR) {
        const int p = idx & 63, lg = idx >> 6;
        const float ar = P.s5_a_re[idx], ai = P.s5_a_im[idx], step = expf(P.s5_log_step[lg]);
        const float mag = expf(ar * step), th = ai * step;
        const float lr = mag * cosf(th), li = mag * sinf(th);
        float* o = P.s5p + (size_t)lg * S5P_STRIDE;
        o[2 * p] = lr; o[2 * p + 1] = li;
        { const float mag512 = expf(512.f * ar * step); const double a = 512.0 * (double)th; const double k = rint(a * 0.15915494309189535); const float rf = (float)fma(-k, 6.283185307179586, a);
          o[128 + 2 * p] = mag512 * cosf(rf); o[128 + 2 * p + 1] = mag512 * sinf(rf); }
        const float xr = lr - 1.f, xi = li, den = 1.f / (ar * ar + ai * ai);
        const float fr = (xr * ar + xi * ai) * den, fi = (xi * ar - xr * ai) * den;
        for (int c = 0; c < 16; ++c) { const float br = P.s5_b_re[(size_t)idx * 16 + c], bi = P.s5_b_im[(size_t)idx * 16 + c];
            o[256 + (p * 16 + c) * 2] = fr * br - fi * bi; o[256 + (p * 16 + c) * 2 + 1] = fr * bi + fi * br; }
    }
}
__device__ __forceinline__ float gelu_tanh_(float x) { const float u = 0.7978845608028654f * (x + 0.044715f * x * x * x); const float e = __expf(-2.f * fabsf(u)); const float th = copysignf((1.f - e) / (1.f + e), u); return 0.5f * x * (1.f + th); }

constexpr int S5_XST = 272;
__device__ __forceinline__ void unit_s5(const Params& P, int layer, int u, char* lds) {
    const int b = u >> 5, g = u & 31, tid = TIDX(), wid = tid >> 6, lane = tid & 63, hi = lane >> 5;
    char* Cm = lds;
    float* ends = (float*)(lds + 32 * S5_XST);
    char* wbase = lds + 32 * S5_XST + 8 * 64 * 2 * 4 + wid * (32 * S5_XST + 32 * 16 * 4);
    char* Xs = wbase;
    float* us = (float*)(wbase + 32 * S5_XST);
    const float* sp = P.s5p + (size_t)(layer * 32 + g) * S5P_STRIDE;
    __syncthreads();
    for (int i = tid; i < 32 * 128; i += NTHR) { const int c = i >> 7, pp = i & 127; float v = 0.f;
        if (c < 16) v = (pp < 64) ? P.s5_c_re[((size_t)(layer * 32 + g) * 16 + c) * 64 + pp] : -P.s5_c_im[((size_t)(layer * 32 + g) * 16 + c) * 64 + (pp - 64)];
        *(bf16_t*)(Cm + c * S5_XST + pp * 2) = f2bf(v); }
    const float lr = sp[2 * lane], li = sp[2 * lane + 1];
    float Br[16], Bi[16];
#pragma unroll
    for (int c = 0; c < 16; ++c) { Br[c] = sp[256 + (lane * 16 + c) * 2]; Bi[c] = sp[256 + (lane * 16 + c) * 2 + 1]; }
    const int tokw = b * SEQ + wid * 512;
    const float dsk = P.s5_d[layer * 512 + g * 16 + (lane & 15)];
    float xr = 0.f, xi = 0.f;
    for (int pass = 0; pass < 2; ++pass) {
        for (int sc = 0; sc < 16; ++sc) {
            const int tok0 = tokw + sc * 32;
            if (lane < 32) { float v[8]; const bf16_t* up = P.p + (size_t)(tok0 + lane) * NPAD + C_SU + g * 16;
                ld8f(up, v);
#pragma unroll
                for (int j = 0; j < 8; ++j) us[lane * 16 + j] = v[j];
                ld8f(up + 8, v);
#pragma unroll
                for (int j = 0; j < 8; ++j) us[lane * 16 + 8 + j] = v[j]; }
            for (int t = 0; t < 32; ++t) {
                const f32x4 u0 = *(const f32x4*)(us + t * 16), u1 = *(const f32x4*)(us + t * 16 + 4), u2 = *(const f32x4*)(us + t * 16 + 8), u3 = *(const f32x4*)(us + t * 16 + 12);
                float br = 0.f, bi = 0.f;
#pragma unroll
                for (int c = 0; c < 4; ++c) { br = fmaf(Br[c], u0[c], br); bi = fmaf(Bi[c], u0[c], bi); br = fmaf(Br[4 + c], u1[c], br); bi = fmaf(Bi[4 + c], u1[c], bi);
                    br = fmaf(Br[8 + c], u2[c], br); bi = fmaf(Bi[8 + c], u2[c], bi); br = fmaf(Br[12 + c], u3[c], br); bi = fmaf(Bi[12 + c], u3[c], bi); }
                const float nr = fmaf(lr, xr, fmaf(-li, xi, br)), ni = fmaf(lr, xi, fmaf(li, xr, bi));
                xr = nr; xi = ni;
                if (pass == 1) { *(bf16_t*)(Xs + t * S5_XST + lane * 2) = f2bf(xr); *(bf16_t*)(Xs + t * S5_XST + (64 + lane) * 2) = f2bf(xi); }
            }
            if (pass == 1) {
                f32x16 acc = {}; mma_tile(acc, Xs, S5_XST, Cm, S5_XST, 128, lane);
                const int c = lane & 31;
                if (c < 16) {
#pragma unroll
                    for (int r = 0; r < 16; ++r) { const int t = crow32(r, hi); const float y = acc[r] + dsk * us[t * 16 + c];
                        P.ybuf[(size_t)(tok0 + t) * 512 + g * 16 + c] = f2bf(gelu_tanh_(y)); } }
            }
        }
        if (pass == 0) {
            ends[(wid * 64 + lane) * 2] = xr; ends[(wid * 64 + lane) * 2 + 1] = xi;
            __syncthreads();
            const float pr = sp[128 + 2 * lane], pi = sp[128 + 2 * lane + 1];
            xr = 0.f; xi = 0.f;
            for (int j = 0; j < wid; ++j) { const float er = ends[(j * 64 + lane) * 2], ei = ends[(j * 64 + lane) * 2 + 1];
                const float nr = pr * xr - pi * xi + er, ni = pr * xi + pi * xr + ei; xr = nr; xi = ni; }
        }
    }
}
constexpr int TOPK = 256;
__device__ __forceinline__ unsigned f2key(float f) { const unsigned u = __float_as_uint(f); return u ^ ((u & 0x80000000u) ? 0xffffffffu : 0x80000000u); }

__device__ __forceinline__ void unit_dsa_index(const Params& P, int u, char* lds) {
    const int b = u & 3, t0 = (511 - (u >> 2)) * 8;
    const int tid = TIDX(), wid = tid >> 6, lane = tid & 63, r32 = lane & 31, hi = lane >> 5;
    float* sc = (float*)lds;
    const bf16_t* pb = P.p + (size_t)b * SEQ * NPAD;
    __syncthreads();
    {
        bf16x8 afr[4][4]; f32x16 wv[4];
        const int qsel = (r32 >> 2) & 1, head = (r32 & 3) + 4 * (r32 >> 3);
#pragma unroll
        for (int rt = 0; rt < 4; ++rt) { const bf16_t* qp = pb + (size_t)(t0 + 2 * rt + qsel) * NPAD + C_DIQ + head * 64 + hi * 8;
#pragma unroll
            for (int kk = 0; kk < 4; ++kk) afr[rt][kk] = *(const bf16x8*)(qp + kk * 16);
            const float* wp = P.iw + (size_t)(b * SEQ + t0 + 2 * rt + hi) * 16;
#pragma unroll
            for (int i = 0; i < 4; ++i) { const f32x4 w4 = *(const f32x4*)(wp + 4 * i); wv[rt][4 * i] = w4[0]; wv[rt][4 * i + 1] = w4[1]; wv[rt][4 * i + 2] = w4[2]; wv[rt][4 * i + 3] = w4[3]; } }
        const int ntile = (t0 + 7) / 32 + 1;
        for (int j = wid; j < ntile; j += 8) {
            const bf16_t* kp = pb + (size_t)(j * 32 + r32) * NPAD + C_DIK + hi * 8;
            bf16x8 bfr[4];
#pragma unroll
            for (int kk = 0; kk < 4; ++kk) bfr[kk] = *(const bf16x8*)(kp + kk * 16);
#pragma unroll
            for (int rt = 0; rt < 4; ++rt) { f32x16 acc = {};
#pragma unroll
                for (int kk = 0; kk < 4; ++kk) acc = __builtin_amdgcn_mfma_f32_32x32x16_bf16(afr[rt][kk], bfr[kk], acc, 0, 0, 0);
                float s = 0.f;
#pragma unroll
                for (int i = 0; i < 16; ++i) s = fmaf(fmaxf(acc[i], 0.f), wv[rt][i], s);
                sc[(2 * rt + hi) * 4096 + j * 32 + r32] = s + 0.f; }
        }
    }
    __syncthreads();
    {
        const int t = t0 + wid; const float* srow = sc + wid * 4096;
        unsigned key[64];
#pragma unroll
        for (int j = 0; j < 64; ++j) { const int s = j * 64 + lane; key[j] = (s <= t) ? f2key(srow[s]) : 0u; }
        unsigned long long* mout = P.mask + (size_t)(b * SEQ + t) * 64;
        unsigned long long myword = 0ull;
        if (t + 1 <= TOPK) {
#pragma unroll
            for (int j = 0; j < 64; ++j) { const unsigned long long m = __ballot(j * 64 + lane <= t); if (lane == j) myword = m; }
        } else {
            const int nreg = t / 64 + 1;
            unsigned T = 0u; int cntT = t + 1;
            for (int bit = 31; bit >= 0; --bit) {
                const unsigned cand = T | (1u << bit); int cnt = 0;
#pragma unroll
                for (int j = 0; j < 64; ++j) if (j < nreg) cnt += __popcll(__ballot(key[j] >= cand));
                if (cnt >= TOPK) { T = cand; cntT = cnt; if (cnt == TOPK) break; }
            }
            if (cntT == TOPK) {
#pragma unroll
                for (int j = 0; j < 64; ++j) { const unsigned long long m = __ballot(key[j] >= T); if (lane == j) myword = m; }
            } else {
                int ngt = 0;
#pragma unroll
                for (int j = 0; j < 64; ++j) ngt += __popcll(__ballot(key[j] > T));
                int need = TOPK - ngt;
#pragma unroll
                for (int j = 0; j < 64; ++j) { const unsigned long long eq = __ballot(key[j] == T), gt = __ballot(key[j] > T);
                    const int ne = __popcll(eq); unsigned long long take = eq;
                    if (ne > need) { take = 0ull; int left = need; unsigned long long e2 = eq;
                        while (left > 0) { const unsigned long long lowbit = e2 & (0ull - e2); take |= lowbit; e2 ^= lowbit; --left; } }
                    need -= (ne > need) ? need : ne;
                    const unsigned long long m = gt | take; if (lane == j) myword = m; }
            }
        }
        mout[lane] = myword;
    }
}

struct DsaOutRow { bf16_t* base; int wid; __device__ __forceinline__ bf16_t* operator()(int r) const { const int rho = wid * 32 + r; return base + (size_t)(rho >> 2) * MIX + (rho & 3) * 128; } };
__device__ __forceinline__ void unit_dsa_attn(const Params& P, int u, char* lds) {
    const int b = u & 3, qb = 63 - (u >> 2), t0 = qb * 64, tokb = b * SEQ;
    const int wid = TIDX() >> 6, lane = TIDX() & 63, r32 = lane & 31, hi = lane >> 5;
    const int rho = wid * 32 + r32, tq = t0 + (rho >> 2), hq = rho & 3;
    const bf16_t* Qw = P.p + (size_t)(tokb + tq) * NPAD + C_DQ + hq * 128 + hi * 8;
    const bf16_t* Kh = P.p + (size_t)tokb * NPAD + C_DK; const bf16_t* Vh = P.p + (size_t)tokb * NPAD + C_DV;
    const unsigned long long* mrow = P.mask + (size_t)(tokb + tq) * 64;
    DsaOutRow ow; ow.base = P.ocat + (size_t)(tokb + t0) * MIX + 1024; ow.wid = wid;
    const int NT = (qb + 2) & ~1;
    att::attn_body<true, NPAD, DsaOutRow>(Qw, Kh, Vh, NT, mrow, ow, lds);
}
__device__ __forceinline__ void phase_gemm_glu(const Params& P, int layer, char* lds) {
    pg8::Gemm g; g.A = P.ybuf; g.Bt = P.WgluT + (size_t)layer * 512 * 512; g.M = NTOK; g.N = 512; g.K = 512;
    pg8::StaticOrder S; S.init(g.M, g.N, (int)gridDim.x, (int)blockIdx.x);
    pg8::EpiGlu E; E.Y = P.ybuf; E.ldy = 512; E.O = P.ocat; E.ldo = MIX; E.ooff = 512;
    pg8::gemm_phase<pg8::EpiGlu, pg8::StaticOrder, false>((PG8_LAS unsigned char*)lds, g, S, E, nullptr);
}
constexpr int LDS_TAIL = LDS_BYTES - 64;

__global__ __launch_bounds__(NTHR, 2) void k_mega(Params P) {
    extern __shared__ __attribute__((aligned(16))) char lds[];
    if (TIDX() == 0) *(uint4*)(lds + LDS_TAIL) = make_uint4(0u, 0u, 0u, 0u);
    __syncthreads();
    XcdBarrier bar = xcd_barrier_post(P.ctl, (volatile LAS unsigned*)(lds + LDS_TAIL));
    const int G = gridDim.x, B = blockIdx.x;
    phase_prologue1(P, lds); phase_rope_table(P); phase_s5_params(P); phase_rmsnorm_x(P, 0);
    xcd_barrier(bar);
    for (int layer = 0; layer < DEPTH; ++layer) {
        if (layer > 0) { phase_rmsnorm_x(P, layer); xcd_barrier(bar); }
        phase_gemm_in(P, layer, lds);
        if (layer == 0) phase_gemm_kv(P, lds);
        xcd_barrier(bar);
        phase_prep(P, layer);
        if (layer == 0) phase_memk_norm(P);
        xcd_barrier(bar);
        for (int u = B; u < 128; u += G) unit_s5(P, layer, u, lds);
        for (int u = B; u < 2048; u += G) unit_dsa_index(P, u, lds);
        for (int u = B; u < 256; u += G) unit_mem_attn(P, layer, u, lds);
        for (int u = B; u < 1024; u += G) unit_gla_a(P, layer, u, lds);
        xcd_barrier(bar);
        phase_gla_scan(P);
        for (int u = B; u < 256; u += G) unit_dsa_attn(P, u, lds);
        phase_gemm_glu(P, layer, lds);
        xcd_barrier(bar);
        for (int u = B; u < 1024; u += G) unit_gla_c(P, layer, u, lds);
        xcd_barrier(bar);
        phase_gate(P, 0, 2048);
        xcd_barrier(bar);
        phase_gemm_out(P, layer, lds);
        xcd_barrier(bar);
    }
}

extern "C" void kernel_launch(void* const* d_in, const int* in_sizes, int n_in, void* d_out, int out_size, void* d_ws, size_t ws_size, hipStream_t stream) {
    if (n_in != 24 || ws_size < WS_END) { fprintf(stderr, "kernel_launch: unexpected n_in %d or ws_size %zu (< %zu)\n", n_in, ws_size, (size_t)WS_END); return; }
    Params P; memset(&P, 0, sizeof(P));
    P.x = (const float*)d_in[0]; P.mem = (const float*)d_in[1]; P.pos = (const int*)d_in[2]; P.ln_gain = (const float*)d_in[3]; P.w_in = (const float*)d_in[4];
    P.gla_w_up = (const float*)d_in[5]; P.gla_b_up = (const float*)d_in[6]; P.s5_a_re = (const float*)d_in[7]; P.s5_a_im = (const float*)d_in[8]; P.s5_log_step = (const float*)d_in[9];
    P.s5_b_re = (const float*)d_in[10]; P.s5_b_im = (const float*)d_in[11]; P.s5_c_re = (const float*)d_in[12]; P.s5_c_im = (const float*)d_in[13]; P.s5_d = (const float*)d_in[14];
    P.s5_w_glu = (const float*)d_in[15]; P.dsa_q_norm = (const float*)d_in[16]; P.dsa_k_norm = (const float*)d_in[17]; P.mem_norm = (const float*)d_in[18]; P.w_mem_kv = (const float*)d_in[19];
    P.mem_q_norm = (const float*)d_in[20]; P.mem_k_norm = (const float*)d_in[21]; P.out_norm = (const float*)d_in[22]; P.w_out = (const float*)d_in[23];
    P.out = (float*)d_out;
    char* ws = (char*)d_ws;
    P.ctl = (unsigned*)(ws + WS_CTL); P.WinT = (bf16_t*)(ws + WS_WINT); P.WoutT = (bf16_t*)(ws + WS_WOUTT); P.WkvT = (bf16_t*)(ws + WS_WKVT); P.WgluT = (bf16_t*)(ws + WS_WGLUT);
    P.memn = (bf16_t*)(ws + WS_MEMN); P.kvmem = (bf16_t*)(ws + WS_KVMEM); P.xn = (bf16_t*)(ws + WS_XN); P.p = (bf16_t*)(ws + WS_P); P.xbuf = (float*)(ws + WS_XBUF);
    P.ocat = (bf16_t*)(ws + WS_OCAT); P.mask = (unsigned long long*)(ws + WS_MASK); P.iw = (float*)(ws + WS_IW); P.ybuf = (bf16_t*)(ws + WS_YBUF); P.rope = (float*)(ws + WS_ROPE);
    P.s5p = (float*)(ws + WS_S5P); P.glas = (float*)(ws + WS_GLAS); P.glad = (float*)(ws + WS_GLAD);
    static int grid = 0;
    if (!grid) {
        int dev = 0, cus = 0, per_cu = 0;
        (void)hipGetDevice(&dev); (void)hipDeviceGetAttribute(&cus, hipDeviceAttributeMultiprocessorCount, dev);
        (void)hipFuncSetAttribute((const void*)k_mega, hipFuncAttributeMaxDynamicSharedMemorySize, LDS_BYTES);
        (void)hipOccupancyMaxActiveBlocksPerMultiprocessor(&per_cu, (const void*)k_mega, NTHR, LDS_BYTES);
        if (per_cu < 1) fprintf(stderr, "kernel_launch: occupancy query reports %d blocks per CU\n", per_cu);
        grid = cus > 0 ? cus : 256;
    }
    (void)hipMemsetAsync(ws + WS_CTL, 0, CTL_BYTES, stream);
    hipLaunchKernelGGL(k_mega, dim3(grid), dim3(NTHR), LDS_BYTES, stream, P);
}
```

```cpp
#include <hip/hip_runtime.h>
#include <stdint.h>
#include <stdio.h>
#include <string.h>

constexpr int NB = 4, SEQ = 4096, NTOK = NB * SEQ, DM = 2048, DEPTH = 4, MEML = 256;
constexpr int NIN = 5984, NPAD = 6144, MIX = 2048;
constexpr int C_GQ = 0, C_GK = 256, C_GV = 512, C_GLR = 1024, C_GZ = 1040, C_SU = 1552, C_SZ = 2064, C_DQ = 2576, C_DK = 3088, C_DV = 3216,
              C_DIQ = 3344, C_DIK = 4368, C_DIW = 4432, C_DZ = 4448, C_MQ = 4960, C_MZ = 5472;
constexpr float EPS = 1e-6f;
constexpr int NTHR = 512;
constexpr int LDS_BYTES = 147456;

typedef unsigned short bf16_t;
typedef short bf16x8 __attribute__((ext_vector_type(8)));
typedef short s16x4 __attribute__((ext_vector_type(4)));
typedef float f32x4 __attribute__((ext_vector_type(4)));
typedef float f32x8 __attribute__((ext_vector_type(8)));
typedef float f32x16 __attribute__((ext_vector_type(16)));
typedef unsigned u32x4 __attribute__((ext_vector_type(4)));
typedef unsigned u32x2 __attribute__((ext_vector_type(2)));
#define LAS __attribute__((address_space(3)))

__device__ __forceinline__ float bf2f(bf16_t b) { return __uint_as_float(((unsigned)b) << 16); }
__device__ __forceinline__ bf16_t f2bf(float f) { unsigned u = __float_as_uint(f); u += 0x7FFFu + ((u >> 16) & 1u); return (bf16_t)(u >> 16); }
__device__ __forceinline__ unsigned pk2bf(float lo, float hi) { return (unsigned)f2bf(lo) | ((unsigned)f2bf(hi) << 16); }
__device__ __forceinline__ float sigmoidf_(float x) { return 1.f / (1.f + __expf(-x)); }
__device__ __forceinline__ float siluf_(float x) { return x / (1.f + __expf(-x)); }

__device__ __forceinline__ int TIDX() { int t = (int)threadIdx.x; asm volatile("" : "+v"(t)); return t; }
__device__ __forceinline__ float shx(float v, int m) { const int src = ((TIDX() & 63) ^ m) << 2; return __int_as_float(__builtin_amdgcn_ds_bpermute(src, __float_as_int(v))); }
__device__ __forceinline__ float wave_sum(float v) {
#pragma unroll
    for (int o = 32; o >= 1; o >>= 1) v += shx(v, o);
    return v;
}
#define XB_TMO      128
#define XB_XCNT(j)  (256  + 64 * (j))
#define XB_XSUB(j)  (1280 + 64 * (j))
#define XB_XGEN(j)  (2304 + 64 * (j))
#define XB_TOP      3328
#define XB_TOPGEN   3392
#define XCD_BAR_WORDS 3456
#define XB_SPIN_CAP (1u << 18)

__device__ __forceinline__ unsigned xb_ld(unsigned* p)              { return __hip_atomic_load(p, __ATOMIC_RELAXED, __HIP_MEMORY_SCOPE_AGENT); }
__device__ __forceinline__ unsigned xb_add(unsigned* p, unsigned v) { return __hip_atomic_fetch_add(p, v, __ATOMIC_RELAXED, __HIP_MEMORY_SCOPE_AGENT); }
__device__ __forceinline__ unsigned xb_xcc_id() { return (unsigned)__builtin_amdgcn_s_getreg((3 << 11) | 20) & 0xFu; }
#define XB_SPIN(cond, bar) do { unsigned _sp = 0; while (cond) { __builtin_amdgcn_s_sleep(1); \
    if ((++_sp & 255u) == 0u) { if (xb_ld(&(bar)[XB_TMO])) break; if (_sp > XB_SPIN_CAP) { atomicAdd(&(bar)[XB_TMO], 1u); break; } } } } while (0)

struct XcdBarrier {
    unsigned* bar; unsigned x;
    volatile LAS unsigned* st;
};

__device__ __forceinline__ XcdBarrier xcd_barrier_post(unsigned* bar, volatile LAS unsigned* st) {
    XcdBarrier b; b.bar = bar; b.x = xb_xcc_id(); b.st = st;
    if (TIDX() == 0) (void)xb_add(&bar[XB_XCNT(b.x)], 1u);
    return b;
}
__device__ __forceinline__ void xcd_barrier_complete(unsigned* bar, unsigned x, unsigned& nloc, unsigned& nx) {
    const unsigned G = gridDim.x * gridDim.y * gridDim.z;
    unsigned sum, cnt, mine, sp = 0u;
    for (;;) {
        sum = 0u; cnt = 0u; mine = 0u;
#pragma unroll
        for (unsigned j = 0; j < 16; ++j) { const unsigned c = xb_ld(&bar[XB_XCNT(j)]); sum += c; cnt += (c > 0u) ? 1u : 0u; mine = (j == x) ? c : mine; }
        if (sum == G) break;
        __builtin_amdgcn_s_sleep(1);
        if ((++sp & 255u) == 0u) { if (xb_ld(&bar[XB_TMO])) break; if (sp > XB_SPIN_CAP) { atomicAdd(&bar[XB_TMO], 1u); break; } }
    }
    nloc = mine > 0u ? mine : 1u; nx = cnt > 0u ? cnt : 1u;
}

__device__ __forceinline__ void xcd_barrier(const XcdBarrier& b) {
    asm volatile("s_waitcnt vmcnt(0)" ::: "memory");
    __syncthreads();
    if (TIDX() == 0) {
        unsigned* bar = b.bar; const unsigned bx = xb_xcc_id();
        __builtin_amdgcn_s_waitcnt(0);
        unsigned nloc = b.st[0], nx = b.st[1];
        if (nloc == 0u) { xcd_barrier_complete(bar, bx, nloc, nx); b.st[0] = nloc; b.st[1] = nx; }
        const unsigned old = xb_add(&bar[XB_XSUB(bx)], 1u);
        const unsigned gen = old / nloc;
        if (old + 1u == (gen + 1u) * nloc) {
            __builtin_amdgcn_fence(__ATOMIC_RELEASE, "agent");
            asm volatile("s_waitcnt vmcnt(0)" ::: "memory");
            const unsigned og = xb_add(&bar[XB_TOP], 1u);
            const unsigned tg = og / nx;
            if (og + 1u == (tg + 1u) * nx) xb_add(&bar[XB_TOPGEN], 1u);
            else XB_SPIN(xb_ld(&bar[XB_TOPGEN]) == tg, bar);
            __builtin_amdgcn_fence(__ATOMIC_ACQUIRE, "agent");
            xb_add(&bar[XB_XGEN(bx)], 1u);
            asm volatile("s_waitcnt vmcnt(0)" ::: "memory");
        } else {
            XB_SPIN(xb_ld(&bar[XB_XGEN(bx)]) == gen, bar);
            __builtin_amdgcn_fence(__ATOMIC_ACQUIRE, "agent");
            asm volatile("s_waitcnt vmcnt(0)" ::: "memory");
        }
    }
    __syncthreads();
}
namespace pg8 {
#define PG8_LAS __attribute__((address_space(3)))
typedef float f32x2 __attribute__((ext_vector_type(2)));
typedef unsigned u32x4 __attribute__((ext_vector_type(4)));
constexpr int BM = 256, BK = 64, HALF = 128, HTB = HALF * BK * 2  , STAGE_BYTES = 8 * HTB, NXCD = 8, WGM = 8;

__host__ __device__ __forceinline__ int lds_byte(int r, int c) { const int st = (r >> 4) * 2 + (c >> 5), rr = r & 15, cc = c & 31, ob = rr * 64 + cc * 2; return st * 1024 + (ob ^ (((ob >> 9) & 1) << 5)); }
__host__ __device__ __forceinline__ void stage_rc(int b, int& R, int& C) { const int st = b / 1024, sb = b % 1024, swz = sb ^ (((sb >> 9) & 1) << 5); R = (st >> 1) * 16 + swz / 64; C = (st & 1) * 32 + (swz % 64) / 2; }
__host__ __device__ __forceinline__ int perm32(int rho) { const int n = rho >> 4, i = rho & 15; return 8 * (i >> 2) + 4 * n + (i & 3); }

struct Unit { int pm, pn; };
struct Gemm { const bf16_t* A; const bf16_t* Bt; int M, N, K; };

struct StaticOrder {
    int nM, nN, nwg, G, c;
    __host__ __device__ void init(int M, int N, int G_, int c_) { nM = M / BM; nN = N / BM; nwg = nM * nN; G = G_; c = c_; }
    __host__ __device__ bool next(int i, Unit& u) const {
        const long L = (long)i * G + c; if (L >= nwg) return false;
        int wgid = (int)L; { const int q = nwg / NXCD, r = nwg % NXCD, xcd = wgid % NXCD, off = wgid / NXCD; wgid = (xcd < r ? xcd * (q + 1) : r * (q + 1) + (xcd - r) * q) + off; }
        const int nig = WGM * nN, gid = wgid / nig, fm = gid * WGM, gsz = (nM - fm) < WGM ? (nM - fm) : WGM;
        u.pm = fm + ((wgid % nig) % gsz); u.pn = (wgid % nig) / gsz; return true;
    }
    __device__ __forceinline__ void a_ready(const Unit&) const {}
    __device__ __forceinline__ void done(const Unit&) const {}
};
__device__ __forceinline__ unsigned cvt_pk_bf16(float lo, float hi) { unsigned r; asm volatile("v_cvt_pk_bf16_f32 %0, %1, %2" : "=v"(r) : "v"(lo), "v"(hi)); return r; }
struct EpiBf16Plain {
    static constexpr bool PERM = true, AFTER_DRAIN = false;
    bf16_t* O; int ldc;
    __device__ __forceinline__ void operator()(const f32x4 (&acc)[2][2][4][2], const Unit& u, int wr, int wc, int fr, int fq) const {
        const int row0 = u.pm * BM + wr * 64 + fr, col0 = u.pn * BM + wc * 32 + 8 * fq;
#pragma unroll
        for (int ai = 0; ai < 2; ++ai)
#pragma unroll
            for (int m = 0; m < 4; ++m) { bf16_t* rowp = O + (size_t)(row0 + ai * HALF + m * 16) * ldc + col0;
#pragma unroll
                for (int bj = 0; bj < 2; ++bj) { const f32x4 v0 = acc[ai][bj][m][0], v1 = acc[ai][bj][m][1];
                    u32x4 w; w.x = cvt_pk_bf16(v0[0], v0[1]); w.y = cvt_pk_bf16(v0[2], v0[3]); w.z = cvt_pk_bf16(v1[0], v1[1]); w.w = cvt_pk_bf16(v1[2], v1[3]);
                    *(u32x4*)(rowp + bj * HALF) = w; } }
    }
};
struct EpiResid {
    static constexpr bool PERM = false, AFTER_DRAIN = false;
    const float* R; float* C; int ldc;
    __device__ __forceinline__ void operator()(const f32x4 (&acc)[2][2][4][2], const Unit& u, int wr, int wc, int fr, int fq) const {
        const int row0 = u.pm * BM + wr * 64 + fr, col0 = u.pn * BM + wc * 32 + 4 * fq;
#pragma unroll
        for (int ai = 0; ai < 2; ++ai)
#pragma unroll
            for (int m = 0; m < 4; ++m) { const size_t off = (size_t)(row0 + ai * HALF + m * 16) * ldc + col0;
#pragma unroll
                for (int bj = 0; bj < 2; ++bj)
#pragma unroll
                    for (int n = 0; n < 2; ++n) { const f32x4 r = *(const f32x4*)(R + off + bj * HALF + n * 16); *(f32x4*)(C + off + bj * HALF + n * 16) = acc[ai][bj][m][n] + r; } }
    }
};
struct EpiGlu {
    static constexpr bool PERM = true, AFTER_DRAIN = false;
    const bf16_t* Y; int ldy; bf16_t* O; int ldo; int ooff;
    __device__ __forceinline__ void operator()(const f32x4 (&acc)[2][2][4][2], const Unit& u, int wr, int wc, int fr, int fq) const {
        const int row0 = u.pm * BM + wr * 64 + fr, col0 = u.pn * BM + wc * 32 + 8 * fq;
#pragma unroll
        for (int ai = 0; ai < 2; ++ai)
#pragma unroll
            for (int m = 0; m < 4; ++m) { const int row = row0 + ai * HALF + m * 16;
#pragma unroll
                for (int bj = 0; bj < 2; ++bj) { const f32x4 v0 = acc[ai][bj][m][0], v1 = acc[ai][bj][m][1];
                    const u32x4 yw = *(const u32x4*)(Y + (size_t)row * ldy + col0 + bj * HALF);
                    float y[8], g[8];
#pragma unroll
                    for (int j = 0; j < 4; ++j) { y[2 * j] = __uint_as_float(yw[j] << 16); y[2 * j + 1] = __uint_as_float(yw[j] & 0xffff0000u); }
#pragma unroll
                    for (int j = 0; j < 4; ++j) { g[j] = 1.f / (1.f + __expf(-v0[j])); g[4 + j] = 1.f / (1.f + __expf(-v1[j])); }
                    u32x4 w; w.x = cvt_pk_bf16(y[0] * g[0], y[1] * g[1]); w.y = cvt_pk_bf16(y[2] * g[2], y[3] * g[3]); w.z = cvt_pk_bf16(y[4] * g[4], y[5] * g[5]); w.w = cvt_pk_bf16(y[6] * g[6], y[7] * g[7]);
                    *(u32x4*)(O + (size_t)row * ldo + ooff + col0 + bj * HALF) = w; } }
    }
};
template <class Epi, class Sched, bool STAMP = false>
__device__ __forceinline__ void gemm_phase(PG8_LAS unsigned char* lds, const Gemm g, const Sched& S, const Epi& E, unsigned long long* stamps) {
    const int tid = TIDX(), wid = __builtin_amdgcn_readfirstlane(tid >> 6), lane = tid & 63, wr = wid >> 2, wc = wid & 3, fr = lane & 15, fq = lane >> 4;
    const int K = g.K, nt = K / BK;
    int ts_lo = 0, ts_hi = 0, nts = 0; const unsigned long long rt_entry = STAMP ? (unsigned long long)wall_clock64() : 0ull;
#define PG8_STAMP() do { if (STAMP && wid == 0 && nts < 64) { const unsigned long long _c = (unsigned long long)clock64(); \
        ts_lo = (lane == nts) ? (int)(unsigned)_c : ts_lo; ts_hi = (lane == nts) ? (int)(unsigned)(_c >> 32) : ts_hi; ++nts; } } while (0)
    PG8_STAMP();
    unsigned voffA[2], voffB[2];
#pragma unroll
    for (int i = 0; i < 2; ++i) { int R, C; stage_rc(tid * 16 + i * 8192, R, C); const int Rb = Epi::PERM ? ((R & ~31) + perm32(R & 31)) : R;
        voffA[i] = (unsigned)(R * K + C) * 2u; voffB[i] = (unsigned)(Rb * K + C) * 2u; }
    const size_t kstep = (size_t)(BK * 2);
    const size_t hstep = (size_t)HALF * K * 2;
    const size_t tstep = 2 * hstep;
    const unsigned ldsw = (unsigned)wid * 1024u;
    const int aoff = lds_byte(wr * 64 + fr, fq * 8), boff = lds_byte(wc * 32 + fr, fq * 8);
#define PG8_SA(b, h) (((b) * 2 + (h)) * HTB)
#define PG8_SB(b, h) ((4 + (b) * 2 + (h)) * HTB)
#define PG8_STAGE(bufoff, gbase, voff) do { _Pragma("unroll") for (int _i = 0; _i < 2; ++_i) \
        __builtin_amdgcn_global_load_lds((const unsigned*)((const char*)(gbase) + (voff)[_i]), (PG8_LAS unsigned*)(lds + (bufoff) + ldsw + _i * 8192), 16, 0, 0); } while (0)
#define PG8_LDA(dst, b, h) do { _Pragma("unroll") for (int m = 0; m < 4; ++m) _Pragma("unroll") for (int k = 0; k < 2; ++k) dst[m][k] = *(const PG8_LAS bf16x8*)(lds + PG8_SA(b, h) + aoff + m * 2048 + k * 1024); } while (0)
#define PG8_LDB(dst, b, h) do { _Pragma("unroll") for (int n = 0; n < 2; ++n) _Pragma("unroll") for (int k = 0; k < 2; ++k) dst[n][k] = *(const PG8_LAS bf16x8*)(lds + PG8_SB(b, h) + boff + n * 2048 + k * 1024); } while (0)
#define PG8_MMA(ai, bj, At, Bt) do { __builtin_amdgcn_s_setprio(1); _Pragma("unroll") for (int m = 0; m < 4; ++m) _Pragma("unroll") for (int n = 0; n < 2; ++n) _Pragma("unroll") for (int k = 0; k < 2; ++k) \
        acc[ai][bj][m][n] = __builtin_amdgcn_mfma_f32_16x16x32_bf16(Bt[n][k], At[m][k], acc[ai][bj][m][n], 0, 0, 0); __builtin_amdgcn_s_setprio(0); } while (0)
#define PG8_WAIT_V(n) asm volatile("s_waitcnt vmcnt(" #n ")" ::: "memory")
#define PG8_WAIT_L(n) asm volatile("s_waitcnt lgkmcnt(" #n ")" ::: "memory")
#define PG8_BAR __builtin_amdgcn_s_barrier()
#define PG8_SCHED __builtin_amdgcn_sched_barrier(0)
    Unit cur, nxt; int ui = 0;
    if (!S.next(0, cur)) return;
    f32x4 acc[2][2][4][2];
#pragma unroll
    for (int a = 0; a < 2; ++a)
#pragma unroll
        for (int b = 0; b < 2; ++b)
#pragma unroll
            for (int m = 0; m < 4; ++m)
#pragma unroll
                for (int n = 0; n < 2; ++n) acc[a][b][m][n] = (f32x4){0.f, 0.f, 0.f, 0.f};
    bf16x8 At[4][2], B0[2][2], B1[2][2];
    const char* cA = (const char*)g.A + (size_t)cur.pm * tstep; const char* cB = (const char*)g.Bt + (size_t)cur.pn * tstep;
    S.a_ready(cur);
    PG8_STAGE(PG8_SB(0, 0), cB, voffB); PG8_STAGE(PG8_SA(0, 0), cA, voffA); PG8_STAGE(PG8_SB(0, 1), cB + hstep, voffB); PG8_STAGE(PG8_SA(0, 1), cA + hstep, voffA);
    if (wr == 1) PG8_BAR;
    PG8_WAIT_V(4); PG8_BAR;
    PG8_STAGE(PG8_SB(1, 0), cB + kstep, voffB); PG8_STAGE(PG8_SA(1, 0), cA + kstep, voffA); PG8_STAGE(PG8_SB(1, 1), cB + hstep + kstep, voffB);
    PG8_WAIT_V(6); PG8_BAR;
    PG8_STAMP();
    for (;;) {
        const bool has_next = S.next(ui + 1, nxt);
        const char* nA = has_next ? (const char*)g.A + (size_t)nxt.pm * tstep : cA; const char* nB = has_next ? (const char*)g.Bt + (size_t)nxt.pn * tstep : cB;
        for (int t = 0; t < nt; t += 2) {
            const bool last = (t == nt - 2);
            const char* a1 = cA + (size_t)(t + 1) * kstep;
            const char* a2 = last ? nA : cA + (size_t)(t + 2) * kstep; const char* b2 = last ? nB : cB + (size_t)(t + 2) * kstep;
            const char* a3 = a2 + kstep; const char* b3 = b2 + kstep;
            if (last && has_next) S.a_ready(nxt);
            PG8_LDB(B0, 0, 0); PG8_SCHED; PG8_LDA(At, 0, 0); PG8_STAGE(PG8_SA(1, 1), a1 + hstep, voffA);
            PG8_WAIT_L(8); PG8_BAR; PG8_WAIT_L(0); PG8_MMA(0, 0, At, B0); PG8_BAR; PG8_SCHED;
            PG8_LDB(B1, 0, 1); PG8_STAGE(PG8_SB(0, 0), b2, voffB);
            PG8_BAR; PG8_WAIT_L(0); PG8_MMA(0, 1, At, B1); PG8_BAR;
            PG8_LDA(At, 0, 1); PG8_STAGE(PG8_SA(0, 0), a2, voffA);
            PG8_BAR; PG8_WAIT_L(0); PG8_MMA(1, 0, At, B0); PG8_BAR; PG8_SCHED;
            PG8_STAGE(PG8_SB(0, 1), b2 + hstep, voffB);
            PG8_WAIT_V(6); PG8_BAR; PG8_MMA(1, 1, At, B1); PG8_BAR;
            PG8_LDB(B0, 1, 0); PG8_SCHED; PG8_LDA(At, 1, 0); PG8_STAGE(PG8_SA(0, 1), a2 + hstep, voffA);
            PG8_WAIT_L(8); PG8_BAR; PG8_WAIT_L(0); PG8_MMA(0, 0, At, B0); PG8_BAR; PG8_SCHED;
            PG8_LDB(B1, 1, 1); PG8_STAGE(PG8_SB(1, 0), b3, voffB);
            PG8_BAR; PG8_WAIT_L(0); PG8_MMA(0, 1, At, B1); PG8_BAR;
            PG8_LDA(At, 1, 1); PG8_STAGE(PG8_SA(1, 0), a3, voffA);
            PG8_BAR; PG8_WAIT_L(0); PG8_MMA(1, 0, At, B0); PG8_BAR; PG8_SCHED;
            PG8_STAGE(PG8_SB(1, 1), b3 + hstep, voffB);
            PG8_WAIT_V(6); PG8_BAR; PG8_MMA(1, 1, At, B1); PG8_BAR;
        }
        PG8_STAMP();
        if constexpr (!Epi::AFTER_DRAIN) { E(acc, cur, wr, wc, fr, fq); S.done(cur); }
        PG8_STAMP();
        if (!has_next) break;
#pragma unroll
        for (int a = 0; a < 2; ++a)
#pragma unroll
            for (int b = 0; b < 2; ++b)
#pragma unroll
                for (int m = 0; m < 4; ++m)
#pragma unroll
                    for (int n = 0; n < 2; ++n) acc[a][b][m][n] = (f32x4){0.f, 0.f, 0.f, 0.f};
        cur = nxt; cA = nA; cB = nB; ++ui;
    }
    PG8_WAIT_V(0);
    if (wr == 0) PG8_BAR;
    PG8_BAR;
    if constexpr (Epi::AFTER_DRAIN) { E.fused(acc, cur, wr, wc, fr, fq, lds, wid, lane); S.done(cur); }
    PG8_STAMP();
    if (STAMP && wid == 0) { stamps[lane] = lane < nts ? (((unsigned long long)(unsigned)ts_hi << 32) | (unsigned)ts_lo) : 0ull;
        if (lane == 62) stamps[62] = rt_entry; if (lane == 63) stamps[63] = (unsigned long long)wall_clock64(); }
#undef PG8_STAMP
#undef PG8_SA
#undef PG8_SB
#undef PG8_STAGE
#undef PG8_LDA
#undef PG8_LDB
#undef PG8_MMA
#undef PG8_WAIT_V
#undef PG8_WAIT_L
#undef PG8_BAR
#undef PG8_SCHED
}
}
namespace att {
constexpr int D = 128, NW = 8, QBLK = 32, KVBLK = 64;
constexpr float SCALE = 0.088388347648318440f, THR = 8.f;
constexpr int SHM_V = KVBLK * D * 2, SHM_K = KVBLK * D * 2, SHM_ATTN = 2 * SHM_V + 2 * SHM_K + NW * 64 * 4;
#define KSWZ(row, colB) ((row) * 256 + ((colB) ^ (((row) & 7) << 4)))
#define SBAR() __builtin_amdgcn_sched_barrier(0)
__device__ __forceinline__ int crow(int r, int hi) { return (r & 3) + 8 * (r >> 2) + 4 * hi; }
__device__ __forceinline__ unsigned cvtpk(float lo, float hi) { unsigned r; asm volatile("v_cvt_pk_bf16_f32 %0, %1, %2" : "=v"(r) : "v"(lo), "v"(hi)); return r; }

template <bool MASKED>
__device__ __forceinline__ void partialSM(f32x16& p0, f32x16& p1, float& m_reg, float& mn, float& alpha, unsigned long long mw, int hi) {
  constexpr float C = SCALE * 1.4426950408889634f;
  if (MASKED) {
    const unsigned w0 = (unsigned)mw >> (4 * hi), w1 = (unsigned)(mw >> 32) >> (4 * hi);
    const float ninf = -__builtin_inff();
#pragma unroll
    for (int r = 0; r < 16; ++r) { const int bit = (r & 3) + 8 * (r >> 2);
      p0[r] = ((w0 >> bit) & 1u) ? p0[r] : ninf; p1[r] = ((w1 >> bit) & 1u) ? p1[r] : ninf; }
  }
  float pmax = p0[0];
#pragma unroll
  for (int r = 1; r < 16; ++r) pmax = fmaxf(pmax, p0[r]);
#pragma unroll
  for (int r = 0; r < 16; ++r) pmax = fmaxf(pmax, p1[r]);
  { auto rr = __builtin_amdgcn_permlane32_swap(__float_as_uint(pmax), __float_as_uint(pmax), false, false);
    pmax = fmaxf(__uint_as_float(rr[0]), __uint_as_float(rr[1])); }
  if (__builtin_expect(__all(pmax - m_reg <= THR / SCALE), 1)) { mn = m_reg; alpha = 1.f; }
  else { mn = fmaxf(m_reg, pmax); alpha = __builtin_amdgcn_exp2f((m_reg - mn) * C); m_reg = mn; }
  const float mnC = -mn * C;
#pragma unroll
  for (int r = 0; r < 16; ++r) p0[r] = fmaf(p0[r], C, mnC);
#pragma unroll
  for (int r = 0; r < 16; ++r) p1[r] = fmaf(p1[r], C, mnC);
#pragma unroll
  for (int r = 0; r < 16; ++r) p0[r] = __builtin_amdgcn_exp2f(p0[r]);
}
__device__ __forceinline__ void finishSM(f32x16& p0, f32x16& p1, float alpha, float& l_reg, bf16x8& pa0, bf16x8& pa1, bf16x8& pa2, bf16x8& pa3) {
#pragma unroll
  for (int r = 0; r < 16; ++r) p1[r] = __builtin_amdgcn_exp2f(p1[r]);
  float ps = 0;
#pragma unroll
  for (int r = 0; r < 16; ++r) ps += p0[r];
#pragma unroll
  for (int r = 0; r < 16; ++r) ps += p1[r];
  { auto rr = __builtin_amdgcn_permlane32_swap(__float_as_uint(ps), __float_as_uint(ps), false, false);
    ps = __uint_as_float(rr[0]) + __uint_as_float(rr[1]); }
  l_reg = l_reg * alpha + ps;
#define PK4(P, BASE, OUT) do { unsigned a0 = cvtpk(P[BASE + 0], P[BASE + 1]), a1 = cvtpk(P[BASE + 2], P[BASE + 3]);   \
    unsigned b0 = cvtpk(P[BASE + 4], P[BASE + 5]), b1 = cvtpk(P[BASE + 6], P[BASE + 7]);                              \
    auto r0 = __builtin_amdgcn_permlane32_swap(a0, b0, false, false); auto r1 = __builtin_amdgcn_permlane32_swap(a1, b1, false, false); \
    u32x4 w = {r0[0], r1[0], r0[1], r1[1]}; OUT = *reinterpret_cast<bf16x8*>(&w); } while (0)
  PK4(p0, 0, pa0); PK4(p0, 8, pa1); PK4(p1, 0, pa2); PK4(p1, 8, pa3);
#undef PK4
}
__device__ __forceinline__ void qkt(f32x16& p0, f32x16& p1, const char* Ks, const bf16x8* qr, int r32, int hi) {
  p0 = f32x16{}; p1 = f32x16{};
#pragma unroll
  for (int d0 = 0; d0 < 8; ++d0) { const int cb = (d0 * 16 + hi * 8) * 2;
    bf16x8 b0 = *reinterpret_cast<const bf16x8*>(Ks + KSWZ(r32, cb));
    bf16x8 b1 = *reinterpret_cast<const bf16x8*>(Ks + KSWZ(32 + r32, cb));
    p0 = __builtin_amdgcn_mfma_f32_32x32x16_bf16(b0, qr[d0], p0, 0, 0, 0);
    p1 = __builtin_amdgcn_mfma_f32_32x32x16_bf16(b1, qr[d0], p1, 0, 0, 0); }
}
__device__ __forceinline__ int v_st(int k, int c) { const int kk = (k & ~0xC) | ((k & 4) << 1) | ((k & 8) >> 1); return ((kk >> 3) * 4 + (c >> 5)) * 512 + ((kk & 7) * 32 + (c & 31)) * 2; }
__device__ __forceinline__ int v_rd_base(int lane) { return ((lane & 3) << 3) | (((lane >> 2) & 3) << 6) | (((lane >> 4) & 1) << 5) | (((lane >> 5) & 1) << 8); }
constexpr int v_rd_off(int d0, int ks, int half) { return d0 * 512 + ks * 4096 + half * 2048; }
template <int OFF> __device__ __forceinline__ s16x4 tr_read(int vb) {
  s16x4 r; asm volatile("ds_read_b64_tr_b16 %0, %1 offset:%2" : "=&v"(r) : "v"(vb), "i"(OFF) : "memory"); return r;
}
template <int D0> __device__ __forceinline__ void pv_one(f32x16& od, int vb, bf16x8 pa0, bf16x8 pa1, bf16x8 pa2, bf16x8 pa3) {
  const s16x4 l0 = tr_read<v_rd_off(D0, 0, 0)>(vb), h0 = tr_read<v_rd_off(D0, 0, 1)>(vb), l1 = tr_read<v_rd_off(D0, 1, 0)>(vb), h1 = tr_read<v_rd_off(D0, 1, 1)>(vb);
  const s16x4 l2 = tr_read<v_rd_off(D0, 2, 0)>(vb), h2 = tr_read<v_rd_off(D0, 2, 1)>(vb), l3 = tr_read<v_rd_off(D0, 3, 0)>(vb), h3 = tr_read<v_rd_off(D0, 3, 1)>(vb);
  asm volatile("s_waitcnt lgkmcnt(0)" ::: "memory"); SBAR();
#define PK(L, H) (bf16x8){L[0], L[1], L[2], L[3], H[0], H[1], H[2], H[3]}
  od = __builtin_amdgcn_mfma_f32_32x32x16_bf16(pa0, PK(l0, h0), od, 0, 0, 0);
  od = __builtin_amdgcn_mfma_f32_32x32x16_bf16(pa1, PK(l1, h1), od, 0, 0, 0);
  od = __builtin_amdgcn_mfma_f32_32x32x16_bf16(pa2, PK(l2, h2), od, 0, 0, 0);
  od = __builtin_amdgcn_mfma_f32_32x32x16_bf16(pa3, PK(l3, h3), od, 0, 0, 0);
#undef PK
}
__device__ __forceinline__ void pv_d0(f32x16* o, int vb, bf16x8 pa0, bf16x8 pa1, bf16x8 pa2, bf16x8 pa3) {
  pv_one<0>(o[0], vb, pa0, pa1, pa2, pa3); pv_one<1>(o[1], vb, pa0, pa1, pa2, pa3); pv_one<2>(o[2], vb, pa0, pa1, pa2, pa3); pv_one<3>(o[3], vb, pa0, pa1, pa2, pa3);
}

template <bool MASKED, int LDK, class OutRow>
__device__ __forceinline__ void attn_body(const bf16_t* __restrict__ Qw, const bf16_t* __restrict__ Kh, const bf16_t* __restrict__ Vh, int NT,
                                          const unsigned long long* __restrict__ mrow, const OutRow& Ow, char* lds) {
  const int tid = TIDX(), wid = tid >> 6, lane = tid & 63, r32 = lane & 31, hi = lane >> 5;
  char* V_lds = lds; char* K_lds = lds + 2 * SHM_V;
  float* ws = (float*)(lds + 2 * SHM_V + 2 * SHM_K) + wid * 64; float* li_l = ws; float* al_l = ws + 32;
  float m_reg = -1e30f, l_reg = 0; f32x16 o[4] = {}; bf16x8 qr[8];
#pragma unroll
  for (int d0 = 0; d0 < 8; ++d0) qr[d0] = *reinterpret_cast<const bf16x8*>(Qw + d0 * 16);
  const int sr = tid >> 4, sc = (tid & 15) * 8, vst0 = v_st(sr, sc), vst1 = v_st(32 + sr, sc);
  const int vb0 = (int)(uintptr_t)V_lds + v_rd_base(lane);
  struct { bf16x8 vs0, vs1, ks0, ks1; } sr_[2];
#define SLOAD(i, k0) do { sr_[i].vs0 = *reinterpret_cast<const bf16x8*>(&Vh[(long)((k0) + sr) * LDK + sc]); sr_[i].vs1 = *reinterpret_cast<const bf16x8*>(&Vh[(long)((k0) + 32 + sr) * LDK + sc]); \
    sr_[i].ks0 = *reinterpret_cast<const bf16x8*>(&Kh[(long)((k0) + sr) * LDK + sc]); sr_[i].ks1 = *reinterpret_cast<const bf16x8*>(&Kh[(long)((k0) + 32 + sr) * LDK + sc]); } while (0)
#define SWRITE(b, i) do { *(bf16x8*)(V_lds + (b) * SHM_V + vst0) = sr_[i].vs0;          \
    *(bf16x8*)(V_lds + (b) * SHM_V + vst1) = sr_[i].vs1; int kc = sc * 2;               \
    *(bf16x8*)(K_lds + (b) * SHM_K + KSWZ(sr, kc)) = sr_[i].ks0;                       \
    *(bf16x8*)(K_lds + (b) * SHM_K + KSWZ(32 + sr, kc)) = sr_[i].ks1; } while (0)
#define SWAIT() asm volatile("s_waitcnt vmcnt(4)" ::: "memory")
#define RESC(a) do { if (__any((a) < 1.f)) { if (hi == 0) al_l[r32] = (a); asm volatile("s_waitcnt lgkmcnt(0)" ::: "memory"); \
    _Pragma("unroll") for (int d = 0; d < 4; ++d) _Pragma("unroll") for (int r = 0; r < 16; ++r) o[d][r] *= al_l[crow(r, hi)]; } } while (0)
  f32x16 pA0, pA1, pB0, pB1; float mnA, mnB, alA, alB; bf16x8 pa0, pa1, pa2, pa3;
  unsigned long long mwA = 0ull, mwB = 0ull;
  constexpr int SE = 0, SO = 1;
  SLOAD(SE, 0); asm volatile("s_waitcnt vmcnt(0)" ::: "memory"); SWRITE(0, SE); __syncthreads();
  if (MASKED) mwA = mrow[0];
  qkt(pA0, pA1, K_lds, qr, r32, hi); partialSM<MASKED>(pA0, pA1, m_reg, mnA, alA, mwA, hi);
  SLOAD(SO, KVBLK); if (2 < NT) SLOAD(SE, 2 * KVBLK);
  if (2 < NT) SWAIT(); else asm volatile("s_waitcnt vmcnt(0)" ::: "memory");
  SWRITE(1, SO); __syncthreads();
  for (int j = 1; j + 1 < NT; j += 2) {
    if (MASKED) { mwB = mrow[j]; mwA = mrow[j + 1]; }
    SBAR(); qkt(pB0, pB1, K_lds + SHM_K, qr, r32, hi);
    finishSM(pA0, pA1, alA, l_reg, pa0, pa1, pa2, pa3); SBAR();
    SLOAD(SO, (j + 2) * KVBLK); SBAR();
    pv_d0(o, vb0, pa0, pa1, pa2, pa3); partialSM<MASKED>(pB0, pB1, m_reg, mnB, alB, mwB, hi);
    __syncthreads(); SWAIT(); SWRITE(0, SE);
    RESC(alB); __syncthreads();
    SBAR(); qkt(pA0, pA1, K_lds, qr, r32, hi);
    finishSM(pB0, pB1, alB, l_reg, pa0, pa1, pa2, pa3); SBAR();
    if (j + 3 < NT) SLOAD(SE, (j + 3) * KVBLK); SBAR();
    pv_d0(o, vb0 + SHM_V, pa0, pa1, pa2, pa3); partialSM<MASKED>(pA0, pA1, m_reg, mnA, alA, mwA, hi);
    __syncthreads(); if (j + 3 < NT) SWAIT(); else asm volatile("s_waitcnt vmcnt(0)" ::: "memory");
    SWRITE(1, SO);
    RESC(alA); __syncthreads();
  }
  if (MASKED) mwB = mrow[NT - 1];
  SBAR(); qkt(pB0, pB1, K_lds + SHM_K, qr, r32, hi);
  finishSM(pA0, pA1, alA, l_reg, pa0, pa1, pa2, pa3); SBAR();
  pv_d0(o, vb0, pa0, pa1, pa2, pa3); partialSM<MASKED>(pB0, pB1, m_reg, mnB, alB, mwB, hi);
  __syncthreads(); RESC(alB);
  finishSM(pB0, pB1, alB, l_reg, pa0, pa1, pa2, pa3); SBAR();
  pv_d0(o, vb0 + SHM_V, pa0, pa1, pa2, pa3);
  if (hi == 0) li_l[r32] = l_reg; asm volatile("s_waitcnt lgkmcnt(0)" ::: "memory");
  float rli[16];
#pragma unroll
  for (int r = 0; r < 16; ++r) rli[r] = __builtin_amdgcn_rcpf(li_l[crow(r, hi)]);
#pragma unroll
  for (int r = 0; r < 16; ++r) { bf16_t* orow = Ow(crow(r, hi));
#pragma unroll
    for (int d0 = 0; d0 < 4; ++d0) orow[d0 * 32 + r32] = f2bf(o[d0][r] * rli[r]); }
  __syncthreads();
#undef SLOAD
#undef SWRITE
#undef SWAIT
#undef RESC
}
}
constexpr size_t al256(size_t x) { return (x + 255) / 256 * 256; }
constexpr size_t WS_CTL   = 0;
constexpr size_t CTL_BYTES = 65536;
constexpr size_t WS_WINT  = WS_CTL + CTL_BYTES;
constexpr size_t WS_WOUTT = WS_WINT + al256((size_t)DEPTH * NPAD * DM * 2);
constexpr size_t WS_WKVT  = WS_WOUTT + al256((size_t)DEPTH * DM * MIX * 2);
constexpr size_t WS_WGLUT = WS_WKVT + al256((size_t)DEPTH * 1024 * DM * 2);
constexpr size_t WS_MEMN  = WS_WGLUT + al256((size_t)DEPTH * 512 * 512 * 2);
constexpr size_t WS_KVMEM = WS_MEMN + al256((size_t)NB * MEML * DM * 2);
constexpr size_t WS_XN    = WS_KVMEM + al256((size_t)NB * MEML * DEPTH * 1024 * 2);
constexpr size_t WS_P     = WS_XN + al256((size_t)NTOK * DM * 2);
constexpr size_t WS_XBUF  = WS_P + al256((size_t)NTOK * NPAD * 2);
constexpr size_t WS_OCAT  = WS_XBUF + al256((size_t)NTOK * DM * 4);
constexpr size_t WS_MASK  = WS_OCAT + al256((size_t)NTOK * MIX * 2);
constexpr size_t WS_IW    = WS_MASK + al256((size_t)NTOK * 64 * 8);
constexpr size_t WS_YBUF  = WS_IW + al256((size_t)NTOK * 16 * 4);
constexpr size_t WS_ROPE  = WS_YBUF + al256((size_t)NTOK * 512 * 2);
constexpr size_t WS_S5P   = WS_ROPE + al256((size_t)NTOK * 48 * 4);
constexpr size_t S5P_BYTES = (size_t)DEPTH * 32 * (64 * 2 + 64 * 2 + 64 * 16 * 2) * 4;
constexpr size_t WS_GLAS  = WS_S5P + al256(S5P_BYTES);
constexpr size_t WS_GLAD  = WS_GLAS + al256((size_t)NB * 64 * 4 * 64 * 128 * 4);
constexpr size_t WS_END   = WS_GLAD + al256((size_t)NB * 64 * 4 * 64 * 4);

struct Params {
    const float* x; const float* mem; const int* pos; const float* ln_gain; const float* w_in; const float* gla_w_up; const float* gla_b_up;
    const float* s5_a_re; const float* s5_a_im; const float* s5_log_step; const float* s5_b_re; const float* s5_b_im; const float* s5_c_re; const float* s5_c_im;
    const float* s5_d; const float* s5_w_glu; const float* dsa_q_norm; const float* dsa_k_norm; const float* mem_norm; const float* w_mem_kv;
    const float* mem_q_norm; const float* mem_k_norm; const float* out_norm; const float* w_out;
    float* out;
    unsigned* ctl; bf16_t* WinT; bf16_t* WoutT; bf16_t* WkvT; bf16_t* WgluT; bf16_t* memn; bf16_t* kvmem; bf16_t* xn; bf16_t* p; float* xbuf; bf16_t* ocat;
    unsigned long long* mask; float* iw; bf16_t* ybuf; float* rope; float* s5p; float* glas; float* glad;
};

__device__ __forceinline__ void transpose_tiles(const float* __restrict__ src, int K, int Nsrc, int Ndst, const float* __restrict__ scale, bf16_t* __restrict__ dst,
                                                int tile, float* lds_tile  ) {
    const int tid = TIDX(), ntn = Ndst / 64;
    const int tk = tile / ntn, tn = tile % ntn, k0 = tk * 64, n0 = tn * 64;
    __syncthreads();
    { const int ty = tid >> 4, tx = tid & 15;
#pragma unroll
      for (int i = 0; i < 2; ++i) { const int k = k0 + ty + 32 * i, n = n0 + 4 * tx;
        f32x4 v = (f32x4){0.f, 0.f, 0.f, 0.f};
        if (n < Nsrc) v = *(const f32x4*)(src + (size_t)k * Nsrc + n);
        const float s = scale ? scale[k] : 1.f;
        float* t = lds_tile + (ty + 32 * i) * 65 + 4 * tx; t[0] = v[0] * s; t[1] = v[1] * s; t[2] = v[2] * s; t[3] = v[3] * s; } }
    __syncthreads();
    { const int n = tid >> 3, kq = tid & 7;
      u32x4 w;
      w.x = pk2bf(lds_tile[(8 * kq + 0) * 65 + n], lds_tile[(8 * kq + 1) * 65 + n]); w.y = pk2bf(lds_tile[(8 * kq + 2) * 65 + n], lds_tile[(8 * kq + 3) * 65 + n]);
      w.z = pk2bf(lds_tile[(8 * kq + 4) * 65 + n], lds_tile[(8 * kq + 5) * 65 + n]); w.w = pk2bf(lds_tile[(8 * kq + 6) * 65 + n], lds_tile[(8 * kq + 7) * 65 + n]);
      *(u32x4*)(dst + (size_t)(n0 + n) * K + k0 + 8 * kq) = w; }
}

__device__ __forceinline__ void rmsnorm_rows(const float* __restrict__ X, bf16_t* __restrict__ Y, int nrows) {
    const int wid = TIDX() >> 6, lane = TIDX() & 63;
    for (int row = blockIdx.x * 8 + wid; row < nrows; row += gridDim.x * 8) {
        const float* xr = X + (size_t)row * DM; f32x4 v[8]; float ss = 0.f;
#pragma unroll
        for (int i = 0; i < 8; ++i) { v[i] = *(const f32x4*)(xr + 4 * lane + 256 * i); ss += v[i][0] * v[i][0] + v[i][1] * v[i][1] + v[i][2] * v[i][2] + v[i][3] * v[i][3]; }
        ss = wave_sum(ss); const float r = rsqrtf(ss * (1.f / DM) + EPS);
        bf16_t* yr = Y + (size_t)row * DM;
#pragma unroll
        for (int i = 0; i < 8; ++i) { u32x2 w; w.x = pk2bf(v[i][0] * r, v[i][1] * r); w.y = pk2bf(v[i][2] * r, v[i][3] * r); *(u32x2*)(yr + 4 * lane + 256 * i) = w; }
    }
}

__device__ __forceinline__ void phase_prologue1(const Params& P, char* lds) {
    float* tile = (float*)lds;
    constexpr int T_IN = (DM / 64) * (NPAD / 64), T_OUT = (MIX / 64) * (DM / 64), T_KV = (DM / 64) * (1024 / 64), T_GLU = 8 * 8;
    constexpr int TOT = DEPTH * (T_IN + T_OUT + T_KV + T_GLU);
    for (int u = blockIdx.x; u < TOT; u += gridDim.x) {
        int l = u / (T_IN + T_OUT + T_KV + T_GLU), r = u % (T_IN + T_OUT + T_KV + T_GLU);
        if (r < T_IN) transpose_tiles(P.w_in + (size_t)l * DM * NIN, DM, NIN, NPAD, P.ln_gain + l * DM, P.WinT + (size_t)l * NPAD * DM, r, tile);
        else if ((r -= T_IN) < T_OUT) transpose_tiles(P.w_out + (size_t)l * MIX * DM, MIX, DM, DM, P.out_norm + l * MIX, P.WoutT + (size_t)l * DM * MIX, r, tile);
        else if ((r -= T_OUT) < T_KV) transpose_tiles(P.w_mem_kv + (size_t)l * DM * 1024, DM, 1024, 1024, P.mem_norm + l * DM, P.WkvT + (size_t)l * 1024 * DM, r, tile);
        else { r -= T_KV; transpose_tiles(P.s5_w_glu + (size_t)l * 512 * 512, 512, 512, 512, nullptr, P.WgluT + (size_t)l * 512 * 512, r, tile); }
    }
    rmsnorm_rows(P.mem, P.memn, NB * MEML);
}
__device__ __forceinline__ void phase_rope_table(const Params& P) {
    for (int idx = blockIdx.x * NTHR + TIDX(); idx < NTOK * 24; idx += gridDim.x * NTHR) {
        const int tok = idx / 24, i = idx % 24;
        const float e = (i < 16) ? -((float)i * 2.0f / 32.0f) : -((float)(i - 16) * 2.0f / 16.0f);
        const float inv_freq = exp2f(e * 18.931568569324174f);
        const float ang = (float)P.pos[tok] * inv_freq;
        const double a = (double)ang; const double k = rint(a * 0.15915494309189535); const float rf = (float)fma(-k, 6.283185307179586, a);
        P.rope[(size_t)idx * 2] = cosf(rf); P.rope[(size_t)idx * 2 + 1] = sinf(rf);
    }
}

__device__ __forceinline__ void phase_rmsnorm_x(const Params& P, int layer) { rmsnorm_rows(layer == 0 ? P.x : P.xbuf, P.xn, NTOK); }

__device__ __forceinline__ void phase_memk_norm(const Params& P) {
    const int wid = TIDX() >> 6, lane = TIDX() & 63;
    for (int it = blockIdx.x * 8 + wid; it < NB * MEML * DEPTH * 4; it += gridDim.x * 8) {
        const int row = it / (DEPTH * 4), l = (it / 4) % DEPTH, h = it % 4;
        bf16_t* kp = P.kvmem + (size_t)row * (DEPTH * 1024) + l * 1024 + h * 128 + 2 * lane;
        const unsigned w = *(const unsigned*)kp; const float a = __uint_as_float(w << 16), b = __uint_as_float(w & 0xffff0000u);
        const float ss = wave_sum(a * a + b * b), r = rsqrtf(ss * (1.f / 128.f) + EPS);
        const float* g = P.mem_k_norm + l * 128 + 2 * lane;
        *(unsigned*)kp = pk2bf(a * r * g[0], b * r * g[1]);
    }
}

__device__ __forceinline__ void ld8f(const bf16_t* p, float (&v)[8]) { const u32x4 w = *(const u32x4*)p;
#pragma unroll
    for (int j = 0; j < 4; ++j) { v[2 * j] = __uint_as_float(w[j] << 16); v[2 * j + 1] = __uint_as_float(w[j] & 0xffff0000u); } }
__device__ __forceinline__ void st8f(bf16_t* p, const float (&v)[8]) { u32x4 w; w.x = pk2bf(v[0], v[1]); w.y = pk2bf(v[2], v[3]); w.z = pk2bf(v[4], v[5]); w.w = pk2bf(v[6], v[7]); *(u32x4*)p = w; }
__device__ __forceinline__ float sum16(float v) { v += shx(v, 1); v += shx(v, 2); v += shx(v, 4); v += shx(v, 8); return v; }

__device__ __forceinline__ void head128_norm_rope(bf16_t* hp, int l16, const float* __restrict__ gain, const float* __restrict__ cs, bool rope, bool do_store) {
    float v[8]; ld8f(hp + 8 * l16, v);
    float ss = 0.f;
#pragma unroll
    for (int j = 0; j < 8; ++j) ss += v[j] * v[j];
    ss = sum16(ss); const float r = rsqrtf(ss * (1.f / 128.f) + EPS);
#pragma unroll
    for (int j = 0; j < 8; ++j) v[j] = v[j] * r * gain[8 * l16 + j];
    if (rope) {
        float o[8];
#pragma unroll
        for (int j = 0; j < 8; ++j) o[j] = shx(v[j], 2);
        if (l16 < 4) { const int fi = (l16 & 1) * 8;
#pragma unroll
            for (int j = 0; j < 8; ++j) { const float c = cs[(fi + j) * 2], s = cs[(fi + j) * 2 + 1];
                v[j] = (l16 < 2) ? (v[j] * c - o[j] * s) : (v[j] * c + o[j] * s); } }
    }
    if (do_store) st8f(hp + 8 * l16, v);
}
__device__ __forceinline__ void rope16_inplace(bf16_t* ip, const float* __restrict__ cs) {
    float a[8], b[8]; ld8f(ip, a); ld8f(ip + 8, b);
#pragma unroll
    for (int j = 0; j < 8; ++j) { const float c = cs[2 * j], s = cs[2 * j + 1], x1 = a[j], x2 = b[j]; a[j] = x1 * c - x2 * s; b[j] = x2 * c + x1 * s; }
    st8f(ip, a); st8f(ip + 8, b);
}
__device__ __forceinline__ void phase_prep(const Params& P, int layer) {
    const int wid = TIDX() >> 6, lane = TIDX() & 63, l16 = lane & 15, grp = lane >> 4;
    for (int tok = blockIdx.x * 8 + wid; tok < NTOK; tok += gridDim.x * 8) {
        bf16_t* row = P.p + (size_t)tok * NPAD;
        const float* cs32 = P.rope + (size_t)tok * 48; const float* cs16 = cs32 + 32;
        head128_norm_rope(row + C_DQ + grp * 128, l16, P.dsa_q_norm + layer * 128, cs32, true, true);
        head128_norm_rope(row + C_DK, l16, P.dsa_k_norm + layer * 128, cs32, true, grp == 0);
        head128_norm_rope(row + C_MQ + grp * 128, l16, P.mem_q_norm + layer * 128, cs32, false, true);
        if ((lane & 3) == 0) rope16_inplace(row + C_DIQ + lane * 16, cs16);
        if (lane == 0) rope16_inplace(row + C_DIK, cs16);
        if (lane < 16) P.iw[(size_t)tok * 16 + lane] = bf2f(row[C_DIW + lane]) * (1.f / 32.f);
    }
}
struct MemOutRow { bf16_t* base; __device__ __forceinline__ bf16_t* operator()(int r) const { return base + (size_t)r * MIX; } };
__device__ __forceinline__ void unit_mem_attn(const Params& P, int layer, int u, char* lds) {
    const int b = u >> 6, h = (u >> 4) & 3, qb = u & 15, tok0 = b * SEQ + qb * 256;
    const int wid = TIDX() >> 6, lane = TIDX() & 63, r32 = lane & 31, hi = lane >> 5;
    const bf16_t* Qw = P.p + (size_t)(tok0 + wid * 32 + r32) * NPAD + C_MQ + h * 128 + hi * 8;
    const bf16_t* Kh = P.kvmem + (size_t)(b * MEML) * (DEPTH * 1024) + layer * 1024 + h * 128;
    MemOutRow ow; ow.base = P.ocat + (size_t)(tok0 + wid * 32) * MIX + 1536 + h * 128;
    att::attn_body<false, DEPTH * 1024, MemOutRow>(Qw, Kh, Kh + 512, MEML / 64, nullptr, ow, lds);
}

__device__ __forceinline__ void phase_gate(const Params& P, int c_lo, int c_hi) {
    const int wid = TIDX() >> 6, lane = TIDX() & 63;
    const int c0 = lane * 32;
    const int seg = c0 >> 9, zc = (seg == 0 ? C_GZ : seg == 1 ? C_SZ : seg == 2 ? C_DZ : C_MZ) + (c0 & 511);
    const bool act = (c0 >= c_lo) && (c0 < c_hi);
    for (int tok = blockIdx.x * 8 + wid; tok < NTOK; tok += gridDim.x * 8) {
        if (!act) { bf16_t* gz_ = P.xn + (size_t)tok * MIX + c0; const u32x4 zz = {0u, 0u, 0u, 0u};
#pragma unroll
            for (int i = 0; i < 4; ++i) *(u32x4*)(gz_ + 8 * i) = zz;
            continue; }
        const bf16_t* op = P.ocat + (size_t)tok * MIX + c0; const bf16_t* zp = P.p + (size_t)tok * NPAD + zc; bf16_t* gp = P.xn + (size_t)tok * MIX + c0;
        float o[32]; float ss = 0.f;
#pragma unroll
        for (int i = 0; i < 4; ++i) { float v[8]; ld8f(op + 8 * i, v);
#pragma unroll
            for (int j = 0; j < 8; ++j) { o[8 * i + j] = v[j]; ss += v[j] * v[j]; } }
        ss += shx(ss, 1); ss += shx(ss, 2);
        const float r = rsqrtf(ss * (1.f / 128.f) + EPS);
#pragma unroll
        for (int i = 0; i < 4; ++i) { float z[8], g[8]; ld8f(zp + 8 * i, z);
#pragma unroll
            for (int j = 0; j < 8; ++j) g[j] = o[8 * i + j] * r * siluf_(z[j]);
            st8f(gp + 8 * i, g); }
    }
}

__device__ __forceinline__ void phase_gemm_in(const Params& P, int layer, char* lds) {
    pg8::Gemm g; g.A = P.xn; g.Bt = P.WinT + (size_t)layer * NPAD * DM; g.M = NTOK; g.N = NPAD; g.K = DM;
    pg8::StaticOrder S; S.init(g.M, g.N, (int)gridDim.x, (int)blockIdx.x);
    pg8::EpiBf16Plain E; E.O = P.p; E.ldc = NPAD;
    pg8::gemm_phase<pg8::EpiBf16Plain, pg8::StaticOrder, false>((PG8_LAS unsigned char*)lds, g, S, E, nullptr);
}
__device__ __forceinline__ void phase_gemm_out(const Params& P, int layer, char* lds) {
    pg8::Gemm g; g.A = P.xn; g.Bt = P.WoutT + (size_t)layer * DM * MIX; g.M = NTOK; g.N = DM; g.K = MIX;
    pg8::StaticOrder S; S.init(g.M, g.N, (int)gridDim.x, (int)blockIdx.x);
    pg8::EpiResid E; E.R = (layer == 0) ? P.x : P.xbuf; E.C = (layer == DEPTH - 1) ? P.out : P.xbuf; E.ldc = DM;
    pg8::gemm_phase<pg8::EpiResid, pg8::StaticOrder, false>((PG8_LAS unsigned char*)lds, g, S, E, nullptr);
}
__device__ __forceinline__ void phase_gemm_kv(const Params& P, char* lds) {
    pg8::Gemm g; g.A = P.memn; g.Bt = P.WkvT; g.M = NB * MEML; g.N = DEPTH * 1024; g.K = DM;
    pg8::StaticOrder S; S.init(g.M, g.N, (int)gridDim.x, (int)blockIdx.x);
    pg8::EpiBf16Plain E; E.O = P.kvmem; E.ldc = DEPTH * 1024;
    pg8::gemm_phase<pg8::EpiBf16Plain, pg8::StaticOrder, false>((PG8_LAS unsigned char*)lds, g, S, E, nullptr);
}
__device__ __forceinline__ void mma_tile(f32x16& acc, const char* A, int lda, const char* B, int ldb, int K, int lane) {
    const int r = lane & 31, kh = lane >> 5;
    const char* ap = A + r * lda + kh * 16; const char* bp = B + r * ldb + kh * 16;
    for (int k = 0; k < K; k += 16) {
        const bf16x8 a = *(const bf16x8*)(ap + k * 2); const bf16x8 b = *(const bf16x8*)(bp + k * 2);
        acc = __builtin_amdgcn_mfma_f32_32x32x16_bf16(a, b, acc, 0, 0, 0);
    }
}
__device__ __forceinline__ int crow32(int r, int hi) { return (r & 3) + 8 * (r >> 2) + 4 * hi; }
__device__ __forceinline__ float log_sigmoid_(float x) { return fminf(x, 0.f) - log1pf(__expf(-fabsf(x))); }

constexpr int GLA_ST = 144;
constexpr int GLA_ST2 = 272;
__device__ __forceinline__ void gla_front(const Params& P, int layer, int tok0, int h, float (&bv)[8], float* glr_s  , float* tot_s  , float* bm_s  , float* bl_s  ) {
    const int tid = TIDX(), d = tid & 63, tg = tid >> 6;
    __syncthreads();
    if (tid < 128) { const int t = tid >> 1, half = tid & 1; float v[8]; ld8f(P.p + (size_t)(tok0 + t) * NPAD + C_GLR + half * 8, v);
#pragma unroll
        for (int j = 0; j < 8; ++j) glr_s[t * 16 + half * 8 + j] = v[j]; }
    float wu[16];
#pragma unroll
    for (int r = 0; r < 16; ++r) wu[r] = P.gla_w_up[((size_t)layer * 16 + r) * 256 + h * 64 + d];
    const float bias = P.gla_b_up[layer * 256 + h * 64 + d];
    __syncthreads();
    float run = 0.f;
#pragma unroll
    for (int i = 0; i < 8; ++i) { const int t = tg * 8 + i; float a = bias;
#pragma unroll
        for (int r = 0; r < 16; ++r) a = fmaf(glr_s[t * 16 + r], wu[r], a);
        run += log_sigmoid_(a) * (1.f / 16.f); bv[i] = run; }
    tot_s[tg * 64 + d] = run;
    __syncthreads();
    float off = 0.f, all = 0.f;
#pragma unroll
    for (int g = 0; g < 8; ++g) { const float v = tot_s[g * 64 + d]; off += (g < tg) ? v : 0.f; all += v; }
#pragma unroll
    for (int i = 0; i < 8; ++i) bv[i] += off;
    if (tg == 4) bm_s[d] = bv[0];
    if (tg == 0) bl_s[d] = all;
    __syncthreads();
}

__device__ __forceinline__ void unit_gla_a(const Params& P, int layer, int u, char* lds) {
    const int b = u >> 8, n = (u >> 2) & 63, h = u & 3, tok0 = b * SEQ + n * 64;
    const int tid = TIDX(), wid = tid >> 6, lane = tid & 63, d = tid & 63, tg = tid >> 6;
    char* kdT = lds;
    char* vT = lds + 64 * GLA_ST;
    float* glr_s = (float*)(lds + 64 * GLA_ST + 128 * GLA_ST); float* tot_s = glr_s + 1024; float* bm_s = tot_s + 512; float* bl_s = bm_s + 64;
    float bv[8]; gla_front(P, layer, tok0, h, bv, glr_s, tot_s, bm_s, bl_s);
    const float bl = bl_s[d];
#pragma unroll
    for (int i = 0; i < 8; ++i) { const int t = tg * 8 + i; const float k = bf2f(P.p[(size_t)(tok0 + t) * NPAD + C_GK + h * 64 + d]);
        *(bf16_t*)(kdT + d * GLA_ST + t * 2) = f2bf(k * __expf(bl - bv[i])); }
    { const int e = tid & 127, sg = tid >> 7;
#pragma unroll
      for (int i = 0; i < 16; ++i) { const int s = sg * 16 + i; *(bf16_t*)(vT + e * GLA_ST + s * 2) = P.p[(size_t)(tok0 + s) * NPAD + C_GV + h * 128 + e]; } }
    __syncthreads();
    const int mt = wid >> 2, nt = wid & 3, hi = lane >> 5;
    f32x16 acc = {}; mma_tile(acc, kdT + mt * 32 * GLA_ST, GLA_ST, vT + nt * 32 * GLA_ST, GLA_ST, 64, lane);
    float* dst = P.glas + ((size_t)((b * 64 + n) * 4 + h)) * 64 * 128;
#pragma unroll
    for (int r = 0; r < 16; ++r) dst[(mt * 32 + crow32(r, hi)) * 128 + nt * 32 + (lane & 31)] = acc[r];
    if (tid < 64) P.glad[((size_t)((b * 64 + n) * 4 + h)) * 64 + tid] = __expf(bl_s[tid]);
}

__device__ __forceinline__ void gla_scan_slice(const Params& P, int idx) {
    {
        const int e = idx & 127, d = (idx >> 7) & 63, h = (idx >> 13) & 3, b = idx >> 15;
        float S = 0.f;
        for (int n0 = 0; n0 < 64; n0 += 8) {
            float ds[8], dc[8];
#pragma unroll
            for (int i = 0; i < 8; ++i) { const size_t cu = (size_t)((b * 64 + n0 + i) * 4 + h); ds[i] = P.glas[cu * 8192 + d * 128 + e]; dc[i] = P.glad[cu * 64 + d]; }
#pragma unroll
            for (int i = 0; i < 8; ++i) { const size_t cu = (size_t)((b * 64 + n0 + i) * 4 + h); P.glas[cu * 8192 + d * 128 + e] = S; S = fmaf(dc[i], S, ds[i]); }
        }
    }
}

__device__ __forceinline__ void unit_gla_c(const Params& P, int layer, int u, char* lds) {
    const int b = u >> 8, n = (u >> 2) & 63, h = u & 3, tok0 = b * SEQ + n * 64;
    const int tid = TIDX(), wid = tid >> 6, lane = tid & 63, d = tid & 63, tg = tid >> 6, hi = lane >> 5;
    char* Acat = lds;
    char* Bcat = Acat + 64 * GLA_ST2;
    char* qe = Bcat + 128 * GLA_ST2;
    char* ke = qe + 64 * GLA_ST;
    float* glr_s = (float*)(ke + 64 * GLA_ST); float* tot_s = glr_s + 1024; float* bm_s = tot_s + 512; float* bl_s = bm_s + 64;
    float bv[8]; gla_front(P, layer, tok0, h, bv, glr_s, tot_s, bm_s, bl_s);
    const float m = bm_s[d];
#pragma unroll
    for (int i = 0; i < 8; ++i) { const int t = tg * 8 + i; const bf16_t* row = P.p + (size_t)(tok0 + t) * NPAD;
        const float q = bf2f(row[C_GQ + h * 64 + d]) * 0.125f, k = bf2f(row[C_GK + h * 64 + d]);
        *(bf16_t*)(qe + t * GLA_ST + d * 2) = f2bf(q * __expf(bv[i] - m));
        *(bf16_t*)(ke + t * GLA_ST + d * 2) = f2bf(k * __expf(m - bv[i]));
        *(bf16_t*)(Acat + t * GLA_ST2 + (64 + d) * 2) = f2bf(q * __expf(bv[i])); }
    { const int e = tid & 127, sg = tid >> 7;
      const float* sp = P.glas + ((size_t)((b * 64 + n) * 4 + h)) * 64 * 128;
#pragma unroll
      for (int i = 0; i < 16; ++i) { const int s = sg * 16 + i;
          *(bf16_t*)(Bcat + e * GLA_ST2 + s * 2) = P.p[(size_t)(tok0 + s) * NPAD + C_GV + h * 128 + e];
          *(bf16_t*)(Bcat + e * GLA_ST2 + (64 + s) * 2) = f2bf(sp[s * 128 + e]); } }
    __syncthreads();
    if (wid < 4) { const int mt = wid >> 1, nt = wid & 1;
        f32x16 acc = {}; mma_tile(acc, qe + mt * 32 * GLA_ST, GLA_ST, ke + nt * 32 * GLA_ST, GLA_ST, 64, lane);
#pragma unroll
        for (int r = 0; r < 16; ++r) { const int t = mt * 32 + crow32(r, hi), s = nt * 32 + (lane & 31);
            *(bf16_t*)(Acat + t * GLA_ST2 + s * 2) = f2bf(s <= t ? acc[r] : 0.f); } }
    __syncthreads();
    { const int mt = wid >> 2, nt = wid & 3;
      f32x16 acc = {}; mma_tile(acc, Acat + mt * 32 * GLA_ST2, GLA_ST2, Bcat + nt * 32 * GLA_ST2, GLA_ST2, 128, lane);
#pragma unroll
      for (int r = 0; r < 16; ++r) { const int t = mt * 32 + crow32(r, hi);
          P.ocat[(size_t)(tok0 + t) * MIX + h * 128 + nt * 32 + (lane & 31)] = f2bf(acc[r]); } }
}
constexpr int S5P_STRIDE = 2304;
__device__ __forceinline__ void phase_s5_params(const Params& P) {
    for (int idx = blockIdx.x * NTHR + TIDX(); idx < DEPTH * 32 * 64; idx += gridDim.x * NTHR) {
        const int p = idx & 63, lg = idx >> 6;
        const float ar = P.s5_a_re[idx], ai = P.s5_a_im[idx], step = expf(P.s5_log_step[lg]);
        const float mag = expf(ar * step), th = ai * step;
        const float lr = mag * cosf(th), li = mag * sinf(th);
        float* o = P.s5p + (size_t)lg * S5P_STRIDE;
        o[2 * p] = lr; o[2 * p + 1] = li;
        { const float mag512 = expf(512.f * ar * step); const double a = 512.0 * (double)th; const double k = rint(a * 0.15915494309189535); const float rf = (float)fma(-k, 6.283185307179586, a);
          o[128 + 2 * p] = mag512 * cosf(rf); o[128 + 2 * p + 1] = mag512 * sinf(rf); }
        const float xr = lr - 1.f, xi = li, den = 1.f / (ar * ar + ai * ai);
        const float fr = (xr * ar + xi * ai) * den, fi = (xi * ar - xr * ai) * den;
        for (int c = 0; c < 16; ++c) { const float br = P.s5_b_re[(size_t)idx * 16 + c], bi = P.s5_b_im[(size_t)idx * 16 + c];
            o[256 + (p * 16 + c) * 2] = fr * br - fi * bi; o[256 + (p * 16 + c) * 2 + 1] = fr * bi + fi * br; }
    }
}
__device__ __forceinline__ float gelu_tanh_(float x) { const float u = 0.7978845608028654f * (x + 0.044715f * x * x * x); const float e = __expf(-2.f * fabsf(u)); const float th = copysignf((1.f - e) / (1.f + e), u); return 0.5f * x * (1.f + th); }

constexpr int S5_XST = 272;
__device__ __forceinline__ void unit_s5(const Params& P, int layer, int u, char* lds) {
    const int b = u >> 5, g = u & 31, tid = TIDX(), wid = tid >> 6, lane = tid & 63, hi = lane >> 5;
    char* Cm = lds;
    float* ends = (float*)(lds + 32 * S5_XST);
    char* wbase = lds + 32 * S5_XST + 8 * 64 * 2 * 4 + wid * (32 * S5_XST + 32 * 16 * 4);
    char* Xs = wbase;
    float* us = (float*)(wbase + 32 * S5_XST);
    const float* sp = P.s5p + (size_t)(layer * 32 + g) * S5P_STRIDE;
    __syncthreads();
    for (int i = tid; i < 32 * 128; i += NTHR) { const int c = i >> 7, pp = i & 127; float v = 0.f;
        if (c < 16) v = (pp < 64) ? P.s5_c_re[((size_t)(layer * 32 + g) * 16 + c) * 64 + pp] : -P.s5_c_im[((size_t)(layer * 32 + g) * 16 + c) * 64 + (pp - 64)];
        *(bf16_t*)(Cm + c * S5_XST + pp * 2) = f2bf(v); }
    const float lr = sp[2 * lane], li = sp[2 * lane + 1];
    float Br[16], Bi[16];
#pragma unroll
    for (int c = 0; c < 16; ++c) { Br[c] = sp[256 + (lane * 16 + c) * 2]; Bi[c] = sp[256 + (lane * 16 + c) * 2 + 1]; }
    const int tokw = b * SEQ + wid * 512;
    const float dsk = P.s5_d[layer * 512 + g * 16 + (lane & 15)];
    float xr = 0.f, xi = 0.f;
    for (int pass = 0; pass < 2; ++pass) {
        for (int sc = 0; sc < 16; ++sc) {
            const int tok0 = tokw + sc * 32;
            if (lane < 32) { float v[8]; const bf16_t* up = P.p + (size_t)(tok0 + lane) * NPAD + C_SU + g * 16;
                ld8f(up, v);
#pragma unroll
                for (int j = 0; j < 8; ++j) us[lane * 16 + j] = v[j];
                ld8f(up + 8, v);
#pragma unroll
                for (int j = 0; j < 8; ++j) us[lane * 16 + 8 + j] = v[j]; }
            for (int t = 0; t < 32; ++t) {
                const f32x4 u0 = *(const f32x4*)(us + t * 16), u1 = *(const f32x4*)(us + t * 16 + 4), u2 = *(const f32x4*)(us + t * 16 + 8), u3 = *(const f32x4*)(us + t * 16 + 12);
                float br = 0.f, bi = 0.f;
#pragma unroll
                for (int c = 0; c < 4; ++c) { br = fmaf(Br[c], u0[c], br); bi = fmaf(Bi[c], u0[c], bi); br = fmaf(Br[4 + c], u1[c], br); bi = fmaf(Bi[4 + c], u1[c], bi);
                    br = fmaf(Br[8 + c], u2[c], br); bi = fmaf(Bi[8 + c], u2[c], bi); br = fmaf(Br[12 + c], u3[c], br); bi = fmaf(Bi[12 + c], u3[c], bi); }
                const float nr = fmaf(lr, xr, fmaf(-li, xi, br)), ni = fmaf(lr, xi, fmaf(li, xr, bi));
                xr = nr; xi = ni;
                if (pass == 1) { *(bf16_t*)(Xs + t * S5_XST + lane * 2) = f2bf(xr); *(bf16_t*)(Xs + t * S5_XST + (64 + lane) * 2) = f2bf(xi); }
            }
            if (pass == 1) {
                f32x16 acc = {}; mma_tile(acc, Xs, S5_XST, Cm, S5_XST, 128, lane);
                const int c = lane & 31;
                if (c < 16) {
#pragma unroll
                    for (int r = 0; r < 16; ++r) { const int t = crow32(r, hi); const float y = acc[r] + dsk * us[t * 16 + c];
                        P.ybuf[(size_t)(tok0 + t) * 512 + g * 16 + c] = f2bf(gelu_tanh_(y)); } }
            }
        }
        if (pass == 0) {
            ends[(wid * 64 + lane) * 2] = xr; ends[(wid * 64 + lane) * 2 + 1] = xi;
            __syncthreads();
            const float pr = sp[128 + 2 * lane], pi = sp[128 + 2 * lane + 1];
            xr = 0.f; xi = 0.f;
            for (int j = 0; j < wid; ++j) { const float er = ends[(j * 64 + lane) * 2], ei = ends[(j * 64 + lane) * 2 + 1];
                const float nr = pr * xr - pi * xi + er, ni = pr * xi + pi * xr + ei; xr = nr; xi = ni; }
        }
    }
}
constexpr int TOPK = 256;
__device__ __forceinline__ unsigned f2key(float f) { const unsigned u = __float_as_uint(f); return u ^ ((u & 0x80000000u) ? 0xffffffffu : 0x80000000u); }

__device__ __forceinline__ void dsa_score_tile(const bf16x8 (&afr)[4][4], const f32x16 (&wv)[4], const bf16x8 (&bfr)[4], float* sc, int col, int hi) {
#pragma unroll
    for (int rt = 0; rt < 4; ++rt) { f32x16 acc = {};
#pragma unroll
        for (int kk = 0; kk < 4; ++kk) acc = __builtin_amdgcn_mfma_f32_32x32x16_bf16(afr[rt][kk], bfr[kk], acc, 0, 0, 0);
        float s0 = 0.f, s1 = 0.f;
#pragma unroll
        for (int i = 0; i < 16; i += 2) { s0 = fmaf(fmaxf(acc[i], 0.f), wv[rt][i], s0); s1 = fmaf(fmaxf(acc[i + 1], 0.f), wv[rt][i + 1], s1); }
        sc[(2 * rt + hi) * 4096 + col] = (s0 + s1) + 0.f; }
}
#define DSA_CNT8(J0) do { _Pragma("unroll") for (int jj = 0; jj < 8; jj += 2) { c0 += (key[(J0) + jj] >= cand) ? 1 : 0; c1 += (key[(J0) + jj + 1] >= cand) ? 1 : 0; } } while (0)

__device__ __forceinline__ void unit_dsa_index(const Params& P, int u, char* lds) {
    const int b = u & 3, t0 = (511 - (u >> 2)) * 8;
    const int tid = TIDX(), wid = tid >> 6, lane = tid & 63, r32 = lane & 31, hi = lane >> 5;
    float* sc = (float*)lds;
    const bf16_t* pb = P.p + (size_t)b * SEQ * NPAD;
    __syncthreads();
    {
        bf16x8 afr[4][4]; f32x16 wv[4];
        const int qsel = (r32 >> 2) & 1, head = (r32 & 3) + 4 * (r32 >> 3);
#pragma unroll
        for (int rt = 0; rt < 4; ++rt) { const bf16_t* qp = pb + (size_t)(t0 + 2 * rt + qsel) * NPAD + C_DIQ + head * 64 + hi * 8;
#pragma unroll
            for (int kk = 0; kk < 4; ++kk) afr[rt][kk] = *(const bf16x8*)(qp + kk * 16);
            const float* wp = P.iw + (size_t)(b * SEQ + t0 + 2 * rt + hi) * 16;
#pragma unroll
            for (int i = 0; i < 4; ++i) { const f32x4 w4 = *(const f32x4*)(wp + 4 * i); wv[rt][4 * i] = w4[0]; wv[rt][4 * i + 1] = w4[1]; wv[rt][4 * i + 2] = w4[2]; wv[rt][4 * i + 3] = w4[3]; } }
        const int ntile = (t0 + 7) / 32 + 1;
        const bf16_t* kp = pb + (size_t)r32 * NPAD + C_DIK + hi * 8;
        bf16x8 bA[4], bB[4];
#define DSA_LDB(dst, J) do { const bf16_t* kq_ = kp + (size_t)(J) * 32 * NPAD; _Pragma("unroll") for (int kk = 0; kk < 4; ++kk) dst[kk] = *(const bf16x8*)(kq_ + kk * 16); } while (0)
        int j = wid;
        if (j < ntile) DSA_LDB(bA, j);
        for (; j < ntile; j += 16) {
            if (j + 8 < ntile) DSA_LDB(bB, j + 8);
            dsa_score_tile(afr, wv, bA, sc, j * 32 + r32, hi);
            if (j + 8 < ntile) { if (j + 16 < ntile) DSA_LDB(bA, j + 16);
                dsa_score_tile(afr, wv, bB, sc, (j + 8) * 32 + r32, hi); }
        }
#undef DSA_LDB
    }
    __syncthreads();
    {
        const int t = t0 + wid; const float* srow = sc + wid * 4096;
        unsigned key[64];
#pragma unroll
        for (int j = 0; j < 64; ++j) { const int s = j * 64 + lane; key[j] = (s <= t) ? f2key(srow[s]) : 0u; }
        unsigned long long* mout = P.mask + (size_t)(b * SEQ + t) * 64;
        unsigned long long myword = 0ull;
        if (t + 1 <= TOPK) {
#pragma unroll
            for (int j = 0; j < 64; ++j) { const unsigned long long m = __ballot(j * 64 + lane <= t); if (lane == j) myword = m; }
        } else {
            const int ngrp = t / 512 + 1;
            unsigned T = 0u; int cntT = t + 1;
            for (int bit = 31; bit >= 0; --bit) {
                const unsigned cand = T | (1u << bit); int c0 = 0, c1 = 0;
                DSA_CNT8(0);
                if (ngrp > 1) DSA_CNT8(8);
                if (ngrp > 2) DSA_CNT8(16);
                if (ngrp > 3) DSA_CNT8(24);
                if (ngrp > 4) DSA_CNT8(32);
                if (ngrp > 5) DSA_CNT8(40);
                if (ngrp > 6) DSA_CNT8(48);
                if (ngrp > 7) DSA_CNT8(56);
                int cl = c0 + c1;
                int cnt = 0;
#pragma unroll
                for (int bb = 0; bb < 7; ++bb) cnt += __popcll(__ballot((cl >> bb) & 1)) << bb;
                if (cnt >= TOPK) { T = cand; cntT = cnt; if (cnt == TOPK) break; }
            }
            if (cntT == TOPK) {
#pragma unroll
                for (int j = 0; j < 64; ++j) { const unsigned long long m = __ballot(key[j] >= T); if (lane == j) myword = m; }
            } else {
                int ngt = 0;
#pragma unroll
                for (int j = 0; j < 64; ++j) ngt += __popcll(__ballot(key[j] > T));
                int need = TOPK - ngt;
#pragma unroll
                for (int j = 0; j < 64; ++j) { const unsigned long long eq = __ballot(key[j] == T), gt = __ballot(key[j] > T);
                    const int ne = __popcll(eq); unsigned long long take = eq;
                    if (ne > need) { take = 0ull; int left = need; unsigned long long e2 = eq;
                        while (left > 0) { const unsigned long long lowbit = e2 & (0ull - e2); take |= lowbit; e2 ^= lowbit; --left; } }
                    need -= (ne > need) ? need : ne;
                    const unsigned long long m = gt | take; if (lane == j) myword = m; }
            }
        }
        mout[lane] = myword;
    }
}

struct DsaOutRow { bf16_t* base; int wid; __device__ __forceinline__ bf16_t* operator()(int r) const { const int rho = wid * 32 + r; return base + (size_t)(rho >> 2) * MIX + (rho & 3) * 128; } };
__device__ __forceinline__ void unit_dsa_attn(const Params& P, int u, char* lds) {
    const int b = u & 3, qb = 63 - (u >> 2), t0 = qb * 64, tokb = b * SEQ;
    const int wid = TIDX() >> 6, lane = TIDX() & 63, r32 = lane & 31, hi = lane >> 5;
    const int rho = wid * 32 + r32, tq = t0 + (rho >> 2), hq = rho & 3;
    const bf16_t* Qw = P.p + (size_t)(tokb + tq) * NPAD + C_DQ + hq * 128 + hi * 8;
    const bf16_t* Kh = P.p + (size_t)tokb * NPAD + C_DK; const bf16_t* Vh = P.p + (size_t)tokb * NPAD + C_DV;
    const unsigned long long* mrow = P.mask + (size_t)(tokb + tq) * 64;
    DsaOutRow ow; ow.base = P.ocat + (size_t)(tokb + t0) * MIX + 1024; ow.wid = wid;
    const int NT = (qb + 2) & ~1;
    att::attn_body<true, NPAD, DsaOutRow>(Qw, Kh, Vh, NT, mrow, ow, lds);
}
__device__ __forceinline__ void phase_gemm_glu(const Params& P, int layer, char* lds) {
    pg8::Gemm g; g.A = P.ybuf; g.Bt = P.WgluT + (size_t)layer * 512 * 512; g.M = NTOK; g.N = 512; g.K = 512;
    pg8::StaticOrder S; S.init(g.M, g.N, (int)gridDim.x, (int)blockIdx.x);
    pg8::EpiGlu E; E.Y = P.ybuf; E.ldy = 512; E.O = P.ocat; E.ldo = MIX; E.ooff = 512;
    pg8::gemm_phase<pg8::EpiGlu, pg8::StaticOrder, false>((PG8_LAS unsigned char*)lds, g, S, E, nullptr);
}

constexpr int CTL_Q0 = 4096;
struct OneUnit { int pm, pn; __device__ __forceinline__ bool next(int i, pg8::Unit& u) const { if (i) return false; u.pm = pm; u.pn = pn; return true; }
    __device__ __forceinline__ void a_ready(const pg8::Unit&) const {} __device__ __forceinline__ void done(const pg8::Unit&) const {} };
__device__ __forceinline__ int q_issue(unsigned* ctr) { return (int)__hip_atomic_fetch_add(ctr, 1u, __ATOMIC_RELAXED, __HIP_MEMORY_SCOPE_AGENT); }
#define Q_LOOP_BEGIN(ctr, total)  { unsigned* q_ctr_ = (ctr); const int q_total_ = (total); volatile int* q_b_ = (volatile int*)(lds + LDS_TAIL + 16); \
    for (;;) { __syncthreads(); if (TIDX() == 0) *q_b_ = q_issue(q_ctr_); __syncthreads(); const int item = *q_b_; if (item >= q_total_) break;
#define Q_LOOP_END  } }
__device__ __forceinline__ void unit_glu(const Params& P, int layer, int u, char* lds) {
    pg8::Gemm g; g.A = P.ybuf; g.Bt = P.WgluT + (size_t)layer * 512 * 512; g.M = NTOK; g.N = 512; g.K = 512;
    OneUnit S; S.pm = u >> 1; S.pn = u & 1;
    pg8::EpiGlu E; E.Y = P.ybuf; E.ldy = 512; E.O = P.ocat; E.ldo = MIX; E.ooff = 512;
    pg8::gemm_phase<pg8::EpiGlu, OneUnit, false>((PG8_LAS unsigned char*)lds, g, S, E, nullptr);
}
constexpr int LDS_TAIL = LDS_BYTES - 64;

__global__ __launch_bounds__(NTHR, 2) void k_mega(Params P) {
    extern __shared__ __attribute__((aligned(16))) char lds[];
    if (TIDX() == 0) *(uint4*)(lds + LDS_TAIL) = make_uint4(0u, 0u, 0u, 0u);
    __syncthreads();
    XcdBarrier bar = xcd_barrier_post(P.ctl, (volatile LAS unsigned*)(lds + LDS_TAIL));
    const int G = gridDim.x, B = blockIdx.x;
    phase_prologue1(P, lds); phase_rope_table(P); phase_s5_params(P); phase_rmsnorm_x(P, 0);
    xcd_barrier(bar);
    for (int layer = 0; layer < DEPTH; ++layer) {
        if (layer > 0) { phase_rmsnorm_x(P, layer); xcd_barrier(bar); }
        phase_gemm_in(P, layer, lds);
        if (layer == 0) phase_gemm_kv(P, lds);
        xcd_barrier(bar);
        phase_prep(P, layer);
        if (layer == 0) phase_memk_norm(P);
        xcd_barrier(bar);
        Q_LOOP_BEGIN(P.ctl + CTL_Q0 + 64 * (layer * 2), 128 + 2048 + 256 + 256)
            if (item < 128) unit_s5(P, layer, item, lds);
            else if (item < 2176) unit_dsa_index(P, item - 128, lds);
            else if (item < 2432) unit_mem_attn(P, layer, item - 2176, lds);
            else { for (int k = 0; k < 4; ++k) unit_gla_a(P, layer, (item - 2432) * 4 + k, lds); }
        Q_LOOP_END
        xcd_barrier(bar);
        Q_LOOP_BEGIN(P.ctl + CTL_Q0 + 64 * (layer * 2 + 1), 256 + 128 + 256)
            if (item < 256) unit_dsa_attn(P, item, lds);
            else if (item < 384) unit_glu(P, layer, item - 256, lds);
            else gla_scan_slice(P, (item - 384) * NTHR + TIDX());
        Q_LOOP_END
        xcd_barrier(bar);
        for (int u = B; u < 1024; u += G) unit_gla_c(P, layer, u, lds);
        xcd_barrier(bar);
        phase_gate(P, 0, 2048);
        xcd_barrier(bar);
        phase_gemm_out(P, layer, lds);
        xcd_barrier(bar);
    }
}

extern "C" void kernel_launch(void* const* d_in, const int* in_sizes, int n_in, void* d_out, int out_size, void* d_ws, size_t ws_size, hipStream_t stream) {
    if (n_in != 24 || ws_size < WS_END) { fprintf(stderr, "kernel_launch: unexpected n_in %d or ws_size %zu (< %zu)\n", n_in, ws_size, (size_t)WS_END); return; }
    Params P; memset(&P, 0, sizeof(P));
    P.x = (const float*)d_in[0]; P.mem = (const float*)d_in[1]; P.pos = (const int*)d_in[2]; P.ln_gain = (const float*)d_in[3]; P.w_in = (const float*)d_in[4];
    P.gla_w_up = (const float*)d_in[5]; P.gla_b_up = (const float*)d_in[6]; P.s5_a_re = (const float*)d_in[7]; P.s5_a_im = (const float*)d_in[8]; P.s5_log_step = (const float*)d_in[9];
    P.s5_b_re = (const float*)d_in[10]; P.s5_b_im = (const float*)d_in[11]; P.s5_c_re = (const float*)d_in[12]; P.s5_c_im = (const float*)d_in[13]; P.s5_d = (const float*)d_in[14];
    P.s5_w_glu = (const float*)d_in[15]; P.dsa_q_norm = (const float*)d_in[16]; P.dsa_k_norm = (const float*)d_in[17]; P.mem_norm = (const float*)d_in[18]; P.w_mem_kv = (const float*)d_in[19];
    P.mem_q_norm = (const float*)d_in[20]; P.mem_k_norm = (const float*)d_in[21]; P.out_norm = (const float*)d_in[22]; P.w_out = (const float*)d_in[23];
    P.out = (float*)d_out;
    char* ws = (char*)d_ws;
    P.ctl = (unsigned*)(ws + WS_CTL); P.WinT = (bf16_t*)(ws + WS_WINT); P.WoutT = (bf16_t*)(ws + WS_WOUTT); P.WkvT = (bf16_t*)(ws + WS_WKVT); P.WgluT = (bf16_t*)(ws + WS_WGLUT);
    P.memn = (bf16_t*)(ws + WS_MEMN); P.kvmem = (bf16_t*)(ws + WS_KVMEM); P.xn = (bf16_t*)(ws + WS_XN); P.p = (bf16_t*)(ws + WS_P); P.xbuf = (float*)(ws + WS_XBUF);
    P.ocat = (bf16_t*)(ws + WS_OCAT); P.mask = (unsigned long long*)(ws + WS_MASK); P.iw = (float*)(ws + WS_IW); P.ybuf = (bf16_t*)(ws + WS_YBUF); P.rope = (float*)(ws + WS_ROPE);
    P.s5p = (float*)(ws + WS_S5P); P.glas = (float*)(ws + WS_GLAS); P.glad = (float*)(ws + WS_GLAD);
    static int grid = 0;
    if (!grid) {
        int dev = 0, cus = 0, per_cu = 0;
        (void)hipGetDevice(&dev); (void)hipDeviceGetAttribute(&cus, hipDeviceAttributeMultiprocessorCount, dev);
        (void)hipFuncSetAttribute((const void*)k_mega, hipFuncAttributeMaxDynamicSharedMemorySize, LDS_BYTES);
        (void)hipOccupancyMaxActiveBlocksPerMultiprocessor(&per_cu, (const void*)k_mega, NTHR, LDS_BYTES);
        if (per_cu < 1) fprintf(stderr, "kernel_launch: occupancy query reports %d blocks per CU\n", per_cu);
        grid = cus > 0 ? cus : 256;
    }
    (void)hipMemsetAsync(ws + WS_CTL, 0, CTL_BYTES, stream);
    hipLaunchKernelGGL(k_mega, dim3(grid), dim3(NTHR), LDS_BYTES, stream, P);
}
```

```cpp
#include <hip/hip_runtime.h>
#include <stdint.h>
#include <stdio.h>
#include <string.h>

constexpr int NB = 4, SEQ = 4096, NTOK = NB * SEQ, DM = 2048, DEPTH = 4, MEML = 256;
constexpr int NIN = 5984, NPAD = 6144, MIX = 2048;
constexpr int C_GQ = 0, C_GK = 256, C_GV = 512, C_GLR = 1024, C_GZ = 1040, C_SU = 1552, C_SZ = 2064, C_DQ = 2576, C_DK = 3088, C_DV = 3216,
              C_DIQ = 3344, C_DIK = 4368, C_DIW = 4432, C_DZ = 4448, C_MQ = 4960, C_MZ = 5472;
constexpr float EPS = 1e-6f;
constexpr int NTHR = 512;
constexpr int LDS_BYTES = 147456;

typedef unsigned short bf16_t;
typedef short bf16x8 __attribute__((ext_vector_type(8)));
typedef short s16x4 __attribute__((ext_vector_type(4)));
typedef float f32x4 __attribute__((ext_vector_type(4)));
typedef float f32x8 __attribute__((ext_vector_type(8)));
typedef float f32x16 __attribute__((ext_vector_type(16)));
typedef unsigned u32x4 __attribute__((ext_vector_type(4)));
typedef unsigned u32x2 __attribute__((ext_vector_type(2)));
#define LAS __attribute__((address_space(3)))

__device__ __forceinline__ float bf2f(bf16_t b) { return __uint_as_float(((unsigned)b) << 16); }
__device__ __forceinline__ bf16_t f2bf(float f) { unsigned u = __float_as_uint(f); u += 0x7FFFu + ((u >> 16) & 1u); return (bf16_t)(u >> 16); }
__device__ __forceinline__ unsigned pk2bf(float lo, float hi) { return (unsigned)f2bf(lo) | ((unsigned)f2bf(hi) << 16); }
__device__ __forceinline__ float sigmoidf_(float x) { return 1.f / (1.f + __expf(-x)); }
__device__ __forceinline__ float siluf_(float x) { return x / (1.f + __expf(-x)); }

__device__ __forceinline__ int TIDX() { int t = (int)threadIdx.x; asm volatile("" : "+v"(t)); return t; }
__device__ __forceinline__ float shx(float v, int m) { const int src = ((TIDX() & 63) ^ m) << 2; return __int_as_float(__builtin_amdgcn_ds_bpermute(src, __float_as_int(v))); }
__device__ __forceinline__ float wave_sum(float v) {
#pragma unroll
    for (int o = 32; o >= 1; o >>= 1) v += shx(v, o);
    return v;
}
#define XB_TMO      128
#define XB_XCNT(j)  (256  + 64 * (j))
#define XB_XSUB(j)  (1280 + 64 * (j))
#define XB_XGEN(j)  (2304 + 64 * (j))
#define XB_TOP      3328
#define XB_TOPGEN   3392
#define XCD_BAR_WORDS 3456
#define XB_SPIN_CAP (1u << 18)

__device__ __forceinline__ unsigned xb_ld(unsigned* p)              { return __hip_atomic_load(p, __ATOMIC_RELAXED, __HIP_MEMORY_SCOPE_AGENT); }
__device__ __forceinline__ unsigned xb_add(unsigned* p, unsigned v) { return __hip_atomic_fetch_add(p, v, __ATOMIC_RELAXED, __HIP_MEMORY_SCOPE_AGENT); }
__device__ __forceinline__ unsigned xb_xcc_id() { return (unsigned)__builtin_amdgcn_s_getreg((3 << 11) | 20) & 0xFu; }
#define XB_SPIN(cond, bar) do { unsigned _sp = 0; while (cond) { __builtin_amdgcn_s_sleep(1); \
    if ((++_sp & 255u) == 0u) { if (xb_ld(&(bar)[XB_TMO])) break; if (_sp > XB_SPIN_CAP) { atomicAdd(&(bar)[XB_TMO], 1u); break; } } } } while (0)

struct XcdBarrier {
    unsigned* bar; unsigned x;
    volatile LAS unsigned* st;
};

__device__ __forceinline__ XcdBarrier xcd_barrier_post(unsigned* bar, volatile LAS unsigned* st) {
    XcdBarrier b; b.bar = bar; b.x = xb_xcc_id(); b.st = st;
    if (TIDX() == 0) (void)xb_add(&bar[XB_XCNT(b.x)], 1u);
    return b;
}
__device__ __forceinline__ void xcd_barrier_complete(unsigned* bar, unsigned x, unsigned& nloc, unsigned& nx) {
    const unsigned G = gridDim.x * gridDim.y * gridDim.z;
    unsigned sum, cnt, mine, sp = 0u;
    for (;;) {
        sum = 0u; cnt = 0u; mine = 0u;
#pragma unroll
        for (unsigned j = 0; j < 16; ++j) { const unsigned c = xb_ld(&bar[XB_XCNT(j)]); sum += c; cnt += (c > 0u) ? 1u : 0u; mine = (j == x) ? c : mine; }
        if (sum == G) break;
        __builtin_amdgcn_s_sleep(1);
        if ((++sp & 255u) == 0u) { if (xb_ld(&bar[XB_TMO])) break; if (sp > XB_SPIN_CAP) { atomicAdd(&bar[XB_TMO], 1u); break; } }
    }
    nloc = mine > 0u ? mine : 1u; nx = cnt > 0u ? cnt : 1u;
}

__device__ __forceinline__ void xcd_barrier(const XcdBarrier& b) {
    asm volatile("s_waitcnt vmcnt(0)" ::: "memory");
    __syncthreads();
    if (TIDX() == 0) {
        unsigned* bar = b.bar; const unsigned bx = xb_xcc_id();
        __builtin_amdgcn_s_waitcnt(0);
        unsigned nloc = b.st[0], nx = b.st[1];
        if (nloc == 0u) { xcd_barrier_complete(bar, bx, nloc, nx); b.st[0] = nloc; b.st[1] = nx; }
        const unsigned old = xb_add(&bar[XB_XSUB(bx)], 1u);
        const unsigned gen = old / nloc;
        if (old + 1u == (gen + 1u) * nloc) {
            __builtin_amdgcn_fence(__ATOMIC_RELEASE, "agent");
            asm volatile("s_waitcnt vmcnt(0)" ::: "memory");
            const unsigned og = xb_add(&bar[XB_TOP], 1u);
            const unsigned tg = og / nx;
            if (og + 1u == (tg + 1u) * nx) xb_add(&bar[XB_TOPGEN], 1u);
            else XB_SPIN(xb_ld(&bar[XB_TOPGEN]) == tg, bar);
            __builtin_amdgcn_fence(__ATOMIC_ACQUIRE, "agent");
            xb_add(&bar[XB_XGEN(bx)], 1u);
            asm volatile("s_waitcnt vmcnt(0)" ::: "memory");
        } else {
            XB_SPIN(xb_ld(&bar[XB_XGEN(bx)]) == gen, bar);
            __builtin_amdgcn_fence(__ATOMIC_ACQUIRE, "agent");
            asm volatile("s_waitcnt vmcnt(0)" ::: "memory");
        }
    }
    __syncthreads();
}
namespace pg8 {
#define PG8_LAS __attribute__((address_space(3)))
typedef float f32x2 __attribute__((ext_vector_type(2)));
typedef unsigned u32x4 __attribute__((ext_vector_type(4)));
constexpr int BM = 256, BK = 64, HALF = 128, HTB = HALF * BK * 2  , STAGE_BYTES = 8 * HTB, NXCD = 8, WGM = 8;

__host__ __device__ __forceinline__ int lds_byte(int r, int c) { const int st = (r >> 4) * 2 + (c >> 5), rr = r & 15, cc = c & 31, ob = rr * 64 + cc * 2; return st * 1024 + (ob ^ (((ob >> 9) & 1) << 5)); }
__host__ __device__ __forceinline__ void stage_rc(int b, int& R, int& C) { const int st = b / 1024, sb = b % 1024, swz = sb ^ (((sb >> 9) & 1) << 5); R = (st >> 1) * 16 + swz / 64; C = (st & 1) * 32 + (swz % 64) / 2; }
__host__ __device__ __forceinline__ int perm32(int rho) { const int n = rho >> 4, i = rho & 15; return 8 * (i >> 2) + 4 * n + (i & 3); }

struct Unit { int pm, pn; };
struct Gemm { const bf16_t* A; const bf16_t* Bt; int M, N, K; };

struct StaticOrder {
    int nM, nN, nwg, G, c;
    __host__ __device__ void init(int M, int N, int G_, int c_) { nM = M / BM; nN = N / BM; nwg = nM * nN; G = G_; c = c_; }
    __host__ __device__ bool next(int i, Unit& u) const {
        const long L = (long)i * G + c; if (L >= nwg) return false;
        int wgid = (int)L; { const int q = nwg / NXCD, r = nwg % NXCD, xcd = wgid % NXCD, off = wgid / NXCD; wgid = (xcd < r ? xcd * (q + 1) : r * (q + 1) + (xcd - r) * q) + off; }
        const int nig = WGM * nN, gid = wgid / nig, fm = gid * WGM, gsz = (nM - fm) < WGM ? (nM - fm) : WGM;
        u.pm = fm + ((wgid % nig) % gsz); u.pn = (wgid % nig) / gsz; return true;
    }
    __device__ __forceinline__ void a_ready(const Unit&) const {}
    __device__ __forceinline__ void done(const Unit&) const {}
};
__device__ __forceinline__ unsigned cvt_pk_bf16(float lo, float hi) { unsigned r; asm volatile("v_cvt_pk_bf16_f32 %0, %1, %2" : "=v"(r) : "v"(lo), "v"(hi)); return r; }
struct EpiBf16Plain {
    static constexpr bool PERM = true, AFTER_DRAIN = false;
    bf16_t* O; int ldc;
    __device__ __forceinline__ void operator()(const f32x4 (&acc)[2][2][4][2], const Unit& u, int wr, int wc, int fr, int fq) const {
        const int row0 = u.pm * BM + wr * 64 + fr, col0 = u.pn * BM + wc * 32 + 8 * fq;
#pragma unroll
        for (int ai = 0; ai < 2; ++ai)
#pragma unroll
            for (int m = 0; m < 4; ++m) { bf16_t* rowp = O + (size_t)(row0 + ai * HALF + m * 16) * ldc + col0;
#pragma unroll
                for (int bj = 0; bj < 2; ++bj) { const f32x4 v0 = acc[ai][bj][m][0], v1 = acc[ai][bj][m][1];
                    u32x4 w; w.x = cvt_pk_bf16(v0[0], v0[1]); w.y = cvt_pk_bf16(v0[2], v0[3]); w.z = cvt_pk_bf16(v1[0], v1[1]); w.w = cvt_pk_bf16(v1[2], v1[3]);
                    *(u32x4*)(rowp + bj * HALF) = w; } }
    }
};
struct EpiResid {
    static constexpr bool PERM = false, AFTER_DRAIN = false;
    const float* R; float* C; int ldc;
    __device__ __forceinline__ void operator()(const f32x4 (&acc)[2][2][4][2], const Unit& u, int wr, int wc, int fr, int fq) const {
        const int row0 = u.pm * BM + wr * 64 + fr, col0 = u.pn * BM + wc * 32 + 4 * fq;
#pragma unroll
        for (int ai = 0; ai < 2; ++ai)
#pragma unroll
            for (int m = 0; m < 4; ++m) { const size_t off = (size_t)(row0 + ai * HALF + m * 16) * ldc + col0;
#pragma unroll
                for (int bj = 0; bj < 2; ++bj)
#pragma unroll
                    for (int n = 0; n < 2; ++n) { const f32x4 r = *(const f32x4*)(R + off + bj * HALF + n * 16); *(f32x4*)(C + off + bj * HALF + n * 16) = acc[ai][bj][m][n] + r; } }
    }
};
struct EpiGlu {
    static constexpr bool PERM = true, AFTER_DRAIN = false;
    const bf16_t* Y; int ldy; bf16_t* O; int ldo; int ooff;
    __device__ __forceinline__ void operator()(const f32x4 (&acc)[2][2][4][2], const Unit& u, int wr, int wc, int fr, int fq) const {
        const int row0 = u.pm * BM + wr * 64 + fr, col0 = u.pn * BM + wc * 32 + 8 * fq;
#pragma unroll
        for (int ai = 0; ai < 2; ++ai)
#pragma unroll
            for (int m = 0; m < 4; ++m) { const int row = row0 + ai * HALF + m * 16;
#pragma unroll
                for (int bj = 0; bj < 2; ++bj) { const f32x4 v0 = acc[ai][bj][m][0], v1 = acc[ai][bj][m][1];
                    const u32x4 yw = *(const u32x4*)(Y + (size_t)row * ldy + col0 + bj * HALF);
                    float y[8], g[8];
#pragma unroll
                    for (int j = 0; j < 4; ++j) { y[2 * j] = __uint_as_float(yw[j] << 16); y[2 * j + 1] = __uint_as_float(yw[j] & 0xffff0000u); }
#pragma unroll
                    for (int j = 0; j < 4; ++j) { g[j] = 1.f / (1.f + __expf(-v0[j])); g[4 + j] = 1.f / (1.f + __expf(-v1[j])); }
                    u32x4 w; w.x = cvt_pk_bf16(y[0] * g[0], y[1] * g[1]); w.y = cvt_pk_bf16(y[2] * g[2], y[3] * g[3]); w.z = cvt_pk_bf16(y[4] * g[4], y[5] * g[5]); w.w = cvt_pk_bf16(y[6] * g[6], y[7] * g[7]);
                    *(u32x4*)(O + (size_t)row * ldo + ooff + col0 + bj * HALF) = w; } }
    }
};
template <class Epi, class Sched, bool STAMP = false>
__device__ __forceinline__ void gemm_phase(PG8_LAS unsigned char* lds, const Gemm g, const Sched& S, const Epi& E, unsigned long long* stamps) {
    const int tid = TIDX(), wid = __builtin_amdgcn_readfirstlane(tid >> 6), lane = tid & 63, wr = wid >> 2, wc = wid & 3, fr = lane & 15, fq = lane >> 4;
    const int K = g.K, nt = K / BK;
    int ts_lo = 0, ts_hi = 0, nts = 0; const unsigned long long rt_entry = STAMP ? (unsigned long long)wall_clock64() : 0ull;
#define PG8_STAMP() do { if (STAMP && wid == 0 && nts < 64) { const unsigned long long _c = (unsigned long long)clock64(); \
        ts_lo = (lane == nts) ? (int)(unsigned)_c : ts_lo; ts_hi = (lane == nts) ? (int)(unsigned)(_c >> 32) : ts_hi; ++nts; } } while (0)
    PG8_STAMP();
    unsigned voffA[2], voffB[2];
#pragma unroll
    for (int i = 0; i < 2; ++i) { int R, C; stage_rc(tid * 16 + i * 8192, R, C); const int Rb = Epi::PERM ? ((R & ~31) + perm32(R & 31)) : R;
        voffA[i] = (unsigned)(R * K + C) * 2u; voffB[i] = (unsigned)(Rb * K + C) * 2u; }
    const size_t kstep = (size_t)(BK * 2);
    const size_t hstep = (size_t)HALF * K * 2;
    const size_t tstep = 2 * hstep;
    const unsigned ldsw = (unsigned)wid * 1024u;
    const int aoff = lds_byte(wr * 64 + fr, fq * 8), boff = lds_byte(wc * 32 + fr, fq * 8);
#define PG8_SA(b, h) (((b) * 2 + (h)) * HTB)
#define PG8_SB(b, h) ((4 + (b) * 2 + (h)) * HTB)
#define PG8_STAGE(bufoff, gbase, voff) do { _Pragma("unroll") for (int _i = 0; _i < 2; ++_i) \
        __builtin_amdgcn_global_load_lds((const unsigned*)((const char*)(gbase) + (voff)[_i]), (PG8_LAS unsigned*)(lds + (bufoff) + ldsw + _i * 8192), 16, 0, 0); } while (0)
#define PG8_LDA(dst, b, h) do { _Pragma("unroll") for (int m = 0; m < 4; ++m) _Pragma("unroll") for (int k = 0; k < 2; ++k) dst[m][k] = *(const PG8_LAS bf16x8*)(lds + PG8_SA(b, h) + aoff + m * 2048 + k * 1024); } while (0)
#define PG8_LDB(dst, b, h) do { _Pragma("unroll") for (int n = 0; n < 2; ++n) _Pragma("unroll") for (int k = 0; k < 2; ++k) dst[n][k] = *(const PG8_LAS bf16x8*)(lds + PG8_SB(b, h) + boff + n * 2048 + k * 1024); } while (0)
#define PG8_MMA(ai, bj, At, Bt) do { __builtin_amdgcn_s_setprio(1); _Pragma("unroll") for (int m = 0; m < 4; ++m) _Pragma("unroll") for (int n = 0; n < 2; ++n) _Pragma("unroll") for (int k = 0; k < 2; ++k) \
        acc[ai][bj][m][n] = __builtin_amdgcn_mfma_f32_16x16x32_bf16(Bt[n][k], At[m][k], acc[ai][bj][m][n], 0, 0, 0); __builtin_amdgcn_s_setprio(0); } while (0)
#define PG8_WAIT_V(n) asm volatile("s_waitcnt vmcnt(" #n ")" ::: "memory")
#define PG8_WAIT_L(n) asm volatile("s_waitcnt lgkmcnt(" #n ")" ::: "memory")
#define PG8_BAR __builtin_amdgcn_s_barrier()
#define PG8_SCHED __builtin_amdgcn_sched_barrier(0)
    Unit cur, nxt; int ui = 0;
    if (!S.next(0, cur)) return;
    f32x4 acc[2][2][4][2];
#pragma unroll
    for (int a = 0; a < 2; ++a)
#pragma unroll
        for (int b = 0; b < 2; ++b)
#pragma unroll
            for (int m = 0; m < 4; ++m)
#pragma unroll
                for (int n = 0; n < 2; ++n) acc[a][b][m][n] = (f32x4){0.f, 0.f, 0.f, 0.f};
    bf16x8 At[4][2], B0[2][2], B1[2][2];
    const char* cA = (const char*)g.A + (size_t)cur.pm * tstep; const char* cB = (const char*)g.Bt + (size_t)cur.pn * tstep;
    S.a_ready(cur);
    PG8_STAGE(PG8_SB(0, 0), cB, voffB); PG8_STAGE(PG8_SA(0, 0), cA, voffA); PG8_STAGE(PG8_SB(0, 1), cB + hstep, voffB); PG8_STAGE(PG8_SA(0, 1), cA + hstep, voffA);
    if (wr == 1) PG8_BAR;
    PG8_WAIT_V(4); PG8_BAR;
    PG8_STAGE(PG8_SB(1, 0), cB + kstep, voffB); PG8_STAGE(PG8_SA(1, 0), cA + kstep, voffA); PG8_STAGE(PG8_SB(1, 1), cB + hstep + kstep, voffB);
    PG8_WAIT_V(6); PG8_BAR;
    PG8_STAMP();
    for (;;) {
        const bool has_next = S.next(ui + 1, nxt);
        const char* nA = has_next ? (const char*)g.A + (size_t)nxt.pm * tstep : cA; const char* nB = has_next ? (const char*)g.Bt + (size_t)nxt.pn * tstep : cB;
        for (int t = 0; t < nt; t += 2) {
            const bool last = (t == nt - 2);
            const char* a1 = cA + (size_t)(t + 1) * kstep;
            const char* a2 = last ? nA : cA + (size_t)(t + 2) * kstep; const char* b2 = last ? nB : cB + (size_t)(t + 2) * kstep;
            const char* a3 = a2 + kstep; const char* b3 = b2 + kstep;
            if (last && has_next) S.a_ready(nxt);
            PG8_LDB(B0, 0, 0); PG8_SCHED; PG8_LDA(At, 0, 0); PG8_STAGE(PG8_SA(1, 1), a1 + hstep, voffA);
            PG8_WAIT_L(8); PG8_BAR; PG8_WAIT_L(0); PG8_MMA(0, 0, At, B0); PG8_BAR; PG8_SCHED;
            PG8_LDB(B1, 0, 1); PG8_STAGE(PG8_SB(0, 0), b2, voffB);
            PG8_BAR; PG8_WAIT_L(0); PG8_MMA(0, 1, At, B1); PG8_BAR;
            PG8_LDA(At, 0, 1); PG8_STAGE(PG8_SA(0, 0), a2, voffA);
            PG8_BAR; PG8_WAIT_L(0); PG8_MMA(1, 0, At, B0); PG8_BAR; PG8_SCHED;
            PG8_STAGE(PG8_SB(0, 1), b2 + hstep, voffB);
            PG8_WAIT_V(6); PG8_BAR; PG8_MMA(1, 1, At, B1); PG8_BAR;
            PG8_LDB(B0, 1, 0); PG8_SCHED; PG8_LDA(At, 1, 0); PG8_STAGE(PG8_SA(0, 1), a2 + hstep, voffA);
            PG8_WAIT_L(8); PG8_BAR; PG8_WAIT_L(0); PG8_MMA(0, 0, At, B0); PG8_BAR; PG8_SCHED;
            PG8_LDB(B1, 1, 1); PG8_STAGE(PG8_SB(1, 0), b3, voffB);
            PG8_BAR; PG8_WAIT_L(0); PG8_MMA(0, 1, At, B1); PG8_BAR;
            PG8_LDA(At, 1, 1); PG8_STAGE(PG8_SA(1, 0), a3, voffA);
            PG8_BAR; PG8_WAIT_L(0); PG8_MMA(1, 0, At, B0); PG8_BAR; PG8_SCHED;
            PG8_STAGE(PG8_SB(1, 1), b3 + hstep, voffB);
            PG8_WAIT_V(6); PG8_BAR; PG8_MMA(1, 1, At, B1); PG8_BAR;
        }
        PG8_STAMP();
        if constexpr (!Epi::AFTER_DRAIN) { E(acc, cur, wr, wc, fr, fq); S.done(cur); }
        PG8_STAMP();
        if (!has_next) break;
#pragma unroll
        for (int a = 0; a < 2; ++a)
#pragma unroll
            for (int b = 0; b < 2; ++b)
#pragma unroll
                for (int m = 0; m < 4; ++m)
#pragma unroll
                    for (int n = 0; n < 2; ++n) acc[a][b][m][n] = (f32x4){0.f, 0.f, 0.f, 0.f};
        cur = nxt; cA = nA; cB = nB; ++ui;
    }
    PG8_WAIT_V(0);
    if (wr == 0) PG8_BAR;
    PG8_BAR;
    if constexpr (Epi::AFTER_DRAIN) { E.fused(acc, cur, wr, wc, fr, fq, lds, wid, lane); S.done(cur); }
    PG8_STAMP();
    if (STAMP && wid == 0) { stamps[lane] = lane < nts ? (((unsigned long long)(unsigned)ts_hi << 32) | (unsigned)ts_lo) : 0ull;
        if (lane == 62) stamps[62] = rt_entry; if (lane == 63) stamps[63] = (unsigned long long)wall_clock64(); }
#undef PG8_STAMP
#undef PG8_SA
#undef PG8_SB
#undef PG8_STAGE
#undef PG8_LDA
#undef PG8_LDB
#undef PG8_MMA
#undef PG8_WAIT_V
#undef PG8_WAIT_L
#undef PG8_BAR
#undef PG8_SCHED
}
}
namespace att {
constexpr int D = 128, NW = 8, QBLK = 32, KVBLK = 64;
constexpr float SCALE = 0.088388347648318440f, THR = 8.f;
constexpr int SHM_V = KVBLK * D * 2, SHM_K = KVBLK * D * 2, SHM_ATTN = 2 * SHM_V + 2 * SHM_K + NW * 64 * 4;
#define KSWZ(row, colB) ((row) * 256 + ((colB) ^ (((row) & 7) << 4)))
#define SBAR() __builtin_amdgcn_sched_barrier(0)
__device__ __forceinline__ int crow(int r, int hi) { return (r & 3) + 8 * (r >> 2) + 4 * hi; }
__device__ __forceinline__ unsigned cvtpk(float lo, float hi) { unsigned r; asm volatile("v_cvt_pk_bf16_f32 %0, %1, %2" : "=v"(r) : "v"(lo), "v"(hi)); return r; }

template <bool MASKED>
__device__ __forceinline__ void partialSM(f32x16& p0, f32x16& p1, float& m_reg, float& mn, float& alpha, unsigned long long mw, int hi) {
  constexpr float C = SCALE * 1.4426950408889634f;
  if (MASKED) {
    const unsigned w0 = (unsigned)mw >> (4 * hi), w1 = (unsigned)(mw >> 32) >> (4 * hi);
    const float ninf = -__builtin_inff();
#pragma unroll
    for (int r = 0; r < 16; ++r) { const int bit = (r & 3) + 8 * (r >> 2);
      p0[r] = ((w0 >> bit) & 1u) ? p0[r] : ninf; p1[r] = ((w1 >> bit) & 1u) ? p1[r] : ninf; }
  }
  float pmax = p0[0];
#pragma unroll
  for (int r = 1; r < 16; ++r) pmax = fmaxf(pmax, p0[r]);
#pragma unroll
  for (int r = 0; r < 16; ++r) pmax = fmaxf(pmax, p1[r]);
  { auto rr = __builtin_amdgcn_permlane32_swap(__float_as_uint(pmax), __float_as_uint(pmax), false, false);
    pmax = fmaxf(__uint_as_float(rr[0]), __uint_as_float(rr[1])); }
  if (__builtin_expect(__all(pmax - m_reg <= THR / SCALE), 1)) { mn = m_reg; alpha = 1.f; }
  else { mn = fmaxf(m_reg, pmax); alpha = __builtin_amdgcn_exp2f((m_reg - mn) * C); m_reg = mn; }
  const float mnC = -mn * C;
#pragma unroll
  for (int r = 0; r < 16; ++r) p0[r] = fmaf(p0[r], C, mnC);
#pragma unroll
  for (int r = 0; r < 16; ++r) p1[r] = fmaf(p1[r], C, mnC);
#pragma unroll
  for (int r = 0; r < 16; ++r) p0[r] = __builtin_amdgcn_exp2f(p0[r]);
}
__device__ __forceinline__ void finishSM(f32x16& p0, f32x16& p1, float alpha, float& l_reg, bf16x8& pa0, bf16x8& pa1, bf16x8& pa2, bf16x8& pa3) {
#pragma unroll
  for (int r = 0; r < 16; ++r) p1[r] = __builtin_amdgcn_exp2f(p1[r]);
  float ps = 0;
#pragma unroll
  for (int r = 0; r < 16; ++r) ps += p0[r];
#pragma unroll
  for (int r = 0; r < 16; ++r) ps += p1[r];
  { auto rr = __builtin_amdgcn_permlane32_swap(__float_as_uint(ps), __float_as_uint(ps), false, false);
    ps = __uint_as_float(rr[0]) + __uint_as_float(rr[1]); }
  l_reg = l_reg * alpha + ps;
#define PK4(P, BASE, OUT) do { unsigned a0 = cvtpk(P[BASE + 0], P[BASE + 1]), a1 = cvtpk(P[BASE + 2], P[BASE + 3]);   \
    unsigned b0 = cvtpk(P[BASE + 4], P[BASE + 5]), b1 = cvtpk(P[BASE + 6], P[BASE + 7]);                              \
    auto r0 = __builtin_amdgcn_permlane32_swap(a0, b0, false, false); auto r1 = __builtin_amdgcn_permlane32_swap(a1, b1, false, false); \
    u32x4 w = {r0[0], r1[0], r0[1], r1[1]}; OUT = *reinterpret_cast<bf16x8*>(&w); } while (0)
  PK4(p0, 0, pa0); PK4(p0, 8, pa1); PK4(p1, 0, pa2); PK4(p1, 8, pa3);
#undef PK4
}
__device__ __forceinline__ void qkt(f32x16& p0, f32x16& p1, const char* Ks, const bf16x8* qr, int r32, int hi) {
  p0 = f32x16{}; p1 = f32x16{};
  asm volatile("" : "+v"(p0), "+v"(p1));
#pragma unroll
  for (int d0 = 0; d0 < 8; ++d0) { const int cb = (d0 * 16 + hi * 8) * 2;
    bf16x8 b0 = *reinterpret_cast<const bf16x8*>(Ks + KSWZ(r32, cb));
    bf16x8 b1 = *reinterpret_cast<const bf16x8*>(Ks + KSWZ(32 + r32, cb));
    p0 = __builtin_amdgcn_mfma_f32_32x32x16_bf16(b0, qr[d0], p0, 0, 0, 0);
    p1 = __builtin_amdgcn_mfma_f32_32x32x16_bf16(b1, qr[d0], p1, 0, 0, 0); }
}
__device__ __forceinline__ int v_st(int k, int c) { const int kk = (k & ~0xC) | ((k & 4) << 1) | ((k & 8) >> 1); return ((kk >> 3) * 4 + (c >> 5)) * 512 + ((kk & 7) * 32 + (c & 31)) * 2; }
__device__ __forceinline__ int v_rd_base(int lane) { return ((lane & 3) << 3) | (((lane >> 2) & 3) << 6) | (((lane >> 4) & 1) << 5) | (((lane >> 5) & 1) << 8); }
constexpr int v_rd_off(int d0, int ks, int half) { return d0 * 512 + ks * 4096 + half * 2048; }
template <int OFF> __device__ __forceinline__ s16x4 tr_read(int vb) {
  s16x4 r; asm volatile("ds_read_b64_tr_b16 %0, %1 offset:%2" : "=&v"(r) : "v"(vb), "i"(OFF) : "memory"); return r;
}
template <int D0> __device__ __forceinline__ void pv_one(f32x16& od, int vb, bf16x8 pa0, bf16x8 pa1, bf16x8 pa2, bf16x8 pa3) {
  const s16x4 l0 = tr_read<v_rd_off(D0, 0, 0)>(vb), h0 = tr_read<v_rd_off(D0, 0, 1)>(vb), l1 = tr_read<v_rd_off(D0, 1, 0)>(vb), h1 = tr_read<v_rd_off(D0, 1, 1)>(vb);
  const s16x4 l2 = tr_read<v_rd_off(D0, 2, 0)>(vb), h2 = tr_read<v_rd_off(D0, 2, 1)>(vb), l3 = tr_read<v_rd_off(D0, 3, 0)>(vb), h3 = tr_read<v_rd_off(D0, 3, 1)>(vb);
  asm volatile("s_waitcnt lgkmcnt(0)" ::: "memory"); SBAR();
#define PK(L, H) (bf16x8){L[0], L[1], L[2], L[3], H[0], H[1], H[2], H[3]}
  od = __builtin_amdgcn_mfma_f32_32x32x16_bf16(pa0, PK(l0, h0), od, 0, 0, 0);
  od = __builtin_amdgcn_mfma_f32_32x32x16_bf16(pa1, PK(l1, h1), od, 0, 0, 0);
  od = __builtin_amdgcn_mfma_f32_32x32x16_bf16(pa2, PK(l2, h2), od, 0, 0, 0);
  od = __builtin_amdgcn_mfma_f32_32x32x16_bf16(pa3, PK(l3, h3), od, 0, 0, 0);
#undef PK
}
__device__ __forceinline__ void pv_d0(f32x16* o, int vb, bf16x8 pa0, bf16x8 pa1, bf16x8 pa2, bf16x8 pa3) {
  pv_one<0>(o[0], vb, pa0, pa1, pa2, pa3); pv_one<1>(o[1], vb, pa0, pa1, pa2, pa3); pv_one<2>(o[2], vb, pa0, pa1, pa2, pa3); pv_one<3>(o[3], vb, pa0, pa1, pa2, pa3);
}

template <bool MASKED, int LDK, int VOFF, class OutRow>
__device__ __forceinline__ void attn_body(const bf16_t* __restrict__ Qw, const bf16_t* __restrict__ Kh, int NT,
                                          const unsigned long long* __restrict__ mbase, unsigned moff, const OutRow& Ow, char* lds) {
  const int tid = TIDX(), wid = tid >> 6, lane = tid & 63, r32 = lane & 31, hi = lane >> 5;
  char* V_lds = lds; char* K_lds = lds + 2 * SHM_V;
  float* ws = (float*)(lds + 2 * SHM_V + 2 * SHM_K) + wid * 64; float* li_l = ws; float* al_l = ws + 32;
  float m_reg = -1e30f, l_reg = 0; f32x16 o[4] = {}; bf16x8 qr[8];
  asm volatile("" : "+v"(o[0]), "+v"(o[1]), "+v"(o[2]), "+v"(o[3]));
#pragma unroll
  for (int d0 = 0; d0 < 8; ++d0) qr[d0] = *reinterpret_cast<const bf16x8*>(Qw + d0 * 16);
  const int sr = tid >> 4, sc = (tid & 15) * 8, vst0 = v_st(sr, sc), vst1 = v_st(32 + sr, sc);
  const int vb0 = (int)(uintptr_t)V_lds + v_rd_base(lane);
  struct { bf16x8 vs0, vs1, ks0, ks1; } sr_[2];
  const unsigned koff = (unsigned)(sr * LDK + sc) * 2u;
#define SLOAD(i, k0) do { const char* kb_ = (const char*)Kh + (size_t)(k0) * (LDK * 2); \
    sr_[i].vs0 = *reinterpret_cast<const bf16x8*>(kb_ + koff + VOFF * 2); sr_[i].vs1 = *reinterpret_cast<const bf16x8*>(kb_ + koff + (32 * LDK + VOFF) * 2); \
    sr_[i].ks0 = *reinterpret_cast<const bf16x8*>(kb_ + koff); sr_[i].ks1 = *reinterpret_cast<const bf16x8*>(kb_ + koff + 32 * LDK * 2); } while (0)
#define SWRITE(b, i) do { *(bf16x8*)(V_lds + (b) * SHM_V + vst0) = sr_[i].vs0;          \
    *(bf16x8*)(V_lds + (b) * SHM_V + vst1) = sr_[i].vs1; int kc = sc * 2;               \
    *(bf16x8*)(K_lds + (b) * SHM_K + KSWZ(sr, kc)) = sr_[i].ks0;                       \
    *(bf16x8*)(K_lds + (b) * SHM_K + KSWZ(32 + sr, kc)) = sr_[i].ks1; } while (0)
#define SWAIT() asm volatile("s_waitcnt vmcnt(4)" ::: "memory")
#define RESC(a) do { if (__any((a) < 1.f)) { if (hi == 0) al_l[r32] = (a); asm volatile("s_waitcnt lgkmcnt(0)" ::: "memory"); \
    _Pragma("unroll") for (int d = 0; d < 4; ++d) _Pragma("unroll") for (int r = 0; r < 16; ++r) o[d][r] *= al_l[crow(r, hi)]; } } while (0)
  f32x16 pA0, pA1, pB0, pB1; float mnA, mnB, alA, alB; bf16x8 pa0, pa1, pa2, pa3;
  unsigned long long mw = 0ull;
  constexpr int SE = 0, SO = 1;
  SLOAD(SE, 0); asm volatile("s_waitcnt vmcnt(0)" ::: "memory"); SWRITE(0, SE); __syncthreads();
  if (MASKED) mw = *(const unsigned long long*)((const char*)mbase + moff);
  qkt(pA0, pA1, K_lds, qr, r32, hi); partialSM<MASKED>(pA0, pA1, m_reg, mnA, alA, mw, hi);
  SLOAD(SO, KVBLK); if (2 < NT) SLOAD(SE, 2 * KVBLK);
  if (2 < NT) SWAIT(); else asm volatile("s_waitcnt vmcnt(0)" ::: "memory");
  SWRITE(1, SO); __syncthreads();
  for (int j = 1; j + 1 < NT; j += 2) {
    if (MASKED) mw = *(const unsigned long long*)((const char*)mbase + (moff + 8u * (unsigned)j));
    SBAR(); qkt(pB0, pB1, K_lds + SHM_K, qr, r32, hi);
    finishSM(pA0, pA1, alA, l_reg, pa0, pa1, pa2, pa3); SBAR();
    SLOAD(SO, (j + 2) * KVBLK); SBAR();
    pv_d0(o, vb0, pa0, pa1, pa2, pa3); partialSM<MASKED>(pB0, pB1, m_reg, mnB, alB, mw, hi);
    if (MASKED) mw = *(const unsigned long long*)((const char*)mbase + (moff + 8u * (unsigned)(j + 1)));
    __syncthreads(); SWAIT(); SWRITE(0, SE);
    RESC(alB); __syncthreads();
    SBAR(); qkt(pA0, pA1, K_lds, qr, r32, hi);
    finishSM(pB0, pB1, alB, l_reg, pa0, pa1, pa2, pa3); SBAR();
    if (j + 3 < NT) SLOAD(SE, (j + 3) * KVBLK); SBAR();
    pv_d0(o, vb0 + SHM_V, pa0, pa1, pa2, pa3); partialSM<MASKED>(pA0, pA1, m_reg, mnA, alA, mw, hi);
    __syncthreads(); if (j + 3 < NT) SWAIT(); else asm volatile("s_waitcnt vmcnt(0)" ::: "memory");
    SWRITE(1, SO);
    RESC(alA); __syncthreads();
  }
  if (MASKED) mw = *(const unsigned long long*)((const char*)mbase + (moff + 8u * (unsigned)(NT - 1)));
  SBAR(); qkt(pB0, pB1, K_lds + SHM_K, qr, r32, hi);
  finishSM(pA0, pA1, alA, l_reg, pa0, pa1, pa2, pa3); SBAR();
  pv_d0(o, vb0, pa0, pa1, pa2, pa3); partialSM<MASKED>(pB0, pB1, m_reg, mnB, alB, mw, hi);
  __syncthreads(); RESC(alB);
  finishSM(pB0, pB1, alB, l_reg, pa0, pa1, pa2, pa3); SBAR();
  pv_d0(o, vb0 + SHM_V, pa0, pa1, pa2, pa3);
  if (hi == 0) li_l[r32] = l_reg; asm volatile("s_waitcnt lgkmcnt(0)" ::: "memory");
  float rli[16];
#pragma unroll
  for (int r = 0; r < 16; ++r) rli[r] = __builtin_amdgcn_rcpf(li_l[crow(r, hi)]);
#pragma unroll
  for (int r = 0; r < 16; ++r) { bf16_t* orow = Ow(crow(r, hi));
#pragma unroll
    for (int d0 = 0; d0 < 4; ++d0) orow[d0 * 32 + r32] = f2bf(o[d0][r] * rli[r]); }
  __syncthreads();
#undef SLOAD
#undef SWRITE
#undef SWAIT
#undef RESC
}
}
constexpr size_t al256(size_t x) { return (x + 255) / 256 * 256; }
constexpr size_t WS_CTL   = 0;
constexpr size_t CTL_BYTES = 65536;
constexpr size_t WS_WINT  = WS_CTL + CTL_BYTES;
constexpr size_t WS_WOUTT = WS_WINT + al256((size_t)DEPTH * NPAD * DM * 2);
constexpr size_t WS_WKVT  = WS_WOUTT + al256((size_t)DEPTH * DM * MIX * 2);
constexpr size_t WS_WGLUT = WS_WKVT + al256((size_t)DEPTH * 1024 * DM * 2);
constexpr size_t WS_MEMN  = WS_WGLUT + al256((size_t)DEPTH * 512 * 512 * 2);
constexpr size_t WS_KVMEM = WS_MEMN + al256((size_t)NB * MEML * DM * 2);
constexpr size_t WS_XN    = WS_KVMEM + al256((size_t)NB * MEML * DEPTH * 1024 * 2);
constexpr size_t WS_P     = WS_XN + al256((size_t)NTOK * DM * 2);
constexpr size_t WS_XBUF  = WS_P + al256((size_t)NTOK * NPAD * 2);
constexpr size_t WS_OCAT  = WS_XBUF + al256((size_t)NTOK * DM * 4);
constexpr size_t WS_MASK  = WS_OCAT + al256((size_t)NTOK * MIX * 2);
constexpr size_t WS_IW    = WS_MASK + al256((size_t)NTOK * 64 * 8);
constexpr size_t WS_YBUF  = WS_IW + al256((size_t)NTOK * 16 * 4);
constexpr size_t WS_ROPE  = WS_YBUF + al256((size_t)NTOK * 512 * 2);
constexpr size_t WS_S5P   = WS_ROPE + al256((size_t)NTOK * 48 * 4);
constexpr size_t S5P_BYTES = (size_t)DEPTH * 32 * (64 * 2 + 64 * 2 + 64 * 16 * 2) * 4;
constexpr size_t WS_GLAS  = WS_S5P + al256(S5P_BYTES);
constexpr size_t WS_GLAD  = WS_GLAS + al256((size_t)NB * 64 * 4 * 64 * 128 * 4);
constexpr size_t WS_END   = WS_GLAD + al256((size_t)NB * 64 * 4 * 64 * 4);

struct Params {
    const float* x; const float* mem; const int* pos; const float* ln_gain; const float* w_in; const float* gla_w_up; const float* gla_b_up;
    const float* s5_a_re; const float* s5_a_im; const float* s5_log_step; const float* s5_b_re; const float* s5_b_im; const float* s5_c_re; const float* s5_c_im;
    const float* s5_d; const float* s5_w_glu; const float* dsa_q_norm; const float* dsa_k_norm; const float* mem_norm; const float* w_mem_kv;
    const float* mem_q_norm; const float* mem_k_norm; const float* out_norm; const float* w_out;
    float* out;
    unsigned* ctl; bf16_t* WinT; bf16_t* WoutT; bf16_t* WkvT; bf16_t* WgluT; bf16_t* memn; bf16_t* kvmem; bf16_t* xn; bf16_t* p; float* xbuf; bf16_t* ocat;
    unsigned long long* mask; float* iw; bf16_t* ybuf; float* rope; float* s5p; float* glas; float* glad;
};

__device__ __forceinline__ void transpose_tiles(const float* __restrict__ src, int K, int Nsrc, int Ndst, const float* __restrict__ scale, bf16_t* __restrict__ dst,
                                                int tile, float* lds_tile  ) {
    const int tid = TIDX(), ntn = Ndst / 64;
    const int tk = tile / ntn, tn = tile % ntn, k0 = tk * 64, n0 = tn * 64;
    __syncthreads();
    { const int ty = tid >> 4, tx = tid & 15;
#pragma unroll
      for (int i = 0; i < 2; ++i) { const int k = k0 + ty + 32 * i, n = n0 + 4 * tx;
        f32x4 v = (f32x4){0.f, 0.f, 0.f, 0.f};
        if (n < Nsrc) v = *(const f32x4*)(src + (size_t)k * Nsrc + n);
        const float s = scale ? scale[k] : 1.f;
        float* t = lds_tile + (ty + 32 * i) * 65 + 4 * tx; t[0] = v[0] * s; t[1] = v[1] * s; t[2] = v[2] * s; t[3] = v[3] * s; } }
    __syncthreads();
    { const int n = tid >> 3, kq = tid & 7;
      u32x4 w;
      w.x = pk2bf(lds_tile[(8 * kq + 0) * 65 + n], lds_tile[(8 * kq + 1) * 65 + n]); w.y = pk2bf(lds_tile[(8 * kq + 2) * 65 + n], lds_tile[(8 * kq + 3) * 65 + n]);
      w.z = pk2bf(lds_tile[(8 * kq + 4) * 65 + n], lds_tile[(8 * kq + 5) * 65 + n]); w.w = pk2bf(lds_tile[(8 * kq + 6) * 65 + n], lds_tile[(8 * kq + 7) * 65 + n]);
      *(u32x4*)(dst + (size_t)(n0 + n) * K + k0 + 8 * kq) = w; }
}

__device__ __forceinline__ void rmsnorm_rows(const float* __restrict__ X, bf16_t* __restrict__ Y, int nrows) {
    const int wid = TIDX() >> 6, lane = TIDX() & 63;
    for (int row = blockIdx.x * 8 + wid; row < nrows; row += gridDim.x * 8) {
        const float* xr = X + (size_t)row * DM; f32x4 v[8]; float ss = 0.f;
#pragma unroll
        for (int i = 0; i < 8; ++i) { v[i] = *(const f32x4*)(xr + 4 * lane + 256 * i); ss += v[i][0] * v[i][0] + v[i][1] * v[i][1] + v[i][2] * v[i][2] + v[i][3] * v[i][3]; }
        ss = wave_sum(ss); const float r = rsqrtf(ss * (1.f / DM) + EPS);
        bf16_t* yr = Y + (size_t)row * DM;
#pragma unroll
        for (int i = 0; i < 8; ++i) { u32x2 w; w.x = pk2bf(v[i][0] * r, v[i][1] * r); w.y = pk2bf(v[i][2] * r, v[i][3] * r); *(u32x2*)(yr + 4 * lane + 256 * i) = w; }
    }
}

__device__ __forceinline__ void phase_prologue1(const Params& P, char* lds) {
    float* tile = (float*)lds;
    constexpr int T_IN = (DM / 64) * (NPAD / 64), T_OUT = (MIX / 64) * (DM / 64), T_KV = (DM / 64) * (1024 / 64), T_GLU = 8 * 8;
    constexpr int TOT = DEPTH * (T_IN + T_OUT + T_KV + T_GLU);
    for (int u = blockIdx.x; u < TOT; u += gridDim.x) {
        int l = u / (T_IN + T_OUT + T_KV + T_GLU), r = u % (T_IN + T_OUT + T_KV + T_GLU);
        if (r < T_IN) transpose_tiles(P.w_in + (size_t)l * DM * NIN, DM, NIN, NPAD, P.ln_gain + l * DM, P.WinT + (size_t)l * NPAD * DM, r, tile);
        else if ((r -= T_IN) < T_OUT) transpose_tiles(P.w_out + (size_t)l * MIX * DM, MIX, DM, DM, P.out_norm + l * MIX, P.WoutT + (size_t)l * DM * MIX, r, tile);
        else if ((r -= T_OUT) < T_KV) transpose_tiles(P.w_mem_kv + (size_t)l * DM * 1024, DM, 1024, 1024, P.mem_norm + l * DM, P.WkvT + (size_t)l * 1024 * DM, r, tile);
        else { r -= T_KV; transpose_tiles(P.s5_w_glu + (size_t)l * 512 * 512, 512, 512, 512, nullptr, P.WgluT + (size_t)l * 512 * 512, r, tile); }
    }
    rmsnorm_rows(P.mem, P.memn, NB * MEML);
}
__device__ __forceinline__ void phase_rope_table(const Params& P) {
    for (int idx = blockIdx.x * NTHR + TIDX(); idx < NTOK * 24; idx += gridDim.x * NTHR) {
        const int tok = idx / 24, i = idx % 24;
        const float e = (i < 16) ? -((float)i * 2.0f / 32.0f) : -((float)(i - 16) * 2.0f / 16.0f);
        const float inv_freq = exp2f(e * 18.931568569324174f);
        const float ang = (float)P.pos[tok] * inv_freq;
        const double a = (double)ang; const double k = rint(a * 0.15915494309189535); const float rf = (float)fma(-k, 6.283185307179586, a);
        P.rope[(size_t)idx * 2] = cosf(rf); P.rope[(size_t)idx * 2 + 1] = sinf(rf);
    }
}

__device__ __forceinline__ void phase_rmsnorm_x(const Params& P, int layer) { rmsnorm_rows(layer == 0 ? P.x : P.xbuf, P.xn, NTOK); }

__device__ __forceinline__ void phase_memk_norm(const Params& P) {
    const int wid = TIDX() >> 6, lane = TIDX() & 63;
    for (int it = blockIdx.x * 8 + wid; it < NB * MEML * DEPTH * 4; it += gridDim.x * 8) {
        const int row = it / (DEPTH * 4), l = (it / 4) % DEPTH, h = it % 4;
        bf16_t* kp = P.kvmem + (size_t)row * (DEPTH * 1024) + l * 1024 + h * 128 + 2 * lane;
        const unsigned w = *(const unsigned*)kp; const float a = __uint_as_float(w << 16), b = __uint_as_float(w & 0xffff0000u);
        const float ss = wave_sum(a * a + b * b), r = rsqrtf(ss * (1.f / 128.f) + EPS);
        const float* g = P.mem_k_norm + l * 128 + 2 * lane;
        *(unsigned*)kp = pk2bf(a * r * g[0], b * r * g[1]);
    }
}

__device__ __forceinline__ void ld8f(const bf16_t* p, float (&v)[8]) { const u32x4 w = *(const u32x4*)p;
#pragma unroll
    for (int j = 0; j < 4; ++j) { v[2 * j] = __uint_as_float(w[j] << 16); v[2 * j + 1] = __uint_as_float(w[j] & 0xffff0000u); } }
__device__ __forceinline__ void st8f(bf16_t* p, const float (&v)[8]) { u32x4 w; w.x = pk2bf(v[0], v[1]); w.y = pk2bf(v[2], v[3]); w.z = pk2bf(v[4], v[5]); w.w = pk2bf(v[6], v[7]); *(u32x4*)p = w; }
__device__ __forceinline__ float sum16(float v) { v += shx(v, 1); v += shx(v, 2); v += shx(v, 4); v += shx(v, 8); return v; }

__device__ __forceinline__ void head128_norm_rope(bf16_t* hp, int l16, const float* __restrict__ gain, const float* __restrict__ cs, bool rope, bool do_store) {
    float v[8]; ld8f(hp + 8 * l16, v);
    float ss = 0.f;
#pragma unroll
    for (int j = 0; j < 8; ++j) ss += v[j] * v[j];
    ss = sum16(ss); const float r = rsqrtf(ss * (1.f / 128.f) + EPS);
#pragma unroll
    for (int j = 0; j < 8; ++j) v[j] = v[j] * r * gain[8 * l16 + j];
    if (rope) {
        float o[8];
#pragma unroll
        for (int j = 0; j < 8; ++j) o[j] = shx(v[j], 2);
        if (l16 < 4) { const int fi = (l16 & 1) * 8;
#pragma unroll
            for (int j = 0; j < 8; ++j) { const float c = cs[(fi + j) * 2], s = cs[(fi + j) * 2 + 1];
                v[j] = (l16 < 2) ? (v[j] * c - o[j] * s) : (v[j] * c + o[j] * s); } }
    }
    if (do_store) st8f(hp + 8 * l16, v);
}
__device__ __forceinline__ void rope16_inplace(bf16_t* ip, const float* __restrict__ cs) {
    float a[8], b[8]; ld8f(ip, a); ld8f(ip + 8, b);
#pragma unroll
    for (int j = 0; j < 8; ++j) { const float c = cs[2 * j], s = cs[2 * j + 1], x1 = a[j], x2 = b[j]; a[j] = x1 * c - x2 * s; b[j] = x2 * c + x1 * s; }
    st8f(ip, a); st8f(ip + 8, b);
}
__device__ __forceinline__ void phase_prep(const Params& P, int layer) {
    const int wid = TIDX() >> 6, lane = TIDX() & 63, l16 = lane & 15, grp = lane >> 4;
    for (int tok = blockIdx.x * 8 + wid; tok < NTOK; tok += gridDim.x * 8) {
        bf16_t* row = P.p + (size_t)tok * NPAD;
        const float* cs32 = P.rope + (size_t)tok * 48; const float* cs16 = cs32 + 32;
        head128_norm_rope(row + C_DQ + grp * 128, l16, P.dsa_q_norm + layer * 128, cs32, true, true);
        head128_norm_rope(row + C_DK, l16, P.dsa_k_norm + layer * 128, cs32, true, grp == 0);
        head128_norm_rope(row + C_MQ + grp * 128, l16, P.mem_q_norm + layer * 128, cs32, false, true);
        if ((lane & 3) == 0) rope16_inplace(row + C_DIQ + lane * 16, cs16);
        if (lane == 0) rope16_inplace(row + C_DIK, cs16);
        if (lane < 16) P.iw[(size_t)tok * 16 + lane] = bf2f(row[C_DIW + lane]) * (1.f / 32.f);
    }
}
struct MemOutRow { bf16_t* base; __device__ __forceinline__ bf16_t* operator()(int r) const { return base + (size_t)r * MIX; } };
__device__ __forceinline__ void unit_mem_attn(const Params& P, int layer, int u, char* lds) {
    const int b = u >> 6, h = (u >> 4) & 3, qb = u & 15, tok0 = b * SEQ + qb * 256;
    const int wid = TIDX() >> 6, lane = TIDX() & 63, r32 = lane & 31, hi = lane >> 5;
    const bf16_t* Qw = P.p + (size_t)(tok0 + wid * 32 + r32) * NPAD + C_MQ + h * 128 + hi * 8;
    const bf16_t* Kh = P.kvmem + (size_t)(b * MEML) * (DEPTH * 1024) + layer * 1024 + h * 128;
    MemOutRow ow; ow.base = P.ocat + (size_t)(tok0 + wid * 32) * MIX + 1536 + h * 128;
    att::attn_body<false, DEPTH * 1024, 512, MemOutRow>(Qw, Kh, MEML / 64, nullptr, 0u, ow, lds);
}

__device__ __forceinline__ void phase_gate(const Params& P, int c_lo, int c_hi) {
    const int wid = TIDX() >> 6, lane = TIDX() & 63;
    const int c0 = lane * 32;
    const int seg = c0 >> 9, zc = (seg == 0 ? C_GZ : seg == 1 ? C_SZ : seg == 2 ? C_DZ : C_MZ) + (c0 & 511);
    const bool act = (c0 >= c_lo) && (c0 < c_hi);
    for (int tok = blockIdx.x * 8 + wid; tok < NTOK; tok += gridDim.x * 8) {
        if (!act) { bf16_t* gz_ = P.xn + (size_t)tok * MIX + c0; const u32x4 zz = {0u, 0u, 0u, 0u};
#pragma unroll
            for (int i = 0; i < 4; ++i) *(u32x4*)(gz_ + 8 * i) = zz;
            continue; }
        const bf16_t* op = P.ocat + (size_t)tok * MIX + c0; const bf16_t* zp = P.p + (size_t)tok * NPAD + zc; bf16_t* gp = P.xn + (size_t)tok * MIX + c0;
        float o[32]; float ss = 0.f;
#pragma unroll
        for (int i = 0; i < 4; ++i) { float v[8]; ld8f(op + 8 * i, v);
#pragma unroll
            for (int j = 0; j < 8; ++j) { o[8 * i + j] = v[j]; ss += v[j] * v[j]; } }
        ss += shx(ss, 1); ss += shx(ss, 2);
        const float r = rsqrtf(ss * (1.f / 128.f) + EPS);
#pragma unroll
        for (int i = 0; i < 4; ++i) { float z[8], g[8]; ld8f(zp + 8 * i, z);
#pragma unroll
            for (int j = 0; j < 8; ++j) g[j] = o[8 * i + j] * r * siluf_(z[j]);
            st8f(gp + 8 * i, g); }
    }
}

__device__ __forceinline__ void phase_gemm_in(const Params& P, int layer, char* lds) {
    pg8::Gemm g; g.A = P.xn; g.Bt = P.WinT + (size_t)layer * NPAD * DM; g.M = NTOK; g.N = NPAD; g.K = DM;
    pg8::StaticOrder S; S.init(g.M, g.N, (int)gridDim.x, (int)blockIdx.x);
    pg8::EpiBf16Plain E; E.O = P.p; E.ldc = NPAD;
    pg8::gemm_phase<pg8::EpiBf16Plain, pg8::StaticOrder, false>((PG8_LAS unsigned char*)lds, g, S, E, nullptr);
}
__device__ __forceinline__ void phase_gemm_out(const Params& P, int layer, char* lds) {
    pg8::Gemm g; g.A = P.xn; g.Bt = P.WoutT + (size_t)layer * DM * MIX; g.M = NTOK; g.N = DM; g.K = MIX;
    pg8::StaticOrder S; S.init(g.M, g.N, (int)gridDim.x, (int)blockIdx.x);
    pg8::EpiResid E; E.R = (layer == 0) ? P.x : P.xbuf; E.C = (layer == DEPTH - 1) ? P.out : P.xbuf; E.ldc = DM;
    pg8::gemm_phase<pg8::EpiResid, pg8::StaticOrder, false>((PG8_LAS unsigned char*)lds, g, S, E, nullptr);
}
__device__ __forceinline__ void phase_gemm_kv(const Params& P, char* lds) {
    pg8::Gemm g; g.A = P.memn; g.Bt = P.WkvT; g.M = NB * MEML; g.N = DEPTH * 1024; g.K = DM;
    pg8::StaticOrder S; S.init(g.M, g.N, (int)gridDim.x, (int)blockIdx.x);
    pg8::EpiBf16Plain E; E.O = P.kvmem; E.ldc = DEPTH * 1024;
    pg8::gemm_phase<pg8::EpiBf16Plain, pg8::StaticOrder, false>((PG8_LAS unsigned char*)lds, g, S, E, nullptr);
}
__device__ __forceinline__ void mma_tile(f32x16& acc, const char* A, int lda, const char* B, int ldb, int K, int lane) {
    const int r = lane & 31, kh = lane >> 5;
    const char* ap = A + r * lda + kh * 16; const char* bp = B + r * ldb + kh * 16;
    asm volatile("" : "+v"(acc));
    for (int k = 0; k < K; k += 16) {
        const bf16x8 a = *(const bf16x8*)(ap + k * 2); const bf16x8 b = *(const bf16x8*)(bp + k * 2);
        acc = __builtin_amdgcn_mfma_f32_32x32x16_bf16(a, b, acc, 0, 0, 0);
    }
}
__device__ __forceinline__ int crow32(int r, int hi) { return (r & 3) + 8 * (r >> 2) + 4 * hi; }
__device__ __forceinline__ float log_sigmoid_(float x) { return fminf(x, 0.f) - log1pf(__expf(-fabsf(x))); }

constexpr int GLA_ST = 144;
constexpr int GLA_ST2 = 272;
__device__ __forceinline__ void gla_front(const Params& P, int layer, int tok0, int h, float (&bv)[8], float* glr_s  , float* tot_s  , float* bm_s  , float* bl_s  ) {
    const int tid = TIDX(), d = tid & 63, tg = tid >> 6;
    __syncthreads();
    if (tid < 128) { const int t = tid >> 1, half = tid & 1; float v[8]; ld8f(P.p + (size_t)(tok0 + t) * NPAD + C_GLR + half * 8, v);
#pragma unroll
        for (int j = 0; j < 8; ++j) glr_s[t * 16 + half * 8 + j] = v[j]; }
    float wu[16];
#pragma unroll
    for (int r = 0; r < 16; ++r) wu[r] = P.gla_w_up[((size_t)layer * 16 + r) * 256 + h * 64 + d];
    const float bias = P.gla_b_up[layer * 256 + h * 64 + d];
    __syncthreads();
    float run = 0.f;
#pragma unroll
    for (int i = 0; i < 8; ++i) { const int t = tg * 8 + i; float a = bias;
#pragma unroll
        for (int r = 0; r < 16; ++r) a = fmaf(glr_s[t * 16 + r], wu[r], a);
        run += log_sigmoid_(a) * (1.f / 16.f); bv[i] = run; }
    tot_s[tg * 64 + d] = run;
    __syncthreads();
    float off = 0.f, all = 0.f;
#pragma unroll
    for (int g = 0; g < 8; ++g) { const float v = tot_s[g * 64 + d]; off += (g < tg) ? v : 0.f; all += v; }
#pragma unroll
    for (int i = 0; i < 8; ++i) bv[i] += off;
    if (tg == 4) bm_s[d] = bv[0];
    if (tg == 0) bl_s[d] = all;
    __syncthreads();
}

__device__ __forceinline__ void unit_gla_a(const Params& P, int layer, int u, char* lds) {
    const int b = u >> 8, n = (u >> 2) & 63, h = u & 3, tok0 = b * SEQ + n * 64;
    const int tid = TIDX(), wid = tid >> 6, lane = tid & 63, d = tid & 63, tg = tid >> 6;
    char* kdT = lds;
    char* vT = lds + 64 * GLA_ST;
    float* glr_s = (float*)(lds + 64 * GLA_ST + 128 * GLA_ST); float* tot_s = glr_s + 1024; float* bm_s = tot_s + 512; float* bl_s = bm_s + 64;
    float bv[8]; gla_front(P, layer, tok0, h, bv, glr_s, tot_s, bm_s, bl_s);
    const float bl = bl_s[d];
#pragma unroll
    for (int i = 0; i < 8; ++i) { const int t = tg * 8 + i; const float k = bf2f(P.p[(size_t)(tok0 + t) * NPAD + C_GK + h * 64 + d]);
        *(bf16_t*)(kdT + d * GLA_ST + t * 2) = f2bf(k * __expf(bl - bv[i])); }
    { const int e = tid & 127, sg = tid >> 7;
#pragma unroll
      for (int i = 0; i < 16; ++i) { const int s = sg * 16 + i; *(bf16_t*)(vT + e * GLA_ST + s * 2) = P.p[(size_t)(tok0 + s) * NPAD + C_GV + h * 128 + e]; } }
    __syncthreads();
    const int mt = wid >> 2, nt = wid & 3, hi = lane >> 5;
    f32x16 acc = {}; mma_tile(acc, kdT + mt * 32 * GLA_ST, GLA_ST, vT + nt * 32 * GLA_ST, GLA_ST, 64, lane);
    float* dst = P.glas + ((size_t)((b * 64 + n) * 4 + h)) * 64 * 128;
#pragma unroll
    for (int r = 0; r < 16; ++r) dst[(mt * 32 + crow32(r, hi)) * 128 + nt * 32 + (lane & 31)] = acc[r];
    if (tid < 64) P.glad[((size_t)((b * 64 + n) * 4 + h)) * 64 + tid] = __expf(bl_s[tid]);
}

__device__ __forceinline__ void gla_scan_slice(const Params& P, int idx) {
    {
        const int e = idx & 127, d = (idx >> 7) & 63, h = (idx >> 13) & 3, b = idx >> 15;
        float S = 0.f;
        for (int n0 = 0; n0 < 64; n0 += 8) {
            float ds[8], dc[8];
#pragma unroll
            for (int i = 0; i < 8; ++i) { const size_t cu = (size_t)((b * 64 + n0 + i) * 4 + h); ds[i] = P.glas[cu * 8192 + d * 128 + e]; dc[i] = P.glad[cu * 64 + d]; }
#pragma unroll
            for (int i = 0; i < 8; ++i) { const size_t cu = (size_t)((b * 64 + n0 + i) * 4 + h); P.glas[cu * 8192 + d * 128 + e] = S; S = fmaf(dc[i], S, ds[i]); }
        }
    }
}

__device__ __forceinline__ void unit_gla_c(const Params& P, int layer, int u, char* lds) {
    const int b = u >> 8, n = (u >> 2) & 63, h = u & 3, tok0 = b * SEQ + n * 64;
    const int tid = TIDX(), wid = tid >> 6, lane = tid & 63, d = tid & 63, tg = tid >> 6, hi = lane >> 5;
    char* Acat = lds;
    char* Bcat = Acat + 64 * GLA_ST2;
    char* qe = Bcat + 128 * GLA_ST2;
    char* ke = qe + 64 * GLA_ST;
    float* glr_s = (float*)(ke + 64 * GLA_ST); float* tot_s = glr_s + 1024; float* bm_s = tot_s + 512; float* bl_s = bm_s + 64;
    float bv[8]; gla_front(P, layer, tok0, h, bv, glr_s, tot_s, bm_s, bl_s);
    const float m = bm_s[d];
#pragma unroll
    for (int i = 0; i < 8; ++i) { const int t = tg * 8 + i; const bf16_t* row = P.p + (size_t)(tok0 + t) * NPAD;
        const float q = bf2f(row[C_GQ + h * 64 + d]) * 0.125f, k = bf2f(row[C_GK + h * 64 + d]);
        *(bf16_t*)(qe + t * GLA_ST + d * 2) = f2bf(q * __expf(bv[i] - m));
        *(bf16_t*)(ke + t * GLA_ST + d * 2) = f2bf(k * __expf(m - bv[i]));
        *(bf16_t*)(Acat + t * GLA_ST2 + (64 + d) * 2) = f2bf(q * __expf(bv[i])); }
    { const int e = tid & 127, sg = tid >> 7;
      const float* sp = P.glas + ((size_t)((b * 64 + n) * 4 + h)) * 64 * 128;
#pragma unroll
      for (int i = 0; i < 16; ++i) { const int s = sg * 16 + i;
          *(bf16_t*)(Bcat + e * GLA_ST2 + s * 2) = P.p[(size_t)(tok0 + s) * NPAD + C_GV + h * 128 + e];
          *(bf16_t*)(Bcat + e * GLA_ST2 + (64 + s) * 2) = f2bf(sp[s * 128 + e]); } }
    __syncthreads();
    if (wid < 4) { const int mt = wid >> 1, nt = wid & 1;
        f32x16 acc = {}; mma_tile(acc, qe + mt * 32 * GLA_ST, GLA_ST, ke + nt * 32 * GLA_ST, GLA_ST, 64, lane);
#pragma unroll
        for (int r = 0; r < 16; ++r) { const int t = mt * 32 + crow32(r, hi), s = nt * 32 + (lane & 31);
            *(bf16_t*)(Acat + t * GLA_ST2 + s * 2) = f2bf(s <= t ? acc[r] : 0.f); } }
    __syncthreads();
    { const int mt = wid >> 2, nt = wid & 3;
      f32x16 acc = {}; mma_tile(acc, Acat + mt * 32 * GLA_ST2, GLA_ST2, Bcat + nt * 32 * GLA_ST2, GLA_ST2, 128, lane);
#pragma unroll
      for (int r = 0; r < 16; ++r) { const int t = mt * 32 + crow32(r, hi);
          P.ocat[(size_t)(tok0 + t) * MIX + h * 128 + nt * 32 + (lane & 31)] = f2bf(acc[r]); } }
}
constexpr int S5P_STRIDE = 2304;
__device__ __forceinline__ void phase_s5_params(const Params& P) {
    for (int idx = blockIdx.x * NTHR + TIDX(); idx < DEPTH * 32 * 64; idx += gridDim.x * NTHR) {
        const int p = idx & 63, lg = idx >> 6;
        const float ar = P.s5_a_re[idx], ai = P.s5_a_im[idx], step = expf(P.s5_log_step[lg]);
        const float mag = expf(ar * step), th = ai * step;
        const float lr = mag * cosf(th), li = mag * sinf(th);
        float* o = P.s5p + (size_t)lg * S5P_STRIDE;
        o[2 * p] = lr; o[2 * p + 1] = li;
        { const float mag512 = expf(512.f * ar * step); const double a = 512.0 * (double)th; const double k = rint(a * 0.15915494309189535); const float rf = (float)fma(-k, 6.283185307179586, a);
          o[128 + 2 * p] = mag512 * cosf(rf); o[128 + 2 * p + 1] = mag512 * sinf(rf); }
        const float xr = lr - 1.f, xi = li, den = 1.f / (ar * ar + ai * ai);
        const float fr = (xr * ar + xi * ai) * den, fi = (xi * ar - xr * ai) * den;
        for (int c = 0; c < 16; ++c) { const float br = P.s5_b_re[(size_t)idx * 16 + c], bi = P.s5_b_im[(size_t)idx * 16 + c];
            o[256 + (p * 16 + c) * 2] = fr * br - fi * bi; o[256 + (p * 16 + c) * 2 + 1] = fr * bi + fi * br; }
    }
}
__device__ __forceinline__ float gelu_tanh_(float x) { const float u = 0.7978845608028654f * (x + 0.044715f * x * x * x); const float e = __expf(-2.f * fabsf(u)); const float th = copysignf((1.f - e) / (1.f + e), u); return 0.5f * x * (1.f + th); }

constexpr int S5_XST = 272;
constexpr int S5_UST = 48;
__device__ __forceinline__ float partner32(float v, int hi) { auto rr = __builtin_amdgcn_permlane32_swap(__float_as_uint(v), __float_as_uint(v), false, false); return __uint_as_float(hi ? rr[0] : rr[1]); }
struct S5Ctx { float l0r, l0i, l1r, l1i, q0r, q0i, q1r, q1i, dsk; char* Cm; char* Bb; char* Xs; char* Us; int lane, hi, j, rho; const bf16_t* ubase; bf16_t* ybase; };
template <bool OUT> __device__ __forceinline__ void s5_tile(const S5Ctx& C, int tok0, float& x0r, float& x0i, float& x1r, float& x1i) {
    const int hi = C.hi, j = C.j, lane = C.lane;
    if (hi == 0) { const bf16_t* up = C.ubase + (size_t)(tok0 + j) * NPAD;
        const bf16x8 w0 = *(const bf16x8*)up, w1 = *(const bf16x8*)(up + 8);
        *(bf16x8*)(C.Us + C.rho * S5_UST) = w0; *(bf16x8*)(C.Us + C.rho * S5_UST + 16) = w1; }
    asm volatile("" ::: "memory");
    f32x16 a0 = {}, a1 = {}, a2 = {}, a3 = {};
    mma_tile(a0, C.Us, S5_UST, C.Bb, S5_UST, 16, lane); mma_tile(a1, C.Us, S5_UST, C.Bb + 32 * S5_UST, S5_UST, 16, lane);
    mma_tile(a2, C.Us, S5_UST, C.Bb + 64 * S5_UST, S5_UST, 16, lane); mma_tile(a3, C.Us, S5_UST, C.Bb + 96 * S5_UST, S5_UST, 16, lane);
    float s0r[16], s0i[16], s1r[16], s1i[16];
#pragma unroll
    for (int r = 0; r < 16; ++r) {
        const float n0r = fmaf(C.l0r, x0r, fmaf(-C.l0i, x0i, a0[r])), n0i = fmaf(C.l0r, x0i, fmaf(C.l0i, x0r, a1[r])); x0r = n0r; x0i = n0i; s0r[r] = n0r; s0i[r] = n0i;
        const float n1r = fmaf(C.l1r, x1r, fmaf(-C.l1i, x1i, a2[r])), n1i = fmaf(C.l1r, x1i, fmaf(C.l1i, x1r, a3[r])); x1r = n1r; x1i = n1i; s1r[r] = n1r; s1i[r] = n1i; }
    float z0r = partner32(x0r, hi), z0i = partner32(x0i, hi), z1r = partner32(x1r, hi), z1i = partner32(x1i, hi);
    if (hi == 0) { z0r = 0.f; z0i = 0.f; z1r = 0.f; z1i = 0.f; }
    if (!OUT) {
        x0r += C.q0r * z0r - C.q0i * z0i; x0i += C.q0r * z0i + C.q0i * z0r; x1r += C.q1r * z1r - C.q1i * z1i; x1i += C.q1r * z1i + C.q1i * z1r;
    } else {
#pragma unroll
        for (int r = 0; r < 16; ++r) {
            const float t0r = C.l0r * z0r - C.l0i * z0i, t0i = C.l0r * z0i + C.l0i * z0r; z0r = t0r; z0i = t0i; s0r[r] += t0r; s0i[r] += t0i;
            const float t1r = C.l1r * z1r - C.l1i * z1i, t1i = C.l1r * z1i + C.l1i * z1r; z1r = t1r; z1i = t1i; s1r[r] += t1r; s1i[r] += t1i; }
        x0r = s0r[15]; x0i = s0i[15]; x1r = s1r[15]; x1i = s1i[15];
#pragma unroll
        for (int r = 0; r < 16; ++r) { char* xr_ = C.Xs + (r + 16 * hi) * S5_XST;
            *(bf16_t*)(xr_ + j * 2) = f2bf(s0r[r]); *(bf16_t*)(xr_ + (64 + j) * 2) = f2bf(s0i[r]);
            *(bf16_t*)(xr_ + (32 + j) * 2) = f2bf(s1r[r]); *(bf16_t*)(xr_ + (96 + j) * 2) = f2bf(s1i[r]); }
        asm volatile("" ::: "memory");
        f32x16 acc = {}; mma_tile(acc, C.Xs, S5_XST, C.Cm, S5_XST, 128, lane);
        if (j < 16) {
#pragma unroll
            for (int r = 0; r < 16; ++r) { const int t = crow32(r, hi); const int rt = ((t & 15) & 3) + 8 * ((t & 15) >> 2) + 4 * (t >> 4);
                const float y = acc[r] + C.dsk * bf2f(*(const bf16_t*)(C.Us + rt * S5_UST + j * 2));
                C.ybase[(size_t)(tok0 + t) * 512 + j] = f2bf(gelu_tanh_(y)); } }
        asm volatile("" ::: "memory");
    }
    { const float e0r = partner32(x0r, hi), e0i = partner32(x0i, hi), e1r = partner32(x1r, hi), e1i = partner32(x1i, hi);
      if (hi == 0) { x0r = e0r; x0i = e0i; x1r = e1r; x1i = e1i; } else { x0r = 0.f; x0i = 0.f; x1r = 0.f; x1i = 0.f; } }
}
__device__ __forceinline__ void unit_s5(const Params& P, int layer, int u, char* lds) {
    const int b = u >> 5, g = u & 31, tid = TIDX(), wid = tid >> 6, lane = tid & 63, hi = lane >> 5, j = lane & 31;
    char* Cm = lds;
    char* Bb = Cm + 32 * S5_XST;
    float* ends = (float*)(Bb + 128 * S5_UST);
    char* wbase = (char*)(ends + 8 * 64 * 2) + wid * (32 * S5_XST + 32 * S5_UST);
    const float* sp = P.s5p + (size_t)(layer * 32 + g) * S5P_STRIDE;
    __syncthreads();
    for (int i = tid; i < 32 * 128; i += NTHR) { const int c = i >> 7, pp = i & 127; float v = 0.f;
        if (c < 16) v = (pp < 64) ? P.s5_c_re[((size_t)(layer * 32 + g) * 16 + c) * 64 + pp] : -P.s5_c_im[((size_t)(layer * 32 + g) * 16 + c) * 64 + (pp - 64)];
        *(bf16_t*)(Cm + c * S5_XST + pp * 2) = f2bf(v); }
    for (int i = tid; i < 128 * 16; i += NTHR) { const int n = i >> 4, c = i & 15, nt = n >> 5, jj = n & 31, p = (nt >> 1) * 32 + jj;
        *(bf16_t*)(Bb + n * S5_UST + c * 2) = f2bf(sp[256 + (p * 16 + c) * 2 + (nt & 1)]); }
    S5Ctx C; C.Cm = Cm; C.Bb = Bb; C.Xs = wbase; C.Us = wbase + 32 * S5_XST; C.lane = lane; C.hi = hi; C.j = j;
    C.l0r = sp[2 * j]; C.l0i = sp[2 * j + 1]; C.l1r = sp[2 * (32 + j)]; C.l1i = sp[2 * (32 + j) + 1];
    { float q0r = C.l0r, q0i = C.l0i, q1r = C.l1r, q1i = C.l1i;
#pragma unroll
      for (int k = 0; k < 4; ++k) { const float a = q0r * q0r - q0i * q0i, bb = 2.f * q0r * q0i; q0r = a; q0i = bb; const float c = q1r * q1r - q1i * q1i, d = 2.f * q1r * q1i; q1r = c; q1i = d; }
      C.q0r = q0r; C.q0i = q0i; C.q1r = q1r; C.q1i = q1i; }
    C.dsk = P.s5_d[layer * 512 + g * 16 + (lane & 15)];
    C.rho = ((j & 15) & 3) + 8 * ((j & 15) >> 2) + 4 * (j >> 4);
    const int tokw = b * SEQ + wid * 512;
    C.ubase = P.p + C_SU + g * 16; C.ybase = P.ybuf + g * 16;
    float x0r = 0.f, x0i = 0.f, x1r = 0.f, x1i = 0.f;
    __syncthreads();
    for (int sc = 0; sc < 16; ++sc) s5_tile<false>(C, tokw + sc * 32, x0r, x0i, x1r, x1i);
    if (hi == 0) { ends[(wid * 64 + j) * 2] = x0r; ends[(wid * 64 + j) * 2 + 1] = x0i; ends[(wid * 64 + 32 + j) * 2] = x1r; ends[(wid * 64 + 32 + j) * 2 + 1] = x1i; }
    __syncthreads();
    { const float p0r = sp[128 + 2 * j], p0i = sp[128 + 2 * j + 1], p1r = sp[128 + 2 * (32 + j)], p1i = sp[128 + 2 * (32 + j) + 1];
      x0r = 0.f; x0i = 0.f; x1r = 0.f; x1i = 0.f;
      for (int w = 0; w < wid; ++w) { const float e0r = ends[(w * 64 + j) * 2], e0i = ends[(w * 64 + j) * 2 + 1], e1r = ends[(w * 64 + 32 + j) * 2], e1i = ends[(w * 64 + 32 + j) * 2 + 1];
          const float n0r = p0r * x0r - p0i * x0i + e0r, n0i = p0r * x0i + p0i * x0r + e0i, n1r = p1r * x1r - p1i * x1i + e1r, n1i = p1r * x1i + p1i * x1r + e1i;
          x0r = n0r; x0i = n0i; x1r = n1r; x1i = n1i; }
      if (hi) { x0r = 0.f; x0i = 0.f; x1r = 0.f; x1i = 0.f; } }
    for (int sc = 0; sc < 16; ++sc) s5_tile<true>(C, tokw + sc * 32, x0r, x0i, x1r, x1i);
}
constexpr int TOPK = 256;
__device__ __forceinline__ unsigned f2key(float f) { const unsigned u = __float_as_uint(f); return u ^ ((u & 0x80000000u) ? 0xffffffffu : 0x80000000u); }

__device__ __forceinline__ void dsa_score_tile(const bf16x8 (&afr)[4][4], const f32x16 (&wv)[4], const bf16x8 (&bfr)[4], float* sc, int col, int hi) {
#pragma unroll
    for (int rt = 0; rt < 4; ++rt) { f32x16 acc = {}; asm volatile("" : "+v"(acc));
#pragma unroll
        for (int kk = 0; kk < 4; ++kk) acc = __builtin_amdgcn_mfma_f32_32x32x16_bf16(afr[rt][kk], bfr[kk], acc, 0, 0, 0);
        float s0 = 0.f, s1 = 0.f;
#pragma unroll
        for (int i = 0; i < 16; i += 2) { s0 = fmaf(fmaxf(acc[i], 0.f), wv[rt][i], s0); s1 = fmaf(fmaxf(acc[i + 1], 0.f), wv[rt][i + 1], s1); }
        sc[(2 * rt + hi) * 4096 + col] = (s0 + s1) + 0.f; }
}
#define DSA_CNT4(K0, K1, K2, K3) asm volatile( \
    "v_cmp_ge_u32_e64 %[m0], %[k0], %[cd]\n\tv_cmp_ge_u32_e64 %[m1], %[k1], %[cd]\n\tv_cmp_ge_u32_e64 %[m2], %[k2], %[cd]\n\tv_cmp_ge_u32_e64 %[m3], %[k3], %[cd]\n\t" \
    "v_addc_co_u32_e64 %[a0], %[m0], %[a0], 0, %[m0]\n\tv_addc_co_u32_e64 %[a1], %[m1], %[a1], 0, %[m1]\n\t" \
    "v_addc_co_u32_e64 %[a0], %[m2], %[a0], 0, %[m2]\n\tv_addc_co_u32_e64 %[a1], %[m3], %[a1], 0, %[m3]" \
    : [a0] "+v"(c0), [a1] "+v"(c1), [m0] "=&s"(sm0), [m1] "=&s"(sm1), [m2] "=&s"(sm2), [m3] "=&s"(sm3) \
    : [k0] "v"(K0), [k1] "v"(K1), [k2] "v"(K2), [k3] "v"(K3), [cd] "v"(cand))
#define DSA_CNT8(J0) do { DSA_CNT4(key[(J0)], key[(J0) + 1], key[(J0) + 2], key[(J0) + 3]); DSA_CNT4(key[(J0) + 4], key[(J0) + 5], key[(J0) + 6], key[(J0) + 7]); } while (0)

__device__ __forceinline__ void unit_dsa_index(const Params& P, int u, char* lds) {
    const int b = u & 3, t0 = (511 - (u >> 2)) * 8;
    const int tid = TIDX(), wid = tid >> 6, lane = tid & 63, r32 = lane & 31, hi = lane >> 5;
    float* sc = (float*)lds;
    const bf16_t* pb = P.p + (size_t)b * SEQ * NPAD;
    __syncthreads();
    {
        bf16x8 afr[4][4]; f32x16 wv[4];
        const int qsel = (r32 >> 2) & 1, head = (r32 & 3) + 4 * (r32 >> 3);
#pragma unroll
        for (int rt = 0; rt < 4; ++rt) { const bf16_t* qp = pb + (size_t)(t0 + 2 * rt + qsel) * NPAD + C_DIQ + head * 64 + hi * 8;
#pragma unroll
            for (int kk = 0; kk < 4; ++kk) afr[rt][kk] = *(const bf16x8*)(qp + kk * 16);
            const float* wp = P.iw + (size_t)(b * SEQ + t0 + 2 * rt + hi) * 16;
#pragma unroll
            for (int i = 0; i < 4; ++i) { const f32x4 w4 = *(const f32x4*)(wp + 4 * i); wv[rt][4 * i] = w4[0]; wv[rt][4 * i + 1] = w4[1]; wv[rt][4 * i + 2] = w4[2]; wv[rt][4 * i + 3] = w4[3]; } }
        const int ntile = (t0 + 7) / 32 + 1;
        const bf16_t* kp = pb + (size_t)r32 * NPAD + C_DIK + hi * 8;
        bf16x8 b0[4], b1[4], b2[4], b3[4];
#define DSA_LDB(dst, K) do { const bf16_t* kq_ = kp + (size_t)(wid + 8 * (K)) * 32 * NPAD; _Pragma("unroll") for (int kk = 0; kk < 4; ++kk) dst[kk] = *(const bf16x8*)(kq_ + kk * 16); } while (0)
#define DSA_TILE(buf, K) dsa_score_tile(afr, wv, buf, sc, (wid + 8 * (K)) * 32 + r32, hi)
        const int nk = (ntile - wid + 7) >> 3;
        const int kl = nk > 0 ? nk - 1 : 0;
#define DSA_MIN(a) ((a) < kl ? (a) : kl)
        DSA_LDB(b0, DSA_MIN(0)); DSA_LDB(b1, DSA_MIN(1)); DSA_LDB(b2, DSA_MIN(2));
        int k = 0;
        for (; k + 4 <= nk; k += 4) {
            DSA_LDB(b3, k + 3); DSA_TILE(b0, k);
            DSA_LDB(b0, DSA_MIN(k + 4)); DSA_TILE(b1, k + 1);
            DSA_LDB(b1, DSA_MIN(k + 5)); DSA_TILE(b2, k + 2);
            DSA_LDB(b2, DSA_MIN(k + 6)); DSA_TILE(b3, k + 3);
        }
        if (k < nk) DSA_TILE(b0, k);
        if (k + 1 < nk) DSA_TILE(b1, k + 1);
        if (k + 2 < nk) DSA_TILE(b2, k + 2);
#undef DSA_MIN
#undef DSA_TILE
#undef DSA_LDB
    }
    __syncthreads();
    {
        const int t = t0 + wid; const float* srow = sc + wid * 4096;
        unsigned key[64];
#pragma unroll
        for (int j = 0; j < 64; ++j) { const int s = j * 64 + lane; key[j] = (s <= t) ? f2key(srow[s]) : 0u; }
        unsigned long long* mout = P.mask + (size_t)(b * SEQ + t) * 64;
        unsigned long long myword = 0ull;
        if (t + 1 <= TOPK) {
#pragma unroll
            for (int j = 0; j < 64; ++j) { const unsigned long long m = __ballot(j * 64 + lane <= t); if (lane == j) myword = m; }
        } else {
            const int ngrp = t / 512 + 1;
            unsigned T = 0u; int cntT = t + 1;
            unsigned kmax = 0u;
#pragma unroll
            for (int j = 0; j < 64; ++j) kmax = key[j] > kmax ? key[j] : kmax;
#pragma unroll
            for (int o = 32; o >= 1; o >>= 1) { const unsigned other = (unsigned)__builtin_amdgcn_ds_bpermute(((lane ^ o) << 2), (int)kmax); kmax = other > kmax ? other : kmax; }
            for (int bit = 31; bit >= 0; --bit) {
                const unsigned cand = T | (1u << bit); unsigned c0 = 0, c1 = 0; unsigned long long sm0, sm1, sm2, sm3;
                if (cand > kmax) continue;
                DSA_CNT8(0);
                if (ngrp > 1) DSA_CNT8(8);
                if (ngrp > 2) DSA_CNT8(16);
                if (ngrp > 3) DSA_CNT8(24);
                if (ngrp > 4) DSA_CNT8(32);
                if (ngrp > 5) DSA_CNT8(40);
                if (ngrp > 6) DSA_CNT8(48);
                if (ngrp > 7) DSA_CNT8(56);
                const int cl = (int)(c0 + c1);
                int cnt = 0;
#pragma unroll
                for (int bb = 0; bb < 7; ++bb) cnt += __popcll(__ballot((cl >> bb) & 1)) << bb;
                if (cnt >= TOPK) { T = cand; cntT = cnt; if (cnt == TOPK) break; }
            }
            if (cntT == TOPK) {
#pragma unroll
                for (int j = 0; j < 64; ++j) { const unsigned long long m = __ballot(key[j] >= T); if (lane == j) myword = m; }
            } else {
                int ngt = 0;
#pragma unroll
                for (int j = 0; j < 64; ++j) ngt += __popcll(__ballot(key[j] > T));
                int need = TOPK - ngt;
#pragma unroll
                for (int j = 0; j < 64; ++j) { const unsigned long long eq = __ballot(key[j] == T), gt = __ballot(key[j] > T);
                    const int ne = __popcll(eq); unsigned long long take = eq;
                    if (ne > need) { take = 0ull; int left = need; unsigned long long e2 = eq;
                        while (left > 0) { const unsigned long long lowbit = e2 & (0ull - e2); take |= lowbit; e2 ^= lowbit; --left; } }
                    need -= (ne > need) ? need : ne;
                    const unsigned long long m = gt | take; if (lane == j) myword = m; }
            }
        }
        mout[lane] = myword;
    }
}

struct DsaOutRow { bf16_t* base; int wid; __device__ __forceinline__ bf16_t* operator()(int r) const { const int rho = wid * 32 + r; return base + (size_t)(rho >> 2) * MIX + (rho & 3) * 128; } };
__device__ __forceinline__ void unit_dsa_attn(const Params& P, int u, char* lds) {
    const int b = u & 3, qb = 63 - (u >> 2), t0 = qb * 64, tokb = b * SEQ;
    const int wid = TIDX() >> 6, lane = TIDX() & 63, r32 = lane & 31, hi = lane >> 5;
    const int rho = wid * 32 + r32, tq = t0 + (rho >> 2), hq = rho & 3;
    const bf16_t* Qw = P.p + (size_t)(tokb + tq) * NPAD + C_DQ + hq * 128 + hi * 8;
    const bf16_t* Kh = P.p + (size_t)tokb * NPAD + C_DK;
    const unsigned moff = (unsigned)(tokb + tq) * 512u;
    DsaOutRow ow; ow.base = P.ocat + (size_t)(tokb + t0) * MIX + 1024; ow.wid = wid;
    const int NT = (qb + 2) & ~1;
    att::attn_body<true, NPAD, C_DV - C_DK, DsaOutRow>(Qw, Kh, NT, P.mask, moff, ow, lds);
}
__device__ __forceinline__ void phase_gemm_glu(const Params& P, int layer, char* lds) {
    pg8::Gemm g; g.A = P.ybuf; g.Bt = P.WgluT + (size_t)layer * 512 * 512; g.M = NTOK; g.N = 512; g.K = 512;
    pg8::StaticOrder S; S.init(g.M, g.N, (int)gridDim.x, (int)blockIdx.x);
    pg8::EpiGlu E; E.Y = P.ybuf; E.ldy = 512; E.O = P.ocat; E.ldo = MIX; E.ooff = 512;
    pg8::gemm_phase<pg8::EpiGlu, pg8::StaticOrder, false>((PG8_LAS unsigned char*)lds, g, S, E, nullptr);
}

constexpr int CTL_Q0 = 4096;
struct OneUnit { int pm, pn; __device__ __forceinline__ bool next(int i, pg8::Unit& u) const { if (i) return false; u.pm = pm; u.pn = pn; return true; }
    __device__ __forceinline__ void a_ready(const pg8::Unit&) const {} __device__ __forceinline__ void done(const pg8::Unit&) const {} };
__device__ __forceinline__ int q_issue(unsigned* ctr) { return (int)__hip_atomic_fetch_add(ctr, 1u, __ATOMIC_RELAXED, __HIP_MEMORY_SCOPE_AGENT); }
#define Q_LOOP_BEGIN(ctr, total)  { unsigned* q_ctr_ = (ctr); const int q_total_ = (total); volatile int* q_b_ = (volatile int*)(lds + LDS_TAIL + 16); \
    for (;;) { __syncthreads(); if (TIDX() == 0) *q_b_ = q_issue(q_ctr_); __syncthreads(); const int item = __builtin_amdgcn_readfirstlane(*q_b_); if (item >= q_total_) break;
#define Q_LOOP_END  } }
__device__ __forceinline__ void unit_glu(const Params& P, int layer, int u, char* lds) {
    pg8::Gemm g; g.A = P.ybuf; g.Bt = P.WgluT + (size_t)layer * 512 * 512; g.M = NTOK; g.N = 512; g.K = 512;
    OneUnit S; S.pm = u >> 1; S.pn = u & 1;
    pg8::EpiGlu E; E.Y = P.ybuf; E.ldy = 512; E.O = P.ocat; E.ldo = MIX; E.ooff = 512;
    pg8::gemm_phase<pg8::EpiGlu, OneUnit, false>((PG8_LAS unsigned char*)lds, g, S, E, nullptr);
}
constexpr int LDS_TAIL = LDS_BYTES - 64;

__global__ __launch_bounds__(NTHR, 2) void k_mega(Params P) {
    extern __shared__ __attribute__((aligned(16))) char lds[];
    if (TIDX() == 0) *(uint4*)(lds + LDS_TAIL) = make_uint4(0u, 0u, 0u, 0u);
    __syncthreads();
    XcdBarrier bar = xcd_barrier_post(P.ctl, (volatile LAS unsigned*)(lds + LDS_TAIL));
    const int G = gridDim.x, B = blockIdx.x;
    phase_prologue1(P, lds); phase_rope_table(P); phase_s5_params(P); phase_rmsnorm_x(P, 0);
    xcd_barrier(bar);
    for (int layer = 0; layer < DEPTH; ++layer) {
        if (layer > 0) { phase_rmsnorm_x(P, layer); xcd_barrier(bar); }
        phase_gemm_in(P, layer, lds);
        if (layer == 0) phase_gemm_kv(P, lds);
        xcd_barrier(bar);
        phase_prep(P, layer);
        if (layer == 0) phase_memk_norm(P);
        xcd_barrier(bar);
        Q_LOOP_BEGIN(P.ctl + CTL_Q0 + 64 * (layer * 2), 128 + 2048 + 256 + 256)
            if (item < 128) unit_s5(P, layer, item, lds);
            else if (item < 2176) unit_dsa_index(P, item - 128, lds);
            else if (item < 2432) unit_mem_attn(P, layer, item - 2176, lds);
            else { for (int k = 0; k < 4; ++k) unit_gla_a(P, layer, (item - 2432) * 4 + k, lds); }
        Q_LOOP_END
        xcd_barrier(bar);
        Q_LOOP_BEGIN(P.ctl + CTL_Q0 + 64 * (layer * 2 + 1), 256 + 128 + 256)
            if (item < 256) unit_dsa_attn(P, item, lds);
            else if (item < 384) unit_glu(P, layer, item - 256, lds);
            else gla_scan_slice(P, (item - 384) * NTHR + TIDX());
        Q_LOOP_END
        xcd_barrier(bar);
        for (int u = B; u < 1024; u += G) unit_gla_c(P, layer, u, lds);
        xcd_barrier(bar);
        phase_gate(P, 0, 2048);
        xcd_barrier(bar);
        phase_gemm_out(P, layer, lds);
        xcd_barrier(bar);
    }
}

extern "C" void kernel_launch(void* const* d_in, const int* in_sizes, int n_in, void* d_out, int out_size, void* d_ws, size_t ws_size, hipStream_t stream) {
    if (n_in != 24 || ws_size < WS_END) { fprintf(stderr, "kernel_launch: unexpected n_in %d or ws_size %zu (< %zu)\n", n_in, ws_size, (size_t)WS_END); return; }
    Params P; memset(&P, 0, sizeof(P));
    P.x = (const float*)d_in[0]; P.mem = (const float*)d_in[1]; P.pos = (const int*)d_in[2]; P.ln_gain = (const float*)d_in[3]; P.w_in = (const float*)d_in[4];
    P.gla_w_up = (const float*)d_in[5]; P.gla_b_up = (const float*)d_in[6]; P.s5_a_re = (const float*)d_in[7]; P.s5_a_im = (const float*)d_in[8]; P.s5_log_step = (const float*)d_in[9];
    P.s5_b_re = (const float*)d_in[10]; P.s5_b_im = (const float*)d_in[11]; P.s5_c_re = (const float*)d_in[12]; P.s5_c_im = (const float*)d_in[13]; P.s5_d = (const float*)d_in[14];
    P.s5_w_glu = (const float*)d_in[15]; P.dsa_q_norm = (const float*)d_in[16]; P.dsa_k_norm = (const float*)d_in[17]; P.mem_norm = (const float*)d_in[18]; P.w_mem_kv = (const float*)d_in[19];
    P.mem_q_norm = (const float*)d_in[20]; P.mem_k_norm = (const float*)d_in[21]; P.out_norm = (const float*)d_in[22]; P.w_out = (const float*)d_in[23];
    P.out = (float*)d_out;
    char* ws = (char*)d_ws;
    P.ctl = (unsigned*)(ws + WS_CTL); P.WinT = (bf16_t*)(ws + WS_WINT); P.WoutT = (bf16_t*)(ws + WS_WOUTT); P.WkvT = (bf16_t*)(ws + WS_WKVT); P.WgluT = (bf16_t*)(ws + WS_WGLUT);
    P.memn = (bf16_t*)(ws + WS_MEMN); P.kvmem = (bf16_t*)(ws + WS_KVMEM); P.xn = (bf16_t*)(ws + WS_XN); P.p = (bf16_t*)(ws + WS_P); P.xbuf = (float*)(ws + WS_XBUF);
    P.ocat = (bf16_t*)(ws + WS_OCAT); P.mask = (unsigned long long*)(ws + WS_MASK); P.iw = (float*)(ws + WS_IW); P.ybuf = (bf16_t*)(ws + WS_YBUF); P.rope = (float*)(ws + WS_ROPE);
    P.s5p = (float*)(ws + WS_S5P); P.glas = (float*)(ws + WS_GLAS); P.glad = (float*)(ws + WS_GLAD);
    static int grid = 0;
    if (!grid) {
        int dev = 0, cus = 0, per_cu = 0;
        (void)hipGetDevice(&dev); (void)hipDeviceGetAttribute(&cus, hipDeviceAttributeMultiprocessorCount, dev);
        (void)hipFuncSetAttribute((const void*)k_mega, hipFuncAttributeMaxDynamicSharedMemorySize, LDS_BYTES);
        (void)hipOccupancyMaxActiveBlocksPerMultiprocessor(&per_cu, (const void*)k_mega, NTHR, LDS_BYTES);
        if (per_cu < 1) fprintf(stderr, "kernel_launch: occupancy query reports %d blocks per CU\n", per_cu);
        grid = cus > 0 ? cus : 256;
    }
    (void)hipMemsetAsync(ws + WS_CTL, 0, CTL_BYTES, stream);
    hipLaunchKernelGGL(k_mega, dim3(grid), dim3(NTHR), LDS_BYTES, stream, P);
}
```

```cpp
#include <hip/hip_runtime.h>
#include <stdint.h>
#include <stdio.h>
#include <string.h>

constexpr int NB = 4, SEQ = 4096, NTOK = NB * SEQ, DM = 2048, DEPTH = 4, MEML = 256;
constexpr int NIN = 5984, NPAD = 6144, MIX = 2048;
constexpr int C_GQ = 0, C_GK = 256, C_GV = 512, C_GLR = 1024, C_GZ = 1040, C_SU = 1552, C_SZ = 2064, C_DQ = 2576, C_DK = 3088, C_DV = 3216,
              C_DIQ = 3344, C_DIK = 4368, C_DIW = 4432, C_DZ = 4448, C_MQ = 4960, C_MZ = 5472;
constexpr float EPS = 1e-6f;
constexpr int NTHR = 512;
constexpr int LDS_BYTES = 147456;

typedef unsigned short bf16_t;
typedef short bf16x8 __attribute__((ext_vector_type(8)));
typedef short s16x4 __attribute__((ext_vector_type(4)));
typedef float f32x4 __attribute__((ext_vector_type(4)));
typedef float f32x8 __attribute__((ext_vector_type(8)));
typedef float f32x16 __attribute__((ext_vector_type(16)));
typedef unsigned u32x4 __attribute__((ext_vector_type(4)));
typedef unsigned u32x2 __attribute__((ext_vector_type(2)));
#define LAS __attribute__((address_space(3)))

__device__ __forceinline__ float bf2f(bf16_t b) { return __uint_as_float(((unsigned)b) << 16); }
__device__ __forceinline__ bf16_t f2bf(float f) { unsigned u = __float_as_uint(f); u += 0x7FFFu + ((u >> 16) & 1u); return (bf16_t)(u >> 16); }
__device__ __forceinline__ unsigned pk2bf(float lo, float hi) { return (unsigned)f2bf(lo) | ((unsigned)f2bf(hi) << 16); }
__device__ __forceinline__ float sigmoidf_(float x) { return 1.f / (1.f + __expf(-x)); }
__device__ __forceinline__ float siluf_(float x) { return x / (1.f + __expf(-x)); }

__device__ __forceinline__ int TIDX() { int t = (int)threadIdx.x; asm volatile("" : "+v"(t)); return t; }
__device__ __forceinline__ float shx(float v, int m) { const int src = ((TIDX() & 63) ^ m) << 2; return __int_as_float(__builtin_amdgcn_ds_bpermute(src, __float_as_int(v))); }
__device__ __forceinline__ float wave_sum(float v) {
#pragma unroll
    for (int o = 32; o >= 1; o >>= 1) v += shx(v, o);
    return v;
}
__device__ __forceinline__ void ld8f(const bf16_t* p, float (&v)[8]) { const u32x4 w = *(const u32x4*)p;
#pragma unroll
    for (int j = 0; j < 4; ++j) { v[2 * j] = __uint_as_float(w[j] << 16); v[2 * j + 1] = __uint_as_float(w[j] & 0xffff0000u); } }
__device__ __forceinline__ void st8f(bf16_t* p, const float (&v)[8]) { u32x4 w; w.x = pk2bf(v[0], v[1]); w.y = pk2bf(v[2], v[3]); w.z = pk2bf(v[4], v[5]); w.w = pk2bf(v[6], v[7]); *(u32x4*)p = w; }
#define XB_TMO      128
#define XB_XCNT(j)  (256  + 64 * (j))
#define XB_XSUB(j)  (1280 + 64 * (j))
#define XB_XGEN(j)  (2304 + 64 * (j))
#define XB_TOP      3328
#define XB_TOPGEN   3392
#define XCD_BAR_WORDS 3456
#define XB_SPIN_CAP (1u << 18)

__device__ __forceinline__ unsigned xb_ld(unsigned* p)              { return __hip_atomic_load(p, __ATOMIC_RELAXED, __HIP_MEMORY_SCOPE_AGENT); }
__device__ __forceinline__ unsigned xb_add(unsigned* p, unsigned v) { return __hip_atomic_fetch_add(p, v, __ATOMIC_RELAXED, __HIP_MEMORY_SCOPE_AGENT); }
__device__ __forceinline__ unsigned xb_xcc_id() { return (unsigned)__builtin_amdgcn_s_getreg((3 << 11) | 20) & 0xFu; }
#define XB_SPIN(cond, bar) do { unsigned _sp = 0; while (cond) { __builtin_amdgcn_s_sleep(1); \
    if ((++_sp & 255u) == 0u) { if (xb_ld(&(bar)[XB_TMO])) break; if (_sp > XB_SPIN_CAP) { atomicAdd(&(bar)[XB_TMO], 1u); break; } } } } while (0)

struct XcdBarrier {
    unsigned* bar; unsigned x;
    volatile LAS unsigned* st;
};

__device__ __forceinline__ XcdBarrier xcd_barrier_post(unsigned* bar, volatile LAS unsigned* st) {
    XcdBarrier b; b.bar = bar; b.x = xb_xcc_id(); b.st = st;
    if (TIDX() == 0) (void)xb_add(&bar[XB_XCNT(b.x)], 1u);
    return b;
}
__device__ __forceinline__ void xcd_barrier_complete(unsigned* bar, unsigned x, unsigned& nloc, unsigned& nx) {
    const unsigned G = gridDim.x * gridDim.y * gridDim.z;
    unsigned sum, cnt, mine, sp = 0u;
    for (;;) {
        sum = 0u; cnt = 0u; mine = 0u;
#pragma unroll
        for (unsigned j = 0; j < 16; ++j) { const unsigned c = xb_ld(&bar[XB_XCNT(j)]); sum += c; cnt += (c > 0u) ? 1u : 0u; mine = (j == x) ? c : mine; }
        if (sum == G) break;
        __builtin_amdgcn_s_sleep(1);
        if ((++sp & 255u) == 0u) { if (xb_ld(&bar[XB_TMO])) break; if (sp > XB_SPIN_CAP) { atomicAdd(&bar[XB_TMO], 1u); break; } }
    }
    nloc = mine > 0u ? mine : 1u; nx = cnt > 0u ? cnt : 1u;
}

__device__ __forceinline__ void xcd_barrier(const XcdBarrier& b) {
    asm volatile("s_waitcnt vmcnt(0)" ::: "memory");
    __syncthreads();
    if (TIDX() == 0) {
        unsigned* bar = b.bar; const unsigned bx = xb_xcc_id();
        __builtin_amdgcn_s_waitcnt(0);
        unsigned nloc = b.st[0], nx = b.st[1];
        if (nloc == 0u) { xcd_barrier_complete(bar, bx, nloc, nx); b.st[0] = nloc; b.st[1] = nx; }
        const unsigned old = xb_add(&bar[XB_XSUB(bx)], 1u);
        const unsigned gen = old / nloc;
        if (old + 1u == (gen + 1u) * nloc) {
            __builtin_amdgcn_fence(__ATOMIC_RELEASE, "agent");
            asm volatile("s_waitcnt vmcnt(0)" ::: "memory");
            const unsigned og = xb_add(&bar[XB_TOP], 1u);
            const unsigned tg = og / nx;
            if (og + 1u == (tg + 1u) * nx) xb_add(&bar[XB_TOPGEN], 1u);
            else XB_SPIN(xb_ld(&bar[XB_TOPGEN]) == tg, bar);
            __builtin_amdgcn_fence(__ATOMIC_ACQUIRE, "agent");
            xb_add(&bar[XB_XGEN(bx)], 1u);
            asm volatile("s_waitcnt vmcnt(0)" ::: "memory");
        } else {
            XB_SPIN(xb_ld(&bar[XB_XGEN(bx)]) == gen, bar);
            __builtin_amdgcn_fence(__ATOMIC_ACQUIRE, "agent");
            asm volatile("s_waitcnt vmcnt(0)" ::: "memory");
        }
    }
    __syncthreads();
}
namespace pg8 {
#define PG8_LAS __attribute__((address_space(3)))
typedef float f32x2 __attribute__((ext_vector_type(2)));
typedef unsigned u32x4 __attribute__((ext_vector_type(4)));
constexpr int BM = 256, BK = 64, HALF = 128, HTB = HALF * BK * 2  , STAGE_BYTES = 8 * HTB, NXCD = 8, WGM = 8;

__host__ __device__ __forceinline__ int lds_byte(int r, int c) { const int st = (r >> 4) * 2 + (c >> 5), rr = r & 15, cc = c & 31, ob = rr * 64 + cc * 2; return st * 1024 + (ob ^ (((ob >> 9) & 1) << 5)); }
__host__ __device__ __forceinline__ void stage_rc(int b, int& R, int& C) { const int st = b / 1024, sb = b % 1024, swz = sb ^ (((sb >> 9) & 1) << 5); R = (st >> 1) * 16 + swz / 64; C = (st & 1) * 32 + (swz % 64) / 2; }
__host__ __device__ __forceinline__ int perm32(int rho) { const int n = rho >> 4, i = rho & 15; return 8 * (i >> 2) + 4 * n + (i & 3); }

struct Unit { int pm, pn; };
struct Gemm { const bf16_t* A; const bf16_t* Bt; int M, N, K; };

struct StaticOrder {
    int nM, nN, nwg, G, c;
    __host__ __device__ void init(int M, int N, int G_, int c_) { nM = M / BM; nN = N / BM; nwg = nM * nN; G = G_; c = c_; }
    __host__ __device__ bool next(int i, Unit& u) const {
        const long L = (long)i * G + c; if (L >= nwg) return false;
        int wgid = (int)L; { const int q = nwg / NXCD, r = nwg % NXCD, xcd = wgid % NXCD, off = wgid / NXCD; wgid = (xcd < r ? xcd * (q + 1) : r * (q + 1) + (xcd - r) * q) + off; }
        const int nig = WGM * nN, gid = wgid / nig, fm = gid * WGM, gsz = (nM - fm) < WGM ? (nM - fm) : WGM;
        u.pm = fm + ((wgid % nig) % gsz); u.pn = (wgid % nig) / gsz; return true;
    }
    __device__ __forceinline__ void a_ready(const Unit&) const {}
    __device__ __forceinline__ void done(const Unit&) const {}
};
__device__ __forceinline__ unsigned cvt_pk_bf16(float lo, float hi) { unsigned r; asm volatile("v_cvt_pk_bf16_f32 %0, %1, %2" : "=v"(r) : "v"(lo), "v"(hi)); return r; }
struct EpiBf16Plain {
    static constexpr bool PERM = true, AFTER_DRAIN = false;
    bf16_t* O; int ldc;
    __device__ __forceinline__ void operator()(const f32x4 (&acc)[2][2][4][2], const Unit& u, int wr, int wc, int fr, int fq) const {
        const int row0 = u.pm * BM + wr * 64 + fr, col0 = u.pn * BM + wc * 32 + 8 * fq;
#pragma unroll
        for (int ai = 0; ai < 2; ++ai)
#pragma unroll
            for (int m = 0; m < 4; ++m) { bf16_t* rowp = O + (size_t)(row0 + ai * HALF + m * 16) * ldc + col0;
#pragma unroll
                for (int bj = 0; bj < 2; ++bj) { const f32x4 v0 = acc[ai][bj][m][0], v1 = acc[ai][bj][m][1];
                    u32x4 w; w.x = cvt_pk_bf16(v0[0], v0[1]); w.y = cvt_pk_bf16(v0[2], v0[3]); w.z = cvt_pk_bf16(v1[0], v1[1]); w.w = cvt_pk_bf16(v1[2], v1[3]);
                    *(u32x4*)(rowp + bj * HALF) = w; } }
    }
};
struct EpiResid {
    static constexpr bool PERM = false, AFTER_DRAIN = false;
    const float* R; float* C; int ldc;
    __device__ __forceinline__ void operator()(const f32x4 (&acc)[2][2][4][2], const Unit& u, int wr, int wc, int fr, int fq) const {
        const int row0 = u.pm * BM + wr * 64 + fr, col0 = u.pn * BM + wc * 32 + 4 * fq;
#pragma unroll
        for (int ai = 0; ai < 2; ++ai)
#pragma unroll
            for (int m = 0; m < 4; ++m) { const size_t off = (size_t)(row0 + ai * HALF + m * 16) * ldc + col0;
#pragma unroll
                for (int bj = 0; bj < 2; ++bj)
#pragma unroll
                    for (int n = 0; n < 2; ++n) { const f32x4 r = *(const f32x4*)(R + off + bj * HALF + n * 16); *(f32x4*)(C + off + bj * HALF + n * 16) = acc[ai][bj][m][n] + r; } }
    }
};
struct EpiGlu {
    static constexpr bool PERM = true, AFTER_DRAIN = false;
    const bf16_t* Y; int ldy; bf16_t* O; int ldo; int ooff;
    __device__ __forceinline__ void operator()(const f32x4 (&acc)[2][2][4][2], const Unit& u, int wr, int wc, int fr, int fq) const {
        const int row0 = u.pm * BM + wr * 64 + fr, col0 = u.pn * BM + wc * 32 + 8 * fq;
#pragma unroll
        for (int ai = 0; ai < 2; ++ai)
#pragma unroll
            for (int m = 0; m < 4; ++m) { const int row = row0 + ai * HALF + m * 16;
#pragma unroll
                for (int bj = 0; bj < 2; ++bj) { const f32x4 v0 = acc[ai][bj][m][0], v1 = acc[ai][bj][m][1];
                    const u32x4 yw = *(const u32x4*)(Y + (size_t)row * ldy + col0 + bj * HALF);
                    float y[8], g[8];
#pragma unroll
                    for (int j = 0; j < 4; ++j) { y[2 * j] = __uint_as_float(yw[j] << 16); y[2 * j + 1] = __uint_as_float(yw[j] & 0xffff0000u); }
#pragma unroll
                    for (int j = 0; j < 4; ++j) { g[j] = 1.f / (1.f + __expf(-v0[j])); g[4 + j] = 1.f / (1.f + __expf(-v1[j])); }
                    u32x4 w; w.x = cvt_pk_bf16(y[0] * g[0], y[1] * g[1]); w.y = cvt_pk_bf16(y[2] * g[2], y[3] * g[3]); w.z = cvt_pk_bf16(y[4] * g[4], y[5] * g[5]); w.w = cvt_pk_bf16(y[6] * g[6], y[7] * g[7]);
                    *(u32x4*)(O + (size_t)row * ldo + ooff + col0 + bj * HALF) = w; } }
    }
};
struct EpiGluGate {
    static constexpr bool PERM = true, AFTER_DRAIN = true;
    const bf16_t* Y; const bf16_t* Pz; bf16_t* G;
    __device__ __forceinline__ void fused(const f32x4 (&acc)[2][2][4][2], const Unit& u, int wr, int wc, int fr, int fq, PG8_LAS unsigned char* lds, int wid, int lane) const {
        constexpr int TS = 528;
        const int row0 = wr * 64 + fr, col0 = wc * 32 + 8 * fq;
#pragma unroll
        for (int ai = 0; ai < 2; ++ai)
#pragma unroll
            for (int m = 0; m < 4; ++m) { const int rl = row0 + ai * HALF + m * 16; const size_t grow = (size_t)u.pm * BM + rl;
#pragma unroll
                for (int bj = 0; bj < 2; ++bj) { const f32x4 v0 = acc[ai][bj][m][0], v1 = acc[ai][bj][m][1];
                    const u32x4 yw = *(const u32x4*)(Y + grow * 512 + u.pn * BM + col0 + bj * HALF);
                    float y[8], g[8];
#pragma unroll
                    for (int j = 0; j < 4; ++j) { y[2 * j] = __uint_as_float(yw[j] << 16); y[2 * j + 1] = __uint_as_float(yw[j] & 0xffff0000u); }
#pragma unroll
                    for (int j = 0; j < 4; ++j) { g[j] = 1.f / (1.f + __expf(-v0[j])); g[4 + j] = 1.f / (1.f + __expf(-v1[j])); }
                    u32x4 w; w.x = cvt_pk_bf16(y[0] * g[0], y[1] * g[1]); w.y = cvt_pk_bf16(y[2] * g[2], y[3] * g[3]); w.z = cvt_pk_bf16(y[4] * g[4], y[5] * g[5]); w.w = cvt_pk_bf16(y[6] * g[6], y[7] * g[7]);
                    *(PG8_LAS u32x4*)(lds + rl * TS + (col0 + bj * HALF) * 2) = w; } }
        __syncthreads();
        { const int t = wid * 64 + lane, row = t >> 1, hd = t & 1; const PG8_LAS unsigned char* src = lds + row * TS + hd * 256;
          float ss = 0.f;
#pragma unroll
          for (int i = 0; i < 16; ++i) { const u32x4 w = *(const PG8_LAS u32x4*)(src + 16 * i);
#pragma unroll
              for (int j = 0; j < 4; ++j) { const float a = __uint_as_float(w[j] << 16), b = __uint_as_float(w[j] & 0xffff0000u); ss += a * a + b * b; } }
          const float rn = rsqrtf(ss * (1.f / 128.f) + 1e-6f);
          const size_t grow = (size_t)u.pm * BM + row; const int cb = u.pn * BM + hd * 128;
          const bf16_t* zp = Pz + grow * 6144 + 2064 + cb; bf16_t* gp = G + grow * 2048 + 512 + cb;
#pragma unroll
          for (int i = 0; i < 16; ++i) { const u32x4 w = *(const PG8_LAS u32x4*)(src + 16 * i); const u32x4 zw = *(const u32x4*)(zp + 8 * i); u32x4 o;
#pragma unroll
              for (int j = 0; j < 4; ++j) { const float a = __uint_as_float(w[j] << 16), b = __uint_as_float(w[j] & 0xffff0000u), za = __uint_as_float(zw[j] << 16), zb = __uint_as_float(zw[j] & 0xffff0000u);
                  o[j] = cvt_pk_bf16(a * rn * (za / (1.f + __expf(-za))), b * rn * (zb / (1.f + __expf(-zb)))); }
              *(u32x4*)(gp + 8 * i) = o; } }
        __syncthreads();
    }
};
template <class Epi, class Sched, bool STAMP = false>
__device__ __forceinline__ void gemm_phase(PG8_LAS unsigned char* lds, const Gemm g, const Sched& S, const Epi& E, unsigned long long* stamps) {
    const int tid = TIDX(), wid = __builtin_amdgcn_readfirstlane(tid >> 6), lane = tid & 63, wr = wid >> 2, wc = wid & 3, fr = lane & 15, fq = lane >> 4;
    const int K = g.K, nt = K / BK;
    int ts_lo = 0, ts_hi = 0, nts = 0; const unsigned long long rt_entry = STAMP ? (unsigned long long)wall_clock64() : 0ull;
#define PG8_STAMP() do { if (STAMP && wid == 0 && nts < 64) { const unsigned long long _c = (unsigned long long)clock64(); \
        ts_lo = (lane == nts) ? (int)(unsigned)_c : ts_lo; ts_hi = (lane == nts) ? (int)(unsigned)(_c >> 32) : ts_hi; ++nts; } } while (0)
    PG8_STAMP();
    unsigned voffA[2], voffB[2];
#pragma unroll
    for (int i = 0; i < 2; ++i) { int R, C; stage_rc(tid * 16 + i * 8192, R, C); const int Rb = Epi::PERM ? ((R & ~31) + perm32(R & 31)) : R;
        voffA[i] = (unsigned)(R * K + C) * 2u; voffB[i] = (unsigned)(Rb * K + C) * 2u; }
    const size_t kstep = (size_t)(BK * 2);
    const size_t hstep = (size_t)HALF * K * 2;
    const size_t tstep = 2 * hstep;
    const unsigned ldsw = (unsigned)wid * 1024u;
    const int aoff = lds_byte(wr * 64 + fr, fq * 8), boff = lds_byte(wc * 32 + fr, fq * 8);
#define PG8_SA(b, h) (((b) * 2 + (h)) * HTB)
#define PG8_SB(b, h) ((4 + (b) * 2 + (h)) * HTB)
#define PG8_STAGE(bufoff, gbase, voff) do { _Pragma("unroll") for (int _i = 0; _i < 2; ++_i) \
        __builtin_amdgcn_global_load_lds((const unsigned*)((const char*)(gbase) + (voff)[_i]), (PG8_LAS unsigned*)(lds + (bufoff) + ldsw + _i * 8192), 16, 0, 0); } while (0)
#define PG8_LDA(dst, b, h) do { _Pragma("unroll") for (int m = 0; m < 4; ++m) _Pragma("unroll") for (int k = 0; k < 2; ++k) dst[m][k] = *(const PG8_LAS bf16x8*)(lds + PG8_SA(b, h) + aoff + m * 2048 + k * 1024); } while (0)
#define PG8_LDB(dst, b, h) do { _Pragma("unroll") for (int n = 0; n < 2; ++n) _Pragma("unroll") for (int k = 0; k < 2; ++k) dst[n][k] = *(const PG8_LAS bf16x8*)(lds + PG8_SB(b, h) + boff + n * 2048 + k * 1024); } while (0)
#define PG8_MMA(ai, bj, At, Bt) do { __builtin_amdgcn_s_setprio(1); _Pragma("unroll") for (int m = 0; m < 4; ++m) _Pragma("unroll") for (int n = 0; n < 2; ++n) _Pragma("unroll") for (int k = 0; k < 2; ++k) \
        acc[ai][bj][m][n] = __builtin_amdgcn_mfma_f32_16x16x32_bf16(Bt[n][k], At[m][k], acc[ai][bj][m][n], 0, 0, 0); __builtin_amdgcn_s_setprio(0); } while (0)
#define PG8_WAIT_V(n) asm volatile("s_waitcnt vmcnt(" #n ")" ::: "memory")
#define PG8_WAIT_L(n) asm volatile("s_waitcnt lgkmcnt(" #n ")" ::: "memory")
#define PG8_BAR __builtin_amdgcn_s_barrier()
#define PG8_SCHED __builtin_amdgcn_sched_barrier(0)
    Unit cur, nxt; int ui = 0;
    if (!S.next(0, cur)) return;
    f32x4 acc[2][2][4][2];
#pragma unroll
    for (int a = 0; a < 2; ++a)
#pragma unroll
        for (int b = 0; b < 2; ++b)
#pragma unroll
            for (int m = 0; m < 4; ++m)
#pragma unroll
                for (int n = 0; n < 2; ++n) acc[a][b][m][n] = (f32x4){0.f, 0.f, 0.f, 0.f};
    bf16x8 At[4][2], B0[2][2], B1[2][2];
    const char* cA = (const char*)g.A + (size_t)cur.pm * tstep; const char* cB = (const char*)g.Bt + (size_t)cur.pn * tstep;
    S.a_ready(cur);
    PG8_STAGE(PG8_SB(0, 0), cB, voffB); PG8_STAGE(PG8_SA(0, 0), cA, voffA); PG8_STAGE(PG8_SB(0, 1), cB + hstep, voffB); PG8_STAGE(PG8_SA(0, 1), cA + hstep, voffA);
    if (wr == 1) PG8_BAR;
    PG8_WAIT_V(4); PG8_BAR;
    PG8_STAGE(PG8_SB(1, 0), cB + kstep, voffB); PG8_STAGE(PG8_SA(1, 0), cA + kstep, voffA); PG8_STAGE(PG8_SB(1, 1), cB + hstep + kstep, voffB);
    PG8_WAIT_V(6); PG8_BAR;
    PG8_STAMP();
    for (;;) {
        const bool has_next = S.next(ui + 1, nxt);
        const char* nA = has_next ? (const char*)g.A + (size_t)nxt.pm * tstep : cA; const char* nB = has_next ? (const char*)g.Bt + (size_t)nxt.pn * tstep : cB;
        for (int t = 0; t < nt; t += 2) {
            const bool last = (t == nt - 2);
            const char* a1 = cA + (size_t)(t + 1) * kstep;
            const char* a2 = last ? nA : cA + (size_t)(t + 2) * kstep; const char* b2 = last ? nB : cB + (size_t)(t + 2) * kstep;
            const char* a3 = a2 + kstep; const char* b3 = b2 + kstep;
            if (last && has_next) S.a_ready(nxt);
            PG8_LDB(B0, 0, 0); PG8_SCHED; PG8_LDA(At, 0, 0); PG8_STAGE(PG8_SA(1, 1), a1 + hstep, voffA);
            PG8_WAIT_L(8); PG8_BAR; PG8_WAIT_L(0); PG8_MMA(0, 0, At, B0); PG8_BAR; PG8_SCHED;
            PG8_LDB(B1, 0, 1); PG8_STAGE(PG8_SB(0, 0), b2, voffB);
            PG8_BAR; PG8_WAIT_L(0); PG8_MMA(0, 1, At, B1); PG8_BAR;
            PG8_LDA(At, 0, 1); PG8_STAGE(PG8_SA(0, 0), a2, voffA);
            PG8_BAR; PG8_WAIT_L(0); PG8_MMA(1, 0, At, B0); PG8_BAR; PG8_SCHED;
            PG8_STAGE(PG8_SB(0, 1), b2 + hstep, voffB);
            PG8_WAIT_V(6); PG8_BAR; PG8_MMA(1, 1, At, B1); PG8_BAR;
            PG8_LDB(B0, 1, 0); PG8_SCHED; PG8_LDA(At, 1, 0); PG8_STAGE(PG8_SA(0, 1), a2 + hstep, voffA);
            PG8_WAIT_L(8); PG8_BAR; PG8_WAIT_L(0); PG8_MMA(0, 0, At, B0); PG8_BAR; PG8_SCHED;
            PG8_LDB(B1, 1, 1); PG8_STAGE(PG8_SB(1, 0), b3, voffB);
            PG8_BAR; PG8_WAIT_L(0); PG8_MMA(0, 1, At, B1); PG8_BAR;
            PG8_LDA(At, 1, 1); PG8_STAGE(PG8_SA(1, 0), a3, voffA);
            PG8_BAR; PG8_WAIT_L(0); PG8_MMA(1, 0, At, B0); PG8_BAR; PG8_SCHED;
            PG8_STAGE(PG8_SB(1, 1), b3 + hstep, voffB);
            PG8_WAIT_V(6); PG8_BAR; PG8_MMA(1, 1, At, B1); PG8_BAR;
        }
        PG8_STAMP();
        if constexpr (!Epi::AFTER_DRAIN) { E(acc, cur, wr, wc, fr, fq); S.done(cur); }
        PG8_STAMP();
        if (!has_next) break;
#pragma unroll
        for (int a = 0; a < 2; ++a)
#pragma unroll
            for (int b = 0; b < 2; ++b)
#pragma unroll
                for (int m = 0; m < 4; ++m)
#pragma unroll
                    for (int n = 0; n < 2; ++n) acc[a][b][m][n] = (f32x4){0.f, 0.f, 0.f, 0.f};
        cur = nxt; cA = nA; cB = nB; ++ui;
    }
    PG8_WAIT_V(0);
    if (wr == 0) PG8_BAR;
    PG8_BAR;
    if constexpr (Epi::AFTER_DRAIN) { E.fused(acc, cur, wr, wc, fr, fq, lds, wid, lane); S.done(cur); }
    PG8_STAMP();
    if (STAMP && wid == 0) { stamps[lane] = lane < nts ? (((unsigned long long)(unsigned)ts_hi << 32) | (unsigned)ts_lo) : 0ull;
        if (lane == 62) stamps[62] = rt_entry; if (lane == 63) stamps[63] = (unsigned long long)wall_clock64(); }
#undef PG8_STAMP
#undef PG8_SA
#undef PG8_SB
#undef PG8_STAGE
#undef PG8_LDA
#undef PG8_LDB
#undef PG8_MMA
#undef PG8_WAIT_V
#undef PG8_WAIT_L
#undef PG8_BAR
#undef PG8_SCHED
}
}
namespace att {
constexpr int D = 128, NW = 8, QBLK = 32, KVBLK = 64;
constexpr float SCALE = 0.088388347648318440f, THR = 8.f;
constexpr int SHM_V = KVBLK * D * 2, SHM_K = KVBLK * D * 2, SHM_ATTN = 2 * SHM_V + 2 * SHM_K + NW * 64 * 4;
#define KSWZ(row, colB) ((row) * 256 + ((colB) ^ (((row) & 7) << 4)))
#define SBAR() __builtin_amdgcn_sched_barrier(0)
__device__ __forceinline__ int crow(int r, int hi) { return (r & 3) + 8 * (r >> 2) + 4 * hi; }
__device__ __forceinline__ unsigned cvtpk(float lo, float hi) { unsigned r; asm volatile("v_cvt_pk_bf16_f32 %0, %1, %2" : "=v"(r) : "v"(lo), "v"(hi)); return r; }

template <bool MASKED>
__device__ __forceinline__ void partialSM(f32x16& p0, f32x16& p1, float& m_reg, float& mn, float& alpha, unsigned long long mw, int hi) {
  constexpr float C = SCALE * 1.4426950408889634f;
  if (MASKED) {
    const unsigned w0 = (unsigned)mw >> (4 * hi), w1 = (unsigned)(mw >> 32) >> (4 * hi);
    const float ninf = -__builtin_inff();
#pragma unroll
    for (int r = 0; r < 16; ++r) { const int bit = (r & 3) + 8 * (r >> 2);
      p0[r] = ((w0 >> bit) & 1u) ? p0[r] : ninf; p1[r] = ((w1 >> bit) & 1u) ? p1[r] : ninf; }
  }
  float pmax = p0[0];
#pragma unroll
  for (int r = 1; r < 16; ++r) pmax = fmaxf(pmax, p0[r]);
#pragma unroll
  for (int r = 0; r < 16; ++r) pmax = fmaxf(pmax, p1[r]);
  { auto rr = __builtin_amdgcn_permlane32_swap(__float_as_uint(pmax), __float_as_uint(pmax), false, false);
    pmax = fmaxf(__uint_as_float(rr[0]), __uint_as_float(rr[1])); }
  if (__builtin_expect(__all(pmax - m_reg <= THR / SCALE), 1)) { mn = m_reg; alpha = 1.f; }
  else { mn = fmaxf(m_reg, pmax); alpha = __builtin_amdgcn_exp2f((m_reg - mn) * C); m_reg = mn; }
  const float mnC = -mn * C;
#pragma unroll
  for (int r = 0; r < 16; ++r) p0[r] = fmaf(p0[r], C, mnC);
#pragma unroll
  for (int r = 0; r < 16; ++r) p1[r] = fmaf(p1[r], C, mnC);
#pragma unroll
  for (int r = 0; r < 16; ++r) p0[r] = __builtin_amdgcn_exp2f(p0[r]);
}
__device__ __forceinline__ void finishSM(f32x16& p0, f32x16& p1, float alpha, float& l_reg, bf16x8& pa0, bf16x8& pa1, bf16x8& pa2, bf16x8& pa3) {
#pragma unroll
  for (int r = 0; r < 16; ++r) p1[r] = __builtin_amdgcn_exp2f(p1[r]);
  float ps = 0;
#pragma unroll
  for (int r = 0; r < 16; ++r) ps += p0[r];
#pragma unroll
  for (int r = 0; r < 16; ++r) ps += p1[r];
  { auto rr = __builtin_amdgcn_permlane32_swap(__float_as_uint(ps), __float_as_uint(ps), false, false);
    ps = __uint_as_float(rr[0]) + __uint_as_float(rr[1]); }
  l_reg = l_reg * alpha + ps;
#define PK4(P, BASE, OUT) do { unsigned a0 = cvtpk(P[BASE + 0], P[BASE + 1]), a1 = cvtpk(P[BASE + 2], P[BASE + 3]);   \
    unsigned b0 = cvtpk(P[BASE + 4], P[BASE + 5]), b1 = cvtpk(P[BASE + 6], P[BASE + 7]);                              \
    auto r0 = __builtin_amdgcn_permlane32_swap(a0, b0, false, false); auto r1 = __builtin_amdgcn_permlane32_swap(a1, b1, false, false); \
    u32x4 w = {r0[0], r1[0], r0[1], r1[1]}; OUT = *reinterpret_cast<bf16x8*>(&w); } while (0)
  PK4(p0, 0, pa0); PK4(p0, 8, pa1); PK4(p1, 0, pa2); PK4(p1, 8, pa3);
#undef PK4
}
__device__ __forceinline__ void qkt(f32x16& p0, f32x16& p1, const char* Ks, const bf16x8* qr, int r32, int hi) {
  p0 = f32x16{}; p1 = f32x16{};
  asm volatile("" : "+v"(p0), "+v"(p1));
#pragma unroll
  for (int d0 = 0; d0 < 8; ++d0) { const int cb = (d0 * 16 + hi * 8) * 2;
    bf16x8 b0 = *reinterpret_cast<const bf16x8*>(Ks + KSWZ(r32, cb));
    bf16x8 b1 = *reinterpret_cast<const bf16x8*>(Ks + KSWZ(32 + r32, cb));
    p0 = __builtin_amdgcn_mfma_f32_32x32x16_bf16(b0, qr[d0], p0, 0, 0, 0);
    p1 = __builtin_amdgcn_mfma_f32_32x32x16_bf16(b1, qr[d0], p1, 0, 0, 0); }
}
__device__ __forceinline__ int v_st(int k, int c) { const int kk = (k & ~0xC) | ((k & 4) << 1) | ((k & 8) >> 1); return ((kk >> 3) * 4 + (c >> 5)) * 512 + ((kk & 7) * 32 + (c & 31)) * 2; }
__device__ __forceinline__ int v_rd_base(int lane) { return ((lane & 3) << 3) | (((lane >> 2) & 3) << 6) | (((lane >> 4) & 1) << 5) | (((lane >> 5) & 1) << 8); }
constexpr int v_rd_off(int d0, int ks, int half) { return d0 * 512 + ks * 4096 + half * 2048; }
template <int OFF> __device__ __forceinline__ s16x4 tr_read(int vb) {
  s16x4 r; asm volatile("ds_read_b64_tr_b16 %0, %1 offset:%2" : "=&v"(r) : "v"(vb), "i"(OFF) : "memory"); return r;
}
template <int D0> __device__ __forceinline__ void pv_one(f32x16& od, int vb, bf16x8 pa0, bf16x8 pa1, bf16x8 pa2, bf16x8 pa3) {
  const s16x4 l0 = tr_read<v_rd_off(D0, 0, 0)>(vb), h0 = tr_read<v_rd_off(D0, 0, 1)>(vb), l1 = tr_read<v_rd_off(D0, 1, 0)>(vb), h1 = tr_read<v_rd_off(D0, 1, 1)>(vb);
  const s16x4 l2 = tr_read<v_rd_off(D0, 2, 0)>(vb), h2 = tr_read<v_rd_off(D0, 2, 1)>(vb), l3 = tr_read<v_rd_off(D0, 3, 0)>(vb), h3 = tr_read<v_rd_off(D0, 3, 1)>(vb);
  asm volatile("s_waitcnt lgkmcnt(0)" ::: "memory"); SBAR();
#define PK(L, H) (bf16x8){L[0], L[1], L[2], L[3], H[0], H[1], H[2], H[3]}
  od = __builtin_amdgcn_mfma_f32_32x32x16_bf16(pa0, PK(l0, h0), od, 0, 0, 0);
  od = __builtin_amdgcn_mfma_f32_32x32x16_bf16(pa1, PK(l1, h1), od, 0, 0, 0);
  od = __builtin_amdgcn_mfma_f32_32x32x16_bf16(pa2, PK(l2, h2), od, 0, 0, 0);
  od = __builtin_amdgcn_mfma_f32_32x32x16_bf16(pa3, PK(l3, h3), od, 0, 0, 0);
#undef PK
}
__device__ __forceinline__ void pv_d0(f32x16* o, int vb, bf16x8 pa0, bf16x8 pa1, bf16x8 pa2, bf16x8 pa3) {
  pv_one<0>(o[0], vb, pa0, pa1, pa2, pa3); pv_one<1>(o[1], vb, pa0, pa1, pa2, pa3); pv_one<2>(o[2], vb, pa0, pa1, pa2, pa3); pv_one<3>(o[3], vb, pa0, pa1, pa2, pa3);
}

template <bool MASKED, int LDK, int VOFF, class OutRow>
__device__ __forceinline__ void attn_body(const bf16_t* __restrict__ Qw, const bf16_t* __restrict__ Kh, int NT,
                                          const unsigned long long* __restrict__ mbase, unsigned moff, const OutRow& Ow, char* lds) {
  const int tid = TIDX(), wid = tid >> 6, lane = tid & 63, r32 = lane & 31, hi = lane >> 5;
  char* V_lds = lds; char* K_lds = lds + 2 * SHM_V;
  float* ws = (float*)(lds + 2 * SHM_V + 2 * SHM_K) + wid * 64; float* li_l = ws; float* al_l = ws + 32;
  float m_reg = -1e30f, l_reg = 0; f32x16 o[4] = {}; bf16x8 qr[8];
  asm volatile("" : "+v"(o[0]), "+v"(o[1]), "+v"(o[2]), "+v"(o[3]));
#pragma unroll
  for (int d0 = 0; d0 < 8; ++d0) qr[d0] = *reinterpret_cast<const bf16x8*>(Qw + d0 * 16);
  const int sr = tid >> 4, sc = (tid & 15) * 8, vst0 = v_st(sr, sc), vst1 = v_st(32 + sr, sc);
  const int vb0 = (int)(uintptr_t)V_lds + v_rd_base(lane);
  struct { bf16x8 vs0, vs1, ks0, ks1; } sr_[2];
  const unsigned koff = (unsigned)(sr * LDK + sc) * 2u;
#define SLOAD(i, k0) do { const char* kb_ = (const char*)Kh + (size_t)(k0) * (LDK * 2); \
    sr_[i].vs0 = *reinterpret_cast<const bf16x8*>(kb_ + koff + VOFF * 2); sr_[i].vs1 = *reinterpret_cast<const bf16x8*>(kb_ + koff + (32 * LDK + VOFF) * 2); \
    sr_[i].ks0 = *reinterpret_cast<const bf16x8*>(kb_ + koff); sr_[i].ks1 = *reinterpret_cast<const bf16x8*>(kb_ + koff + 32 * LDK * 2); } while (0)
#define SWRITE(b, i) do { *(bf16x8*)(V_lds + (b) * SHM_V + vst0) = sr_[i].vs0;          \
    *(bf16x8*)(V_lds + (b) * SHM_V + vst1) = sr_[i].vs1; int kc = sc * 2;               \
    *(bf16x8*)(K_lds + (b) * SHM_K + KSWZ(sr, kc)) = sr_[i].ks0;                       \
    *(bf16x8*)(K_lds + (b) * SHM_K + KSWZ(32 + sr, kc)) = sr_[i].ks1; } while (0)
#define SWAIT() asm volatile("s_waitcnt vmcnt(4)" ::: "memory")
#define RESC(a) do { if (__any((a) < 1.f)) { if (hi == 0) al_l[r32] = (a); asm volatile("s_waitcnt lgkmcnt(0)" ::: "memory"); \
    _Pragma("unroll") for (int d = 0; d < 4; ++d) _Pragma("unroll") for (int r = 0; r < 16; ++r) o[d][r] *= al_l[crow(r, hi)]; } } while (0)
  f32x16 pA0, pA1, pB0, pB1; float mnA, mnB, alA, alB; bf16x8 pa0, pa1, pa2, pa3;
  unsigned long long mw = 0ull;
  constexpr int SE = 0, SO = 1;
  SLOAD(SE, 0); asm volatile("s_waitcnt vmcnt(0)" ::: "memory"); SWRITE(0, SE); __syncthreads();
  if (MASKED) mw = *(const unsigned long long*)((const char*)mbase + moff);
  qkt(pA0, pA1, K_lds, qr, r32, hi); partialSM<MASKED>(pA0, pA1, m_reg, mnA, alA, mw, hi);
  SLOAD(SO, KVBLK); if (2 < NT) SLOAD(SE, 2 * KVBLK);
  if (2 < NT) SWAIT(); else asm volatile("s_waitcnt vmcnt(0)" ::: "memory");
  SWRITE(1, SO); __syncthreads();
  for (int j = 1; j + 1 < NT; j += 2) {
    if (MASKED) mw = *(const unsigned long long*)((const char*)mbase + (moff + 8u * (unsigned)j));
    SBAR(); qkt(pB0, pB1, K_lds + SHM_K, qr, r32, hi);
    finishSM(pA0, pA1, alA, l_reg, pa0, pa1, pa2, pa3); SBAR();
    SLOAD(SO, (j + 2) * KVBLK); SBAR();
    pv_d0(o, vb0, pa0, pa1, pa2, pa3); partialSM<MASKED>(pB0, pB1, m_reg, mnB, alB, mw, hi);
    if (MASKED) mw = *(const unsigned long long*)((const char*)mbase + (moff + 8u * (unsigned)(j + 1)));
    __syncthreads(); SWAIT(); SWRITE(0, SE);
    RESC(alB); __syncthreads();
    SBAR(); qkt(pA0, pA1, K_lds, qr, r32, hi);
    finishSM(pB0, pB1, alB, l_reg, pa0, pa1, pa2, pa3); SBAR();
    if (j + 3 < NT) SLOAD(SE, (j + 3) * KVBLK); SBAR();
    pv_d0(o, vb0 + SHM_V, pa0, pa1, pa2, pa3); partialSM<MASKED>(pA0, pA1, m_reg, mnA, alA, mw, hi);
    __syncthreads(); if (j + 3 < NT) SWAIT(); else asm volatile("s_waitcnt vmcnt(0)" ::: "memory");
    SWRITE(1, SO);
    RESC(alA); __syncthreads();
  }
  if (MASKED) mw = *(const unsigned long long*)((const char*)mbase + (moff + 8u * (unsigned)(NT - 1)));
  SBAR(); qkt(pB0, pB1, K_lds + SHM_K, qr, r32, hi);
  finishSM(pA0, pA1, alA, l_reg, pa0, pa1, pa2, pa3); SBAR();
  pv_d0(o, vb0, pa0, pa1, pa2, pa3); partialSM<MASKED>(pB0, pB1, m_reg, mnB, alB, mw, hi);
  __syncthreads(); RESC(alB);
  finishSM(pB0, pB1, alB, l_reg, pa0, pa1, pa2, pa3); SBAR();
  pv_d0(o, vb0 + SHM_V, pa0, pa1, pa2, pa3);
  if (hi == 0) li_l[r32] = l_reg; asm volatile("s_waitcnt lgkmcnt(0)" ::: "memory");
  float rli[16];
#pragma unroll
  for (int r = 0; r < 16; ++r) rli[r] = __builtin_amdgcn_rcpf(li_l[crow(r, hi)]);
  __syncthreads();
  float* og_s = (float*)lds + wid * (32 * 132);
#pragma unroll
  for (int r = 0; r < 16; ++r) {
#pragma unroll
    for (int d0 = 0; d0 < 4; ++d0) og_s[crow(r, hi) * 132 + d0 * 32 + r32] = o[d0][r] * rli[r]; }
  asm volatile("" ::: "memory");
  { const int row = lane >> 1, half = lane & 1; const float* src = og_s + row * 132 + half * 64;
    f32x4 v[16]; float ss = 0.f;
#pragma unroll
    for (int i = 0; i < 16; ++i) { v[i] = *(const f32x4*)(src + 4 * i); ss += v[i][0] * v[i][0] + v[i][1] * v[i][1] + v[i][2] * v[i][2] + v[i][3] * v[i][3]; }
    ss += shx(ss, 1);
    const float rn = rsqrtf(ss * (1.f / 128.f) + EPS);
    const bf16_t* zp = Ow.zrow(row) + half * 64; bf16_t* gp = Ow.grow(row) + half * 64;
#pragma unroll
    for (int i = 0; i < 8; ++i) { float z[8], g[8]; ld8f(zp + 8 * i, z);
#pragma unroll
      for (int q = 0; q < 4; ++q) { g[q] = v[2 * i][q] * rn * siluf_(z[q]); g[4 + q] = v[2 * i + 1][q] * rn * siluf_(z[4 + q]); }
      st8f(gp + 8 * i, g); } }
  __syncthreads();
#undef SLOAD
#undef SWRITE
#undef SWAIT
#undef RESC
}
}
constexpr size_t al256(size_t x) { return (x + 255) / 256 * 256; }
constexpr size_t WS_CTL   = 0;
constexpr size_t CTL_BYTES = 65536;
constexpr size_t WS_WINT  = WS_CTL + CTL_BYTES;
constexpr size_t WS_WOUTT = WS_WINT + al256((size_t)DEPTH * NPAD * DM * 2);
constexpr size_t WS_WKVT  = WS_WOUTT + al256((size_t)DEPTH * DM * MIX * 2);
constexpr size_t WS_WGLUT = WS_WKVT + al256((size_t)DEPTH * 1024 * DM * 2);
constexpr size_t WS_MEMN  = WS_WGLUT + al256((size_t)DEPTH * 512 * 512 * 2);
constexpr size_t WS_KVMEM = WS_MEMN + al256((size_t)NB * MEML * DM * 2);
constexpr size_t WS_XN    = WS_KVMEM + al256((size_t)NB * MEML * DEPTH * 1024 * 2);
constexpr size_t WS_P     = WS_XN + al256((size_t)NTOK * DM * 2);
constexpr size_t WS_XBUF  = WS_P + al256((size_t)NTOK * NPAD * 2);
constexpr size_t WS_OCAT  = WS_XBUF + al256((size_t)NTOK * DM * 4);
constexpr size_t WS_MASK  = WS_OCAT + al256((size_t)NTOK * MIX * 2);
constexpr size_t WS_IW    = WS_MASK + al256((size_t)NTOK * 64 * 8);
constexpr size_t WS_YBUF  = WS_IW + al256((size_t)NTOK * 16 * 4);
constexpr size_t WS_ROPE  = WS_YBUF + al256((size_t)NTOK * 512 * 2);
constexpr size_t WS_S5P   = WS_ROPE + al256((size_t)NTOK * 48 * 4);
constexpr size_t S5P_BYTES = (size_t)DEPTH * 32 * (64 * 2 + 64 * 2 + 64 * 16 * 2) * 4;
constexpr size_t WS_GLAS  = WS_S5P + al256(S5P_BYTES);
constexpr size_t WS_GLAD  = WS_GLAS + al256((size_t)NB * 64 * 4 * 64 * 128 * 4);
constexpr size_t WS_IKC   = WS_GLAD + al256((size_t)NB * 64 * 4 * 64 * 4);
constexpr size_t WS_KVC   = WS_IKC + al256((size_t)NTOK * 64 * 2);
constexpr size_t WS_END   = WS_KVC + al256((size_t)NTOK * 256 * 2);

struct Params {
    const float* x; const float* mem; const int* pos; const float* ln_gain; const float* w_in; const float* gla_w_up; const float* gla_b_up;
    const float* s5_a_re; const float* s5_a_im; const float* s5_log_step; const float* s5_b_re; const float* s5_b_im; const float* s5_c_re; const float* s5_c_im;
    const float* s5_d; const float* s5_w_glu; const float* dsa_q_norm; const float* dsa_k_norm; const float* mem_norm; const float* w_mem_kv;
    const float* mem_q_norm; const float* mem_k_norm; const float* out_norm; const float* w_out;
    float* out;
    unsigned* ctl; bf16_t* WinT; bf16_t* WoutT; bf16_t* WkvT; bf16_t* WgluT; bf16_t* memn; bf16_t* kvmem; bf16_t* xn; bf16_t* p; float* xbuf; bf16_t* ocat;
    unsigned long long* mask; float* iw; bf16_t* ybuf; float* rope; float* s5p; float* glas; float* glad; bf16_t* ikc; bf16_t* kvc;
};

__device__ __forceinline__ void transpose_tiles(const float* __restrict__ src, int K, int Nsrc, int Ndst, const float* __restrict__ scale, bf16_t* __restrict__ dst,
                                                int tile, float* lds_tile  ) {
    const int tid = TIDX(), ntn = Ndst / 64;
    const int tk = tile / ntn, tn = tile % ntn, k0 = tk * 64, n0 = tn * 64;
    __syncthreads();
    { const int ty = tid >> 4, tx = tid & 15;
#pragma unroll
      for (int i = 0; i < 2; ++i) { const int k = k0 + ty + 32 * i, n = n0 + 4 * tx;
        f32x4 v = (f32x4){0.f, 0.f, 0.f, 0.f};
        if (n < Nsrc) v = *(const f32x4*)(src + (size_t)k * Nsrc + n);
        const float s = scale ? scale[k] : 1.f;
        float* t = lds_tile + (ty + 32 * i) * 65 + 4 * tx; t[0] = v[0] * s; t[1] = v[1] * s; t[2] = v[2] * s; t[3] = v[3] * s; } }
    __syncthreads();
    { const int n = tid >> 3, kq = tid & 7;
      u32x4 w;
      w.x = pk2bf(lds_tile[(8 * kq + 0) * 65 + n], lds_tile[(8 * kq + 1) * 65 + n]); w.y = pk2bf(lds_tile[(8 * kq + 2) * 65 + n], lds_tile[(8 * kq + 3) * 65 + n]);
      w.z = pk2bf(lds_tile[(8 * kq + 4) * 65 + n], lds_tile[(8 * kq + 5) * 65 + n]); w.w = pk2bf(lds_tile[(8 * kq + 6) * 65 + n], lds_tile[(8 * kq + 7) * 65 + n]);
      *(u32x4*)(dst + (size_t)(n0 + n) * K + k0 + 8 * kq) = w; }
}

__device__ __forceinline__ void rmsnorm_rows(const float* __restrict__ X, bf16_t* __restrict__ Y, int nrows) {
    const int wid = TIDX() >> 6, lane = TIDX() & 63;
    for (int row = blockIdx.x * 8 + wid; row < nrows; row += gridDim.x * 8) {
        const float* xr = X + (size_t)row * DM; f32x4 v[8]; float ss = 0.f;
#pragma unroll
        for (int i = 0; i < 8; ++i) { v[i] = *(const f32x4*)(xr + 4 * lane + 256 * i); ss += v[i][0] * v[i][0] + v[i][1] * v[i][1] + v[i][2] * v[i][2] + v[i][3] * v[i][3]; }
        ss = wave_sum(ss); const float r = rsqrtf(ss * (1.f / DM) + EPS);
        bf16_t* yr = Y + (size_t)row * DM;
#pragma unroll
        for (int i = 0; i < 8; ++i) { u32x2 w; w.x = pk2bf(v[i][0] * r, v[i][1] * r); w.y = pk2bf(v[i][2] * r, v[i][3] * r); *(u32x2*)(yr + 4 * lane + 256 * i) = w; }
    }
}

__device__ __forceinline__ void phase_prologue1(const Params& P, char* lds) {
    float* tile = (float*)lds;
    constexpr int T_IN = (DM / 64) * (NPAD / 64), T_OUT = (MIX / 64) * (DM / 64), T_KV = (DM / 64) * (1024 / 64), T_GLU = 8 * 8;
    constexpr int TOT = DEPTH * (T_IN + T_OUT + T_KV + T_GLU);
    for (int u = blockIdx.x; u < TOT; u += gridDim.x) {
        int l = u / (T_IN + T_OUT + T_KV + T_GLU), r = u % (T_IN + T_OUT + T_KV + T_GLU);
        if (r < T_IN) transpose_tiles(P.w_in + (size_t)l * DM * NIN, DM, NIN, NPAD, P.ln_gain + l * DM, P.WinT + (size_t)l * NPAD * DM, r, tile);
        else if ((r -= T_IN) < T_OUT) transpose_tiles(P.w_out + (size_t)l * MIX * DM, MIX, DM, DM, P.out_norm + l * MIX, P.WoutT + (size_t)l * DM * MIX, r, tile);
        else if ((r -= T_OUT) < T_KV) transpose_tiles(P.w_mem_kv + (size_t)l * DM * 1024, DM, 1024, 1024, P.mem_norm + l * DM, P.WkvT + (size_t)l * 1024 * DM, r, tile);
        else { r -= T_KV; transpose_tiles(P.s5_w_glu + (size_t)l * 512 * 512, 512, 512, 512, nullptr, P.WgluT + (size_t)l * 512 * 512, r, tile); }
    }
    rmsnorm_rows(P.mem, P.memn, NB * MEML);
}
__device__ __forceinline__ void phase_rope_table(const Params& P) {
    for (int idx = blockIdx.x * NTHR + TIDX(); idx < NTOK * 24; idx += gridDim.x * NTHR) {
        const int tok = idx / 24, i = idx % 24;
        const float e = (i < 16) ? -((float)i * 2.0f / 32.0f) : -((float)(i - 16) * 2.0f / 16.0f);
        const float inv_freq = exp2f(e * 18.931568569324174f);
        const float ang = (float)P.pos[tok] * inv_freq;
        const double a = (double)ang; const double k = rint(a * 0.15915494309189535); const float rf = (float)fma(-k, 6.283185307179586, a);
        P.rope[(size_t)idx * 2] = cosf(rf); P.rope[(size_t)idx * 2 + 1] = sinf(rf);
    }
}

__device__ __forceinline__ void phase_rmsnorm_x(const Params& P, int layer) { rmsnorm_rows(layer == 0 ? P.x : P.xbuf, P.xn, NTOK); }

__device__ __forceinline__ void phase_memk_norm(const Params& P) {
    const int wid = TIDX() >> 6, lane = TIDX() & 63;
    for (int it = blockIdx.x * 8 + wid; it < NB * MEML * DEPTH * 4; it += gridDim.x * 8) {
        const int row = it / (DEPTH * 4), l = (it / 4) % DEPTH, h = it % 4;
        bf16_t* kp = P.kvmem + (size_t)row * (DEPTH * 1024) + l * 1024 + h * 128 + 2 * lane;
        const unsigned w = *(const unsigned*)kp; const float a = __uint_as_float(w << 16), b = __uint_as_float(w & 0xffff0000u);
        const float ss = wave_sum(a * a + b * b), r = rsqrtf(ss * (1.f / 128.f) + EPS);
        const float* g = P.mem_k_norm + l * 128 + 2 * lane;
        *(unsigned*)kp = pk2bf(a * r * g[0], b * r * g[1]);
    }
}

__device__ __forceinline__ float sum16(float v) { v += shx(v, 1); v += shx(v, 2); v += shx(v, 4); v += shx(v, 8); return v; }

__device__ __forceinline__ void head128_norm_rope_to(const bf16_t* hp, bf16_t* dp, int l16, const float* __restrict__ gain, const float* __restrict__ cs, bool rope, bool do_store) {
    float v[8]; ld8f(hp + 8 * l16, v);
    float ss = 0.f;
#pragma unroll
    for (int j = 0; j < 8; ++j) ss += v[j] * v[j];
    ss = sum16(ss); const float r = rsqrtf(ss * (1.f / 128.f) + EPS);
#pragma unroll
    for (int j = 0; j < 8; ++j) v[j] = v[j] * r * gain[8 * l16 + j];
    if (rope) {
        float o[8];
#pragma unroll
        for (int j = 0; j < 8; ++j) o[j] = shx(v[j], 2);
        if (l16 < 4) { const int fi = (l16 & 1) * 8;
#pragma unroll
            for (int j = 0; j < 8; ++j) { const float c = cs[(fi + j) * 2], s = cs[(fi + j) * 2 + 1];
                v[j] = (l16 < 2) ? (v[j] * c - o[j] * s) : (v[j] * c + o[j] * s); } }
    }
    if (do_store) st8f(dp + 8 * l16, v);
}
__device__ __forceinline__ void head128_norm_rope(bf16_t* hp, int l16, const float* __restrict__ gain, const float* __restrict__ cs, bool rope, bool do_store) { head128_norm_rope_to(hp, hp, l16, gain, cs, rope, do_store); }
__device__ __forceinline__ void rope16_inplace(bf16_t* ip, const float* __restrict__ cs) {
    float a[8], b[8]; ld8f(ip, a); ld8f(ip + 8, b);
#pragma unroll
    for (int j = 0; j < 8; ++j) { const float c = cs[2 * j], s = cs[2 * j + 1], x1 = a[j], x2 = b[j]; a[j] = x1 * c - x2 * s; b[j] = x2 * c + x1 * s; }
    st8f(ip, a); st8f(ip + 8, b);
}
__device__ __forceinline__ void phase_prep(const Params& P, int layer) {
    const int wid = TIDX() >> 6, lane = TIDX() & 63, l16 = lane & 15, grp = lane >> 4;
    for (int tok = blockIdx.x * 8 + wid; tok < NTOK; tok += gridDim.x * 8) {
        bf16_t* row = P.p + (size_t)tok * NPAD;
        const float* cs32 = P.rope + (size_t)tok * 48; const float* cs16 = cs32 + 32;
        head128_norm_rope(row + C_DQ + grp * 128, l16, P.dsa_q_norm + layer * 128, cs32, true, true);
        head128_norm_rope_to(row + C_DK, P.kvc + (size_t)tok * 256, l16, P.dsa_k_norm + layer * 128, cs32, true, grp == 0);
        head128_norm_rope(row + C_MQ + grp * 128, l16, P.mem_q_norm + layer * 128, cs32, false, true);
        if ((lane & 3) == 0) rope16_inplace(row + C_DIQ + lane * 16, cs16);
        if (lane < 4) { bf16_t* dst = P.ikc + (size_t)tok * 64 + lane * 16;
            float a[8], b[8]; ld8f(row + C_DIK + lane * 16, a); ld8f(row + C_DIK + lane * 16 + 8, b);
            if (lane == 0) {
#pragma unroll
                for (int q = 0; q < 8; ++q) { const float c = cs16[2 * q], s = cs16[2 * q + 1], x1 = a[q], x2 = b[q]; a[q] = x1 * c - x2 * s; b[q] = x2 * c + x1 * s; } }
            st8f(dst, a); st8f(dst + 8, b); }
        if (lane >= 16 && lane < 32) { const u32x4 vv = *(const u32x4*)(row + C_DV + (lane - 16) * 8); *(u32x4*)(P.kvc + (size_t)tok * 256 + 128 + (lane - 16) * 8) = vv; }
        if (lane < 16) P.iw[(size_t)tok * 16 + lane] = bf2f(row[C_DIW + lane]) * (1.f / 32.f);
    }
}
struct MemOutRow { const bf16_t* zb; bf16_t* gb;
    __device__ __forceinline__ const bf16_t* zrow(int r) const { return zb + (size_t)r * NPAD; } __device__ __forceinline__ bf16_t* grow(int r) const { return gb + (size_t)r * MIX; } };
__device__ __forceinline__ void unit_mem_attn(const Params& P, int layer, int u, char* lds) {
    const int b = u >> 6, h = (u >> 4) & 3, qb = u & 15, tok0 = b * SEQ + qb * 256;
    const int wid = TIDX() >> 6, lane = TIDX() & 63, r32 = lane & 31, hi = lane >> 5;
    const bf16_t* Qw = P.p + (size_t)(tok0 + wid * 32 + r32) * NPAD + C_MQ + h * 128 + hi * 8;
    const bf16_t* Kh = P.kvmem + (size_t)(b * MEML) * (DEPTH * 1024) + layer * 1024 + h * 128;
    MemOutRow ow; ow.zb = P.p + (size_t)(tok0 + wid * 32) * NPAD + C_MZ + h * 128; ow.gb = P.xn + (size_t)(tok0 + wid * 32) * MIX + 1536 + h * 128;
    att::attn_body<false, DEPTH * 1024, 512, MemOutRow>(Qw, Kh, MEML / 64, nullptr, 0u, ow, lds);
}

__device__ __forceinline__ void phase_gate(const Params& P, int c_lo, int c_hi) {
    const int wid = TIDX() >> 6, lane = TIDX() & 63;
    const int c0 = lane * 32;
    const int seg = c0 >> 9, zc = (seg == 0 ? C_GZ : seg == 1 ? C_SZ : seg == 2 ? C_DZ : C_MZ) + (c0 & 511);
    const bool act = (c0 >= c_lo) && (c0 < c_hi);
    for (int tok = blockIdx.x * 8 + wid; tok < NTOK; tok += gridDim.x * 8) {
        if (!act) { bf16_t* gz_ = P.xn + (size_t)tok * MIX + c0; const u32x4 zz = {0u, 0u, 0u, 0u};
#pragma unroll
            for (int i = 0; i < 4; ++i) *(u32x4*)(gz_ + 8 * i) = zz;
            continue; }
        const bf16_t* op = P.ocat + (size_t)tok * MIX + c0; const bf16_t* zp = P.p + (size_t)tok * NPAD + zc; bf16_t* gp = P.xn + (size_t)tok * MIX + c0;
        float o[32]; float ss = 0.f;
#pragma unroll
        for (int i = 0; i < 4; ++i) { float v[8]; ld8f(op + 8 * i, v);
#pragma unroll
            for (int j = 0; j < 8; ++j) { o[8 * i + j] = v[j]; ss += v[j] * v[j]; } }
        ss += shx(ss, 1); ss += shx(ss, 2);
        const float r = rsqrtf(ss * (1.f / 128.f) + EPS);
#pragma unroll
        for (int i = 0; i < 4; ++i) { float z[8], g[8]; ld8f(zp + 8 * i, z);
#pragma unroll
            for (int j = 0; j < 8; ++j) g[j] = o[8 * i + j] * r * siluf_(z[j]);
            st8f(gp + 8 * i, g); }
    }
}

__device__ __forceinline__ void phase_gemm_in(const Params& P, int layer, char* lds) {
    pg8::Gemm g; g.A = P.xn; g.Bt = P.WinT + (size_t)layer * NPAD * DM; g.M = NTOK; g.N = NPAD; g.K = DM;
    pg8::StaticOrder S; S.init(g.M, g.N, (int)gridDim.x, (int)blockIdx.x);
    pg8::EpiBf16Plain E; E.O = P.p; E.ldc = NPAD;
    pg8::gemm_phase<pg8::EpiBf16Plain, pg8::StaticOrder, false>((PG8_LAS unsigned char*)lds, g, S, E, nullptr);
}
__device__ __forceinline__ void phase_gemm_out(const Params& P, int layer, char* lds) {
    pg8::Gemm g; g.A = P.xn; g.Bt = P.WoutT + (size_t)layer * DM * MIX; g.M = NTOK; g.N = DM; g.K = MIX;
    pg8::StaticOrder S; S.init(g.M, g.N, (int)gridDim.x, (int)blockIdx.x);
    pg8::EpiResid E; E.R = (layer == 0) ? P.x : P.xbuf; E.C = (layer == DEPTH - 1) ? P.out : P.xbuf; E.ldc = DM;
    pg8::gemm_phase<pg8::EpiResid, pg8::StaticOrder, false>((PG8_LAS unsigned char*)lds, g, S, E, nullptr);
}
__device__ __forceinline__ void phase_gemm_kv(const Params& P, char* lds) {
    pg8::Gemm g; g.A = P.memn; g.Bt = P.WkvT; g.M = NB * MEML; g.N = DEPTH * 1024; g.K = DM;
    pg8::StaticOrder S; S.init(g.M, g.N, (int)gridDim.x, (int)blockIdx.x);
    pg8::EpiBf16Plain E; E.O = P.kvmem; E.ldc = DEPTH * 1024;
    pg8::gemm_phase<pg8::EpiBf16Plain, pg8::StaticOrder, false>((PG8_LAS unsigned char*)lds, g, S, E, nullptr);
}
__device__ __forceinline__ void mma_tile(f32x16& acc, const char* A, int lda, const char* B, int ldb, int K, int lane) {
    const int r = lane & 31, kh = lane >> 5;
    const char* ap = A + r * lda + kh * 16; const char* bp = B + r * ldb + kh * 16;
    asm volatile("" : "+v"(acc));
    for (int k = 0; k < K; k += 16) {
        const bf16x8 a = *(const bf16x8*)(ap + k * 2); const bf16x8 b = *(const bf16x8*)(bp + k * 2);
        acc = __builtin_amdgcn_mfma_f32_32x32x16_bf16(a, b, acc, 0, 0, 0);
    }
}
__device__ __forceinline__ int crow32(int r, int hi) { return (r & 3) + 8 * (r >> 2) + 4 * hi; }
__device__ __forceinline__ float log_sigmoid_(float x) { return fminf(x, 0.f) - log1pf(__expf(-fabsf(x))); }

constexpr int GLA_ST = 144;
constexpr int GLA_ST2 = 272;
__device__ __forceinline__ void gla_front(const Params& P, int layer, int tok0, int h, float (&bv)[8], float* glr_s  , float* tot_s  , float* bm_s  , float* bl_s  ) {
    const int tid = TIDX(), d = tid & 63, tg = tid >> 6;
    __syncthreads();
    if (tid < 128) { const int t = tid >> 1, half = tid & 1; float v[8]; ld8f(P.p + (size_t)(tok0 + t) * NPAD + C_GLR + half * 8, v);
#pragma unroll
        for (int j = 0; j < 8; ++j) glr_s[t * 16 + half * 8 + j] = v[j]; }
    float wu[16];
#pragma unroll
    for (int r = 0; r < 16; ++r) wu[r] = P.gla_w_up[((size_t)layer * 16 + r) * 256 + h * 64 + d];
    const float bias = P.gla_b_up[layer * 256 + h * 64 + d];
    __syncthreads();
    float run = 0.f;
#pragma unroll
    for (int i = 0; i < 8; ++i) { const int t = tg * 8 + i; float a = bias;
#pragma unroll
        for (int r = 0; r < 16; ++r) a = fmaf(glr_s[t * 16 + r], wu[r], a);
        run += log_sigmoid_(a) * (1.f / 16.f); bv[i] = run; }
    tot_s[tg * 64 + d] = run;
    __syncthreads();
    float off = 0.f, all = 0.f;
#pragma unroll
    for (int g = 0; g < 8; ++g) { const float v = tot_s[g * 64 + d]; off += (g < tg) ? v : 0.f; all += v; }
#pragma unroll
    for (int i = 0; i < 8; ++i) bv[i] += off;
    if (tg == 4) bm_s[d] = bv[0];
    if (tg == 0) bl_s[d] = all;
    __syncthreads();
}

__device__ __forceinline__ void unit_gla_a(const Params& P, int layer, int u, char* lds) {
    const int b = u >> 8, n = (u >> 2) & 63, h = u & 3, tok0 = b * SEQ + n * 64;
    const int tid = TIDX(), wid = tid >> 6, lane = tid & 63, d = tid & 63, tg = tid >> 6;
    char* kdT = lds;
    char* vT = lds + 64 * GLA_ST;
    float* glr_s = (float*)(lds + 64 * GLA_ST + 128 * GLA_ST); float* tot_s = glr_s + 1024; float* bm_s = tot_s + 512; float* bl_s = bm_s + 64;
    float bv[8]; gla_front(P, layer, tok0, h, bv, glr_s, tot_s, bm_s, bl_s);
    const float bl = bl_s[d];
#pragma unroll
    for (int i = 0; i < 8; ++i) { const int t = tg * 8 + i; const float k = bf2f(P.p[(size_t)(tok0 + t) * NPAD + C_GK + h * 64 + d]);
        *(bf16_t*)(kdT + d * GLA_ST + t * 2) = f2bf(k * __expf(bl - bv[i])); }
    { const int e = tid & 127, sg = tid >> 7;
#pragma unroll
      for (int i = 0; i < 16; ++i) { const int s = sg * 16 + i; *(bf16_t*)(vT + e * GLA_ST + s * 2) = P.p[(size_t)(tok0 + s) * NPAD + C_GV + h * 128 + e]; } }
    __syncthreads();
    const int mt = wid >> 2, nt = wid & 3, hi = lane >> 5;
    f32x16 acc = {}; mma_tile(acc, kdT + mt * 32 * GLA_ST, GLA_ST, vT + nt * 32 * GLA_ST, GLA_ST, 64, lane);
    float* dst = P.glas + ((size_t)((b * 64 + n) * 4 + h)) * 64 * 128;
#pragma unroll
    for (int r = 0; r < 16; ++r) dst[(mt * 32 + crow32(r, hi)) * 128 + nt * 32 + (lane & 31)] = acc[r];
    if (tid < 64) P.glad[((size_t)((b * 64 + n) * 4 + h)) * 64 + tid] = __expf(bl_s[tid]);
}

__device__ __forceinline__ void gla_scan_slice(const Params& P, int idx) {
    {
        const int e = idx & 127, d = (idx >> 7) & 63, h = (idx >> 13) & 3, b = idx >> 15;
        float S = 0.f;
        for (int n0 = 0; n0 < 64; n0 += 8) {
            float ds[8], dc[8];
#pragma unroll
            for (int i = 0; i < 8; ++i) { const size_t cu = (size_t)((b * 64 + n0 + i) * 4 + h); ds[i] = P.glas[cu * 8192 + d * 128 + e]; dc[i] = P.glad[cu * 64 + d]; }
#pragma unroll
            for (int i = 0; i < 8; ++i) { const size_t cu = (size_t)((b * 64 + n0 + i) * 4 + h); P.glas[cu * 8192 + d * 128 + e] = S; S = fmaf(dc[i], S, ds[i]); }
        }
    }
}

__device__ __forceinline__ void unit_gla_c(const Params& P, int layer, int u, char* lds) {
    const int b = u >> 8, n = (u >> 2) & 63, h = u & 3, tok0 = b * SEQ + n * 64;
    const int tid = TIDX(), wid = tid >> 6, lane = tid & 63, d = tid & 63, tg = tid >> 6, hi = lane >> 5;
    char* Acat = lds;
    char* Bcat = Acat + 64 * GLA_ST2;
    char* qe = Bcat + 128 * GLA_ST2;
    char* ke = qe + 64 * GLA_ST;
    float* glr_s = (float*)(ke + 64 * GLA_ST); float* tot_s = glr_s + 1024; float* bm_s = tot_s + 512; float* bl_s = bm_s + 64;
    float* o_s = bl_s + 64;
    float bv[8]; gla_front(P, layer, tok0, h, bv, glr_s, tot_s, bm_s, bl_s);
    const float m = bm_s[d];
#pragma unroll
    for (int i = 0; i < 8; ++i) { const int t = tg * 8 + i; const bf16_t* row = P.p + (size_t)(tok0 + t) * NPAD;
        const float q = bf2f(row[C_GQ + h * 64 + d]) * 0.125f, k = bf2f(row[C_GK + h * 64 + d]);
        *(bf16_t*)(qe + t * GLA_ST + d * 2) = f2bf(q * __expf(bv[i] - m));
        *(bf16_t*)(ke + t * GLA_ST + d * 2) = f2bf(k * __expf(m - bv[i]));
        *(bf16_t*)(Acat + t * GLA_ST2 + (64 + d) * 2) = f2bf(q * __expf(bv[i])); }
    { const int e = tid & 127, sg = tid >> 7;
      const float* sp = P.glas + ((size_t)((b * 64 + n) * 4 + h)) * 64 * 128;
#pragma unroll
      for (int i = 0; i < 16; ++i) { const int s = sg * 16 + i;
          *(bf16_t*)(Bcat + e * GLA_ST2 + s * 2) = P.p[(size_t)(tok0 + s) * NPAD + C_GV + h * 128 + e];
          *(bf16_t*)(Bcat + e * GLA_ST2 + (64 + s) * 2) = f2bf(sp[s * 128 + e]); } }
    __syncthreads();
    if (wid < 4) { const int mt = wid >> 1, nt = wid & 1;
        f32x16 acc = {}; mma_tile(acc, qe + mt * 32 * GLA_ST, GLA_ST, ke + nt * 32 * GLA_ST, GLA_ST, 64, lane);
#pragma unroll
        for (int r = 0; r < 16; ++r) { const int t = mt * 32 + crow32(r, hi), s = nt * 32 + (lane & 31);
            *(bf16_t*)(Acat + t * GLA_ST2 + s * 2) = f2bf(s <= t ? acc[r] : 0.f); } }
    __syncthreads();
    { const int mt = wid >> 2, nt = wid & 3;
      f32x16 acc = {}; mma_tile(acc, Acat + mt * 32 * GLA_ST2, GLA_ST2, Bcat + nt * 32 * GLA_ST2, GLA_ST2, 128, lane);
#pragma unroll
      for (int r = 0; r < 16; ++r) { const int t = mt * 32 + crow32(r, hi); o_s[t * 132 + nt * 32 + (lane & 31)] = acc[r]; } }
    __syncthreads();
    { const int t = tid >> 3, e0 = (tid & 7) * 16; const float* src = o_s + t * 132 + e0;
      f32x4 v[4]; float ss = 0.f;
#pragma unroll
      for (int i = 0; i < 4; ++i) { v[i] = *(const f32x4*)(src + 4 * i); ss += v[i][0] * v[i][0] + v[i][1] * v[i][1] + v[i][2] * v[i][2] + v[i][3] * v[i][3]; }
      ss += shx(ss, 1); ss += shx(ss, 2); ss += shx(ss, 4);
      const float rn = rsqrtf(ss * (1.f / 128.f) + EPS);
      const bf16_t* zp = P.p + (size_t)(tok0 + t) * NPAD + C_GZ + h * 128 + e0; bf16_t* gp = P.xn + (size_t)(tok0 + t) * MIX + h * 128 + e0;
#pragma unroll
      for (int i = 0; i < 2; ++i) { float z[8], gg[8]; ld8f(zp + 8 * i, z);
#pragma unroll
          for (int q = 0; q < 4; ++q) { gg[q] = v[2 * i][q] * rn * siluf_(z[q]); gg[4 + q] = v[2 * i + 1][q] * rn * siluf_(z[4 + q]); }
          st8f(gp + 8 * i, gg); } }
}
constexpr int S5P_STRIDE = 2304;
__device__ __forceinline__ void phase_s5_params(const Params& P) {
    for (int idx = blockIdx.x * NTHR + TIDX(); idx < DEPTH * 32 * 64; idx += gridDim.x * NTHR) {
        const int p = idx & 63, lg = idx >> 6;
        const float ar = P.s5_a_re[idx], ai = P.s5_a_im[idx], step = expf(P.s5_log_step[lg]);
        const float mag = expf(ar * step), th = ai * step;
        const float lr = mag * cosf(th), li = mag * sinf(th);
        float* o = P.s5p + (size_t)lg * S5P_STRIDE;
        o[2 * p] = lr; o[2 * p + 1] = li;
        { const float mag512 = expf(512.f * ar * step); const double a = 512.0 * (double)th; const double k = rint(a * 0.15915494309189535); const float rf = (float)fma(-k, 6.283185307179586, a);
          o[128 + 2 * p] = mag512 * cosf(rf); o[128 + 2 * p + 1] = mag512 * sinf(rf); }
        const float xr = lr - 1.f, xi = li, den = 1.f / (ar * ar + ai * ai);
        const float fr = (xr * ar + xi * ai) * den, fi = (xi * ar - xr * ai) * den;
        for (int c = 0; c < 16; ++c) { const float br = P.s5_b_re[(size_t)idx * 16 + c], bi = P.s5_b_im[(size_t)idx * 16 + c];
            o[256 + (p * 16 + c) * 2] = fr * br - fi * bi; o[256 + (p * 16 + c) * 2 + 1] = fr * bi + fi * br; }
    }
}
__device__ __forceinline__ float gelu_tanh_(float x) { const float u = 0.7978845608028654f * (x + 0.044715f * x * x * x); const float e = __expf(-2.f * fabsf(u)); const float th = copysignf((1.f - e) / (1.f + e), u); return 0.5f * x * (1.f + th); }

constexpr int S5_XST = 272;
constexpr int S5_UST = 48;
__device__ __forceinline__ float partner32(float v, int hi) { auto rr = __builtin_amdgcn_permlane32_swap(__float_as_uint(v), __float_as_uint(v), false, false); return __uint_as_float(hi ? rr[0] : rr[1]); }
struct S5Ctx { float l0r, l0i, l1r, l1i, q0r, q0i, q1r, q1i, dsk; char* Cm; char* Bb; char* Xs; char* Us; int lane, hi, j, rho; const bf16_t* ubase; bf16_t* ybase; };
template <bool OUT> __device__ __forceinline__ void s5_tile(const S5Ctx& C, int tok0, float& x0r, float& x0i, float& x1r, float& x1i) {
    const int hi = C.hi, j = C.j, lane = C.lane;
    if (hi == 0) { const bf16_t* up = C.ubase + (size_t)(tok0 + j) * NPAD;
        const bf16x8 w0 = *(const bf16x8*)up, w1 = *(const bf16x8*)(up + 8);
        *(bf16x8*)(C.Us + C.rho * S5_UST) = w0; *(bf16x8*)(C.Us + C.rho * S5_UST + 16) = w1; }
    asm volatile("" ::: "memory");
    f32x16 a0 = {}, a1 = {}, a2 = {}, a3 = {};
    mma_tile(a0, C.Us, S5_UST, C.Bb, S5_UST, 16, lane); mma_tile(a1, C.Us, S5_UST, C.Bb + 32 * S5_UST, S5_UST, 16, lane);
    mma_tile(a2, C.Us, S5_UST, C.Bb + 64 * S5_UST, S5_UST, 16, lane); mma_tile(a3, C.Us, S5_UST, C.Bb + 96 * S5_UST, S5_UST, 16, lane);
    float s0r[16], s0i[16], s1r[16], s1i[16];
#pragma unroll
    for (int r = 0; r < 16; ++r) {
        const float n0r = fmaf(C.l0r, x0r, fmaf(-C.l0i, x0i, a0[r])), n0i = fmaf(C.l0r, x0i, fmaf(C.l0i, x0r, a1[r])); x0r = n0r; x0i = n0i; s0r[r] = n0r; s0i[r] = n0i;
        const float n1r = fmaf(C.l1r, x1r, fmaf(-C.l1i, x1i, a2[r])), n1i = fmaf(C.l1r, x1i, fmaf(C.l1i, x1r, a3[r])); x1r = n1r; x1i = n1i; s1r[r] = n1r; s1i[r] = n1i; }
    float z0r = partner32(x0r, hi), z0i = partner32(x0i, hi), z1r = partner32(x1r, hi), z1i = partner32(x1i, hi);
    if (hi == 0) { z0r = 0.f; z0i = 0.f; z1r = 0.f; z1i = 0.f; }
    if (!OUT) {
        x0r += C.q0r * z0r - C.q0i * z0i; x0i += C.q0r * z0i + C.q0i * z0r; x1r += C.q1r * z1r - C.q1i * z1i; x1i += C.q1r * z1i + C.q1i * z1r;
    } else {
#pragma unroll
        for (int r = 0; r < 16; ++r) {
            const float t0r = C.l0r * z0r - C.l0i * z0i, t0i = C.l0r * z0i + C.l0i * z0r; z0r = t0r; z0i = t0i; s0r[r] += t0r; s0i[r] += t0i;
            const float t1r = C.l1r * z1r - C.l1i * z1i, t1i = C.l1r * z1i + C.l1i * z1r; z1r = t1r; z1i = t1i; s1r[r] += t1r; s1i[r] += t1i; }
        x0r = s0r[15]; x0i = s0i[15]; x1r = s1r[15]; x1i = s1i[15];
#pragma unroll
        for (int r = 0; r < 16; ++r) { char* xr_ = C.Xs + (r + 16 * hi) * S5_XST;
            *(bf16_t*)(xr_ + j * 2) = f2bf(s0r[r]); *(bf16_t*)(xr_ + (64 + j) * 2) = f2bf(s0i[r]);
            *(bf16_t*)(xr_ + (32 + j) * 2) = f2bf(s1r[r]); *(bf16_t*)(xr_ + (96 + j) * 2) = f2bf(s1i[r]); }
        asm volatile("" ::: "memory");
        f32x16 acc = {}; mma_tile(acc, C.Xs, S5_XST, C.Cm, S5_XST, 128, lane);
        if (j < 16) {
#pragma unroll
            for (int r = 0; r < 16; ++r) { const int t = crow32(r, hi); const int rt = ((t & 15) & 3) + 8 * ((t & 15) >> 2) + 4 * (t >> 4);
                const float y = acc[r] + C.dsk * bf2f(*(const bf16_t*)(C.Us + rt * S5_UST + j * 2));
                C.ybase[(size_t)(tok0 + t) * 512 + j] = f2bf(gelu_tanh_(y)); } }
        asm volatile("" ::: "memory");
    }
    { const float e0r = partner32(x0r, hi), e0i = partner32(x0i, hi), e1r = partner32(x1r, hi), e1i = partner32(x1i, hi);
      if (hi == 0) { x0r = e0r; x0i = e0i; x1r = e1r; x1i = e1i; } else { x0r = 0.f; x0i = 0.f; x1r = 0.f; x1i = 0.f; } }
}
__device__ __forceinline__ void unit_s5(const Params& P, int layer, int u, char* lds) {
    const int b = u >> 5, g = u & 31, tid = TIDX(), wid = tid >> 6, lane = tid & 63, hi = lane >> 5, j = lane & 31;
    char* Cm = lds;
    char* Bb = Cm + 32 * S5_XST;
    float* ends = (float*)(Bb + 128 * S5_UST);
    char* wbase = (char*)(ends + 8 * 64 * 2) + wid * (32 * S5_XST + 32 * S5_UST);
    const float* sp = P.s5p + (size_t)(layer * 32 + g) * S5P_STRIDE;
    __syncthreads();
    for (int i = tid; i < 32 * 128; i += NTHR) { const int c = i >> 7, pp = i & 127; float v = 0.f;
        if (c < 16) v = (pp < 64) ? P.s5_c_re[((size_t)(layer * 32 + g) * 16 + c) * 64 + pp] : -P.s5_c_im[((size_t)(layer * 32 + g) * 16 + c) * 64 + (pp - 64)];
        *(bf16_t*)(Cm + c * S5_XST + pp * 2) = f2bf(v); }
    for (int i = tid; i < 128 * 16; i += NTHR) { const int n = i >> 4, c = i & 15, nt = n >> 5, jj = n & 31, p = (nt >> 1) * 32 + jj;
        *(bf16_t*)(Bb + n * S5_UST + c * 2) = f2bf(sp[256 + (p * 16 + c) * 2 + (nt & 1)]); }
    S5Ctx C; C.Cm = Cm; C.Bb = Bb; C.Xs = wbase; C.Us = wbase + 32 * S5_XST; C.lane = lane; C.hi = hi; C.j = j;
    C.l0r = sp[2 * j]; C.l0i = sp[2 * j + 1]; C.l1r = sp[2 * (32 + j)]; C.l1i = sp[2 * (32 + j) + 1];
    { float q0r = C.l0r, q0i = C.l0i, q1r = C.l1r, q1i = C.l1i;
#pragma unroll
      for (int k = 0; k < 4; ++k) { const float a = q0r * q0r - q0i * q0i, bb = 2.f * q0r * q0i; q0r = a; q0i = bb; const float c = q1r * q1r - q1i * q1i, d = 2.f * q1r * q1i; q1r = c; q1i = d; }
      C.q0r = q0r; C.q0i = q0i; C.q1r = q1r; C.q1i = q1i; }
    C.dsk = P.s5_d[layer * 512 + g * 16 + (lane & 15)];
    C.rho = ((j & 15) & 3) + 8 * ((j & 15) >> 2) + 4 * (j >> 4);
    const int tokw = b * SEQ + wid * 512;
    C.ubase = P.p + C_SU + g * 16; C.ybase = P.ybuf + g * 16;
    float x0r = 0.f, x0i = 0.f, x1r = 0.f, x1i = 0.f;
    __syncthreads();
    for (int sc = 0; sc < 16; ++sc) s5_tile<false>(C, tokw + sc * 32, x0r, x0i, x1r, x1i);
    if (hi == 0) { ends[(wid * 64 + j) * 2] = x0r; ends[(wid * 64 + j) * 2 + 1] = x0i; ends[(wid * 64 + 32 + j) * 2] = x1r; ends[(wid * 64 + 32 + j) * 2 + 1] = x1i; }
    __syncthreads();
    { const float p0r = sp[128 + 2 * j], p0i = sp[128 + 2 * j + 1], p1r = sp[128 + 2 * (32 + j)], p1i = sp[128 + 2 * (32 + j) + 1];
      x0r = 0.f; x0i = 0.f; x1r = 0.f; x1i = 0.f;
      for (int w = 0; w < wid; ++w) { const float e0r = ends[(w * 64 + j) * 2], e0i = ends[(w * 64 + j) * 2 + 1], e1r = ends[(w * 64 + 32 + j) * 2], e1i = ends[(w * 64 + 32 + j) * 2 + 1];
          const float n0r = p0r * x0r - p0i * x0i + e0r, n0i = p0r * x0i + p0i * x0r + e0i, n1r = p1r * x1r - p1i * x1i + e1r, n1i = p1r * x1i + p1i * x1r + e1i;
          x0r = n0r; x0i = n0i; x1r = n1r; x1i = n1i; }
      if (hi) { x0r = 0.f; x0i = 0.f; x1r = 0.f; x1i = 0.f; } }
    for (int sc = 0; sc < 16; ++sc) s5_tile<true>(C, tokw + sc * 32, x0r, x0i, x1r, x1i);
}
constexpr int TOPK = 256;
__device__ __forceinline__ unsigned f2key(float f) { const unsigned u = __float_as_uint(f); return u ^ ((u & 0x80000000u) ? 0xffffffffu : 0x80000000u); }

__device__ __forceinline__ void dsa_score_tile(const bf16x8 (&afr)[4][4], const f32x16 (&wv)[4], const bf16x8 (&bfr)[4], float* sc, int col, int hi) {
#pragma unroll
    for (int rt = 0; rt < 4; ++rt) { f32x16 acc = {}; asm volatile("" : "+v"(acc));
#pragma unroll
        for (int kk = 0; kk < 4; ++kk) acc = __builtin_amdgcn_mfma_f32_32x32x16_bf16(afr[rt][kk], bfr[kk], acc, 0, 0, 0);
        float s0 = 0.f, s1 = 0.f;
#pragma unroll
        for (int i = 0; i < 16; i += 2) { s0 = fmaf(fmaxf(acc[i], 0.f), wv[rt][i], s0); s1 = fmaf(fmaxf(acc[i + 1], 0.f), wv[rt][i + 1], s1); }
        sc[(2 * rt + hi) * 4096 + col] = (s0 + s1) + 0.f; }
}
#define DSA_CNT4(K0, K1, K2, K3) asm volatile( \
    "v_cmp_ge_u32_e64 %[m0], %[k0], %[cd]\n\tv_cmp_ge_u32_e64 %[m1], %[k1], %[cd]\n\tv_cmp_ge_u32_e64 %[m2], %[k2], %[cd]\n\tv_cmp_ge_u32_e64 %[m3], %[k3], %[cd]\n\t" \
    "v_addc_co_u32_e64 %[a0], %[m0], %[a0], 0, %[m0]\n\tv_addc_co_u32_e64 %[a1], %[m1], %[a1], 0, %[m1]\n\t" \
    "v_addc_co_u32_e64 %[a0], %[m2], %[a0], 0, %[m2]\n\tv_addc_co_u32_e64 %[a1], %[m3], %[a1], 0, %[m3]" \
    : [a0] "+v"(c0), [a1] "+v"(c1), [m0] "=&s"(sm0), [m1] "=&s"(sm1), [m2] "=&s"(sm2), [m3] "=&s"(sm3) \
    : [k0] "v"(K0), [k1] "v"(K1), [k2] "v"(K2), [k3] "v"(K3), [cd] "v"(cand))
#define DSA_CNT8(J0) do { DSA_CNT4(key[(J0)], key[(J0) + 1], key[(J0) + 2], key[(J0) + 3]); DSA_CNT4(key[(J0) + 4], key[(J0) + 5], key[(J0) + 6], key[(J0) + 7]); } while (0)

__device__ __forceinline__ void unit_dsa_index(const Params& P, int u, char* lds) {
    const int b = u & 3, t0 = (511 - (u >> 2)) * 8;
    const int tid = TIDX(), wid = tid >> 6, lane = tid & 63, r32 = lane & 31, hi = lane >> 5;
    float* sc = (float*)lds;
    const bf16_t* pb = P.p + (size_t)b * SEQ * NPAD;
    __syncthreads();
    {
        bf16x8 afr[4][4]; f32x16 wv[4];
        const int qsel = (r32 >> 2) & 1, head = (r32 & 3) + 4 * (r32 >> 3);
#pragma unroll
        for (int rt = 0; rt < 4; ++rt) { const bf16_t* qp = pb + (size_t)(t0 + 2 * rt + qsel) * NPAD + C_DIQ + head * 64 + hi * 8;
#pragma unroll
            for (int kk = 0; kk < 4; ++kk) afr[rt][kk] = *(const bf16x8*)(qp + kk * 16);
            const float* wp = P.iw + (size_t)(b * SEQ + t0 + 2 * rt + hi) * 16;
#pragma unroll
            for (int i = 0; i < 4; ++i) { const f32x4 w4 = *(const f32x4*)(wp + 4 * i); wv[rt][4 * i] = w4[0]; wv[rt][4 * i + 1] = w4[1]; wv[rt][4 * i + 2] = w4[2]; wv[rt][4 * i + 3] = w4[3]; } }
        const int ntile = (t0 + 7) / 32 + 1;
        const bf16_t* kp = P.ikc + (size_t)(b * SEQ + r32) * 64 + hi * 8;
        bf16x8 b0[4], b1[4], b2[4], b3[4];
#define DSA_LDB(dst, K) do { const bf16_t* kq_ = kp + (size_t)(wid + 8 * (K)) * 32 * 64; _Pragma("unroll") for (int kk = 0; kk < 4; ++kk) dst[kk] = *(const bf16x8*)(kq_ + kk * 16); } while (0)
#define DSA_TILE(buf, K) dsa_score_tile(afr, wv, buf, sc, (wid + 8 * (K)) * 32 + r32, hi)
        const int nk = (ntile - wid + 7) >> 3;
        const int kl = nk > 0 ? nk - 1 : 0;
#define DSA_MIN(a) ((a) < kl ? (a) : kl)
        DSA_LDB(b0, DSA_MIN(0)); DSA_LDB(b1, DSA_MIN(1)); DSA_LDB(b2, DSA_MIN(2));
        int k = 0;
        for (; k + 4 <= nk; k += 4) {
            DSA_LDB(b3, k + 3); DSA_TILE(b0, k);
            DSA_LDB(b0, DSA_MIN(k + 4)); DSA_TILE(b1, k + 1);
            DSA_LDB(b1, DSA_MIN(k + 5)); DSA_TILE(b2, k + 2);
            DSA_LDB(b2, DSA_MIN(k + 6)); DSA_TILE(b3, k + 3);
        }
        if (k < nk) DSA_TILE(b0, k);
        if (k + 1 < nk) DSA_TILE(b1, k + 1);
        if (k + 2 < nk) DSA_TILE(b2, k + 2);
#undef DSA_MIN
#undef DSA_TILE
#undef DSA_LDB
    }
    __syncthreads();
    {
        const int t = t0 + wid; const float* srow = sc + wid * 4096;
        unsigned key[64];
#pragma unroll
        for (int j = 0; j < 64; ++j) { const int s = j * 64 + lane; key[j] = (s <= t) ? f2key(srow[s]) : 0u; }
        unsigned long long* mout = P.mask + (size_t)(b * SEQ + t) * 64;
        unsigned long long myword = 0ull;
        if (t + 1 <= TOPK) {
#pragma unroll
            for (int j = 0; j < 64; ++j) { const unsigned long long m = __ballot(j * 64 + lane <= t); if (lane == j) myword = m; }
        } else {
            const int ngrp = t / 512 + 1;
            unsigned T = 0u; int cntT = t + 1;
            unsigned kmax = 0u;
#pragma unroll
            for (int j = 0; j < 64; ++j) kmax = key[j] > kmax ? key[j] : kmax;
#pragma unroll
            for (int o = 32; o >= 1; o >>= 1) { const unsigned other = (unsigned)__builtin_amdgcn_ds_bpermute(((lane ^ o) << 2), (int)kmax); kmax = other > kmax ? other : kmax; }
            for (int bit = 31; bit >= 0; --bit) {
                const unsigned cand = T | (1u << bit); unsigned c0 = 0, c1 = 0; unsigned long long sm0, sm1, sm2, sm3;
                if (cand > kmax) continue;
                DSA_CNT8(0);
                if (ngrp > 1) DSA_CNT8(8);
                if (ngrp > 2) DSA_CNT8(16);
                if (ngrp > 3) DSA_CNT8(24);
                if (ngrp > 4) DSA_CNT8(32);
                if (ngrp > 5) DSA_CNT8(40);
                if (ngrp > 6) DSA_CNT8(48);
                if (ngrp > 7) DSA_CNT8(56);
                const int cl = (int)(c0 + c1);
                int cnt = 0;
#pragma unroll
                for (int bb = 0; bb < 7; ++bb) cnt += __popcll(__ballot((cl >> bb) & 1)) << bb;
                if (cnt >= TOPK) { T = cand; cntT = cnt; if (cnt == TOPK) break; }
            }
            if (cntT == TOPK) {
#pragma unroll
                for (int j = 0; j < 64; ++j) { const unsigned long long m = __ballot(key[j] >= T); if (lane == j) myword = m; }
            } else {
                int ngt = 0;
#pragma unroll
                for (int j = 0; j < 64; ++j) ngt += __popcll(__ballot(key[j] > T));
                int need = TOPK - ngt;
#pragma unroll
                for (int j = 0; j < 64; ++j) { const unsigned long long eq = __ballot(key[j] == T), gt = __ballot(key[j] > T);
                    const int ne = __popcll(eq); unsigned long long take = eq;
                    if (ne > need) { take = 0ull; int left = need; unsigned long long e2 = eq;
                        while (left > 0) { const unsigned long long lowbit = e2 & (0ull - e2); take |= lowbit; e2 ^= lowbit; --left; } }
                    need -= (ne > need) ? need : ne;
                    const unsigned long long m = gt | take; if (lane == j) myword = m; }
            }
        }
        mout[lane] = myword;
    }
}

struct DsaOutRow { const bf16_t* zb; bf16_t* gb; int wid;
    __device__ __forceinline__ const bf16_t* zrow(int r) const { const int rho = wid * 32 + r; return zb + (size_t)(rho >> 2) * NPAD + (rho & 3) * 128; }
    __device__ __forceinline__ bf16_t* grow(int r) const { const int rho = wid * 32 + r; return gb + (size_t)(rho >> 2) * MIX + (rho & 3) * 128; } };
__device__ __forceinline__ void unit_dsa_attn(const Params& P, int u, char* lds) {
    const int b = u & 3, qb = 63 - (u >> 2), t0 = qb * 64, tokb = b * SEQ;
    const int wid = TIDX() >> 6, lane = TIDX() & 63, r32 = lane & 31, hi = lane >> 5;
    const int rho = wid * 32 + r32, tq = t0 + (rho >> 2), hq = rho & 3;
    const bf16_t* Qw = P.p + (size_t)(tokb + tq) * NPAD + C_DQ + hq * 128 + hi * 8;
    const bf16_t* Kh = P.kvc + (size_t)tokb * 256;
    const unsigned moff = (unsigned)(tokb + tq) * 512u;
    DsaOutRow ow; ow.zb = P.p + (size_t)(tokb + t0) * NPAD + C_DZ; ow.gb = P.xn + (size_t)(tokb + t0) * MIX + 1024; ow.wid = wid;
    const int NT = (qb + 2) & ~1;
    att::attn_body<true, 256, 128, DsaOutRow>(Qw, Kh, NT, P.mask, moff, ow, lds);
}
__device__ __forceinline__ void phase_gemm_glu(const Params& P, int layer, char* lds) {
    pg8::Gemm g; g.A = P.ybuf; g.Bt = P.WgluT + (size_t)layer * 512 * 512; g.M = NTOK; g.N = 512; g.K = 512;
    pg8::StaticOrder S; S.init(g.M, g.N, (int)gridDim.x, (int)blockIdx.x);
    pg8::EpiGlu E; E.Y = P.ybuf; E.ldy = 512; E.O = P.ocat; E.ldo = MIX; E.ooff = 512;
    pg8::gemm_phase<pg8::EpiGlu, pg8::StaticOrder, false>((PG8_LAS unsigned char*)lds, g, S, E, nullptr);
}

constexpr int CTL_Q0 = 4096;
struct OneUnit { int pm, pn; __device__ __forceinline__ bool next(int i, pg8::Unit& u) const { if (i) return false; u.pm = pm; u.pn = pn; return true; }
    __device__ __forceinline__ void a_ready(const pg8::Unit&) const {} __device__ __forceinline__ void done(const pg8::Unit&) const {} };
__device__ __forceinline__ int q_issue(unsigned* ctr) { return (int)__hip_atomic_fetch_add(ctr, 1u, __ATOMIC_RELAXED, __HIP_MEMORY_SCOPE_AGENT); }
#define Q_LOOP_BEGIN(ctr, total)  { unsigned* q_ctr_ = (ctr); const int q_total_ = (total); volatile int* q_b_ = (volatile int*)(lds + LDS_TAIL + 16); \
    for (;;) { __syncthreads(); if (TIDX() == 0) *q_b_ = q_issue(q_ctr_); __syncthreads(); const int item = __builtin_amdgcn_readfirstlane(*q_b_); if (item >= q_total_) break;
#define Q_LOOP_END  } }
__device__ __forceinline__ void unit_glu(const Params& P, int layer, int u, char* lds) {
    pg8::Gemm g; g.A = P.ybuf; g.Bt = P.WgluT + (size_t)layer * 512 * 512; g.M = NTOK; g.N = 512; g.K = 512;
    OneUnit S; S.pm = u >> 1; S.pn = u & 1;
    pg8::EpiGluGate E; E.Y = P.ybuf; E.Pz = P.p; E.G = P.xn;
    pg8::gemm_phase<pg8::EpiGluGate, OneUnit, false>((PG8_LAS unsigned char*)lds, g, S, E, nullptr);
}
constexpr int LDS_TAIL = LDS_BYTES - 64;

__global__ __launch_bounds__(NTHR, 2) void k_mega(Params P) {
    extern __shared__ __attribute__((aligned(16))) char lds[];
    if (TIDX() == 0) *(uint4*)(lds + LDS_TAIL) = make_uint4(0u, 0u, 0u, 0u);
    __syncthreads();
    XcdBarrier bar = xcd_barrier_post(P.ctl, (volatile LAS unsigned*)(lds + LDS_TAIL));
    const int G = gridDim.x, B = blockIdx.x;
    phase_prologue1(P, lds); phase_rope_table(P); phase_s5_params(P); phase_rmsnorm_x(P, 0);
    xcd_barrier(bar);
    for (int layer = 0; layer < DEPTH; ++layer) {
        if (layer > 0) { phase_rmsnorm_x(P, layer); xcd_barrier(bar); }
        phase_gemm_in(P, layer, lds);
        if (layer == 0) phase_gemm_kv(P, lds);
        xcd_barrier(bar);
        phase_prep(P, layer);
        if (layer == 0) phase_memk_norm(P);
        for (int u = B; u < 1024; u += G) unit_gla_a(P, layer, u, lds);
        xcd_barrier(bar);
        Q_LOOP_BEGIN(P.ctl + CTL_Q0 + 64 * (layer * 2), 128 + 2048 + 256 + 256)
            if (item < 128) unit_s5(P, layer, item, lds);
            else if (item < 2176) unit_dsa_index(P, item - 128, lds);
            else if (item < 2432) unit_mem_attn(P, layer, item - 2176, lds);
            else gla_scan_slice(P, (item - 2432) * NTHR + TIDX());
        Q_LOOP_END
        xcd_barrier(bar);
        Q_LOOP_BEGIN(P.ctl + CTL_Q0 + 64 * (layer * 2 + 1), 256 + 256 + 128)
            if (item < 256) unit_dsa_attn(P, item, lds);
            else if (item < 512) { for (int k = 0; k < 4; ++k) unit_gla_c(P, layer, (item - 256) * 4 + k, lds); }
            else unit_glu(P, layer, item - 512, lds);
        Q_LOOP_END
        xcd_barrier(bar);
        phase_gemm_out(P, layer, lds);
        xcd_barrier(bar);
    }
}

extern "C" void kernel_launch(void* const* d_in, const int* in_sizes, int n_in, void* d_out, int out_size, void* d_ws, size_t ws_size, hipStream_t stream) {
    if (n_in != 24 || ws_size < WS_END) { fprintf(stderr, "kernel_launch: unexpected n_in %d or ws_size %zu (< %zu)\n", n_in, ws_size, (size_t)WS_END); return; }
    Params P; memset(&P, 0, sizeof(P));
    P.x = (const float*)d_in[0]; P.mem = (const float*)d_in[1]; P.pos = (const int*)d_in[2]; P.ln_gain = (const float*)d_in[3]; P.w_in = (const float*)d_in[4];
    P.gla_w_up = (const float*)d_in[5]; P.gla_b_up = (const float*)d_in[6]; P.s5_a_re = (const float*)d_in[7]; P.s5_a_im = (const float*)d_in[8]; P.s5_log_step = (const float*)d_in[9];
    P.s5_b_re = (const float*)d_in[10]; P.s5_b_im = (const float*)d_in[11]; P.s5_c_re = (const float*)d_in[12]; P.s5_c_im = (const float*)d_in[13]; P.s5_d = (const float*)d_in[14];
    P.s5_w_glu = (const float*)d_in[15]; P.dsa_q_norm = (const float*)d_in[16]; P.dsa_k_norm = (const float*)d_in[17]; P.mem_norm = (const float*)d_in[18]; P.w_mem_kv = (const float*)d_in[19];
    P.mem_q_norm = (const float*)d_in[20]; P.mem_k_norm = (const float*)d_in[21]; P.out_norm = (const float*)d_in[22]; P.w_out = (const float*)d_in[23];
    P.out = (float*)d_out;
    char* ws = (char*)d_ws;
    P.ctl = (unsigned*)(ws + WS_CTL); P.WinT = (bf16_t*)(ws + WS_WINT); P.WoutT = (bf16_t*)(ws + WS_WOUTT); P.WkvT = (bf16_t*)(ws + WS_WKVT); P.WgluT = (bf16_t*)(ws + WS_WGLUT);
    P.memn = (bf16_t*)(ws + WS_MEMN); P.kvmem = (bf16_t*)(ws + WS_KVMEM); P.xn = (bf16_t*)(ws + WS_XN); P.p = (bf16_t*)(ws + WS_P); P.xbuf = (float*)(ws + WS_XBUF);
    P.ocat = (bf16_t*)(ws + WS_OCAT); P.mask = (unsigned long long*)(ws + WS_MASK); P.iw = (float*)(ws + WS_IW); P.ybuf = (bf16_t*)(ws + WS_YBUF); P.rope = (float*)(ws + WS_ROPE);
    P.s5p = (float*)(ws + WS_S5P); P.glas = (float*)(ws + WS_GLAS); P.glad = (float*)(ws + WS_GLAD); P.ikc = (bf16_t*)(ws + WS_IKC); P.kvc = (bf16_t*)(ws + WS_KVC);
    static int grid = 0;
    if (!grid) {
        int dev = 0, cus = 0, per_cu = 0;
        (void)hipGetDevice(&dev); (void)hipDeviceGetAttribute(&cus, hipDeviceAttributeMultiprocessorCount, dev);
        (void)hipFuncSetAttribute((const void*)k_mega, hipFuncAttributeMaxDynamicSharedMemorySize, LDS_BYTES);
        (void)hipOccupancyMaxActiveBlocksPerMultiprocessor(&per_cu, (const void*)k_mega, NTHR, LDS_BYTES);
        if (per_cu < 1) fprintf(stderr, "kernel_launch: occupancy query reports %d blocks per CU\n", per_cu);
        grid = cus > 0 ? cus : 256;
    }
    (void)hipMemsetAsync(ws + WS_CTL, 0, CTL_BYTES, stream);
    hipLaunchKernelGGL(k_mega, dim3(grid), dim3(NTHR), LDS_BYTES, stream, P);
}
```

```cpp
#include <hip/hip_runtime.h>
#include <stdint.h>
#include <stdio.h>
#include <string.h>

constexpr int NB = 4, SEQ = 4096, NTOK = NB * SEQ, DM = 2048, DEPTH = 4, MEML = 256;
constexpr int NIN = 5984, NPAD = 6144, MIX = 2048;
constexpr int C_GQ = 0, C_GK = 256, C_GV = 512, C_GLR = 1024, C_GZ = 1040, C_SU = 1552, C_SZ = 2064, C_DQ = 2576, C_DK = 3088, C_DV = 3216,
              C_DIQ = 3344, C_DIK = 4368, C_DIW = 4432, C_DZ = 4448, C_MQ = 4960, C_MZ = 5472;
constexpr float EPS = 1e-6f;
constexpr int NTHR = 512;
constexpr int LDS_BYTES = 147456;

typedef unsigned short bf16_t;
typedef short bf16x8 __attribute__((ext_vector_type(8)));
typedef short s16x4 __attribute__((ext_vector_type(4)));
typedef float f32x4 __attribute__((ext_vector_type(4)));
typedef float f32x8 __attribute__((ext_vector_type(8)));
typedef float f32x16 __attribute__((ext_vector_type(16)));
typedef unsigned u32x4 __attribute__((ext_vector_type(4)));
typedef unsigned u32x2 __attribute__((ext_vector_type(2)));
#define LAS __attribute__((address_space(3)))

__device__ __forceinline__ float bf2f(bf16_t b) { return __uint_as_float(((unsigned)b) << 16); }
__device__ __forceinline__ bf16_t f2bf(float f) { unsigned u = __float_as_uint(f); u += 0x7FFFu + ((u >> 16) & 1u); return (bf16_t)(u >> 16); }
__device__ __forceinline__ unsigned pk2bf(float lo, float hi) { return (unsigned)f2bf(lo) | ((unsigned)f2bf(hi) << 16); }
__device__ __forceinline__ float sigmoidf_(float x) { return 1.f / (1.f + __expf(-x)); }
__device__ __forceinline__ float siluf_(float x) { return x / (1.f + __expf(-x)); }

__device__ __forceinline__ int TIDX() { int t = (int)threadIdx.x; asm volatile("" : "+v"(t)); return t; }
__device__ __forceinline__ float shx(float v, int m) { const int src = ((TIDX() & 63) ^ m) << 2; return __int_as_float(__builtin_amdgcn_ds_bpermute(src, __float_as_int(v))); }
__device__ __forceinline__ float wave_sum(float v) {
#pragma unroll
    for (int o = 32; o >= 1; o >>= 1) v += shx(v, o);
    return v;
}
__device__ __forceinline__ void ld8f(const bf16_t* p, float (&v)[8]) { const u32x4 w = *(const u32x4*)p;
#pragma unroll
    for (int j = 0; j < 4; ++j) { v[2 * j] = __uint_as_float(w[j] << 16); v[2 * j + 1] = __uint_as_float(w[j] & 0xffff0000u); } }
__device__ __forceinline__ void st8f(bf16_t* p, const float (&v)[8]) { u32x4 w; w.x = pk2bf(v[0], v[1]); w.y = pk2bf(v[2], v[3]); w.z = pk2bf(v[4], v[5]); w.w = pk2bf(v[6], v[7]); *(u32x4*)p = w; }
__device__ __forceinline__ float f2bf_f(float f) { return bf2f(f2bf(f)); }
#define XB_TMO      128
#define XB_XCNT(j)  (256  + 64 * (j))
#define XB_XSUB(j)  (1280 + 64 * (j))
#define XB_XGEN(j)  (2304 + 64 * (j))
#define XB_TOP      3328
#define XB_TOPGEN   3392
#define XCD_BAR_WORDS 3456
#define XB_SPIN_CAP (1u << 18)

__device__ __forceinline__ unsigned xb_ld(unsigned* p)              { return __hip_atomic_load(p, __ATOMIC_RELAXED, __HIP_MEMORY_SCOPE_AGENT); }
__device__ __forceinline__ unsigned xb_add(unsigned* p, unsigned v) { return __hip_atomic_fetch_add(p, v, __ATOMIC_RELAXED, __HIP_MEMORY_SCOPE_AGENT); }
__device__ __forceinline__ unsigned xb_xcc_id() { return (unsigned)__builtin_amdgcn_s_getreg((3 << 11) | 20) & 0xFu; }
#define XB_SPIN(cond, bar) do { unsigned _sp = 0; while (cond) { __builtin_amdgcn_s_sleep(1); \
    if ((++_sp & 255u) == 0u) { if (xb_ld(&(bar)[XB_TMO])) break; if (_sp > XB_SPIN_CAP) { atomicAdd(&(bar)[XB_TMO], 1u); break; } } } } while (0)

struct XcdBarrier {
    unsigned* bar; unsigned x;
    volatile LAS unsigned* st;
};

__device__ __forceinline__ XcdBarrier xcd_barrier_post(unsigned* bar, volatile LAS unsigned* st) {
    XcdBarrier b; b.bar = bar; b.x = xb_xcc_id(); b.st = st;
    if (TIDX() == 0) (void)xb_add(&bar[XB_XCNT(b.x)], 1u);
    return b;
}
__device__ __forceinline__ void xcd_barrier_complete(unsigned* bar, unsigned x, unsigned& nloc, unsigned& nx) {
    const unsigned G = gridDim.x * gridDim.y * gridDim.z;
    unsigned sum, cnt, mine, sp = 0u;
    for (;;) {
        sum = 0u; cnt = 0u; mine = 0u;
#pragma unroll
        for (unsigned j = 0; j < 16; ++j) { const unsigned c = xb_ld(&bar[XB_XCNT(j)]); sum += c; cnt += (c > 0u) ? 1u : 0u; mine = (j == x) ? c : mine; }
        if (sum == G) break;
        __builtin_amdgcn_s_sleep(1);
        if ((++sp & 255u) == 0u) { if (xb_ld(&bar[XB_TMO])) break; if (sp > XB_SPIN_CAP) { atomicAdd(&bar[XB_TMO], 1u); break; } }
    }
    nloc = mine > 0u ? mine : 1u; nx = cnt > 0u ? cnt : 1u;
}

__device__ __forceinline__ void xcd_barrier(const XcdBarrier& b) {
    asm volatile("s_waitcnt vmcnt(0)" ::: "memory");
    __syncthreads();
    if (TIDX() == 0) {
        unsigned* bar = b.bar; const unsigned bx = xb_xcc_id();
        __builtin_amdgcn_s_waitcnt(0);
        unsigned nloc = b.st[0], nx = b.st[1];
        if (nloc == 0u) { xcd_barrier_complete(bar, bx, nloc, nx); b.st[0] = nloc; b.st[1] = nx; }
        const unsigned old = xb_add(&bar[XB_XSUB(bx)], 1u);
        const unsigned gen = old / nloc;
        if (old + 1u == (gen + 1u) * nloc) {
            __builtin_amdgcn_fence(__ATOMIC_RELEASE, "agent");
            asm volatile("s_waitcnt vmcnt(0)" ::: "memory");
            const unsigned og = xb_add(&bar[XB_TOP], 1u);
            const unsigned tg = og / nx;
            if (og + 1u == (tg + 1u) * nx) xb_add(&bar[XB_TOPGEN], 1u);
            else XB_SPIN(xb_ld(&bar[XB_TOPGEN]) == tg, bar);
            __builtin_amdgcn_fence(__ATOMIC_ACQUIRE, "agent");
            xb_add(&bar[XB_XGEN(bx)], 1u);
            asm volatile("s_waitcnt vmcnt(0)" ::: "memory");
        } else {
            XB_SPIN(xb_ld(&bar[XB_XGEN(bx)]) == gen, bar);
            __builtin_amdgcn_fence(__ATOMIC_ACQUIRE, "agent");
            asm volatile("s_waitcnt vmcnt(0)" ::: "memory");
        }
    }
    __syncthreads();
}
namespace pg8 {
#define PG8_LAS __attribute__((address_space(3)))
typedef float f32x2 __attribute__((ext_vector_type(2)));
typedef unsigned u32x4 __attribute__((ext_vector_type(4)));
constexpr int BM = 256, BK = 64, HALF = 128, HTB = HALF * BK * 2  , STAGE_BYTES = 8 * HTB, NXCD = 8, WGM = 8;

__host__ __device__ __forceinline__ int lds_byte(int r, int c) { const int st = (r >> 4) * 2 + (c >> 5), rr = r & 15, cc = c & 31, ob = rr * 64 + cc * 2; return st * 1024 + (ob ^ (((ob >> 9) & 1) << 5)); }
__host__ __device__ __forceinline__ void stage_rc(int b, int& R, int& C) { const int st = b / 1024, sb = b % 1024, swz = sb ^ (((sb >> 9) & 1) << 5); R = (st >> 1) * 16 + swz / 64; C = (st & 1) * 32 + (swz % 64) / 2; }
__host__ __device__ __forceinline__ int perm32(int rho) { const int n = rho >> 4, i = rho & 15; return 8 * (i >> 2) + 4 * n + (i & 3); }

struct Unit { int pm, pn; };
struct Gemm { const bf16_t* A; const bf16_t* Bt; int M, N, K; };

struct StaticOrder {
    int nM, nN, nwg, G, c;
    __host__ __device__ void init(int M, int N, int G_, int c_) { nM = M / BM; nN = N / BM; nwg = nM * nN; G = G_; c = c_; }
    __host__ __device__ bool next(int i, Unit& u) const {
        const long L = (long)i * G + c; if (L >= nwg) return false;
        int wgid = (int)L; { const int q = nwg / NXCD, r = nwg % NXCD, xcd = wgid % NXCD, off = wgid / NXCD; wgid = (xcd < r ? xcd * (q + 1) : r * (q + 1) + (xcd - r) * q) + off; }
        const int nig = WGM * nN, gid = wgid / nig, fm = gid * WGM, gsz = (nM - fm) < WGM ? (nM - fm) : WGM;
        u.pm = fm + ((wgid % nig) % gsz); u.pn = (wgid % nig) / gsz; return true;
    }
    __device__ __forceinline__ void a_ready(const Unit&) const {}
    __device__ __forceinline__ void done(const Unit&) const {}
};
__device__ __forceinline__ unsigned cvt_pk_bf16(float lo, float hi) { unsigned r; asm volatile("v_cvt_pk_bf16_f32 %0, %1, %2" : "=v"(r) : "v"(lo), "v"(hi)); return r; }
struct EpiBf16Plain {
    static constexpr bool PERM = true, AFTER_DRAIN = false;
    bf16_t* O; int ldc;
    __device__ __forceinline__ void operator()(const f32x4 (&acc)[2][2][4][2], const Unit& u, int wr, int wc, int fr, int fq) const {
        const int row0 = u.pm * BM + wr * 64 + fr, col0 = u.pn * BM + wc * 32 + 8 * fq;
#pragma unroll
        for (int ai = 0; ai < 2; ++ai)
#pragma unroll
            for (int m = 0; m < 4; ++m) { bf16_t* rowp = O + (size_t)(row0 + ai * HALF + m * 16) * ldc + col0;
#pragma unroll
                for (int bj = 0; bj < 2; ++bj) { const f32x4 v0 = acc[ai][bj][m][0], v1 = acc[ai][bj][m][1];
                    u32x4 w; w.x = cvt_pk_bf16(v0[0], v0[1]); w.y = cvt_pk_bf16(v0[2], v0[3]); w.z = cvt_pk_bf16(v1[0], v1[1]); w.w = cvt_pk_bf16(v1[2], v1[3]);
                    *(u32x4*)(rowp + bj * HALF) = w; } }
    }
};
struct EpiResid {
    static constexpr bool PERM = false, AFTER_DRAIN = false;
    const float* R; float* C; int ldc;
    __device__ __forceinline__ void operator()(const f32x4 (&acc)[2][2][4][2], const Unit& u, int wr, int wc, int fr, int fq) const {
        const int row0 = u.pm * BM + wr * 64 + fr, col0 = u.pn * BM + wc * 32 + 4 * fq;
#pragma unroll
        for (int ai = 0; ai < 2; ++ai)
#pragma unroll
            for (int m = 0; m < 4; ++m) { const size_t off = (size_t)(row0 + ai * HALF + m * 16) * ldc + col0;
#pragma unroll
                for (int bj = 0; bj < 2; ++bj)
#pragma unroll
                    for (int n = 0; n < 2; ++n) { const f32x4 r = *(const f32x4*)(R + off + bj * HALF + n * 16); *(f32x4*)(C + off + bj * HALF + n * 16) = acc[ai][bj][m][n] + r; } }
    }
};
struct EpiGlu {
    static constexpr bool PERM = true, AFTER_DRAIN = false;
    const bf16_t* Y; int ldy; bf16_t* O; int ldo; int ooff;
    __device__ __forceinline__ void operator()(const f32x4 (&acc)[2][2][4][2], const Unit& u, int wr, int wc, int fr, int fq) const {
        const int row0 = u.pm * BM + wr * 64 + fr, col0 = u.pn * BM + wc * 32 + 8 * fq;
#pragma unroll
        for (int ai = 0; ai < 2; ++ai)
#pragma unroll
            for (int m = 0; m < 4; ++m) { const int row = row0 + ai * HALF + m * 16;
#pragma unroll
                for (int bj = 0; bj < 2; ++bj) { const f32x4 v0 = acc[ai][bj][m][0], v1 = acc[ai][bj][m][1];
                    const u32x4 yw = *(const u32x4*)(Y + (size_t)row * ldy + col0 + bj * HALF);
                    float y[8], g[8];
#pragma unroll
                    for (int j = 0; j < 4; ++j) { y[2 * j] = __uint_as_float(yw[j] << 16); y[2 * j + 1] = __uint_as_float(yw[j] & 0xffff0000u); }
#pragma unroll
                    for (int j = 0; j < 4; ++j) { g[j] = 1.f / (1.f + __expf(-v0[j])); g[4 + j] = 1.f / (1.f + __expf(-v1[j])); }
                    u32x4 w; w.x = cvt_pk_bf16(y[0] * g[0], y[1] * g[1]); w.y = cvt_pk_bf16(y[2] * g[2], y[3] * g[3]); w.z = cvt_pk_bf16(y[4] * g[4], y[5] * g[5]); w.w = cvt_pk_bf16(y[6] * g[6], y[7] * g[7]);
                    *(u32x4*)(O + (size_t)row * ldo + ooff + col0 + bj * HALF) = w; } }
    }
};
struct EpiGluGate {
    static constexpr bool PERM = true, AFTER_DRAIN = true;
    const bf16_t* Y; const bf16_t* Pz; bf16_t* G;
    __device__ __forceinline__ void fused(const f32x4 (&acc)[2][2][4][2], const Unit& u, int wr, int wc, int fr, int fq, PG8_LAS unsigned char* lds, int wid, int lane) const {
        constexpr int TS = 528;
        const int row0 = wr * 64 + fr, col0 = wc * 32 + 8 * fq;
#pragma unroll
        for (int ai = 0; ai < 2; ++ai)
#pragma unroll
            for (int m = 0; m < 4; ++m) { const int rl = row0 + ai * HALF + m * 16; const size_t grow = (size_t)u.pm * BM + rl;
#pragma unroll
                for (int bj = 0; bj < 2; ++bj) { const f32x4 v0 = acc[ai][bj][m][0], v1 = acc[ai][bj][m][1];
                    const u32x4 yw = *(const u32x4*)(Y + grow * 512 + u.pn * BM + col0 + bj * HALF);
                    float y[8], g[8];
#pragma unroll
                    for (int j = 0; j < 4; ++j) { y[2 * j] = __uint_as_float(yw[j] << 16); y[2 * j + 1] = __uint_as_float(yw[j] & 0xffff0000u); }
#pragma unroll
                    for (int j = 0; j < 4; ++j) { g[j] = 1.f / (1.f + __expf(-v0[j])); g[4 + j] = 1.f / (1.f + __expf(-v1[j])); }
                    u32x4 w; w.x = cvt_pk_bf16(y[0] * g[0], y[1] * g[1]); w.y = cvt_pk_bf16(y[2] * g[2], y[3] * g[3]); w.z = cvt_pk_bf16(y[4] * g[4], y[5] * g[5]); w.w = cvt_pk_bf16(y[6] * g[6], y[7] * g[7]);
                    *(PG8_LAS u32x4*)(lds + rl * TS + (col0 + bj * HALF) * 2) = w; } }
        __syncthreads();
        { const int t = wid * 64 + lane, row = t >> 1, hd = t & 1; const PG8_LAS unsigned char* src = lds + row * TS + hd * 256;
          float ss = 0.f;
#pragma unroll
          for (int i = 0; i < 16; ++i) { const u32x4 w = *(const PG8_LAS u32x4*)(src + 16 * i);
#pragma unroll
              for (int j = 0; j < 4; ++j) { const float a = __uint_as_float(w[j] << 16), b = __uint_as_float(w[j] & 0xffff0000u); ss += a * a + b * b; } }
          const float rn = rsqrtf(ss * (1.f / 128.f) + 1e-6f);
          const size_t grow = (size_t)u.pm * BM + row; const int cb = u.pn * BM + hd * 128;
          const bf16_t* zp = Pz + grow * 6144 + 2064 + cb; bf16_t* gp = G + grow * 2048 + 512 + cb;
#pragma unroll
          for (int i = 0; i < 16; ++i) { const u32x4 w = *(const PG8_LAS u32x4*)(src + 16 * i); const u32x4 zw = *(const u32x4*)(zp + 8 * i); u32x4 o;
#pragma unroll
              for (int j = 0; j < 4; ++j) { const float a = __uint_as_float(w[j] << 16), b = __uint_as_float(w[j] & 0xffff0000u), za = __uint_as_float(zw[j] << 16), zb = __uint_as_float(zw[j] & 0xffff0000u);
                  o[j] = cvt_pk_bf16(a * rn * (za / (1.f + __expf(-za))), b * rn * (zb / (1.f + __expf(-zb)))); }
              *(u32x4*)(gp + 8 * i) = o; } }
        __syncthreads();
    }
};
struct EpiBf16Scale {
    static constexpr bool PERM = true, AFTER_DRAIN = false;
    bf16_t* O; int ldc; const float* ssq;
    __device__ __forceinline__ void operator()(const f32x4 (&acc)[2][2][4][2], const Unit& u, int wr, int wc, int fr, int fq) const {
        const int row0 = u.pm * BM + wr * 64 + fr, col0 = u.pn * BM + wc * 32 + 8 * fq;
#pragma unroll
        for (int ai = 0; ai < 2; ++ai)
#pragma unroll
            for (int m = 0; m < 4; ++m) { const int row = row0 + ai * HALF + m * 16; bf16_t* rowp = O + (size_t)row * ldc + col0;
                float ssum = 0.f; { const f32x4* sp_ = (const f32x4*)(ssq + (size_t)row * 32);
#pragma unroll
                    for (int q = 0; q < 8; ++q) { const f32x4 t4 = sp_[q]; ssum += (t4[0] + t4[1]) + (t4[2] + t4[3]); } }
                const float s = rsqrtf(ssum * (1.f / 2048.f) + 1e-6f);
#pragma unroll
                for (int bj = 0; bj < 2; ++bj) { const f32x4 v0 = acc[ai][bj][m][0] * s, v1 = acc[ai][bj][m][1] * s;
                    u32x4 w; w.x = cvt_pk_bf16(v0[0], v0[1]); w.y = cvt_pk_bf16(v0[2], v0[3]); w.z = cvt_pk_bf16(v1[0], v1[1]); w.w = cvt_pk_bf16(v1[2], v1[3]);
                    *(u32x4*)(rowp + bj * HALF) = w; } }
    }
};
struct EpiResidNext {
    static constexpr bool PERM = false, AFTER_DRAIN = false;
    const float* R; float* C; int ldc; bf16_t* XB; float* ssq;
    __device__ __forceinline__ void operator()(const f32x4 (&acc)[2][2][4][2], const Unit& u, int wr, int wc, int fr, int fq) const {
        const int row0 = u.pm * BM + wr * 64 + fr, col0 = u.pn * BM + wc * 32 + 4 * fq;
#pragma unroll
        for (int ai = 0; ai < 2; ++ai)
#pragma unroll
            for (int m = 0; m < 4; ++m) { const int row = row0 + ai * HALF + m * 16; const size_t off = (size_t)row * ldc + col0; float ss = 0.f;
#pragma unroll
                for (int bj = 0; bj < 2; ++bj)
#pragma unroll
                    for (int n = 0; n < 2; ++n) { const f32x4 r = *(const f32x4*)(R + off + bj * HALF + n * 16); const f32x4 v = acc[ai][bj][m][n] + r;
                        *(f32x4*)(C + off + bj * HALF + n * 16) = v;
                        if (XB) { u32x2 w; w.x = cvt_pk_bf16(v[0], v[1]); w.y = cvt_pk_bf16(v[2], v[3]); *(u32x2*)(XB + off + bj * HALF + n * 16) = w; }
                        ss += v[0] * v[0] + v[1] * v[1] + v[2] * v[2] + v[3] * v[3]; }
                if (ssq) { ss += shx(ss, 16); ss += shx(ss, 32); if (fq == 0) ssq[(size_t)row * 32 + u.pn * 4 + wc] = ss; } }
    }
};
template <class Epi, class Sched, bool STAMP = false>
__device__ __forceinline__ void gemm_phase(PG8_LAS unsigned char* lds, const Gemm g, const Sched& S, const Epi& E, unsigned long long* stamps) {
    const int tid = TIDX(), wid = __builtin_amdgcn_readfirstlane(tid >> 6), lane = tid & 63, wr = wid >> 2, wc = wid & 3, fr = lane & 15, fq = lane >> 4;
    const int K = g.K, nt = K / BK;
    int ts_lo = 0, ts_hi = 0, nts = 0; const unsigned long long rt_entry = STAMP ? (unsigned long long)wall_clock64() : 0ull;
#define PG8_STAMP() do { if (STAMP && wid == 0 && nts < 64) { const unsigned long long _c = (unsigned long long)clock64(); \
        ts_lo = (lane == nts) ? (int)(unsigned)_c : ts_lo; ts_hi = (lane == nts) ? (int)(unsigned)(_c >> 32) : ts_hi; ++nts; } } while (0)
    PG8_STAMP();
    unsigned voffA[2], voffB[2];
#pragma unroll
    for (int i = 0; i < 2; ++i) { int R, C; stage_rc(tid * 16 + i * 8192, R, C); const int Rb = Epi::PERM ? ((R & ~31) + perm32(R & 31)) : R;
        voffA[i] = (unsigned)(R * K + C) * 2u; voffB[i] = (unsigned)(Rb * K + C) * 2u; }
    const size_t kstep = (size_t)(BK * 2);
    const size_t hstep = (size_t)HALF * K * 2;
    const size_t tstep = 2 * hstep;
    const unsigned ldsw = (unsigned)wid * 1024u;
    const int aoff = lds_byte(wr * 64 + fr, fq * 8), boff = lds_byte(wc * 32 + fr, fq * 8);
#define PG8_SA(b, h) (((b) * 2 + (h)) * HTB)
#define PG8_SB(b, h) ((4 + (b) * 2 + (h)) * HTB)
#define PG8_STAGE(bufoff, gbase, voff) do { _Pragma("unroll") for (int _i = 0; _i < 2; ++_i) \
        __builtin_amdgcn_global_load_lds((const unsigned*)((const char*)(gbase) + (voff)[_i]), (PG8_LAS unsigned*)(lds + (bufoff) + ldsw + _i * 8192), 16, 0, 0); } while (0)
#define PG8_LDA(dst, b, h) do { _Pragma("unroll") for (int m = 0; m < 4; ++m) _Pragma("unroll") for (int k = 0; k < 2; ++k) dst[m][k] = *(const PG8_LAS bf16x8*)(lds + PG8_SA(b, h) + aoff + m * 2048 + k * 1024); } while (0)
#define PG8_LDB(dst, b, h) do { _Pragma("unroll") for (int n = 0; n < 2; ++n) _Pragma("unroll") for (int k = 0; k < 2; ++k) dst[n][k] = *(const PG8_LAS bf16x8*)(lds + PG8_SB(b, h) + boff + n * 2048 + k * 1024); } while (0)
#define PG8_MMA(ai, bj, At, Bt) do { __builtin_amdgcn_s_setprio(1); _Pragma("unroll") for (int m = 0; m < 4; ++m) _Pragma("unroll") for (int n = 0; n < 2; ++n) _Pragma("unroll") for (int k = 0; k < 2; ++k) \
        acc[ai][bj][m][n] = __builtin_amdgcn_mfma_f32_16x16x32_bf16(Bt[n][k], At[m][k], acc[ai][bj][m][n], 0, 0, 0); __builtin_amdgcn_s_setprio(0); } while (0)
#define PG8_WAIT_V(n) asm volatile("s_waitcnt vmcnt(" #n ")" ::: "memory")
#define PG8_WAIT_L(n) asm volatile("s_waitcnt lgkmcnt(" #n ")" ::: "memory")
#define PG8_BAR __builtin_amdgcn_s_barrier()
#define PG8_SCHED __builtin_amdgcn_sched_barrier(0)
    Unit cur, nxt; int ui = 0;
    if (!S.next(0, cur)) return;
    f32x4 acc[2][2][4][2];
#pragma unroll
    for (int a = 0; a < 2; ++a)
#pragma unroll
        for (int b = 0; b < 2; ++b)
#pragma unroll
            for (int m = 0; m < 4; ++m)
#pragma unroll
                for (int n = 0; n < 2; ++n) acc[a][b][m][n] = (f32x4){0.f, 0.f, 0.f, 0.f};
    bf16x8 At[4][2], B0[2][2], B1[2][2];
    const char* cA = (const char*)g.A + (size_t)cur.pm * tstep; const char* cB = (const char*)g.Bt + (size_t)cur.pn * tstep;
    S.a_ready(cur);
    PG8_STAGE(PG8_SB(0, 0), cB, voffB); PG8_STAGE(PG8_SA(0, 0), cA, voffA); PG8_STAGE(PG8_SB(0, 1), cB + hstep, voffB); PG8_STAGE(PG8_SA(0, 1), cA + hstep, voffA);
    if (wr == 1) PG8_BAR;
    PG8_WAIT_V(4); PG8_BAR;
    PG8_STAGE(PG8_SB(1, 0), cB + kstep, voffB); PG8_STAGE(PG8_SA(1, 0), cA + kstep, voffA); PG8_STAGE(PG8_SB(1, 1), cB + hstep + kstep, voffB);
    PG8_WAIT_V(6); PG8_BAR;
    PG8_STAMP();
    for (;;) {
        const bool has_next = S.next(ui + 1, nxt);
        const char* nA = has_next ? (const char*)g.A + (size_t)nxt.pm * tstep : cA; const char* nB = has_next ? (const char*)g.Bt + (size_t)nxt.pn * tstep : cB;
        for (int t = 0; t < nt; t += 2) {
            const bool last = (t == nt - 2);
            const char* a1 = cA + (size_t)(t + 1) * kstep;
            const char* a2 = last ? nA : cA + (size_t)(t + 2) * kstep; const char* b2 = last ? nB : cB + (size_t)(t + 2) * kstep;
            const char* a3 = a2 + kstep; const char* b3 = b2 + kstep;
            if (last && has_next) S.a_ready(nxt);
            PG8_LDB(B0, 0, 0); PG8_SCHED; PG8_LDA(At, 0, 0); PG8_STAGE(PG8_SA(1, 1), a1 + hstep, voffA);
            PG8_WAIT_L(8); PG8_BAR; PG8_WAIT_L(0); PG8_MMA(0, 0, At, B0); PG8_BAR; PG8_SCHED;
            PG8_LDB(B1, 0, 1); PG8_STAGE(PG8_SB(0, 0), b2, voffB);
            PG8_BAR; PG8_WAIT_L(0); PG8_MMA(0, 1, At, B1); PG8_BAR;
            PG8_LDA(At, 0, 1); PG8_STAGE(PG8_SA(0, 0), a2, voffA);
            PG8_BAR; PG8_WAIT_L(0); PG8_MMA(1, 0, At, B0); PG8_BAR; PG8_SCHED;
            PG8_STAGE(PG8_SB(0, 1), b2 + hstep, voffB);
            PG8_WAIT_V(6); PG8_BAR; PG8_MMA(1, 1, At, B1); PG8_BAR;
            PG8_LDB(B0, 1, 0); PG8_SCHED; PG8_LDA(At, 1, 0); PG8_STAGE(PG8_SA(0, 1), a2 + hstep, voffA);
            PG8_WAIT_L(8); PG8_BAR; PG8_WAIT_L(0); PG8_MMA(0, 0, At, B0); PG8_BAR; PG8_SCHED;
            PG8_LDB(B1, 1, 1); PG8_STAGE(PG8_SB(1, 0), b3, voffB);
            PG8_BAR; PG8_WAIT_L(0); PG8_MMA(0, 1, At, B1); PG8_BAR;
            PG8_LDA(At, 1, 1); PG8_STAGE(PG8_SA(1, 0), a3, voffA);
            PG8_BAR; PG8_WAIT_L(0); PG8_MMA(1, 0, At, B0); PG8_BAR; PG8_SCHED;
            PG8_STAGE(PG8_SB(1, 1), b3 + hstep, voffB);
            PG8_WAIT_V(6); PG8_BAR; PG8_MMA(1, 1, At, B1); PG8_BAR;
        }
        PG8_STAMP();
        if constexpr (!Epi::AFTER_DRAIN) { E(acc, cur, wr, wc, fr, fq); S.done(cur); }
        PG8_STAMP();
        if (!has_next) break;
#pragma unroll
        for (int a = 0; a < 2; ++a)
#pragma unroll
            for (int b = 0; b < 2; ++b)
#pragma unroll
                for (int m = 0; m < 4; ++m)
#pragma unroll
                    for (int n = 0; n < 2; ++n) acc[a][b][m][n] = (f32x4){0.f, 0.f, 0.f, 0.f};
        cur = nxt; cA = nA; cB = nB; ++ui;
    }
    PG8_WAIT_V(0);
    if (wr == 0) PG8_BAR;
    PG8_BAR;
    if constexpr (Epi::AFTER_DRAIN) { E.fused(acc, cur, wr, wc, fr, fq, lds, wid, lane); S.done(cur); }
    PG8_STAMP();
    if (STAMP && wid == 0) { stamps[lane] = lane < nts ? (((unsigned long long)(unsigned)ts_hi << 32) | (unsigned)ts_lo) : 0ull;
        if (lane == 62) stamps[62] = rt_entry; if (lane == 63) stamps[63] = (unsigned long long)wall_clock64(); }
#undef PG8_STAMP
#undef PG8_SA
#undef PG8_SB
#undef PG8_STAGE
#undef PG8_LDA
#undef PG8_LDB
#undef PG8_MMA
#undef PG8_WAIT_V
#undef PG8_WAIT_L
#undef PG8_BAR
#undef PG8_SCHED
}
}
namespace att {
constexpr int D = 128, NW = 8, QBLK = 32, KVBLK = 64;
constexpr float SCALE = 0.088388347648318440f, THR = 8.f;
constexpr int SHM_V = KVBLK * D * 2, SHM_K = KVBLK * D * 2, SHM_ATTN = 2 * SHM_V + 2 * SHM_K + NW * 64 * 4;
#define KSWZ(row, colB) ((row) * 256 + ((colB) ^ (((row) & 7) << 4)))
#define SBAR() __builtin_amdgcn_sched_barrier(0)
__device__ __forceinline__ int crow(int r, int hi) { return (r & 3) + 8 * (r >> 2) + 4 * hi; }
__device__ __forceinline__ unsigned cvtpk(float lo, float hi) { unsigned r; asm volatile("v_cvt_pk_bf16_f32 %0, %1, %2" : "=v"(r) : "v"(lo), "v"(hi)); return r; }

template <bool MASKED>
__device__ __forceinline__ void partialSM(f32x16& p0, f32x16& p1, float& m_reg, float& mn, float& alpha, unsigned long long mw, int hi) {
  constexpr float C = SCALE * 1.4426950408889634f;
  if (MASKED) {
    const unsigned w0 = (unsigned)mw >> (4 * hi), w1 = (unsigned)(mw >> 32) >> (4 * hi);
    const float ninf = -__builtin_inff();
#pragma unroll
    for (int r = 0; r < 16; ++r) { const int bit = (r & 3) + 8 * (r >> 2);
      p0[r] = ((w0 >> bit) & 1u) ? p0[r] : ninf; p1[r] = ((w1 >> bit) & 1u) ? p1[r] : ninf; }
  }
  float pmax = p0[0];
#pragma unroll
  for (int r = 1; r < 16; ++r) pmax = fmaxf(pmax, p0[r]);
#pragma unroll
  for (int r = 0; r < 16; ++r) pmax = fmaxf(pmax, p1[r]);
  { auto rr = __builtin_amdgcn_permlane32_swap(__float_as_uint(pmax), __float_as_uint(pmax), false, false);
    pmax = fmaxf(__uint_as_float(rr[0]), __uint_as_float(rr[1])); }
  if (__builtin_expect(__all(pmax - m_reg <= THR / SCALE), 1)) { mn = m_reg; alpha = 1.f; }
  else { mn = fmaxf(m_reg, pmax); alpha = __builtin_amdgcn_exp2f((m_reg - mn) * C); m_reg = mn; }
  const float mnC = -mn * C;
#pragma unroll
  for (int r = 0; r < 16; ++r) p0[r] = fmaf(p0[r], C, mnC);
#pragma unroll
  for (int r = 0; r < 16; ++r) p1[r] = fmaf(p1[r], C, mnC);
#pragma unroll
  for (int r = 0; r < 16; ++r) p0[r] = __builtin_amdgcn_exp2f(p0[r]);
}
__device__ __forceinline__ void finishSM(f32x16& p0, f32x16& p1, float alpha, float& l_reg, bf16x8& pa0, bf16x8& pa1, bf16x8& pa2, bf16x8& pa3) {
#pragma unroll
  for (int r = 0; r < 16; ++r) p1[r] = __builtin_amdgcn_exp2f(p1[r]);
  float ps = 0;
#pragma unroll
  for (int r = 0; r < 16; ++r) ps += p0[r];
#pragma unroll
  for (int r = 0; r < 16; ++r) ps += p1[r];
  { auto rr = __builtin_amdgcn_permlane32_swap(__float_as_uint(ps), __float_as_uint(ps), false, false);
    ps = __uint_as_float(rr[0]) + __uint_as_float(rr[1]); }
  l_reg = l_reg * alpha + ps;
#define PK4(P, BASE, OUT) do { unsigned a0 = cvtpk(P[BASE + 0], P[BASE + 1]), a1 = cvtpk(P[BASE + 2], P[BASE + 3]);   \
    unsigned b0 = cvtpk(P[BASE + 4], P[BASE + 5]), b1 = cvtpk(P[BASE + 6], P[BASE + 7]);                              \
    auto r0 = __builtin_amdgcn_permlane32_swap(a0, b0, false, false); auto r1 = __builtin_amdgcn_permlane32_swap(a1, b1, false, false); \
    u32x4 w = {r0[0], r1[0], r0[1], r1[1]}; OUT = *reinterpret_cast<bf16x8*>(&w); } while (0)
  PK4(p0, 0, pa0); PK4(p0, 8, pa1); PK4(p1, 0, pa2); PK4(p1, 8, pa3);
#undef PK4
}
__device__ __forceinline__ void qkt(f32x16& p0, f32x16& p1, const char* Ks, const bf16x8* qr, int r32, int hi) {
  p0 = f32x16{}; p1 = f32x16{};
  asm volatile("" : "+v"(p0), "+v"(p1));
#pragma unroll
  for (int d0 = 0; d0 < 8; ++d0) { const int cb = (d0 * 16 + hi * 8) * 2;
    bf16x8 b0 = *reinterpret_cast<const bf16x8*>(Ks + KSWZ(r32, cb));
    bf16x8 b1 = *reinterpret_cast<const bf16x8*>(Ks + KSWZ(32 + r32, cb));
    p0 = __builtin_amdgcn_mfma_f32_32x32x16_bf16(b0, qr[d0], p0, 0, 0, 0);
    p1 = __builtin_amdgcn_mfma_f32_32x32x16_bf16(b1, qr[d0], p1, 0, 0, 0); }
}
__device__ __forceinline__ int v_st(int k, int c) { const int kk = (k & ~0xC) | ((k & 4) << 1) | ((k & 8) >> 1); return ((kk >> 3) * 4 + (c >> 5)) * 512 + ((kk & 7) * 32 + (c & 31)) * 2; }
__device__ __forceinline__ int v_rd_base(int lane) { return ((lane & 3) << 3) | (((lane >> 2) & 3) << 6) | (((lane >> 4) & 1) << 5) | (((lane >> 5) & 1) << 8); }
constexpr int v_rd_off(int d0, int ks, int half) { return d0 * 512 + ks * 4096 + half * 2048; }
template <int OFF> __device__ __forceinline__ s16x4 tr_read(int vb) {
  s16x4 r; asm volatile("ds_read_b64_tr_b16 %0, %1 offset:%2" : "=&v"(r) : "v"(vb), "i"(OFF) : "memory"); return r;
}
template <int D0> __device__ __forceinline__ void pv_one(f32x16& od, int vb, bf16x8 pa0, bf16x8 pa1, bf16x8 pa2, bf16x8 pa3) {
  const s16x4 l0 = tr_read<v_rd_off(D0, 0, 0)>(vb), h0 = tr_read<v_rd_off(D0, 0, 1)>(vb), l1 = tr_read<v_rd_off(D0, 1, 0)>(vb), h1 = tr_read<v_rd_off(D0, 1, 1)>(vb);
  const s16x4 l2 = tr_read<v_rd_off(D0, 2, 0)>(vb), h2 = tr_read<v_rd_off(D0, 2, 1)>(vb), l3 = tr_read<v_rd_off(D0, 3, 0)>(vb), h3 = tr_read<v_rd_off(D0, 3, 1)>(vb);
  asm volatile("s_waitcnt lgkmcnt(0)" ::: "memory"); SBAR();
#define PK(L, H) (bf16x8){L[0], L[1], L[2], L[3], H[0], H[1], H[2], H[3]}
  od = __builtin_amdgcn_mfma_f32_32x32x16_bf16(pa0, PK(l0, h0), od, 0, 0, 0);
  od = __builtin_amdgcn_mfma_f32_32x32x16_bf16(pa1, PK(l1, h1), od, 0, 0, 0);
  od = __builtin_amdgcn_mfma_f32_32x32x16_bf16(pa2, PK(l2, h2), od, 0, 0, 0);
  od = __builtin_amdgcn_mfma_f32_32x32x16_bf16(pa3, PK(l3, h3), od, 0, 0, 0);
#undef PK
}
__device__ __forceinline__ void pv_d0(f32x16* o, int vb, bf16x8 pa0, bf16x8 pa1, bf16x8 pa2, bf16x8 pa3) {
  pv_one<0>(o[0], vb, pa0, pa1, pa2, pa3); pv_one<1>(o[1], vb, pa0, pa1, pa2, pa3); pv_one<2>(o[2], vb, pa0, pa1, pa2, pa3); pv_one<3>(o[3], vb, pa0, pa1, pa2, pa3);
}

template <bool MASKED, int LDK, int VOFF, class OutRow>
__device__ __forceinline__ void attn_body(const bf16_t* __restrict__ Qw, const bf16_t* __restrict__ Kh, int NT,
                                          const unsigned long long* __restrict__ mbase, unsigned moff, const OutRow& Ow, char* lds) {
  const int tid = TIDX(), wid = tid >> 6, lane = tid & 63, r32 = lane & 31, hi = lane >> 5;
  char* V_lds = lds; char* K_lds = lds + 2 * SHM_V;
  float* ws = (float*)(lds + 2 * SHM_V + 2 * SHM_K) + wid * 64; float* li_l = ws; float* al_l = ws + 32;
  float m_reg = -1e30f, l_reg = 0; f32x16 o[4] = {}; bf16x8 qr[8];
  asm volatile("" : "+v"(o[0]), "+v"(o[1]), "+v"(o[2]), "+v"(o[3]));
#pragma unroll
  for (int d0 = 0; d0 < 8; ++d0) qr[d0] = *reinterpret_cast<const bf16x8*>(Qw + d0 * 16);
  const int sr = tid >> 4, sc = (tid & 15) * 8, vst0 = v_st(sr, sc), vst1 = v_st(32 + sr, sc);
  const int vb0 = (int)(uintptr_t)V_lds + v_rd_base(lane);
  struct { bf16x8 vs0, vs1, ks0, ks1; } sr_[2];
  const unsigned koff = (unsigned)(sr * LDK + sc) * 2u;
#define SLOAD(i, k0) do { const char* kb_ = (const char*)Kh + (size_t)(k0) * (LDK * 2); \
    sr_[i].vs0 = *reinterpret_cast<const bf16x8*>(kb_ + koff + VOFF * 2); sr_[i].vs1 = *reinterpret_cast<const bf16x8*>(kb_ + koff + (32 * LDK + VOFF) * 2); \
    sr_[i].ks0 = *reinterpret_cast<const bf16x8*>(kb_ + koff); sr_[i].ks1 = *reinterpret_cast<const bf16x8*>(kb_ + koff + 32 * LDK * 2); } while (0)
#define SWRITE(b, i) do { *(bf16x8*)(V_lds + (b) * SHM_V + vst0) = sr_[i].vs0;          \
    *(bf16x8*)(V_lds + (b) * SHM_V + vst1) = sr_[i].vs1; int kc = sc * 2;               \
    *(bf16x8*)(K_lds + (b) * SHM_K + KSWZ(sr, kc)) = sr_[i].ks0;                       \
    *(bf16x8*)(K_lds + (b) * SHM_K + KSWZ(32 + sr, kc)) = sr_[i].ks1; } while (0)
#define SWAIT() asm volatile("s_waitcnt vmcnt(4)" ::: "memory")
#define RESC(a) do { if (__any((a) < 1.f)) { if (hi == 0) al_l[r32] = (a); asm volatile("s_waitcnt lgkmcnt(0)" ::: "memory"); \
    _Pragma("unroll") for (int d = 0; d < 4; ++d) _Pragma("unroll") for (int r = 0; r < 16; ++r) o[d][r] *= al_l[crow(r, hi)]; } } while (0)
  f32x16 pA0, pA1, pB0, pB1; float mnA, mnB, alA, alB; bf16x8 pa0, pa1, pa2, pa3;
  unsigned long long mw = 0ull;
  constexpr int SE = 0, SO = 1;
  SLOAD(SE, 0); asm volatile("s_waitcnt vmcnt(0)" ::: "memory"); SWRITE(0, SE); __syncthreads();
  if (MASKED) mw = *(const unsigned long long*)((const char*)mbase + moff);
  qkt(pA0, pA1, K_lds, qr, r32, hi); partialSM<MASKED>(pA0, pA1, m_reg, mnA, alA, mw, hi);
  SLOAD(SO, KVBLK); if (2 < NT) SLOAD(SE, 2 * KVBLK);
  if (2 < NT) SWAIT(); else asm volatile("s_waitcnt vmcnt(0)" ::: "memory");
  SWRITE(1, SO); __syncthreads();
  for (int j = 1; j + 1 < NT; j += 2) {
    if (MASKED) mw = *(const unsigned long long*)((const char*)mbase + (moff + 8u * (unsigned)j));
    SBAR(); qkt(pB0, pB1, K_lds + SHM_K, qr, r32, hi);
    finishSM(pA0, pA1, alA, l_reg, pa0, pa1, pa2, pa3); SBAR();
    SLOAD(SO, (j + 2) * KVBLK); SBAR();
    pv_d0(o, vb0, pa0, pa1, pa2, pa3); partialSM<MASKED>(pB0, pB1, m_reg, mnB, alB, mw, hi);
    if (MASKED) mw = *(const unsigned long long*)((const char*)mbase + (moff + 8u * (unsigned)(j + 1)));
    __syncthreads(); SWAIT(); SWRITE(0, SE);
    RESC(alB); __syncthreads();
    SBAR(); qkt(pA0, pA1, K_lds, qr, r32, hi);
    finishSM(pB0, pB1, alB, l_reg, pa0, pa1, pa2, pa3); SBAR();
    if (j + 3 < NT) SLOAD(SE, (j + 3) * KVBLK); SBAR();
    pv_d0(o, vb0 + SHM_V, pa0, pa1, pa2, pa3); partialSM<MASKED>(pA0, pA1, m_reg, mnA, alA, mw, hi);
    __syncthreads(); if (j + 3 < NT) SWAIT(); else asm volatile("s_waitcnt vmcnt(0)" ::: "memory");
    SWRITE(1, SO);
    RESC(alA); __syncthreads();
  }
  if (MASKED) mw = *(const unsigned long long*)((const char*)mbase + (moff + 8u * (unsigned)(NT - 1)));
  SBAR(); qkt(pB0, pB1, K_lds + SHM_K, qr, r32, hi);
  finishSM(pA0, pA1, alA, l_reg, pa0, pa1, pa2, pa3); SBAR();
  pv_d0(o, vb0, pa0, pa1, pa2, pa3); partialSM<MASKED>(pB0, pB1, m_reg, mnB, alB, mw, hi);
  __syncthreads(); RESC(alB);
  finishSM(pB0, pB1, alB, l_reg, pa0, pa1, pa2, pa3); SBAR();
  pv_d0(o, vb0 + SHM_V, pa0, pa1, pa2, pa3);
  if (hi == 0) li_l[r32] = l_reg; asm volatile("s_waitcnt lgkmcnt(0)" ::: "memory");
  float rli[16];
#pragma unroll
  for (int r = 0; r < 16; ++r) rli[r] = __builtin_amdgcn_rcpf(li_l[crow(r, hi)]);
  __syncthreads();
  float* og_s = (float*)lds + wid * (32 * 132);
#pragma unroll
  for (int r = 0; r < 16; ++r) {
#pragma unroll
    for (int d0 = 0; d0 < 4; ++d0) og_s[crow(r, hi) * 132 + d0 * 32 + r32] = o[d0][r] * rli[r]; }
  asm volatile("" ::: "memory");
  { const int row = lane >> 1, half = lane & 1; const float* src = og_s + row * 132 + half * 64;
    f32x4 v[16]; float ss = 0.f;
#pragma unroll
    for (int i = 0; i < 16; ++i) { v[i] = *(const f32x4*)(src + 4 * i); ss += v[i][0] * v[i][0] + v[i][1] * v[i][1] + v[i][2] * v[i][2] + v[i][3] * v[i][3]; }
    ss += shx(ss, 1);
    const float rn = rsqrtf(ss * (1.f / 128.f) + EPS);
    const bf16_t* zp = Ow.zrow(row) + half * 64; bf16_t* gp = Ow.grow(row) + half * 64;
#pragma unroll
    for (int i = 0; i < 8; ++i) { float z[8], g[8]; ld8f(zp + 8 * i, z);
#pragma unroll
      for (int q = 0; q < 4; ++q) { g[q] = v[2 * i][q] * rn * siluf_(z[q]); g[4 + q] = v[2 * i + 1][q] * rn * siluf_(z[4 + q]); }
      st8f(gp + 8 * i, g); } }
  __syncthreads();
#undef SLOAD
#undef SWRITE
#undef SWAIT
#undef RESC
}
}
constexpr size_t al256(size_t x) { return (x + 255) / 256 * 256; }
constexpr size_t WS_CTL   = 0;
constexpr size_t CTL_BYTES = 65536;
constexpr size_t WS_WINT  = WS_CTL + CTL_BYTES;
constexpr size_t WS_WOUTT = WS_WINT + al256((size_t)DEPTH * NPAD * DM * 2);
constexpr size_t WS_WKVT  = WS_WOUTT + al256((size_t)DEPTH * DM * MIX * 2);
constexpr size_t WS_WGLUT = WS_WKVT + al256((size_t)DEPTH * 1024 * DM * 2);
constexpr size_t WS_MEMN  = WS_WGLUT + al256((size_t)DEPTH * 512 * 512 * 2);
constexpr size_t WS_KVMEM = WS_MEMN + al256((size_t)NB * MEML * DM * 2);
constexpr size_t WS_XN    = WS_KVMEM + al256((size_t)NB * MEML * DEPTH * 1024 * 2);
constexpr size_t WS_P     = WS_XN + al256((size_t)NTOK * DM * 2);
constexpr size_t WS_XBUF  = WS_P + al256((size_t)NTOK * NPAD * 2);
constexpr size_t WS_OCAT  = WS_XBUF + al256((size_t)NTOK * DM * 4);
constexpr size_t WS_MASK  = WS_OCAT + al256((size_t)NTOK * MIX * 2);
constexpr size_t WS_IW    = WS_MASK + al256((size_t)NTOK * 64 * 8);
constexpr size_t WS_YBUF  = WS_IW + al256((size_t)NTOK * 16 * 4);
constexpr size_t WS_ROPE  = WS_YBUF + al256((size_t)NTOK * 512 * 2);
constexpr size_t WS_S5P   = WS_ROPE + al256((size_t)NTOK * 48 * 4);
constexpr size_t S5P_BYTES = (size_t)DEPTH * 32 * (64 * 2 + 64 * 2 + 64 * 16 * 2) * 4;
constexpr size_t WS_GLAS  = WS_S5P + al256(S5P_BYTES);
constexpr size_t WS_GLAD  = WS_GLAS + al256((size_t)NB * 64 * 4 * 64 * 128 * 4);
constexpr size_t WS_IKC   = WS_GLAD + al256((size_t)NB * 64 * 4 * 64 * 4);
constexpr size_t WS_KVC   = WS_IKC + al256((size_t)NTOK * 64 * 2);
constexpr size_t WS_IQL   = WS_KVC + al256((size_t)NTOK * 256 * 2);
constexpr size_t WS_SSQ   = WS_IQL + al256((size_t)NTOK * 64 * 2);
constexpr size_t WS_END   = WS_SSQ + al256((size_t)DEPTH * NTOK * 32 * 4);

struct Params {
    const float* x; const float* mem; const int* pos; const float* ln_gain; const float* w_in; const float* gla_w_up; const float* gla_b_up;
    const float* s5_a_re; const float* s5_a_im; const float* s5_log_step; const float* s5_b_re; const float* s5_b_im; const float* s5_c_re; const float* s5_c_im;
    const float* s5_d; const float* s5_w_glu; const float* dsa_q_norm; const float* dsa_k_norm; const float* mem_norm; const float* w_mem_kv;
    const float* mem_q_norm; const float* mem_k_norm; const float* out_norm; const float* w_out;
    float* out;
    char* ws;
    __device__ __forceinline__ unsigned* ctl_() const { return (unsigned*)(ws + WS_CTL); }
    __device__ __forceinline__ bf16_t* WinT_() const { return (bf16_t*)(ws + WS_WINT); }
    __device__ __forceinline__ bf16_t* WoutT_() const { return (bf16_t*)(ws + WS_WOUTT); }
    __device__ __forceinline__ bf16_t* WkvT_() const { return (bf16_t*)(ws + WS_WKVT); }
    __device__ __forceinline__ bf16_t* WgluT_() const { return (bf16_t*)(ws + WS_WGLUT); }
    __device__ __forceinline__ bf16_t* memn_() const { return (bf16_t*)(ws + WS_MEMN); }
    __device__ __forceinline__ bf16_t* kvmem_() const { return (bf16_t*)(ws + WS_KVMEM); }
    __device__ __forceinline__ bf16_t* xn_() const { return (bf16_t*)(ws + WS_XN); }
    __device__ __forceinline__ bf16_t* p_() const { return (bf16_t*)(ws + WS_P); }
    __device__ __forceinline__ float* xbuf_() const { return (float*)(ws + WS_XBUF); }
    __device__ __forceinline__ bf16_t* ocat_() const { return (bf16_t*)(ws + WS_OCAT); }
    __device__ __forceinline__ unsigned long long* mask_() const { return (unsigned long long*)(ws + WS_MASK); }
    __device__ __forceinline__ float* iw_() const { return (float*)(ws + WS_IW); }
    __device__ __forceinline__ bf16_t* ybuf_() const { return (bf16_t*)(ws + WS_YBUF); }
    __device__ __forceinline__ float* rope_() const { return (float*)(ws + WS_ROPE); }
    __device__ __forceinline__ float* s5p_() const { return (float*)(ws + WS_S5P); }
    __device__ __forceinline__ float* glas_() const { return (float*)(ws + WS_GLAS); }
    __device__ __forceinline__ float* glad_() const { return (float*)(ws + WS_GLAD); }
    __device__ __forceinline__ bf16_t* ikc_() const { return (bf16_t*)(ws + WS_IKC); }
    __device__ __forceinline__ bf16_t* kvc_() const { return (bf16_t*)(ws + WS_KVC); }
    __device__ __forceinline__ float* ssq_() const { return (float*)(ws + WS_SSQ); }
    __device__ __forceinline__ bf16_t* iql_() const { return (bf16_t*)(ws + WS_IQL); }
};

__device__ __forceinline__ void transpose_tiles(const float* __restrict__ src, int K, int Nsrc, int Ndst, const float* __restrict__ scale, bf16_t* __restrict__ dst,
                                                int tile, float* lds_tile  ) {
    const int tid = TIDX(), ntn = Ndst / 64;
    const int tk = tile / ntn, tn = tile % ntn, k0 = tk * 64, n0 = tn * 64;
    __syncthreads();
    { const int ty = tid >> 4, tx = tid & 15;
#pragma unroll
      for (int i = 0; i < 2; ++i) { const int k = k0 + ty + 32 * i, n = n0 + 4 * tx;
        f32x4 v = (f32x4){0.f, 0.f, 0.f, 0.f};
        if (n < Nsrc) v = *(const f32x4*)(src + (size_t)k * Nsrc + n);
        const float s = scale ? scale[k] : 1.f;
        float* t = lds_tile + (ty + 32 * i) * 65 + 4 * tx; t[0] = v[0] * s; t[1] = v[1] * s; t[2] = v[2] * s; t[3] = v[3] * s; } }
    __syncthreads();
    { const int n = tid >> 3, kq = tid & 7;
      u32x4 w;
      w.x = pk2bf(lds_tile[(8 * kq + 0) * 65 + n], lds_tile[(8 * kq + 1) * 65 + n]); w.y = pk2bf(lds_tile[(8 * kq + 2) * 65 + n], lds_tile[(8 * kq + 3) * 65 + n]);
      w.z = pk2bf(lds_tile[(8 * kq + 4) * 65 + n], lds_tile[(8 * kq + 5) * 65 + n]); w.w = pk2bf(lds_tile[(8 * kq + 6) * 65 + n], lds_tile[(8 * kq + 7) * 65 + n]);
      *(u32x4*)(dst + (size_t)(n0 + n) * K + k0 + 8 * kq) = w; }
}

__device__ __forceinline__ void rmsnorm_rows(const float* __restrict__ X, bf16_t* __restrict__ Y, int nrows) {
    const int wid = TIDX() >> 6, lane = TIDX() & 63;
    for (int row = blockIdx.x * 8 + wid; row < nrows; row += gridDim.x * 8) {
        const float* xr = X + (size_t)row * DM; f32x4 v[8]; float ss = 0.f;
#pragma unroll
        for (int i = 0; i < 8; ++i) { v[i] = *(const f32x4*)(xr + 4 * lane + 256 * i); ss += v[i][0] * v[i][0] + v[i][1] * v[i][1] + v[i][2] * v[i][2] + v[i][3] * v[i][3]; }
        ss = wave_sum(ss); const float r = rsqrtf(ss * (1.f / DM) + EPS);
        bf16_t* yr = Y + (size_t)row * DM;
#pragma unroll
        for (int i = 0; i < 8; ++i) { u32x2 w; w.x = pk2bf(v[i][0] * r, v[i][1] * r); w.y = pk2bf(v[i][2] * r, v[i][3] * r); *(u32x2*)(yr + 4 * lane + 256 * i) = w; }
    }
}

__device__ __forceinline__ void rows_bf16_ssq(const float* __restrict__ X, bf16_t* __restrict__ Y, float* __restrict__ ssq, int nrows) {
    const int wid = TIDX() >> 6, lane = TIDX() & 63;
    for (int row = blockIdx.x * 8 + wid; row < nrows; row += gridDim.x * 8) {
        const float* xr = X + (size_t)row * DM; bf16_t* yr = Y + (size_t)row * DM; float ss = 0.f;
#pragma unroll
        for (int i = 0; i < 8; ++i) { const f32x4 v = *(const f32x4*)(xr + 4 * lane + 256 * i); ss += v[0] * v[0] + v[1] * v[1] + v[2] * v[2] + v[3] * v[3];
            u32x2 w; w.x = pk2bf(v[0], v[1]); w.y = pk2bf(v[2], v[3]); *(u32x2*)(yr + 4 * lane + 256 * i) = w; }
        ss = wave_sum(ss); if (lane < 32) ssq[(size_t)row * 32 + lane] = (lane == 0) ? ss : 0.f;
    }
}
__device__ __forceinline__ void phase_prologue1(const Params& P, char* lds) {
    float* tile = (float*)lds;
    constexpr int T_IN = (DM / 64) * (NPAD / 64), T_OUT = (MIX / 64) * (DM / 64), T_KV = (DM / 64) * (1024 / 64), T_GLU = 8 * 8;
    constexpr int TOT = DEPTH * (T_IN + T_OUT + T_KV + T_GLU);
    for (int u = blockIdx.x; u < TOT; u += gridDim.x) {
        int l = u / (T_IN + T_OUT + T_KV + T_GLU), r = u % (T_IN + T_OUT + T_KV + T_GLU);
        if (r < T_IN) transpose_tiles(P.w_in + (size_t)l * DM * NIN, DM, NIN, NPAD, P.ln_gain + l * DM, P.WinT_() + (size_t)l * NPAD * DM, r, tile);
        else if ((r -= T_IN) < T_OUT) transpose_tiles(P.w_out + (size_t)l * MIX * DM, MIX, DM, DM, P.out_norm + l * MIX, P.WoutT_() + (size_t)l * DM * MIX, r, tile);
        else if ((r -= T_OUT) < T_KV) transpose_tiles(P.w_mem_kv + (size_t)l * DM * 1024, DM, 1024, 1024, P.mem_norm + l * DM, P.WkvT_() + (size_t)l * 1024 * DM, r, tile);
        else { r -= T_KV; transpose_tiles(P.s5_w_glu + (size_t)l * 512 * 512, 512, 512, 512, nullptr, P.WgluT_() + (size_t)l * 512 * 512, r, tile); }
    }
    rmsnorm_rows(P.mem, P.memn_(), NB * MEML);
}
__device__ __forceinline__ void phase_rope_table(const Params& P) {
    for (int idx = blockIdx.x * NTHR + TIDX(); idx < NTOK * 24; idx += gridDim.x * NTHR) {
        const int tok = idx / 24, i = idx % 24;
        const float e = (i < 16) ? -((float)i * 2.0f / 32.0f) : -((float)(i - 16) * 2.0f / 16.0f);
        const float inv_freq = exp2f(e * 18.931568569324174f);
        const float ang = (float)P.pos[tok] * inv_freq;
        const double a = (double)ang; const double k = rint(a * 0.15915494309189535); const float rf = (float)fma(-k, 6.283185307179586, a);
        P.rope_()[(size_t)idx * 2] = cosf(rf); P.rope_()[(size_t)idx * 2 + 1] = sinf(rf);
    }
}

__device__ __forceinline__ void phase_rmsnorm_x(const Params& P, int layer) { rmsnorm_rows(layer == 0 ? P.x : P.xbuf_(), P.xn_(), NTOK); }

__device__ __forceinline__ void phase_memk_norm(const Params& P) {
    const int wid = TIDX() >> 6, lane = TIDX() & 63;
    for (int it = blockIdx.x * 8 + wid; it < NB * MEML * DEPTH * 4; it += gridDim.x * 8) {
        const int row = it / (DEPTH * 4), l = (it / 4) % DEPTH, h = it % 4;
        bf16_t* kp = P.kvmem_() + (size_t)row * (DEPTH * 1024) + l * 1024 + h * 128 + 2 * lane;
        const unsigned w = *(const unsigned*)kp; const float a = __uint_as_float(w << 16), b = __uint_as_float(w & 0xffff0000u);
        const float ss = wave_sum(a * a + b * b), r = rsqrtf(ss * (1.f / 128.f) + EPS);
        const float* g = P.mem_k_norm + l * 128 + 2 * lane;
        *(unsigned*)kp = pk2bf(a * r * g[0], b * r * g[1]);
    }
}

__device__ __forceinline__ float sum16(float v) { v += shx(v, 1); v += shx(v, 2); v += shx(v, 4); v += shx(v, 8); return v; }

__device__ __forceinline__ void head128_norm_rope_to(const bf16_t* hp, bf16_t* dp, int l16, const float* __restrict__ gain, const float* __restrict__ cs, bool rope, bool do_store) {
    float v[8]; ld8f(hp + 8 * l16, v);
    float ss = 0.f;
#pragma unroll
    for (int j = 0; j < 8; ++j) ss += v[j] * v[j];
    ss = sum16(ss); const float r = rsqrtf(ss * (1.f / 128.f) + EPS);
#pragma unroll
    for (int j = 0; j < 8; ++j) v[j] = v[j] * r * gain[8 * l16 + j];
    if (rope) {
        float o[8];
#pragma unroll
        for (int j = 0; j < 8; ++j) o[j] = shx(v[j], 2);
        if (l16 < 4) { const int fi = (l16 & 1) * 8;
#pragma unroll
            for (int j = 0; j < 8; ++j) { const float c = cs[(fi + j) * 2], s = cs[(fi + j) * 2 + 1];
                v[j] = (l16 < 2) ? (v[j] * c - o[j] * s) : (v[j] * c + o[j] * s); } }
    }
    if (do_store) st8f(dp + 8 * l16, v);
}
__device__ __forceinline__ void head128_norm_rope(bf16_t* hp, int l16, const float* __restrict__ gain, const float* __restrict__ cs, bool rope, bool do_store) { head128_norm_rope_to(hp, hp, l16, gain, cs, rope, do_store); }
__device__ __forceinline__ void rope16_inplace(bf16_t* ip, const float* __restrict__ cs) {
    float a[8], b[8]; ld8f(ip, a); ld8f(ip + 8, b);
#pragma unroll
    for (int j = 0; j < 8; ++j) { const float c = cs[2 * j], s = cs[2 * j + 1], x1 = a[j], x2 = b[j]; a[j] = x1 * c - x2 * s; b[j] = x2 * c + x1 * s; }
    st8f(ip, a); st8f(ip + 8, b);
}
__device__ __forceinline__ void phase_prep(const Params& P, int layer) {
    const int wid = TIDX() >> 6, lane = TIDX() & 63, l16 = lane & 15, grp = lane >> 4;
    for (int tok = blockIdx.x * 8 + wid; tok < NTOK; tok += gridDim.x * 8) {
        bf16_t* row = P.p_() + (size_t)tok * NPAD;
        const float* cs32 = P.rope_() + (size_t)tok * 48; const float* cs16 = cs32 + 32;
        head128_norm_rope(row + C_DQ + grp * 128, l16, P.dsa_q_norm + layer * 128, cs32, true, true);
        head128_norm_rope_to(row + C_DK, P.kvc_() + (size_t)tok * 256, l16, P.dsa_k_norm + layer * 128, cs32, true, grp == 0);
        head128_norm_rope(row + C_MQ + grp * 128, l16, P.mem_q_norm + layer * 128, cs32, false, true);
        if ((lane & 3) == 0) rope16_inplace(row + C_DIQ + lane * 16, cs16);
        if (lane < 4) {
            bf16_t* dst = P.ikc_() + (size_t)(tok >> 5) * 2048 + lane * 512 + (tok & 31) * 8;
            float a[8], b[8]; ld8f(row + C_DIK + lane * 16, a); ld8f(row + C_DIK + lane * 16 + 8, b);
            if (lane == 0) {
#pragma unroll
                for (int q = 0; q < 8; ++q) { const float c = cs16[2 * q], s = cs16[2 * q + 1], x1 = a[q], x2 = b[q]; a[q] = x1 * c - x2 * s; b[q] = x2 * c + x1 * s; } }
            st8f(dst, a); st8f(dst + 256, b); }
        if (lane >= 16 && lane < 32) { const u32x4 vv = *(const u32x4*)(row + C_DV + (lane - 16) * 8); *(u32x4*)(P.kvc_() + (size_t)tok * 256 + 128 + (lane - 16) * 8) = vv; }
        if (lane < 16) P.iw_()[(size_t)tok * 16 + lane] = bf2f(row[C_DIW + lane]) * (1.f / 32.f);
    }
}
struct MemOutRow { const bf16_t* zb; bf16_t* gb;
    __device__ __forceinline__ const bf16_t* zrow(int r) const { return zb + (size_t)r * NPAD; } __device__ __forceinline__ bf16_t* grow(int r) const { return gb + (size_t)r * MIX; } };
__device__ __forceinline__ void unit_mem_attn(const Params& P, int layer, int u, char* lds) {
    const int b = u >> 6, h = (u >> 4) & 3, qb = u & 15, tok0 = b * SEQ + qb * 256;
    const int wid = TIDX() >> 6, lane = TIDX() & 63, r32 = lane & 31, hi = lane >> 5;
    const bf16_t* Qw = P.p_() + (size_t)(tok0 + wid * 32 + r32) * NPAD + C_MQ + h * 128 + hi * 8;
    const bf16_t* Kh = P.kvmem_() + (size_t)(b * MEML) * (DEPTH * 1024) + layer * 1024 + h * 128;
    MemOutRow ow; ow.zb = P.p_() + (size_t)(tok0 + wid * 32) * NPAD + C_MZ + h * 128; ow.gb = P.xn_() + (size_t)(tok0 + wid * 32) * MIX + 1536 + h * 128;
    att::attn_body<false, DEPTH * 1024, 512, MemOutRow>(Qw, Kh, MEML / 64, nullptr, 0u, ow, lds);
}

__device__ __forceinline__ void phase_gate(const Params& P, int c_lo, int c_hi) {
    const int wid = TIDX() >> 6, lane = TIDX() & 63;
    const int c0 = lane * 32;
    const int seg = c0 >> 9, zc = (seg == 0 ? C_GZ : seg == 1 ? C_SZ : seg == 2 ? C_DZ : C_MZ) + (c0 & 511);
    const bool act = (c0 >= c_lo) && (c0 < c_hi);
    for (int tok = blockIdx.x * 8 + wid; tok < NTOK; tok += gridDim.x * 8) {
        if (!act) { bf16_t* gz_ = P.xn_() + (size_t)tok * MIX + c0; const u32x4 zz = {0u, 0u, 0u, 0u};
#pragma unroll
            for (int i = 0; i < 4; ++i) *(u32x4*)(gz_ + 8 * i) = zz;
            continue; }
        const bf16_t* op = P.ocat_() + (size_t)tok * MIX + c0; const bf16_t* zp = P.p_() + (size_t)tok * NPAD + zc; bf16_t* gp = P.xn_() + (size_t)tok * MIX + c0;
        float o[32]; float ss = 0.f;
#pragma unroll
        for (int i = 0; i < 4; ++i) { float v[8]; ld8f(op + 8 * i, v);
#pragma unroll
            for (int j = 0; j < 8; ++j) { o[8 * i + j] = v[j]; ss += v[j] * v[j]; } }
        ss += shx(ss, 1); ss += shx(ss, 2);
        const float r = rsqrtf(ss * (1.f / 128.f) + EPS);
#pragma unroll
        for (int i = 0; i < 4; ++i) { float z[8], g[8]; ld8f(zp + 8 * i, z);
#pragma unroll
            for (int j = 0; j < 8; ++j) g[j] = o[8 * i + j] * r * siluf_(z[j]);
            st8f(gp + 8 * i, g); }
    }
}

__device__ __forceinline__ void phase_gemm_in(const Params& P, int layer, char* lds) {
    pg8::Gemm g; g.A = P.xn_(); g.Bt = P.WinT_() + (size_t)layer * NPAD * DM; g.M = NTOK; g.N = NPAD; g.K = DM;
    pg8::StaticOrder S; S.init(g.M, g.N, (int)gridDim.x, (int)blockIdx.x);
    pg8::EpiBf16Plain E; E.O = P.p_(); E.ldc = NPAD;
    pg8::gemm_phase<pg8::EpiBf16Plain, pg8::StaticOrder, false>((PG8_LAS unsigned char*)lds, g, S, E, nullptr);
}
__device__ __forceinline__ void phase_gemm_out(const Params& P, int layer, char* lds) {
    pg8::Gemm g; g.A = P.xn_(); g.Bt = P.WoutT_() + (size_t)layer * DM * MIX; g.M = NTOK; g.N = DM; g.K = MIX;
    pg8::StaticOrder S; S.init(g.M, g.N, (int)gridDim.x, (int)blockIdx.x);
    pg8::EpiResid E; E.R = (layer == 0) ? P.x : P.xbuf_(); E.C = (layer == DEPTH - 1) ? P.out : P.xbuf_(); E.ldc = DM;
    pg8::gemm_phase<pg8::EpiResid, pg8::StaticOrder, false>((PG8_LAS unsigned char*)lds, g, S, E, nullptr);
}
__device__ __forceinline__ void phase_gemm_kv(const Params& P, char* lds) {
    pg8::Gemm g; g.A = P.memn_(); g.Bt = P.WkvT_(); g.M = NB * MEML; g.N = DEPTH * 1024; g.K = DM;
    pg8::StaticOrder S; S.init(g.M, g.N, (int)gridDim.x, (int)blockIdx.x);
    pg8::EpiBf16Plain E; E.O = P.kvmem_(); E.ldc = DEPTH * 1024;
    pg8::gemm_phase<pg8::EpiBf16Plain, pg8::StaticOrder, false>((PG8_LAS unsigned char*)lds, g, S, E, nullptr);
}
__device__ __forceinline__ void mma_tile(f32x16& acc, const char* A, int lda, const char* B, int ldb, int K, int lane) {
    const int r = lane & 31, kh = lane >> 5;
    const char* ap = A + r * lda + kh * 16; const char* bp = B + r * ldb + kh * 16;
    asm volatile("" : "+v"(acc));
    for (int k = 0; k < K; k += 16) {
        const bf16x8 a = *(const bf16x8*)(ap + k * 2); const bf16x8 b = *(const bf16x8*)(bp + k * 2);
        acc = __builtin_amdgcn_mfma_f32_32x32x16_bf16(a, b, acc, 0, 0, 0);
    }
}
__device__ __forceinline__ int crow32(int r, int hi) { return (r & 3) + 8 * (r >> 2) + 4 * hi; }
__device__ __forceinline__ float log_sigmoid_(float x) { return fminf(x, 0.f) - log1pf(__expf(-fabsf(x))); }

constexpr int GLA_ST = 144;
constexpr int GLA_ST2 = 272;
__device__ __forceinline__ void gla_front(const Params& P, int layer, int tok0, int h, float (&bv)[8], float* glr_s  , float* tot_s  , float* bm_s  , float* bl_s  ) {
    const int tid = TIDX(), d = tid & 63, tg = tid >> 6;
    __syncthreads();
    if (tid < 128) { const int t = tid >> 1, half = tid & 1; float v[8]; ld8f(P.p_() + (size_t)(tok0 + t) * NPAD + C_GLR + half * 8, v);
#pragma unroll
        for (int j = 0; j < 8; ++j) glr_s[t * 16 + half * 8 + j] = v[j]; }
    float wu[16];
#pragma unroll
    for (int r = 0; r < 16; ++r) wu[r] = P.gla_w_up[((size_t)layer * 16 + r) * 256 + h * 64 + d];
    const float bias = P.gla_b_up[layer * 256 + h * 64 + d];
    __syncthreads();
    float run = 0.f;
#pragma unroll
    for (int i = 0; i < 8; ++i) { const int t = tg * 8 + i; float a = bias;
#pragma unroll
        for (int r = 0; r < 16; ++r) a = fmaf(glr_s[t * 16 + r], wu[r], a);
        run += log_sigmoid_(a) * (1.f / 16.f); bv[i] = run; }
    tot_s[tg * 64 + d] = run;
    __syncthreads();
    float off = 0.f, all = 0.f;
#pragma unroll
    for (int g = 0; g < 8; ++g) { const float v = tot_s[g * 64 + d]; off += (g < tg) ? v : 0.f; all += v; }
#pragma unroll
    for (int i = 0; i < 8; ++i) bv[i] += off;
    if (tg == 4) bm_s[d] = bv[0];
    if (tg == 0) bl_s[d] = all;
    __syncthreads();
}

__device__ __forceinline__ void unit_gla_a(const Params& P, int layer, int u, char* lds) {
    const int b = u >> 8, n = (u >> 2) & 63, h = u & 3, tok0 = b * SEQ + n * 64;
    const int tid = TIDX(), wid = tid >> 6, lane = tid & 63, d = tid & 63, tg = tid >> 6;
    char* kdT = lds;
    char* vT = lds + 64 * GLA_ST;
    float* glr_s = (float*)(lds + 64 * GLA_ST + 128 * GLA_ST); float* tot_s = glr_s + 1024; float* bm_s = tot_s + 512; float* bl_s = bm_s + 64;
    float bv[8]; gla_front(P, layer, tok0, h, bv, glr_s, tot_s, bm_s, bl_s);
    const float bl = bl_s[d];
#pragma unroll
    for (int i = 0; i < 8; ++i) { const int t = tg * 8 + i; const float k = bf2f(P.p_()[(size_t)(tok0 + t) * NPAD + C_GK + h * 64 + d]);
        *(bf16_t*)(kdT + d * GLA_ST + t * 2) = f2bf(k * __expf(bl - bv[i])); }
    { const int e = tid & 127, sg = tid >> 7;
#pragma unroll
      for (int i = 0; i < 16; ++i) { const int s = sg * 16 + i; *(bf16_t*)(vT + e * GLA_ST + s * 2) = P.p_()[(size_t)(tok0 + s) * NPAD + C_GV + h * 128 + e]; } }
    __syncthreads();
    const int mt = wid >> 2, nt = wid & 3, hi = lane >> 5;
    f32x16 acc = {}; mma_tile(acc, kdT + mt * 32 * GLA_ST, GLA_ST, vT + nt * 32 * GLA_ST, GLA_ST, 64, lane);
    float* dst = P.glas_() + ((size_t)((b * 64 + n) * 4 + h)) * 64 * 128;
#pragma unroll
    for (int r = 0; r < 16; ++r) dst[(mt * 32 + crow32(r, hi)) * 128 + nt * 32 + (lane & 31)] = acc[r];
    if (tid < 64) P.glad_()[((size_t)((b * 64 + n) * 4 + h)) * 64 + tid] = __expf(bl_s[tid]);
}

__device__ __forceinline__ void gla_scan_slice(const Params& P, int idx) {
    {
        const int e = idx & 127, d = (idx >> 7) & 63, h = (idx >> 13) & 3, b = idx >> 15;
        float S = 0.f;
        for (int n0 = 0; n0 < 64; n0 += 8) {
            float ds[8], dc[8];
#pragma unroll
            for (int i = 0; i < 8; ++i) { const size_t cu = (size_t)((b * 64 + n0 + i) * 4 + h); ds[i] = P.glas_()[cu * 8192 + d * 128 + e]; dc[i] = P.glad_()[cu * 64 + d]; }
#pragma unroll
            for (int i = 0; i < 8; ++i) { const size_t cu = (size_t)((b * 64 + n0 + i) * 4 + h); P.glas_()[cu * 8192 + d * 128 + e] = S; S = fmaf(dc[i], S, ds[i]); }
        }
    }
}

__device__ __forceinline__ void unit_gla_c(const Params& P, int layer, int u, char* lds) {
    const int b = u >> 8, n = (u >> 2) & 63, h = u & 3, tok0 = b * SEQ + n * 64;
    const int tid = TIDX(), wid = tid >> 6, lane = tid & 63, d = tid & 63, tg = tid >> 6, hi = lane >> 5;
    char* Acat = lds;
    char* Bcat = Acat + 64 * GLA_ST2;
    char* qe = Bcat + 128 * GLA_ST2;
    char* ke = qe + 64 * GLA_ST;
    float* glr_s = (float*)(ke + 64 * GLA_ST); float* tot_s = glr_s + 1024; float* bm_s = tot_s + 512; float* bl_s = bm_s + 64;
    float* o_s = bl_s + 64;
    float bv[8]; gla_front(P, layer, tok0, h, bv, glr_s, tot_s, bm_s, bl_s);
    const float m = bm_s[d];
#pragma unroll
    for (int i = 0; i < 8; ++i) { const int t = tg * 8 + i; const bf16_t* row = P.p_() + (size_t)(tok0 + t) * NPAD;
        const float q = bf2f(row[C_GQ + h * 64 + d]) * 0.125f, k = bf2f(row[C_GK + h * 64 + d]);
        *(bf16_t*)(qe + t * GLA_ST + d * 2) = f2bf(q * __expf(bv[i] - m));
        *(bf16_t*)(ke + t * GLA_ST + d * 2) = f2bf(k * __expf(m - bv[i]));
        *(bf16_t*)(Acat + t * GLA_ST2 + (64 + d) * 2) = f2bf(q * __expf(bv[i])); }
    { const int e = tid & 127, sg = tid >> 7;
      const float* sp = P.glas_() + ((size_t)((b * 64 + n) * 4 + h)) * 64 * 128;
#pragma unroll
      for (int i = 0; i < 16; ++i) { const int s = sg * 16 + i;
          *(bf16_t*)(Bcat + e * GLA_ST2 + s * 2) = P.p_()[(size_t)(tok0 + s) * NPAD + C_GV + h * 128 + e];
          *(bf16_t*)(Bcat + e * GLA_ST2 + (64 + s) * 2) = f2bf(sp[s * 128 + e]); } }
    __syncthreads();
    if (wid < 4) { const int mt = wid >> 1, nt = wid & 1;
        f32x16 acc = {}; mma_tile(acc, qe + mt * 32 * GLA_ST, GLA_ST, ke + nt * 32 * GLA_ST, GLA_ST, 64, lane);
#pragma unroll
        for (int r = 0; r < 16; ++r) { const int t = mt * 32 + crow32(r, hi), s = nt * 32 + (lane & 31);
            *(bf16_t*)(Acat + t * GLA_ST2 + s * 2) = f2bf(s <= t ? acc[r] : 0.f); } }
    __syncthreads();
    { const int mt = wid >> 2, nt = wid & 3;
      f32x16 acc = {}; mma_tile(acc, Acat + mt * 32 * GLA_ST2, GLA_ST2, Bcat + nt * 32 * GLA_ST2, GLA_ST2, 128, lane);
#pragma unroll
      for (int r = 0; r < 16; ++r) { const int t = mt * 32 + crow32(r, hi); o_s[t * 132 + nt * 32 + (lane & 31)] = acc[r]; } }
    __syncthreads();
    { const int t = tid >> 3, e0 = (tid & 7) * 16; const float* src = o_s + t * 132 + e0;
      f32x4 v[4]; float ss = 0.f;
#pragma unroll
      for (int i = 0; i < 4; ++i) { v[i] = *(const f32x4*)(src + 4 * i); ss += v[i][0] * v[i][0] + v[i][1] * v[i][1] + v[i][2] * v[i][2] + v[i][3] * v[i][3]; }
      ss += shx(ss, 1); ss += shx(ss, 2); ss += shx(ss, 4);
      const float rn = rsqrtf(ss * (1.f / 128.f) + EPS);
      const bf16_t* zp = P.p_() + (size_t)(tok0 + t) * NPAD + C_GZ + h * 128 + e0; bf16_t* gp = P.xn_() + (size_t)(tok0 + t) * MIX + h * 128 + e0;
#pragma unroll
      for (int i = 0; i < 2; ++i) { float z[8], gg[8]; ld8f(zp + 8 * i, z);
#pragma unroll
          for (int q = 0; q < 4; ++q) { gg[q] = v[2 * i][q] * rn * siluf_(z[q]); gg[4 + q] = v[2 * i + 1][q] * rn * siluf_(z[4 + q]); }
          st8f(gp + 8 * i, gg); } }
}
constexpr int S5P_STRIDE = 2304;
__device__ __forceinline__ void phase_s5_params(const Params& P) {
    for (int idx = blockIdx.x * NTHR + TIDX(); idx < DEPTH * 32 * 64; idx += gridDim.x * NTHR) {
        const int p = idx & 63, lg = idx >> 6;
        const float ar = P.s5_a_re[idx], ai = P.s5_a_im[idx], step = expf(P.s5_log_step[lg]);
        const float mag = expf(ar * step), th = ai * step;
        const float lr = mag * cosf(th), li = mag * sinf(th);
        float* o = P.s5p_() + (size_t)lg * S5P_STRIDE;
        o[2 * p] = lr; o[2 * p + 1] = li;
        { const float mag512 = expf(512.f * ar * step); const double a = 512.0 * (double)th; const double k = rint(a * 0.15915494309189535); const float rf = (float)fma(-k, 6.283185307179586, a);
          o[128 + 2 * p] = mag512 * cosf(rf); o[128 + 2 * p + 1] = mag512 * sinf(rf); }
        const float xr = lr - 1.f, xi = li, den = 1.f / (ar * ar + ai * ai);
        const float fr = (xr * ar + xi * ai) * den, fi = (xi * ar - xr * ai) * den;
        for (int c = 0; c < 16; ++c) { const float br = P.s5_b_re[(size_t)idx * 16 + c], bi = P.s5_b_im[(size_t)idx * 16 + c];
            o[256 + (p * 16 + c) * 2] = fr * br - fi * bi; o[256 + (p * 16 + c) * 2 + 1] = fr * bi + fi * br; }
    }
}
__device__ __forceinline__ float gelu_tanh_(float x) { const float u = 0.7978845608028654f * (x + 0.044715f * x * x * x); const float e = __expf(-2.f * fabsf(u)); const float th = copysignf((1.f - e) / (1.f + e), u); return 0.5f * x * (1.f + th); }

constexpr int S5_XST = 272;
constexpr int S5_UST = 48;
__device__ __forceinline__ float partner32(float v, int hi) { auto rr = __builtin_amdgcn_permlane32_swap(__float_as_uint(v), __float_as_uint(v), false, false); return __uint_as_float(hi ? rr[0] : rr[1]); }
struct S5Ctx { float l0r, l0i, l1r, l1i, q0r, q0i, q1r, q1i, dsk; char* Cm; char* Bb; char* Xs; char* Us; int lane, hi, j, rho; const bf16_t* ubase; bf16_t* ybase; };
template <bool OUT> __device__ __forceinline__ void s5_tile(const S5Ctx& C, int tok0, float& x0r, float& x0i, float& x1r, float& x1i) {
    const int hi = C.hi, j = C.j, lane = C.lane;
    if (hi == 0) { const bf16_t* up = C.ubase + (size_t)(tok0 + j) * NPAD;
        const bf16x8 w0 = *(const bf16x8*)up, w1 = *(const bf16x8*)(up + 8);
        *(bf16x8*)(C.Us + C.rho * S5_UST) = w0; *(bf16x8*)(C.Us + C.rho * S5_UST + 16) = w1; }
    asm volatile("" ::: "memory");
    f32x16 a0 = {}, a1 = {}, a2 = {}, a3 = {};
    mma_tile(a0, C.Us, S5_UST, C.Bb, S5_UST, 16, lane); mma_tile(a1, C.Us, S5_UST, C.Bb + 32 * S5_UST, S5_UST, 16, lane);
    mma_tile(a2, C.Us, S5_UST, C.Bb + 64 * S5_UST, S5_UST, 16, lane); mma_tile(a3, C.Us, S5_UST, C.Bb + 96 * S5_UST, S5_UST, 16, lane);
    float s0r[16], s0i[16], s1r[16], s1i[16];
#pragma unroll
    for (int r = 0; r < 16; ++r) {
        const float n0r = fmaf(C.l0r, x0r, fmaf(-C.l0i, x0i, a0[r])), n0i = fmaf(C.l0r, x0i, fmaf(C.l0i, x0r, a1[r])); x0r = n0r; x0i = n0i; s0r[r] = n0r; s0i[r] = n0i;
        const float n1r = fmaf(C.l1r, x1r, fmaf(-C.l1i, x1i, a2[r])), n1i = fmaf(C.l1r, x1i, fmaf(C.l1i, x1r, a3[r])); x1r = n1r; x1i = n1i; s1r[r] = n1r; s1i[r] = n1i; }
    float z0r = partner32(x0r, hi), z0i = partner32(x0i, hi), z1r = partner32(x1r, hi), z1i = partner32(x1i, hi);
    if (hi == 0) { z0r = 0.f; z0i = 0.f; z1r = 0.f; z1i = 0.f; }
    if (!OUT) {
        x0r += C.q0r * z0r - C.q0i * z0i; x0i += C.q0r * z0i + C.q0i * z0r; x1r += C.q1r * z1r - C.q1i * z1i; x1i += C.q1r * z1i + C.q1i * z1r;
    } else {
#pragma unroll
        for (int r = 0; r < 16; ++r) {
            const float t0r = C.l0r * z0r - C.l0i * z0i, t0i = C.l0r * z0i + C.l0i * z0r; z0r = t0r; z0i = t0i; s0r[r] += t0r; s0i[r] += t0i;
            const float t1r = C.l1r * z1r - C.l1i * z1i, t1i = C.l1r * z1i + C.l1i * z1r; z1r = t1r; z1i = t1i; s1r[r] += t1r; s1i[r] += t1i; }
        x0r = s0r[15]; x0i = s0i[15]; x1r = s1r[15]; x1i = s1i[15];
#pragma unroll
        for (int r = 0; r < 16; ++r) { char* xr_ = C.Xs + (r + 16 * hi) * S5_XST;
            *(bf16_t*)(xr_ + j * 2) = f2bf(s0r[r]); *(bf16_t*)(xr_ + (64 + j) * 2) = f2bf(s0i[r]);
            *(bf16_t*)(xr_ + (32 + j) * 2) = f2bf(s1r[r]); *(bf16_t*)(xr_ + (96 + j) * 2) = f2bf(s1i[r]); }
        asm volatile("" ::: "memory");
        f32x16 acc = {}; mma_tile(acc, C.Xs, S5_XST, C.Cm, S5_XST, 128, lane);
        if (j < 16) {
#pragma unroll
            for (int r = 0; r < 16; ++r) { const int t = crow32(r, hi); const int rt = ((t & 15) & 3) + 8 * ((t & 15) >> 2) + 4 * (t >> 4);
                const float y = acc[r] + C.dsk * bf2f(*(const bf16_t*)(C.Us + rt * S5_UST + j * 2));
                C.ybase[(size_t)(tok0 + t) * 512 + j] = f2bf(gelu_tanh_(y)); } }
        asm volatile("" ::: "memory");
    }
    { const float e0r = partner32(x0r, hi), e0i = partner32(x0i, hi), e1r = partner32(x1r, hi), e1i = partner32(x1i, hi);
      if (hi == 0) { x0r = e0r; x0i = e0i; x1r = e1r; x1i = e1i; } else { x0r = 0.f; x0i = 0.f; x1r = 0.f; x1i = 0.f; } }
}
__device__ __forceinline__ void unit_s5(const Params& P, int layer, int u, char* lds) {
    const int b = u >> 5, g = u & 31, tid = TIDX(), wid = tid >> 6, lane = tid & 63, hi = lane >> 5, j = lane & 31;
    char* Cm = lds;
    char* Bb = Cm + 32 * S5_XST;
    float* ends = (float*)(Bb + 128 * S5_UST);
    char* wbase = (char*)(ends + 8 * 64 * 2) + wid * (32 * S5_XST + 32 * S5_UST);
    const float* sp = P.s5p_() + (size_t)(layer * 32 + g) * S5P_STRIDE;
    __syncthreads();
    for (int i = tid; i < 32 * 128; i += NTHR) { const int c = i >> 7, pp = i & 127; float v = 0.f;
        if (c < 16) v = (pp < 64) ? P.s5_c_re[((size_t)(layer * 32 + g) * 16 + c) * 64 + pp] : -P.s5_c_im[((size_t)(layer * 32 + g) * 16 + c) * 64 + (pp - 64)];
        *(bf16_t*)(Cm + c * S5_XST + pp * 2) = f2bf(v); }
    for (int i = tid; i < 128 * 16; i += NTHR) { const int n = i >> 4, c = i & 15, nt = n >> 5, jj = n & 31, p = (nt >> 1) * 32 + jj;
        *(bf16_t*)(Bb + n * S5_UST + c * 2) = f2bf(sp[256 + (p * 16 + c) * 2 + (nt & 1)]); }
    S5Ctx C; C.Cm = Cm; C.Bb = Bb; C.Xs = wbase; C.Us = wbase + 32 * S5_XST; C.lane = lane; C.hi = hi; C.j = j;
    C.l0r = sp[2 * j]; C.l0i = sp[2 * j + 1]; C.l1r = sp[2 * (32 + j)]; C.l1i = sp[2 * (32 + j) + 1];
    { float q0r = C.l0r, q0i = C.l0i, q1r = C.l1r, q1i = C.l1i;
#pragma unroll
      for (int k = 0; k < 4; ++k) { const float a = q0r * q0r - q0i * q0i, bb = (q0r + q0r) * q0i; q0r = a; q0i = bb; const float c = q1r * q1r - q1i * q1i, d = (q1r + q1r) * q1i; q1r = c; q1i = d; }
      C.q0r = q0r; C.q0i = q0i; C.q1r = q1r; C.q1i = q1i; }
    C.dsk = P.s5_d[layer * 512 + g * 16 + (lane & 15)];
    C.rho = ((j & 15) & 3) + 8 * ((j & 15) >> 2) + 4 * (j >> 4);
    const int tokw = b * SEQ + wid * 512;
    C.ubase = P.p_() + C_SU + g * 16; C.ybase = P.ybuf_() + g * 16;
    float x0r = 0.f, x0i = 0.f, x1r = 0.f, x1i = 0.f;
    __syncthreads();
    for (int sc = 0; sc < 16; ++sc) s5_tile<false>(C, tokw + sc * 32, x0r, x0i, x1r, x1i);
    if (hi == 0) { ends[(wid * 64 + j) * 2] = x0r; ends[(wid * 64 + j) * 2 + 1] = x0i; ends[(wid * 64 + 32 + j) * 2] = x1r; ends[(wid * 64 + 32 + j) * 2 + 1] = x1i; }
    __syncthreads();
    { const float p0r = sp[128 + 2 * j], p0i = sp[128 + 2 * j + 1], p1r = sp[128 + 2 * (32 + j)], p1i = sp[128 + 2 * (32 + j) + 1];
      x0r = 0.f; x0i = 0.f; x1r = 0.f; x1i = 0.f;
      for (int w = 0; w < wid; ++w) { const float e0r = ends[(w * 64 + j) * 2], e0i = ends[(w * 64 + j) * 2 + 1], e1r = ends[(w * 64 + 32 + j) * 2], e1i = ends[(w * 64 + 32 + j) * 2 + 1];
          const float n0r = p0r * x0r - p0i * x0i + e0r, n0i = p0r * x0i + p0i * x0r + e0i, n1r = p1r * x1r - p1i * x1i + e1r, n1i = p1r * x1i + p1i * x1r + e1i;
          x0r = n0r; x0i = n0i; x1r = n1r; x1i = n1i; }
      if (hi) { x0r = 0.f; x0i = 0.f; x1r = 0.f; x1i = 0.f; } }
    for (int sc = 0; sc < 16; ++sc) s5_tile<true>(C, tokw + sc * 32, x0r, x0i, x1r, x1i);
}
constexpr int TOPK = 256;
__device__ __forceinline__ unsigned f2key(float f) { const unsigned u = __float_as_uint(f); return u ^ ((u & 0x80000000u) ? 0xffffffffu : 0x80000000u); }

__device__ __forceinline__ float relu1(float x) { const int b = __float_as_int(x); return __int_as_float(b > 0 ? b : 0); }
#define DSA_MM(acc, rt, kk) acc = __builtin_amdgcn_mfma_f32_32x32x16_bf16(afr[rt][kk], bfr[kk], acc, 0, 0, 0)
#define DSA_HS(acc, rt, q) do { s0 = fmaf(relu1(acc[4 * (q)]), wv[rt][4 * (q)], s0); s1 = fmaf(relu1(acc[4 * (q) + 1]), wv[rt][4 * (q) + 1], s1); \
                                s0 = fmaf(relu1(acc[4 * (q) + 2]), wv[rt][4 * (q) + 2], s0); s1 = fmaf(relu1(acc[4 * (q) + 3]), wv[rt][4 * (q) + 3], s1); } while (0)
#define DSA_SG() do { __builtin_amdgcn_sched_group_barrier(0x8, 1, 0); __builtin_amdgcn_sched_group_barrier(0x2, 8, 0); } while (0)
__device__ __forceinline__ void dsa_score_tile(const bf16x8 (&afr)[4][4], const f32x16 (&wv)[4], const bf16x8 (&bfr)[4], float* sc, int col, int hi) {
    f32x16 accA = {}, accB = {}; asm volatile("" : "+v"(accA), "+v"(accB));
    float s0, s1;
    DSA_MM(accA, 0, 0); DSA_MM(accA, 0, 1); DSA_MM(accA, 0, 2); DSA_MM(accA, 0, 3);
    s0 = 0.f; s1 = 0.f;
    DSA_MM(accB, 1, 0); DSA_HS(accA, 0, 0); DSA_SG(); DSA_MM(accB, 1, 1); DSA_HS(accA, 0, 1); DSA_SG();
    DSA_MM(accB, 1, 2); DSA_HS(accA, 0, 2); DSA_SG(); DSA_MM(accB, 1, 3); DSA_HS(accA, 0, 3); DSA_SG();
    sc[(0 + hi) * 4096 + col] = (s0 + s1) + 0.f;
    accA = (f32x16){}; asm volatile("" : "+v"(accA)); s0 = 0.f; s1 = 0.f;
    DSA_MM(accA, 2, 0); DSA_HS(accB, 1, 0); DSA_SG(); DSA_MM(accA, 2, 1); DSA_HS(accB, 1, 1); DSA_SG();
    DSA_MM(accA, 2, 2); DSA_HS(accB, 1, 2); DSA_SG(); DSA_MM(accA, 2, 3); DSA_HS(accB, 1, 3); DSA_SG();
    sc[(2 + hi) * 4096 + col] = (s0 + s1) + 0.f;
    accB = (f32x16){}; asm volatile("" : "+v"(accB)); s0 = 0.f; s1 = 0.f;
    DSA_MM(accB, 3, 0); DSA_HS(accA, 2, 0); DSA_SG(); DSA_MM(accB, 3, 1); DSA_HS(accA, 2, 1); DSA_SG();
    DSA_MM(accB, 3, 2); DSA_HS(accA, 2, 2); DSA_SG(); DSA_MM(accB, 3, 3); DSA_HS(accA, 2, 3); DSA_SG();
    sc[(4 + hi) * 4096 + col] = (s0 + s1) + 0.f;
    s0 = 0.f; s1 = 0.f;
    DSA_HS(accB, 3, 0); DSA_HS(accB, 3, 1); DSA_HS(accB, 3, 2); DSA_HS(accB, 3, 3);
    sc[(6 + hi) * 4096 + col] = (s0 + s1) + 0.f;
}
#define DSA_CNT4(K0, K1, K2, K3) asm volatile( \
    "v_cmp_ge_u32_e64 %[m0], %[k0], %[cd]\n\tv_cmp_ge_u32_e64 %[m1], %[k1], %[cd]\n\tv_cmp_ge_u32_e64 %[m2], %[k2], %[cd]\n\tv_cmp_ge_u32_e64 %[m3], %[k3], %[cd]\n\t" \
    "v_addc_co_u32_e64 %[a0], %[m0], %[a0], 0, %[m0]\n\tv_addc_co_u32_e64 %[a1], %[m1], %[a1], 0, %[m1]\n\t" \
    "v_addc_co_u32_e64 %[a0], %[m2], %[a0], 0, %[m2]\n\tv_addc_co_u32_e64 %[a1], %[m3], %[a1], 0, %[m3]" \
    : [a0] "+v"(c0), [a1] "+v"(c1), [m0] "=&s"(sm0), [m1] "=&s"(sm1), [m2] "=&s"(sm2), [m3] "=&s"(sm3) \
    : [k0] "v"(K0), [k1] "v"(K1), [k2] "v"(K2), [k3] "v"(K3), [cd] "v"(cand))
#define DSA_CNT8(J0) do { DSA_CNT4(key[(J0)], key[(J0) + 1], key[(J0) + 2], key[(J0) + 3]); DSA_CNT4(key[(J0) + 4], key[(J0) + 5], key[(J0) + 6], key[(J0) + 7]); } while (0)

__device__ __forceinline__ void unit_dsa_index(const Params& P, int u, char* lds) {
    const int b = u & 3, t0 = (511 - (u >> 2)) * 8;
    const int tid = TIDX(), wid = tid >> 6, lane = tid & 63, r32 = lane & 31, hi = lane >> 5;
    float* sc = (float*)lds;
    const bf16_t* pb = P.p_() + (size_t)b * SEQ * NPAD;
    __syncthreads();
    {
        bf16x8 afr[4][4]; f32x16 wv[4];
        const int qsel = (r32 >> 2) & 1, head = (r32 & 3) + 4 * (r32 >> 3);
#pragma unroll
        for (int rt = 0; rt < 4; ++rt) { const bf16_t* qp = pb + (size_t)(t0 + 2 * rt + qsel) * NPAD + C_DIQ + head * 64 + hi * 8;
#pragma unroll
            for (int kk = 0; kk < 4; ++kk) afr[rt][kk] = *(const bf16x8*)(qp + kk * 16);
            const float* wp = P.iw_() + (size_t)(b * SEQ + t0 + 2 * rt + hi) * 16;
#pragma unroll
            for (int i = 0; i < 4; ++i) { const f32x4 w4 = *(const f32x4*)(wp + 4 * i); wv[rt][4 * i] = w4[0]; wv[rt][4 * i + 1] = w4[1]; wv[rt][4 * i + 2] = w4[2]; wv[rt][4 * i + 3] = w4[3]; } }
        const int ntile = (t0 + 7) / 32 + 1;
        const bf16_t* kp = P.ikc_() + (size_t)(b * (SEQ / 32)) * 2048 + lane * 8;
        bf16x8 b0[4], b1[4], b2[4];
#define DSA_LDB(dst, K) do { const bf16_t* kq_ = kp + (size_t)(wid + 8 * (K)) * 2048; _Pragma("unroll") for (int kk = 0; kk < 4; ++kk) dst[kk] = *(const bf16x8*)(kq_ + kk * 512); } while (0)
#define DSA_TILE(buf, K) dsa_score_tile(afr, wv, buf, sc, (wid + 8 * (K)) * 32 + r32, hi)
        const int nk = (ntile - wid + 7) >> 3;
        const int kl = nk > 0 ? nk - 1 : 0;
#define DSA_MIN(a) ((a) < kl ? (a) : kl)
        DSA_LDB(b0, DSA_MIN(0)); DSA_LDB(b1, DSA_MIN(1));
        int k = 0;
        for (; k + 3 <= nk; k += 3) {
            DSA_LDB(b2, k + 2); DSA_TILE(b0, k);
            DSA_LDB(b0, DSA_MIN(k + 3)); DSA_TILE(b1, k + 1);
            DSA_LDB(b1, DSA_MIN(k + 4)); DSA_TILE(b2, k + 2);
        }
        if (k < nk) DSA_TILE(b0, k);
        if (k + 1 < nk) DSA_TILE(b1, k + 1);
#undef DSA_TILE
#undef DSA_MIN
#undef DSA_TILE
#undef DSA_LDB
    }
    __syncthreads();
    {
        const int t = t0 + wid; const float* srow = sc + wid * 4096;
        unsigned key[64];
#pragma unroll
        for (int j = 0; j < 64; ++j) { const int s = j * 64 + lane; key[j] = (s <= t) ? f2key(srow[s]) : 0u; }
        unsigned long long* mout = P.mask_() + (size_t)(b * SEQ + t) * 64;
        unsigned long long myword = 0ull;
        if (t + 1 <= TOPK) {
#pragma unroll
            for (int j = 0; j < 64; ++j) { const unsigned long long m = __ballot(j * 64 + lane <= t); if (lane == j) myword = m; }
        } else {
            const int ngrp = t / 512 + 1;
            unsigned T = 0u; int cntT = t + 1;
            unsigned kmax = 0u;
#pragma unroll
            for (int j = 0; j < 64; ++j) kmax = key[j] > kmax ? key[j] : kmax;
#pragma unroll
            for (int o = 32; o >= 1; o >>= 1) { const unsigned other = (unsigned)__builtin_amdgcn_ds_bpermute(((lane ^ o) << 2), (int)kmax); kmax = other > kmax ? other : kmax; }
            for (int bit = 31; bit >= 0; --bit) {
                const unsigned cand = T | (1u << bit); unsigned c0 = 0, c1 = 0; unsigned long long sm0, sm1, sm2, sm3;
                if (cand > kmax) continue;
                DSA_CNT8(0);
                if (ngrp > 1) DSA_CNT8(8);
                if (ngrp > 2) DSA_CNT8(16);
                if (ngrp > 3) DSA_CNT8(24);
                if (ngrp > 4) DSA_CNT8(32);
                if (ngrp > 5) DSA_CNT8(40);
                if (ngrp > 6) DSA_CNT8(48);
                if (ngrp > 7) DSA_CNT8(56);
                const int cl = (int)(c0 + c1);
                int cnt = 0;
#pragma unroll
                for (int bb = 0; bb < 7; ++bb) cnt += __popcll(__ballot((cl >> bb) & 1)) << bb;
                if (cnt >= TOPK) { T = cand; cntT = cnt; if (cnt == TOPK) break; }
            }
            if (cntT == TOPK) {
#pragma unroll
                for (int j = 0; j < 64; ++j) { const unsigned long long m = __ballot(key[j] >= T); if (lane == j) myword = m; }
            } else {
                int ngt = 0;
#pragma unroll
                for (int j = 0; j < 64; ++j) ngt += __popcll(__ballot(key[j] > T));
                int need = TOPK - ngt;
#pragma unroll
                for (int j = 0; j < 64; ++j) { const unsigned long long eq = __ballot(key[j] == T), gt = __ballot(key[j] > T);
                    const int ne = __popcll(eq); unsigned long long take = eq;
                    if (ne > need) { take = 0ull; int left = need; unsigned long long e2 = eq;
                        while (left > 0) { const unsigned long long lowbit = e2 & (0ull - e2); take |= lowbit; e2 ^= lowbit; --left; } }
                    need -= (ne > need) ? need : ne;
                    const unsigned long long m = gt | take; if (lane == j) myword = m; }
            }
        }
        mout[lane] = myword;
    }
}

struct DsaOutRow { const bf16_t* zb; bf16_t* gb; int wid;
    __device__ __forceinline__ const bf16_t* zrow(int r) const { const int rho = wid * 32 + r; return zb + (size_t)(rho >> 2) * NPAD + (rho & 3) * 128; }
    __device__ __forceinline__ bf16_t* grow(int r) const { const int rho = wid * 32 + r; return gb + (size_t)(rho >> 2) * MIX + (rho & 3) * 128; } };
__device__ __forceinline__ void unit_dsa_attn(const Params& P, int u, char* lds) {
    const int b = u & 3, qb = 63 - (u >> 2), t0 = qb * 64, tokb = b * SEQ;
    const int wid = TIDX() >> 6, lane = TIDX() & 63, r32 = lane & 31, hi = lane >> 5;
    const int rho = wid * 32 + r32, tq = t0 + (rho >> 2), hq = rho & 3;
    const bf16_t* Qw = P.p_() + (size_t)(tokb + tq) * NPAD + C_DQ + hq * 128 + hi * 8;
    const bf16_t* Kh = P.kvc_() + (size_t)tokb * 256;
    const unsigned moff = (unsigned)(tokb + tq) * 512u;
    DsaOutRow ow; ow.zb = P.p_() + (size_t)(tokb + t0) * NPAD + C_DZ; ow.gb = P.xn_() + (size_t)(tokb + t0) * MIX + 1024; ow.wid = wid;
    const int NT = (qb + 2) & ~1;
    att::attn_body<true, 256, 128, DsaOutRow>(Qw, Kh, NT, P.mask_(), moff, ow, lds);
}
__device__ __forceinline__ void phase_gemm_glu(const Params& P, int layer, char* lds) {
    pg8::Gemm g; g.A = P.ybuf_(); g.Bt = P.WgluT_() + (size_t)layer * 512 * 512; g.M = NTOK; g.N = 512; g.K = 512;
    pg8::StaticOrder S; S.init(g.M, g.N, (int)gridDim.x, (int)blockIdx.x);
    pg8::EpiGlu E; E.Y = P.ybuf_(); E.ldy = 512; E.O = P.ocat_(); E.ldo = MIX; E.ooff = 512;
    pg8::gemm_phase<pg8::EpiGlu, pg8::StaticOrder, false>((PG8_LAS unsigned char*)lds, g, S, E, nullptr);
}

constexpr int CTL_Q0 = 4096;
struct OneUnit { int pm, pn; __device__ __forceinline__ bool next(int i, pg8::Unit& u) const { if (i) return false; u.pm = pm; u.pn = pn; return true; }
    __device__ __forceinline__ void a_ready(const pg8::Unit&) const {} __device__ __forceinline__ void done(const pg8::Unit&) const {} };
__device__ __forceinline__ int q_issue(unsigned* ctr) { return (int)__hip_atomic_fetch_add(ctr, 1u, __ATOMIC_RELAXED, __HIP_MEMORY_SCOPE_AGENT); }
#define Q_LOOP_BEGIN(ctr, total)  { unsigned* q_ctr_ = (ctr); const int q_total_ = (total); volatile int* q_b_ = (volatile int*)(lds + LDS_TAIL + 16); \
    for (;;) { __syncthreads(); if (TIDX() == 0) *q_b_ = q_issue(q_ctr_); __syncthreads(); const int item = __builtin_amdgcn_readfirstlane(*q_b_); if (item >= q_total_) break;
#define Q_LOOP_END  } }
__device__ __forceinline__ void unit_glu(const Params& P, int layer, int u, char* lds) {
    pg8::Gemm g; g.A = P.ybuf_(); g.Bt = P.WgluT_() + (size_t)layer * 512 * 512; g.M = NTOK; g.N = 512; g.K = 512;
    OneUnit S; S.pm = u >> 1; S.pn = u & 1;
    pg8::EpiGluGate E; E.Y = P.ybuf_(); E.Pz = P.p_(); E.G = P.xn_();
    pg8::gemm_phase<pg8::EpiGluGate, OneUnit, false>((PG8_LAS unsigned char*)lds, g, S, E, nullptr);
}
constexpr int LDS_TAIL = LDS_BYTES - 64;

__global__ __launch_bounds__(NTHR, 2) void k_mega(Params P) {
    extern __shared__ __attribute__((aligned(16))) char lds[];
    if (TIDX() == 0) *(uint4*)(lds + LDS_TAIL) = make_uint4(0u, 0u, 0u, 0u);
    __syncthreads();
    XcdBarrier bar = xcd_barrier_post(P.ctl_(), (volatile LAS unsigned*)(lds + LDS_TAIL));
    const int G = gridDim.x, B = blockIdx.x;
    phase_prologue1(P, lds); phase_rope_table(P); phase_s5_params(P); phase_rmsnorm_x(P, 0);
    xcd_barrier(bar);
    for (int layer = 0; layer < DEPTH; ++layer) {
        if (layer > 0) { phase_rmsnorm_x(P, layer); xcd_barrier(bar); }
        phase_gemm_in(P, layer, lds);
        if (layer == 0) phase_gemm_kv(P, lds);
        xcd_barrier(bar);
        phase_prep(P, layer);
        if (layer == 0) phase_memk_norm(P);
        for (int u = B; u < 1024; u += G) unit_gla_a(P, layer, u, lds);
        xcd_barrier(bar);
        Q_LOOP_BEGIN(P.ctl_() + CTL_Q0 + 64 * (layer * 2), 128 + 2048 + 256 + 256)
            if (item < 128) unit_s5(P, layer, item, lds);
            else if (item < 2176) unit_dsa_index(P, item - 128, lds);
            else if (item < 2432) unit_mem_attn(P, layer, item - 2176, lds);
            else gla_scan_slice(P, (item - 2432) * NTHR + TIDX());
        Q_LOOP_END
        xcd_barrier(bar);
        Q_LOOP_BEGIN(P.ctl_() + CTL_Q0 + 64 * (layer * 2 + 1), 256 + 256 + 128)
            if (item < 256) unit_dsa_attn(P, item, lds);
            else if (item < 512) { for (int k = 0; k < 4; ++k) unit_gla_c(P, layer, (item - 256) * 4 + k, lds); }
            else unit_glu(P, layer, item - 512, lds);
        Q_LOOP_END
        xcd_barrier(bar);
        phase_gemm_out(P, layer, lds);
        xcd_barrier(bar);
    }
}

extern "C" void kernel_launch(void* const* d_in, const int* in_sizes, int n_in, void* d_out, int out_size, void* d_ws, size_t ws_size, hipStream_t stream) {
    if (n_in != 24 || ws_size < WS_END) { fprintf(stderr, "kernel_launch: unexpected n_in %d or ws_size %zu (< %zu)\n", n_in, ws_size, (size_t)WS_END); return; }
    Params P; memset(&P, 0, sizeof(P));
    P.x = (const float*)d_in[0]; P.mem = (const float*)d_in[1]; P.pos = (const int*)d_in[2]; P.ln_gain = (const float*)d_in[3]; P.w_in = (const float*)d_in[4];
    P.gla_w_up = (const float*)d_in[5]; P.gla_b_up = (const float*)d_in[6]; P.s5_a_re = (const float*)d_in[7]; P.s5_a_im = (const float*)d_in[8]; P.s5_log_step = (const float*)d_in[9];
    P.s5_b_re = (const float*)d_in[10]; P.s5_b_im = (const float*)d_in[11]; P.s5_c_re = (const float*)d_in[12]; P.s5_c_im = (const float*)d_in[13]; P.s5_d = (const float*)d_in[14];
    P.s5_w_glu = (const float*)d_in[15]; P.dsa_q_norm = (const float*)d_in[16]; P.dsa_k_norm = (const float*)d_in[17]; P.mem_norm = (const float*)d_in[18]; P.w_mem_kv = (const float*)d_in[19];
    P.mem_q_norm = (const float*)d_in[20]; P.mem_k_norm = (const float*)d_in[21]; P.out_norm = (const float*)d_in[22]; P.w_out = (const float*)d_in[23];
    P.out = (float*)d_out;
    char* ws = (char*)d_ws; P.ws = ws;
    static int grid = 0;
    if (!grid) {
        int dev = 0, cus = 0, per_cu = 0;
        (void)hipGetDevice(&dev); (void)hipDeviceGetAttribute(&cus, hipDeviceAttributeMultiprocessorCount, dev);
        (void)hipFuncSetAttribute((const void*)k_mega, hipFuncAttributeMaxDynamicSharedMemorySize, LDS_BYTES);
        (void)hipOccupancyMaxActiveBlocksPerMultiprocessor(&per_cu, (const void*)k_mega, NTHR, LDS_BYTES);
        if (per_cu < 1) fprintf(stderr, "kernel_launch: occupancy query reports %d blocks per CU\n", per_cu);
        grid = cus > 0 ? cus : 256;
    }
    (void)hipMemsetAsync(ws + WS_CTL, 0, CTL_BYTES, stream);
    hipLaunchKernelGGL(k_mega, dim3(grid), dim3(NTHR), LDS_BYTES, stream, P);
}
```

```cpp
#include <hip/hip_runtime.h>
#include <stdint.h>
#include <stdio.h>
#include <string.h>

constexpr int NB = 4, SEQ = 4096, NTOK = NB * SEQ, DM = 2048, DEPTH = 4, MEML = 256;
constexpr int NIN = 5984, NPAD = 6144, MIX = 2048;
constexpr int C_GQ = 0, C_GK = 256, C_GV = 512, C_GLR = 1024, C_GZ = 1040, C_SU = 1552, C_SZ = 2064, C_DQ = 2576, C_DK = 3088, C_DV = 3216,
              C_DIQ = 3344, C_DIK = 4368, C_DIW = 4432, C_DZ = 4448, C_MQ = 4960, C_MZ = 5472;
constexpr float EPS = 1e-6f;
constexpr int NTHR = 512;
constexpr int LDS_BYTES = 147456;

typedef unsigned short bf16_t;
typedef short bf16x8 __attribute__((ext_vector_type(8)));
typedef short s16x4 __attribute__((ext_vector_type(4)));
typedef float f32x4 __attribute__((ext_vector_type(4)));
typedef float f32x8 __attribute__((ext_vector_type(8)));
typedef float f32x16 __attribute__((ext_vector_type(16)));
typedef unsigned u32x4 __attribute__((ext_vector_type(4)));
typedef unsigned u32x2 __attribute__((ext_vector_type(2)));
#define LAS __attribute__((address_space(3)))

__device__ __forceinline__ float bf2f(bf16_t b) { return __uint_as_float(((unsigned)b) << 16); }
__device__ __forceinline__ bf16_t f2bf(float f) { unsigned u = __float_as_uint(f); u += 0x7FFFu + ((u >> 16) & 1u); return (bf16_t)(u >> 16); }
__device__ __forceinline__ unsigned pk2bf(float lo, float hi) { return (unsigned)f2bf(lo) | ((unsigned)f2bf(hi) << 16); }
__device__ __forceinline__ float sigmoidf_(float x) { return 1.f / (1.f + __expf(-x)); }
__device__ __forceinline__ float siluf_(float x) { return x / (1.f + __expf(-x)); }

__device__ __forceinline__ int TIDX() { int t = (int)threadIdx.x; asm volatile("" : "+v"(t)); return t; }
__device__ __forceinline__ float shx(float v, int m) { const int src = ((TIDX() & 63) ^ m) << 2; return __int_as_float(__builtin_amdgcn_ds_bpermute(src, __float_as_int(v))); }
__device__ __forceinline__ float wave_sum(float v) {
#pragma unroll
    for (int o = 32; o >= 1; o >>= 1) v += shx(v, o);
    return v;
}
__device__ __forceinline__ void ld8f(const bf16_t* p, float (&v)[8]) { const u32x4 w = *(const u32x4*)p;
#pragma unroll
    for (int j = 0; j < 4; ++j) { v[2 * j] = __uint_as_float(w[j] << 16); v[2 * j + 1] = __uint_as_float(w[j] & 0xffff0000u); } }
__device__ __forceinline__ void st8f(bf16_t* p, const float (&v)[8]) { u32x4 w; w.x = pk2bf(v[0], v[1]); w.y = pk2bf(v[2], v[3]); w.z = pk2bf(v[4], v[5]); w.w = pk2bf(v[6], v[7]); *(u32x4*)p = w; }
__device__ __forceinline__ float f2bf_f(float f) { return bf2f(f2bf(f)); }
#define XB_TMO      128
#define XB_XCNT(j)  (256  + 64 * (j))
#define XB_XSUB(j)  (1280 + 64 * (j))
#define XB_XGEN(j)  (2304 + 64 * (j))
#define XB_TOP      3328
#define XB_TOPGEN   3392
#define XCD_BAR_WORDS 3456
#define XB_SPIN_CAP (1u << 18)

__device__ __forceinline__ unsigned xb_ld(unsigned* p)              { return __hip_atomic_load(p, __ATOMIC_RELAXED, __HIP_MEMORY_SCOPE_AGENT); }
__device__ __forceinline__ unsigned xb_add(unsigned* p, unsigned v) { return __hip_atomic_fetch_add(p, v, __ATOMIC_RELAXED, __HIP_MEMORY_SCOPE_AGENT); }
__device__ __forceinline__ unsigned xb_xcc_id() { return (unsigned)__builtin_amdgcn_s_getreg((3 << 11) | 20) & 0xFu; }
#define XB_SPIN(cond, bar) do { unsigned _sp = 0; while (cond) { __builtin_amdgcn_s_sleep(1); \
    if ((++_sp & 255u) == 0u) { if (xb_ld(&(bar)[XB_TMO])) break; if (_sp > XB_SPIN_CAP) { atomicAdd(&(bar)[XB_TMO], 1u); break; } } } } while (0)

struct XcdBarrier {
    unsigned* bar; unsigned x;
    volatile LAS unsigned* st;
};

__device__ __forceinline__ XcdBarrier xcd_barrier_post(unsigned* bar, volatile LAS unsigned* st) {
    XcdBarrier b; b.bar = bar; b.x = xb_xcc_id(); b.st = st;
    if (TIDX() == 0) (void)xb_add(&bar[XB_XCNT(b.x)], 1u);
    return b;
}
__device__ __forceinline__ void xcd_barrier_complete(unsigned* bar, unsigned x, unsigned& nloc, unsigned& nx) {
    const unsigned G = gridDim.x * gridDim.y * gridDim.z;
    unsigned sum, cnt, mine, sp = 0u;
    for (;;) {
        sum = 0u; cnt = 0u; mine = 0u;
#pragma unroll
        for (unsigned j = 0; j < 16; ++j) { const unsigned c = xb_ld(&bar[XB_XCNT(j)]); sum += c; cnt += (c > 0u) ? 1u : 0u; mine = (j == x) ? c : mine; }
        if (sum == G) break;
        __builtin_amdgcn_s_sleep(1);
        if ((++sp & 255u) == 0u) { if (xb_ld(&bar[XB_TMO])) break; if (sp > XB_SPIN_CAP) { atomicAdd(&bar[XB_TMO], 1u); break; } }
    }
    nloc = mine > 0u ? mine : 1u; nx = cnt > 0u ? cnt : 1u;
}

__device__ __forceinline__ void xcd_barrier(const XcdBarrier& b) {
    asm volatile("s_waitcnt vmcnt(0)" ::: "memory");
    __syncthreads();
    if (TIDX() == 0) {
        unsigned* bar = b.bar; const unsigned bx = xb_xcc_id();
        __builtin_amdgcn_s_waitcnt(0);
        unsigned nloc = b.st[0], nx = b.st[1];
        if (nloc == 0u) { xcd_barrier_complete(bar, bx, nloc, nx); b.st[0] = nloc; b.st[1] = nx; }
        const unsigned old = xb_add(&bar[XB_XSUB(bx)], 1u);
        const unsigned gen = old / nloc;
        if (old + 1u == (gen + 1u) * nloc) {
            __builtin_amdgcn_fence(__ATOMIC_RELEASE, "agent");
            asm volatile("s_waitcnt vmcnt(0)" ::: "memory");
            const unsigned og = xb_add(&bar[XB_TOP], 1u);
            const unsigned tg = og / nx;
            if (og + 1u == (tg + 1u) * nx) xb_add(&bar[XB_TOPGEN], 1u);
            else XB_SPIN(xb_ld(&bar[XB_TOPGEN]) == tg, bar);
            __builtin_amdgcn_fence(__ATOMIC_ACQUIRE, "agent");
            xb_add(&bar[XB_XGEN(bx)], 1u);
            asm volatile("s_waitcnt vmcnt(0)" ::: "memory");
        } else {
            XB_SPIN(xb_ld(&bar[XB_XGEN(bx)]) == gen, bar);
            __builtin_amdgcn_fence(__ATOMIC_ACQUIRE, "agent");
            asm volatile("s_waitcnt vmcnt(0)" ::: "memory");
        }
    }
    __syncthreads();
}
namespace pg8 {
#define PG8_LAS __attribute__((address_space(3)))
typedef float f32x2 __attribute__((ext_vector_type(2)));
typedef unsigned u32x4 __attribute__((ext_vector_type(4)));
constexpr int BM = 256, BK = 64, HALF = 128, HTB = HALF * BK * 2  , STAGE_BYTES = 8 * HTB, NXCD = 8, WGM = 8;

__host__ __device__ __forceinline__ int lds_byte(int r, int c) { const int st = (r >> 4) * 2 + (c >> 5), rr = r & 15, cc = c & 31, ob = rr * 64 + cc * 2; return st * 1024 + (ob ^ (((ob >> 9) & 1) << 5)); }
__host__ __device__ __forceinline__ void stage_rc(int b, int& R, int& C) { const int st = b / 1024, sb = b % 1024, swz = sb ^ (((sb >> 9) & 1) << 5); R = (st >> 1) * 16 + swz / 64; C = (st & 1) * 32 + (swz % 64) / 2; }
__host__ __device__ __forceinline__ int perm32(int rho) { const int n = rho >> 4, i = rho & 15; return 8 * (i >> 2) + 4 * n + (i & 3); }

struct Unit { int pm, pn; };
struct Gemm { const bf16_t* A; const bf16_t* Bt; int M, N, K; };

struct StaticOrder {
    int nM, nN, nwg, G, c;
    __host__ __device__ void init(int M, int N, int G_, int c_) { nM = M / BM; nN = N / BM; nwg = nM * nN; G = G_; c = c_; }
    __host__ __device__ bool next(int i, Unit& u) const {
        const long L = (long)i * G + c; if (L >= nwg) return false;
        int wgid = (int)L; { const int q = nwg / NXCD, r = nwg % NXCD, xcd = wgid % NXCD, off = wgid / NXCD; wgid = (xcd < r ? xcd * (q + 1) : r * (q + 1) + (xcd - r) * q) + off; }
        const int nig = WGM * nN, gid = wgid / nig, fm = gid * WGM, gsz = (nM - fm) < WGM ? (nM - fm) : WGM;
        u.pm = fm + ((wgid % nig) % gsz); u.pn = (wgid % nig) / gsz; return true;
    }
    __device__ __forceinline__ void a_ready(const Unit&) const {}
    __device__ __forceinline__ void done(const Unit&) const {}
};
__device__ __forceinline__ unsigned cvt_pk_bf16(float lo, float hi) { unsigned r; asm volatile("v_cvt_pk_bf16_f32 %0, %1, %2" : "=v"(r) : "v"(lo), "v"(hi)); return r; }
struct EpiBf16Plain {
    static constexpr bool PERM = true, AFTER_DRAIN = false;
    bf16_t* O; int ldc;
    __device__ __forceinline__ void operator()(const f32x4 (&acc)[2][2][4][2], const Unit& u, int wr, int wc, int fr, int fq) const {
        const int row0 = u.pm * BM + wr * 64 + fr, col0 = u.pn * BM + wc * 32 + 8 * fq;
#pragma unroll
        for (int ai = 0; ai < 2; ++ai)
#pragma unroll
            for (int m = 0; m < 4; ++m) { bf16_t* rowp = O + (size_t)(row0 + ai * HALF + m * 16) * ldc + col0;
#pragma unroll
                for (int bj = 0; bj < 2; ++bj) { const f32x4 v0 = acc[ai][bj][m][0], v1 = acc[ai][bj][m][1];
                    u32x4 w; w.x = cvt_pk_bf16(v0[0], v0[1]); w.y = cvt_pk_bf16(v0[2], v0[3]); w.z = cvt_pk_bf16(v1[0], v1[1]); w.w = cvt_pk_bf16(v1[2], v1[3]);
                    *(u32x4*)(rowp + bj * HALF) = w; } }
    }
};
struct EpiResid {
    static constexpr bool PERM = false, AFTER_DRAIN = false;
    const float* R; float* C; int ldc;
    __device__ __forceinline__ void operator()(const f32x4 (&acc)[2][2][4][2], const Unit& u, int wr, int wc, int fr, int fq) const {
        const int row0 = u.pm * BM + wr * 64 + fr, col0 = u.pn * BM + wc * 32 + 4 * fq;
#pragma unroll
        for (int ai = 0; ai < 2; ++ai)
#pragma unroll
            for (int m = 0; m < 4; ++m) { const size_t off = (size_t)(row0 + ai * HALF + m * 16) * ldc + col0;
#pragma unroll
                for (int bj = 0; bj < 2; ++bj)
#pragma unroll
                    for (int n = 0; n < 2; ++n) { const f32x4 r = *(const f32x4*)(R + off + bj * HALF + n * 16); *(f32x4*)(C + off + bj * HALF + n * 16) = acc[ai][bj][m][n] + r; } }
    }
};
struct EpiGlu {
    static constexpr bool PERM = true, AFTER_DRAIN = false;
    const bf16_t* Y; int ldy; bf16_t* O; int ldo; int ooff;
    __device__ __forceinline__ void operator()(const f32x4 (&acc)[2][2][4][2], const Unit& u, int wr, int wc, int fr, int fq) const {
        const int row0 = u.pm * BM + wr * 64 + fr, col0 = u.pn * BM + wc * 32 + 8 * fq;
#pragma unroll
        for (int ai = 0; ai < 2; ++ai)
#pragma unroll
            for (int m = 0; m < 4; ++m) { const int row = row0 + ai * HALF + m * 16;
#pragma unroll
                for (int bj = 0; bj < 2; ++bj) { const f32x4 v0 = acc[ai][bj][m][0], v1 = acc[ai][bj][m][1];
                    const u32x4 yw = *(const u32x4*)(Y + (size_t)row * ldy + col0 + bj * HALF);
                    float y[8], g[8];
#pragma unroll
                    for (int j = 0; j < 4; ++j) { y[2 * j] = __uint_as_float(yw[j] << 16); y[2 * j + 1] = __uint_as_float(yw[j] & 0xffff0000u); }
#pragma unroll
                    for (int j = 0; j < 4; ++j) { g[j] = 1.f / (1.f + __expf(-v0[j])); g[4 + j] = 1.f / (1.f + __expf(-v1[j])); }
                    u32x4 w; w.x = cvt_pk_bf16(y[0] * g[0], y[1] * g[1]); w.y = cvt_pk_bf16(y[2] * g[2], y[3] * g[3]); w.z = cvt_pk_bf16(y[4] * g[4], y[5] * g[5]); w.w = cvt_pk_bf16(y[6] * g[6], y[7] * g[7]);
                    *(u32x4*)(O + (size_t)row * ldo + ooff + col0 + bj * HALF) = w; } }
    }
};
struct EpiGluGate {
    static constexpr bool PERM = true, AFTER_DRAIN = true;
    const bf16_t* Y; const bf16_t* Pz; bf16_t* G;
    __device__ __forceinline__ void fused(const f32x4 (&acc)[2][2][4][2], const Unit& u, int wr, int wc, int fr, int fq, PG8_LAS unsigned char* lds, int wid, int lane) const {
        constexpr int TS = 528;
        const int row0 = wr * 64 + fr, col0 = wc * 32 + 8 * fq;
#pragma unroll
        for (int ai = 0; ai < 2; ++ai)
#pragma unroll
            for (int m = 0; m < 4; ++m) { const int rl = row0 + ai * HALF + m * 16; const size_t grow = (size_t)u.pm * BM + rl;
#pragma unroll
                for (int bj = 0; bj < 2; ++bj) { const f32x4 v0 = acc[ai][bj][m][0], v1 = acc[ai][bj][m][1];
                    const u32x4 yw = *(const u32x4*)(Y + grow * 512 + u.pn * BM + col0 + bj * HALF);
                    float y[8], g[8];
#pragma unroll
                    for (int j = 0; j < 4; ++j) { y[2 * j] = __uint_as_float(yw[j] << 16); y[2 * j + 1] = __uint_as_float(yw[j] & 0xffff0000u); }
#pragma unroll
                    for (int j = 0; j < 4; ++j) { g[j] = 1.f / (1.f + __expf(-v0[j])); g[4 + j] = 1.f / (1.f + __expf(-v1[j])); }
                    u32x4 w; w.x = cvt_pk_bf16(y[0] * g[0], y[1] * g[1]); w.y = cvt_pk_bf16(y[2] * g[2], y[3] * g[3]); w.z = cvt_pk_bf16(y[4] * g[4], y[5] * g[5]); w.w = cvt_pk_bf16(y[6] * g[6], y[7] * g[7]);
                    *(PG8_LAS u32x4*)(lds + rl * TS + (col0 + bj * HALF) * 2) = w; } }
        __syncthreads();
        { const int t = wid * 64 + lane, row = t >> 1, hd = t & 1; const PG8_LAS unsigned char* src = lds + row * TS + hd * 256;
          float ss = 0.f;
#pragma unroll
          for (int i = 0; i < 16; ++i) { const u32x4 w = *(const PG8_LAS u32x4*)(src + 16 * i);
#pragma unroll
              for (int j = 0; j < 4; ++j) { const float a = __uint_as_float(w[j] << 16), b = __uint_as_float(w[j] & 0xffff0000u); ss += a * a + b * b; } }
          const float rn = rsqrtf(ss * (1.f / 128.f) + 1e-6f);
          const size_t grow = (size_t)u.pm * BM + row; const int cb = u.pn * BM + hd * 128;
          const bf16_t* zp = Pz + grow * 6144 + 2064 + cb; bf16_t* gp = G + grow * 2048 + 512 + cb;
#pragma unroll
          for (int i = 0; i < 16; ++i) { const u32x4 w = *(const PG8_LAS u32x4*)(src + 16 * i); const u32x4 zw = *(const u32x4*)(zp + 8 * i); u32x4 o;
#pragma unroll
              for (int j = 0; j < 4; ++j) { const float a = __uint_as_float(w[j] << 16), b = __uint_as_float(w[j] & 0xffff0000u), za = __uint_as_float(zw[j] << 16), zb = __uint_as_float(zw[j] & 0xffff0000u);
                  o[j] = cvt_pk_bf16(a * rn * (za / (1.f + __expf(-za))), b * rn * (zb / (1.f + __expf(-zb)))); }
              *(u32x4*)(gp + 8 * i) = o; } }
        __syncthreads();
    }
};
struct EpiBf16Scale {
    static constexpr bool PERM = true, AFTER_DRAIN = false;
    bf16_t* O; int ldc; const float* ssq;
    __device__ __forceinline__ void operator()(const f32x4 (&acc)[2][2][4][2], const Unit& u, int wr, int wc, int fr, int fq) const {
        const int row0 = u.pm * BM + wr * 64 + fr, col0 = u.pn * BM + wc * 32 + 8 * fq;
#pragma unroll
        for (int ai = 0; ai < 2; ++ai)
#pragma unroll
            for (int m = 0; m < 4; ++m) { const int row = row0 + ai * HALF + m * 16; bf16_t* rowp = O + (size_t)row * ldc + col0;
                float ssum = 0.f; { const f32x4* sp_ = (const f32x4*)(ssq + (size_t)row * 32);
#pragma unroll
                    for (int q = 0; q < 8; ++q) { const f32x4 t4 = sp_[q]; ssum += (t4[0] + t4[1]) + (t4[2] + t4[3]); } }
                const float s = rsqrtf(ssum * (1.f / 2048.f) + 1e-6f);
#pragma unroll
                for (int bj = 0; bj < 2; ++bj) { const f32x4 v0 = acc[ai][bj][m][0] * s, v1 = acc[ai][bj][m][1] * s;
                    u32x4 w; w.x = cvt_pk_bf16(v0[0], v0[1]); w.y = cvt_pk_bf16(v0[2], v0[3]); w.z = cvt_pk_bf16(v1[0], v1[1]); w.w = cvt_pk_bf16(v1[2], v1[3]);
                    *(u32x4*)(rowp + bj * HALF) = w; } }
    }
};
struct EpiResidNext {
    static constexpr bool PERM = false, AFTER_DRAIN = false;
    const float* R; float* C; int ldc; bf16_t* XB; float* ssq;
    __device__ __forceinline__ void operator()(const f32x4 (&acc)[2][2][4][2], const Unit& u, int wr, int wc, int fr, int fq) const {
        const int row0 = u.pm * BM + wr * 64 + fr, col0 = u.pn * BM + wc * 32 + 4 * fq;
#pragma unroll
        for (int ai = 0; ai < 2; ++ai)
#pragma unroll
            for (int m = 0; m < 4; ++m) { const int row = row0 + ai * HALF + m * 16; const size_t off = (size_t)row * ldc + col0; float ss = 0.f;
#pragma unroll
                for (int bj = 0; bj < 2; ++bj)
#pragma unroll
                    for (int n = 0; n < 2; ++n) { const f32x4 r = *(const f32x4*)(R + off + bj * HALF + n * 16); const f32x4 v = acc[ai][bj][m][n] + r;
                        *(f32x4*)(C + off + bj * HALF + n * 16) = v;
                        if (XB) { u32x2 w; w.x = cvt_pk_bf16(v[0], v[1]); w.y = cvt_pk_bf16(v[2], v[3]); *(u32x2*)(XB + off + bj * HALF + n * 16) = w; }
                        ss += v[0] * v[0] + v[1] * v[1] + v[2] * v[2] + v[3] * v[3]; }
                if (ssq) { ss += shx(ss, 16); ss += shx(ss, 32); if (fq == 0) ssq[(size_t)row * 32 + u.pn * 4 + wc] = ss; } }
    }
};
template <class Epi, class Sched, bool STAMP = false>
__device__ __forceinline__ void gemm_phase(PG8_LAS unsigned char* lds, const Gemm g, const Sched& S, const Epi& E, unsigned long long* stamps) {
    const int tid = TIDX(), wid = __builtin_amdgcn_readfirstlane(tid >> 6), lane = tid & 63, wr = wid >> 2, wc = wid & 3, fr = lane & 15, fq = lane >> 4;
    const int K = g.K, nt = K / BK;
    int ts_lo = 0, ts_hi = 0, nts = 0; const unsigned long long rt_entry = STAMP ? (unsigned long long)wall_clock64() : 0ull;
#define PG8_STAMP() do { if (STAMP && wid == 0 && nts < 64) { const unsigned long long _c = (unsigned long long)clock64(); \
        ts_lo = (lane == nts) ? (int)(unsigned)_c : ts_lo; ts_hi = (lane == nts) ? (int)(unsigned)(_c >> 32) : ts_hi; ++nts; } } while (0)
    PG8_STAMP();
    unsigned voffA[2], voffB[2];
#pragma unroll
    for (int i = 0; i < 2; ++i) { int R, C; stage_rc(tid * 16 + i * 8192, R, C); const int Rb = Epi::PERM ? ((R & ~31) + perm32(R & 31)) : R;
        voffA[i] = (unsigned)(R * K + C) * 2u; voffB[i] = (unsigned)(Rb * K + C) * 2u; }
    const size_t kstep = (size_t)(BK * 2);
    const size_t hstep = (size_t)HALF * K * 2;
    const size_t tstep = 2 * hstep;
    const unsigned ldsw = (unsigned)wid * 1024u;
    const int aoff = lds_byte(wr * 64 + fr, fq * 8), boff = lds_byte(wc * 32 + fr, fq * 8);
#define PG8_SA(b, h) (((b) * 2 + (h)) * HTB)
#define PG8_SB(b, h) ((4 + (b) * 2 + (h)) * HTB)
#define PG8_STAGE(bufoff, gbase, voff) do { _Pragma("unroll") for (int _i = 0; _i < 2; ++_i) \
        __builtin_amdgcn_global_load_lds((const unsigned*)((const char*)(gbase) + (voff)[_i]), (PG8_LAS unsigned*)(lds + (bufoff) + ldsw + _i * 8192), 16, 0, 0); } while (0)
#define PG8_LDA(dst, b, h) do { _Pragma("unroll") for (int m = 0; m < 4; ++m) _Pragma("unroll") for (int k = 0; k < 2; ++k) dst[m][k] = *(const PG8_LAS bf16x8*)(lds + PG8_SA(b, h) + aoff + m * 2048 + k * 1024); } while (0)
#define PG8_LDB(dst, b, h) do { _Pragma("unroll") for (int n = 0; n < 2; ++n) _Pragma("unroll") for (int k = 0; k < 2; ++k) dst[n][k] = *(const PG8_LAS bf16x8*)(lds + PG8_SB(b, h) + boff + n * 2048 + k * 1024); } while (0)
#define PG8_MMA(ai, bj, At, Bt) do { __builtin_amdgcn_s_setprio(1); _Pragma("unroll") for (int m = 0; m < 4; ++m) _Pragma("unroll") for (int n = 0; n < 2; ++n) _Pragma("unroll") for (int k = 0; k < 2; ++k) \
        acc[ai][bj][m][n] = __builtin_amdgcn_mfma_f32_16x16x32_bf16(Bt[n][k], At[m][k], acc[ai][bj][m][n], 0, 0, 0); __builtin_amdgcn_s_setprio(0); } while (0)
#define PG8_WAIT_V(n) asm volatile("s_waitcnt vmcnt(" #n ")" ::: "memory")
#define PG8_WAIT_L(n) asm volatile("s_waitcnt lgkmcnt(" #n ")" ::: "memory")
#define PG8_BAR __builtin_amdgcn_s_barrier()
#define PG8_SCHED __builtin_amdgcn_sched_barrier(0)
    Unit cur, nxt; int ui = 0;
    if (!S.next(0, cur)) return;
    f32x4 acc[2][2][4][2];
#pragma unroll
    for (int a = 0; a < 2; ++a)
#pragma unroll
        for (int b = 0; b < 2; ++b)
#pragma unroll
            for (int m = 0; m < 4; ++m)
#pragma unroll
                for (int n = 0; n < 2; ++n) acc[a][b][m][n] = (f32x4){0.f, 0.f, 0.f, 0.f};
    bf16x8 At[4][2], B0[2][2], B1[2][2];
    const char* cA = (const char*)g.A + (size_t)cur.pm * tstep; const char* cB = (const char*)g.Bt + (size_t)cur.pn * tstep;
    S.a_ready(cur);
    PG8_STAGE(PG8_SB(0, 0), cB, voffB); PG8_STAGE(PG8_SA(0, 0), cA, voffA); PG8_STAGE(PG8_SB(0, 1), cB + hstep, voffB); PG8_STAGE(PG8_SA(0, 1), cA + hstep, voffA);
    if (wr == 1) PG8_BAR;
    PG8_WAIT_V(4); PG8_BAR;
    PG8_STAGE(PG8_SB(1, 0), cB + kstep, voffB); PG8_STAGE(PG8_SA(1, 0), cA + kstep, voffA); PG8_STAGE(PG8_SB(1, 1), cB + hstep + kstep, voffB);
    PG8_WAIT_V(6); PG8_BAR;
    PG8_STAMP();
    for (;;) {
        const bool has_next = S.next(ui + 1, nxt);
        const char* nA = has_next ? (const char*)g.A + (size_t)nxt.pm * tstep : cA; const char* nB = has_next ? (const char*)g.Bt + (size_t)nxt.pn * tstep : cB;
        for (int t = 0; t < nt; t += 2) {
            const bool last = (t == nt - 2);
            const char* a1 = cA + (size_t)(t + 1) * kstep;
            const char* a2 = last ? nA : cA + (size_t)(t + 2) * kstep; const char* b2 = last ? nB : cB + (size_t)(t + 2) * kstep;
            const char* a3 = a2 + kstep; const char* b3 = b2 + kstep;
            if (last && has_next) S.a_ready(nxt);
            PG8_LDB(B0, 0, 0); PG8_SCHED; PG8_LDA(At, 0, 0); PG8_STAGE(PG8_SA(1, 1), a1 + hstep, voffA);
            PG8_WAIT_L(8); PG8_BAR; PG8_WAIT_L(0); PG8_MMA(0, 0, At, B0); PG8_BAR; PG8_SCHED;
            PG8_LDB(B1, 0, 1); PG8_STAGE(PG8_SB(0, 0), b2, voffB);
            PG8_BAR; PG8_WAIT_L(0); PG8_MMA(0, 1, At, B1); PG8_BAR;
            PG8_LDA(At, 0, 1); PG8_STAGE(PG8_SA(0, 0), a2, voffA);
            PG8_BAR; PG8_WAIT_L(0); PG8_MMA(1, 0, At, B0); PG8_BAR; PG8_SCHED;
            PG8_STAGE(PG8_SB(0, 1), b2 + hstep, voffB);
            PG8_WAIT_V(6); PG8_BAR; PG8_MMA(1, 1, At, B1); PG8_BAR;
            PG8_LDB(B0, 1, 0); PG8_SCHED; PG8_LDA(At, 1, 0); PG8_STAGE(PG8_SA(0, 1), a2 + hstep, voffA);
            PG8_WAIT_L(8); PG8_BAR; PG8_WAIT_L(0); PG8_MMA(0, 0, At, B0); PG8_BAR; PG8_SCHED;
            PG8_LDB(B1, 1, 1); PG8_STAGE(PG8_SB(1, 0), b3, voffB);
            PG8_BAR; PG8_WAIT_L(0); PG8_MMA(0, 1, At, B1); PG8_BAR;
            PG8_LDA(At, 1, 1); PG8_STAGE(PG8_SA(1, 0), a3, voffA);
            PG8_BAR; PG8_WAIT_L(0); PG8_MMA(1, 0, At, B0); PG8_BAR; PG8_SCHED;
            PG8_STAGE(PG8_SB(1, 1), b3 + hstep, voffB);
            PG8_WAIT_V(6); PG8_BAR; PG8_MMA(1, 1, At, B1); PG8_BAR;
        }
        PG8_STAMP();
        if constexpr (!Epi::AFTER_DRAIN) { E(acc, cur, wr, wc, fr, fq); S.done(cur); }
        PG8_STAMP();
        if (!has_next) break;
#pragma unroll
        for (int a = 0; a < 2; ++a)
#pragma unroll
            for (int b = 0; b < 2; ++b)
#pragma unroll
                for (int m = 0; m < 4; ++m)
#pragma unroll
                    for (int n = 0; n < 2; ++n) acc[a][b][m][n] = (f32x4){0.f, 0.f, 0.f, 0.f};
        cur = nxt; cA = nA; cB = nB; ++ui;
    }
    PG8_WAIT_V(0);
    if (wr == 0) PG8_BAR;
    PG8_BAR;
    if constexpr (Epi::AFTER_DRAIN) { E.fused(acc, cur, wr, wc, fr, fq, lds, wid, lane); S.done(cur); }
    PG8_STAMP();
    if (STAMP && wid == 0) { stamps[lane] = lane < nts ? (((unsigned long long)(unsigned)ts_hi << 32) | (unsigned)ts_lo) : 0ull;
        if (lane == 62) stamps[62] = rt_entry; if (lane == 63) stamps[63] = (unsigned long long)wall_clock64(); }
#undef PG8_STAMP
#undef PG8_SA
#undef PG8_SB
#undef PG8_STAGE
#undef PG8_LDA
#undef PG8_LDB
#undef PG8_MMA
#undef PG8_WAIT_V
#undef PG8_WAIT_L
#undef PG8_BAR
#undef PG8_SCHED
}
}
namespace att {
constexpr int D = 128, NW = 8, QBLK = 32, KVBLK = 64;
constexpr float SCALE = 0.088388347648318440f, THR = 8.f;
constexpr int SHM_V = KVBLK * D * 2, SHM_K = KVBLK * D * 2, SHM_ATTN = 2 * SHM_V + 2 * SHM_K + NW * 64 * 4;
#define KSWZ(row, colB) ((row) * 256 + ((colB) ^ (((row) & 7) << 4)))
#define SBAR() __builtin_amdgcn_sched_barrier(0)
__device__ __forceinline__ int crow(int r, int hi) { return (r & 3) + 8 * (r >> 2) + 4 * hi; }
__device__ __forceinline__ unsigned cvtpk(float lo, float hi) { unsigned r; asm volatile("v_cvt_pk_bf16_f32 %0, %1, %2" : "=v"(r) : "v"(lo), "v"(hi)); return r; }

template <bool MASKED>
__device__ __forceinline__ void partialSM(f32x16& p0, f32x16& p1, float& m_reg, float& mn, float& alpha, unsigned long long mw, int hi) {
  constexpr float C = SCALE * 1.4426950408889634f;
  if (MASKED) {
    const unsigned w0 = (unsigned)mw >> (4 * hi), w1 = (unsigned)(mw >> 32) >> (4 * hi);
    const float ninf = -__builtin_inff();
#pragma unroll
    for (int r = 0; r < 16; ++r) { const int bit = (r & 3) + 8 * (r >> 2);
      p0[r] = ((w0 >> bit) & 1u) ? p0[r] : ninf; p1[r] = ((w1 >> bit) & 1u) ? p1[r] : ninf; }
  }
  float pmax = p0[0];
#pragma unroll
  for (int r = 1; r < 16; ++r) pmax = fmaxf(pmax, p0[r]);
#pragma unroll
  for (int r = 0; r < 16; ++r) pmax = fmaxf(pmax, p1[r]);
  { auto rr = __builtin_amdgcn_permlane32_swap(__float_as_uint(pmax), __float_as_uint(pmax), false, false);
    pmax = fmaxf(__uint_as_float(rr[0]), __uint_as_float(rr[1])); }
  if (__builtin_expect(__all(pmax - m_reg <= THR / SCALE), 1)) { mn = m_reg; alpha = 1.f; }
  else { mn = fmaxf(m_reg, pmax); alpha = __builtin_amdgcn_exp2f((m_reg - mn) * C); m_reg = mn; }
  const float mnC = -mn * C;
#pragma unroll
  for (int r = 0; r < 16; ++r) p0[r] = fmaf(p0[r], C, mnC);
#pragma unroll
  for (int r = 0; r < 16; ++r) p1[r] = fmaf(p1[r], C, mnC);
#pragma unroll
  for (int r = 0; r < 16; ++r) p0[r] = __builtin_amdgcn_exp2f(p0[r]);
}
__device__ __forceinline__ void finishSM(f32x16& p0, f32x16& p1, float alpha, float& l_reg, bf16x8& pa0, bf16x8& pa1, bf16x8& pa2, bf16x8& pa3) {
#pragma unroll
  for (int r = 0; r < 16; ++r) p1[r] = __builtin_amdgcn_exp2f(p1[r]);
  float ps = 0;
#pragma unroll
  for (int r = 0; r < 16; ++r) ps += p0[r];
#pragma unroll
  for (int r = 0; r < 16; ++r) ps += p1[r];
  { auto rr = __builtin_amdgcn_permlane32_swap(__float_as_uint(ps), __float_as_uint(ps), false, false);
    ps = __uint_as_float(rr[0]) + __uint_as_float(rr[1]); }
  l_reg = l_reg * alpha + ps;
#define PK4(P, BASE, OUT) do { unsigned a0 = cvtpk(P[BASE + 0], P[BASE + 1]), a1 = cvtpk(P[BASE + 2], P[BASE + 3]);   \
    unsigned b0 = cvtpk(P[BASE + 4], P[BASE + 5]), b1 = cvtpk(P[BASE + 6], P[BASE + 7]);                              \
    auto r0 = __builtin_amdgcn_permlane32_swap(a0, b0, false, false); auto r1 = __builtin_amdgcn_permlane32_swap(a1, b1, false, false); \
    u32x4 w = {r0[0], r1[0], r0[1], r1[1]}; OUT = *reinterpret_cast<bf16x8*>(&w); } while (0)
  PK4(p0, 0, pa0); PK4(p0, 8, pa1); PK4(p1, 0, pa2); PK4(p1, 8, pa3);
#undef PK4
}
__device__ __forceinline__ void qkt(f32x16& p0, f32x16& p1, const char* Ks, const bf16x8* qr, int r32, int hi) {
  p0 = f32x16{}; p1 = f32x16{};
  asm volatile("" : "+v"(p0), "+v"(p1));
#pragma unroll
  for (int d0 = 0; d0 < 8; ++d0) { const int cb = (d0 * 16 + hi * 8) * 2;
    bf16x8 b0 = *reinterpret_cast<const bf16x8*>(Ks + KSWZ(r32, cb));
    bf16x8 b1 = *reinterpret_cast<const bf16x8*>(Ks + KSWZ(32 + r32, cb));
    p0 = __builtin_amdgcn_mfma_f32_32x32x16_bf16(b0, qr[d0], p0, 0, 0, 0);
    p1 = __builtin_amdgcn_mfma_f32_32x32x16_bf16(b1, qr[d0], p1, 0, 0, 0); }
}
__device__ __forceinline__ int v_st(int k, int c) { const int kk = (k & ~0xC) | ((k & 4) << 1) | ((k & 8) >> 1); return ((kk >> 3) * 4 + (c >> 5)) * 512 + ((kk & 7) * 32 + (c & 31)) * 2; }
__device__ __forceinline__ int v_rd_base(int lane) { return ((lane & 3) << 3) | (((lane >> 2) & 3) << 6) | (((lane >> 4) & 1) << 5) | (((lane >> 5) & 1) << 8); }
constexpr int v_rd_off(int d0, int ks, int half) { return d0 * 512 + ks * 4096 + half * 2048; }
template <int OFF> __device__ __forceinline__ s16x4 tr_read(int vb) {
  s16x4 r; asm volatile("ds_read_b64_tr_b16 %0, %1 offset:%2" : "=&v"(r) : "v"(vb), "i"(OFF) : "memory"); return r;
}
template <int D0> __device__ __forceinline__ void pv_one(f32x16& od, int vb, bf16x8 pa0, bf16x8 pa1, bf16x8 pa2, bf16x8 pa3) {
  const s16x4 l0 = tr_read<v_rd_off(D0, 0, 0)>(vb), h0 = tr_read<v_rd_off(D0, 0, 1)>(vb), l1 = tr_read<v_rd_off(D0, 1, 0)>(vb), h1 = tr_read<v_rd_off(D0, 1, 1)>(vb);
  const s16x4 l2 = tr_read<v_rd_off(D0, 2, 0)>(vb), h2 = tr_read<v_rd_off(D0, 2, 1)>(vb), l3 = tr_read<v_rd_off(D0, 3, 0)>(vb), h3 = tr_read<v_rd_off(D0, 3, 1)>(vb);
  asm volatile("s_waitcnt lgkmcnt(0)" ::: "memory"); SBAR();
#define PK(L, H) (bf16x8){L[0], L[1], L[2], L[3], H[0], H[1], H[2], H[3]}
  od = __builtin_amdgcn_mfma_f32_32x32x16_bf16(pa0, PK(l0, h0), od, 0, 0, 0);
  od = __builtin_amdgcn_mfma_f32_32x32x16_bf16(pa1, PK(l1, h1), od, 0, 0, 0);
  od = __builtin_amdgcn_mfma_f32_32x32x16_bf16(pa2, PK(l2, h2), od, 0, 0, 0);
  od = __builtin_amdgcn_mfma_f32_32x32x16_bf16(pa3, PK(l3, h3), od, 0, 0, 0);
#undef PK
}
__device__ __forceinline__ void pv_d0(f32x16* o, int vb, bf16x8 pa0, bf16x8 pa1, bf16x8 pa2, bf16x8 pa3) {
  pv_one<0>(o[0], vb, pa0, pa1, pa2, pa3); pv_one<1>(o[1], vb, pa0, pa1, pa2, pa3); pv_one<2>(o[2], vb, pa0, pa1, pa2, pa3); pv_one<3>(o[3], vb, pa0, pa1, pa2, pa3);
}

template <bool MASKED, int LDK, int VOFF, class OutRow>
__device__ __forceinline__ void attn_body(const bf16_t* __restrict__ Qw, const bf16_t* __restrict__ Kh, int NT,
                                          const unsigned long long* __restrict__ mbase, unsigned moff, const OutRow& Ow, char* lds) {
  const int tid = TIDX(), wid = tid >> 6, lane = tid & 63, r32 = lane & 31, hi = lane >> 5;
  char* V_lds = lds; char* K_lds = lds + 2 * SHM_V;
  float* ws = (float*)(lds + 2 * SHM_V + 2 * SHM_K) + wid * 64; float* li_l = ws; float* al_l = ws + 32;
  float m_reg = -1e30f, l_reg = 0; f32x16 o[4] = {}; bf16x8 qr[8];
  asm volatile("" : "+v"(o[0]), "+v"(o[1]), "+v"(o[2]), "+v"(o[3]));
#pragma unroll
  for (int d0 = 0; d0 < 8; ++d0) qr[d0] = *reinterpret_cast<const bf16x8*>(Qw + d0 * 16);
  const int sr = tid >> 4, sc = (tid & 15) * 8, vst0 = v_st(sr, sc), vst1 = v_st(32 + sr, sc);
  const int vb0 = (int)(uintptr_t)V_lds + v_rd_base(lane);
  struct { bf16x8 vs0, vs1, ks0, ks1; } sr_[2];
  const unsigned koff = (unsigned)(sr * LDK + sc) * 2u;
#define SLOAD(i, k0) do { const char* kb_ = (const char*)Kh + (size_t)(k0) * (LDK * 2); \
    sr_[i].vs0 = *reinterpret_cast<const bf16x8*>(kb_ + koff + VOFF * 2); sr_[i].vs1 = *reinterpret_cast<const bf16x8*>(kb_ + koff + (32 * LDK + VOFF) * 2); \
    sr_[i].ks0 = *reinterpret_cast<const bf16x8*>(kb_ + koff); sr_[i].ks1 = *reinterpret_cast<const bf16x8*>(kb_ + koff + 32 * LDK * 2); } while (0)
#define SWRITE(b, i) do { *(bf16x8*)(V_lds + (b) * SHM_V + vst0) = sr_[i].vs0;          \
    *(bf16x8*)(V_lds + (b) * SHM_V + vst1) = sr_[i].vs1; int kc = sc * 2;               \
    *(bf16x8*)(K_lds + (b) * SHM_K + KSWZ(sr, kc)) = sr_[i].ks0;                       \
    *(bf16x8*)(K_lds + (b) * SHM_K + KSWZ(32 + sr, kc)) = sr_[i].ks1; } while (0)
#define SWAIT() asm volatile("s_waitcnt vmcnt(4)" ::: "memory")
#define RESC(a) do { if (__any((a) < 1.f)) { if (hi == 0) al_l[r32] = (a); asm volatile("s_waitcnt lgkmcnt(0)" ::: "memory"); \
    _Pragma("unroll") for (int d = 0; d < 4; ++d) _Pragma("unroll") for (int r = 0; r < 16; ++r) o[d][r] *= al_l[crow(r, hi)]; } } while (0)
  f32x16 pA0, pA1, pB0, pB1; float mnA, mnB, alA, alB; bf16x8 pa0, pa1, pa2, pa3;
  unsigned long long mw = 0ull;
  constexpr int SE = 0, SO = 1;
  SLOAD(SE, 0); asm volatile("s_waitcnt vmcnt(0)" ::: "memory"); SWRITE(0, SE); __syncthreads();
  if (MASKED) mw = *(const unsigned long long*)((const char*)mbase + moff);
  qkt(pA0, pA1, K_lds, qr, r32, hi); partialSM<MASKED>(pA0, pA1, m_reg, mnA, alA, mw, hi);
  SLOAD(SO, KVBLK); if (2 < NT) SLOAD(SE, 2 * KVBLK);
  if (2 < NT) SWAIT(); else asm volatile("s_waitcnt vmcnt(0)" ::: "memory");
  SWRITE(1, SO); __syncthreads();
  for (int j = 1; j + 1 < NT; j += 2) {
    if (MASKED) mw = *(const unsigned long long*)((const char*)mbase + (moff + 8u * (unsigned)j));
    SBAR(); qkt(pB0, pB1, K_lds + SHM_K, qr, r32, hi);
    finishSM(pA0, pA1, alA, l_reg, pa0, pa1, pa2, pa3); SBAR();
    SLOAD(SO, (j + 2) * KVBLK); SBAR();
    pv_d0(o, vb0, pa0, pa1, pa2, pa3); partialSM<MASKED>(pB0, pB1, m_reg, mnB, alB, mw, hi);
    if (MASKED) mw = *(const unsigned long long*)((const char*)mbase + (moff + 8u * (unsigned)(j + 1)));
    __syncthreads(); SWAIT(); SWRITE(0, SE);
    RESC(alB); __syncthreads();
    SBAR(); qkt(pA0, pA1, K_lds, qr, r32, hi);
    finishSM(pB0, pB1, alB, l_reg, pa0, pa1, pa2, pa3); SBAR();
    if (j + 3 < NT) SLOAD(SE, (j + 3) * KVBLK); SBAR();
    pv_d0(o, vb0 + SHM_V, pa0, pa1, pa2, pa3); partialSM<MASKED>(pA0, pA1, m_reg, mnA, alA, mw, hi);
    __syncthreads(); if (j + 3 < NT) SWAIT(); else asm volatile("s_waitcnt vmcnt(0)" ::: "memory");
    SWRITE(1, SO);
    RESC(alA); __syncthreads();
  }
  if (MASKED) mw = *(const unsigned long long*)((const char*)mbase + (moff + 8u * (unsigned)(NT - 1)));
  SBAR(); qkt(pB0, pB1, K_lds + SHM_K, qr, r32, hi);
  finishSM(pA0, pA1, alA, l_reg, pa0, pa1, pa2, pa3); SBAR();
  pv_d0(o, vb0, pa0, pa1, pa2, pa3); partialSM<MASKED>(pB0, pB1, m_reg, mnB, alB, mw, hi);
  __syncthreads(); RESC(alB);
  finishSM(pB0, pB1, alB, l_reg, pa0, pa1, pa2, pa3); SBAR();
  pv_d0(o, vb0 + SHM_V, pa0, pa1, pa2, pa3);
  if (hi == 0) li_l[r32] = l_reg; asm volatile("s_waitcnt lgkmcnt(0)" ::: "memory");
  float rli[16];
#pragma unroll
  for (int r = 0; r < 16; ++r) rli[r] = __builtin_amdgcn_rcpf(li_l[crow(r, hi)]);
  __syncthreads();
  float* og_s = (float*)lds + wid * (32 * 132);
#pragma unroll
  for (int r = 0; r < 16; ++r) {
#pragma unroll
    for (int d0 = 0; d0 < 4; ++d0) og_s[crow(r, hi) * 132 + d0 * 32 + r32] = o[d0][r] * rli[r]; }
  asm volatile("" ::: "memory");
  { const int row = lane >> 1, half = lane & 1; const float* src = og_s + row * 132 + half * 64;
    f32x4 v[16]; float ss = 0.f;
#pragma unroll
    for (int i = 0; i < 16; ++i) { v[i] = *(const f32x4*)(src + 4 * i); ss += v[i][0] * v[i][0] + v[i][1] * v[i][1] + v[i][2] * v[i][2] + v[i][3] * v[i][3]; }
    ss += shx(ss, 1);
    const float rn = rsqrtf(ss * (1.f / 128.f) + EPS);
    const bf16_t* zp = Ow.zrow(row) + half * 64; bf16_t* gp = Ow.grow(row) + half * 64;
#pragma unroll
    for (int i = 0; i < 8; ++i) { float z[8], g[8]; ld8f(zp + 8 * i, z);
#pragma unroll
      for (int q = 0; q < 4; ++q) { g[q] = v[2 * i][q] * rn * siluf_(z[q]); g[4 + q] = v[2 * i + 1][q] * rn * siluf_(z[4 + q]); }
      st8f(gp + 8 * i, g); } }
  __syncthreads();
#undef SLOAD
#undef SWRITE
#undef SWAIT
#undef RESC
}
}
constexpr size_t al256(size_t x) { return (x + 255) / 256 * 256; }
constexpr size_t WS_CTL   = 0;
constexpr size_t CTL_BYTES = 65536;
constexpr size_t WS_WINT  = WS_CTL + CTL_BYTES;
constexpr size_t WS_WOUTT = WS_WINT + al256((size_t)DEPTH * NPAD * DM * 2);
constexpr size_t WS_WKVT  = WS_WOUTT + al256((size_t)DEPTH * DM * MIX * 2);
constexpr size_t WS_WGLUT = WS_WKVT + al256((size_t)DEPTH * 1024 * DM * 2);
constexpr size_t WS_MEMN  = WS_WGLUT + al256((size_t)DEPTH * 512 * 512 * 2);
constexpr size_t WS_KVMEM = WS_MEMN + al256((size_t)NB * MEML * DM * 2);
constexpr size_t WS_XN    = WS_KVMEM + al256((size_t)NB * MEML * DEPTH * 1024 * 2);
constexpr size_t WS_P     = WS_XN + al256((size_t)NTOK * DM * 2);
constexpr size_t WS_XBUF  = WS_P + al256((size_t)NTOK * NPAD * 2);
constexpr size_t WS_OCAT  = WS_XBUF + al256((size_t)NTOK * DM * 4);
constexpr size_t WS_MASK  = WS_OCAT + al256((size_t)NTOK * MIX * 2);
constexpr size_t WS_IW    = WS_MASK + al256((size_t)NTOK * 64 * 8);
constexpr size_t WS_YBUF  = WS_IW + al256((size_t)NTOK * 16 * 4);
constexpr size_t WS_ROPE  = WS_YBUF + al256((size_t)NTOK * 512 * 2);
constexpr size_t WS_S5P   = WS_ROPE + al256((size_t)NTOK * 48 * 4);
constexpr size_t S5P_BYTES = (size_t)DEPTH * 32 * (64 * 2 + 64 * 2 + 64 * 16 * 2) * 4;
constexpr size_t WS_GLAS  = WS_S5P + al256(S5P_BYTES);
constexpr size_t WS_GLAD  = WS_GLAS + al256((size_t)NB * 64 * 4 * 64 * 128 * 4);
constexpr size_t WS_IKC   = WS_GLAD + al256((size_t)NB * 64 * 4 * 64 * 4);
constexpr size_t WS_KVC   = WS_IKC + al256((size_t)NTOK * 64 * 2);
constexpr size_t WS_IQL   = WS_KVC + al256((size_t)NTOK * 256 * 2);
constexpr size_t WS_SSQ   = WS_IQL + al256((size_t)NTOK * 64 * 2);
constexpr size_t WS_END   = WS_SSQ + al256((size_t)DEPTH * NTOK * 32 * 4);

struct Params {
    const float* x; const float* mem; const int* pos; const float* ln_gain; const float* w_in; const float* gla_w_up; const float* gla_b_up;
    const float* s5_a_re; const float* s5_a_im; const float* s5_log_step; const float* s5_b_re; const float* s5_b_im; const float* s5_c_re; const float* s5_c_im;
    const float* s5_d; const float* s5_w_glu; const float* dsa_q_norm; const float* dsa_k_norm; const float* mem_norm; const float* w_mem_kv;
    const float* mem_q_norm; const float* mem_k_norm; const float* out_norm; const float* w_out;
    float* out;
    char* ws;
    __device__ __forceinline__ unsigned* ctl_() const { return (unsigned*)(ws + WS_CTL); }
    __device__ __forceinline__ bf16_t* WinT_() const { return (bf16_t*)(ws + WS_WINT); }
    __device__ __forceinline__ bf16_t* WoutT_() const { return (bf16_t*)(ws + WS_WOUTT); }
    __device__ __forceinline__ bf16_t* WkvT_() const { return (bf16_t*)(ws + WS_WKVT); }
    __device__ __forceinline__ bf16_t* WgluT_() const { return (bf16_t*)(ws + WS_WGLUT); }
    __device__ __forceinline__ bf16_t* memn_() const { return (bf16_t*)(ws + WS_MEMN); }
    __device__ __forceinline__ bf16_t* kvmem_() const { return (bf16_t*)(ws + WS_KVMEM); }
    __device__ __forceinline__ bf16_t* xn_() const { return (bf16_t*)(ws + WS_XN); }
    __device__ __forceinline__ bf16_t* p_() const { return (bf16_t*)(ws + WS_P); }
    __device__ __forceinline__ float* xbuf_() const { return (float*)(ws + WS_XBUF); }
    __device__ __forceinline__ bf16_t* ocat_() const { return (bf16_t*)(ws + WS_OCAT); }
    __device__ __forceinline__ unsigned long long* mask_() const { return (unsigned long long*)(ws + WS_MASK); }
    __device__ __forceinline__ float* iw_() const { return (float*)(ws + WS_IW); }
    __device__ __forceinline__ bf16_t* ybuf_() const { return (bf16_t*)(ws + WS_YBUF); }
    __device__ __forceinline__ float* rope_() const { return (float*)(ws + WS_ROPE); }
    __device__ __forceinline__ float* s5p_() const { return (float*)(ws + WS_S5P); }
    __device__ __forceinline__ float* glas_() const { return (float*)(ws + WS_GLAS); }
    __device__ __forceinline__ float* glad_() const { return (float*)(ws + WS_GLAD); }
    __device__ __forceinline__ bf16_t* ikc_() const { return (bf16_t*)(ws + WS_IKC); }
    __device__ __forceinline__ bf16_t* kvc_() const { return (bf16_t*)(ws + WS_KVC); }
    __device__ __forceinline__ float* ssq_() const { return (float*)(ws + WS_SSQ); }
    __device__ __forceinline__ bf16_t* iql_() const { return (bf16_t*)(ws + WS_IQL); }
};

__device__ __forceinline__ void transpose_tiles(const float* __restrict__ src, int K, int Nsrc, int Ndst, const float* __restrict__ scale, bf16_t* __restrict__ dst,
                                                int tile, float* lds_tile  ) {
    const int tid = TIDX(), ntn = Ndst / 64;
    const int tk = tile / ntn, tn = tile % ntn, k0 = tk * 64, n0 = tn * 64;
    __syncthreads();
    { const int ty = tid >> 4, tx = tid & 15;
#pragma unroll
      for (int i = 0; i < 2; ++i) { const int k = k0 + ty + 32 * i, n = n0 + 4 * tx;
        f32x4 v = (f32x4){0.f, 0.f, 0.f, 0.f};
        if (n < Nsrc) v = *(const f32x4*)(src + (size_t)k * Nsrc + n);
        const float s = scale ? scale[k] : 1.f;
        float* t = lds_tile + (ty + 32 * i) * 65 + 4 * tx; t[0] = v[0] * s; t[1] = v[1] * s; t[2] = v[2] * s; t[3] = v[3] * s; } }
    __syncthreads();
    { const int n = tid >> 3, kq = tid & 7;
      u32x4 w;
      w.x = pk2bf(lds_tile[(8 * kq + 0) * 65 + n], lds_tile[(8 * kq + 1) * 65 + n]); w.y = pk2bf(lds_tile[(8 * kq + 2) * 65 + n], lds_tile[(8 * kq + 3) * 65 + n]);
      w.z = pk2bf(lds_tile[(8 * kq + 4) * 65 + n], lds_tile[(8 * kq + 5) * 65 + n]); w.w = pk2bf(lds_tile[(8 * kq + 6) * 65 + n], lds_tile[(8 * kq + 7) * 65 + n]);
      *(u32x4*)(dst + (size_t)(n0 + n) * K + k0 + 8 * kq) = w; }
}

__device__ __forceinline__ void rmsnorm_rows(const float* __restrict__ X, bf16_t* __restrict__ Y, int nrows) {
    const int wid = TIDX() >> 6, lane = TIDX() & 63;
    for (int row = blockIdx.x * 8 + wid; row < nrows; row += gridDim.x * 8) {
        const float* xr = X + (size_t)row * DM; f32x4 v[8]; float ss = 0.f;
#pragma unroll
        for (int i = 0; i < 8; ++i) { v[i] = *(const f32x4*)(xr + 4 * lane + 256 * i); ss += v[i][0] * v[i][0] + v[i][1] * v[i][1] + v[i][2] * v[i][2] + v[i][3] * v[i][3]; }
        ss = wave_sum(ss); const float r = rsqrtf(ss * (1.f / DM) + EPS);
        bf16_t* yr = Y + (size_t)row * DM;
#pragma unroll
        for (int i = 0; i < 8; ++i) { u32x2 w; w.x = pk2bf(v[i][0] * r, v[i][1] * r); w.y = pk2bf(v[i][2] * r, v[i][3] * r); *(u32x2*)(yr + 4 * lane + 256 * i) = w; }
    }
}

__device__ __forceinline__ void rows_bf16_ssq(const float* __restrict__ X, bf16_t* __restrict__ Y, float* __restrict__ ssq, int nrows) {
    const int wid = TIDX() >> 6, lane = TIDX() & 63;
    for (int row = blockIdx.x * 8 + wid; row < nrows; row += gridDim.x * 8) {
        const float* xr = X + (size_t)row * DM; bf16_t* yr = Y + (size_t)row * DM; float ss = 0.f;
#pragma unroll
        for (int i = 0; i < 8; ++i) { const f32x4 v = *(const f32x4*)(xr + 4 * lane + 256 * i); ss += v[0] * v[0] + v[1] * v[1] + v[2] * v[2] + v[3] * v[3];
            u32x2 w; w.x = pk2bf(v[0], v[1]); w.y = pk2bf(v[2], v[3]); *(u32x2*)(yr + 4 * lane + 256 * i) = w; }
        ss = wave_sum(ss); if (lane < 32) ssq[(size_t)row * 32 + lane] = (lane == 0) ? ss : 0.f;
    }
}
__device__ __forceinline__ void phase_prologue1(const Params& P, char* lds) {
    float* tile = (float*)lds;
    constexpr int T_IN = (DM / 64) * (NPAD / 64), T_OUT = (MIX / 64) * (DM / 64), T_KV = (DM / 64) * (1024 / 64), T_GLU = 8 * 8;
    constexpr int TOT = DEPTH * (T_IN + T_OUT + T_KV + T_GLU);
    for (int u = blockIdx.x; u < TOT; u += gridDim.x) {
        int l = u / (T_IN + T_OUT + T_KV + T_GLU), r = u % (T_IN + T_OUT + T_KV + T_GLU);
        if (r < T_IN) transpose_tiles(P.w_in + (size_t)l * DM * NIN, DM, NIN, NPAD, P.ln_gain + l * DM, P.WinT_() + (size_t)l * NPAD * DM, r, tile);
        else if ((r -= T_IN) < T_OUT) transpose_tiles(P.w_out + (size_t)l * MIX * DM, MIX, DM, DM, P.out_norm + l * MIX, P.WoutT_() + (size_t)l * DM * MIX, r, tile);
        else if ((r -= T_OUT) < T_KV) transpose_tiles(P.w_mem_kv + (size_t)l * DM * 1024, DM, 1024, 1024, P.mem_norm + l * DM, P.WkvT_() + (size_t)l * 1024 * DM, r, tile);
        else { r -= T_KV; transpose_tiles(P.s5_w_glu + (size_t)l * 512 * 512, 512, 512, 512, nullptr, P.WgluT_() + (size_t)l * 512 * 512, r, tile); }
    }
    rmsnorm_rows(P.mem, P.memn_(), NB * MEML);
}
__device__ __forceinline__ void phase_rope_table(const Params& P) {
    for (int idx = blockIdx.x * NTHR + TIDX(); idx < NTOK * 24; idx += gridDim.x * NTHR) {
        const int tok = idx / 24, i = idx % 24;
        const float e = (i < 16) ? -((float)i * 2.0f / 32.0f) : -((float)(i - 16) * 2.0f / 16.0f);
        const float inv_freq = exp2f(e * 18.931568569324174f);
        const float ang = (float)P.pos[tok] * inv_freq;
        const double a = (double)ang; const double k = rint(a * 0.15915494309189535); const float rf = (float)fma(-k, 6.283185307179586, a);
        P.rope_()[(size_t)idx * 2] = cosf(rf); P.rope_()[(size_t)idx * 2 + 1] = sinf(rf);
    }
}

__device__ __forceinline__ void phase_rmsnorm_x(const Params& P, int layer) { rmsnorm_rows(layer == 0 ? P.x : P.xbuf_(), P.xn_(), NTOK); }

__device__ __forceinline__ void phase_memk_norm(const Params& P) {
    const int wid = TIDX() >> 6, lane = TIDX() & 63;
    for (int it = blockIdx.x * 8 + wid; it < NB * MEML * DEPTH * 4; it += gridDim.x * 8) {
        const int row = it / (DEPTH * 4), l = (it / 4) % DEPTH, h = it % 4;
        bf16_t* kp = P.kvmem_() + (size_t)row * (DEPTH * 1024) + l * 1024 + h * 128 + 2 * lane;
        const unsigned w = *(const unsigned*)kp; const float a = __uint_as_float(w << 16), b = __uint_as_float(w & 0xffff0000u);
        const float ss = wave_sum(a * a + b * b), r = rsqrtf(ss * (1.f / 128.f) + EPS);
        const float* g = P.mem_k_norm + l * 128 + 2 * lane;
        *(unsigned*)kp = pk2bf(a * r * g[0], b * r * g[1]);
    }
}

__device__ __forceinline__ float sum16(float v) { v += shx(v, 1); v += shx(v, 2); v += shx(v, 4); v += shx(v, 8); return v; }

__device__ __forceinline__ void head128_norm_rope_to(const bf16_t* hp, bf16_t* dp, int l16, const float* __restrict__ gain, const float* __restrict__ cs, bool rope, bool do_store) {
    float v[8]; ld8f(hp + 8 * l16, v);
    float ss = 0.f;
#pragma unroll
    for (int j = 0; j < 8; ++j) ss += v[j] * v[j];
    ss = sum16(ss); const float r = rsqrtf(ss * (1.f / 128.f) + EPS);
#pragma unroll
    for (int j = 0; j < 8; ++j) v[j] = v[j] * r * gain[8 * l16 + j];
    if (rope) {
        float o[8];
#pragma unroll
        for (int j = 0; j < 8; ++j) o[j] = shx(v[j], 2);
        if (l16 < 4) { const int fi = (l16 & 1) * 8;
#pragma unroll
            for (int j = 0; j < 8; ++j) { const float c = cs[(fi + j) * 2], s = cs[(fi + j) * 2 + 1];
                v[j] = (l16 < 2) ? (v[j] * c - o[j] * s) : (v[j] * c + o[j] * s); } }
    }
    if (do_store) st8f(dp + 8 * l16, v);
}
__device__ __forceinline__ void head128_norm_rope(bf16_t* hp, int l16, const float* __restrict__ gain, const float* __restrict__ cs, bool rope, bool do_store) { head128_norm_rope_to(hp, hp, l16, gain, cs, rope, do_store); }
__device__ __forceinline__ void rope16_inplace(bf16_t* ip, const float* __restrict__ cs) {
    float a[8], b[8]; ld8f(ip, a); ld8f(ip + 8, b);
#pragma unroll
    for (int j = 0; j < 8; ++j) { const float c = cs[2 * j], s = cs[2 * j + 1], x1 = a[j], x2 = b[j]; a[j] = x1 * c - x2 * s; b[j] = x2 * c + x1 * s; }
    st8f(ip, a); st8f(ip + 8, b);
}
__device__ __forceinline__ void phase_prep(const Params& P, int layer) {
    const int wid = TIDX() >> 6, lane = TIDX() & 63, l16 = lane & 15, grp = lane >> 4;
    for (int tok = blockIdx.x * 8 + wid; tok < NTOK; tok += gridDim.x * 8) {
        bf16_t* row = P.p_() + (size_t)tok * NPAD;
        const float* cs32 = P.rope_() + (size_t)tok * 48; const float* cs16 = cs32 + 32;
        head128_norm_rope(row + C_DQ + grp * 128, l16, P.dsa_q_norm + layer * 128, cs32, true, true);
        head128_norm_rope_to(row + C_DK, P.kvc_() + (size_t)tok * 256, l16, P.dsa_k_norm + layer * 128, cs32, true, grp == 0);
        head128_norm_rope(row + C_MQ + grp * 128, l16, P.mem_q_norm + layer * 128, cs32, false, true);
        if ((lane & 3) == 0) rope16_inplace(row + C_DIQ + lane * 16, cs16);
        if (lane < 4) {
            bf16_t* dst = P.ikc_() + (size_t)(tok >> 5) * 2048 + lane * 512 + (tok & 31) * 8;
            float a[8], b[8]; ld8f(row + C_DIK + lane * 16, a); ld8f(row + C_DIK + lane * 16 + 8, b);
            if (lane == 0) {
#pragma unroll
                for (int q = 0; q < 8; ++q) { const float c = cs16[2 * q], s = cs16[2 * q + 1], x1 = a[q], x2 = b[q]; a[q] = x1 * c - x2 * s; b[q] = x2 * c + x1 * s; } }
            st8f(dst, a); st8f(dst + 256, b); }
        if (lane >= 16 && lane < 32) { const u32x4 vv = *(const u32x4*)(row + C_DV + (lane - 16) * 8); *(u32x4*)(P.kvc_() + (size_t)tok * 256 + 128 + (lane - 16) * 8) = vv; }
        if (lane < 16) P.iw_()[(size_t)tok * 16 + lane] = bf2f(row[C_DIW + lane]) * (1.f / 32.f);
    }
}
struct MemOutRow { const bf16_t* zb; bf16_t* gb;
    __device__ __forceinline__ const bf16_t* zrow(int r) const { return zb + (size_t)r * NPAD; } __device__ __forceinline__ bf16_t* grow(int r) const { return gb + (size_t)r * MIX; } };
__device__ __forceinline__ void unit_mem_attn(const Params& P, int layer, int u, char* lds) {
    const int b = u >> 6, h = (u >> 4) & 3, qb = u & 15, tok0 = b * SEQ + qb * 256;
    const int wid = TIDX() >> 6, lane = TIDX() & 63, r32 = lane & 31, hi = lane >> 5;
    const bf16_t* Qw = P.p_() + (size_t)(tok0 + wid * 32 + r32) * NPAD + C_MQ + h * 128 + hi * 8;
    const bf16_t* Kh = P.kvmem_() + (size_t)(b * MEML) * (DEPTH * 1024) + layer * 1024 + h * 128;
    MemOutRow ow; ow.zb = P.p_() + (size_t)(tok0 + wid * 32) * NPAD + C_MZ + h * 128; ow.gb = P.xn_() + (size_t)(tok0 + wid * 32) * MIX + 1536 + h * 128;
    att::attn_body<false, DEPTH * 1024, 512, MemOutRow>(Qw, Kh, MEML / 64, nullptr, 0u, ow, lds);
}

__device__ __forceinline__ void phase_gate(const Params& P, int c_lo, int c_hi) {
    const int wid = TIDX() >> 6, lane = TIDX() & 63;
    const int c0 = lane * 32;
    const int seg = c0 >> 9, zc = (seg == 0 ? C_GZ : seg == 1 ? C_SZ : seg == 2 ? C_DZ : C_MZ) + (c0 & 511);
    const bool act = (c0 >= c_lo) && (c0 < c_hi);
    for (int tok = blockIdx.x * 8 + wid; tok < NTOK; tok += gridDim.x * 8) {
        if (!act) { bf16_t* gz_ = P.xn_() + (size_t)tok * MIX + c0; const u32x4 zz = {0u, 0u, 0u, 0u};
#pragma unroll
            for (int i = 0; i < 4; ++i) *(u32x4*)(gz_ + 8 * i) = zz;
            continue; }
        const bf16_t* op = P.ocat_() + (size_t)tok * MIX + c0; const bf16_t* zp = P.p_() + (size_t)tok * NPAD + zc; bf16_t* gp = P.xn_() + (size_t)tok * MIX + c0;
        float o[32]; float ss = 0.f;
#pragma unroll
        for (int i = 0; i < 4; ++i) { float v[8]; ld8f(op + 8 * i, v);
#pragma unroll
            for (int j = 0; j < 8; ++j) { o[8 * i + j] = v[j]; ss += v[j] * v[j]; } }
        ss += shx(ss, 1); ss += shx(ss, 2);
        const float r = rsqrtf(ss * (1.f / 128.f) + EPS);
#pragma unroll
        for (int i = 0; i < 4; ++i) { float z[8], g[8]; ld8f(zp + 8 * i, z);
#pragma unroll
            for (int j = 0; j < 8; ++j) g[j] = o[8 * i + j] * r * siluf_(z[j]);
            st8f(gp + 8 * i, g); }
    }
}

__device__ __forceinline__ void phase_gemm_in(const Params& P, int layer, char* lds) {
    pg8::Gemm g; g.A = P.xn_(); g.Bt = P.WinT_() + (size_t)layer * NPAD * DM; g.M = NTOK; g.N = NPAD; g.K = DM;
    pg8::StaticOrder S; S.init(g.M, g.N, (int)gridDim.x, (int)blockIdx.x);
    pg8::EpiBf16Plain E; E.O = P.p_(); E.ldc = NPAD;
    pg8::gemm_phase<pg8::EpiBf16Plain, pg8::StaticOrder, false>((PG8_LAS unsigned char*)lds, g, S, E, nullptr);
}
__device__ __forceinline__ void phase_gemm_out(const Params& P, int layer, char* lds) {
    pg8::Gemm g; g.A = P.xn_(); g.Bt = P.WoutT_() + (size_t)layer * DM * MIX; g.M = NTOK; g.N = DM; g.K = MIX;
    pg8::StaticOrder S; S.init(g.M, g.N, (int)gridDim.x, (int)blockIdx.x);
    pg8::EpiResid E; E.R = (layer == 0) ? P.x : P.xbuf_(); E.C = (layer == DEPTH - 1) ? P.out : P.xbuf_(); E.ldc = DM;
    pg8::gemm_phase<pg8::EpiResid, pg8::StaticOrder, false>((PG8_LAS unsigned char*)lds, g, S, E, nullptr);
}
__device__ __forceinline__ void phase_gemm_kv(const Params& P, char* lds) {
    pg8::Gemm g; g.A = P.memn_(); g.Bt = P.WkvT_(); g.M = NB * MEML; g.N = DEPTH * 1024; g.K = DM;
    pg8::StaticOrder S; S.init(g.M, g.N, (int)gridDim.x, (int)blockIdx.x);
    pg8::EpiBf16Plain E; E.O = P.kvmem_(); E.ldc = DEPTH * 1024;
    pg8::gemm_phase<pg8::EpiBf16Plain, pg8::StaticOrder, false>((PG8_LAS unsigned char*)lds, g, S, E, nullptr);
}
__device__ __forceinline__ void mma_tile(f32x16& acc, const char* A, int lda, const char* B, int ldb, int K, int lane) {
    const int r = lane & 31, kh = lane >> 5;
    const char* ap = A + r * lda + kh * 16; const char* bp = B + r * ldb + kh * 16;
    asm volatile("" : "+v"(acc));
    for (int k = 0; k < K; k += 16) {
        const bf16x8 a = *(const bf16x8*)(ap + k * 2); const bf16x8 b = *(const bf16x8*)(bp + k * 2);
        acc = __builtin_amdgcn_mfma_f32_32x32x16_bf16(a, b, acc, 0, 0, 0);
    }
}
__device__ __forceinline__ int crow32(int r, int hi) { return (r & 3) + 8 * (r >> 2) + 4 * hi; }
__device__ __forceinline__ float log_sigmoid_(float x) { return fminf(x, 0.f) - log1pf(__expf(-fabsf(x))); }

constexpr int GLA_ST = 144;
constexpr int GLA_ST2 = 272;
__device__ __forceinline__ void gla_front(const Params& P, int layer, int tok0, int h, float (&bv)[8], float* glr_s  , float* tot_s  , float* bm_s  , float* bl_s  ) {
    const int tid = TIDX(), d = tid & 63, tg = tid >> 6;
    __syncthreads();
    if (tid < 128) { const int t = tid >> 1, half = tid & 1; float v[8]; ld8f(P.p_() + (size_t)(tok0 + t) * NPAD + C_GLR + half * 8, v);
#pragma unroll
        for (int j = 0; j < 8; ++j) glr_s[t * 16 + half * 8 + j] = v[j]; }
    float wu[16];
#pragma unroll
    for (int r = 0; r < 16; ++r) wu[r] = P.gla_w_up[((size_t)layer * 16 + r) * 256 + h * 64 + d];
    const float bias = P.gla_b_up[layer * 256 + h * 64 + d];
    __syncthreads();
    float run = 0.f;
#pragma unroll
    for (int i = 0; i < 8; ++i) { const int t = tg * 8 + i; float a = bias;
#pragma unroll
        for (int r = 0; r < 16; ++r) a = fmaf(glr_s[t * 16 + r], wu[r], a);
        run += log_sigmoid_(a) * (1.f / 16.f); bv[i] = run; }
    tot_s[tg * 64 + d] = run;
    __syncthreads();
    float off = 0.f, all = 0.f;
#pragma unroll
    for (int g = 0; g < 8; ++g) { const float v = tot_s[g * 64 + d]; off += (g < tg) ? v : 0.f; all += v; }
#pragma unroll
    for (int i = 0; i < 8; ++i) bv[i] += off;
    if (tg == 4) bm_s[d] = bv[0];
    if (tg == 0) bl_s[d] = all;
    __syncthreads();
}

__device__ __forceinline__ void unit_gla_a(const Params& P, int layer, int u, char* lds) {
    const int b = u >> 8, n = (u >> 2) & 63, h = u & 3, tok0 = b * SEQ + n * 64;
    const int tid = TIDX(), wid = tid >> 6, lane = tid & 63, d = tid & 63, tg = tid >> 6;
    char* kdT = lds;
    char* vT = lds + 64 * GLA_ST;
    float* glr_s = (float*)(lds + 64 * GLA_ST + 128 * GLA_ST); float* tot_s = glr_s + 1024; float* bm_s = tot_s + 512; float* bl_s = bm_s + 64;
    float bv[8]; gla_front(P, layer, tok0, h, bv, glr_s, tot_s, bm_s, bl_s);
    const float bl = bl_s[d];
#pragma unroll
    for (int i = 0; i < 8; ++i) { const int t = tg * 8 + i; const float k = bf2f(P.p_()[(size_t)(tok0 + t) * NPAD + C_GK + h * 64 + d]);
        *(bf16_t*)(kdT + d * GLA_ST + t * 2) = f2bf(k * __expf(bl - bv[i])); }
    { const int e = tid & 127, sg = tid >> 7;
#pragma unroll
      for (int i = 0; i < 16; ++i) { const int s = sg * 16 + i; *(bf16_t*)(vT + e * GLA_ST + s * 2) = P.p_()[(size_t)(tok0 + s) * NPAD + C_GV + h * 128 + e]; } }
    __syncthreads();
    const int mt = wid >> 2, nt = wid & 3, hi = lane >> 5;
    f32x16 acc = {}; mma_tile(acc, kdT + mt * 32 * GLA_ST, GLA_ST, vT + nt * 32 * GLA_ST, GLA_ST, 64, lane);
    float* dst = P.glas_() + ((size_t)((b * 64 + n) * 4 + h)) * 64 * 128;
#pragma unroll
    for (int r = 0; r < 16; ++r) dst[(mt * 32 + crow32(r, hi)) * 128 + nt * 32 + (lane & 31)] = acc[r];
    if (tid < 64) P.glad_()[((size_t)((b * 64 + n) * 4 + h)) * 64 + tid] = __expf(bl_s[tid]);
}

__device__ __forceinline__ void gla_scan_slice(const Params& P, int idx) {
    {
        const int e = idx & 127, d = (idx >> 7) & 63, h = (idx >> 13) & 3, b = idx >> 15;
        float S = 0.f;
        for (int n0 = 0; n0 < 64; n0 += 8) {
            float ds[8], dc[8];
#pragma unroll
            for (int i = 0; i < 8; ++i) { const size_t cu = (size_t)((b * 64 + n0 + i) * 4 + h); ds[i] = P.glas_()[cu * 8192 + d * 128 + e]; dc[i] = P.glad_()[cu * 64 + d]; }
#pragma unroll
            for (int i = 0; i < 8; ++i) { const size_t cu = (size_t)((b * 64 + n0 + i) * 4 + h); P.glas_()[cu * 8192 + d * 128 + e] = S; S = fmaf(dc[i], S, ds[i]); }
        }
    }
}

__device__ __forceinline__ void unit_gla_c(const Params& P, int layer, int u, char* lds) {
    const int b = u >> 8, n = (u >> 2) & 63, h = u & 3, tok0 = b * SEQ + n * 64;
    const int tid = TIDX(), wid = tid >> 6, lane = tid & 63, d = tid & 63, tg = tid >> 6, hi = lane >> 5;
    char* Acat = lds;
    char* Bcat = Acat + 64 * GLA_ST2;
    char* qe = Bcat + 128 * GLA_ST2;
    char* ke = qe + 64 * GLA_ST;
    float* glr_s = (float*)(ke + 64 * GLA_ST); float* tot_s = glr_s + 1024; float* bm_s = tot_s + 512; float* bl_s = bm_s + 64;
    float* o_s = bl_s + 64;
    float bv[8]; gla_front(P, layer, tok0, h, bv, glr_s, tot_s, bm_s, bl_s);
    const float m = bm_s[d];
#pragma unroll
    for (int i = 0; i < 8; ++i) { const int t = tg * 8 + i; const bf16_t* row = P.p_() + (size_t)(tok0 + t) * NPAD;
        const float q = bf2f(row[C_GQ + h * 64 + d]) * 0.125f, k = bf2f(row[C_GK + h * 64 + d]);
        *(bf16_t*)(qe + t * GLA_ST + d * 2) = f2bf(q * __expf(bv[i] - m));
        *(bf16_t*)(ke + t * GLA_ST + d * 2) = f2bf(k * __expf(m - bv[i]));
        *(bf16_t*)(Acat + t * GLA_ST2 + (64 + d) * 2) = f2bf(q * __expf(bv[i])); }
    { const int e = tid & 127, sg = tid >> 7;
      const float* sp = P.glas_() + ((size_t)((b * 64 + n) * 4 + h)) * 64 * 128;
#pragma unroll
      for (int i = 0; i < 16; ++i) { const int s = sg * 16 + i;
          *(bf16_t*)(Bcat + e * GLA_ST2 + s * 2) = P.p_()[(size_t)(tok0 + s) * NPAD + C_GV + h * 128 + e];
          *(bf16_t*)(Bcat + e * GLA_ST2 + (64 + s) * 2) = f2bf(sp[s * 128 + e]); } }
    __syncthreads();
    if (wid < 4) { const int mt = wid >> 1, nt = wid & 1;
        f32x16 acc = {}; mma_tile(acc, qe + mt * 32 * GLA_ST, GLA_ST, ke + nt * 32 * GLA_ST, GLA_ST, 64, lane);
#pragma unroll
        for (int r = 0; r < 16; ++r) { const int t = mt * 32 + crow32(r, hi), s = nt * 32 + (lane & 31);
            *(bf16_t*)(Acat + t * GLA_ST2 + s * 2) = f2bf(s <= t ? acc[r] : 0.f); } }
    __syncthreads();
    { const int mt = wid >> 2, nt = wid & 3;
      f32x16 acc = {}; mma_tile(acc, Acat + mt * 32 * GLA_ST2, GLA_ST2, Bcat + nt * 32 * GLA_ST2, GLA_ST2, 128, lane);
#pragma unroll
      for (int r = 0; r < 16; ++r) { const int t = mt * 32 + crow32(r, hi); o_s[t * 132 + nt * 32 + (lane & 31)] = acc[r]; } }
    __syncthreads();
    { const int t = tid >> 3, e0 = (tid & 7) * 16; const float* src = o_s + t * 132 + e0;
      f32x4 v[4]; float ss = 0.f;
#pragma unroll
      for (int i = 0; i < 4; ++i) { v[i] = *(const f32x4*)(src + 4 * i); ss += v[i][0] * v[i][0] + v[i][1] * v[i][1] + v[i][2] * v[i][2] + v[i][3] * v[i][3]; }
      ss += shx(ss, 1); ss += shx(ss, 2); ss += shx(ss, 4);
      const float rn = rsqrtf(ss * (1.f / 128.f) + EPS);
      const bf16_t* zp = P.p_() + (size_t)(tok0 + t) * NPAD + C_GZ + h * 128 + e0; bf16_t* gp = P.xn_() + (size_t)(tok0 + t) * MIX + h * 128 + e0;
#pragma unroll
      for (int i = 0; i < 2; ++i) { float z[8], gg[8]; ld8f(zp + 8 * i, z);
#pragma unroll
          for (int q = 0; q < 4; ++q) { gg[q] = v[2 * i][q] * rn * siluf_(z[q]); gg[4 + q] = v[2 * i + 1][q] * rn * siluf_(z[4 + q]); }
          st8f(gp + 8 * i, gg); } }
}
constexpr int S5P_STRIDE = 2304;
__device__ __forceinline__ void phase_s5_params(const Params& P) {
    for (int idx = blockIdx.x * NTHR + TIDX(); idx < DEPTH * 32 * 64; idx += gridDim.x * NTHR) {
        const int p = idx & 63, lg = idx >> 6;
        const float ar = P.s5_a_re[idx], ai = P.s5_a_im[idx], step = expf(P.s5_log_step[lg]);
        const float mag = expf(ar * step), th = ai * step;
        const float lr = mag * cosf(th), li = mag * sinf(th);
        float* o = P.s5p_() + (size_t)lg * S5P_STRIDE;
        o[2 * p] = lr; o[2 * p + 1] = li;
        { const float mag512 = expf(512.f * ar * step); const double a = 512.0 * (double)th; const double k = rint(a * 0.15915494309189535); const float rf = (float)fma(-k, 6.283185307179586, a);
          o[128 + 2 * p] = mag512 * cosf(rf); o[128 + 2 * p + 1] = mag512 * sinf(rf); }
        const float xr = lr - 1.f, xi = li, den = 1.f / (ar * ar + ai * ai);
        const float fr = (xr * ar + xi * ai) * den, fi = (xi * ar - xr * ai) * den;
        for (int c = 0; c < 16; ++c) { const float br = P.s5_b_re[(size_t)idx * 16 + c], bi = P.s5_b_im[(size_t)idx * 16 + c];
            o[256 + (p * 16 + c) * 2] = fr * br - fi * bi; o[256 + (p * 16 + c) * 2 + 1] = fr * bi + fi * br; }
    }
}
__device__ __forceinline__ float gelu_tanh_(float x) { const float u = 0.7978845608028654f * (x + 0.044715f * x * x * x); const float e = __expf(-2.f * fabsf(u)); const float th = copysignf((1.f - e) / (1.f + e), u); return 0.5f * x * (1.f + th); }

constexpr int S5_XST = 272;
constexpr int S5_UST = 48;
__device__ __forceinline__ float partner32(float v, int hi) { auto rr = __builtin_amdgcn_permlane32_swap(__float_as_uint(v), __float_as_uint(v), false, false); return __uint_as_float(hi ? rr[0] : rr[1]); }
struct S5Ctx { float l0r, l0i, l1r, l1i, q0r, q0i, q1r, q1i, dsk; char* Cm; char* Bb; char* Xs; char* Us; int lane, hi, j, rho; const bf16_t* ubase; bf16_t* ybase; };
template <bool OUT> __device__ __forceinline__ void s5_tile(const S5Ctx& C, int tok0, float& x0r, float& x0i, float& x1r, float& x1i) {
    const int hi = C.hi, j = C.j, lane = C.lane;
    if (hi == 0) { const bf16_t* up = C.ubase + (size_t)(tok0 + j) * NPAD;
        const bf16x8 w0 = *(const bf16x8*)up, w1 = *(const bf16x8*)(up + 8);
        *(bf16x8*)(C.Us + C.rho * S5_UST) = w0; *(bf16x8*)(C.Us + C.rho * S5_UST + 16) = w1; }
    asm volatile("" ::: "memory");
    f32x16 a0 = {}, a1 = {}, a2 = {}, a3 = {};
    mma_tile(a0, C.Us, S5_UST, C.Bb, S5_UST, 16, lane); mma_tile(a1, C.Us, S5_UST, C.Bb + 32 * S5_UST, S5_UST, 16, lane);
    mma_tile(a2, C.Us, S5_UST, C.Bb + 64 * S5_UST, S5_UST, 16, lane); mma_tile(a3, C.Us, S5_UST, C.Bb + 96 * S5_UST, S5_UST, 16, lane);
    float s0r[16], s0i[16], s1r[16], s1i[16];
#pragma unroll
    for (int r = 0; r < 16; ++r) {
        const float n0r = fmaf(C.l0r, x0r, fmaf(-C.l0i, x0i, a0[r])), n0i = fmaf(C.l0r, x0i, fmaf(C.l0i, x0r, a1[r])); x0r = n0r; x0i = n0i; s0r[r] = n0r; s0i[r] = n0i;
        const float n1r = fmaf(C.l1r, x1r, fmaf(-C.l1i, x1i, a2[r])), n1i = fmaf(C.l1r, x1i, fmaf(C.l1i, x1r, a3[r])); x1r = n1r; x1i = n1i; s1r[r] = n1r; s1i[r] = n1i; }
    float z0r = partner32(x0r, hi), z0i = partner32(x0i, hi), z1r = partner32(x1r, hi), z1i = partner32(x1i, hi);
    if (hi == 0) { z0r = 0.f; z0i = 0.f; z1r = 0.f; z1i = 0.f; }
    if (!OUT) {
        x0r += C.q0r * z0r - C.q0i * z0i; x0i += C.q0r * z0i + C.q0i * z0r; x1r += C.q1r * z1r - C.q1i * z1i; x1i += C.q1r * z1i + C.q1i * z1r;
    } else {
#pragma unroll
        for (int r = 0; r < 16; ++r) {
            const float t0r = C.l0r * z0r - C.l0i * z0i, t0i = C.l0r * z0i + C.l0i * z0r; z0r = t0r; z0i = t0i; s0r[r] += t0r; s0i[r] += t0i;
            const float t1r = C.l1r * z1r - C.l1i * z1i, t1i = C.l1r * z1i + C.l1i * z1r; z1r = t1r; z1i = t1i; s1r[r] += t1r; s1i[r] += t1i; }
        x0r = s0r[15]; x0i = s0i[15]; x1r = s1r[15]; x1i = s1i[15];
#pragma unroll
        for (int r = 0; r < 16; ++r) { char* xr_ = C.Xs + (r + 16 * hi) * S5_XST;
            *(bf16_t*)(xr_ + j * 2) = f2bf(s0r[r]); *(bf16_t*)(xr_ + (64 + j) * 2) = f2bf(s0i[r]);
            *(bf16_t*)(xr_ + (32 + j) * 2) = f2bf(s1r[r]); *(bf16_t*)(xr_ + (96 + j) * 2) = f2bf(s1i[r]); }
        asm volatile("" ::: "memory");
        f32x16 acc = {}; mma_tile(acc, C.Xs, S5_XST, C.Cm, S5_XST, 128, lane);
        if (j < 16) {
#pragma unroll
            for (int r = 0; r < 16; ++r) { const int t = crow32(r, hi); const int rt = ((t & 15) & 3) + 8 * ((t & 15) >> 2) + 4 * (t >> 4);
                const float y = acc[r] + C.dsk * bf2f(*(const bf16_t*)(C.Us + rt * S5_UST + j * 2));
                C.ybase[(size_t)(tok0 + t) * 512 + j] = f2bf(gelu_tanh_(y)); } }
        asm volatile("" ::: "memory");
    }
    { const float e0r = partner32(x0r, hi), e0i = partner32(x0i, hi), e1r = partner32(x1r, hi), e1i = partner32(x1i, hi);
      if (hi == 0) { x0r = e0r; x0i = e0i; x1r = e1r; x1i = e1i; } else { x0r = 0.f; x0i = 0.f; x1r = 0.f; x1i = 0.f; } }
}
__device__ __forceinline__ void unit_s5(const Params& P, int layer, int u, char* lds) {
    const int b = u >> 5, g = u & 31, tid = TIDX(), wid = tid >> 6, lane = tid & 63, hi = lane >> 5, j = lane & 31;
    char* Cm = lds;
    char* Bb = Cm + 32 * S5_XST;
    float* ends = (float*)(Bb + 128 * S5_UST);
    char* wbase = (char*)(ends + 8 * 64 * 2) + wid * (32 * S5_XST + 32 * S5_UST);
    const float* sp = P.s5p_() + (size_t)(layer * 32 + g) * S5P_STRIDE;
    __syncthreads();
    for (int i = tid; i < 32 * 128; i += NTHR) { const int c = i >> 7, pp = i & 127; float v = 0.f;
        if (c < 16) v = (pp < 64) ? P.s5_c_re[((size_t)(layer * 32 + g) * 16 + c) * 64 + pp] : -P.s5_c_im[((size_t)(layer * 32 + g) * 16 + c) * 64 + (pp - 64)];
        *(bf16_t*)(Cm + c * S5_XST + pp * 2) = f2bf(v); }
    for (int i = tid; i < 128 * 16; i += NTHR) { const int n = i >> 4, c = i & 15, nt = n >> 5, jj = n & 31, p = (nt >> 1) * 32 + jj;
        *(bf16_t*)(Bb + n * S5_UST + c * 2) = f2bf(sp[256 + (p * 16 + c) * 2 + (nt & 1)]); }
    S5Ctx C; C.Cm = Cm; C.Bb = Bb; C.Xs = wbase; C.Us = wbase + 32 * S5_XST; C.lane = lane; C.hi = hi; C.j = j;
    C.l0r = sp[2 * j]; C.l0i = sp[2 * j + 1]; C.l1r = sp[2 * (32 + j)]; C.l1i = sp[2 * (32 + j) + 1];
    { float q0r = C.l0r, q0i = C.l0i, q1r = C.l1r, q1i = C.l1i;
#pragma unroll
      for (int k = 0; k < 4; ++k) { const float a = q0r * q0r - q0i * q0i, bb = (q0r + q0r) * q0i; q0r = a; q0i = bb; const float c = q1r * q1r - q1i * q1i, d = (q1r + q1r) * q1i; q1r = c; q1i = d; }
      C.q0r = q0r; C.q0i = q0i; C.q1r = q1r; C.q1i = q1i; }
    C.dsk = P.s5_d[layer * 512 + g * 16 + (lane & 15)];
    C.rho = ((j & 15) & 3) + 8 * ((j & 15) >> 2) + 4 * (j >> 4);
    const int tokw = b * SEQ + wid * 512;
    C.ubase = P.p_() + C_SU + g * 16; C.ybase = P.ybuf_() + g * 16;
    float x0r = 0.f, x0i = 0.f, x1r = 0.f, x1i = 0.f;
    __syncthreads();
    for (int sc = 0; sc < 16; ++sc) s5_tile<false>(C, tokw + sc * 32, x0r, x0i, x1r, x1i);
    if (hi == 0) { ends[(wid * 64 + j) * 2] = x0r; ends[(wid * 64 + j) * 2 + 1] = x0i; ends[(wid * 64 + 32 + j) * 2] = x1r; ends[(wid * 64 + 32 + j) * 2 + 1] = x1i; }
    __syncthreads();
    { const float p0r = sp[128 + 2 * j], p0i = sp[128 + 2 * j + 1], p1r = sp[128 + 2 * (32 + j)], p1i = sp[128 + 2 * (32 + j) + 1];
      x0r = 0.f; x0i = 0.f; x1r = 0.f; x1i = 0.f;
      for (int w = 0; w < wid; ++w) { const float e0r = ends[(w * 64 + j) * 2], e0i = ends[(w * 64 + j) * 2 + 1], e1r = ends[(w * 64 + 32 + j) * 2], e1i = ends[(w * 64 + 32 + j) * 2 + 1];
          const float n0r = p0r * x0r - p0i * x0i + e0r, n0i = p0r * x0i + p0i * x0r + e0i, n1r = p1r * x1r - p1i * x1i + e1r, n1i = p1r * x1i + p1i * x1r + e1i;
          x0r = n0r; x0i = n0i; x1r = n1r; x1i = n1i; }
      if (hi) { x0r = 0.f; x0i = 0.f; x1r = 0.f; x1i = 0.f; } }
    for (int sc = 0; sc < 16; ++sc) s5_tile<true>(C, tokw + sc * 32, x0r, x0i, x1r, x1i);
}
constexpr int TOPK = 256;
__device__ __forceinline__ unsigned f2key(float f) { const unsigned u = __float_as_uint(f); return u ^ ((u & 0x80000000u) ? 0xffffffffu : 0x80000000u); }

__device__ __forceinline__ float relu1(float x) { const int b = __float_as_int(x); return __int_as_float(b > 0 ? b : 0); }
#define DSA_MM(acc, rt, kk) acc = __builtin_amdgcn_mfma_f32_32x32x16_bf16(afr[rt][kk], bfr[kk], acc, 0, 0, 0)
#define DSA_HS(acc, rt, q) do { s0 = fmaf(relu1(acc[4 * (q)]), wv[rt][4 * (q)], s0); s1 = fmaf(relu1(acc[4 * (q) + 1]), wv[rt][4 * (q) + 1], s1); \
                                s0 = fmaf(relu1(acc[4 * (q) + 2]), wv[rt][4 * (q) + 2], s0); s1 = fmaf(relu1(acc[4 * (q) + 3]), wv[rt][4 * (q) + 3], s1); } while (0)
#define DSA_SG() do { __builtin_amdgcn_sched_group_barrier(0x8, 1, 0); __builtin_amdgcn_sched_group_barrier(0x2, 8, 0); } while (0)
__device__ __forceinline__ void dsa_score_tile(const bf16x8 (&afr)[4][4], const f32x16 (&wv)[4], const bf16x8 (&bfr)[4], float* sc, int col, int hi) {
    f32x16 accA = {}, accB = {}; asm volatile("" : "+v"(accA), "+v"(accB));
    float s0, s1;
    DSA_MM(accA, 0, 0); DSA_MM(accA, 0, 1); DSA_MM(accA, 0, 2); DSA_MM(accA, 0, 3);
    s0 = 0.f; s1 = 0.f;
    DSA_MM(accB, 1, 0); DSA_HS(accA, 0, 0); DSA_SG(); DSA_MM(accB, 1, 1); DSA_HS(accA, 0, 1); DSA_SG();
    DSA_MM(accB, 1, 2); DSA_HS(accA, 0, 2); DSA_SG(); DSA_MM(accB, 1, 3); DSA_HS(accA, 0, 3); DSA_SG();
    sc[(0 + hi) * 4096 + col] = (s0 + s1) + 0.f;
    accA = (f32x16){}; asm volatile("" : "+v"(accA)); s0 = 0.f; s1 = 0.f;
    DSA_MM(accA, 2, 0); DSA_HS(accB, 1, 0); DSA_SG(); DSA_MM(accA, 2, 1); DSA_HS(accB, 1, 1); DSA_SG();
    DSA_MM(accA, 2, 2); DSA_HS(accB, 1, 2); DSA_SG(); DSA_MM(accA, 2, 3); DSA_HS(accB, 1, 3); DSA_SG();
    sc[(2 + hi) * 4096 + col] = (s0 + s1) + 0.f;
    accB = (f32x16){}; asm volatile("" : "+v"(accB)); s0 = 0.f; s1 = 0.f;
    DSA_MM(accB, 3, 0); DSA_HS(accA, 2, 0); DSA_SG(); DSA_MM(accB, 3, 1); DSA_HS(accA, 2, 1); DSA_SG();
    DSA_MM(accB, 3, 2); DSA_HS(accA, 2, 2); DSA_SG(); DSA_MM(accB, 3, 3); DSA_HS(accA, 2, 3); DSA_SG();
    sc[(4 + hi) * 4096 + col] = (s0 + s1) + 0.f;
    s0 = 0.f; s1 = 0.f;
    DSA_HS(accB, 3, 0); DSA_HS(accB, 3, 1); DSA_HS(accB, 3, 2); DSA_HS(accB, 3, 3);
    sc[(6 + hi) * 4096 + col] = (s0 + s1) + 0.f;
}
#define DSA_CNT4(K0, K1, K2, K3) asm volatile( \
    "v_cmp_ge_u32_e64 %[m0], %[k0], %[cd]\n\tv_cmp_ge_u32_e64 %[m1], %[k1], %[cd]\n\tv_cmp_ge_u32_e64 %[m2], %[k2], %[cd]\n\tv_cmp_ge_u32_e64 %[m3], %[k3], %[cd]\n\t" \
    "v_addc_co_u32_e64 %[a0], %[m0], %[a0], 0, %[m0]\n\tv_addc_co_u32_e64 %[a1], %[m1], %[a1], 0, %[m1]\n\t" \
    "v_addc_co_u32_e64 %[a0], %[m2], %[a0], 0, %[m2]\n\tv_addc_co_u32_e64 %[a1], %[m3], %[a1], 0, %[m3]" \
    : [a0] "+v"(c0), [a1] "+v"(c1), [m0] "=&s"(sm0), [m1] "=&s"(sm1), [m2] "=&s"(sm2), [m3] "=&s"(sm3) \
    : [k0] "v"(K0), [k1] "v"(K1), [k2] "v"(K2), [k3] "v"(K3), [cd] "v"(cand))
#define DSA_CNT8(J0) do { DSA_CNT4(key[(J0)], key[(J0) + 1], key[(J0) + 2], key[(J0) + 3]); DSA_CNT4(key[(J0) + 4], key[(J0) + 5], key[(J0) + 6], key[(J0) + 7]); } while (0)

__device__ __forceinline__ void unit_dsa_index(const Params& P, int u, char* lds) {
    const int b = u & 3, t0 = (511 - (u >> 2)) * 8;
    const int tid = TIDX(), wid = tid >> 6, lane = tid & 63, r32 = lane & 31, hi = lane >> 5;
    float* sc = (float*)lds;
    const bf16_t* pb = P.p_() + (size_t)b * SEQ * NPAD;
    __syncthreads();
    {
        bf16x8 afr[4][4]; f32x16 wv[4];
        const int qsel = (r32 >> 2) & 1, head = (r32 & 3) + 4 * (r32 >> 3);
#pragma unroll
        for (int rt = 0; rt < 4; ++rt) { const bf16_t* qp = pb + (size_t)(t0 + 2 * rt + qsel) * NPAD + C_DIQ + head * 64 + hi * 8;
#pragma unroll
            for (int kk = 0; kk < 4; ++kk) afr[rt][kk] = *(const bf16x8*)(qp + kk * 16);
            const float* wp = P.iw_() + (size_t)(b * SEQ + t0 + 2 * rt + hi) * 16;
#pragma unroll
            for (int i = 0; i < 4; ++i) { const f32x4 w4 = *(const f32x4*)(wp + 4 * i); wv[rt][4 * i] = w4[0]; wv[rt][4 * i + 1] = w4[1]; wv[rt][4 * i + 2] = w4[2]; wv[rt][4 * i + 3] = w4[3]; } }
        const int ntile = (t0 + 7) / 32 + 1;
        const bf16_t* kp = P.ikc_() + (size_t)(b * (SEQ / 32)) * 2048 + lane * 8;
        bf16x8 b0[4], b1[4], b2[4];
#define DSA_LDB(dst, K) do { const bf16_t* kq_ = kp + (size_t)(wid + 8 * (K)) * 2048; _Pragma("unroll") for (int kk = 0; kk < 4; ++kk) dst[kk] = *(const bf16x8*)(kq_ + kk * 512); } while (0)
#define DSA_TILE(buf, K) dsa_score_tile(afr, wv, buf, sc, (wid + 8 * (K)) * 32 + r32, hi)
        const int nk = (ntile - wid + 7) >> 3;
        const int kl = nk > 0 ? nk - 1 : 0;
#define DSA_MIN(a) ((a) < kl ? (a) : kl)
        DSA_LDB(b0, DSA_MIN(0)); DSA_LDB(b1, DSA_MIN(1));
        int k = 0;
        for (; k + 3 <= nk; k += 3) {
            DSA_LDB(b2, k + 2); DSA_TILE(b0, k);
            DSA_LDB(b0, DSA_MIN(k + 3)); DSA_TILE(b1, k + 1);
            DSA_LDB(b1, DSA_MIN(k + 4)); DSA_TILE(b2, k + 2);
        }
        if (k < nk) DSA_TILE(b0, k);
        if (k + 1 < nk) DSA_TILE(b1, k + 1);
#undef DSA_TILE
#undef DSA_MIN
#undef DSA_TILE
#undef DSA_LDB
    }
    __syncthreads();
    {
        const int t = t0 + wid; const float* srow = sc + wid * 4096;
        unsigned key[64];
#pragma unroll
        for (int j = 0; j < 64; ++j) { const int s = j * 64 + lane; key[j] = (s <= t) ? f2key(srow[s]) : 0u; }
        unsigned long long* mout = P.mask_() + (size_t)(b * SEQ + t) * 64;
        unsigned long long myword = 0ull;
        if (t + 1 <= TOPK) {
#pragma unroll
            for (int j = 0; j < 64; ++j) { const unsigned long long m = __ballot(j * 64 + lane <= t); if (lane == j) myword = m; }
        } else {
            const int ngrp = t / 512 + 1;
            unsigned* hist = (unsigned*)(sc + wid * 4096);
            asm volatile("" ::: "memory");
            { const u32x4 zz4 = {0u, 0u, 0u, 0u};
#pragma unroll
              for (int i = 0; i < 16; ++i) *(u32x4*)(hist + (i * 64 + lane) * 4) = zz4; }
            asm volatile("" ::: "memory");
#define DSA_H8(J0) do { _Pragma("unroll") for (int jj = 0; jj < 8; ++jj) atomicAdd(hist + (key[(J0) + jj] >> 20), 1u); } while (0)
            DSA_H8(0);
            if (ngrp > 1) DSA_H8(8);
            if (ngrp > 2) DSA_H8(16);
            if (ngrp > 3) DSA_H8(24);
            if (ngrp > 4) DSA_H8(32);
            if (ngrp > 5) DSA_H8(40);
            if (ngrp > 6) DSA_H8(48);
            if (ngrp > 7) DSA_H8(56);
#undef DSA_H8
            asm volatile("" ::: "memory");
#define DSA_SUFFIX(s) do { _Pragma("unroll") for (int o = 1; o < 64; o <<= 1) { unsigned t_ = (unsigned)__builtin_amdgcn_ds_bpermute(((lane + o) & 63) << 2, (int)(s)); (s) += (lane + o < 64) ? t_ : 0u; } } while (0)
            unsigned mine = 0u;
#pragma unroll
            for (int i = 0; i < 16; ++i) { const u32x4 v4 = *(const u32x4*)(hist + lane * 64 + ((i + lane) & 15) * 4); mine += (v4[0] + v4[1]) + (v4[2] + v4[3]); }
            unsigned suf = mine; DSA_SUFFIX(suf);
            const unsigned long long mL = __ballot(suf - mine < (unsigned)TOPK && suf >= (unsigned)TOPK);
            const int Ls = (int)__builtin_ctzll(mL);
            const unsigned cntA = (unsigned)__builtin_amdgcn_readlane((int)(suf - mine), Ls);
            unsigned h2 = hist[Ls * 64 + lane]; unsigned suf2 = h2; DSA_SUFFIX(suf2);
            const unsigned long long mB = __ballot(cntA + suf2 - h2 < (unsigned)TOPK && cntA + suf2 >= (unsigned)TOPK);
            const int Bs = (int)__builtin_ctzll(mB);
            const unsigned bstar = (unsigned)(Ls * 64 + Bs);
            const unsigned cntAbove = cntA + (unsigned)__builtin_amdgcn_readlane((int)(suf2 - h2), Bs);
            const unsigned inbin = (unsigned)__builtin_amdgcn_readlane((int)h2, Bs);
#undef DSA_SUFFIX
            unsigned T = bstar << 20; int cntT = (int)(cntAbove + inbin);
            if (cntT != TOPK) {
                asm volatile("" ::: "memory");
                int nslot = 0;
#pragma unroll
                for (int j = 0; j < 64; ++j) { if ((key[j] >> 20) == bstar) { hist[nslot * 64 + lane] = key[j]; ++nslot; } }
                asm volatile("" ::: "memory");
                int R = nslot;
#pragma unroll
                for (int o = 32; o >= 1; o >>= 1) { const int other = __builtin_amdgcn_ds_bpermute(((lane ^ o) << 2), R); R = other > R ? other : R; }
                R = __builtin_amdgcn_readfirstlane(R);
                if (R <= 8) {
                    unsigned c[8];
#pragma unroll
                    for (int r = 0; r < 8; ++r) c[r] = (r < nslot) ? hist[r * 64 + lane] : 0u;
                    for (int bit = 19; bit >= 0; --bit) {
                        const unsigned cand = T | (1u << bit); int cnt = (int)cntAbove;
#pragma unroll
                        for (int r = 0; r < 8; ++r) cnt += __popcll(__ballot(c[r] >= cand));
                        if (cnt >= TOPK) { T = cand; cntT = cnt; if (cnt == TOPK) break; }
                    }
                } else {
                    for (int bit = 19; bit >= 0; --bit) {
                        const unsigned cand = T | (1u << bit); unsigned c0 = 0, c1 = 0; unsigned long long sm0, sm1, sm2, sm3;
                        DSA_CNT8(0);
                        if (ngrp > 1) DSA_CNT8(8);
                        if (ngrp > 2) DSA_CNT8(16);
                        if (ngrp > 3) DSA_CNT8(24);
                        if (ngrp > 4) DSA_CNT8(32);
                        if (ngrp > 5) DSA_CNT8(40);
                        if (ngrp > 6) DSA_CNT8(48);
                        if (ngrp > 7) DSA_CNT8(56);
                        const int cl = (int)(c0 + c1);
                        int cnt = 0;
#pragma unroll
                        for (int bb = 0; bb < 7; ++bb) cnt += __popcll(__ballot((cl >> bb) & 1)) << bb;
                        if (cnt >= TOPK) { T = cand; cntT = cnt; if (cnt == TOPK) break; }
                    }
                }
            }
            if (cntT == TOPK) {
#pragma unroll
                for (int j = 0; j < 64; ++j) { const unsigned long long m = __ballot(key[j] >= T); if (lane == j) myword = m; }
            } else {
                int ngt = 0;
#pragma unroll
                for (int j = 0; j < 64; ++j) ngt += __popcll(__ballot(key[j] > T));
                int need = TOPK - ngt;
#pragma unroll
                for (int j = 0; j < 64; ++j) { const unsigned long long eq = __ballot(key[j] == T), gt = __ballot(key[j] > T);
                    const int ne = __popcll(eq); unsigned long long take = eq;
                    if (ne > need) { take = 0ull; int left = need; unsigned long long e2 = eq;
                        while (left > 0) { const unsigned long long lowbit = e2 & (0ull - e2); take |= lowbit; e2 ^= lowbit; --left; } }
                    need -= (ne > need) ? need : ne;
                    const unsigned long long m = gt | take; if (lane == j) myword = m; }
            }
        }
        mout[lane] = myword;
    }
}

struct DsaOutRow { const bf16_t* zb; bf16_t* gb; int wid;
    __device__ __forceinline__ const bf16_t* zrow(int r) const { const int rho = wid * 32 + r; return zb + (size_t)(rho >> 2) * NPAD + (rho & 3) * 128; }
    __device__ __forceinline__ bf16_t* grow(int r) const { const int rho = wid * 32 + r; return gb + (size_t)(rho >> 2) * MIX + (rho & 3) * 128; } };
__device__ __forceinline__ void unit_dsa_attn(const Params& P, int u, char* lds) {
    const int b = u & 3, qb = 63 - (u >> 2), t0 = qb * 64, tokb = b * SEQ;
    const int wid = TIDX() >> 6, lane = TIDX() & 63, r32 = lane & 31, hi = lane >> 5;
    const int rho = wid * 32 + r32, tq = t0 + (rho >> 2), hq = rho & 3;
    const bf16_t* Qw = P.p_() + (size_t)(tokb + tq) * NPAD + C_DQ + hq * 128 + hi * 8;
    const bf16_t* Kh = P.kvc_() + (size_t)tokb * 256;
    const unsigned moff = (unsigned)(tokb + tq) * 512u;
    DsaOutRow ow; ow.zb = P.p_() + (size_t)(tokb + t0) * NPAD + C_DZ; ow.gb = P.xn_() + (size_t)(tokb + t0) * MIX + 1024; ow.wid = wid;
    const int NT = (qb + 2) & ~1;
    att::attn_body<true, 256, 128, DsaOutRow>(Qw, Kh, NT, P.mask_(), moff, ow, lds);
}
__device__ __forceinline__ void phase_gemm_glu(const Params& P, int layer, char* lds) {
    pg8::Gemm g; g.A = P.ybuf_(); g.Bt = P.WgluT_() + (size_t)layer * 512 * 512; g.M = NTOK; g.N = 512; g.K = 512;
    pg8::StaticOrder S; S.init(g.M, g.N, (int)gridDim.x, (int)blockIdx.x);
    pg8::EpiGlu E; E.Y = P.ybuf_(); E.ldy = 512; E.O = P.ocat_(); E.ldo = MIX; E.ooff = 512;
    pg8::gemm_phase<pg8::EpiGlu, pg8::StaticOrder, false>((PG8_LAS unsigned char*)lds, g, S, E, nullptr);
}

constexpr int CTL_Q0 = 4096;
struct OneUnit { int pm, pn; __device__ __forceinline__ bool next(int i, pg8::Unit& u) const { if (i) return false; u.pm = pm; u.pn = pn; return true; }
    __device__ __forceinline__ void a_ready(const pg8::Unit&) const {} __device__ __forceinline__ void done(const pg8::Unit&) const {} };
__device__ __forceinline__ int q_issue(unsigned* ctr) { return (int)__hip_atomic_fetch_add(ctr, 1u, __ATOMIC_RELAXED, __HIP_MEMORY_SCOPE_AGENT); }
#define Q_LOOP_BEGIN(ctr, total)  { unsigned* q_ctr_ = (ctr); const int q_total_ = (total); volatile int* q_b_ = (volatile int*)(lds + LDS_TAIL + 16); \
    for (;;) { __syncthreads(); if (TIDX() == 0) *q_b_ = q_issue(q_ctr_); __syncthreads(); const int item = __builtin_amdgcn_readfirstlane(*q_b_); if (item >= q_total_) break;
#define Q_LOOP_END  } }
__device__ __forceinline__ void unit_glu(const Params& P, int layer, int u, char* lds) {
    pg8::Gemm g; g.A = P.ybuf_(); g.Bt = P.WgluT_() + (size_t)layer * 512 * 512; g.M = NTOK; g.N = 512; g.K = 512;
    OneUnit S; S.pm = u >> 1; S.pn = u & 1;
    pg8::EpiGluGate E; E.Y = P.ybuf_(); E.Pz = P.p_(); E.G = P.xn_();
    pg8::gemm_phase<pg8::EpiGluGate, OneUnit, false>((PG8_LAS unsigned char*)lds, g, S, E, nullptr);
}
constexpr int LDS_TAIL = LDS_BYTES - 64;

__global__ __launch_bounds__(NTHR, 2) void k_mega(Params P) {
    extern __shared__ __attribute__((aligned(16))) char lds[];
    if (TIDX() == 0) *(uint4*)(lds + LDS_TAIL) = make_uint4(0u, 0u, 0u, 0u);
    __syncthreads();
    XcdBarrier bar = xcd_barrier_post(P.ctl_(), (volatile LAS unsigned*)(lds + LDS_TAIL));
    const int G = gridDim.x, B = blockIdx.x;
    phase_prologue1(P, lds); phase_rope_table(P); phase_s5_params(P); phase_rmsnorm_x(P, 0);
    xcd_barrier(bar);
    for (int layer = 0; layer < DEPTH; ++layer) {
        if (layer > 0) { phase_rmsnorm_x(P, layer); xcd_barrier(bar); }
        phase_gemm_in(P, layer, lds);
        if (layer == 0) phase_gemm_kv(P, lds);
        xcd_barrier(bar);
        phase_prep(P, layer);
        if (layer == 0) phase_memk_norm(P);
        for (int u = B; u < 1024; u += G) unit_gla_a(P, layer, u, lds);
        xcd_barrier(bar);
        Q_LOOP_BEGIN(P.ctl_() + CTL_Q0 + 64 * (layer * 2), 128 + 2048 + 256 + 256)
            if (item < 128) unit_s5(P, layer, item, lds);
            else if (item < 2176) unit_dsa_index(P, item - 128, lds);
            else if (item < 2432) unit_mem_attn(P, layer, item - 2176, lds);
            else gla_scan_slice(P, (item - 2432) * NTHR + TIDX());
        Q_LOOP_END
        xcd_barrier(bar);
        Q_LOOP_BEGIN(P.ctl_() + CTL_Q0 + 64 * (layer * 2 + 1), 256 + 256 + 128)
            if (item < 256) unit_dsa_attn(P, item, lds);
            else if (item < 512) { for (int k = 0; k < 4; ++k) unit_gla_c(P, layer, (item - 256) * 4 + k, lds); }
            else unit_glu(P, layer, item - 512, lds);
        Q_LOOP_END
        xcd_barrier(bar);
        phase_gemm_out(P, layer, lds);
        xcd_barrier(bar);
    }
}

extern "C" void kernel_launch(void* const* d_in, const int* in_sizes, int n_in, void* d_out, int out_size, void* d_ws, size_t ws_size, hipStream_t stream) {
    if (n_in != 24 || ws_size < WS_END) { fprintf(stderr, "kernel_launch: unexpected n_in %d or ws_size %zu (< %zu)\n", n_in, ws_size, (size_t)WS_END); return; }
    Params P; memset(&P, 0, sizeof(P));
    P.x = (const float*)d_in[0]; P.mem = (const float*)d_in[1]; P.pos = (const int*)d_in[2]; P.ln_gain = (const float*)d_in[3]; P.w_in = (const float*)d_in[4];
    P.gla_w_up = (const float*)d_in[5]; P.gla_b_up = (const float*)d_in[6]; P.s5_a_re = (const float*)d_in[7]; P.s5_a_im = (const float*)d_in[8]; P.s5_log_step = (const float*)d_in[9];
    P.s5_b_re = (const float*)d_in[10]; P.s5_b_im = (const float*)d_in[11]; P.s5_c_re = (const float*)d_in[12]; P.s5_c_im = (const float*)d_in[13]; P.s5_d = (const float*)d_in[14];
    P.s5_w_glu = (const float*)d_in[15]; P.dsa_q_norm = (const float*)d_in[16]; P.dsa_k_norm = (const float*)d_in[17]; P.mem_norm = (const float*)d_in[18]; P.w_mem_kv = (const float*)d_in[19];
    P.mem_q_norm = (const float*)d_in[20]; P.mem_k_norm = (const float*)d_in[21]; P.out_norm = (const float*)d_in[22]; P.w_out = (const float*)d_in[23];
    P.out = (float*)d_out;
    char* ws = (char*)d_ws; P.ws = ws;
    static int grid = 0;
    if (!grid) {
        int dev = 0, cus = 0, per_cu = 0;
        (void)hipGetDevice(&dev); (void)hipDeviceGetAttribute(&cus, hipDeviceAttributeMultiprocessorCount, dev);
        (void)hipFuncSetAttribute((const void*)k_mega, hipFuncAttributeMaxDynamicSharedMemorySize, LDS_BYTES);
        (void)hipOccupancyMaxActiveBlocksPerMultiprocessor(&per_cu, (const void*)k_mega, NTHR, LDS_BYTES);
        if (per_cu < 1) fprintf(stderr, "kernel_launch: occupancy query reports %d blocks per CU\n", per_cu);
        grid = cus > 0 ? cus : 256;
    }
    (void)hipMemsetAsync(ws + WS_CTL, 0, CTL_BYTES, stream);
    hipLaunchKernelGGL(k_mega, dim3(grid), dim3(NTHR), LDS_BYTES, stream, P);
}
```

```cpp
#include <hip/hip_runtime.h>
#include <stdint.h>
#include <stdio.h>
#include <string.h>

constexpr int NB = 4, SEQ = 4096, NTOK = NB * SEQ, DM = 2048, DEPTH = 4, MEML = 256;
constexpr int NIN = 5984, NPAD = 6144, MIX = 2048;
constexpr int C_GQ = 0, C_GK = 256, C_GV = 512, C_GLR = 1024, C_GZ = 1040, C_SU = 1552, C_SZ = 2064, C_DQ = 2576, C_DK = 3088, C_DV = 3216,
              C_DIQ = 3344, C_DIK = 4368, C_DIW = 4432, C_DZ = 4448, C_MQ = 4960, C_MZ = 5472;
constexpr float EPS = 1e-6f;
constexpr int NTHR = 512;
constexpr int LDS_BYTES = 147456;

typedef unsigned short bf16_t;
typedef short bf16x8 __attribute__((ext_vector_type(8)));
typedef short s16x4 __attribute__((ext_vector_type(4)));
typedef float f32x4 __attribute__((ext_vector_type(4)));
typedef float f32x8 __attribute__((ext_vector_type(8)));
typedef float f32x16 __attribute__((ext_vector_type(16)));
typedef unsigned u32x4 __attribute__((ext_vector_type(4)));
typedef unsigned u32x2 __attribute__((ext_vector_type(2)));
#define LAS __attribute__((address_space(3)))

__device__ __forceinline__ float bf2f(bf16_t b) { return __uint_as_float(((unsigned)b) << 16); }
__device__ __forceinline__ bf16_t f2bf(float f) { unsigned u = __float_as_uint(f); u += 0x7FFFu + ((u >> 16) & 1u); return (bf16_t)(u >> 16); }
__device__ __forceinline__ unsigned pk2bf(float lo, float hi) { return (unsigned)f2bf(lo) | ((unsigned)f2bf(hi) << 16); }
__device__ __forceinline__ float sigmoidf_(float x) { return 1.f / (1.f + __expf(-x)); }
__device__ __forceinline__ float siluf_(float x) { return x / (1.f + __expf(-x)); }

__device__ __forceinline__ int TIDX() { int t = (int)threadIdx.x; asm volatile("" : "+v"(t)); return t; }
__device__ __forceinline__ float shx(float v, int m) { const int src = ((TIDX() & 63) ^ m) << 2; return __int_as_float(__builtin_amdgcn_ds_bpermute(src, __float_as_int(v))); }
__device__ __forceinline__ float wave_sum(float v) {
#pragma unroll
    for (int o = 32; o >= 1; o >>= 1) v += shx(v, o);
    return v;
}
__device__ __forceinline__ void ld8f(const bf16_t* p, float (&v)[8]) { const u32x4 w = *(const u32x4*)p;
#pragma unroll
    for (int j = 0; j < 4; ++j) { v[2 * j] = __uint_as_float(w[j] << 16); v[2 * j + 1] = __uint_as_float(w[j] & 0xffff0000u); } }
__device__ __forceinline__ void st8f(bf16_t* p, const float (&v)[8]) { u32x4 w; w.x = pk2bf(v[0], v[1]); w.y = pk2bf(v[2], v[3]); w.z = pk2bf(v[4], v[5]); w.w = pk2bf(v[6], v[7]); *(u32x4*)p = w; }
__device__ __forceinline__ float f2bf_f(float f) { return bf2f(f2bf(f)); }
#define XB_TMO      128
#define XB_XCNT(j)  (256  + 64 * (j))
#define XB_XSUB(j)  (1280 + 64 * (j))
#define XB_XGEN(j)  (2304 + 64 * (j))
#define XB_TOP      3328
#define XB_TOPGEN   3392
#define XCD_BAR_WORDS 3456
#define XB_SPIN_CAP (1u << 18)

__device__ __forceinline__ unsigned xb_ld(unsigned* p)              { return __hip_atomic_load(p, __ATOMIC_RELAXED, __HIP_MEMORY_SCOPE_AGENT); }
__device__ __forceinline__ unsigned xb_add(unsigned* p, unsigned v) { return __hip_atomic_fetch_add(p, v, __ATOMIC_RELAXED, __HIP_MEMORY_SCOPE_AGENT); }
__device__ __forceinline__ unsigned xb_xcc_id() { return (unsigned)__builtin_amdgcn_s_getreg((3 << 11) | 20) & 0xFu; }
#define XB_SPIN(cond, bar) do { unsigned _sp = 0; while (cond) { __builtin_amdgcn_s_sleep(1); \
    if ((++_sp & 255u) == 0u) { if (xb_ld(&(bar)[XB_TMO])) break; if (_sp > XB_SPIN_CAP) { atomicAdd(&(bar)[XB_TMO], 1u); break; } } } } while (0)

struct XcdBarrier {
    unsigned* bar; unsigned x;
    volatile LAS unsigned* st;
};

__device__ __forceinline__ XcdBarrier xcd_barrier_post(unsigned* bar, volatile LAS unsigned* st) {
    XcdBarrier b; b.bar = bar; b.x = xb_xcc_id(); b.st = st;
    if (TIDX() == 0) (void)xb_add(&bar[XB_XCNT(b.x)], 1u);
    return b;
}
__device__ __forceinline__ void xcd_barrier_complete(unsigned* bar, unsigned x, unsigned& nloc, unsigned& nx) {
    const unsigned G = gridDim.x * gridDim.y * gridDim.z;
    unsigned sum, cnt, mine, sp = 0u;
    for (;;) {
        sum = 0u; cnt = 0u; mine = 0u;
#pragma unroll
        for (unsigned j = 0; j < 16; ++j) { const unsigned c = xb_ld(&bar[XB_XCNT(j)]); sum += c; cnt += (c > 0u) ? 1u : 0u; mine = (j == x) ? c : mine; }
        if (sum == G) break;
        __builtin_amdgcn_s_sleep(1);
        if ((++sp & 255u) == 0u) { if (xb_ld(&bar[XB_TMO])) break; if (sp > XB_SPIN_CAP) { atomicAdd(&bar[XB_TMO], 1u); break; } }
    }
    nloc = mine > 0u ? mine : 1u; nx = cnt > 0u ? cnt : 1u;
}

__device__ __forceinline__ void xcd_barrier(const XcdBarrier& b) {
    asm volatile("s_waitcnt vmcnt(0)" ::: "memory");
    __syncthreads();
    if (TIDX() == 0) {
        unsigned* bar = b.bar; const unsigned bx = xb_xcc_id();
        __builtin_amdgcn_s_waitcnt(0);
        unsigned nloc = b.st[0], nx = b.st[1];
        if (nloc == 0u) { xcd_barrier_complete(bar, bx, nloc, nx); b.st[0] = nloc; b.st[1] = nx; }
        const unsigned old = xb_add(&bar[XB_XSUB(bx)], 1u);
        const unsigned gen = old / nloc;
        if (old + 1u == (gen + 1u) * nloc) {
            __builtin_amdgcn_fence(__ATOMIC_RELEASE, "agent");
            asm volatile("s_waitcnt vmcnt(0)" ::: "memory");
            const unsigned og = xb_add(&bar[XB_TOP], 1u);
            const unsigned tg = og / nx;
            if (og + 1u == (tg + 1u) * nx) xb_add(&bar[XB_TOPGEN], 1u);
            else XB_SPIN(xb_ld(&bar[XB_TOPGEN]) == tg, bar);
            __builtin_amdgcn_fence(__ATOMIC_ACQUIRE, "agent");
            xb_add(&bar[XB_XGEN(bx)], 1u);
            asm volatile("s_waitcnt vmcnt(0)" ::: "memory");
        } else {
            XB_SPIN(xb_ld(&bar[XB_XGEN(bx)]) == gen, bar);
            __builtin_amdgcn_fence(__ATOMIC_ACQUIRE, "agent");
            asm volatile("s_waitcnt vmcnt(0)" ::: "memory");
        }
    }
    __syncthreads();
}
namespace pg8 {
#define PG8_LAS __attribute__((address_space(3)))
typedef float f32x2 __attribute__((ext_vector_type(2)));
typedef unsigned u32x4 __attribute__((ext_vector_type(4)));
constexpr int BM = 256, BK = 64, HALF = 128, HTB = HALF * BK * 2  , STAGE_BYTES = 8 * HTB, NXCD = 8, WGM = 8;

__host__ __device__ __forceinline__ int lds_byte(int r, int c) { const int st = (r >> 4) * 2 + (c >> 5), rr = r & 15, cc = c & 31, ob = rr * 64 + cc * 2; return st * 1024 + (ob ^ (((ob >> 9) & 1) << 5)); }
__host__ __device__ __forceinline__ void stage_rc(int b, int& R, int& C) { const int st = b / 1024, sb = b % 1024, swz = sb ^ (((sb >> 9) & 1) << 5); R = (st >> 1) * 16 + swz / 64; C = (st & 1) * 32 + (swz % 64) / 2; }
__host__ __device__ __forceinline__ int perm32(int rho) { const int n = rho >> 4, i = rho & 15; return 8 * (i >> 2) + 4 * n + (i & 3); }

struct Unit { int pm, pn; };
struct Gemm { const bf16_t* A; const bf16_t* Bt; int M, N, K; };

struct StaticOrder {
    int nM, nN, nwg, G, c;
    __host__ __device__ void init(int M, int N, int G_, int c_) { nM = M / BM; nN = N / BM; nwg = nM * nN; G = G_; c = c_; }
    __host__ __device__ bool next(int i, Unit& u) const {
        const long L = (long)i * G + c; if (L >= nwg) return false;
        int wgid = (int)L; { const int q = nwg / NXCD, r = nwg % NXCD, xcd = wgid % NXCD, off = wgid / NXCD; wgid = (xcd < r ? xcd * (q + 1) : r * (q + 1) + (xcd - r) * q) + off; }
        const int nig = WGM * nN, gid = wgid / nig, fm = gid * WGM, gsz = (nM - fm) < WGM ? (nM - fm) : WGM;
        u.pm = fm + ((wgid % nig) % gsz); u.pn = (wgid % nig) / gsz; return true;
    }
    __device__ __forceinline__ void a_ready(const Unit&) const {}
    __device__ __forceinline__ void done(const Unit&) const {}
};
__device__ __forceinline__ unsigned cvt_pk_bf16(float lo, float hi) { unsigned r; asm volatile("v_cvt_pk_bf16_f32 %0, %1, %2" : "=v"(r) : "v"(lo), "v"(hi)); return r; }
struct EpiBf16Plain {
    static constexpr bool PERM = true, AFTER_DRAIN = false;
    bf16_t* O; int ldc;
    __device__ __forceinline__ void operator()(const f32x4 (&acc)[2][2][4][2], const Unit& u, int wr, int wc, int fr, int fq) const {
        const int row0 = u.pm * BM + wr * 64 + fr, col0 = u.pn * BM + wc * 32 + 8 * fq;
#pragma unroll
        for (int ai = 0; ai < 2; ++ai)
#pragma unroll
            for (int m = 0; m < 4; ++m) { bf16_t* rowp = O + (size_t)(row0 + ai * HALF + m * 16) * ldc + col0;
#pragma unroll
                for (int bj = 0; bj < 2; ++bj) { const f32x4 v0 = acc[ai][bj][m][0], v1 = acc[ai][bj][m][1];
                    u32x4 w; w.x = cvt_pk_bf16(v0[0], v0[1]); w.y = cvt_pk_bf16(v0[2], v0[3]); w.z = cvt_pk_bf16(v1[0], v1[1]); w.w = cvt_pk_bf16(v1[2], v1[3]);
                    *(u32x4*)(rowp + bj * HALF) = w; } }
    }
};
struct EpiResid {
    static constexpr bool PERM = false, AFTER_DRAIN = false;
    const float* R; float* C; int ldc;
    __device__ __forceinline__ void operator()(const f32x4 (&acc)[2][2][4][2], const Unit& u, int wr, int wc, int fr, int fq) const {
        const int row0 = u.pm * BM + wr * 64 + fr, col0 = u.pn * BM + wc * 32 + 4 * fq;
#pragma unroll
        for (int ai = 0; ai < 2; ++ai)
#pragma unroll
            for (int m = 0; m < 4; ++m) { const size_t off = (size_t)(row0 + ai * HALF + m * 16) * ldc + col0;
#pragma unroll
                for (int bj = 0; bj < 2; ++bj)
#pragma unroll
                    for (int n = 0; n < 2; ++n) { const f32x4 r = *(const f32x4*)(R + off + bj * HALF + n * 16); *(f32x4*)(C + off + bj * HALF + n * 16) = acc[ai][bj][m][n] + r; } }
    }
};
struct EpiGlu {
    static constexpr bool PERM = true, AFTER_DRAIN = false;
    const bf16_t* Y; int ldy; bf16_t* O; int ldo; int ooff;
    __device__ __forceinline__ void operator()(const f32x4 (&acc)[2][2][4][2], const Unit& u, int wr, int wc, int fr, int fq) const {
        const int row0 = u.pm * BM + wr * 64 + fr, col0 = u.pn * BM + wc * 32 + 8 * fq;
#pragma unroll
        for (int ai = 0; ai < 2; ++ai)
#pragma unroll
            for (int m = 0; m < 4; ++m) { const int row = row0 + ai * HALF + m * 16;
#pragma unroll
                for (int bj = 0; bj < 2; ++bj) { const f32x4 v0 = acc[ai][bj][m][0], v1 = acc[ai][bj][m][1];
                    const u32x4 yw = *(const u32x4*)(Y + (size_t)row * ldy + col0 + bj * HALF);
                    float y[8], g[8];
#pragma unroll
                    for (int j = 0; j < 4; ++j) { y[2 * j] = __uint_as_float(yw[j] << 16); y[2 * j + 1] = __uint_as_float(yw[j] & 0xffff0000u); }
#pragma unroll
                    for (int j = 0; j < 4; ++j) { g[j] = 1.f / (1.f + __expf(-v0[j])); g[4 + j] = 1.f / (1.f + __expf(-v1[j])); }
                    u32x4 w; w.x = cvt_pk_bf16(y[0] * g[0], y[1] * g[1]); w.y = cvt_pk_bf16(y[2] * g[2], y[3] * g[3]); w.z = cvt_pk_bf16(y[4] * g[4], y[5] * g[5]); w.w = cvt_pk_bf16(y[6] * g[6], y[7] * g[7]);
                    *(u32x4*)(O + (size_t)row * ldo + ooff + col0 + bj * HALF) = w; } }
    }
};
struct EpiGluGate {
    static constexpr bool PERM = true, AFTER_DRAIN = true;
    const bf16_t* Y; const bf16_t* Pz; bf16_t* G;
    __device__ __forceinline__ void fused(const f32x4 (&acc)[2][2][4][2], const Unit& u, int wr, int wc, int fr, int fq, PG8_LAS unsigned char* lds, int wid, int lane) const {
        constexpr int TS = 528;
        const int row0 = wr * 64 + fr, col0 = wc * 32 + 8 * fq;
#pragma unroll
        for (int ai = 0; ai < 2; ++ai)
#pragma unroll
            for (int m = 0; m < 4; ++m) { const int rl = row0 + ai * HALF + m * 16; const size_t grow = (size_t)u.pm * BM + rl;
#pragma unroll
                for (int bj = 0; bj < 2; ++bj) { const f32x4 v0 = acc[ai][bj][m][0], v1 = acc[ai][bj][m][1];
                    const u32x4 yw = *(const u32x4*)(Y + grow * 512 + u.pn * BM + col0 + bj * HALF);
                    float y[8], g[8];
#pragma unroll
                    for (int j = 0; j < 4; ++j) { y[2 * j] = __uint_as_float(yw[j] << 16); y[2 * j + 1] = __uint_as_float(yw[j] & 0xffff0000u); }
#pragma unroll
                    for (int j = 0; j < 4; ++j) { g[j] = 1.f / (1.f + __expf(-v0[j])); g[4 + j] = 1.f / (1.f + __expf(-v1[j])); }
                    u32x4 w; w.x = cvt_pk_bf16(y[0] * g[0], y[1] * g[1]); w.y = cvt_pk_bf16(y[2] * g[2], y[3] * g[3]); w.z = cvt_pk_bf16(y[4] * g[4], y[5] * g[5]); w.w = cvt_pk_bf16(y[6] * g[6], y[7] * g[7]);
                    *(PG8_LAS u32x4*)(lds + rl * TS + (col0 + bj * HALF) * 2) = w; } }
        __syncthreads();
        { const int t = wid * 64 + lane, row = t >> 1, hd = t & 1; const PG8_LAS unsigned char* src = lds + row * TS + hd * 256;
          float ss = 0.f;
#pragma unroll
          for (int i = 0; i < 16; ++i) { const u32x4 w = *(const PG8_LAS u32x4*)(src + 16 * i);
#pragma unroll
              for (int j = 0; j < 4; ++j) { const float a = __uint_as_float(w[j] << 16), b = __uint_as_float(w[j] & 0xffff0000u); ss += a * a + b * b; } }
          const float rn = rsqrtf(ss * (1.f / 128.f) + 1e-6f);
          const size_t grow = (size_t)u.pm * BM + row; const int cb = u.pn * BM + hd * 128;
          const bf16_t* zp = Pz + grow * 6144 + 2064 + cb; bf16_t* gp = G + grow * 2048 + 512 + cb;
#pragma unroll
          for (int i = 0; i < 16; ++i) { const u32x4 w = *(const PG8_LAS u32x4*)(src + 16 * i); const u32x4 zw = *(const u32x4*)(zp + 8 * i); u32x4 o;
#pragma unroll
              for (int j = 0; j < 4; ++j) { const float a = __uint_as_float(w[j] << 16), b = __uint_as_float(w[j] & 0xffff0000u), za = __uint_as_float(zw[j] << 16), zb = __uint_as_float(zw[j] & 0xffff0000u);
                  o[j] = cvt_pk_bf16(a * rn * (za / (1.f + __expf(-za))), b * rn * (zb / (1.f + __expf(-zb)))); }
              *(u32x4*)(gp + 8 * i) = o; } }
        __syncthreads();
    }
};
struct EpiBf16Scale {
    static constexpr bool PERM = true, AFTER_DRAIN = false;
    bf16_t* O; int ldc; const float* ssq;
    __device__ __forceinline__ void operator()(const f32x4 (&acc)[2][2][4][2], const Unit& u, int wr, int wc, int fr, int fq) const {
        const int row0 = u.pm * BM + wr * 64 + fr, col0 = u.pn * BM + wc * 32 + 8 * fq;
#pragma unroll
        for (int ai = 0; ai < 2; ++ai)
#pragma unroll
            for (int m = 0; m < 4; ++m) { const int row = row0 + ai * HALF + m * 16; bf16_t* rowp = O + (size_t)row * ldc + col0;
                float ssum = 0.f; { const f32x4* sp_ = (const f32x4*)(ssq + (size_t)row * 32);
#pragma unroll
                    for (int q = 0; q < 8; ++q) { const f32x4 t4 = sp_[q]; ssum += (t4[0] + t4[1]) + (t4[2] + t4[3]); } }
                const float s = rsqrtf(ssum * (1.f / 2048.f) + 1e-6f);
#pragma unroll
                for (int bj = 0; bj < 2; ++bj) { const f32x4 v0 = acc[ai][bj][m][0] * s, v1 = acc[ai][bj][m][1] * s;
                    u32x4 w; w.x = cvt_pk_bf16(v0[0], v0[1]); w.y = cvt_pk_bf16(v0[2], v0[3]); w.z = cvt_pk_bf16(v1[0], v1[1]); w.w = cvt_pk_bf16(v1[2], v1[3]);
                    *(u32x4*)(rowp + bj * HALF) = w; } }
    }
};
struct EpiResidNext {
    static constexpr bool PERM = false, AFTER_DRAIN = false;
    const float* R; float* C; int ldc; bf16_t* XB; float* ssq;
    __device__ __forceinline__ void operator()(const f32x4 (&acc)[2][2][4][2], const Unit& u, int wr, int wc, int fr, int fq) const {
        const int row0 = u.pm * BM + wr * 64 + fr, col0 = u.pn * BM + wc * 32 + 4 * fq;
#pragma unroll
        for (int ai = 0; ai < 2; ++ai)
#pragma unroll
            for (int m = 0; m < 4; ++m) { const int row = row0 + ai * HALF + m * 16; const size_t off = (size_t)row * ldc + col0; float ss = 0.f;
#pragma unroll
                for (int bj = 0; bj < 2; ++bj)
#pragma unroll
                    for (int n = 0; n < 2; ++n) { const f32x4 r = *(const f32x4*)(R + off + bj * HALF + n * 16); const f32x4 v = acc[ai][bj][m][n] + r;
                        *(f32x4*)(C + off + bj * HALF + n * 16) = v;
                        if (XB) { u32x2 w; w.x = cvt_pk_bf16(v[0], v[1]); w.y = cvt_pk_bf16(v[2], v[3]); *(u32x2*)(XB + off + bj * HALF + n * 16) = w; }
                        ss += v[0] * v[0] + v[1] * v[1] + v[2] * v[2] + v[3] * v[3]; }
                if (ssq) { ss += shx(ss, 16); ss += shx(ss, 32); if (fq == 0) ssq[(size_t)row * 32 + u.pn * 4 + wc] = ss; } }
    }
};
template <class Epi, class Sched, bool STAMP = false>
__device__ __forceinline__ void gemm_phase(PG8_LAS unsigned char* lds, const Gemm g, const Sched& S, const Epi& E, unsigned long long* stamps) {
    const int tid = TIDX(), wid = __builtin_amdgcn_readfirstlane(tid >> 6), lane = tid & 63, wr = wid >> 2, wc = wid & 3, fr = lane & 15, fq = lane >> 4;
    const int K = g.K, nt = K / BK;
    int ts_lo = 0, ts_hi = 0, nts = 0; const unsigned long long rt_entry = STAMP ? (unsigned long long)wall_clock64() : 0ull;
#define PG8_STAMP() do { if (STAMP && wid == 0 && nts < 64) { const unsigned long long _c = (unsigned long long)clock64(); \
        ts_lo = (lane == nts) ? (int)(unsigned)_c : ts_lo; ts_hi = (lane == nts) ? (int)(unsigned)(_c >> 32) : ts_hi; ++nts; } } while (0)
    PG8_STAMP();
    unsigned voffA[2], voffB[2];
#pragma unroll
    for (int i = 0; i < 2; ++i) { int R, C; stage_rc(tid * 16 + i * 8192, R, C); const int Rb = Epi::PERM ? ((R & ~31) + perm32(R & 31)) : R;
        voffA[i] = (unsigned)(R * K + C) * 2u; voffB[i] = (unsigned)(Rb * K + C) * 2u; }
    const size_t kstep = (size_t)(BK * 2);
    const size_t hstep = (size_t)HALF * K * 2;
    const size_t tstep = 2 * hstep;
    const unsigned ldsw = (unsigned)wid * 1024u;
    const int aoff = lds_byte(wr * 64 + fr, fq * 8), boff = lds_byte(wc * 32 + fr, fq * 8);
#define PG8_SA(b, h) (((b) * 2 + (h)) * HTB)
#define PG8_SB(b, h) ((4 + (b) * 2 + (h)) * HTB)
#define PG8_STAGE(bufoff, gbase, voff) do { _Pragma("unroll") for (int _i = 0; _i < 2; ++_i) \
        __builtin_amdgcn_global_load_lds((const unsigned*)((const char*)(gbase) + (voff)[_i]), (PG8_LAS unsigned*)(lds + (bufoff) + ldsw + _i * 8192), 16, 0, 0); } while (0)
#define PG8_LDA(dst, b, h) do { _Pragma("unroll") for (int m = 0; m < 4; ++m) _Pragma("unroll") for (int k = 0; k < 2; ++k) dst[m][k] = *(const PG8_LAS bf16x8*)(lds + PG8_SA(b, h) + aoff + m * 2048 + k * 1024); } while (0)
#define PG8_LDB(dst, b, h) do { _Pragma("unroll") for (int n = 0; n < 2; ++n) _Pragma("unroll") for (int k = 0; k < 2; ++k) dst[n][k] = *(const PG8_LAS bf16x8*)(lds + PG8_SB(b, h) + boff + n * 2048 + k * 1024); } while (0)
#define PG8_MMA(ai, bj, At, Bt) do { __builtin_amdgcn_s_setprio(1); _Pragma("unroll") for (int m = 0; m < 4; ++m) _Pragma("unroll") for (int n = 0; n < 2; ++n) _Pragma("unroll") for (int k = 0; k < 2; ++k) \
        acc[ai][bj][m][n] = __builtin_amdgcn_mfma_f32_16x16x32_bf16(Bt[n][k], At[m][k], acc[ai][bj][m][n], 0, 0, 0); __builtin_amdgcn_s_setprio(0); } while (0)
#define PG8_WAIT_V(n) asm volatile("s_waitcnt vmcnt(" #n ")" ::: "memory")
#define PG8_WAIT_L(n) asm volatile("s_waitcnt lgkmcnt(" #n ")" ::: "memory")
#define PG8_BAR __builtin_amdgcn_s_barrier()
#define PG8_SCHED __builtin_amdgcn_sched_barrier(0)
    Unit cur, nxt; int ui = 0;
    if (!S.next(0, cur)) return;
    f32x4 acc[2][2][4][2];
#pragma unroll
    for (int a = 0; a < 2; ++a)
#pragma unroll
        for (int b = 0; b < 2; ++b)
#pragma unroll
            for (int m = 0; m < 4; ++m)
#pragma unroll
                for (int n = 0; n < 2; ++n) acc[a][b][m][n] = (f32x4){0.f, 0.f, 0.f, 0.f};
    bf16x8 At[4][2], B0[2][2], B1[2][2];
    const char* cA = (const char*)g.A + (size_t)cur.pm * tstep; const char* cB = (const char*)g.Bt + (size_t)cur.pn * tstep;
    S.a_ready(cur);
    PG8_STAGE(PG8_SB(0, 0), cB, voffB); PG8_STAGE(PG8_SA(0, 0), cA, voffA); PG8_STAGE(PG8_SB(0, 1), cB + hstep, voffB); PG8_STAGE(PG8_SA(0, 1), cA + hstep, voffA);
    if (wr == 1) PG8_BAR;
    PG8_WAIT_V(4); PG8_BAR;
    PG8_STAGE(PG8_SB(1, 0), cB + kstep, voffB); PG8_STAGE(PG8_SA(1, 0), cA + kstep, voffA); PG8_STAGE(PG8_SB(1, 1), cB + hstep + kstep, voffB);
    PG8_WAIT_V(6); PG8_BAR;
    PG8_STAMP();
    for (;;) {
        const bool has_next = S.next(ui + 1, nxt);
        const char* nA = has_next ? (const char*)g.A + (size_t)nxt.pm * tstep : cA; const char* nB = has_next ? (const char*)g.Bt + (size_t)nxt.pn * tstep : cB;
        for (int t = 0; t < nt; t += 2) {
            const bool last = (t == nt - 2);
            const char* a1 = cA + (size_t)(t + 1) * kstep;
            const char* a2 = last ? nA : cA + (size_t)(t + 2) * kstep; const char* b2 = last ? nB : cB + (size_t)(t + 2) * kstep;
            const char* a3 = a2 + kstep; const char* b3 = b2 + kstep;
            if (last && has_next) S.a_ready(nxt);
            PG8_LDB(B0, 0, 0); PG8_SCHED; PG8_LDA(At, 0, 0); PG8_STAGE(PG8_SA(1, 1), a1 + hstep, voffA);
            PG8_WAIT_L(8); PG8_BAR; PG8_WAIT_L(0); PG8_MMA(0, 0, At, B0); PG8_BAR; PG8_SCHED;
            PG8_LDB(B1, 0, 1); PG8_STAGE(PG8_SB(0, 0), b2, voffB);
            PG8_BAR; PG8_WAIT_L(0); PG8_MMA(0, 1, At, B1); PG8_BAR;
            PG8_LDA(At, 0, 1); PG8_STAGE(PG8_SA(0, 0), a2, voffA);
            PG8_BAR; PG8_WAIT_L(0); PG8_MMA(1, 0, At, B0); PG8_BAR; PG8_SCHED;
            PG8_STAGE(PG8_SB(0, 1), b2 + hstep, voffB);
            PG8_WAIT_V(6); PG8_BAR; PG8_MMA(1, 1, At, B1); PG8_BAR;
            PG8_LDB(B0, 1, 0); PG8_SCHED; PG8_LDA(At, 1, 0); PG8_STAGE(PG8_SA(0, 1), a2 + hstep, voffA);
            PG8_WAIT_L(8); PG8_BAR; PG8_WAIT_L(0); PG8_MMA(0, 0, At, B0); PG8_BAR; PG8_SCHED;
            PG8_LDB(B1, 1, 1); PG8_STAGE(PG8_SB(1, 0), b3, voffB);
            PG8_BAR; PG8_WAIT_L(0); PG8_MMA(0, 1, At, B1); PG8_BAR;
            PG8_LDA(At, 1, 1); PG8_STAGE(PG8_SA(1, 0), a3, voffA);
            PG8_BAR; PG8_WAIT_L(0); PG8_MMA(1, 0, At, B0); PG8_BAR; PG8_SCHED;
            PG8_STAGE(PG8_SB(1, 1), b3 + hstep, voffB);
            PG8_WAIT_V(6); PG8_BAR; PG8_MMA(1, 1, At, B1); PG8_BAR;
        }
        PG8_STAMP();
        if constexpr (!Epi::AFTER_DRAIN) { E(acc, cur, wr, wc, fr, fq); S.done(cur); }
        PG8_STAMP();
        if (!has_next) break;
#pragma unroll
        for (int a = 0; a < 2; ++a)
#pragma unroll
            for (int b = 0; b < 2; ++b)
#pragma unroll
                for (int m = 0; m < 4; ++m)
#pragma unroll
                    for (int n = 0; n < 2; ++n) acc[a][b][m][n] = (f32x4){0.f, 0.f, 0.f, 0.f};
        cur = nxt; cA = nA; cB = nB; ++ui;
    }
    PG8_WAIT_V(0);
    if (wr == 0) PG8_BAR;
    PG8_BAR;
    if constexpr (Epi::AFTER_DRAIN) { E.fused(acc, cur, wr, wc, fr, fq, lds, wid, lane); S.done(cur); }
    PG8_STAMP();
    if (STAMP && wid == 0) { stamps[lane] = lane < nts ? (((unsigned long long)(unsigned)ts_hi << 32) | (unsigned)ts_lo) : 0ull;
        if (lane == 62) stamps[62] = rt_entry; if (lane == 63) stamps[63] = (unsigned long long)wall_clock64(); }
#undef PG8_STAMP
#undef PG8_SA
#undef PG8_SB
#undef PG8_STAGE
#undef PG8_LDA
#undef PG8_LDB
#undef PG8_MMA
#undef PG8_WAIT_V
#undef PG8_WAIT_L
#undef PG8_BAR
#undef PG8_SCHED
}
}
namespace att {
constexpr int D = 128, NW = 8, QBLK = 32, KVBLK = 64;
constexpr float SCALE = 0.088388347648318440f, THR = 8.f;
constexpr int SHM_V = KVBLK * D * 2, SHM_K = KVBLK * D * 2, SHM_ATTN = 2 * SHM_V + 2 * SHM_K + NW * 64 * 4;
#define KSWZ(row, colB) ((row) * 256 + ((colB) ^ (((row) & 7) << 4)))
#define SBAR() __builtin_amdgcn_sched_barrier(0)
__device__ __forceinline__ int crow(int r, int hi) { return (r & 3) + 8 * (r >> 2) + 4 * hi; }
__device__ __forceinline__ unsigned cvtpk(float lo, float hi) { unsigned r; asm volatile("v_cvt_pk_bf16_f32 %0, %1, %2" : "=v"(r) : "v"(lo), "v"(hi)); return r; }

template <bool MASKED>
__device__ __forceinline__ void partialSM(f32x16& p0, f32x16& p1, float& m_reg, float& mn, float& alpha, unsigned long long mw, int hi) {
  constexpr float C = SCALE * 1.4426950408889634f;
  if (MASKED) {
    const unsigned w0 = (unsigned)mw >> (4 * hi), w1 = (unsigned)(mw >> 32) >> (4 * hi);
    const float ninf = -__builtin_inff();
#pragma unroll
    for (int r = 0; r < 16; ++r) { const int bit = (r & 3) + 8 * (r >> 2);
      p0[r] = ((w0 >> bit) & 1u) ? p0[r] : ninf; p1[r] = ((w1 >> bit) & 1u) ? p1[r] : ninf; }
  }
  float pmax = p0[0];
#pragma unroll
  for (int r = 1; r < 16; ++r) pmax = fmaxf(pmax, p0[r]);
#pragma unroll
  for (int r = 0; r < 16; ++r) pmax = fmaxf(pmax, p1[r]);
  { auto rr = __builtin_amdgcn_permlane32_swap(__float_as_uint(pmax), __float_as_uint(pmax), false, false);
    pmax = fmaxf(__uint_as_float(rr[0]), __uint_as_float(rr[1])); }
  if (__builtin_expect(__all(pmax - m_reg <= THR / SCALE), 1)) { mn = m_reg; alpha = 1.f; }
  else { mn = fmaxf(m_reg, pmax); alpha = __builtin_amdgcn_exp2f((m_reg - mn) * C); m_reg = mn; }
  const float mnC = -mn * C;
#pragma unroll
  for (int r = 0; r < 16; ++r) p0[r] = fmaf(p0[r], C, mnC);
#pragma unroll
  for (int r = 0; r < 16; ++r) p1[r] = fmaf(p1[r], C, mnC);
#pragma unroll
  for (int r = 0; r < 16; ++r) p0[r] = __builtin_amdgcn_exp2f(p0[r]);
}
__device__ __forceinline__ void finishSM(f32x16& p0, f32x16& p1, float alpha, float& l_reg, bf16x8& pa0, bf16x8& pa1, bf16x8& pa2, bf16x8& pa3) {
#pragma unroll
  for (int r = 0; r < 16; ++r) p1[r] = __builtin_amdgcn_exp2f(p1[r]);
  float ps = 0;
#pragma unroll
  for (int r = 0; r < 16; ++r) ps += p0[r];
#pragma unroll
  for (int r = 0; r < 16; ++r) ps += p1[r];
  { auto rr = __builtin_amdgcn_permlane32_swap(__float_as_uint(ps), __float_as_uint(ps), false, false);
    ps = __uint_as_float(rr[0]) + __uint_as_float(rr[1]); }
  l_reg = l_reg * alpha + ps;
#define PK4(P, BASE, OUT) do { unsigned a0 = cvtpk(P[BASE + 0], P[BASE + 1]), a1 = cvtpk(P[BASE + 2], P[BASE + 3]);   \
    unsigned b0 = cvtpk(P[BASE + 4], P[BASE + 5]), b1 = cvtpk(P[BASE + 6], P[BASE + 7]);                              \
    auto r0 = __builtin_amdgcn_permlane32_swap(a0, b0, false, false); auto r1 = __builtin_amdgcn_permlane32_swap(a1, b1, false, false); \
    u32x4 w = {r0[0], r1[0], r0[1], r1[1]}; OUT = *reinterpret_cast<bf16x8*>(&w); } while (0)
  PK4(p0, 0, pa0); PK4(p0, 8, pa1); PK4(p1, 0, pa2); PK4(p1, 8, pa3);
#undef PK4
}
__device__ __forceinline__ void qkt(f32x16& p0, f32x16& p1, const char* Ks, const bf16x8* qr, int r32, int hi) {
  p0 = f32x16{}; p1 = f32x16{};
  asm volatile("" : "+v"(p0), "+v"(p1));
#pragma unroll
  for (int d0 = 0; d0 < 8; ++d0) { const int cb = (d0 * 16 + hi * 8) * 2;
    bf16x8 b0 = *reinterpret_cast<const bf16x8*>(Ks + KSWZ(r32, cb));
    bf16x8 b1 = *reinterpret_cast<const bf16x8*>(Ks + KSWZ(32 + r32, cb));
    p0 = __builtin_amdgcn_mfma_f32_32x32x16_bf16(b0, qr[d0], p0, 0, 0, 0);
    p1 = __builtin_amdgcn_mfma_f32_32x32x16_bf16(b1, qr[d0], p1, 0, 0, 0); }
}
__device__ __forceinline__ int v_st(int k, int c) { const int kk = (k & ~0xC) | ((k & 4) << 1) | ((k & 8) >> 1); return ((kk >> 3) * 4 + (c >> 5)) * 512 + ((kk & 7) * 32 + (c & 31)) * 2; }
__device__ __forceinline__ int v_rd_base(int lane) { return ((lane & 3) << 3) | (((lane >> 2) & 3) << 6) | (((lane >> 4) & 1) << 5) | (((lane >> 5) & 1) << 8); }
constexpr int v_rd_off(int d0, int ks, int half) { return d0 * 512 + ks * 4096 + half * 2048; }
template <int OFF> __device__ __forceinline__ s16x4 tr_read(int vb) {
  s16x4 r; asm volatile("ds_read_b64_tr_b16 %0, %1 offset:%2" : "=&v"(r) : "v"(vb), "i"(OFF) : "memory"); return r;
}
template <int D0> __device__ __forceinline__ void pv_one(f32x16& od, int vb, bf16x8 pa0, bf16x8 pa1, bf16x8 pa2, bf16x8 pa3) {
  const s16x4 l0 = tr_read<v_rd_off(D0, 0, 0)>(vb), h0 = tr_read<v_rd_off(D0, 0, 1)>(vb), l1 = tr_read<v_rd_off(D0, 1, 0)>(vb), h1 = tr_read<v_rd_off(D0, 1, 1)>(vb);
  const s16x4 l2 = tr_read<v_rd_off(D0, 2, 0)>(vb), h2 = tr_read<v_rd_off(D0, 2, 1)>(vb), l3 = tr_read<v_rd_off(D0, 3, 0)>(vb), h3 = tr_read<v_rd_off(D0, 3, 1)>(vb);
  asm volatile("s_waitcnt lgkmcnt(0)" ::: "memory"); SBAR();
#define PK(L, H) (bf16x8){L[0], L[1], L[2], L[3], H[0], H[1], H[2], H[3]}
  od = __builtin_amdgcn_mfma_f32_32x32x16_bf16(pa0, PK(l0, h0), od, 0, 0, 0);
  od = __builtin_amdgcn_mfma_f32_32x32x16_bf16(pa1, PK(l1, h1), od, 0, 0, 0);
  od = __builtin_amdgcn_mfma_f32_32x32x16_bf16(pa2, PK(l2, h2), od, 0, 0, 0);
  od = __builtin_amdgcn_mfma_f32_32x32x16_bf16(pa3, PK(l3, h3), od, 0, 0, 0);
#undef PK
}
__device__ __forceinline__ void pv_d0(f32x16* o, int vb, bf16x8 pa0, bf16x8 pa1, bf16x8 pa2, bf16x8 pa3) {
  pv_one<0>(o[0], vb, pa0, pa1, pa2, pa3); pv_one<1>(o[1], vb, pa0, pa1, pa2, pa3); pv_one<2>(o[2], vb, pa0, pa1, pa2, pa3); pv_one<3>(o[3], vb, pa0, pa1, pa2, pa3);
}

template <bool MASKED, int LDK, int VOFF, class OutRow>
__device__ __forceinline__ void attn_body(const bf16_t* __restrict__ Qw, const bf16_t* __restrict__ Kh, int NT,
                                          const unsigned long long* __restrict__ mbase, unsigned moff, const OutRow& Ow, char* lds) {
  const int tid = TIDX(), wid = tid >> 6, lane = tid & 63, r32 = lane & 31, hi = lane >> 5;
  char* V_lds = lds; char* K_lds = lds + 2 * SHM_V;
  float* ws = (float*)(lds + 2 * SHM_V + 2 * SHM_K) + wid * 64; float* li_l = ws; float* al_l = ws + 32;
  float m_reg = -1e30f, l_reg = 0; f32x16 o[4] = {}; bf16x8 qr[8];
  asm volatile("" : "+v"(o[0]), "+v"(o[1]), "+v"(o[2]), "+v"(o[3]));
#pragma unroll
  for (int d0 = 0; d0 < 8; ++d0) qr[d0] = *reinterpret_cast<const bf16x8*>(Qw + d0 * 16);
  const int sr = tid >> 4, sc = (tid & 15) * 8, vst0 = v_st(sr, sc), vst1 = v_st(32 + sr, sc);
  const int vb0 = (int)(uintptr_t)V_lds + v_rd_base(lane);
  struct { bf16x8 vs0, vs1, ks0, ks1; } sr_[2];
  const unsigned koff = (unsigned)(sr * LDK + sc) * 2u;
#define SLOAD(i, k0) do { const char* kb_ = (const char*)Kh + (size_t)(k0) * (LDK * 2); \
    sr_[i].vs0 = *reinterpret_cast<const bf16x8*>(kb_ + koff + VOFF * 2); sr_[i].vs1 = *reinterpret_cast<const bf16x8*>(kb_ + koff + (32 * LDK + VOFF) * 2); \
    sr_[i].ks0 = *reinterpret_cast<const bf16x8*>(kb_ + koff); sr_[i].ks1 = *reinterpret_cast<const bf16x8*>(kb_ + koff + 32 * LDK * 2); } while (0)
#define SWRITE(b, i) do { *(bf16x8*)(V_lds + (b) * SHM_V + vst0) = sr_[i].vs0;          \
    *(bf16x8*)(V_lds + (b) * SHM_V + vst1) = sr_[i].vs1; int kc = sc * 2;               \
    *(bf16x8*)(K_lds + (b) * SHM_K + KSWZ(sr, kc)) = sr_[i].ks0;                       \
    *(bf16x8*)(K_lds + (b) * SHM_K + KSWZ(32 + sr, kc)) = sr_[i].ks1; } while (0)
#define SWAIT() asm volatile("s_waitcnt vmcnt(4)" ::: "memory")
#define RESC(a) do { if (__any((a) < 1.f)) { if (hi == 0) al_l[r32] = (a); asm volatile("s_waitcnt lgkmcnt(0)" ::: "memory"); \
    _Pragma("unroll") for (int d = 0; d < 4; ++d) _Pragma("unroll") for (int r = 0; r < 16; ++r) o[d][r] *= al_l[crow(r, hi)]; } } while (0)
  f32x16 pA0, pA1, pB0, pB1; float mnA, mnB, alA, alB; bf16x8 pa0, pa1, pa2, pa3;
  unsigned long long mw = 0ull;
  constexpr int SE = 0, SO = 1;
  SLOAD(SE, 0); asm volatile("s_waitcnt vmcnt(0)" ::: "memory"); SWRITE(0, SE); __syncthreads();
  if (MASKED) mw = *(const unsigned long long*)((const char*)mbase + moff);
  qkt(pA0, pA1, K_lds, qr, r32, hi); partialSM<MASKED>(pA0, pA1, m_reg, mnA, alA, mw, hi);
  SLOAD(SO, KVBLK); if (2 < NT) SLOAD(SE, 2 * KVBLK);
  if (2 < NT) SWAIT(); else asm volatile("s_waitcnt vmcnt(0)" ::: "memory");
  SWRITE(1, SO); __syncthreads();
  for (int j = 1; j + 1 < NT; j += 2) {
    if (MASKED) mw = *(const unsigned long long*)((const char*)mbase + (moff + 8u * (unsigned)j));
    SBAR(); qkt(pB0, pB1, K_lds + SHM_K, qr, r32, hi);
    finishSM(pA0, pA1, alA, l_reg, pa0, pa1, pa2, pa3); SBAR();
    SLOAD(SO, (j + 2) * KVBLK); SBAR();
    pv_d0(o, vb0, pa0, pa1, pa2, pa3); partialSM<MASKED>(pB0, pB1, m_reg, mnB, alB, mw, hi);
    if (MASKED) mw = *(const unsigned long long*)((const char*)mbase + (moff + 8u * (unsigned)(j + 1)));
    __syncthreads(); SWAIT(); SWRITE(0, SE);
    RESC(alB); __syncthreads();
    SBAR(); qkt(pA0, pA1, K_lds, qr, r32, hi);
    finishSM(pB0, pB1, alB, l_reg, pa0, pa1, pa2, pa3); SBAR();
    if (j + 3 < NT) SLOAD(SE, (j + 3) * KVBLK); SBAR();
    pv_d0(o, vb0 + SHM_V, pa0, pa1, pa2, pa3); partialSM<MASKED>(pA0, pA1, m_reg, mnA, alA, mw, hi);
    __syncthreads(); if (j + 3 < NT) SWAIT(); else asm volatile("s_waitcnt vmcnt(0)" ::: "memory");
    SWRITE(1, SO);
    RESC(alA); __syncthreads();
  }
  if (MASKED) mw = *(const unsigned long long*)((const char*)mbase + (moff + 8u * (unsigned)(NT - 1)));
  SBAR(); qkt(pB0, pB1, K_lds + SHM_K, qr, r32, hi);
  finishSM(pA0, pA1, alA, l_reg, pa0, pa1, pa2, pa3); SBAR();
  pv_d0(o, vb0, pa0, pa1, pa2, pa3); partialSM<MASKED>(pB0, pB1, m_reg, mnB, alB, mw, hi);
  __syncthreads(); RESC(alB);
  finishSM(pB0, pB1, alB, l_reg, pa0, pa1, pa2, pa3); SBAR();
  pv_d0(o, vb0 + SHM_V, pa0, pa1, pa2, pa3);
  if (hi == 0) li_l[r32] = l_reg; asm volatile("s_waitcnt lgkmcnt(0)" ::: "memory");
  float rli[16];
#pragma unroll
  for (int r = 0; r < 16; ++r) rli[r] = __builtin_amdgcn_rcpf(li_l[crow(r, hi)]);
  __syncthreads();
  float* og_s = (float*)lds + wid * (32 * 132);
#pragma unroll
  for (int r = 0; r < 16; ++r) {
#pragma unroll
    for (int d0 = 0; d0 < 4; ++d0) og_s[crow(r, hi) * 132 + d0 * 32 + r32] = o[d0][r] * rli[r]; }
  asm volatile("" ::: "memory");
  { const int row = lane >> 1, half = lane & 1; const float* src = og_s + row * 132 + half * 64;
    f32x4 v[16]; float ss = 0.f;
#pragma unroll
    for (int i = 0; i < 16; ++i) { v[i] = *(const f32x4*)(src + 4 * i); ss += v[i][0] * v[i][0] + v[i][1] * v[i][1] + v[i][2] * v[i][2] + v[i][3] * v[i][3]; }
    ss += shx(ss, 1);
    const float rn = rsqrtf(ss * (1.f / 128.f) + EPS);
    const bf16_t* zp = Ow.zrow(row) + half * 64; bf16_t* gp = Ow.grow(row) + half * 64;
#pragma unroll
    for (int i = 0; i < 8; ++i) { float z[8], g[8]; ld8f(zp + 8 * i, z);
#pragma unroll
      for (int q = 0; q < 4; ++q) { g[q] = v[2 * i][q] * rn * siluf_(z[q]); g[4 + q] = v[2 * i + 1][q] * rn * siluf_(z[4 + q]); }
      st8f(gp + 8 * i, g); } }
  __syncthreads();
#undef SLOAD
#undef SWRITE
#undef SWAIT
#undef RESC
}
}
constexpr size_t al256(size_t x) { return (x + 255) / 256 * 256; }
constexpr size_t WS_CTL   = 0;
constexpr size_t CTL_BYTES = 65536;
constexpr size_t WS_WINT  = WS_CTL + CTL_BYTES;
constexpr size_t WS_WOUTT = WS_WINT + al256((size_t)DEPTH * NPAD * DM * 2);
constexpr size_t WS_WKVT  = WS_WOUTT + al256((size_t)DEPTH * DM * MIX * 2);
constexpr size_t WS_WGLUT = WS_WKVT + al256((size_t)DEPTH * 1024 * DM * 2);
constexpr size_t WS_MEMN  = WS_WGLUT + al256((size_t)DEPTH * 512 * 512 * 2);
constexpr size_t WS_KVMEM = WS_MEMN + al256((size_t)NB * MEML * DM * 2);
constexpr size_t WS_XN    = WS_KVMEM + al256((size_t)NB * MEML * DEPTH * 1024 * 2);
constexpr size_t WS_P     = WS_XN + al256((size_t)NTOK * DM * 2);
constexpr size_t WS_XBUF  = WS_P + al256((size_t)NTOK * NPAD * 2);
constexpr size_t WS_OCAT  = WS_XBUF + al256((size_t)NTOK * DM * 4);
constexpr size_t WS_MASK  = WS_OCAT + al256((size_t)NTOK * MIX * 2);
constexpr size_t WS_IW    = WS_MASK + al256((size_t)NTOK * 64 * 8);
constexpr size_t WS_YBUF  = WS_IW + al256((size_t)NTOK * 16 * 4);
constexpr size_t WS_ROPE  = WS_YBUF + al256((size_t)NTOK * 512 * 2);
constexpr size_t WS_S5P   = WS_ROPE + al256((size_t)NTOK * 48 * 4);
constexpr size_t S5P_BYTES = (size_t)DEPTH * 32 * (64 * 2 + 64 * 2 + 64 * 16 * 2) * 4;
constexpr size_t WS_GLAS  = WS_S5P + al256(S5P_BYTES);
constexpr size_t WS_GLAD  = WS_GLAS + al256((size_t)NB * 64 * 4 * 64 * 128 * 4);
constexpr size_t WS_IKC   = WS_GLAD + al256((size_t)NB * 64 * 4 * 64 * 4);
constexpr size_t WS_KVC   = WS_IKC + al256((size_t)NTOK * 64 * 2);
constexpr size_t WS_IQL   = WS_KVC + al256((size_t)NTOK * 256 * 2);
constexpr size_t WS_SSQ   = WS_IQL + al256((size_t)NTOK * 64 * 2);
constexpr size_t DSP_SLOT = (size_t)(256 * 128 + 512) * 4;
constexpr size_t WS_DSP   = WS_SSQ + 256;
constexpr size_t WS_END   = WS_DSP + al256((size_t)160 * 2 * DSP_SLOT);

struct Params {
    const float* x; const float* mem; const int* pos; const float* ln_gain; const float* w_in; const float* gla_w_up; const float* gla_b_up;
    const float* s5_a_re; const float* s5_a_im; const float* s5_log_step; const float* s5_b_re; const float* s5_b_im; const float* s5_c_re; const float* s5_c_im;
    const float* s5_d; const float* s5_w_glu; const float* dsa_q_norm; const float* dsa_k_norm; const float* mem_norm; const float* w_mem_kv;
    const float* mem_q_norm; const float* mem_k_norm; const float* out_norm; const float* w_out;
    float* out;
    char* ws;
    __device__ __forceinline__ unsigned* ctl_() const { return (unsigned*)(ws + WS_CTL); }
    __device__ __forceinline__ bf16_t* WinT_() const { return (bf16_t*)(ws + WS_WINT); }
    __device__ __forceinline__ bf16_t* WoutT_() const { return (bf16_t*)(ws + WS_WOUTT); }
    __device__ __forceinline__ bf16_t* WkvT_() const { return (bf16_t*)(ws + WS_WKVT); }
    __device__ __forceinline__ bf16_t* WgluT_() const { return (bf16_t*)(ws + WS_WGLUT); }
    __device__ __forceinline__ bf16_t* memn_() const { return (bf16_t*)(ws + WS_MEMN); }
    __device__ __forceinline__ bf16_t* kvmem_() const { return (bf16_t*)(ws + WS_KVMEM); }
    __device__ __forceinline__ bf16_t* xn_() const { return (bf16_t*)(ws + WS_XN); }
    __device__ __forceinline__ bf16_t* p_() const { return (bf16_t*)(ws + WS_P); }
    __device__ __forceinline__ float* xbuf_() const { return (float*)(ws + WS_XBUF); }
    __device__ __forceinline__ bf16_t* ocat_() const { return (bf16_t*)(ws + WS_OCAT); }
    __device__ __forceinline__ unsigned long long* mask_() const { return (unsigned long long*)(ws + WS_MASK); }
    __device__ __forceinline__ float* iw_() const { return (float*)(ws + WS_IW); }
    __device__ __forceinline__ bf16_t* ybuf_() const { return (bf16_t*)(ws + WS_YBUF); }
    __device__ __forceinline__ float* rope_() const { return (float*)(ws + WS_ROPE); }
    __device__ __forceinline__ float* s5p_() const { return (float*)(ws + WS_S5P); }
    __device__ __forceinline__ float* glas_() const { return (float*)(ws + WS_GLAS); }
    __device__ __forceinline__ float* glad_() const { return (float*)(ws + WS_GLAD); }
    __device__ __forceinline__ bf16_t* ikc_() const { return (bf16_t*)(ws + WS_IKC); }
    __device__ __forceinline__ bf16_t* kvc_() const { return (bf16_t*)(ws + WS_KVC); }
    __device__ __forceinline__ float* ssq_() const { return (float*)(ws + WS_SSQ); }
    __device__ __forceinline__ bf16_t* iql_() const { return (bf16_t*)(ws + WS_IQL); }
    __device__ __forceinline__ char* dsp_() const { return ws + WS_DSP; }
};

__device__ __forceinline__ void transpose_tiles(const float* __restrict__ src, int K, int Nsrc, int Ndst, const float* __restrict__ scale, bf16_t* __restrict__ dst,
                                                int tile, float* lds_tile  ) {
    const int tid = TIDX(), ntn = Ndst / 256;
    const int tk = tile / ntn, tn = tile % ntn, k0 = tk * 64, n0 = tn * 256;
    __syncthreads();
    { const int ty = tid >> 4, tx = tid & 15;
      f32x4 v[2][4];
#pragma unroll
      for (int i = 0; i < 2; ++i)
#pragma unroll
        for (int q = 0; q < 4; ++q) { const int k = k0 + ty + 32 * i, n = n0 + 4 * tx + 64 * q;
          v[i][q] = (f32x4){0.f, 0.f, 0.f, 0.f};
          if (n < Nsrc) v[i][q] = *(const f32x4*)(src + (size_t)k * Nsrc + n); }
#pragma unroll
      for (int i = 0; i < 2; ++i) { const float s = scale ? scale[k0 + ty + 32 * i] : 1.f;
#pragma unroll
        for (int q = 0; q < 4; ++q) { float* t = lds_tile + (ty + 32 * i) * 257 + 4 * tx + 64 * q; t[0] = v[i][q][0] * s; t[1] = v[i][q][1] * s; t[2] = v[i][q][2] * s; t[3] = v[i][q][3] * s; } } }
    __syncthreads();
    { const int n = tid >> 1, kh = (tid & 1) * 32;
#pragma unroll
      for (int j = 0; j < 4; ++j) { const int kb = kh + 8 * j; u32x4 w;
        w.x = pk2bf(lds_tile[(kb + 0) * 257 + n], lds_tile[(kb + 1) * 257 + n]); w.y = pk2bf(lds_tile[(kb + 2) * 257 + n], lds_tile[(kb + 3) * 257 + n]);
        w.z = pk2bf(lds_tile[(kb + 4) * 257 + n], lds_tile[(kb + 5) * 257 + n]); w.w = pk2bf(lds_tile[(kb + 6) * 257 + n], lds_tile[(kb + 7) * 257 + n]);
        *(u32x4*)(dst + (size_t)(n0 + n) * K + k0 + kb) = w; } }
}

__device__ __forceinline__ void rmsnorm_rows(const float* __restrict__ X, bf16_t* __restrict__ Y, int nrows) {
    const int wid = TIDX() >> 6, lane = TIDX() & 63;
    for (int row = blockIdx.x * 8 + wid; row < nrows; row += gridDim.x * 8) {
        const float* xr = X + (size_t)row * DM; f32x4 v[8]; float ss = 0.f;
#pragma unroll
        for (int i = 0; i < 8; ++i) { v[i] = *(const f32x4*)(xr + 4 * lane + 256 * i); ss += v[i][0] * v[i][0] + v[i][1] * v[i][1] + v[i][2] * v[i][2] + v[i][3] * v[i][3]; }
        ss = wave_sum(ss); const float r = rsqrtf(ss * (1.f / DM) + EPS);
        bf16_t* yr = Y + (size_t)row * DM;
#pragma unroll
        for (int i = 0; i < 8; ++i) { u32x2 w; w.x = pk2bf(v[i][0] * r, v[i][1] * r); w.y = pk2bf(v[i][2] * r, v[i][3] * r); *(u32x2*)(yr + 4 * lane + 256 * i) = w; }
    }
}

__device__ __forceinline__ void rows_bf16_ssq(const float* __restrict__ X, bf16_t* __restrict__ Y, float* __restrict__ ssq, int nrows) {
    const int wid = TIDX() >> 6, lane = TIDX() & 63;
    for (int row = blockIdx.x * 8 + wid; row < nrows; row += gridDim.x * 8) {
        const float* xr = X + (size_t)row * DM; bf16_t* yr = Y + (size_t)row * DM; float ss = 0.f;
#pragma unroll
        for (int i = 0; i < 8; ++i) { const f32x4 v = *(const f32x4*)(xr + 4 * lane + 256 * i); ss += v[0] * v[0] + v[1] * v[1] + v[2] * v[2] + v[3] * v[3];
            u32x2 w; w.x = pk2bf(v[0], v[1]); w.y = pk2bf(v[2], v[3]); *(u32x2*)(yr + 4 * lane + 256 * i) = w; }
        ss = wave_sum(ss); if (lane < 32) ssq[(size_t)row * 32 + lane] = (lane == 0) ? ss : 0.f;
    }
}
__device__ __forceinline__ void phase_prologue1(const Params& P, char* lds) {
    float* tile = (float*)lds;
    constexpr int T_IN = (DM / 64) * (NPAD / 256), T_OUT = (MIX / 64) * (DM / 256), T_KV = (DM / 64) * (1024 / 256), T_GLU = 8 * 2;
    constexpr int TOT = DEPTH * (T_IN + T_OUT + T_KV + T_GLU);
    for (int u = blockIdx.x; u < TOT; u += gridDim.x) {
        int l = u / (T_IN + T_OUT + T_KV + T_GLU), r = u % (T_IN + T_OUT + T_KV + T_GLU);
        if (r < T_IN) transpose_tiles(P.w_in + (size_t)l * DM * NIN, DM, NIN, NPAD, P.ln_gain + l * DM, P.WinT_() + (size_t)l * NPAD * DM, r, tile);
        else if ((r -= T_IN) < T_OUT) transpose_tiles(P.w_out + (size_t)l * MIX * DM, MIX, DM, DM, P.out_norm + l * MIX, P.WoutT_() + (size_t)l * DM * MIX, r, tile);
        else if ((r -= T_OUT) < T_KV) transpose_tiles(P.w_mem_kv + (size_t)l * DM * 1024, DM, 1024, 1024, P.mem_norm + l * DM, P.WkvT_() + (size_t)l * 1024 * DM, r, tile);
        else { r -= T_KV; transpose_tiles(P.s5_w_glu + (size_t)l * 512 * 512, 512, 512, 512, nullptr, P.WgluT_() + (size_t)l * 512 * 512, r, tile); }
    }
    rmsnorm_rows(P.mem, P.memn_(), NB * MEML);
}
__device__ __forceinline__ void phase_rope_table(const Params& P) {
    for (int idx = blockIdx.x * NTHR + TIDX(); idx < NTOK * 24; idx += gridDim.x * NTHR) {
        const int tok = idx / 24, i = idx % 24;
        const float e = (i < 16) ? -((float)i * 2.0f / 32.0f) : -((float)(i - 16) * 2.0f / 16.0f);
        const float inv_freq = exp2f(e * 18.931568569324174f);
        const float ang = (float)P.pos[tok] * inv_freq;
        const double a = (double)ang; const double k = rint(a * 0.15915494309189535); const float rf = (float)fma(-k, 6.283185307179586, a);
        P.rope_()[(size_t)idx * 2] = cosf(rf); P.rope_()[(size_t)idx * 2 + 1] = sinf(rf);
    }
}

__device__ __forceinline__ void phase_rmsnorm_x(const Params& P, int layer) { rmsnorm_rows(layer == 0 ? P.x : P.xbuf_(), P.xn_(), NTOK); }

__device__ __forceinline__ void phase_memk_norm(const Params& P) {
    const int wid = TIDX() >> 6, lane = TIDX() & 63;
    for (int it = blockIdx.x * 8 + wid; it < NB * MEML * DEPTH * 4; it += gridDim.x * 8) {
        const int row = it / (DEPTH * 4), l = (it / 4) % DEPTH, h = it % 4;
        bf16_t* kp = P.kvmem_() + (size_t)row * (DEPTH * 1024) + l * 1024 + h * 128 + 2 * lane;
        const unsigned w = *(const unsigned*)kp; const float a = __uint_as_float(w << 16), b = __uint_as_float(w & 0xffff0000u);
        const float ss = wave_sum(a * a + b * b), r = rsqrtf(ss * (1.f / 128.f) + EPS);
        const float* g = P.mem_k_norm + l * 128 + 2 * lane;
        *(unsigned*)kp = pk2bf(a * r * g[0], b * r * g[1]);
    }
}

__device__ __forceinline__ float sum16(float v) { v += shx(v, 1); v += shx(v, 2); v += shx(v, 4); v += shx(v, 8); return v; }

__device__ __forceinline__ void head128_norm_rope_to(const bf16_t* hp, bf16_t* dp, int l16, const float* __restrict__ gain, const float* __restrict__ cs, bool rope, bool do_store) {
    float v[8]; ld8f(hp + 8 * l16, v);
    float ss = 0.f;
#pragma unroll
    for (int j = 0; j < 8; ++j) ss += v[j] * v[j];
    ss = sum16(ss); const float r = rsqrtf(ss * (1.f / 128.f) + EPS);
#pragma unroll
    for (int j = 0; j < 8; ++j) v[j] = v[j] * r * gain[8 * l16 + j];
    if (rope) {
        float o[8];
#pragma unroll
        for (int j = 0; j < 8; ++j) o[j] = shx(v[j], 2);
        if (l16 < 4) { const int fi = (l16 & 1) * 8;
#pragma unroll
            for (int j = 0; j < 8; ++j) { const float c = cs[(fi + j) * 2], s = cs[(fi + j) * 2 + 1];
                v[j] = (l16 < 2) ? (v[j] * c - o[j] * s) : (v[j] * c + o[j] * s); } }
    }
    if (do_store) st8f(dp + 8 * l16, v);
}
__device__ __forceinline__ void head128_norm_rope(bf16_t* hp, int l16, const float* __restrict__ gain, const float* __restrict__ cs, bool rope, bool do_store) { head128_norm_rope_to(hp, hp, l16, gain, cs, rope, do_store); }
__device__ __forceinline__ void rope16_inplace(bf16_t* ip, const float* __restrict__ cs) {
    float a[8], b[8]; ld8f(ip, a); ld8f(ip + 8, b);
#pragma unroll
    for (int j = 0; j < 8; ++j) { const float c = cs[2 * j], s = cs[2 * j + 1], x1 = a[j], x2 = b[j]; a[j] = x1 * c - x2 * s; b[j] = x2 * c + x1 * s; }
    st8f(ip, a); st8f(ip + 8, b);
}
__device__ __forceinline__ void phase_prep(const Params& P, int layer) {
    const int wid = TIDX() >> 6, lane = TIDX() & 63, l16 = lane & 15, grp = lane >> 4;
    for (int tok = blockIdx.x * 8 + wid; tok < NTOK; tok += gridDim.x * 8) {
        bf16_t* row = P.p_() + (size_t)tok * NPAD;
        const float* cs32 = P.rope_() + (size_t)tok * 48; const float* cs16 = cs32 + 32;
        head128_norm_rope(row + C_DQ + grp * 128, l16, P.dsa_q_norm + layer * 128, cs32, true, true);
        head128_norm_rope_to(row + C_DK, P.kvc_() + (size_t)tok * 256, l16, P.dsa_k_norm + layer * 128, cs32, true, grp == 0);
        head128_norm_rope(row + C_MQ + grp * 128, l16, P.mem_q_norm + layer * 128, cs32, false, true);
        if ((lane & 3) == 0) rope16_inplace(row + C_DIQ + lane * 16, cs16);
        if (lane < 4) {
            bf16_t* dst = P.ikc_() + (size_t)(tok >> 5) * 2048 + lane * 512 + (tok & 31) * 8;
            float a[8], b[8]; ld8f(row + C_DIK + lane * 16, a); ld8f(row + C_DIK + lane * 16 + 8, b);
            if (lane == 0) {
#pragma unroll
                for (int q = 0; q < 8; ++q) { const float c = cs16[2 * q], s = cs16[2 * q + 1], x1 = a[q], x2 = b[q]; a[q] = x1 * c - x2 * s; b[q] = x2 * c + x1 * s; } }
            st8f(dst, a); st8f(dst + 256, b); }
        if (lane >= 16 && lane < 32) { const u32x4 vv = *(const u32x4*)(row + C_DV + (lane - 16) * 8); *(u32x4*)(P.kvc_() + (size_t)tok * 256 + 128 + (lane - 16) * 8) = vv; }
        if (lane < 16) P.iw_()[(size_t)tok * 16 + lane] = bf2f(row[C_DIW + lane]) * (1.f / 32.f);
    }
}
struct MemOutRow { const bf16_t* zb; bf16_t* gb;
    __device__ __forceinline__ const bf16_t* zrow(int r) const { return zb + (size_t)r * NPAD; } __device__ __forceinline__ bf16_t* grow(int r) const { return gb + (size_t)r * MIX; } };
__device__ __forceinline__ void unit_mem_attn(const Params& P, int layer, int u, char* lds) {
    const int b = u >> 6, h = (u >> 4) & 3, qb = u & 15, tok0 = b * SEQ + qb * 256;
    const int wid = TIDX() >> 6, lane = TIDX() & 63, r32 = lane & 31, hi = lane >> 5;
    const bf16_t* Qw = P.p_() + (size_t)(tok0 + wid * 32 + r32) * NPAD + C_MQ + h * 128 + hi * 8;
    const bf16_t* Kh = P.kvmem_() + (size_t)(b * MEML) * (DEPTH * 1024) + layer * 1024 + h * 128;
    MemOutRow ow; ow.zb = P.p_() + (size_t)(tok0 + wid * 32) * NPAD + C_MZ + h * 128; ow.gb = P.xn_() + (size_t)(tok0 + wid * 32) * MIX + 1536 + h * 128;
    att::attn_body<false, DEPTH * 1024, 512, MemOutRow>(Qw, Kh, MEML / 64, nullptr, 0u, ow, lds);
}

__device__ __forceinline__ void phase_gate(const Params& P, int c_lo, int c_hi) {
    const int wid = TIDX() >> 6, lane = TIDX() & 63;
    const int c0 = lane * 32;
    const int seg = c0 >> 9, zc = (seg == 0 ? C_GZ : seg == 1 ? C_SZ : seg == 2 ? C_DZ : C_MZ) + (c0 & 511);
    const bool act = (c0 >= c_lo) && (c0 < c_hi);
    for (int tok = blockIdx.x * 8 + wid; tok < NTOK; tok += gridDim.x * 8) {
        if (!act) { bf16_t* gz_ = P.xn_() + (size_t)tok * MIX + c0; const u32x4 zz = {0u, 0u, 0u, 0u};
#pragma unroll
            for (int i = 0; i < 4; ++i) *(u32x4*)(gz_ + 8 * i) = zz;
            continue; }
        const bf16_t* op = P.ocat_() + (size_t)tok * MIX + c0; const bf16_t* zp = P.p_() + (size_t)tok * NPAD + zc; bf16_t* gp = P.xn_() + (size_t)tok * MIX + c0;
        float o[32]; float ss = 0.f;
#pragma unroll
        for (int i = 0; i < 4; ++i) { float v[8]; ld8f(op + 8 * i, v);
#pragma unroll
            for (int j = 0; j < 8; ++j) { o[8 * i + j] = v[j]; ss += v[j] * v[j]; } }
        ss += shx(ss, 1); ss += shx(ss, 2);
        const float r = rsqrtf(ss * (1.f / 128.f) + EPS);
#pragma unroll
        for (int i = 0; i < 4; ++i) { float z[8], g[8]; ld8f(zp + 8 * i, z);
#pragma unroll
            for (int j = 0; j < 8; ++j) g[j] = o[8 * i + j] * r * siluf_(z[j]);
            st8f(gp + 8 * i, g); }
    }
}

__device__ __forceinline__ void phase_gemm_in(const Params& P, int layer, char* lds) {
    pg8::Gemm g; g.A = P.xn_(); g.Bt = P.WinT_() + (size_t)layer * NPAD * DM; g.M = NTOK; g.N = NPAD; g.K = DM;
    pg8::StaticOrder S; S.init(g.M, g.N, (int)gridDim.x, (int)blockIdx.x);
    pg8::EpiBf16Plain E; E.O = P.p_(); E.ldc = NPAD;
    pg8::gemm_phase<pg8::EpiBf16Plain, pg8::StaticOrder, false>((PG8_LAS unsigned char*)lds, g, S, E, nullptr);
}
__device__ __forceinline__ void phase_gemm_out(const Params& P, int layer, char* lds) {
    pg8::Gemm g; g.A = P.xn_(); g.Bt = P.WoutT_() + (size_t)layer * DM * MIX; g.M = NTOK; g.N = DM; g.K = MIX;
    pg8::StaticOrder S; S.init(g.M, g.N, (int)gridDim.x, (int)blockIdx.x);
    pg8::EpiResid E; E.R = (layer == 0) ? P.x : P.xbuf_(); E.C = (layer == DEPTH - 1) ? P.out : P.xbuf_(); E.ldc = DM;
    pg8::gemm_phase<pg8::EpiResid, pg8::StaticOrder, false>((PG8_LAS unsigned char*)lds, g, S, E, nullptr);
}
__device__ __forceinline__ void phase_gemm_kv(const Params& P, char* lds) {
    pg8::Gemm g; g.A = P.memn_(); g.Bt = P.WkvT_(); g.M = NB * MEML; g.N = DEPTH * 1024; g.K = DM;
    pg8::StaticOrder S; S.init(g.M, g.N, (int)gridDim.x, (int)blockIdx.x);
    pg8::EpiBf16Plain E; E.O = P.kvmem_(); E.ldc = DEPTH * 1024;
    pg8::gemm_phase<pg8::EpiBf16Plain, pg8::StaticOrder, false>((PG8_LAS unsigned char*)lds, g, S, E, nullptr);
}
__device__ __forceinline__ void mma_tile(f32x16& acc, const char* A, int lda, const char* B, int ldb, int K, int lane) {
    const int r = lane & 31, kh = lane >> 5;
    const char* ap = A + r * lda + kh * 16; const char* bp = B + r * ldb + kh * 16;
    asm volatile("" : "+v"(acc));
    for (int k = 0; k < K; k += 16) {
        const bf16x8 a = *(const bf16x8*)(ap + k * 2); const bf16x8 b = *(const bf16x8*)(bp + k * 2);
        acc = __builtin_amdgcn_mfma_f32_32x32x16_bf16(a, b, acc, 0, 0, 0);
    }
}
__device__ __forceinline__ int crow32(int r, int hi) { return (r & 3) + 8 * (r >> 2) + 4 * hi; }
__device__ __forceinline__ float log_sigmoid_(float x) { return fminf(x, 0.f) - log1pf(__expf(-fabsf(x))); }

constexpr int GLA_ST = 144;
constexpr int GLA_ST2 = 272;
__device__ __forceinline__ void gla_front(const Params& P, int layer, int tok0, int h, float (&bv)[8], float* glr_s  , float* tot_s  , float* bm_s  , float* bl_s  ) {
    const int tid = TIDX(), d = tid & 63, tg = tid >> 6;
    __syncthreads();
    if (tid < 128) { const int t = tid >> 1, half = tid & 1; float v[8]; ld8f(P.p_() + (size_t)(tok0 + t) * NPAD + C_GLR + half * 8, v);
#pragma unroll
        for (int j = 0; j < 8; ++j) glr_s[t * 16 + half * 8 + j] = v[j]; }
    float wu[16];
#pragma unroll
    for (int r = 0; r < 16; ++r) wu[r] = P.gla_w_up[((size_t)layer * 16 + r) * 256 + h * 64 + d];
    const float bias = P.gla_b_up[layer * 256 + h * 64 + d];
    __syncthreads();
    float run = 0.f;
#pragma unroll
    for (int i = 0; i < 8; ++i) { const int t = tg * 8 + i; float a = bias;
#pragma unroll
        for (int r = 0; r < 16; ++r) a = fmaf(glr_s[t * 16 + r], wu[r], a);
        run += log_sigmoid_(a) * (1.f / 16.f); bv[i] = run; }
    tot_s[tg * 64 + d] = run;
    __syncthreads();
    float off = 0.f, all = 0.f;
#pragma unroll
    for (int g = 0; g < 8; ++g) { const float v = tot_s[g * 64 + d]; off += (g < tg) ? v : 0.f; all += v; }
#pragma unroll
    for (int i = 0; i < 8; ++i) bv[i] += off;
    if (tg == 4) bm_s[d] = bv[0];
    if (tg == 0) bl_s[d] = all;
    __syncthreads();
}

__device__ __forceinline__ void unit_gla_a(const Params& P, int layer, int u, char* lds) {
    const int b = u >> 8, n = (u >> 2) & 63, h = u & 3, tok0 = b * SEQ + n * 64;
    const int tid = TIDX(), wid = tid >> 6, lane = tid & 63, d = tid & 63, tg = tid >> 6;
    char* kdT = lds;
    char* vT = lds + 64 * GLA_ST;
    float* glr_s = (float*)(lds + 64 * GLA_ST + 128 * GLA_ST); float* tot_s = glr_s + 1024; float* bm_s = tot_s + 512; float* bl_s = bm_s + 64;
    float bv[8]; gla_front(P, layer, tok0, h, bv, glr_s, tot_s, bm_s, bl_s);
    const float bl = bl_s[d];
#pragma unroll
    for (int i = 0; i < 8; ++i) { const int t = tg * 8 + i; const float k = bf2f(P.p_()[(size_t)(tok0 + t) * NPAD + C_GK + h * 64 + d]);
        *(bf16_t*)(kdT + d * GLA_ST + t * 2) = f2bf(k * __expf(bl - bv[i])); }
    { const int e = tid & 127, sg = tid >> 7;
#pragma unroll
      for (int i = 0; i < 16; ++i) { const int s = sg * 16 + i; *(bf16_t*)(vT + e * GLA_ST + s * 2) = P.p_()[(size_t)(tok0 + s) * NPAD + C_GV + h * 128 + e]; } }
    __syncthreads();
    const int mt = wid >> 2, nt = wid & 3, hi = lane >> 5;
    f32x16 acc = {}; mma_tile(acc, kdT + mt * 32 * GLA_ST, GLA_ST, vT + nt * 32 * GLA_ST, GLA_ST, 64, lane);
    float* dst = P.glas_() + ((size_t)((b * 64 + n) * 4 + h)) * 64 * 128;
#pragma unroll
    for (int r = 0; r < 16; ++r) dst[(mt * 32 + crow32(r, hi)) * 128 + nt * 32 + (lane & 31)] = acc[r];
    if (tid < 64) P.glad_()[((size_t)((b * 64 + n) * 4 + h)) * 64 + tid] = __expf(bl_s[tid]);
}

__device__ __forceinline__ void gla_scan_slice(const Params& P, int idx) {
    {
        const int e = idx & 127, d = (idx >> 7) & 63, h = (idx >> 13) & 3, b = idx >> 15;
        float S = 0.f;
        for (int n0 = 0; n0 < 64; n0 += 8) {
            float ds[8], dc[8];
#pragma unroll
            for (int i = 0; i < 8; ++i) { const size_t cu = (size_t)((b * 64 + n0 + i) * 4 + h); ds[i] = P.glas_()[cu * 8192 + d * 128 + e]; dc[i] = P.glad_()[cu * 64 + d]; }
#pragma unroll
            for (int i = 0; i < 8; ++i) { const size_t cu = (size_t)((b * 64 + n0 + i) * 4 + h); P.glas_()[cu * 8192 + d * 128 + e] = S; S = fmaf(dc[i], S, ds[i]); }
        }
    }
}

__device__ __forceinline__ void unit_gla_c(const Params& P, int layer, int u, char* lds) {
    const int b = u >> 8, n = (u >> 2) & 63, h = u & 3, tok0 = b * SEQ + n * 64;
    const int tid = TIDX(), wid = tid >> 6, lane = tid & 63, d = tid & 63, tg = tid >> 6, hi = lane >> 5;
    char* Acat = lds;
    char* Bcat = Acat + 64 * GLA_ST2;
    char* qe = Bcat + 128 * GLA_ST2;
    char* ke = qe + 64 * GLA_ST;
    float* glr_s = (float*)(ke + 64 * GLA_ST); float* tot_s = glr_s + 1024; float* bm_s = tot_s + 512; float* bl_s = bm_s + 64;
    float* o_s = bl_s + 64;
    float bv[8]; gla_front(P, layer, tok0, h, bv, glr_s, tot_s, bm_s, bl_s);
    const float m = bm_s[d];
#pragma unroll
    for (int i = 0; i < 8; ++i) { const int t = tg * 8 + i; const bf16_t* row = P.p_() + (size_t)(tok0 + t) * NPAD;
        const float q = bf2f(row[C_GQ + h * 64 + d]) * 0.125f, k = bf2f(row[C_GK + h * 64 + d]);
        *(bf16_t*)(qe + t * GLA_ST + d * 2) = f2bf(q * __expf(bv[i] - m));
        *(bf16_t*)(ke + t * GLA_ST + d * 2) = f2bf(k * __expf(m - bv[i]));
        *(bf16_t*)(Acat + t * GLA_ST2 + (64 + d) * 2) = f2bf(q * __expf(bv[i])); }
    { const int e = tid & 127, sg = tid >> 7;
      const float* sp = P.glas_() + ((size_t)((b * 64 + n) * 4 + h)) * 64 * 128;
#pragma unroll
      for (int i = 0; i < 16; ++i) { const int s = sg * 16 + i;
          *(bf16_t*)(Bcat + e * GLA_ST2 + s * 2) = P.p_()[(size_t)(tok0 + s) * NPAD + C_GV + h * 128 + e];
          *(bf16_t*)(Bcat + e * GLA_ST2 + (64 + s) * 2) = f2bf(sp[s * 128 + e]); } }
    __syncthreads();
    if (wid < 4) { const int mt = wid >> 1, nt = wid & 1;
        f32x16 acc = {}; mma_tile(acc, qe + mt * 32 * GLA_ST, GLA_ST, ke + nt * 32 * GLA_ST, GLA_ST, 64, lane);
#pragma unroll
        for (int r = 0; r < 16; ++r) { const int t = mt * 32 + crow32(r, hi), s = nt * 32 + (lane & 31);
            *(bf16_t*)(Acat + t * GLA_ST2 + s * 2) = f2bf(s <= t ? acc[r] : 0.f); } }
    __syncthreads();
    { const int mt = wid >> 2, nt = wid & 3;
      f32x16 acc = {}; mma_tile(acc, Acat + mt * 32 * GLA_ST2, GLA_ST2, Bcat + nt * 32 * GLA_ST2, GLA_ST2, 128, lane);
#pragma unroll
      for (int r = 0; r < 16; ++r) { const int t = mt * 32 + crow32(r, hi); o_s[t * 132 + nt * 32 + (lane & 31)] = acc[r]; } }
    __syncthreads();
    { const int t = tid >> 3, e0 = (tid & 7) * 16; const float* src = o_s + t * 132 + e0;
      f32x4 v[4]; float ss = 0.f;
#pragma unroll
      for (int i = 0; i < 4; ++i) { v[i] = *(const f32x4*)(src + 4 * i); ss += v[i][0] * v[i][0] + v[i][1] * v[i][1] + v[i][2] * v[i][2] + v[i][3] * v[i][3]; }
      ss += shx(ss, 1); ss += shx(ss, 2); ss += shx(ss, 4);
      const float rn = rsqrtf(ss * (1.f / 128.f) + EPS);
      const bf16_t* zp = P.p_() + (size_t)(tok0 + t) * NPAD + C_GZ + h * 128 + e0; bf16_t* gp = P.xn_() + (size_t)(tok0 + t) * MIX + h * 128 + e0;
#pragma unroll
      for (int i = 0; i < 2; ++i) { float z[8], gg[8]; ld8f(zp + 8 * i, z);
#pragma unroll
          for (int q = 0; q < 4; ++q) { gg[q] = v[2 * i][q] * rn * siluf_(z[q]); gg[4 + q] = v[2 * i + 1][q] * rn * siluf_(z[4 + q]); }
          st8f(gp + 8 * i, gg); } }
}
constexpr int S5P_STRIDE = 2304;
__device__ __forceinline__ void phase_s5_params(const Params& P) {
    for (int idx = blockIdx.x * NTHR + TIDX(); idx < DEPTH * 32 * 64; idx += gridDim.x * NTHR) {
        const int p = idx & 63, lg = idx >> 6;
        const float ar = P.s5_a_re[idx], ai = P.s5_a_im[idx], step = expf(P.s5_log_step[lg]);
        const float mag = expf(ar * step), th = ai * step;
        const float lr = mag * cosf(th), li = mag * sinf(th);
        float* o = P.s5p_() + (size_t)lg * S5P_STRIDE;
        o[2 * p] = lr; o[2 * p + 1] = li;
        { const float mag512 = expf(512.f * ar * step); const double a = 512.0 * (double)th; const double k = rint(a * 0.15915494309189535); const float rf = (float)fma(-k, 6.283185307179586, a);
          o[128 + 2 * p] = mag512 * cosf(rf); o[128 + 2 * p + 1] = mag512 * sinf(rf); }
        const float xr = lr - 1.f, xi = li, den = 1.f / (ar * ar + ai * ai);
        const float fr = (xr * ar + xi * ai) * den, fi = (xi * ar - xr * ai) * den;
        for (int c = 0; c < 16; ++c) { const float br = P.s5_b_re[(size_t)idx * 16 + c], bi = P.s5_b_im[(size_t)idx * 16 + c];
            o[256 + (p * 16 + c) * 2] = fr * br - fi * bi; o[256 + (p * 16 + c) * 2 + 1] = fr * bi + fi * br; }
    }
}
__device__ __forceinline__ float gelu_tanh_(float x) { const float u = 0.7978845608028654f * (x + 0.044715f * x * x * x); const float e = __expf(-2.f * fabsf(u)); const float th = copysignf((1.f - e) / (1.f + e), u); return 0.5f * x * (1.f + th); }

constexpr int S5_XST = 272;
constexpr int S5_UST = 48;
__device__ __forceinline__ float partner32(float v, int hi) { auto rr = __builtin_amdgcn_permlane32_swap(__float_as_uint(v), __float_as_uint(v), false, false); return __uint_as_float(hi ? rr[0] : rr[1]); }
struct S5Ctx { float l0r, l0i, l1r, l1i, q0r, q0i, q1r, q1i, dsk; char* Cm; char* Bb; char* Xs; char* Us; int lane, hi, j, rho; const bf16_t* ubase; bf16_t* ybase; };
template <bool OUT> __device__ __forceinline__ void s5_tile(const S5Ctx& C, int tok0, float& x0r, float& x0i, float& x1r, float& x1i) {
    const int hi = C.hi, j = C.j, lane = C.lane;
    if (hi == 0) { const bf16_t* up = C.ubase + (size_t)(tok0 + j) * NPAD;
        const bf16x8 w0 = *(const bf16x8*)up, w1 = *(const bf16x8*)(up + 8);
        *(bf16x8*)(C.Us + C.rho * S5_UST) = w0; *(bf16x8*)(C.Us + C.rho * S5_UST + 16) = w1; }
    asm volatile("" ::: "memory");
    f32x16 a0 = {}, a1 = {}, a2 = {}, a3 = {};
    mma_tile(a0, C.Us, S5_UST, C.Bb, S5_UST, 16, lane); mma_tile(a1, C.Us, S5_UST, C.Bb + 32 * S5_UST, S5_UST, 16, lane);
    mma_tile(a2, C.Us, S5_UST, C.Bb + 64 * S5_UST, S5_UST, 16, lane); mma_tile(a3, C.Us, S5_UST, C.Bb + 96 * S5_UST, S5_UST, 16, lane);
    float s0r[16], s0i[16], s1r[16], s1i[16];
#pragma unroll
    for (int r = 0; r < 16; ++r) {
        const float n0r = fmaf(C.l0r, x0r, fmaf(-C.l0i, x0i, a0[r])), n0i = fmaf(C.l0r, x0i, fmaf(C.l0i, x0r, a1[r])); x0r = n0r; x0i = n0i; s0r[r] = n0r; s0i[r] = n0i;
        const float n1r = fmaf(C.l1r, x1r, fmaf(-C.l1i, x1i, a2[r])), n1i = fmaf(C.l1r, x1i, fmaf(C.l1i, x1r, a3[r])); x1r = n1r; x1i = n1i; s1r[r] = n1r; s1i[r] = n1i; }
    float z0r = partner32(x0r, hi), z0i = partner32(x0i, hi), z1r = partner32(x1r, hi), z1i = partner32(x1i, hi);
    if (hi == 0) { z0r = 0.f; z0i = 0.f; z1r = 0.f; z1i = 0.f; }
    if (!OUT) {
        x0r += C.q0r * z0r - C.q0i * z0i; x0i += C.q0r * z0i + C.q0i * z0r; x1r += C.q1r * z1r - C.q1i * z1i; x1i += C.q1r * z1i + C.q1i * z1r;
    } else {
#pragma unroll
        for (int r = 0; r < 16; ++r) {
            const float t0r = C.l0r * z0r - C.l0i * z0i, t0i = C.l0r * z0i + C.l0i * z0r; z0r = t0r; z0i = t0i; s0r[r] += t0r; s0i[r] += t0i;
            const float t1r = C.l1r * z1r - C.l1i * z1i, t1i = C.l1r * z1i + C.l1i * z1r; z1r = t1r; z1i = t1i; s1r[r] += t1r; s1i[r] += t1i; }
        x0r = s0r[15]; x0i = s0i[15]; x1r = s1r[15]; x1i = s1i[15];
#pragma unroll
        for (int r = 0; r < 16; ++r) { char* xr_ = C.Xs + (r + 16 * hi) * S5_XST;
            *(bf16_t*)(xr_ + j * 2) = f2bf(s0r[r]); *(bf16_t*)(xr_ + (64 + j) * 2) = f2bf(s0i[r]);
            *(bf16_t*)(xr_ + (32 + j) * 2) = f2bf(s1r[r]); *(bf16_t*)(xr_ + (96 + j) * 2) = f2bf(s1i[r]); }
        asm volatile("" ::: "memory");
        f32x16 acc = {}; mma_tile(acc, C.Xs, S5_XST, C.Cm, S5_XST, 128, lane);
        if (j < 16) {
#pragma unroll
            for (int r = 0; r < 16; ++r) { const int t = crow32(r, hi); const int rt = ((t & 15) & 3) + 8 * ((t & 15) >> 2) + 4 * (t >> 4);
                const float y = acc[r] + C.dsk * bf2f(*(const bf16_t*)(C.Us + rt * S5_UST + j * 2));
                C.ybase[(size_t)(tok0 + t) * 512 + j] = f2bf(gelu_tanh_(y)); } }
        asm volatile("" ::: "memory");
    }
    { const float e0r = partner32(x0r, hi), e0i = partner32(x0i, hi), e1r = partner32(x1r, hi), e1i = partner32(x1i, hi);
      if (hi == 0) { x0r = e0r; x0i = e0i; x1r = e1r; x1i = e1i; } else { x0r = 0.f; x0i = 0.f; x1r = 0.f; x1i = 0.f; } }
}
__device__ __forceinline__ void unit_s5(const Params& P, int layer, int u, char* lds) {
    const int b = u >> 5, g = u & 31, tid = TIDX(), wid = tid >> 6, lane = tid & 63, hi = lane >> 5, j = lane & 31;
    char* Cm = lds;
    char* Bb = Cm + 32 * S5_XST;
    float* ends = (float*)(Bb + 128 * S5_UST);
    char* wbase = (char*)(ends + 8 * 64 * 2) + wid * (32 * S5_XST + 32 * S5_UST);
    const float* sp = P.s5p_() + (size_t)(layer * 32 + g) * S5P_STRIDE;
    __syncthreads();
    for (int i = tid; i < 32 * 128; i += NTHR) { const int c = i >> 7, pp = i & 127; float v = 0.f;
        if (c < 16) v = (pp < 64) ? P.s5_c_re[((size_t)(layer * 32 + g) * 16 + c) * 64 + pp] : -P.s5_c_im[((size_t)(layer * 32 + g) * 16 + c) * 64 + (pp - 64)];
        *(bf16_t*)(Cm + c * S5_XST + pp * 2) = f2bf(v); }
    for (int i = tid; i < 128 * 16; i += NTHR) { const int n = i >> 4, c = i & 15, nt = n >> 5, jj = n & 31, p = (nt >> 1) * 32 + jj;
        *(bf16_t*)(Bb + n * S5_UST + c * 2) = f2bf(sp[256 + (p * 16 + c) * 2 + (nt & 1)]); }
    S5Ctx C; C.Cm = Cm; C.Bb = Bb; C.Xs = wbase; C.Us = wbase + 32 * S5_XST; C.lane = lane; C.hi = hi; C.j = j;
    C.l0r = sp[2 * j]; C.l0i = sp[2 * j + 1]; C.l1r = sp[2 * (32 + j)]; C.l1i = sp[2 * (32 + j) + 1];
    { float q0r = C.l0r, q0i = C.l0i, q1r = C.l1r, q1i = C.l1i;
#pragma unroll
      for (int k = 0; k < 4; ++k) { const float a = q0r * q0r - q0i * q0i, bb = (q0r + q0r) * q0i; q0r = a; q0i = bb; const float c = q1r * q1r - q1i * q1i, d = (q1r + q1r) * q1i; q1r = c; q1i = d; }
      C.q0r = q0r; C.q0i = q0i; C.q1r = q1r; C.q1i = q1i; }
    C.dsk = P.s5_d[layer * 512 + g * 16 + (lane & 15)];
    C.rho = ((j & 15) & 3) + 8 * ((j & 15) >> 2) + 4 * (j >> 4);
    const int tokw = b * SEQ + wid * 512;
    C.ubase = P.p_() + C_SU + g * 16; C.ybase = P.ybuf_() + g * 16;
    float x0r = 0.f, x0i = 0.f, x1r = 0.f, x1i = 0.f;
    __syncthreads();
    for (int sc = 0; sc < 16; ++sc) s5_tile<false>(C, tokw + sc * 32, x0r, x0i, x1r, x1i);
    if (hi == 0) { ends[(wid * 64 + j) * 2] = x0r; ends[(wid * 64 + j) * 2 + 1] = x0i; ends[(wid * 64 + 32 + j) * 2] = x1r; ends[(wid * 64 + 32 + j) * 2 + 1] = x1i; }
    __syncthreads();
    { const float p0r = sp[128 + 2 * j], p0i = sp[128 + 2 * j + 1], p1r = sp[128 + 2 * (32 + j)], p1i = sp[128 + 2 * (32 + j) + 1];
      x0r = 0.f; x0i = 0.f; x1r = 0.f; x1i = 0.f;
      for (int w = 0; w < wid; ++w) { const float e0r = ends[(w * 64 + j) * 2], e0i = ends[(w * 64 + j) * 2 + 1], e1r = ends[(w * 64 + 32 + j) * 2], e1i = ends[(w * 64 + 32 + j) * 2 + 1];
          const float n0r = p0r * x0r - p0i * x0i + e0r, n0i = p0r * x0i + p0i * x0r + e0i, n1r = p1r * x1r - p1i * x1i + e1r, n1i = p1r * x1i + p1i * x1r + e1i;
          x0r = n0r; x0i = n0i; x1r = n1r; x1i = n1i; }
      if (hi) { x0r = 0.f; x0i = 0.f; x1r = 0.f; x1i = 0.f; } }
    for (int sc = 0; sc < 16; ++sc) s5_tile<true>(C, tokw + sc * 32, x0r, x0i, x1r, x1i);
}
constexpr int TOPK = 256;
__device__ __forceinline__ unsigned f2key(float f) { const unsigned u = __float_as_uint(f); return u ^ ((u & 0x80000000u) ? 0xffffffffu : 0x80000000u); }

__device__ __forceinline__ float relu1(float x) { const int b = __float_as_int(x); return __int_as_float(b > 0 ? b : 0); }
#define DSA_MM(acc, rt, kk) acc = __builtin_amdgcn_mfma_f32_32x32x16_bf16(afr[rt][kk], bfr[kk], acc, 0, 0, 0)
#define DSA_HS(acc, rt, q) do { s0 = fmaf(relu1(acc[4 * (q)]), wv[rt][4 * (q)], s0); s1 = fmaf(relu1(acc[4 * (q) + 1]), wv[rt][4 * (q) + 1], s1); \
                                s0 = fmaf(relu1(acc[4 * (q) + 2]), wv[rt][4 * (q) + 2], s0); s1 = fmaf(relu1(acc[4 * (q) + 3]), wv[rt][4 * (q) + 3], s1); } while (0)
#define DSA_SG() do { __builtin_amdgcn_sched_group_barrier(0x8, 1, 0); __builtin_amdgcn_sched_group_barrier(0x2, 8, 0); } while (0)
__device__ __forceinline__ void dsa_score_tile(const bf16x8 (&afr)[4][4], const f32x16 (&wv)[4], const bf16x8 (&bfr)[4], float* sc, int col, int hi) {
    f32x16 accA = {}, accB = {}; asm volatile("" : "+v"(accA), "+v"(accB));
    float s0, s1;
    DSA_MM(accA, 0, 0); DSA_MM(accA, 0, 1); DSA_MM(accA, 0, 2); DSA_MM(accA, 0, 3);
    s0 = 0.f; s1 = 0.f;
    DSA_MM(accB, 1, 0); DSA_HS(accA, 0, 0); DSA_SG(); DSA_MM(accB, 1, 1); DSA_HS(accA, 0, 1); DSA_SG();
    DSA_MM(accB, 1, 2); DSA_HS(accA, 0, 2); DSA_SG(); DSA_MM(accB, 1, 3); DSA_HS(accA, 0, 3); DSA_SG();
    sc[(0 + hi) * 4096 + col] = (s0 + s1) + 0.f;
    accA = (f32x16){}; asm volatile("" : "+v"(accA)); s0 = 0.f; s1 = 0.f;
    DSA_MM(accA, 2, 0); DSA_HS(accB, 1, 0); DSA_SG(); DSA_MM(accA, 2, 1); DSA_HS(accB, 1, 1); DSA_SG();
    DSA_MM(accA, 2, 2); DSA_HS(accB, 1, 2); DSA_SG(); DSA_MM(accA, 2, 3); DSA_HS(accB, 1, 3); DSA_SG();
    sc[(2 + hi) * 4096 + col] = (s0 + s1) + 0.f;
    accB = (f32x16){}; asm volatile("" : "+v"(accB)); s0 = 0.f; s1 = 0.f;
    DSA_MM(accB, 3, 0); DSA_HS(accA, 2, 0); DSA_SG(); DSA_MM(accB, 3, 1); DSA_HS(accA, 2, 1); DSA_SG();
    DSA_MM(accB, 3, 2); DSA_HS(accA, 2, 2); DSA_SG(); DSA_MM(accB, 3, 3); DSA_HS(accA, 2, 3); DSA_SG();
    sc[(4 + hi) * 4096 + col] = (s0 + s1) + 0.f;
    s0 = 0.f; s1 = 0.f;
    DSA_HS(accB, 3, 0); DSA_HS(accB, 3, 1); DSA_HS(accB, 3, 2); DSA_HS(accB, 3, 3);
    sc[(6 + hi) * 4096 + col] = (s0 + s1) + 0.f;
}
#define DSA_CNT4(K0, K1, K2, K3) asm volatile( \
    "v_cmp_ge_u32_e64 %[m0], %[k0], %[cd]\n\tv_cmp_ge_u32_e64 %[m1], %[k1], %[cd]\n\tv_cmp_ge_u32_e64 %[m2], %[k2], %[cd]\n\tv_cmp_ge_u32_e64 %[m3], %[k3], %[cd]\n\t" \
    "v_addc_co_u32_e64 %[a0], %[m0], %[a0], 0, %[m0]\n\tv_addc_co_u32_e64 %[a1], %[m1], %[a1], 0, %[m1]\n\t" \
    "v_addc_co_u32_e64 %[a0], %[m2], %[a0], 0, %[m2]\n\tv_addc_co_u32_e64 %[a1], %[m3], %[a1], 0, %[m3]" \
    : [a0] "+v"(c0), [a1] "+v"(c1), [m0] "=&s"(sm0), [m1] "=&s"(sm1), [m2] "=&s"(sm2), [m3] "=&s"(sm3) \
    : [k0] "v"(K0), [k1] "v"(K1), [k2] "v"(K2), [k3] "v"(K3), [cd] "v"(cand))
#define DSA_CNT8(J0) do { DSA_CNT4(key[(J0)], key[(J0) + 1], key[(J0) + 2], key[(J0) + 3]); DSA_CNT4(key[(J0) + 4], key[(J0) + 5], key[(J0) + 6], key[(J0) + 7]); } while (0)

__device__ __forceinline__ void unit_dsa_index(const Params& P, int u, char* lds) {
    const int b = u & 3, t0 = (511 - (u >> 2)) * 8;
    const int tid = TIDX(), wid = tid >> 6, lane = tid & 63, r32 = lane & 31, hi = lane >> 5;
    float* sc = (float*)lds;
    const bf16_t* pb = P.p_() + (size_t)b * SEQ * NPAD;
    __syncthreads();
    {
        bf16x8 afr[4][4]; f32x16 wv[4];
        const int qsel = (r32 >> 2) & 1, head = (r32 & 3) + 4 * (r32 >> 3);
#pragma unroll
        for (int rt = 0; rt < 4; ++rt) { const bf16_t* qp = pb + (size_t)(t0 + 2 * rt + qsel) * NPAD + C_DIQ + head * 64 + hi * 8;
#pragma unroll
            for (int kk = 0; kk < 4; ++kk) afr[rt][kk] = *(const bf16x8*)(qp + kk * 16);
            const float* wp = P.iw_() + (size_t)(b * SEQ + t0 + 2 * rt + hi) * 16;
#pragma unroll
            for (int i = 0; i < 4; ++i) { const f32x4 w4 = *(const f32x4*)(wp + 4 * i); wv[rt][4 * i] = w4[0]; wv[rt][4 * i + 1] = w4[1]; wv[rt][4 * i + 2] = w4[2]; wv[rt][4 * i + 3] = w4[3]; } }
        const int ntile = (t0 + 7) / 32 + 1;
        const bf16_t* kp = P.ikc_() + (size_t)(b * (SEQ / 32)) * 2048 + lane * 8;
        bf16x8 b0[4], b1[4], b2[4];
#define DSA_LDB(dst, K) do { const bf16_t* kq_ = kp + (size_t)(wid + 8 * (K)) * 2048; _Pragma("unroll") for (int kk = 0; kk < 4; ++kk) dst[kk] = *(const bf16x8*)(kq_ + kk * 512); } while (0)
#define DSA_TILE(buf, K) dsa_score_tile(afr, wv, buf, sc, (wid + 8 * (K)) * 32 + r32, hi)
        const int nk = (ntile - wid + 7) >> 3;
        const int kl = nk > 0 ? nk - 1 : 0;
#define DSA_MIN(a) ((a) < kl ? (a) : kl)
        DSA_LDB(b0, DSA_MIN(0)); DSA_LDB(b1, DSA_MIN(1));
        int k = 0;
        for (; k + 3 <= nk; k += 3) {
            DSA_LDB(b2, k + 2); DSA_TILE(b0, k);
            DSA_LDB(b0, DSA_MIN(k + 3)); DSA_TILE(b1, k + 1);
            DSA_LDB(b1, DSA_MIN(k + 4)); DSA_TILE(b2, k + 2);
        }
        if (k < nk) DSA_TILE(b0, k);
        if (k + 1 < nk) DSA_TILE(b1, k + 1);
#undef DSA_TILE
#undef DSA_MIN
#undef DSA_TILE
#undef DSA_LDB
    }
    __syncthreads();
    {
        const int t = t0 + wid; const float* srow = sc + wid * 4096;
        unsigned key[64];
#pragma unroll
        for (int j = 0; j < 64; ++j) { const int s = j * 64 + lane; key[j] = (s <= t) ? f2key(srow[s]) : 0u; }
        unsigned long long* mout = P.mask_() + (size_t)(b * SEQ + t) * 64;
        unsigned long long myword = 0ull;
        if (t + 1 <= TOPK) {
#pragma unroll
            for (int j = 0; j < 64; ++j) { const unsigned long long m = __ballot(j * 64 + lane <= t); if (lane == j) myword = m; }
        } else {
            const int ngrp = t / 512 + 1;
            unsigned* hist = (unsigned*)(sc + wid * 4096);
            asm volatile("" ::: "memory");
            { const u32x4 zz4 = {0u, 0u, 0u, 0u};
#pragma unroll
              for (int i = 0; i < 16; ++i) *(u32x4*)(hist + (i * 64 + lane) * 4) = zz4; }
            asm volatile("" ::: "memory");
#define DSA_H8(J0) do { _Pragma("unroll") for (int jj = 0; jj < 8; ++jj) atomicAdd(hist + (key[(J0) + jj] >> 20), 1u); } while (0)
            DSA_H8(0);
            if (ngrp > 1) DSA_H8(8);
            if (ngrp > 2) DSA_H8(16);
            if (ngrp > 3) DSA_H8(24);
            if (ngrp > 4) DSA_H8(32);
            if (ngrp > 5) DSA_H8(40);
            if (ngrp > 6) DSA_H8(48);
            if (ngrp > 7) DSA_H8(56);
#undef DSA_H8
            asm volatile("" ::: "memory");
#define DSA_SUFFIX(s) do { _Pragma("unroll") for (int o = 1; o < 64; o <<= 1) { unsigned t_ = (unsigned)__builtin_amdgcn_ds_bpermute(((lane + o) & 63) << 2, (int)(s)); (s) += (lane + o < 64) ? t_ : 0u; } } while (0)
            unsigned mine = 0u;
#pragma unroll
            for (int i = 0; i < 16; ++i) { const u32x4 v4 = *(const u32x4*)(hist + lane * 64 + ((i + lane) & 15) * 4); mine += (v4[0] + v4[1]) + (v4[2] + v4[3]); }
            unsigned suf = mine; DSA_SUFFIX(suf);
            const unsigned long long mL = __ballot(suf - mine < (unsigned)TOPK && suf >= (unsigned)TOPK);
            const int Ls = (int)__builtin_ctzll(mL);
            const unsigned cntA = (unsigned)__builtin_amdgcn_readlane((int)(suf - mine), Ls);
            unsigned h2 = hist[Ls * 64 + lane]; unsigned suf2 = h2; DSA_SUFFIX(suf2);
            const unsigned long long mB = __ballot(cntA + suf2 - h2 < (unsigned)TOPK && cntA + suf2 >= (unsigned)TOPK);
            const int Bs = (int)__builtin_ctzll(mB);
            const unsigned bstar = (unsigned)(Ls * 64 + Bs);
            const unsigned cntAbove = cntA + (unsigned)__builtin_amdgcn_readlane((int)(suf2 - h2), Bs);
            const unsigned inbin = (unsigned)__builtin_amdgcn_readlane((int)h2, Bs);
#undef DSA_SUFFIX
            unsigned T = bstar << 20; int cntT = (int)(cntAbove + inbin);
            if (cntT != TOPK) {
                asm volatile("" ::: "memory");
                int nslot = 0;
#pragma unroll
                for (int j = 0; j < 64; ++j) { if ((key[j] >> 20) == bstar) { hist[nslot * 64 + lane] = key[j]; ++nslot; } }
                asm volatile("" ::: "memory");
                int R = nslot;
#pragma unroll
                for (int o = 32; o >= 1; o >>= 1) { const int other = __builtin_amdgcn_ds_bpermute(((lane ^ o) << 2), R); R = other > R ? other : R; }
                R = __builtin_amdgcn_readfirstlane(R);
                if (R <= 8) {
                    unsigned c[8];
#pragma unroll
                    for (int r = 0; r < 8; ++r) c[r] = (r < nslot) ? hist[r * 64 + lane] : 0u;
                    for (int bit = 19; bit >= 0; --bit) {
                        const unsigned cand = T | (1u << bit); int cnt = (int)cntAbove;
#pragma unroll
                        for (int r = 0; r < 8; ++r) cnt += __popcll(__ballot(c[r] >= cand));
                        if (cnt >= TOPK) { T = cand; cntT = cnt; if (cnt == TOPK) break; }
                    }
                } else {
                    for (int bit = 19; bit >= 0; --bit) {
                        const unsigned cand = T | (1u << bit); unsigned c0 = 0, c1 = 0; unsigned long long sm0, sm1, sm2, sm3;
                        DSA_CNT8(0);
                        if (ngrp > 1) DSA_CNT8(8);
                        if (ngrp > 2) DSA_CNT8(16);
                        if (ngrp > 3) DSA_CNT8(24);
                        if (ngrp > 4) DSA_CNT8(32);
                        if (ngrp > 5) DSA_CNT8(40);
                        if (ngrp > 6) DSA_CNT8(48);
                        if (ngrp > 7) DSA_CNT8(56);
                        const int cl = (int)(c0 + c1);
                        int cnt = 0;
#pragma unroll
                        for (int bb = 0; bb < 7; ++bb) cnt += __popcll(__ballot((cl >> bb) & 1)) << bb;
                        if (cnt >= TOPK) { T = cand; cntT = cnt; if (cnt == TOPK) break; }
                    }
                }
            }
            if (cntT == TOPK) {
#pragma unroll
                for (int j = 0; j < 64; ++j) { const unsigned long long m = __ballot(key[j] >= T); if (lane == j) myword = m; }
            } else {
                int ngt = 0;
#pragma unroll
                for (int j = 0; j < 64; ++j) ngt += __popcll(__ballot(key[j] > T));
                int need = TOPK - ngt;
#pragma unroll
                for (int j = 0; j < 64; ++j) { const unsigned long long eq = __ballot(key[j] == T), gt = __ballot(key[j] > T);
                    const int ne = __popcll(eq); unsigned long long take = eq;
                    if (ne > need) { take = 0ull; int left = need; unsigned long long e2 = eq;
                        while (left > 0) { const unsigned long long lowbit = e2 & (0ull - e2); take |= lowbit; e2 ^= lowbit; --left; } }
                    need -= (ne > need) ? need : ne;
                    const unsigned long long m = gt | take; if (lane == j) myword = m; }
            }
        }
        mout[lane] = myword;
    }
}

struct DsaOutRow { const bf16_t* zb; bf16_t* gb; int wid;
    __device__ __forceinline__ const bf16_t* zrow(int r) const { const int rho = wid * 32 + r; return zb + (size_t)(rho >> 2) * NPAD + (rho & 3) * 128; }
    __device__ __forceinline__ bf16_t* grow(int r) const { const int rho = wid * 32 + r; return gb + (size_t)(rho >> 2) * MIX + (rho & 3) * 128; } };
__device__ __forceinline__ void unit_dsa_attn(const Params& P, int u, char* lds) {
    const int b = u & 3, qb = 63 - (u >> 2), t0 = qb * 64, tokb = b * SEQ;
    const int wid = TIDX() >> 6, lane = TIDX() & 63, r32 = lane & 31, hi = lane >> 5;
    const int rho = wid * 32 + r32, tq = t0 + (rho >> 2), hq = rho & 3;
    const bf16_t* Qw = P.p_() + (size_t)(tokb + tq) * NPAD + C_DQ + hq * 128 + hi * 8;
    const bf16_t* Kh = P.kvc_() + (size_t)tokb * 256;
    const unsigned moff = (unsigned)(tokb + tq) * 512u;
    DsaOutRow ow; ow.zb = P.p_() + (size_t)(tokb + t0) * NPAD + C_DZ; ow.gb = P.xn_() + (size_t)(tokb + t0) * MIX + 1024; ow.wid = wid;
    const int NT = (qb + 2) & ~1;
    att::attn_body<true, 256, 128, DsaOutRow>(Qw, Kh, NT, P.mask_(), moff, ow, lds);
}
__device__ __forceinline__ void phase_gemm_glu(const Params& P, int layer, char* lds) {
    pg8::Gemm g; g.A = P.ybuf_(); g.Bt = P.WgluT_() + (size_t)layer * 512 * 512; g.M = NTOK; g.N = 512; g.K = 512;
    pg8::StaticOrder S; S.init(g.M, g.N, (int)gridDim.x, (int)blockIdx.x);
    pg8::EpiGlu E; E.Y = P.ybuf_(); E.ldy = 512; E.O = P.ocat_(); E.ldo = MIX; E.ooff = 512;
    pg8::gemm_phase<pg8::EpiGlu, pg8::StaticOrder, false>((PG8_LAS unsigned char*)lds, g, S, E, nullptr);
}

constexpr int CTL_Q0 = 4096;
struct OneUnit { int pm, pn; __device__ __forceinline__ bool next(int i, pg8::Unit& u) const { if (i) return false; u.pm = pm; u.pn = pn; return true; }
    __device__ __forceinline__ void a_ready(const pg8::Unit&) const {} __device__ __forceinline__ void done(const pg8::Unit&) const {} };
__device__ __forceinline__ int q_issue(unsigned* ctr) { return (int)__hip_atomic_fetch_add(ctr, 1u, __ATOMIC_RELAXED, __HIP_MEMORY_SCOPE_AGENT); }
#define Q_LOOP_BEGIN(ctr, total)  { unsigned* q_ctr_ = (ctr); const int q_total_ = (total); volatile int* q_b_ = (volatile int*)(lds + LDS_TAIL + 16); \
    for (;;) { __syncthreads(); if (TIDX() == 0) *q_b_ = q_issue(q_ctr_); __syncthreads(); const int item = __builtin_amdgcn_readfirstlane(*q_b_); if (item >= q_total_) break;
#define Q_LOOP_END  } }
__device__ __forceinline__ void unit_glu(const Params& P, int layer, int u, char* lds) {
    pg8::Gemm g; g.A = P.ybuf_(); g.Bt = P.WgluT_() + (size_t)layer * 512 * 512; g.M = NTOK; g.N = 512; g.K = 512;
    OneUnit S; S.pm = u >> 1; S.pn = u & 1;
    pg8::EpiGluGate E; E.Y = P.ybuf_(); E.Pz = P.p_(); E.G = P.xn_();
    pg8::gemm_phase<pg8::EpiGluGate, OneUnit, false>((PG8_LAS unsigned char*)lds, g, S, E, nullptr);
}
constexpr int LDS_TAIL = LDS_BYTES - 64;

__global__ __launch_bounds__(NTHR, 2) void k_mega(Params P) {
    extern __shared__ __attribute__((aligned(16))) char lds[];
    if (TIDX() == 0) *(uint4*)(lds + LDS_TAIL) = make_uint4(0u, 0u, 0u, 0u);
    __syncthreads();
    XcdBarrier bar = xcd_barrier_post(P.ctl_(), (volatile LAS unsigned*)(lds + LDS_TAIL));
    const int G = gridDim.x, B = blockIdx.x;
    phase_prologue1(P, lds); phase_rope_table(P); phase_s5_params(P); phase_rmsnorm_x(P, 0);
    xcd_barrier(bar);
    for (int layer = 0; layer < DEPTH; ++layer) {
        if (layer > 0) { phase_rmsnorm_x(P, layer); xcd_barrier(bar); }
        phase_gemm_in(P, layer, lds);
        if (layer == 0) phase_gemm_kv(P, lds);
        xcd_barrier(bar);
        phase_prep(P, layer);
        if (layer == 0) phase_memk_norm(P);
        for (int u = B; u < 1024; u += G) unit_gla_a(P, layer, u, lds);
        xcd_barrier(bar);
        Q_LOOP_BEGIN(P.ctl_() + CTL_Q0 + 64 * (layer * 2), 128 + 2048 + 256 + 256)
            if (item < 128) unit_s5(P, layer, item, lds);
            else if (item < 2176) unit_dsa_index(P, item - 128, lds);
            else if (item < 2432) unit_mem_attn(P, layer, item - 2176, lds);
            else gla_scan_slice(P, (item - 2432) * NTHR + TIDX());
        Q_LOOP_END
        xcd_barrier(bar);
        Q_LOOP_BEGIN(P.ctl_() + CTL_Q0 + 64 * (layer * 2 + 1), 256 + 256 + 128)
            if (item < 256) unit_dsa_attn(P, item, lds);
            else if (item < 512) { for (int k = 0; k < 4; ++k) unit_gla_c(P, layer, (item - 256) * 4 + k, lds); }
            else unit_glu(P, layer, item - 512, lds);
        Q_LOOP_END
        xcd_barrier(bar);
        phase_gemm_out(P, layer, lds);
        xcd_barrier(bar);
    }
}

extern "C" void kernel_launch(void* const* d_in, const int* in_sizes, int n_in, void* d_out, int out_size, void* d_ws, size_t ws_size, hipStream_t stream) {
    if (n_in != 24 || ws_size < WS_END) { fprintf(stderr, "kernel_launch: unexpected n_in %d or ws_size %zu (< %zu)\n", n_in, ws_size, (size_t)WS_END); return; }
    Params P; memset(&P, 0, sizeof(P));
    P.x = (const float*)d_in[0]; P.mem = (const float*)d_in[1]; P.pos = (const int*)d_in[2]; P.ln_gain = (const float*)d_in[3]; P.w_in = (const float*)d_in[4];
    P.gla_w_up = (const float*)d_in[5]; P.gla_b_up = (const float*)d_in[6]; P.s5_a_re = (const float*)d_in[7]; P.s5_a_im = (const float*)d_in[8]; P.s5_log_step = (const float*)d_in[9];
    P.s5_b_re = (const float*)d_in[10]; P.s5_b_im = (const float*)d_in[11]; P.s5_c_re = (const float*)d_in[12]; P.s5_c_im = (const float*)d_in[13]; P.s5_d = (const float*)d_in[14];
    P.s5_w_glu = (const float*)d_in[15]; P.dsa_q_norm = (const float*)d_in[16]; P.dsa_k_norm = (const float*)d_in[17]; P.mem_norm = (const float*)d_in[18]; P.w_mem_kv = (const float*)d_in[19];
    P.mem_q_norm = (const float*)d_in[20]; P.mem_k_norm = (const float*)d_in[21]; P.out_norm = (const float*)d_in[22]; P.w_out = (const float*)d_in[23];
    P.out = (float*)d_out;
    char* ws = (char*)d_ws; P.ws = ws;
    static int grid = 0;
    if (!grid) {
        int dev = 0, cus = 0, per_cu = 0;
        (void)hipGetDevice(&dev); (void)hipDeviceGetAttribute(&cus, hipDeviceAttributeMultiprocessorCount, dev);
        (void)hipFuncSetAttribute((const void*)k_mega, hipFuncAttributeMaxDynamicSharedMemorySize, LDS_BYTES);
        (void)hipOccupancyMaxActiveBlocksPerMultiprocessor(&per_cu, (const void*)k_mega, NTHR, LDS_BYTES);
        if (per_cu < 1) fprintf(stderr, "kernel_launch: occupancy query reports %d blocks per CU\n", per_cu);
        grid = cus > 0 ? cus : 256;
    }
    (void)hipMemsetAsync(ws + WS_CTL, 0, CTL_BYTES, stream);
    hipLaunchKernelGGL(k_mega, dim3(grid), dim3(NTHR), LDS_BYTES, stream, P);
}
```

```cpp
#include <hip/hip_runtime.h>
#include <stdint.h>
#include <stdio.h>
#include <string.h>

constexpr int NB = 4, SEQ = 4096, NTOK = NB * SEQ, DM = 2048, DEPTH = 4, MEML = 256;
constexpr int NIN = 5984, NPAD = 6144, MIX = 2048;
constexpr int C_GQ = 0, C_GK = 256, C_GV = 512, C_GLR = 1024, C_GZ = 1040, C_SU = 1552, C_SZ = 2064, C_DQ = 2576, C_DK = 3088, C_DV = 3216,
              C_DIQ = 3344, C_DIK = 4368, C_DIW = 4432, C_DZ = 4448, C_MQ = 4960, C_MZ = 5472;
constexpr float EPS = 1e-6f;
constexpr int NTHR = 512;
constexpr int LDS_BYTES = 147456;

typedef unsigned short bf16_t;
typedef short bf16x8 __attribute__((ext_vector_type(8)));
typedef short s16x4 __attribute__((ext_vector_type(4)));
typedef float f32x4 __attribute__((ext_vector_type(4)));
typedef float f32x8 __attribute__((ext_vector_type(8)));
typedef float f32x16 __attribute__((ext_vector_type(16)));
typedef unsigned u32x4 __attribute__((ext_vector_type(4)));
typedef unsigned u32x2 __attribute__((ext_vector_type(2)));
#define LAS __attribute__((address_space(3)))

__device__ __forceinline__ float bf2f(bf16_t b) { return __uint_as_float(((unsigned)b) << 16); }
__device__ __forceinline__ bf16_t f2bf(float f) { unsigned u = __float_as_uint(f); u += 0x7FFFu + ((u >> 16) & 1u); return (bf16_t)(u >> 16); }
__device__ __forceinline__ unsigned pk2bf(float lo, float hi) { return (unsigned)f2bf(lo) | ((unsigned)f2bf(hi) << 16); }
__device__ __forceinline__ float sigmoidf_(float x) { return 1.f / (1.f + __expf(-x)); }
__device__ __forceinline__ float siluf_(float x) { return x / (1.f + __expf(-x)); }

__device__ __forceinline__ int TIDX() { int t = (int)threadIdx.x; asm volatile("" : "+v"(t)); return t; }
__device__ __forceinline__ float shx(float v, int m) { const int src = ((TIDX() & 63) ^ m) << 2; return __int_as_float(__builtin_amdgcn_ds_bpermute(src, __float_as_int(v))); }
__device__ __forceinline__ float wave_sum(float v) {
#pragma unroll
    for (int o = 32; o >= 1; o >>= 1) v += shx(v, o);
    return v;
}
__device__ __forceinline__ void ld8f(const bf16_t* p, float (&v)[8]) { const u32x4 w = *(const u32x4*)p;
#pragma unroll
    for (int j = 0; j < 4; ++j) { v[2 * j] = __uint_as_float(w[j] << 16); v[2 * j + 1] = __uint_as_float(w[j] & 0xffff0000u); } }
__device__ __forceinline__ void st8f(bf16_t* p, const float (&v)[8]) { u32x4 w; w.x = pk2bf(v[0], v[1]); w.y = pk2bf(v[2], v[3]); w.z = pk2bf(v[4], v[5]); w.w = pk2bf(v[6], v[7]); *(u32x4*)p = w; }
__device__ __forceinline__ float f2bf_f(float f) { return bf2f(f2bf(f)); }
#define XB_TMO      128
#define XB_XCNT(j)  (256  + 64 * (j))
#define XB_XSUB(j)  (1280 + 64 * (j))
#define XB_XGEN(j)  (2304 + 64 * (j))
#define XB_TOP      3328
#define XB_TOPGEN   3392
#define XCD_BAR_WORDS 3456
#define XB_SPIN_CAP (1u << 18)

__device__ __forceinline__ unsigned xb_ld(unsigned* p)              { return __hip_atomic_load(p, __ATOMIC_RELAXED, __HIP_MEMORY_SCOPE_AGENT); }
__device__ __forceinline__ unsigned xb_add(unsigned* p, unsigned v) { return __hip_atomic_fetch_add(p, v, __ATOMIC_RELAXED, __HIP_MEMORY_SCOPE_AGENT); }
__device__ __forceinline__ unsigned xb_xcc_id() { return (unsigned)__builtin_amdgcn_s_getreg((3 << 11) | 20) & 0xFu; }
#define XB_SPIN(cond, bar) do { unsigned _sp = 0; while (cond) { __builtin_amdgcn_s_sleep(1); \
    if ((++_sp & 255u) == 0u) { if (xb_ld(&(bar)[XB_TMO])) break; if (_sp > XB_SPIN_CAP) { atomicAdd(&(bar)[XB_TMO], 1u); break; } } } } while (0)

struct XcdBarrier {
    unsigned* bar; unsigned x;
    volatile LAS unsigned* st;
};

__device__ __forceinline__ XcdBarrier xcd_barrier_post(unsigned* bar, volatile LAS unsigned* st) {
    XcdBarrier b; b.bar = bar; b.x = xb_xcc_id(); b.st = st;
    if (TIDX() == 0) (void)xb_add(&bar[XB_XCNT(b.x)], 1u);
    return b;
}
__device__ __forceinline__ void xcd_barrier_complete(unsigned* bar, unsigned x, unsigned& nloc, unsigned& nx) {
    const unsigned G = gridDim.x * gridDim.y * gridDim.z;
    unsigned sum, cnt, mine, sp = 0u;
    for (;;) {
        sum = 0u; cnt = 0u; mine = 0u;
#pragma unroll
        for (unsigned j = 0; j < 16; ++j) { const unsigned c = xb_ld(&bar[XB_XCNT(j)]); sum += c; cnt += (c > 0u) ? 1u : 0u; mine = (j == x) ? c : mine; }
        if (sum == G) break;
        __builtin_amdgcn_s_sleep(1);
        if ((++sp & 255u) == 0u) { if (xb_ld(&bar[XB_TMO])) break; if (sp > XB_SPIN_CAP) { atomicAdd(&bar[XB_TMO], 1u); break; } }
    }
    nloc = mine > 0u ? mine : 1u; nx = cnt > 0u ? cnt : 1u;
}

__device__ __forceinline__ void xcd_barrier(const XcdBarrier& b) {
    asm volatile("s_waitcnt vmcnt(0)" ::: "memory");
    __syncthreads();
    if (TIDX() == 0) {
        unsigned* bar = b.bar; const unsigned bx = xb_xcc_id();
        __builtin_amdgcn_s_waitcnt(0);
        unsigned nloc = b.st[0], nx = b.st[1];
        if (nloc == 0u) { xcd_barrier_complete(bar, bx, nloc, nx); b.st[0] = nloc; b.st[1] = nx; }
        const unsigned old = xb_add(&bar[XB_XSUB(bx)], 1u);
        const unsigned gen = old / nloc;
        if (old + 1u == (gen + 1u) * nloc) {
            __builtin_amdgcn_fence(__ATOMIC_RELEASE, "agent");
            asm volatile("s_waitcnt vmcnt(0)" ::: "memory");
            const unsigned og = xb_add(&bar[XB_TOP], 1u);
            const unsigned tg = og / nx;
            if (og + 1u == (tg + 1u) * nx) xb_add(&bar[XB_TOPGEN], 1u);
            else XB_SPIN(xb_ld(&bar[XB_TOPGEN]) == tg, bar);
            __builtin_amdgcn_fence(__ATOMIC_ACQUIRE, "agent");
            xb_add(&bar[XB_XGEN(bx)], 1u);
            asm volatile("s_waitcnt vmcnt(0)" ::: "memory");
        } else {
            XB_SPIN(xb_ld(&bar[XB_XGEN(bx)]) == gen, bar);
            __builtin_amdgcn_fence(__ATOMIC_ACQUIRE, "agent");
            asm volatile("s_waitcnt vmcnt(0)" ::: "memory");
        }
    }
    __syncthreads();
}
namespace pg8 {
#define PG8_LAS __attribute__((address_space(3)))
typedef float f32x2 __attribute__((ext_vector_type(2)));
typedef unsigned u32x4 __attribute__((ext_vector_type(4)));
constexpr int BM = 256, BK = 64, HALF = 128, HTB = HALF * BK * 2  , STAGE_BYTES = 8 * HTB, NXCD = 8, WGM = 8;

__host__ __device__ __forceinline__ int lds_byte(int r, int c) { const int st = (r >> 4) * 2 + (c >> 5), rr = r & 15, cc = c & 31, ob = rr * 64 + cc * 2; return st * 1024 + (ob ^ (((ob >> 9) & 1) << 5)); }
__host__ __device__ __forceinline__ void stage_rc(int b, int& R, int& C) { const int st = b / 1024, sb = b % 1024, swz = sb ^ (((sb >> 9) & 1) << 5); R = (st >> 1) * 16 + swz / 64; C = (st & 1) * 32 + (swz % 64) / 2; }
__host__ __device__ __forceinline__ int perm32(int rho) { const int n = rho >> 4, i = rho & 15; return 8 * (i >> 2) + 4 * n + (i & 3); }

struct Unit { int pm, pn; };
struct Gemm { const bf16_t* A; const bf16_t* Bt; int M, N, K; };

struct StaticOrder {
    int nM, nN, nwg, G, c;
    __host__ __device__ void init(int M, int N, int G_, int c_) { nM = M / BM; nN = N / BM; nwg = nM * nN; G = G_; c = c_; }
    __host__ __device__ bool next(int i, Unit& u) const {
        const long L = (long)i * G + c; if (L >= nwg) return false;
        int wgid = (int)L; { const int q = nwg / NXCD, r = nwg % NXCD, xcd = wgid % NXCD, off = wgid / NXCD; wgid = (xcd < r ? xcd * (q + 1) : r * (q + 1) + (xcd - r) * q) + off; }
        const int nig = WGM * nN, gid = wgid / nig, fm = gid * WGM, gsz = (nM - fm) < WGM ? (nM - fm) : WGM;
        u.pm = fm + ((wgid % nig) % gsz); u.pn = (wgid % nig) / gsz; return true;
    }
    __device__ __forceinline__ void a_ready(const Unit&) const {}
    __device__ __forceinline__ void done(const Unit&) const {}
};
__device__ __forceinline__ unsigned cvt_pk_bf16(float lo, float hi) { unsigned r; asm volatile("v_cvt_pk_bf16_f32 %0, %1, %2" : "=v"(r) : "v"(lo), "v"(hi)); return r; }
struct EpiBf16Plain {
    static constexpr bool PERM = true, AFTER_DRAIN = false;
    bf16_t* O; int ldc;
    __device__ __forceinline__ void operator()(const f32x4 (&acc)[2][2][4][2], const Unit& u, int wr, int wc, int fr, int fq) const {
        const int row0 = u.pm * BM + wr * 64 + fr, col0 = u.pn * BM + wc * 32 + 8 * fq;
#pragma unroll
        for (int ai = 0; ai < 2; ++ai)
#pragma unroll
            for (int m = 0; m < 4; ++m) { bf16_t* rowp = O + (size_t)(row0 + ai * HALF + m * 16) * ldc + col0;
#pragma unroll
                for (int bj = 0; bj < 2; ++bj) { const f32x4 v0 = acc[ai][bj][m][0], v1 = acc[ai][bj][m][1];
                    u32x4 w; w.x = cvt_pk_bf16(v0[0], v0[1]); w.y = cvt_pk_bf16(v0[2], v0[3]); w.z = cvt_pk_bf16(v1[0], v1[1]); w.w = cvt_pk_bf16(v1[2], v1[3]);
                    *(u32x4*)(rowp + bj * HALF) = w; } }
    }
};
struct EpiResid {
    static constexpr bool PERM = false, AFTER_DRAIN = false;
    const float* R; float* C; int ldc;
    __device__ __forceinline__ void operator()(const f32x4 (&acc)[2][2][4][2], const Unit& u, int wr, int wc, int fr, int fq) const {
        const int row0 = u.pm * BM + wr * 64 + fr, col0 = u.pn * BM + wc * 32 + 4 * fq;
#pragma unroll
        for (int ai = 0; ai < 2; ++ai)
#pragma unroll
            for (int m = 0; m < 4; ++m) { const size_t off = (size_t)(row0 + ai * HALF + m * 16) * ldc + col0;
#pragma unroll
                for (int bj = 0; bj < 2; ++bj)
#pragma unroll
                    for (int n = 0; n < 2; ++n) { const f32x4 r = *(const f32x4*)(R + off + bj * HALF + n * 16); *(f32x4*)(C + off + bj * HALF + n * 16) = acc[ai][bj][m][n] + r; } }
    }
};
struct EpiGlu {
    static constexpr bool PERM = true, AFTER_DRAIN = false;
    const bf16_t* Y; int ldy; bf16_t* O; int ldo; int ooff;
    __device__ __forceinline__ void operator()(const f32x4 (&acc)[2][2][4][2], const Unit& u, int wr, int wc, int fr, int fq) const {
        const int row0 = u.pm * BM + wr * 64 + fr, col0 = u.pn * BM + wc * 32 + 8 * fq;
#pragma unroll
        for (int ai = 0; ai < 2; ++ai)
#pragma unroll
            for (int m = 0; m < 4; ++m) { const int row = row0 + ai * HALF + m * 16;
#pragma unroll
                for (int bj = 0; bj < 2; ++bj) { const f32x4 v0 = acc[ai][bj][m][0], v1 = acc[ai][bj][m][1];
                    const u32x4 yw = *(const u32x4*)(Y + (size_t)row * ldy + col0 + bj * HALF);
                    float y[8], g[8];
#pragma unroll
                    for (int j = 0; j < 4; ++j) { y[2 * j] = __uint_as_float(yw[j] << 16); y[2 * j + 1] = __uint_as_float(yw[j] & 0xffff0000u); }
#pragma unroll
                    for (int j = 0; j < 4; ++j) { g[j] = 1.f / (1.f + __expf(-v0[j])); g[4 + j] = 1.f / (1.f + __expf(-v1[j])); }
                    u32x4 w; w.x = cvt_pk_bf16(y[0] * g[0], y[1] * g[1]); w.y = cvt_pk_bf16(y[2] * g[2], y[3] * g[3]); w.z = cvt_pk_bf16(y[4] * g[4], y[5] * g[5]); w.w = cvt_pk_bf16(y[6] * g[6], y[7] * g[7]);
                    *(u32x4*)(O + (size_t)row * ldo + ooff + col0 + bj * HALF) = w; } }
    }
};
struct EpiGluGate {
    static constexpr bool PERM = true, AFTER_DRAIN = true;
    const bf16_t* Y; const bf16_t* Pz; bf16_t* G;
    __device__ __forceinline__ void fused(const f32x4 (&acc)[2][2][4][2], const Unit& u, int wr, int wc, int fr, int fq, PG8_LAS unsigned char* lds, int wid, int lane) const {
        constexpr int TS = 528;
        const int row0 = wr * 64 + fr, col0 = wc * 32 + 8 * fq;
#pragma unroll
        for (int ai = 0; ai < 2; ++ai)
#pragma unroll
            for (int m = 0; m < 4; ++m) { const int rl = row0 + ai * HALF + m * 16; const size_t grow = (size_t)u.pm * BM + rl;
#pragma unroll
                for (int bj = 0; bj < 2; ++bj) { const f32x4 v0 = acc[ai][bj][m][0], v1 = acc[ai][bj][m][1];
                    const u32x4 yw = *(const u32x4*)(Y + grow * 512 + u.pn * BM + col0 + bj * HALF);
                    float y[8], g[8];
#pragma unroll
                    for (int j = 0; j < 4; ++j) { y[2 * j] = __uint_as_float(yw[j] << 16); y[2 * j + 1] = __uint_as_float(yw[j] & 0xffff0000u); }
#pragma unroll
                    for (int j = 0; j < 4; ++j) { g[j] = 1.f / (1.f + __expf(-v0[j])); g[4 + j] = 1.f / (1.f + __expf(-v1[j])); }
                    u32x4 w; w.x = cvt_pk_bf16(y[0] * g[0], y[1] * g[1]); w.y = cvt_pk_bf16(y[2] * g[2], y[3] * g[3]); w.z = cvt_pk_bf16(y[4] * g[4], y[5] * g[5]); w.w = cvt_pk_bf16(y[6] * g[6], y[7] * g[7]);
                    *(PG8_LAS u32x4*)(lds + rl * TS + (col0 + bj * HALF) * 2) = w; } }
        __syncthreads();
        { const int t = wid * 64 + lane, row = t >> 1, hd = t & 1; const PG8_LAS unsigned char* src = lds + row * TS + hd * 256;
          float ss = 0.f;
#pragma unroll
          for (int i = 0; i < 16; ++i) { const u32x4 w = *(const PG8_LAS u32x4*)(src + 16 * i);
#pragma unroll
              for (int j = 0; j < 4; ++j) { const float a = __uint_as_float(w[j] << 16), b = __uint_as_float(w[j] & 0xffff0000u); ss += a * a + b * b; } }
          const float rn = rsqrtf(ss * (1.f / 128.f) + 1e-6f);
          const size_t grow = (size_t)u.pm * BM + row; const int cb = u.pn * BM + hd * 128;
          const bf16_t* zp = Pz + grow * 6144 + 2064 + cb; bf16_t* gp = G + grow * 2048 + 512 + cb;
#pragma unroll
          for (int i = 0; i < 16; ++i) { const u32x4 w = *(const PG8_LAS u32x4*)(src + 16 * i); const u32x4 zw = *(const u32x4*)(zp + 8 * i); u32x4 o;
#pragma unroll
              for (int j = 0; j < 4; ++j) { const float a = __uint_as_float(w[j] << 16), b = __uint_as_float(w[j] & 0xffff0000u), za = __uint_as_float(zw[j] << 16), zb = __uint_as_float(zw[j] & 0xffff0000u);
                  o[j] = cvt_pk_bf16(a * rn * (za / (1.f + __expf(-za))), b * rn * (zb / (1.f + __expf(-zb)))); }
              *(u32x4*)(gp + 8 * i) = o; } }
        __syncthreads();
    }
};
struct EpiBf16Scale {
    static constexpr bool PERM = true, AFTER_DRAIN = false;
    bf16_t* O; int ldc; const float* ssq;
    __device__ __forceinline__ void operator()(const f32x4 (&acc)[2][2][4][2], const Unit& u, int wr, int wc, int fr, int fq) const {
        const int row0 = u.pm * BM + wr * 64 + fr, col0 = u.pn * BM + wc * 32 + 8 * fq;
#pragma unroll
        for (int ai = 0; ai < 2; ++ai)
#pragma unroll
            for (int m = 0; m < 4; ++m) { const int row = row0 + ai * HALF + m * 16; bf16_t* rowp = O + (size_t)row * ldc + col0;
                float ssum = 0.f; { const f32x4* sp_ = (const f32x4*)(ssq + (size_t)row * 32);
#pragma unroll
                    for (int q = 0; q < 8; ++q) { const f32x4 t4 = sp_[q]; ssum += (t4[0] + t4[1]) + (t4[2] + t4[3]); } }
                const float s = rsqrtf(ssum * (1.f / 2048.f) + 1e-6f);
#pragma unroll
                for (int bj = 0; bj < 2; ++bj) { const f32x4 v0 = acc[ai][bj][m][0] * s, v1 = acc[ai][bj][m][1] * s;
                    u32x4 w; w.x = cvt_pk_bf16(v0[0], v0[1]); w.y = cvt_pk_bf16(v0[2], v0[3]); w.z = cvt_pk_bf16(v1[0], v1[1]); w.w = cvt_pk_bf16(v1[2], v1[3]);
                    *(u32x4*)(rowp + bj * HALF) = w; } }
    }
};
struct EpiResidNext {
    static constexpr bool PERM = false, AFTER_DRAIN = false;
    const float* R; float* C; int ldc; bf16_t* XB; float* ssq;
    __device__ __forceinline__ void operator()(const f32x4 (&acc)[2][2][4][2], const Unit& u, int wr, int wc, int fr, int fq) const {
        const int row0 = u.pm * BM + wr * 64 + fr, col0 = u.pn * BM + wc * 32 + 4 * fq;
#pragma unroll
        for (int ai = 0; ai < 2; ++ai)
#pragma unroll
            for (int m = 0; m < 4; ++m) { const int row = row0 + ai * HALF + m * 16; const size_t off = (size_t)row * ldc + col0; float ss = 0.f;
#pragma unroll
                for (int bj = 0; bj < 2; ++bj)
#pragma unroll
                    for (int n = 0; n < 2; ++n) { const f32x4 r = *(const f32x4*)(R + off + bj * HALF + n * 16); const f32x4 v = acc[ai][bj][m][n] + r;
                        *(f32x4*)(C + off + bj * HALF + n * 16) = v;
                        if (XB) { u32x2 w; w.x = cvt_pk_bf16(v[0], v[1]); w.y = cvt_pk_bf16(v[2], v[3]); *(u32x2*)(XB + off + bj * HALF + n * 16) = w; }
                        ss += v[0] * v[0] + v[1] * v[1] + v[2] * v[2] + v[3] * v[3]; }
                if (ssq) { ss += shx(ss, 16); ss += shx(ss, 32); if (fq == 0) ssq[(size_t)row * 32 + u.pn * 4 + wc] = ss; } }
    }
};
template <class Epi, class Sched, bool STAMP = false>
__device__ __forceinline__ void gemm_phase(PG8_LAS unsigned char* lds, const Gemm g, const Sched& S, const Epi& E, unsigned long long* stamps) {
    const int tid = TIDX(), wid = __builtin_amdgcn_readfirstlane(tid >> 6), lane = tid & 63, wr = wid >> 2, wc = wid & 3, fr = lane & 15, fq = lane >> 4;
    const int K = g.K, nt = K / BK;
    int ts_lo = 0, ts_hi = 0, nts = 0; const unsigned long long rt_entry = STAMP ? (unsigned long long)wall_clock64() : 0ull;
#define PG8_STAMP() do { if (STAMP && wid == 0 && nts < 64) { const unsigned long long _c = (unsigned long long)clock64(); \
        ts_lo = (lane == nts) ? (int)(unsigned)_c : ts_lo; ts_hi = (lane == nts) ? (int)(unsigned)(_c >> 32) : ts_hi; ++nts; } } while (0)
    PG8_STAMP();
    unsigned voffA[2], voffB[2];
#pragma unroll
    for (int i = 0; i < 2; ++i) { int R, C; stage_rc(tid * 16 + i * 8192, R, C); const int Rb = Epi::PERM ? ((R & ~31) + perm32(R & 31)) : R;
        voffA[i] = (unsigned)(R * K + C) * 2u; voffB[i] = (unsigned)(Rb * K + C) * 2u; }
    const size_t kstep = (size_t)(BK * 2);
    const size_t hstep = (size_t)HALF * K * 2;
    const size_t tstep = 2 * hstep;
    const unsigned ldsw = (unsigned)wid * 1024u;
    const int aoff = lds_byte(wr * 64 + fr, fq * 8), boff = lds_byte(wc * 32 + fr, fq * 8);
#define PG8_SA(b, h) (((b) * 2 + (h)) * HTB)
#define PG8_SB(b, h) ((4 + (b) * 2 + (h)) * HTB)
#define PG8_STAGE(bufoff, gbase, voff) do { _Pragma("unroll") for (int _i = 0; _i < 2; ++_i) \
        __builtin_amdgcn_global_load_lds((const unsigned*)((const char*)(gbase) + (voff)[_i]), (PG8_LAS unsigned*)(lds + (bufoff) + ldsw + _i * 8192), 16, 0, 0); } while (0)
#define PG8_LDA(dst, b, h) do { _Pragma("unroll") for (int m = 0; m < 4; ++m) _Pragma("unroll") for (int k = 0; k < 2; ++k) dst[m][k] = *(const PG8_LAS bf16x8*)(lds + PG8_SA(b, h) + aoff + m * 2048 + k * 1024); } while (0)
#define PG8_LDB(dst, b, h) do { _Pragma("unroll") for (int n = 0; n < 2; ++n) _Pragma("unroll") for (int k = 0; k < 2; ++k) dst[n][k] = *(const PG8_LAS bf16x8*)(lds + PG8_SB(b, h) + boff + n * 2048 + k * 1024); } while (0)
#define PG8_MMA(ai, bj, At, Bt) do { __builtin_amdgcn_s_setprio(1); _Pragma("unroll") for (int m = 0; m < 4; ++m) _Pragma("unroll") for (int n = 0; n < 2; ++n) _Pragma("unroll") for (int k = 0; k < 2; ++k) \
        acc[ai][bj][m][n] = __builtin_amdgcn_mfma_f32_16x16x32_bf16(Bt[n][k], At[m][k], acc[ai][bj][m][n], 0, 0, 0); __builtin_amdgcn_s_setprio(0); } while (0)
#define PG8_WAIT_V(n) asm volatile("s_waitcnt vmcnt(" #n ")" ::: "memory")
#define PG8_WAIT_L(n) asm volatile("s_waitcnt lgkmcnt(" #n ")" ::: "memory")
#define PG8_BAR __builtin_amdgcn_s_barrier()
#define PG8_SCHED __builtin_amdgcn_sched_barrier(0)
    Unit cur, nxt; int ui = 0;
    if (!S.next(0, cur)) return;
    f32x4 acc[2][2][4][2];
#pragma unroll
    for (int a = 0; a < 2; ++a)
#pragma unroll
        for (int b = 0; b < 2; ++b)
#pragma unroll
            for (int m = 0; m < 4; ++m)
#pragma unroll
                for (int n = 0; n < 2; ++n) acc[a][b][m][n] = (f32x4){0.f, 0.f, 0.f, 0.f};
    bf16x8 At[4][2], B0[2][2], B1[2][2];
    const char* cA = (const char*)g.A + (size_t)cur.pm * tstep; const char* cB = (const char*)g.Bt + (size_t)cur.pn * tstep;
    S.a_ready(cur);
    PG8_STAGE(PG8_SB(0, 0), cB, voffB); PG8_STAGE(PG8_SA(0, 0), cA, voffA); PG8_STAGE(PG8_SB(0, 1), cB + hstep, voffB); PG8_STAGE(PG8_SA(0, 1), cA + hstep, voffA);
    if (wr == 1) PG8_BAR;
    PG8_WAIT_V(4); PG8_BAR;
    PG8_STAGE(PG8_SB(1, 0), cB + kstep, voffB); PG8_STAGE(PG8_SA(1, 0), cA + kstep, voffA); PG8_STAGE(PG8_SB(1, 1), cB + hstep + kstep, voffB);
    PG8_WAIT_V(6); PG8_BAR;
    PG8_STAMP();
    for (;;) {
        const bool has_next = S.next(ui + 1, nxt);
        const char* nA = has_next ? (const char*)g.A + (size_t)nxt.pm * tstep : cA; const char* nB = has_next ? (const char*)g.Bt + (size_t)nxt.pn * tstep : cB;
        for (int t = 0; t < nt; t += 2) {
            const bool last = (t == nt - 2);
            const char* a1 = cA + (size_t)(t + 1) * kstep;
            const char* a2 = last ? nA : cA + (size_t)(t + 2) * kstep; const char* b2 = last ? nB : cB + (size_t)(t + 2) * kstep;
            const char* a3 = a2 + kstep; const char* b3 = b2 + kstep;
            if (last && has_next) S.a_ready(nxt);
            PG8_LDB(B0, 0, 0); PG8_SCHED; PG8_LDA(At, 0, 0); PG8_STAGE(PG8_SA(1, 1), a1 + hstep, voffA);
            PG8_WAIT_L(8); PG8_BAR; PG8_WAIT_L(0); PG8_MMA(0, 0, At, B0); PG8_BAR; PG8_SCHED;
            PG8_LDB(B1, 0, 1); PG8_STAGE(PG8_SB(0, 0), b2, voffB);
            PG8_BAR; PG8_WAIT_L(0); PG8_MMA(0, 1, At, B1); PG8_BAR;
            PG8_LDA(At, 0, 1); PG8_STAGE(PG8_SA(0, 0), a2, voffA);
            PG8_BAR; PG8_WAIT_L(0); PG8_MMA(1, 0, At, B0); PG8_BAR; PG8_SCHED;
            PG8_STAGE(PG8_SB(0, 1), b2 + hstep, voffB);
            PG8_WAIT_V(6); PG8_BAR; PG8_MMA(1, 1, At, B1); PG8_BAR;
            PG8_LDB(B0, 1, 0); PG8_SCHED; PG8_LDA(At, 1, 0); PG8_STAGE(PG8_SA(0, 1), a2 + hstep, voffA);
            PG8_WAIT_L(8); PG8_BAR; PG8_WAIT_L(0); PG8_MMA(0, 0, At, B0); PG8_BAR; PG8_SCHED;
            PG8_LDB(B1, 1, 1); PG8_STAGE(PG8_SB(1, 0), b3, voffB);
            PG8_BAR; PG8_WAIT_L(0); PG8_MMA(0, 1, At, B1); PG8_BAR;
            PG8_LDA(At, 1, 1); PG8_STAGE(PG8_SA(1, 0), a3, voffA);
            PG8_BAR; PG8_WAIT_L(0); PG8_MMA(1, 0, At, B0); PG8_BAR; PG8_SCHED;
            PG8_STAGE(PG8_SB(1, 1), b3 + hstep, voffB);
            PG8_WAIT_V(6); PG8_BAR; PG8_MMA(1, 1, At, B1); PG8_BAR;
        }
        PG8_STAMP();
        if constexpr (!Epi::AFTER_DRAIN) { E(acc, cur, wr, wc, fr, fq); S.done(cur); }
        PG8_STAMP();
        if (!has_next) break;
#pragma unroll
        for (int a = 0; a < 2; ++a)
#pragma unroll
            for (int b = 0; b < 2; ++b)
#pragma unroll
                for (int m = 0; m < 4; ++m)
#pragma unroll
                    for (int n = 0; n < 2; ++n) acc[a][b][m][n] = (f32x4){0.f, 0.f, 0.f, 0.f};
        cur = nxt; cA = nA; cB = nB; ++ui;
    }
    PG8_WAIT_V(0);
    if (wr == 0) PG8_BAR;
    PG8_BAR;
    if constexpr (Epi::AFTER_DRAIN) { E.fused(acc, cur, wr, wc, fr, fq, lds, wid, lane); S.done(cur); }
    PG8_STAMP();
    if (STAMP && wid == 0) { stamps[lane] = lane < nts ? (((unsigned long long)(unsigned)ts_hi << 32) | (unsigned)ts_lo) : 0ull;
        if (lane == 62) stamps[62] = rt_entry; if (lane == 63) stamps[63] = (unsigned long long)wall_clock64(); }
#undef PG8_STAMP
#undef PG8_SA
#undef PG8_SB
#undef PG8_STAGE
#undef PG8_LDA
#undef PG8_LDB
#undef PG8_MMA
#undef PG8_WAIT_V
#undef PG8_WAIT_L
#undef PG8_BAR
#undef PG8_SCHED
}
}
namespace att {
constexpr int D = 128, NW = 8, QBLK = 32, KVBLK = 64;
constexpr float SCALE = 0.088388347648318440f, THR = 8.f;
constexpr int SHM_V = KVBLK * D * 2, SHM_K = KVBLK * D * 2, SHM_ATTN = 2 * SHM_V + 2 * SHM_K + NW * 64 * 4;
#define KSWZ(row, colB) ((row) * 256 + ((colB) ^ (((row) & 7) << 4)))
#define SBAR() __builtin_amdgcn_sched_barrier(0)
__device__ __forceinline__ int crow(int r, int hi) { return (r & 3) + 8 * (r >> 2) + 4 * hi; }
__device__ __forceinline__ unsigned cvtpk(float lo, float hi) { unsigned r; asm volatile("v_cvt_pk_bf16_f32 %0, %1, %2" : "=v"(r) : "v"(lo), "v"(hi)); return r; }

template <bool MASKED>
__device__ __forceinline__ void partialSM(f32x16& p0, f32x16& p1, float& m_reg, float& mn, float& alpha, unsigned long long mw, int hi) {
  constexpr float C = SCALE * 1.4426950408889634f;
  float pmax = p0[0];
#pragma unroll
  for (int r = 1; r < 16; ++r) pmax = fmaxf(pmax, p0[r]);
#pragma unroll
  for (int r = 0; r < 16; ++r) pmax = fmaxf(pmax, p1[r]);
  { auto rr = __builtin_amdgcn_permlane32_swap(__float_as_uint(pmax), __float_as_uint(pmax), false, false);
    pmax = fmaxf(__uint_as_float(rr[0]), __uint_as_float(rr[1])); }
  if (__builtin_expect(__all(pmax - m_reg <= THR / SCALE), 1)) { mn = m_reg; alpha = 1.f; }
  else { mn = fmaxf(m_reg, pmax); alpha = __builtin_amdgcn_exp2f((m_reg - mn) * C); m_reg = mn; }
  const float mnC = -mn * C;
#pragma unroll
  for (int r = 0; r < 16; ++r) p0[r] = fmaf(p0[r], C, mnC);
#pragma unroll
  for (int r = 0; r < 16; ++r) p1[r] = fmaf(p1[r], C, mnC);
#pragma unroll
  for (int r = 0; r < 16; ++r) p0[r] = __builtin_amdgcn_exp2f(p0[r]);
}
__device__ __forceinline__ void finishSM(f32x16& p0, f32x16& p1, float alpha, float& l_reg, bf16x8& pa0, bf16x8& pa1, bf16x8& pa2, bf16x8& pa3) {
#pragma unroll
  for (int r = 0; r < 16; ++r) p1[r] = __builtin_amdgcn_exp2f(p1[r]);
  float ps = 0;
#pragma unroll
  for (int r = 0; r < 16; ++r) ps += p0[r];
#pragma unroll
  for (int r = 0; r < 16; ++r) ps += p1[r];
  { auto rr = __builtin_amdgcn_permlane32_swap(__float_as_uint(ps), __float_as_uint(ps), false, false);
    ps = __uint_as_float(rr[0]) + __uint_as_float(rr[1]); }
  l_reg = l_reg * alpha + ps;
#define PK4(P, BASE, OUT) do { unsigned a0 = cvtpk(P[BASE + 0], P[BASE + 1]), a1 = cvtpk(P[BASE + 2], P[BASE + 3]);   \
    unsigned b0 = cvtpk(P[BASE + 4], P[BASE + 5]), b1 = cvtpk(P[BASE + 6], P[BASE + 7]);                              \
    auto r0 = __builtin_amdgcn_permlane32_swap(a0, b0, false, false); auto r1 = __builtin_amdgcn_permlane32_swap(a1, b1, false, false); \
    u32x4 w = {r0[0], r1[0], r0[1], r1[1]}; OUT = *reinterpret_cast<bf16x8*>(&w); } while (0)
  PK4(p0, 0, pa0); PK4(p0, 8, pa1); PK4(p1, 0, pa2); PK4(p1, 8, pa3);
#undef PK4
}
template <int R> __device__ __forceinline__ float mask_bias(unsigned nw) {
  unsigned t; constexpr int bit = (R & 3) + 8 * (R >> 2);
  asm("v_bfe_i32 %0, %1, %2, 1\n\tv_and_b32 %0, 0xff800000, %0" : "=v"(t) : "v"(nw), "n"(bit));
  return __uint_as_float(t);
}
template <bool MASKED>
__device__ __forceinline__ void qkt(f32x16& p0, f32x16& p1, const char* Ks, const bf16x8* qr, int r32, int hi, unsigned long long mw) {
  if (MASKED) {
    const unsigned n0 = ~((unsigned)mw >> (4 * hi)), n1 = ~((unsigned)(mw >> 32) >> (4 * hi));
#define MB_(R) p0[R] = mask_bias<R>(n0); p1[R] = mask_bias<R>(n1);
    MB_(0) MB_(1) MB_(2) MB_(3) MB_(4) MB_(5) MB_(6) MB_(7) MB_(8) MB_(9) MB_(10) MB_(11) MB_(12) MB_(13) MB_(14) MB_(15)
#undef MB_
  } else { p0 = f32x16{}; p1 = f32x16{}; }
  asm volatile("" : "+v"(p0), "+v"(p1));
#pragma unroll
  for (int d0 = 0; d0 < 8; ++d0) { const int cb = (d0 * 16 + hi * 8) * 2;
    bf16x8 b0 = *reinterpret_cast<const bf16x8*>(Ks + KSWZ(r32, cb));
    bf16x8 b1 = *reinterpret_cast<const bf16x8*>(Ks + KSWZ(32 + r32, cb));
    p0 = __builtin_amdgcn_mfma_f32_32x32x16_bf16(b0, qr[d0], p0, 0, 0, 0);
    p1 = __builtin_amdgcn_mfma_f32_32x32x16_bf16(b1, qr[d0], p1, 0, 0, 0); }
}
__device__ __forceinline__ int v_st(int k, int c) { const int kk = (k & ~0xC) | ((k & 4) << 1) | ((k & 8) >> 1); return ((kk >> 3) * 4 + (c >> 5)) * 512 + ((kk & 7) * 32 + (c & 31)) * 2; }
__device__ __forceinline__ int v_rd_base(int lane) { return ((lane & 3) << 3) | (((lane >> 2) & 3) << 6) | (((lane >> 4) & 1) << 5) | (((lane >> 5) & 1) << 8); }
constexpr int v_rd_off(int d0, int ks, int half) { return d0 * 512 + ks * 4096 + half * 2048; }
template <int OFF> __device__ __forceinline__ s16x4 tr_read(int vb) {
  s16x4 r; asm volatile("ds_read_b64_tr_b16 %0, %1 offset:%2" : "=&v"(r) : "v"(vb), "i"(OFF) : "memory"); return r;
}
template <int D0> __device__ __forceinline__ void pv_one(f32x16& od, int vb, bf16x8 pa0, bf16x8 pa1, bf16x8 pa2, bf16x8 pa3) {
  const s16x4 l0 = tr_read<v_rd_off(D0, 0, 0)>(vb), h0 = tr_read<v_rd_off(D0, 0, 1)>(vb), l1 = tr_read<v_rd_off(D0, 1, 0)>(vb), h1 = tr_read<v_rd_off(D0, 1, 1)>(vb);
  const s16x4 l2 = tr_read<v_rd_off(D0, 2, 0)>(vb), h2 = tr_read<v_rd_off(D0, 2, 1)>(vb), l3 = tr_read<v_rd_off(D0, 3, 0)>(vb), h3 = tr_read<v_rd_off(D0, 3, 1)>(vb);
  asm volatile("s_waitcnt lgkmcnt(0)" ::: "memory"); SBAR();
#define PK(L, H) (bf16x8){L[0], L[1], L[2], L[3], H[0], H[1], H[2], H[3]}
  od = __builtin_amdgcn_mfma_f32_32x32x16_bf16(pa0, PK(l0, h0), od, 0, 0, 0);
  od = __builtin_amdgcn_mfma_f32_32x32x16_bf16(pa1, PK(l1, h1), od, 0, 0, 0);
  od = __builtin_amdgcn_mfma_f32_32x32x16_bf16(pa2, PK(l2, h2), od, 0, 0, 0);
  od = __builtin_amdgcn_mfma_f32_32x32x16_bf16(pa3, PK(l3, h3), od, 0, 0, 0);
#undef PK
}
__device__ __forceinline__ void pv_d0(f32x16* o, int vb, bf16x8 pa0, bf16x8 pa1, bf16x8 pa2, bf16x8 pa3) {
  pv_one<0>(o[0], vb, pa0, pa1, pa2, pa3); pv_one<1>(o[1], vb, pa0, pa1, pa2, pa3); pv_one<2>(o[2], vb, pa0, pa1, pa2, pa3); pv_one<3>(o[3], vb, pa0, pa1, pa2, pa3);
}

template <bool MASKED, int LDK, int VOFF, class OutRow>
__device__ __forceinline__ void attn_body(const bf16_t* __restrict__ Qw, const bf16_t* __restrict__ Kh, int NT,
                                          const unsigned long long* __restrict__ mbase, unsigned moff, const OutRow& Ow, char* lds) {
  const int tid = TIDX(), wid = tid >> 6, lane = tid & 63, r32 = lane & 31, hi = lane >> 5;
  char* V_lds = lds; char* K_lds = lds + 2 * SHM_V;
  float* ws = (float*)(lds + 2 * SHM_V + 2 * SHM_K) + wid * 64; float* li_l = ws; float* al_l = ws + 32;
  float m_reg = -1e30f, l_reg = 0; f32x16 o[4] = {}; bf16x8 qr[8];
  asm volatile("" : "+v"(o[0]), "+v"(o[1]), "+v"(o[2]), "+v"(o[3]));
#pragma unroll
  for (int d0 = 0; d0 < 8; ++d0) qr[d0] = *reinterpret_cast<const bf16x8*>(Qw + d0 * 16);
  const int sr = tid >> 4, sc = (tid & 15) * 8, vst0 = v_st(sr, sc), vst1 = v_st(32 + sr, sc);
  const int vb0 = (int)(uintptr_t)V_lds + v_rd_base(lane);
  struct { bf16x8 vs0, vs1, ks0, ks1; } sr_[2];
  const unsigned koff = (unsigned)(sr * LDK + sc) * 2u;
#define SLOAD(i, k0) do { const char* kb_ = (const char*)Kh + (size_t)(k0) * (LDK * 2); \
    sr_[i].vs0 = *reinterpret_cast<const bf16x8*>(kb_ + koff + VOFF * 2); sr_[i].vs1 = *reinterpret_cast<const bf16x8*>(kb_ + koff + (32 * LDK + VOFF) * 2); \
    sr_[i].ks0 = *reinterpret_cast<const bf16x8*>(kb_ + koff); sr_[i].ks1 = *reinterpret_cast<const bf16x8*>(kb_ + koff + 32 * LDK * 2); } while (0)
#define SWRITE(b, i) do { *(bf16x8*)(V_lds + (b) * SHM_V + vst0) = sr_[i].vs0;          \
    *(bf16x8*)(V_lds + (b) * SHM_V + vst1) = sr_[i].vs1; int kc = sc * 2;               \
    *(bf16x8*)(K_lds + (b) * SHM_K + KSWZ(sr, kc)) = sr_[i].ks0;                       \
    *(bf16x8*)(K_lds + (b) * SHM_K + KSWZ(32 + sr, kc)) = sr_[i].ks1; } while (0)
#define SWAIT() asm volatile("s_waitcnt vmcnt(4)" ::: "memory")
#define RESC(a) do { if (__any((a) < 1.f)) { if (hi == 0) al_l[r32] = (a); asm volatile("s_waitcnt lgkmcnt(0)" ::: "memory"); \
    _Pragma("unroll") for (int d = 0; d < 4; ++d) _Pragma("unroll") for (int r = 0; r < 16; ++r) o[d][r] *= al_l[crow(r, hi)]; } } while (0)
  f32x16 pA0, pA1, pB0, pB1; float mnA, mnB, alA, alB; bf16x8 pa0, pa1, pa2, pa3;
  unsigned long long mw = 0ull;
  constexpr int SE = 0, SO = 1;
  if (MASKED) mw = *(const unsigned long long*)((const char*)mbase + moff);
  SLOAD(SE, 0); asm volatile("s_waitcnt vmcnt(0)" ::: "memory"); SWRITE(0, SE); __syncthreads();
  qkt<MASKED>(pA0, pA1, K_lds, qr, r32, hi, mw);
  if (MASKED) mw = *(const unsigned long long*)((const char*)mbase + (moff + 8u));
  partialSM<MASKED>(pA0, pA1, m_reg, mnA, alA, mw, hi);
  SLOAD(SO, KVBLK); SLOAD(SE, (2 < NT ? 2 : NT - 1) * KVBLK);
  SWAIT();
  SWRITE(1, SO); __syncthreads();
  for (int j = 1; j + 1 < NT; j += 2) {
    SBAR(); qkt<MASKED>(pB0, pB1, K_lds + SHM_K, qr, r32, hi, mw);
    if (MASKED) mw = *(const unsigned long long*)((const char*)mbase + (moff + 8u * (unsigned)(j + 1)));
    finishSM(pA0, pA1, alA, l_reg, pa0, pa1, pa2, pa3); SBAR();
    SLOAD(SO, (j + 2) * KVBLK); SBAR();
    pv_d0(o, vb0, pa0, pa1, pa2, pa3); partialSM<MASKED>(pB0, pB1, m_reg, mnB, alB, mw, hi);
    __syncthreads(); if (MASKED) asm volatile("s_waitcnt vmcnt(5)" ::: "memory"); else SWAIT();
    SWRITE(0, SE);
    RESC(alB); __syncthreads();
    SBAR(); qkt<MASKED>(pA0, pA1, K_lds, qr, r32, hi, mw);
    if (MASKED) mw = *(const unsigned long long*)((const char*)mbase + (moff + 8u * (unsigned)(j + 2)));
    finishSM(pB0, pB1, alB, l_reg, pa0, pa1, pa2, pa3); SBAR();
    SLOAD(SE, (j + 3 < NT ? j + 3 : NT - 1) * KVBLK); SBAR();
    pv_d0(o, vb0 + SHM_V, pa0, pa1, pa2, pa3); partialSM<MASKED>(pA0, pA1, m_reg, mnA, alA, mw, hi);
    __syncthreads(); if (MASKED) asm volatile("s_waitcnt vmcnt(5)" ::: "memory"); else SWAIT();
    SWRITE(1, SO);
    RESC(alA); __syncthreads();
  }
  SBAR(); qkt<MASKED>(pB0, pB1, K_lds + SHM_K, qr, r32, hi, mw);
  finishSM(pA0, pA1, alA, l_reg, pa0, pa1, pa2, pa3); SBAR();
  pv_d0(o, vb0, pa0, pa1, pa2, pa3); partialSM<MASKED>(pB0, pB1, m_reg, mnB, alB, mw, hi);
  __syncthreads(); RESC(alB);
  finishSM(pB0, pB1, alB, l_reg, pa0, pa1, pa2, pa3); SBAR();
  pv_d0(o, vb0 + SHM_V, pa0, pa1, pa2, pa3);
  if (hi == 0) li_l[r32] = l_reg; asm volatile("s_waitcnt lgkmcnt(0)" ::: "memory");
  float rli[16];
#pragma unroll
  for (int r = 0; r < 16; ++r) rli[r] = __builtin_amdgcn_rcpf(li_l[crow(r, hi)]);
  __syncthreads();
  float* og_s = (float*)lds + wid * (32 * 132);
#pragma unroll
  for (int r = 0; r < 16; ++r) {
#pragma unroll
    for (int d0 = 0; d0 < 4; ++d0) og_s[crow(r, hi) * 132 + d0 * 32 + r32] = o[d0][r] * rli[r]; }
  asm volatile("" ::: "memory");
  { const int row = lane >> 1, half = lane & 1; const float* src = og_s + row * 132 + half * 64;
    f32x4 v[16]; float ss = 0.f;
#pragma unroll
    for (int i = 0; i < 16; ++i) { v[i] = *(const f32x4*)(src + 4 * i); ss += v[i][0] * v[i][0] + v[i][1] * v[i][1] + v[i][2] * v[i][2] + v[i][3] * v[i][3]; }
    ss += shx(ss, 1);
    const float rn = rsqrtf(ss * (1.f / 128.f) + EPS);
    const bf16_t* zp = Ow.zrow(row) + half * 64; bf16_t* gp = Ow.grow(row) + half * 64;
#pragma unroll
    for (int i = 0; i < 8; ++i) { float z[8], g[8]; ld8f(zp + 8 * i, z);
#pragma unroll
      for (int q = 0; q < 4; ++q) { g[q] = v[2 * i][q] * rn * siluf_(z[q]); g[4 + q] = v[2 * i + 1][q] * rn * siluf_(z[4 + q]); }
      st8f(gp + 8 * i, g); } }
  __syncthreads();
#undef SLOAD
#undef SWRITE
#undef SWAIT
#undef RESC
}
}
constexpr size_t al256(size_t x) { return (x + 255) / 256 * 256; }
constexpr size_t WS_CTL   = 0;
constexpr size_t CTL_BYTES = 65536;
constexpr size_t WS_WINT  = WS_CTL + CTL_BYTES;
constexpr size_t WS_WOUTT = WS_WINT + al256((size_t)DEPTH * NPAD * DM * 2);
constexpr size_t WS_WKVT  = WS_WOUTT + al256((size_t)DEPTH * DM * MIX * 2);
constexpr size_t WS_WGLUT = WS_WKVT + al256((size_t)DEPTH * 1024 * DM * 2);
constexpr size_t WS_MEMN  = WS_WGLUT + al256((size_t)DEPTH * 512 * 512 * 2);
constexpr size_t WS_KVMEM = WS_MEMN + al256((size_t)NB * MEML * DM * 2);
constexpr size_t WS_XN    = WS_KVMEM + al256((size_t)NB * MEML * DEPTH * 1024 * 2);
constexpr size_t WS_P     = WS_XN + al256((size_t)NTOK * DM * 2);
constexpr size_t WS_XBUF  = WS_P + al256((size_t)NTOK * NPAD * 2);
constexpr size_t WS_OCAT  = WS_XBUF + al256((size_t)NTOK * DM * 4);
constexpr size_t WS_MASK  = WS_OCAT + al256((size_t)NTOK * MIX * 2);
constexpr size_t WS_IW    = WS_MASK + al256((size_t)NTOK * 64 * 8);
constexpr size_t WS_YBUF  = WS_IW + al256((size_t)NTOK * 16 * 4);
constexpr size_t WS_ROPE  = WS_YBUF + al256((size_t)NTOK * 512 * 2);
constexpr size_t WS_S5P   = WS_ROPE + al256((size_t)NTOK * 48 * 4);
constexpr size_t S5P_BYTES = (size_t)DEPTH * 32 * (64 * 2 + 64 * 2 + 64 * 16 * 2) * 4;
constexpr size_t WS_GLAS  = WS_S5P + al256(S5P_BYTES);
constexpr size_t WS_GLAD  = WS_GLAS + al256((size_t)NB * 64 * 4 * 64 * 128 * 4);
constexpr size_t WS_IKC   = WS_GLAD + al256((size_t)NB * 64 * 4 * 64 * 4);
constexpr size_t WS_KVC   = WS_IKC + al256((size_t)NTOK * 64 * 2);
constexpr size_t WS_IQL   = WS_KVC + al256((size_t)NTOK * 256 * 2);
constexpr size_t WS_SSQ   = WS_IQL + al256((size_t)NTOK * 64 * 2);
constexpr size_t DSP_SLOT = (size_t)(256 * 128 + 512) * 4;
constexpr size_t WS_DSP   = WS_SSQ + 256;
constexpr size_t WS_END   = WS_DSP + al256((size_t)160 * 2 * DSP_SLOT);

struct Params {
    const float* x; const float* mem; const int* pos; const float* ln_gain; const float* w_in; const float* gla_w_up; const float* gla_b_up;
    const float* s5_a_re; const float* s5_a_im; const float* s5_log_step; const float* s5_b_re; const float* s5_b_im; const float* s5_c_re; const float* s5_c_im;
    const float* s5_d; const float* s5_w_glu; const float* dsa_q_norm; const float* dsa_k_norm; const float* mem_norm; const float* w_mem_kv;
    const float* mem_q_norm; const float* mem_k_norm; const float* out_norm; const float* w_out;
    float* out;
    char* ws;
    __device__ __forceinline__ unsigned* ctl_() const { return (unsigned*)(ws + WS_CTL); }
    __device__ __forceinline__ bf16_t* WinT_() const { return (bf16_t*)(ws + WS_WINT); }
    __device__ __forceinline__ bf16_t* WoutT_() const { return (bf16_t*)(ws + WS_WOUTT); }
    __device__ __forceinline__ bf16_t* WkvT_() const { return (bf16_t*)(ws + WS_WKVT); }
    __device__ __forceinline__ bf16_t* WgluT_() const { return (bf16_t*)(ws + WS_WGLUT); }
    __device__ __forceinline__ bf16_t* memn_() const { return (bf16_t*)(ws + WS_MEMN); }
    __device__ __forceinline__ bf16_t* kvmem_() const { return (bf16_t*)(ws + WS_KVMEM); }
    __device__ __forceinline__ bf16_t* xn_() const { return (bf16_t*)(ws + WS_XN); }
    __device__ __forceinline__ bf16_t* p_() const { return (bf16_t*)(ws + WS_P); }
    __device__ __forceinline__ float* xbuf_() const { return (float*)(ws + WS_XBUF); }
    __device__ __forceinline__ bf16_t* ocat_() const { return (bf16_t*)(ws + WS_OCAT); }
    __device__ __forceinline__ unsigned long long* mask_() const { return (unsigned long long*)(ws + WS_MASK); }
    __device__ __forceinline__ float* iw_() const { return (float*)(ws + WS_IW); }
    __device__ __forceinline__ bf16_t* ybuf_() const { return (bf16_t*)(ws + WS_YBUF); }
    __device__ __forceinline__ float* rope_() const { return (float*)(ws + WS_ROPE); }
    __device__ __forceinline__ float* s5p_() const { return (float*)(ws + WS_S5P); }
    __device__ __forceinline__ float* glas_() const { return (float*)(ws + WS_GLAS); }
    __device__ __forceinline__ float* glad_() const { return (float*)(ws + WS_GLAD); }
    __device__ __forceinline__ bf16_t* ikc_() const { return (bf16_t*)(ws + WS_IKC); }
    __device__ __forceinline__ bf16_t* kvc_() const { return (bf16_t*)(ws + WS_KVC); }
    __device__ __forceinline__ float* ssq_() const { return (float*)(ws + WS_SSQ); }
    __device__ __forceinline__ bf16_t* iql_() const { return (bf16_t*)(ws + WS_IQL); }
    __device__ __forceinline__ char* dsp_() const { return ws + WS_DSP; }
};

__device__ __forceinline__ void transpose_tiles(const float* __restrict__ src, int K, int Nsrc, int Ndst, const float* __restrict__ scale, bf16_t* __restrict__ dst,
                                                int tile, float* lds_tile  ) {
    const int tid = TIDX(), ntn = Ndst / 256;
    const int tk = tile / ntn, tn = tile % ntn, k0 = tk * 64, n0 = tn * 256;
    __syncthreads();
    { const int ty = tid >> 4, tx = tid & 15;
      f32x4 v[2][4];
#pragma unroll
      for (int i = 0; i < 2; ++i)
#pragma unroll
        for (int q = 0; q < 4; ++q) { const int k = k0 + ty + 32 * i, n = n0 + 4 * tx + 64 * q;
          v[i][q] = (f32x4){0.f, 0.f, 0.f, 0.f};
          if (n < Nsrc) v[i][q] = *(const f32x4*)(src + (size_t)k * Nsrc + n); }
#pragma unroll
      for (int i = 0; i < 2; ++i) { const float s = scale ? scale[k0 + ty + 32 * i] : 1.f;
#pragma unroll
        for (int q = 0; q < 4; ++q) { float* t = lds_tile + (ty + 32 * i) * 257 + 4 * tx + 64 * q; t[0] = v[i][q][0] * s; t[1] = v[i][q][1] * s; t[2] = v[i][q][2] * s; t[3] = v[i][q][3] * s; } } }
    __syncthreads();
    { const int n = tid >> 1, kh = (tid & 1) * 32;
#pragma unroll
      for (int j = 0; j < 4; ++j) { const int kb = kh + 8 * j; u32x4 w;
        w.x = pk2bf(lds_tile[(kb + 0) * 257 + n], lds_tile[(kb + 1) * 257 + n]); w.y = pk2bf(lds_tile[(kb + 2) * 257 + n], lds_tile[(kb + 3) * 257 + n]);
        w.z = pk2bf(lds_tile[(kb + 4) * 257 + n], lds_tile[(kb + 5) * 257 + n]); w.w = pk2bf(lds_tile[(kb + 6) * 257 + n], lds_tile[(kb + 7) * 257 + n]);
        *(u32x4*)(dst + (size_t)(n0 + n) * K + k0 + kb) = w; } }
}

__device__ __forceinline__ void rmsnorm_rows(const float* __restrict__ X, bf16_t* __restrict__ Y, int nrows) {
    const int wid = TIDX() >> 6, lane = TIDX() & 63;
    for (int row = blockIdx.x * 8 + wid; row < nrows; row += gridDim.x * 8) {
        const float* xr = X + (size_t)row * DM; f32x4 v[8]; float ss = 0.f;
#pragma unroll
        for (int i = 0; i < 8; ++i) { v[i] = *(const f32x4*)(xr + 4 * lane + 256 * i); ss += v[i][0] * v[i][0] + v[i][1] * v[i][1] + v[i][2] * v[i][2] + v[i][3] * v[i][3]; }
        ss = wave_sum(ss); const float r = rsqrtf(ss * (1.f / DM) + EPS);
        bf16_t* yr = Y + (size_t)row * DM;
#pragma unroll
        for (int i = 0; i < 8; ++i) { u32x2 w; w.x = pk2bf(v[i][0] * r, v[i][1] * r); w.y = pk2bf(v[i][2] * r, v[i][3] * r); *(u32x2*)(yr + 4 * lane + 256 * i) = w; }
    }
}

__device__ __forceinline__ void rows_bf16_ssq(const float* __restrict__ X, bf16_t* __restrict__ Y, float* __restrict__ ssq, int nrows) {
    const int wid = TIDX() >> 6, lane = TIDX() & 63;
    for (int row = blockIdx.x * 8 + wid; row < nrows; row += gridDim.x * 8) {
        const float* xr = X + (size_t)row * DM; bf16_t* yr = Y + (size_t)row * DM; float ss = 0.f;
#pragma unroll
        for (int i = 0; i < 8; ++i) { const f32x4 v = *(const f32x4*)(xr + 4 * lane + 256 * i); ss += v[0] * v[0] + v[1] * v[1] + v[2] * v[2] + v[3] * v[3];
            u32x2 w; w.x = pk2bf(v[0], v[1]); w.y = pk2bf(v[2], v[3]); *(u32x2*)(yr + 4 * lane + 256 * i) = w; }
        ss = wave_sum(ss); if (lane < 32) ssq[(size_t)row * 32 + lane] = (lane == 0) ? ss : 0.f;
    }
}
__device__ __forceinline__ void phase_prologue1(const Params& P, char* lds) {
    float* tile = (float*)lds;
    constexpr int T_IN = (DM / 64) * (NPAD / 256), T_OUT = (MIX / 64) * (DM / 256), T_KV = (DM / 64) * (1024 / 256), T_GLU = 8 * 2;
    constexpr int TOT = DEPTH * (T_IN + T_OUT + T_KV + T_GLU);
    for (int u = blockIdx.x; u < TOT; u += gridDim.x) {
        int l = u / (T_IN + T_OUT + T_KV + T_GLU), r = u % (T_IN + T_OUT + T_KV + T_GLU);
        if (r < T_IN) transpose_tiles(P.w_in + (size_t)l * DM * NIN, DM, NIN, NPAD, P.ln_gain + l * DM, P.WinT_() + (size_t)l * NPAD * DM, r, tile);
        else if ((r -= T_IN) < T_OUT) transpose_tiles(P.w_out + (size_t)l * MIX * DM, MIX, DM, DM, P.out_norm + l * MIX, P.WoutT_() + (size_t)l * DM * MIX, r, tile);
        else if ((r -= T_OUT) < T_KV) transpose_tiles(P.w_mem_kv + (size_t)l * DM * 1024, DM, 1024, 1024, P.mem_norm + l * DM, P.WkvT_() + (size_t)l * 1024 * DM, r, tile);
        else { r -= T_KV; transpose_tiles(P.s5_w_glu + (size_t)l * 512 * 512, 512, 512, 512, nullptr, P.WgluT_() + (size_t)l * 512 * 512, r, tile); }
    }
    rmsnorm_rows(P.mem, P.memn_(), NB * MEML);
}
__device__ __forceinline__ void phase_rope_table(const Params& P) {
    for (int idx = blockIdx.x * NTHR + TIDX(); idx < NTOK * 24; idx += gridDim.x * NTHR) {
        const int tok = idx / 24, i = idx % 24;
        const float e = (i < 16) ? -((float)i * 2.0f / 32.0f) : -((float)(i - 16) * 2.0f / 16.0f);
        const float inv_freq = exp2f(e * 18.931568569324174f);
        const float ang = (float)P.pos[tok] * inv_freq;
        const double a = (double)ang; const double k = rint(a * 0.15915494309189535); const float rf = (float)fma(-k, 6.283185307179586, a);
        P.rope_()[(size_t)idx * 2] = cosf(rf); P.rope_()[(size_t)idx * 2 + 1] = sinf(rf);
    }
}

__device__ __forceinline__ void phase_rmsnorm_x(const Params& P, int layer) { rmsnorm_rows(layer == 0 ? P.x : P.xbuf_(), P.xn_(), NTOK); }

__device__ __forceinline__ void phase_memk_norm(const Params& P) {
    const int wid = TIDX() >> 6, lane = TIDX() & 63;
    for (int it = blockIdx.x * 8 + wid; it < NB * MEML * DEPTH * 4; it += gridDim.x * 8) {
        const int row = it / (DEPTH * 4), l = (it / 4) % DEPTH, h = it % 4;
        bf16_t* kp = P.kvmem_() + (size_t)row * (DEPTH * 1024) + l * 1024 + h * 128 + 2 * lane;
        const unsigned w = *(const unsigned*)kp; const float a = __uint_as_float(w << 16), b = __uint_as_float(w & 0xffff0000u);
        const float ss = wave_sum(a * a + b * b), r = rsqrtf(ss * (1.f / 128.f) + EPS);
        const float* g = P.mem_k_norm + l * 128 + 2 * lane;
        *(unsigned*)kp = pk2bf(a * r * g[0], b * r * g[1]);
    }
}

__device__ __forceinline__ float sum16(float v) { v += shx(v, 1); v += shx(v, 2); v += shx(v, 4); v += shx(v, 8); return v; }

__device__ __forceinline__ void head128_norm_rope_to(const bf16_t* hp, bf16_t* dp, int l16, const float* __restrict__ gain, const float* __restrict__ cs, bool rope, bool do_store) {
    float v[8]; ld8f(hp + 8 * l16, v);
    float ss = 0.f;
#pragma unroll
    for (int j = 0; j < 8; ++j) ss += v[j] * v[j];
    ss = sum16(ss); const float r = rsqrtf(ss * (1.f / 128.f) + EPS);
#pragma unroll
    for (int j = 0; j < 8; ++j) v[j] = v[j] * r * gain[8 * l16 + j];
    if (rope) {
        float o[8];
#pragma unroll
        for (int j = 0; j < 8; ++j) o[j] = shx(v[j], 2);
        if (l16 < 4) { const int fi = (l16 & 1) * 8;
#pragma unroll
            for (int j = 0; j < 8; ++j) { const float c = cs[(fi + j) * 2], s = cs[(fi + j) * 2 + 1];
                v[j] = (l16 < 2) ? (v[j] * c - o[j] * s) : (v[j] * c + o[j] * s); } }
    }
    if (do_store) st8f(dp + 8 * l16, v);
}
__device__ __forceinline__ void head128_norm_rope(bf16_t* hp, int l16, const float* __restrict__ gain, const float* __restrict__ cs, bool rope, bool do_store) { head128_norm_rope_to(hp, hp, l16, gain, cs, rope, do_store); }
__device__ __forceinline__ void rope16_inplace(bf16_t* ip, const float* __restrict__ cs) {
    float a[8], b[8]; ld8f(ip, a); ld8f(ip + 8, b);
#pragma unroll
    for (int j = 0; j < 8; ++j) { const float c = cs[2 * j], s = cs[2 * j + 1], x1 = a[j], x2 = b[j]; a[j] = x1 * c - x2 * s; b[j] = x2 * c + x1 * s; }
    st8f(ip, a); st8f(ip + 8, b);
}
__device__ __forceinline__ void phase_prep(const Params& P, int layer) {
    const int wid = TIDX() >> 6, lane = TIDX() & 63, l16 = lane & 15, grp = lane >> 4;
    for (int tok = blockIdx.x * 8 + wid; tok < NTOK; tok += gridDim.x * 8) {
        bf16_t* row = P.p_() + (size_t)tok * NPAD;
        const float* cs32 = P.rope_() + (size_t)tok * 48; const float* cs16 = cs32 + 32;
        head128_norm_rope(row + C_DQ + grp * 128, l16, P.dsa_q_norm + layer * 128, cs32, true, true);
        head128_norm_rope_to(row + C_DK, P.kvc_() + (size_t)tok * 256, l16, P.dsa_k_norm + layer * 128, cs32, true, grp == 0);
        head128_norm_rope(row + C_MQ + grp * 128, l16, P.mem_q_norm + layer * 128, cs32, false, true);
        if ((lane & 3) == 0) rope16_inplace(row + C_DIQ + lane * 16, cs16);
        if (lane < 4) {
            bf16_t* dst = P.ikc_() + (size_t)(tok >> 5) * 2048 + lane * 512 + (tok & 31) * 8;
            float a[8], b[8]; ld8f(row + C_DIK + lane * 16, a); ld8f(row + C_DIK + lane * 16 + 8, b);
            if (lane == 0) {
#pragma unroll
                for (int q = 0; q < 8; ++q) { const float c = cs16[2 * q], s = cs16[2 * q + 1], x1 = a[q], x2 = b[q]; a[q] = x1 * c - x2 * s; b[q] = x2 * c + x1 * s; } }
            st8f(dst, a); st8f(dst + 256, b); }
        if (lane >= 16 && lane < 32) { const u32x4 vv = *(const u32x4*)(row + C_DV + (lane - 16) * 8); *(u32x4*)(P.kvc_() + (size_t)tok * 256 + 128 + (lane - 16) * 8) = vv; }
        if (lane < 16) P.iw_()[(size_t)tok * 16 + lane] = bf2f(row[C_DIW + lane]) * (1.f / 32.f);
    }
}
struct MemOutRow { const bf16_t* zb; bf16_t* gb;
    __device__ __forceinline__ const bf16_t* zrow(int r) const { return zb + (size_t)r * NPAD; } __device__ __forceinline__ bf16_t* grow(int r) const { return gb + (size_t)r * MIX; } };
__device__ __forceinline__ void unit_mem_attn(const Params& P, int layer, int u, char* lds) {
    const int b = u >> 6, h = (u >> 4) & 3, qb = u & 15, tok0 = b * SEQ + qb * 256;
    const int wid = TIDX() >> 6, lane = TIDX() & 63, r32 = lane & 31, hi = lane >> 5;
    const bf16_t* Qw = P.p_() + (size_t)(tok0 + wid * 32 + r32) * NPAD + C_MQ + h * 128 + hi * 8;
    const bf16_t* Kh = P.kvmem_() + (size_t)(b * MEML) * (DEPTH * 1024) + layer * 1024 + h * 128;
    MemOutRow ow; ow.zb = P.p_() + (size_t)(tok0 + wid * 32) * NPAD + C_MZ + h * 128; ow.gb = P.xn_() + (size_t)(tok0 + wid * 32) * MIX + 1536 + h * 128;
    att::attn_body<false, DEPTH * 1024, 512, MemOutRow>(Qw, Kh, MEML / 64, nullptr, 0u, ow, lds);
}

__device__ __forceinline__ void phase_gate(const Params& P, int c_lo, int c_hi) {
    const int wid = TIDX() >> 6, lane = TIDX() & 63;
    const int c0 = lane * 32;
    const int seg = c0 >> 9, zc = (seg == 0 ? C_GZ : seg == 1 ? C_SZ : seg == 2 ? C_DZ : C_MZ) + (c0 & 511);
    const bool act = (c0 >= c_lo) && (c0 < c_hi);
    for (int tok = blockIdx.x * 8 + wid; tok < NTOK; tok += gridDim.x * 8) {
        if (!act) { bf16_t* gz_ = P.xn_() + (size_t)tok * MIX + c0; const u32x4 zz = {0u, 0u, 0u, 0u};
#pragma unroll
            for (int i = 0; i < 4; ++i) *(u32x4*)(gz_ + 8 * i) = zz;
            continue; }
        const bf16_t* op = P.ocat_() + (size_t)tok * MIX + c0; const bf16_t* zp = P.p_() + (size_t)tok * NPAD + zc; bf16_t* gp = P.xn_() + (size_t)tok * MIX + c0;
        float o[32]; float ss = 0.f;
#pragma unroll
        for (int i = 0; i < 4; ++i) { float v[8]; ld8f(op + 8 * i, v);
#pragma unroll
            for (int j = 0; j < 8; ++j) { o[8 * i + j] = v[j]; ss += v[j] * v[j]; } }
        ss += shx(ss, 1); ss += shx(ss, 2);
        const float r = rsqrtf(ss * (1.f / 128.f) + EPS);
#pragma unroll
        for (int i = 0; i < 4; ++i) { float z[8], g[8]; ld8f(zp + 8 * i, z);
#pragma unroll
            for (int j = 0; j < 8; ++j) g[j] = o[8 * i + j] * r * siluf_(z[j]);
            st8f(gp + 8 * i, g); }
    }
}

__device__ __forceinline__ void phase_gemm_in(const Params& P, int layer, char* lds) {
    pg8::Gemm g; g.A = P.xn_(); g.Bt = P.WinT_() + (size_t)layer * NPAD * DM; g.M = NTOK; g.N = NPAD; g.K = DM;
    pg8::StaticOrder S; S.init(g.M, g.N, (int)gridDim.x, (int)blockIdx.x);
    pg8::EpiBf16Plain E; E.O = P.p_(); E.ldc = NPAD;
    pg8::gemm_phase<pg8::EpiBf16Plain, pg8::StaticOrder, false>((PG8_LAS unsigned char*)lds, g, S, E, nullptr);
}
__device__ __forceinline__ void phase_gemm_out(const Params& P, int layer, char* lds) {
    pg8::Gemm g; g.A = P.xn_(); g.Bt = P.WoutT_() + (size_t)layer * DM * MIX; g.M = NTOK; g.N = DM; g.K = MIX;
    pg8::StaticOrder S; S.init(g.M, g.N, (int)gridDim.x, (int)blockIdx.x);
    pg8::EpiResid E; E.R = (layer == 0) ? P.x : P.xbuf_(); E.C = (layer == DEPTH - 1) ? P.out : P.xbuf_(); E.ldc = DM;
    pg8::gemm_phase<pg8::EpiResid, pg8::StaticOrder, false>((PG8_LAS unsigned char*)lds, g, S, E, nullptr);
}
__device__ __forceinline__ void phase_gemm_kv(const Params& P, char* lds) {
    pg8::Gemm g; g.A = P.memn_(); g.Bt = P.WkvT_(); g.M = NB * MEML; g.N = DEPTH * 1024; g.K = DM;
    pg8::StaticOrder S; S.init(g.M, g.N, (int)gridDim.x, (int)blockIdx.x);
    pg8::EpiBf16Plain E; E.O = P.kvmem_(); E.ldc = DEPTH * 1024;
    pg8::gemm_phase<pg8::EpiBf16Plain, pg8::StaticOrder, false>((PG8_LAS unsigned char*)lds, g, S, E, nullptr);
}
__device__ __forceinline__ void mma_tile(f32x16& acc, const char* A, int lda, const char* B, int ldb, int K, int lane) {
    const int r = lane & 31, kh = lane >> 5;
    const char* ap = A + r * lda + kh * 16; const char* bp = B + r * ldb + kh * 16;
    asm volatile("" : "+v"(acc));
    for (int k = 0; k < K; k += 16) {
        const bf16x8 a = *(const bf16x8*)(ap + k * 2); const bf16x8 b = *(const bf16x8*)(bp + k * 2);
        acc = __builtin_amdgcn_mfma_f32_32x32x16_bf16(a, b, acc, 0, 0, 0);
    }
}
__device__ __forceinline__ int crow32(int r, int hi) { return (r & 3) + 8 * (r >> 2) + 4 * hi; }
__device__ __forceinline__ float log_sigmoid_(float x) { return fminf(x, 0.f) - log1pf(__expf(-fabsf(x))); }

constexpr int GLA_ST = 144;
constexpr int GLA_ST2 = 272;
__device__ __forceinline__ void gla_front(const Params& P, int layer, int tok0, int h, float (&bv)[8], float* glr_s  , float* tot_s  , float* bm_s  , float* bl_s  ) {
    const int tid = TIDX(), d = tid & 63, tg = tid >> 6;
    __syncthreads();
    if (tid < 128) { const int t = tid >> 1, half = tid & 1; float v[8]; ld8f(P.p_() + (size_t)(tok0 + t) * NPAD + C_GLR + half * 8, v);
#pragma unroll
        for (int j = 0; j < 8; ++j) glr_s[t * 16 + half * 8 + j] = v[j]; }
    float wu[16];
#pragma unroll
    for (int r = 0; r < 16; ++r) wu[r] = P.gla_w_up[((size_t)layer * 16 + r) * 256 + h * 64 + d];
    const float bias = P.gla_b_up[layer * 256 + h * 64 + d];
    __syncthreads();
    float run = 0.f;
#pragma unroll
    for (int i = 0; i < 8; ++i) { const int t = tg * 8 + i; float a = bias;
#pragma unroll
        for (int r = 0; r < 16; ++r) a = fmaf(glr_s[t * 16 + r], wu[r], a);
        run += log_sigmoid_(a) * (1.f / 16.f); bv[i] = run; }
    tot_s[tg * 64 + d] = run;
    __syncthreads();
    float off = 0.f, all = 0.f;
#pragma unroll
    for (int g = 0; g < 8; ++g) { const float v = tot_s[g * 64 + d]; off += (g < tg) ? v : 0.f; all += v; }
#pragma unroll
    for (int i = 0; i < 8; ++i) bv[i] += off;
    if (tg == 4) bm_s[d] = bv[0];
    if (tg == 0) bl_s[d] = all;
    __syncthreads();
}

__device__ __forceinline__ void unit_gla_a(const Params& P, int layer, int u, char* lds) {
    const int b = u >> 8, n = (u >> 2) & 63, h = u & 3, tok0 = b * SEQ + n * 64;
    const int tid = TIDX(), wid = tid >> 6, lane = tid & 63, d = tid & 63, tg = tid >> 6;
    char* kdT = lds;
    char* vT = lds + 64 * GLA_ST;
    float* glr_s = (float*)(lds + 64 * GLA_ST + 128 * GLA_ST); float* tot_s = glr_s + 1024; float* bm_s = tot_s + 512; float* bl_s = bm_s + 64;
    float bv[8]; gla_front(P, layer, tok0, h, bv, glr_s, tot_s, bm_s, bl_s);
    const float bl = bl_s[d];
#pragma unroll
    for (int i = 0; i < 8; ++i) { const int t = tg * 8 + i; const float k = bf2f(P.p_()[(size_t)(tok0 + t) * NPAD + C_GK + h * 64 + d]);
        *(bf16_t*)(kdT + d * GLA_ST + t * 2) = f2bf(k * __expf(bl - bv[i])); }
    { const int e = tid & 127, sg = tid >> 7;
#pragma unroll
      for (int i = 0; i < 16; ++i) { const int s = sg * 16 + i; *(bf16_t*)(vT + e * GLA_ST + s * 2) = P.p_()[(size_t)(tok0 + s) * NPAD + C_GV + h * 128 + e]; } }
    __syncthreads();
    const int mt = wid >> 1, nt = wid & 1, hi = lane >> 5;
    f32x16 acc = {}; mma_tile(acc, vT + mt * 32 * GLA_ST, GLA_ST, kdT + nt * 32 * GLA_ST, GLA_ST, 64, lane);
    float* dst = P.glas_() + ((size_t)((b * 64 + n) * 4 + h)) * 64 * 128;
#pragma unroll
    for (int r = 0; r < 16; ++r) dst[(mt * 32 + crow32(r, hi)) * 64 + nt * 32 + (lane & 31)] = acc[r];
    if (tid < 64) P.glad_()[((size_t)((b * 64 + n) * 4 + h)) * 64 + tid] = __expf(bl_s[tid]);
}

__device__ __forceinline__ void gla_scan_slice(const Params& P, int idx) {
    {
        const int el = idx & 8191, d = idx & 63, h = (idx >> 13) & 3, b = idx >> 15;
        bf16_t* gst = P.ocat_();
        float S = 0.f;
        for (int n0 = 0; n0 < 64; n0 += 8) {
            float ds[8], dc[8];
#pragma unroll
            for (int i = 0; i < 8; ++i) { const size_t cu = (size_t)((b * 64 + n0 + i) * 4 + h); ds[i] = P.glas_()[cu * 8192 + el]; dc[i] = P.glad_()[cu * 64 + d]; }
#pragma unroll
            for (int i = 0; i < 8; ++i) { const size_t cu = (size_t)((b * 64 + n0 + i) * 4 + h); gst[cu * 8192 + el] = f2bf(S); S = fmaf(dc[i], S, ds[i]); }
        }
    }
}

constexpr int GC_BST = 68;
constexpr int GC_B_BYTES = 4 * 64 * GC_BST * 4, GC_V_BYTES = 4 * 16384;
__device__ __forceinline__ void unit_gla_c4(const Params& P, int layer, int ub, char* lds) {
    const int b = ub >> 6, n = ub & 63, tok0 = b * SEQ + n * 64;
    const int tid = TIDX(), wid = tid >> 6, lane = tid & 63, r32 = lane & 31, hi = lane >> 5, h = wid >> 1, rh = wid & 1;
    float* b_s = (float*)lds;
    char* V_s = lds + GC_B_BYTES;
    float* glr_s = (float*)(lds + GC_B_BYTES + GC_V_BYTES);
    float* tot_s = glr_s + 1024;
    __syncthreads();
    const bf16_t* prow = P.p_() + (size_t)tok0 * NPAD;
    const bf16x8 glr_raw = *(const bf16x8*)(prow + (size_t)((tid & 127) >> 1) * NPAD + C_GLR + (tid & 1) * 8);
    const int gd = tid & 63, gh = (tid >> 6) & 3, gt = tid >> 8;
    float wu[16];
#pragma unroll
    for (int r = 0; r < 16; ++r) wu[r] = P.gla_w_up[((size_t)layer * 16 + r) * 256 + gh * 64 + gd];
    const float bias = P.gla_b_up[layer * 256 + gh * 64 + gd];
    bf16x8 qraw[4], kraw[2][4], vs[4][2];
    { const bf16_t* qp = prow + (size_t)(rh * 32 + r32) * NPAD + C_GQ + h * 64 + hi * 8;
#pragma unroll
      for (int d0 = 0; d0 < 4; ++d0) qraw[d0] = *(const bf16x8*)(qp + d0 * 16);
#pragma unroll
      for (int sh = 0; sh < 2; ++sh) { const bf16_t* kp = prow + (size_t)(sh * 32 + r32) * NPAD + C_GK + h * 64 + hi * 8;
#pragma unroll
          for (int d0 = 0; d0 < 4; ++d0) kraw[sh][d0] = *(const bf16x8*)(kp + d0 * 16); } }
    const int sr = tid >> 4, sc = (tid & 15) * 8;
#pragma unroll
    for (int hv = 0; hv < 4; ++hv) { vs[hv][0] = *(const bf16x8*)(prow + (size_t)sr * NPAD + C_GV + hv * 128 + sc); vs[hv][1] = *(const bf16x8*)(prow + (size_t)(32 + sr) * NPAD + C_GV + hv * 128 + sc); }
    if (tid < 128) {
#pragma unroll
        for (int j = 0; j < 8; ++j) glr_s[(tid >> 1) * 16 + (tid & 1) * 8 + j] = bf2f((bf16_t)glr_raw[j]); }
    __syncthreads();
    float gv[32]; float run = 0.f;
#pragma unroll
    for (int i = 0; i < 32; ++i) { const float* gr = glr_s + (gt * 32 + i) * 16; float a = bias;
#pragma unroll
        for (int r4 = 0; r4 < 4; ++r4) { const f32x4 g4 = *(const f32x4*)(gr + 4 * r4); a = fmaf(g4[0], wu[4 * r4], a); a = fmaf(g4[1], wu[4 * r4 + 1], a); a = fmaf(g4[2], wu[4 * r4 + 2], a); a = fmaf(g4[3], wu[4 * r4 + 3], a); }
        run += log_sigmoid_(a) * (1.f / 16.f); gv[i] = run; }
    if (gt == 0) tot_s[gh * 64 + gd] = run;
    { const int vst0 = att::v_st(sr, sc), vst1 = att::v_st(32 + sr, sc);
#pragma unroll
      for (int hv = 0; hv < 4; ++hv) { *(bf16x8*)(V_s + hv * 16384 + vst0) = vs[hv][0]; *(bf16x8*)(V_s + hv * 16384 + vst1) = vs[hv][1]; } }
    __syncthreads();
    { const float off = gt ? tot_s[gh * 64 + gd] : 0.f; float* bp = b_s + (gh * 64 + gt * 32) * GC_BST + gd;
#pragma unroll
      for (int i = 0; i < 32; ++i) bp[i * GC_BST] = gv[i] + off; }
    bf16x8 sfr[4][4];
    { const bf16_t* sp = P.ocat_() + ((size_t)((b * 64 + n) * 4 + h)) * 8192 + r32 * 64 + hi * 8;
#pragma unroll
      for (int eb = 0; eb < 4; ++eb)
#pragma unroll
          for (int ds = 0; ds < 4; ++ds) sfr[eb][ds] = *(const bf16x8*)(sp + eb * 32 * 64 + ds * 16); }
    __syncthreads();
    const float* bh = b_s + h * 64 * GC_BST + hi * 8;
    bf16x8 qe[4], qb[4], ke[2][4];
#pragma unroll
    for (int d0 = 0; d0 < 4; ++d0) {
        const f32x4 m0 = *(const f32x4*)(bh + 32 * GC_BST + d0 * 16), m1 = *(const f32x4*)(bh + 32 * GC_BST + d0 * 16 + 4);
        const f32x4 q0 = *(const f32x4*)(bh + (rh * 32 + r32) * GC_BST + d0 * 16), q1 = *(const f32x4*)(bh + (rh * 32 + r32) * GC_BST + d0 * 16 + 4);
        float e1[8], e2[8];
#pragma unroll
        for (int j = 0; j < 8; ++j) { const float mv = j < 4 ? m0[j] : m1[j - 4], bq = j < 4 ? q0[j] : q1[j - 4]; const float q = bf2f((bf16_t)qraw[d0][j]) * 0.125f;
            e1[j] = q * __expf(bq - mv); e2[j] = q * __expf(bq); }
        { u32x4 w = {att::cvtpk(e1[0], e1[1]), att::cvtpk(e1[2], e1[3]), att::cvtpk(e1[4], e1[5]), att::cvtpk(e1[6], e1[7])}; qe[d0] = *reinterpret_cast<bf16x8*>(&w); }
        { u32x4 w = {att::cvtpk(e2[0], e2[1]), att::cvtpk(e2[2], e2[3]), att::cvtpk(e2[4], e2[5]), att::cvtpk(e2[6], e2[7])}; qb[d0] = *reinterpret_cast<bf16x8*>(&w); }
#pragma unroll
        for (int sh = 0; sh < 2; ++sh) {
            const f32x4 k0 = *(const f32x4*)(bh + (sh * 32 + r32) * GC_BST + d0 * 16), k1 = *(const f32x4*)(bh + (sh * 32 + r32) * GC_BST + d0 * 16 + 4);
            float e3[8];
#pragma unroll
            for (int j = 0; j < 8; ++j) { const float mv = j < 4 ? m0[j] : m1[j - 4], bk = j < 4 ? k0[j] : k1[j - 4]; e3[j] = bf2f((bf16_t)kraw[sh][d0][j]) * __expf(mv - bk); }
            u32x4 w = {att::cvtpk(e3[0], e3[1]), att::cvtpk(e3[2], e3[3]), att::cvtpk(e3[4], e3[5]), att::cvtpk(e3[6], e3[7])}; ke[sh][d0] = *reinterpret_cast<bf16x8*>(&w); }
    }
    f32x16 p0 = {}, p1 = {};
    asm volatile("" : "+v"(p0), "+v"(p1));
#pragma unroll
    for (int d0 = 0; d0 < 4; ++d0) { p0 = __builtin_amdgcn_mfma_f32_32x32x16_bf16(ke[0][d0], qe[d0], p0, 0, 0, 0); p1 = __builtin_amdgcn_mfma_f32_32x32x16_bf16(ke[1][d0], qe[d0], p1, 0, 0, 0); }
    { const int t = rh * 32 + r32;
#pragma unroll
      for (int r = 0; r < 16; ++r) { const int s0 = att::crow(r, hi); p0[r] = (s0 <= t) ? p0[r] : 0.f; p1[r] = (32 + s0 <= t) ? p1[r] : 0.f; } }
    bf16x8 pa0, pa1, pa2, pa3;
#define GC_PK4(Pv, BASE, OUT) do { unsigned a0 = att::cvtpk(Pv[BASE + 0], Pv[BASE + 1]), a1 = att::cvtpk(Pv[BASE + 2], Pv[BASE + 3]);   \
    unsigned b0 = att::cvtpk(Pv[BASE + 4], Pv[BASE + 5]), b1 = att::cvtpk(Pv[BASE + 6], Pv[BASE + 7]);                              \
    auto r0 = __builtin_amdgcn_permlane32_swap(a0, b0, false, false); auto r1 = __builtin_amdgcn_permlane32_swap(a1, b1, false, false); \
    u32x4 w = {r0[0], r1[0], r0[1], r1[1]}; OUT = *reinterpret_cast<bf16x8*>(&w); } while (0)
    GC_PK4(p0, 0, pa0); GC_PK4(p0, 8, pa1); GC_PK4(p1, 0, pa2); GC_PK4(p1, 8, pa3);
#undef GC_PK4
    f32x16 o[4] = {};
    asm volatile("" : "+v"(o[0]), "+v"(o[1]), "+v"(o[2]), "+v"(o[3]));
    att::pv_d0(o, (int)(uintptr_t)(V_s + h * 16384) + att::v_rd_base(lane), pa0, pa1, pa2, pa3);
#pragma unroll
    for (int eb = 0; eb < 4; ++eb)
#pragma unroll
        for (int ds = 0; ds < 4; ++ds) o[eb] = __builtin_amdgcn_mfma_f32_32x32x16_bf16(qb[ds], sfr[eb][ds], o[eb], 0, 0, 0);
    __syncthreads();
    float* og_s = (float*)lds + wid * (32 * 132);
#pragma unroll
    for (int r = 0; r < 16; ++r) {
#pragma unroll
        for (int eb = 0; eb < 4; ++eb) og_s[att::crow(r, hi) * 132 + eb * 32 + r32] = o[eb][r]; }
    asm volatile("" ::: "memory");
    { const int row = lane >> 1, half = lane & 1; const float* src = og_s + row * 132 + half * 64;
      f32x4 v[16]; float ss = 0.f;
#pragma unroll
      for (int i = 0; i < 16; ++i) { v[i] = *(const f32x4*)(src + 4 * i); ss += v[i][0] * v[i][0] + v[i][1] * v[i][1] + v[i][2] * v[i][2] + v[i][3] * v[i][3]; }
      ss += shx(ss, 1);
      const float rn = rsqrtf(ss * (1.f / 128.f) + EPS);
      const size_t tok = (size_t)(tok0 + rh * 32 + row);
      const bf16_t* zp = P.p_() + tok * NPAD + C_GZ + h * 128 + half * 64; bf16_t* gp = P.xn_() + tok * MIX + h * 128 + half * 64;
#pragma unroll
      for (int i = 0; i < 8; ++i) { float z[8], g[8]; ld8f(zp + 8 * i, z);
#pragma unroll
          for (int q = 0; q < 4; ++q) { g[q] = v[2 * i][q] * rn * siluf_(z[q]); g[4 + q] = v[2 * i + 1][q] * rn * siluf_(z[4 + q]); }
          st8f(gp + 8 * i, g); } }
    __syncthreads();
}
constexpr int S5P_STRIDE = 2304;
__device__ __forceinline__ void phase_s5_params(const Params& P) {
    for (int idx = blockIdx.x * NTHR + TIDX(); idx < DEPTH * 32 * 64; idx += gridDim.x * NTHR) {
        const int p = idx & 63, lg = idx >> 6;
        const float ar = P.s5_a_re[idx], ai = P.s5_a_im[idx], step = expf(P.s5_log_step[lg]);
        const float mag = expf(ar * step), th = ai * step;
        const float lr = mag * cosf(th), li = mag * sinf(th);
        float* o = P.s5p_() + (size_t)lg * S5P_STRIDE;
        o[2 * p] = lr; o[2 * p + 1] = li;
        { const float mag512 = expf(512.f * ar * step); const double a = 512.0 * (double)th; const double k = rint(a * 0.15915494309189535); const float rf = (float)fma(-k, 6.283185307179586, a);
          o[128 + 2 * p] = mag512 * cosf(rf); o[128 + 2 * p + 1] = mag512 * sinf(rf); }
        const float xr = lr - 1.f, xi = li, den = 1.f / (ar * ar + ai * ai);
        const float fr = (xr * ar + xi * ai) * den, fi = (xi * ar - xr * ai) * den;
        for (int c = 0; c < 16; ++c) { const float br = P.s5_b_re[(size_t)idx * 16 + c], bi = P.s5_b_im[(size_t)idx * 16 + c];
            o[256 + (p * 16 + c) * 2] = fr * br - fi * bi; o[256 + (p * 16 + c) * 2 + 1] = fr * bi + fi * br; }
    }
}
__device__ __forceinline__ float gelu_tanh_(float x) { const float u = 0.7978845608028654f * (x + 0.044715f * x * x * x); const float e = __expf(-2.f * fabsf(u)); const float th = copysignf((1.f - e) / (1.f + e), u); return 0.5f * x * (1.f + th); }

constexpr int S5_XST = 272;
constexpr int S5_UST = 48;
__device__ __forceinline__ float partner32(float v, int hi) { auto rr = __builtin_amdgcn_permlane32_swap(__float_as_uint(v), __float_as_uint(v), false, false); return __uint_as_float(hi ? rr[0] : rr[1]); }
struct S5Ctx { float l0r, l0i, l1r, l1i, q0r, q0i, q1r, q1i, dsk; char* Cm; char* Bb; char* Xs; char* Us; int lane, hi, j, rho; const bf16_t* ubase; bf16_t* ybase; };
template <bool OUT> __device__ __forceinline__ void s5_tile(const S5Ctx& C, int tok0, float& x0r, float& x0i, float& x1r, float& x1i) {
    const int hi = C.hi, j = C.j, lane = C.lane;
    if (hi == 0) { const bf16_t* up = C.ubase + (size_t)(tok0 + j) * NPAD;
        const bf16x8 w0 = *(const bf16x8*)up, w1 = *(const bf16x8*)(up + 8);
        *(bf16x8*)(C.Us + C.rho * S5_UST) = w0; *(bf16x8*)(C.Us + C.rho * S5_UST + 16) = w1; }
    asm volatile("" ::: "memory");
    f32x16 a0 = {}, a1 = {}, a2 = {}, a3 = {};
    mma_tile(a0, C.Us, S5_UST, C.Bb, S5_UST, 16, lane); mma_tile(a1, C.Us, S5_UST, C.Bb + 32 * S5_UST, S5_UST, 16, lane);
    mma_tile(a2, C.Us, S5_UST, C.Bb + 64 * S5_UST, S5_UST, 16, lane); mma_tile(a3, C.Us, S5_UST, C.Bb + 96 * S5_UST, S5_UST, 16, lane);
    float s0r[16], s0i[16], s1r[16], s1i[16];
#pragma unroll
    for (int r = 0; r < 16; ++r) {
        const float n0r = fmaf(C.l0r, x0r, fmaf(-C.l0i, x0i, a0[r])), n0i = fmaf(C.l0r, x0i, fmaf(C.l0i, x0r, a1[r])); x0r = n0r; x0i = n0i; s0r[r] = n0r; s0i[r] = n0i;
        const float n1r = fmaf(C.l1r, x1r, fmaf(-C.l1i, x1i, a2[r])), n1i = fmaf(C.l1r, x1i, fmaf(C.l1i, x1r, a3[r])); x1r = n1r; x1i = n1i; s1r[r] = n1r; s1i[r] = n1i; }
    float z0r = partner32(x0r, hi), z0i = partner32(x0i, hi), z1r = partner32(x1r, hi), z1i = partner32(x1i, hi);
    if (hi == 0) { z0r = 0.f; z0i = 0.f; z1r = 0.f; z1i = 0.f; }
    if (!OUT) {
        x0r += C.q0r * z0r - C.q0i * z0i; x0i += C.q0r * z0i + C.q0i * z0r; x1r += C.q1r * z1r - C.q1i * z1i; x1i += C.q1r * z1i + C.q1i * z1r;
    } else {
#pragma unroll
        for (int r = 0; r < 16; ++r) {
            const float t0r = C.l0r * z0r - C.l0i * z0i, t0i = C.l0r * z0i + C.l0i * z0r; z0r = t0r; z0i = t0i; s0r[r] += t0r; s0i[r] += t0i;
            const float t1r = C.l1r * z1r - C.l1i * z1i, t1i = C.l1r * z1i + C.l1i * z1r; z1r = t1r; z1i = t1i; s1r[r] += t1r; s1i[r] += t1i; }
        x0r = s0r[15]; x0i = s0i[15]; x1r = s1r[15]; x1i = s1i[15];
#pragma unroll
        for (int r = 0; r < 16; ++r) { char* xr_ = C.Xs + (r + 16 * hi) * S5_XST;
            *(bf16_t*)(xr_ + j * 2) = f2bf(s0r[r]); *(bf16_t*)(xr_ + (64 + j) * 2) = f2bf(s0i[r]);
            *(bf16_t*)(xr_ + (32 + j) * 2) = f2bf(s1r[r]); *(bf16_t*)(xr_ + (96 + j) * 2) = f2bf(s1i[r]); }
        asm volatile("" ::: "memory");
        f32x16 acc = {}; mma_tile(acc, C.Xs, S5_XST, C.Cm, S5_XST, 128, lane);
        if (j < 16) {
#pragma unroll
            for (int r = 0; r < 16; ++r) { const int t = crow32(r, hi); const int rt = ((t & 15) & 3) + 8 * ((t & 15) >> 2) + 4 * (t >> 4);
                const float y = acc[r] + C.dsk * bf2f(*(const bf16_t*)(C.Us + rt * S5_UST + j * 2));
                C.ybase[(size_t)(tok0 + t) * 512 + j] = f2bf(gelu_tanh_(y)); } }
        asm volatile("" ::: "memory");
    }
    { const float e0r = partner32(x0r, hi), e0i = partner32(x0i, hi), e1r = partner32(x1r, hi), e1i = partner32(x1i, hi);
      if (hi == 0) { x0r = e0r; x0i = e0i; x1r = e1r; x1i = e1i; } else { x0r = 0.f; x0i = 0.f; x1r = 0.f; x1i = 0.f; } }
}
__device__ __forceinline__ void unit_s5(const Params& P, int layer, int u, char* lds) {
    const int b = u >> 5, g = u & 31, tid = TIDX(), wid = tid >> 6, lane = tid & 63, hi = lane >> 5, j = lane & 31;
    char* Cm = lds;
    char* Bb = Cm + 32 * S5_XST;
    float* ends = (float*)(Bb + 128 * S5_UST);
    char* wbase = (char*)(ends + 8 * 64 * 2) + wid * (32 * S5_XST + 32 * S5_UST);
    const float* sp = P.s5p_() + (size_t)(layer * 32 + g) * S5P_STRIDE;
    __syncthreads();
    for (int i = tid; i < 32 * 128; i += NTHR) { const int c = i >> 7, pp = i & 127; float v = 0.f;
        if (c < 16) v = (pp < 64) ? P.s5_c_re[((size_t)(layer * 32 + g) * 16 + c) * 64 + pp] : -P.s5_c_im[((size_t)(layer * 32 + g) * 16 + c) * 64 + (pp - 64)];
        *(bf16_t*)(Cm + c * S5_XST + pp * 2) = f2bf(v); }
    for (int i = tid; i < 128 * 16; i += NTHR) { const int n = i >> 4, c = i & 15, nt = n >> 5, jj = n & 31, p = (nt >> 1) * 32 + jj;
        *(bf16_t*)(Bb + n * S5_UST + c * 2) = f2bf(sp[256 + (p * 16 + c) * 2 + (nt & 1)]); }
    S5Ctx C; C.Cm = Cm; C.Bb = Bb; C.Xs = wbase; C.Us = wbase + 32 * S5_XST; C.lane = lane; C.hi = hi; C.j = j;
    C.l0r = sp[2 * j]; C.l0i = sp[2 * j + 1]; C.l1r = sp[2 * (32 + j)]; C.l1i = sp[2 * (32 + j) + 1];
    { float q0r = C.l0r, q0i = C.l0i, q1r = C.l1r, q1i = C.l1i;
#pragma unroll
      for (int k = 0; k < 4; ++k) { const float a = q0r * q0r - q0i * q0i, bb = (q0r + q0r) * q0i; q0r = a; q0i = bb; const float c = q1r * q1r - q1i * q1i, d = (q1r + q1r) * q1i; q1r = c; q1i = d; }
      C.q0r = q0r; C.q0i = q0i; C.q1r = q1r; C.q1i = q1i; }
    C.dsk = P.s5_d[layer * 512 + g * 16 + (lane & 15)];
    C.rho = ((j & 15) & 3) + 8 * ((j & 15) >> 2) + 4 * (j >> 4);
    const int tokw = b * SEQ + wid * 512;
    C.ubase = P.p_() + C_SU + g * 16; C.ybase = P.ybuf_() + g * 16;
    float x0r = 0.f, x0i = 0.f, x1r = 0.f, x1i = 0.f;
    __syncthreads();
    for (int sc = 0; sc < 16; ++sc) s5_tile<false>(C, tokw + sc * 32, x0r, x0i, x1r, x1i);
    if (hi == 0) { ends[(wid * 64 + j) * 2] = x0r; ends[(wid * 64 + j) * 2 + 1] = x0i; ends[(wid * 64 + 32 + j) * 2] = x1r; ends[(wid * 64 + 32 + j) * 2 + 1] = x1i; }
    __syncthreads();
    { const float p0r = sp[128 + 2 * j], p0i = sp[128 + 2 * j + 1], p1r = sp[128 + 2 * (32 + j)], p1i = sp[128 + 2 * (32 + j) + 1];
      x0r = 0.f; x0i = 0.f; x1r = 0.f; x1i = 0.f;
      for (int w = 0; w < wid; ++w) { const float e0r = ends[(w * 64 + j) * 2], e0i = ends[(w * 64 + j) * 2 + 1], e1r = ends[(w * 64 + 32 + j) * 2], e1i = ends[(w * 64 + 32 + j) * 2 + 1];
          const float n0r = p0r * x0r - p0i * x0i + e0r, n0i = p0r * x0i + p0i * x0r + e0i, n1r = p1r * x1r - p1i * x1i + e1r, n1i = p1r * x1i + p1i * x1r + e1i;
          x0r = n0r; x0i = n0i; x1r = n1r; x1i = n1i; }
      if (hi) { x0r = 0.f; x0i = 0.f; x1r = 0.f; x1i = 0.f; } }
    for (int sc = 0; sc < 16; ++sc) s5_tile<true>(C, tokw + sc * 32, x0r, x0i, x1r, x1i);
}
constexpr int TOPK = 256;
__device__ __forceinline__ unsigned f2key(float f) { const unsigned u = __float_as_uint(f); return u ^ ((u & 0x80000000u) ? 0xffffffffu : 0x80000000u); }

__device__ __forceinline__ float relu1(float x) { const int b = __float_as_int(x); return __int_as_float(b > 0 ? b : 0); }
#define DSA_MM(acc, rt, kk) acc = __builtin_amdgcn_mfma_f32_32x32x16_bf16(afr[rt][kk], bfr[kk], acc, 0, 0, 0)
#define DSA_HS(acc, rt, q) do { s0 = fmaf(relu1(acc[4 * (q)]), wv[rt][4 * (q)], s0); s1 = fmaf(relu1(acc[4 * (q) + 1]), wv[rt][4 * (q) + 1], s1); \
                                s0 = fmaf(relu1(acc[4 * (q) + 2]), wv[rt][4 * (q) + 2], s0); s1 = fmaf(relu1(acc[4 * (q) + 3]), wv[rt][4 * (q) + 3], s1); } while (0)
#define DSA_SG() do { __builtin_amdgcn_sched_group_barrier(0x8, 1, 0); __builtin_amdgcn_sched_group_barrier(0x2, 8, 0); } while (0)
__device__ __forceinline__ void dsa_score_tile(const bf16x8 (&afr)[4][4], const f32x16 (&wv)[4], const bf16x8 (&bfr)[4], float* sc, int col, int hi) {
    f32x16 accA = {}, accB = {}; asm volatile("" : "+v"(accA), "+v"(accB));
    float s0, s1;
    DSA_MM(accA, 0, 0); DSA_MM(accA, 0, 1); DSA_MM(accA, 0, 2); DSA_MM(accA, 0, 3);
    s0 = 0.f; s1 = 0.f;
    DSA_MM(accB, 1, 0); DSA_HS(accA, 0, 0); DSA_SG(); DSA_MM(accB, 1, 1); DSA_HS(accA, 0, 1); DSA_SG();
    DSA_MM(accB, 1, 2); DSA_HS(accA, 0, 2); DSA_SG(); DSA_MM(accB, 1, 3); DSA_HS(accA, 0, 3); DSA_SG();
    sc[(0 + hi) * 4096 + col] = (s0 + s1) + 0.f;
    accA = (f32x16){}; asm volatile("" : "+v"(accA)); s0 = 0.f; s1 = 0.f;
    DSA_MM(accA, 2, 0); DSA_HS(accB, 1, 0); DSA_SG(); DSA_MM(accA, 2, 1); DSA_HS(accB, 1, 1); DSA_SG();
    DSA_MM(accA, 2, 2); DSA_HS(accB, 1, 2); DSA_SG(); DSA_MM(accA, 2, 3); DSA_HS(accB, 1, 3); DSA_SG();
    sc[(2 + hi) * 4096 + col] = (s0 + s1) + 0.f;
    accB = (f32x16){}; asm volatile("" : "+v"(accB)); s0 = 0.f; s1 = 0.f;
    DSA_MM(accB, 3, 0); DSA_HS(accA, 2, 0); DSA_SG(); DSA_MM(accB, 3, 1); DSA_HS(accA, 2, 1); DSA_SG();
    DSA_MM(accB, 3, 2); DSA_HS(accA, 2, 2); DSA_SG(); DSA_MM(accB, 3, 3); DSA_HS(accA, 2, 3); DSA_SG();
    sc[(4 + hi) * 4096 + col] = (s0 + s1) + 0.f;
    s0 = 0.f; s1 = 0.f;
    DSA_HS(accB, 3, 0); DSA_HS(accB, 3, 1); DSA_HS(accB, 3, 2); DSA_HS(accB, 3, 3);
    sc[(6 + hi) * 4096 + col] = (s0 + s1) + 0.f;
}
#define DSA_CNT4(K0, K1, K2, K3) asm volatile( \
    "v_cmp_ge_u32_e64 %[m0], %[k0], %[cd]\n\tv_cmp_ge_u32_e64 %[m1], %[k1], %[cd]\n\tv_cmp_ge_u32_e64 %[m2], %[k2], %[cd]\n\tv_cmp_ge_u32_e64 %[m3], %[k3], %[cd]\n\t" \
    "v_addc_co_u32_e64 %[a0], %[m0], %[a0], 0, %[m0]\n\tv_addc_co_u32_e64 %[a1], %[m1], %[a1], 0, %[m1]\n\t" \
    "v_addc_co_u32_e64 %[a0], %[m2], %[a0], 0, %[m2]\n\tv_addc_co_u32_e64 %[a1], %[m3], %[a1], 0, %[m3]" \
    : [a0] "+v"(c0), [a1] "+v"(c1), [m0] "=&s"(sm0), [m1] "=&s"(sm1), [m2] "=&s"(sm2), [m3] "=&s"(sm3) \
    : [k0] "v"(K0), [k1] "v"(K1), [k2] "v"(K2), [k3] "v"(K3), [cd] "v"(cand))
#define DSA_CNT8(J0) do { DSA_CNT4(key[(J0)], key[(J0) + 1], key[(J0) + 2], key[(J0) + 3]); DSA_CNT4(key[(J0) + 4], key[(J0) + 5], key[(J0) + 6], key[(J0) + 7]); } while (0)

__device__ __forceinline__ void unit_dsa_index(const Params& P, int u, char* lds) {
    const int b = u & 3, t0 = (511 - (u >> 2)) * 8;
    const int tid = TIDX(), wid = tid >> 6, lane = tid & 63, r32 = lane & 31, hi = lane >> 5;
    float* sc = (float*)lds;
    const bf16_t* pb = P.p_() + (size_t)b * SEQ * NPAD;
    __syncthreads();
    {
        bf16x8 afr[4][4]; f32x16 wv[4];
        const int qsel = (r32 >> 2) & 1, head = (r32 & 3) + 4 * (r32 >> 3);
#pragma unroll
        for (int rt = 0; rt < 4; ++rt) { const bf16_t* qp = pb + (size_t)(t0 + 2 * rt + qsel) * NPAD + C_DIQ + head * 64 + hi * 8;
#pragma unroll
            for (int kk = 0; kk < 4; ++kk) afr[rt][kk] = *(const bf16x8*)(qp + kk * 16);
            const float* wp = P.iw_() + (size_t)(b * SEQ + t0 + 2 * rt + hi) * 16;
#pragma unroll
            for (int i = 0; i < 4; ++i) { const f32x4 w4 = *(const f32x4*)(wp + 4 * i); wv[rt][4 * i] = w4[0]; wv[rt][4 * i + 1] = w4[1]; wv[rt][4 * i + 2] = w4[2]; wv[rt][4 * i + 3] = w4[3]; } }
        const int ntile = (t0 + 7) / 32 + 1;
        const bf16_t* kp = P.ikc_() + (size_t)(b * (SEQ / 32)) * 2048 + lane * 8;
        bf16x8 b0[4], b1[4], b2[4];
#define DSA_LDB(dst, K) do { const bf16_t* kq_ = kp + (size_t)(wid + 8 * (K)) * 2048; _Pragma("unroll") for (int kk = 0; kk < 4; ++kk) dst[kk] = *(const bf16x8*)(kq_ + kk * 512); } while (0)
#define DSA_TILE(buf, K) dsa_score_tile(afr, wv, buf, sc, (wid + 8 * (K)) * 32 + r32, hi)
        const int nk = (ntile - wid + 7) >> 3;
        const int kl = nk > 0 ? nk - 1 : 0;
#define DSA_MIN(a) ((a) < kl ? (a) : kl)
        DSA_LDB(b0, DSA_MIN(0)); DSA_LDB(b1, DSA_MIN(1));
        int k = 0;
        for (; k + 3 <= nk; k += 3) {
            DSA_LDB(b2, k + 2); DSA_TILE(b0, k);
            DSA_LDB(b0, DSA_MIN(k + 3)); DSA_TILE(b1, k + 1);
            DSA_LDB(b1, DSA_MIN(k + 4)); DSA_TILE(b2, k + 2);
        }
        if (k < nk) DSA_TILE(b0, k);
        if (k + 1 < nk) DSA_TILE(b1, k + 1);
#undef DSA_TILE
#undef DSA_MIN
#undef DSA_TILE
#undef DSA_LDB
    }
    __syncthreads();
    {
        const int t = t0 + wid; const float* srow = sc + wid * 4096;
        unsigned key[64];
#pragma unroll
        for (int j = 0; j < 64; ++j) { const int s = j * 64 + lane; key[j] = (s <= t) ? f2key(srow[s]) : 0u; }
        unsigned long long* mout = P.mask_() + (size_t)(b * SEQ + t) * 64;
        unsigned long long myword = 0ull;
        if (t + 1 <= TOPK) {
#pragma unroll
            for (int j = 0; j < 64; ++j) { const unsigned long long m = __ballot(j * 64 + lane <= t); if (lane == j) myword = m; }
        } else {
            const int ngrp = t / 512 + 1;
            unsigned* hist = (unsigned*)(sc + wid * 4096);
            asm volatile("" ::: "memory");
            { const u32x4 zz4 = {0u, 0u, 0u, 0u};
#pragma unroll
              for (int i = 0; i < 16; ++i) *(u32x4*)(hist + (i * 64 + lane) * 4) = zz4; }
            asm volatile("" ::: "memory");
#define DSA_H8(J0) do { _Pragma("unroll") for (int jj = 0; jj < 8; ++jj) atomicAdd(hist + (key[(J0) + jj] >> 20), 1u); } while (0)
            DSA_H8(0);
            if (ngrp > 1) DSA_H8(8);
            if (ngrp > 2) DSA_H8(16);
            if (ngrp > 3) DSA_H8(24);
            if (ngrp > 4) DSA_H8(32);
            if (ngrp > 5) DSA_H8(40);
            if (ngrp > 6) DSA_H8(48);
            if (ngrp > 7) DSA_H8(56);
#undef DSA_H8
            asm volatile("" ::: "memory");
#define DSA_SUFFIX(s) do { _Pragma("unroll") for (int o = 1; o < 64; o <<= 1) { unsigned t_ = (unsigned)__builtin_amdgcn_ds_bpermute(((lane + o) & 63) << 2, (int)(s)); (s) += (lane + o < 64) ? t_ : 0u; } } while (0)
            unsigned mine = 0u;
#pragma unroll
            for (int i = 0; i < 16; ++i) { const u32x4 v4 = *(const u32x4*)(hist + lane * 64 + ((i + lane) & 15) * 4); mine += (v4[0] + v4[1]) + (v4[2] + v4[3]); }
            unsigned suf = mine; DSA_SUFFIX(suf);
            const unsigned long long mL = __ballot(suf - mine < (unsigned)TOPK && suf >= (unsigned)TOPK);
            const int Ls = (int)__builtin_ctzll(mL);
            const unsigned cntA = (unsigned)__builtin_amdgcn_readlane((int)(suf - mine), Ls);
            unsigned h2 = hist[Ls * 64 + lane]; unsigned suf2 = h2; DSA_SUFFIX(suf2);
            const unsigned long long mB = __ballot(cntA + suf2 - h2 < (unsigned)TOPK && cntA + suf2 >= (unsigned)TOPK);
            const int Bs = (int)__builtin_ctzll(mB);
            const unsigned bstar = (unsigned)(Ls * 64 + Bs);
            const unsigned cntAbove = cntA + (unsigned)__builtin_amdgcn_readlane((int)(suf2 - h2), Bs);
            const unsigned inbin = (unsigned)__builtin_amdgcn_readlane((int)h2, Bs);
#undef DSA_SUFFIX
            unsigned T = bstar << 20; int cntT = (int)(cntAbove + inbin);
            if (cntT != TOPK) {
                asm volatile("" ::: "memory");
                int nslot = 0;
#pragma unroll
                for (int j = 0; j < 64; ++j) { if ((key[j] >> 20) == bstar) { hist[nslot * 64 + lane] = key[j]; ++nslot; } }
                asm volatile("" ::: "memory");
                int R = nslot;
#pragma unroll
                for (int o = 32; o >= 1; o >>= 1) { const int other = __builtin_amdgcn_ds_bpermute(((lane ^ o) << 2), R); R = other > R ? other : R; }
                R = __builtin_amdgcn_readfirstlane(R);
                if (R <= 8) {
                    unsigned c[8];
#pragma unroll
                    for (int r = 0; r < 8; ++r) c[r] = (r < nslot) ? hist[r * 64 + lane] : 0u;
                    for (int bit = 19; bit >= 0; --bit) {
                        const unsigned cand = T | (1u << bit); int cnt = (int)cntAbove;
#pragma unroll
                        for (int r = 0; r < 8; ++r) cnt += __popcll(__ballot(c[r] >= cand));
                        if (cnt >= TOPK) { T = cand; cntT = cnt; if (cnt == TOPK) break; }
                    }
                } else {
                    for (int bit = 19; bit >= 0; --bit) {
                        const unsigned cand = T | (1u << bit); unsigned c0 = 0, c1 = 0; unsigned long long sm0, sm1, sm2, sm3;
                        DSA_CNT8(0);
                        if (ngrp > 1) DSA_CNT8(8);
                        if (ngrp > 2) DSA_CNT8(16);
                        if (ngrp > 3) DSA_CNT8(24);
                        if (ngrp > 4) DSA_CNT8(32);
                        if (ngrp > 5) DSA_CNT8(40);
                        if (ngrp > 6) DSA_CNT8(48);
                        if (ngrp > 7) DSA_CNT8(56);
                        const int cl = (int)(c0 + c1);
                        int cnt = 0;
#pragma unroll
                        for (int bb = 0; bb < 7; ++bb) cnt += __popcll(__ballot((cl >> bb) & 1)) << bb;
                        if (cnt >= TOPK) { T = cand; cntT = cnt; if (cnt == TOPK) break; }
                    }
                }
            }
            if (cntT == TOPK) {
#pragma unroll
                for (int j = 0; j < 64; ++j) { const unsigned long long m = __ballot(key[j] >= T); if (lane == j) myword = m; }
            } else {
                int ngt = 0;
#pragma unroll
                for (int j = 0; j < 64; ++j) ngt += __popcll(__ballot(key[j] > T));
                int need = TOPK - ngt;
#pragma unroll
                for (int j = 0; j < 64; ++j) { const unsigned long long eq = __ballot(key[j] == T), gt = __ballot(key[j] > T);
                    const int ne = __popcll(eq); unsigned long long take = eq;
                    if (ne > need) { take = 0ull; int left = need; unsigned long long e2 = eq;
                        while (left > 0) { const unsigned long long lowbit = e2 & (0ull - e2); take |= lowbit; e2 ^= lowbit; --left; } }
                    need -= (ne > need) ? need : ne;
                    const unsigned long long m = gt | take; if (lane == j) myword = m; }
            }
        }
        mout[lane] = myword;
    }
}

struct DsaOutRow { const bf16_t* zb; bf16_t* gb; int wid;
    __device__ __forceinline__ const bf16_t* zrow(int r) const { const int rho = wid * 32 + r; return zb + (size_t)(rho >> 2) * NPAD + (rho & 3) * 128; }
    __device__ __forceinline__ bf16_t* grow(int r) const { const int rho = wid * 32 + r; return gb + (size_t)(rho >> 2) * MIX + (rho & 3) * 128; } };
__device__ __forceinline__ void unit_dsa_attn(const Params& P, int u, char* lds) {
    const int b = u & 3, qb = 63 - (u >> 2), t0 = qb * 64, tokb = b * SEQ;
    const int wid = TIDX() >> 6, lane = TIDX() & 63, r32 = lane & 31, hi = lane >> 5;
    const int rho = wid * 32 + r32, tq = t0 + (rho >> 2), hq = rho & 3;
    const bf16_t* Qw = P.p_() + (size_t)(tokb + tq) * NPAD + C_DQ + hq * 128 + hi * 8;
    const bf16_t* Kh = P.kvc_() + (size_t)tokb * 256;
    const unsigned moff = (unsigned)(tokb + tq) * 512u;
    DsaOutRow ow; ow.zb = P.p_() + (size_t)(tokb + t0) * NPAD + C_DZ; ow.gb = P.xn_() + (size_t)(tokb + t0) * MIX + 1024; ow.wid = wid;
    const int NT = (qb + 2) & ~1;
    att::attn_body<true, 256, 128, DsaOutRow>(Qw, Kh, NT, P.mask_(), moff, ow, lds);
}
__device__ __forceinline__ void phase_gemm_glu(const Params& P, int layer, char* lds) {
    pg8::Gemm g; g.A = P.ybuf_(); g.Bt = P.WgluT_() + (size_t)layer * 512 * 512; g.M = NTOK; g.N = 512; g.K = 512;
    pg8::StaticOrder S; S.init(g.M, g.N, (int)gridDim.x, (int)blockIdx.x);
    pg8::EpiGlu E; E.Y = P.ybuf_(); E.ldy = 512; E.O = P.ocat_(); E.ldo = MIX; E.ooff = 512;
    pg8::gemm_phase<pg8::EpiGlu, pg8::StaticOrder, false>((PG8_LAS unsigned char*)lds, g, S, E, nullptr);
}

constexpr int CTL_Q0 = 4096;
struct OneUnit { int pm, pn; __device__ __forceinline__ bool next(int i, pg8::Unit& u) const { if (i) return false; u.pm = pm; u.pn = pn; return true; }
    __device__ __forceinline__ void a_ready(const pg8::Unit&) const {} __device__ __forceinline__ void done(const pg8::Unit&) const {} };
__device__ __forceinline__ int q_issue(unsigned* ctr) { return (int)__hip_atomic_fetch_add(ctr, 1u, __ATOMIC_RELAXED, __HIP_MEMORY_SCOPE_AGENT); }
#define Q_LOOP_BEGIN(ctr, total)  { unsigned* q_ctr_ = (ctr); const int q_total_ = (total); volatile int* q_b_ = (volatile int*)(lds + LDS_TAIL + 16); \
    for (;;) { __syncthreads(); if (TIDX() == 0) *q_b_ = q_issue(q_ctr_); __syncthreads(); const int item = __builtin_amdgcn_readfirstlane(*q_b_); if (item >= q_total_) break;
#define Q_LOOP_END  } }
__device__ __forceinline__ void unit_glu(const Params& P, int layer, int u, char* lds) {
    pg8::Gemm g; g.A = P.ybuf_(); g.Bt = P.WgluT_() + (size_t)layer * 512 * 512; g.M = NTOK; g.N = 512; g.K = 512;
    OneUnit S; S.pm = u >> 1; S.pn = u & 1;
    pg8::EpiGluGate E; E.Y = P.ybuf_(); E.Pz = P.p_(); E.G = P.xn_();
    pg8::gemm_phase<pg8::EpiGluGate, OneUnit, false>((PG8_LAS unsigned char*)lds, g, S, E, nullptr);
}
constexpr int LDS_TAIL = LDS_BYTES - 64;

__global__ __launch_bounds__(NTHR, 2) void k_mega(Params P) {
    extern __shared__ __attribute__((aligned(16))) char lds[];
    if (TIDX() == 0) *(uint4*)(lds + LDS_TAIL) = make_uint4(0u, 0u, 0u, 0u);
    __syncthreads();
    XcdBarrier bar = xcd_barrier_post(P.ctl_(), (volatile LAS unsigned*)(lds + LDS_TAIL));
    const int G = gridDim.x, B = blockIdx.x;
    phase_prologue1(P, lds); phase_rope_table(P); phase_s5_params(P); phase_rmsnorm_x(P, 0);
    xcd_barrier(bar);
    for (int layer = 0; layer < DEPTH; ++layer) {
        if (layer > 0) { phase_rmsnorm_x(P, layer); xcd_barrier(bar); }
        phase_gemm_in(P, layer, lds);
        if (layer == 0) phase_gemm_kv(P, lds);
        xcd_barrier(bar);
        phase_prep(P, layer);
        if (layer == 0) phase_memk_norm(P);
        for (int u = B; u < 1024; u += G) unit_gla_a(P, layer, u, lds);
        xcd_barrier(bar);
        Q_LOOP_BEGIN(P.ctl_() + CTL_Q0 + 64 * (layer * 2), 128 + 2048 + 256 + 256)
            if (item < 128) unit_s5(P, layer, item, lds);
            else if (item < 2176) unit_dsa_index(P, item - 128, lds);
            else if (item < 2432) unit_mem_attn(P, layer, item - 2176, lds);
            else gla_scan_slice(P, (item - 2432) * NTHR + TIDX());
        Q_LOOP_END
        xcd_barrier(bar);
        Q_LOOP_BEGIN(P.ctl_() + CTL_Q0 + 64 * (layer * 2 + 1), 256 + 256 + 128)
            if (item < 256) unit_dsa_attn(P, item, lds);
            else if (item < 512) unit_gla_c4(P, layer, item - 256, lds);
            else unit_glu(P, layer, item - 512, lds);
        Q_LOOP_END
        xcd_barrier(bar);
        phase_gemm_out(P, layer, lds);
        xcd_barrier(bar);
    }
}

extern "C" void kernel_launch(void* const* d_in, const int* in_sizes, int n_in, void* d_out, int out_size, void* d_ws, size_t ws_size, hipStream_t stream) {
    if (n_in != 24 || ws_size < WS_END) { fprintf(stderr, "kernel_launch: unexpected n_in %d or ws_size %zu (< %zu)\n", n_in, ws_size, (size_t)WS_END); return; }
    Params P; memset(&P, 0, sizeof(P));
    P.x = (const float*)d_in[0]; P.mem = (const float*)d_in[1]; P.pos = (const int*)d_in[2]; P.ln_gain = (const float*)d_in[3]; P.w_in = (const float*)d_in[4];
    P.gla_w_up = (const float*)d_in[5]; P.gla_b_up = (const float*)d_in[6]; P.s5_a_re = (const float*)d_in[7]; P.s5_a_im = (const float*)d_in[8]; P.s5_log_step = (const float*)d_in[9];
    P.s5_b_re = (const float*)d_in[10]; P.s5_b_im = (const float*)d_in[11]; P.s5_c_re = (const float*)d_in[12]; P.s5_c_im = (const float*)d_in[13]; P.s5_d = (const float*)d_in[14];
    P.s5_w_glu = (const float*)d_in[15]; P.dsa_q_norm = (const float*)d_in[16]; P.dsa_k_norm = (const float*)d_in[17]; P.mem_norm = (const float*)d_in[18]; P.w_mem_kv = (const float*)d_in[19];
    P.mem_q_norm = (const float*)d_in[20]; P.mem_k_norm = (const float*)d_in[21]; P.out_norm = (const float*)d_in[22]; P.w_out = (const float*)d_in[23];
    P.out = (float*)d_out;
    char* ws = (char*)d_ws; P.ws = ws;
    static int grid = 0;
    if (!grid) {
        int dev = 0, cus = 0, per_cu = 0;
        (void)hipGetDevice(&dev); (void)hipDeviceGetAttribute(&cus, hipDeviceAttributeMultiprocessorCount, dev);
        (void)hipFuncSetAttribute((const void*)k_mega, hipFuncAttributeMaxDynamicSharedMemorySize, LDS_BYTES);
        (void)hipOccupancyMaxActiveBlocksPerMultiprocessor(&per_cu, (const void*)k_mega, NTHR, LDS_BYTES);
        if (per_cu < 1) fprintf(stderr, "kernel_launch: occupancy query reports %d blocks per CU\n", per_cu);
        grid = cus > 0 ? cus : 256;
    }
    (void)hipMemsetAsync(ws + WS_CTL, 0, CTL_BYTES, stream);
    hipLaunchKernelGGL(k_mega, dim3(grid), dim3(NTHR), LDS_BYTES, stream, P);
}
```

```cpp
#include <hip/hip_runtime.h>
#include <stdint.h>
#include <stdio.h>
#include <string.h>

constexpr int NB = 4, SEQ = 4096, NTOK = NB * SEQ, DM = 2048, DEPTH = 4, MEML = 256;
constexpr int NIN = 5984, NPAD = 6144, MIX = 2048;
constexpr int C_GQ = 0, C_GK = 256, C_GV = 512, C_GLR = 1024, C_GZ = 1040, C_SU = 1552, C_SZ = 2064, C_DQ = 2576, C_DK = 3088, C_DV = 3216,
              C_DIQ = 3344, C_DIK = 4368, C_DIW = 4432, C_DZ = 4448, C_MQ = 4960, C_MZ = 5472;
constexpr float EPS = 1e-6f;
constexpr int NTHR = 512;
constexpr int LDS_BYTES = 147456;

typedef unsigned short bf16_t;
typedef short bf16x8 __attribute__((ext_vector_type(8)));
typedef short s16x4 __attribute__((ext_vector_type(4)));
typedef float f32x4 __attribute__((ext_vector_type(4)));
typedef float f32x8 __attribute__((ext_vector_type(8)));
typedef float f32x16 __attribute__((ext_vector_type(16)));
typedef unsigned u32x4 __attribute__((ext_vector_type(4)));
typedef unsigned u32x2 __attribute__((ext_vector_type(2)));
#define LAS __attribute__((address_space(3)))

__device__ __forceinline__ float bf2f(bf16_t b) { return __uint_as_float(((unsigned)b) << 16); }
__device__ __forceinline__ bf16_t f2bf(float f) { unsigned u = __float_as_uint(f); u += 0x7FFFu + ((u >> 16) & 1u); return (bf16_t)(u >> 16); }
__device__ __forceinline__ unsigned pk2bf(float lo, float hi) { return (unsigned)f2bf(lo) | ((unsigned)f2bf(hi) << 16); }
__device__ __forceinline__ float sigmoidf_(float x) { return 1.f / (1.f + __expf(-x)); }
__device__ __forceinline__ float siluf_(float x) { return x / (1.f + __expf(-x)); }

__device__ __forceinline__ int TIDX() { int t = (int)threadIdx.x; asm volatile("" : "+v"(t)); return t; }
__device__ __forceinline__ float shx(float v, int m) { const int src = ((TIDX() & 63) ^ m) << 2; return __int_as_float(__builtin_amdgcn_ds_bpermute(src, __float_as_int(v))); }
__device__ __forceinline__ float wave_sum(float v) {
#pragma unroll
    for (int o = 32; o >= 1; o >>= 1) v += shx(v, o);
    return v;
}
__device__ __forceinline__ void ld8f(const bf16_t* p, float (&v)[8]) { const u32x4 w = *(const u32x4*)p;
#pragma unroll
    for (int j = 0; j < 4; ++j) { v[2 * j] = __uint_as_float(w[j] << 16); v[2 * j + 1] = __uint_as_float(w[j] & 0xffff0000u); } }
__device__ __forceinline__ void st8f(bf16_t* p, const float (&v)[8]) { u32x4 w; w.x = pk2bf(v[0], v[1]); w.y = pk2bf(v[2], v[3]); w.z = pk2bf(v[4], v[5]); w.w = pk2bf(v[6], v[7]); *(u32x4*)p = w; }
__device__ __forceinline__ float f2bf_f(float f) { return bf2f(f2bf(f)); }
#define XB_TMO      128
#define XB_XCNT(j)  (256  + 64 * (j))
#define XB_XSUB(j)  (1280 + 64 * (j))
#define XB_XGEN(j)  (2304 + 64 * (j))
#define XB_TOP      3328
#define XB_TOPGEN   3392
#define XCD_BAR_WORDS 3456
#define XB_SPIN_CAP (1u << 18)

__device__ __forceinline__ unsigned xb_ld(unsigned* p)              { return __hip_atomic_load(p, __ATOMIC_RELAXED, __HIP_MEMORY_SCOPE_AGENT); }
__device__ __forceinline__ unsigned xb_add(unsigned* p, unsigned v) { return __hip_atomic_fetch_add(p, v, __ATOMIC_RELAXED, __HIP_MEMORY_SCOPE_AGENT); }
__device__ __forceinline__ unsigned xb_xcc_id() { return (unsigned)__builtin_amdgcn_s_getreg((3 << 11) | 20) & 0xFu; }
#define XB_SPIN(cond, bar) do { unsigned _sp = 0; while (cond) { __builtin_amdgcn_s_sleep(1); \
    if ((++_sp & 255u) == 0u) { if (xb_ld(&(bar)[XB_TMO])) break; if (_sp > XB_SPIN_CAP) { atomicAdd(&(bar)[XB_TMO], 1u); break; } } } } while (0)

struct XcdBarrier {
    unsigned* bar; unsigned x;
    volatile LAS unsigned* st;
};

__device__ __forceinline__ XcdBarrier xcd_barrier_post(unsigned* bar, volatile LAS unsigned* st) {
    XcdBarrier b; b.bar = bar; b.x = xb_xcc_id(); b.st = st;
    if (TIDX() == 0) (void)xb_add(&bar[XB_XCNT(b.x)], 1u);
    return b;
}
__device__ __forceinline__ void xcd_barrier_complete(unsigned* bar, unsigned x, unsigned& nloc, unsigned& nx) {
    const unsigned G = gridDim.x * gridDim.y * gridDim.z;
    unsigned sum, cnt, mine, sp = 0u;
    for (;;) {
        sum = 0u; cnt = 0u; mine = 0u;
#pragma unroll
        for (unsigned j = 0; j < 16; ++j) { const unsigned c = xb_ld(&bar[XB_XCNT(j)]); sum += c; cnt += (c > 0u) ? 1u : 0u; mine = (j == x) ? c : mine; }
        if (sum == G) break;
        __builtin_amdgcn_s_sleep(1);
        if ((++sp & 255u) == 0u) { if (xb_ld(&bar[XB_TMO])) break; if (sp > XB_SPIN_CAP) { atomicAdd(&bar[XB_TMO], 1u); break; } }
    }
    nloc = mine > 0u ? mine : 1u; nx = cnt > 0u ? cnt : 1u;
}

__device__ __forceinline__ void xcd_barrier(const XcdBarrier& b) {
    asm volatile("s_waitcnt vmcnt(0)" ::: "memory");
    __syncthreads();
    if (TIDX() == 0) {
        unsigned* bar = b.bar; const unsigned bx = xb_xcc_id();
        __builtin_amdgcn_s_waitcnt(0);
        unsigned nloc = b.st[0], nx = b.st[1];
        if (nloc == 0u) { xcd_barrier_complete(bar, bx, nloc, nx); b.st[0] = nloc; b.st[1] = nx; }
        const unsigned old = xb_add(&bar[XB_XSUB(bx)], 1u);
        const unsigned gen = old / nloc;
        if (old + 1u == (gen + 1u) * nloc) {
            __builtin_amdgcn_fence(__ATOMIC_RELEASE, "agent");
            asm volatile("s_waitcnt vmcnt(0)" ::: "memory");
            const unsigned og = xb_add(&bar[XB_TOP], 1u);
            const unsigned tg = og / nx;
            if (og + 1u == (tg + 1u) * nx) xb_add(&bar[XB_TOPGEN], 1u);
            else XB_SPIN(xb_ld(&bar[XB_TOPGEN]) == tg, bar);
            __builtin_amdgcn_fence(__ATOMIC_ACQUIRE, "agent");
            xb_add(&bar[XB_XGEN(bx)], 1u);
            asm volatile("s_waitcnt vmcnt(0)" ::: "memory");
        } else {
            XB_SPIN(xb_ld(&bar[XB_XGEN(bx)]) == gen, bar);
            __builtin_amdgcn_fence(__ATOMIC_ACQUIRE, "agent");
            asm volatile("s_waitcnt vmcnt(0)" ::: "memory");
        }
    }
    __syncthreads();
}
namespace pg8 {
#define PG8_LAS __attribute__((address_space(3)))
typedef float f32x2 __attribute__((ext_vector_type(2)));
typedef unsigned u32x4 __attribute__((ext_vector_type(4)));
constexpr int BM = 256, BK = 64, HALF = 128, HTB = HALF * BK * 2  , STAGE_BYTES = 8 * HTB, NXCD = 8, WGM = 8;

__host__ __device__ __forceinline__ int lds_byte(int r, int c) { const int st = (r >> 4) * 2 + (c >> 5), rr = r & 15, cc = c & 31, ob = rr * 64 + cc * 2; return st * 1024 + (ob ^ (((ob >> 9) & 1) << 5)); }
__host__ __device__ __forceinline__ void stage_rc(int b, int& R, int& C) { const int st = b / 1024, sb = b % 1024, swz = sb ^ (((sb >> 9) & 1) << 5); R = (st >> 1) * 16 + swz / 64; C = (st & 1) * 32 + (swz % 64) / 2; }
__host__ __device__ __forceinline__ int perm32(int rho) { const int n = rho >> 4, i = rho & 15; return 8 * (i >> 2) + 4 * n + (i & 3); }

struct Unit { int pm, pn; };
struct Gemm { const bf16_t* A; const bf16_t* Bt; int M, N, K; };

struct StaticOrder {
    int nM, nN, nwg, G, c;
    __host__ __device__ void init(int M, int N, int G_, int c_) { nM = M / BM; nN = N / BM; nwg = nM * nN; G = G_; c = c_; }
    __host__ __device__ bool next(int i, Unit& u) const {
        const long L = (long)i * G + c; if (L >= nwg) return false;
        int wgid = (int)L; { const int q = nwg / NXCD, r = nwg % NXCD, xcd = wgid % NXCD, off = wgid / NXCD; wgid = (xcd < r ? xcd * (q + 1) : r * (q + 1) + (xcd - r) * q) + off; }
        const int nig = WGM * nN, gid = wgid / nig, fm = gid * WGM, gsz = (nM - fm) < WGM ? (nM - fm) : WGM;
        u.pm = fm + ((wgid % nig) % gsz); u.pn = (wgid % nig) / gsz; return true;
    }
    __device__ __forceinline__ void a_ready(const Unit&) const {}
    __device__ __forceinline__ void done(const Unit&) const {}
};
__device__ __forceinline__ unsigned cvt_pk_bf16(float lo, float hi) { unsigned r; asm volatile("v_cvt_pk_bf16_f32 %0, %1, %2" : "=v"(r) : "v"(lo), "v"(hi)); return r; }
struct EpiBf16Plain {
    static constexpr bool PERM = true, AFTER_DRAIN = false;
    bf16_t* O; int ldc;
    __device__ __forceinline__ void operator()(const f32x4 (&acc)[2][2][4][2], const Unit& u, int wr, int wc, int fr, int fq) const {
        const int row0 = u.pm * BM + wr * 64 + fr, col0 = u.pn * BM + wc * 32 + 8 * fq;
#pragma unroll
        for (int ai = 0; ai < 2; ++ai)
#pragma unroll
            for (int m = 0; m < 4; ++m) { bf16_t* rowp = O + (size_t)(row0 + ai * HALF + m * 16) * ldc + col0;
#pragma unroll
                for (int bj = 0; bj < 2; ++bj) { const f32x4 v0 = acc[ai][bj][m][0], v1 = acc[ai][bj][m][1];
                    u32x4 w; w.x = cvt_pk_bf16(v0[0], v0[1]); w.y = cvt_pk_bf16(v0[2], v0[3]); w.z = cvt_pk_bf16(v1[0], v1[1]); w.w = cvt_pk_bf16(v1[2], v1[3]);
                    *(u32x4*)(rowp + bj * HALF) = w; } }
    }
};
struct EpiResid {
    static constexpr bool PERM = false, AFTER_DRAIN = false;
    const float* R; float* C; int ldc;
    __device__ __forceinline__ void operator()(const f32x4 (&acc)[2][2][4][2], const Unit& u, int wr, int wc, int fr, int fq) const {
        const int row0 = u.pm * BM + wr * 64 + fr, col0 = u.pn * BM + wc * 32 + 4 * fq;
#pragma unroll
        for (int ai = 0; ai < 2; ++ai)
#pragma unroll
            for (int m = 0; m < 4; ++m) { const size_t off = (size_t)(row0 + ai * HALF + m * 16) * ldc + col0;
#pragma unroll
                for (int bj = 0; bj < 2; ++bj)
#pragma unroll
                    for (int n = 0; n < 2; ++n) { const f32x4 r = *(const f32x4*)(R + off + bj * HALF + n * 16); *(f32x4*)(C + off + bj * HALF + n * 16) = acc[ai][bj][m][n] + r; } }
    }
};
struct EpiGlu {
    static constexpr bool PERM = true, AFTER_DRAIN = false;
    const bf16_t* Y; int ldy; bf16_t* O; int ldo; int ooff;
    __device__ __forceinline__ void operator()(const f32x4 (&acc)[2][2][4][2], const Unit& u, int wr, int wc, int fr, int fq) const {
        const int row0 = u.pm * BM + wr * 64 + fr, col0 = u.pn * BM + wc * 32 + 8 * fq;
#pragma unroll
        for (int ai = 0; ai < 2; ++ai)
#pragma unroll
            for (int m = 0; m < 4; ++m) { const int row = row0 + ai * HALF + m * 16;
#pragma unroll
                for (int bj = 0; bj < 2; ++bj) { const f32x4 v0 = acc[ai][bj][m][0], v1 = acc[ai][bj][m][1];
                    const u32x4 yw = *(const u32x4*)(Y + (size_t)row * ldy + col0 + bj * HALF);
                    float y[8], g[8];
#pragma unroll
                    for (int j = 0; j < 4; ++j) { y[2 * j] = __uint_as_float(yw[j] << 16); y[2 * j + 1] = __uint_as_float(yw[j] & 0xffff0000u); }
#pragma unroll
                    for (int j = 0; j < 4; ++j) { g[j] = 1.f / (1.f + __expf(-v0[j])); g[4 + j] = 1.f / (1.f + __expf(-v1[j])); }
                    u32x4 w; w.x = cvt_pk_bf16(y[0] * g[0], y[1] * g[1]); w.y = cvt_pk_bf16(y[2] * g[2], y[3] * g[3]); w.z = cvt_pk_bf16(y[4] * g[4], y[5] * g[5]); w.w = cvt_pk_bf16(y[6] * g[6], y[7] * g[7]);
                    *(u32x4*)(O + (size_t)row * ldo + ooff + col0 + bj * HALF) = w; } }
    }
};
struct EpiGluGate {
    static constexpr bool PERM = true, AFTER_DRAIN = true;
    const bf16_t* Y; const bf16_t* Pz; bf16_t* G;
    __device__ __forceinline__ void fused(const f32x4 (&acc)[2][2][4][2], const Unit& u, int wr, int wc, int fr, int fq, PG8_LAS unsigned char* lds, int wid, int lane) const {
        constexpr int TS = 528;
        const int row0 = wr * 64 + fr, col0 = wc * 32 + 8 * fq;
#pragma unroll
        for (int ai = 0; ai < 2; ++ai)
#pragma unroll
            for (int m = 0; m < 4; ++m) { const int rl = row0 + ai * HALF + m * 16; const size_t grow = (size_t)u.pm * BM + rl;
#pragma unroll
                for (int bj = 0; bj < 2; ++bj) { const f32x4 v0 = acc[ai][bj][m][0], v1 = acc[ai][bj][m][1];
                    const u32x4 yw = *(const u32x4*)(Y + grow * 512 + u.pn * BM + col0 + bj * HALF);
                    float y[8], g[8];
#pragma unroll
                    for (int j = 0; j < 4; ++j) { y[2 * j] = __uint_as_float(yw[j] << 16); y[2 * j + 1] = __uint_as_float(yw[j] & 0xffff0000u); }
#pragma unroll
                    for (int j = 0; j < 4; ++j) { g[j] = 1.f / (1.f + __expf(-v0[j])); g[4 + j] = 1.f / (1.f + __expf(-v1[j])); }
                    u32x4 w; w.x = cvt_pk_bf16(y[0] * g[0], y[1] * g[1]); w.y = cvt_pk_bf16(y[2] * g[2], y[3] * g[3]); w.z = cvt_pk_bf16(y[4] * g[4], y[5] * g[5]); w.w = cvt_pk_bf16(y[6] * g[6], y[7] * g[7]);
                    *(PG8_LAS u32x4*)(lds + rl * TS + (col0 + bj * HALF) * 2) = w; } }
        __syncthreads();
        { const int t = wid * 64 + lane, row = t >> 1, hd = t & 1; const PG8_LAS unsigned char* src = lds + row * TS + hd * 256;
          float ss = 0.f;
#pragma unroll
          for (int i = 0; i < 16; ++i) { const u32x4 w = *(const PG8_LAS u32x4*)(src + 16 * i);
#pragma unroll
              for (int j = 0; j < 4; ++j) { const float a = __uint_as_float(w[j] << 16), b = __uint_as_float(w[j] & 0xffff0000u); ss += a * a + b * b; } }
          const float rn = rsqrtf(ss * (1.f / 128.f) + 1e-6f);
          const size_t grow = (size_t)u.pm * BM + row; const int cb = u.pn * BM + hd * 128;
          const bf16_t* zp = Pz + grow * 6144 + 2064 + cb; bf16_t* gp = G + grow * 2048 + 512 + cb;
#pragma unroll
          for (int i = 0; i < 16; ++i) { const u32x4 w = *(const PG8_LAS u32x4*)(src + 16 * i); const u32x4 zw = *(const u32x4*)(zp + 8 * i); u32x4 o;
#pragma unroll
              for (int j = 0; j < 4; ++j) { const float a = __uint_as_float(w[j] << 16), b = __uint_as_float(w[j] & 0xffff0000u), za = __uint_as_float(zw[j] << 16), zb = __uint_as_float(zw[j] & 0xffff0000u);
                  o[j] = cvt_pk_bf16(a * rn * (za / (1.f + __expf(-za))), b * rn * (zb / (1.f + __expf(-zb)))); }
              *(u32x4*)(gp + 8 * i) = o; } }
        __syncthreads();
    }
};
struct EpiBf16Scale {
    static constexpr bool PERM = true, AFTER_DRAIN = false;
    bf16_t* O; int ldc; const float* ssq;
    __device__ __forceinline__ void operator()(const f32x4 (&acc)[2][2][4][2], const Unit& u, int wr, int wc, int fr, int fq) const {
        const int row0 = u.pm * BM + wr * 64 + fr, col0 = u.pn * BM + wc * 32 + 8 * fq;
#pragma unroll
        for (int ai = 0; ai < 2; ++ai)
#pragma unroll
            for (int m = 0; m < 4; ++m) { const int row = row0 + ai * HALF + m * 16; bf16_t* rowp = O + (size_t)row * ldc + col0;
                float ssum = 0.f; { const f32x4* sp_ = (const f32x4*)(ssq + (size_t)row * 32);
#pragma unroll
                    for (int q = 0; q < 8; ++q) { const f32x4 t4 = sp_[q]; ssum += (t4[0] + t4[1]) + (t4[2] + t4[3]); } }
                const float s = rsqrtf(ssum * (1.f / 2048.f) + 1e-6f);
#pragma unroll
                for (int bj = 0; bj < 2; ++bj) { const f32x4 v0 = acc[ai][bj][m][0] * s, v1 = acc[ai][bj][m][1] * s;
                    u32x4 w; w.x = cvt_pk_bf16(v0[0], v0[1]); w.y = cvt_pk_bf16(v0[2], v0[3]); w.z = cvt_pk_bf16(v1[0], v1[1]); w.w = cvt_pk_bf16(v1[2], v1[3]);
                    *(u32x4*)(rowp + bj * HALF) = w; } }
    }
};
struct EpiResidNext {
    static constexpr bool PERM = false, AFTER_DRAIN = false;
    const float* R; float* C; int ldc; bf16_t* XB; float* ssq;
    __device__ __forceinline__ void operator()(const f32x4 (&acc)[2][2][4][2], const Unit& u, int wr, int wc, int fr, int fq) const {
        const int row0 = u.pm * BM + wr * 64 + fr, col0 = u.pn * BM + wc * 32 + 4 * fq;
#pragma unroll
        for (int ai = 0; ai < 2; ++ai)
#pragma unroll
            for (int m = 0; m < 4; ++m) { const int row = row0 + ai * HALF + m * 16; const size_t off = (size_t)row * ldc + col0; float ss = 0.f;
#pragma unroll
                for (int bj = 0; bj < 2; ++bj)
#pragma unroll
                    for (int n = 0; n < 2; ++n) { const f32x4 r = *(const f32x4*)(R + off + bj * HALF + n * 16); const f32x4 v = acc[ai][bj][m][n] + r;
                        *(f32x4*)(C + off + bj * HALF + n * 16) = v;
                        if (XB) { u32x2 w; w.x = cvt_pk_bf16(v[0], v[1]); w.y = cvt_pk_bf16(v[2], v[3]); *(u32x2*)(XB + off + bj * HALF + n * 16) = w; }
                        ss += v[0] * v[0] + v[1] * v[1] + v[2] * v[2] + v[3] * v[3]; }
                if (ssq) { ss += shx(ss, 16); ss += shx(ss, 32); if (fq == 0) ssq[(size_t)row * 32 + u.pn * 4 + wc] = ss; } }
    }
};
template <class Epi, class Sched, bool STAMP = false>
__device__ __forceinline__ void gemm_phase(PG8_LAS unsigned char* lds, const Gemm g, const Sched& S, const Epi& E, unsigned long long* stamps) {
    const int tid = TIDX(), wid = __builtin_amdgcn_readfirstlane(tid >> 6), lane = tid & 63, wr = wid >> 2, wc = wid & 3, fr = lane & 15, fq = lane >> 4;
    const int K = g.K, nt = K / BK;
    int ts_lo = 0, ts_hi = 0, nts = 0; const unsigned long long rt_entry = STAMP ? (unsigned long long)wall_clock64() : 0ull;
#define PG8_STAMP() do { if (STAMP && wid == 0 && nts < 64) { const unsigned long long _c = (unsigned long long)clock64(); \
        ts_lo = (lane == nts) ? (int)(unsigned)_c : ts_lo; ts_hi = (lane == nts) ? (int)(unsigned)(_c >> 32) : ts_hi; ++nts; } } while (0)
    PG8_STAMP();
    unsigned voffA[2], voffB[2];
#pragma unroll
    for (int i = 0; i < 2; ++i) { int R, C; stage_rc(tid * 16 + i * 8192, R, C); const int Rb = Epi::PERM ? ((R & ~31) + perm32(R & 31)) : R;
        voffA[i] = (unsigned)(R * K + C) * 2u; voffB[i] = (unsigned)(Rb * K + C) * 2u; }
    const size_t kstep = (size_t)(BK * 2);
    const size_t hstep = (size_t)HALF * K * 2;
    const size_t tstep = 2 * hstep;
    const unsigned ldsw = (unsigned)wid * 1024u;
    const int aoff = lds_byte(wr * 64 + fr, fq * 8), boff = lds_byte(wc * 32 + fr, fq * 8);
#define PG8_SA(b, h) (((b) * 2 + (h)) * HTB)
#define PG8_SB(b, h) ((4 + (b) * 2 + (h)) * HTB)
#define PG8_STAGE(bufoff, gbase, voff) do { _Pragma("unroll") for (int _i = 0; _i < 2; ++_i) \
        __builtin_amdgcn_global_load_lds((const unsigned*)((const char*)(gbase) + (voff)[_i]), (PG8_LAS unsigned*)(lds + (bufoff) + ldsw + _i * 8192), 16, 0, 0); } while (0)
#define PG8_LDA(dst, b, h) do { _Pragma("unroll") for (int m = 0; m < 4; ++m) _Pragma("unroll") for (int k = 0; k < 2; ++k) dst[m][k] = *(const PG8_LAS bf16x8*)(lds + PG8_SA(b, h) + aoff + m * 2048 + k * 1024); } while (0)
#define PG8_LDB(dst, b, h) do { _Pragma("unroll") for (int n = 0; n < 2; ++n) _Pragma("unroll") for (int k = 0; k < 2; ++k) dst[n][k] = *(const PG8_LAS bf16x8*)(lds + PG8_SB(b, h) + boff + n * 2048 + k * 1024); } while (0)
#define PG8_MMA(ai, bj, At, Bt) do { __builtin_amdgcn_s_setprio(1); _Pragma("unroll") for (int m = 0; m < 4; ++m) _Pragma("unroll") for (int n = 0; n < 2; ++n) _Pragma("unroll") for (int k = 0; k < 2; ++k) \
        acc[ai][bj][m][n] = __builtin_amdgcn_mfma_f32_16x16x32_bf16(Bt[n][k], At[m][k], acc[ai][bj][m][n], 0, 0, 0); __builtin_amdgcn_s_setprio(0); } while (0)
#define PG8_WAIT_V(n) asm volatile("s_waitcnt vmcnt(" #n ")" ::: "memory")
#define PG8_WAIT_L(n) asm volatile("s_waitcnt lgkmcnt(" #n ")" ::: "memory")
#define PG8_BAR __builtin_amdgcn_s_barrier()
#define PG8_SCHED __builtin_amdgcn_sched_barrier(0)
    Unit cur, nxt; int ui = 0;
    if (!S.next(0, cur)) return;
    f32x4 acc[2][2][4][2];
#pragma unroll
    for (int a = 0; a < 2; ++a)
#pragma unroll
        for (int b = 0; b < 2; ++b)
#pragma unroll
            for (int m = 0; m < 4; ++m)
#pragma unroll
                for (int n = 0; n < 2; ++n) acc[a][b][m][n] = (f32x4){0.f, 0.f, 0.f, 0.f};
    bf16x8 At[4][2], B0[2][2], B1[2][2];
    const char* cA = (const char*)g.A + (size_t)cur.pm * tstep; const char* cB = (const char*)g.Bt + (size_t)cur.pn * tstep;
    S.a_ready(cur);
    PG8_STAGE(PG8_SB(0, 0), cB, voffB); PG8_STAGE(PG8_SA(0, 0), cA, voffA); PG8_STAGE(PG8_SB(0, 1), cB + hstep, voffB); PG8_STAGE(PG8_SA(0, 1), cA + hstep, voffA);
    if (wr == 1) PG8_BAR;
    PG8_WAIT_V(4); PG8_BAR;
    PG8_STAGE(PG8_SB(1, 0), cB + kstep, voffB); PG8_STAGE(PG8_SA(1, 0), cA + kstep, voffA); PG8_STAGE(PG8_SB(1, 1), cB + hstep + kstep, voffB);
    PG8_WAIT_V(6); PG8_BAR;
    PG8_STAMP();
    for (;;) {
        const bool has_next = S.next(ui + 1, nxt);
        const char* nA = has_next ? (const char*)g.A + (size_t)nxt.pm * tstep : cA; const char* nB = has_next ? (const char*)g.Bt + (size_t)nxt.pn * tstep : cB;
        for (int t = 0; t < nt; t += 2) {
            const bool last = (t == nt - 2);
            const char* a1 = cA + (size_t)(t + 1) * kstep;
            const char* a2 = last ? nA : cA + (size_t)(t + 2) * kstep; const char* b2 = last ? nB : cB + (size_t)(t + 2) * kstep;
            const char* a3 = a2 + kstep; const char* b3 = b2 + kstep;
            if (last && has_next) S.a_ready(nxt);
            PG8_LDB(B0, 0, 0); PG8_SCHED; PG8_LDA(At, 0, 0); PG8_STAGE(PG8_SA(1, 1), a1 + hstep, voffA);
            PG8_WAIT_L(8); PG8_BAR; PG8_WAIT_L(0); PG8_MMA(0, 0, At, B0); PG8_BAR; PG8_SCHED;
            PG8_LDB(B1, 0, 1); PG8_STAGE(PG8_SB(0, 0), b2, voffB);
            PG8_BAR; PG8_WAIT_L(0); PG8_MMA(0, 1, At, B1); PG8_BAR;
            PG8_LDA(At, 0, 1); PG8_STAGE(PG8_SA(0, 0), a2, voffA);
            PG8_BAR; PG8_WAIT_L(0); PG8_MMA(1, 0, At, B0); PG8_BAR; PG8_SCHED;
            PG8_STAGE(PG8_SB(0, 1), b2 + hstep, voffB);
            PG8_WAIT_V(6); PG8_BAR; PG8_MMA(1, 1, At, B1); PG8_BAR;
            PG8_LDB(B0, 1, 0); PG8_SCHED; PG8_LDA(At, 1, 0); PG8_STAGE(PG8_SA(0, 1), a2 + hstep, voffA);
            PG8_WAIT_L(8); PG8_BAR; PG8_WAIT_L(0); PG8_MMA(0, 0, At, B0); PG8_BAR; PG8_SCHED;
            PG8_LDB(B1, 1, 1); PG8_STAGE(PG8_SB(1, 0), b3, voffB);
            PG8_BAR; PG8_WAIT_L(0); PG8_MMA(0, 1, At, B1); PG8_BAR;
            PG8_LDA(At, 1, 1); PG8_STAGE(PG8_SA(1, 0), a3, voffA);
            PG8_BAR; PG8_WAIT_L(0); PG8_MMA(1, 0, At, B0); PG8_BAR; PG8_SCHED;
            PG8_STAGE(PG8_SB(1, 1), b3 + hstep, voffB);
            PG8_WAIT_V(6); PG8_BAR; PG8_MMA(1, 1, At, B1); PG8_BAR;
        }
        PG8_STAMP();
        if constexpr (!Epi::AFTER_DRAIN) { E(acc, cur, wr, wc, fr, fq); S.done(cur); }
        PG8_STAMP();
        if (!has_next) break;
#pragma unroll
        for (int a = 0; a < 2; ++a)
#pragma unroll
            for (int b = 0; b < 2; ++b)
#pragma unroll
                for (int m = 0; m < 4; ++m)
#pragma unroll
                    for (int n = 0; n < 2; ++n) acc[a][b][m][n] = (f32x4){0.f, 0.f, 0.f, 0.f};
        cur = nxt; cA = nA; cB = nB; ++ui;
    }
    PG8_WAIT_V(0);
    if (wr == 0) PG8_BAR;
    PG8_BAR;
    if constexpr (Epi::AFTER_DRAIN) { E.fused(acc, cur, wr, wc, fr, fq, lds, wid, lane); S.done(cur); }
    PG8_STAMP();
    if (STAMP && wid == 0) { stamps[lane] = lane < nts ? (((unsigned long long)(unsigned)ts_hi << 32) | (unsigned)ts_lo) : 0ull;
        if (lane == 62) stamps[62] = rt_entry; if (lane == 63) stamps[63] = (unsigned long long)wall_clock64(); }
#undef PG8_STAMP
#undef PG8_SA
#undef PG8_SB
#undef PG8_STAGE
#undef PG8_LDA
#undef PG8_LDB
#undef PG8_MMA
#undef PG8_WAIT_V
#undef PG8_WAIT_L
#undef PG8_BAR
#undef PG8_SCHED
}
}
namespace att {
constexpr int D = 128, NW = 8, QBLK = 32, KVBLK = 64;
constexpr float SCALE = 0.088388347648318440f, THR = 8.f;
constexpr int SHM_V = KVBLK * D * 2, SHM_K = KVBLK * D * 2, SHM_ATTN = 2 * SHM_V + 2 * SHM_K + NW * 64 * 4;
#define KSWZ(row, colB) ((row) * 256 + ((colB) ^ (((row) & 7) << 4)))
#define SBAR() __builtin_amdgcn_sched_barrier(0)
__device__ __forceinline__ int crow(int r, int hi) { return (r & 3) + 8 * (r >> 2) + 4 * hi; }
__device__ __forceinline__ unsigned cvtpk(float lo, float hi) { unsigned r; asm volatile("v_cvt_pk_bf16_f32 %0, %1, %2" : "=v"(r) : "v"(lo), "v"(hi)); return r; }

template <bool MASKED>
__device__ __forceinline__ void partialSM(f32x16& p0, f32x16& p1, float& m_reg, float& mn, float& alpha, unsigned long long mw, int hi) {
  constexpr float C = SCALE * 1.4426950408889634f;
  float pmax = p0[0];
#pragma unroll
  for (int r = 1; r < 16; ++r) pmax = fmaxf(pmax, p0[r]);
#pragma unroll
  for (int r = 0; r < 16; ++r) pmax = fmaxf(pmax, p1[r]);
  { auto rr = __builtin_amdgcn_permlane32_swap(__float_as_uint(pmax), __float_as_uint(pmax), false, false);
    pmax = fmaxf(__uint_as_float(rr[0]), __uint_as_float(rr[1])); }
  if (__builtin_expect(__all(pmax - m_reg <= THR / SCALE), 1)) { mn = m_reg; alpha = 1.f; }
  else { mn = fmaxf(m_reg, pmax); alpha = __builtin_amdgcn_exp2f((m_reg - mn) * C); m_reg = mn; }
  const float mnC = -mn * C;
#pragma unroll
  for (int r = 0; r < 16; ++r) p0[r] = fmaf(p0[r], C, mnC);
#pragma unroll
  for (int r = 0; r < 16; ++r) p1[r] = fmaf(p1[r], C, mnC);
#pragma unroll
  for (int r = 0; r < 16; ++r) p0[r] = __builtin_amdgcn_exp2f(p0[r]);
}
__device__ __forceinline__ void finishSM(f32x16& p0, f32x16& p1, float alpha, float& l_reg, bf16x8& pa0, bf16x8& pa1, bf16x8& pa2, bf16x8& pa3) {
#pragma unroll
  for (int r = 0; r < 16; ++r) p1[r] = __builtin_amdgcn_exp2f(p1[r]);
  float ps = 0;
#pragma unroll
  for (int r = 0; r < 16; ++r) ps += p0[r];
#pragma unroll
  for (int r = 0; r < 16; ++r) ps += p1[r];
  { auto rr = __builtin_amdgcn_permlane32_swap(__float_as_uint(ps), __float_as_uint(ps), false, false);
    ps = __uint_as_float(rr[0]) + __uint_as_float(rr[1]); }
  l_reg = l_reg * alpha + ps;
#define PK4(P, BASE, OUT) do { unsigned a0 = cvtpk(P[BASE + 0], P[BASE + 1]), a1 = cvtpk(P[BASE + 2], P[BASE + 3]);   \
    unsigned b0 = cvtpk(P[BASE + 4], P[BASE + 5]), b1 = cvtpk(P[BASE + 6], P[BASE + 7]);                              \
    auto r0 = __builtin_amdgcn_permlane32_swap(a0, b0, false, false); auto r1 = __builtin_amdgcn_permlane32_swap(a1, b1, false, false); \
    u32x4 w = {r0[0], r1[0], r0[1], r1[1]}; OUT = *reinterpret_cast<bf16x8*>(&w); } while (0)
  PK4(p0, 0, pa0); PK4(p0, 8, pa1); PK4(p1, 0, pa2); PK4(p1, 8, pa3);
#undef PK4
}
template <int R> __device__ __forceinline__ float mask_bias(unsigned nw) {
  unsigned t; constexpr int bit = (R & 3) + 8 * (R >> 2);
  asm("v_bfe_i32 %0, %1, %2, 1\n\tv_and_b32 %0, 0xff800000, %0" : "=v"(t) : "v"(nw), "n"(bit));
  return __uint_as_float(t);
}
template <bool MASKED>
__device__ __forceinline__ void qkt(f32x16& p0, f32x16& p1, const char* Ks, const bf16x8* qr, int r32, int hi, unsigned long long mw) {
  if (MASKED) {
    const unsigned n0 = ~((unsigned)mw >> (4 * hi)), n1 = ~((unsigned)(mw >> 32) >> (4 * hi));
#define MB_(R) p0[R] = mask_bias<R>(n0); p1[R] = mask_bias<R>(n1);
    MB_(0) MB_(1) MB_(2) MB_(3) MB_(4) MB_(5) MB_(6) MB_(7) MB_(8) MB_(9) MB_(10) MB_(11) MB_(12) MB_(13) MB_(14) MB_(15)
#undef MB_
  } else { p0 = f32x16{}; p1 = f32x16{}; }
  asm volatile("" : "+v"(p0), "+v"(p1));
#pragma unroll
  for (int d0 = 0; d0 < 8; ++d0) { const int cb = (d0 * 16 + hi * 8) * 2;
    bf16x8 b0 = *reinterpret_cast<const bf16x8*>(Ks + KSWZ(r32, cb));
    bf16x8 b1 = *reinterpret_cast<const bf16x8*>(Ks + KSWZ(32 + r32, cb));
    p0 = __builtin_amdgcn_mfma_f32_32x32x16_bf16(b0, qr[d0], p0, 0, 0, 0);
    p1 = __builtin_amdgcn_mfma_f32_32x32x16_bf16(b1, qr[d0], p1, 0, 0, 0); }
}
__device__ __forceinline__ int v_st(int k, int c) { const int kk = (k & ~0xC) | ((k & 4) << 1) | ((k & 8) >> 1); return ((kk >> 3) * 4 + (c >> 5)) * 512 + ((kk & 7) * 32 + (c & 31)) * 2; }
__device__ __forceinline__ int v_rd_base(int lane) { return ((lane & 3) << 3) | (((lane >> 2) & 3) << 6) | (((lane >> 4) & 1) << 5) | (((lane >> 5) & 1) << 8); }
constexpr int v_rd_off(int d0, int ks, int half) { return d0 * 512 + ks * 4096 + half * 2048; }
template <int OFF> __device__ __forceinline__ s16x4 tr_read(int vb) {
  s16x4 r; asm volatile("ds_read_b64_tr_b16 %0, %1 offset:%2" : "=&v"(r) : "v"(vb), "i"(OFF) : "memory"); return r;
}
template <int D0> __device__ __forceinline__ void pv_one(f32x16& od, int vb, bf16x8 pa0, bf16x8 pa1, bf16x8 pa2, bf16x8 pa3) {
  const s16x4 l0 = tr_read<v_rd_off(D0, 0, 0)>(vb), h0 = tr_read<v_rd_off(D0, 0, 1)>(vb), l1 = tr_read<v_rd_off(D0, 1, 0)>(vb), h1 = tr_read<v_rd_off(D0, 1, 1)>(vb);
  const s16x4 l2 = tr_read<v_rd_off(D0, 2, 0)>(vb), h2 = tr_read<v_rd_off(D0, 2, 1)>(vb), l3 = tr_read<v_rd_off(D0, 3, 0)>(vb), h3 = tr_read<v_rd_off(D0, 3, 1)>(vb);
  asm volatile("s_waitcnt lgkmcnt(0)" ::: "memory"); SBAR();
#define PK(L, H) (bf16x8){L[0], L[1], L[2], L[3], H[0], H[1], H[2], H[3]}
  od = __builtin_amdgcn_mfma_f32_32x32x16_bf16(pa0, PK(l0, h0), od, 0, 0, 0);
  od = __builtin_amdgcn_mfma_f32_32x32x16_bf16(pa1, PK(l1, h1), od, 0, 0, 0);
  od = __builtin_amdgcn_mfma_f32_32x32x16_bf16(pa2, PK(l2, h2), od, 0, 0, 0);
  od = __builtin_amdgcn_mfma_f32_32x32x16_bf16(pa3, PK(l3, h3), od, 0, 0, 0);
#undef PK
}
__device__ __forceinline__ void pv_d0(f32x16* o, int vb, bf16x8 pa0, bf16x8 pa1, bf16x8 pa2, bf16x8 pa3) {
  pv_one<0>(o[0], vb, pa0, pa1, pa2, pa3); pv_one<1>(o[1], vb, pa0, pa1, pa2, pa3); pv_one<2>(o[2], vb, pa0, pa1, pa2, pa3); pv_one<3>(o[3], vb, pa0, pa1, pa2, pa3);
}

template <bool MASKED, int LDK, int VOFF, class OutRow>
__device__ __forceinline__ void attn_body(const bf16_t* __restrict__ Qw, const bf16_t* __restrict__ Kh, int NT,
                                          const unsigned long long* __restrict__ mbase, unsigned moff, const OutRow& Ow, char* lds) {
  const int tid = TIDX(), wid = tid >> 6, lane = tid & 63, r32 = lane & 31, hi = lane >> 5;
  char* V_lds = lds; char* K_lds = lds + 2 * SHM_V;
  float* ws = (float*)(lds + 2 * SHM_V + 2 * SHM_K) + wid * 64; float* li_l = ws; float* al_l = ws + 32;
  float m_reg = -1e30f, l_reg = 0; f32x16 o[4] = {}; bf16x8 qr[8];
  asm volatile("" : "+v"(o[0]), "+v"(o[1]), "+v"(o[2]), "+v"(o[3]));
#pragma unroll
  for (int d0 = 0; d0 < 8; ++d0) qr[d0] = *reinterpret_cast<const bf16x8*>(Qw + d0 * 16);
  const int sr = tid >> 4, sc = (tid & 15) * 8, vst0 = v_st(sr, sc), vst1 = v_st(32 + sr, sc);
  const int vb0 = (int)(uintptr_t)V_lds + v_rd_base(lane);
  struct { bf16x8 vs0, vs1, ks0, ks1; } sr_[2];
  const unsigned koff = (unsigned)(sr * LDK + sc) * 2u;
#define SLOAD(i, k0) do { const char* kb_ = (const char*)Kh + (size_t)(k0) * (LDK * 2); \
    sr_[i].vs0 = *reinterpret_cast<const bf16x8*>(kb_ + koff + VOFF * 2); sr_[i].vs1 = *reinterpret_cast<const bf16x8*>(kb_ + koff + (32 * LDK + VOFF) * 2); \
    sr_[i].ks0 = *reinterpret_cast<const bf16x8*>(kb_ + koff); sr_[i].ks1 = *reinterpret_cast<const bf16x8*>(kb_ + koff + 32 * LDK * 2); } while (0)
#define SWRITE(b, i) do { *(bf16x8*)(V_lds + (b) * SHM_V + vst0) = sr_[i].vs0;          \
    *(bf16x8*)(V_lds + (b) * SHM_V + vst1) = sr_[i].vs1; int kc = sc * 2;               \
    *(bf16x8*)(K_lds + (b) * SHM_K + KSWZ(sr, kc)) = sr_[i].ks0;                       \
    *(bf16x8*)(K_lds + (b) * SHM_K + KSWZ(32 + sr, kc)) = sr_[i].ks1; } while (0)
#define SWAIT() asm volatile("s_waitcnt vmcnt(4)" ::: "memory")
#define RESC(a) do { if (__any((a) < 1.f)) { if (hi == 0) al_l[r32] = (a); asm volatile("s_waitcnt lgkmcnt(0)" ::: "memory"); \
    _Pragma("unroll") for (int d = 0; d < 4; ++d) _Pragma("unroll") for (int r = 0; r < 16; ++r) o[d][r] *= al_l[crow(r, hi)]; } } while (0)
  f32x16 pA0, pA1, pB0, pB1; float mnA, mnB, alA, alB; bf16x8 pa0, pa1, pa2, pa3;
  unsigned long long mw = 0ull;
  constexpr int SE = 0, SO = 1;
  if (MASKED) mw = *(const unsigned long long*)((const char*)mbase + moff);
  SLOAD(SE, 0); asm volatile("s_waitcnt vmcnt(0)" ::: "memory"); SWRITE(0, SE); __syncthreads();
  qkt<MASKED>(pA0, pA1, K_lds, qr, r32, hi, mw);
  if (MASKED) mw = *(const unsigned long long*)((const char*)mbase + (moff + 8u));
  partialSM<MASKED>(pA0, pA1, m_reg, mnA, alA, mw, hi);
  SLOAD(SO, KVBLK); SLOAD(SE, (2 < NT ? 2 : NT - 1) * KVBLK);
  SWAIT();
  SWRITE(1, SO); __syncthreads();
  for (int j = 1; j + 1 < NT; j += 2) {
    SBAR(); qkt<MASKED>(pB0, pB1, K_lds + SHM_K, qr, r32, hi, mw);
    if (MASKED) mw = *(const unsigned long long*)((const char*)mbase + (moff + 8u * (unsigned)(j + 1)));
    finishSM(pA0, pA1, alA, l_reg, pa0, pa1, pa2, pa3); SBAR();
    SLOAD(SO, (j + 2) * KVBLK); SBAR();
    pv_d0(o, vb0, pa0, pa1, pa2, pa3); partialSM<MASKED>(pB0, pB1, m_reg, mnB, alB, mw, hi);
    __syncthreads(); if (MASKED) asm volatile("s_waitcnt vmcnt(5)" ::: "memory"); else SWAIT();
    SWRITE(0, SE);
    RESC(alB); __syncthreads();
    SBAR(); qkt<MASKED>(pA0, pA1, K_lds, qr, r32, hi, mw);
    if (MASKED) mw = *(const unsigned long long*)((const char*)mbase + (moff + 8u * (unsigned)(j + 2)));
    finishSM(pB0, pB1, alB, l_reg, pa0, pa1, pa2, pa3); SBAR();
    SLOAD(SE, (j + 3 < NT ? j + 3 : NT - 1) * KVBLK); SBAR();
    pv_d0(o, vb0 + SHM_V, pa0, pa1, pa2, pa3); partialSM<MASKED>(pA0, pA1, m_reg, mnA, alA, mw, hi);
    __syncthreads(); if (MASKED) asm volatile("s_waitcnt vmcnt(5)" ::: "memory"); else SWAIT();
    SWRITE(1, SO);
    RESC(alA); __syncthreads();
  }
  SBAR(); qkt<MASKED>(pB0, pB1, K_lds + SHM_K, qr, r32, hi, mw);
  finishSM(pA0, pA1, alA, l_reg, pa0, pa1, pa2, pa3); SBAR();
  pv_d0(o, vb0, pa0, pa1, pa2, pa3); partialSM<MASKED>(pB0, pB1, m_reg, mnB, alB, mw, hi);
  __syncthreads(); RESC(alB);
  finishSM(pB0, pB1, alB, l_reg, pa0, pa1, pa2, pa3); SBAR();
  pv_d0(o, vb0 + SHM_V, pa0, pa1, pa2, pa3);
  if (hi == 0) li_l[r32] = l_reg; asm volatile("s_waitcnt lgkmcnt(0)" ::: "memory");
  float rli[16];
#pragma unroll
  for (int r = 0; r < 16; ++r) rli[r] = __builtin_amdgcn_rcpf(li_l[crow(r, hi)]);
  __syncthreads();
  float* og_s = (float*)lds + wid * (32 * 132);
#pragma unroll
  for (int r = 0; r < 16; ++r) {
#pragma unroll
    for (int d0 = 0; d0 < 4; ++d0) og_s[crow(r, hi) * 132 + d0 * 32 + r32] = o[d0][r] * rli[r]; }
  asm volatile("" ::: "memory");
  { const int row = lane >> 1, half = lane & 1; const float* src = og_s + row * 132 + half * 64;
    f32x4 v[16]; float ss = 0.f;
#pragma unroll
    for (int i = 0; i < 16; ++i) { v[i] = *(const f32x4*)(src + 4 * i); ss += v[i][0] * v[i][0] + v[i][1] * v[i][1] + v[i][2] * v[i][2] + v[i][3] * v[i][3]; }
    ss += shx(ss, 1);
    const float rn = rsqrtf(ss * (1.f / 128.f) + EPS);
    const bf16_t* zp = Ow.zrow(row) + half * 64; bf16_t* gp = Ow.grow(row) + half * 64;
#pragma unroll
    for (int i = 0; i < 8; ++i) { float z[8], g[8]; ld8f(zp + 8 * i, z);
#pragma unroll
      for (int q = 0; q < 4; ++q) { g[q] = v[2 * i][q] * rn * siluf_(z[q]); g[4 + q] = v[2 * i + 1][q] * rn * siluf_(z[4 + q]); }
      st8f(gp + 8 * i, g); } }
  __syncthreads();
#undef SLOAD
#undef SWRITE
#undef SWAIT
#undef RESC
}
}
constexpr size_t al256(size_t x) { return (x + 255) / 256 * 256; }
constexpr size_t WS_CTL   = 0;
constexpr size_t CTL_BYTES = 65536;
constexpr size_t WS_WINT  = WS_CTL + CTL_BYTES;
constexpr size_t WS_WOUTT = WS_WINT + al256((size_t)DEPTH * NPAD * DM * 2);
constexpr size_t WS_WKVT  = WS_WOUTT + al256((size_t)DEPTH * DM * MIX * 2);
constexpr size_t WS_WGLUT = WS_WKVT + al256((size_t)DEPTH * 1024 * DM * 2);
constexpr size_t WS_MEMN  = WS_WGLUT + al256((size_t)DEPTH * 512 * 512 * 2);
constexpr size_t WS_KVMEM = WS_MEMN + al256((size_t)NB * MEML * DM * 2);
constexpr size_t WS_XN    = WS_KVMEM + al256((size_t)NB * MEML * DEPTH * 1024 * 2);
constexpr size_t WS_P     = WS_XN + al256((size_t)NTOK * DM * 2);
constexpr size_t WS_XBUF  = WS_P + al256((size_t)NTOK * NPAD * 2);
constexpr size_t WS_OCAT  = WS_XBUF + al256((size_t)NTOK * DM * 4);
constexpr size_t WS_MASK  = WS_OCAT + al256((size_t)NTOK * MIX * 2);
constexpr size_t WS_IW    = WS_MASK + al256((size_t)NTOK * 64 * 8);
constexpr size_t WS_YBUF  = WS_IW + al256((size_t)NTOK * 16 * 4);
constexpr size_t WS_ROPE  = WS_YBUF + al256((size_t)NTOK * 512 * 2);
constexpr size_t WS_S5P   = WS_ROPE + al256((size_t)NTOK * 48 * 4);
constexpr size_t S5P_BYTES = (size_t)DEPTH * 32 * (64 * 2 + 64 * 2 + 64 * 16 * 2) * 4;
constexpr size_t WS_GLAS  = WS_S5P + al256(S5P_BYTES);
constexpr size_t WS_GLAD  = WS_GLAS + al256((size_t)NB * 64 * 4 * 64 * 128 * 4);
constexpr size_t WS_IKC   = WS_GLAD + al256((size_t)NB * 64 * 4 * 64 * 4);
constexpr size_t WS_KVC   = WS_IKC + al256((size_t)NTOK * 64 * 2);
constexpr size_t WS_IQL   = WS_KVC + al256((size_t)NTOK * 256 * 2);
constexpr size_t WS_SSQ   = WS_IQL + al256((size_t)NTOK * 64 * 2);
constexpr size_t DSP_SLOT = (size_t)(256 * 128 + 512) * 4;
constexpr size_t WS_DSP   = WS_SSQ + 256;
constexpr size_t WS_END   = WS_DSP + al256((size_t)160 * 2 * DSP_SLOT);

struct Params {
    const float* x; const float* mem; const int* pos; const float* ln_gain; const float* w_in; const float* gla_w_up; const float* gla_b_up;
    const float* s5_a_re; const float* s5_a_im; const float* s5_log_step; const float* s5_b_re; const float* s5_b_im; const float* s5_c_re; const float* s5_c_im;
    const float* s5_d; const float* s5_w_glu; const float* dsa_q_norm; const float* dsa_k_norm; const float* mem_norm; const float* w_mem_kv;
    const float* mem_q_norm; const float* mem_k_norm; const float* out_norm; const float* w_out;
    float* out;
    char* ws;
    __device__ __forceinline__ unsigned* ctl_() const { return (unsigned*)(ws + WS_CTL); }
    __device__ __forceinline__ bf16_t* WinT_() const { return (bf16_t*)(ws + WS_WINT); }
    __device__ __forceinline__ bf16_t* WoutT_() const { return (bf16_t*)(ws + WS_WOUTT); }
    __device__ __forceinline__ bf16_t* WkvT_() const { return (bf16_t*)(ws + WS_WKVT); }
    __device__ __forceinline__ bf16_t* WgluT_() const { return (bf16_t*)(ws + WS_WGLUT); }
    __device__ __forceinline__ bf16_t* memn_() const { return (bf16_t*)(ws + WS_MEMN); }
    __device__ __forceinline__ bf16_t* kvmem_() const { return (bf16_t*)(ws + WS_KVMEM); }
    __device__ __forceinline__ bf16_t* xn_() const { return (bf16_t*)(ws + WS_XN); }
    __device__ __forceinline__ bf16_t* p_() const { return (bf16_t*)(ws + WS_P); }
    __device__ __forceinline__ float* xbuf_() const { return (float*)(ws + WS_XBUF); }
    __device__ __forceinline__ bf16_t* ocat_() const { return (bf16_t*)(ws + WS_OCAT); }
    __device__ __forceinline__ unsigned long long* mask_() const { return (unsigned long long*)(ws + WS_MASK); }
    __device__ __forceinline__ float* iw_() const { return (float*)(ws + WS_IW); }
    __device__ __forceinline__ bf16_t* ybuf_() const { return (bf16_t*)(ws + WS_YBUF); }
    __device__ __forceinline__ float* rope_() const { return (float*)(ws + WS_ROPE); }
    __device__ __forceinline__ float* s5p_() const { return (float*)(ws + WS_S5P); }
    __device__ __forceinline__ float* glas_() const { return (float*)(ws + WS_GLAS); }
    __device__ __forceinline__ float* glad_() const { return (float*)(ws + WS_GLAD); }
    __device__ __forceinline__ bf16_t* ikc_() const { return (bf16_t*)(ws + WS_IKC); }
    __device__ __forceinline__ bf16_t* kvc_() const { return (bf16_t*)(ws + WS_KVC); }
    __device__ __forceinline__ float* ssq_() const { return (float*)(ws + WS_SSQ); }
    __device__ __forceinline__ bf16_t* iql_() const { return (bf16_t*)(ws + WS_IQL); }
    __device__ __forceinline__ char* dsp_() const { return ws + WS_DSP; }
};

__device__ __forceinline__ void transpose_tiles(const float* __restrict__ src, int K, int Nsrc, int Ndst, const float* __restrict__ scale, bf16_t* __restrict__ dst,
                                                int tile, float* lds_tile  ) {
    const int tid = TIDX(), ntn = Ndst / 256;
    const int tk = tile / ntn, tn = tile % ntn, k0 = tk * 64, n0 = tn * 256;
    __syncthreads();
    { const int ty = tid >> 4, tx = tid & 15;
      f32x4 v[2][4];
#pragma unroll
      for (int i = 0; i < 2; ++i)
#pragma unroll
        for (int q = 0; q < 4; ++q) { const int k = k0 + ty + 32 * i, n = n0 + 4 * tx + 64 * q;
          v[i][q] = (f32x4){0.f, 0.f, 0.f, 0.f};
          if (n < Nsrc) v[i][q] = *(const f32x4*)(src + (size_t)k * Nsrc + n); }
#pragma unroll
      for (int i = 0; i < 2; ++i) { const float s = scale ? scale[k0 + ty + 32 * i] : 1.f;
#pragma unroll
        for (int q = 0; q < 4; ++q) { float* t = lds_tile + (ty + 32 * i) * 257 + 4 * tx + 64 * q; t[0] = v[i][q][0] * s; t[1] = v[i][q][1] * s; t[2] = v[i][q][2] * s; t[3] = v[i][q][3] * s; } } }
    __syncthreads();
    { const int n = tid >> 1, kh = (tid & 1) * 32;
#pragma unroll
      for (int j = 0; j < 4; ++j) { const int kb = kh + 8 * j; u32x4 w;
        w.x = pk2bf(lds_tile[(kb + 0) * 257 + n], lds_tile[(kb + 1) * 257 + n]); w.y = pk2bf(lds_tile[(kb + 2) * 257 + n], lds_tile[(kb + 3) * 257 + n]);
        w.z = pk2bf(lds_tile[(kb + 4) * 257 + n], lds_tile[(kb + 5) * 257 + n]); w.w = pk2bf(lds_tile[(kb + 6) * 257 + n], lds_tile[(kb + 7) * 257 + n]);
        *(u32x4*)(dst + (size_t)(n0 + n) * K + k0 + kb) = w; } }
}

__device__ __forceinline__ void rmsnorm_rows(const float* __restrict__ X, bf16_t* __restrict__ Y, int nrows) {
    const int wid = TIDX() >> 6, lane = TIDX() & 63;
    for (int row = blockIdx.x * 8 + wid; row < nrows; row += gridDim.x * 8) {
        const float* xr = X + (size_t)row * DM; f32x4 v[8]; float ss = 0.f;
#pragma unroll
        for (int i = 0; i < 8; ++i) { v[i] = *(const f32x4*)(xr + 4 * lane + 256 * i); ss += v[i][0] * v[i][0] + v[i][1] * v[i][1] + v[i][2] * v[i][2] + v[i][3] * v[i][3]; }
        ss = wave_sum(ss); const float r = rsqrtf(ss * (1.f / DM) + EPS);
        bf16_t* yr = Y + (size_t)row * DM;
#pragma unroll
        for (int i = 0; i < 8; ++i) { u32x2 w; w.x = pk2bf(v[i][0] * r, v[i][1] * r); w.y = pk2bf(v[i][2] * r, v[i][3] * r); *(u32x2*)(yr + 4 * lane + 256 * i) = w; }
    }
}

__device__ __forceinline__ void rows_bf16_ssq(const float* __restrict__ X, bf16_t* __restrict__ Y, float* __restrict__ ssq, int nrows) {
    const int wid = TIDX() >> 6, lane = TIDX() & 63;
    for (int row = blockIdx.x * 8 + wid; row < nrows; row += gridDim.x * 8) {
        const float* xr = X + (size_t)row * DM; bf16_t* yr = Y + (size_t)row * DM; float ss = 0.f;
#pragma unroll
        for (int i = 0; i < 8; ++i) { const f32x4 v = *(const f32x4*)(xr + 4 * lane + 256 * i); ss += v[0] * v[0] + v[1] * v[1] + v[2] * v[2] + v[3] * v[3];
            u32x2 w; w.x = pk2bf(v[0], v[1]); w.y = pk2bf(v[2], v[3]); *(u32x2*)(yr + 4 * lane + 256 * i) = w; }
        ss = wave_sum(ss); if (lane < 32) ssq[(size_t)row * 32 + lane] = (lane == 0) ? ss : 0.f;
    }
}
__device__ __forceinline__ void phase_prologue1(const Params& P, char* lds) {
    float* tile = (float*)lds;
    constexpr int T_IN = (DM / 64) * (NPAD / 256), T_OUT = (MIX / 64) * (DM / 256), T_KV = (DM / 64) * (1024 / 256), T_GLU = 8 * 2;
    constexpr int TOT = DEPTH * (T_IN + T_OUT + T_KV + T_GLU);
    for (int u = blockIdx.x; u < TOT; u += gridDim.x) {
        int l = u / (T_IN + T_OUT + T_KV + T_GLU), r = u % (T_IN + T_OUT + T_KV + T_GLU);
        if (r < T_IN) transpose_tiles(P.w_in + (size_t)l * DM * NIN, DM, NIN, NPAD, P.ln_gain + l * DM, P.WinT_() + (size_t)l * NPAD * DM, r, tile);
        else if ((r -= T_IN) < T_OUT) transpose_tiles(P.w_out + (size_t)l * MIX * DM, MIX, DM, DM, P.out_norm + l * MIX, P.WoutT_() + (size_t)l * DM * MIX, r, tile);
        else if ((r -= T_OUT) < T_KV) transpose_tiles(P.w_mem_kv + (size_t)l * DM * 1024, DM, 1024, 1024, P.mem_norm + l * DM, P.WkvT_() + (size_t)l * 1024 * DM, r, tile);
        else { r -= T_KV; transpose_tiles(P.s5_w_glu + (size_t)l * 512 * 512, 512, 512, 512, nullptr, P.WgluT_() + (size_t)l * 512 * 512, r, tile); }
    }
    rmsnorm_rows(P.mem, P.memn_(), NB * MEML);
}
__device__ __forceinline__ void phase_rope_table(const Params& P) {
    for (int idx = blockIdx.x * NTHR + TIDX(); idx < NTOK * 24; idx += gridDim.x * NTHR) {
        const int tok = idx / 24, i = idx % 24;
        const float e = (i < 16) ? -((float)i * 2.0f / 32.0f) : -((float)(i - 16) * 2.0f / 16.0f);
        const float inv_freq = exp2f(e * 18.931568569324174f);
        const float ang = (float)P.pos[tok] * inv_freq;
        const double a = (double)ang; const double k = rint(a * 0.15915494309189535); const float rf = (float)fma(-k, 6.283185307179586, a);
        P.rope_()[(size_t)idx * 2] = cosf(rf); P.rope_()[(size_t)idx * 2 + 1] = sinf(rf);
    }
}

__device__ __forceinline__ void phase_rmsnorm_x(const Params& P, int layer) { rmsnorm_rows(layer == 0 ? P.x : P.xbuf_(), P.xn_(), NTOK); }

__device__ __forceinline__ void phase_memk_norm(const Params& P) {
    const int wid = TIDX() >> 6, lane = TIDX() & 63;
    for (int it = blockIdx.x * 8 + wid; it < NB * MEML * DEPTH * 4; it += gridDim.x * 8) {
        const int row = it / (DEPTH * 4), l = (it / 4) % DEPTH, h = it % 4;
        bf16_t* kp = P.kvmem_() + (size_t)row * (DEPTH * 1024) + l * 1024 + h * 128 + 2 * lane;
        const unsigned w = *(const unsigned*)kp; const float a = __uint_as_float(w << 16), b = __uint_as_float(w & 0xffff0000u);
        const float ss = wave_sum(a * a + b * b), r = rsqrtf(ss * (1.f / 128.f) + EPS);
        const float* g = P.mem_k_norm + l * 128 + 2 * lane;
        *(unsigned*)kp = pk2bf(a * r * g[0], b * r * g[1]);
    }
}

__device__ __forceinline__ float sum16(float v) { v += shx(v, 1); v += shx(v, 2); v += shx(v, 4); v += shx(v, 8); return v; }

__device__ __forceinline__ void head128_norm_rope_to(const bf16_t* hp, bf16_t* dp, int l16, const float* __restrict__ gain, const float* __restrict__ cs, bool rope, bool do_store) {
    float v[8]; ld8f(hp + 8 * l16, v);
    float ss = 0.f;
#pragma unroll
    for (int j = 0; j < 8; ++j) ss += v[j] * v[j];
    ss = sum16(ss); const float r = rsqrtf(ss * (1.f / 128.f) + EPS);
#pragma unroll
    for (int j = 0; j < 8; ++j) v[j] = v[j] * r * gain[8 * l16 + j];
    if (rope) {
        float o[8];
#pragma unroll
        for (int j = 0; j < 8; ++j) o[j] = shx(v[j], 2);
        if (l16 < 4) { const int fi = (l16 & 1) * 8;
#pragma unroll
            for (int j = 0; j < 8; ++j) { const float c = cs[(fi + j) * 2], s = cs[(fi + j) * 2 + 1];
                v[j] = (l16 < 2) ? (v[j] * c - o[j] * s) : (v[j] * c + o[j] * s); } }
    }
    if (do_store) st8f(dp + 8 * l16, v);
}
__device__ __forceinline__ void head128_norm_rope(bf16_t* hp, int l16, const float* __restrict__ gain, const float* __restrict__ cs, bool rope, bool do_store) { head128_norm_rope_to(hp, hp, l16, gain, cs, rope, do_store); }
__device__ __forceinline__ void rope16_inplace(bf16_t* ip, const float* __restrict__ cs) {
    float a[8], b[8]; ld8f(ip, a); ld8f(ip + 8, b);
#pragma unroll
    for (int j = 0; j < 8; ++j) { const float c = cs[2 * j], s = cs[2 * j + 1], x1 = a[j], x2 = b[j]; a[j] = x1 * c - x2 * s; b[j] = x2 * c + x1 * s; }
    st8f(ip, a); st8f(ip + 8, b);
}
__device__ __forceinline__ void phase_prep(const Params& P, int layer) {
    const int wid = TIDX() >> 6, lane = TIDX() & 63, l16 = lane & 15, grp = lane >> 4;
    for (int tok = blockIdx.x * 8 + wid; tok < NTOK; tok += gridDim.x * 8) {
        bf16_t* row = P.p_() + (size_t)tok * NPAD;
        const float* cs32 = P.rope_() + (size_t)tok * 48; const float* cs16 = cs32 + 32;
        head128_norm_rope(row + C_DQ + grp * 128, l16, P.dsa_q_norm + layer * 128, cs32, true, true);
        head128_norm_rope_to(row + C_DK, P.kvc_() + (size_t)tok * 256, l16, P.dsa_k_norm + layer * 128, cs32, true, grp == 0);
        head128_norm_rope(row + C_MQ + grp * 128, l16, P.mem_q_norm + layer * 128, cs32, false, true);
        if ((lane & 3) == 0) rope16_inplace(row + C_DIQ + lane * 16, cs16);
        if (lane < 4) {
            bf16_t* dst = P.ikc_() + (size_t)(tok >> 5) * 2048 + lane * 512 + (tok & 31) * 8;
            float a[8], b[8]; ld8f(row + C_DIK + lane * 16, a); ld8f(row + C_DIK + lane * 16 + 8, b);
            if (lane == 0) {
#pragma unroll
                for (int q = 0; q < 8; ++q) { const float c = cs16[2 * q], s = cs16[2 * q + 1], x1 = a[q], x2 = b[q]; a[q] = x1 * c - x2 * s; b[q] = x2 * c + x1 * s; } }
            st8f(dst, a); st8f(dst + 256, b); }
        if (lane >= 16 && lane < 32) { const u32x4 vv = *(const u32x4*)(row + C_DV + (lane - 16) * 8); *(u32x4*)(P.kvc_() + (size_t)tok * 256 + 128 + (lane - 16) * 8) = vv; }
        if (lane < 16) P.iw_()[(size_t)tok * 16 + lane] = bf2f(row[C_DIW + lane]) * (1.f / 32.f);
    }
}
struct MemOutRow { const bf16_t* zb; bf16_t* gb;
    __device__ __forceinline__ const bf16_t* zrow(int r) const { return zb + (size_t)r * NPAD; } __device__ __forceinline__ bf16_t* grow(int r) const { return gb + (size_t)r * MIX; } };
__device__ __forceinline__ void unit_mem_attn(const Params& P, int layer, int u, char* lds) {
    const int b = u >> 6, h = (u >> 4) & 3, qb = u & 15, tok0 = b * SEQ + qb * 256;
    const int wid = TIDX() >> 6, lane = TIDX() & 63, r32 = lane & 31, hi = lane >> 5;
    const bf16_t* Qw = P.p_() + (size_t)(tok0 + wid * 32 + r32) * NPAD + C_MQ + h * 128 + hi * 8;
    const bf16_t* Kh = P.kvmem_() + (size_t)(b * MEML) * (DEPTH * 1024) + layer * 1024 + h * 128;
    MemOutRow ow; ow.zb = P.p_() + (size_t)(tok0 + wid * 32) * NPAD + C_MZ + h * 128; ow.gb = P.xn_() + (size_t)(tok0 + wid * 32) * MIX + 1536 + h * 128;
    att::attn_body<false, DEPTH * 1024, 512, MemOutRow>(Qw, Kh, MEML / 64, nullptr, 0u, ow, lds);
}

__device__ __forceinline__ void phase_gate(const Params& P, int c_lo, int c_hi) {
    const int wid = TIDX() >> 6, lane = TIDX() & 63;
    const int c0 = lane * 32;
    const int seg = c0 >> 9, zc = (seg == 0 ? C_GZ : seg == 1 ? C_SZ : seg == 2 ? C_DZ : C_MZ) + (c0 & 511);
    const bool act = (c0 >= c_lo) && (c0 < c_hi);
    for (int tok = blockIdx.x * 8 + wid; tok < NTOK; tok += gridDim.x * 8) {
        if (!act) { bf16_t* gz_ = P.xn_() + (size_t)tok * MIX + c0; const u32x4 zz = {0u, 0u, 0u, 0u};
#pragma unroll
            for (int i = 0; i < 4; ++i) *(u32x4*)(gz_ + 8 * i) = zz;
            continue; }
        const bf16_t* op = P.ocat_() + (size_t)tok * MIX + c0; const bf16_t* zp = P.p_() + (size_t)tok * NPAD + zc; bf16_t* gp = P.xn_() + (size_t)tok * MIX + c0;
        float o[32]; float ss = 0.f;
#pragma unroll
        for (int i = 0; i < 4; ++i) { float v[8]; ld8f(op + 8 * i, v);
#pragma unroll
            for (int j = 0; j < 8; ++j) { o[8 * i + j] = v[j]; ss += v[j] * v[j]; } }
        ss += shx(ss, 1); ss += shx(ss, 2);
        const float r = rsqrtf(ss * (1.f / 128.f) + EPS);
#pragma unroll
        for (int i = 0; i < 4; ++i) { float z[8], g[8]; ld8f(zp + 8 * i, z);
#pragma unroll
            for (int j = 0; j < 8; ++j) g[j] = o[8 * i + j] * r * siluf_(z[j]);
            st8f(gp + 8 * i, g); }
    }
}

__device__ __forceinline__ void phase_gemm_in(const Params& P, int layer, char* lds) {
    pg8::Gemm g; g.A = P.xn_(); g.Bt = P.WinT_() + (size_t)layer * NPAD * DM; g.M = NTOK; g.N = NPAD; g.K = DM;
    pg8::StaticOrder S; S.init(g.M, g.N, (int)gridDim.x, (int)blockIdx.x);
    pg8::EpiBf16Plain E; E.O = P.p_(); E.ldc = NPAD;
    pg8::gemm_phase<pg8::EpiBf16Plain, pg8::StaticOrder, false>((PG8_LAS unsigned char*)lds, g, S, E, nullptr);
}
__device__ __forceinline__ void phase_gemm_out(const Params& P, int layer, char* lds) {
    pg8::Gemm g; g.A = P.xn_(); g.Bt = P.WoutT_() + (size_t)layer * DM * MIX; g.M = NTOK; g.N = DM; g.K = MIX;
    pg8::StaticOrder S; S.init(g.M, g.N, (int)gridDim.x, (int)blockIdx.x);
    pg8::EpiResid E; E.R = (layer == 0) ? P.x : P.xbuf_(); E.C = (layer == DEPTH - 1) ? P.out : P.xbuf_(); E.ldc = DM;
    pg8::gemm_phase<pg8::EpiResid, pg8::StaticOrder, false>((PG8_LAS unsigned char*)lds, g, S, E, nullptr);
}
__device__ __forceinline__ void phase_gemm_kv(const Params& P, char* lds) {
    pg8::Gemm g; g.A = P.memn_(); g.Bt = P.WkvT_(); g.M = NB * MEML; g.N = DEPTH * 1024; g.K = DM;
    pg8::StaticOrder S; S.init(g.M, g.N, (int)gridDim.x, (int)blockIdx.x);
    pg8::EpiBf16Plain E; E.O = P.kvmem_(); E.ldc = DEPTH * 1024;
    pg8::gemm_phase<pg8::EpiBf16Plain, pg8::StaticOrder, false>((PG8_LAS unsigned char*)lds, g, S, E, nullptr);
}
__device__ __forceinline__ void mma_tile(f32x16& acc, const char* A, int lda, const char* B, int ldb, int K, int lane) {
    const int r = lane & 31, kh = lane >> 5;
    const char* ap = A + r * lda + kh * 16; const char* bp = B + r * ldb + kh * 16;
    asm volatile("" : "+v"(acc));
    for (int k = 0; k < K; k += 16) {
        const bf16x8 a = *(const bf16x8*)(ap + k * 2); const bf16x8 b = *(const bf16x8*)(bp + k * 2);
        acc = __builtin_amdgcn_mfma_f32_32x32x16_bf16(a, b, acc, 0, 0, 0);
    }
}
__device__ __forceinline__ int crow32(int r, int hi) { return (r & 3) + 8 * (r >> 2) + 4 * hi; }
__device__ __forceinline__ float log_sigmoid_(float x) { return fminf(x, 0.f) - log1pf(__expf(-fabsf(x))); }

constexpr int GLA_ST = 144;
constexpr int GC_BST = 68;
constexpr int GC_B_BYTES = 4 * 64 * GC_BST * 4, GC_V_BYTES = 4 * 16384;
__device__ __forceinline__ float* gla_gb(const Params& P) { return (float*)((char*)P.ocat_() + (size_t)32 * 1024 * 1024); }
__device__ __forceinline__ float log_sigmoid_fast(float x) { return fminf(x, 0.f) - __logf(1.f + __expf(-fabsf(x))); }

__device__ __forceinline__ void unit_gla_a4(const Params& P, int layer, int ub, char* lds) {
    const int b = ub >> 6, n = ub & 63, tok0 = b * SEQ + n * 64;
    const int tid = TIDX(), wid = tid >> 6, lane = tid & 63, r32 = lane & 31, hi = lane >> 5, h = wid >> 1, eh = wid & 1;
    float* b_s = (float*)lds;
    char* V_s = lds;
    char* K_s = lds + GC_B_BYTES;
    float* glr_s = (float*)(lds + GC_B_BYTES + GC_V_BYTES);
    float* tot_s = glr_s + 1024;
    __syncthreads();
    const bf16_t* prow = P.p_() + (size_t)tok0 * NPAD;
    const bf16x8 glr_raw = *(const bf16x8*)(prow + (size_t)((tid & 127) >> 1) * NPAD + C_GLR + (tid & 1) * 8);
    const int gd = tid & 63, gh = (tid >> 6) & 3, gt = tid >> 8;
    float wu[16];
#pragma unroll
    for (int r = 0; r < 16; ++r) wu[r] = P.gla_w_up[((size_t)layer * 16 + r) * 256 + gh * 64 + gd];
    const float bias = P.gla_b_up[layer * 256 + gh * 64 + gd];
    bf16x8 kraw[4], vs[4][2];
    const int ks_ = tid >> 3, kc = (tid & 7) * 8;
#pragma unroll
    for (int hv = 0; hv < 4; ++hv) kraw[hv] = *(const bf16x8*)(prow + (size_t)ks_ * NPAD + C_GK + hv * 64 + kc);
    const int sr = tid >> 4, sc = (tid & 15) * 8;
#pragma unroll
    for (int hv = 0; hv < 4; ++hv) { vs[hv][0] = *(const bf16x8*)(prow + (size_t)sr * NPAD + C_GV + hv * 128 + sc); vs[hv][1] = *(const bf16x8*)(prow + (size_t)(32 + sr) * NPAD + C_GV + hv * 128 + sc); }
    if (tid < 128) {
#pragma unroll
        for (int j = 0; j < 8; ++j) glr_s[(tid >> 1) * 16 + (tid & 1) * 8 + j] = bf2f((bf16_t)glr_raw[j]); }
    __syncthreads();
    float gv[32]; float run = 0.f;
#pragma unroll
    for (int i = 0; i < 32; ++i) { const float* gr = glr_s + (gt * 32 + i) * 16; float a = bias;
#pragma unroll
        for (int r4 = 0; r4 < 4; ++r4) { const f32x4 g4 = *(const f32x4*)(gr + 4 * r4); a = fmaf(g4[0], wu[4 * r4], a); a = fmaf(g4[1], wu[4 * r4 + 1], a); a = fmaf(g4[2], wu[4 * r4 + 2], a); a = fmaf(g4[3], wu[4 * r4 + 3], a); }
        run += log_sigmoid_fast(a) * (1.f / 16.f); gv[i] = run; }
    if (gt == 0) tot_s[gh * 64 + gd] = run;
    __syncthreads();
    { const float off = gt ? tot_s[gh * 64 + gd] : 0.f; float* bp = b_s + (gh * 64 + gt * 32) * GC_BST + gd;
      float* gp = gla_gb(P) + (size_t)(tok0 + gt * 32) * 256 + gh * 64 + gd;
#pragma unroll
      for (int i = 0; i < 32; ++i) { const float v = gv[i] + off; bp[i * GC_BST] = v; gp[(size_t)i * 256] = v; }
      if (gt) P.glad_()[((size_t)((b * 64 + n) * 4 + gh)) * 64 + gd] = __expf(gv[31] + off); }
    __syncthreads();
#pragma unroll
    for (int hv = 0; hv < 4; ++hv) { const float* br = b_s + (hv * 64 + ks_) * GC_BST + kc; const float* bl = b_s + (hv * 64 + 63) * GC_BST + kc;
        const f32x4 b0 = *(const f32x4*)br, b1 = *(const f32x4*)(br + 4), l0 = *(const f32x4*)bl, l1 = *(const f32x4*)(bl + 4);
        float e[8];
#pragma unroll
        for (int j = 0; j < 8; ++j) e[j] = bf2f((bf16_t)kraw[hv][j]) * __expf((j < 4 ? l0[j] : l1[j - 4]) - (j < 4 ? b0[j] : b1[j - 4]));
        u32x4 w = {att::cvtpk(e[0], e[1]), att::cvtpk(e[2], e[3]), att::cvtpk(e[4], e[5]), att::cvtpk(e[6], e[7])};
        *(u32x4*)(K_s + hv * 16384 + att::v_st(ks_, kc)) = w; }
    __syncthreads();
    { const int vst0 = att::v_st(sr, sc), vst1 = att::v_st(32 + sr, sc);
#pragma unroll
      for (int hv = 0; hv < 4; ++hv) { *(bf16x8*)(V_s + hv * 16384 + vst0) = vs[hv][0]; *(bf16x8*)(V_s + hv * 16384 + vst1) = vs[hv][1]; } }
    __syncthreads();
    const int vb = (int)(uintptr_t)(V_s + h * 16384) + att::v_rd_base(lane), kb = (int)(uintptr_t)(K_s + h * 16384) + att::v_rd_base(lane);
    f32x16 acc[2][2] = {};
    asm volatile("" : "+v"(acc[0][0]), "+v"(acc[0][1]), "+v"(acc[1][0]), "+v"(acc[1][1]));
#define GA_PK(L, H) (bf16x8){L[0], L[1], L[2], L[3], H[0], H[1], H[2], H[3]}
#define GA_STEP(KS) do { \
    const s16x4 k0l = att::tr_read<att::v_rd_off(0, KS, 0)>(kb), k0h = att::tr_read<att::v_rd_off(0, KS, 1)>(kb), k1l = att::tr_read<att::v_rd_off(1, KS, 0)>(kb), k1h = att::tr_read<att::v_rd_off(1, KS, 1)>(kb); \
    s16x4 v0l, v0h, v1l, v1h; \
    if (eh == 0) { v0l = att::tr_read<att::v_rd_off(0, KS, 0)>(vb); v0h = att::tr_read<att::v_rd_off(0, KS, 1)>(vb); v1l = att::tr_read<att::v_rd_off(1, KS, 0)>(vb); v1h = att::tr_read<att::v_rd_off(1, KS, 1)>(vb); } \
    else         { v0l = att::tr_read<att::v_rd_off(2, KS, 0)>(vb); v0h = att::tr_read<att::v_rd_off(2, KS, 1)>(vb); v1l = att::tr_read<att::v_rd_off(3, KS, 0)>(vb); v1h = att::tr_read<att::v_rd_off(3, KS, 1)>(vb); } \
    asm volatile("s_waitcnt lgkmcnt(0)" ::: "memory"); __builtin_amdgcn_sched_barrier(0); \
    acc[0][0] = __builtin_amdgcn_mfma_f32_32x32x16_bf16(GA_PK(v0l, v0h), GA_PK(k0l, k0h), acc[0][0], 0, 0, 0); \
    acc[0][1] = __builtin_amdgcn_mfma_f32_32x32x16_bf16(GA_PK(v0l, v0h), GA_PK(k1l, k1h), acc[0][1], 0, 0, 0); \
    acc[1][0] = __builtin_amdgcn_mfma_f32_32x32x16_bf16(GA_PK(v1l, v1h), GA_PK(k0l, k0h), acc[1][0], 0, 0, 0); \
    acc[1][1] = __builtin_amdgcn_mfma_f32_32x32x16_bf16(GA_PK(v1l, v1h), GA_PK(k1l, k1h), acc[1][1], 0, 0, 0); } while (0)
    GA_STEP(0); GA_STEP(1); GA_STEP(2); GA_STEP(3);
#undef GA_STEP
#undef GA_PK
    float* dst = P.glas_() + ((size_t)((b * 64 + n) * 4 + h)) * 8192;
#pragma unroll
    for (int et = 0; et < 2; ++et)
#pragma unroll
        for (int dt = 0; dt < 2; ++dt)
#pragma unroll
            for (int r = 0; r < 16; ++r) dst[((eh * 2 + et) * 32 + att::crow(r, hi)) * 64 + dt * 32 + r32] = acc[et][dt][r];
    __syncthreads();
}

__device__ __forceinline__ void gla_scan_slice(const Params& P, int idx) {
    {
        const int el = idx & 8191, d = idx & 63, h = (idx >> 13) & 3, b = idx >> 15;
        bf16_t* gst = P.ocat_();
        float S = 0.f;
        for (int n0 = 0; n0 < 64; n0 += 8) {
            float ds[8], dc[8];
#pragma unroll
            for (int i = 0; i < 8; ++i) { const size_t cu = (size_t)((b * 64 + n0 + i) * 4 + h); ds[i] = P.glas_()[cu * 8192 + el]; dc[i] = P.glad_()[cu * 64 + d]; }
#pragma unroll
            for (int i = 0; i < 8; ++i) { const size_t cu = (size_t)((b * 64 + n0 + i) * 4 + h); gst[cu * 8192 + el] = f2bf(S); S = fmaf(dc[i], S, ds[i]); }
        }
    }
}

__device__ __forceinline__ void unit_gla_c4(const Params& P, int layer, int ub, char* lds) {
    const int b = ub >> 6, n = ub & 63, tok0 = b * SEQ + n * 64;
    const int tid = TIDX(), wid = tid >> 6, lane = tid & 63, r32 = lane & 31, hi = lane >> 5, h = wid >> 1, rh = wid & 1;
    float* b_s = (float*)lds;
    char* V_s = lds + GC_B_BYTES;
    __syncthreads();
    const bf16_t* prow = P.p_() + (size_t)tok0 * NPAD;
    bf16x8 qraw[4], kraw[2][4], vs[4][2];
    const int sr = tid >> 4, sc = (tid & 15) * 8;
#pragma unroll
    for (int hv = 0; hv < 4; ++hv) { vs[hv][0] = *(const bf16x8*)(prow + (size_t)sr * NPAD + C_GV + hv * 128 + sc); vs[hv][1] = *(const bf16x8*)(prow + (size_t)(32 + sr) * NPAD + C_GV + hv * 128 + sc); }
    f32x4 braw[8];
    { const float* gp = gla_gb(P) + (size_t)tok0 * 256 + tid * 4;
#pragma unroll
      for (int i = 0; i < 8; ++i) braw[i] = *(const f32x4*)(gp + i * 2048); }
    { const bf16_t* qp = prow + (size_t)(rh * 32 + r32) * NPAD + C_GQ + h * 64 + hi * 8;
#pragma unroll
      for (int d0 = 0; d0 < 4; ++d0) qraw[d0] = *(const bf16x8*)(qp + d0 * 16);
#pragma unroll
      for (int sh = 0; sh < 2; ++sh) { const bf16_t* kp = prow + (size_t)(sh * 32 + r32) * NPAD + C_GK + h * 64 + hi * 8;
#pragma unroll
          for (int d0 = 0; d0 < 4; ++d0) kraw[sh][d0] = *(const bf16x8*)(kp + d0 * 16); } }
    bf16x8 sfr[4][4];
    { const bf16_t* sp = P.ocat_() + ((size_t)((b * 64 + n) * 4 + h)) * 8192 + r32 * 64 + hi * 8;
#pragma unroll
      for (int eb = 0; eb < 4; ++eb)
#pragma unroll
          for (int ds = 0; ds < 4; ++ds) sfr[eb][ds] = *(const bf16x8*)(sp + eb * 32 * 64 + ds * 16); }
    { const int vst0 = att::v_st(sr, sc), vst1 = att::v_st(32 + sr, sc);
#pragma unroll
      for (int hv = 0; hv < 4; ++hv) { *(bf16x8*)(V_s + hv * 16384 + vst0) = vs[hv][0]; *(bf16x8*)(V_s + hv * 16384 + vst1) = vs[hv][1]; } }
#pragma unroll
    for (int i = 0; i < 8; ++i) { const int c = tid + 512 * i, t = c >> 6, c4 = c & 63;
        *(f32x4*)(b_s + ((c4 >> 4) * 64 + t) * GC_BST + (c4 & 15) * 4) = braw[i]; }
    __syncthreads();
    const float* bh = b_s + h * 64 * GC_BST + hi * 8;
    bf16x8 qe[4], qb[4], ke[2][4];
#pragma unroll
    for (int d0 = 0; d0 < 4; ++d0) {
        const f32x4 m0 = *(const f32x4*)(bh + 32 * GC_BST + d0 * 16), m1 = *(const f32x4*)(bh + 32 * GC_BST + d0 * 16 + 4);
        const f32x4 q0 = *(const f32x4*)(bh + (rh * 32 + r32) * GC_BST + d0 * 16), q1 = *(const f32x4*)(bh + (rh * 32 + r32) * GC_BST + d0 * 16 + 4);
        float e1[8], e2[8];
#pragma unroll
        for (int j = 0; j < 8; ++j) { const float mv = j < 4 ? m0[j] : m1[j - 4], bq = j < 4 ? q0[j] : q1[j - 4]; const float q = bf2f((bf16_t)qraw[d0][j]) * 0.125f;
            e1[j] = q * __expf(bq - mv); e2[j] = q * __expf(bq); }
        { u32x4 w = {att::cvtpk(e1[0], e1[1]), att::cvtpk(e1[2], e1[3]), att::cvtpk(e1[4], e1[5]), att::cvtpk(e1[6], e1[7])}; qe[d0] = *reinterpret_cast<bf16x8*>(&w); }
        { u32x4 w = {att::cvtpk(e2[0], e2[1]), att::cvtpk(e2[2], e2[3]), att::cvtpk(e2[4], e2[5]), att::cvtpk(e2[6], e2[7])}; qb[d0] = *reinterpret_cast<bf16x8*>(&w); }
#pragma unroll
        for (int sh = 0; sh < 2; ++sh) {
            const f32x4 k0 = *(const f32x4*)(bh + (sh * 32 + r32) * GC_BST + d0 * 16), k1 = *(const f32x4*)(bh + (sh * 32 + r32) * GC_BST + d0 * 16 + 4);
            float e3[8];
#pragma unroll
            for (int j = 0; j < 8; ++j) { const float mv = j < 4 ? m0[j] : m1[j - 4], bk = j < 4 ? k0[j] : k1[j - 4]; e3[j] = bf2f((bf16_t)kraw[sh][d0][j]) * __expf(mv - bk); }
            u32x4 w = {att::cvtpk(e3[0], e3[1]), att::cvtpk(e3[2], e3[3]), att::cvtpk(e3[4], e3[5]), att::cvtpk(e3[6], e3[7])}; ke[sh][d0] = *reinterpret_cast<bf16x8*>(&w); }
    }
    f32x16 p0 = {}, p1 = {};
    asm volatile("" : "+v"(p0), "+v"(p1));
#pragma unroll
    for (int d0 = 0; d0 < 4; ++d0) { p0 = __builtin_amdgcn_mfma_f32_32x32x16_bf16(ke[0][d0], qe[d0], p0, 0, 0, 0); p1 = __builtin_amdgcn_mfma_f32_32x32x16_bf16(ke[1][d0], qe[d0], p1, 0, 0, 0); }
    { const int t = rh * 32 + r32;
#pragma unroll
      for (int r = 0; r < 16; ++r) { const int s0 = att::crow(r, hi); p0[r] = (s0 <= t) ? p0[r] : 0.f; p1[r] = (32 + s0 <= t) ? p1[r] : 0.f; } }
    bf16x8 pa0, pa1, pa2, pa3;
#define GC_PK4(Pv, BASE, OUT) do { unsigned a0 = att::cvtpk(Pv[BASE + 0], Pv[BASE + 1]), a1 = att::cvtpk(Pv[BASE + 2], Pv[BASE + 3]);   \
    unsigned b0 = att::cvtpk(Pv[BASE + 4], Pv[BASE + 5]), b1 = att::cvtpk(Pv[BASE + 6], Pv[BASE + 7]);                              \
    auto r0 = __builtin_amdgcn_permlane32_swap(a0, b0, false, false); auto r1 = __builtin_amdgcn_permlane32_swap(a1, b1, false, false); \
    u32x4 w = {r0[0], r1[0], r0[1], r1[1]}; OUT = *reinterpret_cast<bf16x8*>(&w); } while (0)
    GC_PK4(p0, 0, pa0); GC_PK4(p0, 8, pa1); GC_PK4(p1, 0, pa2); GC_PK4(p1, 8, pa3);
#undef GC_PK4
    f32x16 o[4] = {};
    asm volatile("" : "+v"(o[0]), "+v"(o[1]), "+v"(o[2]), "+v"(o[3]));
    att::pv_d0(o, (int)(uintptr_t)(V_s + h * 16384) + att::v_rd_base(lane), pa0, pa1, pa2, pa3);
#pragma unroll
    for (int eb = 0; eb < 4; ++eb)
#pragma unroll
        for (int ds = 0; ds < 4; ++ds) o[eb] = __builtin_amdgcn_mfma_f32_32x32x16_bf16(qb[ds], sfr[eb][ds], o[eb], 0, 0, 0);
    __syncthreads();
    float* og_s = (float*)lds + wid * (32 * 132);
#pragma unroll
    for (int r = 0; r < 16; ++r) {
#pragma unroll
        for (int eb = 0; eb < 4; ++eb) og_s[att::crow(r, hi) * 132 + eb * 32 + r32] = o[eb][r]; }
    asm volatile("" ::: "memory");
    { const int row = lane >> 1, half = lane & 1; const float* src = og_s + row * 132 + half * 64;
      f32x4 v[16]; float ss = 0.f;
#pragma unroll
      for (int i = 0; i < 16; ++i) { v[i] = *(const f32x4*)(src + 4 * i); ss += v[i][0] * v[i][0] + v[i][1] * v[i][1] + v[i][2] * v[i][2] + v[i][3] * v[i][3]; }
      ss += shx(ss, 1);
      const float rn = rsqrtf(ss * (1.f / 128.f) + EPS);
      const size_t tok = (size_t)(tok0 + rh * 32 + row);
      const bf16_t* zp = P.p_() + tok * NPAD + C_GZ + h * 128 + half * 64; bf16_t* gp = P.xn_() + tok * MIX + h * 128 + half * 64;
#pragma unroll
      for (int i = 0; i < 8; ++i) { float z[8], g[8]; ld8f(zp + 8 * i, z);
#pragma unroll
          for (int q = 0; q < 4; ++q) { g[q] = v[2 * i][q] * rn * siluf_(z[q]); g[4 + q] = v[2 * i + 1][q] * rn * siluf_(z[4 + q]); }
          st8f(gp + 8 * i, g); } }
    __syncthreads();
}
constexpr int S5P_STRIDE = 2304;
__device__ __forceinline__ void phase_s5_params(const Params& P) {
    for (int idx = blockIdx.x * NTHR + TIDX(); idx < DEPTH * 32 * 64; idx += gridDim.x * NTHR) {
        const int p = idx & 63, lg = idx >> 6;
        const float ar = P.s5_a_re[idx], ai = P.s5_a_im[idx], step = expf(P.s5_log_step[lg]);
        const float mag = expf(ar * step), th = ai * step;
        const float lr = mag * cosf(th), li = mag * sinf(th);
        float* o = P.s5p_() + (size_t)lg * S5P_STRIDE;
        o[2 * p] = lr; o[2 * p + 1] = li;
        { const float mag512 = expf(512.f * ar * step); const double a = 512.0 * (double)th; const double k = rint(a * 0.15915494309189535); const float rf = (float)fma(-k, 6.283185307179586, a);
          o[128 + 2 * p] = mag512 * cosf(rf); o[128 + 2 * p + 1] = mag512 * sinf(rf); }
        const float xr = lr - 1.f, xi = li, den = 1.f / (ar * ar + ai * ai);
        const float fr = (xr * ar + xi * ai) * den, fi = (xi * ar - xr * ai) * den;
        for (int c = 0; c < 16; ++c) { const float br = P.s5_b_re[(size_t)idx * 16 + c], bi = P.s5_b_im[(size_t)idx * 16 + c];
            o[256 + (p * 16 + c) * 2] = fr * br - fi * bi; o[256 + (p * 16 + c) * 2 + 1] = fr * bi + fi * br; }
    }
}
__device__ __forceinline__ float gelu_tanh_(float x) { const float u = 0.7978845608028654f * (x + 0.044715f * x * x * x); const float e = __expf(-2.f * fabsf(u)); const float th = copysignf((1.f - e) / (1.f + e), u); return 0.5f * x * (1.f + th); }

constexpr int S5_XST = 272;
constexpr int S5_UST = 48;
__device__ __forceinline__ float partner32(float v, int hi) { auto rr = __builtin_amdgcn_permlane32_swap(__float_as_uint(v), __float_as_uint(v), false, false); return __uint_as_float(hi ? rr[0] : rr[1]); }
struct S5Ctx { float l0r, l0i, l1r, l1i, q0r, q0i, q1r, q1i, dsk; char* Cm; char* Bb; char* Xs; char* Us; int lane, hi, j, rho; const bf16_t* ubase; bf16_t* ybase; };
template <bool OUT> __device__ __forceinline__ void s5_tile(const S5Ctx& C, int tok0, float& x0r, float& x0i, float& x1r, float& x1i) {
    const int hi = C.hi, j = C.j, lane = C.lane;
    if (hi == 0) { const bf16_t* up = C.ubase + (size_t)(tok0 + j) * NPAD;
        const bf16x8 w0 = *(const bf16x8*)up, w1 = *(const bf16x8*)(up + 8);
        *(bf16x8*)(C.Us + C.rho * S5_UST) = w0; *(bf16x8*)(C.Us + C.rho * S5_UST + 16) = w1; }
    asm volatile("" ::: "memory");
    f32x16 a0 = {}, a1 = {}, a2 = {}, a3 = {};
    mma_tile(a0, C.Us, S5_UST, C.Bb, S5_UST, 16, lane); mma_tile(a1, C.Us, S5_UST, C.Bb + 32 * S5_UST, S5_UST, 16, lane);
    mma_tile(a2, C.Us, S5_UST, C.Bb + 64 * S5_UST, S5_UST, 16, lane); mma_tile(a3, C.Us, S5_UST, C.Bb + 96 * S5_UST, S5_UST, 16, lane);
    float s0r[16], s0i[16], s1r[16], s1i[16];
#pragma unroll
    for (int r = 0; r < 16; ++r) {
        const float n0r = fmaf(C.l0r, x0r, fmaf(-C.l0i, x0i, a0[r])), n0i = fmaf(C.l0r, x0i, fmaf(C.l0i, x0r, a1[r])); x0r = n0r; x0i = n0i; s0r[r] = n0r; s0i[r] = n0i;
        const float n1r = fmaf(C.l1r, x1r, fmaf(-C.l1i, x1i, a2[r])), n1i = fmaf(C.l1r, x1i, fmaf(C.l1i, x1r, a3[r])); x1r = n1r; x1i = n1i; s1r[r] = n1r; s1i[r] = n1i; }
    float z0r = partner32(x0r, hi), z0i = partner32(x0i, hi), z1r = partner32(x1r, hi), z1i = partner32(x1i, hi);
    if (hi == 0) { z0r = 0.f; z0i = 0.f; z1r = 0.f; z1i = 0.f; }
    if (!OUT) {
        x0r += C.q0r * z0r - C.q0i * z0i; x0i += C.q0r * z0i + C.q0i * z0r; x1r += C.q1r * z1r - C.q1i * z1i; x1i += C.q1r * z1i + C.q1i * z1r;
    } else {
#pragma unroll
        for (int r = 0; r < 16; ++r) {
            const float t0r = C.l0r * z0r - C.l0i * z0i, t0i = C.l0r * z0i + C.l0i * z0r; z0r = t0r; z0i = t0i; s0r[r] += t0r; s0i[r] += t0i;
            const float t1r = C.l1r * z1r - C.l1i * z1i, t1i = C.l1r * z1i + C.l1i * z1r; z1r = t1r; z1i = t1i; s1r[r] += t1r; s1i[r] += t1i; }
        x0r = s0r[15]; x0i = s0i[15]; x1r = s1r[15]; x1i = s1i[15];
#pragma unroll
        for (int r = 0; r < 16; ++r) { char* xr_ = C.Xs + (r + 16 * hi) * S5_XST;
            *(bf16_t*)(xr_ + j * 2) = f2bf(s0r[r]); *(bf16_t*)(xr_ + (64 + j) * 2) = f2bf(s0i[r]);
            *(bf16_t*)(xr_ + (32 + j) * 2) = f2bf(s1r[r]); *(bf16_t*)(xr_ + (96 + j) * 2) = f2bf(s1i[r]); }
        asm volatile("" ::: "memory");
        f32x16 acc = {}; mma_tile(acc, C.Xs, S5_XST, C.Cm, S5_XST, 128, lane);
        if (j < 16) {
#pragma unroll
            for (int r = 0; r < 16; ++r) { const int t = crow32(r, hi); const int rt = ((t & 15) & 3) + 8 * ((t & 15) >> 2) + 4 * (t >> 4);
                const float y = acc[r] + C.dsk * bf2f(*(const bf16_t*)(C.Us + rt * S5_UST + j * 2));
                C.ybase[(size_t)(tok0 + t) * 512 + j] = f2bf(gelu_tanh_(y)); } }
        asm volatile("" ::: "memory");
    }
    { const float e0r = partner32(x0r, hi), e0i = partner32(x0i, hi), e1r = partner32(x1r, hi), e1i = partner32(x1i, hi);
      if (hi == 0) { x0r = e0r; x0i = e0i; x1r = e1r; x1i = e1i; } else { x0r = 0.f; x0i = 0.f; x1r = 0.f; x1i = 0.f; } }
}
__device__ __forceinline__ void unit_s5(const Params& P, int layer, int u, char* lds) {
    const int b = u >> 5, g = u & 31, tid = TIDX(), wid = tid >> 6, lane = tid & 63, hi = lane >> 5, j = lane & 31;
    char* Cm = lds;
    char* Bb = Cm + 32 * S5_XST;
    float* ends = (float*)(Bb + 128 * S5_UST);
    char* wbase = (char*)(ends + 8 * 64 * 2) + wid * (32 * S5_XST + 32 * S5_UST);
    const float* sp = P.s5p_() + (size_t)(layer * 32 + g) * S5P_STRIDE;
    __syncthreads();
    for (int i = tid; i < 32 * 128; i += NTHR) { const int c = i >> 7, pp = i & 127; float v = 0.f;
        if (c < 16) v = (pp < 64) ? P.s5_c_re[((size_t)(layer * 32 + g) * 16 + c) * 64 + pp] : -P.s5_c_im[((size_t)(layer * 32 + g) * 16 + c) * 64 + (pp - 64)];
        *(bf16_t*)(Cm + c * S5_XST + pp * 2) = f2bf(v); }
    for (int i = tid; i < 128 * 16; i += NTHR) { const int n = i >> 4, c = i & 15, nt = n >> 5, jj = n & 31, p = (nt >> 1) * 32 + jj;
        *(bf16_t*)(Bb + n * S5_UST + c * 2) = f2bf(sp[256 + (p * 16 + c) * 2 + (nt & 1)]); }
    S5Ctx C; C.Cm = Cm; C.Bb = Bb; C.Xs = wbase; C.Us = wbase + 32 * S5_XST; C.lane = lane; C.hi = hi; C.j = j;
    C.l0r = sp[2 * j]; C.l0i = sp[2 * j + 1]; C.l1r = sp[2 * (32 + j)]; C.l1i = sp[2 * (32 + j) + 1];
    { float q0r = C.l0r, q0i = C.l0i, q1r = C.l1r, q1i = C.l1i;
#pragma unroll
      for (int k = 0; k < 4; ++k) { const float a = q0r * q0r - q0i * q0i, bb = (q0r + q0r) * q0i; q0r = a; q0i = bb; const float c = q1r * q1r - q1i * q1i, d = (q1r + q1r) * q1i; q1r = c; q1i = d; }
      C.q0r = q0r; C.q0i = q0i; C.q1r = q1r; C.q1i = q1i; }
    C.dsk = P.s5_d[layer * 512 + g * 16 + (lane & 15)];
    C.rho = ((j & 15) & 3) + 8 * ((j & 15) >> 2) + 4 * (j >> 4);
    const int tokw = b * SEQ + wid * 512;
    C.ubase = P.p_() + C_SU + g * 16; C.ybase = P.ybuf_() + g * 16;
    float x0r = 0.f, x0i = 0.f, x1r = 0.f, x1i = 0.f;
    __syncthreads();
    for (int sc = 0; sc < 16; ++sc) s5_tile<false>(C, tokw + sc * 32, x0r, x0i, x1r, x1i);
    if (hi == 0) { ends[(wid * 64 + j) * 2] = x0r; ends[(wid * 64 + j) * 2 + 1] = x0i; ends[(wid * 64 + 32 + j) * 2] = x1r; ends[(wid * 64 + 32 + j) * 2 + 1] = x1i; }
    __syncthreads();
    { const float p0r = sp[128 + 2 * j], p0i = sp[128 + 2 * j + 1], p1r = sp[128 + 2 * (32 + j)], p1i = sp[128 + 2 * (32 + j) + 1];
      x0r = 0.f; x0i = 0.f; x1r = 0.f; x1i = 0.f;
      for (int w = 0; w < wid; ++w) { const float e0r = ends[(w * 64 + j) * 2], e0i = ends[(w * 64 + j) * 2 + 1], e1r = ends[(w * 64 + 32 + j) * 2], e1i = ends[(w * 64 + 32 + j) * 2 + 1];
          const float n0r = p0r * x0r - p0i * x0i + e0r, n0i = p0r * x0i + p0i * x0r + e0i, n1r = p1r * x1r - p1i * x1i + e1r, n1i = p1r * x1i + p1i * x1r + e1i;
          x0r = n0r; x0i = n0i; x1r = n1r; x1i = n1i; }
      if (hi) { x0r = 0.f; x0i = 0.f; x1r = 0.f; x1i = 0.f; } }
    for (int sc = 0; sc < 16; ++sc) s5_tile<true>(C, tokw + sc * 32, x0r, x0i, x1r, x1i);
}
constexpr int TOPK = 256;
__device__ __forceinline__ unsigned f2key(float f) { const unsigned u = __float_as_uint(f); return u ^ ((u & 0x80000000u) ? 0xffffffffu : 0x80000000u); }

__device__ __forceinline__ float relu1(float x) { const int b = __float_as_int(x); return __int_as_float(b > 0 ? b : 0); }
#define DSA_MM(acc, rt, kk) acc = __builtin_amdgcn_mfma_f32_32x32x16_bf16(afr[rt][kk], bfr[kk], acc, 0, 0, 0)
#define DSA_HS(acc, rt, q) do { s0 = fmaf(relu1(acc[4 * (q)]), wv[rt][4 * (q)], s0); s1 = fmaf(relu1(acc[4 * (q) + 1]), wv[rt][4 * (q) + 1], s1); \
                                s0 = fmaf(relu1(acc[4 * (q) + 2]), wv[rt][4 * (q) + 2], s0); s1 = fmaf(relu1(acc[4 * (q) + 3]), wv[rt][4 * (q) + 3], s1); } while (0)
#define DSA_SG() do { __builtin_amdgcn_sched_group_barrier(0x8, 1, 0); __builtin_amdgcn_sched_group_barrier(0x2, 8, 0); } while (0)
__device__ __forceinline__ void dsa_score_tile(const bf16x8 (&afr)[4][4], const f32x16 (&wv)[4], const bf16x8 (&bfr)[4], float* sc, int col, int hi) {
    f32x16 accA = {}, accB = {}; asm volatile("" : "+v"(accA), "+v"(accB));
    float s0, s1;
    DSA_MM(accA, 0, 0); DSA_MM(accA, 0, 1); DSA_MM(accA, 0, 2); DSA_MM(accA, 0, 3);
    s0 = 0.f; s1 = 0.f;
    DSA_MM(accB, 1, 0); DSA_HS(accA, 0, 0); DSA_SG(); DSA_MM(accB, 1, 1); DSA_HS(accA, 0, 1); DSA_SG();
    DSA_MM(accB, 1, 2); DSA_HS(accA, 0, 2); DSA_SG(); DSA_MM(accB, 1, 3); DSA_HS(accA, 0, 3); DSA_SG();
    sc[(0 + hi) * 4096 + col] = (s0 + s1) + 0.f;
    accA = (f32x16){}; asm volatile("" : "+v"(accA)); s0 = 0.f; s1 = 0.f;
    DSA_MM(accA, 2, 0); DSA_HS(accB, 1, 0); DSA_SG(); DSA_MM(accA, 2, 1); DSA_HS(accB, 1, 1); DSA_SG();
    DSA_MM(accA, 2, 2); DSA_HS(accB, 1, 2); DSA_SG(); DSA_MM(accA, 2, 3); DSA_HS(accB, 1, 3); DSA_SG();
    sc[(2 + hi) * 4096 + col] = (s0 + s1) + 0.f;
    accB = (f32x16){}; asm volatile("" : "+v"(accB)); s0 = 0.f; s1 = 0.f;
    DSA_MM(accB, 3, 0); DSA_HS(accA, 2, 0); DSA_SG(); DSA_MM(accB, 3, 1); DSA_HS(accA, 2, 1); DSA_SG();
    DSA_MM(accB, 3, 2); DSA_HS(accA, 2, 2); DSA_SG(); DSA_MM(accB, 3, 3); DSA_HS(accA, 2, 3); DSA_SG();
    sc[(4 + hi) * 4096 + col] = (s0 + s1) + 0.f;
    s0 = 0.f; s1 = 0.f;
    DSA_HS(accB, 3, 0); DSA_HS(accB, 3, 1); DSA_HS(accB, 3, 2); DSA_HS(accB, 3, 3);
    sc[(6 + hi) * 4096 + col] = (s0 + s1) + 0.f;
}
#define DSA_CNT4(K0, K1, K2, K3) asm volatile( \
    "v_cmp_ge_u32_e64 %[m0], %[k0], %[cd]\n\tv_cmp_ge_u32_e64 %[m1], %[k1], %[cd]\n\tv_cmp_ge_u32_e64 %[m2], %[k2], %[cd]\n\tv_cmp_ge_u32_e64 %[m3], %[k3], %[cd]\n\t" \
    "v_addc_co_u32_e64 %[a0], %[m0], %[a0], 0, %[m0]\n\tv_addc_co_u32_e64 %[a1], %[m1], %[a1], 0, %[m1]\n\t" \
    "v_addc_co_u32_e64 %[a0], %[m2], %[a0], 0, %[m2]\n\tv_addc_co_u32_e64 %[a1], %[m3], %[a1], 0, %[m3]" \
    : [a0] "+v"(c0), [a1] "+v"(c1), [m0] "=&s"(sm0), [m1] "=&s"(sm1), [m2] "=&s"(sm2), [m3] "=&s"(sm3) \
    : [k0] "v"(K0), [k1] "v"(K1), [k2] "v"(K2), [k3] "v"(K3), [cd] "v"(cand))
#define DSA_CNT8(J0) do { DSA_CNT4(key[(J0)], key[(J0) + 1], key[(J0) + 2], key[(J0) + 3]); DSA_CNT4(key[(J0) + 4], key[(J0) + 5], key[(J0) + 6], key[(J0) + 7]); } while (0)

__device__ __forceinline__ void unit_dsa_index(const Params& P, int u, char* lds) {
    const int b = u & 3, t0 = (511 - (u >> 2)) * 8;
    const int tid = TIDX(), wid = tid >> 6, lane = tid & 63, r32 = lane & 31, hi = lane >> 5;
    float* sc = (float*)lds;
    const bf16_t* pb = P.p_() + (size_t)b * SEQ * NPAD;
    __syncthreads();
    {
        bf16x8 afr[4][4]; f32x16 wv[4];
        const int qsel = (r32 >> 2) & 1, head = (r32 & 3) + 4 * (r32 >> 3);
#pragma unroll
        for (int rt = 0; rt < 4; ++rt) { const bf16_t* qp = pb + (size_t)(t0 + 2 * rt + qsel) * NPAD + C_DIQ + head * 64 + hi * 8;
#pragma unroll
            for (int kk = 0; kk < 4; ++kk) afr[rt][kk] = *(const bf16x8*)(qp + kk * 16);
            const float* wp = P.iw_() + (size_t)(b * SEQ + t0 + 2 * rt + hi) * 16;
#pragma unroll
            for (int i = 0; i < 4; ++i) { const f32x4 w4 = *(const f32x4*)(wp + 4 * i); wv[rt][4 * i] = w4[0]; wv[rt][4 * i + 1] = w4[1]; wv[rt][4 * i + 2] = w4[2]; wv[rt][4 * i + 3] = w4[3]; } }
        const int ntile = (t0 + 7) / 32 + 1;
        const bf16_t* kp = P.ikc_() + (size_t)(b * (SEQ / 32)) * 2048 + lane * 8;
        bf16x8 b0[4], b1[4], b2[4];
#define DSA_LDB(dst, K) do { const bf16_t* kq_ = kp + (size_t)(wid + 8 * (K)) * 2048; _Pragma("unroll") for (int kk = 0; kk < 4; ++kk) dst[kk] = *(const bf16x8*)(kq_ + kk * 512); } while (0)
#define DSA_TILE(buf, K) dsa_score_tile(afr, wv, buf, sc, (wid + 8 * (K)) * 32 + r32, hi)
        const int nk = (ntile - wid + 7) >> 3;
        const int kl = nk > 0 ? nk - 1 : 0;
#define DSA_MIN(a) ((a) < kl ? (a) : kl)
        DSA_LDB(b0, DSA_MIN(0)); DSA_LDB(b1, DSA_MIN(1));
        int k = 0;
        for (; k + 3 <= nk; k += 3) {
            DSA_LDB(b2, k + 2); DSA_TILE(b0, k);
            DSA_LDB(b0, DSA_MIN(k + 3)); DSA_TILE(b1, k + 1);
            DSA_LDB(b1, DSA_MIN(k + 4)); DSA_TILE(b2, k + 2);
        }
        if (k < nk) DSA_TILE(b0, k);
        if (k + 1 < nk) DSA_TILE(b1, k + 1);
#undef DSA_TILE
#undef DSA_MIN
#undef DSA_TILE
#undef DSA_LDB
    }
    __syncthreads();
    {
        const int t = t0 + wid; const float* srow = sc + wid * 4096;
        unsigned key[64];
#pragma unroll
        for (int j = 0; j < 64; ++j) { const int s = j * 64 + lane; key[j] = (s <= t) ? f2key(srow[s]) : 0u; }
        unsigned long long* mout = P.mask_() + (size_t)(b * SEQ + t) * 64;
        unsigned long long myword = 0ull;
        if (t + 1 <= TOPK) {
#pragma unroll
            for (int j = 0; j < 64; ++j) { const unsigned long long m = __ballot(j * 64 + lane <= t); if (lane == j) myword = m; }
        } else {
            const int ngrp = t / 512 + 1;
            unsigned* hist = (unsigned*)(sc + wid * 4096);
            asm volatile("" ::: "memory");
            { const u32x4 zz4 = {0u, 0u, 0u, 0u};
#pragma unroll
              for (int i = 0; i < 16; ++i) *(u32x4*)(hist + (i * 64 + lane) * 4) = zz4; }
            asm volatile("" ::: "memory");
#define DSA_H8(J0) do { _Pragma("unroll") for (int jj = 0; jj < 8; ++jj) atomicAdd(hist + (key[(J0) + jj] >> 20), 1u); } while (0)
            DSA_H8(0);
            if (ngrp > 1) DSA_H8(8);
            if (ngrp > 2) DSA_H8(16);
            if (ngrp > 3) DSA_H8(24);
            if (ngrp > 4) DSA_H8(32);
            if (ngrp > 5) DSA_H8(40);
            if (ngrp > 6) DSA_H8(48);
            if (ngrp > 7) DSA_H8(56);
#undef DSA_H8
            asm volatile("" ::: "memory");
#define DSA_SUFFIX(s) do { _Pragma("unroll") for (int o = 1; o < 64; o <<= 1) { unsigned t_ = (unsigned)__builtin_amdgcn_ds_bpermute(((lane + o) & 63) << 2, (int)(s)); (s) += (lane + o < 64) ? t_ : 0u; } } while (0)
            unsigned mine = 0u;
#pragma unroll
            for (int i = 0; i < 16; ++i) { const u32x4 v4 = *(const u32x4*)(hist + lane * 64 + ((i + lane) & 15) * 4); mine += (v4[0] + v4[1]) + (v4[2] + v4[3]); }
            unsigned suf = mine; DSA_SUFFIX(suf);
            const unsigned long long mL = __ballot(suf - mine < (unsigned)TOPK && suf >= (unsigned)TOPK);
            const int Ls = (int)__builtin_ctzll(mL);
            const unsigned cntA = (unsigned)__builtin_amdgcn_readlane((int)(suf - mine), Ls);
            unsigned h2 = hist[Ls * 64 + lane]; unsigned suf2 = h2; DSA_SUFFIX(suf2);
            const unsigned long long mB = __ballot(cntA + suf2 - h2 < (unsigned)TOPK && cntA + suf2 >= (unsigned)TOPK);
            const int Bs = (int)__builtin_ctzll(mB);
            const unsigned bstar = (unsigned)(Ls * 64 + Bs);
            const unsigned cntAbove = cntA + (unsigned)__builtin_amdgcn_readlane((int)(suf2 - h2), Bs);
            const unsigned inbin = (unsigned)__builtin_amdgcn_readlane((int)h2, Bs);
#undef DSA_SUFFIX
            unsigned T = bstar << 20; int cntT = (int)(cntAbove + inbin);
            if (cntT != TOPK) {
                asm volatile("" ::: "memory");
                int nslot = 0;
#pragma unroll
                for (int j = 0; j < 64; ++j) { if ((key[j] >> 20) == bstar) { hist[nslot * 64 + lane] = key[j]; ++nslot; } }
                asm volatile("" ::: "memory");
                int R = nslot;
#pragma unroll
                for (int o = 32; o >= 1; o >>= 1) { const int other = __builtin_amdgcn_ds_bpermute(((lane ^ o) << 2), R); R = other > R ? other : R; }
                R = __builtin_amdgcn_readfirstlane(R);
                if (R <= 8) {
                    unsigned c[8];
#pragma unroll
                    for (int r = 0; r < 8; ++r) c[r] = (r < nslot) ? hist[r * 64 + lane] : 0u;
                    for (int bit = 19; bit >= 0; --bit) {
                        const unsigned cand = T | (1u << bit); int cnt = (int)cntAbove;
#pragma unroll
                        for (int r = 0; r < 8; ++r) cnt += __popcll(__ballot(c[r] >= cand));
                        if (cnt >= TOPK) { T = cand; cntT = cnt; if (cnt == TOPK) break; }
                    }
                } else {
                    for (int bit = 19; bit >= 0; --bit) {
                        const unsigned cand = T | (1u << bit); unsigned c0 = 0, c1 = 0; unsigned long long sm0, sm1, sm2, sm3;
                        DSA_CNT8(0);
                        if (ngrp > 1) DSA_CNT8(8);
                        if (ngrp > 2) DSA_CNT8(16);
                        if (ngrp > 3) DSA_CNT8(24);
                        if (ngrp > 4) DSA_CNT8(32);
                        if (ngrp > 5) DSA_CNT8(40);
                        if (ngrp > 6) DSA_CNT8(48);
                        if (ngrp > 7) DSA_CNT8(56);
                        const int cl = (int)(c0 + c1);
                        int cnt = 0;
#pragma unroll
                        for (int bb = 0; bb < 7; ++bb) cnt += __popcll(__ballot((cl >> bb) & 1)) << bb;
                        if (cnt >= TOPK) { T = cand; cntT = cnt; if (cnt == TOPK) break; }
                    }
                }
            }
            if (cntT == TOPK) {
#pragma unroll
                for (int j = 0; j < 64; ++j) { const unsigned long long m = __ballot(key[j] >= T); if (lane == j) myword = m; }
            } else {
                int ngt = 0;
#pragma unroll
                for (int j = 0; j < 64; ++j) ngt += __popcll(__ballot(key[j] > T));
                int need = TOPK - ngt;
#pragma unroll
                for (int j = 0; j < 64; ++j) { const unsigned long long eq = __ballot(key[j] == T), gt = __ballot(key[j] > T);
                    const int ne = __popcll(eq); unsigned long long take = eq;
                    if (ne > need) { take = 0ull; int left = need; unsigned long long e2 = eq;
                        while (left > 0) { const unsigned long long lowbit = e2 & (0ull - e2); take |= lowbit; e2 ^= lowbit; --left; } }
                    need -= (ne > need) ? need : ne;
                    const unsigned long long m = gt | take; if (lane == j) myword = m; }
            }
        }
        mout[lane] = myword;
    }
}

struct DsaOutRow { const bf16_t* zb; bf16_t* gb; int wid;
    __device__ __forceinline__ const bf16_t* zrow(int r) const { const int rho = wid * 32 + r; return zb + (size_t)(rho >> 2) * NPAD + (rho & 3) * 128; }
    __device__ __forceinline__ bf16_t* grow(int r) const { const int rho = wid * 32 + r; return gb + (size_t)(rho >> 2) * MIX + (rho & 3) * 128; } };
__device__ __forceinline__ void unit_dsa_attn(const Params& P, int u, char* lds) {
    const int b = u & 3, qb = 63 - (u >> 2), t0 = qb * 64, tokb = b * SEQ;
    const int wid = TIDX() >> 6, lane = TIDX() & 63, r32 = lane & 31, hi = lane >> 5;
    const int rho = wid * 32 + r32, tq = t0 + (rho >> 2), hq = rho & 3;
    const bf16_t* Qw = P.p_() + (size_t)(tokb + tq) * NPAD + C_DQ + hq * 128 + hi * 8;
    const bf16_t* Kh = P.kvc_() + (size_t)tokb * 256;
    const unsigned moff = (unsigned)(tokb + tq) * 512u;
    DsaOutRow ow; ow.zb = P.p_() + (size_t)(tokb + t0) * NPAD + C_DZ; ow.gb = P.xn_() + (size_t)(tokb + t0) * MIX + 1024; ow.wid = wid;
    const int NT = (qb + 2) & ~1;
    att::attn_body<true, 256, 128, DsaOutRow>(Qw, Kh, NT, P.mask_(), moff, ow, lds);
}
__device__ __forceinline__ void phase_gemm_glu(const Params& P, int layer, char* lds) {
    pg8::Gemm g; g.A = P.ybuf_(); g.Bt = P.WgluT_() + (size_t)layer * 512 * 512; g.M = NTOK; g.N = 512; g.K = 512;
    pg8::StaticOrder S; S.init(g.M, g.N, (int)gridDim.x, (int)blockIdx.x);
    pg8::EpiGlu E; E.Y = P.ybuf_(); E.ldy = 512; E.O = P.ocat_(); E.ldo = MIX; E.ooff = 512;
    pg8::gemm_phase<pg8::EpiGlu, pg8::StaticOrder, false>((PG8_LAS unsigned char*)lds, g, S, E, nullptr);
}

constexpr int CTL_Q0 = 4096;
struct OneUnit { int pm, pn; __device__ __forceinline__ bool next(int i, pg8::Unit& u) const { if (i) return false; u.pm = pm; u.pn = pn; return true; }
    __device__ __forceinline__ void a_ready(const pg8::Unit&) const {} __device__ __forceinline__ void done(const pg8::Unit&) const {} };
__device__ __forceinline__ int q_issue(unsigned* ctr) { return (int)__hip_atomic_fetch_add(ctr, 1u, __ATOMIC_RELAXED, __HIP_MEMORY_SCOPE_AGENT); }
#define Q_LOOP_BEGIN(ctr, total)  { unsigned* q_ctr_ = (ctr); const int q_total_ = (total); volatile int* q_b_ = (volatile int*)(lds + LDS_TAIL + 16); \
    for (;;) { __syncthreads(); if (TIDX() == 0) *q_b_ = q_issue(q_ctr_); __syncthreads(); const int item = __builtin_amdgcn_readfirstlane(*q_b_); if (item >= q_total_) break;
#define Q_LOOP_END  } }
__device__ __forceinline__ void unit_glu(const Params& P, int layer, int u, char* lds) {
    pg8::Gemm g; g.A = P.ybuf_(); g.Bt = P.WgluT_() + (size_t)layer * 512 * 512; g.M = NTOK; g.N = 512; g.K = 512;
    OneUnit S; S.pm = u >> 1; S.pn = u & 1;
    pg8::EpiGluGate E; E.Y = P.ybuf_(); E.Pz = P.p_(); E.G = P.xn_();
    pg8::gemm_phase<pg8::EpiGluGate, OneUnit, false>((PG8_LAS unsigned char*)lds, g, S, E, nullptr);
}
constexpr int LDS_TAIL = LDS_BYTES - 64;

__global__ __launch_bounds__(NTHR, 2) void k_mega(Params P) {
    extern __shared__ __attribute__((aligned(16))) char lds[];
    if (TIDX() == 0) *(uint4*)(lds + LDS_TAIL) = make_uint4(0u, 0u, 0u, 0u);
    __syncthreads();
    XcdBarrier bar = xcd_barrier_post(P.ctl_(), (volatile LAS unsigned*)(lds + LDS_TAIL));
    const int G = gridDim.x, B = blockIdx.x;
    phase_prologue1(P, lds); phase_rope_table(P); phase_s5_params(P); phase_rmsnorm_x(P, 0);
    xcd_barrier(bar);
    for (int layer = 0; layer < DEPTH; ++layer) {
        if (layer > 0) { phase_rmsnorm_x(P, layer); xcd_barrier(bar); }
        phase_gemm_in(P, layer, lds);
        if (layer == 0) phase_gemm_kv(P, lds);
        xcd_barrier(bar);
        phase_prep(P, layer);
        if (layer == 0) phase_memk_norm(P);
        for (int u = B; u < 256; u += G) unit_gla_a4(P, layer, u, lds);
        xcd_barrier(bar);
        Q_LOOP_BEGIN(P.ctl_() + CTL_Q0 + 64 * (layer * 2), 128 + 2048 + 256 + 256)
            if (item < 128) unit_s5(P, layer, item, lds);
            else if (item < 2176) unit_dsa_index(P, item - 128, lds);
            else if (item < 2432) unit_mem_attn(P, layer, item - 2176, lds);
            else gla_scan_slice(P, (item - 2432) * NTHR + TIDX());
        Q_LOOP_END
        xcd_barrier(bar);
        Q_LOOP_BEGIN(P.ctl_() + CTL_Q0 + 64 * (layer * 2 + 1), 256 + 256 + 128)
            if (item < 256) unit_dsa_attn(P, item, lds);
            else if (item < 512) unit_gla_c4(P, layer, item - 256, lds);
            else unit_glu(P, layer, item - 512, lds);
        Q_LOOP_END
        xcd_barrier(bar);
        phase_gemm_out(P, layer, lds);
        xcd_barrier(bar);
    }
}

extern "C" void kernel_launch(void* const* d_in, const int* in_sizes, int n_in, void* d_out, int out_size, void* d_ws, size_t ws_size, hipStream_t stream) {
    if (n_in != 24 || ws_size < WS_END) { fprintf(stderr, "kernel_launch: unexpected n_in %d or ws_size %zu (< %zu)\n", n_in, ws_size, (size_t)WS_END); return; }
    Params P; memset(&P, 0, sizeof(P));
    P.x = (const float*)d_in[0]; P.mem = (const float*)d_in[1]; P.pos = (const int*)d_in[2]; P.ln_gain = (const float*)d_in[3]; P.w_in = (const float*)d_in[4];
    P.gla_w_up = (const float*)d_in[5]; P.gla_b_up = (const float*)d_in[6]; P.s5_a_re = (const float*)d_in[7]; P.s5_a_im = (const float*)d_in[8]; P.s5_log_step = (const float*)d_in[9];
    P.s5_b_re = (const float*)d_in[10]; P.s5_b_im = (const float*)d_in[11]; P.s5_c_re = (const float*)d_in[12]; P.s5_c_im = (const float*)d_in[13]; P.s5_d = (const float*)d_in[14];
    P.s5_w_glu = (const float*)d_in[15]; P.dsa_q_norm = (const float*)d_in[16]; P.dsa_k_norm = (const float*)d_in[17]; P.mem_norm = (const float*)d_in[18]; P.w_mem_kv = (const float*)d_in[19];
    P.mem_q_norm = (const float*)d_in[20]; P.mem_k_norm = (const float*)d_in[21]; P.out_norm = (const float*)d_in[22]; P.w_out = (const float*)d_in[23];
    P.out = (float*)d_out;
    char* ws = (char*)d_ws; P.ws = ws;
    static int grid = 0;
    if (!grid) {
        int dev = 0, cus = 0, per_cu = 0;
        (void)hipGetDevice(&dev); (void)hipDeviceGetAttribute(&cus, hipDeviceAttributeMultiprocessorCount, dev);
        (void)hipFuncSetAttribute((const void*)k_mega, hipFuncAttributeMaxDynamicSharedMemorySize, LDS_BYTES);
        (void)hipOccupancyMaxActiveBlocksPerMultiprocessor(&per_cu, (const void*)k_mega, NTHR, LDS_BYTES);
        if (per_cu < 1) fprintf(stderr, "kernel_launch: occupancy query reports %d blocks per CU\n", per_cu);
        grid = cus > 0 ? cus : 256;
    }
    (void)hipMemsetAsync(ws + WS_CTL, 0, CTL_BYTES, stream);
    hipLaunchKernelGGL(k_mega, dim3(grid), dim3(NTHR), LDS_BYTES, stream, P);
}
```

```cpp
#include <hip/hip_runtime.h>
#include <stdint.h>
#include <stdio.h>
#include <string.h>

constexpr int NB = 4, SEQ = 4096, NTOK = NB * SEQ, DM = 2048, DEPTH = 4, MEML = 256;
constexpr int NIN = 5984, NPAD = 6144, MIX = 2048;
constexpr int C_GQ = 0, C_GK = 256, C_GV = 512, C_GLR = 1024, C_GZ = 1040, C_SU = 1552, C_SZ = 2064, C_DQ = 2576, C_DK = 3088, C_DV = 3216,
              C_DIQ = 3344, C_DIK = 4368, C_DIW = 4432, C_DZ = 4448, C_MQ = 4960, C_MZ = 5472;
constexpr float EPS = 1e-6f;
constexpr int NTHR = 512;
constexpr int LDS_BYTES = 147456;

typedef unsigned short bf16_t;
typedef short bf16x8 __attribute__((ext_vector_type(8)));
typedef short s16x4 __attribute__((ext_vector_type(4)));
typedef float f32x4 __attribute__((ext_vector_type(4)));
typedef float f32x8 __attribute__((ext_vector_type(8)));
typedef float f32x16 __attribute__((ext_vector_type(16)));
typedef unsigned u32x4 __attribute__((ext_vector_type(4)));
typedef unsigned u32x2 __attribute__((ext_vector_type(2)));
#define LAS __attribute__((address_space(3)))

__device__ __forceinline__ float bf2f(bf16_t b) { return __uint_as_float(((unsigned)b) << 16); }
__device__ __forceinline__ bf16_t f2bf(float f) { unsigned u = __float_as_uint(f); u += 0x7FFFu + ((u >> 16) & 1u); return (bf16_t)(u >> 16); }
__device__ __forceinline__ unsigned pk2bf(float lo, float hi) { return (unsigned)f2bf(lo) | ((unsigned)f2bf(hi) << 16); }
__device__ __forceinline__ float sigmoidf_(float x) { return 1.f / (1.f + __expf(-x)); }
__device__ __forceinline__ float siluf_(float x) { return x / (1.f + __expf(-x)); }

__device__ __forceinline__ int TIDX() { int t = (int)threadIdx.x; asm volatile("" : "+v"(t)); return t; }
__device__ __forceinline__ float shx(float v, int m) { const int src = ((TIDX() & 63) ^ m) << 2; return __int_as_float(__builtin_amdgcn_ds_bpermute(src, __float_as_int(v))); }
__device__ __forceinline__ float wave_sum(float v) {
#pragma unroll
    for (int o = 32; o >= 1; o >>= 1) v += shx(v, o);
    return v;
}
__device__ __forceinline__ void ld8f(const bf16_t* p, float (&v)[8]) { const u32x4 w = *(const u32x4*)p;
#pragma unroll
    for (int j = 0; j < 4; ++j) { v[2 * j] = __uint_as_float(w[j] << 16); v[2 * j + 1] = __uint_as_float(w[j] & 0xffff0000u); } }
__device__ __forceinline__ void st8f(bf16_t* p, const float (&v)[8]) { u32x4 w; w.x = pk2bf(v[0], v[1]); w.y = pk2bf(v[2], v[3]); w.z = pk2bf(v[4], v[5]); w.w = pk2bf(v[6], v[7]); *(u32x4*)p = w; }
__device__ __forceinline__ float f2bf_f(float f) { return bf2f(f2bf(f)); }
#define XB_TMO      128
#define XB_XCNT(j)  (256  + 64 * (j))
#define XB_XSUB(j)  (1280 + 64 * (j))
#define XB_XGEN(j)  (2304 + 64 * (j))
#define XB_TOP      3328
#define XB_TOPGEN   3392
#define XCD_BAR_WORDS 3456
#define XB_SPIN_CAP (1u << 18)

__device__ __forceinline__ unsigned xb_ld(unsigned* p)              { return __hip_atomic_load(p, __ATOMIC_RELAXED, __HIP_MEMORY_SCOPE_AGENT); }
__device__ __forceinline__ unsigned xb_add(unsigned* p, unsigned v) { return __hip_atomic_fetch_add(p, v, __ATOMIC_RELAXED, __HIP_MEMORY_SCOPE_AGENT); }
__device__ __forceinline__ unsigned xb_xcc_id() { return (unsigned)__builtin_amdgcn_s_getreg((3 << 11) | 20) & 0xFu; }
#define XB_SPIN(cond, bar) do { unsigned _sp = 0; while (cond) { __builtin_amdgcn_s_sleep(1); \
    if ((++_sp & 255u) == 0u) { if (xb_ld(&(bar)[XB_TMO])) break; if (_sp > XB_SPIN_CAP) { atomicAdd(&(bar)[XB_TMO], 1u); break; } } } } while (0)

struct XcdBarrier {
    unsigned* bar; unsigned x;
    volatile LAS unsigned* st;
};

__device__ __forceinline__ XcdBarrier xcd_barrier_post(unsigned* bar, volatile LAS unsigned* st) {
    XcdBarrier b; b.bar = bar; b.x = xb_xcc_id(); b.st = st;
    if (TIDX() == 0) (void)xb_add(&bar[XB_XCNT(b.x)], 1u);
    return b;
}
__device__ __forceinline__ void xcd_barrier_complete(unsigned* bar, unsigned x, unsigned& nloc, unsigned& nx) {
    const unsigned G = gridDim.x * gridDim.y * gridDim.z;
    unsigned sum, cnt, mine, sp = 0u;
    for (;;) {
        sum = 0u; cnt = 0u; mine = 0u;
#pragma unroll
        for (unsigned j = 0; j < 16; ++j) { const unsigned c = xb_ld(&bar[XB_XCNT(j)]); sum += c; cnt += (c > 0u) ? 1u : 0u; mine = (j == x) ? c : mine; }
        if (sum == G) break;
        __builtin_amdgcn_s_sleep(1);
        if ((++sp & 255u) == 0u) { if (xb_ld(&bar[XB_TMO])) break; if (sp > XB_SPIN_CAP) { atomicAdd(&bar[XB_TMO], 1u); break; } }
    }
    nloc = mine > 0u ? mine : 1u; nx = cnt > 0u ? cnt : 1u;
}

__device__ __forceinline__ void xcd_barrier(const XcdBarrier& b) {
    asm volatile("s_waitcnt vmcnt(0)" ::: "memory");
    __syncthreads();
    if (TIDX() == 0) {
        unsigned* bar = b.bar; const unsigned bx = xb_xcc_id();
        __builtin_amdgcn_s_waitcnt(0);
        unsigned nloc = b.st[0], nx = b.st[1];
        if (nloc == 0u) { xcd_barrier_complete(bar, bx, nloc, nx); b.st[0] = nloc; b.st[1] = nx; }
        const unsigned old = xb_add(&bar[XB_XSUB(bx)], 1u);
        const unsigned gen = old / nloc;
        if (old + 1u == (gen + 1u) * nloc) {
            __builtin_amdgcn_fence(__ATOMIC_RELEASE, "agent");
            asm volatile("s_waitcnt vmcnt(0)" ::: "memory");
            const unsigned og = xb_add(&bar[XB_TOP], 1u);
            const unsigned tg = og / nx;
            if (og + 1u == (tg + 1u) * nx) xb_add(&bar[XB_TOPGEN], 1u);
            else XB_SPIN(xb_ld(&bar[XB_TOPGEN]) == tg, bar);
            __builtin_amdgcn_fence(__ATOMIC_ACQUIRE, "agent");
            xb_add(&bar[XB_XGEN(bx)], 1u);
            asm volatile("s_waitcnt vmcnt(0)" ::: "memory");
        } else {
            XB_SPIN(xb_ld(&bar[XB_XGEN(bx)]) == gen, bar);
            __builtin_amdgcn_fence(__ATOMIC_ACQUIRE, "agent");
            asm volatile("s_waitcnt vmcnt(0)" ::: "memory");
        }
    }
    __syncthreads();
}
namespace pg8 {
#define PG8_LAS __attribute__((address_space(3)))
typedef float f32x2 __attribute__((ext_vector_type(2)));
typedef unsigned u32x4 __attribute__((ext_vector_type(4)));
constexpr int BM = 256, BK = 64, HALF = 128, HTB = HALF * BK * 2  , STAGE_BYTES = 8 * HTB, NXCD = 8, WGM = 8;

__host__ __device__ __forceinline__ int lds_byte(int r, int c) { const int st = (r >> 4) * 2 + (c >> 5), rr = r & 15, cc = c & 31, ob = rr * 64 + cc * 2; return st * 1024 + (ob ^ (((ob >> 9) & 1) << 5)); }
__host__ __device__ __forceinline__ void stage_rc(int b, int& R, int& C) { const int st = b / 1024, sb = b % 1024, swz = sb ^ (((sb >> 9) & 1) << 5); R = (st >> 1) * 16 + swz / 64; C = (st & 1) * 32 + (swz % 64) / 2; }
__host__ __device__ __forceinline__ int perm32(int rho) { const int n = rho >> 4, i = rho & 15; return 8 * (i >> 2) + 4 * n + (i & 3); }

struct Unit { int pm, pn; };
struct Gemm { const bf16_t* A; const bf16_t* Bt; int M, N, K; };

struct StaticOrder {
    int nM, nN, nwg, G, c;
    __host__ __device__ void init(int M, int N, int G_, int c_) { nM = M / BM; nN = N / BM; nwg = nM * nN; G = G_; c = c_; }
    __host__ __device__ bool next(int i, Unit& u) const {
        const long L = (long)i * G + c; if (L >= nwg) return false;
        int wgid = (int)L; { const int q = nwg / NXCD, r = nwg % NXCD, xcd = wgid % NXCD, off = wgid / NXCD; wgid = (xcd < r ? xcd * (q + 1) : r * (q + 1) + (xcd - r) * q) + off; }
        const int nig = WGM * nN, gid = wgid / nig, fm = gid * WGM, gsz = (nM - fm) < WGM ? (nM - fm) : WGM;
        u.pm = fm + ((wgid % nig) % gsz); u.pn = (wgid % nig) / gsz; return true;
    }
    __device__ __forceinline__ void a_ready(const Unit&) const {}
    __device__ __forceinline__ void done(const Unit&) const {}
};
__device__ __forceinline__ unsigned cvt_pk_bf16(float lo, float hi) { unsigned r; asm volatile("v_cvt_pk_bf16_f32 %0, %1, %2" : "=v"(r) : "v"(lo), "v"(hi)); return r; }
struct EpiBf16Plain {
    static constexpr bool PERM = true, AFTER_DRAIN = false;
    bf16_t* O; int ldc;
    __device__ __forceinline__ void operator()(const f32x4 (&acc)[2][2][4][2], const Unit& u, int wr, int wc, int fr, int fq) const {
        const int row0 = u.pm * BM + wr * 64 + fr, col0 = u.pn * BM + wc * 32 + 8 * fq;
#pragma unroll
        for (int ai = 0; ai < 2; ++ai)
#pragma unroll
            for (int m = 0; m < 4; ++m) { bf16_t* rowp = O + (size_t)(row0 + ai * HALF + m * 16) * ldc + col0;
#pragma unroll
                for (int bj = 0; bj < 2; ++bj) { const f32x4 v0 = acc[ai][bj][m][0], v1 = acc[ai][bj][m][1];
                    u32x4 w; w.x = cvt_pk_bf16(v0[0], v0[1]); w.y = cvt_pk_bf16(v0[2], v0[3]); w.z = cvt_pk_bf16(v1[0], v1[1]); w.w = cvt_pk_bf16(v1[2], v1[3]);
                    *(u32x4*)(rowp + bj * HALF) = w; } }
    }
};
struct EpiResid {
    static constexpr bool PERM = false, AFTER_DRAIN = false;
    const float* R; float* C; int ldc;
    __device__ __forceinline__ void operator()(const f32x4 (&acc)[2][2][4][2], const Unit& u, int wr, int wc, int fr, int fq) const {
        const int row0 = u.pm * BM + wr * 64 + fr, col0 = u.pn * BM + wc * 32 + 4 * fq;
#pragma unroll
        for (int ai = 0; ai < 2; ++ai)
#pragma unroll
            for (int m = 0; m < 4; ++m) { const size_t off = (size_t)(row0 + ai * HALF + m * 16) * ldc + col0;
#pragma unroll
                for (int bj = 0; bj < 2; ++bj)
#pragma unroll
                    for (int n = 0; n < 2; ++n) { const f32x4 r = *(const f32x4*)(R + off + bj * HALF + n * 16); *(f32x4*)(C + off + bj * HALF + n * 16) = acc[ai][bj][m][n] + r; } }
    }
};
struct EpiResidMix {
    static constexpr bool PERM = true, AFTER_DRAIN = false;
    const void* R; void* C; int ldc; int r16, c16;
    __device__ __forceinline__ void operator()(const f32x4 (&acc)[2][2][4][2], const Unit& u, int wr, int wc, int fr, int fq) const {
        const int row0 = u.pm * BM + wr * 64 + fr, col0 = u.pn * BM + wc * 32 + 8 * fq;
#pragma unroll
        for (int ai = 0; ai < 2; ++ai)
#pragma unroll
            for (int m = 0; m < 4; ++m) { const size_t off = (size_t)(row0 + ai * HALF + m * 16) * ldc + col0;
                f32x4 r0[2], r1[2];
                if (r16) {
#pragma unroll
                    for (int bj = 0; bj < 2; ++bj) { const u32x4 w = *(const u32x4*)((const bf16_t*)R + off + bj * HALF);
                        r0[bj] = f32x4{__uint_as_float(w.x << 16), __uint_as_float(w.x & 0xffff0000u), __uint_as_float(w.y << 16), __uint_as_float(w.y & 0xffff0000u)};
                        r1[bj] = f32x4{__uint_as_float(w.z << 16), __uint_as_float(w.z & 0xffff0000u), __uint_as_float(w.w << 16), __uint_as_float(w.w & 0xffff0000u)}; }
                } else {
#pragma unroll
                    for (int bj = 0; bj < 2; ++bj) { r0[bj] = *(const f32x4*)((const float*)R + off + bj * HALF); r1[bj] = *(const f32x4*)((const float*)R + off + bj * HALF + 4); }
                }
#pragma unroll
                for (int bj = 0; bj < 2; ++bj) { const f32x4 v0 = acc[ai][bj][m][0] + r0[bj], v1 = acc[ai][bj][m][1] + r1[bj];
                    if (c16) { u32x4 w; w.x = cvt_pk_bf16(v0[0], v0[1]); w.y = cvt_pk_bf16(v0[2], v0[3]); w.z = cvt_pk_bf16(v1[0], v1[1]); w.w = cvt_pk_bf16(v1[2], v1[3]);
                        *(u32x4*)((bf16_t*)C + off + bj * HALF) = w; }
                    else { *(f32x4*)((float*)C + off + bj * HALF) = v0; *(f32x4*)((float*)C + off + bj * HALF + 4) = v1; } } }
    }
};
struct EpiGlu {
    static constexpr bool PERM = true, AFTER_DRAIN = false;
    const bf16_t* Y; int ldy; bf16_t* O; int ldo; int ooff;
    __device__ __forceinline__ void operator()(const f32x4 (&acc)[2][2][4][2], const Unit& u, int wr, int wc, int fr, int fq) const {
        const int row0 = u.pm * BM + wr * 64 + fr, col0 = u.pn * BM + wc * 32 + 8 * fq;
#pragma unroll
        for (int ai = 0; ai < 2; ++ai)
#pragma unroll
            for (int m = 0; m < 4; ++m) { const int row = row0 + ai * HALF + m * 16;
#pragma unroll
                for (int bj = 0; bj < 2; ++bj) { const f32x4 v0 = acc[ai][bj][m][0], v1 = acc[ai][bj][m][1];
                    const u32x4 yw = *(const u32x4*)(Y + (size_t)row * ldy + col0 + bj * HALF);
                    float y[8], g[8];
#pragma unroll
                    for (int j = 0; j < 4; ++j) { y[2 * j] = __uint_as_float(yw[j] << 16); y[2 * j + 1] = __uint_as_float(yw[j] & 0xffff0000u); }
#pragma unroll
                    for (int j = 0; j < 4; ++j) { g[j] = 1.f / (1.f + __expf(-v0[j])); g[4 + j] = 1.f / (1.f + __expf(-v1[j])); }
                    u32x4 w; w.x = cvt_pk_bf16(y[0] * g[0], y[1] * g[1]); w.y = cvt_pk_bf16(y[2] * g[2], y[3] * g[3]); w.z = cvt_pk_bf16(y[4] * g[4], y[5] * g[5]); w.w = cvt_pk_bf16(y[6] * g[6], y[7] * g[7]);
                    *(u32x4*)(O + (size_t)row * ldo + ooff + col0 + bj * HALF) = w; } }
    }
};
struct EpiGluGate {
    static constexpr bool PERM = true, AFTER_DRAIN = true;
    const bf16_t* Y; const bf16_t* Pz; bf16_t* G;
    __device__ __forceinline__ void fused(const f32x4 (&acc)[2][2][4][2], const Unit& u, int wr, int wc, int fr, int fq, PG8_LAS unsigned char* lds, int wid, int lane) const {
        constexpr int TS = 528;
        const int row0 = wr * 64 + fr, col0 = wc * 32 + 8 * fq;
#pragma unroll
        for (int ai = 0; ai < 2; ++ai)
#pragma unroll
            for (int m = 0; m < 4; ++m) { const int rl = row0 + ai * HALF + m * 16; const size_t grow = (size_t)u.pm * BM + rl;
#pragma unroll
                for (int bj = 0; bj < 2; ++bj) { const f32x4 v0 = acc[ai][bj][m][0], v1 = acc[ai][bj][m][1];
                    const u32x4 yw = *(const u32x4*)(Y + grow * 512 + u.pn * BM + col0 + bj * HALF);
                    float y[8], g[8];
#pragma unroll
                    for (int j = 0; j < 4; ++j) { y[2 * j] = __uint_as_float(yw[j] << 16); y[2 * j + 1] = __uint_as_float(yw[j] & 0xffff0000u); }
#pragma unroll
                    for (int j = 0; j < 4; ++j) { g[j] = 1.f / (1.f + __expf(-v0[j])); g[4 + j] = 1.f / (1.f + __expf(-v1[j])); }
                    u32x4 w; w.x = cvt_pk_bf16(y[0] * g[0], y[1] * g[1]); w.y = cvt_pk_bf16(y[2] * g[2], y[3] * g[3]); w.z = cvt_pk_bf16(y[4] * g[4], y[5] * g[5]); w.w = cvt_pk_bf16(y[6] * g[6], y[7] * g[7]);
                    *(PG8_LAS u32x4*)(lds + rl * TS + (col0 + bj * HALF) * 2) = w; } }
        __syncthreads();
        { const int t = wid * 64 + lane, row = t >> 1, hd = t & 1; const PG8_LAS unsigned char* src = lds + row * TS + hd * 256;
          float ss = 0.f;
#pragma unroll
          for (int i = 0; i < 16; ++i) { const u32x4 w = *(const PG8_LAS u32x4*)(src + 16 * i);
#pragma unroll
              for (int j = 0; j < 4; ++j) { const float a = __uint_as_float(w[j] << 16), b = __uint_as_float(w[j] & 0xffff0000u); ss += a * a + b * b; } }
          const float rn = rsqrtf(ss * (1.f / 128.f) + 1e-6f);
          const size_t grow = (size_t)u.pm * BM + row; const int cb = u.pn * BM + hd * 128;
          const bf16_t* zp = Pz + grow * 6144 + 2064 + cb; bf16_t* gp = G + grow * 2048 + 512 + cb;
#pragma unroll
          for (int i = 0; i < 16; ++i) { const u32x4 w = *(const PG8_LAS u32x4*)(src + 16 * i); const u32x4 zw = *(const u32x4*)(zp + 8 * i); u32x4 o;
#pragma unroll
              for (int j = 0; j < 4; ++j) { const float a = __uint_as_float(w[j] << 16), b = __uint_as_float(w[j] & 0xffff0000u), za = __uint_as_float(zw[j] << 16), zb = __uint_as_float(zw[j] & 0xffff0000u);
                  o[j] = cvt_pk_bf16(a * rn * (za / (1.f + __expf(-za))), b * rn * (zb / (1.f + __expf(-zb)))); }
              *(u32x4*)(gp + 8 * i) = o; } }
        __syncthreads();
    }
};
struct EpiBf16Scale {
    static constexpr bool PERM = true, AFTER_DRAIN = false;
    bf16_t* O; int ldc; const float* ssq;
    __device__ __forceinline__ void operator()(const f32x4 (&acc)[2][2][4][2], const Unit& u, int wr, int wc, int fr, int fq) const {
        const int row0 = u.pm * BM + wr * 64 + fr, col0 = u.pn * BM + wc * 32 + 8 * fq;
#pragma unroll
        for (int ai = 0; ai < 2; ++ai)
#pragma unroll
            for (int m = 0; m < 4; ++m) { const int row = row0 + ai * HALF + m * 16; bf16_t* rowp = O + (size_t)row * ldc + col0;
                float ssum = 0.f; { const f32x4* sp_ = (const f32x4*)(ssq + (size_t)row * 32);
#pragma unroll
                    for (int q = 0; q < 8; ++q) { const f32x4 t4 = sp_[q]; ssum += (t4[0] + t4[1]) + (t4[2] + t4[3]); } }
                const float s = rsqrtf(ssum * (1.f / 2048.f) + 1e-6f);
#pragma unroll
                for (int bj = 0; bj < 2; ++bj) { const f32x4 v0 = acc[ai][bj][m][0] * s, v1 = acc[ai][bj][m][1] * s;
                    u32x4 w; w.x = cvt_pk_bf16(v0[0], v0[1]); w.y = cvt_pk_bf16(v0[2], v0[3]); w.z = cvt_pk_bf16(v1[0], v1[1]); w.w = cvt_pk_bf16(v1[2], v1[3]);
                    *(u32x4*)(rowp + bj * HALF) = w; } }
    }
};
struct EpiResidNext {
    static constexpr bool PERM = false, AFTER_DRAIN = false;
    const float* R; float* C; int ldc; bf16_t* XB; float* ssq;
    __device__ __forceinline__ void operator()(const f32x4 (&acc)[2][2][4][2], const Unit& u, int wr, int wc, int fr, int fq) const {
        const int row0 = u.pm * BM + wr * 64 + fr, col0 = u.pn * BM + wc * 32 + 4 * fq;
#pragma unroll
        for (int ai = 0; ai < 2; ++ai)
#pragma unroll
            for (int m = 0; m < 4; ++m) { const int row = row0 + ai * HALF + m * 16; const size_t off = (size_t)row * ldc + col0; float ss = 0.f;
#pragma unroll
                for (int bj = 0; bj < 2; ++bj)
#pragma unroll
                    for (int n = 0; n < 2; ++n) { const f32x4 r = *(const f32x4*)(R + off + bj * HALF + n * 16); const f32x4 v = acc[ai][bj][m][n] + r;
                        *(f32x4*)(C + off + bj * HALF + n * 16) = v;
                        if (XB) { u32x2 w; w.x = cvt_pk_bf16(v[0], v[1]); w.y = cvt_pk_bf16(v[2], v[3]); *(u32x2*)(XB + off + bj * HALF + n * 16) = w; }
                        ss += v[0] * v[0] + v[1] * v[1] + v[2] * v[2] + v[3] * v[3]; }
                if (ssq) { ss += shx(ss, 16); ss += shx(ss, 32); if (fq == 0) ssq[(size_t)row * 32 + u.pn * 4 + wc] = ss; } }
    }
};
template <class Epi, class Sched, bool STAMP = false>
__device__ __forceinline__ void gemm_phase(PG8_LAS unsigned char* lds, const Gemm g, const Sched& S, const Epi& E, unsigned long long* stamps) {
    const int tid = TIDX(), wid = __builtin_amdgcn_readfirstlane(tid >> 6), lane = tid & 63, wr = wid >> 2, wc = wid & 3, fr = lane & 15, fq = lane >> 4;
    const int K = g.K, nt = K / BK;
    int ts_lo = 0, ts_hi = 0, nts = 0; const unsigned long long rt_entry = STAMP ? (unsigned long long)wall_clock64() : 0ull;
#define PG8_STAMP() do { if (STAMP && wid == 0 && nts < 64) { const unsigned long long _c = (unsigned long long)clock64(); \
        ts_lo = (lane == nts) ? (int)(unsigned)_c : ts_lo; ts_hi = (lane == nts) ? (int)(unsigned)(_c >> 32) : ts_hi; ++nts; } } while (0)
    PG8_STAMP();
    unsigned voffA[2], voffB[2];
#pragma unroll
    for (int i = 0; i < 2; ++i) { int R, C; stage_rc(tid * 16 + i * 8192, R, C); const int Rb = Epi::PERM ? ((R & ~31) + perm32(R & 31)) : R;
        voffA[i] = (unsigned)(R * K + C) * 2u; voffB[i] = (unsigned)(Rb * K + C) * 2u; }
    const size_t kstep = (size_t)(BK * 2);
    const size_t hstep = (size_t)HALF * K * 2;
    const size_t tstep = 2 * hstep;
    const unsigned ldsw = (unsigned)wid * 1024u;
    const int aoff = lds_byte(wr * 64 + fr, fq * 8), boff = lds_byte(wc * 32 + fr, fq * 8);
#define PG8_SA(b, h) (((b) * 2 + (h)) * HTB)
#define PG8_SB(b, h) ((4 + (b) * 2 + (h)) * HTB)
#define PG8_STAGE(bufoff, gbase, voff) do { _Pragma("unroll") for (int _i = 0; _i < 2; ++_i) \
        __builtin_amdgcn_global_load_lds((const unsigned*)((const char*)(gbase) + (voff)[_i]), (PG8_LAS unsigned*)(lds + (bufoff) + ldsw + _i * 8192), 16, 0, 0); } while (0)
#define PG8_LDA(dst, b, h) do { _Pragma("unroll") for (int m = 0; m < 4; ++m) _Pragma("unroll") for (int k = 0; k < 2; ++k) dst[m][k] = *(const PG8_LAS bf16x8*)(lds + PG8_SA(b, h) + aoff + m * 2048 + k * 1024); } while (0)
#define PG8_LDB(dst, b, h) do { _Pragma("unroll") for (int n = 0; n < 2; ++n) _Pragma("unroll") for (int k = 0; k < 2; ++k) dst[n][k] = *(const PG8_LAS bf16x8*)(lds + PG8_SB(b, h) + boff + n * 2048 + k * 1024); } while (0)
#define PG8_MMA(ai, bj, At, Bt) do { __builtin_amdgcn_s_setprio(1); _Pragma("unroll") for (int m = 0; m < 4; ++m) _Pragma("unroll") for (int n = 0; n < 2; ++n) _Pragma("unroll") for (int k = 0; k < 2; ++k) \
        acc[ai][bj][m][n] = __builtin_amdgcn_mfma_f32_16x16x32_bf16(Bt[n][k], At[m][k], acc[ai][bj][m][n], 0, 0, 0); __builtin_amdgcn_s_setprio(0); } while (0)
#define PG8_WAIT_V(n) asm volatile("s_waitcnt vmcnt(" #n ")" ::: "memory")
#define PG8_WAIT_L(n) asm volatile("s_waitcnt lgkmcnt(" #n ")" ::: "memory")
#define PG8_BAR __builtin_amdgcn_s_barrier()
#define PG8_SCHED __builtin_amdgcn_sched_barrier(0)
    Unit cur, nxt; int ui = 0;
    if (!S.next(0, cur)) return;
    f32x4 acc[2][2][4][2];
#pragma unroll
    for (int a = 0; a < 2; ++a)
#pragma unroll
        for (int b = 0; b < 2; ++b)
#pragma unroll
            for (int m = 0; m < 4; ++m)
#pragma unroll
                for (int n = 0; n < 2; ++n) acc[a][b][m][n] = (f32x4){0.f, 0.f, 0.f, 0.f};
    bf16x8 At[4][2], B0[2][2], B1[2][2];
    const char* cA = (const char*)g.A + (size_t)cur.pm * tstep; const char* cB = (const char*)g.Bt + (size_t)cur.pn * tstep;
    S.a_ready(cur);
    PG8_STAGE(PG8_SB(0, 0), cB, voffB); PG8_STAGE(PG8_SA(0, 0), cA, voffA); PG8_STAGE(PG8_SB(0, 1), cB + hstep, voffB); PG8_STAGE(PG8_SA(0, 1), cA + hstep, voffA);
    if (wr == 1) PG8_BAR;
    PG8_WAIT_V(4); PG8_BAR;
    PG8_STAGE(PG8_SB(1, 0), cB + kstep, voffB); PG8_STAGE(PG8_SA(1, 0), cA + kstep, voffA); PG8_STAGE(PG8_SB(1, 1), cB + hstep + kstep, voffB);
    PG8_WAIT_V(6); PG8_BAR;
    PG8_STAMP();
    for (;;) {
        const bool has_next = S.next(ui + 1, nxt);
        const char* nA = has_next ? (const char*)g.A + (size_t)nxt.pm * tstep : cA; const char* nB = has_next ? (const char*)g.Bt + (size_t)nxt.pn * tstep : cB;
        for (int t = 0; t < nt; t += 2) {
            const bool last = (t == nt - 2);
            const char* a1 = cA + (size_t)(t + 1) * kstep;
            const char* a2 = last ? nA : cA + (size_t)(t + 2) * kstep; const char* b2 = last ? nB : cB + (size_t)(t + 2) * kstep;
            const char* a3 = a2 + kstep; const char* b3 = b2 + kstep;
            if (last && has_next) S.a_ready(nxt);
            PG8_LDB(B0, 0, 0); PG8_SCHED; PG8_LDA(At, 0, 0); PG8_STAGE(PG8_SA(1, 1), a1 + hstep, voffA);
            PG8_WAIT_L(8); PG8_BAR; PG8_WAIT_L(0); PG8_MMA(0, 0, At, B0); PG8_BAR; PG8_SCHED;
            PG8_LDB(B1, 0, 1); PG8_STAGE(PG8_SB(0, 0), b2, voffB);
            PG8_BAR; PG8_WAIT_L(0); PG8_MMA(0, 1, At, B1); PG8_BAR;
            PG8_LDA(At, 0, 1); PG8_STAGE(PG8_SA(0, 0), a2, voffA);
            PG8_BAR; PG8_WAIT_L(0); PG8_MMA(1, 0, At, B0); PG8_BAR; PG8_SCHED;
            PG8_STAGE(PG8_SB(0, 1), b2 + hstep, voffB);
            PG8_WAIT_V(6); PG8_BAR; PG8_MMA(1, 1, At, B1); PG8_BAR;
            PG8_LDB(B0, 1, 0); PG8_SCHED; PG8_LDA(At, 1, 0); PG8_STAGE(PG8_SA(0, 1), a2 + hstep, voffA);
            PG8_WAIT_L(8); PG8_BAR; PG8_WAIT_L(0); PG8_MMA(0, 0, At, B0); PG8_BAR; PG8_SCHED;
            PG8_LDB(B1, 1, 1); PG8_STAGE(PG8_SB(1, 0), b3, voffB);
            PG8_BAR; PG8_WAIT_L(0); PG8_MMA(0, 1, At, B1); PG8_BAR;
            PG8_LDA(At, 1, 1); PG8_STAGE(PG8_SA(1, 0), a3, voffA);
            PG8_BAR; PG8_WAIT_L(0); PG8_MMA(1, 0, At, B0); PG8_BAR; PG8_SCHED;
            PG8_STAGE(PG8_SB(1, 1), b3 + hstep, voffB);
            PG8_WAIT_V(6); PG8_BAR; PG8_MMA(1, 1, At, B1); PG8_BAR;
        }
        PG8_STAMP();
        if constexpr (!Epi::AFTER_DRAIN) { E(acc, cur, wr, wc, fr, fq); S.done(cur); }
        PG8_STAMP();
        if (!has_next) break;
#pragma unroll
        for (int a = 0; a < 2; ++a)
#pragma unroll
            for (int b = 0; b < 2; ++b)
#pragma unroll
                for (int m = 0; m < 4; ++m)
#pragma unroll
                    for (int n = 0; n < 2; ++n) acc[a][b][m][n] = (f32x4){0.f, 0.f, 0.f, 0.f};
        cur = nxt; cA = nA; cB = nB; ++ui;
    }
    PG8_WAIT_V(0);
    if (wr == 0) PG8_BAR;
    PG8_BAR;
    if constexpr (Epi::AFTER_DRAIN) { E.fused(acc, cur, wr, wc, fr, fq, lds, wid, lane); S.done(cur); }
    PG8_STAMP();
    if (STAMP && wid == 0) { stamps[lane] = lane < nts ? (((unsigned long long)(unsigned)ts_hi << 32) | (unsigned)ts_lo) : 0ull;
        if (lane == 62) stamps[62] = rt_entry; if (lane == 63) stamps[63] = (unsigned long long)wall_clock64(); }
#undef PG8_STAMP
#undef PG8_SA
#undef PG8_SB
#undef PG8_STAGE
#undef PG8_LDA
#undef PG8_LDB
#undef PG8_MMA
#undef PG8_WAIT_V
#undef PG8_WAIT_L
#undef PG8_BAR
#undef PG8_SCHED
}
}
namespace att {
constexpr int D = 128, NW = 8, QBLK = 32, KVBLK = 64;
constexpr float SCALE = 0.088388347648318440f, THR = 8.f;
constexpr int SHM_V = KVBLK * D * 2, SHM_K = KVBLK * D * 2, SHM_ATTN = 2 * SHM_V + 2 * SHM_K + NW * 64 * 4;
#define KSWZ(row, colB) ((row) * 256 + ((colB) ^ (((row) & 7) << 4)))
#define SBAR() __builtin_amdgcn_sched_barrier(0)
__device__ __forceinline__ int crow(int r, int hi) { return (r & 3) + 8 * (r >> 2) + 4 * hi; }
__device__ __forceinline__ unsigned cvtpk(float lo, float hi) { unsigned r; asm volatile("v_cvt_pk_bf16_f32 %0, %1, %2" : "=v"(r) : "v"(lo), "v"(hi)); return r; }

template <bool MASKED>
__device__ __forceinline__ void partialSM(f32x16& p0, f32x16& p1, float& m_reg, float& mn, float& alpha, unsigned long long mw, int hi) {
  constexpr float C = SCALE * 1.4426950408889634f;
  float pmax = p0[0];
#pragma unroll
  for (int r = 1; r < 16; ++r) pmax = fmaxf(pmax, p0[r]);
#pragma unroll
  for (int r = 0; r < 16; ++r) pmax = fmaxf(pmax, p1[r]);
  { auto rr = __builtin_amdgcn_permlane32_swap(__float_as_uint(pmax), __float_as_uint(pmax), false, false);
    pmax = fmaxf(__uint_as_float(rr[0]), __uint_as_float(rr[1])); }
  if (__builtin_expect(__all(pmax - m_reg <= THR / SCALE), 1)) { mn = m_reg; alpha = 1.f; }
  else { mn = fmaxf(m_reg, pmax); alpha = __builtin_amdgcn_exp2f((m_reg - mn) * C); m_reg = mn; }
  const float mnC = -mn * C;
#pragma unroll
  for (int r = 0; r < 16; ++r) p0[r] = fmaf(p0[r], C, mnC);
#pragma unroll
  for (int r = 0; r < 16; ++r) p1[r] = fmaf(p1[r], C, mnC);
#pragma unroll
  for (int r = 0; r < 16; ++r) p0[r] = __builtin_amdgcn_exp2f(p0[r]);
}
__device__ __forceinline__ void finishSM(f32x16& p0, f32x16& p1, float alpha, float& l_reg, bf16x8& pa0, bf16x8& pa1, bf16x8& pa2, bf16x8& pa3) {
#pragma unroll
  for (int r = 0; r < 16; ++r) p1[r] = __builtin_amdgcn_exp2f(p1[r]);
  float ps = 0;
#pragma unroll
  for (int r = 0; r < 16; ++r) ps += p0[r];
#pragma unroll
  for (int r = 0; r < 16; ++r) ps += p1[r];
  { auto rr = __builtin_amdgcn_permlane32_swap(__float_as_uint(ps), __float_as_uint(ps), false, false);
    ps = __uint_as_float(rr[0]) + __uint_as_float(rr[1]); }
  l_reg = l_reg * alpha + ps;
#define PK4(P, BASE, OUT) do { unsigned a0 = cvtpk(P[BASE + 0], P[BASE + 1]), a1 = cvtpk(P[BASE + 2], P[BASE + 3]);   \
    unsigned b0 = cvtpk(P[BASE + 4], P[BASE + 5]), b1 = cvtpk(P[BASE + 6], P[BASE + 7]);                              \
    auto r0 = __builtin_amdgcn_permlane32_swap(a0, b0, false, false); auto r1 = __builtin_amdgcn_permlane32_swap(a1, b1, false, false); \
    u32x4 w = {r0[0], r1[0], r0[1], r1[1]}; OUT = *reinterpret_cast<bf16x8*>(&w); } while (0)
  PK4(p0, 0, pa0); PK4(p0, 8, pa1); PK4(p1, 0, pa2); PK4(p1, 8, pa3);
#undef PK4
}
template <int R> __device__ __forceinline__ float mask_bias(unsigned nw) {
  unsigned t; constexpr int bit = (R & 3) + 8 * (R >> 2);
  asm("v_bfe_i32 %0, %1, %2, 1\n\tv_and_b32 %0, 0xff800000, %0" : "=v"(t) : "v"(nw), "n"(bit));
  return __uint_as_float(t);
}
template <bool MASKED>
__device__ __forceinline__ void qkt(f32x16& p0, f32x16& p1, const char* Ks, const bf16x8* qr, int r32, int hi, unsigned long long mw) {
  if (MASKED) {
    const unsigned n0 = ~((unsigned)mw >> (4 * hi)), n1 = ~((unsigned)(mw >> 32) >> (4 * hi));
#define MB_(R) p0[R] = mask_bias<R>(n0); p1[R] = mask_bias<R>(n1);
    MB_(0) MB_(1) MB_(2) MB_(3) MB_(4) MB_(5) MB_(6) MB_(7) MB_(8) MB_(9) MB_(10) MB_(11) MB_(12) MB_(13) MB_(14) MB_(15)
#undef MB_
  } else { p0 = f32x16{}; p1 = f32x16{}; }
  asm volatile("" : "+v"(p0), "+v"(p1));
#pragma unroll
  for (int d0 = 0; d0 < 8; ++d0) { const int cb = (d0 * 16 + hi * 8) * 2;
    bf16x8 b0 = *reinterpret_cast<const bf16x8*>(Ks + KSWZ(r32, cb));
    bf16x8 b1 = *reinterpret_cast<const bf16x8*>(Ks + KSWZ(32 + r32, cb));
    p0 = __builtin_amdgcn_mfma_f32_32x32x16_bf16(b0, qr[d0], p0, 0, 0, 0);
    p1 = __builtin_amdgcn_mfma_f32_32x32x16_bf16(b1, qr[d0], p1, 0, 0, 0); }
}
__device__ __forceinline__ int v_st(int k, int c) { const int kk = (k & ~0xC) | ((k & 4) << 1) | ((k & 8) >> 1); return ((kk >> 3) * 4 + (c >> 5)) * 512 + ((kk & 7) * 32 + (c & 31)) * 2; }
__device__ __forceinline__ int v_rd_base(int lane) { return ((lane & 3) << 3) | (((lane >> 2) & 3) << 6) | (((lane >> 4) & 1) << 5) | (((lane >> 5) & 1) << 8); }
constexpr int v_rd_off(int d0, int ks, int half) { return d0 * 512 + ks * 4096 + half * 2048; }
template <int OFF> __device__ __forceinline__ s16x4 tr_read(int vb) {
  s16x4 r; asm volatile("ds_read_b64_tr_b16 %0, %1 offset:%2" : "=&v"(r) : "v"(vb), "i"(OFF) : "memory"); return r;
}
template <int D0> __device__ __forceinline__ void pv_one(f32x16& od, int vb, bf16x8 pa0, bf16x8 pa1, bf16x8 pa2, bf16x8 pa3) {
  const s16x4 l0 = tr_read<v_rd_off(D0, 0, 0)>(vb), h0 = tr_read<v_rd_off(D0, 0, 1)>(vb), l1 = tr_read<v_rd_off(D0, 1, 0)>(vb), h1 = tr_read<v_rd_off(D0, 1, 1)>(vb);
  const s16x4 l2 = tr_read<v_rd_off(D0, 2, 0)>(vb), h2 = tr_read<v_rd_off(D0, 2, 1)>(vb), l3 = tr_read<v_rd_off(D0, 3, 0)>(vb), h3 = tr_read<v_rd_off(D0, 3, 1)>(vb);
  asm volatile("s_waitcnt lgkmcnt(0)" ::: "memory"); SBAR();
#define PK(L, H) (bf16x8){L[0], L[1], L[2], L[3], H[0], H[1], H[2], H[3]}
  od = __builtin_amdgcn_mfma_f32_32x32x16_bf16(pa0, PK(l0, h0), od, 0, 0, 0);
  od = __builtin_amdgcn_mfma_f32_32x32x16_bf16(pa1, PK(l1, h1), od, 0, 0, 0);
  od = __builtin_amdgcn_mfma_f32_32x32x16_bf16(pa2, PK(l2, h2), od, 0, 0, 0);
  od = __builtin_amdgcn_mfma_f32_32x32x16_bf16(pa3, PK(l3, h3), od, 0, 0, 0);
#undef PK
}
__device__ __forceinline__ void pv_d0(f32x16* o, int vb, bf16x8 pa0, bf16x8 pa1, bf16x8 pa2, bf16x8 pa3) {
  pv_one<0>(o[0], vb, pa0, pa1, pa2, pa3); pv_one<1>(o[1], vb, pa0, pa1, pa2, pa3); pv_one<2>(o[2], vb, pa0, pa1, pa2, pa3); pv_one<3>(o[3], vb, pa0, pa1, pa2, pa3);
}

template <bool MASKED, int LDK, int VOFF, class OutRow>
__device__ __forceinline__ void attn_body(const bf16_t* __restrict__ Qw, const bf16_t* __restrict__ Kh, int NT,
                                          const unsigned long long* __restrict__ mbase, unsigned moff, const OutRow& Ow, char* lds) {
  const int tid = TIDX(), wid = tid >> 6, lane = tid & 63, r32 = lane & 31, hi = lane >> 5;
  char* V_lds = lds; char* K_lds = lds + 2 * SHM_V;
  float* ws = (float*)(lds + 2 * SHM_V + 2 * SHM_K) + wid * 64; float* li_l = ws; float* al_l = ws + 32;
  float m_reg = -1e30f, l_reg = 0; f32x16 o[4] = {}; bf16x8 qr[8];
  asm volatile("" : "+v"(o[0]), "+v"(o[1]), "+v"(o[2]), "+v"(o[3]));
#pragma unroll
  for (int d0 = 0; d0 < 8; ++d0) qr[d0] = *reinterpret_cast<const bf16x8*>(Qw + d0 * 16);
  const int sr = tid >> 4, sc = (tid & 15) * 8, vst0 = v_st(sr, sc), vst1 = v_st(32 + sr, sc);
  const int vb0 = (int)(uintptr_t)V_lds + v_rd_base(lane);
  struct { bf16x8 vs0, vs1, ks0, ks1; } sr_[2];
  const unsigned koff = (unsigned)(sr * LDK + sc) * 2u;
#define SLOAD(i, k0) do { const char* kb_ = (const char*)Kh + (size_t)(k0) * (LDK * 2); \
    sr_[i].vs0 = *reinterpret_cast<const bf16x8*>(kb_ + koff + VOFF * 2); sr_[i].vs1 = *reinterpret_cast<const bf16x8*>(kb_ + koff + (32 * LDK + VOFF) * 2); \
    sr_[i].ks0 = *reinterpret_cast<const bf16x8*>(kb_ + koff); sr_[i].ks1 = *reinterpret_cast<const bf16x8*>(kb_ + koff + 32 * LDK * 2); } while (0)
#define SWRITE(b, i) do { *(bf16x8*)(V_lds + (b) * SHM_V + vst0) = sr_[i].vs0;          \
    *(bf16x8*)(V_lds + (b) * SHM_V + vst1) = sr_[i].vs1; int kc = sc * 2;               \
    *(bf16x8*)(K_lds + (b) * SHM_K + KSWZ(sr, kc)) = sr_[i].ks0;                       \
    *(bf16x8*)(K_lds + (b) * SHM_K + KSWZ(32 + sr, kc)) = sr_[i].ks1; } while (0)
#define SWAIT() asm volatile("s_waitcnt vmcnt(4)" ::: "memory")
#define RESC(a) do { if (__any((a) < 1.f)) { if (hi == 0) al_l[r32] = (a); asm volatile("s_waitcnt lgkmcnt(0)" ::: "memory"); \
    _Pragma("unroll") for (int d = 0; d < 4; ++d) _Pragma("unroll") for (int r = 0; r < 16; ++r) o[d][r] *= al_l[crow(r, hi)]; } } while (0)
  f32x16 pA0, pA1, pB0, pB1; float mnA, mnB, alA, alB; bf16x8 pa0, pa1, pa2, pa3;
  unsigned long long mw = 0ull;
  constexpr int SE = 0, SO = 1;
  if (MASKED) mw = *(const unsigned long long*)((const char*)mbase + moff);
  SLOAD(SE, 0); asm volatile("s_waitcnt vmcnt(0)" ::: "memory"); SWRITE(0, SE); __syncthreads();
  qkt<MASKED>(pA0, pA1, K_lds, qr, r32, hi, mw);
  if (MASKED) mw = *(const unsigned long long*)((const char*)mbase + (moff + 8u));
  partialSM<MASKED>(pA0, pA1, m_reg, mnA, alA, mw, hi);
  SLOAD(SO, KVBLK); SLOAD(SE, (2 < NT ? 2 : NT - 1) * KVBLK);
  SWAIT();
  SWRITE(1, SO); __syncthreads();
  for (int j = 1; j + 1 < NT; j += 2) {
    SBAR(); qkt<MASKED>(pB0, pB1, K_lds + SHM_K, qr, r32, hi, mw);
    if (MASKED) mw = *(const unsigned long long*)((const char*)mbase + (moff + 8u * (unsigned)(j + 1)));
    finishSM(pA0, pA1, alA, l_reg, pa0, pa1, pa2, pa3); SBAR();
    SLOAD(SO, (j + 2) * KVBLK); SBAR();
    pv_d0(o, vb0, pa0, pa1, pa2, pa3); partialSM<MASKED>(pB0, pB1, m_reg, mnB, alB, mw, hi);
    __syncthreads(); if (MASKED) asm volatile("s_waitcnt vmcnt(5)" ::: "memory"); else SWAIT();
    SWRITE(0, SE);
    RESC(alB); __syncthreads();
    SBAR(); qkt<MASKED>(pA0, pA1, K_lds, qr, r32, hi, mw);
    if (MASKED) mw = *(const unsigned long long*)((const char*)mbase + (moff + 8u * (unsigned)(j + 2)));
    finishSM(pB0, pB1, alB, l_reg, pa0, pa1, pa2, pa3); SBAR();
    SLOAD(SE, (j + 3 < NT ? j + 3 : NT - 1) * KVBLK); SBAR();
    pv_d0(o, vb0 + SHM_V, pa0, pa1, pa2, pa3); partialSM<MASKED>(pA0, pA1, m_reg, mnA, alA, mw, hi);
    __syncthreads(); if (MASKED) asm volatile("s_waitcnt vmcnt(5)" ::: "memory"); else SWAIT();
    SWRITE(1, SO);
    RESC(alA); __syncthreads();
  }
  SBAR(); qkt<MASKED>(pB0, pB1, K_lds + SHM_K, qr, r32, hi, mw);
  finishSM(pA0, pA1, alA, l_reg, pa0, pa1, pa2, pa3); SBAR();
  pv_d0(o, vb0, pa0, pa1, pa2, pa3); partialSM<MASKED>(pB0, pB1, m_reg, mnB, alB, mw, hi);
  __syncthreads(); RESC(alB);
  finishSM(pB0, pB1, alB, l_reg, pa0, pa1, pa2, pa3); SBAR();
  pv_d0(o, vb0 + SHM_V, pa0, pa1, pa2, pa3);
  if (hi == 0) li_l[r32] = l_reg; asm volatile("s_waitcnt lgkmcnt(0)" ::: "memory");
  float rli[16];
#pragma unroll
  for (int r = 0; r < 16; ++r) rli[r] = __builtin_amdgcn_rcpf(li_l[crow(r, hi)]);
  __syncthreads();
  float* og_s = (float*)lds + wid * (32 * 132);
#pragma unroll
  for (int r = 0; r < 16; ++r) {
#pragma unroll
    for (int d0 = 0; d0 < 4; ++d0) og_s[crow(r, hi) * 132 + d0 * 32 + r32] = o[d0][r] * rli[r]; }
  asm volatile("" ::: "memory");
  { const int row = lane >> 1, half = lane & 1; const float* src = og_s + row * 132 + half * 64;
    f32x4 v[16]; float ss = 0.f;
#pragma unroll
    for (int i = 0; i < 16; ++i) { v[i] = *(const f32x4*)(src + 4 * i); ss += v[i][0] * v[i][0] + v[i][1] * v[i][1] + v[i][2] * v[i][2] + v[i][3] * v[i][3]; }
    ss += shx(ss, 1);
    const float rn = rsqrtf(ss * (1.f / 128.f) + EPS);
    const bf16_t* zp = Ow.zrow(row) + half * 64; bf16_t* gp = Ow.grow(row) + half * 64;
#pragma unroll
    for (int i = 0; i < 8; ++i) { float z[8], g[8]; ld8f(zp + 8 * i, z);
#pragma unroll
      for (int q = 0; q < 4; ++q) { g[q] = v[2 * i][q] * rn * siluf_(z[q]); g[4 + q] = v[2 * i + 1][q] * rn * siluf_(z[4 + q]); }
      st8f(gp + 8 * i, g); } }
  __syncthreads();
#undef SLOAD
#undef SWRITE
#undef SWAIT
#undef RESC
}
}
constexpr size_t al256(size_t x) { return (x + 255) / 256 * 256; }
constexpr size_t WS_CTL   = 0;
constexpr size_t CTL_BYTES = 65536;
constexpr size_t WS_WINT  = WS_CTL + CTL_BYTES;
constexpr size_t WS_WOUTT = WS_WINT + al256((size_t)DEPTH * NPAD * DM * 2);
constexpr size_t WS_WKVT  = WS_WOUTT + al256((size_t)DEPTH * DM * MIX * 2);
constexpr size_t WS_WGLUT = WS_WKVT + al256((size_t)DEPTH * 1024 * DM * 2);
constexpr size_t WS_MEMN  = WS_WGLUT + al256((size_t)DEPTH * 512 * 512 * 2);
constexpr size_t WS_KVMEM = WS_MEMN + al256((size_t)NB * MEML * DM * 2);
constexpr size_t WS_XN    = WS_KVMEM + al256((size_t)NB * MEML * DEPTH * 1024 * 2);
constexpr size_t WS_P     = WS_XN + al256((size_t)NTOK * DM * 2);
constexpr size_t WS_XBUF  = WS_P + al256((size_t)NTOK * NPAD * 2);
constexpr size_t WS_OCAT  = WS_XBUF + al256((size_t)NTOK * DM * 4);
constexpr size_t WS_MASK  = WS_OCAT + al256((size_t)NTOK * MIX * 2);
constexpr size_t WS_IW    = WS_MASK + al256((size_t)NTOK * 64 * 8);
constexpr size_t WS_YBUF  = WS_IW + al256((size_t)NTOK * 16 * 4);
constexpr size_t WS_ROPE  = WS_YBUF + al256((size_t)NTOK * 512 * 2);
constexpr size_t WS_S5P   = WS_ROPE + al256((size_t)NTOK * 48 * 4);
constexpr size_t S5P_BYTES = (size_t)DEPTH * 32 * (64 * 2 + 64 * 2 + 64 * 16 * 2) * 4;
constexpr size_t WS_GLAS  = WS_S5P + al256(S5P_BYTES);
constexpr size_t WS_GLAD  = WS_GLAS + al256((size_t)NB * 64 * 4 * 64 * 128 * 4);
constexpr size_t WS_IKC   = WS_GLAD + al256((size_t)NB * 64 * 4 * 64 * 4);
constexpr size_t WS_KVC   = WS_IKC + al256((size_t)NTOK * 64 * 2);
constexpr size_t WS_IQL   = WS_KVC + al256((size_t)NTOK * 256 * 2);
constexpr size_t WS_SSQ   = WS_IQL + al256((size_t)NTOK * 64 * 2);
constexpr size_t DSP_SLOT = (size_t)(256 * 128 + 512) * 4;
constexpr size_t WS_DSP   = WS_SSQ + 256;
constexpr size_t WS_END   = WS_DSP + al256((size_t)160 * 2 * DSP_SLOT);

struct Params {
    const float* x; const float* mem; const int* pos; const float* ln_gain; const float* w_in; const float* gla_w_up; const float* gla_b_up;
    const float* s5_a_re; const float* s5_a_im; const float* s5_log_step; const float* s5_b_re; const float* s5_b_im; const float* s5_c_re; const float* s5_c_im;
    const float* s5_d; const float* s5_w_glu; const float* dsa_q_norm; const float* dsa_k_norm; const float* mem_norm; const float* w_mem_kv;
    const float* mem_q_norm; const float* mem_k_norm; const float* out_norm; const float* w_out;
    float* out;
    char* ws;
    __device__ __forceinline__ unsigned* ctl_() const { return (unsigned*)(ws + WS_CTL); }
    __device__ __forceinline__ bf16_t* WinT_() const { return (bf16_t*)(ws + WS_WINT); }
    __device__ __forceinline__ bf16_t* WoutT_() const { return (bf16_t*)(ws + WS_WOUTT); }
    __device__ __forceinline__ bf16_t* WkvT_() const { return (bf16_t*)(ws + WS_WKVT); }
    __device__ __forceinline__ bf16_t* WgluT_() const { return (bf16_t*)(ws + WS_WGLUT); }
    __device__ __forceinline__ bf16_t* memn_() const { return (bf16_t*)(ws + WS_MEMN); }
    __device__ __forceinline__ bf16_t* kvmem_() const { return (bf16_t*)(ws + WS_KVMEM); }
    __device__ __forceinline__ bf16_t* xn_() const { return (bf16_t*)(ws + WS_XN); }
    __device__ __forceinline__ bf16_t* p_() const { return (bf16_t*)(ws + WS_P); }
    __device__ __forceinline__ bf16_t* xbuf_() const { return (bf16_t*)(ws + WS_XBUF); }
    __device__ __forceinline__ bf16_t* ocat_() const { return (bf16_t*)(ws + WS_OCAT); }
    __device__ __forceinline__ unsigned long long* mask_() const { return (unsigned long long*)(ws + WS_MASK); }
    __device__ __forceinline__ float* iw_() const { return (float*)(ws + WS_IW); }
    __device__ __forceinline__ bf16_t* ybuf_() const { return (bf16_t*)(ws + WS_YBUF); }
    __device__ __forceinline__ float* rope_() const { return (float*)(ws + WS_ROPE); }
    __device__ __forceinline__ float* s5p_() const { return (float*)(ws + WS_S5P); }
    __device__ __forceinline__ float* glas_() const { return (float*)(ws + WS_GLAS); }
    __device__ __forceinline__ float* glad_() const { return (float*)(ws + WS_GLAD); }
    __device__ __forceinline__ bf16_t* ikc_() const { return (bf16_t*)(ws + WS_IKC); }
    __device__ __forceinline__ bf16_t* kvc_() const { return (bf16_t*)(ws + WS_KVC); }
    __device__ __forceinline__ float* ssq_() const { return (float*)(ws + WS_SSQ); }
    __device__ __forceinline__ bf16_t* iql_() const { return (bf16_t*)(ws + WS_IQL); }
    __device__ __forceinline__ char* dsp_() const { return ws + WS_DSP; }
};

__device__ __forceinline__ void transpose_tiles(const float* __restrict__ src, int K, int Nsrc, int Ndst, const float* __restrict__ scale, bf16_t* __restrict__ dst,
                                                int tile, float* lds_tile  ) {
    const int tid = TIDX(), ntn = Ndst / 256;
    const int tk = tile / ntn, tn = tile % ntn, k0 = tk * 64, n0 = tn * 256;
    __syncthreads();
    { const int ty = tid >> 4, tx = tid & 15;
      f32x4 v[2][4];
#pragma unroll
      for (int i = 0; i < 2; ++i)
#pragma unroll
        for (int q = 0; q < 4; ++q) { const int k = k0 + ty + 32 * i, n = n0 + 4 * tx + 64 * q;
          v[i][q] = (f32x4){0.f, 0.f, 0.f, 0.f};
          if (n < Nsrc) v[i][q] = *(const f32x4*)(src + (size_t)k * Nsrc + n); }
#pragma unroll
      for (int i = 0; i < 2; ++i) { const float s = scale ? scale[k0 + ty + 32 * i] : 1.f;
#pragma unroll
        for (int q = 0; q < 4; ++q) { float* t = lds_tile + (ty + 32 * i) * 257 + 4 * tx + 64 * q; t[0] = v[i][q][0] * s; t[1] = v[i][q][1] * s; t[2] = v[i][q][2] * s; t[3] = v[i][q][3] * s; } } }
    __syncthreads();
    { const int n = tid >> 1, kh = (tid & 1) * 32;
#pragma unroll
      for (int j = 0; j < 4; ++j) { const int kb = kh + 8 * j; u32x4 w;
        w.x = pk2bf(lds_tile[(kb + 0) * 257 + n], lds_tile[(kb + 1) * 257 + n]); w.y = pk2bf(lds_tile[(kb + 2) * 257 + n], lds_tile[(kb + 3) * 257 + n]);
        w.z = pk2bf(lds_tile[(kb + 4) * 257 + n], lds_tile[(kb + 5) * 257 + n]); w.w = pk2bf(lds_tile[(kb + 6) * 257 + n], lds_tile[(kb + 7) * 257 + n]);
        *(u32x4*)(dst + (size_t)(n0 + n) * K + k0 + kb) = w; } }
}

__device__ __forceinline__ void rmsnorm_rows(const float* __restrict__ X, bf16_t* __restrict__ Y, int nrows) {
    const int wid = TIDX() >> 6, lane = TIDX() & 63;
    for (int row = blockIdx.x * 8 + wid; row < nrows; row += gridDim.x * 8) {
        const float* xr = X + (size_t)row * DM; f32x4 v[8]; float ss = 0.f;
#pragma unroll
        for (int i = 0; i < 8; ++i) { v[i] = *(const f32x4*)(xr + 4 * lane + 256 * i); ss += v[i][0] * v[i][0] + v[i][1] * v[i][1] + v[i][2] * v[i][2] + v[i][3] * v[i][3]; }
        ss = wave_sum(ss); const float r = rsqrtf(ss * (1.f / DM) + EPS);
        bf16_t* yr = Y + (size_t)row * DM;
#pragma unroll
        for (int i = 0; i < 8; ++i) { u32x2 w; w.x = pk2bf(v[i][0] * r, v[i][1] * r); w.y = pk2bf(v[i][2] * r, v[i][3] * r); *(u32x2*)(yr + 4 * lane + 256 * i) = w; }
    }
}

__device__ __forceinline__ void rmsnorm_rows16(const bf16_t* __restrict__ X, bf16_t* __restrict__ Y, int nrows) {
    const int wid = TIDX() >> 6, lane = TIDX() & 63;
    for (int row = blockIdx.x * 8 + wid; row < nrows; row += gridDim.x * 8) {
        const bf16_t* xr = X + (size_t)row * DM; float v[4][8]; float ss = 0.f;
#pragma unroll
        for (int i = 0; i < 4; ++i) { ld8f(xr + 8 * lane + 512 * i, v[i]);
#pragma unroll
            for (int j = 0; j < 8; ++j) ss += v[i][j] * v[i][j]; }
        ss = wave_sum(ss); const float r = rsqrtf(ss * (1.f / DM) + EPS);
        bf16_t* yr = Y + (size_t)row * DM;
#pragma unroll
        for (int i = 0; i < 4; ++i) { float o[8];
#pragma unroll
            for (int j = 0; j < 8; ++j) o[j] = v[i][j] * r;
            st8f(yr + 8 * lane + 512 * i, o); }
    }
}

__device__ __forceinline__ void rows_bf16_ssq(const float* __restrict__ X, bf16_t* __restrict__ Y, float* __restrict__ ssq, int nrows) {
    const int wid = TIDX() >> 6, lane = TIDX() & 63;
    for (int row = blockIdx.x * 8 + wid; row < nrows; row += gridDim.x * 8) {
        const float* xr = X + (size_t)row * DM; bf16_t* yr = Y + (size_t)row * DM; float ss = 0.f;
#pragma unroll
        for (int i = 0; i < 8; ++i) { const f32x4 v = *(const f32x4*)(xr + 4 * lane + 256 * i); ss += v[0] * v[0] + v[1] * v[1] + v[2] * v[2] + v[3] * v[3];
            u32x2 w; w.x = pk2bf(v[0], v[1]); w.y = pk2bf(v[2], v[3]); *(u32x2*)(yr + 4 * lane + 256 * i) = w; }
        ss = wave_sum(ss); if (lane < 32) ssq[(size_t)row * 32 + lane] = (lane == 0) ? ss : 0.f;
    }
}
__device__ __forceinline__ void phase_prologue1(const Params& P, char* lds) {
    float* tile = (float*)lds;
    constexpr int T_IN = (DM / 64) * (NPAD / 256), T_OUT = (MIX / 64) * (DM / 256), T_KV = (DM / 64) * (1024 / 256), T_GLU = 8 * 2;
    constexpr int TOT = DEPTH * (T_IN + T_OUT + T_KV + T_GLU);
    for (int u = blockIdx.x; u < TOT; u += gridDim.x) {
        int l = u / (T_IN + T_OUT + T_KV + T_GLU), r = u % (T_IN + T_OUT + T_KV + T_GLU);
        if (r < T_IN) transpose_tiles(P.w_in + (size_t)l * DM * NIN, DM, NIN, NPAD, P.ln_gain + l * DM, P.WinT_() + (size_t)l * NPAD * DM, r, tile);
        else if ((r -= T_IN) < T_OUT) transpose_tiles(P.w_out + (size_t)l * MIX * DM, MIX, DM, DM, P.out_norm + l * MIX, P.WoutT_() + (size_t)l * DM * MIX, r, tile);
        else if ((r -= T_OUT) < T_KV) transpose_tiles(P.w_mem_kv + (size_t)l * DM * 1024, DM, 1024, 1024, P.mem_norm + l * DM, P.WkvT_() + (size_t)l * 1024 * DM, r, tile);
        else { r -= T_KV; transpose_tiles(P.s5_w_glu + (size_t)l * 512 * 512, 512, 512, 512, nullptr, P.WgluT_() + (size_t)l * 512 * 512, r, tile); }
    }
    rmsnorm_rows(P.mem, P.memn_(), NB * MEML);
}
__device__ __forceinline__ void phase_rope_table(const Params& P) {
    for (int idx = blockIdx.x * NTHR + TIDX(); idx < NTOK * 24; idx += gridDim.x * NTHR) {
        const int tok = idx / 24, i = idx % 24;
        const float e = (i < 16) ? -((float)i * 2.0f / 32.0f) : -((float)(i - 16) * 2.0f / 16.0f);
        const float inv_freq = exp2f(e * 18.931568569324174f);
        const float ang = (float)P.pos[tok] * inv_freq;
        const double a = (double)ang; const double k = rint(a * 0.15915494309189535); const float rf = (float)fma(-k, 6.283185307179586, a);
        P.rope_()[(size_t)idx * 2] = cosf(rf); P.rope_()[(size_t)idx * 2 + 1] = sinf(rf);
    }
}

__device__ __forceinline__ void phase_rmsnorm_x(const Params& P, int layer) { if (layer == 0) rmsnorm_rows(P.x, P.xn_(), NTOK); else rmsnorm_rows16(P.xbuf_(), P.xn_(), NTOK); }

__device__ __forceinline__ void phase_memk_norm(const Params& P) {
    const int wid = TIDX() >> 6, lane = TIDX() & 63;
    for (int it = blockIdx.x * 8 + wid; it < NB * MEML * DEPTH * 4; it += gridDim.x * 8) {
        const int row = it / (DEPTH * 4), l = (it / 4) % DEPTH, h = it % 4;
        bf16_t* kp = P.kvmem_() + (size_t)row * (DEPTH * 1024) + l * 1024 + h * 128 + 2 * lane;
        const unsigned w = *(const unsigned*)kp; const float a = __uint_as_float(w << 16), b = __uint_as_float(w & 0xffff0000u);
        const float ss = wave_sum(a * a + b * b), r = rsqrtf(ss * (1.f / 128.f) + EPS);
        const float* g = P.mem_k_norm + l * 128 + 2 * lane;
        *(unsigned*)kp = pk2bf(a * r * g[0], b * r * g[1]);
    }
}

__device__ __forceinline__ float sum16(float v) { v += shx(v, 1); v += shx(v, 2); v += shx(v, 4); v += shx(v, 8); return v; }

__device__ __forceinline__ void head128_norm_rope_to(const bf16_t* hp, bf16_t* dp, int l16, const float* __restrict__ gain, const float* __restrict__ cs, bool rope, bool do_store) {
    float v[8]; ld8f(hp + 8 * l16, v);
    float ss = 0.f;
#pragma unroll
    for (int j = 0; j < 8; ++j) ss += v[j] * v[j];
    ss = sum16(ss); const float r = rsqrtf(ss * (1.f / 128.f) + EPS);
#pragma unroll
    for (int j = 0; j < 8; ++j) v[j] = v[j] * r * gain[8 * l16 + j];
    if (rope) {
        float o[8];
#pragma unroll
        for (int j = 0; j < 8; ++j) o[j] = shx(v[j], 2);
        if (l16 < 4) { const int fi = (l16 & 1) * 8;
#pragma unroll
            for (int j = 0; j < 8; ++j) { const float c = cs[(fi + j) * 2], s = cs[(fi + j) * 2 + 1];
                v[j] = (l16 < 2) ? (v[j] * c - o[j] * s) : (v[j] * c + o[j] * s); } }
    }
    if (do_store) st8f(dp + 8 * l16, v);
}
__device__ __forceinline__ void head128_norm_rope(bf16_t* hp, int l16, const float* __restrict__ gain, const float* __restrict__ cs, bool rope, bool do_store) { head128_norm_rope_to(hp, hp, l16, gain, cs, rope, do_store); }
__device__ __forceinline__ void rope16_inplace(bf16_t* ip, const float* __restrict__ cs) {
    float a[8], b[8]; ld8f(ip, a); ld8f(ip + 8, b);
#pragma unroll
    for (int j = 0; j < 8; ++j) { const float c = cs[2 * j], s = cs[2 * j + 1], x1 = a[j], x2 = b[j]; a[j] = x1 * c - x2 * s; b[j] = x2 * c + x1 * s; }
    st8f(ip, a); st8f(ip + 8, b);
}
__device__ __forceinline__ void phase_prep(const Params& P, int layer) {
    const int wid = TIDX() >> 6, lane = TIDX() & 63, l16 = lane & 15, grp = lane >> 4;
    for (int tok = blockIdx.x * 8 + wid; tok < NTOK; tok += gridDim.x * 8) {
        bf16_t* row = P.p_() + (size_t)tok * NPAD;
        const float* cs32 = P.rope_() + (size_t)tok * 48; const float* cs16 = cs32 + 32;
        head128_norm_rope(row + C_DQ + grp * 128, l16, P.dsa_q_norm + layer * 128, cs32, true, true);
        head128_norm_rope_to(row + C_DK, P.kvc_() + (size_t)tok * 256, l16, P.dsa_k_norm + layer * 128, cs32, true, grp == 0);
        head128_norm_rope(row + C_MQ + grp * 128, l16, P.mem_q_norm + layer * 128, cs32, false, true);
        if ((lane & 3) == 0) rope16_inplace(row + C_DIQ + lane * 16, cs16);
        if (lane < 4) {
            bf16_t* dst = P.ikc_() + (size_t)(tok >> 5) * 2048 + lane * 512 + (tok & 31) * 8;
            float a[8], b[8]; ld8f(row + C_DIK + lane * 16, a); ld8f(row + C_DIK + lane * 16 + 8, b);
            if (lane == 0) {
#pragma unroll
                for (int q = 0; q < 8; ++q) { const float c = cs16[2 * q], s = cs16[2 * q + 1], x1 = a[q], x2 = b[q]; a[q] = x1 * c - x2 * s; b[q] = x2 * c + x1 * s; } }
            st8f(dst, a); st8f(dst + 256, b); }
        if (lane >= 16 && lane < 32) { const u32x4 vv = *(const u32x4*)(row + C_DV + (lane - 16) * 8); *(u32x4*)(P.kvc_() + (size_t)tok * 256 + 128 + (lane - 16) * 8) = vv; }
        if (lane < 16) P.iw_()[(size_t)tok * 16 + lane] = bf2f(row[C_DIW + lane]) * (1.f / 32.f);
    }
}
struct MemOutRow { const bf16_t* zb; bf16_t* gb;
    __device__ __forceinline__ const bf16_t* zrow(int r) const { return zb + (size_t)r * NPAD; } __device__ __forceinline__ bf16_t* grow(int r) const { return gb + (size_t)r * MIX; } };
__device__ __forceinline__ void unit_mem_attn(const Params& P, int layer, int u, char* lds) {
    const int b = u >> 6, h = (u >> 4) & 3, qb = u & 15, tok0 = b * SEQ + qb * 256;
    const int wid = TIDX() >> 6, lane = TIDX() & 63, r32 = lane & 31, hi = lane >> 5;
    const bf16_t* Qw = P.p_() + (size_t)(tok0 + wid * 32 + r32) * NPAD + C_MQ + h * 128 + hi * 8;
    const bf16_t* Kh = P.kvmem_() + (size_t)(b * MEML) * (DEPTH * 1024) + layer * 1024 + h * 128;
    MemOutRow ow; ow.zb = P.p_() + (size_t)(tok0 + wid * 32) * NPAD + C_MZ + h * 128; ow.gb = P.xn_() + (size_t)(tok0 + wid * 32) * MIX + 1536 + h * 128;
    att::attn_body<false, DEPTH * 1024, 512, MemOutRow>(Qw, Kh, MEML / 64, nullptr, 0u, ow, lds);
}

__device__ __forceinline__ void phase_gate(const Params& P, int c_lo, int c_hi) {
    const int wid = TIDX() >> 6, lane = TIDX() & 63;
    const int c0 = lane * 32;
    const int seg = c0 >> 9, zc = (seg == 0 ? C_GZ : seg == 1 ? C_SZ : seg == 2 ? C_DZ : C_MZ) + (c0 & 511);
    const bool act = (c0 >= c_lo) && (c0 < c_hi);
    for (int tok = blockIdx.x * 8 + wid; tok < NTOK; tok += gridDim.x * 8) {
        if (!act) { bf16_t* gz_ = P.xn_() + (size_t)tok * MIX + c0; const u32x4 zz = {0u, 0u, 0u, 0u};
#pragma unroll
            for (int i = 0; i < 4; ++i) *(u32x4*)(gz_ + 8 * i) = zz;
            continue; }
        const bf16_t* op = P.ocat_() + (size_t)tok * MIX + c0; const bf16_t* zp = P.p_() + (size_t)tok * NPAD + zc; bf16_t* gp = P.xn_() + (size_t)tok * MIX + c0;
        float o[32]; float ss = 0.f;
#pragma unroll
        for (int i = 0; i < 4; ++i) { float v[8]; ld8f(op + 8 * i, v);
#pragma unroll
            for (int j = 0; j < 8; ++j) { o[8 * i + j] = v[j]; ss += v[j] * v[j]; } }
        ss += shx(ss, 1); ss += shx(ss, 2);
        const float r = rsqrtf(ss * (1.f / 128.f) + EPS);
#pragma unroll
        for (int i = 0; i < 4; ++i) { float z[8], g[8]; ld8f(zp + 8 * i, z);
#pragma unroll
            for (int j = 0; j < 8; ++j) g[j] = o[8 * i + j] * r * siluf_(z[j]);
            st8f(gp + 8 * i, g); }
    }
}

__device__ __forceinline__ void phase_gemm_in(const Params& P, int layer, char* lds) {
    pg8::Gemm g; g.A = P.xn_(); g.Bt = P.WinT_() + (size_t)layer * NPAD * DM; g.M = NTOK; g.N = NPAD; g.K = DM;
    pg8::StaticOrder S; S.init(g.M, g.N, (int)gridDim.x, (int)blockIdx.x);
    pg8::EpiBf16Plain E; E.O = P.p_(); E.ldc = NPAD;
    pg8::gemm_phase<pg8::EpiBf16Plain, pg8::StaticOrder, false>((PG8_LAS unsigned char*)lds, g, S, E, nullptr);
}
__device__ __forceinline__ void phase_gemm_out(const Params& P, int layer, char* lds) {
    pg8::Gemm g; g.A = P.xn_(); g.Bt = P.WoutT_() + (size_t)layer * DM * MIX; g.M = NTOK; g.N = DM; g.K = MIX;
    pg8::StaticOrder S; S.init(g.M, g.N, (int)gridDim.x, (int)blockIdx.x);
    pg8::EpiResidMix E; E.R = (layer == 0) ? (const void*)P.x : (const void*)P.xbuf_(); E.C = (layer == DEPTH - 1) ? (void*)P.out : (void*)P.xbuf_(); E.ldc = DM;
    E.r16 = (layer != 0); E.c16 = (layer != DEPTH - 1);
    pg8::gemm_phase<pg8::EpiResidMix, pg8::StaticOrder, false>((PG8_LAS unsigned char*)lds, g, S, E, nullptr);
}
__device__ __forceinline__ void phase_gemm_kv(const Params& P, char* lds) {
    pg8::Gemm g; g.A = P.memn_(); g.Bt = P.WkvT_(); g.M = NB * MEML; g.N = DEPTH * 1024; g.K = DM;
    pg8::StaticOrder S; S.init(g.M, g.N, (int)gridDim.x, (int)blockIdx.x);
    pg8::EpiBf16Plain E; E.O = P.kvmem_(); E.ldc = DEPTH * 1024;
    pg8::gemm_phase<pg8::EpiBf16Plain, pg8::StaticOrder, false>((PG8_LAS unsigned char*)lds, g, S, E, nullptr);
}
__device__ __forceinline__ void mma_tile(f32x16& acc, const char* A, int lda, const char* B, int ldb, int K, int lane) {
    const int r = lane & 31, kh = lane >> 5;
    const char* ap = A + r * lda + kh * 16; const char* bp = B + r * ldb + kh * 16;
    asm volatile("" : "+v"(acc));
    for (int k = 0; k < K; k += 16) {
        const bf16x8 a = *(const bf16x8*)(ap + k * 2); const bf16x8 b = *(const bf16x8*)(bp + k * 2);
        acc = __builtin_amdgcn_mfma_f32_32x32x16_bf16(a, b, acc, 0, 0, 0);
    }
}
__device__ __forceinline__ int crow32(int r, int hi) { return (r & 3) + 8 * (r >> 2) + 4 * hi; }
__device__ __forceinline__ float log_sigmoid_(float x) { return fminf(x, 0.f) - log1pf(__expf(-fabsf(x))); }

constexpr int GLA_ST = 144;
constexpr int GC_BST = 68;
constexpr int GC_B_BYTES = 4 * 64 * GC_BST * 4, GC_V_BYTES = 4 * 16384;
__device__ __forceinline__ float* gla_gb(const Params& P) { return (float*)((char*)P.ocat_() + (size_t)32 * 1024 * 1024); }
__device__ __forceinline__ float log_sigmoid_fast(float x) { return fminf(x, 0.f) - __logf(1.f + __expf(-fabsf(x))); }

__device__ __forceinline__ void unit_gla_a4(const Params& P, int layer, int ub, char* lds) {
    const int b = ub >> 6, n = ub & 63, tok0 = b * SEQ + n * 64;
    const int tid = TIDX(), wid = tid >> 6, lane = tid & 63, r32 = lane & 31, hi = lane >> 5, h = wid >> 1, eh = wid & 1;
    float* b_s = (float*)lds;
    char* V_s = lds;
    char* K_s = lds + GC_B_BYTES;
    float* glr_s = (float*)(lds + GC_B_BYTES + GC_V_BYTES);
    float* tot_s = glr_s + 1024;
    __syncthreads();
    const bf16_t* prow = P.p_() + (size_t)tok0 * NPAD;
    const bf16x8 glr_raw = *(const bf16x8*)(prow + (size_t)((tid & 127) >> 1) * NPAD + C_GLR + (tid & 1) * 8);
    const int gd = tid & 63, gh = (tid >> 6) & 3, gt = tid >> 8;
    float wu[16];
#pragma unroll
    for (int r = 0; r < 16; ++r) wu[r] = P.gla_w_up[((size_t)layer * 16 + r) * 256 + gh * 64 + gd];
    const float bias = P.gla_b_up[layer * 256 + gh * 64 + gd];
    bf16x8 kraw[4], vs[4][2];
    const int ks_ = tid >> 3, kc = (tid & 7) * 8;
#pragma unroll
    for (int hv = 0; hv < 4; ++hv) kraw[hv] = *(const bf16x8*)(prow + (size_t)ks_ * NPAD + C_GK + hv * 64 + kc);
    const int sr = tid >> 4, sc = (tid & 15) * 8;
#pragma unroll
    for (int hv = 0; hv < 4; ++hv) { vs[hv][0] = *(const bf16x8*)(prow + (size_t)sr * NPAD + C_GV + hv * 128 + sc); vs[hv][1] = *(const bf16x8*)(prow + (size_t)(32 + sr) * NPAD + C_GV + hv * 128 + sc); }
    if (tid < 128) {
#pragma unroll
        for (int j = 0; j < 8; ++j) glr_s[(tid >> 1) * 16 + (tid & 1) * 8 + j] = bf2f((bf16_t)glr_raw[j]); }
    __syncthreads();
    float gv[32]; float run = 0.f;
#pragma unroll
    for (int i = 0; i < 32; ++i) { const float* gr = glr_s + (gt * 32 + i) * 16; float a = bias;
#pragma unroll
        for (int r4 = 0; r4 < 4; ++r4) { const f32x4 g4 = *(const f32x4*)(gr + 4 * r4); a = fmaf(g4[0], wu[4 * r4], a); a = fmaf(g4[1], wu[4 * r4 + 1], a); a = fmaf(g4[2], wu[4 * r4 + 2], a); a = fmaf(g4[3], wu[4 * r4 + 3], a); }
        run += log_sigmoid_fast(a) * (1.f / 16.f); gv[i] = run; }
    if (gt == 0) tot_s[gh * 64 + gd] = run;
    __syncthreads();
    { const float off = gt ? tot_s[gh * 64 + gd] : 0.f; float* bp = b_s + (gh * 64 + gt * 32) * GC_BST + gd;
      float* gp = gla_gb(P) + (size_t)(tok0 + gt * 32) * 256 + gh * 64 + gd;
#pragma unroll
      for (int i = 0; i < 32; ++i) { const float v = gv[i] + off; bp[i * GC_BST] = v; gp[(size_t)i * 256] = v; }
      if (gt) P.glad_()[((size_t)((b * 64 + n) * 4 + gh)) * 64 + gd] = __expf(gv[31] + off); }
    __syncthreads();
#pragma unroll
    for (int hv = 0; hv < 4; ++hv) { const float* br = b_s + (hv * 64 + ks_) * GC_BST + kc; const float* bl = b_s + (hv * 64 + 63) * GC_BST + kc;
        const f32x4 b0 = *(const f32x4*)br, b1 = *(const f32x4*)(br + 4), l0 = *(const f32x4*)bl, l1 = *(const f32x4*)(bl + 4);
        float e[8];
#pragma unroll
        for (int j = 0; j < 8; ++j) e[j] = bf2f((bf16_t)kraw[hv][j]) * __expf((j < 4 ? l0[j] : l1[j - 4]) - (j < 4 ? b0[j] : b1[j - 4]));
        u32x4 w = {att::cvtpk(e[0], e[1]), att::cvtpk(e[2], e[3]), att::cvtpk(e[4], e[5]), att::cvtpk(e[6], e[7])};
        *(u32x4*)(K_s + hv * 16384 + att::v_st(ks_, kc)) = w; }
    __syncthreads();
    { const int vst0 = att::v_st(sr, sc), vst1 = att::v_st(32 + sr, sc);
#pragma unroll
      for (int hv = 0; hv < 4; ++hv) { *(bf16x8*)(V_s + hv * 16384 + vst0) = vs[hv][0]; *(bf16x8*)(V_s + hv * 16384 + vst1) = vs[hv][1]; } }
    __syncthreads();
    const int vb = (int)(uintptr_t)(V_s + h * 16384) + att::v_rd_base(lane), kb = (int)(uintptr_t)(K_s + h * 16384) + att::v_rd_base(lane);
    f32x16 acc[2][2] = {};
    asm volatile("" : "+v"(acc[0][0]), "+v"(acc[0][1]), "+v"(acc[1][0]), "+v"(acc[1][1]));
#define GA_PK(L, H) (bf16x8){L[0], L[1], L[2], L[3], H[0], H[1], H[2], H[3]}
#define GA_STEP(KS) do { \
    const s16x4 k0l = att::tr_read<att::v_rd_off(0, KS, 0)>(kb), k0h = att::tr_read<att::v_rd_off(0, KS, 1)>(kb), k1l = att::tr_read<att::v_rd_off(1, KS, 0)>(kb), k1h = att::tr_read<att::v_rd_off(1, KS, 1)>(kb); \
    s16x4 v0l, v0h, v1l, v1h; \
    if (eh == 0) { v0l = att::tr_read<att::v_rd_off(0, KS, 0)>(vb); v0h = att::tr_read<att::v_rd_off(0, KS, 1)>(vb); v1l = att::tr_read<att::v_rd_off(1, KS, 0)>(vb); v1h = att::tr_read<att::v_rd_off(1, KS, 1)>(vb); } \
    else         { v0l = att::tr_read<att::v_rd_off(2, KS, 0)>(vb); v0h = att::tr_read<att::v_rd_off(2, KS, 1)>(vb); v1l = att::tr_read<att::v_rd_off(3, KS, 0)>(vb); v1h = att::tr_read<att::v_rd_off(3, KS, 1)>(vb); } \
    asm volatile("s_waitcnt lgkmcnt(0)" ::: "memory"); __builtin_amdgcn_sched_barrier(0); \
    acc[0][0] = __builtin_amdgcn_mfma_f32_32x32x16_bf16(GA_PK(v0l, v0h), GA_PK(k0l, k0h), acc[0][0], 0, 0, 0); \
    acc[0][1] = __builtin_amdgcn_mfma_f32_32x32x16_bf16(GA_PK(v0l, v0h), GA_PK(k1l, k1h), acc[0][1], 0, 0, 0); \
    acc[1][0] = __builtin_amdgcn_mfma_f32_32x32x16_bf16(GA_PK(v1l, v1h), GA_PK(k0l, k0h), acc[1][0], 0, 0, 0); \
    acc[1][1] = __builtin_amdgcn_mfma_f32_32x32x16_bf16(GA_PK(v1l, v1h), GA_PK(k1l, k1h), acc[1][1], 0, 0, 0); } while (0)
    GA_STEP(0); GA_STEP(1); GA_STEP(2); GA_STEP(3);
#undef GA_STEP
#undef GA_PK
    float* dst = P.glas_() + ((size_t)((b * 64 + n) * 4 + h)) * 8192;
#pragma unroll
    for (int et = 0; et < 2; ++et)
#pragma unroll
        for (int dt = 0; dt < 2; ++dt)
#pragma unroll
            for (int r = 0; r < 16; ++r) dst[((eh * 2 + et) * 32 + att::crow(r, hi)) * 64 + dt * 32 + r32] = acc[et][dt][r];
    __syncthreads();
}

__device__ __forceinline__ void gla_scan_slice(const Params& P, int idx) {
    {
        const int el = idx & 8191, d = idx & 63, h = (idx >> 13) & 3, b = idx >> 15;
        bf16_t* gst = P.ocat_();
        float S = 0.f;
        for (int n0 = 0; n0 < 64; n0 += 8) {
            float ds[8], dc[8];
#pragma unroll
            for (int i = 0; i < 8; ++i) { const size_t cu = (size_t)((b * 64 + n0 + i) * 4 + h); ds[i] = P.glas_()[cu * 8192 + el]; dc[i] = P.glad_()[cu * 64 + d]; }
#pragma unroll
            for (int i = 0; i < 8; ++i) { const size_t cu = (size_t)((b * 64 + n0 + i) * 4 + h); gst[cu * 8192 + el] = f2bf(S); S = fmaf(dc[i], S, ds[i]); }
        }
    }
}

__device__ __forceinline__ void unit_gla_c4(const Params& P, int layer, int ub, char* lds) {
    const int b = ub >> 6, n = ub & 63, tok0 = b * SEQ + n * 64;
    const int tid = TIDX(), wid = tid >> 6, lane = tid & 63, r32 = lane & 31, hi = lane >> 5, h = wid >> 1, rh = wid & 1;
    float* b_s = (float*)lds;
    char* V_s = lds + GC_B_BYTES;
    __syncthreads();
    const bf16_t* prow = P.p_() + (size_t)tok0 * NPAD;
    bf16x8 qraw[4], kraw[2][4], vs[4][2];
    const int sr = tid >> 4, sc = (tid & 15) * 8;
#pragma unroll
    for (int hv = 0; hv < 4; ++hv) { vs[hv][0] = *(const bf16x8*)(prow + (size_t)sr * NPAD + C_GV + hv * 128 + sc); vs[hv][1] = *(const bf16x8*)(prow + (size_t)(32 + sr) * NPAD + C_GV + hv * 128 + sc); }
    f32x4 braw[8];
    { const float* gp = gla_gb(P) + (size_t)tok0 * 256 + tid * 4;
#pragma unroll
      for (int i = 0; i < 8; ++i) braw[i] = *(const f32x4*)(gp + i * 2048); }
    { const bf16_t* qp = prow + (size_t)(rh * 32 + r32) * NPAD + C_GQ + h * 64 + hi * 8;
#pragma unroll
      for (int d0 = 0; d0 < 4; ++d0) qraw[d0] = *(const bf16x8*)(qp + d0 * 16);
#pragma unroll
      for (int sh = 0; sh < 2; ++sh) { const bf16_t* kp = prow + (size_t)(sh * 32 + r32) * NPAD + C_GK + h * 64 + hi * 8;
#pragma unroll
          for (int d0 = 0; d0 < 4; ++d0) kraw[sh][d0] = *(const bf16x8*)(kp + d0 * 16); } }
    bf16x8 sfr[4][4];
    { const bf16_t* sp = P.ocat_() + ((size_t)((b * 64 + n) * 4 + h)) * 8192 + r32 * 64 + hi * 8;
#pragma unroll
      for (int eb = 0; eb < 4; ++eb)
#pragma unroll
          for (int ds = 0; ds < 4; ++ds) sfr[eb][ds] = *(const bf16x8*)(sp + eb * 32 * 64 + ds * 16); }
    { const int vst0 = att::v_st(sr, sc), vst1 = att::v_st(32 + sr, sc);
#pragma unroll
      for (int hv = 0; hv < 4; ++hv) { *(bf16x8*)(V_s + hv * 16384 + vst0) = vs[hv][0]; *(bf16x8*)(V_s + hv * 16384 + vst1) = vs[hv][1]; } }
#pragma unroll
    for (int i = 0; i < 8; ++i) { const int c = tid + 512 * i, t = c >> 6, c4 = c & 63;
        *(f32x4*)(b_s + ((c4 >> 4) * 64 + t) * GC_BST + (c4 & 15) * 4) = braw[i]; }
    __syncthreads();
    const float* bh = b_s + h * 64 * GC_BST + hi * 8;
    bf16x8 qe[4], qb[4], ke[2][4];
#pragma unroll
    for (int d0 = 0; d0 < 4; ++d0) {
        const f32x4 m0 = *(const f32x4*)(bh + 32 * GC_BST + d0 * 16), m1 = *(const f32x4*)(bh + 32 * GC_BST + d0 * 16 + 4);
        const f32x4 q0 = *(const f32x4*)(bh + (rh * 32 + r32) * GC_BST + d0 * 16), q1 = *(const f32x4*)(bh + (rh * 32 + r32) * GC_BST + d0 * 16 + 4);
        float e1[8], e2[8];
#pragma unroll
        for (int j = 0; j < 8; ++j) { const float mv = j < 4 ? m0[j] : m1[j - 4], bq = j < 4 ? q0[j] : q1[j - 4]; const float q = bf2f((bf16_t)qraw[d0][j]) * 0.125f;
            e1[j] = q * __expf(bq - mv); e2[j] = q * __expf(bq); }
        { u32x4 w = {att::cvtpk(e1[0], e1[1]), att::cvtpk(e1[2], e1[3]), att::cvtpk(e1[4], e1[5]), att::cvtpk(e1[6], e1[7])}; qe[d0] = *reinterpret_cast<bf16x8*>(&w); }
        { u32x4 w = {att::cvtpk(e2[0], e2[1]), att::cvtpk(e2[2], e2[3]), att::cvtpk(e2[4], e2[5]), att::cvtpk(e2[6], e2[7])}; qb[d0] = *reinterpret_cast<bf16x8*>(&w); }
#pragma unroll
        for (int sh = 0; sh < 2; ++sh) {
            const f32x4 k0 = *(const f32x4*)(bh + (sh * 32 + r32) * GC_BST + d0 * 16), k1 = *(const f32x4*)(bh + (sh * 32 + r32) * GC_BST + d0 * 16 + 4);
            float e3[8];
#pragma unroll
            for (int j = 0; j < 8; ++j) { const float mv = j < 4 ? m0[j] : m1[j - 4], bk = j < 4 ? k0[j] : k1[j - 4]; e3[j] = bf2f((bf16_t)kraw[sh][d0][j]) * __expf(mv - bk); }
            u32x4 w = {att::cvtpk(e3[0], e3[1]), att::cvtpk(e3[2], e3[3]), att::cvtpk(e3[4], e3[5]), att::cvtpk(e3[6], e3[7])}; ke[sh][d0] = *reinterpret_cast<bf16x8*>(&w); }
    }
    f32x16 p0 = {}, p1 = {};
    asm volatile("" : "+v"(p0), "+v"(p1));
#pragma unroll
    for (int d0 = 0; d0 < 4; ++d0) { p0 = __builtin_amdgcn_mfma_f32_32x32x16_bf16(ke[0][d0], qe[d0], p0, 0, 0, 0); p1 = __builtin_amdgcn_mfma_f32_32x32x16_bf16(ke[1][d0], qe[d0], p1, 0, 0, 0); }
    { const int t = rh * 32 + r32;
#pragma unroll
      for (int r = 0; r < 16; ++r) { const int s0 = att::crow(r, hi); p0[r] = (s0 <= t) ? p0[r] : 0.f; p1[r] = (32 + s0 <= t) ? p1[r] : 0.f; } }
    bf16x8 pa0, pa1, pa2, pa3;
#define GC_PK4(Pv, BASE, OUT) do { unsigned a0 = att::cvtpk(Pv[BASE + 0], Pv[BASE + 1]), a1 = att::cvtpk(Pv[BASE + 2], Pv[BASE + 3]);   \
    unsigned b0 = att::cvtpk(Pv[BASE + 4], Pv[BASE + 5]), b1 = att::cvtpk(Pv[BASE + 6], Pv[BASE + 7]);                              \
    auto r0 = __builtin_amdgcn_permlane32_swap(a0, b0, false, false); auto r1 = __builtin_amdgcn_permlane32_swap(a1, b1, false, false); \
    u32x4 w = {r0[0], r1[0], r0[1], r1[1]}; OUT = *reinterpret_cast<bf16x8*>(&w); } while (0)
    GC_PK4(p0, 0, pa0); GC_PK4(p0, 8, pa1); GC_PK4(p1, 0, pa2); GC_PK4(p1, 8, pa3);
#undef GC_PK4
    f32x16 o[4] = {};
    asm volatile("" : "+v"(o[0]), "+v"(o[1]), "+v"(o[2]), "+v"(o[3]));
    att::pv_d0(o, (int)(uintptr_t)(V_s + h * 16384) + att::v_rd_base(lane), pa0, pa1, pa2, pa3);
#pragma unroll
    for (int eb = 0; eb < 4; ++eb)
#pragma unroll
        for (int ds = 0; ds < 4; ++ds) o[eb] = __builtin_amdgcn_mfma_f32_32x32x16_bf16(qb[ds], sfr[eb][ds], o[eb], 0, 0, 0);
    __syncthreads();
    float* og_s = (float*)lds + wid * (32 * 132);
#pragma unroll
    for (int r = 0; r < 16; ++r) {
#pragma unroll
        for (int eb = 0; eb < 4; ++eb) og_s[att::crow(r, hi) * 132 + eb * 32 + r32] = o[eb][r]; }
    asm volatile("" ::: "memory");
    { const int row = lane >> 1, half = lane & 1; const float* src = og_s + row * 132 + half * 64;
      f32x4 v[16]; float ss = 0.f;
#pragma unroll
      for (int i = 0; i < 16; ++i) { v[i] = *(const f32x4*)(src + 4 * i); ss += v[i][0] * v[i][0] + v[i][1] * v[i][1] + v[i][2] * v[i][2] + v[i][3] * v[i][3]; }
      ss += shx(ss, 1);
      const float rn = rsqrtf(ss * (1.f / 128.f) + EPS);
      const size_t tok = (size_t)(tok0 + rh * 32 + row);
      const bf16_t* zp = P.p_() + tok * NPAD + C_GZ + h * 128 + half * 64; bf16_t* gp = P.xn_() + tok * MIX + h * 128 + half * 64;
#pragma unroll
      for (int i = 0; i < 8; ++i) { float z[8], g[8]; ld8f(zp + 8 * i, z);
#pragma unroll
          for (int q = 0; q < 4; ++q) { g[q] = v[2 * i][q] * rn * siluf_(z[q]); g[4 + q] = v[2 * i + 1][q] * rn * siluf_(z[4 + q]); }
          st8f(gp + 8 * i, g); } }
    __syncthreads();
}
constexpr int S5P_STRIDE = 2304;
__device__ __forceinline__ void phase_s5_params(const Params& P) {
    for (int idx = blockIdx.x * NTHR + TIDX(); idx < DEPTH * 32 * 64; idx += gridDim.x * NTHR) {
        const int p = idx & 63, lg = idx >> 6;
        const float ar = P.s5_a_re[idx], ai = P.s5_a_im[idx], step = expf(P.s5_log_step[lg]);
        const float mag = expf(ar * step), th = ai * step;
        const float lr = mag * cosf(th), li = mag * sinf(th);
        float* o = P.s5p_() + (size_t)lg * S5P_STRIDE;
        o[2 * p] = lr; o[2 * p + 1] = li;
        { const float mag512 = expf(512.f * ar * step); const double a = 512.0 * (double)th; const double k = rint(a * 0.15915494309189535); const float rf = (float)fma(-k, 6.283185307179586, a);
          o[128 + 2 * p] = mag512 * cosf(rf); o[128 + 2 * p + 1] = mag512 * sinf(rf); }
        const float xr = lr - 1.f, xi = li, den = 1.f / (ar * ar + ai * ai);
        const float fr = (xr * ar + xi * ai) * den, fi = (xi * ar - xr * ai) * den;
        for (int c = 0; c < 16; ++c) { const float br = P.s5_b_re[(size_t)idx * 16 + c], bi = P.s5_b_im[(size_t)idx * 16 + c];
            o[256 + (p * 16 + c) * 2] = fr * br - fi * bi; o[256 + (p * 16 + c) * 2 + 1] = fr * bi + fi * br; }
    }
}
__device__ __forceinline__ float gelu_tanh_(float x) { const float u = 0.7978845608028654f * (x + 0.044715f * x * x * x); const float e = __expf(-2.f * fabsf(u)); const float th = copysignf((1.f - e) / (1.f + e), u); return 0.5f * x * (1.f + th); }

constexpr int S5_XST = 272;
constexpr int S5_UST = 48;
__device__ __forceinline__ float partner32(float v, int hi) { auto rr = __builtin_amdgcn_permlane32_swap(__float_as_uint(v), __float_as_uint(v), false, false); return __uint_as_float(hi ? rr[0] : rr[1]); }
struct S5Ctx { float l0r, l0i, l1r, l1i, q0r, q0i, q1r, q1i, dsk; char* Cm; char* Bb; char* Xs; char* Us; int lane, hi, j, rho; const bf16_t* ubase; bf16_t* ybase; };
template <bool OUT> __device__ __forceinline__ void s5_tile(const S5Ctx& C, int tok0, float& x0r, float& x0i, float& x1r, float& x1i) {
    const int hi = C.hi, j = C.j, lane = C.lane;
    if (hi == 0) { const bf16_t* up = C.ubase + (size_t)(tok0 + j) * NPAD;
        const bf16x8 w0 = *(const bf16x8*)up, w1 = *(const bf16x8*)(up + 8);
        *(bf16x8*)(C.Us + C.rho * S5_UST) = w0; *(bf16x8*)(C.Us + C.rho * S5_UST + 16) = w1; }
    asm volatile("" ::: "memory");
    f32x16 a0 = {}, a1 = {}, a2 = {}, a3 = {};
    mma_tile(a0, C.Us, S5_UST, C.Bb, S5_UST, 16, lane); mma_tile(a1, C.Us, S5_UST, C.Bb + 32 * S5_UST, S5_UST, 16, lane);
    mma_tile(a2, C.Us, S5_UST, C.Bb + 64 * S5_UST, S5_UST, 16, lane); mma_tile(a3, C.Us, S5_UST, C.Bb + 96 * S5_UST, S5_UST, 16, lane);
    float s0r[16], s0i[16], s1r[16], s1i[16];
#pragma unroll
    for (int r = 0; r < 16; ++r) {
        const float n0r = fmaf(C.l0r, x0r, fmaf(-C.l0i, x0i, a0[r])), n0i = fmaf(C.l0r, x0i, fmaf(C.l0i, x0r, a1[r])); x0r = n0r; x0i = n0i; s0r[r] = n0r; s0i[r] = n0i;
        const float n1r = fmaf(C.l1r, x1r, fmaf(-C.l1i, x1i, a2[r])), n1i = fmaf(C.l1r, x1i, fmaf(C.l1i, x1r, a3[r])); x1r = n1r; x1i = n1i; s1r[r] = n1r; s1i[r] = n1i; }
    float z0r = partner32(x0r, hi), z0i = partner32(x0i, hi), z1r = partner32(x1r, hi), z1i = partner32(x1i, hi);
    if (hi == 0) { z0r = 0.f; z0i = 0.f; z1r = 0.f; z1i = 0.f; }
    if (!OUT) {
        x0r += C.q0r * z0r - C.q0i * z0i; x0i += C.q0r * z0i + C.q0i * z0r; x1r += C.q1r * z1r - C.q1i * z1i; x1i += C.q1r * z1i + C.q1i * z1r;
    } else {
#pragma unroll
        for (int r = 0; r < 16; ++r) {
            const float t0r = C.l0r * z0r - C.l0i * z0i, t0i = C.l0r * z0i + C.l0i * z0r; z0r = t0r; z0i = t0i; s0r[r] += t0r; s0i[r] += t0i;
            const float t1r = C.l1r * z1r - C.l1i * z1i, t1i = C.l1r * z1i + C.l1i * z1r; z1r = t1r; z1i = t1i; s1r[r] += t1r; s1i[r] += t1i; }
        x0r = s0r[15]; x0i = s0i[15]; x1r = s1r[15]; x1i = s1i[15];
#pragma unroll
        for (int r = 0; r < 16; ++r) { char* xr_ = C.Xs + (r + 16 * hi) * S5_XST;
            *(bf16_t*)(xr_ + j * 2) = f2bf(s0r[r]); *(bf16_t*)(xr_ + (64 + j) * 2) = f2bf(s0i[r]);
            *(bf16_t*)(xr_ + (32 + j) * 2) = f2bf(s1r[r]); *(bf16_t*)(xr_ + (96 + j) * 2) = f2bf(s1i[r]); }
        asm volatile("" ::: "memory");
        f32x16 acc = {}; mma_tile(acc, C.Xs, S5_XST, C.Cm, S5_XST, 128, lane);
        if (j < 16) {
#pragma unroll
            for (int r = 0; r < 16; ++r) { const int t = crow32(r, hi); const int rt = ((t & 15) & 3) + 8 * ((t & 15) >> 2) + 4 * (t >> 4);
                const float y = acc[r] + C.dsk * bf2f(*(const bf16_t*)(C.Us + rt * S5_UST + j * 2));
                C.ybase[(size_t)(tok0 + t) * 512 + j] = f2bf(gelu_tanh_(y)); } }
        asm volatile("" ::: "memory");
    }
    { const float e0r = partner32(x0r, hi), e0i = partner32(x0i, hi), e1r = partner32(x1r, hi), e1i = partner32(x1i, hi);
      if (hi == 0) { x0r = e0r; x0i = e0i; x1r = e1r; x1i = e1i; } else { x0r = 0.f; x0i = 0.f; x1r = 0.f; x1i = 0.f; } }
}
__device__ __forceinline__ void unit_s5(const Params& P, int layer, int u, char* lds) {
    const int b = u >> 5, g = u & 31, tid = TIDX(), wid = tid >> 6, lane = tid & 63, hi = lane >> 5, j = lane & 31;
    char* Cm = lds;
    char* Bb = Cm + 32 * S5_XST;
    float* ends = (float*)(Bb + 128 * S5_UST);
    char* wbase = (char*)(ends + 8 * 64 * 2) + wid * (32 * S5_XST + 32 * S5_UST);
    const float* sp = P.s5p_() + (size_t)(layer * 32 + g) * S5P_STRIDE;
    __syncthreads();
    for (int i = tid; i < 32 * 128; i += NTHR) { const int c = i >> 7, pp = i & 127; float v = 0.f;
        if (c < 16) v = (pp < 64) ? P.s5_c_re[((size_t)(layer * 32 + g) * 16 + c) * 64 + pp] : -P.s5_c_im[((size_t)(layer * 32 + g) * 16 + c) * 64 + (pp - 64)];
        *(bf16_t*)(Cm + c * S5_XST + pp * 2) = f2bf(v); }
    for (int i = tid; i < 128 * 16; i += NTHR) { const int n = i >> 4, c = i & 15, nt = n >> 5, jj = n & 31, p = (nt >> 1) * 32 + jj;
        *(bf16_t*)(Bb + n * S5_UST + c * 2) = f2bf(sp[256 + (p * 16 + c) * 2 + (nt & 1)]); }
    S5Ctx C; C.Cm = Cm; C.Bb = Bb; C.Xs = wbase; C.Us = wbase + 32 * S5_XST; C.lane = lane; C.hi = hi; C.j = j;
    C.l0r = sp[2 * j]; C.l0i = sp[2 * j + 1]; C.l1r = sp[2 * (32 + j)]; C.l1i = sp[2 * (32 + j) + 1];
    { float q0r = C.l0r, q0i = C.l0i, q1r = C.l1r, q1i = C.l1i;
#pragma unroll
      for (int k = 0; k < 4; ++k) { const float a = q0r * q0r - q0i * q0i, bb = (q0r + q0r) * q0i; q0r = a; q0i = bb; const float c = q1r * q1r - q1i * q1i, d = (q1r + q1r) * q1i; q1r = c; q1i = d; }
      C.q0r = q0r; C.q0i = q0i; C.q1r = q1r; C.q1i = q1i; }
    C.dsk = P.s5_d[layer * 512 + g * 16 + (lane & 15)];
    C.rho = ((j & 15) & 3) + 8 * ((j & 15) >> 2) + 4 * (j >> 4);
    const int tokw = b * SEQ + wid * 512;
    C.ubase = P.p_() + C_SU + g * 16; C.ybase = P.ybuf_() + g * 16;
    float x0r = 0.f, x0i = 0.f, x1r = 0.f, x1i = 0.f;
    __syncthreads();
    for (int sc = 0; sc < 16; ++sc) s5_tile<false>(C, tokw + sc * 32, x0r, x0i, x1r, x1i);
    if (hi == 0) { ends[(wid * 64 + j) * 2] = x0r; ends[(wid * 64 + j) * 2 + 1] = x0i; ends[(wid * 64 + 32 + j) * 2] = x1r; ends[(wid * 64 + 32 + j) * 2 + 1] = x1i; }
    __syncthreads();
    { const float p0r = sp[128 + 2 * j], p0i = sp[128 + 2 * j + 1], p1r = sp[128 + 2 * (32 + j)], p1i = sp[128 + 2 * (32 + j) + 1];
      x0r = 0.f; x0i = 0.f; x1r = 0.f; x1i = 0.f;
      for (int w = 0; w < wid; ++w) { const float e0r = ends[(w * 64 + j) * 2], e0i = ends[(w * 64 + j) * 2 + 1], e1r = ends[(w * 64 + 32 + j) * 2], e1i = ends[(w * 64 + 32 + j) * 2 + 1];
          const float n0r = p0r * x0r - p0i * x0i + e0r, n0i = p0r * x0i + p0i * x0r + e0i, n1r = p1r * x1r - p1i * x1i + e1r, n1i = p1r * x1i + p1i * x1r + e1i;
          x0r = n0r; x0i = n0i; x1r = n1r; x1i = n1i; }
      if (hi) { x0r = 0.f; x0i = 0.f; x1r = 0.f; x1i = 0.f; } }
    for (int sc = 0; sc < 16; ++sc) s5_tile<true>(C, tokw + sc * 32, x0r, x0i, x1r, x1i);
}
constexpr int TOPK = 256;
__device__ __forceinline__ unsigned f2key(float f) { const unsigned u = __float_as_uint(f); return u ^ ((u & 0x80000000u) ? 0xffffffffu : 0x80000000u); }

__device__ __forceinline__ float relu1(float x) { const int b = __float_as_int(x); return __int_as_float(b > 0 ? b : 0); }
#define DSA_MM(acc, rt, kk) acc = __builtin_amdgcn_mfma_f32_32x32x16_bf16(afr[rt][kk], bfr[kk], acc, 0, 0, 0)
#define DSA_HS(acc, rt, q) do { s0 = fmaf(relu1(acc[4 * (q)]), wv[rt][4 * (q)], s0); s1 = fmaf(relu1(acc[4 * (q) + 1]), wv[rt][4 * (q) + 1], s1); \
                                s0 = fmaf(relu1(acc[4 * (q) + 2]), wv[rt][4 * (q) + 2], s0); s1 = fmaf(relu1(acc[4 * (q) + 3]), wv[rt][4 * (q) + 3], s1); } while (0)
#define DSA_SG() do { __builtin_amdgcn_sched_group_barrier(0x8, 1, 0); __builtin_amdgcn_sched_group_barrier(0x2, 8, 0); } while (0)
__device__ __forceinline__ void dsa_score_tile(const bf16x8 (&afr)[4][4], const f32x16 (&wv)[4], const bf16x8 (&bfr)[4], float* sc, int col, int hi) {
    f32x16 accA = {}, accB = {}; asm volatile("" : "+v"(accA), "+v"(accB));
    float s0, s1;
    DSA_MM(accA, 0, 0); DSA_MM(accA, 0, 1); DSA_MM(accA, 0, 2); DSA_MM(accA, 0, 3);
    s0 = 0.f; s1 = 0.f;
    DSA_MM(accB, 1, 0); DSA_HS(accA, 0, 0); DSA_SG(); DSA_MM(accB, 1, 1); DSA_HS(accA, 0, 1); DSA_SG();
    DSA_MM(accB, 1, 2); DSA_HS(accA, 0, 2); DSA_SG(); DSA_MM(accB, 1, 3); DSA_HS(accA, 0, 3); DSA_SG();
    sc[(0 + hi) * 4096 + col] = (s0 + s1) + 0.f;
    accA = (f32x16){}; asm volatile("" : "+v"(accA)); s0 = 0.f; s1 = 0.f;
    DSA_MM(accA, 2, 0); DSA_HS(accB, 1, 0); DSA_SG(); DSA_MM(accA, 2, 1); DSA_HS(accB, 1, 1); DSA_SG();
    DSA_MM(accA, 2, 2); DSA_HS(accB, 1, 2); DSA_SG(); DSA_MM(accA, 2, 3); DSA_HS(accB, 1, 3); DSA_SG();
    sc[(2 + hi) * 4096 + col] = (s0 + s1) + 0.f;
    accB = (f32x16){}; asm volatile("" : "+v"(accB)); s0 = 0.f; s1 = 0.f;
    DSA_MM(accB, 3, 0); DSA_HS(accA, 2, 0); DSA_SG(); DSA_MM(accB, 3, 1); DSA_HS(accA, 2, 1); DSA_SG();
    DSA_MM(accB, 3, 2); DSA_HS(accA, 2, 2); DSA_SG(); DSA_MM(accB, 3, 3); DSA_HS(accA, 2, 3); DSA_SG();
    sc[(4 + hi) * 4096 + col] = (s0 + s1) + 0.f;
    s0 = 0.f; s1 = 0.f;
    DSA_HS(accB, 3, 0); DSA_HS(accB, 3, 1); DSA_HS(accB, 3, 2); DSA_HS(accB, 3, 3);
    sc[(6 + hi) * 4096 + col] = (s0 + s1) + 0.f;
}
#define DSA_CNT4(K0, K1, K2, K3) asm volatile( \
    "v_cmp_ge_u32_e64 %[m0], %[k0], %[cd]\n\tv_cmp_ge_u32_e64 %[m1], %[k1], %[cd]\n\tv_cmp_ge_u32_e64 %[m2], %[k2], %[cd]\n\tv_cmp_ge_u32_e64 %[m3], %[k3], %[cd]\n\t" \
    "v_addc_co_u32_e64 %[a0], %[m0], %[a0], 0, %[m0]\n\tv_addc_co_u32_e64 %[a1], %[m1], %[a1], 0, %[m1]\n\t" \
    "v_addc_co_u32_e64 %[a0], %[m2], %[a0], 0, %[m2]\n\tv_addc_co_u32_e64 %[a1], %[m3], %[a1], 0, %[m3]" \
    : [a0] "+v"(c0), [a1] "+v"(c1), [m0] "=&s"(sm0), [m1] "=&s"(sm1), [m2] "=&s"(sm2), [m3] "=&s"(sm3) \
    : [k0] "v"(K0), [k1] "v"(K1), [k2] "v"(K2), [k3] "v"(K3), [cd] "v"(cand))
#define DSA_CNT8(J0) do { DSA_CNT4(key[(J0)], key[(J0) + 1], key[(J0) + 2], key[(J0) + 3]); DSA_CNT4(key[(J0) + 4], key[(J0) + 5], key[(J0) + 6], key[(J0) + 7]); } while (0)

__device__ __forceinline__ void unit_dsa_index(const Params& P, int u, char* lds) {
    const int b = u & 3, t0 = (511 - (u >> 2)) * 8;
    const int tid = TIDX(), wid = tid >> 6, lane = tid & 63, r32 = lane & 31, hi = lane >> 5;
    float* sc = (float*)lds;
    const bf16_t* pb = P.p_() + (size_t)b * SEQ * NPAD;
    __syncthreads();
    {
        bf16x8 afr[4][4]; f32x16 wv[4];
        const int qsel = (r32 >> 2) & 1, head = (r32 & 3) + 4 * (r32 >> 3);
#pragma unroll
        for (int rt = 0; rt < 4; ++rt) { const bf16_t* qp = pb + (size_t)(t0 + 2 * rt + qsel) * NPAD + C_DIQ + head * 64 + hi * 8;
#pragma unroll
            for (int kk = 0; kk < 4; ++kk) afr[rt][kk] = *(const bf16x8*)(qp + kk * 16);
            const float* wp = P.iw_() + (size_t)(b * SEQ + t0 + 2 * rt + hi) * 16;
#pragma unroll
            for (int i = 0; i < 4; ++i) { const f32x4 w4 = *(const f32x4*)(wp + 4 * i); wv[rt][4 * i] = w4[0]; wv[rt][4 * i + 1] = w4[1]; wv[rt][4 * i + 2] = w4[2]; wv[rt][4 * i + 3] = w4[3]; } }
        const int ntile = (t0 + 7) / 32 + 1;
        const bf16_t* kp = P.ikc_() + (size_t)(b * (SEQ / 32)) * 2048 + lane * 8;
        bf16x8 b0[4], b1[4], b2[4];
#define DSA_LDB(dst, K) do { const bf16_t* kq_ = kp + (size_t)(wid + 8 * (K)) * 2048; _Pragma("unroll") for (int kk = 0; kk < 4; ++kk) dst[kk] = *(const bf16x8*)(kq_ + kk * 512); } while (0)
#define DSA_TILE(buf, K) dsa_score_tile(afr, wv, buf, sc, (wid + 8 * (K)) * 32 + r32, hi)
        const int nk = (ntile - wid + 7) >> 3;
        const int kl = nk > 0 ? nk - 1 : 0;
#define DSA_MIN(a) ((a) < kl ? (a) : kl)
        DSA_LDB(b0, DSA_MIN(0)); DSA_LDB(b1, DSA_MIN(1));
        int k = 0;
        for (; k + 3 <= nk; k += 3) {
            DSA_LDB(b2, k + 2); DSA_TILE(b0, k);
            DSA_LDB(b0, DSA_MIN(k + 3)); DSA_TILE(b1, k + 1);
            DSA_LDB(b1, DSA_MIN(k + 4)); DSA_TILE(b2, k + 2);
        }
        if (k < nk) DSA_TILE(b0, k);
        if (k + 1 < nk) DSA_TILE(b1, k + 1);
#undef DSA_TILE
#undef DSA_MIN
#undef DSA_TILE
#undef DSA_LDB
    }
    __syncthreads();
    {
        const int t = t0 + wid; const float* srow = sc + wid * 4096;
        unsigned key[64];
#pragma unroll
        for (int j = 0; j < 64; ++j) { const int s = j * 64 + lane; key[j] = (s <= t) ? f2key(srow[s]) : 0u; }
        unsigned long long* mout = P.mask_() + (size_t)(b * SEQ + t) * 64;
        unsigned long long myword = 0ull;
        if (t + 1 <= TOPK) {
#pragma unroll
            for (int j = 0; j < 64; ++j) { const unsigned long long m = __ballot(j * 64 + lane <= t); if (lane == j) myword = m; }
        } else {
            const int ngrp = t / 512 + 1;
            unsigned* hist = (unsigned*)(sc + wid * 4096);
            asm volatile("" ::: "memory");
            { const u32x4 zz4 = {0u, 0u, 0u, 0u};
#pragma unroll
              for (int i = 0; i < 16; ++i) *(u32x4*)(hist + (i * 64 + lane) * 4) = zz4; }
            asm volatile("" ::: "memory");
#define DSA_H8(J0) do { _Pragma("unroll") for (int jj = 0; jj < 8; ++jj) atomicAdd(hist + (key[(J0) + jj] >> 20), 1u); } while (0)
            DSA_H8(0);
            if (ngrp > 1) DSA_H8(8);
            if (ngrp > 2) DSA_H8(16);
            if (ngrp > 3) DSA_H8(24);
            if (ngrp > 4) DSA_H8(32);
            if (ngrp > 5) DSA_H8(40);
            if (ngrp > 6) DSA_H8(48);
            if (ngrp > 7) DSA_H8(56);
#undef DSA_H8
            asm volatile("" ::: "memory");
#define DSA_SUFFIX(s) do { _Pragma("unroll") for (int o = 1; o < 64; o <<= 1) { unsigned t_ = (unsigned)__builtin_amdgcn_ds_bpermute(((lane + o) & 63) << 2, (int)(s)); (s) += (lane + o < 64) ? t_ : 0u; } } while (0)
            unsigned mine = 0u;
#pragma unroll
            for (int i = 0; i < 16; ++i) { const u32x4 v4 = *(const u32x4*)(hist + lane * 64 + ((i + lane) & 15) * 4); mine += (v4[0] + v4[1]) + (v4[2] + v4[3]); }
            unsigned suf = mine; DSA_SUFFIX(suf);
            const unsigned long long mL = __ballot(suf - mine < (unsigned)TOPK && suf >= (unsigned)TOPK);
            const int Ls = (int)__builtin_ctzll(mL);
            const unsigned cntA = (unsigned)__builtin_amdgcn_readlane((int)(suf - mine), Ls);
            unsigned h2 = hist[Ls * 64 + lane]; unsigned suf2 = h2; DSA_SUFFIX(suf2);
            const unsigned long long mB = __ballot(cntA + suf2 - h2 < (unsigned)TOPK && cntA + suf2 >= (unsigned)TOPK);
            const int Bs = (int)__builtin_ctzll(mB);
            const unsigned bstar = (unsigned)(Ls * 64 + Bs);
            const unsigned cntAbove = cntA + (unsigned)__builtin_amdgcn_readlane((int)(suf2 - h2), Bs);
            const unsigned inbin = (unsigned)__builtin_amdgcn_readlane((int)h2, Bs);
#undef DSA_SUFFIX
            unsigned T = bstar << 20; int cntT = (int)(cntAbove + inbin);
            if (cntT != TOPK) {
                asm volatile("" ::: "memory");
                int nslot = 0;
#pragma unroll
                for (int j = 0; j < 64; ++j) { if ((key[j] >> 20) == bstar) { hist[nslot * 64 + lane] = key[j]; ++nslot; } }
                asm volatile("" ::: "memory");
                int R = nslot;
#pragma unroll
                for (int o = 32; o >= 1; o >>= 1) { const int other = __builtin_amdgcn_ds_bpermute(((lane ^ o) << 2), R); R = other > R ? other : R; }
                R = __builtin_amdgcn_readfirstlane(R);
                if (R <= 8) {
                    unsigned c[8];
#pragma unroll
                    for (int r = 0; r < 8; ++r) c[r] = (r < nslot) ? hist[r * 64 + lane] : 0u;
                    for (int bit = 19; bit >= 0; --bit) {
                        const unsigned cand = T | (1u << bit); int cnt = (int)cntAbove;
#pragma unroll
                        for (int r = 0; r < 8; ++r) cnt += __popcll(__ballot(c[r] >= cand));
                        if (cnt >= TOPK) { T = cand; cntT = cnt; if (cnt == TOPK) break; }
                    }
                } else {
                    for (int bit = 19; bit >= 0; --bit) {
                        const unsigned cand = T | (1u << bit); unsigned c0 = 0, c1 = 0; unsigned long long sm0, sm1, sm2, sm3;
                        DSA_CNT8(0);
                        if (ngrp > 1) DSA_CNT8(8);
                        if (ngrp > 2) DSA_CNT8(16);
                        if (ngrp > 3) DSA_CNT8(24);
                        if (ngrp > 4) DSA_CNT8(32);
                        if (ngrp > 5) DSA_CNT8(40);
                        if (ngrp > 6) DSA_CNT8(48);
                        if (ngrp > 7) DSA_CNT8(56);
                        const int cl = (int)(c0 + c1);
                        int cnt = 0;
#pragma unroll
                        for (int bb = 0; bb < 7; ++bb) cnt += __popcll(__ballot((cl >> bb) & 1)) << bb;
                        if (cnt >= TOPK) { T = cand; cntT = cnt; if (cnt == TOPK) break; }
                    }
                }
            }
            if (cntT == TOPK) {
#pragma unroll
                for (int j = 0; j < 64; ++j) { const unsigned long long m = __ballot(key[j] >= T); if (lane == j) myword = m; }
            } else {
                int ngt = 0;
#pragma unroll
                for (int j = 0; j < 64; ++j) ngt += __popcll(__ballot(key[j] > T));
                int need = TOPK - ngt;
#pragma unroll
                for (int j = 0; j < 64; ++j) { const unsigned long long eq = __ballot(key[j] == T), gt = __ballot(key[j] > T);
                    const int ne = __popcll(eq); unsigned long long take = eq;
                    if (ne > need) { take = 0ull; int left = need; unsigned long long e2 = eq;
                        while (left > 0) { const unsigned long long lowbit = e2 & (0ull - e2); take |= lowbit; e2 ^= lowbit; --left; } }
                    need -= (ne > need) ? need : ne;
                    const unsigned long long m = gt | take; if (lane == j) myword = m; }
            }
        }
        mout[lane] = myword;
    }
}

struct DsaOutRow { const bf16_t* zb; bf16_t* gb; int wid;
    __device__ __forceinline__ const bf16_t* zrow(int r) const { const int rho = wid * 32 + r; return zb + (size_t)(rho >> 2) * NPAD + (rho & 3) * 128; }
    __device__ __forceinline__ bf16_t* grow(int r) const { const int rho = wid * 32 + r; return gb + (size_t)(rho >> 2) * MIX + (rho & 3) * 128; } };
__device__ __forceinline__ void unit_dsa_attn(const Params& P, int u, char* lds) {
    const int b = u & 3, qb = 63 - (u >> 2), t0 = qb * 64, tokb = b * SEQ;
    const int wid = TIDX() >> 6, lane = TIDX() & 63, r32 = lane & 31, hi = lane >> 5;
    const int rho = wid * 32 + r32, tq = t0 + (rho >> 2), hq = rho & 3;
    const bf16_t* Qw = P.p_() + (size_t)(tokb + tq) * NPAD + C_DQ + hq * 128 + hi * 8;
    const bf16_t* Kh = P.kvc_() + (size_t)tokb * 256;
    const unsigned moff = (unsigned)(tokb + tq) * 512u;
    DsaOutRow ow; ow.zb = P.p_() + (size_t)(tokb + t0) * NPAD + C_DZ; ow.gb = P.xn_() + (size_t)(tokb + t0) * MIX + 1024; ow.wid = wid;
    const int NT = (qb + 2) & ~1;
    att::attn_body<true, 256, 128, DsaOutRow>(Qw, Kh, NT, P.mask_(), moff, ow, lds);
}
__device__ __forceinline__ void phase_gemm_glu(const Params& P, int layer, char* lds) {
    pg8::Gemm g; g.A = P.ybuf_(); g.Bt = P.WgluT_() + (size_t)layer * 512 * 512; g.M = NTOK; g.N = 512; g.K = 512;
    pg8::StaticOrder S; S.init(g.M, g.N, (int)gridDim.x, (int)blockIdx.x);
    pg8::EpiGlu E; E.Y = P.ybuf_(); E.ldy = 512; E.O = P.ocat_(); E.ldo = MIX; E.ooff = 512;
    pg8::gemm_phase<pg8::EpiGlu, pg8::StaticOrder, false>((PG8_LAS unsigned char*)lds, g, S, E, nullptr);
}

constexpr int CTL_Q0 = 4096;
struct OneUnit { int pm, pn; __device__ __forceinline__ bool next(int i, pg8::Unit& u) const { if (i) return false; u.pm = pm; u.pn = pn; return true; }
    __device__ __forceinline__ void a_ready(const pg8::Unit&) const {} __device__ __forceinline__ void done(const pg8::Unit&) const {} };
__device__ __forceinline__ int q_issue(unsigned* ctr) { return (int)__hip_atomic_fetch_add(ctr, 1u, __ATOMIC_RELAXED, __HIP_MEMORY_SCOPE_AGENT); }
#define Q_LOOP_BEGIN(ctr, total)  { unsigned* q_ctr_ = (ctr); const int q_total_ = (total); volatile int* q_b_ = (volatile int*)(lds + LDS_TAIL + 16); \
    for (;;) { __syncthreads(); if (TIDX() == 0) *q_b_ = q_issue(q_ctr_); __syncthreads(); const int item = __builtin_amdgcn_readfirstlane(*q_b_); if (item >= q_total_) break;
#define Q_LOOP_END  } }
__device__ __forceinline__ void unit_glu(const Params& P, int layer, int u, char* lds) {
    pg8::Gemm g; g.A = P.ybuf_(); g.Bt = P.WgluT_() + (size_t)layer * 512 * 512; g.M = NTOK; g.N = 512; g.K = 512;
    OneUnit S; S.pm = u >> 1; S.pn = u & 1;
    pg8::EpiGluGate E; E.Y = P.ybuf_(); E.Pz = P.p_(); E.G = P.xn_();
    pg8::gemm_phase<pg8::EpiGluGate, OneUnit, false>((PG8_LAS unsigned char*)lds, g, S, E, nullptr);
}
constexpr int LDS_TAIL = LDS_BYTES - 64;

__global__ __launch_bounds__(NTHR, 2) void k_mega(Params P) {
    extern __shared__ __attribute__((aligned(16))) char lds[];
    if (TIDX() == 0) *(uint4*)(lds + LDS_TAIL) = make_uint4(0u, 0u, 0u, 0u);
    __syncthreads();
    XcdBarrier bar = xcd_barrier_post(P.ctl_(), (volatile LAS unsigned*)(lds + LDS_TAIL));
    const int G = gridDim.x, B = blockIdx.x;
    phase_prologue1(P, lds); phase_rope_table(P); phase_s5_params(P); phase_rmsnorm_x(P, 0);
    xcd_barrier(bar);
    for (int layer = 0; layer < DEPTH; ++layer) {
        if (layer > 0) { phase_rmsnorm_x(P, layer); xcd_barrier(bar); }
        phase_gemm_in(P, layer, lds);
        if (layer == 0) phase_gemm_kv(P, lds);
        xcd_barrier(bar);
        phase_prep(P, layer);
        if (layer == 0) phase_memk_norm(P);
        for (int u = B; u < 256; u += G) unit_gla_a4(P, layer, u, lds);
        xcd_barrier(bar);
        Q_LOOP_BEGIN(P.ctl_() + CTL_Q0 + 64 * (layer * 2), 128 + 2048 + 256 + 256)
            if (item < 128) unit_s5(P, layer, item, lds);
            else if (item < 2176) unit_dsa_index(P, item - 128, lds);
            else if (item < 2432) unit_mem_attn(P, layer, item - 2176, lds);
            else gla_scan_slice(P, (item - 2432) * NTHR + TIDX());
        Q_LOOP_END
        xcd_barrier(bar);
        Q_LOOP_BEGIN(P.ctl_() + CTL_Q0 + 64 * (layer * 2 + 1), 256 + 256 + 128)
            if (item < 256) unit_dsa_attn(P, item, lds);
            else if (item < 512) unit_gla_c4(P, layer, item - 256, lds);
            else unit_glu(P, layer, item - 512, lds);
        Q_LOOP_END
        xcd_barrier(bar);
        phase_gemm_out(P, layer, lds);
        xcd_barrier(bar);
    }
}

extern "C" void kernel_launch(void* const* d_in, const int* in_sizes, int n_in, void* d_out, int out_size, void* d_ws, size_t ws_size, hipStream_t stream) {
    if (n_in != 24 || ws_size < WS_END) { fprintf(stderr, "kernel_launch: unexpected n_in %d or ws_size %zu (< %zu)\n", n_in, ws_size, (size_t)WS_END); return; }
    Params P; memset(&P, 0, sizeof(P));
    P.x = (const float*)d_in[0]; P.mem = (const float*)d_in[1]; P.pos = (const int*)d_in[2]; P.ln_gain = (const float*)d_in[3]; P.w_in = (const float*)d_in[4];
    P.gla_w_up = (const float*)d_in[5]; P.gla_b_up = (const float*)d_in[6]; P.s5_a_re = (const float*)d_in[7]; P.s5_a_im = (const float*)d_in[8]; P.s5_log_step = (const float*)d_in[9];
    P.s5_b_re = (const float*)d_in[10]; P.s5_b_im = (const float*)d_in[11]; P.s5_c_re = (const float*)d_in[12]; P.s5_c_im = (const float*)d_in[13]; P.s5_d = (const float*)d_in[14];
    P.s5_w_glu = (const float*)d_in[15]; P.dsa_q_norm = (const float*)d_in[16]; P.dsa_k_norm = (const float*)d_in[17]; P.mem_norm = (const float*)d_in[18]; P.w_mem_kv = (const float*)d_in[19];
    P.mem_q_norm = (const float*)d_in[20]; P.mem_k_norm = (const float*)d_in[21]; P.out_norm = (const float*)d_in[22]; P.w_out = (const float*)d_in[23];
    P.out = (float*)d_out;
    char* ws = (char*)d_ws; P.ws = ws;
    static int grid = 0;
    if (!grid) {
        int dev = 0, cus = 0, per_cu = 0;
        (void)hipGetDevice(&dev); (void)hipDeviceGetAttribute(&cus, hipDeviceAttributeMultiprocessorCount, dev);
        (void)hipFuncSetAttribute((const void*)k_mega, hipFuncAttributeMaxDynamicSharedMemorySize, LDS_BYTES);
        (void)hipOccupancyMaxActiveBlocksPerMultiprocessor(&per_cu, (const void*)k_mega, NTHR, LDS_BYTES);
        if (per_cu < 1) fprintf(stderr, "kernel_launch: occupancy query reports %d blocks per CU\n", per_cu);
        grid = cus > 0 ? cus : 256;
    }
    (void)hipMemsetAsync(ws + WS_CTL, 0, CTL_BYTES, stream);
    hipLaunchKernelGGL(k_mega, dim3(grid), dim3(NTHR), LDS_BYTES, stream, P);
}
```

```cpp
#include <hip/hip_runtime.h>
#include <stdint.h>
#include <stdio.h>
#include <string.h>

constexpr int NB = 4, SEQ = 4096, NTOK = NB * SEQ, DM = 2048, DEPTH = 4, MEML = 256;
constexpr int NIN = 5984, NPAD = 6144, MIX = 2048;
constexpr int C_GQ = 0, C_GK = 256, C_GV = 512, C_GLR = 1024, C_GZ = 1040, C_SU = 1552, C_SZ = 2064, C_DQ = 2576, C_DK = 3088, C_DV = 3216,
              C_DIQ = 3344, C_DIK = 4368, C_DIW = 4432, C_DZ = 4448, C_MQ = 4960, C_MZ = 5472;
constexpr float EPS = 1e-6f;
constexpr int NTHR = 512;
constexpr int LDS_BYTES = 147456;

typedef unsigned short bf16_t;
typedef short bf16x8 __attribute__((ext_vector_type(8)));
typedef short s16x4 __attribute__((ext_vector_type(4)));
typedef float f32x4 __attribute__((ext_vector_type(4)));
typedef float f32x8 __attribute__((ext_vector_type(8)));
typedef float f32x16 __attribute__((ext_vector_type(16)));
typedef unsigned u32x4 __attribute__((ext_vector_type(4)));
typedef unsigned u32x2 __attribute__((ext_vector_type(2)));
#define LAS __attribute__((address_space(3)))

__device__ __forceinline__ float bf2f(bf16_t b) { return __uint_as_float(((unsigned)b) << 16); }
__device__ __forceinline__ bf16_t f2bf(float f) { unsigned u = __float_as_uint(f); u += 0x7FFFu + ((u >> 16) & 1u); return (bf16_t)(u >> 16); }
__device__ __forceinline__ unsigned pk2bf(float lo, float hi) { return (unsigned)f2bf(lo) | ((unsigned)f2bf(hi) << 16); }
__device__ __forceinline__ float sigmoidf_(float x) { return 1.f / (1.f + __expf(-x)); }
__device__ __forceinline__ float siluf_(float x) { return x / (1.f + __expf(-x)); }

__device__ __forceinline__ int TIDX() { int t = (int)threadIdx.x; asm volatile("" : "+v"(t)); return t; }
__device__ __forceinline__ float shx(float v, int m) { const int src = ((TIDX() & 63) ^ m) << 2; return __int_as_float(__builtin_amdgcn_ds_bpermute(src, __float_as_int(v))); }
__device__ __forceinline__ float wave_sum(float v) {
#pragma unroll
    for (int o = 32; o >= 1; o >>= 1) v += shx(v, o);
    return v;
}
__device__ __forceinline__ void ld8f(const bf16_t* p, float (&v)[8]) { const u32x4 w = *(const u32x4*)p;
#pragma unroll
    for (int j = 0; j < 4; ++j) { v[2 * j] = __uint_as_float(w[j] << 16); v[2 * j + 1] = __uint_as_float(w[j] & 0xffff0000u); } }
__device__ __forceinline__ void st8f(bf16_t* p, const float (&v)[8]) { u32x4 w; w.x = pk2bf(v[0], v[1]); w.y = pk2bf(v[2], v[3]); w.z = pk2bf(v[4], v[5]); w.w = pk2bf(v[6], v[7]); *(u32x4*)p = w; }
__device__ __forceinline__ float f2bf_f(float f) { return bf2f(f2bf(f)); }

#ifndef TPROBE
#define TPROBE 0
#endif
#if TPROBE
#define TPU_START(id) do { if (TPROBE == (id) && TIDX() == 0) *(volatile unsigned long long*)(lds + LDS_BYTES - 24) = __builtin_amdgcn_s_memrealtime(); } while (0)
#define TPU_STOP(id) do { if (TPROBE == (id) && TIDX() == 0) *(volatile unsigned long long*)(lds + LDS_BYTES - 32) += __builtin_amdgcn_s_memrealtime() - *(volatile unsigned long long*)(lds + LDS_BYTES - 24); } while (0)
#else
#define TPU_START(id) do {} while (0)
#define TPU_STOP(id) do {} while (0)
#endif
#define XB_TMO      128
#define XB_XCNT(j)  (256  + 64 * (j))
#define XB_XSUB(j)  (1280 + 64 * (j))
#define XB_XGEN(j)  (2304 + 64 * (j))
#define XB_TOP      3328
#define XB_TOPGEN   3392
#define XCD_BAR_WORDS 3456
#define XB_SPIN_CAP (1u << 18)

__device__ __forceinline__ unsigned xb_ld(unsigned* p)              { return __hip_atomic_load(p, __ATOMIC_RELAXED, __HIP_MEMORY_SCOPE_AGENT); }
__device__ __forceinline__ unsigned xb_add(unsigned* p, unsigned v) { return __hip_atomic_fetch_add(p, v, __ATOMIC_RELAXED, __HIP_MEMORY_SCOPE_AGENT); }
__device__ __forceinline__ unsigned xb_xcc_id() { return (unsigned)__builtin_amdgcn_s_getreg((3 << 11) | 20) & 0xFu; }
#define XB_SPIN(cond, bar) do { unsigned _sp = 0; while (cond) { __builtin_amdgcn_s_sleep(1); \
    if ((++_sp & 255u) == 0u) { if (xb_ld(&(bar)[XB_TMO])) break; if (_sp > XB_SPIN_CAP) { atomicAdd(&(bar)[XB_TMO], 1u); break; } } } } while (0)

struct XcdBarrier {
    unsigned* bar; unsigned x;
    volatile LAS unsigned* st;
};

__device__ __forceinline__ XcdBarrier xcd_barrier_post(unsigned* bar, volatile LAS unsigned* st) {
    XcdBarrier b; b.bar = bar; b.x = xb_xcc_id(); b.st = st;
    if (TIDX() == 0) (void)xb_add(&bar[XB_XCNT(b.x)], 1u);
    return b;
}
__device__ __forceinline__ void xcd_barrier_complete(unsigned* bar, unsigned x, unsigned& nloc, unsigned& nx) {
    const unsigned G = gridDim.x * gridDim.y * gridDim.z;
    unsigned sum, cnt, mine, sp = 0u;
    for (;;) {
        sum = 0u; cnt = 0u; mine = 0u;
#pragma unroll
        for (unsigned j = 0; j < 16; ++j) { const unsigned c = xb_ld(&bar[XB_XCNT(j)]); sum += c; cnt += (c > 0u) ? 1u : 0u; mine = (j == x) ? c : mine; }
        if (sum == G) break;
        __builtin_amdgcn_s_sleep(1);
        if ((++sp & 255u) == 0u) { if (xb_ld(&bar[XB_TMO])) break; if (sp > XB_SPIN_CAP) { atomicAdd(&bar[XB_TMO], 1u); break; } }
    }
    nloc = mine > 0u ? mine : 1u; nx = cnt > 0u ? cnt : 1u;
}

__device__ __forceinline__ void xcd_barrier(const XcdBarrier& b) {
    asm volatile("s_waitcnt vmcnt(0)" ::: "memory");
    __syncthreads();
    if (TIDX() == 0) {
        unsigned* bar = b.bar; const unsigned bx = xb_xcc_id();
        __builtin_amdgcn_s_waitcnt(0);
        unsigned nloc = b.st[0], nx = b.st[1];
        if (nloc == 0u) { xcd_barrier_complete(bar, bx, nloc, nx); b.st[0] = nloc; b.st[1] = nx; }
        const unsigned old = xb_add(&bar[XB_XSUB(bx)], 1u);
        const unsigned gen = old / nloc;
        if (old + 1u == (gen + 1u) * nloc) {
            __builtin_amdgcn_fence(__ATOMIC_RELEASE, "agent");
            asm volatile("s_waitcnt vmcnt(0)" ::: "memory");
            const unsigned og = xb_add(&bar[XB_TOP], 1u);
            const unsigned tg = og / nx;
            if (og + 1u == (tg + 1u) * nx) xb_add(&bar[XB_TOPGEN], 1u);
            else XB_SPIN(xb_ld(&bar[XB_TOPGEN]) == tg, bar);
            __builtin_amdgcn_fence(__ATOMIC_ACQUIRE, "agent");
            xb_add(&bar[XB_XGEN(bx)], 1u);
            asm volatile("s_waitcnt vmcnt(0)" ::: "memory");
        } else {
            XB_SPIN(xb_ld(&bar[XB_XGEN(bx)]) == gen, bar);
            __builtin_amdgcn_fence(__ATOMIC_ACQUIRE, "agent");
            asm volatile("s_waitcnt vmcnt(0)" ::: "memory");
        }
    }
    __syncthreads();
}
namespace pg8 {
#define PG8_LAS __attribute__((address_space(3)))
typedef float f32x2 __attribute__((ext_vector_type(2)));
typedef unsigned u32x4 __attribute__((ext_vector_type(4)));
constexpr int BM = 256, BK = 64, HALF = 128, HTB = HALF * BK * 2  , STAGE_BYTES = 8 * HTB, NXCD = 8, WGM = 8;

__host__ __device__ __forceinline__ int lds_byte(int r, int c) { const int st = (r >> 4) * 2 + (c >> 5), rr = r & 15, cc = c & 31, ob = rr * 64 + cc * 2; return st * 1024 + (ob ^ (((ob >> 9) & 1) << 5)); }
__host__ __device__ __forceinline__ void stage_rc(int b, int& R, int& C) { const int st = b / 1024, sb = b % 1024, swz = sb ^ (((sb >> 9) & 1) << 5); R = (st >> 1) * 16 + swz / 64; C = (st & 1) * 32 + (swz % 64) / 2; }
__host__ __device__ __forceinline__ int perm32(int rho) { const int n = rho >> 4, i = rho & 15; return 8 * (i >> 2) + 4 * n + (i & 3); }

struct Unit { int pm, pn; };
struct Gemm { const bf16_t* A; const bf16_t* Bt; int M, N, K; };

struct StaticOrder {
    int nM, nN, nwg, G, c;
    __host__ __device__ void init(int M, int N, int G_, int c_) { nM = M / BM; nN = N / BM; nwg = nM * nN; G = G_; c = c_; }
    __host__ __device__ bool next(int i, Unit& u) const {
        const long L = (long)i * G + c; if (L >= nwg) return false;
        int wgid = (int)L; { const int q = nwg / NXCD, r = nwg % NXCD, xcd = wgid % NXCD, off = wgid / NXCD; wgid = (xcd < r ? xcd * (q + 1) : r * (q + 1) + (xcd - r) * q) + off; }
        const int nig = WGM * nN, gid = wgid / nig, fm = gid * WGM, gsz = (nM - fm) < WGM ? (nM - fm) : WGM;
        u.pm = fm + ((wgid % nig) % gsz); u.pn = (wgid % nig) / gsz; return true;
    }
    __device__ __forceinline__ void a_ready(const Unit&) const {}
    __device__ __forceinline__ void done(const Unit&) const {}
};
__device__ __forceinline__ unsigned cvt_pk_bf16(float lo, float hi) { unsigned r; asm volatile("v_cvt_pk_bf16_f32 %0, %1, %2" : "=v"(r) : "v"(lo), "v"(hi)); return r; }
struct EpiBf16Plain {
    static constexpr bool PERM = true, AFTER_DRAIN = false;
    bf16_t* O; int ldc;
    __device__ __forceinline__ void operator()(const f32x4 (&acc)[2][2][4][2], const Unit& u, int wr, int wc, int fr, int fq) const {
        const int row0 = u.pm * BM + wr * 64 + fr, col0 = u.pn * BM + wc * 32 + 8 * fq;
#pragma unroll
        for (int ai = 0; ai < 2; ++ai)
#pragma unroll
            for (int m = 0; m < 4; ++m) { bf16_t* rowp = O + (size_t)(row0 + ai * HALF + m * 16) * ldc + col0;
#pragma unroll
                for (int bj = 0; bj < 2; ++bj) { const f32x4 v0 = acc[ai][bj][m][0], v1 = acc[ai][bj][m][1];
                    u32x4 w; w.x = cvt_pk_bf16(v0[0], v0[1]); w.y = cvt_pk_bf16(v0[2], v0[3]); w.z = cvt_pk_bf16(v1[0], v1[1]); w.w = cvt_pk_bf16(v1[2], v1[3]);
                    *(u32x4*)(rowp + bj * HALF) = w; } }
    }
};
struct EpiResid {
    static constexpr bool PERM = false, AFTER_DRAIN = false;
    const float* R; float* C; int ldc;
    __device__ __forceinline__ void operator()(const f32x4 (&acc)[2][2][4][2], const Unit& u, int wr, int wc, int fr, int fq) const {
        const int row0 = u.pm * BM + wr * 64 + fr, col0 = u.pn * BM + wc * 32 + 4 * fq;
#pragma unroll
        for (int ai = 0; ai < 2; ++ai)
#pragma unroll
            for (int m = 0; m < 4; ++m) { const size_t off = (size_t)(row0 + ai * HALF + m * 16) * ldc + col0;
#pragma unroll
                for (int bj = 0; bj < 2; ++bj)
#pragma unroll
                    for (int n = 0; n < 2; ++n) { const f32x4 r = *(const f32x4*)(R + off + bj * HALF + n * 16); *(f32x4*)(C + off + bj * HALF + n * 16) = acc[ai][bj][m][n] + r; } }
    }
};
struct EpiResidMix {
    static constexpr bool PERM = true, AFTER_DRAIN = false;
    const void* R; void* C; int ldc; int r16, c16;
    __device__ __forceinline__ void operator()(const f32x4 (&acc)[2][2][4][2], const Unit& u, int wr, int wc, int fr, int fq) const {
        const int row0 = u.pm * BM + wr * 64 + fr, col0 = u.pn * BM + wc * 32 + 8 * fq;
#pragma unroll
        for (int ai = 0; ai < 2; ++ai)
#pragma unroll
            for (int m = 0; m < 4; ++m) { const size_t off = (size_t)(row0 + ai * HALF + m * 16) * ldc + col0;
                f32x4 r0[2], r1[2];
                if (r16) {
#pragma unroll
                    for (int bj = 0; bj < 2; ++bj) { const u32x4 w = *(const u32x4*)((const bf16_t*)R + off + bj * HALF);
                        r0[bj] = f32x4{__uint_as_float(w.x << 16), __uint_as_float(w.x & 0xffff0000u), __uint_as_float(w.y << 16), __uint_as_float(w.y & 0xffff0000u)};
                        r1[bj] = f32x4{__uint_as_float(w.z << 16), __uint_as_float(w.z & 0xffff0000u), __uint_as_float(w.w << 16), __uint_as_float(w.w & 0xffff0000u)}; }
                } else {
#pragma unroll
                    for (int bj = 0; bj < 2; ++bj) { r0[bj] = *(const f32x4*)((const float*)R + off + bj * HALF); r1[bj] = *(const f32x4*)((const float*)R + off + bj * HALF + 4); }
                }
#pragma unroll
                for (int bj = 0; bj < 2; ++bj) { const f32x4 v0 = acc[ai][bj][m][0] + r0[bj], v1 = acc[ai][bj][m][1] + r1[bj];
                    if (c16) { u32x4 w; w.x = cvt_pk_bf16(v0[0], v0[1]); w.y = cvt_pk_bf16(v0[2], v0[3]); w.z = cvt_pk_bf16(v1[0], v1[1]); w.w = cvt_pk_bf16(v1[2], v1[3]);
                        *(u32x4*)((bf16_t*)C + off + bj * HALF) = w; }
                    else { *(f32x4*)((float*)C + off + bj * HALF) = v0; *(f32x4*)((float*)C + off + bj * HALF + 4) = v1; } } }
    }
};
struct EpiGlu {
    static constexpr bool PERM = true, AFTER_DRAIN = false;
    const bf16_t* Y; int ldy; bf16_t* O; int ldo; int ooff;
    __device__ __forceinline__ void operator()(const f32x4 (&acc)[2][2][4][2], const Unit& u, int wr, int wc, int fr, int fq) const {
        const int row0 = u.pm * BM + wr * 64 + fr, col0 = u.pn * BM + wc * 32 + 8 * fq;
#pragma unroll
        for (int ai = 0; ai < 2; ++ai)
#pragma unroll
            for (int m = 0; m < 4; ++m) { const int row = row0 + ai * HALF + m * 16;
#pragma unroll
                for (int bj = 0; bj < 2; ++bj) { const f32x4 v0 = acc[ai][bj][m][0], v1 = acc[ai][bj][m][1];
                    const u32x4 yw = *(const u32x4*)(Y + (size_t)row * ldy + col0 + bj * HALF);
                    float y[8], g[8];
#pragma unroll
                    for (int j = 0; j < 4; ++j) { y[2 * j] = __uint_as_float(yw[j] << 16); y[2 * j + 1] = __uint_as_float(yw[j] & 0xffff0000u); }
#pragma unroll
                    for (int j = 0; j < 4; ++j) { g[j] = 1.f / (1.f + __expf(-v0[j])); g[4 + j] = 1.f / (1.f + __expf(-v1[j])); }
                    u32x4 w; w.x = cvt_pk_bf16(y[0] * g[0], y[1] * g[1]); w.y = cvt_pk_bf16(y[2] * g[2], y[3] * g[3]); w.z = cvt_pk_bf16(y[4] * g[4], y[5] * g[5]); w.w = cvt_pk_bf16(y[6] * g[6], y[7] * g[7]);
                    *(u32x4*)(O + (size_t)row * ldo + ooff + col0 + bj * HALF) = w; } }
    }
};
struct EpiGluGate {
    static constexpr bool PERM = true, AFTER_DRAIN = true;
    const bf16_t* Y; const bf16_t* Pz; bf16_t* G;
    __device__ __forceinline__ void fused(const f32x4 (&acc)[2][2][4][2], const Unit& u, int wr, int wc, int fr, int fq, PG8_LAS unsigned char* lds, int wid, int lane) const {
        constexpr int TS = 528;
        const int row0 = wr * 64 + fr, col0 = wc * 32 + 8 * fq;
#pragma unroll
        for (int ai = 0; ai < 2; ++ai)
#pragma unroll
            for (int m = 0; m < 4; ++m) { const int rl = row0 + ai * HALF + m * 16; const size_t grow = (size_t)u.pm * BM + rl;
#pragma unroll
                for (int bj = 0; bj < 2; ++bj) { const f32x4 v0 = acc[ai][bj][m][0], v1 = acc[ai][bj][m][1];
                    const u32x4 yw = *(const u32x4*)(Y + grow * 512 + u.pn * BM + col0 + bj * HALF);
                    float y[8], g[8];
#pragma unroll
                    for (int j = 0; j < 4; ++j) { y[2 * j] = __uint_as_float(yw[j] << 16); y[2 * j + 1] = __uint_as_float(yw[j] & 0xffff0000u); }
#pragma unroll
                    for (int j = 0; j < 4; ++j) { g[j] = 1.f / (1.f + __expf(-v0[j])); g[4 + j] = 1.f / (1.f + __expf(-v1[j])); }
                    u32x4 w; w.x = cvt_pk_bf16(y[0] * g[0], y[1] * g[1]); w.y = cvt_pk_bf16(y[2] * g[2], y[3] * g[3]); w.z = cvt_pk_bf16(y[4] * g[4], y[5] * g[5]); w.w = cvt_pk_bf16(y[6] * g[6], y[7] * g[7]);
                    *(PG8_LAS u32x4*)(lds + rl * TS + (col0 + bj * HALF) * 2) = w; } }
        __syncthreads();
        { const int t = wid * 64 + lane, row = t >> 1, hd = t & 1; const PG8_LAS unsigned char* src = lds + row * TS + hd * 256;
          float ss = 0.f;
#pragma unroll
          for (int i = 0; i < 16; ++i) { const u32x4 w = *(const PG8_LAS u32x4*)(src + 16 * i);
#pragma unroll
              for (int j = 0; j < 4; ++j) { const float a = __uint_as_float(w[j] << 16), b = __uint_as_float(w[j] & 0xffff0000u); ss += a * a + b * b; } }
          const float rn = rsqrtf(ss * (1.f / 128.f) + 1e-6f);
          const size_t grow = (size_t)u.pm * BM + row; const int cb = u.pn * BM + hd * 128;
          const bf16_t* zp = Pz + grow * 6144 + 2064 + cb; bf16_t* gp = G + grow * 2048 + 512 + cb;
#pragma unroll
          for (int i = 0; i < 16; ++i) { const u32x4 w = *(const PG8_LAS u32x4*)(src + 16 * i); const u32x4 zw = *(const u32x4*)(zp + 8 * i); u32x4 o;
#pragma unroll
              for (int j = 0; j < 4; ++j) { const float a = __uint_as_float(w[j] << 16), b = __uint_as_float(w[j] & 0xffff0000u), za = __uint_as_float(zw[j] << 16), zb = __uint_as_float(zw[j] & 0xffff0000u);
                  o[j] = cvt_pk_bf16(a * rn * (za / (1.f + __expf(-za))), b * rn * (zb / (1.f + __expf(-zb)))); }
              *(u32x4*)(gp + 8 * i) = o; } }
        __syncthreads();
    }
};
struct EpiBf16Scale {
    static constexpr bool PERM = true, AFTER_DRAIN = false;
    bf16_t* O; int ldc; const float* ssq;
    __device__ __forceinline__ void operator()(const f32x4 (&acc)[2][2][4][2], const Unit& u, int wr, int wc, int fr, int fq) const {
        const int row0 = u.pm * BM + wr * 64 + fr, col0 = u.pn * BM + wc * 32 + 8 * fq;
#pragma unroll
        for (int ai = 0; ai < 2; ++ai)
#pragma unroll
            for (int m = 0; m < 4; ++m) { const int row = row0 + ai * HALF + m * 16; bf16_t* rowp = O + (size_t)row * ldc + col0;
                float ssum = 0.f; { const f32x4* sp_ = (const f32x4*)(ssq + (size_t)row * 32);
#pragma unroll
                    for (int q = 0; q < 8; ++q) { const f32x4 t4 = sp_[q]; ssum += (t4[0] + t4[1]) + (t4[2] + t4[3]); } }
                const float s = rsqrtf(ssum * (1.f / 2048.f) + 1e-6f);
#pragma unroll
                for (int bj = 0; bj < 2; ++bj) { const f32x4 v0 = acc[ai][bj][m][0] * s, v1 = acc[ai][bj][m][1] * s;
                    u32x4 w; w.x = cvt_pk_bf16(v0[0], v0[1]); w.y = cvt_pk_bf16(v0[2], v0[3]); w.z = cvt_pk_bf16(v1[0], v1[1]); w.w = cvt_pk_bf16(v1[2], v1[3]);
                    *(u32x4*)(rowp + bj * HALF) = w; } }
    }
};
struct EpiResidNext {
    static constexpr bool PERM = false, AFTER_DRAIN = false;
    const float* R; float* C; int ldc; bf16_t* XB; float* ssq;
    __device__ __forceinline__ void operator()(const f32x4 (&acc)[2][2][4][2], const Unit& u, int wr, int wc, int fr, int fq) const {
        const int row0 = u.pm * BM + wr * 64 + fr, col0 = u.pn * BM + wc * 32 + 4 * fq;
#pragma unroll
        for (int ai = 0; ai < 2; ++ai)
#pragma unroll
            for (int m = 0; m < 4; ++m) { const int row = row0 + ai * HALF + m * 16; const size_t off = (size_t)row * ldc + col0; float ss = 0.f;
#pragma unroll
                for (int bj = 0; bj < 2; ++bj)
#pragma unroll
                    for (int n = 0; n < 2; ++n) { const f32x4 r = *(const f32x4*)(R + off + bj * HALF + n * 16); const f32x4 v = acc[ai][bj][m][n] + r;
                        *(f32x4*)(C + off + bj * HALF + n * 16) = v;
                        if (XB) { u32x2 w; w.x = cvt_pk_bf16(v[0], v[1]); w.y = cvt_pk_bf16(v[2], v[3]); *(u32x2*)(XB + off + bj * HALF + n * 16) = w; }
                        ss += v[0] * v[0] + v[1] * v[1] + v[2] * v[2] + v[3] * v[3]; }
                if (ssq) { ss += shx(ss, 16); ss += shx(ss, 32); if (fq == 0) ssq[(size_t)row * 32 + u.pn * 4 + wc] = ss; } }
    }
};
template <class Epi, class Sched, bool STAMP = false>
__device__ __forceinline__ void gemm_phase(PG8_LAS unsigned char* lds, const Gemm g, const Sched& S, const Epi& E, unsigned long long* stamps) {
    const int tid = TIDX(), wid = __builtin_amdgcn_readfirstlane(tid >> 6), lane = tid & 63, wr = wid >> 2, wc = wid & 3, fr = lane & 15, fq = lane >> 4;
    const int K = g.K, nt = K / BK;
    int ts_lo = 0, ts_hi = 0, nts = 0; const unsigned long long rt_entry = STAMP ? (unsigned long long)wall_clock64() : 0ull;
#define PG8_STAMP() do { if (STAMP && wid == 0 && nts < 64) { const unsigned long long _c = (unsigned long long)clock64(); \
        ts_lo = (lane == nts) ? (int)(unsigned)_c : ts_lo; ts_hi = (lane == nts) ? (int)(unsigned)(_c >> 32) : ts_hi; ++nts; } } while (0)
    PG8_STAMP();
    unsigned voffA[2], voffB[2];
#pragma unroll
    for (int i = 0; i < 2; ++i) { int R, C; stage_rc(tid * 16 + i * 8192, R, C); const int Rb = Epi::PERM ? ((R & ~31) + perm32(R & 31)) : R;
        voffA[i] = (unsigned)(R * K + C) * 2u; voffB[i] = (unsigned)(Rb * K + C) * 2u; }
    const size_t kstep = (size_t)(BK * 2);
    const size_t hstep = (size_t)HALF * K * 2;
    const size_t tstep = 2 * hstep;
    const unsigned ldsw = (unsigned)wid * 1024u;
    const int aoff = lds_byte(wr * 64 + fr, fq * 8), boff = lds_byte(wc * 32 + fr, fq * 8);
#define PG8_SA(b, h) (((b) * 2 + (h)) * HTB)
#define PG8_SB(b, h) ((4 + (b) * 2 + (h)) * HTB)
#define PG8_STAGE(bufoff, gbase, voff) do { _Pragma("unroll") for (int _i = 0; _i < 2; ++_i) \
        __builtin_amdgcn_global_load_lds((const unsigned*)((const char*)(gbase) + (voff)[_i]), (PG8_LAS unsigned*)(lds + (bufoff) + ldsw + _i * 8192), 16, 0, 0); } while (0)
#define PG8_LDA(dst, b, h) do { _Pragma("unroll") for (int m = 0; m < 4; ++m) _Pragma("unroll") for (int k = 0; k < 2; ++k) dst[m][k] = *(const PG8_LAS bf16x8*)(lds + PG8_SA(b, h) + aoff + m * 2048 + k * 1024); } while (0)
#define PG8_LDB(dst, b, h) do { _Pragma("unroll") for (int n = 0; n < 2; ++n) _Pragma("unroll") for (int k = 0; k < 2; ++k) dst[n][k] = *(const PG8_LAS bf16x8*)(lds + PG8_SB(b, h) + boff + n * 2048 + k * 1024); } while (0)
#define PG8_MMA(ai, bj, At, Bt) do { __builtin_amdgcn_s_setprio(1); _Pragma("unroll") for (int m = 0; m < 4; ++m) _Pragma("unroll") for (int n = 0; n < 2; ++n) _Pragma("unroll") for (int k = 0; k < 2; ++k) \
        acc[ai][bj][m][n] = __builtin_amdgcn_mfma_f32_16x16x32_bf16(Bt[n][k], At[m][k], acc[ai][bj][m][n], 0, 0, 0); __builtin_amdgcn_s_setprio(0); } while (0)
#define PG8_WAIT_V(n) asm volatile("s_waitcnt vmcnt(" #n ")" ::: "memory")
#define PG8_WAIT_L(n) asm volatile("s_waitcnt lgkmcnt(" #n ")" ::: "memory")
#define PG8_BAR __builtin_amdgcn_s_barrier()
#define PG8_SCHED __builtin_amdgcn_sched_barrier(0)
    Unit cur, nxt; int ui = 0;
    if (!S.next(0, cur)) return;
    f32x4 acc[2][2][4][2];
#pragma unroll
    for (int a = 0; a < 2; ++a)
#pragma unroll
        for (int b = 0; b < 2; ++b)
#pragma unroll
            for (int m = 0; m < 4; ++m)
#pragma unroll
                for (int n = 0; n < 2; ++n) acc[a][b][m][n] = (f32x4){0.f, 0.f, 0.f, 0.f};
    bf16x8 At[4][2], B0[2][2], B1[2][2];
    const char* cA = (const char*)g.A + (size_t)cur.pm * tstep; const char* cB = (const char*)g.Bt + (size_t)cur.pn * tstep;
    S.a_ready(cur);
    PG8_STAGE(PG8_SB(0, 0), cB, voffB); PG8_STAGE(PG8_SA(0, 0), cA, voffA); PG8_STAGE(PG8_SB(0, 1), cB + hstep, voffB); PG8_STAGE(PG8_SA(0, 1), cA + hstep, voffA);
    if (wr == 1) PG8_BAR;
    PG8_WAIT_V(4); PG8_BAR;
    PG8_STAGE(PG8_SB(1, 0), cB + kstep, voffB); PG8_STAGE(PG8_SA(1, 0), cA + kstep, voffA); PG8_STAGE(PG8_SB(1, 1), cB + hstep + kstep, voffB);
    PG8_WAIT_V(6); PG8_BAR;
    PG8_STAMP();
    for (;;) {
        const bool has_next = S.next(ui + 1, nxt);
        const char* nA = has_next ? (const char*)g.A + (size_t)nxt.pm * tstep : cA; const char* nB = has_next ? (const char*)g.Bt + (size_t)nxt.pn * tstep : cB;
        for (int t = 0; t < nt; t += 2) {
            const bool last = (t == nt - 2);
            const char* a1 = cA + (size_t)(t + 1) * kstep;
            const char* a2 = last ? nA : cA + (size_t)(t + 2) * kstep; const char* b2 = last ? nB : cB + (size_t)(t + 2) * kstep;
            const char* a3 = a2 + kstep; const char* b3 = b2 + kstep;
            if (last && has_next) S.a_ready(nxt);
            PG8_LDB(B0, 0, 0); PG8_SCHED; PG8_LDA(At, 0, 0); PG8_STAGE(PG8_SA(1, 1), a1 + hstep, voffA);
            PG8_WAIT_L(8); PG8_BAR; PG8_WAIT_L(0); PG8_MMA(0, 0, At, B0); PG8_BAR; PG8_SCHED;
            PG8_LDB(B1, 0, 1); PG8_STAGE(PG8_SB(0, 0), b2, voffB);
            PG8_BAR; PG8_WAIT_L(0); PG8_MMA(0, 1, At, B1); PG8_BAR;
            PG8_LDA(At, 0, 1); PG8_STAGE(PG8_SA(0, 0), a2, voffA);
            PG8_BAR; PG8_WAIT_L(0); PG8_MMA(1, 0, At, B0); PG8_BAR; PG8_SCHED;
            PG8_STAGE(PG8_SB(0, 1), b2 + hstep, voffB);
            PG8_WAIT_V(6); PG8_BAR; PG8_MMA(1, 1, At, B1); PG8_BAR;
            PG8_LDB(B0, 1, 0); PG8_SCHED; PG8_LDA(At, 1, 0); PG8_STAGE(PG8_SA(0, 1), a2 + hstep, voffA);
            PG8_WAIT_L(8); PG8_BAR; PG8_WAIT_L(0); PG8_MMA(0, 0, At, B0); PG8_BAR; PG8_SCHED;
            PG8_LDB(B1, 1, 1); PG8_STAGE(PG8_SB(1, 0), b3, voffB);
            PG8_BAR; PG8_WAIT_L(0); PG8_MMA(0, 1, At, B1); PG8_BAR;
            PG8_LDA(At, 1, 1); PG8_STAGE(PG8_SA(1, 0), a3, voffA);
            PG8_BAR; PG8_WAIT_L(0); PG8_MMA(1, 0, At, B0); PG8_BAR; PG8_SCHED;
            PG8_STAGE(PG8_SB(1, 1), b3 + hstep, voffB);
            PG8_WAIT_V(6); PG8_BAR; PG8_MMA(1, 1, At, B1); PG8_BAR;
        }
        PG8_STAMP();
        if constexpr (!Epi::AFTER_DRAIN) { E(acc, cur, wr, wc, fr, fq); S.done(cur); }
        PG8_STAMP();
        if (!has_next) break;
#pragma unroll
        for (int a = 0; a < 2; ++a)
#pragma unroll
            for (int b = 0; b < 2; ++b)
#pragma unroll
                for (int m = 0; m < 4; ++m)
#pragma unroll
                    for (int n = 0; n < 2; ++n) acc[a][b][m][n] = (f32x4){0.f, 0.f, 0.f, 0.f};
        cur = nxt; cA = nA; cB = nB; ++ui;
    }
    PG8_WAIT_V(0);
    if (wr == 0) PG8_BAR;
    PG8_BAR;
    if constexpr (Epi::AFTER_DRAIN) { E.fused(acc, cur, wr, wc, fr, fq, lds, wid, lane); S.done(cur); }
    PG8_STAMP();
    if (STAMP && wid == 0) { stamps[lane] = lane < nts ? (((unsigned long long)(unsigned)ts_hi << 32) | (unsigned)ts_lo) : 0ull;
        if (lane == 62) stamps[62] = rt_entry; if (lane == 63) stamps[63] = (unsigned long long)wall_clock64(); }
#undef PG8_STAMP
#undef PG8_SA
#undef PG8_SB
#undef PG8_STAGE
#undef PG8_LDA
#undef PG8_LDB
#undef PG8_MMA
#undef PG8_WAIT_V
#undef PG8_WAIT_L
#undef PG8_BAR
#undef PG8_SCHED
}
}
namespace att {
constexpr int D = 128, NW = 8, QBLK = 32, KVBLK = 64;
constexpr float SCALE = 0.088388347648318440f, THR = 8.f;
constexpr int SHM_V = KVBLK * D * 2, SHM_K = KVBLK * D * 2, SHM_ATTN = 2 * SHM_V + 2 * SHM_K + NW * 64 * 4;
#define KSWZ(row, colB) ((row) * 256 + ((colB) ^ (((row) & 7) << 4)))
#define SBAR() __builtin_amdgcn_sched_barrier(0)
__device__ __forceinline__ int crow(int r, int hi) { return (r & 3) + 8 * (r >> 2) + 4 * hi; }
__device__ __forceinline__ unsigned cvtpk(float lo, float hi) { unsigned r; asm volatile("v_cvt_pk_bf16_f32 %0, %1, %2" : "=v"(r) : "v"(lo), "v"(hi)); return r; }

template <bool MASKED>
__device__ __forceinline__ void partialSM(f32x16& p0, f32x16& p1, float& m_reg, float& mn, float& alpha, unsigned long long mw, int hi) {
  constexpr float C = SCALE * 1.4426950408889634f;
  float pmax = p0[0];
#pragma unroll
  for (int r = 1; r < 16; ++r) pmax = fmaxf(pmax, p0[r]);
#pragma unroll
  for (int r = 0; r < 16; ++r) pmax = fmaxf(pmax, p1[r]);
  { auto rr = __builtin_amdgcn_permlane32_swap(__float_as_uint(pmax), __float_as_uint(pmax), false, false);
    pmax = fmaxf(__uint_as_float(rr[0]), __uint_as_float(rr[1])); }
  if (__builtin_expect(__all(pmax - m_reg <= THR / SCALE), 1)) { mn = m_reg; alpha = 1.f; }
  else { mn = fmaxf(m_reg, pmax); alpha = __builtin_amdgcn_exp2f((m_reg - mn) * C); m_reg = mn; }
  const float mnC = -mn * C;
#pragma unroll
  for (int r = 0; r < 16; ++r) p0[r] = fmaf(p0[r], C, mnC);
#pragma unroll
  for (int r = 0; r < 16; ++r) p1[r] = fmaf(p1[r], C, mnC);
#pragma unroll
  for (int r = 0; r < 16; ++r) p0[r] = __builtin_amdgcn_exp2f(p0[r]);
}
__device__ __forceinline__ void finishSM(f32x16& p0, f32x16& p1, float alpha, float& l_reg, bf16x8& pa0, bf16x8& pa1, bf16x8& pa2, bf16x8& pa3) {
#pragma unroll
  for (int r = 0; r < 16; ++r) p1[r] = __builtin_amdgcn_exp2f(p1[r]);
  float ps = 0;
#pragma unroll
  for (int r = 0; r < 16; ++r) ps += p0[r];
#pragma unroll
  for (int r = 0; r < 16; ++r) ps += p1[r];
  { auto rr = __builtin_amdgcn_permlane32_swap(__float_as_uint(ps), __float_as_uint(ps), false, false);
    ps = __uint_as_float(rr[0]) + __uint_as_float(rr[1]); }
  l_reg = l_reg * alpha + ps;
#define PK4(P, BASE, OUT) do { unsigned a0 = cvtpk(P[BASE + 0], P[BASE + 1]), a1 = cvtpk(P[BASE + 2], P[BASE + 3]);   \
    unsigned b0 = cvtpk(P[BASE + 4], P[BASE + 5]), b1 = cvtpk(P[BASE + 6], P[BASE + 7]);                              \
    auto r0 = __builtin_amdgcn_permlane32_swap(a0, b0, false, false); auto r1 = __builtin_amdgcn_permlane32_swap(a1, b1, false, false); \
    u32x4 w = {r0[0], r1[0], r0[1], r1[1]}; OUT = *reinterpret_cast<bf16x8*>(&w); } while (0)
  PK4(p0, 0, pa0); PK4(p0, 8, pa1); PK4(p1, 0, pa2); PK4(p1, 8, pa3);
#undef PK4
}
template <int R> __device__ __forceinline__ float mask_bias(unsigned nw) {
  unsigned t; constexpr int bit = (R & 3) + 8 * (R >> 2);
  asm("v_bfe_i32 %0, %1, %2, 1\n\tv_and_b32 %0, 0xff800000, %0" : "=v"(t) : "v"(nw), "n"(bit));
  return __uint_as_float(t);
}
template <bool MASKED>
__device__ __forceinline__ void qkt(f32x16& p0, f32x16& p1, const char* Ks, const bf16x8* qr, int r32, int hi, unsigned long long mw) {
  if (MASKED) {
    const unsigned n0 = ~((unsigned)mw >> (4 * hi)), n1 = ~((unsigned)(mw >> 32) >> (4 * hi));
#define MB_(R) p0[R] = mask_bias<R>(n0); p1[R] = mask_bias<R>(n1);
    MB_(0) MB_(1) MB_(2) MB_(3) MB_(4) MB_(5) MB_(6) MB_(7) MB_(8) MB_(9) MB_(10) MB_(11) MB_(12) MB_(13) MB_(14) MB_(15)
#undef MB_
  } else { p0 = f32x16{}; p1 = f32x16{}; }
  asm volatile("" : "+v"(p0), "+v"(p1));
#pragma unroll
  for (int d0 = 0; d0 < 8; ++d0) { const int cb = (d0 * 16 + hi * 8) * 2;
    bf16x8 b0 = *reinterpret_cast<const bf16x8*>(Ks + KSWZ(r32, cb));
    bf16x8 b1 = *reinterpret_cast<const bf16x8*>(Ks + KSWZ(32 + r32, cb));
    p0 = __builtin_amdgcn_mfma_f32_32x32x16_bf16(b0, qr[d0], p0, 0, 0, 0);
    p1 = __builtin_amdgcn_mfma_f32_32x32x16_bf16(b1, qr[d0], p1, 0, 0, 0); }
}
__device__ __forceinline__ int v_st(int k, int c) { const int kk = (k & ~0xC) | ((k & 4) << 1) | ((k & 8) >> 1); return ((kk >> 3) * 4 + (c >> 5)) * 512 + ((kk & 7) * 32 + (c & 31)) * 2; }
__device__ __forceinline__ int v_rd_base(int lane) { return ((lane & 3) << 3) | (((lane >> 2) & 3) << 6) | (((lane >> 4) & 1) << 5) | (((lane >> 5) & 1) << 8); }
constexpr int v_rd_off(int d0, int ks, int half) { return d0 * 512 + ks * 4096 + half * 2048; }
template <int OFF> __device__ __forceinline__ s16x4 tr_read(int vb) {
  s16x4 r; asm volatile("ds_read_b64_tr_b16 %0, %1 offset:%2" : "=&v"(r) : "v"(vb), "i"(OFF) : "memory"); return r;
}
template <int D0> __device__ __forceinline__ void pv_one(f32x16& od, int vb, bf16x8 pa0, bf16x8 pa1, bf16x8 pa2, bf16x8 pa3) {
  const s16x4 l0 = tr_read<v_rd_off(D0, 0, 0)>(vb), h0 = tr_read<v_rd_off(D0, 0, 1)>(vb), l1 = tr_read<v_rd_off(D0, 1, 0)>(vb), h1 = tr_read<v_rd_off(D0, 1, 1)>(vb);
  const s16x4 l2 = tr_read<v_rd_off(D0, 2, 0)>(vb), h2 = tr_read<v_rd_off(D0, 2, 1)>(vb), l3 = tr_read<v_rd_off(D0, 3, 0)>(vb), h3 = tr_read<v_rd_off(D0, 3, 1)>(vb);
  asm volatile("s_waitcnt lgkmcnt(0)" ::: "memory"); SBAR();
#define PK(L, H) (bf16x8){L[0], L[1], L[2], L[3], H[0], H[1], H[2], H[3]}
  od = __builtin_amdgcn_mfma_f32_32x32x16_bf16(pa0, PK(l0, h0), od, 0, 0, 0);
  od = __builtin_amdgcn_mfma_f32_32x32x16_bf16(pa1, PK(l1, h1), od, 0, 0, 0);
  od = __builtin_amdgcn_mfma_f32_32x32x16_bf16(pa2, PK(l2, h2), od, 0, 0, 0);
  od = __builtin_amdgcn_mfma_f32_32x32x16_bf16(pa3, PK(l3, h3), od, 0, 0, 0);
#undef PK
}
__device__ __forceinline__ void pv_d0(f32x16* o, int vb, bf16x8 pa0, bf16x8 pa1, bf16x8 pa2, bf16x8 pa3) {
  pv_one<0>(o[0], vb, pa0, pa1, pa2, pa3); pv_one<1>(o[1], vb, pa0, pa1, pa2, pa3); pv_one<2>(o[2], vb, pa0, pa1, pa2, pa3); pv_one<3>(o[3], vb, pa0, pa1, pa2, pa3);
}

template <bool MASKED, int LDK, int VOFF, class OutRow>
__device__ __forceinline__ void attn_body(const bf16_t* __restrict__ Qw, const bf16_t* __restrict__ Kh, int NT,
                                          const unsigned long long* __restrict__ mbase, unsigned moff, const OutRow& Ow, char* lds) {
  const int tid = TIDX(), wid = tid >> 6, lane = tid & 63, r32 = lane & 31, hi = lane >> 5;
  char* V_lds = lds; char* K_lds = lds + 2 * SHM_V;
  float* ws = (float*)(lds + 2 * SHM_V + 2 * SHM_K) + wid * 64; float* li_l = ws; float* al_l = ws + 32;
  float m_reg = -1e30f, l_reg = 0; f32x16 o[4] = {}; bf16x8 qr[8];
  asm volatile("" : "+v"(o[0]), "+v"(o[1]), "+v"(o[2]), "+v"(o[3]));
#pragma unroll
  for (int d0 = 0; d0 < 8; ++d0) qr[d0] = *reinterpret_cast<const bf16x8*>(Qw + d0 * 16);
  const int sr = tid >> 4, sc = (tid & 15) * 8, vst0 = v_st(sr, sc), vst1 = v_st(32 + sr, sc);
  const int vb0 = (int)(uintptr_t)V_lds + v_rd_base(lane);
  struct { bf16x8 vs0, vs1, ks0, ks1; } sr_[2];
  const unsigned koff = (unsigned)(sr * LDK + sc) * 2u;
#define SLOAD(i, k0) do { const char* kb_ = (const char*)Kh + (size_t)(k0) * (LDK * 2); \
    sr_[i].vs0 = *reinterpret_cast<const bf16x8*>(kb_ + koff + VOFF * 2); sr_[i].vs1 = *reinterpret_cast<const bf16x8*>(kb_ + koff + (32 * LDK + VOFF) * 2); \
    sr_[i].ks0 = *reinterpret_cast<const bf16x8*>(kb_ + koff); sr_[i].ks1 = *reinterpret_cast<const bf16x8*>(kb_ + koff + 32 * LDK * 2); } while (0)
#define SWRITE(b, i) do { *(bf16x8*)(V_lds + (b) * SHM_V + vst0) = sr_[i].vs0;          \
    *(bf16x8*)(V_lds + (b) * SHM_V + vst1) = sr_[i].vs1; int kc = sc * 2;               \
    *(bf16x8*)(K_lds + (b) * SHM_K + KSWZ(sr, kc)) = sr_[i].ks0;                       \
    *(bf16x8*)(K_lds + (b) * SHM_K + KSWZ(32 + sr, kc)) = sr_[i].ks1; } while (0)
#define SWAIT() asm volatile("s_waitcnt vmcnt(4)" ::: "memory")
#define RESC(a) do { if (__any((a) < 1.f)) { if (hi == 0) al_l[r32] = (a); asm volatile("s_waitcnt lgkmcnt(0)" ::: "memory"); \
    _Pragma("unroll") for (int d = 0; d < 4; ++d) _Pragma("unroll") for (int r = 0; r < 16; ++r) o[d][r] *= al_l[crow(r, hi)]; } } while (0)
  f32x16 pA0, pA1, pB0, pB1; float mnA, mnB, alA, alB; bf16x8 pa0, pa1, pa2, pa3;
  unsigned long long mw = 0ull;
  constexpr int SE = 0, SO = 1;
  if (MASKED) mw = *(const unsigned long long*)((const char*)mbase + moff);
  SLOAD(SE, 0); asm volatile("s_waitcnt vmcnt(0)" ::: "memory"); SWRITE(0, SE); __syncthreads();
  qkt<MASKED>(pA0, pA1, K_lds, qr, r32, hi, mw);
  if (MASKED) mw = *(const unsigned long long*)((const char*)mbase + (moff + 8u));
  partialSM<MASKED>(pA0, pA1, m_reg, mnA, alA, mw, hi);
  SLOAD(SO, KVBLK); SLOAD(SE, (2 < NT ? 2 : NT - 1) * KVBLK);
  SWAIT();
  SWRITE(1, SO); __syncthreads();
  for (int j = 1; j + 1 < NT; j += 2) {
    SBAR(); qkt<MASKED>(pB0, pB1, K_lds + SHM_K, qr, r32, hi, mw);
    if (MASKED) mw = *(const unsigned long long*)((const char*)mbase + (moff + 8u * (unsigned)(j + 1)));
    finishSM(pA0, pA1, alA, l_reg, pa0, pa1, pa2, pa3); SBAR();
    SLOAD(SO, (j + 2) * KVBLK); SBAR();
    pv_d0(o, vb0, pa0, pa1, pa2, pa3); partialSM<MASKED>(pB0, pB1, m_reg, mnB, alB, mw, hi);
    __syncthreads(); if (MASKED) asm volatile("s_waitcnt vmcnt(5)" ::: "memory"); else SWAIT();
    SWRITE(0, SE);
    RESC(alB); __syncthreads();
    SBAR(); qkt<MASKED>(pA0, pA1, K_lds, qr, r32, hi, mw);
    if (MASKED) mw = *(const unsigned long long*)((const char*)mbase + (moff + 8u * (unsigned)(j + 2)));
    finishSM(pB0, pB1, alB, l_reg, pa0, pa1, pa2, pa3); SBAR();
    SLOAD(SE, (j + 3 < NT ? j + 3 : NT - 1) * KVBLK); SBAR();
    pv_d0(o, vb0 + SHM_V, pa0, pa1, pa2, pa3); partialSM<MASKED>(pA0, pA1, m_reg, mnA, alA, mw, hi);
    __syncthreads(); if (MASKED) asm volatile("s_waitcnt vmcnt(5)" ::: "memory"); else SWAIT();
    SWRITE(1, SO);
    RESC(alA); __syncthreads();
  }
  SBAR(); qkt<MASKED>(pB0, pB1, K_lds + SHM_K, qr, r32, hi, mw);
  finishSM(pA0, pA1, alA, l_reg, pa0, pa1, pa2, pa3); SBAR();
  pv_d0(o, vb0, pa0, pa1, pa2, pa3); partialSM<MASKED>(pB0, pB1, m_reg, mnB, alB, mw, hi);
  __syncthreads(); RESC(alB);
  finishSM(pB0, pB1, alB, l_reg, pa0, pa1, pa2, pa3); SBAR();
  pv_d0(o, vb0 + SHM_V, pa0, pa1, pa2, pa3);
  if (hi == 0) li_l[r32] = l_reg; asm volatile("s_waitcnt lgkmcnt(0)" ::: "memory");
  float rli[16];
#pragma unroll
  for (int r = 0; r < 16; ++r) rli[r] = __builtin_amdgcn_rcpf(li_l[crow(r, hi)]);
  __syncthreads();
  float* og_s = (float*)lds + wid * (32 * 132);
#pragma unroll
  for (int r = 0; r < 16; ++r) {
#pragma unroll
    for (int d0 = 0; d0 < 4; ++d0) og_s[crow(r, hi) * 132 + d0 * 32 + r32] = o[d0][r] * rli[r]; }
  asm volatile("" ::: "memory");
  { const int row = lane >> 1, half = lane & 1; const float* src = og_s + row * 132 + half * 64;
    f32x4 v[16]; float ss = 0.f;
#pragma unroll
    for (int i = 0; i < 16; ++i) { v[i] = *(const f32x4*)(src + 4 * i); ss += v[i][0] * v[i][0] + v[i][1] * v[i][1] + v[i][2] * v[i][2] + v[i][3] * v[i][3]; }
    ss += shx(ss, 1);
    const float rn = rsqrtf(ss * (1.f / 128.f) + EPS);
    const bf16_t* zp = Ow.zrow(row) + half * 64; bf16_t* gp = Ow.grow(row) + half * 64;
#pragma unroll
    for (int i = 0; i < 8; ++i) { float z[8], g[8]; ld8f(zp + 8 * i, z);
#pragma unroll
      for (int q = 0; q < 4; ++q) { g[q] = v[2 * i][q] * rn * siluf_(z[q]); g[4 + q] = v[2 * i + 1][q] * rn * siluf_(z[4 + q]); }
      st8f(gp + 8 * i, g); } }
  __syncthreads();
#undef SLOAD
#undef SWRITE
#undef SWAIT
#undef RESC
}
}
constexpr size_t al256(size_t x) { return (x + 255) / 256 * 256; }
constexpr size_t WS_CTL   = 0;
constexpr size_t CTL_BYTES = 65536;
constexpr size_t WS_WINT  = WS_CTL + CTL_BYTES;
constexpr size_t WS_WOUTT = WS_WINT + al256((size_t)DEPTH * NPAD * DM * 2);
constexpr size_t WS_WKVT  = WS_WOUTT + al256((size_t)DEPTH * DM * MIX * 2);
constexpr size_t WS_WGLUT = WS_WKVT + al256((size_t)DEPTH * 1024 * DM * 2);
constexpr size_t WS_MEMN  = WS_WGLUT + al256((size_t)DEPTH * 512 * 512 * 2);
constexpr size_t WS_KVMEM = WS_MEMN + al256((size_t)NB * MEML * DM * 2);
constexpr size_t WS_XN    = WS_KVMEM + al256((size_t)NB * MEML * DEPTH * 1024 * 2);
constexpr size_t WS_P     = WS_XN + al256((size_t)NTOK * DM * 2);
constexpr size_t WS_XBUF  = WS_P + al256((size_t)NTOK * NPAD * 2);
constexpr size_t WS_OCAT  = WS_XBUF + al256((size_t)NTOK * DM * 4);
constexpr size_t WS_MASK  = WS_OCAT + al256((size_t)NTOK * MIX * 2);
constexpr size_t WS_IW    = WS_MASK + al256((size_t)NTOK * 64 * 8);
constexpr size_t WS_YBUF  = WS_IW + al256((size_t)NTOK * 16 * 4);
constexpr size_t WS_ROPE  = WS_YBUF + al256((size_t)NTOK * 512 * 2);
constexpr size_t WS_S5P   = WS_ROPE + al256((size_t)NTOK * 48 * 4);
constexpr size_t S5P_BYTES = (size_t)DEPTH * 32 * (64 * 2 + 64 * 2 + 64 * 16 * 2) * 4;
constexpr size_t WS_GLAS  = WS_S5P + al256(S5P_BYTES);
constexpr size_t WS_GLAD  = WS_GLAS + al256((size_t)NB * 64 * 4 * 64 * 128 * 4);
constexpr size_t WS_IKC   = WS_GLAD + al256((size_t)NB * 64 * 4 * 64 * 4);
constexpr size_t WS_KVC   = WS_IKC + al256((size_t)NTOK * 64 * 2);
constexpr size_t WS_IQL   = WS_KVC + al256((size_t)NTOK * 256 * 2);
constexpr size_t WS_SSQ   = WS_IQL + al256((size_t)NTOK * 64 * 2);
constexpr size_t DSP_SLOT = (size_t)(256 * 128 + 512) * 4;
constexpr size_t WS_DSP   = WS_SSQ + 256;
constexpr size_t WS_END   = WS_DSP + al256((size_t)160 * 2 * DSP_SLOT);

struct Params {
    const float* x; const float* mem; const int* pos; const float* ln_gain; const float* w_in; const float* gla_w_up; const float* gla_b_up;
    const float* s5_a_re; const float* s5_a_im; const float* s5_log_step; const float* s5_b_re; const float* s5_b_im; const float* s5_c_re; const float* s5_c_im;
    const float* s5_d; const float* s5_w_glu; const float* dsa_q_norm; const float* dsa_k_norm; const float* mem_norm; const float* w_mem_kv;
    const float* mem_q_norm; const float* mem_k_norm; const float* out_norm; const float* w_out;
    float* out;
    char* ws;
    __device__ __forceinline__ unsigned* ctl_() const { return (unsigned*)(ws + WS_CTL); }
    __device__ __forceinline__ bf16_t* WinT_() const { return (bf16_t*)(ws + WS_WINT); }
    __device__ __forceinline__ bf16_t* WoutT_() const { return (bf16_t*)(ws + WS_WOUTT); }
    __device__ __forceinline__ bf16_t* WkvT_() const { return (bf16_t*)(ws + WS_WKVT); }
    __device__ __forceinline__ bf16_t* WgluT_() const { return (bf16_t*)(ws + WS_WGLUT); }
    __device__ __forceinline__ bf16_t* memn_() const { return (bf16_t*)(ws + WS_MEMN); }
    __device__ __forceinline__ bf16_t* kvmem_() const { return (bf16_t*)(ws + WS_KVMEM); }
    __device__ __forceinline__ bf16_t* xn_() const { return (bf16_t*)(ws + WS_XN); }
    __device__ __forceinline__ bf16_t* p_() const { return (bf16_t*)(ws + WS_P); }
    __device__ __forceinline__ bf16_t* xbuf_() const { return (bf16_t*)(ws + WS_XBUF); }
    __device__ __forceinline__ bf16_t* ocat_() const { return (bf16_t*)(ws + WS_OCAT); }
    __device__ __forceinline__ unsigned long long* mask_() const { return (unsigned long long*)(ws + WS_MASK); }
    __device__ __forceinline__ float* iw_() const { return (float*)(ws + WS_IW); }
    __device__ __forceinline__ bf16_t* ybuf_() const { return (bf16_t*)(ws + WS_YBUF); }
    __device__ __forceinline__ float* rope_() const { return (float*)(ws + WS_ROPE); }
    __device__ __forceinline__ float* s5p_() const { return (float*)(ws + WS_S5P); }
    __device__ __forceinline__ float* glas_() const { return (float*)(ws + WS_GLAS); }
    __device__ __forceinline__ float* glad_() const { return (float*)(ws + WS_GLAD); }
    __device__ __forceinline__ bf16_t* ikc_() const { return (bf16_t*)(ws + WS_IKC); }
    __device__ __forceinline__ bf16_t* kvc_() const { return (bf16_t*)(ws + WS_KVC); }
    __device__ __forceinline__ float* ssq_() const { return (float*)(ws + WS_SSQ); }
    __device__ __forceinline__ bf16_t* iql_() const { return (bf16_t*)(ws + WS_IQL); }
    __device__ __forceinline__ char* dsp_() const { return ws + WS_DSP; }
};

__device__ __forceinline__ void transpose_tiles(const float* __restrict__ src, int K, int Nsrc, int Ndst, const float* __restrict__ scale, bf16_t* __restrict__ dst,
                                                int tile, float* lds_tile  ) {
    const int tid = TIDX(), ntn = Ndst / 256;
    const int tk = tile / ntn, tn = tile % ntn, k0 = tk * 64, n0 = tn * 256;
    __syncthreads();
    { const int ty = tid >> 4, tx = tid & 15;
      f32x4 v[2][4];
#pragma unroll
      for (int i = 0; i < 2; ++i)
#pragma unroll
        for (int q = 0; q < 4; ++q) { const int k = k0 + ty + 32 * i, n = n0 + 4 * tx + 64 * q;
          v[i][q] = (f32x4){0.f, 0.f, 0.f, 0.f};
          if (n < Nsrc) v[i][q] = *(const f32x4*)(src + (size_t)k * Nsrc + n); }
#pragma unroll
      for (int i = 0; i < 2; ++i) { const float s = scale ? scale[k0 + ty + 32 * i] : 1.f;
#pragma unroll
        for (int q = 0; q < 4; ++q) { float* t = lds_tile + (ty + 32 * i) * 257 + 4 * tx + 64 * q; t[0] = v[i][q][0] * s; t[1] = v[i][q][1] * s; t[2] = v[i][q][2] * s; t[3] = v[i][q][3] * s; } } }
    __syncthreads();
    { const int n = tid >> 1, kh = (tid & 1) * 32;
#pragma unroll
      for (int j = 0; j < 4; ++j) { const int kb = kh + 8 * j; u32x4 w;
        w.x = pk2bf(lds_tile[(kb + 0) * 257 + n], lds_tile[(kb + 1) * 257 + n]); w.y = pk2bf(lds_tile[(kb + 2) * 257 + n], lds_tile[(kb + 3) * 257 + n]);
        w.z = pk2bf(lds_tile[(kb + 4) * 257 + n], lds_tile[(kb + 5) * 257 + n]); w.w = pk2bf(lds_tile[(kb + 6) * 257 + n], lds_tile[(kb + 7) * 257 + n]);
        *(u32x4*)(dst + (size_t)(n0 + n) * K + k0 + kb) = w; } }
}

__device__ __forceinline__ void rmsnorm_rows(const float* __restrict__ X, bf16_t* __restrict__ Y, int nrows) {
    const int wid = TIDX() >> 6, lane = TIDX() & 63;
    for (int row = blockIdx.x * 8 + wid; row < nrows; row += gridDim.x * 8) {
        const float* xr = X + (size_t)row * DM; f32x4 v[8]; float ss = 0.f;
#pragma unroll
        for (int i = 0; i < 8; ++i) { v[i] = *(const f32x4*)(xr + 4 * lane + 256 * i); ss += v[i][0] * v[i][0] + v[i][1] * v[i][1] + v[i][2] * v[i][2] + v[i][3] * v[i][3]; }
        ss = wave_sum(ss); const float r = rsqrtf(ss * (1.f / DM) + EPS);
        bf16_t* yr = Y + (size_t)row * DM;
#pragma unroll
        for (int i = 0; i < 8; ++i) { u32x2 w; w.x = pk2bf(v[i][0] * r, v[i][1] * r); w.y = pk2bf(v[i][2] * r, v[i][3] * r); *(u32x2*)(yr + 4 * lane + 256 * i) = w; }
    }
}

__device__ __forceinline__ void rmsnorm_rows16(const bf16_t* __restrict__ X, bf16_t* __restrict__ Y, int nrows) {
    const int wid = TIDX() >> 6, lane = TIDX() & 63;
    for (int row = blockIdx.x * 8 + wid; row < nrows; row += gridDim.x * 8) {
        const bf16_t* xr = X + (size_t)row * DM; float v[4][8]; float ss = 0.f;
#pragma unroll
        for (int i = 0; i < 4; ++i) { ld8f(xr + 8 * lane + 512 * i, v[i]);
#pragma unroll
            for (int j = 0; j < 8; ++j) ss += v[i][j] * v[i][j]; }
        ss = wave_sum(ss); const float r = rsqrtf(ss * (1.f / DM) + EPS);
        bf16_t* yr = Y + (size_t)row * DM;
#pragma unroll
        for (int i = 0; i < 4; ++i) { float o[8];
#pragma unroll
            for (int j = 0; j < 8; ++j) o[j] = v[i][j] * r;
            st8f(yr + 8 * lane + 512 * i, o); }
    }
}

__device__ __forceinline__ void rows_bf16_ssq(const float* __restrict__ X, bf16_t* __restrict__ Y, float* __restrict__ ssq, int nrows) {
    const int wid = TIDX() >> 6, lane = TIDX() & 63;
    for (int row = blockIdx.x * 8 + wid; row < nrows; row += gridDim.x * 8) {
        const float* xr = X + (size_t)row * DM; bf16_t* yr = Y + (size_t)row * DM; float ss = 0.f;
#pragma unroll
        for (int i = 0; i < 8; ++i) { const f32x4 v = *(const f32x4*)(xr + 4 * lane + 256 * i); ss += v[0] * v[0] + v[1] * v[1] + v[2] * v[2] + v[3] * v[3];
            u32x2 w; w.x = pk2bf(v[0], v[1]); w.y = pk2bf(v[2], v[3]); *(u32x2*)(yr + 4 * lane + 256 * i) = w; }
        ss = wave_sum(ss); if (lane < 32) ssq[(size_t)row * 32 + lane] = (lane == 0) ? ss : 0.f;
    }
}
__device__ __forceinline__ void phase_prologue1(const Params& P, char* lds) {
    float* tile = (float*)lds;
    constexpr int T_IN = (DM / 64) * (NPAD / 256), T_OUT = (MIX / 64) * (DM / 256), T_KV = (DM / 64) * (1024 / 256), T_GLU = 8 * 2;
    constexpr int TOT = DEPTH * (T_IN + T_OUT + T_KV + T_GLU);
    for (int u = blockIdx.x; u < TOT; u += gridDim.x) {
        int l = u / (T_IN + T_OUT + T_KV + T_GLU), r = u % (T_IN + T_OUT + T_KV + T_GLU);
        if (r < T_IN) transpose_tiles(P.w_in + (size_t)l * DM * NIN, DM, NIN, NPAD, P.ln_gain + l * DM, P.WinT_() + (size_t)l * NPAD * DM, r, tile);
        else if ((r -= T_IN) < T_OUT) transpose_tiles(P.w_out + (size_t)l * MIX * DM, MIX, DM, DM, P.out_norm + l * MIX, P.WoutT_() + (size_t)l * DM * MIX, r, tile);
        else if ((r -= T_OUT) < T_KV) transpose_tiles(P.w_mem_kv + (size_t)l * DM * 1024, DM, 1024, 1024, P.mem_norm + l * DM, P.WkvT_() + (size_t)l * 1024 * DM, r, tile);
        else { r -= T_KV; transpose_tiles(P.s5_w_glu + (size_t)l * 512 * 512, 512, 512, 512, nullptr, P.WgluT_() + (size_t)l * 512 * 512, r, tile); }
    }
    rmsnorm_rows(P.mem, P.memn_(), NB * MEML);
}
__device__ __forceinline__ void phase_rope_table(const Params& P) {
    for (int idx = blockIdx.x * NTHR + TIDX(); idx < NTOK * 24; idx += gridDim.x * NTHR) {
        const int tok = idx / 24, i = idx % 24;
        const float e = (i < 16) ? -((float)i * 2.0f / 32.0f) : -((float)(i - 16) * 2.0f / 16.0f);
        const float inv_freq = exp2f(e * 18.931568569324174f);
        const float ang = (float)P.pos[tok] * inv_freq;
        const double a = (double)ang; const double k = rint(a * 0.15915494309189535); const float rf = (float)fma(-k, 6.283185307179586, a);
        P.rope_()[(size_t)idx * 2] = cosf(rf); P.rope_()[(size_t)idx * 2 + 1] = sinf(rf);
    }
}

__device__ __forceinline__ void phase_rmsnorm_x(const Params& P, int layer) { if (layer == 0) rmsnorm_rows(P.x, P.xn_(), NTOK); else rmsnorm_rows16(P.xbuf_(), P.xn_(), NTOK); }

__device__ __forceinline__ void phase_memk_norm(const Params& P) {
    const int wid = TIDX() >> 6, lane = TIDX() & 63;
    for (int it = blockIdx.x * 8 + wid; it < NB * MEML * DEPTH * 4; it += gridDim.x * 8) {
        const int row = it / (DEPTH * 4), l = (it / 4) % DEPTH, h = it % 4;
        bf16_t* kp = P.kvmem_() + (size_t)row * (DEPTH * 1024) + l * 1024 + h * 128 + 2 * lane;
        const unsigned w = *(const unsigned*)kp; const float a = __uint_as_float(w << 16), b = __uint_as_float(w & 0xffff0000u);
        const float ss = wave_sum(a * a + b * b), r = rsqrtf(ss * (1.f / 128.f) + EPS);
        const float* g = P.mem_k_norm + l * 128 + 2 * lane;
        *(unsigned*)kp = pk2bf(a * r * g[0], b * r * g[1]);
    }
}

__device__ __forceinline__ float sum16(float v) { v += shx(v, 1); v += shx(v, 2); v += shx(v, 4); v += shx(v, 8); return v; }

__device__ __forceinline__ void head128_norm_rope_to(const bf16_t* hp, bf16_t* dp, int l16, const float* __restrict__ gain, const float* __restrict__ cs, bool rope, bool do_store) {
    float v[8]; ld8f(hp + 8 * l16, v);
    float ss = 0.f;
#pragma unroll
    for (int j = 0; j < 8; ++j) ss += v[j] * v[j];
    ss = sum16(ss); const float r = rsqrtf(ss * (1.f / 128.f) + EPS);
#pragma unroll
    for (int j = 0; j < 8; ++j) v[j] = v[j] * r * gain[8 * l16 + j];
    if (rope) {
        float o[8];
#pragma unroll
        for (int j = 0; j < 8; ++j) o[j] = shx(v[j], 2);
        if (l16 < 4) { const int fi = (l16 & 1) * 8;
#pragma unroll
            for (int j = 0; j < 8; ++j) { const float c = cs[(fi + j) * 2], s = cs[(fi + j) * 2 + 1];
                v[j] = (l16 < 2) ? (v[j] * c - o[j] * s) : (v[j] * c + o[j] * s); } }
    }
    if (do_store) st8f(dp + 8 * l16, v);
}
__device__ __forceinline__ void head128_norm_rope(bf16_t* hp, int l16, const float* __restrict__ gain, const float* __restrict__ cs, bool rope, bool do_store) { head128_norm_rope_to(hp, hp, l16, gain, cs, rope, do_store); }
__device__ __forceinline__ void rope16_inplace(bf16_t* ip, const float* __restrict__ cs) {
    float a[8], b[8]; ld8f(ip, a); ld8f(ip + 8, b);
#pragma unroll
    for (int j = 0; j < 8; ++j) { const float c = cs[2 * j], s = cs[2 * j + 1], x1 = a[j], x2 = b[j]; a[j] = x1 * c - x2 * s; b[j] = x2 * c + x1 * s; }
    st8f(ip, a); st8f(ip + 8, b);
}
__device__ __forceinline__ void phase_prep(const Params& P, int layer) {
    const int wid = TIDX() >> 6, lane = TIDX() & 63, l16 = lane & 15, grp = lane >> 4;
    for (int tok = blockIdx.x * 8 + wid; tok < NTOK; tok += gridDim.x * 8) {
        bf16_t* row = P.p_() + (size_t)tok * NPAD;
        const float* cs32 = P.rope_() + (size_t)tok * 48; const float* cs16 = cs32 + 32;
        head128_norm_rope(row + C_DQ + grp * 128, l16, P.dsa_q_norm + layer * 128, cs32, true, true);
        head128_norm_rope_to(row + C_DK, P.kvc_() + (size_t)tok * 256, l16, P.dsa_k_norm + layer * 128, cs32, true, grp == 0);
        head128_norm_rope(row + C_MQ + grp * 128, l16, P.mem_q_norm + layer * 128, cs32, false, true);
        if ((lane & 3) == 0) rope16_inplace(row + C_DIQ + lane * 16, cs16);
        if (lane < 4) {
            bf16_t* dst = P.ikc_() + (size_t)(tok >> 5) * 2048 + lane * 512 + (tok & 31) * 8;
            float a[8], b[8]; ld8f(row + C_DIK + lane * 16, a); ld8f(row + C_DIK + lane * 16 + 8, b);
            if (lane == 0) {
#pragma unroll
                for (int q = 0; q < 8; ++q) { const float c = cs16[2 * q], s = cs16[2 * q + 1], x1 = a[q], x2 = b[q]; a[q] = x1 * c - x2 * s; b[q] = x2 * c + x1 * s; } }
            st8f(dst, a); st8f(dst + 256, b); }
        if (lane >= 16 && lane < 32) { const u32x4 vv = *(const u32x4*)(row + C_DV + (lane - 16) * 8); *(u32x4*)(P.kvc_() + (size_t)tok * 256 + 128 + (lane - 16) * 8) = vv; }
        if (lane < 16) P.iw_()[(size_t)tok * 16 + lane] = bf2f(row[C_DIW + lane]) * (1.f / 32.f);
    }
}
struct MemOutRow { const bf16_t* zb; bf16_t* gb;
    __device__ __forceinline__ const bf16_t* zrow(int r) const { return zb + (size_t)r * NPAD; } __device__ __forceinline__ bf16_t* grow(int r) const { return gb + (size_t)r * MIX; } };
__device__ __forceinline__ void unit_mem_attn(const Params& P, int layer, int u, char* lds) {
    const int b = u >> 6, h = (u >> 4) & 3, qb = u & 15, tok0 = b * SEQ + qb * 256;
    const int wid = TIDX() >> 6, lane = TIDX() & 63, r32 = lane & 31, hi = lane >> 5;
    const bf16_t* Qw = P.p_() + (size_t)(tok0 + wid * 32 + r32) * NPAD + C_MQ + h * 128 + hi * 8;
    const bf16_t* Kh = P.kvmem_() + (size_t)(b * MEML) * (DEPTH * 1024) + layer * 1024 + h * 128;
    MemOutRow ow; ow.zb = P.p_() + (size_t)(tok0 + wid * 32) * NPAD + C_MZ + h * 128; ow.gb = P.xn_() + (size_t)(tok0 + wid * 32) * MIX + 1536 + h * 128;
    att::attn_body<false, DEPTH * 1024, 512, MemOutRow>(Qw, Kh, MEML / 64, nullptr, 0u, ow, lds);
}

__device__ __forceinline__ void phase_gate(const Params& P, int c_lo, int c_hi) {
    const int wid = TIDX() >> 6, lane = TIDX() & 63;
    const int c0 = lane * 32;
    const int seg = c0 >> 9, zc = (seg == 0 ? C_GZ : seg == 1 ? C_SZ : seg == 2 ? C_DZ : C_MZ) + (c0 & 511);
    const bool act = (c0 >= c_lo) && (c0 < c_hi);
    for (int tok = blockIdx.x * 8 + wid; tok < NTOK; tok += gridDim.x * 8) {
        if (!act) { bf16_t* gz_ = P.xn_() + (size_t)tok * MIX + c0; const u32x4 zz = {0u, 0u, 0u, 0u};
#pragma unroll
            for (int i = 0; i < 4; ++i) *(u32x4*)(gz_ + 8 * i) = zz;
            continue; }
        const bf16_t* op = P.ocat_() + (size_t)tok * MIX + c0; const bf16_t* zp = P.p_() + (size_t)tok * NPAD + zc; bf16_t* gp = P.xn_() + (size_t)tok * MIX + c0;
        float o[32]; float ss = 0.f;
#pragma unroll
        for (int i = 0; i < 4; ++i) { float v[8]; ld8f(op + 8 * i, v);
#pragma unroll
            for (int j = 0; j < 8; ++j) { o[8 * i + j] = v[j]; ss += v[j] * v[j]; } }
        ss += shx(ss, 1); ss += shx(ss, 2);
        const float r = rsqrtf(ss * (1.f / 128.f) + EPS);
#pragma unroll
        for (int i = 0; i < 4; ++i) { float z[8], g[8]; ld8f(zp + 8 * i, z);
#pragma unroll
            for (int j = 0; j < 8; ++j) g[j] = o[8 * i + j] * r * siluf_(z[j]);
            st8f(gp + 8 * i, g); }
    }
}

__device__ __forceinline__ void phase_gemm_in(const Params& P, int layer, char* lds) {
    pg8::Gemm g; g.A = P.xn_(); g.Bt = P.WinT_() + (size_t)layer * NPAD * DM; g.M = NTOK; g.N = NPAD; g.K = DM;
    pg8::StaticOrder S; S.init(g.M, g.N, (int)gridDim.x, (int)blockIdx.x);
    pg8::EpiBf16Plain E; E.O = P.p_(); E.ldc = NPAD;
    pg8::gemm_phase<pg8::EpiBf16Plain, pg8::StaticOrder, false>((PG8_LAS unsigned char*)lds, g, S, E, nullptr);
}
__device__ __forceinline__ void phase_gemm_out(const Params& P, int layer, char* lds) {
    pg8::Gemm g; g.A = P.xn_(); g.Bt = P.WoutT_() + (size_t)layer * DM * MIX; g.M = NTOK; g.N = DM; g.K = MIX;
    pg8::StaticOrder S; S.init(g.M, g.N, (int)gridDim.x, (int)blockIdx.x);
    pg8::EpiResidMix E; E.R = (layer == 0) ? (const void*)P.x : (const void*)P.xbuf_(); E.C = (layer == DEPTH - 1) ? (void*)P.out : (void*)P.xbuf_(); E.ldc = DM;
    E.r16 = (layer != 0); E.c16 = (layer != DEPTH - 1);
    pg8::gemm_phase<pg8::EpiResidMix, pg8::StaticOrder, false>((PG8_LAS unsigned char*)lds, g, S, E, nullptr);
}
__device__ __forceinline__ void phase_gemm_kv(const Params& P, char* lds) {
    pg8::Gemm g; g.A = P.memn_(); g.Bt = P.WkvT_(); g.M = NB * MEML; g.N = DEPTH * 1024; g.K = DM;
    pg8::StaticOrder S; S.init(g.M, g.N, (int)gridDim.x, (int)blockIdx.x);
    pg8::EpiBf16Plain E; E.O = P.kvmem_(); E.ldc = DEPTH * 1024;
    pg8::gemm_phase<pg8::EpiBf16Plain, pg8::StaticOrder, false>((PG8_LAS unsigned char*)lds, g, S, E, nullptr);
}
__device__ __forceinline__ void mma_tile(f32x16& acc, const char* A, int lda, const char* B, int ldb, int K, int lane) {
    const int r = lane & 31, kh = lane >> 5;
    const char* ap = A + r * lda + kh * 16; const char* bp = B + r * ldb + kh * 16;
    asm volatile("" : "+v"(acc));
    for (int k = 0; k < K; k += 16) {
        const bf16x8 a = *(const bf16x8*)(ap + k * 2); const bf16x8 b = *(const bf16x8*)(bp + k * 2);
        acc = __builtin_amdgcn_mfma_f32_32x32x16_bf16(a, b, acc, 0, 0, 0);
    }
}
__device__ __forceinline__ int crow32(int r, int hi) { return (r & 3) + 8 * (r >> 2) + 4 * hi; }
__device__ __forceinline__ float log_sigmoid_(float x) { return fminf(x, 0.f) - log1pf(__expf(-fabsf(x))); }

constexpr int GLA_ST = 144;
constexpr int GC_BST = 68;
constexpr int GC_B_BYTES = 4 * 64 * GC_BST * 4, GC_V_BYTES = 4 * 16384;
__device__ __forceinline__ float* gla_gb(const Params& P) { return (float*)((char*)P.ocat_() + (size_t)32 * 1024 * 1024); }
__device__ __forceinline__ float log_sigmoid_fast(float x) { return fminf(x, 0.f) - __logf(1.f + __expf(-fabsf(x))); }

__device__ __forceinline__ void unit_gla_a4(const Params& P, int layer, int ub, char* lds) {
    const int b = ub >> 6, n = ub & 63, tok0 = b * SEQ + n * 64;
    const int tid = TIDX(), wid = tid >> 6, lane = tid & 63, r32 = lane & 31, hi = lane >> 5, h = wid >> 1, eh = wid & 1;
    float* b_s = (float*)lds;
    char* V_s = lds;
    char* K_s = lds + GC_B_BYTES;
    float* glr_s = (float*)(lds + GC_B_BYTES + GC_V_BYTES);
    float* tot_s = glr_s + 1024;
    __syncthreads();
    const bf16_t* prow = P.p_() + (size_t)tok0 * NPAD;
    const bf16x8 glr_raw = *(const bf16x8*)(prow + (size_t)((tid & 127) >> 1) * NPAD + C_GLR + (tid & 1) * 8);
    const int gd = tid & 63, gh = (tid >> 6) & 3, gt = tid >> 8;
    float wu[16];
#pragma unroll
    for (int r = 0; r < 16; ++r) wu[r] = P.gla_w_up[((size_t)layer * 16 + r) * 256 + gh * 64 + gd];
    const float bias = P.gla_b_up[layer * 256 + gh * 64 + gd];
    bf16x8 kraw[4], vs[4][2];
    const int ks_ = tid >> 3, kc = (tid & 7) * 8;
#pragma unroll
    for (int hv = 0; hv < 4; ++hv) kraw[hv] = *(const bf16x8*)(prow + (size_t)ks_ * NPAD + C_GK + hv * 64 + kc);
    const int sr = tid >> 4, sc = (tid & 15) * 8;
#pragma unroll
    for (int hv = 0; hv < 4; ++hv) { vs[hv][0] = *(const bf16x8*)(prow + (size_t)sr * NPAD + C_GV + hv * 128 + sc); vs[hv][1] = *(const bf16x8*)(prow + (size_t)(32 + sr) * NPAD + C_GV + hv * 128 + sc); }
    if (tid < 128) {
#pragma unroll
        for (int j = 0; j < 8; ++j) glr_s[(tid >> 1) * 16 + (tid & 1) * 8 + j] = bf2f((bf16_t)glr_raw[j]); }
    __syncthreads();
    float gv[32]; float run = 0.f;
#pragma unroll
    for (int i = 0; i < 32; ++i) { const float* gr = glr_s + (gt * 32 + i) * 16; float a = bias;
#pragma unroll
        for (int r4 = 0; r4 < 4; ++r4) { const f32x4 g4 = *(const f32x4*)(gr + 4 * r4); a = fmaf(g4[0], wu[4 * r4], a); a = fmaf(g4[1], wu[4 * r4 + 1], a); a = fmaf(g4[2], wu[4 * r4 + 2], a); a = fmaf(g4[3], wu[4 * r4 + 3], a); }
        run += log_sigmoid_fast(a) * (1.f / 16.f); gv[i] = run; }
    if (gt == 0) tot_s[gh * 64 + gd] = run;
    __syncthreads();
    { const float off = gt ? tot_s[gh * 64 + gd] : 0.f; float* bp = b_s + (gh * 64 + gt * 32) * GC_BST + gd;
      float* gp = gla_gb(P) + (size_t)(tok0 + gt * 32) * 256 + gh * 64 + gd;
#pragma unroll
      for (int i = 0; i < 32; ++i) { const float v = gv[i] + off; bp[i * GC_BST] = v; gp[(size_t)i * 256] = v; }
      if (gt) P.glad_()[((size_t)((b * 64 + n) * 4 + gh)) * 64 + gd] = __expf(gv[31] + off); }
    __syncthreads();
#pragma unroll
    for (int hv = 0; hv < 4; ++hv) { const float* br = b_s + (hv * 64 + ks_) * GC_BST + kc; const float* bl = b_s + (hv * 64 + 63) * GC_BST + kc;
        const f32x4 b0 = *(const f32x4*)br, b1 = *(const f32x4*)(br + 4), l0 = *(const f32x4*)bl, l1 = *(const f32x4*)(bl + 4);
        float e[8];
#pragma unroll
        for (int j = 0; j < 8; ++j) e[j] = bf2f((bf16_t)kraw[hv][j]) * __expf((j < 4 ? l0[j] : l1[j - 4]) - (j < 4 ? b0[j] : b1[j - 4]));
        u32x4 w = {att::cvtpk(e[0], e[1]), att::cvtpk(e[2], e[3]), att::cvtpk(e[4], e[5]), att::cvtpk(e[6], e[7])};
        *(u32x4*)(K_s + hv * 16384 + att::v_st(ks_, kc)) = w; }
    __syncthreads();
    { const int vst0 = att::v_st(sr, sc), vst1 = att::v_st(32 + sr, sc);
#pragma unroll
      for (int hv = 0; hv < 4; ++hv) { *(bf16x8*)(V_s + hv * 16384 + vst0) = vs[hv][0]; *(bf16x8*)(V_s + hv * 16384 + vst1) = vs[hv][1]; } }
    __syncthreads();
    const int vb = (int)(uintptr_t)(V_s + h * 16384) + att::v_rd_base(lane), kb = (int)(uintptr_t)(K_s + h * 16384) + att::v_rd_base(lane);
    f32x16 acc[2][2] = {};
    asm volatile("" : "+v"(acc[0][0]), "+v"(acc[0][1]), "+v"(acc[1][0]), "+v"(acc[1][1]));
#define GA_PK(L, H) (bf16x8){L[0], L[1], L[2], L[3], H[0], H[1], H[2], H[3]}
#define GA_STEP(KS) do { \
    const s16x4 k0l = att::tr_read<att::v_rd_off(0, KS, 0)>(kb), k0h = att::tr_read<att::v_rd_off(0, KS, 1)>(kb), k1l = att::tr_read<att::v_rd_off(1, KS, 0)>(kb), k1h = att::tr_read<att::v_rd_off(1, KS, 1)>(kb); \
    s16x4 v0l, v0h, v1l, v1h; \
    if (eh == 0) { v0l = att::tr_read<att::v_rd_off(0, KS, 0)>(vb); v0h = att::tr_read<att::v_rd_off(0, KS, 1)>(vb); v1l = att::tr_read<att::v_rd_off(1, KS, 0)>(vb); v1h = att::tr_read<att::v_rd_off(1, KS, 1)>(vb); } \
    else         { v0l = att::tr_read<att::v_rd_off(2, KS, 0)>(vb); v0h = att::tr_read<att::v_rd_off(2, KS, 1)>(vb); v1l = att::tr_read<att::v_rd_off(3, KS, 0)>(vb); v1h = att::tr_read<att::v_rd_off(3, KS, 1)>(vb); } \
    asm volatile("s_waitcnt lgkmcnt(0)" ::: "memory"); __builtin_amdgcn_sched_barrier(0); \
    acc[0][0] = __builtin_amdgcn_mfma_f32_32x32x16_bf16(GA_PK(v0l, v0h), GA_PK(k0l, k0h), acc[0][0], 0, 0, 0); \
    acc[0][1] = __builtin_amdgcn_mfma_f32_32x32x16_bf16(GA_PK(v0l, v0h), GA_PK(k1l, k1h), acc[0][1], 0, 0, 0); \
    acc[1][0] = __builtin_amdgcn_mfma_f32_32x32x16_bf16(GA_PK(v1l, v1h), GA_PK(k0l, k0h), acc[1][0], 0, 0, 0); \
    acc[1][1] = __builtin_amdgcn_mfma_f32_32x32x16_bf16(GA_PK(v1l, v1h), GA_PK(k1l, k1h), acc[1][1], 0, 0, 0); } while (0)
    GA_STEP(0); GA_STEP(1); GA_STEP(2); GA_STEP(3);
#undef GA_STEP
#undef GA_PK
    float* dst = P.glas_() + ((size_t)((b * 64 + n) * 4 + h)) * 8192;
#pragma unroll
    for (int et = 0; et < 2; ++et)
#pragma unroll
        for (int dt = 0; dt < 2; ++dt)
#pragma unroll
            for (int r = 0; r < 16; ++r) dst[((eh * 2 + et) * 32 + att::crow(r, hi)) * 64 + dt * 32 + r32] = acc[et][dt][r];
    __syncthreads();
}

__device__ __forceinline__ void gla_scan_slice(const Params& P, int idx) {
    {
        const int el = idx & 8191, d = idx & 63, h = (idx >> 13) & 3, b = idx >> 15;
        bf16_t* gst = P.ocat_();
        float S = 0.f;
        for (int n0 = 0; n0 < 64; n0 += 8) {
            float ds[8], dc[8];
#pragma unroll
            for (int i = 0; i < 8; ++i) { const size_t cu = (size_t)((b * 64 + n0 + i) * 4 + h); ds[i] = P.glas_()[cu * 8192 + el]; dc[i] = P.glad_()[cu * 64 + d]; }
#pragma unroll
            for (int i = 0; i < 8; ++i) { const size_t cu = (size_t)((b * 64 + n0 + i) * 4 + h); gst[cu * 8192 + el] = f2bf(S); S = fmaf(dc[i], S, ds[i]); }
        }
    }
}

__device__ __forceinline__ void unit_gla_c4(const Params& P, int layer, int ub, char* lds) {
    const int b = ub >> 6, n = ub & 63, tok0 = b * SEQ + n * 64;
    const int tid = TIDX(), wid = tid >> 6, lane = tid & 63, r32 = lane & 31, hi = lane >> 5, h = wid >> 1, rh = wid & 1;
    float* b_s = (float*)lds;
    char* V_s = lds + GC_B_BYTES;
    __syncthreads();
    const bf16_t* prow = P.p_() + (size_t)tok0 * NPAD;
    bf16x8 qraw[4], kraw[2][4], vs[4][2];
    const int sr = tid >> 4, sc = (tid & 15) * 8;
#pragma unroll
    for (int hv = 0; hv < 4; ++hv) { vs[hv][0] = *(const bf16x8*)(prow + (size_t)sr * NPAD + C_GV + hv * 128 + sc); vs[hv][1] = *(const bf16x8*)(prow + (size_t)(32 + sr) * NPAD + C_GV + hv * 128 + sc); }
    f32x4 braw[8];
    { const float* gp = gla_gb(P) + (size_t)tok0 * 256 + tid * 4;
#pragma unroll
      for (int i = 0; i < 8; ++i) braw[i] = *(const f32x4*)(gp + i * 2048); }
    { const bf16_t* qp = prow + (size_t)(rh * 32 + r32) * NPAD + C_GQ + h * 64 + hi * 8;
#pragma unroll
      for (int d0 = 0; d0 < 4; ++d0) qraw[d0] = *(const bf16x8*)(qp + d0 * 16);
#pragma unroll
      for (int sh = 0; sh < 2; ++sh) { const bf16_t* kp = prow + (size_t)(sh * 32 + r32) * NPAD + C_GK + h * 64 + hi * 8;
#pragma unroll
          for (int d0 = 0; d0 < 4; ++d0) kraw[sh][d0] = *(const bf16x8*)(kp + d0 * 16); } }
    bf16x8 sfr[4][4];
    { const bf16_t* sp = P.ocat_() + ((size_t)((b * 64 + n) * 4 + h)) * 8192 + r32 * 64 + hi * 8;
#pragma unroll
      for (int eb = 0; eb < 4; ++eb)
#pragma unroll
          for (int ds = 0; ds < 4; ++ds) sfr[eb][ds] = *(const bf16x8*)(sp + eb * 32 * 64 + ds * 16); }
    { const int vst0 = att::v_st(sr, sc), vst1 = att::v_st(32 + sr, sc);
#pragma unroll
      for (int hv = 0; hv < 4; ++hv) { *(bf16x8*)(V_s + hv * 16384 + vst0) = vs[hv][0]; *(bf16x8*)(V_s + hv * 16384 + vst1) = vs[hv][1]; } }
#pragma unroll
    for (int i = 0; i < 8; ++i) { const int c = tid + 512 * i, t = c >> 6, c4 = c & 63;
        *(f32x4*)(b_s + ((c4 >> 4) * 64 + t) * GC_BST + (c4 & 15) * 4) = braw[i]; }
    __syncthreads();
    const float* bh = b_s + h * 64 * GC_BST + hi * 8;
    bf16x8 qe[4], qb[4], ke[2][4];
#pragma unroll
    for (int d0 = 0; d0 < 4; ++d0) {
        const f32x4 m0 = *(const f32x4*)(bh + 32 * GC_BST + d0 * 16), m1 = *(const f32x4*)(bh + 32 * GC_BST + d0 * 16 + 4);
        const f32x4 q0 = *(const f32x4*)(bh + (rh * 32 + r32) * GC_BST + d0 * 16), q1 = *(const f32x4*)(bh + (rh * 32 + r32) * GC_BST + d0 * 16 + 4);
        float e1[8], e2[8];
#pragma unroll
        for (int j = 0; j < 8; ++j) { const float mv = j < 4 ? m0[j] : m1[j - 4], bq = j < 4 ? q0[j] : q1[j - 4]; const float q = bf2f((bf16_t)qraw[d0][j]) * 0.125f;
            e1[j] = q * __expf(bq - mv); e2[j] = q * __expf(bq); }
        { u32x4 w = {att::cvtpk(e1[0], e1[1]), att::cvtpk(e1[2], e1[3]), att::cvtpk(e1[4], e1[5]), att::cvtpk(e1[6], e1[7])}; qe[d0] = *reinterpret_cast<bf16x8*>(&w); }
        { u32x4 w = {att::cvtpk(e2[0], e2[1]), att::cvtpk(e2[2], e2[3]), att::cvtpk(e2[4], e2[5]), att::cvtpk(e2[6], e2[7])}; qb[d0] = *reinterpret_cast<bf16x8*>(&w); }
#pragma unroll
        for (int sh = 0; sh < 2; ++sh) {
            const f32x4 k0 = *(const f32x4*)(bh + (sh * 32 + r32) * GC_BST + d0 * 16), k1 = *(const f32x4*)(bh + (sh * 32 + r32) * GC_BST + d0 * 16 + 4);
            float e3[8];
#pragma unroll
            for (int j = 0; j < 8; ++j) { const float mv = j < 4 ? m0[j] : m1[j - 4], bk = j < 4 ? k0[j] : k1[j - 4]; e3[j] = bf2f((bf16_t)kraw[sh][d0][j]) * __expf(mv - bk); }
            u32x4 w = {att::cvtpk(e3[0], e3[1]), att::cvtpk(e3[2], e3[3]), att::cvtpk(e3[4], e3[5]), att::cvtpk(e3[6], e3[7])}; ke[sh][d0] = *reinterpret_cast<bf16x8*>(&w); }
    }
    f32x16 p0 = {}, p1 = {};
    asm volatile("" : "+v"(p0), "+v"(p1));
#pragma unroll
    for (int d0 = 0; d0 < 4; ++d0) { p0 = __builtin_amdgcn_mfma_f32_32x32x16_bf16(ke[0][d0], qe[d0], p0, 0, 0, 0); p1 = __builtin_amdgcn_mfma_f32_32x32x16_bf16(ke[1][d0], qe[d0], p1, 0, 0, 0); }
    { const int t = rh * 32 + r32;
#pragma unroll
      for (int r = 0; r < 16; ++r) { const int s0 = att::crow(r, hi); p0[r] = (s0 <= t) ? p0[r] : 0.f; p1[r] = (32 + s0 <= t) ? p1[r] : 0.f; } }
    bf16x8 pa0, pa1, pa2, pa3;
#define GC_PK4(Pv, BASE, OUT) do { unsigned a0 = att::cvtpk(Pv[BASE + 0], Pv[BASE + 1]), a1 = att::cvtpk(Pv[BASE + 2], Pv[BASE + 3]);   \
    unsigned b0 = att::cvtpk(Pv[BASE + 4], Pv[BASE + 5]), b1 = att::cvtpk(Pv[BASE + 6], Pv[BASE + 7]);                              \
    auto r0 = __builtin_amdgcn_permlane32_swap(a0, b0, false, false); auto r1 = __builtin_amdgcn_permlane32_swap(a1, b1, false, false); \
    u32x4 w = {r0[0], r1[0], r0[1], r1[1]}; OUT = *reinterpret_cast<bf16x8*>(&w); } while (0)
    GC_PK4(p0, 0, pa0); GC_PK4(p0, 8, pa1); GC_PK4(p1, 0, pa2); GC_PK4(p1, 8, pa3);
#undef GC_PK4
    f32x16 o[4] = {};
    asm volatile("" : "+v"(o[0]), "+v"(o[1]), "+v"(o[2]), "+v"(o[3]));
    att::pv_d0(o, (int)(uintptr_t)(V_s + h * 16384) + att::v_rd_base(lane), pa0, pa1, pa2, pa3);
#pragma unroll
    for (int eb = 0; eb < 4; ++eb)
#pragma unroll
        for (int ds = 0; ds < 4; ++ds) o[eb] = __builtin_amdgcn_mfma_f32_32x32x16_bf16(qb[ds], sfr[eb][ds], o[eb], 0, 0, 0);
    __syncthreads();
    float* og_s = (float*)lds + wid * (32 * 132);
#pragma unroll
    for (int r = 0; r < 16; ++r) {
#pragma unroll
        for (int eb = 0; eb < 4; ++eb) og_s[att::crow(r, hi) * 132 + eb * 32 + r32] = o[eb][r]; }
    asm volatile("" ::: "memory");
    { const int row = lane >> 1, half = lane & 1; const float* src = og_s + row * 132 + half * 64;
      f32x4 v[16]; float ss = 0.f;
#pragma unroll
      for (int i = 0; i < 16; ++i) { v[i] = *(const f32x4*)(src + 4 * i); ss += v[i][0] * v[i][0] + v[i][1] * v[i][1] + v[i][2] * v[i][2] + v[i][3] * v[i][3]; }
      ss += shx(ss, 1);
      const float rn = rsqrtf(ss * (1.f / 128.f) + EPS);
      const size_t tok = (size_t)(tok0 + rh * 32 + row);
      const bf16_t* zp = P.p_() + tok * NPAD + C_GZ + h * 128 + half * 64; bf16_t* gp = P.xn_() + tok * MIX + h * 128 + half * 64;
#pragma unroll
      for (int i = 0; i < 8; ++i) { float z[8], g[8]; ld8f(zp + 8 * i, z);
#pragma unroll
          for (int q = 0; q < 4; ++q) { g[q] = v[2 * i][q] * rn * siluf_(z[q]); g[4 + q] = v[2 * i + 1][q] * rn * siluf_(z[4 + q]); }
          st8f(gp + 8 * i, g); } }
    __syncthreads();
}
constexpr int S5P_STRIDE = 2304;
__device__ __forceinline__ void phase_s5_params(const Params& P) {
    for (int idx = blockIdx.x * NTHR + TIDX(); idx < DEPTH * 32 * 64; idx += gridDim.x * NTHR) {
        const int p = idx & 63, lg = idx >> 6;
        const float ar = P.s5_a_re[idx], ai = P.s5_a_im[idx], step = expf(P.s5_log_step[lg]);
        const float mag = expf(ar * step), th = ai * step;
        const float lr = mag * cosf(th), li = mag * sinf(th);
        float* o = P.s5p_() + (size_t)lg * S5P_STRIDE;
        o[2 * p] = lr; o[2 * p + 1] = li;
        { const float mag512 = expf(512.f * ar * step); const double a = 512.0 * (double)th; const double k = rint(a * 0.15915494309189535); const float rf = (float)fma(-k, 6.283185307179586, a);
          o[128 + 2 * p] = mag512 * cosf(rf); o[128 + 2 * p + 1] = mag512 * sinf(rf); }
        const float xr = lr - 1.f, xi = li, den = 1.f / (ar * ar + ai * ai);
        const float fr = (xr * ar + xi * ai) * den, fi = (xi * ar - xr * ai) * den;
        for (int c = 0; c < 16; ++c) { const float br = P.s5_b_re[(size_t)idx * 16 + c], bi = P.s5_b_im[(size_t)idx * 16 + c];
            o[256 + (p * 16 + c) * 2] = fr * br - fi * bi; o[256 + (p * 16 + c) * 2 + 1] = fr * bi + fi * br; }
    }
}
__device__ __forceinline__ float gelu_tanh_(float x) { const float u = 0.7978845608028654f * (x + 0.044715f * x * x * x); const float e = __expf(-2.f * fabsf(u)); const float th = copysignf((1.f - e) / (1.f + e), u); return 0.5f * x * (1.f + th); }

constexpr int S5_XST = 272;
constexpr int S5_UST = 48;
__device__ __forceinline__ float partner32(float v, int hi) { auto rr = __builtin_amdgcn_permlane32_swap(__float_as_uint(v), __float_as_uint(v), false, false); return __uint_as_float(hi ? rr[0] : rr[1]); }
struct S5Ctx { float l0r, l0i, l1r, l1i, q0r, q0i, q1r, q1i, dsk; char* Cm; char* Bb; char* Xs; char* Us; int lane, hi, j, rho; const bf16_t* ubase; bf16_t* ybase; };
template <bool OUT> __device__ __forceinline__ void s5_tile(const S5Ctx& C, int tok0, float& x0r, float& x0i, float& x1r, float& x1i) {
    const int hi = C.hi, j = C.j, lane = C.lane;
    if (hi == 0) { const bf16_t* up = C.ubase + (size_t)(tok0 + j) * NPAD;
        const bf16x8 w0 = *(const bf16x8*)up, w1 = *(const bf16x8*)(up + 8);
        *(bf16x8*)(C.Us + C.rho * S5_UST) = w0; *(bf16x8*)(C.Us + C.rho * S5_UST + 16) = w1; }
    asm volatile("" ::: "memory");
    f32x16 a0 = {}, a1 = {}, a2 = {}, a3 = {};
    mma_tile(a0, C.Us, S5_UST, C.Bb, S5_UST, 16, lane); mma_tile(a1, C.Us, S5_UST, C.Bb + 32 * S5_UST, S5_UST, 16, lane);
    mma_tile(a2, C.Us, S5_UST, C.Bb + 64 * S5_UST, S5_UST, 16, lane); mma_tile(a3, C.Us, S5_UST, C.Bb + 96 * S5_UST, S5_UST, 16, lane);
    float s0r[16], s0i[16], s1r[16], s1i[16];
#pragma unroll
    for (int r = 0; r < 16; ++r) {
        const float n0r = fmaf(C.l0r, x0r, fmaf(-C.l0i, x0i, a0[r])), n0i = fmaf(C.l0r, x0i, fmaf(C.l0i, x0r, a1[r])); x0r = n0r; x0i = n0i; s0r[r] = n0r; s0i[r] = n0i;
        const float n1r = fmaf(C.l1r, x1r, fmaf(-C.l1i, x1i, a2[r])), n1i = fmaf(C.l1r, x1i, fmaf(C.l1i, x1r, a3[r])); x1r = n1r; x1i = n1i; s1r[r] = n1r; s1i[r] = n1i; }
    float z0r = partner32(x0r, hi), z0i = partner32(x0i, hi), z1r = partner32(x1r, hi), z1i = partner32(x1i, hi);
    if (hi == 0) { z0r = 0.f; z0i = 0.f; z1r = 0.f; z1i = 0.f; }
    if (!OUT) {
        x0r += C.q0r * z0r - C.q0i * z0i; x0i += C.q0r * z0i + C.q0i * z0r; x1r += C.q1r * z1r - C.q1i * z1i; x1i += C.q1r * z1i + C.q1i * z1r;
    } else {
#pragma unroll
        for (int r = 0; r < 16; ++r) {
            const float t0r = C.l0r * z0r - C.l0i * z0i, t0i = C.l0r * z0i + C.l0i * z0r; z0r = t0r; z0i = t0i; s0r[r] += t0r; s0i[r] += t0i;
            const float t1r = C.l1r * z1r - C.l1i * z1i, t1i = C.l1r * z1i + C.l1i * z1r; z1r = t1r; z1i = t1i; s1r[r] += t1r; s1i[r] += t1i; }
        x0r = s0r[15]; x0i = s0i[15]; x1r = s1r[15]; x1i = s1i[15];
#pragma unroll
        for (int r = 0; r < 16; ++r) { char* xr_ = C.Xs + (r + 16 * hi) * S5_XST;
            *(bf16_t*)(xr_ + j * 2) = f2bf(s0r[r]); *(bf16_t*)(xr_ + (64 + j) * 2) = f2bf(s0i[r]);
            *(bf16_t*)(xr_ + (32 + j) * 2) = f2bf(s1r[r]); *(bf16_t*)(xr_ + (96 + j) * 2) = f2bf(s1i[r]); }
        asm volatile("" ::: "memory");
        f32x16 acc = {}; mma_tile(acc, C.Xs, S5_XST, C.Cm, S5_XST, 128, lane);
        if (j < 16) {
#pragma unroll
            for (int r = 0; r < 16; ++r) { const int t = crow32(r, hi); const int rt = ((t & 15) & 3) + 8 * ((t & 15) >> 2) + 4 * (t >> 4);
                const float y = acc[r] + C.dsk * bf2f(*(const bf16_t*)(C.Us + rt * S5_UST + j * 2));
                C.ybase[(size_t)(tok0 + t) * 512 + j] = f2bf(gelu_tanh_(y)); } }
        asm volatile("" ::: "memory");
    }
    { const float e0r = partner32(x0r, hi), e0i = partner32(x0i, hi), e1r = partner32(x1r, hi), e1i = partner32(x1i, hi);
      if (hi == 0) { x0r = e0r; x0i = e0i; x1r = e1r; x1i = e1i; } else { x0r = 0.f; x0i = 0.f; x1r = 0.f; x1i = 0.f; } }
}
__device__ __forceinline__ void unit_s5(const Params& P, int layer, int u, char* lds) {
    const int b = u >> 5, g = u & 31, tid = TIDX(), wid = tid >> 6, lane = tid & 63, hi = lane >> 5, j = lane & 31;
    char* Cm = lds;
    char* Bb = Cm + 32 * S5_XST;
    float* ends = (float*)(Bb + 128 * S5_UST);
    char* wbase = (char*)(ends + 8 * 64 * 2) + wid * (32 * S5_XST + 32 * S5_UST);
    const float* sp = P.s5p_() + (size_t)(layer * 32 + g) * S5P_STRIDE;
    __syncthreads();
    for (int i = tid; i < 32 * 128; i += NTHR) { const int c = i >> 7, pp = i & 127; float v = 0.f;
        if (c < 16) v = (pp < 64) ? P.s5_c_re[((size_t)(layer * 32 + g) * 16 + c) * 64 + pp] : -P.s5_c_im[((size_t)(layer * 32 + g) * 16 + c) * 64 + (pp - 64)];
        *(bf16_t*)(Cm + c * S5_XST + pp * 2) = f2bf(v); }
    for (int i = tid; i < 128 * 16; i += NTHR) { const int n = i >> 4, c = i & 15, nt = n >> 5, jj = n & 31, p = (nt >> 1) * 32 + jj;
        *(bf16_t*)(Bb + n * S5_UST + c * 2) = f2bf(sp[256 + (p * 16 + c) * 2 + (nt & 1)]); }
    S5Ctx C; C.Cm = Cm; C.Bb = Bb; C.Xs = wbase; C.Us = wbase + 32 * S5_XST; C.lane = lane; C.hi = hi; C.j = j;
    C.l0r = sp[2 * j]; C.l0i = sp[2 * j + 1]; C.l1r = sp[2 * (32 + j)]; C.l1i = sp[2 * (32 + j) + 1];
    { float q0r = C.l0r, q0i = C.l0i, q1r = C.l1r, q1i = C.l1i;
#pragma unroll
      for (int k = 0; k < 4; ++k) { const float a = q0r * q0r - q0i * q0i, bb = (q0r + q0r) * q0i; q0r = a; q0i = bb; const float c = q1r * q1r - q1i * q1i, d = (q1r + q1r) * q1i; q1r = c; q1i = d; }
      C.q0r = q0r; C.q0i = q0i; C.q1r = q1r; C.q1i = q1i; }
    C.dsk = P.s5_d[layer * 512 + g * 16 + (lane & 15)];
    C.rho = ((j & 15) & 3) + 8 * ((j & 15) >> 2) + 4 * (j >> 4);
    const int tokw = b * SEQ + wid * 512;
    C.ubase = P.p_() + C_SU + g * 16; C.ybase = P.ybuf_() + g * 16;
    float x0r = 0.f, x0i = 0.f, x1r = 0.f, x1i = 0.f;
    __syncthreads();
    for (int sc = 0; sc < 16; ++sc) s5_tile<false>(C, tokw + sc * 32, x0r, x0i, x1r, x1i);
    if (hi == 0) { ends[(wid * 64 + j) * 2] = x0r; ends[(wid * 64 + j) * 2 + 1] = x0i; ends[(wid * 64 + 32 + j) * 2] = x1r; ends[(wid * 64 + 32 + j) * 2 + 1] = x1i; }
    __syncthreads();
    { const float p0r = sp[128 + 2 * j], p0i = sp[128 + 2 * j + 1], p1r = sp[128 + 2 * (32 + j)], p1i = sp[128 + 2 * (32 + j) + 1];
      x0r = 0.f; x0i = 0.f; x1r = 0.f; x1i = 0.f;
      for (int w = 0; w < wid; ++w) { const float e0r = ends[(w * 64 + j) * 2], e0i = ends[(w * 64 + j) * 2 + 1], e1r = ends[(w * 64 + 32 + j) * 2], e1i = ends[(w * 64 + 32 + j) * 2 + 1];
          const float n0r = p0r * x0r - p0i * x0i + e0r, n0i = p0r * x0i + p0i * x0r + e0i, n1r = p1r * x1r - p1i * x1i + e1r, n1i = p1r * x1i + p1i * x1r + e1i;
          x0r = n0r; x0i = n0i; x1r = n1r; x1i = n1i; }
      if (hi) { x0r = 0.f; x0i = 0.f; x1r = 0.f; x1i = 0.f; } }
    for (int sc = 0; sc < 16; ++sc) s5_tile<true>(C, tokw + sc * 32, x0r, x0i, x1r, x1i);
}
constexpr int TOPK = 256;
__device__ __forceinline__ unsigned f2key(float f) { const unsigned u = __float_as_uint(f); return u ^ ((u & 0x80000000u) ? 0xffffffffu : 0x80000000u); }

__device__ __forceinline__ float relu1(float x) { const int b = __float_as_int(x); return __int_as_float(b > 0 ? b : 0); }
#define DSA_MM(acc, rt, kk) acc = __builtin_amdgcn_mfma_f32_32x32x16_bf16(afr[rt][kk], bfr[kk], acc, 0, 0, 0)
#define DSA_HS(acc, rt, q) do { s0 = fmaf(relu1(acc[4 * (q)]), wv[rt][4 * (q)], s0); s1 = fmaf(relu1(acc[4 * (q) + 1]), wv[rt][4 * (q) + 1], s1); \
                                s0 = fmaf(relu1(acc[4 * (q) + 2]), wv[rt][4 * (q) + 2], s0); s1 = fmaf(relu1(acc[4 * (q) + 3]), wv[rt][4 * (q) + 3], s1); } while (0)
#define DSA_SG() do { __builtin_amdgcn_sched_group_barrier(0x8, 1, 0); __builtin_amdgcn_sched_group_barrier(0x2, 8, 0); } while (0)
__device__ __forceinline__ void dsa_score_tile(const bf16x8 (&afr)[4][4], const f32x16 (&wv)[4], const bf16x8 (&bfr)[4], float* sc, int col, int hi) {
    f32x16 accA = {}, accB = {}; asm volatile("" : "+v"(accA), "+v"(accB));
    float s0, s1;
    DSA_MM(accA, 0, 0); DSA_MM(accA, 0, 1); DSA_MM(accA, 0, 2); DSA_MM(accA, 0, 3);
    s0 = 0.f; s1 = 0.f;
    DSA_MM(accB, 1, 0); DSA_HS(accA, 0, 0); DSA_SG(); DSA_MM(accB, 1, 1); DSA_HS(accA, 0, 1); DSA_SG();
    DSA_MM(accB, 1, 2); DSA_HS(accA, 0, 2); DSA_SG(); DSA_MM(accB, 1, 3); DSA_HS(accA, 0, 3); DSA_SG();
    sc[(0 + hi) * 4096 + col] = (s0 + s1) + 0.f;
    accA = (f32x16){}; asm volatile("" : "+v"(accA)); s0 = 0.f; s1 = 0.f;
    DSA_MM(accA, 2, 0); DSA_HS(accB, 1, 0); DSA_SG(); DSA_MM(accA, 2, 1); DSA_HS(accB, 1, 1); DSA_SG();
    DSA_MM(accA, 2, 2); DSA_HS(accB, 1, 2); DSA_SG(); DSA_MM(accA, 2, 3); DSA_HS(accB, 1, 3); DSA_SG();
    sc[(2 + hi) * 4096 + col] = (s0 + s1) + 0.f;
    accB = (f32x16){}; asm volatile("" : "+v"(accB)); s0 = 0.f; s1 = 0.f;
    DSA_MM(accB, 3, 0); DSA_HS(accA, 2, 0); DSA_SG(); DSA_MM(accB, 3, 1); DSA_HS(accA, 2, 1); DSA_SG();
    DSA_MM(accB, 3, 2); DSA_HS(accA, 2, 2); DSA_SG(); DSA_MM(accB, 3, 3); DSA_HS(accA, 2, 3); DSA_SG();
    sc[(4 + hi) * 4096 + col] = (s0 + s1) + 0.f;
    s0 = 0.f; s1 = 0.f;
    DSA_HS(accB, 3, 0); DSA_HS(accB, 3, 1); DSA_HS(accB, 3, 2); DSA_HS(accB, 3, 3);
    sc[(6 + hi) * 4096 + col] = (s0 + s1) + 0.f;
}
#define DSA_CNT4(K0, K1, K2, K3) asm volatile( \
    "v_cmp_ge_u32_e64 %[m0], %[k0], %[cd]\n\tv_cmp_ge_u32_e64 %[m1], %[k1], %[cd]\n\tv_cmp_ge_u32_e64 %[m2], %[k2], %[cd]\n\tv_cmp_ge_u32_e64 %[m3], %[k3], %[cd]\n\t" \
    "v_addc_co_u32_e64 %[a0], %[m0], %[a0], 0, %[m0]\n\tv_addc_co_u32_e64 %[a1], %[m1], %[a1], 0, %[m1]\n\t" \
    "v_addc_co_u32_e64 %[a0], %[m2], %[a0], 0, %[m2]\n\tv_addc_co_u32_e64 %[a1], %[m3], %[a1], 0, %[m3]" \
    : [a0] "+v"(c0), [a1] "+v"(c1), [m0] "=&s"(sm0), [m1] "=&s"(sm1), [m2] "=&s"(sm2), [m3] "=&s"(sm3) \
    : [k0] "v"(K0), [k1] "v"(K1), [k2] "v"(K2), [k3] "v"(K3), [cd] "v"(cand))
#define DSA_CNT8(J0) do { DSA_CNT4(key[(J0)], key[(J0) + 1], key[(J0) + 2], key[(J0) + 3]); DSA_CNT4(key[(J0) + 4], key[(J0) + 5], key[(J0) + 6], key[(J0) + 7]); } while (0)

__device__ __forceinline__ void unit_dsa_index(const Params& P, int u, char* lds) {
    const int b = u & 3, t0 = (511 - (u >> 2)) * 8;
    const int tid = TIDX(), wid = tid >> 6, lane = tid & 63, r32 = lane & 31, hi = lane >> 5;
    float* sc = (float*)lds;
    const bf16_t* pb = P.p_() + (size_t)b * SEQ * NPAD;
    __syncthreads();
    TPU_START(101);
    {
        bf16x8 afr[4][4]; f32x16 wv[4];
        const int qsel = (r32 >> 2) & 1, head = (r32 & 3) + 4 * (r32 >> 3);
#pragma unroll
        for (int rt = 0; rt < 4; ++rt) { const bf16_t* qp = pb + (size_t)(t0 + 2 * rt + qsel) * NPAD + C_DIQ + head * 64 + hi * 8;
#pragma unroll
            for (int kk = 0; kk < 4; ++kk) afr[rt][kk] = *(const bf16x8*)(qp + kk * 16);
            const float* wp = P.iw_() + (size_t)(b * SEQ + t0 + 2 * rt + hi) * 16;
#pragma unroll
            for (int i = 0; i < 4; ++i) { const f32x4 w4 = *(const f32x4*)(wp + 4 * i); wv[rt][4 * i] = w4[0]; wv[rt][4 * i + 1] = w4[1]; wv[rt][4 * i + 2] = w4[2]; wv[rt][4 * i + 3] = w4[3]; } }
        const int ntile = (t0 + 7) / 32 + 1;
        const bf16_t* kp = P.ikc_() + (size_t)(b * (SEQ / 32)) * 2048 + lane * 8;
        bf16x8 b0[4], b1[4], b2[4];
#define DSA_LDB(dst, K) do { const bf16_t* kq_ = kp + (size_t)(wid + 8 * (K)) * 2048; _Pragma("unroll") for (int kk = 0; kk < 4; ++kk) dst[kk] = *(const bf16x8*)(kq_ + kk * 512); } while (0)
#define DSA_TILE(buf, K) dsa_score_tile(afr, wv, buf, sc, (wid + 8 * (K)) * 32 + r32, hi)
        const int nk = (ntile - wid + 7) >> 3;
        const int kl = nk > 0 ? nk - 1 : 0;
#define DSA_MIN(a) ((a) < kl ? (a) : kl)
        DSA_LDB(b0, DSA_MIN(0)); DSA_LDB(b1, DSA_MIN(1));
        int k = 0;
        for (; k + 3 <= nk; k += 3) {
            DSA_LDB(b2, k + 2); DSA_TILE(b0, k);
            DSA_LDB(b0, DSA_MIN(k + 3)); DSA_TILE(b1, k + 1);
            DSA_LDB(b1, DSA_MIN(k + 4)); DSA_TILE(b2, k + 2);
        }
        if (k < nk) DSA_TILE(b0, k);
        if (k + 1 < nk) DSA_TILE(b1, k + 1);
#undef DSA_TILE
#undef DSA_MIN
#undef DSA_TILE
#undef DSA_LDB
    }
    __syncthreads();
    TPU_STOP(101); TPU_START(102);
    {
        const int t = t0 + wid; const float* srow = sc + wid * 4096;
        unsigned key[64];
#pragma unroll
        for (int j = 0; j < 64; ++j) { const int s = j * 64 + lane; key[j] = (s <= t) ? f2key(srow[s]) : 0u; }
        unsigned long long* mout = P.mask_() + (size_t)(b * SEQ + t) * 64;
        unsigned long long myword = 0ull;
        TPU_START(105); TPU_START(106); TPU_START(107); TPU_START(108); TPU_START(109);
        if (t + 1 <= TOPK) {
#pragma unroll
            for (int j = 0; j < 64; ++j) { const unsigned long long m = __ballot(j * 64 + lane <= t); if (lane == j) myword = m; }
        } else {
            const int ngrp = t / 512 + 1;
#if TPROBE == 105
            asm volatile("" :: "v"(key[0]), "v"(key[63]));
#endif
            TPU_STOP(105);
            unsigned* hist = (unsigned*)(sc + wid * 4096);
            asm volatile("" ::: "memory");
            { const u32x4 zz4 = {0u, 0u, 0u, 0u};
#pragma unroll
              for (int i = 0; i < 16; ++i) *(u32x4*)(hist + (i * 64 + lane) * 4) = zz4; }
            asm volatile("" ::: "memory");
#define DSA_H8(J0) do { _Pragma("unroll") for (int jj = 0; jj < 8; ++jj) atomicAdd(hist + (key[(J0) + jj] >> 20), 1u); } while (0)
            DSA_H8(0);
            if (ngrp > 1) DSA_H8(8);
            if (ngrp > 2) DSA_H8(16);
            if (ngrp > 3) DSA_H8(24);
            if (ngrp > 4) DSA_H8(32);
            if (ngrp > 5) DSA_H8(40);
            if (ngrp > 6) DSA_H8(48);
            if (ngrp > 7) DSA_H8(56);
#undef DSA_H8
            asm volatile("" ::: "memory");
#if TPROBE == 106
            asm volatile("s_waitcnt lgkmcnt(0)" ::: "memory");
#endif
            TPU_STOP(106);
#define DSA_SUFFIX(s) do { _Pragma("unroll") for (int o = 1; o < 64; o <<= 1) { unsigned t_ = (unsigned)__builtin_amdgcn_ds_bpermute(((lane + o) & 63) << 2, (int)(s)); (s) += (lane + o < 64) ? t_ : 0u; } } while (0)
            unsigned mine = 0u;
#pragma unroll
            for (int i = 0; i < 16; ++i) { const u32x4 v4 = *(const u32x4*)(hist + lane * 64 + ((i + lane) & 15) * 4); mine += (v4[0] + v4[1]) + (v4[2] + v4[3]); }
            unsigned suf = mine; DSA_SUFFIX(suf);
            const unsigned long long mL = __ballot(suf - mine < (unsigned)TOPK && suf >= (unsigned)TOPK);
            const int Ls = (int)__builtin_ctzll(mL);
            const unsigned cntA = (unsigned)__builtin_amdgcn_readlane((int)(suf - mine), Ls);
            unsigned h2 = hist[Ls * 64 + lane]; unsigned suf2 = h2; DSA_SUFFIX(suf2);
            const unsigned long long mB = __ballot(cntA + suf2 - h2 < (unsigned)TOPK && cntA + suf2 >= (unsigned)TOPK);
            const int Bs = (int)__builtin_ctzll(mB);
            const unsigned bstar = (unsigned)(Ls * 64 + Bs);
            const unsigned cntAbove = cntA + (unsigned)__builtin_amdgcn_readlane((int)(suf2 - h2), Bs);
            const unsigned inbin = (unsigned)__builtin_amdgcn_readlane((int)h2, Bs);
#undef DSA_SUFFIX
            TPU_STOP(107);
            unsigned T = bstar << 20; int cntT = (int)(cntAbove + inbin);
            if (cntT != TOPK) {
                asm volatile("" ::: "memory");
                int nslot = 0;
#pragma unroll
                for (int j = 0; j < 64; ++j) { if ((key[j] >> 20) == bstar) { hist[nslot * 64 + lane] = key[j]; ++nslot; } }
                asm volatile("" ::: "memory");
                int R = nslot;
#pragma unroll
                for (int o = 32; o >= 1; o >>= 1) { const int other = __builtin_amdgcn_ds_bpermute(((lane ^ o) << 2), R); R = other > R ? other : R; }
                R = __builtin_amdgcn_readfirstlane(R);
                if (R <= 8) {
                    unsigned c[8];
#pragma unroll
                    for (int r = 0; r < 8; ++r) c[r] = (r < nslot) ? hist[r * 64 + lane] : 0u;
                    for (int bit = 19; bit >= 0; --bit) {
                        const unsigned cand = T | (1u << bit); int cnt = (int)cntAbove;
#pragma unroll
                        for (int r = 0; r < 8; ++r) cnt += __popcll(__ballot(c[r] >= cand));
                        if (cnt >= TOPK) { T = cand; cntT = cnt; if (cnt == TOPK) break; }
                    }
                } else {
                    for (int bit = 19; bit >= 0; --bit) {
                        const unsigned cand = T | (1u << bit); unsigned c0 = 0, c1 = 0; unsigned long long sm0, sm1, sm2, sm3;
                        DSA_CNT8(0);
                        if (ngrp > 1) DSA_CNT8(8);
                        if (ngrp > 2) DSA_CNT8(16);
                        if (ngrp > 3) DSA_CNT8(24);
                        if (ngrp > 4) DSA_CNT8(32);
                        if (ngrp > 5) DSA_CNT8(40);
                        if (ngrp > 6) DSA_CNT8(48);
                        if (ngrp > 7) DSA_CNT8(56);
                        const int cl = (int)(c0 + c1);
                        int cnt = 0;
#pragma unroll
                        for (int bb = 0; bb < 7; ++bb) cnt += __popcll(__ballot((cl >> bb) & 1)) << bb;
                        if (cnt >= TOPK) { T = cand; cntT = cnt; if (cnt == TOPK) break; }
                    }
                }
            }
            TPU_STOP(108);
            if (cntT == TOPK) {
#pragma unroll
                for (int j = 0; j < 64; ++j) { const unsigned long long m = __ballot(key[j] >= T); if (lane == j) myword = m; }
            } else {
                int ngt = 0;
#pragma unroll
                for (int j = 0; j < 64; ++j) ngt += __popcll(__ballot(key[j] > T));
                int need = TOPK - ngt;
#pragma unroll
                for (int j = 0; j < 64; ++j) { const unsigned long long eq = __ballot(key[j] == T), gt = __ballot(key[j] > T);
                    const int ne = __popcll(eq); unsigned long long take = eq;
                    if (ne > need) { take = 0ull; int left = need; unsigned long long e2 = eq;
                        while (left > 0) { const unsigned long long lowbit = e2 & (0ull - e2); take |= lowbit; e2 ^= lowbit; --left; } }
                    need -= (ne > need) ? need : ne;
                    const unsigned long long m = gt | take; if (lane == j) myword = m; }
            }
        }
        mout[lane] = myword;
        TPU_STOP(109);
    }
    TPU_STOP(102);
}

struct DsaOutRow { const bf16_t* zb; bf16_t* gb; int wid;
    __device__ __forceinline__ const bf16_t* zrow(int r) const { const int rho = wid * 32 + r; return zb + (size_t)(rho >> 2) * NPAD + (rho & 3) * 128; }
    __device__ __forceinline__ bf16_t* grow(int r) const { const int rho = wid * 32 + r; return gb + (size_t)(rho >> 2) * MIX + (rho & 3) * 128; } };
__device__ __forceinline__ void unit_dsa_attn(const Params& P, int u, char* lds) {
    const int b = u & 3, qb = 63 - (u >> 2), t0 = qb * 64, tokb = b * SEQ;
    const int wid = TIDX() >> 6, lane = TIDX() & 63, r32 = lane & 31, hi = lane >> 5;
    const int rho = wid * 32 + r32, tq = t0 + (rho >> 2), hq = rho & 3;
    const bf16_t* Qw = P.p_() + (size_t)(tokb + tq) * NPAD + C_DQ + hq * 128 + hi * 8;
    const bf16_t* Kh = P.kvc_() + (size_t)tokb * 256;
    const unsigned moff = (unsigned)(tokb + tq) * 512u;
    DsaOutRow ow; ow.zb = P.p_() + (size_t)(tokb + t0) * NPAD + C_DZ; ow.gb = P.xn_() + (size_t)(tokb + t0) * MIX + 1024; ow.wid = wid;
    const int NT = (qb + 2) & ~1;
    att::attn_body<true, 256, 128, DsaOutRow>(Qw, Kh, NT, P.mask_(), moff, ow, lds);
}
__device__ __forceinline__ void phase_gemm_glu(const Params& P, int layer, char* lds) {
    pg8::Gemm g; g.A = P.ybuf_(); g.Bt = P.WgluT_() + (size_t)layer * 512 * 512; g.M = NTOK; g.N = 512; g.K = 512;
    pg8::StaticOrder S; S.init(g.M, g.N, (int)gridDim.x, (int)blockIdx.x);
    pg8::EpiGlu E; E.Y = P.ybuf_(); E.ldy = 512; E.O = P.ocat_(); E.ldo = MIX; E.ooff = 512;
    pg8::gemm_phase<pg8::EpiGlu, pg8::StaticOrder, false>((PG8_LAS unsigned char*)lds, g, S, E, nullptr);
}

constexpr int CTL_Q0 = 4096;
struct OneUnit { int pm, pn; __device__ __forceinline__ bool next(int i, pg8::Unit& u) const { if (i) return false; u.pm = pm; u.pn = pn; return true; }
    __device__ __forceinline__ void a_ready(const pg8::Unit&) const {} __device__ __forceinline__ void done(const pg8::Unit&) const {} };
__device__ __forceinline__ int q_issue(unsigned* ctr) { return (int)__hip_atomic_fetch_add(ctr, 1u, __ATOMIC_RELAXED, __HIP_MEMORY_SCOPE_AGENT); }
#define Q_LOOP_BEGIN(ctr, total)  { unsigned* q_ctr_ = (ctr); const int q_total_ = (total); volatile int* q_b_ = (volatile int*)(lds + LDS_TAIL + 16); \
    for (;;) { __syncthreads(); if (TIDX() == 0) *q_b_ = q_issue(q_ctr_); __syncthreads(); const int item = __builtin_amdgcn_readfirstlane(*q_b_); if (item >= q_total_) break;
#define Q_LOOP_END  } }
__device__ __forceinline__ void unit_glu(const Params& P, int layer, int u, char* lds) {
    pg8::Gemm g; g.A = P.ybuf_(); g.Bt = P.WgluT_() + (size_t)layer * 512 * 512; g.M = NTOK; g.N = 512; g.K = 512;
    OneUnit S; S.pm = u >> 1; S.pn = u & 1;
    pg8::EpiGluGate E; E.Y = P.ybuf_(); E.Pz = P.p_(); E.G = P.xn_();
    pg8::gemm_phase<pg8::EpiGluGate, OneUnit, false>((PG8_LAS unsigned char*)lds, g, S, E, nullptr);
}
constexpr int LDS_TAIL = LDS_BYTES - 64;

__global__ __launch_bounds__(NTHR, 2) void k_mega(Params P) {
    extern __shared__ __attribute__((aligned(16))) char lds[];
    if (TIDX() == 0) *(uint4*)(lds + LDS_TAIL) = make_uint4(0u, 0u, 0u, 0u);
    __syncthreads();
    XcdBarrier bar = xcd_barrier_post(P.ctl_(), (volatile LAS unsigned*)(lds + LDS_TAIL));
    const int G = gridDim.x, B = blockIdx.x;
    phase_prologue1(P, lds); phase_rope_table(P); phase_s5_params(P); phase_rmsnorm_x(P, 0);
    xcd_barrier(bar);
    for (int layer = 0; layer < DEPTH; ++layer) {
        if (layer > 0) { phase_rmsnorm_x(P, layer); xcd_barrier(bar); }
        phase_gemm_in(P, layer, lds);
        if (layer == 0) phase_gemm_kv(P, lds);
        xcd_barrier(bar);
        phase_prep(P, layer);
        if (layer == 0) phase_memk_norm(P);
        for (int u = B; u < 256; u += G) unit_gla_a4(P, layer, u, lds);
        xcd_barrier(bar);
        Q_LOOP_BEGIN(P.ctl_() + CTL_Q0 + 64 * (layer * 2), 128 + 2048 + 256)
            if (item < 128) unit_s5(P, layer, item, lds);
            else if (item < 2176) unit_dsa_index(P, item - 128, lds);
            else gla_scan_slice(P, (item - 2176) * NTHR + TIDX());
        Q_LOOP_END
        xcd_barrier(bar);
        Q_LOOP_BEGIN(P.ctl_() + CTL_Q0 + 64 * (layer * 2 + 1), 256 + 256 + 128 + 256)
            if (item < 256) unit_dsa_attn(P, item, lds);
            else if (item < 512) unit_gla_c4(P, layer, item - 256, lds);
            else if (item < 640) unit_glu(P, layer, item - 512, lds);
            else unit_mem_attn(P, layer, item - 640, lds);
        Q_LOOP_END
        xcd_barrier(bar);
        phase_gemm_out(P, layer, lds);
        xcd_barrier(bar);
    }
}

extern "C" void kernel_launch(void* const* d_in, const int* in_sizes, int n_in, void* d_out, int out_size, void* d_ws, size_t ws_size, hipStream_t stream) {
    if (n_in != 24 || ws_size < WS_END) { fprintf(stderr, "kernel_launch: unexpected n_in %d or ws_size %zu (< %zu)\n", n_in, ws_size, (size_t)WS_END); return; }
    Params P; memset(&P, 0, sizeof(P));
    P.x = (const float*)d_in[0]; P.mem = (const float*)d_in[1]; P.pos = (const int*)d_in[2]; P.ln_gain = (const float*)d_in[3]; P.w_in = (const float*)d_in[4];
    P.gla_w_up = (const float*)d_in[5]; P.gla_b_up = (const float*)d_in[6]; P.s5_a_re = (const float*)d_in[7]; P.s5_a_im = (const float*)d_in[8]; P.s5_log_step = (const float*)d_in[9];
    P.s5_b_re = (const float*)d_in[10]; P.s5_b_im = (const float*)d_in[11]; P.s5_c_re = (const float*)d_in[12]; P.s5_c_im = (const float*)d_in[13]; P.s5_d = (const float*)d_in[14];
    P.s5_w_glu = (const float*)d_in[15]; P.dsa_q_norm = (const float*)d_in[16]; P.dsa_k_norm = (const float*)d_in[17]; P.mem_norm = (const float*)d_in[18]; P.w_mem_kv = (const float*)d_in[19];
    P.mem_q_norm = (const float*)d_in[20]; P.mem_k_norm = (const float*)d_in[21]; P.out_norm = (const float*)d_in[22]; P.w_out = (const float*)d_in[23];
    P.out = (float*)d_out;
    char* ws = (char*)d_ws; P.ws = ws;
    static int grid = 0;
    if (!grid) {
        int dev = 0, cus = 0, per_cu = 0;
        (void)hipGetDevice(&dev); (void)hipDeviceGetAttribute(&cus, hipDeviceAttributeMultiprocessorCount, dev);
        (void)hipFuncSetAttribute((const void*)k_mega, hipFuncAttributeMaxDynamicSharedMemorySize, LDS_BYTES);
        (void)hipOccupancyMaxActiveBlocksPerMultiprocessor(&per_cu, (const void*)k_mega, NTHR, LDS_BYTES);
        if (per_cu < 1) fprintf(stderr, "kernel_launch: occupancy query reports %d blocks per CU\n", per_cu);
        grid = cus > 0 ? cus : 256;
    }
    (void)hipMemsetAsync(ws + WS_CTL, 0, CTL_BYTES, stream);
    hipLaunchKernelGGL(k_mega, dim3(grid), dim3(NTHR), LDS_BYTES, stream, P);
}
```

```cpp
#include <hip/hip_runtime.h>
#include <stdint.h>
#include <stdio.h>
#include <string.h>

constexpr int NB = 4, SEQ = 4096, NTOK = NB * SEQ, DM = 2048, DEPTH = 4, MEML = 256;
constexpr int NIN = 5984, NPAD = 6144, MIX = 2048;
constexpr int C_GQ = 0, C_GK = 256, C_GV = 512, C_GLR = 1024, C_GZ = 1040, C_SU = 1552, C_SZ = 2064, C_DQ = 2576, C_DK = 3088, C_DV = 3216,
              C_DIQ = 3344, C_DIK = 4368, C_DIW = 4432, C_DZ = 4448, C_MQ = 4960, C_MZ = 5472;
constexpr float EPS = 1e-6f;
constexpr int NTHR = 512;
constexpr int LDS_BYTES = 147456;

typedef unsigned short bf16_t;
typedef short bf16x8 __attribute__((ext_vector_type(8)));
typedef short s16x4 __attribute__((ext_vector_type(4)));
typedef float f32x4 __attribute__((ext_vector_type(4)));
typedef float f32x8 __attribute__((ext_vector_type(8)));
typedef float f32x16 __attribute__((ext_vector_type(16)));
typedef unsigned u32x4 __attribute__((ext_vector_type(4)));
typedef unsigned u32x2 __attribute__((ext_vector_type(2)));
#define LAS __attribute__((address_space(3)))

__device__ __forceinline__ float bf2f(bf16_t b) { return __uint_as_float(((unsigned)b) << 16); }
__device__ __forceinline__ bf16_t f2bf(float f) { unsigned u = __float_as_uint(f); u += 0x7FFFu + ((u >> 16) & 1u); return (bf16_t)(u >> 16); }
__device__ __forceinline__ unsigned pk2bf(float lo, float hi) { return (unsigned)f2bf(lo) | ((unsigned)f2bf(hi) << 16); }
__device__ __forceinline__ float sigmoidf_(float x) { return 1.f / (1.f + __expf(-x)); }
__device__ __forceinline__ float siluf_(float x) { return x / (1.f + __expf(-x)); }

__device__ __forceinline__ int TIDX() { int t = (int)threadIdx.x; asm volatile("" : "+v"(t)); return t; }
__device__ __forceinline__ float shx(float v, int m) { const int src = ((TIDX() & 63) ^ m) << 2; return __int_as_float(__builtin_amdgcn_ds_bpermute(src, __float_as_int(v))); }
__device__ __forceinline__ float wave_sum(float v) {
#pragma unroll
    for (int o = 32; o >= 1; o >>= 1) v += shx(v, o);
    return v;
}
__device__ __forceinline__ void ld8f(const bf16_t* p, float (&v)[8]) { const u32x4 w = *(const u32x4*)p;
#pragma unroll
    for (int j = 0; j < 4; ++j) { v[2 * j] = __uint_as_float(w[j] << 16); v[2 * j + 1] = __uint_as_float(w[j] & 0xffff0000u); } }
__device__ __forceinline__ void st8f(bf16_t* p, const float (&v)[8]) { u32x4 w; w.x = pk2bf(v[0], v[1]); w.y = pk2bf(v[2], v[3]); w.z = pk2bf(v[4], v[5]); w.w = pk2bf(v[6], v[7]); *(u32x4*)p = w; }
__device__ __forceinline__ float f2bf_f(float f) { return bf2f(f2bf(f)); }

#ifndef TPROBE
#define TPROBE 0
#endif
#if TPROBE
#define TPU_START(id) do { if (TPROBE == (id) && TIDX() == 0) *(volatile unsigned long long*)(lds + LDS_BYTES - 24) = __builtin_amdgcn_s_memrealtime(); } while (0)
#define TPU_STOP(id) do { if (TPROBE == (id) && TIDX() == 0) *(volatile unsigned long long*)(lds + LDS_BYTES - 32) += __builtin_amdgcn_s_memrealtime() - *(volatile unsigned long long*)(lds + LDS_BYTES - 24); } while (0)
#else
#define TPU_START(id) do {} while (0)
#define TPU_STOP(id) do {} while (0)
#endif
#define XB_TMO      128
#define XB_XCNT(j)  (256  + 64 * (j))
#define XB_XSUB(j)  (1280 + 64 * (j))
#define XB_XGEN(j)  (2304 + 64 * (j))
#define XB_TOP      3328
#define XB_TOPGEN   3392
#define XCD_BAR_WORDS 3456
#define XB_SPIN_CAP (1u << 18)

__device__ __forceinline__ unsigned xb_ld(unsigned* p)              { return __hip_atomic_load(p, __ATOMIC_RELAXED, __HIP_MEMORY_SCOPE_AGENT); }
__device__ __forceinline__ unsigned xb_add(unsigned* p, unsigned v) { return __hip_atomic_fetch_add(p, v, __ATOMIC_RELAXED, __HIP_MEMORY_SCOPE_AGENT); }
__device__ __forceinline__ unsigned xb_xcc_id() { return (unsigned)__builtin_amdgcn_s_getreg((3 << 11) | 20) & 0xFu; }
#define XB_SPIN(cond, bar) do { unsigned _sp = 0; while (cond) { __builtin_amdgcn_s_sleep(1); \
    if ((++_sp & 255u) == 0u) { if (xb_ld(&(bar)[XB_TMO])) break; if (_sp > XB_SPIN_CAP) { atomicAdd(&(bar)[XB_TMO], 1u); break; } } } } while (0)

struct XcdBarrier {
    unsigned* bar; unsigned x;
    volatile LAS unsigned* st;
};

__device__ __forceinline__ XcdBarrier xcd_barrier_post(unsigned* bar, volatile LAS unsigned* st) {
    XcdBarrier b; b.bar = bar; b.x = xb_xcc_id(); b.st = st;
    if (TIDX() == 0) (void)xb_add(&bar[XB_XCNT(b.x)], 1u);
    return b;
}
__device__ __forceinline__ void xcd_barrier_complete(unsigned* bar, unsigned x, unsigned& nloc, unsigned& nx) {
    const unsigned G = gridDim.x * gridDim.y * gridDim.z;
    unsigned sum, cnt, mine, sp = 0u;
    for (;;) {
        sum = 0u; cnt = 0u; mine = 0u;
#pragma unroll
        for (unsigned j = 0; j < 16; ++j) { const unsigned c = xb_ld(&bar[XB_XCNT(j)]); sum += c; cnt += (c > 0u) ? 1u : 0u; mine = (j == x) ? c : mine; }
        if (sum == G) break;
        __builtin_amdgcn_s_sleep(1);
        if ((++sp & 255u) == 0u) { if (xb_ld(&bar[XB_TMO])) break; if (sp > XB_SPIN_CAP) { atomicAdd(&bar[XB_TMO], 1u); break; } }
    }
    nloc = mine > 0u ? mine : 1u; nx = cnt > 0u ? cnt : 1u;
}

__device__ __forceinline__ void xcd_barrier(const XcdBarrier& b) {
    asm volatile("s_waitcnt vmcnt(0)" ::: "memory");
    __syncthreads();
    if (TIDX() == 0) {
        unsigned* bar = b.bar; const unsigned bx = xb_xcc_id();
        __builtin_amdgcn_s_waitcnt(0);
        unsigned nloc = b.st[0], nx = b.st[1];
        if (nloc == 0u) { xcd_barrier_complete(bar, bx, nloc, nx); b.st[0] = nloc; b.st[1] = nx; }
        const unsigned old = xb_add(&bar[XB_XSUB(bx)], 1u);
        const unsigned gen = old / nloc;
        if (old + 1u == (gen + 1u) * nloc) {
            __builtin_amdgcn_fence(__ATOMIC_RELEASE, "agent");
            asm volatile("s_waitcnt vmcnt(0)" ::: "memory");
            const unsigned og = xb_add(&bar[XB_TOP], 1u);
            const unsigned tg = og / nx;
            if (og + 1u == (tg + 1u) * nx) xb_add(&bar[XB_TOPGEN], 1u);
            else XB_SPIN(xb_ld(&bar[XB_TOPGEN]) == tg, bar);
            __builtin_amdgcn_fence(__ATOMIC_ACQUIRE, "agent");
            xb_add(&bar[XB_XGEN(bx)], 1u);
            asm volatile("s_waitcnt vmcnt(0)" ::: "memory");
        } else {
            XB_SPIN(xb_ld(&bar[XB_XGEN(bx)]) == gen, bar);
            __builtin_amdgcn_fence(__ATOMIC_ACQUIRE, "agent");
            asm volatile("s_waitcnt vmcnt(0)" ::: "memory");
        }
    }
    __syncthreads();
}
namespace pg8 {
#define PG8_LAS __attribute__((address_space(3)))
typedef float f32x2 __attribute__((ext_vector_type(2)));
typedef unsigned u32x4 __attribute__((ext_vector_type(4)));
constexpr int BM = 256, BK = 64, HALF = 128, HTB = HALF * BK * 2  , STAGE_BYTES = 8 * HTB, NXCD = 8, WGM = 8;

__host__ __device__ __forceinline__ int lds_byte(int r, int c) { const int st = (r >> 4) * 2 + (c >> 5), rr = r & 15, cc = c & 31, ob = rr * 64 + cc * 2; return st * 1024 + (ob ^ (((ob >> 9) & 1) << 5)); }
__host__ __device__ __forceinline__ void stage_rc(int b, int& R, int& C) { const int st = b / 1024, sb = b % 1024, swz = sb ^ (((sb >> 9) & 1) << 5); R = (st >> 1) * 16 + swz / 64; C = (st & 1) * 32 + (swz % 64) / 2; }
__host__ __device__ __forceinline__ int perm32(int rho) { const int n = rho >> 4, i = rho & 15; return 8 * (i >> 2) + 4 * n + (i & 3); }

struct Unit { int pm, pn; };
struct Gemm { const bf16_t* A; const bf16_t* Bt; int M, N, K; };

struct StaticOrder {
    int nM, nN, nwg, G, c;
    __host__ __device__ void init(int M, int N, int G_, int c_) { nM = M / BM; nN = N / BM; nwg = nM * nN; G = G_; c = c_; }
    __host__ __device__ bool next(int i, Unit& u) const {
        const long L = (long)i * G + c; if (L >= nwg) return false;
        int wgid = (int)L; { const int q = nwg / NXCD, r = nwg % NXCD, xcd = wgid % NXCD, off = wgid / NXCD; wgid = (xcd < r ? xcd * (q + 1) : r * (q + 1) + (xcd - r) * q) + off; }
        const int nig = WGM * nN, gid = wgid / nig, fm = gid * WGM, gsz = (nM - fm) < WGM ? (nM - fm) : WGM;
        u.pm = fm + ((wgid % nig) % gsz); u.pn = (wgid % nig) / gsz; return true;
    }
    __device__ __forceinline__ void a_ready(const Unit&) const {}
    __device__ __forceinline__ void done(const Unit&) const {}
};
__device__ __forceinline__ unsigned cvt_pk_bf16(float lo, float hi) { unsigned r; asm volatile("v_cvt_pk_bf16_f32 %0, %1, %2" : "=v"(r) : "v"(lo), "v"(hi)); return r; }
struct EpiBf16Plain {
    static constexpr bool PERM = true, AFTER_DRAIN = false;
    bf16_t* O; int ldc;
    __device__ __forceinline__ void operator()(const f32x4 (&acc)[2][2][4][2], const Unit& u, int wr, int wc, int fr, int fq) const {
        const int row0 = u.pm * BM + wr * 64 + fr, col0 = u.pn * BM + wc * 32 + 8 * fq;
#pragma unroll
        for (int ai = 0; ai < 2; ++ai)
#pragma unroll
            for (int m = 0; m < 4; ++m) { bf16_t* rowp = O + (size_t)(row0 + ai * HALF + m * 16) * ldc + col0;
#pragma unroll
                for (int bj = 0; bj < 2; ++bj) { const f32x4 v0 = acc[ai][bj][m][0], v1 = acc[ai][bj][m][1];
                    u32x4 w; w.x = cvt_pk_bf16(v0[0], v0[1]); w.y = cvt_pk_bf16(v0[2], v0[3]); w.z = cvt_pk_bf16(v1[0], v1[1]); w.w = cvt_pk_bf16(v1[2], v1[3]);
                    *(u32x4*)(rowp + bj * HALF) = w; } }
    }
};
struct EpiResid {
    static constexpr bool PERM = false, AFTER_DRAIN = false;
    const float* R; float* C; int ldc;
    __device__ __forceinline__ void operator()(const f32x4 (&acc)[2][2][4][2], const Unit& u, int wr, int wc, int fr, int fq) const {
        const int row0 = u.pm * BM + wr * 64 + fr, col0 = u.pn * BM + wc * 32 + 4 * fq;
#pragma unroll
        for (int ai = 0; ai < 2; ++ai)
#pragma unroll
            for (int m = 0; m < 4; ++m) { const size_t off = (size_t)(row0 + ai * HALF + m * 16) * ldc + col0;
#pragma unroll
                for (int bj = 0; bj < 2; ++bj)
#pragma unroll
                    for (int n = 0; n < 2; ++n) { const f32x4 r = *(const f32x4*)(R + off + bj * HALF + n * 16); *(f32x4*)(C + off + bj * HALF + n * 16) = acc[ai][bj][m][n] + r; } }
    }
};
struct EpiResidMix {
    static constexpr bool PERM = true, AFTER_DRAIN = false;
    const void* R; void* C; int ldc; int r16, c16;
    __device__ __forceinline__ void operator()(const f32x4 (&acc)[2][2][4][2], const Unit& u, int wr, int wc, int fr, int fq) const {
        const int row0 = u.pm * BM + wr * 64 + fr, col0 = u.pn * BM + wc * 32 + 8 * fq;
#pragma unroll
        for (int ai = 0; ai < 2; ++ai)
#pragma unroll
            for (int m = 0; m < 4; ++m) { const size_t off = (size_t)(row0 + ai * HALF + m * 16) * ldc + col0;
                f32x4 r0[2], r1[2];
                if (r16) {
#pragma unroll
                    for (int bj = 0; bj < 2; ++bj) { const u32x4 w = *(const u32x4*)((const bf16_t*)R + off + bj * HALF);
                        r0[bj] = f32x4{__uint_as_float(w.x << 16), __uint_as_float(w.x & 0xffff0000u), __uint_as_float(w.y << 16), __uint_as_float(w.y & 0xffff0000u)};
                        r1[bj] = f32x4{__uint_as_float(w.z << 16), __uint_as_float(w.z & 0xffff0000u), __uint_as_float(w.w << 16), __uint_as_float(w.w & 0xffff0000u)}; }
                } else {
#pragma unroll
                    for (int bj = 0; bj < 2; ++bj) { r0[bj] = *(const f32x4*)((const float*)R + off + bj * HALF); r1[bj] = *(const f32x4*)((const float*)R + off + bj * HALF + 4); }
                }
#pragma unroll
                for (int bj = 0; bj < 2; ++bj) { const f32x4 v0 = acc[ai][bj][m][0] + r0[bj], v1 = acc[ai][bj][m][1] + r1[bj];
                    if (c16) { u32x4 w; w.x = cvt_pk_bf16(v0[0], v0[1]); w.y = cvt_pk_bf16(v0[2], v0[3]); w.z = cvt_pk_bf16(v1[0], v1[1]); w.w = cvt_pk_bf16(v1[2], v1[3]);
                        *(u32x4*)((bf16_t*)C + off + bj * HALF) = w; }
                    else { *(f32x4*)((float*)C + off + bj * HALF) = v0; *(f32x4*)((float*)C + off + bj * HALF + 4) = v1; } } }
    }
};
struct EpiGlu {
    static constexpr bool PERM = true, AFTER_DRAIN = false;
    const bf16_t* Y; int ldy; bf16_t* O; int ldo; int ooff;
    __device__ __forceinline__ void operator()(const f32x4 (&acc)[2][2][4][2], const Unit& u, int wr, int wc, int fr, int fq) const {
        const int row0 = u.pm * BM + wr * 64 + fr, col0 = u.pn * BM + wc * 32 + 8 * fq;
#pragma unroll
        for (int ai = 0; ai < 2; ++ai)
#pragma unroll
            for (int m = 0; m < 4; ++m) { const int row = row0 + ai * HALF + m * 16;
#pragma unroll
                for (int bj = 0; bj < 2; ++bj) { const f32x4 v0 = acc[ai][bj][m][0], v1 = acc[ai][bj][m][1];
                    const u32x4 yw = *(const u32x4*)(Y + (size_t)row * ldy + col0 + bj * HALF);
                    float y[8], g[8];
#pragma unroll
                    for (int j = 0; j < 4; ++j) { y[2 * j] = __uint_as_float(yw[j] << 16); y[2 * j + 1] = __uint_as_float(yw[j] & 0xffff0000u); }
#pragma unroll
                    for (int j = 0; j < 4; ++j) { g[j] = 1.f / (1.f + __expf(-v0[j])); g[4 + j] = 1.f / (1.f + __expf(-v1[j])); }
                    u32x4 w; w.x = cvt_pk_bf16(y[0] * g[0], y[1] * g[1]); w.y = cvt_pk_bf16(y[2] * g[2], y[3] * g[3]); w.z = cvt_pk_bf16(y[4] * g[4], y[5] * g[5]); w.w = cvt_pk_bf16(y[6] * g[6], y[7] * g[7]);
                    *(u32x4*)(O + (size_t)row * ldo + ooff + col0 + bj * HALF) = w; } }
    }
};
struct EpiGluGate {
    static constexpr bool PERM = true, AFTER_DRAIN = true;
    const bf16_t* Y; const bf16_t* Pz; bf16_t* G;
    __device__ __forceinline__ void fused(const f32x4 (&acc)[2][2][4][2], const Unit& u, int wr, int wc, int fr, int fq, PG8_LAS unsigned char* lds, int wid, int lane) const {
        constexpr int TS = 528;
        const int row0 = wr * 64 + fr, col0 = wc * 32 + 8 * fq;
#pragma unroll
        for (int ai = 0; ai < 2; ++ai)
#pragma unroll
            for (int m = 0; m < 4; ++m) { const int rl = row0 + ai * HALF + m * 16; const size_t grow = (size_t)u.pm * BM + rl;
#pragma unroll
                for (int bj = 0; bj < 2; ++bj) { const f32x4 v0 = acc[ai][bj][m][0], v1 = acc[ai][bj][m][1];
                    const u32x4 yw = *(const u32x4*)(Y + grow * 512 + u.pn * BM + col0 + bj * HALF);
                    float y[8], g[8];
#pragma unroll
                    for (int j = 0; j < 4; ++j) { y[2 * j] = __uint_as_float(yw[j] << 16); y[2 * j + 1] = __uint_as_float(yw[j] & 0xffff0000u); }
#pragma unroll
                    for (int j = 0; j < 4; ++j) { g[j] = 1.f / (1.f + __expf(-v0[j])); g[4 + j] = 1.f / (1.f + __expf(-v1[j])); }
                    u32x4 w; w.x = cvt_pk_bf16(y[0] * g[0], y[1] * g[1]); w.y = cvt_pk_bf16(y[2] * g[2], y[3] * g[3]); w.z = cvt_pk_bf16(y[4] * g[4], y[5] * g[5]); w.w = cvt_pk_bf16(y[6] * g[6], y[7] * g[7]);
                    *(PG8_LAS u32x4*)(lds + rl * TS + (col0 + bj * HALF) * 2) = w; } }
        __syncthreads();
        { const int t = wid * 64 + lane, row = t >> 1, hd = t & 1; const PG8_LAS unsigned char* src = lds + row * TS + hd * 256;
          float ss = 0.f;
#pragma unroll
          for (int i = 0; i < 16; ++i) { const u32x4 w = *(const PG8_LAS u32x4*)(src + 16 * i);
#pragma unroll
              for (int j = 0; j < 4; ++j) { const float a = __uint_as_float(w[j] << 16), b = __uint_as_float(w[j] & 0xffff0000u); ss += a * a + b * b; } }
          const float rn = rsqrtf(ss * (1.f / 128.f) + 1e-6f);
          const size_t grow = (size_t)u.pm * BM + row; const int cb = u.pn * BM + hd * 128;
          const bf16_t* zp = Pz + grow * 6144 + 2064 + cb; bf16_t* gp = G + grow * 2048 + 512 + cb;
#pragma unroll
          for (int i = 0; i < 16; ++i) { const u32x4 w = *(const PG8_LAS u32x4*)(src + 16 * i); const u32x4 zw = *(const u32x4*)(zp + 8 * i); u32x4 o;
#pragma unroll
              for (int j = 0; j < 4; ++j) { const float a = __uint_as_float(w[j] << 16), b = __uint_as_float(w[j] & 0xffff0000u), za = __uint_as_float(zw[j] << 16), zb = __uint_as_float(zw[j] & 0xffff0000u);
                  o[j] = cvt_pk_bf16(a * rn * (za / (1.f + __expf(-za))), b * rn * (zb / (1.f + __expf(-zb)))); }
              *(u32x4*)(gp + 8 * i) = o; } }
        __syncthreads();
    }
};
struct EpiBf16Scale {
    static constexpr bool PERM = true, AFTER_DRAIN = false;
    bf16_t* O; int ldc; const float* ssq;
    __device__ __forceinline__ void operator()(const f32x4 (&acc)[2][2][4][2], const Unit& u, int wr, int wc, int fr, int fq) const {
        const int row0 = u.pm * BM + wr * 64 + fr, col0 = u.pn * BM + wc * 32 + 8 * fq;
#pragma unroll
        for (int ai = 0; ai < 2; ++ai)
#pragma unroll
            for (int m = 0; m < 4; ++m) { const int row = row0 + ai * HALF + m * 16; bf16_t* rowp = O + (size_t)row * ldc + col0;
                float ssum = 0.f; { const f32x4* sp_ = (const f32x4*)(ssq + (size_t)row * 32);
#pragma unroll
                    for (int q = 0; q < 8; ++q) { const f32x4 t4 = sp_[q]; ssum += (t4[0] + t4[1]) + (t4[2] + t4[3]); } }
                const float s = rsqrtf(ssum * (1.f / 2048.f) + 1e-6f);
#pragma unroll
                for (int bj = 0; bj < 2; ++bj) { const f32x4 v0 = acc[ai][bj][m][0] * s, v1 = acc[ai][bj][m][1] * s;
                    u32x4 w; w.x = cvt_pk_bf16(v0[0], v0[1]); w.y = cvt_pk_bf16(v0[2], v0[3]); w.z = cvt_pk_bf16(v1[0], v1[1]); w.w = cvt_pk_bf16(v1[2], v1[3]);
                    *(u32x4*)(rowp + bj * HALF) = w; } }
    }
};
struct EpiResidNext {
    static constexpr bool PERM = false, AFTER_DRAIN = false;
    const float* R; float* C; int ldc; bf16_t* XB; float* ssq;
    __device__ __forceinline__ void operator()(const f32x4 (&acc)[2][2][4][2], const Unit& u, int wr, int wc, int fr, int fq) const {
        const int row0 = u.pm * BM + wr * 64 + fr, col0 = u.pn * BM + wc * 32 + 4 * fq;
#pragma unroll
        for (int ai = 0; ai < 2; ++ai)
#pragma unroll
            for (int m = 0; m < 4; ++m) { const int row = row0 + ai * HALF + m * 16; const size_t off = (size_t)row * ldc + col0; float ss = 0.f;
#pragma unroll
                for (int bj = 0; bj < 2; ++bj)
#pragma unroll
                    for (int n = 0; n < 2; ++n) { const f32x4 r = *(const f32x4*)(R + off + bj * HALF + n * 16); const f32x4 v = acc[ai][bj][m][n] + r;
                        *(f32x4*)(C + off + bj * HALF + n * 16) = v;
                        if (XB) { u32x2 w; w.x = cvt_pk_bf16(v[0], v[1]); w.y = cvt_pk_bf16(v[2], v[3]); *(u32x2*)(XB + off + bj * HALF + n * 16) = w; }
                        ss += v[0] * v[0] + v[1] * v[1] + v[2] * v[2] + v[3] * v[3]; }
                if (ssq) { ss += shx(ss, 16); ss += shx(ss, 32); if (fq == 0) ssq[(size_t)row * 32 + u.pn * 4 + wc] = ss; } }
    }
};
template <class Epi, class Sched, bool STAMP = false>
__device__ __forceinline__ void gemm_phase(PG8_LAS unsigned char* lds, const Gemm g, const Sched& S, const Epi& E, unsigned long long* stamps) {
    const int tid = TIDX(), wid = __builtin_amdgcn_readfirstlane(tid >> 6), lane = tid & 63, wr = wid >> 2, wc = wid & 3, fr = lane & 15, fq = lane >> 4;
    const int K = g.K, nt = K / BK;
    int ts_lo = 0, ts_hi = 0, nts = 0; const unsigned long long rt_entry = STAMP ? (unsigned long long)wall_clock64() : 0ull;
#define PG8_STAMP() do { if (STAMP && wid == 0 && nts < 64) { const unsigned long long _c = (unsigned long long)clock64(); \
        ts_lo = (lane == nts) ? (int)(unsigned)_c : ts_lo; ts_hi = (lane == nts) ? (int)(unsigned)(_c >> 32) : ts_hi; ++nts; } } while (0)
    PG8_STAMP();
    unsigned voffA[2], voffB[2];
#pragma unroll
    for (int i = 0; i < 2; ++i) { int R, C; stage_rc(tid * 16 + i * 8192, R, C); const int Rb = Epi::PERM ? ((R & ~31) + perm32(R & 31)) : R;
        voffA[i] = (unsigned)(R * K + C) * 2u; voffB[i] = (unsigned)(Rb * K + C) * 2u; }
    const size_t kstep = (size_t)(BK * 2);
    const size_t hstep = (size_t)HALF * K * 2;
    const size_t tstep = 2 * hstep;
    const unsigned ldsw = (unsigned)wid * 1024u;
    const int aoff = lds_byte(wr * 64 + fr, fq * 8), boff = lds_byte(wc * 32 + fr, fq * 8);
#define PG8_SA(b, h) (((b) * 2 + (h)) * HTB)
#define PG8_SB(b, h) ((4 + (b) * 2 + (h)) * HTB)
#define PG8_STAGE(bufoff, gbase, voff) do { _Pragma("unroll") for (int _i = 0; _i < 2; ++_i) \
        __builtin_amdgcn_global_load_lds((const unsigned*)((const char*)(gbase) + (voff)[_i]), (PG8_LAS unsigned*)(lds + (bufoff) + ldsw + _i * 8192), 16, 0, 0); } while (0)
#define PG8_LDA(dst, b, h) do { _Pragma("unroll") for (int m = 0; m < 4; ++m) _Pragma("unroll") for (int k = 0; k < 2; ++k) dst[m][k] = *(const PG8_LAS bf16x8*)(lds + PG8_SA(b, h) + aoff + m * 2048 + k * 1024); } while (0)
#define PG8_LDB(dst, b, h) do { _Pragma("unroll") for (int n = 0; n < 2; ++n) _Pragma("unroll") for (int k = 0; k < 2; ++k) dst[n][k] = *(const PG8_LAS bf16x8*)(lds + PG8_SB(b, h) + boff + n * 2048 + k * 1024); } while (0)
#define PG8_MMA(ai, bj, At, Bt) do { __builtin_amdgcn_s_setprio(1); _Pragma("unroll") for (int m = 0; m < 4; ++m) _Pragma("unroll") for (int n = 0; n < 2; ++n) _Pragma("unroll") for (int k = 0; k < 2; ++k) \
        acc[ai][bj][m][n] = __builtin_amdgcn_mfma_f32_16x16x32_bf16(Bt[n][k], At[m][k], acc[ai][bj][m][n], 0, 0, 0); __builtin_amdgcn_s_setprio(0); } while (0)
#define PG8_WAIT_V(n) asm volatile("s_waitcnt vmcnt(" #n ")" ::: "memory")
#define PG8_WAIT_L(n) asm volatile("s_waitcnt lgkmcnt(" #n ")" ::: "memory")
#define PG8_BAR __builtin_amdgcn_s_barrier()
#define PG8_SCHED __builtin_amdgcn_sched_barrier(0)
    Unit cur, nxt; int ui = 0;
    if (!S.next(0, cur)) return;
    f32x4 acc[2][2][4][2];
#pragma unroll
    for (int a = 0; a < 2; ++a)
#pragma unroll
        for (int b = 0; b < 2; ++b)
#pragma unroll
            for (int m = 0; m < 4; ++m)
#pragma unroll
                for (int n = 0; n < 2; ++n) acc[a][b][m][n] = (f32x4){0.f, 0.f, 0.f, 0.f};
    bf16x8 At[4][2], B0[2][2], B1[2][2];
    const char* cA = (const char*)g.A + (size_t)cur.pm * tstep; const char* cB = (const char*)g.Bt + (size_t)cur.pn * tstep;
    S.a_ready(cur);
    PG8_STAGE(PG8_SB(0, 0), cB, voffB); PG8_STAGE(PG8_SA(0, 0), cA, voffA); PG8_STAGE(PG8_SB(0, 1), cB + hstep, voffB); PG8_STAGE(PG8_SA(0, 1), cA + hstep, voffA);
    if (wr == 1) PG8_BAR;
    PG8_WAIT_V(4); PG8_BAR;
    PG8_STAGE(PG8_SB(1, 0), cB + kstep, voffB); PG8_STAGE(PG8_SA(1, 0), cA + kstep, voffA); PG8_STAGE(PG8_SB(1, 1), cB + hstep + kstep, voffB);
    PG8_WAIT_V(6); PG8_BAR;
    PG8_STAMP();
    for (;;) {
        const bool has_next = S.next(ui + 1, nxt);
        const char* nA = has_next ? (const char*)g.A + (size_t)nxt.pm * tstep : cA; const char* nB = has_next ? (const char*)g.Bt + (size_t)nxt.pn * tstep : cB;
        for (int t = 0; t < nt; t += 2) {
            const bool last = (t == nt - 2);
            const char* a1 = cA + (size_t)(t + 1) * kstep;
            const char* a2 = last ? nA : cA + (size_t)(t + 2) * kstep; const char* b2 = last ? nB : cB + (size_t)(t + 2) * kstep;
            const char* a3 = a2 + kstep; const char* b3 = b2 + kstep;
            if (last && has_next) S.a_ready(nxt);
            PG8_LDB(B0, 0, 0); PG8_SCHED; PG8_LDA(At, 0, 0); PG8_STAGE(PG8_SA(1, 1), a1 + hstep, voffA);
            PG8_WAIT_L(8); PG8_BAR; PG8_WAIT_L(0); PG8_MMA(0, 0, At, B0); PG8_BAR; PG8_SCHED;
            PG8_LDB(B1, 0, 1); PG8_STAGE(PG8_SB(0, 0), b2, voffB);
            PG8_BAR; PG8_WAIT_L(0); PG8_MMA(0, 1, At, B1); PG8_BAR;
            PG8_LDA(At, 0, 1); PG8_STAGE(PG8_SA(0, 0), a2, voffA);
            PG8_BAR; PG8_WAIT_L(0); PG8_MMA(1, 0, At, B0); PG8_BAR; PG8_SCHED;
            PG8_STAGE(PG8_SB(0, 1), b2 + hstep, voffB);
            PG8_WAIT_V(6); PG8_BAR; PG8_MMA(1, 1, At, B1); PG8_BAR;
            PG8_LDB(B0, 1, 0); PG8_SCHED; PG8_LDA(At, 1, 0); PG8_STAGE(PG8_SA(0, 1), a2 + hstep, voffA);
            PG8_WAIT_L(8); PG8_BAR; PG8_WAIT_L(0); PG8_MMA(0, 0, At, B0); PG8_BAR; PG8_SCHED;
            PG8_LDB(B1, 1, 1); PG8_STAGE(PG8_SB(1, 0), b3, voffB);
            PG8_BAR; PG8_WAIT_L(0); PG8_MMA(0, 1, At, B1); PG8_BAR;
            PG8_LDA(At, 1, 1); PG8_STAGE(PG8_SA(1, 0), a3, voffA);
            PG8_BAR; PG8_WAIT_L(0); PG8_MMA(1, 0, At, B0); PG8_BAR; PG8_SCHED;
            PG8_STAGE(PG8_SB(1, 1), b3 + hstep, voffB);
            PG8_WAIT_V(6); PG8_BAR; PG8_MMA(1, 1, At, B1); PG8_BAR;
        }
        PG8_STAMP();
        if constexpr (!Epi::AFTER_DRAIN) { E(acc, cur, wr, wc, fr, fq); S.done(cur); }
        PG8_STAMP();
        if (!has_next) break;
#pragma unroll
        for (int a = 0; a < 2; ++a)
#pragma unroll
            for (int b = 0; b < 2; ++b)
#pragma unroll
                for (int m = 0; m < 4; ++m)
#pragma unroll
                    for (int n = 0; n < 2; ++n) acc[a][b][m][n] = (f32x4){0.f, 0.f, 0.f, 0.f};
        cur = nxt; cA = nA; cB = nB; ++ui;
    }
    PG8_WAIT_V(0);
    if (wr == 0) PG8_BAR;
    PG8_BAR;
    if constexpr (Epi::AFTER_DRAIN) { E.fused(acc, cur, wr, wc, fr, fq, lds, wid, lane); S.done(cur); }
    PG8_STAMP();
    if (STAMP && wid == 0) { stamps[lane] = lane < nts ? (((unsigned long long)(unsigned)ts_hi << 32) | (unsigned)ts_lo) : 0ull;
        if (lane == 62) stamps[62] = rt_entry; if (lane == 63) stamps[63] = (unsigned long long)wall_clock64(); }
#undef PG8_STAMP
#undef PG8_SA
#undef PG8_SB
#undef PG8_STAGE
#undef PG8_LDA
#undef PG8_LDB
#undef PG8_MMA
#undef PG8_WAIT_V
#undef PG8_WAIT_L
#undef PG8_BAR
#undef PG8_SCHED
}
}
namespace att {
constexpr int D = 128, NW = 8, QBLK = 32, KVBLK = 64;
constexpr float SCALE = 0.088388347648318440f, THR = 8.f;
constexpr int SHM_V = KVBLK * D * 2, SHM_K = KVBLK * D * 2, SHM_ATTN = 2 * SHM_V + 2 * SHM_K + NW * 64 * 4;
#define KSWZ(row, colB) ((row) * 256 + ((colB) ^ (((row) & 7) << 4)))
#define SBAR() __builtin_amdgcn_sched_barrier(0)
__device__ __forceinline__ int crow(int r, int hi) { return (r & 3) + 8 * (r >> 2) + 4 * hi; }
__device__ __forceinline__ unsigned cvtpk(float lo, float hi) { unsigned r; asm volatile("v_cvt_pk_bf16_f32 %0, %1, %2" : "=v"(r) : "v"(lo), "v"(hi)); return r; }

template <bool MASKED>
__device__ __forceinline__ void partialSM(f32x16& p0, f32x16& p1, float& m_reg, float& mn, float& alpha, unsigned long long mw, int hi) {
  constexpr float C = SCALE * 1.4426950408889634f;
  float pmax = p0[0];
#pragma unroll
  for (int r = 1; r < 16; ++r) pmax = fmaxf(pmax, p0[r]);
#pragma unroll
  for (int r = 0; r < 16; ++r) pmax = fmaxf(pmax, p1[r]);
  { auto rr = __builtin_amdgcn_permlane32_swap(__float_as_uint(pmax), __float_as_uint(pmax), false, false);
    pmax = fmaxf(__uint_as_float(rr[0]), __uint_as_float(rr[1])); }
  if (__builtin_expect(__all(pmax - m_reg <= THR / SCALE), 1)) { mn = m_reg; alpha = 1.f; }
  else { mn = fmaxf(m_reg, pmax); alpha = __builtin_amdgcn_exp2f((m_reg - mn) * C); m_reg = mn; }
  const float mnC = -mn * C;
#pragma unroll
  for (int r = 0; r < 16; ++r) p0[r] = fmaf(p0[r], C, mnC);
#pragma unroll
  for (int r = 0; r < 16; ++r) p1[r] = fmaf(p1[r], C, mnC);
#pragma unroll
  for (int r = 0; r < 16; ++r) p0[r] = __builtin_amdgcn_exp2f(p0[r]);
}
__device__ __forceinline__ void finishSM(f32x16& p0, f32x16& p1, float alpha, float& l_reg, bf16x8& pa0, bf16x8& pa1, bf16x8& pa2, bf16x8& pa3) {
#pragma unroll
  for (int r = 0; r < 16; ++r) p1[r] = __builtin_amdgcn_exp2f(p1[r]);
  float ps = 0;
#pragma unroll
  for (int r = 0; r < 16; ++r) ps += p0[r];
#pragma unroll
  for (int r = 0; r < 16; ++r) ps += p1[r];
  { auto rr = __builtin_amdgcn_permlane32_swap(__float_as_uint(ps), __float_as_uint(ps), false, false);
    ps = __uint_as_float(rr[0]) + __uint_as_float(rr[1]); }
  l_reg = l_reg * alpha + ps;
#define PK4(P, BASE, OUT) do { unsigned a0 = cvtpk(P[BASE + 0], P[BASE + 1]), a1 = cvtpk(P[BASE + 2], P[BASE + 3]);   \
    unsigned b0 = cvtpk(P[BASE + 4], P[BASE + 5]), b1 = cvtpk(P[BASE + 6], P[BASE + 7]);                              \
    auto r0 = __builtin_amdgcn_permlane32_swap(a0, b0, false, false); auto r1 = __builtin_amdgcn_permlane32_swap(a1, b1, false, false); \
    u32x4 w = {r0[0], r1[0], r0[1], r1[1]}; OUT = *reinterpret_cast<bf16x8*>(&w); } while (0)
  PK4(p0, 0, pa0); PK4(p0, 8, pa1); PK4(p1, 0, pa2); PK4(p1, 8, pa3);
#undef PK4
}
template <int R> __device__ __forceinline__ float mask_bias(unsigned nw) {
  unsigned t; constexpr int bit = (R & 3) + 8 * (R >> 2);
  asm("v_bfe_i32 %0, %1, %2, 1\n\tv_and_b32 %0, 0xff800000, %0" : "=v"(t) : "v"(nw), "n"(bit));
  return __uint_as_float(t);
}
template <bool MASKED>
__device__ __forceinline__ void qkt(f32x16& p0, f32x16& p1, const char* Ks, const bf16x8* qr, int r32, int hi, unsigned long long mw) {
  if (MASKED) {
    const unsigned n0 = ~((unsigned)mw >> (4 * hi)), n1 = ~((unsigned)(mw >> 32) >> (4 * hi));
#define MB_(R) p0[R] = mask_bias<R>(n0); p1[R] = mask_bias<R>(n1);
    MB_(0) MB_(1) MB_(2) MB_(3) MB_(4) MB_(5) MB_(6) MB_(7) MB_(8) MB_(9) MB_(10) MB_(11) MB_(12) MB_(13) MB_(14) MB_(15)
#undef MB_
  } else { p0 = f32x16{}; p1 = f32x16{}; }
  asm volatile("" : "+v"(p0), "+v"(p1));
#pragma unroll
  for (int d0 = 0; d0 < 8; ++d0) { const int cb = (d0 * 16 + hi * 8) * 2;
    bf16x8 b0 = *reinterpret_cast<const bf16x8*>(Ks + KSWZ(r32, cb));
    bf16x8 b1 = *reinterpret_cast<const bf16x8*>(Ks + KSWZ(32 + r32, cb));
    p0 = __builtin_amdgcn_mfma_f32_32x32x16_bf16(b0, qr[d0], p0, 0, 0, 0);
    p1 = __builtin_amdgcn_mfma_f32_32x32x16_bf16(b1, qr[d0], p1, 0, 0, 0); }
}
__device__ __forceinline__ int v_st(int k, int c) { const int kk = (k & ~0xC) | ((k & 4) << 1) | ((k & 8) >> 1); return ((kk >> 3) * 4 + (c >> 5)) * 512 + ((kk & 7) * 32 + (c & 31)) * 2; }
__device__ __forceinline__ int v_rd_base(int lane) { return ((lane & 3) << 3) | (((lane >> 2) & 3) << 6) | (((lane >> 4) & 1) << 5) | (((lane >> 5) & 1) << 8); }
constexpr int v_rd_off(int d0, int ks, int half) { return d0 * 512 + ks * 4096 + half * 2048; }
template <int OFF> __device__ __forceinline__ s16x4 tr_read(int vb) {
  s16x4 r; asm volatile("ds_read_b64_tr_b16 %0, %1 offset:%2" : "=&v"(r) : "v"(vb), "i"(OFF) : "memory"); return r;
}
template <int D0> __device__ __forceinline__ void pv_one(f32x16& od, int vb, bf16x8 pa0, bf16x8 pa1, bf16x8 pa2, bf16x8 pa3) {
  const s16x4 l0 = tr_read<v_rd_off(D0, 0, 0)>(vb), h0 = tr_read<v_rd_off(D0, 0, 1)>(vb), l1 = tr_read<v_rd_off(D0, 1, 0)>(vb), h1 = tr_read<v_rd_off(D0, 1, 1)>(vb);
  const s16x4 l2 = tr_read<v_rd_off(D0, 2, 0)>(vb), h2 = tr_read<v_rd_off(D0, 2, 1)>(vb), l3 = tr_read<v_rd_off(D0, 3, 0)>(vb), h3 = tr_read<v_rd_off(D0, 3, 1)>(vb);
  asm volatile("s_waitcnt lgkmcnt(0)" ::: "memory"); SBAR();
#define PK(L, H) (bf16x8){L[0], L[1], L[2], L[3], H[0], H[1], H[2], H[3]}
  od = __builtin_amdgcn_mfma_f32_32x32x16_bf16(pa0, PK(l0, h0), od, 0, 0, 0);
  od = __builtin_amdgcn_mfma_f32_32x32x16_bf16(pa1, PK(l1, h1), od, 0, 0, 0);
  od = __builtin_amdgcn_mfma_f32_32x32x16_bf16(pa2, PK(l2, h2), od, 0, 0, 0);
  od = __builtin_amdgcn_mfma_f32_32x32x16_bf16(pa3, PK(l3, h3), od, 0, 0, 0);
#undef PK
}
__device__ __forceinline__ void pv_d0(f32x16* o, int vb, bf16x8 pa0, bf16x8 pa1, bf16x8 pa2, bf16x8 pa3) {
  pv_one<0>(o[0], vb, pa0, pa1, pa2, pa3); pv_one<1>(o[1], vb, pa0, pa1, pa2, pa3); pv_one<2>(o[2], vb, pa0, pa1, pa2, pa3); pv_one<3>(o[3], vb, pa0, pa1, pa2, pa3);
}

template <bool MASKED, int LDK, int VOFF, class OutRow>
__device__ __forceinline__ void attn_body(const bf16_t* __restrict__ Qw, const bf16_t* __restrict__ Kh, int NT,
                                          const unsigned long long* __restrict__ mbase, unsigned moff, const OutRow& Ow, char* lds) {
  const int tid = TIDX(), wid = tid >> 6, lane = tid & 63, r32 = lane & 31, hi = lane >> 5;
  char* V_lds = lds; char* K_lds = lds + 2 * SHM_V;
  float* ws = (float*)(lds + 2 * SHM_V + 2 * SHM_K) + wid * 64; float* li_l = ws; float* al_l = ws + 32;
  float m_reg = -1e30f, l_reg = 0; f32x16 o[4] = {}; bf16x8 qr[8];
  asm volatile("" : "+v"(o[0]), "+v"(o[1]), "+v"(o[2]), "+v"(o[3]));
#pragma unroll
  for (int d0 = 0; d0 < 8; ++d0) qr[d0] = *reinterpret_cast<const bf16x8*>(Qw + d0 * 16);
  const int sr = tid >> 4, sc = (tid & 15) * 8, vst0 = v_st(sr, sc), vst1 = v_st(32 + sr, sc);
  const int vb0 = (int)(uintptr_t)V_lds + v_rd_base(lane);
  struct { bf16x8 vs0, vs1, ks0, ks1; } sr_[2];
  const unsigned koff = (unsigned)(sr * LDK + sc) * 2u;
#define SLOAD(i, k0) do { const char* kb_ = (const char*)Kh + (size_t)(k0) * (LDK * 2); \
    sr_[i].vs0 = *reinterpret_cast<const bf16x8*>(kb_ + koff + VOFF * 2); sr_[i].vs1 = *reinterpret_cast<const bf16x8*>(kb_ + koff + (32 * LDK + VOFF) * 2); \
    sr_[i].ks0 = *reinterpret_cast<const bf16x8*>(kb_ + koff); sr_[i].ks1 = *reinterpret_cast<const bf16x8*>(kb_ + koff + 32 * LDK * 2); } while (0)
#define SWRITE(b, i) do { *(bf16x8*)(V_lds + (b) * SHM_V + vst0) = sr_[i].vs0;          \
    *(bf16x8*)(V_lds + (b) * SHM_V + vst1) = sr_[i].vs1; int kc = sc * 2;               \
    *(bf16x8*)(K_lds + (b) * SHM_K + KSWZ(sr, kc)) = sr_[i].ks0;                       \
    *(bf16x8*)(K_lds + (b) * SHM_K + KSWZ(32 + sr, kc)) = sr_[i].ks1; } while (0)
#define SWAIT() asm volatile("s_waitcnt vmcnt(4)" ::: "memory")
#define RESC(a) do { if (__any((a) < 1.f)) { if (hi == 0) al_l[r32] = (a); asm volatile("s_waitcnt lgkmcnt(0)" ::: "memory"); \
    _Pragma("unroll") for (int d = 0; d < 4; ++d) _Pragma("unroll") for (int r = 0; r < 16; ++r) o[d][r] *= al_l[crow(r, hi)]; } } while (0)
  f32x16 pA0, pA1, pB0, pB1; float mnA, mnB, alA, alB; bf16x8 pa0, pa1, pa2, pa3;
  unsigned long long mw = 0ull;
  constexpr int SE = 0, SO = 1;
  if (MASKED) mw = *(const unsigned long long*)((const char*)mbase + moff);
  SLOAD(SE, 0); asm volatile("s_waitcnt vmcnt(0)" ::: "memory"); SWRITE(0, SE); __syncthreads();
  qkt<MASKED>(pA0, pA1, K_lds, qr, r32, hi, mw);
  if (MASKED) mw = *(const unsigned long long*)((const char*)mbase + (moff + 8u));
  partialSM<MASKED>(pA0, pA1, m_reg, mnA, alA, mw, hi);
  SLOAD(SO, KVBLK); SLOAD(SE, (2 < NT ? 2 : NT - 1) * KVBLK);
  SWAIT();
  SWRITE(1, SO); __syncthreads();
  for (int j = 1; j + 1 < NT; j += 2) {
    SBAR(); qkt<MASKED>(pB0, pB1, K_lds + SHM_K, qr, r32, hi, mw);
    if (MASKED) mw = *(const unsigned long long*)((const char*)mbase + (moff + 8u * (unsigned)(j + 1)));
    finishSM(pA0, pA1, alA, l_reg, pa0, pa1, pa2, pa3); SBAR();
    SLOAD(SO, (j + 2) * KVBLK); SBAR();
    pv_d0(o, vb0, pa0, pa1, pa2, pa3); partialSM<MASKED>(pB0, pB1, m_reg, mnB, alB, mw, hi);
    __syncthreads(); if (MASKED) asm volatile("s_waitcnt vmcnt(5)" ::: "memory"); else SWAIT();
    SWRITE(0, SE);
    RESC(alB); __syncthreads();
    SBAR(); qkt<MASKED>(pA0, pA1, K_lds, qr, r32, hi, mw);
    if (MASKED) mw = *(const unsigned long long*)((const char*)mbase + (moff + 8u * (unsigned)(j + 2)));
    finishSM(pB0, pB1, alB, l_reg, pa0, pa1, pa2, pa3); SBAR();
    SLOAD(SE, (j + 3 < NT ? j + 3 : NT - 1) * KVBLK); SBAR();
    pv_d0(o, vb0 + SHM_V, pa0, pa1, pa2, pa3); partialSM<MASKED>(pA0, pA1, m_reg, mnA, alA, mw, hi);
    __syncthreads(); if (MASKED) asm volatile("s_waitcnt vmcnt(5)" ::: "memory"); else SWAIT();
    SWRITE(1, SO);
    RESC(alA); __syncthreads();
  }
  SBAR(); qkt<MASKED>(pB0, pB1, K_lds + SHM_K, qr, r32, hi, mw);
  finishSM(pA0, pA1, alA, l_reg, pa0, pa1, pa2, pa3); SBAR();
  pv_d0(o, vb0, pa0, pa1, pa2, pa3); partialSM<MASKED>(pB0, pB1, m_reg, mnB, alB, mw, hi);
  __syncthreads(); RESC(alB);
  finishSM(pB0, pB1, alB, l_reg, pa0, pa1, pa2, pa3); SBAR();
  pv_d0(o, vb0 + SHM_V, pa0, pa1, pa2, pa3);
  if (hi == 0) li_l[r32] = l_reg; asm volatile("s_waitcnt lgkmcnt(0)" ::: "memory");
  float rli[16];
#pragma unroll
  for (int r = 0; r < 16; ++r) rli[r] = __builtin_amdgcn_rcpf(li_l[crow(r, hi)]);
  __syncthreads();
  float* og_s = (float*)lds + wid * (32 * 132);
#pragma unroll
  for (int r = 0; r < 16; ++r) {
#pragma unroll
    for (int d0 = 0; d0 < 4; ++d0) og_s[crow(r, hi) * 132 + d0 * 32 + r32] = o[d0][r] * rli[r]; }
  asm volatile("" ::: "memory");
  { const int row = lane >> 1, half = lane & 1; const float* src = og_s + row * 132 + half * 64;
    f32x4 v[16]; float ss = 0.f;
#pragma unroll
    for (int i = 0; i < 16; ++i) { v[i] = *(const f32x4*)(src + 4 * i); ss += v[i][0] * v[i][0] + v[i][1] * v[i][1] + v[i][2] * v[i][2] + v[i][3] * v[i][3]; }
    ss += shx(ss, 1);
    const float rn = rsqrtf(ss * (1.f / 128.f) + EPS);
    const bf16_t* zp = Ow.zrow(row) + half * 64; bf16_t* gp = Ow.grow(row) + half * 64;
#pragma unroll
    for (int i = 0; i < 8; ++i) { float z[8], g[8]; ld8f(zp + 8 * i, z);
#pragma unroll
      for (int q = 0; q < 4; ++q) { g[q] = v[2 * i][q] * rn * siluf_(z[q]); g[4 + q] = v[2 * i + 1][q] * rn * siluf_(z[4 + q]); }
      st8f(gp + 8 * i, g); } }
  __syncthreads();
#undef SLOAD
#undef SWRITE
#undef SWAIT
#undef RESC
}
}
constexpr size_t al256(size_t x) { return (x + 255) / 256 * 256; }
constexpr size_t WS_CTL   = 0;
constexpr size_t CTL_BYTES = 65536;
constexpr size_t WS_WINT  = WS_CTL + CTL_BYTES;
constexpr size_t WS_WOUTT = WS_WINT + al256((size_t)DEPTH * NPAD * DM * 2);
constexpr size_t WS_WKVT  = WS_WOUTT + al256((size_t)DEPTH * DM * MIX * 2);
constexpr size_t WS_WGLUT = WS_WKVT + al256((size_t)DEPTH * 1024 * DM * 2);
constexpr size_t WS_MEMN  = WS_WGLUT + al256((size_t)DEPTH * 512 * 512 * 2);
constexpr size_t WS_KVMEM = WS_MEMN + al256((size_t)NB * MEML * DM * 2);
constexpr size_t WS_XN    = WS_KVMEM + al256((size_t)NB * MEML * DEPTH * 1024 * 2);
constexpr size_t WS_P     = WS_XN + al256((size_t)NTOK * DM * 2);
constexpr size_t WS_XBUF  = WS_P + al256((size_t)NTOK * NPAD * 2);
constexpr size_t WS_OCAT  = WS_XBUF + al256((size_t)NTOK * DM * 4);
constexpr size_t WS_MASK  = WS_OCAT + al256((size_t)NTOK * MIX * 2);
constexpr size_t WS_IW    = WS_MASK + al256((size_t)NTOK * 64 * 8);
constexpr size_t WS_YBUF  = WS_IW + al256((size_t)NTOK * 16 * 4);
constexpr size_t WS_ROPE  = WS_YBUF + al256((size_t)NTOK * 512 * 2);
constexpr size_t WS_S5P   = WS_ROPE + al256((size_t)NTOK * 48 * 4);
constexpr size_t S5P_BYTES = (size_t)DEPTH * 32 * (64 * 2 + 64 * 2 + 64 * 16 * 2) * 4;
constexpr size_t WS_GLAS  = WS_S5P + al256(S5P_BYTES);
constexpr size_t WS_GLAD  = WS_GLAS + al256((size_t)NB * 64 * 4 * 64 * 128 * 4);
constexpr size_t WS_IKC   = WS_GLAD + al256((size_t)NB * 64 * 4 * 64 * 4);
constexpr size_t WS_KVC   = WS_IKC + al256((size_t)NTOK * 64 * 2);
constexpr size_t WS_IQL   = WS_KVC + al256((size_t)NTOK * 256 * 2);
constexpr size_t WS_SSQ   = WS_IQL + al256((size_t)NTOK * 64 * 2);
constexpr size_t DSP_SLOT = (size_t)(256 * 128 + 512) * 4;
constexpr size_t WS_DSP   = WS_SSQ + 256;
constexpr size_t WS_END   = WS_DSP + al256((size_t)160 * 2 * DSP_SLOT);

struct Params {
    const float* x; const float* mem; const int* pos; const float* ln_gain; const float* w_in; const float* gla_w_up; const float* gla_b_up;
    const float* s5_a_re; const float* s5_a_im; const float* s5_log_step; const float* s5_b_re; const float* s5_b_im; const float* s5_c_re; const float* s5_c_im;
    const float* s5_d; const float* s5_w_glu; const float* dsa_q_norm; const float* dsa_k_norm; const float* mem_norm; const float* w_mem_kv;
    const float* mem_q_norm; const float* mem_k_norm; const float* out_norm; const float* w_out;
    float* out;
    char* ws;
    __device__ __forceinline__ unsigned* ctl_() const { return (unsigned*)(ws + WS_CTL); }
    __device__ __forceinline__ bf16_t* WinT_() const { return (bf16_t*)(ws + WS_WINT); }
    __device__ __forceinline__ bf16_t* WoutT_() const { return (bf16_t*)(ws + WS_WOUTT); }
    __device__ __forceinline__ bf16_t* WkvT_() const { return (bf16_t*)(ws + WS_WKVT); }
    __device__ __forceinline__ bf16_t* WgluT_() const { return (bf16_t*)(ws + WS_WGLUT); }
    __device__ __forceinline__ bf16_t* memn_() const { return (bf16_t*)(ws + WS_MEMN); }
    __device__ __forceinline__ bf16_t* kvmem_() const { return (bf16_t*)(ws + WS_KVMEM); }
    __device__ __forceinline__ bf16_t* xn_() const { return (bf16_t*)(ws + WS_XN); }
    __device__ __forceinline__ bf16_t* p_() const { return (bf16_t*)(ws + WS_P); }
    __device__ __forceinline__ bf16_t* xbuf_() const { return (bf16_t*)(ws + WS_XBUF); }
    __device__ __forceinline__ bf16_t* ocat_() const { return (bf16_t*)(ws + WS_OCAT); }
    __device__ __forceinline__ unsigned long long* mask_() const { return (unsigned long long*)(ws + WS_MASK); }
    __device__ __forceinline__ float* iw_() const { return (float*)(ws + WS_IW); }
    __device__ __forceinline__ bf16_t* ybuf_() const { return (bf16_t*)(ws + WS_YBUF); }
    __device__ __forceinline__ float* rope_() const { return (float*)(ws + WS_ROPE); }
    __device__ __forceinline__ float* s5p_() const { return (float*)(ws + WS_S5P); }
    __device__ __forceinline__ float* glas_() const { return (float*)(ws + WS_GLAS); }
    __device__ __forceinline__ float* glad_() const { return (float*)(ws + WS_GLAD); }
    __device__ __forceinline__ bf16_t* ikc_() const { return (bf16_t*)(ws + WS_IKC); }
    __device__ __forceinline__ bf16_t* kvc_() const { return (bf16_t*)(ws + WS_KVC); }
    __device__ __forceinline__ float* ssq_() const { return (float*)(ws + WS_SSQ); }
    __device__ __forceinline__ bf16_t* iql_() const { return (bf16_t*)(ws + WS_IQL); }
    __device__ __forceinline__ char* dsp_() const { return ws + WS_DSP; }
};

__device__ __forceinline__ void transpose_tiles(const float* __restrict__ src, int K, int Nsrc, int Ndst, const float* __restrict__ scale, bf16_t* __restrict__ dst,
                                                int tile, float* lds_tile  ) {
    const int tid = TIDX(), ntn = Ndst / 256;
    const int tk = tile / ntn, tn = tile % ntn, k0 = tk * 64, n0 = tn * 256;
    __syncthreads();
    { const int ty = tid >> 4, tx = tid & 15;
      f32x4 v[2][4];
#pragma unroll
      for (int i = 0; i < 2; ++i)
#pragma unroll
        for (int q = 0; q < 4; ++q) { const int k = k0 + ty + 32 * i, n = n0 + 4 * tx + 64 * q;
          v[i][q] = (f32x4){0.f, 0.f, 0.f, 0.f};
          if (n < Nsrc) v[i][q] = *(const f32x4*)(src + (size_t)k * Nsrc + n); }
#pragma unroll
      for (int i = 0; i < 2; ++i) { const float s = scale ? scale[k0 + ty + 32 * i] : 1.f;
#pragma unroll
        for (int q = 0; q < 4; ++q) { float* t = lds_tile + (ty + 32 * i) * 257 + 4 * tx + 64 * q; t[0] = v[i][q][0] * s; t[1] = v[i][q][1] * s; t[2] = v[i][q][2] * s; t[3] = v[i][q][3] * s; } } }
    __syncthreads();
    { const int n = tid >> 1, kh = (tid & 1) * 32;
#pragma unroll
      for (int j = 0; j < 4; ++j) { const int kb = kh + 8 * j; u32x4 w;
        w.x = pk2bf(lds_tile[(kb + 0) * 257 + n], lds_tile[(kb + 1) * 257 + n]); w.y = pk2bf(lds_tile[(kb + 2) * 257 + n], lds_tile[(kb + 3) * 257 + n]);
        w.z = pk2bf(lds_tile[(kb + 4) * 257 + n], lds_tile[(kb + 5) * 257 + n]); w.w = pk2bf(lds_tile[(kb + 6) * 257 + n], lds_tile[(kb + 7) * 257 + n]);
        *(u32x4*)(dst + (size_t)(n0 + n) * K + k0 + kb) = w; } }
}

__device__ __forceinline__ void rmsnorm_rows(const float* __restrict__ X, bf16_t* __restrict__ Y, int nrows) {
    const int wid = TIDX() >> 6, lane = TIDX() & 63;
    for (int row = blockIdx.x * 8 + wid; row < nrows; row += gridDim.x * 8) {
        const float* xr = X + (size_t)row * DM; f32x4 v[8]; float ss = 0.f;
#pragma unroll
        for (int i = 0; i < 8; ++i) { v[i] = *(const f32x4*)(xr + 4 * lane + 256 * i); ss += v[i][0] * v[i][0] + v[i][1] * v[i][1] + v[i][2] * v[i][2] + v[i][3] * v[i][3]; }
        ss = wave_sum(ss); const float r = rsqrtf(ss * (1.f / DM) + EPS);
        bf16_t* yr = Y + (size_t)row * DM;
#pragma unroll
        for (int i = 0; i < 8; ++i) { u32x2 w; w.x = pk2bf(v[i][0] * r, v[i][1] * r); w.y = pk2bf(v[i][2] * r, v[i][3] * r); *(u32x2*)(yr + 4 * lane + 256 * i) = w; }
    }
}

__device__ __forceinline__ void rmsnorm_rows16(const bf16_t* __restrict__ X, bf16_t* __restrict__ Y, int nrows) {
    const int wid = TIDX() >> 6, lane = TIDX() & 63;
    for (int row = blockIdx.x * 8 + wid; row < nrows; row += gridDim.x * 8) {
        const bf16_t* xr = X + (size_t)row * DM; float v[4][8]; float ss = 0.f;
#pragma unroll
        for (int i = 0; i < 4; ++i) { ld8f(xr + 8 * lane + 512 * i, v[i]);
#pragma unroll
            for (int j = 0; j < 8; ++j) ss += v[i][j] * v[i][j]; }
        ss = wave_sum(ss); const float r = rsqrtf(ss * (1.f / DM) + EPS);
        bf16_t* yr = Y + (size_t)row * DM;
#pragma unroll
        for (int i = 0; i < 4; ++i) { float o[8];
#pragma unroll
            for (int j = 0; j < 8; ++j) o[j] = v[i][j] * r;
            st8f(yr + 8 * lane + 512 * i, o); }
    }
}

__device__ __forceinline__ void rows_bf16_ssq(const float* __restrict__ X, bf16_t* __restrict__ Y, float* __restrict__ ssq, int nrows) {
    const int wid = TIDX() >> 6, lane = TIDX() & 63;
    for (int row = blockIdx.x * 8 + wid; row < nrows; row += gridDim.x * 8) {
        const float* xr = X + (size_t)row * DM; bf16_t* yr = Y + (size_t)row * DM; float ss = 0.f;
#pragma unroll
        for (int i = 0; i < 8; ++i) { const f32x4 v = *(const f32x4*)(xr + 4 * lane + 256 * i); ss += v[0] * v[0] + v[1] * v[1] + v[2] * v[2] + v[3] * v[3];
            u32x2 w; w.x = pk2bf(v[0], v[1]); w.y = pk2bf(v[2], v[3]); *(u32x2*)(yr + 4 * lane + 256 * i) = w; }
        ss = wave_sum(ss); if (lane < 32) ssq[(size_t)row * 32 + lane] = (lane == 0) ? ss : 0.f;
    }
}
__device__ __forceinline__ void phase_prologue1(const Params& P, char* lds) {
    float* tile = (float*)lds;
    constexpr int T_IN = (DM / 64) * (NPAD / 256), T_OUT = (MIX / 64) * (DM / 256), T_KV = (DM / 64) * (1024 / 256), T_GLU = 8 * 2;
    constexpr int TOT = DEPTH * (T_IN + T_OUT + T_KV + T_GLU);
    for (int u = blockIdx.x; u < TOT; u += gridDim.x) {
        int l = u / (T_IN + T_OUT + T_KV + T_GLU), r = u % (T_IN + T_OUT + T_KV + T_GLU);
        if (r < T_IN) transpose_tiles(P.w_in + (size_t)l * DM * NIN, DM, NIN, NPAD, P.ln_gain + l * DM, P.WinT_() + (size_t)l * NPAD * DM, r, tile);
        else if ((r -= T_IN) < T_OUT) transpose_tiles(P.w_out + (size_t)l * MIX * DM, MIX, DM, DM, P.out_norm + l * MIX, P.WoutT_() + (size_t)l * DM * MIX, r, tile);
        else if ((r -= T_OUT) < T_KV) transpose_tiles(P.w_mem_kv + (size_t)l * DM * 1024, DM, 1024, 1024, P.mem_norm + l * DM, P.WkvT_() + (size_t)l * 1024 * DM, r, tile);
        else { r -= T_KV; transpose_tiles(P.s5_w_glu + (size_t)l * 512 * 512, 512, 512, 512, nullptr, P.WgluT_() + (size_t)l * 512 * 512, r, tile); }
    }
    rmsnorm_rows(P.mem, P.memn_(), NB * MEML);
}
__device__ __forceinline__ void phase_rope_table(const Params& P) {
    for (int idx = blockIdx.x * NTHR + TIDX(); idx < NTOK * 24; idx += gridDim.x * NTHR) {
        const int tok = idx / 24, i = idx % 24;
        const float e = (i < 16) ? -((float)i * 2.0f / 32.0f) : -((float)(i - 16) * 2.0f / 16.0f);
        const float inv_freq = exp2f(e * 18.931568569324174f);
        const float ang = (float)P.pos[tok] * inv_freq;
        const double a = (double)ang; const double k = rint(a * 0.15915494309189535); const float rf = (float)fma(-k, 6.283185307179586, a);
        P.rope_()[(size_t)idx * 2] = cosf(rf); P.rope_()[(size_t)idx * 2 + 1] = sinf(rf);
    }
}

__device__ __forceinline__ void phase_rmsnorm_x(const Params& P, int layer) { if (layer == 0) rmsnorm_rows(P.x, P.xn_(), NTOK); else rmsnorm_rows16(P.xbuf_(), P.xn_(), NTOK); }

__device__ __forceinline__ void phase_memk_norm(const Params& P) {
    const int wid = TIDX() >> 6, lane = TIDX() & 63;
    for (int it = blockIdx.x * 8 + wid; it < NB * MEML * DEPTH * 4; it += gridDim.x * 8) {
        const int row = it / (DEPTH * 4), l = (it / 4) % DEPTH, h = it % 4;
        bf16_t* kp = P.kvmem_() + (size_t)row * (DEPTH * 1024) + l * 1024 + h * 128 + 2 * lane;
        const unsigned w = *(const unsigned*)kp; const float a = __uint_as_float(w << 16), b = __uint_as_float(w & 0xffff0000u);
        const float ss = wave_sum(a * a + b * b), r = rsqrtf(ss * (1.f / 128.f) + EPS);
        const float* g = P.mem_k_norm + l * 128 + 2 * lane;
        *(unsigned*)kp = pk2bf(a * r * g[0], b * r * g[1]);
    }
}

__device__ __forceinline__ float sum16(float v) { v += shx(v, 1); v += shx(v, 2); v += shx(v, 4); v += shx(v, 8); return v; }

__device__ __forceinline__ void head128_norm_rope_to(const bf16_t* hp, bf16_t* dp, int l16, const float* __restrict__ gain, const float* __restrict__ cs, bool rope, bool do_store) {
    float v[8]; ld8f(hp + 8 * l16, v);
    float ss = 0.f;
#pragma unroll
    for (int j = 0; j < 8; ++j) ss += v[j] * v[j];
    ss = sum16(ss); const float r = rsqrtf(ss * (1.f / 128.f) + EPS);
#pragma unroll
    for (int j = 0; j < 8; ++j) v[j] = v[j] * r * gain[8 * l16 + j];
    if (rope) {
        float o[8];
#pragma unroll
        for (int j = 0; j < 8; ++j) o[j] = shx(v[j], 2);
        if (l16 < 4) { const int fi = (l16 & 1) * 8;
#pragma unroll
            for (int j = 0; j < 8; ++j) { const float c = cs[(fi + j) * 2], s = cs[(fi + j) * 2 + 1];
                v[j] = (l16 < 2) ? (v[j] * c - o[j] * s) : (v[j] * c + o[j] * s); } }
    }
    if (do_store) st8f(dp + 8 * l16, v);
}
__device__ __forceinline__ void head128_norm_rope(bf16_t* hp, int l16, const float* __restrict__ gain, const float* __restrict__ cs, bool rope, bool do_store) { head128_norm_rope_to(hp, hp, l16, gain, cs, rope, do_store); }
__device__ __forceinline__ void rope16_inplace(bf16_t* ip, const float* __restrict__ cs) {
    float a[8], b[8]; ld8f(ip, a); ld8f(ip + 8, b);
#pragma unroll
    for (int j = 0; j < 8; ++j) { const float c = cs[2 * j], s = cs[2 * j + 1], x1 = a[j], x2 = b[j]; a[j] = x1 * c - x2 * s; b[j] = x2 * c + x1 * s; }
    st8f(ip, a); st8f(ip + 8, b);
}
struct PrepIn { u32x4 q, k, m, i0, i1, ik0, ik1, v; bf16_t w; f32x4 c32[4], c16[4]; };
__device__ __forceinline__ void prep_load(const Params& P, int tok, int lane, PrepIn& I) {
    const int l16 = lane & 15, grp = lane >> 4;
    const bf16_t* row = P.p_() + (size_t)tok * NPAD;
    I.q = *(const u32x4*)(row + C_DQ + grp * 128 + 8 * l16);
    I.k = *(const u32x4*)(row + C_DK + 8 * l16);
    I.m = *(const u32x4*)(row + C_MQ + grp * 128 + 8 * l16);
    I.i0 = *(const u32x4*)(row + C_DIQ + (lane >> 2) * 64); I.i1 = *(const u32x4*)(row + C_DIQ + (lane >> 2) * 64 + 8);
    I.ik0 = *(const u32x4*)(row + C_DIK + (lane & 3) * 16); I.ik1 = *(const u32x4*)(row + C_DIK + (lane & 3) * 16 + 8);
    I.v = *(const u32x4*)(row + C_DV + l16 * 8);
    I.w = row[C_DIW + l16];
    const float* cs32 = P.rope_() + (size_t)tok * 48;
#pragma unroll
    for (int i = 0; i < 4; ++i) { I.c32[i] = *(const f32x4*)(cs32 + (l16 & 1) * 16 + 4 * i); I.c16[i] = *(const f32x4*)(cs32 + 32 + 4 * i); }
}
__device__ __forceinline__ void unpack8(const u32x4 w, float (&v)[8]) {
    v[0] = __uint_as_float(w.x << 16); v[1] = __uint_as_float(w.x & 0xffff0000u); v[2] = __uint_as_float(w.y << 16); v[3] = __uint_as_float(w.y & 0xffff0000u);
    v[4] = __uint_as_float(w.z << 16); v[5] = __uint_as_float(w.z & 0xffff0000u); v[6] = __uint_as_float(w.w << 16); v[7] = __uint_as_float(w.w & 0xffff0000u); }
__device__ __forceinline__ void head128_nr(float (&v)[8], int l16, const float (&gain)[8], const f32x4 (&cs)[4], bool rope) {
    float ss = 0.f;
#pragma unroll
    for (int j = 0; j < 8; ++j) ss += v[j] * v[j];
    ss = sum16(ss); const float r = rsqrtf(ss * (1.f / 128.f) + EPS);
#pragma unroll
    for (int j = 0; j < 8; ++j) v[j] = v[j] * r * gain[j];
    if (rope) {
        float o[8];
#pragma unroll
        for (int j = 0; j < 8; ++j) o[j] = shx(v[j], 2);
        if (l16 < 4) {
#pragma unroll
            for (int j = 0; j < 8; ++j) { const float c = cs[j >> 1][(j & 1) * 2], s = cs[j >> 1][(j & 1) * 2 + 1];
                v[j] = (l16 < 2) ? (v[j] * c - o[j] * s) : (v[j] * c + o[j] * s); } }
    }
}
__device__ __forceinline__ void prep_finish(const Params& P, int tok, int lane, const PrepIn& I, const float (&gq)[8], const float (&gk)[8], const float (&gm)[8]) {
    const int l16 = lane & 15, grp = lane >> 4;
    bf16_t* row = P.p_() + (size_t)tok * NPAD;
    float q[8], k[8], m[8];
    unpack8(I.q, q); unpack8(I.k, k); unpack8(I.m, m);
    head128_nr(q, l16, gq, I.c32, true); head128_nr(k, l16, gk, I.c32, true); head128_nr(m, l16, gm, I.c32, false);
    st8f(row + C_DQ + grp * 128 + 8 * l16, q);
    if (grp == 0) st8f(P.kvc_() + (size_t)tok * 256 + 8 * l16, k);
    st8f(row + C_MQ + grp * 128 + 8 * l16, m);
    {
        float a[8], b[8]; unpack8(I.i0, a); unpack8(I.i1, b);
#pragma unroll
        for (int j = 0; j < 8; ++j) { const float c = I.c16[j >> 1][(j & 1) * 2], s = I.c16[j >> 1][(j & 1) * 2 + 1], x1 = a[j], x2 = b[j]; a[j] = x1 * c - x2 * s; b[j] = x2 * c + x1 * s; }
        if ((lane & 3) == 0) { st8f(row + C_DIQ + (lane >> 2) * 64, a); st8f(row + C_DIQ + (lane >> 2) * 64 + 8, b); } }
    {
        float a[8], b[8]; unpack8(I.ik0, a); unpack8(I.ik1, b);
        if ((lane & 3) == 0) {
#pragma unroll
            for (int j = 0; j < 8; ++j) { const float c = I.c16[j >> 1][(j & 1) * 2], s = I.c16[j >> 1][(j & 1) * 2 + 1], x1 = a[j], x2 = b[j]; a[j] = x1 * c - x2 * s; b[j] = x2 * c + x1 * s; } }
        if (lane < 4) { bf16_t* dst = P.ikc_() + (size_t)(tok >> 5) * 2048 + lane * 512 + (tok & 31) * 8; st8f(dst, a); st8f(dst + 256, b); } }
    if (lane >= 16 && lane < 32) *(u32x4*)(P.kvc_() + (size_t)tok * 256 + 128 + l16 * 8) = I.v;
    if (lane < 16) P.iw_()[(size_t)tok * 16 + lane] = bf2f(I.w) * (1.f / 32.f);
}
__device__ __forceinline__ void phase_prep(const Params& P, int layer) {
    const int wid = TIDX() >> 6, lane = TIDX() & 63, l16 = lane & 15;
    float gq[8], gk[8], gm[8];
#pragma unroll
    for (int j = 0; j < 8; ++j) { gq[j] = P.dsa_q_norm[layer * 128 + 8 * l16 + j]; gk[j] = P.dsa_k_norm[layer * 128 + 8 * l16 + j]; gm[j] = P.mem_q_norm[layer * 128 + 8 * l16 + j]; }
    const int stride = gridDim.x * 8;
    for (int tok = blockIdx.x * 8 + wid; tok < NTOK; tok += 2 * stride) {
        const int tok2 = tok + stride; const bool two = tok2 < NTOK;
        PrepIn A, B2;
        prep_load(P, tok, lane, A); prep_load(P, two ? tok2 : tok, lane, B2);
        prep_finish(P, tok, lane, A, gq, gk, gm);
        if (two) prep_finish(P, tok2, lane, B2, gq, gk, gm);
    }
}
struct MemOutRow { const bf16_t* zb; bf16_t* gb;
    __device__ __forceinline__ const bf16_t* zrow(int r) const { return zb + (size_t)r * NPAD; } __device__ __forceinline__ bf16_t* grow(int r) const { return gb + (size_t)r * MIX; } };
__device__ __forceinline__ void unit_mem_attn(const Params& P, int layer, int u, char* lds) {
    const int b = u >> 6, h = (u >> 4) & 3, qb = u & 15, tok0 = b * SEQ + qb * 256;
    const int wid = TIDX() >> 6, lane = TIDX() & 63, r32 = lane & 31, hi = lane >> 5;
    const bf16_t* Qw = P.p_() + (size_t)(tok0 + wid * 32 + r32) * NPAD + C_MQ + h * 128 + hi * 8;
    const bf16_t* Kh = P.kvmem_() + (size_t)(b * MEML) * (DEPTH * 1024) + layer * 1024 + h * 128;
    MemOutRow ow; ow.zb = P.p_() + (size_t)(tok0 + wid * 32) * NPAD + C_MZ + h * 128; ow.gb = P.xn_() + (size_t)(tok0 + wid * 32) * MIX + 1536 + h * 128;
    att::attn_body<false, DEPTH * 1024, 512, MemOutRow>(Qw, Kh, MEML / 64, nullptr, 0u, ow, lds);
}

__device__ __forceinline__ void phase_gate(const Params& P, int c_lo, int c_hi) {
    const int wid = TIDX() >> 6, lane = TIDX() & 63;
    const int c0 = lane * 32;
    const int seg = c0 >> 9, zc = (seg == 0 ? C_GZ : seg == 1 ? C_SZ : seg == 2 ? C_DZ : C_MZ) + (c0 & 511);
    const bool act = (c0 >= c_lo) && (c0 < c_hi);
    for (int tok = blockIdx.x * 8 + wid; tok < NTOK; tok += gridDim.x * 8) {
        if (!act) { bf16_t* gz_ = P.xn_() + (size_t)tok * MIX + c0; const u32x4 zz = {0u, 0u, 0u, 0u};
#pragma unroll
            for (int i = 0; i < 4; ++i) *(u32x4*)(gz_ + 8 * i) = zz;
            continue; }
        const bf16_t* op = P.ocat_() + (size_t)tok * MIX + c0; const bf16_t* zp = P.p_() + (size_t)tok * NPAD + zc; bf16_t* gp = P.xn_() + (size_t)tok * MIX + c0;
        float o[32]; float ss = 0.f;
#pragma unroll
        for (int i = 0; i < 4; ++i) { float v[8]; ld8f(op + 8 * i, v);
#pragma unroll
            for (int j = 0; j < 8; ++j) { o[8 * i + j] = v[j]; ss += v[j] * v[j]; } }
        ss += shx(ss, 1); ss += shx(ss, 2);
        const float r = rsqrtf(ss * (1.f / 128.f) + EPS);
#pragma unroll
        for (int i = 0; i < 4; ++i) { float z[8], g[8]; ld8f(zp + 8 * i, z);
#pragma unroll
            for (int j = 0; j < 8; ++j) g[j] = o[8 * i + j] * r * siluf_(z[j]);
            st8f(gp + 8 * i, g); }
    }
}

__device__ __forceinline__ void phase_gemm_in(const Params& P, int layer, char* lds) {
    pg8::Gemm g; g.A = P.xn_(); g.Bt = P.WinT_() + (size_t)layer * NPAD * DM; g.M = NTOK; g.N = NPAD; g.K = DM;
    pg8::StaticOrder S; S.init(g.M, g.N, (int)gridDim.x, (int)blockIdx.x);
    pg8::EpiBf16Plain E; E.O = P.p_(); E.ldc = NPAD;
    pg8::gemm_phase<pg8::EpiBf16Plain, pg8::StaticOrder, false>((PG8_LAS unsigned char*)lds, g, S, E, nullptr);
}
__device__ __forceinline__ void phase_gemm_out(const Params& P, int layer, char* lds) {
    pg8::Gemm g; g.A = P.xn_(); g.Bt = P.WoutT_() + (size_t)layer * DM * MIX; g.M = NTOK; g.N = DM; g.K = MIX;
    pg8::StaticOrder S; S.init(g.M, g.N, (int)gridDim.x, (int)blockIdx.x);
    pg8::EpiResidMix E; E.R = (layer == 0) ? (const void*)P.x : (const void*)P.xbuf_(); E.C = (layer == DEPTH - 1) ? (void*)P.out : (void*)P.xbuf_(); E.ldc = DM;
    E.r16 = (layer != 0); E.c16 = (layer != DEPTH - 1);
    pg8::gemm_phase<pg8::EpiResidMix, pg8::StaticOrder, false>((PG8_LAS unsigned char*)lds, g, S, E, nullptr);
}
__device__ __forceinline__ void phase_gemm_kv(const Params& P, char* lds) {
    pg8::Gemm g; g.A = P.memn_(); g.Bt = P.WkvT_(); g.M = NB * MEML; g.N = DEPTH * 1024; g.K = DM;
    pg8::StaticOrder S; S.init(g.M, g.N, (int)gridDim.x, (int)blockIdx.x);
    pg8::EpiBf16Plain E; E.O = P.kvmem_(); E.ldc = DEPTH * 1024;
    pg8::gemm_phase<pg8::EpiBf16Plain, pg8::StaticOrder, false>((PG8_LAS unsigned char*)lds, g, S, E, nullptr);
}
__device__ __forceinline__ void mma_tile(f32x16& acc, const char* A, int lda, const char* B, int ldb, int K, int lane) {
    const int r = lane & 31, kh = lane >> 5;
    const char* ap = A + r * lda + kh * 16; const char* bp = B + r * ldb + kh * 16;
    asm volatile("" : "+v"(acc));
    for (int k = 0; k < K; k += 16) {
        const bf16x8 a = *(const bf16x8*)(ap + k * 2); const bf16x8 b = *(const bf16x8*)(bp + k * 2);
        acc = __builtin_amdgcn_mfma_f32_32x32x16_bf16(a, b, acc, 0, 0, 0);
    }
}
__device__ __forceinline__ int crow32(int r, int hi) { return (r & 3) + 8 * (r >> 2) + 4 * hi; }
__device__ __forceinline__ float log_sigmoid_(float x) { return fminf(x, 0.f) - log1pf(__expf(-fabsf(x))); }

constexpr int GLA_ST = 144;
constexpr int GC_BST = 68;
constexpr int GC_B_BYTES = 4 * 64 * GC_BST * 4, GC_V_BYTES = 4 * 16384;
__device__ __forceinline__ float* gla_gb(const Params& P) { return (float*)((char*)P.ocat_() + (size_t)32 * 1024 * 1024); }
__device__ __forceinline__ float log_sigmoid_fast(float x) { return fminf(x, 0.f) - __logf(1.f + __expf(-fabsf(x))); }

__device__ __forceinline__ void unit_gla_a4(const Params& P, int layer, int ub, char* lds) {
    const int b = ub >> 6, n = ub & 63, tok0 = b * SEQ + n * 64;
    const int tid = TIDX(), wid = tid >> 6, lane = tid & 63, r32 = lane & 31, hi = lane >> 5, h = wid >> 1, eh = wid & 1;
    float* b_s = (float*)lds;
    char* V_s = lds;
    char* K_s = lds + GC_B_BYTES;
    float* glr_s = (float*)(lds + GC_B_BYTES + GC_V_BYTES);
    float* tot_s = glr_s + 1024;
    __syncthreads();
    const bf16_t* prow = P.p_() + (size_t)tok0 * NPAD;
    const bf16x8 glr_raw = *(const bf16x8*)(prow + (size_t)((tid & 127) >> 1) * NPAD + C_GLR + (tid & 1) * 8);
    const int gd = tid & 63, gh = (tid >> 6) & 3, gt = tid >> 8;
    float wu[16];
#pragma unroll
    for (int r = 0; r < 16; ++r) wu[r] = P.gla_w_up[((size_t)layer * 16 + r) * 256 + gh * 64 + gd];
    const float bias = P.gla_b_up[layer * 256 + gh * 64 + gd];
    bf16x8 kraw[4], vs[4][2];
    const int ks_ = tid >> 3, kc = (tid & 7) * 8;
#pragma unroll
    for (int hv = 0; hv < 4; ++hv) kraw[hv] = *(const bf16x8*)(prow + (size_t)ks_ * NPAD + C_GK + hv * 64 + kc);
    const int sr = tid >> 4, sc = (tid & 15) * 8;
#pragma unroll
    for (int hv = 0; hv < 4; ++hv) { vs[hv][0] = *(const bf16x8*)(prow + (size_t)sr * NPAD + C_GV + hv * 128 + sc); vs[hv][1] = *(const bf16x8*)(prow + (size_t)(32 + sr) * NPAD + C_GV + hv * 128 + sc); }
    if (tid < 128) {
#pragma unroll
        for (int j = 0; j < 8; ++j) glr_s[(tid >> 1) * 16 + (tid & 1) * 8 + j] = bf2f((bf16_t)glr_raw[j]); }
    __syncthreads();
    float gv[32]; float run = 0.f;
#pragma unroll
    for (int i = 0; i < 32; ++i) { const float* gr = glr_s + (gt * 32 + i) * 16; float a = bias;
#pragma unroll
        for (int r4 = 0; r4 < 4; ++r4) { const f32x4 g4 = *(const f32x4*)(gr + 4 * r4); a = fmaf(g4[0], wu[4 * r4], a); a = fmaf(g4[1], wu[4 * r4 + 1], a); a = fmaf(g4[2], wu[4 * r4 + 2], a); a = fmaf(g4[3], wu[4 * r4 + 3], a); }
        run += log_sigmoid_fast(a) * (1.f / 16.f); gv[i] = run; }
    if (gt == 0) tot_s[gh * 64 + gd] = run;
    __syncthreads();
    { const float off = gt ? tot_s[gh * 64 + gd] : 0.f; float* bp = b_s + (gh * 64 + gt * 32) * GC_BST + gd;
      float* gp = gla_gb(P) + (size_t)(tok0 + gt * 32) * 256 + gh * 64 + gd;
#pragma unroll
      for (int i = 0; i < 32; ++i) { const float v = gv[i] + off; bp[i * GC_BST] = v; gp[(size_t)i * 256] = v; }
      if (gt) P.glad_()[((size_t)((b * 64 + n) * 4 + gh)) * 64 + gd] = __expf(gv[31] + off); }
    __syncthreads();
#pragma unroll
    for (int hv = 0; hv < 4; ++hv) { const float* br = b_s + (hv * 64 + ks_) * GC_BST + kc; const float* bl = b_s + (hv * 64 + 63) * GC_BST + kc;
        const f32x4 b0 = *(const f32x4*)br, b1 = *(const f32x4*)(br + 4), l0 = *(const f32x4*)bl, l1 = *(const f32x4*)(bl + 4);
        float e[8];
#pragma unroll
        for (int j = 0; j < 8; ++j) e[j] = bf2f((bf16_t)kraw[hv][j]) * __expf((j < 4 ? l0[j] : l1[j - 4]) - (j < 4 ? b0[j] : b1[j - 4]));
        u32x4 w = {att::cvtpk(e[0], e[1]), att::cvtpk(e[2], e[3]), att::cvtpk(e[4], e[5]), att::cvtpk(e[6], e[7])};
        *(u32x4*)(K_s + hv * 16384 + att::v_st(ks_, kc)) = w; }
    __syncthreads();
    { const int vst0 = att::v_st(sr, sc), vst1 = att::v_st(32 + sr, sc);
#pragma unroll
      for (int hv = 0; hv < 4; ++hv) { *(bf16x8*)(V_s + hv * 16384 + vst0) = vs[hv][0]; *(bf16x8*)(V_s + hv * 16384 + vst1) = vs[hv][1]; } }
    __syncthreads();
    const int vb = (int)(uintptr_t)(V_s + h * 16384) + att::v_rd_base(lane), kb = (int)(uintptr_t)(K_s + h * 16384) + att::v_rd_base(lane);
    f32x16 acc[2][2] = {};
    asm volatile("" : "+v"(acc[0][0]), "+v"(acc[0][1]), "+v"(acc[1][0]), "+v"(acc[1][1]));
#define GA_PK(L, H) (bf16x8){L[0], L[1], L[2], L[3], H[0], H[1], H[2], H[3]}
#define GA_STEP(KS) do { \
    const s16x4 k0l = att::tr_read<att::v_rd_off(0, KS, 0)>(kb), k0h = att::tr_read<att::v_rd_off(0, KS, 1)>(kb), k1l = att::tr_read<att::v_rd_off(1, KS, 0)>(kb), k1h = att::tr_read<att::v_rd_off(1, KS, 1)>(kb); \
    s16x4 v0l, v0h, v1l, v1h; \
    if (eh == 0) { v0l = att::tr_read<att::v_rd_off(0, KS, 0)>(vb); v0h = att::tr_read<att::v_rd_off(0, KS, 1)>(vb); v1l = att::tr_read<att::v_rd_off(1, KS, 0)>(vb); v1h = att::tr_read<att::v_rd_off(1, KS, 1)>(vb); } \
    else         { v0l = att::tr_read<att::v_rd_off(2, KS, 0)>(vb); v0h = att::tr_read<att::v_rd_off(2, KS, 1)>(vb); v1l = att::tr_read<att::v_rd_off(3, KS, 0)>(vb); v1h = att::tr_read<att::v_rd_off(3, KS, 1)>(vb); } \
    asm volatile("s_waitcnt lgkmcnt(0)" ::: "memory"); __builtin_amdgcn_sched_barrier(0); \
    acc[0][0] = __builtin_amdgcn_mfma_f32_32x32x16_bf16(GA_PK(v0l, v0h), GA_PK(k0l, k0h), acc[0][0], 0, 0, 0); \
    acc[0][1] = __builtin_amdgcn_mfma_f32_32x32x16_bf16(GA_PK(v0l, v0h), GA_PK(k1l, k1h), acc[0][1], 0, 0, 0); \
    acc[1][0] = __builtin_amdgcn_mfma_f32_32x32x16_bf16(GA_PK(v1l, v1h), GA_PK(k0l, k0h), acc[1][0], 0, 0, 0); \
    acc[1][1] = __builtin_amdgcn_mfma_f32_32x32x16_bf16(GA_PK(v1l, v1h), GA_PK(k1l, k1h), acc[1][1], 0, 0, 0); } while (0)
    GA_STEP(0); GA_STEP(1); GA_STEP(2); GA_STEP(3);
#undef GA_STEP
#undef GA_PK
    float* dst = P.glas_() + ((size_t)((b * 64 + n) * 4 + h)) * 8192;
#pragma unroll
    for (int et = 0; et < 2; ++et)
#pragma unroll
        for (int dt = 0; dt < 2; ++dt)
#pragma unroll
            for (int r = 0; r < 16; ++r) dst[((eh * 2 + et) * 32 + att::crow(r, hi)) * 64 + dt * 32 + r32] = acc[et][dt][r];
    __syncthreads();
}

__device__ __forceinline__ void gla_scan_slice(const Params& P, int idx) {
    {
        const int el = idx & 8191, d = idx & 63, h = (idx >> 13) & 3, b = idx >> 15;
        bf16_t* gst = P.ocat_();
        float S = 0.f;
        for (int n0 = 0; n0 < 64; n0 += 8) {
            float ds[8], dc[8];
#pragma unroll
            for (int i = 0; i < 8; ++i) { const size_t cu = (size_t)((b * 64 + n0 + i) * 4 + h); ds[i] = P.glas_()[cu * 8192 + el]; dc[i] = P.glad_()[cu * 64 + d]; }
#pragma unroll
            for (int i = 0; i < 8; ++i) { const size_t cu = (size_t)((b * 64 + n0 + i) * 4 + h); gst[cu * 8192 + el] = f2bf(S); S = fmaf(dc[i], S, ds[i]); }
        }
    }
}

__device__ __forceinline__ void unit_gla_c4(const Params& P, int layer, int ub, char* lds) {
    const int b = ub >> 6, n = ub & 63, tok0 = b * SEQ + n * 64;
    const int tid = TIDX(), wid = tid >> 6, lane = tid & 63, r32 = lane & 31, hi = lane >> 5, h = wid >> 1, rh = wid & 1;
    float* b_s = (float*)lds;
    char* V_s = lds + GC_B_BYTES;
    __syncthreads();
    const bf16_t* prow = P.p_() + (size_t)tok0 * NPAD;
    bf16x8 qraw[4], kraw[2][4], vs[4][2];
    const int sr = tid >> 4, sc = (tid & 15) * 8;
#pragma unroll
    for (int hv = 0; hv < 4; ++hv) { vs[hv][0] = *(const bf16x8*)(prow + (size_t)sr * NPAD + C_GV + hv * 128 + sc); vs[hv][1] = *(const bf16x8*)(prow + (size_t)(32 + sr) * NPAD + C_GV + hv * 128 + sc); }
    f32x4 braw[8];
    { const float* gp = gla_gb(P) + (size_t)tok0 * 256 + tid * 4;
#pragma unroll
      for (int i = 0; i < 8; ++i) braw[i] = *(const f32x4*)(gp + i * 2048); }
    { const bf16_t* qp = prow + (size_t)(rh * 32 + r32) * NPAD + C_GQ + h * 64 + hi * 8;
#pragma unroll
      for (int d0 = 0; d0 < 4; ++d0) qraw[d0] = *(const bf16x8*)(qp + d0 * 16);
#pragma unroll
      for (int sh = 0; sh < 2; ++sh) { const bf16_t* kp = prow + (size_t)(sh * 32 + r32) * NPAD + C_GK + h * 64 + hi * 8;
#pragma unroll
          for (int d0 = 0; d0 < 4; ++d0) kraw[sh][d0] = *(const bf16x8*)(kp + d0 * 16); } }
    bf16x8 sfr[4][4];
    { const bf16_t* sp = P.ocat_() + ((size_t)((b * 64 + n) * 4 + h)) * 8192 + r32 * 64 + hi * 8;
#pragma unroll
      for (int eb = 0; eb < 4; ++eb)
#pragma unroll
          for (int ds = 0; ds < 4; ++ds) sfr[eb][ds] = *(const bf16x8*)(sp + eb * 32 * 64 + ds * 16); }
    { const int vst0 = att::v_st(sr, sc), vst1 = att::v_st(32 + sr, sc);
#pragma unroll
      for (int hv = 0; hv < 4; ++hv) { *(bf16x8*)(V_s + hv * 16384 + vst0) = vs[hv][0]; *(bf16x8*)(V_s + hv * 16384 + vst1) = vs[hv][1]; } }
#pragma unroll
    for (int i = 0; i < 8; ++i) { const int c = tid + 512 * i, t = c >> 6, c4 = c & 63;
        *(f32x4*)(b_s + ((c4 >> 4) * 64 + t) * GC_BST + (c4 & 15) * 4) = braw[i]; }
    __syncthreads();
    const float* bh = b_s + h * 64 * GC_BST + hi * 8;
    bf16x8 qe[4], qb[4], ke[2][4];
#pragma unroll
    for (int d0 = 0; d0 < 4; ++d0) {
        const f32x4 m0 = *(const f32x4*)(bh + 32 * GC_BST + d0 * 16), m1 = *(const f32x4*)(bh + 32 * GC_BST + d0 * 16 + 4);
        const f32x4 q0 = *(const f32x4*)(bh + (rh * 32 + r32) * GC_BST + d0 * 16), q1 = *(const f32x4*)(bh + (rh * 32 + r32) * GC_BST + d0 * 16 + 4);
        float e1[8], e2[8];
#pragma unroll
        for (int j = 0; j < 8; ++j) { const float mv = j < 4 ? m0[j] : m1[j - 4], bq = j < 4 ? q0[j] : q1[j - 4]; const float q = bf2f((bf16_t)qraw[d0][j]) * 0.125f;
            e1[j] = q * __expf(bq - mv); e2[j] = q * __expf(bq); }
        { u32x4 w = {att::cvtpk(e1[0], e1[1]), att::cvtpk(e1[2], e1[3]), att::cvtpk(e1[4], e1[5]), att::cvtpk(e1[6], e1[7])}; qe[d0] = *reinterpret_cast<bf16x8*>(&w); }
        { u32x4 w = {att::cvtpk(e2[0], e2[1]), att::cvtpk(e2[2], e2[3]), att::cvtpk(e2[4], e2[5]), att::cvtpk(e2[6], e2[7])}; qb[d0] = *reinterpret_cast<bf16x8*>(&w); }
#pragma unroll
        for (int sh = 0; sh < 2; ++sh) {
            const f32x4 k0 = *(const f32x4*)(bh + (sh * 32 + r32) * GC_BST + d0 * 16), k1 = *(const f32x4*)(bh + (sh * 32 + r32) * GC_BST + d0 * 16 + 4);
            float e3[8];
#pragma unroll
            for (int j = 0; j < 8; ++j) { const float mv = j < 4 ? m0[j] : m1[j - 4], bk = j < 4 ? k0[j] : k1[j - 4]; e3[j] = bf2f((bf16_t)kraw[sh][d0][j]) * __expf(mv - bk); }
            u32x4 w = {att::cvtpk(e3[0], e3[1]), att::cvtpk(e3[2], e3[3]), att::cvtpk(e3[4], e3[5]), att::cvtpk(e3[6], e3[7])}; ke[sh][d0] = *reinterpret_cast<bf16x8*>(&w); }
    }
    f32x16 p0 = {}, p1 = {};
    asm volatile("" : "+v"(p0), "+v"(p1));
#pragma unroll
    for (int d0 = 0; d0 < 4; ++d0) { p0 = __builtin_amdgcn_mfma_f32_32x32x16_bf16(ke[0][d0], qe[d0], p0, 0, 0, 0); p1 = __builtin_amdgcn_mfma_f32_32x32x16_bf16(ke[1][d0], qe[d0], p1, 0, 0, 0); }
    { const int t = rh * 32 + r32;
#pragma unroll
      for (int r = 0; r < 16; ++r) { const int s0 = att::crow(r, hi); p0[r] = (s0 <= t) ? p0[r] : 0.f; p1[r] = (32 + s0 <= t) ? p1[r] : 0.f; } }
    bf16x8 pa0, pa1, pa2, pa3;
#define GC_PK4(Pv, BASE, OUT) do { unsigned a0 = att::cvtpk(Pv[BASE + 0], Pv[BASE + 1]), a1 = att::cvtpk(Pv[BASE + 2], Pv[BASE + 3]);   \
    unsigned b0 = att::cvtpk(Pv[BASE + 4], Pv[BASE + 5]), b1 = att::cvtpk(Pv[BASE + 6], Pv[BASE + 7]);                              \
    auto r0 = __builtin_amdgcn_permlane32_swap(a0, b0, false, false); auto r1 = __builtin_amdgcn_permlane32_swap(a1, b1, false, false); \
    u32x4 w = {r0[0], r1[0], r0[1], r1[1]}; OUT = *reinterpret_cast<bf16x8*>(&w); } while (0)
    GC_PK4(p0, 0, pa0); GC_PK4(p0, 8, pa1); GC_PK4(p1, 0, pa2); GC_PK4(p1, 8, pa3);
#undef GC_PK4
    f32x16 o[4] = {};
    asm volatile("" : "+v"(o[0]), "+v"(o[1]), "+v"(o[2]), "+v"(o[3]));
    att::pv_d0(o, (int)(uintptr_t)(V_s + h * 16384) + att::v_rd_base(lane), pa0, pa1, pa2, pa3);
#pragma unroll
    for (int eb = 0; eb < 4; ++eb)
#pragma unroll
        for (int ds = 0; ds < 4; ++ds) o[eb] = __builtin_amdgcn_mfma_f32_32x32x16_bf16(qb[ds], sfr[eb][ds], o[eb], 0, 0, 0);
    __syncthreads();
    float* og_s = (float*)lds + wid * (32 * 132);
#pragma unroll
    for (int r = 0; r < 16; ++r) {
#pragma unroll
        for (int eb = 0; eb < 4; ++eb) og_s[att::crow(r, hi) * 132 + eb * 32 + r32] = o[eb][r]; }
    asm volatile("" ::: "memory");
    { const int row = lane >> 1, half = lane & 1; const float* src = og_s + row * 132 + half * 64;
      f32x4 v[16]; float ss = 0.f;
#pragma unroll
      for (int i = 0; i < 16; ++i) { v[i] = *(const f32x4*)(src + 4 * i); ss += v[i][0] * v[i][0] + v[i][1] * v[i][1] + v[i][2] * v[i][2] + v[i][3] * v[i][3]; }
      ss += shx(ss, 1);
      const float rn = rsqrtf(ss * (1.f / 128.f) + EPS);
      const size_t tok = (size_t)(tok0 + rh * 32 + row);
      const bf16_t* zp = P.p_() + tok * NPAD + C_GZ + h * 128 + half * 64; bf16_t* gp = P.xn_() + tok * MIX + h * 128 + half * 64;
#pragma unroll
      for (int i = 0; i < 8; ++i) { float z[8], g[8]; ld8f(zp + 8 * i, z);
#pragma unroll
          for (int q = 0; q < 4; ++q) { g[q] = v[2 * i][q] * rn * siluf_(z[q]); g[4 + q] = v[2 * i + 1][q] * rn * siluf_(z[4 + q]); }
          st8f(gp + 8 * i, g); } }
    __syncthreads();
}
constexpr int S5P_STRIDE = 2304;
__device__ __forceinline__ void phase_s5_params(const Params& P) {
    for (int idx = blockIdx.x * NTHR + TIDX(); idx < DEPTH * 32 * 64; idx += gridDim.x * NTHR) {
        const int p = idx & 63, lg = idx >> 6;
        const float ar = P.s5_a_re[idx], ai = P.s5_a_im[idx], step = expf(P.s5_log_step[lg]);
        const float mag = expf(ar * step), th = ai * step;
        const float lr = mag * cosf(th), li = mag * sinf(th);
        float* o = P.s5p_() + (size_t)lg * S5P_STRIDE;
        o[2 * p] = lr; o[2 * p + 1] = li;
        { const float mag512 = expf(512.f * ar * step); const double a = 512.0 * (double)th; const double k = rint(a * 0.15915494309189535); const float rf = (float)fma(-k, 6.283185307179586, a);
          o[128 + 2 * p] = mag512 * cosf(rf); o[128 + 2 * p + 1] = mag512 * sinf(rf); }
        const float xr = lr - 1.f, xi = li, den = 1.f / (ar * ar + ai * ai);
        const float fr = (xr * ar + xi * ai) * den, fi = (xi * ar - xr * ai) * den;
        for (int c = 0; c < 16; ++c) { const float br = P.s5_b_re[(size_t)idx * 16 + c], bi = P.s5_b_im[(size_t)idx * 16 + c];
            o[256 + (p * 16 + c) * 2] = fr * br - fi * bi; o[256 + (p * 16 + c) * 2 + 1] = fr * bi + fi * br; }
    }
}
__device__ __forceinline__ float gelu_tanh_(float x) { const float u = 0.7978845608028654f * (x + 0.044715f * x * x * x); const float e = __expf(-2.f * fabsf(u)); const float th = copysignf((1.f - e) / (1.f + e), u); return 0.5f * x * (1.f + th); }

constexpr int S5_XST = 272;
constexpr int S5_UST = 48;
__device__ __forceinline__ float partner32(float v, int hi) { auto rr = __builtin_amdgcn_permlane32_swap(__float_as_uint(v), __float_as_uint(v), false, false); return __uint_as_float(hi ? rr[0] : rr[1]); }
struct S5Ctx { float l0r, l0i, l1r, l1i, q0r, q0i, q1r, q1i, dsk; char* Cm; char* Bb; char* Xs; char* Us; int lane, hi, j, rho; const bf16_t* ubase; bf16_t* ybase; };
template <bool OUT> __device__ __forceinline__ void s5_tile(const S5Ctx& C, int tok0, float& x0r, float& x0i, float& x1r, float& x1i) {
    const int hi = C.hi, j = C.j, lane = C.lane;
    if (hi == 0) { const bf16_t* up = C.ubase + (size_t)(tok0 + j) * NPAD;
        const bf16x8 w0 = *(const bf16x8*)up, w1 = *(const bf16x8*)(up + 8);
        *(bf16x8*)(C.Us + C.rho * S5_UST) = w0; *(bf16x8*)(C.Us + C.rho * S5_UST + 16) = w1; }
    asm volatile("" ::: "memory");
    f32x16 a0 = {}, a1 = {}, a2 = {}, a3 = {};
    mma_tile(a0, C.Us, S5_UST, C.Bb, S5_UST, 16, lane); mma_tile(a1, C.Us, S5_UST, C.Bb + 32 * S5_UST, S5_UST, 16, lane);
    mma_tile(a2, C.Us, S5_UST, C.Bb + 64 * S5_UST, S5_UST, 16, lane); mma_tile(a3, C.Us, S5_UST, C.Bb + 96 * S5_UST, S5_UST, 16, lane);
    float s0r[16], s0i[16], s1r[16], s1i[16];
#pragma unroll
    for (int r = 0; r < 16; ++r) {
        const float n0r = fmaf(C.l0r, x0r, fmaf(-C.l0i, x0i, a0[r])), n0i = fmaf(C.l0r, x0i, fmaf(C.l0i, x0r, a1[r])); x0r = n0r; x0i = n0i; s0r[r] = n0r; s0i[r] = n0i;
        const float n1r = fmaf(C.l1r, x1r, fmaf(-C.l1i, x1i, a2[r])), n1i = fmaf(C.l1r, x1i, fmaf(C.l1i, x1r, a3[r])); x1r = n1r; x1i = n1i; s1r[r] = n1r; s1i[r] = n1i; }
    float z0r = partner32(x0r, hi), z0i = partner32(x0i, hi), z1r = partner32(x1r, hi), z1i = partner32(x1i, hi);
    if (hi == 0) { z0r = 0.f; z0i = 0.f; z1r = 0.f; z1i = 0.f; }
    if (!OUT) {
        x0r += C.q0r * z0r - C.q0i * z0i; x0i += C.q0r * z0i + C.q0i * z0r; x1r += C.q1r * z1r - C.q1i * z1i; x1i += C.q1r * z1i + C.q1i * z1r;
    } else {
#pragma unroll
        for (int r = 0; r < 16; ++r) {
            const float t0r = C.l0r * z0r - C.l0i * z0i, t0i = C.l0r * z0i + C.l0i * z0r; z0r = t0r; z0i = t0i; s0r[r] += t0r; s0i[r] += t0i;
            const float t1r = C.l1r * z1r - C.l1i * z1i, t1i = C.l1r * z1i + C.l1i * z1r; z1r = t1r; z1i = t1i; s1r[r] += t1r; s1i[r] += t1i; }
        x0r = s0r[15]; x0i = s0i[15]; x1r = s1r[15]; x1i = s1i[15];
#pragma unroll
        for (int r = 0; r < 16; ++r) { char* xr_ = C.Xs + (r + 16 * hi) * S5_XST;
            *(bf16_t*)(xr_ + j * 2) = f2bf(s0r[r]); *(bf16_t*)(xr_ + (64 + j) * 2) = f2bf(s0i[r]);
            *(bf16_t*)(xr_ + (32 + j) * 2) = f2bf(s1r[r]); *(bf16_t*)(xr_ + (96 + j) * 2) = f2bf(s1i[r]); }
        asm volatile("" ::: "memory");
        f32x16 acc = {}; mma_tile(acc, C.Xs, S5_XST, C.Cm, S5_XST, 128, lane);
        if (j < 16) {
#pragma unroll
            for (int r = 0; r < 16; ++r) { const int t = crow32(r, hi); const int rt = ((t & 15) & 3) + 8 * ((t & 15) >> 2) + 4 * (t >> 4);
                const float y = acc[r] + C.dsk * bf2f(*(const bf16_t*)(C.Us + rt * S5_UST + j * 2));
                C.ybase[(size_t)(tok0 + t) * 512 + j] = f2bf(gelu_tanh_(y)); } }
        asm volatile("" ::: "memory");
    }
    { const float e0r = partner32(x0r, hi), e0i = partner32(x0i, hi), e1r = partner32(x1r, hi), e1i = partner32(x1i, hi);
      if (hi == 0) { x0r = e0r; x0i = e0i; x1r = e1r; x1i = e1i; } else { x0r = 0.f; x0i = 0.f; x1r = 0.f; x1i = 0.f; } }
}
__device__ __forceinline__ void unit_s5(const Params& P, int layer, int u, char* lds) {
    const int b = u >> 5, g = u & 31, tid = TIDX(), wid = tid >> 6, lane = tid & 63, hi = lane >> 5, j = lane & 31;
    char* Cm = lds;
    char* Bb = Cm + 32 * S5_XST;
    float* ends = (float*)(Bb + 128 * S5_UST);
    char* wbase = (char*)(ends + 8 * 64 * 2) + wid * (32 * S5_XST + 32 * S5_UST);
    const float* sp = P.s5p_() + (size_t)(layer * 32 + g) * S5P_STRIDE;
    __syncthreads();
    for (int i = tid; i < 32 * 128; i += NTHR) { const int c = i >> 7, pp = i & 127; float v = 0.f;
        if (c < 16) v = (pp < 64) ? P.s5_c_re[((size_t)(layer * 32 + g) * 16 + c) * 64 + pp] : -P.s5_c_im[((size_t)(layer * 32 + g) * 16 + c) * 64 + (pp - 64)];
        *(bf16_t*)(Cm + c * S5_XST + pp * 2) = f2bf(v); }
    for (int i = tid; i < 128 * 16; i += NTHR) { const int n = i >> 4, c = i & 15, nt = n >> 5, jj = n & 31, p = (nt >> 1) * 32 + jj;
        *(bf16_t*)(Bb + n * S5_UST + c * 2) = f2bf(sp[256 + (p * 16 + c) * 2 + (nt & 1)]); }
    S5Ctx C; C.Cm = Cm; C.Bb = Bb; C.Xs = wbase; C.Us = wbase + 32 * S5_XST; C.lane = lane; C.hi = hi; C.j = j;
    C.l0r = sp[2 * j]; C.l0i = sp[2 * j + 1]; C.l1r = sp[2 * (32 + j)]; C.l1i = sp[2 * (32 + j) + 1];
    { float q0r = C.l0r, q0i = C.l0i, q1r = C.l1r, q1i = C.l1i;
#pragma unroll
      for (int k = 0; k < 4; ++k) { const float a = q0r * q0r - q0i * q0i, bb = (q0r + q0r) * q0i; q0r = a; q0i = bb; const float c = q1r * q1r - q1i * q1i, d = (q1r + q1r) * q1i; q1r = c; q1i = d; }
      C.q0r = q0r; C.q0i = q0i; C.q1r = q1r; C.q1i = q1i; }
    C.dsk = P.s5_d[layer * 512 + g * 16 + (lane & 15)];
    C.rho = ((j & 15) & 3) + 8 * ((j & 15) >> 2) + 4 * (j >> 4);
    const int tokw = b * SEQ + wid * 512;
    C.ubase = P.p_() + C_SU + g * 16; C.ybase = P.ybuf_() + g * 16;
    float x0r = 0.f, x0i = 0.f, x1r = 0.f, x1i = 0.f;
    __syncthreads();
    for (int sc = 0; sc < 16; ++sc) s5_tile<false>(C, tokw + sc * 32, x0r, x0i, x1r, x1i);
    if (hi == 0) { ends[(wid * 64 + j) * 2] = x0r; ends[(wid * 64 + j) * 2 + 1] = x0i; ends[(wid * 64 + 32 + j) * 2] = x1r; ends[(wid * 64 + 32 + j) * 2 + 1] = x1i; }
    __syncthreads();
    { const float p0r = sp[128 + 2 * j], p0i = sp[128 + 2 * j + 1], p1r = sp[128 + 2 * (32 + j)], p1i = sp[128 + 2 * (32 + j) + 1];
      x0r = 0.f; x0i = 0.f; x1r = 0.f; x1i = 0.f;
      for (int w = 0; w < wid; ++w) { const float e0r = ends[(w * 64 + j) * 2], e0i = ends[(w * 64 + j) * 2 + 1], e1r = ends[(w * 64 + 32 + j) * 2], e1i = ends[(w * 64 + 32 + j) * 2 + 1];
          const float n0r = p0r * x0r - p0i * x0i + e0r, n0i = p0r * x0i + p0i * x0r + e0i, n1r = p1r * x1r - p1i * x1i + e1r, n1i = p1r * x1i + p1i * x1r + e1i;
          x0r = n0r; x0i = n0i; x1r = n1r; x1i = n1i; }
      if (hi) { x0r = 0.f; x0i = 0.f; x1r = 0.f; x1i = 0.f; } }
    for (int sc = 0; sc < 16; ++sc) s5_tile<true>(C, tokw + sc * 32, x0r, x0i, x1r, x1i);
}
constexpr int TOPK = 256;
__device__ __forceinline__ unsigned f2key(float f) { const unsigned u = __float_as_uint(f); return u ^ ((u & 0x80000000u) ? 0xffffffffu : 0x80000000u); }

__device__ __forceinline__ float relu1(float x) { const int b = __float_as_int(x); return __int_as_float(b > 0 ? b : 0); }
#define DSA_MM(acc, rt, kk) acc = __builtin_amdgcn_mfma_f32_32x32x16_bf16(afr[rt][kk], bfr[kk], acc, 0, 0, 0)
#define DSA_HS(acc, rt, q) do { s0 = fmaf(relu1(acc[4 * (q)]), wv[rt][4 * (q)], s0); s1 = fmaf(relu1(acc[4 * (q) + 1]), wv[rt][4 * (q) + 1], s1); \
                                s0 = fmaf(relu1(acc[4 * (q) + 2]), wv[rt][4 * (q) + 2], s0); s1 = fmaf(relu1(acc[4 * (q) + 3]), wv[rt][4 * (q) + 3], s1); } while (0)
#define DSA_SG() do { __builtin_amdgcn_sched_group_barrier(0x8, 1, 0); __builtin_amdgcn_sched_group_barrier(0x2, 8, 0); } while (0)
__device__ __forceinline__ void dsa_score_tile(const bf16x8 (&afr)[4][4], const f32x16 (&wv)[4], const bf16x8 (&bfr)[4], float* sc, int col, int hi) {
    f32x16 accA = {}, accB = {}; asm volatile("" : "+v"(accA), "+v"(accB));
    float s0, s1;
    DSA_MM(accA, 0, 0); DSA_MM(accA, 0, 1); DSA_MM(accA, 0, 2); DSA_MM(accA, 0, 3);
    s0 = 0.f; s1 = 0.f;
    DSA_MM(accB, 1, 0); DSA_HS(accA, 0, 0); DSA_SG(); DSA_MM(accB, 1, 1); DSA_HS(accA, 0, 1); DSA_SG();
    DSA_MM(accB, 1, 2); DSA_HS(accA, 0, 2); DSA_SG(); DSA_MM(accB, 1, 3); DSA_HS(accA, 0, 3); DSA_SG();
    sc[(0 + hi) * 4096 + col] = (s0 + s1) + 0.f;
    accA = (f32x16){}; asm volatile("" : "+v"(accA)); s0 = 0.f; s1 = 0.f;
    DSA_MM(accA, 2, 0); DSA_HS(accB, 1, 0); DSA_SG(); DSA_MM(accA, 2, 1); DSA_HS(accB, 1, 1); DSA_SG();
    DSA_MM(accA, 2, 2); DSA_HS(accB, 1, 2); DSA_SG(); DSA_MM(accA, 2, 3); DSA_HS(accB, 1, 3); DSA_SG();
    sc[(2 + hi) * 4096 + col] = (s0 + s1) + 0.f;
    accB = (f32x16){}; asm volatile("" : "+v"(accB)); s0 = 0.f; s1 = 0.f;
    DSA_MM(accB, 3, 0); DSA_HS(accA, 2, 0); DSA_SG(); DSA_MM(accB, 3, 1); DSA_HS(accA, 2, 1); DSA_SG();
    DSA_MM(accB, 3, 2); DSA_HS(accA, 2, 2); DSA_SG(); DSA_MM(accB, 3, 3); DSA_HS(accA, 2, 3); DSA_SG();
    sc[(4 + hi) * 4096 + col] = (s0 + s1) + 0.f;
    s0 = 0.f; s1 = 0.f;
    DSA_HS(accB, 3, 0); DSA_HS(accB, 3, 1); DSA_HS(accB, 3, 2); DSA_HS(accB, 3, 3);
    sc[(6 + hi) * 4096 + col] = (s0 + s1) + 0.f;
}
#define DSA_CNT4(K0, K1, K2, K3) asm volatile( \
    "v_cmp_ge_u32_e64 %[m0], %[k0], %[cd]\n\tv_cmp_ge_u32_e64 %[m1], %[k1], %[cd]\n\tv_cmp_ge_u32_e64 %[m2], %[k2], %[cd]\n\tv_cmp_ge_u32_e64 %[m3], %[k3], %[cd]\n\t" \
    "v_addc_co_u32_e64 %[a0], %[m0], %[a0], 0, %[m0]\n\tv_addc_co_u32_e64 %[a1], %[m1], %[a1], 0, %[m1]\n\t" \
    "v_addc_co_u32_e64 %[a0], %[m2], %[a0], 0, %[m2]\n\tv_addc_co_u32_e64 %[a1], %[m3], %[a1], 0, %[m3]" \
    : [a0] "+v"(c0), [a1] "+v"(c1), [m0] "=&s"(sm0), [m1] "=&s"(sm1), [m2] "=&s"(sm2), [m3] "=&s"(sm3) \
    : [k0] "v"(K0), [k1] "v"(K1), [k2] "v"(K2), [k3] "v"(K3), [cd] "v"(cand))
#define DSA_CNT8(J0) do { DSA_CNT4(key[(J0)], key[(J0) + 1], key[(J0) + 2], key[(J0) + 3]); DSA_CNT4(key[(J0) + 4], key[(J0) + 5], key[(J0) + 6], key[(J0) + 7]); } while (0)

__device__ __forceinline__ void unit_dsa_index(const Params& P, int u, char* lds) {
    const int b = u & 3, t0 = (511 - (u >> 2)) * 8;
    const int tid = TIDX(), wid = tid >> 6, lane = tid & 63, r32 = lane & 31, hi = lane >> 5;
    float* sc = (float*)lds;
    const bf16_t* pb = P.p_() + (size_t)b * SEQ * NPAD;
    __syncthreads();
    TPU_START(101);
    {
        bf16x8 afr[4][4]; f32x16 wv[4];
        const int qsel = (r32 >> 2) & 1, head = (r32 & 3) + 4 * (r32 >> 3);
#pragma unroll
        for (int rt = 0; rt < 4; ++rt) { const bf16_t* qp = pb + (size_t)(t0 + 2 * rt + qsel) * NPAD + C_DIQ + head * 64 + hi * 8;
#pragma unroll
            for (int kk = 0; kk < 4; ++kk) afr[rt][kk] = *(const bf16x8*)(qp + kk * 16);
            const float* wp = P.iw_() + (size_t)(b * SEQ + t0 + 2 * rt + hi) * 16;
#pragma unroll
            for (int i = 0; i < 4; ++i) { const f32x4 w4 = *(const f32x4*)(wp + 4 * i); wv[rt][4 * i] = w4[0]; wv[rt][4 * i + 1] = w4[1]; wv[rt][4 * i + 2] = w4[2]; wv[rt][4 * i + 3] = w4[3]; } }
        const int ntile = (t0 + 7) / 32 + 1;
        const bf16_t* kp = P.ikc_() + (size_t)(b * (SEQ / 32)) * 2048 + lane * 8;
        bf16x8 b0[4], b1[4], b2[4];
#define DSA_LDB(dst, K) do { const bf16_t* kq_ = kp + (size_t)(wid + 8 * (K)) * 2048; _Pragma("unroll") for (int kk = 0; kk < 4; ++kk) dst[kk] = *(const bf16x8*)(kq_ + kk * 512); } while (0)
#define DSA_TILE(buf, K) dsa_score_tile(afr, wv, buf, sc, (wid + 8 * (K)) * 32 + r32, hi)
        const int nk = (ntile - wid + 7) >> 3;
        const int kl = nk > 0 ? nk - 1 : 0;
#define DSA_MIN(a) ((a) < kl ? (a) : kl)
        DSA_LDB(b0, DSA_MIN(0)); DSA_LDB(b1, DSA_MIN(1));
#if TPROBE == 103
        TPU_START(103); asm volatile("s_waitcnt vmcnt(0)" ::: "memory"); TPU_STOP(103);
#endif
#if TPROBE == 104
        asm volatile("s_waitcnt vmcnt(0)" ::: "memory"); TPU_START(104);
#endif
        int k = 0;
        for (; k + 3 <= nk; k += 3) {
            DSA_LDB(b2, k + 2); DSA_TILE(b0, k);
            DSA_LDB(b0, DSA_MIN(k + 3)); DSA_TILE(b1, k + 1);
            DSA_LDB(b1, DSA_MIN(k + 4)); DSA_TILE(b2, k + 2);
        }
        if (k < nk) DSA_TILE(b0, k);
        if (k + 1 < nk) DSA_TILE(b1, k + 1);
#if TPROBE == 104
        asm volatile("s_waitcnt lgkmcnt(0)" ::: "memory"); TPU_STOP(104);
#endif
#undef DSA_TILE
#undef DSA_MIN
#undef DSA_TILE
#undef DSA_LDB
    }
    __syncthreads();
    TPU_STOP(101); TPU_START(102);
    {
        const int t = t0 + wid; const float* srow = sc + wid * 4096;
        unsigned key[64];
#pragma unroll
        for (int j = 0; j < 64; ++j) { const int s = j * 64 + lane; key[j] = (s <= t) ? f2key(srow[s]) : 0u; }
        unsigned long long* mout = P.mask_() + (size_t)(b * SEQ + t) * 64;
        unsigned long long myword = 0ull;
        TPU_START(105); TPU_START(106); TPU_START(107); TPU_START(108); TPU_START(109);
        if (t + 1 <= TOPK) {
#pragma unroll
            for (int j = 0; j < 64; ++j) { const unsigned long long m = __ballot(j * 64 + lane <= t); if (lane == j) myword = m; }
        } else {
            const int ngrp = t / 512 + 1;
#if TPROBE == 105
            asm volatile("" :: "v"(key[0]), "v"(key[63]));
#endif
            TPU_STOP(105);
            unsigned* hist = (unsigned*)(sc + wid * 4096);
            asm volatile("" ::: "memory");
            { const u32x4 zz4 = {0u, 0u, 0u, 0u};
#pragma unroll
              for (int i = 0; i < 16; ++i) *(u32x4*)(hist + (i * 64 + lane) * 4) = zz4; }
            asm volatile("" ::: "memory");
#define DSA_H8(J0) do { _Pragma("unroll") for (int jj = 0; jj < 8; ++jj) atomicAdd(hist + (key[(J0) + jj] >> 20), 1u); } while (0)
            DSA_H8(0);
            if (ngrp > 1) DSA_H8(8);
            if (ngrp > 2) DSA_H8(16);
            if (ngrp > 3) DSA_H8(24);
            if (ngrp > 4) DSA_H8(32);
            if (ngrp > 5) DSA_H8(40);
            if (ngrp > 6) DSA_H8(48);
            if (ngrp > 7) DSA_H8(56);
#undef DSA_H8
            asm volatile("" ::: "memory");
#if TPROBE == 106
            asm volatile("s_waitcnt lgkmcnt(0)" ::: "memory");
#endif
            TPU_STOP(106);
#define DSA_SUFFIX(s) do { _Pragma("unroll") for (int o = 1; o < 64; o <<= 1) { unsigned t_ = (unsigned)__builtin_amdgcn_ds_bpermute(((lane + o) & 63) << 2, (int)(s)); (s) += (lane + o < 64) ? t_ : 0u; } } while (0)
            unsigned mine = 0u;
#pragma unroll
            for (int i = 0; i < 16; ++i) { const u32x4 v4 = *(const u32x4*)(hist + lane * 64 + ((i + lane) & 15) * 4); mine += (v4[0] + v4[1]) + (v4[2] + v4[3]); }
            unsigned suf = mine; DSA_SUFFIX(suf);
            const unsigned long long mL = __ballot(suf - mine < (unsigned)TOPK && suf >= (unsigned)TOPK);
            const int Ls = (int)__builtin_ctzll(mL);
            const unsigned cntA = (unsigned)__builtin_amdgcn_readlane((int)(suf - mine), Ls);
            unsigned h2 = hist[Ls * 64 + lane]; unsigned suf2 = h2; DSA_SUFFIX(suf2);
            const unsigned long long mB = __ballot(cntA + suf2 - h2 < (unsigned)TOPK && cntA + suf2 >= (unsigned)TOPK);
            const int Bs = (int)__builtin_ctzll(mB);
            const unsigned bstar = (unsigned)(Ls * 64 + Bs);
            const unsigned cntAbove = cntA + (unsigned)__builtin_amdgcn_readlane((int)(suf2 - h2), Bs);
            const unsigned inbin = (unsigned)__builtin_amdgcn_readlane((int)h2, Bs);
#undef DSA_SUFFIX
            TPU_STOP(107);
            unsigned T = bstar << 20; int cntT = (int)(cntAbove + inbin);
            if (cntT != TOPK) {
                asm volatile("" ::: "memory");
                int nslot = 0;
#pragma unroll
                for (int j = 0; j < 64; ++j) { if ((key[j] >> 20) == bstar) { hist[nslot * 64 + lane] = key[j]; ++nslot; } }
                asm volatile("" ::: "memory");
                int R = nslot;
#pragma unroll
                for (int o = 32; o >= 1; o >>= 1) { const int other = __builtin_amdgcn_ds_bpermute(((lane ^ o) << 2), R); R = other > R ? other : R; }
                R = __builtin_amdgcn_readfirstlane(R);
                if (R <= 8) {
                    unsigned c[8];
#pragma unroll
                    for (int r = 0; r < 8; ++r) c[r] = (r < nslot) ? hist[r * 64 + lane] : 0u;
                    for (int bit = 19; bit >= 0; --bit) {
                        const unsigned cand = T | (1u << bit); int cnt = (int)cntAbove;
#pragma unroll
                        for (int r = 0; r < 8; ++r) cnt += __popcll(__ballot(c[r] >= cand));
                        if (cnt >= TOPK) { T = cand; cntT = cnt; if (cnt == TOPK) break; }
                    }
                } else {
                    for (int bit = 19; bit >= 0; --bit) {
                        const unsigned cand = T | (1u << bit); unsigned c0 = 0, c1 = 0; unsigned long long sm0, sm1, sm2, sm3;
                        DSA_CNT8(0);
                        if (ngrp > 1) DSA_CNT8(8);
                        if (ngrp > 2) DSA_CNT8(16);
                        if (ngrp > 3) DSA_CNT8(24);
                        if (ngrp > 4) DSA_CNT8(32);
                        if (ngrp > 5) DSA_CNT8(40);
                        if (ngrp > 6) DSA_CNT8(48);
                        if (ngrp > 7) DSA_CNT8(56);
                        const int cl = (int)(c0 + c1);
                        int cnt = 0;
#pragma unroll
                        for (int bb = 0; bb < 7; ++bb) cnt += __popcll(__ballot((cl >> bb) & 1)) << bb;
                        if (cnt >= TOPK) { T = cand; cntT = cnt; if (cnt == TOPK) break; }
                    }
                }
            }
            TPU_STOP(108);
            if (cntT == TOPK) {
#pragma unroll
                for (int j = 0; j < 64; ++j) { const unsigned long long m = __ballot(key[j] >= T); if (lane == j) myword = m; }
            } else {
                int ngt = 0;
#pragma unroll
                for (int j = 0; j < 64; ++j) ngt += __popcll(__ballot(key[j] > T));
                int need = TOPK - ngt;
#pragma unroll
                for (int j = 0; j < 64; ++j) { const unsigned long long eq = __ballot(key[j] == T), gt = __ballot(key[j] > T);
                    const int ne = __popcll(eq); unsigned long long take = eq;
                    if (ne > need) { take = 0ull; int left = need; unsigned long long e2 = eq;
                        while (left > 0) { const unsigned long long lowbit = e2 & (0ull - e2); take |= lowbit; e2 ^= lowbit; --left; } }
                    need -= (ne > need) ? need : ne;
                    const unsigned long long m = gt | take; if (lane == j) myword = m; }
            }
        }
        mout[lane] = myword;
        TPU_STOP(109);
    }
    TPU_STOP(102);
}

struct DsaOutRow { const bf16_t* zb; bf16_t* gb; int wid;
    __device__ __forceinline__ const bf16_t* zrow(int r) const { const int rho = wid * 32 + r; return zb + (size_t)(rho >> 2) * NPAD + (rho & 3) * 128; }
    __device__ __forceinline__ bf16_t* grow(int r) const { const int rho = wid * 32 + r; return gb + (size_t)(rho >> 2) * MIX + (rho & 3) * 128; } };
__device__ __forceinline__ void unit_dsa_attn(const Params& P, int u, char* lds) {
    const int b = u & 3, qb = 63 - (u >> 2), t0 = qb * 64, tokb = b * SEQ;
    const int wid = TIDX() >> 6, lane = TIDX() & 63, r32 = lane & 31, hi = lane >> 5;
    const int rho = wid * 32 + r32, tq = t0 + (rho >> 2), hq = rho & 3;
    const bf16_t* Qw = P.p_() + (size_t)(tokb + tq) * NPAD + C_DQ + hq * 128 + hi * 8;
    const bf16_t* Kh = P.kvc_() + (size_t)tokb * 256;
    const unsigned moff = (unsigned)(tokb + tq) * 512u;
    DsaOutRow ow; ow.zb = P.p_() + (size_t)(tokb + t0) * NPAD + C_DZ; ow.gb = P.xn_() + (size_t)(tokb + t0) * MIX + 1024; ow.wid = wid;
    const int NT = (qb + 2) & ~1;
    att::attn_body<true, 256, 128, DsaOutRow>(Qw, Kh, NT, P.mask_(), moff, ow, lds);
}
__device__ __forceinline__ void phase_gemm_glu(const Params& P, int layer, char* lds) {
    pg8::Gemm g; g.A = P.ybuf_(); g.Bt = P.WgluT_() + (size_t)layer * 512 * 512; g.M = NTOK; g.N = 512; g.K = 512;
    pg8::StaticOrder S; S.init(g.M, g.N, (int)gridDim.x, (int)blockIdx.x);
    pg8::EpiGlu E; E.Y = P.ybuf_(); E.ldy = 512; E.O = P.ocat_(); E.ldo = MIX; E.ooff = 512;
    pg8::gemm_phase<pg8::EpiGlu, pg8::StaticOrder, false>((PG8_LAS unsigned char*)lds, g, S, E, nullptr);
}

constexpr int CTL_Q0 = 4096;
struct OneUnit { int pm, pn; __device__ __forceinline__ bool next(int i, pg8::Unit& u) const { if (i) return false; u.pm = pm; u.pn = pn; return true; }
    __device__ __forceinline__ void a_ready(const pg8::Unit&) const {} __device__ __forceinline__ void done(const pg8::Unit&) const {} };
__device__ __forceinline__ int q_issue(unsigned* ctr) { return (int)__hip_atomic_fetch_add(ctr, 1u, __ATOMIC_RELAXED, __HIP_MEMORY_SCOPE_AGENT); }
#define Q_LOOP_BEGIN(ctr, total)  { unsigned* q_ctr_ = (ctr); const int q_total_ = (total); volatile int* q_b_ = (volatile int*)(lds + LDS_TAIL + 16); \
    for (;;) { __syncthreads(); if (TIDX() == 0) *q_b_ = q_issue(q_ctr_); __syncthreads(); const int item = __builtin_amdgcn_readfirstlane(*q_b_); if (item >= q_total_) break;
#define Q_LOOP_END  } }
__device__ __forceinline__ void unit_glu(const Params& P, int layer, int u, char* lds) {
    pg8::Gemm g; g.A = P.ybuf_(); g.Bt = P.WgluT_() + (size_t)layer * 512 * 512; g.M = NTOK; g.N = 512; g.K = 512;
    OneUnit S; S.pm = u >> 1; S.pn = u & 1;
    pg8::EpiGluGate E; E.Y = P.ybuf_(); E.Pz = P.p_(); E.G = P.xn_();
    pg8::gemm_phase<pg8::EpiGluGate, OneUnit, false>((PG8_LAS unsigned char*)lds, g, S, E, nullptr);
}
constexpr int LDS_TAIL = LDS_BYTES - 64;

__global__ __launch_bounds__(NTHR, 2) void k_mega(Params P) {
    extern __shared__ __attribute__((aligned(16))) char lds[];
    if (TIDX() == 0) *(uint4*)(lds + LDS_TAIL) = make_uint4(0u, 0u, 0u, 0u);
    __syncthreads();
    XcdBarrier bar = xcd_barrier_post(P.ctl_(), (volatile LAS unsigned*)(lds + LDS_TAIL));
    const int G = gridDim.x, B = blockIdx.x;
    phase_prologue1(P, lds); phase_rope_table(P); phase_s5_params(P); phase_rmsnorm_x(P, 0);
    xcd_barrier(bar);
    for (int layer = 0; layer < DEPTH; ++layer) {
        if (layer > 0) { phase_rmsnorm_x(P, layer); xcd_barrier(bar); }
        phase_gemm_in(P, layer, lds);
        if (layer == 0) phase_gemm_kv(P, lds);
        xcd_barrier(bar);
        phase_prep(P, layer);
        if (layer == 0) phase_memk_norm(P);
        for (int u = B; u < 256; u += G) unit_gla_a4(P, layer, u, lds);
        xcd_barrier(bar);
        Q_LOOP_BEGIN(P.ctl_() + CTL_Q0 + 64 * (layer * 2), 128 + 2048 + 256)
            if (item < 128) unit_s5(P, layer, item, lds);
            else if (item < 2176) unit_dsa_index(P, item - 128, lds);
            else gla_scan_slice(P, (item - 2176) * NTHR + TIDX());
        Q_LOOP_END
        xcd_barrier(bar);
        Q_LOOP_BEGIN(P.ctl_() + CTL_Q0 + 64 * (layer * 2 + 1), 256 + 256 + 128 + 256)
            if (item < 256) unit_dsa_attn(P, item, lds);
            else if (item < 512) unit_gla_c4(P, layer, item - 256, lds);
            else if (item < 640) unit_glu(P, layer, item - 512, lds);
            else unit_mem_attn(P, layer, item - 640, lds);
        Q_LOOP_END
        xcd_barrier(bar);
        phase_gemm_out(P, layer, lds);
        xcd_barrier(bar);
    }
}

extern "C" void kernel_launch(void* const* d_in, const int* in_sizes, int n_in, void* d_out, int out_size, void* d_ws, size_t ws_size, hipStream_t stream) {
    if (n_in != 24 || ws_size < WS_END) { fprintf(stderr, "kernel_launch: unexpected n_in %d or ws_size %zu (< %zu)\n", n_in, ws_size, (size_t)WS_END); return; }
    Params P; memset(&P, 0, sizeof(P));
    P.x = (const float*)d_in[0]; P.mem = (const float*)d_in[1]; P.pos = (const int*)d_in[2]; P.ln_gain = (const float*)d_in[3]; P.w_in = (const float*)d_in[4];
    P.gla_w_up = (const float*)d_in[5]; P.gla_b_up = (const float*)d_in[6]; P.s5_a_re = (const float*)d_in[7]; P.s5_a_im = (const float*)d_in[8]; P.s5_log_step = (const float*)d_in[9];
    P.s5_b_re = (const float*)d_in[10]; P.s5_b_im = (const float*)d_in[11]; P.s5_c_re = (const float*)d_in[12]; P.s5_c_im = (const float*)d_in[13]; P.s5_d = (const float*)d_in[14];
    P.s5_w_glu = (const float*)d_in[15]; P.dsa_q_norm = (const float*)d_in[16]; P.dsa_k_norm = (const float*)d_in[17]; P.mem_norm = (const float*)d_in[18]; P.w_mem_kv = (const float*)d_in[19];
    P.mem_q_norm = (const float*)d_in[20]; P.mem_k_norm = (const float*)d_in[21]; P.out_norm = (const float*)d_in[22]; P.w_out = (const float*)d_in[23];
    P.out = (float*)d_out;
    char* ws = (char*)d_ws; P.ws = ws;
    static int grid = 0;
    if (!grid) {
        int dev = 0, cus = 0, per_cu = 0;
        (void)hipGetDevice(&dev); (void)hipDeviceGetAttribute(&cus, hipDeviceAttributeMultiprocessorCount, dev);
        (void)hipFuncSetAttribute((const void*)k_mega, hipFuncAttributeMaxDynamicSharedMemorySize, LDS_BYTES);
        (void)hipOccupancyMaxActiveBlocksPerMultiprocessor(&per_cu, (const void*)k_mega, NTHR, LDS_BYTES);
        if (per_cu < 1) fprintf(stderr, "kernel_launch: occupancy query reports %d blocks per CU\n", per_cu);
        grid = cus > 0 ? cus : 256;
    }
    (void)hipMemsetAsync(ws + WS_CTL, 0, CTL_BYTES, stream);
    hipLaunchKernelGGL(k_mega, dim3(grid), dim3(NTHR), LDS_BYTES, stream, P);
}
```

```cpp
#include <hip/hip_runtime.h>
#include <stdint.h>
#include <stdio.h>
#include <string.h>

constexpr int NB = 4, SEQ = 4096, NTOK = NB * SEQ, DM = 2048, DEPTH = 4, MEML = 256;
constexpr int NIN = 5984, NPAD = 6144, MIX = 2048;
constexpr int C_GQ = 0, C_GK = 256, C_GV = 512, C_GLR = 1024, C_GZ = 1040, C_SU = 1552, C_SZ = 2064, C_DQ = 2576, C_DK = 3088, C_DV = 3216,
              C_DIQ = 3344, C_DIK = 4368, C_DIW = 4432, C_DZ = 4448, C_MQ = 4960, C_MZ = 5472;
constexpr float EPS = 1e-6f;
constexpr int NTHR = 512;
constexpr int LDS_BYTES = 147456;

typedef unsigned short bf16_t;
typedef short bf16x8 __attribute__((ext_vector_type(8)));
typedef short s16x4 __attribute__((ext_vector_type(4)));
typedef float f32x4 __attribute__((ext_vector_type(4)));
typedef float f32x8 __attribute__((ext_vector_type(8)));
typedef float f32x16 __attribute__((ext_vector_type(16)));
typedef unsigned u32x4 __attribute__((ext_vector_type(4)));
typedef unsigned u32x2 __attribute__((ext_vector_type(2)));
#define LAS __attribute__((address_space(3)))

__device__ __forceinline__ float bf2f(bf16_t b) { return __uint_as_float(((unsigned)b) << 16); }
__device__ __forceinline__ bf16_t f2bf(float f) { unsigned u = __float_as_uint(f); u += 0x7FFFu + ((u >> 16) & 1u); return (bf16_t)(u >> 16); }
__device__ __forceinline__ unsigned pk2bf(float lo, float hi) { return (unsigned)f2bf(lo) | ((unsigned)f2bf(hi) << 16); }
__device__ __forceinline__ float sigmoidf_(float x) { return 1.f / (1.f + __expf(-x)); }
__device__ __forceinline__ float siluf_(float x) { return x / (1.f + __expf(-x)); }

__device__ __forceinline__ int TIDX() { int t = (int)threadIdx.x; asm volatile("" : "+v"(t)); return t; }
__device__ __forceinline__ float shx(float v, int m) { const int src = ((TIDX() & 63) ^ m) << 2; return __int_as_float(__builtin_amdgcn_ds_bpermute(src, __float_as_int(v))); }
__device__ __forceinline__ float wave_sum(float v) {
#pragma unroll
    for (int o = 32; o >= 1; o >>= 1) v += shx(v, o);
    return v;
}
__device__ __forceinline__ void ld8f(const bf16_t* p, float (&v)[8]) { const u32x4 w = *(const u32x4*)p;
#pragma unroll
    for (int j = 0; j < 4; ++j) { v[2 * j] = __uint_as_float(w[j] << 16); v[2 * j + 1] = __uint_as_float(w[j] & 0xffff0000u); } }
__device__ __forceinline__ void st8f(bf16_t* p, const float (&v)[8]) { u32x4 w; w.x = pk2bf(v[0], v[1]); w.y = pk2bf(v[2], v[3]); w.z = pk2bf(v[4], v[5]); w.w = pk2bf(v[6], v[7]); *(u32x4*)p = w; }
__device__ __forceinline__ float f2bf_f(float f) { return bf2f(f2bf(f)); }

#ifndef TPROBE
#define TPROBE 0
#endif
#if TPROBE
#define TPU_START(id) do { if (TPROBE == (id) && TIDX() == 0) *(volatile unsigned long long*)(lds + LDS_BYTES - 24) = __builtin_amdgcn_s_memrealtime(); } while (0)
#define TPU_STOP(id) do { if (TPROBE == (id) && TIDX() == 0) *(volatile unsigned long long*)(lds + LDS_BYTES - 32) += __builtin_amdgcn_s_memrealtime() - *(volatile unsigned long long*)(lds + LDS_BYTES - 24); } while (0)
#else
#define TPU_START(id) do {} while (0)
#define TPU_STOP(id) do {} while (0)
#endif
#define XB_TMO      128
#define XB_XCNT(j)  (256  + 64 * (j))
#define XB_XSUB(j)  (1280 + 64 * (j))
#define XB_XGEN(j)  (2304 + 64 * (j))
#define XB_TOP      3328
#define XB_TOPGEN   3392
#define XCD_BAR_WORDS 3456
#define XB_SPIN_CAP (1u << 18)

__device__ __forceinline__ unsigned xb_ld(unsigned* p)              { return __hip_atomic_load(p, __ATOMIC_RELAXED, __HIP_MEMORY_SCOPE_AGENT); }
__device__ __forceinline__ unsigned xb_add(unsigned* p, unsigned v) { return __hip_atomic_fetch_add(p, v, __ATOMIC_RELAXED, __HIP_MEMORY_SCOPE_AGENT); }
__device__ __forceinline__ unsigned xb_xcc_id() { return (unsigned)__builtin_amdgcn_s_getreg((3 << 11) | 20) & 0xFu; }
#define XB_SPIN(cond, bar) do { unsigned _sp = 0; while (cond) { __builtin_amdgcn_s_sleep(1); \
    if ((++_sp & 255u) == 0u) { if (xb_ld(&(bar)[XB_TMO])) break; if (_sp > XB_SPIN_CAP) { atomicAdd(&(bar)[XB_TMO], 1u); break; } } } } while (0)

struct XcdBarrier {
    unsigned* bar; unsigned x;
    volatile LAS unsigned* st;
};

__device__ __forceinline__ XcdBarrier xcd_barrier_post(unsigned* bar, volatile LAS unsigned* st) {
    XcdBarrier b; b.bar = bar; b.x = xb_xcc_id(); b.st = st;
    if (TIDX() == 0) (void)xb_add(&bar[XB_XCNT(b.x)], 1u);
    return b;
}
__device__ __forceinline__ void xcd_barrier_complete(unsigned* bar, unsigned x, unsigned& nloc, unsigned& nx) {
    const unsigned G = gridDim.x * gridDim.y * gridDim.z;
    unsigned sum, cnt, mine, sp = 0u;
    for (;;) {
        sum = 0u; cnt = 0u; mine = 0u;
#pragma unroll
        for (unsigned j = 0; j < 16; ++j) { const unsigned c = xb_ld(&bar[XB_XCNT(j)]); sum += c; cnt += (c > 0u) ? 1u : 0u; mine = (j == x) ? c : mine; }
        if (sum == G) break;
        __builtin_amdgcn_s_sleep(1);
        if ((++sp & 255u) == 0u) { if (xb_ld(&bar[XB_TMO])) break; if (sp > XB_SPIN_CAP) { atomicAdd(&bar[XB_TMO], 1u); break; } }
    }
    nloc = mine > 0u ? mine : 1u; nx = cnt > 0u ? cnt : 1u;
}

__device__ __forceinline__ void xcd_barrier(const XcdBarrier& b) {
    asm volatile("s_waitcnt vmcnt(0)" ::: "memory");
    __syncthreads();
    if (TIDX() == 0) {
        unsigned* bar = b.bar; const unsigned bx = xb_xcc_id();
        __builtin_amdgcn_s_waitcnt(0);
        unsigned nloc = b.st[0], nx = b.st[1];
        if (nloc == 0u) { xcd_barrier_complete(bar, bx, nloc, nx); b.st[0] = nloc; b.st[1] = nx; }
        const unsigned old = xb_add(&bar[XB_XSUB(bx)], 1u);
        const unsigned gen = old / nloc;
        if (old + 1u == (gen + 1u) * nloc) {
            __builtin_amdgcn_fence(__ATOMIC_RELEASE, "agent");
            asm volatile("s_waitcnt vmcnt(0)" ::: "memory");
            const unsigned og = xb_add(&bar[XB_TOP], 1u);
            const unsigned tg = og / nx;
            if (og + 1u == (tg + 1u) * nx) xb_add(&bar[XB_TOPGEN], 1u);
            else XB_SPIN(xb_ld(&bar[XB_TOPGEN]) == tg, bar);
            __builtin_amdgcn_fence(__ATOMIC_ACQUIRE, "agent");
            xb_add(&bar[XB_XGEN(bx)], 1u);
            asm volatile("s_waitcnt vmcnt(0)" ::: "memory");
        } else {
            XB_SPIN(xb_ld(&bar[XB_XGEN(bx)]) == gen, bar);
            __builtin_amdgcn_fence(__ATOMIC_ACQUIRE, "agent");
            asm volatile("s_waitcnt vmcnt(0)" ::: "memory");
        }
    }
    __syncthreads();
}
namespace pg8 {
#define PG8_LAS __attribute__((address_space(3)))
typedef float f32x2 __attribute__((ext_vector_type(2)));
typedef unsigned u32x4 __attribute__((ext_vector_type(4)));
constexpr int BM = 256, BK = 64, HALF = 128, HTB = HALF * BK * 2  , STAGE_BYTES = 8 * HTB, NXCD = 8, WGM = 8;

__host__ __device__ __forceinline__ int lds_byte(int r, int c) { const int st = (r >> 4) * 2 + (c >> 5), rr = r & 15, cc = c & 31, ob = rr * 64 + cc * 2; return st * 1024 + (ob ^ (((ob >> 9) & 1) << 5)); }
__host__ __device__ __forceinline__ void stage_rc(int b, int& R, int& C) { const int st = b / 1024, sb = b % 1024, swz = sb ^ (((sb >> 9) & 1) << 5); R = (st >> 1) * 16 + swz / 64; C = (st & 1) * 32 + (swz % 64) / 2; }
__host__ __device__ __forceinline__ int perm32(int rho) { const int n = rho >> 4, i = rho & 15; return 8 * (i >> 2) + 4 * n + (i & 3); }

struct Unit { int pm, pn; };
struct Gemm { const bf16_t* A; const bf16_t* Bt; int M, N, K; };

struct StaticOrder {
    int nM, nN, nwg, G, c;
    __host__ __device__ void init(int M, int N, int G_, int c_) { nM = M / BM; nN = N / BM; nwg = nM * nN; G = G_; c = c_; }
    __host__ __device__ bool next(int i, Unit& u) const {
        const long L = (long)i * G + c; if (L >= nwg) return false;
        int wgid = (int)L; { const int q = nwg / NXCD, r = nwg % NXCD, xcd = wgid % NXCD, off = wgid / NXCD; wgid = (xcd < r ? xcd * (q + 1) : r * (q + 1) + (xcd - r) * q) + off; }
        const int nig = WGM * nN, gid = wgid / nig, fm = gid * WGM, gsz = (nM - fm) < WGM ? (nM - fm) : WGM;
        u.pm = fm + ((wgid % nig) % gsz); u.pn = (wgid % nig) / gsz; return true;
    }
    __device__ __forceinline__ void a_ready(const Unit&) const {}
    __device__ __forceinline__ void done(const Unit&) const {}
};
__device__ __forceinline__ unsigned cvt_pk_bf16(float lo, float hi) { unsigned r; asm volatile("v_cvt_pk_bf16_f32 %0, %1, %2" : "=v"(r) : "v"(lo), "v"(hi)); return r; }
struct EpiBf16Plain {
    static constexpr bool PERM = true, AFTER_DRAIN = false;
    bf16_t* O; int ldc;
    __device__ __forceinline__ void operator()(const f32x4 (&acc)[2][2][4][2], const Unit& u, int wr, int wc, int fr, int fq) const {
        const int row0 = u.pm * BM + wr * 64 + fr, col0 = u.pn * BM + wc * 32 + 8 * fq;
#pragma unroll
        for (int ai = 0; ai < 2; ++ai)
#pragma unroll
            for (int m = 0; m < 4; ++m) { bf16_t* rowp = O + (size_t)(row0 + ai * HALF + m * 16) * ldc + col0;
#pragma unroll
                for (int bj = 0; bj < 2; ++bj) { const f32x4 v0 = acc[ai][bj][m][0], v1 = acc[ai][bj][m][1];
                    u32x4 w; w.x = cvt_pk_bf16(v0[0], v0[1]); w.y = cvt_pk_bf16(v0[2], v0[3]); w.z = cvt_pk_bf16(v1[0], v1[1]); w.w = cvt_pk_bf16(v1[2], v1[3]);
                    *(u32x4*)(rowp + bj * HALF) = w; } }
    }
};
struct EpiResid {
    static constexpr bool PERM = false, AFTER_DRAIN = false;
    const float* R; float* C; int ldc;
    __device__ __forceinline__ void operator()(const f32x4 (&acc)[2][2][4][2], const Unit& u, int wr, int wc, int fr, int fq) const {
        const int row0 = u.pm * BM + wr * 64 + fr, col0 = u.pn * BM + wc * 32 + 4 * fq;
#pragma unroll
        for (int ai = 0; ai < 2; ++ai)
#pragma unroll
            for (int m = 0; m < 4; ++m) { const size_t off = (size_t)(row0 + ai * HALF + m * 16) * ldc + col0;
#pragma unroll
                for (int bj = 0; bj < 2; ++bj)
#pragma unroll
                    for (int n = 0; n < 2; ++n) { const f32x4 r = *(const f32x4*)(R + off + bj * HALF + n * 16); *(f32x4*)(C + off + bj * HALF + n * 16) = acc[ai][bj][m][n] + r; } }
    }
};
struct EpiResidMix {
    static constexpr bool PERM = true, AFTER_DRAIN = false;
    const void* R; void* C; int ldc; int r16, c16;
    __device__ __forceinline__ void operator()(const f32x4 (&acc)[2][2][4][2], const Unit& u, int wr, int wc, int fr, int fq) const {
        const int row0 = u.pm * BM + wr * 64 + fr, col0 = u.pn * BM + wc * 32 + 8 * fq;
#pragma unroll
        for (int ai = 0; ai < 2; ++ai)
#pragma unroll
            for (int m = 0; m < 4; ++m) { const size_t off = (size_t)(row0 + ai * HALF + m * 16) * ldc + col0;
                f32x4 r0[2], r1[2];
                if (r16) {
#pragma unroll
                    for (int bj = 0; bj < 2; ++bj) { const u32x4 w = *(const u32x4*)((const bf16_t*)R + off + bj * HALF);
                        r0[bj] = f32x4{__uint_as_float(w.x << 16), __uint_as_float(w.x & 0xffff0000u), __uint_as_float(w.y << 16), __uint_as_float(w.y & 0xffff0000u)};
                        r1[bj] = f32x4{__uint_as_float(w.z << 16), __uint_as_float(w.z & 0xffff0000u), __uint_as_float(w.w << 16), __uint_as_float(w.w & 0xffff0000u)}; }
                } else {
#pragma unroll
                    for (int bj = 0; bj < 2; ++bj) { r0[bj] = *(const f32x4*)((const float*)R + off + bj * HALF); r1[bj] = *(const f32x4*)((const float*)R + off + bj * HALF + 4); }
                }
#pragma unroll
                for (int bj = 0; bj < 2; ++bj) { const f32x4 v0 = acc[ai][bj][m][0] + r0[bj], v1 = acc[ai][bj][m][1] + r1[bj];
                    if (c16) { u32x4 w; w.x = cvt_pk_bf16(v0[0], v0[1]); w.y = cvt_pk_bf16(v0[2], v0[3]); w.z = cvt_pk_bf16(v1[0], v1[1]); w.w = cvt_pk_bf16(v1[2], v1[3]);
                        *(u32x4*)((bf16_t*)C + off + bj * HALF) = w; }
                    else { *(f32x4*)((float*)C + off + bj * HALF) = v0; *(f32x4*)((float*)C + off + bj * HALF + 4) = v1; } } }
    }
};
struct EpiGlu {
    static constexpr bool PERM = true, AFTER_DRAIN = false;
    const bf16_t* Y; int ldy; bf16_t* O; int ldo; int ooff;
    __device__ __forceinline__ void operator()(const f32x4 (&acc)[2][2][4][2], const Unit& u, int wr, int wc, int fr, int fq) const {
        const int row0 = u.pm * BM + wr * 64 + fr, col0 = u.pn * BM + wc * 32 + 8 * fq;
#pragma unroll
        for (int ai = 0; ai < 2; ++ai)
#pragma unroll
            for (int m = 0; m < 4; ++m) { const int row = row0 + ai * HALF + m * 16;
#pragma unroll
                for (int bj = 0; bj < 2; ++bj) { const f32x4 v0 = acc[ai][bj][m][0], v1 = acc[ai][bj][m][1];
                    const u32x4 yw = *(const u32x4*)(Y + (size_t)row * ldy + col0 + bj * HALF);
                    float y[8], g[8];
#pragma unroll
                    for (int j = 0; j < 4; ++j) { y[2 * j] = __uint_as_float(yw[j] << 16); y[2 * j + 1] = __uint_as_float(yw[j] & 0xffff0000u); }
#pragma unroll
                    for (int j = 0; j < 4; ++j) { g[j] = 1.f / (1.f + __expf(-v0[j])); g[4 + j] = 1.f / (1.f + __expf(-v1[j])); }
                    u32x4 w; w.x = cvt_pk_bf16(y[0] * g[0], y[1] * g[1]); w.y = cvt_pk_bf16(y[2] * g[2], y[3] * g[3]); w.z = cvt_pk_bf16(y[4] * g[4], y[5] * g[5]); w.w = cvt_pk_bf16(y[6] * g[6], y[7] * g[7]);
                    *(u32x4*)(O + (size_t)row * ldo + ooff + col0 + bj * HALF) = w; } }
    }
};
struct EpiGluGate {
    static constexpr bool PERM = true, AFTER_DRAIN = true;
    const bf16_t* Y; const bf16_t* Pz; bf16_t* G;
    __device__ __forceinline__ void fused(const f32x4 (&acc)[2][2][4][2], const Unit& u, int wr, int wc, int fr, int fq, PG8_LAS unsigned char* lds, int wid, int lane) const {
        constexpr int TS = 528;
        const int row0 = wr * 64 + fr, col0 = wc * 32 + 8 * fq;
#pragma unroll
        for (int ai = 0; ai < 2; ++ai)
#pragma unroll
            for (int m = 0; m < 4; ++m) { const int rl = row0 + ai * HALF + m * 16; const size_t grow = (size_t)u.pm * BM + rl;
#pragma unroll
                for (int bj = 0; bj < 2; ++bj) { const f32x4 v0 = acc[ai][bj][m][0], v1 = acc[ai][bj][m][1];
                    const u32x4 yw = *(const u32x4*)(Y + grow * 512 + u.pn * BM + col0 + bj * HALF);
                    float y[8], g[8];
#pragma unroll
                    for (int j = 0; j < 4; ++j) { y[2 * j] = __uint_as_float(yw[j] << 16); y[2 * j + 1] = __uint_as_float(yw[j] & 0xffff0000u); }
#pragma unroll
                    for (int j = 0; j < 4; ++j) { g[j] = 1.f / (1.f + __expf(-v0[j])); g[4 + j] = 1.f / (1.f + __expf(-v1[j])); }
                    u32x4 w; w.x = cvt_pk_bf16(y[0] * g[0], y[1] * g[1]); w.y = cvt_pk_bf16(y[2] * g[2], y[3] * g[3]); w.z = cvt_pk_bf16(y[4] * g[4], y[5] * g[5]); w.w = cvt_pk_bf16(y[6] * g[6], y[7] * g[7]);
                    *(PG8_LAS u32x4*)(lds + rl * TS + (col0 + bj * HALF) * 2) = w; } }
        __syncthreads();
        { const int t = wid * 64 + lane, row = t >> 1, hd = t & 1; const PG8_LAS unsigned char* src = lds + row * TS + hd * 256;
          float ss = 0.f;
#pragma unroll
          for (int i = 0; i < 16; ++i) { const u32x4 w = *(const PG8_LAS u32x4*)(src + 16 * i);
#pragma unroll
              for (int j = 0; j < 4; ++j) { const float a = __uint_as_float(w[j] << 16), b = __uint_as_float(w[j] & 0xffff0000u); ss += a * a + b * b; } }
          const float rn = rsqrtf(ss * (1.f / 128.f) + 1e-6f);
          const size_t grow = (size_t)u.pm * BM + row; const int cb = u.pn * BM + hd * 128;
          const bf16_t* zp = Pz + grow * 6144 + 2064 + cb; bf16_t* gp = G + grow * 2048 + 512 + cb;
#pragma unroll
          for (int i = 0; i < 16; ++i) { const u32x4 w = *(const PG8_LAS u32x4*)(src + 16 * i); const u32x4 zw = *(const u32x4*)(zp + 8 * i); u32x4 o;
#pragma unroll
              for (int j = 0; j < 4; ++j) { const float a = __uint_as_float(w[j] << 16), b = __uint_as_float(w[j] & 0xffff0000u), za = __uint_as_float(zw[j] << 16), zb = __uint_as_float(zw[j] & 0xffff0000u);
                  o[j] = cvt_pk_bf16(a * rn * (za / (1.f + __expf(-za))), b * rn * (zb / (1.f + __expf(-zb)))); }
              *(u32x4*)(gp + 8 * i) = o; } }
        __syncthreads();
    }
};
struct EpiBf16Scale {
    static constexpr bool PERM = true, AFTER_DRAIN = false;
    bf16_t* O; int ldc; const float* ssq;
    __device__ __forceinline__ void operator()(const f32x4 (&acc)[2][2][4][2], const Unit& u, int wr, int wc, int fr, int fq) const {
        const int row0 = u.pm * BM + wr * 64 + fr, col0 = u.pn * BM + wc * 32 + 8 * fq;
#pragma unroll
        for (int ai = 0; ai < 2; ++ai)
#pragma unroll
            for (int m = 0; m < 4; ++m) { const int row = row0 + ai * HALF + m * 16; bf16_t* rowp = O + (size_t)row * ldc + col0;
                float ssum = 0.f; { const f32x4* sp_ = (const f32x4*)(ssq + (size_t)row * 32);
#pragma unroll
                    for (int q = 0; q < 8; ++q) { const f32x4 t4 = sp_[q]; ssum += (t4[0] + t4[1]) + (t4[2] + t4[3]); } }
                const float s = rsqrtf(ssum * (1.f / 2048.f) + 1e-6f);
#pragma unroll
                for (int bj = 0; bj < 2; ++bj) { const f32x4 v0 = acc[ai][bj][m][0] * s, v1 = acc[ai][bj][m][1] * s;
                    u32x4 w; w.x = cvt_pk_bf16(v0[0], v0[1]); w.y = cvt_pk_bf16(v0[2], v0[3]); w.z = cvt_pk_bf16(v1[0], v1[1]); w.w = cvt_pk_bf16(v1[2], v1[3]);
                    *(u32x4*)(rowp + bj * HALF) = w; } }
    }
};
struct EpiResidNext {
    static constexpr bool PERM = false, AFTER_DRAIN = false;
    const float* R; float* C; int ldc; bf16_t* XB; float* ssq;
    __device__ __forceinline__ void operator()(const f32x4 (&acc)[2][2][4][2], const Unit& u, int wr, int wc, int fr, int fq) const {
        const int row0 = u.pm * BM + wr * 64 + fr, col0 = u.pn * BM + wc * 32 + 4 * fq;
#pragma unroll
        for (int ai = 0; ai < 2; ++ai)
#pragma unroll
            for (int m = 0; m < 4; ++m) { const int row = row0 + ai * HALF + m * 16; const size_t off = (size_t)row * ldc + col0; float ss = 0.f;
#pragma unroll
                for (int bj = 0; bj < 2; ++bj)
#pragma unroll
                    for (int n = 0; n < 2; ++n) { const f32x4 r = *(const f32x4*)(R + off + bj * HALF + n * 16); const f32x4 v = acc[ai][bj][m][n] + r;
                        *(f32x4*)(C + off + bj * HALF + n * 16) = v;
                        if (XB) { u32x2 w; w.x = cvt_pk_bf16(v[0], v[1]); w.y = cvt_pk_bf16(v[2], v[3]); *(u32x2*)(XB + off + bj * HALF + n * 16) = w; }
                        ss += v[0] * v[0] + v[1] * v[1] + v[2] * v[2] + v[3] * v[3]; }
                if (ssq) { ss += shx(ss, 16); ss += shx(ss, 32); if (fq == 0) ssq[(size_t)row * 32 + u.pn * 4 + wc] = ss; } }
    }
};
template <class Epi, class Sched, bool STAMP = false>
__device__ __forceinline__ void gemm_phase(PG8_LAS unsigned char* lds, const Gemm g, const Sched& S, const Epi& E, unsigned long long* stamps) {
    const int tid = TIDX(), wid = __builtin_amdgcn_readfirstlane(tid >> 6), lane = tid & 63, wr = wid >> 2, wc = wid & 3, fr = lane & 15, fq = lane >> 4;
    const int K = g.K, nt = K / BK;
    int ts_lo = 0, ts_hi = 0, nts = 0; const unsigned long long rt_entry = STAMP ? (unsigned long long)wall_clock64() : 0ull;
#define PG8_STAMP() do { if (STAMP && wid == 0 && nts < 64) { const unsigned long long _c = (unsigned long long)clock64(); \
        ts_lo = (lane == nts) ? (int)(unsigned)_c : ts_lo; ts_hi = (lane == nts) ? (int)(unsigned)(_c >> 32) : ts_hi; ++nts; } } while (0)
    PG8_STAMP();
    unsigned voffA[2], voffB[2];
#pragma unroll
    for (int i = 0; i < 2; ++i) { int R, C; stage_rc(tid * 16 + i * 8192, R, C); const int Rb = Epi::PERM ? ((R & ~31) + perm32(R & 31)) : R;
        voffA[i] = (unsigned)(R * K + C) * 2u; voffB[i] = (unsigned)(Rb * K + C) * 2u; }
    const size_t kstep = (size_t)(BK * 2);
    const size_t hstep = (size_t)HALF * K * 2;
    const size_t tstep = 2 * hstep;
    const unsigned ldsw = (unsigned)wid * 1024u;
    const int aoff = lds_byte(wr * 64 + fr, fq * 8), boff = lds_byte(wc * 32 + fr, fq * 8);
#define PG8_SA(b, h) (((b) * 2 + (h)) * HTB)
#define PG8_SB(b, h) ((4 + (b) * 2 + (h)) * HTB)
#define PG8_STAGE(bufoff, gbase, voff) do { _Pragma("unroll") for (int _i = 0; _i < 2; ++_i) \
        __builtin_amdgcn_global_load_lds((const unsigned*)((const char*)(gbase) + (voff)[_i]), (PG8_LAS unsigned*)(lds + (bufoff) + ldsw + _i * 8192), 16, 0, 0); } while (0)
#define PG8_LDA(dst, b, h) do { _Pragma("unroll") for (int m = 0; m < 4; ++m) _Pragma("unroll") for (int k = 0; k < 2; ++k) dst[m][k] = *(const PG8_LAS bf16x8*)(lds + PG8_SA(b, h) + aoff + m * 2048 + k * 1024); } while (0)
#define PG8_LDB(dst, b, h) do { _Pragma("unroll") for (int n = 0; n < 2; ++n) _Pragma("unroll") for (int k = 0; k < 2; ++k) dst[n][k] = *(const PG8_LAS bf16x8*)(lds + PG8_SB(b, h) + boff + n * 2048 + k * 1024); } while (0)
#define PG8_MMA(ai, bj, At, Bt) do { __builtin_amdgcn_s_setprio(1); _Pragma("unroll") for (int m = 0; m < 4; ++m) _Pragma("unroll") for (int n = 0; n < 2; ++n) _Pragma("unroll") for (int k = 0; k < 2; ++k) \
        acc[ai][bj][m][n] = __builtin_amdgcn_mfma_f32_16x16x32_bf16(Bt[n][k], At[m][k], acc[ai][bj][m][n], 0, 0, 0); __builtin_amdgcn_s_setprio(0); } while (0)
#define PG8_WAIT_V(n) asm volatile("s_waitcnt vmcnt(" #n ")" ::: "memory")
#define PG8_WAIT_L(n) asm volatile("s_waitcnt lgkmcnt(" #n ")" ::: "memory")
#define PG8_BAR __builtin_amdgcn_s_barrier()
#define PG8_SCHED __builtin_amdgcn_sched_barrier(0)
    Unit cur, nxt; int ui = 0;
    if (!S.next(0, cur)) return;
    f32x4 acc[2][2][4][2];
#pragma unroll
    for (int a = 0; a < 2; ++a)
#pragma unroll
        for (int b = 0; b < 2; ++b)
#pragma unroll
            for (int m = 0; m < 4; ++m)
#pragma unroll
                for (int n = 0; n < 2; ++n) acc[a][b][m][n] = (f32x4){0.f, 0.f, 0.f, 0.f};
    bf16x8 At[4][2], B0[2][2], B1[2][2];
    const char* cA = (const char*)g.A + (size_t)cur.pm * tstep; const char* cB = (const char*)g.Bt + (size_t)cur.pn * tstep;
    S.a_ready(cur);
    PG8_STAGE(PG8_SB(0, 0), cB, voffB); PG8_STAGE(PG8_SA(0, 0), cA, voffA); PG8_STAGE(PG8_SB(0, 1), cB + hstep, voffB); PG8_STAGE(PG8_SA(0, 1), cA + hstep, voffA);
    if (wr == 1) PG8_BAR;
    PG8_WAIT_V(4); PG8_BAR;
    PG8_STAGE(PG8_SB(1, 0), cB + kstep, voffB); PG8_STAGE(PG8_SA(1, 0), cA + kstep, voffA); PG8_STAGE(PG8_SB(1, 1), cB + hstep + kstep, voffB);
    PG8_WAIT_V(6); PG8_BAR;
    PG8_STAMP();
    for (;;) {
        const bool has_next = S.next(ui + 1, nxt);
        const char* nA = has_next ? (const char*)g.A + (size_t)nxt.pm * tstep : cA; const char* nB = has_next ? (const char*)g.Bt + (size_t)nxt.pn * tstep : cB;
        for (int t = 0; t < nt; t += 2) {
            const bool last = (t == nt - 2);
            const char* a1 = cA + (size_t)(t + 1) * kstep;
            const char* a2 = last ? nA : cA + (size_t)(t + 2) * kstep; const char* b2 = last ? nB : cB + (size_t)(t + 2) * kstep;
            const char* a3 = a2 + kstep; const char* b3 = b2 + kstep;
            if (last && has_next) S.a_ready(nxt);
            PG8_LDB(B0, 0, 0); PG8_SCHED; PG8_LDA(At, 0, 0); PG8_STAGE(PG8_SA(1, 1), a1 + hstep, voffA);
            PG8_WAIT_L(8); PG8_BAR; PG8_WAIT_L(0); PG8_MMA(0, 0, At, B0); PG8_BAR; PG8_SCHED;
            PG8_LDB(B1, 0, 1); PG8_STAGE(PG8_SB(0, 0), b2, voffB);
            PG8_BAR; PG8_WAIT_L(0); PG8_MMA(0, 1, At, B1); PG8_BAR;
            PG8_LDA(At, 0, 1); PG8_STAGE(PG8_SA(0, 0), a2, voffA);
            PG8_BAR; PG8_WAIT_L(0); PG8_MMA(1, 0, At, B0); PG8_BAR; PG8_SCHED;
            PG8_STAGE(PG8_SB(0, 1), b2 + hstep, voffB);
            PG8_WAIT_V(6); PG8_BAR; PG8_MMA(1, 1, At, B1); PG8_BAR;
            PG8_LDB(B0, 1, 0); PG8_SCHED; PG8_LDA(At, 1, 0); PG8_STAGE(PG8_SA(0, 1), a2 + hstep, voffA);
            PG8_WAIT_L(8); PG8_BAR; PG8_WAIT_L(0); PG8_MMA(0, 0, At, B0); PG8_BAR; PG8_SCHED;
            PG8_LDB(B1, 1, 1); PG8_STAGE(PG8_SB(1, 0), b3, voffB);
            PG8_BAR; PG8_WAIT_L(0); PG8_MMA(0, 1, At, B1); PG8_BAR;
            PG8_LDA(At, 1, 1); PG8_STAGE(PG8_SA(1, 0), a3, voffA);
            PG8_BAR; PG8_WAIT_L(0); PG8_MMA(1, 0, At, B0); PG8_BAR; PG8_SCHED;
            PG8_STAGE(PG8_SB(1, 1), b3 + hstep, voffB);
            PG8_WAIT_V(6); PG8_BAR; PG8_MMA(1, 1, At, B1); PG8_BAR;
        }
        PG8_STAMP();
        if constexpr (!Epi::AFTER_DRAIN) { E(acc, cur, wr, wc, fr, fq); S.done(cur); }
        PG8_STAMP();
        if (!has_next) break;
#pragma unroll
        for (int a = 0; a < 2; ++a)
#pragma unroll
            for (int b = 0; b < 2; ++b)
#pragma unroll
                for (int m = 0; m < 4; ++m)
#pragma unroll
                    for (int n = 0; n < 2; ++n) acc[a][b][m][n] = (f32x4){0.f, 0.f, 0.f, 0.f};
        cur = nxt; cA = nA; cB = nB; ++ui;
    }
    PG8_WAIT_V(0);
    if (wr == 0) PG8_BAR;
    PG8_BAR;
    if constexpr (Epi::AFTER_DRAIN) { E.fused(acc, cur, wr, wc, fr, fq, lds, wid, lane); S.done(cur); }
    PG8_STAMP();
    if (STAMP && wid == 0) { stamps[lane] = lane < nts ? (((unsigned long long)(unsigned)ts_hi << 32) | (unsigned)ts_lo) : 0ull;
        if (lane == 62) stamps[62] = rt_entry; if (lane == 63) stamps[63] = (unsigned long long)wall_clock64(); }
#undef PG8_STAMP
#undef PG8_SA
#undef PG8_SB
#undef PG8_STAGE
#undef PG8_LDA
#undef PG8_LDB
#undef PG8_MMA
#undef PG8_WAIT_V
#undef PG8_WAIT_L
#undef PG8_BAR
#undef PG8_SCHED
}
}
namespace att {
constexpr int D = 128, NW = 8, QBLK = 32, KVBLK = 64;
constexpr float SCALE = 0.088388347648318440f, THR = 8.f;
constexpr int SHM_V = KVBLK * D * 2, SHM_K = KVBLK * D * 2, SHM_ATTN = 2 * SHM_V + 2 * SHM_K + NW * 64 * 4;
#define KSWZ(row, colB) ((row) * 256 + ((colB) ^ (((row) & 7) << 4)))
#define SBAR() __builtin_amdgcn_sched_barrier(0)
__device__ __forceinline__ int crow(int r, int hi) { return (r & 3) + 8 * (r >> 2) + 4 * hi; }
__device__ __forceinline__ unsigned cvtpk(float lo, float hi) { unsigned r; asm volatile("v_cvt_pk_bf16_f32 %0, %1, %2" : "=v"(r) : "v"(lo), "v"(hi)); return r; }

template <bool MASKED>
__device__ __forceinline__ void partialSM(f32x16& p0, f32x16& p1, float& m_reg, float& mn, float& alpha, unsigned long long mw, int hi) {
  constexpr float C = SCALE * 1.4426950408889634f;
  float pmax = p0[0];
#pragma unroll
  for (int r = 1; r < 16; ++r) pmax = fmaxf(pmax, p0[r]);
#pragma unroll
  for (int r = 0; r < 16; ++r) pmax = fmaxf(pmax, p1[r]);
  { auto rr = __builtin_amdgcn_permlane32_swap(__float_as_uint(pmax), __float_as_uint(pmax), false, false);
    pmax = fmaxf(__uint_as_float(rr[0]), __uint_as_float(rr[1])); }
  if (__builtin_expect(__all(pmax - m_reg <= THR / SCALE), 1)) { mn = m_reg; alpha = 1.f; }
  else { mn = fmaxf(m_reg, pmax); alpha = __builtin_amdgcn_exp2f((m_reg - mn) * C); m_reg = mn; }
  const float mnC = -mn * C;
#pragma unroll
  for (int r = 0; r < 16; ++r) p0[r] = fmaf(p0[r], C, mnC);
#pragma unroll
  for (int r = 0; r < 16; ++r) p1[r] = fmaf(p1[r], C, mnC);
#pragma unroll
  for (int r = 0; r < 16; ++r) p0[r] = __builtin_amdgcn_exp2f(p0[r]);
}
__device__ __forceinline__ void finishSM(f32x16& p0, f32x16& p1, float alpha, float& l_reg, bf16x8& pa0, bf16x8& pa1, bf16x8& pa2, bf16x8& pa3) {
#pragma unroll
  for (int r = 0; r < 16; ++r) p1[r] = __builtin_amdgcn_exp2f(p1[r]);
  float ps = 0;
#pragma unroll
  for (int r = 0; r < 16; ++r) ps += p0[r];
#pragma unroll
  for (int r = 0; r < 16; ++r) ps += p1[r];
  { auto rr = __builtin_amdgcn_permlane32_swap(__float_as_uint(ps), __float_as_uint(ps), false, false);
    ps = __uint_as_float(rr[0]) + __uint_as_float(rr[1]); }
  l_reg = l_reg * alpha + ps;
#define PK4(P, BASE, OUT) do { unsigned a0 = cvtpk(P[BASE + 0], P[BASE + 1]), a1 = cvtpk(P[BASE + 2], P[BASE + 3]);   \
    unsigned b0 = cvtpk(P[BASE + 4], P[BASE + 5]), b1 = cvtpk(P[BASE + 6], P[BASE + 7]);                              \
    auto r0 = __builtin_amdgcn_permlane32_swap(a0, b0, false, false); auto r1 = __builtin_amdgcn_permlane32_swap(a1, b1, false, false); \
    u32x4 w = {r0[0], r1[0], r0[1], r1[1]}; OUT = *reinterpret_cast<bf16x8*>(&w); } while (0)
  PK4(p0, 0, pa0); PK4(p0, 8, pa1); PK4(p1, 0, pa2); PK4(p1, 8, pa3);
#undef PK4
}
template <int R> __device__ __forceinline__ float mask_bias(unsigned nw) {
  unsigned t; constexpr int bit = (R & 3) + 8 * (R >> 2);
  asm("v_bfe_i32 %0, %1, %2, 1\n\tv_and_b32 %0, 0xff800000, %0" : "=v"(t) : "v"(nw), "n"(bit));
  return __uint_as_float(t);
}
template <bool MASKED>
__device__ __forceinline__ void qkt(f32x16& p0, f32x16& p1, const char* Ks, const bf16x8* qr, int r32, int hi, unsigned long long mw) {
  if (MASKED) {
    const unsigned n0 = ~((unsigned)mw >> (4 * hi)), n1 = ~((unsigned)(mw >> 32) >> (4 * hi));
#define MB_(R) p0[R] = mask_bias<R>(n0); p1[R] = mask_bias<R>(n1);
    MB_(0) MB_(1) MB_(2) MB_(3) MB_(4) MB_(5) MB_(6) MB_(7) MB_(8) MB_(9) MB_(10) MB_(11) MB_(12) MB_(13) MB_(14) MB_(15)
#undef MB_
  } else { p0 = f32x16{}; p1 = f32x16{}; }
  asm volatile("" : "+v"(p0), "+v"(p1));
#pragma unroll
  for (int d0 = 0; d0 < 8; ++d0) { const int cb = (d0 * 16 + hi * 8) * 2;
    bf16x8 b0 = *reinterpret_cast<const bf16x8*>(Ks + KSWZ(r32, cb));
    bf16x8 b1 = *reinterpret_cast<const bf16x8*>(Ks + KSWZ(32 + r32, cb));
    p0 = __builtin_amdgcn_mfma_f32_32x32x16_bf16(b0, qr[d0], p0, 0, 0, 0);
    p1 = __builtin_amdgcn_mfma_f32_32x32x16_bf16(b1, qr[d0], p1, 0, 0, 0); }
}
__device__ __forceinline__ int v_st(int k, int c) { const int kk = (k & ~0xC) | ((k & 4) << 1) | ((k & 8) >> 1); return ((kk >> 3) * 4 + (c >> 5)) * 512 + ((kk & 7) * 32 + (c & 31)) * 2; }
__device__ __forceinline__ int v_rd_base(int lane) { return ((lane & 3) << 3) | (((lane >> 2) & 3) << 6) | (((lane >> 4) & 1) << 5) | (((lane >> 5) & 1) << 8); }
constexpr int v_rd_off(int d0, int ks, int half) { return d0 * 512 + ks * 4096 + half * 2048; }
template <int OFF> __device__ __forceinline__ s16x4 tr_read(int vb) {
  s16x4 r; asm volatile("ds_read_b64_tr_b16 %0, %1 offset:%2" : "=&v"(r) : "v"(vb), "i"(OFF) : "memory"); return r;
}
template <int D0> __device__ __forceinline__ void pv_one(f32x16& od, int vb, bf16x8 pa0, bf16x8 pa1, bf16x8 pa2, bf16x8 pa3) {
  const s16x4 l0 = tr_read<v_rd_off(D0, 0, 0)>(vb), h0 = tr_read<v_rd_off(D0, 0, 1)>(vb), l1 = tr_read<v_rd_off(D0, 1, 0)>(vb), h1 = tr_read<v_rd_off(D0, 1, 1)>(vb);
  const s16x4 l2 = tr_read<v_rd_off(D0, 2, 0)>(vb), h2 = tr_read<v_rd_off(D0, 2, 1)>(vb), l3 = tr_read<v_rd_off(D0, 3, 0)>(vb), h3 = tr_read<v_rd_off(D0, 3, 1)>(vb);
  asm volatile("s_waitcnt lgkmcnt(0)" ::: "memory"); SBAR();
#define PK(L, H) (bf16x8){L[0], L[1], L[2], L[3], H[0], H[1], H[2], H[3]}
  od = __builtin_amdgcn_mfma_f32_32x32x16_bf16(pa0, PK(l0, h0), od, 0, 0, 0);
  od = __builtin_amdgcn_mfma_f32_32x32x16_bf16(pa1, PK(l1, h1), od, 0, 0, 0);
  od = __builtin_amdgcn_mfma_f32_32x32x16_bf16(pa2, PK(l2, h2), od, 0, 0, 0);
  od = __builtin_amdgcn_mfma_f32_32x32x16_bf16(pa3, PK(l3, h3), od, 0, 0, 0);
#undef PK
}
__device__ __forceinline__ void pv_d0(f32x16* o, int vb, bf16x8 pa0, bf16x8 pa1, bf16x8 pa2, bf16x8 pa3) {
  pv_one<0>(o[0], vb, pa0, pa1, pa2, pa3); pv_one<1>(o[1], vb, pa0, pa1, pa2, pa3); pv_one<2>(o[2], vb, pa0, pa1, pa2, pa3); pv_one<3>(o[3], vb, pa0, pa1, pa2, pa3);
}

template <bool MASKED, int LDK, int VOFF, int QT, class OutRow>
__device__ __forceinline__ void attn_body(const bf16_t* __restrict__ Qw, const float* __restrict__ qgain, const float* __restrict__ qcs, const bf16_t* __restrict__ Kh, int NT,
                                          const unsigned long long* __restrict__ mbase, unsigned moff, const OutRow& Ow, char* lds) {
  const int tid = TIDX(), wid = tid >> 6, lane = tid & 63, r32 = lane & 31, hi = lane >> 5;
  char* V_lds = lds; char* K_lds = lds + 2 * SHM_V;
  float* ws = (float*)(lds + 2 * SHM_V + 2 * SHM_K) + wid * 64; float* li_l = ws; float* al_l = ws + 32;
  float m_reg = -1e30f, l_reg = 0; f32x16 o[4] = {}; bf16x8 qr[8];
  asm volatile("" : "+v"(o[0]), "+v"(o[1]), "+v"(o[2]), "+v"(o[3]));
#pragma unroll
  for (int d0 = 0; d0 < 8; ++d0) qr[d0] = *reinterpret_cast<const bf16x8*>(Qw + d0 * 16);
  if (QT) {
    float ss = 0.f;
#pragma unroll
    for (int d0 = 0; d0 < 8; ++d0)
#pragma unroll
      for (int j = 0; j < 8; ++j) { const float x = bf2f((bf16_t)qr[d0][j]); ss += x * x; }
    { auto rr = __builtin_amdgcn_permlane32_swap(__float_as_uint(ss), __float_as_uint(ss), false, false); ss = __uint_as_float(rr[0]) + __uint_as_float(rr[1]); }
    const float rn = rsqrtf(ss * (1.f / 128.f) + EPS);
    float x01[2][8];
#pragma unroll
    for (int d0 = 0; d0 < 8; ++d0) { const f32x4 g0 = *(const f32x4*)(qgain + d0 * 16 + hi * 8), g1 = *(const f32x4*)(qgain + d0 * 16 + hi * 8 + 4);
      float x[8];
#pragma unroll
      for (int j = 0; j < 8; ++j) x[j] = bf2f((bf16_t)qr[d0][j]) * rn * (j < 4 ? g0[j] : g1[j - 4]);
      if (QT == 2 && d0 < 2) {
#pragma unroll
        for (int j = 0; j < 8; ++j) x01[d0][j] = x[j];
      } else { u32x4 w = {cvtpk(x[0], x[1]), cvtpk(x[2], x[3]), cvtpk(x[4], x[5]), cvtpk(x[6], x[7])}; qr[d0] = *reinterpret_cast<bf16x8*>(&w); } }
    if (QT == 2) {
      float a[8], b[8];
#pragma unroll
      for (int j2 = 0; j2 < 4; ++j2) { const f32x4 cs = *(const f32x4*)(qcs + hi * 16 + 4 * j2);
#pragma unroll
        for (int q = 0; q < 2; ++q) { const int j = 2 * j2 + q; const float c = cs[2 * q], sn = cs[2 * q + 1], x1 = x01[0][j], x2 = x01[1][j]; a[j] = x1 * c - x2 * sn; b[j] = x2 * c + x1 * sn; } }
      { u32x4 w = {cvtpk(a[0], a[1]), cvtpk(a[2], a[3]), cvtpk(a[4], a[5]), cvtpk(a[6], a[7])}; qr[0] = *reinterpret_cast<bf16x8*>(&w); }
      { u32x4 w = {cvtpk(b[0], b[1]), cvtpk(b[2], b[3]), cvtpk(b[4], b[5]), cvtpk(b[6], b[7])}; qr[1] = *reinterpret_cast<bf16x8*>(&w); }
    }
  }
  const int sr = tid >> 4, sc = (tid & 15) * 8, vst0 = v_st(sr, sc), vst1 = v_st(32 + sr, sc);
  const int vb0 = (int)(uintptr_t)V_lds + v_rd_base(lane);
  struct { bf16x8 vs0, vs1, ks0, ks1; } sr_[2];
  const unsigned koff = (unsigned)(sr * LDK + sc) * 2u;
#define SLOAD(i, k0) do { const char* kb_ = (const char*)Kh + (size_t)(k0) * (LDK * 2); \
    sr_[i].vs0 = *reinterpret_cast<const bf16x8*>(kb_ + koff + VOFF * 2); sr_[i].vs1 = *reinterpret_cast<const bf16x8*>(kb_ + koff + (32 * LDK + VOFF) * 2); \
    sr_[i].ks0 = *reinterpret_cast<const bf16x8*>(kb_ + koff); sr_[i].ks1 = *reinterpret_cast<const bf16x8*>(kb_ + koff + 32 * LDK * 2); } while (0)
#define SWRITE(b, i) do { *(bf16x8*)(V_lds + (b) * SHM_V + vst0) = sr_[i].vs0;          \
    *(bf16x8*)(V_lds + (b) * SHM_V + vst1) = sr_[i].vs1; int kc = sc * 2;               \
    *(bf16x8*)(K_lds + (b) * SHM_K + KSWZ(sr, kc)) = sr_[i].ks0;                       \
    *(bf16x8*)(K_lds + (b) * SHM_K + KSWZ(32 + sr, kc)) = sr_[i].ks1; } while (0)
#define SWAIT() asm volatile("s_waitcnt vmcnt(4)" ::: "memory")
#define RESC(a) do { if (__any((a) < 1.f)) { if (hi == 0) al_l[r32] = (a); asm volatile("s_waitcnt lgkmcnt(0)" ::: "memory"); \
    _Pragma("unroll") for (int d = 0; d < 4; ++d) _Pragma("unroll") for (int r = 0; r < 16; ++r) o[d][r] *= al_l[crow(r, hi)]; } } while (0)
  f32x16 pA0, pA1, pB0, pB1; float mnA, mnB, alA, alB; bf16x8 pa0, pa1, pa2, pa3;
  unsigned long long mw = 0ull;
  constexpr int SE = 0, SO = 1;
  if (MASKED) mw = *(const unsigned long long*)((const char*)mbase + moff);
  SLOAD(SE, 0); asm volatile("s_waitcnt vmcnt(0)" ::: "memory"); SWRITE(0, SE); __syncthreads();
  qkt<MASKED>(pA0, pA1, K_lds, qr, r32, hi, mw);
  if (MASKED) mw = *(const unsigned long long*)((const char*)mbase + (moff + 8u));
  partialSM<MASKED>(pA0, pA1, m_reg, mnA, alA, mw, hi);
  SLOAD(SO, KVBLK); SLOAD(SE, (2 < NT ? 2 : NT - 1) * KVBLK);
  SWAIT();
  SWRITE(1, SO); __syncthreads();
  for (int j = 1; j + 1 < NT; j += 2) {
    SBAR(); qkt<MASKED>(pB0, pB1, K_lds + SHM_K, qr, r32, hi, mw);
    if (MASKED) mw = *(const unsigned long long*)((const char*)mbase + (moff + 8u * (unsigned)(j + 1)));
    finishSM(pA0, pA1, alA, l_reg, pa0, pa1, pa2, pa3); SBAR();
    SLOAD(SO, (j + 2) * KVBLK); SBAR();
    pv_d0(o, vb0, pa0, pa1, pa2, pa3); partialSM<MASKED>(pB0, pB1, m_reg, mnB, alB, mw, hi);
    __syncthreads(); if (MASKED) asm volatile("s_waitcnt vmcnt(5)" ::: "memory"); else SWAIT();
    SWRITE(0, SE);
    RESC(alB); __syncthreads();
    SBAR(); qkt<MASKED>(pA0, pA1, K_lds, qr, r32, hi, mw);
    if (MASKED) mw = *(const unsigned long long*)((const char*)mbase + (moff + 8u * (unsigned)(j + 2)));
    finishSM(pB0, pB1, alB, l_reg, pa0, pa1, pa2, pa3); SBAR();
    SLOAD(SE, (j + 3 < NT ? j + 3 : NT - 1) * KVBLK); SBAR();
    pv_d0(o, vb0 + SHM_V, pa0, pa1, pa2, pa3); partialSM<MASKED>(pA0, pA1, m_reg, mnA, alA, mw, hi);
    __syncthreads(); if (MASKED) asm volatile("s_waitcnt vmcnt(5)" ::: "memory"); else SWAIT();
    SWRITE(1, SO);
    RESC(alA); __syncthreads();
  }
  SBAR(); qkt<MASKED>(pB0, pB1, K_lds + SHM_K, qr, r32, hi, mw);
  finishSM(pA0, pA1, alA, l_reg, pa0, pa1, pa2, pa3); SBAR();
  pv_d0(o, vb0, pa0, pa1, pa2, pa3); partialSM<MASKED>(pB0, pB1, m_reg, mnB, alB, mw, hi);
  __syncthreads(); RESC(alB);
  finishSM(pB0, pB1, alB, l_reg, pa0, pa1, pa2, pa3); SBAR();
  pv_d0(o, vb0 + SHM_V, pa0, pa1, pa2, pa3);
  if (hi == 0) li_l[r32] = l_reg; asm volatile("s_waitcnt lgkmcnt(0)" ::: "memory");
  float rli[16];
#pragma unroll
  for (int r = 0; r < 16; ++r) rli[r] = __builtin_amdgcn_rcpf(li_l[crow(r, hi)]);
  __syncthreads();
  float* og_s = (float*)lds + wid * (32 * 132);
#pragma unroll
  for (int r = 0; r < 16; ++r) {
#pragma unroll
    for (int d0 = 0; d0 < 4; ++d0) og_s[crow(r, hi) * 132 + d0 * 32 + r32] = o[d0][r] * rli[r]; }
  asm volatile("" ::: "memory");
  { const int row = lane >> 1, half = lane & 1; const float* src = og_s + row * 132 + half * 64;
    f32x4 v[16]; float ss = 0.f;
#pragma unroll
    for (int i = 0; i < 16; ++i) { v[i] = *(const f32x4*)(src + 4 * i); ss += v[i][0] * v[i][0] + v[i][1] * v[i][1] + v[i][2] * v[i][2] + v[i][3] * v[i][3]; }
    ss += shx(ss, 1);
    const float rn = rsqrtf(ss * (1.f / 128.f) + EPS);
    const bf16_t* zp = Ow.zrow(row) + half * 64; bf16_t* gp = Ow.grow(row) + half * 64;
#pragma unroll
    for (int i = 0; i < 8; ++i) { float z[8], g[8]; ld8f(zp + 8 * i, z);
#pragma unroll
      for (int q = 0; q < 4; ++q) { g[q] = v[2 * i][q] * rn * siluf_(z[q]); g[4 + q] = v[2 * i + 1][q] * rn * siluf_(z[4 + q]); }
      st8f(gp + 8 * i, g); } }
  __syncthreads();
#undef SLOAD
#undef SWRITE
#undef SWAIT
#undef RESC
}
}
constexpr size_t al256(size_t x) { return (x + 255) / 256 * 256; }
constexpr size_t WS_CTL   = 0;
constexpr size_t CTL_BYTES = 65536;
constexpr size_t WS_WINT  = WS_CTL + CTL_BYTES;
constexpr size_t WS_WOUTT = WS_WINT + al256((size_t)DEPTH * NPAD * DM * 2);
constexpr size_t WS_WKVT  = WS_WOUTT + al256((size_t)DEPTH * DM * MIX * 2);
constexpr size_t WS_WGLUT = WS_WKVT + al256((size_t)DEPTH * 1024 * DM * 2);
constexpr size_t WS_MEMN  = WS_WGLUT + al256((size_t)DEPTH * 512 * 512 * 2);
constexpr size_t WS_KVMEM = WS_MEMN + al256((size_t)NB * MEML * DM * 2);
constexpr size_t WS_XN    = WS_KVMEM + al256((size_t)NB * MEML * DEPTH * 1024 * 2);
constexpr size_t WS_P     = WS_XN + al256((size_t)NTOK * DM * 2);
constexpr size_t WS_XBUF  = WS_P + al256((size_t)NTOK * NPAD * 2);
constexpr size_t WS_OCAT  = WS_XBUF + al256((size_t)NTOK * DM * 4);
constexpr size_t WS_MASK  = WS_OCAT + al256((size_t)NTOK * MIX * 2);
constexpr size_t WS_IW    = WS_MASK + al256((size_t)NTOK * 64 * 8);
constexpr size_t WS_YBUF  = WS_IW + al256((size_t)NTOK * 16 * 4);
constexpr size_t WS_ROPE  = WS_YBUF + al256((size_t)NTOK * 512 * 2);
constexpr size_t WS_S5P   = WS_ROPE + al256((size_t)NTOK * 48 * 4);
constexpr size_t S5P_BYTES = (size_t)DEPTH * 32 * (64 * 2 + 64 * 2 + 64 * 16 * 2) * 4;
constexpr size_t WS_GLAS  = WS_S5P + al256(S5P_BYTES);
constexpr size_t WS_GLAD  = WS_GLAS + al256((size_t)NB * 64 * 4 * 64 * 128 * 4);
constexpr size_t WS_IKC   = WS_GLAD + al256((size_t)NB * 64 * 4 * 64 * 4);
constexpr size_t WS_KVC   = WS_IKC + al256((size_t)NTOK * 64 * 2);
constexpr size_t WS_IQL   = WS_KVC + al256((size_t)NTOK * 256 * 2);
constexpr size_t WS_SSQ   = WS_IQL + al256((size_t)NTOK * 64 * 2);
constexpr size_t DSP_SLOT = (size_t)(256 * 128 + 512) * 4;
constexpr size_t WS_DSP   = WS_SSQ + 256;
constexpr size_t WS_END   = WS_DSP + al256((size_t)160 * 2 * DSP_SLOT);

struct Params {
    const float* x; const float* mem; const int* pos; const float* ln_gain; const float* w_in; const float* gla_w_up; const float* gla_b_up;
    const float* s5_a_re; const float* s5_a_im; const float* s5_log_step; const float* s5_b_re; const float* s5_b_im; const float* s5_c_re; const float* s5_c_im;
    const float* s5_d; const float* s5_w_glu; const float* dsa_q_norm; const float* dsa_k_norm; const float* mem_norm; const float* w_mem_kv;
    const float* mem_q_norm; const float* mem_k_norm; const float* out_norm; const float* w_out;
    float* out;
    char* ws;
    __device__ __forceinline__ unsigned* ctl_() const { return (unsigned*)(ws + WS_CTL); }
    __device__ __forceinline__ bf16_t* WinT_() const { return (bf16_t*)(ws + WS_WINT); }
    __device__ __forceinline__ bf16_t* WoutT_() const { return (bf16_t*)(ws + WS_WOUTT); }
    __device__ __forceinline__ bf16_t* WkvT_() const { return (bf16_t*)(ws + WS_WKVT); }
    __device__ __forceinline__ bf16_t* WgluT_() const { return (bf16_t*)(ws + WS_WGLUT); }
    __device__ __forceinline__ bf16_t* memn_() const { return (bf16_t*)(ws + WS_MEMN); }
    __device__ __forceinline__ bf16_t* kvmem_() const { return (bf16_t*)(ws + WS_KVMEM); }
    __device__ __forceinline__ bf16_t* xn_() const { return (bf16_t*)(ws + WS_XN); }
    __device__ __forceinline__ bf16_t* p_() const { return (bf16_t*)(ws + WS_P); }
    __device__ __forceinline__ bf16_t* xbuf_() const { return (bf16_t*)(ws + WS_XBUF); }
    __device__ __forceinline__ bf16_t* ocat_() const { return (bf16_t*)(ws + WS_OCAT); }
    __device__ __forceinline__ unsigned long long* mask_() const { return (unsigned long long*)(ws + WS_MASK); }
    __device__ __forceinline__ float* iw_() const { return (float*)(ws + WS_IW); }
    __device__ __forceinline__ bf16_t* ybuf_() const { return (bf16_t*)(ws + WS_YBUF); }
    __device__ __forceinline__ float* rope_() const { return (float*)(ws + WS_ROPE); }
    __device__ __forceinline__ float* s5p_() const { return (float*)(ws + WS_S5P); }
    __device__ __forceinline__ float* glas_() const { return (float*)(ws + WS_GLAS); }
    __device__ __forceinline__ float* glad_() const { return (float*)(ws + WS_GLAD); }
    __device__ __forceinline__ bf16_t* ikc_() const { return (bf16_t*)(ws + WS_IKC); }
    __device__ __forceinline__ bf16_t* kvc_() const { return (bf16_t*)(ws + WS_KVC); }
    __device__ __forceinline__ float* ssq_() const { return (float*)(ws + WS_SSQ); }
    __device__ __forceinline__ bf16_t* iql_() const { return (bf16_t*)(ws + WS_IQL); }
    __device__ __forceinline__ char* dsp_() const { return ws + WS_DSP; }
};

__device__ __forceinline__ void transpose_tiles(const float* __restrict__ src, int K, int Nsrc, int Ndst, const float* __restrict__ scale, bf16_t* __restrict__ dst,
                                                int tile, float* lds_tile  ) {
    const int tid = TIDX(), ntn = Ndst / 256;
    const int tk = tile / ntn, tn = tile % ntn, k0 = tk * 64, n0 = tn * 256;
    __syncthreads();
    { const int ty = tid >> 4, tx = tid & 15;
      f32x4 v[2][4];
#pragma unroll
      for (int i = 0; i < 2; ++i)
#pragma unroll
        for (int q = 0; q < 4; ++q) { const int k = k0 + ty + 32 * i, n = n0 + 4 * tx + 64 * q;
          v[i][q] = (f32x4){0.f, 0.f, 0.f, 0.f};
          if (n < Nsrc) v[i][q] = *(const f32x4*)(src + (size_t)k * Nsrc + n); }
#pragma unroll
      for (int i = 0; i < 2; ++i) { const float s = scale ? scale[k0 + ty + 32 * i] : 1.f;
#pragma unroll
        for (int q = 0; q < 4; ++q) { float* t = lds_tile + (ty + 32 * i) * 257 + 4 * tx + 64 * q; t[0] = v[i][q][0] * s; t[1] = v[i][q][1] * s; t[2] = v[i][q][2] * s; t[3] = v[i][q][3] * s; } } }
    __syncthreads();
    { const int n = tid >> 1, kh = (tid & 1) * 32;
#pragma unroll
      for (int j = 0; j < 4; ++j) { const int kb = kh + 8 * j; u32x4 w;
        w.x = pk2bf(lds_tile[(kb + 0) * 257 + n], lds_tile[(kb + 1) * 257 + n]); w.y = pk2bf(lds_tile[(kb + 2) * 257 + n], lds_tile[(kb + 3) * 257 + n]);
        w.z = pk2bf(lds_tile[(kb + 4) * 257 + n], lds_tile[(kb + 5) * 257 + n]); w.w = pk2bf(lds_tile[(kb + 6) * 257 + n], lds_tile[(kb + 7) * 257 + n]);
        *(u32x4*)(dst + (size_t)(n0 + n) * K + k0 + kb) = w; } }
}

__device__ __forceinline__ void rmsnorm_rows(const float* __restrict__ X, bf16_t* __restrict__ Y, int nrows) {
    const int wid = TIDX() >> 6, lane = TIDX() & 63;
    for (int row = blockIdx.x * 8 + wid; row < nrows; row += gridDim.x * 8) {
        const float* xr = X + (size_t)row * DM; f32x4 v[8]; float ss = 0.f;
#pragma unroll
        for (int i = 0; i < 8; ++i) { v[i] = *(const f32x4*)(xr + 4 * lane + 256 * i); ss += v[i][0] * v[i][0] + v[i][1] * v[i][1] + v[i][2] * v[i][2] + v[i][3] * v[i][3]; }
        ss = wave_sum(ss); const float r = rsqrtf(ss * (1.f / DM) + EPS);
        bf16_t* yr = Y + (size_t)row * DM;
#pragma unroll
        for (int i = 0; i < 8; ++i) { u32x2 w; w.x = pk2bf(v[i][0] * r, v[i][1] * r); w.y = pk2bf(v[i][2] * r, v[i][3] * r); *(u32x2*)(yr + 4 * lane + 256 * i) = w; }
    }
}

__device__ __forceinline__ void rmsnorm_rows16(const bf16_t* __restrict__ X, bf16_t* __restrict__ Y, int nrows) {
    const int wid = TIDX() >> 6, lane = TIDX() & 63;
    for (int row = blockIdx.x * 8 + wid; row < nrows; row += gridDim.x * 8) {
        const bf16_t* xr = X + (size_t)row * DM; float v[4][8]; float ss = 0.f;
#pragma unroll
        for (int i = 0; i < 4; ++i) { ld8f(xr + 8 * lane + 512 * i, v[i]);
#pragma unroll
            for (int j = 0; j < 8; ++j) ss += v[i][j] * v[i][j]; }
        ss = wave_sum(ss); const float r = rsqrtf(ss * (1.f / DM) + EPS);
        bf16_t* yr = Y + (size_t)row * DM;
#pragma unroll
        for (int i = 0; i < 4; ++i) { float o[8];
#pragma unroll
            for (int j = 0; j < 8; ++j) o[j] = v[i][j] * r;
            st8f(yr + 8 * lane + 512 * i, o); }
    }
}

__device__ __forceinline__ void rows_bf16_ssq(const float* __restrict__ X, bf16_t* __restrict__ Y, float* __restrict__ ssq, int nrows) {
    const int wid = TIDX() >> 6, lane = TIDX() & 63;
    for (int row = blockIdx.x * 8 + wid; row < nrows; row += gridDim.x * 8) {
        const float* xr = X + (size_t)row * DM; bf16_t* yr = Y + (size_t)row * DM; float ss = 0.f;
#pragma unroll
        for (int i = 0; i < 8; ++i) { const f32x4 v = *(const f32x4*)(xr + 4 * lane + 256 * i); ss += v[0] * v[0] + v[1] * v[1] + v[2] * v[2] + v[3] * v[3];
            u32x2 w; w.x = pk2bf(v[0], v[1]); w.y = pk2bf(v[2], v[3]); *(u32x2*)(yr + 4 * lane + 256 * i) = w; }
        ss = wave_sum(ss); if (lane < 32) ssq[(size_t)row * 32 + lane] = (lane == 0) ? ss : 0.f;
    }
}
__device__ __forceinline__ void phase_prologue1(const Params& P, char* lds) {
    float* tile = (float*)lds;
    constexpr int T_IN = (DM / 64) * (NPAD / 256), T_OUT = (MIX / 64) * (DM / 256), T_KV = (DM / 64) * (1024 / 256), T_GLU = 8 * 2;
    constexpr int TOT = DEPTH * (T_IN + T_OUT + T_KV + T_GLU);
    for (int u = blockIdx.x; u < TOT; u += gridDim.x) {
        int l = u / (T_IN + T_OUT + T_KV + T_GLU), r = u % (T_IN + T_OUT + T_KV + T_GLU);
        if (r < T_IN) transpose_tiles(P.w_in + (size_t)l * DM * NIN, DM, NIN, NPAD, P.ln_gain + l * DM, P.WinT_() + (size_t)l * NPAD * DM, r, tile);
        else if ((r -= T_IN) < T_OUT) transpose_tiles(P.w_out + (size_t)l * MIX * DM, MIX, DM, DM, P.out_norm + l * MIX, P.WoutT_() + (size_t)l * DM * MIX, r, tile);
        else if ((r -= T_OUT) < T_KV) transpose_tiles(P.w_mem_kv + (size_t)l * DM * 1024, DM, 1024, 1024, P.mem_norm + l * DM, P.WkvT_() + (size_t)l * 1024 * DM, r, tile);
        else { r -= T_KV; transpose_tiles(P.s5_w_glu + (size_t)l * 512 * 512, 512, 512, 512, nullptr, P.WgluT_() + (size_t)l * 512 * 512, r, tile); }
    }
    rmsnorm_rows(P.mem, P.memn_(), NB * MEML);
}
__device__ __forceinline__ void phase_rope_table(const Params& P) {
    for (int idx = blockIdx.x * NTHR + TIDX(); idx < NTOK * 24; idx += gridDim.x * NTHR) {
        const int tok = idx / 24, i = idx % 24;
        const float e = (i < 16) ? -((float)i * 2.0f / 32.0f) : -((float)(i - 16) * 2.0f / 16.0f);
        const float inv_freq = exp2f(e * 18.931568569324174f);
        const float ang = (float)P.pos[tok] * inv_freq;
        const double a = (double)ang; const double k = rint(a * 0.15915494309189535); const float rf = (float)fma(-k, 6.283185307179586, a);
        P.rope_()[(size_t)idx * 2] = cosf(rf); P.rope_()[(size_t)idx * 2 + 1] = sinf(rf);
    }
}

__device__ __forceinline__ void phase_rmsnorm_x(const Params& P, int layer) { if (layer == 0) rmsnorm_rows(P.x, P.xn_(), NTOK); else rmsnorm_rows16(P.xbuf_(), P.xn_(), NTOK); }

__device__ __forceinline__ void phase_memk_norm(const Params& P) {
    const int wid = TIDX() >> 6, lane = TIDX() & 63;
    for (int it = blockIdx.x * 8 + wid; it < NB * MEML * DEPTH * 4; it += gridDim.x * 8) {
        const int row = it / (DEPTH * 4), l = (it / 4) % DEPTH, h = it % 4;
        bf16_t* kp = P.kvmem_() + (size_t)row * (DEPTH * 1024) + l * 1024 + h * 128 + 2 * lane;
        const unsigned w = *(const unsigned*)kp; const float a = __uint_as_float(w << 16), b = __uint_as_float(w & 0xffff0000u);
        const float ss = wave_sum(a * a + b * b), r = rsqrtf(ss * (1.f / 128.f) + EPS);
        const float* g = P.mem_k_norm + l * 128 + 2 * lane;
        *(unsigned*)kp = pk2bf(a * r * g[0], b * r * g[1]);
    }
}

__device__ __forceinline__ float sum16(float v) { v += shx(v, 1); v += shx(v, 2); v += shx(v, 4); v += shx(v, 8); return v; }

__device__ __forceinline__ void head128_norm_rope_to(const bf16_t* hp, bf16_t* dp, int l16, const float* __restrict__ gain, const float* __restrict__ cs, bool rope, bool do_store) {
    float v[8]; ld8f(hp + 8 * l16, v);
    float ss = 0.f;
#pragma unroll
    for (int j = 0; j < 8; ++j) ss += v[j] * v[j];
    ss = sum16(ss); const float r = rsqrtf(ss * (1.f / 128.f) + EPS);
#pragma unroll
    for (int j = 0; j < 8; ++j) v[j] = v[j] * r * gain[8 * l16 + j];
    if (rope) {
        float o[8];
#pragma unroll
        for (int j = 0; j < 8; ++j) o[j] = shx(v[j], 2);
        if (l16 < 4) { const int fi = (l16 & 1) * 8;
#pragma unroll
            for (int j = 0; j < 8; ++j) { const float c = cs[(fi + j) * 2], s = cs[(fi + j) * 2 + 1];
                v[j] = (l16 < 2) ? (v[j] * c - o[j] * s) : (v[j] * c + o[j] * s); } }
    }
    if (do_store) st8f(dp + 8 * l16, v);
}
__device__ __forceinline__ void head128_norm_rope(bf16_t* hp, int l16, const float* __restrict__ gain, const float* __restrict__ cs, bool rope, bool do_store) { head128_norm_rope_to(hp, hp, l16, gain, cs, rope, do_store); }
__device__ __forceinline__ void rope16_inplace(bf16_t* ip, const float* __restrict__ cs) {
    float a[8], b[8]; ld8f(ip, a); ld8f(ip + 8, b);
#pragma unroll
    for (int j = 0; j < 8; ++j) { const float c = cs[2 * j], s = cs[2 * j + 1], x1 = a[j], x2 = b[j]; a[j] = x1 * c - x2 * s; b[j] = x2 * c + x1 * s; }
    st8f(ip, a); st8f(ip + 8, b);
}
struct PrepIn { u32x4 k, i0, i1, ik0, ik1, v; bf16_t w; f32x4 c32[4], c16[4]; };
__device__ __forceinline__ void prep_load(const Params& P, int tok, int lane, PrepIn& I) {
    const int l16 = lane & 15, grp = lane >> 4;
    const bf16_t* row = P.p_() + (size_t)tok * NPAD;
    I.k = *(const u32x4*)(row + C_DK + 8 * l16);
    I.i0 = *(const u32x4*)(row + C_DIQ + (lane >> 2) * 64); I.i1 = *(const u32x4*)(row + C_DIQ + (lane >> 2) * 64 + 8);
    I.ik0 = *(const u32x4*)(row + C_DIK + (lane & 3) * 16); I.ik1 = *(const u32x4*)(row + C_DIK + (lane & 3) * 16 + 8);
    I.v = *(const u32x4*)(row + C_DV + l16 * 8);
    I.w = row[C_DIW + l16];
    const float* cs32 = P.rope_() + (size_t)tok * 48;
#pragma unroll
    for (int i = 0; i < 4; ++i) { I.c32[i] = *(const f32x4*)(cs32 + (l16 & 1) * 16 + 4 * i); I.c16[i] = *(const f32x4*)(cs32 + 32 + 4 * i); }
}
__device__ __forceinline__ void unpack8(const u32x4 w, float (&v)[8]) {
    v[0] = __uint_as_float(w.x << 16); v[1] = __uint_as_float(w.x & 0xffff0000u); v[2] = __uint_as_float(w.y << 16); v[3] = __uint_as_float(w.y & 0xffff0000u);
    v[4] = __uint_as_float(w.z << 16); v[5] = __uint_as_float(w.z & 0xffff0000u); v[6] = __uint_as_float(w.w << 16); v[7] = __uint_as_float(w.w & 0xffff0000u); }
__device__ __forceinline__ void head128_nr(float (&v)[8], int l16, const float (&gain)[8], const f32x4 (&cs)[4], bool rope) {
    float ss = 0.f;
#pragma unroll
    for (int j = 0; j < 8; ++j) ss += v[j] * v[j];
    ss = sum16(ss); const float r = rsqrtf(ss * (1.f / 128.f) + EPS);
#pragma unroll
    for (int j = 0; j < 8; ++j) v[j] = v[j] * r * gain[j];
    if (rope) {
        float o[8];
#pragma unroll
        for (int j = 0; j < 8; ++j) o[j] = shx(v[j], 2);
        if (l16 < 4) {
#pragma unroll
            for (int j = 0; j < 8; ++j) { const float c = cs[j >> 1][(j & 1) * 2], s = cs[j >> 1][(j & 1) * 2 + 1];
                v[j] = (l16 < 2) ? (v[j] * c - o[j] * s) : (v[j] * c + o[j] * s); } }
    }
}
__device__ __forceinline__ void prep_finish(const Params& P, int tok, int lane, const PrepIn& I, const float (&gq)[8], const float (&gk)[8], const float (&gm)[8]) {
    const int l16 = lane & 15, grp = lane >> 4;
    bf16_t* row = P.p_() + (size_t)tok * NPAD;
    float k[8];
    unpack8(I.k, k);
    head128_nr(k, l16, gk, I.c32, true);
    if (grp == 0) st8f(P.kvc_() + (size_t)tok * 256 + 8 * l16, k);
    {
        float a[8], b[8]; unpack8(I.i0, a); unpack8(I.i1, b);
#pragma unroll
        for (int j = 0; j < 8; ++j) { const float c = I.c16[j >> 1][(j & 1) * 2], s = I.c16[j >> 1][(j & 1) * 2 + 1], x1 = a[j], x2 = b[j]; a[j] = x1 * c - x2 * s; b[j] = x2 * c + x1 * s; }
        if ((lane & 3) == 0) { st8f(row + C_DIQ + (lane >> 2) * 64, a); st8f(row + C_DIQ + (lane >> 2) * 64 + 8, b); } }
    {
        float a[8], b[8]; unpack8(I.ik0, a); unpack8(I.ik1, b);
        if ((lane & 3) == 0) {
#pragma unroll
            for (int j = 0; j < 8; ++j) { const float c = I.c16[j >> 1][(j & 1) * 2], s = I.c16[j >> 1][(j & 1) * 2 + 1], x1 = a[j], x2 = b[j]; a[j] = x1 * c - x2 * s; b[j] = x2 * c + x1 * s; } }
        if (lane < 4) { bf16_t* dst = P.ikc_() + (size_t)(tok >> 5) * 2048 + lane * 512 + (tok & 31) * 8; st8f(dst, a); st8f(dst + 256, b); } }
    if (lane >= 16 && lane < 32) *(u32x4*)(P.kvc_() + (size_t)tok * 256 + 128 + l16 * 8) = I.v;
    if (lane < 16) P.iw_()[(size_t)tok * 16 + lane] = bf2f(I.w) * (1.f / 32.f);
}
__device__ __forceinline__ void phase_prep(const Params& P, int layer) {
    const int wid = TIDX() >> 6, lane = TIDX() & 63, l16 = lane & 15;
    float gq[8], gk[8], gm[8];
#pragma unroll
    for (int j = 0; j < 8; ++j) { gq[j] = P.dsa_q_norm[layer * 128 + 8 * l16 + j]; gk[j] = P.dsa_k_norm[layer * 128 + 8 * l16 + j]; gm[j] = P.mem_q_norm[layer * 128 + 8 * l16 + j]; }
    const int stride = gridDim.x * 8;
    for (int tok = blockIdx.x * 8 + wid; tok < NTOK; tok += 2 * stride) {
        const int tok2 = tok + stride; const bool two = tok2 < NTOK;
        PrepIn A, B2;
        prep_load(P, tok, lane, A); prep_load(P, two ? tok2 : tok, lane, B2);
        prep_finish(P, tok, lane, A, gq, gk, gm);
        if (two) prep_finish(P, tok2, lane, B2, gq, gk, gm);
    }
}
struct MemOutRow { const bf16_t* zb; bf16_t* gb;
    __device__ __forceinline__ const bf16_t* zrow(int r) const { return zb + (size_t)r * NPAD; } __device__ __forceinline__ bf16_t* grow(int r) const { return gb + (size_t)r * MIX; } };
__device__ __forceinline__ void unit_mem_attn(const Params& P, int layer, int u, char* lds) {
    const int b = u >> 6, h = (u >> 4) & 3, qb = u & 15, tok0 = b * SEQ + qb * 256;
    const int wid = TIDX() >> 6, lane = TIDX() & 63, r32 = lane & 31, hi = lane >> 5;
    const bf16_t* Qw = P.p_() + (size_t)(tok0 + wid * 32 + r32) * NPAD + C_MQ + h * 128 + hi * 8;
    const bf16_t* Kh = P.kvmem_() + (size_t)(b * MEML) * (DEPTH * 1024) + layer * 1024 + h * 128;
    MemOutRow ow; ow.zb = P.p_() + (size_t)(tok0 + wid * 32) * NPAD + C_MZ + h * 128; ow.gb = P.xn_() + (size_t)(tok0 + wid * 32) * MIX + 1536 + h * 128;
    att::attn_body<false, DEPTH * 1024, 512, 1, MemOutRow>(Qw, P.mem_q_norm + layer * 128, nullptr, Kh, MEML / 64, nullptr, 0u, ow, lds);
}

__device__ __forceinline__ void phase_gate(const Params& P, int c_lo, int c_hi) {
    const int wid = TIDX() >> 6, lane = TIDX() & 63;
    const int c0 = lane * 32;
    const int seg = c0 >> 9, zc = (seg == 0 ? C_GZ : seg == 1 ? C_SZ : seg == 2 ? C_DZ : C_MZ) + (c0 & 511);
    const bool act = (c0 >= c_lo) && (c0 < c_hi);
    for (int tok = blockIdx.x * 8 + wid; tok < NTOK; tok += gridDim.x * 8) {
        if (!act) { bf16_t* gz_ = P.xn_() + (size_t)tok * MIX + c0; const u32x4 zz = {0u, 0u, 0u, 0u};
#pragma unroll
            for (int i = 0; i < 4; ++i) *(u32x4*)(gz_ + 8 * i) = zz;
            continue; }
        const bf16_t* op = P.ocat_() + (size_t)tok * MIX + c0; const bf16_t* zp = P.p_() + (size_t)tok * NPAD + zc; bf16_t* gp = P.xn_() + (size_t)tok * MIX + c0;
        float o[32]; float ss = 0.f;
#pragma unroll
        for (int i = 0; i < 4; ++i) { float v[8]; ld8f(op + 8 * i, v);
#pragma unroll
            for (int j = 0; j < 8; ++j) { o[8 * i + j] = v[j]; ss += v[j] * v[j]; } }
        ss += shx(ss, 1); ss += shx(ss, 2);
        const float r = rsqrtf(ss * (1.f / 128.f) + EPS);
#pragma unroll
        for (int i = 0; i < 4; ++i) { float z[8], g[8]; ld8f(zp + 8 * i, z);
#pragma unroll
            for (int j = 0; j < 8; ++j) g[j] = o[8 * i + j] * r * siluf_(z[j]);
            st8f(gp + 8 * i, g); }
    }
}

__device__ __forceinline__ void phase_gemm_in(const Params& P, int layer, char* lds) {
    pg8::Gemm g; g.A = P.xn_(); g.Bt = P.WinT_() + (size_t)layer * NPAD * DM; g.M = NTOK; g.N = NPAD; g.K = DM;
    pg8::StaticOrder S; S.init(g.M, g.N, (int)gridDim.x, (int)blockIdx.x);
    pg8::EpiBf16Plain E; E.O = P.p_(); E.ldc = NPAD;
    pg8::gemm_phase<pg8::EpiBf16Plain, pg8::StaticOrder, false>((PG8_LAS unsigned char*)lds, g, S, E, nullptr);
}
__device__ __forceinline__ void phase_gemm_out(const Params& P, int layer, char* lds) {
    pg8::Gemm g; g.A = P.xn_(); g.Bt = P.WoutT_() + (size_t)layer * DM * MIX; g.M = NTOK; g.N = DM; g.K = MIX;
    pg8::StaticOrder S; S.init(g.M, g.N, (int)gridDim.x, (int)blockIdx.x);
    pg8::EpiResidMix E; E.R = (layer == 0) ? (const void*)P.x : (const void*)P.xbuf_(); E.C = (layer == DEPTH - 1) ? (void*)P.out : (void*)P.xbuf_(); E.ldc = DM;
    E.r16 = (layer != 0); E.c16 = (layer != DEPTH - 1);
    pg8::gemm_phase<pg8::EpiResidMix, pg8::StaticOrder, false>((PG8_LAS unsigned char*)lds, g, S, E, nullptr);
}
__device__ __forceinline__ void phase_gemm_kv(const Params& P, char* lds) {
    pg8::Gemm g; g.A = P.memn_(); g.Bt = P.WkvT_(); g.M = NB * MEML; g.N = DEPTH * 1024; g.K = DM;
    pg8::StaticOrder S; S.init(g.M, g.N, (int)gridDim.x, (int)blockIdx.x);
    pg8::EpiBf16Plain E; E.O = P.kvmem_(); E.ldc = DEPTH * 1024;
    pg8::gemm_phase<pg8::EpiBf16Plain, pg8::StaticOrder, false>((PG8_LAS unsigned char*)lds, g, S, E, nullptr);
}
__device__ __forceinline__ void mma_tile(f32x16& acc, const char* A, int lda, const char* B, int ldb, int K, int lane) {
    const int r = lane & 31, kh = lane >> 5;
    const char* ap = A + r * lda + kh * 16; const char* bp = B + r * ldb + kh * 16;
    asm volatile("" : "+v"(acc));
    for (int k = 0; k < K; k += 16) {
        const bf16x8 a = *(const bf16x8*)(ap + k * 2); const bf16x8 b = *(const bf16x8*)(bp + k * 2);
        acc = __builtin_amdgcn_mfma_f32_32x32x16_bf16(a, b, acc, 0, 0, 0);
    }
}
__device__ __forceinline__ int crow32(int r, int hi) { return (r & 3) + 8 * (r >> 2) + 4 * hi; }
__device__ __forceinline__ float log_sigmoid_(float x) { return fminf(x, 0.f) - log1pf(__expf(-fabsf(x))); }

constexpr int GLA_ST = 144;
constexpr int GC_BST = 68;
constexpr int GC_B_BYTES = 4 * 64 * GC_BST * 4, GC_V_BYTES = 4 * 16384;
__device__ __forceinline__ float* gla_gb(const Params& P) { return (float*)((char*)P.ocat_() + (size_t)32 * 1024 * 1024); }
__device__ __forceinline__ float log_sigmoid_fast(float x) { return fminf(x, 0.f) - __logf(1.f + __expf(-fabsf(x))); }

__device__ __forceinline__ void unit_gla_a4(const Params& P, int layer, int ub, char* lds) {
    const int b = ub >> 6, n = ub & 63, tok0 = b * SEQ + n * 64;
    const int tid = TIDX(), wid = tid >> 6, lane = tid & 63, r32 = lane & 31, hi = lane >> 5, h = wid >> 1, eh = wid & 1;
    float* b_s = (float*)lds;
    char* V_s = lds;
    char* K_s = lds + GC_B_BYTES;
    float* glr_s = (float*)(lds + GC_B_BYTES + GC_V_BYTES);
    float* tot_s = glr_s + 1024;
    __syncthreads();
    const bf16_t* prow = P.p_() + (size_t)tok0 * NPAD;
    const bf16x8 glr_raw = *(const bf16x8*)(prow + (size_t)((tid & 127) >> 1) * NPAD + C_GLR + (tid & 1) * 8);
    const int gd = tid & 63, gh = (tid >> 6) & 3, gt = tid >> 8;
    float wu[16];
#pragma unroll
    for (int r = 0; r < 16; ++r) wu[r] = P.gla_w_up[((size_t)layer * 16 + r) * 256 + gh * 64 + gd];
    const float bias = P.gla_b_up[layer * 256 + gh * 64 + gd];
    bf16x8 kraw[4], vs[4][2];
    const int ks_ = tid >> 3, kc = (tid & 7) * 8;
#pragma unroll
    for (int hv = 0; hv < 4; ++hv) kraw[hv] = *(const bf16x8*)(prow + (size_t)ks_ * NPAD + C_GK + hv * 64 + kc);
    const int sr = tid >> 4, sc = (tid & 15) * 8;
#pragma unroll
    for (int hv = 0; hv < 4; ++hv) { vs[hv][0] = *(const bf16x8*)(prow + (size_t)sr * NPAD + C_GV + hv * 128 + sc); vs[hv][1] = *(const bf16x8*)(prow + (size_t)(32 + sr) * NPAD + C_GV + hv * 128 + sc); }
    if (tid < 128) {
#pragma unroll
        for (int j = 0; j < 8; ++j) glr_s[(tid >> 1) * 16 + (tid & 1) * 8 + j] = bf2f((bf16_t)glr_raw[j]); }
    __syncthreads();
    float gv[32]; float run = 0.f;
#pragma unroll
    for (int i = 0; i < 32; ++i) { const float* gr = glr_s + (gt * 32 + i) * 16; float a = bias;
#pragma unroll
        for (int r4 = 0; r4 < 4; ++r4) { const f32x4 g4 = *(const f32x4*)(gr + 4 * r4); a = fmaf(g4[0], wu[4 * r4], a); a = fmaf(g4[1], wu[4 * r4 + 1], a); a = fmaf(g4[2], wu[4 * r4 + 2], a); a = fmaf(g4[3], wu[4 * r4 + 3], a); }
        run += log_sigmoid_fast(a) * (1.f / 16.f); gv[i] = run; }
    if (gt == 0) tot_s[gh * 64 + gd] = run;
    __syncthreads();
    { const float off = gt ? tot_s[gh * 64 + gd] : 0.f; float* bp = b_s + (gh * 64 + gt * 32) * GC_BST + gd;
      float* gp = gla_gb(P) + (size_t)(tok0 + gt * 32) * 256 + gh * 64 + gd;
#pragma unroll
      for (int i = 0; i < 32; ++i) { const float v = gv[i] + off; bp[i * GC_BST] = v; gp[(size_t)i * 256] = v; }
      if (gt) P.glad_()[((size_t)((b * 64 + n) * 4 + gh)) * 64 + gd] = __expf(gv[31] + off); }
    __syncthreads();
#pragma unroll
    for (int hv = 0; hv < 4; ++hv) { const float* br = b_s + (hv * 64 + ks_) * GC_BST + kc; const float* bl = b_s + (hv * 64 + 63) * GC_BST + kc;
        const f32x4 b0 = *(const f32x4*)br, b1 = *(const f32x4*)(br + 4), l0 = *(const f32x4*)bl, l1 = *(const f32x4*)(bl + 4);
        float e[8];
#pragma unroll
        for (int j = 0; j < 8; ++j) e[j] = bf2f((bf16_t)kraw[hv][j]) * __expf((j < 4 ? l0[j] : l1[j - 4]) - (j < 4 ? b0[j] : b1[j - 4]));
        u32x4 w = {att::cvtpk(e[0], e[1]), att::cvtpk(e[2], e[3]), att::cvtpk(e[4], e[5]), att::cvtpk(e[6], e[7])};
        *(u32x4*)(K_s + hv * 16384 + att::v_st(ks_, kc)) = w; }
    __syncthreads();
    { const int vst0 = att::v_st(sr, sc), vst1 = att::v_st(32 + sr, sc);
#pragma unroll
      for (int hv = 0; hv < 4; ++hv) { *(bf16x8*)(V_s + hv * 16384 + vst0) = vs[hv][0]; *(bf16x8*)(V_s + hv * 16384 + vst1) = vs[hv][1]; } }
    __syncthreads();
    const int vb = (int)(uintptr_t)(V_s + h * 16384) + att::v_rd_base(lane), kb = (int)(uintptr_t)(K_s + h * 16384) + att::v_rd_base(lane);
    f32x16 acc[2][2] = {};
    asm volatile("" : "+v"(acc[0][0]), "+v"(acc[0][1]), "+v"(acc[1][0]), "+v"(acc[1][1]));
#define GA_PK(L, H) (bf16x8){L[0], L[1], L[2], L[3], H[0], H[1], H[2], H[3]}
#define GA_STEP(KS) do { \
    const s16x4 k0l = att::tr_read<att::v_rd_off(0, KS, 0)>(kb), k0h = att::tr_read<att::v_rd_off(0, KS, 1)>(kb), k1l = att::tr_read<att::v_rd_off(1, KS, 0)>(kb), k1h = att::tr_read<att::v_rd_off(1, KS, 1)>(kb); \
    s16x4 v0l, v0h, v1l, v1h; \
    if (eh == 0) { v0l = att::tr_read<att::v_rd_off(0, KS, 0)>(vb); v0h = att::tr_read<att::v_rd_off(0, KS, 1)>(vb); v1l = att::tr_read<att::v_rd_off(1, KS, 0)>(vb); v1h = att::tr_read<att::v_rd_off(1, KS, 1)>(vb); } \
    else         { v0l = att::tr_read<att::v_rd_off(2, KS, 0)>(vb); v0h = att::tr_read<att::v_rd_off(2, KS, 1)>(vb); v1l = att::tr_read<att::v_rd_off(3, KS, 0)>(vb); v1h = att::tr_read<att::v_rd_off(3, KS, 1)>(vb); } \
    asm volatile("s_waitcnt lgkmcnt(0)" ::: "memory"); __builtin_amdgcn_sched_barrier(0); \
    acc[0][0] = __builtin_amdgcn_mfma_f32_32x32x16_bf16(GA_PK(v0l, v0h), GA_PK(k0l, k0h), acc[0][0], 0, 0, 0); \
    acc[0][1] = __builtin_amdgcn_mfma_f32_32x32x16_bf16(GA_PK(v0l, v0h), GA_PK(k1l, k1h), acc[0][1], 0, 0, 0); \
    acc[1][0] = __builtin_amdgcn_mfma_f32_32x32x16_bf16(GA_PK(v1l, v1h), GA_PK(k0l, k0h), acc[1][0], 0, 0, 0); \
    acc[1][1] = __builtin_amdgcn_mfma_f32_32x32x16_bf16(GA_PK(v1l, v1h), GA_PK(k1l, k1h), acc[1][1], 0, 0, 0); } while (0)
    GA_STEP(0); GA_STEP(1); GA_STEP(2); GA_STEP(3);
#undef GA_STEP
#undef GA_PK
    float* dst = P.glas_() + ((size_t)((b * 64 + n) * 4 + h)) * 8192;
#pragma unroll
    for (int et = 0; et < 2; ++et)
#pragma unroll
        for (int dt = 0; dt < 2; ++dt)
#pragma unroll
            for (int r = 0; r < 16; ++r) dst[((eh * 2 + et) * 32 + att::crow(r, hi)) * 64 + dt * 32 + r32] = acc[et][dt][r];
    __syncthreads();
}

__device__ __forceinline__ void gla_scan_slice(const Params& P, int idx) {
    {
        const int el = idx & 8191, d = idx & 63, h = (idx >> 13) & 3, b = idx >> 15;
        bf16_t* gst = P.ocat_();
        float S = 0.f;
        for (int n0 = 0; n0 < 64; n0 += 8) {
            float ds[8], dc[8];
#pragma unroll
            for (int i = 0; i < 8; ++i) { const size_t cu = (size_t)((b * 64 + n0 + i) * 4 + h); ds[i] = P.glas_()[cu * 8192 + el]; dc[i] = P.glad_()[cu * 64 + d]; }
#pragma unroll
            for (int i = 0; i < 8; ++i) { const size_t cu = (size_t)((b * 64 + n0 + i) * 4 + h); gst[cu * 8192 + el] = f2bf(S); S = fmaf(dc[i], S, ds[i]); }
        }
    }
}

__device__ __forceinline__ void unit_gla_c4(const Params& P, int layer, int ub, char* lds) {
    const int b = ub >> 6, n = ub & 63, tok0 = b * SEQ + n * 64;
    const int tid = TIDX(), wid = tid >> 6, lane = tid & 63, r32 = lane & 31, hi = lane >> 5, h = wid >> 1, rh = wid & 1;
    float* b_s = (float*)lds;
    char* V_s = lds + GC_B_BYTES;
    __syncthreads();
    const bf16_t* prow = P.p_() + (size_t)tok0 * NPAD;
    bf16x8 qraw[4], kraw[2][4], vs[4][2];
    const int sr = tid >> 4, sc = (tid & 15) * 8;
#pragma unroll
    for (int hv = 0; hv < 4; ++hv) { vs[hv][0] = *(const bf16x8*)(prow + (size_t)sr * NPAD + C_GV + hv * 128 + sc); vs[hv][1] = *(const bf16x8*)(prow + (size_t)(32 + sr) * NPAD + C_GV + hv * 128 + sc); }
    f32x4 braw[8];
    { const float* gp = gla_gb(P) + (size_t)tok0 * 256 + tid * 4;
#pragma unroll
      for (int i = 0; i < 8; ++i) braw[i] = *(const f32x4*)(gp + i * 2048); }
    { const bf16_t* qp = prow + (size_t)(rh * 32 + r32) * NPAD + C_GQ + h * 64 + hi * 8;
#pragma unroll
      for (int d0 = 0; d0 < 4; ++d0) qraw[d0] = *(const bf16x8*)(qp + d0 * 16);
#pragma unroll
      for (int sh = 0; sh < 2; ++sh) { const bf16_t* kp = prow + (size_t)(sh * 32 + r32) * NPAD + C_GK + h * 64 + hi * 8;
#pragma unroll
          for (int d0 = 0; d0 < 4; ++d0) kraw[sh][d0] = *(const bf16x8*)(kp + d0 * 16); } }
    bf16x8 sfr[4][4];
    { const bf16_t* sp = P.ocat_() + ((size_t)((b * 64 + n) * 4 + h)) * 8192 + r32 * 64 + hi * 8;
#pragma unroll
      for (int eb = 0; eb < 4; ++eb)
#pragma unroll
          for (int ds = 0; ds < 4; ++ds) sfr[eb][ds] = *(const bf16x8*)(sp + eb * 32 * 64 + ds * 16); }
    { const int vst0 = att::v_st(sr, sc), vst1 = att::v_st(32 + sr, sc);
#pragma unroll
      for (int hv = 0; hv < 4; ++hv) { *(bf16x8*)(V_s + hv * 16384 + vst0) = vs[hv][0]; *(bf16x8*)(V_s + hv * 16384 + vst1) = vs[hv][1]; } }
#pragma unroll
    for (int i = 0; i < 8; ++i) { const int c = tid + 512 * i, t = c >> 6, c4 = c & 63;
        *(f32x4*)(b_s + ((c4 >> 4) * 64 + t) * GC_BST + (c4 & 15) * 4) = braw[i]; }
    __syncthreads();
    const float* bh = b_s + h * 64 * GC_BST + hi * 8;
    bf16x8 qe[4], qb[4], ke[2][4];
#pragma unroll
    for (int d0 = 0; d0 < 4; ++d0) {
        const f32x4 m0 = *(const f32x4*)(bh + 32 * GC_BST + d0 * 16), m1 = *(const f32x4*)(bh + 32 * GC_BST + d0 * 16 + 4);
        const f32x4 q0 = *(const f32x4*)(bh + (rh * 32 + r32) * GC_BST + d0 * 16), q1 = *(const f32x4*)(bh + (rh * 32 + r32) * GC_BST + d0 * 16 + 4);
        float e1[8], e2[8];
#pragma unroll
        for (int j = 0; j < 8; ++j) { const float mv = j < 4 ? m0[j] : m1[j - 4], bq = j < 4 ? q0[j] : q1[j - 4]; const float q = bf2f((bf16_t)qraw[d0][j]) * 0.125f;
            e1[j] = q * __expf(bq - mv); e2[j] = q * __expf(bq); }
        { u32x4 w = {att::cvtpk(e1[0], e1[1]), att::cvtpk(e1[2], e1[3]), att::cvtpk(e1[4], e1[5]), att::cvtpk(e1[6], e1[7])}; qe[d0] = *reinterpret_cast<bf16x8*>(&w); }
        { u32x4 w = {att::cvtpk(e2[0], e2[1]), att::cvtpk(e2[2], e2[3]), att::cvtpk(e2[4], e2[5]), att::cvtpk(e2[6], e2[7])}; qb[d0] = *reinterpret_cast<bf16x8*>(&w); }
#pragma unroll
        for (int sh = 0; sh < 2; ++sh) {
            const f32x4 k0 = *(const f32x4*)(bh + (sh * 32 + r32) * GC_BST + d0 * 16), k1 = *(const f32x4*)(bh + (sh * 32 + r32) * GC_BST + d0 * 16 + 4);
            float e3[8];
#pragma unroll
            for (int j = 0; j < 8; ++j) { const float mv = j < 4 ? m0[j] : m1[j - 4], bk = j < 4 ? k0[j] : k1[j - 4]; e3[j] = bf2f((bf16_t)kraw[sh][d0][j]) * __expf(mv - bk); }
            u32x4 w = {att::cvtpk(e3[0], e3[1]), att::cvtpk(e3[2], e3[3]), att::cvtpk(e3[4], e3[5]), att::cvtpk(e3[6], e3[7])}; ke[sh][d0] = *reinterpret_cast<bf16x8*>(&w); }
    }
    f32x16 p0 = {}, p1 = {};
    asm volatile("" : "+v"(p0), "+v"(p1));
#pragma unroll
    for (int d0 = 0; d0 < 4; ++d0) { p0 = __builtin_amdgcn_mfma_f32_32x32x16_bf16(ke[0][d0], qe[d0], p0, 0, 0, 0); p1 = __builtin_amdgcn_mfma_f32_32x32x16_bf16(ke[1][d0], qe[d0], p1, 0, 0, 0); }
    { const int t = rh * 32 + r32;
#pragma unroll
      for (int r = 0; r < 16; ++r) { const int s0 = att::crow(r, hi); p0[r] = (s0 <= t) ? p0[r] : 0.f; p1[r] = (32 + s0 <= t) ? p1[r] : 0.f; } }
    bf16x8 pa0, pa1, pa2, pa3;
#define GC_PK4(Pv, BASE, OUT) do { unsigned a0 = att::cvtpk(Pv[BASE + 0], Pv[BASE + 1]), a1 = att::cvtpk(Pv[BASE + 2], Pv[BASE + 3]);   \
    unsigned b0 = att::cvtpk(Pv[BASE + 4], Pv[BASE + 5]), b1 = att::cvtpk(Pv[BASE + 6], Pv[BASE + 7]);                              \
    auto r0 = __builtin_amdgcn_permlane32_swap(a0, b0, false, false); auto r1 = __builtin_amdgcn_permlane32_swap(a1, b1, false, false); \
    u32x4 w = {r0[0], r1[0], r0[1], r1[1]}; OUT = *reinterpret_cast<bf16x8*>(&w); } while (0)
    GC_PK4(p0, 0, pa0); GC_PK4(p0, 8, pa1); GC_PK4(p1, 0, pa2); GC_PK4(p1, 8, pa3);
#undef GC_PK4
    f32x16 o[4] = {};
    asm volatile("" : "+v"(o[0]), "+v"(o[1]), "+v"(o[2]), "+v"(o[3]));
    att::pv_d0(o, (int)(uintptr_t)(V_s + h * 16384) + att::v_rd_base(lane), pa0, pa1, pa2, pa3);
#pragma unroll
    for (int eb = 0; eb < 4; ++eb)
#pragma unroll
        for (int ds = 0; ds < 4; ++ds) o[eb] = __builtin_amdgcn_mfma_f32_32x32x16_bf16(qb[ds], sfr[eb][ds], o[eb], 0, 0, 0);
    __syncthreads();
    float* og_s = (float*)lds + wid * (32 * 132);
#pragma unroll
    for (int r = 0; r < 16; ++r) {
#pragma unroll
        for (int eb = 0; eb < 4; ++eb) og_s[att::crow(r, hi) * 132 + eb * 32 + r32] = o[eb][r]; }
    asm volatile("" ::: "memory");
    { const int row = lane >> 1, half = lane & 1; const float* src = og_s + row * 132 + half * 64;
      f32x4 v[16]; float ss = 0.f;
#pragma unroll
      for (int i = 0; i < 16; ++i) { v[i] = *(const f32x4*)(src + 4 * i); ss += v[i][0] * v[i][0] + v[i][1] * v[i][1] + v[i][2] * v[i][2] + v[i][3] * v[i][3]; }
      ss += shx(ss, 1);
      const float rn = rsqrtf(ss * (1.f / 128.f) + EPS);
      const size_t tok = (size_t)(tok0 + rh * 32 + row);
      const bf16_t* zp = P.p_() + tok * NPAD + C_GZ + h * 128 + half * 64; bf16_t* gp = P.xn_() + tok * MIX + h * 128 + half * 64;
#pragma unroll
      for (int i = 0; i < 8; ++i) { float z[8], g[8]; ld8f(zp + 8 * i, z);
#pragma unroll
          for (int q = 0; q < 4; ++q) { g[q] = v[2 * i][q] * rn * siluf_(z[q]); g[4 + q] = v[2 * i + 1][q] * rn * siluf_(z[4 + q]); }
          st8f(gp + 8 * i, g); } }
    __syncthreads();
}
constexpr int S5P_STRIDE = 2304;
__device__ __forceinline__ void phase_s5_params(const Params& P) {
    for (int idx = blockIdx.x * NTHR + TIDX(); idx < DEPTH * 32 * 64; idx += gridDim.x * NTHR) {
        const int p = idx & 63, lg = idx >> 6;
        const float ar = P.s5_a_re[idx], ai = P.s5_a_im[idx], step = expf(P.s5_log_step[lg]);
        const float mag = expf(ar * step), th = ai * step;
        const float lr = mag * cosf(th), li = mag * sinf(th);
        float* o = P.s5p_() + (size_t)lg * S5P_STRIDE;
        o[2 * p] = lr; o[2 * p + 1] = li;
        { const float mag512 = expf(512.f * ar * step); const double a = 512.0 * (double)th; const double k = rint(a * 0.15915494309189535); const float rf = (float)fma(-k, 6.283185307179586, a);
          o[128 + 2 * p] = mag512 * cosf(rf); o[128 + 2 * p + 1] = mag512 * sinf(rf); }
        const float xr = lr - 1.f, xi = li, den = 1.f / (ar * ar + ai * ai);
        const float fr = (xr * ar + xi * ai) * den, fi = (xi * ar - xr * ai) * den;
        for (int c = 0; c < 16; ++c) { const float br = P.s5_b_re[(size_t)idx * 16 + c], bi = P.s5_b_im[(size_t)idx * 16 + c];
            o[256 + (p * 16 + c) * 2] = fr * br - fi * bi; o[256 + (p * 16 + c) * 2 + 1] = fr * bi + fi * br; }
    }
}
__device__ __forceinline__ float gelu_tanh_(float x) { const float u = 0.7978845608028654f * (x + 0.044715f * x * x * x); const float e = __expf(-2.f * fabsf(u)); const float th = copysignf((1.f - e) / (1.f + e), u); return 0.5f * x * (1.f + th); }

constexpr int S5_XST = 272;
constexpr int S5_UST = 48;
__device__ __forceinline__ float partner32(float v, int hi) { auto rr = __builtin_amdgcn_permlane32_swap(__float_as_uint(v), __float_as_uint(v), false, false); return __uint_as_float(hi ? rr[0] : rr[1]); }
struct S5Ctx { float l0r, l0i, l1r, l1i, q0r, q0i, q1r, q1i, dsk; char* Cm; char* Bb; char* Xs; char* Us; int lane, hi, j, rho; const bf16_t* ubase; bf16_t* ybase; };
template <bool OUT> __device__ __forceinline__ void s5_tile(const S5Ctx& C, int tok0, float& x0r, float& x0i, float& x1r, float& x1i) {
    const int hi = C.hi, j = C.j, lane = C.lane;
    if (hi == 0) { const bf16_t* up = C.ubase + (size_t)(tok0 + j) * NPAD;
        const bf16x8 w0 = *(const bf16x8*)up, w1 = *(const bf16x8*)(up + 8);
        *(bf16x8*)(C.Us + C.rho * S5_UST) = w0; *(bf16x8*)(C.Us + C.rho * S5_UST + 16) = w1; }
    asm volatile("" ::: "memory");
    f32x16 a0 = {}, a1 = {}, a2 = {}, a3 = {};
    mma_tile(a0, C.Us, S5_UST, C.Bb, S5_UST, 16, lane); mma_tile(a1, C.Us, S5_UST, C.Bb + 32 * S5_UST, S5_UST, 16, lane);
    mma_tile(a2, C.Us, S5_UST, C.Bb + 64 * S5_UST, S5_UST, 16, lane); mma_tile(a3, C.Us, S5_UST, C.Bb + 96 * S5_UST, S5_UST, 16, lane);
    float s0r[16], s0i[16], s1r[16], s1i[16];
#pragma unroll
    for (int r = 0; r < 16; ++r) {
        const float n0r = fmaf(C.l0r, x0r, fmaf(-C.l0i, x0i, a0[r])), n0i = fmaf(C.l0r, x0i, fmaf(C.l0i, x0r, a1[r])); x0r = n0r; x0i = n0i; s0r[r] = n0r; s0i[r] = n0i;
        const float n1r = fmaf(C.l1r, x1r, fmaf(-C.l1i, x1i, a2[r])), n1i = fmaf(C.l1r, x1i, fmaf(C.l1i, x1r, a3[r])); x1r = n1r; x1i = n1i; s1r[r] = n1r; s1i[r] = n1i; }
    float z0r = partner32(x0r, hi), z0i = partner32(x0i, hi), z1r = partner32(x1r, hi), z1i = partner32(x1i, hi);
    if (hi == 0) { z0r = 0.f; z0i = 0.f; z1r = 0.f; z1i = 0.f; }
    if (!OUT) {
        x0r += C.q0r * z0r - C.q0i * z0i; x0i += C.q0r * z0i + C.q0i * z0r; x1r += C.q1r * z1r - C.q1i * z1i; x1i += C.q1r * z1i + C.q1i * z1r;
    } else {
#pragma unroll
        for (int r = 0; r < 16; ++r) {
            const float t0r = C.l0r * z0r - C.l0i * z0i, t0i = C.l0r * z0i + C.l0i * z0r; z0r = t0r; z0i = t0i; s0r[r] += t0r; s0i[r] += t0i;
            const float t1r = C.l1r * z1r - C.l1i * z1i, t1i = C.l1r * z1i + C.l1i * z1r; z1r = t1r; z1i = t1i; s1r[r] += t1r; s1i[r] += t1i; }
        x0r = s0r[15]; x0i = s0i[15]; x1r = s1r[15]; x1i = s1i[15];
#pragma unroll
        for (int r = 0; r < 16; ++r) { char* xr_ = C.Xs + (r + 16 * hi) * S5_XST;
            *(bf16_t*)(xr_ + j * 2) = f2bf(s0r[r]); *(bf16_t*)(xr_ + (64 + j) * 2) = f2bf(s0i[r]);
            *(bf16_t*)(xr_ + (32 + j) * 2) = f2bf(s1r[r]); *(bf16_t*)(xr_ + (96 + j) * 2) = f2bf(s1i[r]); }
        asm volatile("" ::: "memory");
        f32x16 acc = {}; mma_tile(acc, C.Xs, S5_XST, C.Cm, S5_XST, 128, lane);
        if (j < 16) {
#pragma unroll
            for (int r = 0; r < 16; ++r) { const int t = crow32(r, hi); const int rt = ((t & 15) & 3) + 8 * ((t & 15) >> 2) + 4 * (t >> 4);
                const float y = acc[r] + C.dsk * bf2f(*(const bf16_t*)(C.Us + rt * S5_UST + j * 2));
                C.ybase[(size_t)(tok0 + t) * 512 + j] = f2bf(gelu_tanh_(y)); } }
        asm volatile("" ::: "memory");
    }
    { const float e0r = partner32(x0r, hi), e0i = partner32(x0i, hi), e1r = partner32(x1r, hi), e1i = partner32(x1i, hi);
      if (hi == 0) { x0r = e0r; x0i = e0i; x1r = e1r; x1i = e1i; } else { x0r = 0.f; x0i = 0.f; x1r = 0.f; x1i = 0.f; } }
}
__device__ __forceinline__ void unit_s5(const Params& P, int layer, int u, char* lds) {
    const int b = u >> 5, g = u & 31, tid = TIDX(), wid = tid >> 6, lane = tid & 63, hi = lane >> 5, j = lane & 31;
    char* Cm = lds;
    char* Bb = Cm + 32 * S5_XST;
    float* ends = (float*)(Bb + 128 * S5_UST);
    char* wbase = (char*)(ends + 8 * 64 * 2) + wid * (32 * S5_XST + 32 * S5_UST);
    const float* sp = P.s5p_() + (size_t)(layer * 32 + g) * S5P_STRIDE;
    __syncthreads();
    for (int i = tid; i < 32 * 128; i += NTHR) { const int c = i >> 7, pp = i & 127; float v = 0.f;
        if (c < 16) v = (pp < 64) ? P.s5_c_re[((size_t)(layer * 32 + g) * 16 + c) * 64 + pp] : -P.s5_c_im[((size_t)(layer * 32 + g) * 16 + c) * 64 + (pp - 64)];
        *(bf16_t*)(Cm + c * S5_XST + pp * 2) = f2bf(v); }
    for (int i = tid; i < 128 * 16; i += NTHR) { const int n = i >> 4, c = i & 15, nt = n >> 5, jj = n & 31, p = (nt >> 1) * 32 + jj;
        *(bf16_t*)(Bb + n * S5_UST + c * 2) = f2bf(sp[256 + (p * 16 + c) * 2 + (nt & 1)]); }
    S5Ctx C; C.Cm = Cm; C.Bb = Bb; C.Xs = wbase; C.Us = wbase + 32 * S5_XST; C.lane = lane; C.hi = hi; C.j = j;
    C.l0r = sp[2 * j]; C.l0i = sp[2 * j + 1]; C.l1r = sp[2 * (32 + j)]; C.l1i = sp[2 * (32 + j) + 1];
    { float q0r = C.l0r, q0i = C.l0i, q1r = C.l1r, q1i = C.l1i;
#pragma unroll
      for (int k = 0; k < 4; ++k) { const float a = q0r * q0r - q0i * q0i, bb = (q0r + q0r) * q0i; q0r = a; q0i = bb; const float c = q1r * q1r - q1i * q1i, d = (q1r + q1r) * q1i; q1r = c; q1i = d; }
      C.q0r = q0r; C.q0i = q0i; C.q1r = q1r; C.q1i = q1i; }
    C.dsk = P.s5_d[layer * 512 + g * 16 + (lane & 15)];
    C.rho = ((j & 15) & 3) + 8 * ((j & 15) >> 2) + 4 * (j >> 4);
    const int tokw = b * SEQ + wid * 512;
    C.ubase = P.p_() + C_SU + g * 16; C.ybase = P.ybuf_() + g * 16;
    float x0r = 0.f, x0i = 0.f, x1r = 0.f, x1i = 0.f;
    __syncthreads();
    for (int sc = 0; sc < 16; ++sc) s5_tile<false>(C, tokw + sc * 32, x0r, x0i, x1r, x1i);
    if (hi == 0) { ends[(wid * 64 + j) * 2] = x0r; ends[(wid * 64 + j) * 2 + 1] = x0i; ends[(wid * 64 + 32 + j) * 2] = x1r; ends[(wid * 64 + 32 + j) * 2 + 1] = x1i; }
    __syncthreads();
    { const float p0r = sp[128 + 2 * j], p0i = sp[128 + 2 * j + 1], p1r = sp[128 + 2 * (32 + j)], p1i = sp[128 + 2 * (32 + j) + 1];
      x0r = 0.f; x0i = 0.f; x1r = 0.f; x1i = 0.f;
      for (int w = 0; w < wid; ++w) { const float e0r = ends[(w * 64 + j) * 2], e0i = ends[(w * 64 + j) * 2 + 1], e1r = ends[(w * 64 + 32 + j) * 2], e1i = ends[(w * 64 + 32 + j) * 2 + 1];
          const float n0r = p0r * x0r - p0i * x0i + e0r, n0i = p0r * x0i + p0i * x0r + e0i, n1r = p1r * x1r - p1i * x1i + e1r, n1i = p1r * x1i + p1i * x1r + e1i;
          x0r = n0r; x0i = n0i; x1r = n1r; x1i = n1i; }
      if (hi) { x0r = 0.f; x0i = 0.f; x1r = 0.f; x1i = 0.f; } }
    for (int sc = 0; sc < 16; ++sc) s5_tile<true>(C, tokw + sc * 32, x0r, x0i, x1r, x1i);
}
constexpr int TOPK = 256;
__device__ __forceinline__ unsigned f2key(float f) { const unsigned u = __float_as_uint(f); return u ^ ((u & 0x80000000u) ? 0xffffffffu : 0x80000000u); }

__device__ __forceinline__ float relu1(float x) { const int b = __float_as_int(x); return __int_as_float(b > 0 ? b : 0); }
#define DSA_MM(acc, rt, kk) acc = __builtin_amdgcn_mfma_f32_32x32x16_bf16(afr[rt][kk], bfr[kk], acc, 0, 0, 0)
#define DSA_HS(acc, rt, q) do { s0 = fmaf(relu1(acc[4 * (q)]), wv[rt][4 * (q)], s0); s1 = fmaf(relu1(acc[4 * (q) + 1]), wv[rt][4 * (q) + 1], s1); \
                                s0 = fmaf(relu1(acc[4 * (q) + 2]), wv[rt][4 * (q) + 2], s0); s1 = fmaf(relu1(acc[4 * (q) + 3]), wv[rt][4 * (q) + 3], s1); } while (0)
#define DSA_SG() do { __builtin_amdgcn_sched_group_barrier(0x8, 1, 0); __builtin_amdgcn_sched_group_barrier(0x2, 8, 0); } while (0)
__device__ __forceinline__ void dsa_score_tile(const bf16x8 (&afr)[4][4], const f32x16 (&wv)[4], const bf16x8 (&bfr)[4], float* sc, int col, int hi) {
    f32x16 accA = {}, accB = {}; asm volatile("" : "+v"(accA), "+v"(accB));
    float s0, s1;
    DSA_MM(accA, 0, 0); DSA_MM(accA, 0, 1); DSA_MM(accA, 0, 2); DSA_MM(accA, 0, 3);
    s0 = 0.f; s1 = 0.f;
    DSA_MM(accB, 1, 0); DSA_HS(accA, 0, 0); DSA_SG(); DSA_MM(accB, 1, 1); DSA_HS(accA, 0, 1); DSA_SG();
    DSA_MM(accB, 1, 2); DSA_HS(accA, 0, 2); DSA_SG(); DSA_MM(accB, 1, 3); DSA_HS(accA, 0, 3); DSA_SG();
    sc[(0 + hi) * 4096 + col] = (s0 + s1) + 0.f;
    accA = (f32x16){}; asm volatile("" : "+v"(accA)); s0 = 0.f; s1 = 0.f;
    DSA_MM(accA, 2, 0); DSA_HS(accB, 1, 0); DSA_SG(); DSA_MM(accA, 2, 1); DSA_HS(accB, 1, 1); DSA_SG();
    DSA_MM(accA, 2, 2); DSA_HS(accB, 1, 2); DSA_SG(); DSA_MM(accA, 2, 3); DSA_HS(accB, 1, 3); DSA_SG();
    sc[(2 + hi) * 4096 + col] = (s0 + s1) + 0.f;
    accB = (f32x16){}; asm volatile("" : "+v"(accB)); s0 = 0.f; s1 = 0.f;
    DSA_MM(accB, 3, 0); DSA_HS(accA, 2, 0); DSA_SG(); DSA_MM(accB, 3, 1); DSA_HS(accA, 2, 1); DSA_SG();
    DSA_MM(accB, 3, 2); DSA_HS(accA, 2, 2); DSA_SG(); DSA_MM(accB, 3, 3); DSA_HS(accA, 2, 3); DSA_SG();
    sc[(4 + hi) * 4096 + col] = (s0 + s1) + 0.f;
    s0 = 0.f; s1 = 0.f;
    DSA_HS(accB, 3, 0); DSA_HS(accB, 3, 1); DSA_HS(accB, 3, 2); DSA_HS(accB, 3, 3);
    sc[(6 + hi) * 4096 + col] = (s0 + s1) + 0.f;
}
#define DSA_CNT4(K0, K1, K2, K3) asm volatile( \
    "v_cmp_ge_u32_e64 %[m0], %[k0], %[cd]\n\tv_cmp_ge_u32_e64 %[m1], %[k1], %[cd]\n\tv_cmp_ge_u32_e64 %[m2], %[k2], %[cd]\n\tv_cmp_ge_u32_e64 %[m3], %[k3], %[cd]\n\t" \
    "v_addc_co_u32_e64 %[a0], %[m0], %[a0], 0, %[m0]\n\tv_addc_co_u32_e64 %[a1], %[m1], %[a1], 0, %[m1]\n\t" \
    "v_addc_co_u32_e64 %[a0], %[m2], %[a0], 0, %[m2]\n\tv_addc_co_u32_e64 %[a1], %[m3], %[a1], 0, %[m3]" \
    : [a0] "+v"(c0), [a1] "+v"(c1), [m0] "=&s"(sm0), [m1] "=&s"(sm1), [m2] "=&s"(sm2), [m3] "=&s"(sm3) \
    : [k0] "v"(K0), [k1] "v"(K1), [k2] "v"(K2), [k3] "v"(K3), [cd] "v"(cand))
#define DSA_CNT8(J0) do { DSA_CNT4(key[(J0)], key[(J0) + 1], key[(J0) + 2], key[(J0) + 3]); DSA_CNT4(key[(J0) + 4], key[(J0) + 5], key[(J0) + 6], key[(J0) + 7]); } while (0)

__device__ __forceinline__ void unit_dsa_index(const Params& P, int u, char* lds) {
    const int b = u & 3, t0 = (511 - (u >> 2)) * 8;
    const int tid = TIDX(), wid = tid >> 6, lane = tid & 63, r32 = lane & 31, hi = lane >> 5;
    float* sc = (float*)lds;
    const bf16_t* pb = P.p_() + (size_t)b * SEQ * NPAD;
    __syncthreads();
    TPU_START(101);
    {
        bf16x8 afr[4][4]; f32x16 wv[4];
        const int qsel = (r32 >> 2) & 1, head = (r32 & 3) + 4 * (r32 >> 3);
#pragma unroll
        for (int rt = 0; rt < 4; ++rt) { const bf16_t* qp = pb + (size_t)(t0 + 2 * rt + qsel) * NPAD + C_DIQ + head * 64 + hi * 8;
#pragma unroll
            for (int kk = 0; kk < 4; ++kk) afr[rt][kk] = *(const bf16x8*)(qp + kk * 16);
            const float* wp = P.iw_() + (size_t)(b * SEQ + t0 + 2 * rt + hi) * 16;
#pragma unroll
            for (int i = 0; i < 4; ++i) { const f32x4 w4 = *(const f32x4*)(wp + 4 * i); wv[rt][4 * i] = w4[0]; wv[rt][4 * i + 1] = w4[1]; wv[rt][4 * i + 2] = w4[2]; wv[rt][4 * i + 3] = w4[3]; } }
        const int ntile = (t0 + 7) / 32 + 1;
        const bf16_t* kp = P.ikc_() + (size_t)(b * (SEQ / 32)) * 2048 + lane * 8;
        bf16x8 b0[4], b1[4], b2[4];
#define DSA_LDB(dst, K) do { const bf16_t* kq_ = kp + (size_t)(wid + 8 * (K)) * 2048; _Pragma("unroll") for (int kk = 0; kk < 4; ++kk) dst[kk] = *(const bf16x8*)(kq_ + kk * 512); } while (0)
#define DSA_TILE(buf, K) dsa_score_tile(afr, wv, buf, sc, (wid + 8 * (K)) * 32 + r32, hi)
        const int nk = (ntile - wid + 7) >> 3;
        const int kl = nk > 0 ? nk - 1 : 0;
#define DSA_MIN(a) ((a) < kl ? (a) : kl)
        DSA_LDB(b0, DSA_MIN(0)); DSA_LDB(b1, DSA_MIN(1));
#if TPROBE == 103
        TPU_START(103); asm volatile("s_waitcnt vmcnt(0)" ::: "memory"); TPU_STOP(103);
#endif
#if TPROBE == 104
        asm volatile("s_waitcnt vmcnt(0)" ::: "memory"); TPU_START(104);
#endif
        int k = 0;
        for (; k + 3 <= nk; k += 3) {
            DSA_LDB(b2, k + 2); DSA_TILE(b0, k);
            DSA_LDB(b0, DSA_MIN(k + 3)); DSA_TILE(b1, k + 1);
            DSA_LDB(b1, DSA_MIN(k + 4)); DSA_TILE(b2, k + 2);
        }
        if (k < nk) DSA_TILE(b0, k);
        if (k + 1 < nk) DSA_TILE(b1, k + 1);
#if TPROBE == 104
        asm volatile("s_waitcnt lgkmcnt(0)" ::: "memory"); TPU_STOP(104);
#endif
#undef DSA_TILE
#undef DSA_MIN
#undef DSA_TILE
#undef DSA_LDB
    }
    __syncthreads();
    TPU_STOP(101); TPU_START(102);
    {
        const int t = t0 + wid; const float* srow = sc + wid * 4096;
        unsigned key[64];
#pragma unroll
        for (int j = 0; j < 64; ++j) { const int s = j * 64 + lane; key[j] = (s <= t) ? f2key(srow[s]) : 0u; }
        unsigned long long* mout = P.mask_() + (size_t)(b * SEQ + t) * 64;
        unsigned long long myword = 0ull;
        TPU_START(105); TPU_START(106); TPU_START(107); TPU_START(108); TPU_START(109);
        if (t + 1 <= TOPK) {
#pragma unroll
            for (int j = 0; j < 64; ++j) { const unsigned long long m = __ballot(j * 64 + lane <= t); if (lane == j) myword = m; }
        } else {
            const int ngrp = t / 512 + 1;
#if TPROBE == 105
            asm volatile("" :: "v"(key[0]), "v"(key[63]));
#endif
            TPU_STOP(105);
            unsigned* hist = (unsigned*)(sc + wid * 4096);
            asm volatile("" ::: "memory");
            { const u32x4 zz4 = {0u, 0u, 0u, 0u};
#pragma unroll
              for (int i = 0; i < 16; ++i) *(u32x4*)(hist + (i * 64 + lane) * 4) = zz4; }
            asm volatile("" ::: "memory");
#define DSA_H8(J0) do { _Pragma("unroll") for (int jj = 0; jj < 8; ++jj) atomicAdd(hist + (key[(J0) + jj] >> 20), 1u); } while (0)
            DSA_H8(0);
            if (ngrp > 1) DSA_H8(8);
            if (ngrp > 2) DSA_H8(16);
            if (ngrp > 3) DSA_H8(24);
            if (ngrp > 4) DSA_H8(32);
            if (ngrp > 5) DSA_H8(40);
            if (ngrp > 6) DSA_H8(48);
            if (ngrp > 7) DSA_H8(56);
#undef DSA_H8
            asm volatile("" ::: "memory");
#if TPROBE == 106
            asm volatile("s_waitcnt lgkmcnt(0)" ::: "memory");
#endif
            TPU_STOP(106);
#define DSA_SUFFIX(s) do { _Pragma("unroll") for (int o = 1; o < 64; o <<= 1) { unsigned t_ = (unsigned)__builtin_amdgcn_ds_bpermute(((lane + o) & 63) << 2, (int)(s)); (s) += (lane + o < 64) ? t_ : 0u; } } while (0)
            unsigned mine = 0u;
#pragma unroll
            for (int i = 0; i < 16; ++i) { const u32x4 v4 = *(const u32x4*)(hist + lane * 64 + ((i + lane) & 15) * 4); mine += (v4[0] + v4[1]) + (v4[2] + v4[3]); }
            unsigned suf = mine; DSA_SUFFIX(suf);
            const unsigned long long mL = __ballot(suf - mine < (unsigned)TOPK && suf >= (unsigned)TOPK);
            const int Ls = (int)__builtin_ctzll(mL);
            const unsigned cntA = (unsigned)__builtin_amdgcn_readlane((int)(suf - mine), Ls);
            unsigned h2 = hist[Ls * 64 + lane]; unsigned suf2 = h2; DSA_SUFFIX(suf2);
            const unsigned long long mB = __ballot(cntA + suf2 - h2 < (unsigned)TOPK && cntA + suf2 >= (unsigned)TOPK);
            const int Bs = (int)__builtin_ctzll(mB);
            const unsigned bstar = (unsigned)(Ls * 64 + Bs);
            const unsigned cntAbove = cntA + (unsigned)__builtin_amdgcn_readlane((int)(suf2 - h2), Bs);
            const unsigned inbin = (unsigned)__builtin_amdgcn_readlane((int)h2, Bs);
#undef DSA_SUFFIX
            TPU_STOP(107);
            unsigned T = bstar << 20; int cntT = (int)(cntAbove + inbin);
            if (cntT != TOPK) {
                asm volatile("" ::: "memory");
                int nslot = 0;
#pragma unroll
                for (int j = 0; j < 64; ++j) { if ((key[j] >> 20) == bstar) { hist[nslot * 64 + lane] = key[j]; ++nslot; } }
                asm volatile("" ::: "memory");
                int R = nslot;
#pragma unroll
                for (int o = 32; o >= 1; o >>= 1) { const int other = __builtin_amdgcn_ds_bpermute(((lane ^ o) << 2), R); R = other > R ? other : R; }
                R = __builtin_amdgcn_readfirstlane(R);
                if (R <= 8) {
                    unsigned c[8];
#pragma unroll
                    for (int r = 0; r < 8; ++r) c[r] = (r < nslot) ? hist[r * 64 + lane] : 0u;
                    for (int bit = 19; bit >= 0; --bit) {
                        const unsigned cand = T | (1u << bit); int cnt = (int)cntAbove;
#pragma unroll
                        for (int r = 0; r < 8; ++r) cnt += __popcll(__ballot(c[r] >= cand));
                        if (cnt >= TOPK) { T = cand; cntT = cnt; if (cnt == TOPK) break; }
                    }
                } else {
                    for (int bit = 19; bit >= 0; --bit) {
                        const unsigned cand = T | (1u << bit); unsigned c0 = 0, c1 = 0; unsigned long long sm0, sm1, sm2, sm3;
                        DSA_CNT8(0);
                        if (ngrp > 1) DSA_CNT8(8);
                        if (ngrp > 2) DSA_CNT8(16);
                        if (ngrp > 3) DSA_CNT8(24);
                        if (ngrp > 4) DSA_CNT8(32);
                        if (ngrp > 5) DSA_CNT8(40);
                        if (ngrp > 6) DSA_CNT8(48);
                        if (ngrp > 7) DSA_CNT8(56);
                        const int cl = (int)(c0 + c1);
                        int cnt = 0;
#pragma unroll
                        for (int bb = 0; bb < 7; ++bb) cnt += __popcll(__ballot((cl >> bb) & 1)) << bb;
                        if (cnt >= TOPK) { T = cand; cntT = cnt; if (cnt == TOPK) break; }
                    }
                }
            }
            TPU_STOP(108);
            if (cntT == TOPK) {
#pragma unroll
                for (int j = 0; j < 64; ++j) { const unsigned long long m = __ballot(key[j] >= T); if (lane == j) myword = m; }
            } else {
                int ngt = 0;
#pragma unroll
                for (int j = 0; j < 64; ++j) ngt += __popcll(__ballot(key[j] > T));
                int need = TOPK - ngt;
#pragma unroll
                for (int j = 0; j < 64; ++j) { const unsigned long long eq = __ballot(key[j] == T), gt = __ballot(key[j] > T);
                    const int ne = __popcll(eq); unsigned long long take = eq;
                    if (ne > need) { take = 0ull; int left = need; unsigned long long e2 = eq;
                        while (left > 0) { const unsigned long long lowbit = e2 & (0ull - e2); take |= lowbit; e2 ^= lowbit; --left; } }
                    need -= (ne > need) ? need : ne;
                    const unsigned long long m = gt | take; if (lane == j) myword = m; }
            }
        }
        mout[lane] = myword;
        TPU_STOP(109);
    }
    TPU_STOP(102);
}

struct DsaOutRow { const bf16_t* zb; bf16_t* gb; int wid;
    __device__ __forceinline__ const bf16_t* zrow(int r) const { const int rho = wid * 32 + r; return zb + (size_t)(rho >> 2) * NPAD + (rho & 3) * 128; }
    __device__ __forceinline__ bf16_t* grow(int r) const { const int rho = wid * 32 + r; return gb + (size_t)(rho >> 2) * MIX + (rho & 3) * 128; } };
__device__ __forceinline__ void unit_dsa_attn(const Params& P, int cur_layer, int u, char* lds) {
    const int b = u & 3, qb = 63 - (u >> 2), t0 = qb * 64, tokb = b * SEQ;
    const int wid = TIDX() >> 6, lane = TIDX() & 63, r32 = lane & 31, hi = lane >> 5;
    const int rho = wid * 32 + r32, tq = t0 + (rho >> 2), hq = rho & 3;
    const bf16_t* Qw = P.p_() + (size_t)(tokb + tq) * NPAD + C_DQ + hq * 128 + hi * 8;
    const bf16_t* Kh = P.kvc_() + (size_t)tokb * 256;
    const unsigned moff = (unsigned)(tokb + tq) * 512u;
    DsaOutRow ow; ow.zb = P.p_() + (size_t)(tokb + t0) * NPAD + C_DZ; ow.gb = P.xn_() + (size_t)(tokb + t0) * MIX + 1024; ow.wid = wid;
    const int NT = (qb + 2) & ~1;
    att::attn_body<true, 256, 128, 2, DsaOutRow>(Qw, P.dsa_q_norm + cur_layer * 128, P.rope_() + (size_t)(tokb + tq) * 48, Kh, NT, P.mask_(), moff, ow, lds);
}
__device__ __forceinline__ void phase_gemm_glu(const Params& P, int layer, char* lds) {
    pg8::Gemm g; g.A = P.ybuf_(); g.Bt = P.WgluT_() + (size_t)layer * 512 * 512; g.M = NTOK; g.N = 512; g.K = 512;
    pg8::StaticOrder S; S.init(g.M, g.N, (int)gridDim.x, (int)blockIdx.x);
    pg8::EpiGlu E; E.Y = P.ybuf_(); E.ldy = 512; E.O = P.ocat_(); E.ldo = MIX; E.ooff = 512;
    pg8::gemm_phase<pg8::EpiGlu, pg8::StaticOrder, false>((PG8_LAS unsigned char*)lds, g, S, E, nullptr);
}

constexpr int CTL_Q0 = 4096;
struct OneUnit { int pm, pn; __device__ __forceinline__ bool next(int i, pg8::Unit& u) const { if (i) return false; u.pm = pm; u.pn = pn; return true; }
    __device__ __forceinline__ void a_ready(const pg8::Unit&) const {} __device__ __forceinline__ void done(const pg8::Unit&) const {} };
__device__ __forceinline__ int q_issue(unsigned* ctr) { return (int)__hip_atomic_fetch_add(ctr, 1u, __ATOMIC_RELAXED, __HIP_MEMORY_SCOPE_AGENT); }
#define Q_LOOP_BEGIN(ctr, total)  { unsigned* q_ctr_ = (ctr); const int q_total_ = (total); volatile int* q_b_ = (volatile int*)(lds + LDS_TAIL + 16); \
    for (;;) { __syncthreads(); if (TIDX() == 0) *q_b_ = q_issue(q_ctr_); __syncthreads(); const int item = __builtin_amdgcn_readfirstlane(*q_b_); if (item >= q_total_) break;
#define Q_LOOP_END  } }
__device__ __forceinline__ void unit_glu(const Params& P, int layer, int u, char* lds) {
    pg8::Gemm g; g.A = P.ybuf_(); g.Bt = P.WgluT_() + (size_t)layer * 512 * 512; g.M = NTOK; g.N = 512; g.K = 512;
    OneUnit S; S.pm = u >> 1; S.pn = u & 1;
    pg8::EpiGluGate E; E.Y = P.ybuf_(); E.Pz = P.p_(); E.G = P.xn_();
    pg8::gemm_phase<pg8::EpiGluGate, OneUnit, false>((PG8_LAS unsigned char*)lds, g, S, E, nullptr);
}
constexpr int LDS_TAIL = LDS_BYTES - 64;

__global__ __launch_bounds__(NTHR, 2) void k_mega(Params P) {
    extern __shared__ __attribute__((aligned(16))) char lds[];
    if (TIDX() == 0) *(uint4*)(lds + LDS_TAIL) = make_uint4(0u, 0u, 0u, 0u);
    __syncthreads();
    XcdBarrier bar = xcd_barrier_post(P.ctl_(), (volatile LAS unsigned*)(lds + LDS_TAIL));
    const int G = gridDim.x, B = blockIdx.x;
    phase_prologue1(P, lds); phase_rope_table(P); phase_s5_params(P); phase_rmsnorm_x(P, 0);
    xcd_barrier(bar);
    for (int layer = 0; layer < DEPTH; ++layer) {
        if (layer > 0) { phase_rmsnorm_x(P, layer); xcd_barrier(bar); }
        phase_gemm_in(P, layer, lds);
        if (layer == 0) phase_gemm_kv(P, lds);
        xcd_barrier(bar);
        phase_prep(P, layer);
        if (layer == 0) phase_memk_norm(P);
        for (int u = B; u < 256; u += G) unit_gla_a4(P, layer, u, lds);
        xcd_barrier(bar);
        Q_LOOP_BEGIN(P.ctl_() + CTL_Q0 + 64 * (layer * 2), 128 + 2048 + 256)
            if (item < 128) unit_s5(P, layer, item, lds);
            else if (item < 2176) unit_dsa_index(P, item - 128, lds);
            else gla_scan_slice(P, (item - 2176) * NTHR + TIDX());
        Q_LOOP_END
        xcd_barrier(bar);
        Q_LOOP_BEGIN(P.ctl_() + CTL_Q0 + 64 * (layer * 2 + 1), 256 + 256 + 128 + 256)
            if (item < 256) unit_dsa_attn(P, layer, item, lds);
            else if (item < 512) unit_gla_c4(P, layer, item - 256, lds);
            else if (item < 640) unit_glu(P, layer, item - 512, lds);
            else unit_mem_attn(P, layer, item - 640, lds);
        Q_LOOP_END
        xcd_barrier(bar);
        phase_gemm_out(P, layer, lds);
        xcd_barrier(bar);
    }
}

extern "C" void kernel_launch(void* const* d_in, const int* in_sizes, int n_in, void* d_out, int out_size, void* d_ws, size_t ws_size, hipStream_t stream) {
    if (n_in != 24 || ws_size < WS_END) { fprintf(stderr, "kernel_launch: unexpected n_in %d or ws_size %zu (< %zu)\n", n_in, ws_size, (size_t)WS_END); return; }
    Params P; memset(&P, 0, sizeof(P));
    P.x = (const float*)d_in[0]; P.mem = (const float*)d_in[1]; P.pos = (const int*)d_in[2]; P.ln_gain = (const float*)d_in[3]; P.w_in = (const float*)d_in[4];
    P.gla_w_up = (const float*)d_in[5]; P.gla_b_up = (const float*)d_in[6]; P.s5_a_re = (const float*)d_in[7]; P.s5_a_im = (const float*)d_in[8]; P.s5_log_step = (const float*)d_in[9];
    P.s5_b_re = (const float*)d_in[10]; P.s5_b_im = (const float*)d_in[11]; P.s5_c_re = (const float*)d_in[12]; P.s5_c_im = (const float*)d_in[13]; P.s5_d = (const float*)d_in[14];
    P.s5_w_glu = (const float*)d_in[15]; P.dsa_q_norm = (const float*)d_in[16]; P.dsa_k_norm = (const float*)d_in[17]; P.mem_norm = (const float*)d_in[18]; P.w_mem_kv = (const float*)d_in[19];
    P.mem_q_norm = (const float*)d_in[20]; P.mem_k_norm = (const float*)d_in[21]; P.out_norm = (const float*)d_in[22]; P.w_out = (const float*)d_in[23];
    P.out = (float*)d_out;
    char* ws = (char*)d_ws; P.ws = ws;
    static int grid = 0;
    if (!grid) {
        int dev = 0, cus = 0, per_cu = 0;
        (void)hipGetDevice(&dev); (void)hipDeviceGetAttribute(&cus, hipDeviceAttributeMultiprocessorCount, dev);
        (void)hipFuncSetAttribute((const void*)k_mega, hipFuncAttributeMaxDynamicSharedMemorySize, LDS_BYTES);
        (void)hipOccupancyMaxActiveBlocksPerMultiprocessor(&per_cu, (const void*)k_mega, NTHR, LDS_BYTES);
        if (per_cu < 1) fprintf(stderr, "kernel_launch: occupancy query reports %d blocks per CU\n", per_cu);
        grid = cus > 0 ? cus : 256;
    }
    (void)hipMemsetAsync(ws + WS_CTL, 0, CTL_BYTES, stream);
    hipLaunchKernelGGL(k_mega, dim3(grid), dim3(NTHR), LDS_BYTES, stream, P);
}
```

```cpp
#include <hip/hip_runtime.h>
#include <stdint.h>
#include <stdio.h>
#include <string.h>

constexpr int NB = 4, SEQ = 4096, NTOK = NB * SEQ, DM = 2048, DEPTH = 4, MEML = 256;
constexpr int NIN = 5984, NPAD = 6144, MIX = 2048;
constexpr int C_GQ = 0, C_GK = 256, C_GV = 512, C_GLR = 1024, C_GZ = 1040, C_SU = 1552, C_SZ = 2064, C_DQ = 2576, C_DK = 3088, C_DV = 3216,
              C_DIQ = 3344, C_DIK = 4368, C_DIW = 4432, C_DZ = 4448, C_MQ = 4960, C_MZ = 5472;
constexpr float EPS = 1e-6f;
constexpr int NTHR = 512;
constexpr int LDS_BYTES = 147456;

typedef unsigned short bf16_t;
typedef short bf16x8 __attribute__((ext_vector_type(8)));
typedef short s16x4 __attribute__((ext_vector_type(4)));
typedef float f32x4 __attribute__((ext_vector_type(4)));
typedef float f32x8 __attribute__((ext_vector_type(8)));
typedef float f32x16 __attribute__((ext_vector_type(16)));
typedef unsigned u32x4 __attribute__((ext_vector_type(4)));
typedef unsigned u32x2 __attribute__((ext_vector_type(2)));
#define LAS __attribute__((address_space(3)))

__device__ __forceinline__ float bf2f(bf16_t b) { return __uint_as_float(((unsigned)b) << 16); }
__device__ __forceinline__ bf16_t f2bf(float f) { unsigned u = __float_as_uint(f); u += 0x7FFFu + ((u >> 16) & 1u); return (bf16_t)(u >> 16); }
__device__ __forceinline__ unsigned pk2bf(float lo, float hi) { return (unsigned)f2bf(lo) | ((unsigned)f2bf(hi) << 16); }
__device__ __forceinline__ float sigmoidf_(float x) { return 1.f / (1.f + __expf(-x)); }
__device__ __forceinline__ float siluf_(float x) { return x / (1.f + __expf(-x)); }

__device__ __forceinline__ int TIDX() { int t = (int)threadIdx.x; asm volatile("" : "+v"(t)); return t; }
__device__ __forceinline__ float shx(float v, int m) { const int src = ((TIDX() & 63) ^ m) << 2; return __int_as_float(__builtin_amdgcn_ds_bpermute(src, __float_as_int(v))); }
__device__ __forceinline__ float wave_sum(float v) {
#pragma unroll
    for (int o = 32; o >= 1; o >>= 1) v += shx(v, o);
    return v;
}
__device__ __forceinline__ void ld8f(const bf16_t* p, float (&v)[8]) { const u32x4 w = *(const u32x4*)p;
#pragma unroll
    for (int j = 0; j < 4; ++j) { v[2 * j] = __uint_as_float(w[j] << 16); v[2 * j + 1] = __uint_as_float(w[j] & 0xffff0000u); } }
__device__ __forceinline__ void st8f(bf16_t* p, const float (&v)[8]) { u32x4 w; w.x = pk2bf(v[0], v[1]); w.y = pk2bf(v[2], v[3]); w.z = pk2bf(v[4], v[5]); w.w = pk2bf(v[6], v[7]); *(u32x4*)p = w; }
__device__ __forceinline__ float f2bf_f(float f) { return bf2f(f2bf(f)); }

#ifndef TPROBE
#define TPROBE 0
#endif
#if TPROBE
#define TPU_START(id) do { if (TPROBE == (id) && TIDX() == 0) *(volatile unsigned long long*)(lds + LDS_BYTES - 24) = __builtin_amdgcn_s_memrealtime(); } while (0)
#define TPU_STOP(id) do { if (TPROBE == (id) && TIDX() == 0) *(volatile unsigned long long*)(lds + LDS_BYTES - 32) += __builtin_amdgcn_s_memrealtime() - *(volatile unsigned long long*)(lds + LDS_BYTES - 24); } while (0)
#else
#define TPU_START(id) do {} while (0)
#define TPU_STOP(id) do {} while (0)
#endif
#define XB_TMO      128
#define XB_XCNT(j)  (256  + 64 * (j))
#define XB_XSUB(j)  (1280 + 64 * (j))
#define XB_XGEN(j)  (2304 + 64 * (j))
#define XB_TOP      3328
#define XB_TOPGEN   3392
#define XCD_BAR_WORDS 3456
#define XB_SPIN_CAP (1u << 18)

__device__ __forceinline__ unsigned xb_ld(unsigned* p)              { return __hip_atomic_load(p, __ATOMIC_RELAXED, __HIP_MEMORY_SCOPE_AGENT); }
__device__ __forceinline__ unsigned xb_add(unsigned* p, unsigned v) { return __hip_atomic_fetch_add(p, v, __ATOMIC_RELAXED, __HIP_MEMORY_SCOPE_AGENT); }
__device__ __forceinline__ unsigned xb_xcc_id() { return (unsigned)__builtin_amdgcn_s_getreg((3 << 11) | 20) & 0xFu; }
#define XB_SPIN(cond, bar) do { unsigned _sp = 0; while (cond) { __builtin_amdgcn_s_sleep(1); \
    if ((++_sp & 255u) == 0u) { if (xb_ld(&(bar)[XB_TMO])) break; if (_sp > XB_SPIN_CAP) { atomicAdd(&(bar)[XB_TMO], 1u); break; } } } } while (0)

struct XcdBarrier {
    unsigned* bar; unsigned x;
    volatile LAS unsigned* st;
};

__device__ __forceinline__ XcdBarrier xcd_barrier_post(unsigned* bar, volatile LAS unsigned* st) {
    XcdBarrier b; b.bar = bar; b.x = xb_xcc_id(); b.st = st;
    if (TIDX() == 0) (void)xb_add(&bar[XB_XCNT(b.x)], 1u);
    return b;
}
__device__ __forceinline__ void xcd_barrier_complete(unsigned* bar, unsigned x, unsigned& nloc, unsigned& nx) {
    const unsigned G = gridDim.x * gridDim.y * gridDim.z;
    unsigned sum, cnt, mine, sp = 0u;
    for (;;) {
        sum = 0u; cnt = 0u; mine = 0u;
#pragma unroll
        for (unsigned j = 0; j < 16; ++j) { const unsigned c = xb_ld(&bar[XB_XCNT(j)]); sum += c; cnt += (c > 0u) ? 1u : 0u; mine = (j == x) ? c : mine; }
        if (sum == G) break;
        __builtin_amdgcn_s_sleep(1);
        if ((++sp & 255u) == 0u) { if (xb_ld(&bar[XB_TMO])) break; if (sp > XB_SPIN_CAP) { atomicAdd(&bar[XB_TMO], 1u); break; } }
    }
    nloc = mine > 0u ? mine : 1u; nx = cnt > 0u ? cnt : 1u;
}

__device__ __forceinline__ void xcd_barrier(const XcdBarrier& b) {
    asm volatile("s_waitcnt vmcnt(0)" ::: "memory");
    __syncthreads();
    if (TIDX() == 0) {
        unsigned* bar = b.bar; const unsigned bx = xb_xcc_id();
        __builtin_amdgcn_s_waitcnt(0);
        unsigned nloc = b.st[0], nx = b.st[1];
        if (nloc == 0u) { xcd_barrier_complete(bar, bx, nloc, nx); b.st[0] = nloc; b.st[1] = nx; }
        const unsigned old = xb_add(&bar[XB_XSUB(bx)], 1u);
        const unsigned gen = old / nloc;
        if (old + 1u == (gen + 1u) * nloc) {
            __builtin_amdgcn_fence(__ATOMIC_RELEASE, "agent");
            asm volatile("s_waitcnt vmcnt(0)" ::: "memory");
            const unsigned og = xb_add(&bar[XB_TOP], 1u);
            const unsigned tg = og / nx;
            if (og + 1u == (tg + 1u) * nx) xb_add(&bar[XB_TOPGEN], 1u);
            else XB_SPIN(xb_ld(&bar[XB_TOPGEN]) == tg, bar);
            __builtin_amdgcn_fence(__ATOMIC_ACQUIRE, "agent");
            xb_add(&bar[XB_XGEN(bx)], 1u);
            asm volatile("s_waitcnt vmcnt(0)" ::: "memory");
        } else {
            XB_SPIN(xb_ld(&bar[XB_XGEN(bx)]) == gen, bar);
            __builtin_amdgcn_fence(__ATOMIC_ACQUIRE, "agent");
            asm volatile("s_waitcnt vmcnt(0)" ::: "memory");
        }
    }
    __syncthreads();
}
namespace pg8 {
#define PG8_LAS __attribute__((address_space(3)))
typedef float f32x2 __attribute__((ext_vector_type(2)));
typedef unsigned u32x4 __attribute__((ext_vector_type(4)));
constexpr int BM = 256, BK = 64, HALF = 128, HTB = HALF * BK * 2  , STAGE_BYTES = 8 * HTB, NXCD = 8, WGM = 8;

__host__ __device__ __forceinline__ int lds_byte(int r, int c) { const int st = (r >> 4) * 2 + (c >> 5), rr = r & 15, cc = c & 31, ob = rr * 64 + cc * 2; return st * 1024 + (ob ^ (((ob >> 9) & 1) << 5)); }
__host__ __device__ __forceinline__ void stage_rc(int b, int& R, int& C) { const int st = b / 1024, sb = b % 1024, swz = sb ^ (((sb >> 9) & 1) << 5); R = (st >> 1) * 16 + swz / 64; C = (st & 1) * 32 + (swz % 64) / 2; }
__host__ __device__ __forceinline__ int perm32(int rho) { const int n = rho >> 4, i = rho & 15; return 8 * (i >> 2) + 4 * n + (i & 3); }

struct Unit { int pm, pn; };
struct Gemm { const bf16_t* A; const bf16_t* Bt; int M, N, K; };

struct StaticOrder {
    int nM, nN, nwg, G, c;
    __host__ __device__ void init(int M, int N, int G_, int c_) { nM = M / BM; nN = N / BM; nwg = nM * nN; G = G_; c = c_; }
    __host__ __device__ bool next(int i, Unit& u) const {
        const long L = (long)i * G + c; if (L >= nwg) return false;
        int wgid = (int)L; { const int q = nwg / NXCD, r = nwg % NXCD, xcd = wgid % NXCD, off = wgid / NXCD; wgid = (xcd < r ? xcd * (q + 1) : r * (q + 1) + (xcd - r) * q) + off; }
        const int nig = WGM * nN, gid = wgid / nig, fm = gid * WGM, gsz = (nM - fm) < WGM ? (nM - fm) : WGM;
        u.pm = fm + ((wgid % nig) % gsz); u.pn = (wgid % nig) / gsz; return true;
    }
    __device__ __forceinline__ void a_ready(const Unit&) const {}
    __device__ __forceinline__ void done(const Unit&) const {}
};
__device__ __forceinline__ unsigned cvt_pk_bf16(float lo, float hi) { unsigned r; asm volatile("v_cvt_pk_bf16_f32 %0, %1, %2" : "=v"(r) : "v"(lo), "v"(hi)); return r; }
struct EpiBf16Plain {
    static constexpr bool PERM = true, AFTER_DRAIN = false;
    bf16_t* O; int ldc;
    __device__ __forceinline__ void operator()(const f32x4 (&acc)[2][2][4][2], const Unit& u, int wr, int wc, int fr, int fq) const {
        const int row0 = u.pm * BM + wr * 64 + fr, col0 = u.pn * BM + wc * 32 + 8 * fq;
#pragma unroll
        for (int ai = 0; ai < 2; ++ai)
#pragma unroll
            for (int m = 0; m < 4; ++m) { bf16_t* rowp = O + (size_t)(row0 + ai * HALF + m * 16) * ldc + col0;
#pragma unroll
                for (int bj = 0; bj < 2; ++bj) { const f32x4 v0 = acc[ai][bj][m][0], v1 = acc[ai][bj][m][1];
                    u32x4 w; w.x = cvt_pk_bf16(v0[0], v0[1]); w.y = cvt_pk_bf16(v0[2], v0[3]); w.z = cvt_pk_bf16(v1[0], v1[1]); w.w = cvt_pk_bf16(v1[2], v1[3]);
                    *(u32x4*)(rowp + bj * HALF) = w; } }
    }
};
struct EpiResid {
    static constexpr bool PERM = false, AFTER_DRAIN = false;
    const float* R; float* C; int ldc;
    __device__ __forceinline__ void operator()(const f32x4 (&acc)[2][2][4][2], const Unit& u, int wr, int wc, int fr, int fq) const {
        const int row0 = u.pm * BM + wr * 64 + fr, col0 = u.pn * BM + wc * 32 + 4 * fq;
#pragma unroll
        for (int ai = 0; ai < 2; ++ai)
#pragma unroll
            for (int m = 0; m < 4; ++m) { const size_t off = (size_t)(row0 + ai * HALF + m * 16) * ldc + col0;
#pragma unroll
                for (int bj = 0; bj < 2; ++bj)
#pragma unroll
                    for (int n = 0; n < 2; ++n) { const f32x4 r = *(const f32x4*)(R + off + bj * HALF + n * 16); *(f32x4*)(C + off + bj * HALF + n * 16) = acc[ai][bj][m][n] + r; } }
    }
};
struct EpiResidMix {
    static constexpr bool PERM = true, AFTER_DRAIN = false;
    const void* R; void* C; int ldc; int r16, c16;
    __device__ __forceinline__ void operator()(const f32x4 (&acc)[2][2][4][2], const Unit& u, int wr, int wc, int fr, int fq) const {
        const int row0 = u.pm * BM + wr * 64 + fr, col0 = u.pn * BM + wc * 32 + 8 * fq;
#pragma unroll
        for (int ai = 0; ai < 2; ++ai)
#pragma unroll
            for (int m = 0; m < 4; ++m) { const size_t off = (size_t)(row0 + ai * HALF + m * 16) * ldc + col0;
                f32x4 r0[2], r1[2];
                if (r16) {
#pragma unroll
                    for (int bj = 0; bj < 2; ++bj) { const u32x4 w = *(const u32x4*)((const bf16_t*)R + off + bj * HALF);
                        r0[bj] = f32x4{__uint_as_float(w.x << 16), __uint_as_float(w.x & 0xffff0000u), __uint_as_float(w.y << 16), __uint_as_float(w.y & 0xffff0000u)};
                        r1[bj] = f32x4{__uint_as_float(w.z << 16), __uint_as_float(w.z & 0xffff0000u), __uint_as_float(w.w << 16), __uint_as_float(w.w & 0xffff0000u)}; }
                } else {
#pragma unroll
                    for (int bj = 0; bj < 2; ++bj) { r0[bj] = *(const f32x4*)((const float*)R + off + bj * HALF); r1[bj] = *(const f32x4*)((const float*)R + off + bj * HALF + 4); }
                }
#pragma unroll
                for (int bj = 0; bj < 2; ++bj) { const f32x4 v0 = acc[ai][bj][m][0] + r0[bj], v1 = acc[ai][bj][m][1] + r1[bj];
                    if (c16) { u32x4 w; w.x = cvt_pk_bf16(v0[0], v0[1]); w.y = cvt_pk_bf16(v0[2], v0[3]); w.z = cvt_pk_bf16(v1[0], v1[1]); w.w = cvt_pk_bf16(v1[2], v1[3]);
                        *(u32x4*)((bf16_t*)C + off + bj * HALF) = w; }
                    else { *(f32x4*)((float*)C + off + bj * HALF) = v0; *(f32x4*)((float*)C + off + bj * HALF + 4) = v1; } } }
    }
};
struct EpiGlu {
    static constexpr bool PERM = true, AFTER_DRAIN = false;
    const bf16_t* Y; int ldy; bf16_t* O; int ldo; int ooff;
    __device__ __forceinline__ void operator()(const f32x4 (&acc)[2][2][4][2], const Unit& u, int wr, int wc, int fr, int fq) const {
        const int row0 = u.pm * BM + wr * 64 + fr, col0 = u.pn * BM + wc * 32 + 8 * fq;
#pragma unroll
        for (int ai = 0; ai < 2; ++ai)
#pragma unroll
            for (int m = 0; m < 4; ++m) { const int row = row0 + ai * HALF + m * 16;
#pragma unroll
                for (int bj = 0; bj < 2; ++bj) { const f32x4 v0 = acc[ai][bj][m][0], v1 = acc[ai][bj][m][1];
                    const u32x4 yw = *(const u32x4*)(Y + (size_t)row * ldy + col0 + bj * HALF);
                    float y[8], g[8];
#pragma unroll
                    for (int j = 0; j < 4; ++j) { y[2 * j] = __uint_as_float(yw[j] << 16); y[2 * j + 1] = __uint_as_float(yw[j] & 0xffff0000u); }
#pragma unroll
                    for (int j = 0; j < 4; ++j) { g[j] = 1.f / (1.f + __expf(-v0[j])); g[4 + j] = 1.f / (1.f + __expf(-v1[j])); }
                    u32x4 w; w.x = cvt_pk_bf16(y[0] * g[0], y[1] * g[1]); w.y = cvt_pk_bf16(y[2] * g[2], y[3] * g[3]); w.z = cvt_pk_bf16(y[4] * g[4], y[5] * g[5]); w.w = cvt_pk_bf16(y[6] * g[6], y[7] * g[7]);
                    *(u32x4*)(O + (size_t)row * ldo + ooff + col0 + bj * HALF) = w; } }
    }
};
struct EpiGluGate {
    static constexpr bool PERM = true, AFTER_DRAIN = true;
    const bf16_t* Y; const bf16_t* Pz; bf16_t* G;
    __device__ __forceinline__ void fused(const f32x4 (&acc)[2][2][4][2], const Unit& u, int wr, int wc, int fr, int fq, PG8_LAS unsigned char* lds, int wid, int lane) const {
        constexpr int TS = 528;
        const int row0 = wr * 64 + fr, col0 = wc * 32 + 8 * fq;
#pragma unroll
        for (int ai = 0; ai < 2; ++ai)
#pragma unroll
            for (int m = 0; m < 4; ++m) { const int rl = row0 + ai * HALF + m * 16; const size_t grow = (size_t)u.pm * BM + rl;
#pragma unroll
                for (int bj = 0; bj < 2; ++bj) { const f32x4 v0 = acc[ai][bj][m][0], v1 = acc[ai][bj][m][1];
                    const u32x4 yw = *(const u32x4*)(Y + grow * 512 + u.pn * BM + col0 + bj * HALF);
                    float y[8], g[8];
#pragma unroll
                    for (int j = 0; j < 4; ++j) { y[2 * j] = __uint_as_float(yw[j] << 16); y[2 * j + 1] = __uint_as_float(yw[j] & 0xffff0000u); }
#pragma unroll
                    for (int j = 0; j < 4; ++j) { g[j] = 1.f / (1.f + __expf(-v0[j])); g[4 + j] = 1.f / (1.f + __expf(-v1[j])); }
                    u32x4 w; w.x = cvt_pk_bf16(y[0] * g[0], y[1] * g[1]); w.y = cvt_pk_bf16(y[2] * g[2], y[3] * g[3]); w.z = cvt_pk_bf16(y[4] * g[4], y[5] * g[5]); w.w = cvt_pk_bf16(y[6] * g[6], y[7] * g[7]);
                    *(PG8_LAS u32x4*)(lds + rl * TS + (col0 + bj * HALF) * 2) = w; } }
        __syncthreads();
        { const int t = wid * 64 + lane, row = t >> 1, hd = t & 1; const PG8_LAS unsigned char* src = lds + row * TS + hd * 256;
          float ss = 0.f;
#pragma unroll
          for (int i = 0; i < 16; ++i) { const u32x4 w = *(const PG8_LAS u32x4*)(src + 16 * i);
#pragma unroll
              for (int j = 0; j < 4; ++j) { const float a = __uint_as_float(w[j] << 16), b = __uint_as_float(w[j] & 0xffff0000u); ss += a * a + b * b; } }
          const float rn = rsqrtf(ss * (1.f / 128.f) + 1e-6f);
          const size_t grow = (size_t)u.pm * BM + row; const int cb = u.pn * BM + hd * 128;
          const bf16_t* zp = Pz + grow * 6144 + 2064 + cb; bf16_t* gp = G + grow * 2048 + 512 + cb;
#pragma unroll
          for (int i = 0; i < 16; ++i) { const u32x4 w = *(const PG8_LAS u32x4*)(src + 16 * i); const u32x4 zw = *(const u32x4*)(zp + 8 * i); u32x4 o;
#pragma unroll
              for (int j = 0; j < 4; ++j) { const float a = __uint_as_float(w[j] << 16), b = __uint_as_float(w[j] & 0xffff0000u), za = __uint_as_float(zw[j] << 16), zb = __uint_as_float(zw[j] & 0xffff0000u);
                  o[j] = cvt_pk_bf16(a * rn * (za / (1.f + __expf(-za))), b * rn * (zb / (1.f + __expf(-zb)))); }
              *(u32x4*)(gp + 8 * i) = o; } }
        __syncthreads();
    }
};
struct EpiBf16Scale {
    static constexpr bool PERM = true, AFTER_DRAIN = false;
    bf16_t* O; int ldc; const float* ssq;
    __device__ __forceinline__ void operator()(const f32x4 (&acc)[2][2][4][2], const Unit& u, int wr, int wc, int fr, int fq) const {
        const int row0 = u.pm * BM + wr * 64 + fr, col0 = u.pn * BM + wc * 32 + 8 * fq;
#pragma unroll
        for (int ai = 0; ai < 2; ++ai)
#pragma unroll
            for (int m = 0; m < 4; ++m) { const int row = row0 + ai * HALF + m * 16; bf16_t* rowp = O + (size_t)row * ldc + col0;
                float ssum = 0.f; { const f32x4* sp_ = (const f32x4*)(ssq + (size_t)row * 32);
#pragma unroll
                    for (int q = 0; q < 8; ++q) { const f32x4 t4 = sp_[q]; ssum += (t4[0] + t4[1]) + (t4[2] + t4[3]); } }
                const float s = rsqrtf(ssum * (1.f / 2048.f) + 1e-6f);
#pragma unroll
                for (int bj = 0; bj < 2; ++bj) { const f32x4 v0 = acc[ai][bj][m][0] * s, v1 = acc[ai][bj][m][1] * s;
                    u32x4 w; w.x = cvt_pk_bf16(v0[0], v0[1]); w.y = cvt_pk_bf16(v0[2], v0[3]); w.z = cvt_pk_bf16(v1[0], v1[1]); w.w = cvt_pk_bf16(v1[2], v1[3]);
                    *(u32x4*)(rowp + bj * HALF) = w; } }
    }
};
struct EpiResidNext {
    static constexpr bool PERM = false, AFTER_DRAIN = false;
    const float* R; float* C; int ldc; bf16_t* XB; float* ssq;
    __device__ __forceinline__ void operator()(const f32x4 (&acc)[2][2][4][2], const Unit& u, int wr, int wc, int fr, int fq) const {
        const int row0 = u.pm * BM + wr * 64 + fr, col0 = u.pn * BM + wc * 32 + 4 * fq;
#pragma unroll
        for (int ai = 0; ai < 2; ++ai)
#pragma unroll
            for (int m = 0; m < 4; ++m) { const int row = row0 + ai * HALF + m * 16; const size_t off = (size_t)row * ldc + col0; float ss = 0.f;
#pragma unroll
                for (int bj = 0; bj < 2; ++bj)
#pragma unroll
                    for (int n = 0; n < 2; ++n) { const f32x4 r = *(const f32x4*)(R + off + bj * HALF + n * 16); const f32x4 v = acc[ai][bj][m][n] + r;
                        *(f32x4*)(C + off + bj * HALF + n * 16) = v;
                        if (XB) { u32x2 w; w.x = cvt_pk_bf16(v[0], v[1]); w.y = cvt_pk_bf16(v[2], v[3]); *(u32x2*)(XB + off + bj * HALF + n * 16) = w; }
                        ss += v[0] * v[0] + v[1] * v[1] + v[2] * v[2] + v[3] * v[3]; }
                if (ssq) { ss += shx(ss, 16); ss += shx(ss, 32); if (fq == 0) ssq[(size_t)row * 32 + u.pn * 4 + wc] = ss; } }
    }
};
template <class Epi, class Sched, bool STAMP = false>
__device__ __forceinline__ void gemm_phase(PG8_LAS unsigned char* lds, const Gemm g, const Sched& S, const Epi& E, unsigned long long* stamps) {
    const int tid = TIDX(), wid = __builtin_amdgcn_readfirstlane(tid >> 6), lane = tid & 63, wr = wid >> 2, wc = wid & 3, fr = lane & 15, fq = lane >> 4;
    const int K = g.K, nt = K / BK;
    int ts_lo = 0, ts_hi = 0, nts = 0; const unsigned long long rt_entry = STAMP ? (unsigned long long)wall_clock64() : 0ull;
#define PG8_STAMP() do { if (STAMP && wid == 0 && nts < 64) { const unsigned long long _c = (unsigned long long)clock64(); \
        ts_lo = (lane == nts) ? (int)(unsigned)_c : ts_lo; ts_hi = (lane == nts) ? (int)(unsigned)(_c >> 32) : ts_hi; ++nts; } } while (0)
    PG8_STAMP();
    unsigned voffA[2], voffB[2];
#pragma unroll
    for (int i = 0; i < 2; ++i) { int R, C; stage_rc(tid * 16 + i * 8192, R, C); const int Rb = Epi::PERM ? ((R & ~31) + perm32(R & 31)) : R;
        voffA[i] = (unsigned)(R * K + C) * 2u; voffB[i] = (unsigned)(Rb * K + C) * 2u; }
    const size_t kstep = (size_t)(BK * 2);
    const size_t hstep = (size_t)HALF * K * 2;
    const size_t tstep = 2 * hstep;
    const unsigned ldsw = (unsigned)wid * 1024u;
    const int aoff = lds_byte(wr * 64 + fr, fq * 8), boff = lds_byte(wc * 32 + fr, fq * 8);
#define PG8_SA(b, h) (((b) * 2 + (h)) * HTB)
#define PG8_SB(b, h) ((4 + (b) * 2 + (h)) * HTB)
#define PG8_STAGE(bufoff, gbase, voff) do { _Pragma("unroll") for (int _i = 0; _i < 2; ++_i) \
        __builtin_amdgcn_global_load_lds((const unsigned*)((const char*)(gbase) + (voff)[_i]), (PG8_LAS unsigned*)(lds + (bufoff) + ldsw + _i * 8192), 16, 0, 0); } while (0)
#define PG8_LDA(dst, b, h) do { _Pragma("unroll") for (int m = 0; m < 4; ++m) _Pragma("unroll") for (int k = 0; k < 2; ++k) dst[m][k] = *(const PG8_LAS bf16x8*)(lds + PG8_SA(b, h) + aoff + m * 2048 + k * 1024); } while (0)
#define PG8_LDB(dst, b, h) do { _Pragma("unroll") for (int n = 0; n < 2; ++n) _Pragma("unroll") for (int k = 0; k < 2; ++k) dst[n][k] = *(const PG8_LAS bf16x8*)(lds + PG8_SB(b, h) + boff + n * 2048 + k * 1024); } while (0)
#define PG8_MMA(ai, bj, At, Bt) do { __builtin_amdgcn_s_setprio(1); _Pragma("unroll") for (int m = 0; m < 4; ++m) _Pragma("unroll") for (int n = 0; n < 2; ++n) _Pragma("unroll") for (int k = 0; k < 2; ++k) \
        acc[ai][bj][m][n] = __builtin_amdgcn_mfma_f32_16x16x32_bf16(Bt[n][k], At[m][k], acc[ai][bj][m][n], 0, 0, 0); __builtin_amdgcn_s_setprio(0); } while (0)
#define PG8_WAIT_V(n) asm volatile("s_waitcnt vmcnt(" #n ")" ::: "memory")
#define PG8_WAIT_L(n) asm volatile("s_waitcnt lgkmcnt(" #n ")" ::: "memory")
#define PG8_BAR __builtin_amdgcn_s_barrier()
#define PG8_SCHED __builtin_amdgcn_sched_barrier(0)
    Unit cur, nxt; int ui = 0;
    if (!S.next(0, cur)) return;
    f32x4 acc[2][2][4][2];
#pragma unroll
    for (int a = 0; a < 2; ++a)
#pragma unroll
        for (int b = 0; b < 2; ++b)
#pragma unroll
            for (int m = 0; m < 4; ++m)
#pragma unroll
                for (int n = 0; n < 2; ++n) acc[a][b][m][n] = (f32x4){0.f, 0.f, 0.f, 0.f};
    bf16x8 At[4][2], B0[2][2], B1[2][2];
    const char* cA = (const char*)g.A + (size_t)cur.pm * tstep; const char* cB = (const char*)g.Bt + (size_t)cur.pn * tstep;
    S.a_ready(cur);
    PG8_STAGE(PG8_SB(0, 0), cB, voffB); PG8_STAGE(PG8_SA(0, 0), cA, voffA); PG8_STAGE(PG8_SB(0, 1), cB + hstep, voffB); PG8_STAGE(PG8_SA(0, 1), cA + hstep, voffA);
    if (wr == 1) PG8_BAR;
    PG8_WAIT_V(4); PG8_BAR;
    PG8_STAGE(PG8_SB(1, 0), cB + kstep, voffB); PG8_STAGE(PG8_SA(1, 0), cA + kstep, voffA); PG8_STAGE(PG8_SB(1, 1), cB + hstep + kstep, voffB);
    PG8_WAIT_V(6); PG8_BAR;
    PG8_STAMP();
    for (;;) {
        const bool has_next = S.next(ui + 1, nxt);
        const char* nA = has_next ? (const char*)g.A + (size_t)nxt.pm * tstep : cA; const char* nB = has_next ? (const char*)g.Bt + (size_t)nxt.pn * tstep : cB;
        for (int t = 0; t < nt; t += 2) {
            const bool last = (t == nt - 2);
            const char* a1 = cA + (size_t)(t + 1) * kstep;
            const char* a2 = last ? nA : cA + (size_t)(t + 2) * kstep; const char* b2 = last ? nB : cB + (size_t)(t + 2) * kstep;
            const char* a3 = a2 + kstep; const char* b3 = b2 + kstep;
            if (last && has_next) S.a_ready(nxt);
            PG8_LDB(B0, 0, 0); PG8_SCHED; PG8_LDA(At, 0, 0); PG8_STAGE(PG8_SA(1, 1), a1 + hstep, voffA);
            PG8_WAIT_L(8); PG8_BAR; PG8_WAIT_L(0); PG8_MMA(0, 0, At, B0); PG8_BAR; PG8_SCHED;
            PG8_LDB(B1, 0, 1); PG8_STAGE(PG8_SB(0, 0), b2, voffB);
            PG8_BAR; PG8_WAIT_L(0); PG8_MMA(0, 1, At, B1); PG8_BAR;
            PG8_LDA(At, 0, 1); PG8_STAGE(PG8_SA(0, 0), a2, voffA);
            PG8_BAR; PG8_WAIT_L(0); PG8_MMA(1, 0, At, B0); PG8_BAR; PG8_SCHED;
            PG8_STAGE(PG8_SB(0, 1), b2 + hstep, voffB);
            PG8_WAIT_V(6); PG8_BAR; PG8_MMA(1, 1, At, B1); PG8_BAR;
            PG8_LDB(B0, 1, 0); PG8_SCHED; PG8_LDA(At, 1, 0); PG8_STAGE(PG8_SA(0, 1), a2 + hstep, voffA);
            PG8_WAIT_L(8); PG8_BAR; PG8_WAIT_L(0); PG8_MMA(0, 0, At, B0); PG8_BAR; PG8_SCHED;
            PG8_LDB(B1, 1, 1); PG8_STAGE(PG8_SB(1, 0), b3, voffB);
            PG8_BAR; PG8_WAIT_L(0); PG8_MMA(0, 1, At, B1); PG8_BAR;
            PG8_LDA(At, 1, 1); PG8_STAGE(PG8_SA(1, 0), a3, voffA);
            PG8_BAR; PG8_WAIT_L(0); PG8_MMA(1, 0, At, B0); PG8_BAR; PG8_SCHED;
            PG8_STAGE(PG8_SB(1, 1), b3 + hstep, voffB);
            PG8_WAIT_V(6); PG8_BAR; PG8_MMA(1, 1, At, B1); PG8_BAR;
        }
        PG8_STAMP();
        if constexpr (!Epi::AFTER_DRAIN) { E(acc, cur, wr, wc, fr, fq); S.done(cur); }
        PG8_STAMP();
        if (!has_next) break;
#pragma unroll
        for (int a = 0; a < 2; ++a)
#pragma unroll
            for (int b = 0; b < 2; ++b)
#pragma unroll
                for (int m = 0; m < 4; ++m)
#pragma unroll
                    for (int n = 0; n < 2; ++n) acc[a][b][m][n] = (f32x4){0.f, 0.f, 0.f, 0.f};
        cur = nxt; cA = nA; cB = nB; ++ui;
    }
    PG8_WAIT_V(0);
    if (wr == 0) PG8_BAR;
    PG8_BAR;
    if constexpr (Epi::AFTER_DRAIN) { E.fused(acc, cur, wr, wc, fr, fq, lds, wid, lane); S.done(cur); }
    PG8_STAMP();
    if (STAMP && wid == 0) { stamps[lane] = lane < nts ? (((unsigned long long)(unsigned)ts_hi << 32) | (unsigned)ts_lo) : 0ull;
        if (lane == 62) stamps[62] = rt_entry; if (lane == 63) stamps[63] = (unsigned long long)wall_clock64(); }
#undef PG8_STAMP
#undef PG8_SA
#undef PG8_SB
#undef PG8_STAGE
#undef PG8_LDA
#undef PG8_LDB
#undef PG8_MMA
#undef PG8_WAIT_V
#undef PG8_WAIT_L
#undef PG8_BAR
#undef PG8_SCHED
}
}
namespace att {
constexpr int D = 128, NW = 8, QBLK = 32, KVBLK = 64;
constexpr float SCALE = 0.088388347648318440f, THR = 8.f;
constexpr int SHM_V = KVBLK * D * 2, SHM_K = KVBLK * D * 2, SHM_ATTN = 2 * SHM_V + 2 * SHM_K + NW * 64 * 4;
#define KSWZ(row, colB) ((row) * 256 + ((colB) ^ (((row) & 7) << 4)))
#define SBAR() __builtin_amdgcn_sched_barrier(0)
__device__ __forceinline__ int crow(int r, int hi) { return (r & 3) + 8 * (r >> 2) + 4 * hi; }
__device__ __forceinline__ unsigned cvtpk(float lo, float hi) { unsigned r; asm volatile("v_cvt_pk_bf16_f32 %0, %1, %2" : "=v"(r) : "v"(lo), "v"(hi)); return r; }

template <bool MASKED>
__device__ __forceinline__ void partialSM(f32x16& p0, f32x16& p1, float& m_reg, float& mn, float& alpha, unsigned long long mw, int hi) {
  constexpr float C = SCALE * 1.4426950408889634f;
  float pmax = p0[0];
#pragma unroll
  for (int r = 1; r < 16; ++r) pmax = fmaxf(pmax, p0[r]);
#pragma unroll
  for (int r = 0; r < 16; ++r) pmax = fmaxf(pmax, p1[r]);
  { auto rr = __builtin_amdgcn_permlane32_swap(__float_as_uint(pmax), __float_as_uint(pmax), false, false);
    pmax = fmaxf(__uint_as_float(rr[0]), __uint_as_float(rr[1])); }
  if (__builtin_expect(__all(pmax - m_reg <= THR / SCALE), 1)) { mn = m_reg; alpha = 1.f; }
  else { mn = fmaxf(m_reg, pmax); alpha = __builtin_amdgcn_exp2f((m_reg - mn) * C); m_reg = mn; }
  const float mnC = -mn * C;
#pragma unroll
  for (int r = 0; r < 16; ++r) p0[r] = fmaf(p0[r], C, mnC);
#pragma unroll
  for (int r = 0; r < 16; ++r) p1[r] = fmaf(p1[r], C, mnC);
#pragma unroll
  for (int r = 0; r < 16; ++r) p0[r] = __builtin_amdgcn_exp2f(p0[r]);
}
__device__ __forceinline__ void finishSM(f32x16& p0, f32x16& p1, float alpha, float& l_reg, bf16x8& pa0, bf16x8& pa1, bf16x8& pa2, bf16x8& pa3) {
#pragma unroll
  for (int r = 0; r < 16; ++r) p1[r] = __builtin_amdgcn_exp2f(p1[r]);
  float ps = 0;
#pragma unroll
  for (int r = 0; r < 16; ++r) ps += p0[r];
#pragma unroll
  for (int r = 0; r < 16; ++r) ps += p1[r];
  { auto rr = __builtin_amdgcn_permlane32_swap(__float_as_uint(ps), __float_as_uint(ps), false, false);
    ps = __uint_as_float(rr[0]) + __uint_as_float(rr[1]); }
  l_reg = l_reg * alpha + ps;
#define PK4(P, BASE, OUT) do { unsigned a0 = cvtpk(P[BASE + 0], P[BASE + 1]), a1 = cvtpk(P[BASE + 2], P[BASE + 3]);   \
    unsigned b0 = cvtpk(P[BASE + 4], P[BASE + 5]), b1 = cvtpk(P[BASE + 6], P[BASE + 7]);                              \
    auto r0 = __builtin_amdgcn_permlane32_swap(a0, b0, false, false); auto r1 = __builtin_amdgcn_permlane32_swap(a1, b1, false, false); \
    u32x4 w = {r0[0], r1[0], r0[1], r1[1]}; OUT = *reinterpret_cast<bf16x8*>(&w); } while (0)
  PK4(p0, 0, pa0); PK4(p0, 8, pa1); PK4(p1, 0, pa2); PK4(p1, 8, pa3);
#undef PK4
}
template <int R> __device__ __forceinline__ float mask_bias(unsigned nw) {
  unsigned t; constexpr int bit = (R & 3) + 8 * (R >> 2);
  asm("v_bfe_i32 %0, %1, %2, 1\n\tv_and_b32 %0, 0xff800000, %0" : "=v"(t) : "v"(nw), "n"(bit));
  return __uint_as_float(t);
}
template <bool MASKED>
__device__ __forceinline__ void qkt(f32x16& p0, f32x16& p1, const char* Ks, const bf16x8* qr, int r32, int hi, unsigned long long mw) {
  if (MASKED) {
    const unsigned n0 = ~((unsigned)mw >> (4 * hi)), n1 = ~((unsigned)(mw >> 32) >> (4 * hi));
#define MB_(R) p0[R] = mask_bias<R>(n0); p1[R] = mask_bias<R>(n1);
    MB_(0) MB_(1) MB_(2) MB_(3) MB_(4) MB_(5) MB_(6) MB_(7) MB_(8) MB_(9) MB_(10) MB_(11) MB_(12) MB_(13) MB_(14) MB_(15)
#undef MB_
  } else { p0 = f32x16{}; p1 = f32x16{}; }
  asm volatile("" : "+v"(p0), "+v"(p1));
#pragma unroll
  for (int d0 = 0; d0 < 8; ++d0) { const int cb = (d0 * 16 + hi * 8) * 2;
    bf16x8 b0 = *reinterpret_cast<const bf16x8*>(Ks + KSWZ(r32, cb));
    bf16x8 b1 = *reinterpret_cast<const bf16x8*>(Ks + KSWZ(32 + r32, cb));
    p0 = __builtin_amdgcn_mfma_f32_32x32x16_bf16(b0, qr[d0], p0, 0, 0, 0);
    p1 = __builtin_amdgcn_mfma_f32_32x32x16_bf16(b1, qr[d0], p1, 0, 0, 0); }
}
__device__ __forceinline__ int v_st(int k, int c) { const int kk = (k & ~0xC) | ((k & 4) << 1) | ((k & 8) >> 1); return ((kk >> 3) * 4 + (c >> 5)) * 512 + ((kk & 7) * 32 + (c & 31)) * 2; }
__device__ __forceinline__ int v_rd_base(int lane) { return ((lane & 3) << 3) | (((lane >> 2) & 3) << 6) | (((lane >> 4) & 1) << 5) | (((lane >> 5) & 1) << 8); }
constexpr int v_rd_off(int d0, int ks, int half) { return d0 * 512 + ks * 4096 + half * 2048; }
template <int OFF> __device__ __forceinline__ s16x4 tr_read(int vb) {
  s16x4 r; asm volatile("ds_read_b64_tr_b16 %0, %1 offset:%2" : "=&v"(r) : "v"(vb), "i"(OFF) : "memory"); return r;
}
template <int D0> __device__ __forceinline__ void pv_one(f32x16& od, int vb, bf16x8 pa0, bf16x8 pa1, bf16x8 pa2, bf16x8 pa3) {
  const s16x4 l0 = tr_read<v_rd_off(D0, 0, 0)>(vb), h0 = tr_read<v_rd_off(D0, 0, 1)>(vb), l1 = tr_read<v_rd_off(D0, 1, 0)>(vb), h1 = tr_read<v_rd_off(D0, 1, 1)>(vb);
  const s16x4 l2 = tr_read<v_rd_off(D0, 2, 0)>(vb), h2 = tr_read<v_rd_off(D0, 2, 1)>(vb), l3 = tr_read<v_rd_off(D0, 3, 0)>(vb), h3 = tr_read<v_rd_off(D0, 3, 1)>(vb);
  asm volatile("s_waitcnt lgkmcnt(0)" ::: "memory"); SBAR();
#define PK(L, H) (bf16x8){L[0], L[1], L[2], L[3], H[0], H[1], H[2], H[3]}
  od = __builtin_amdgcn_mfma_f32_32x32x16_bf16(pa0, PK(l0, h0), od, 0, 0, 0);
  od = __builtin_amdgcn_mfma_f32_32x32x16_bf16(pa1, PK(l1, h1), od, 0, 0, 0);
  od = __builtin_amdgcn_mfma_f32_32x32x16_bf16(pa2, PK(l2, h2), od, 0, 0, 0);
  od = __builtin_amdgcn_mfma_f32_32x32x16_bf16(pa3, PK(l3, h3), od, 0, 0, 0);
#undef PK
}
__device__ __forceinline__ void pv_d0(f32x16* o, int vb, bf16x8 pa0, bf16x8 pa1, bf16x8 pa2, bf16x8 pa3) {
  pv_one<0>(o[0], vb, pa0, pa1, pa2, pa3); pv_one<1>(o[1], vb, pa0, pa1, pa2, pa3); pv_one<2>(o[2], vb, pa0, pa1, pa2, pa3); pv_one<3>(o[3], vb, pa0, pa1, pa2, pa3);
}

template <bool MASKED, int LDK, int VOFF, int QT, class OutRow>
__device__ __forceinline__ void attn_body(const bf16_t* __restrict__ Qw, const float* __restrict__ qgain, const float* __restrict__ qcs, const bf16_t* __restrict__ Kh, int NT,
                                          const unsigned long long* __restrict__ mbase, unsigned moff, const OutRow& Ow, char* lds) {
  const int tid = TIDX(), wid = tid >> 6, lane = tid & 63, r32 = lane & 31, hi = lane >> 5;
  char* V_lds = lds; char* K_lds = lds + 2 * SHM_V;
  float* ws = (float*)(lds + 2 * SHM_V + 2 * SHM_K) + wid * 64; float* li_l = ws; float* al_l = ws + 32;
  float m_reg = -1e30f, l_reg = 0; f32x16 o[4] = {}; bf16x8 qr[8];
  asm volatile("" : "+v"(o[0]), "+v"(o[1]), "+v"(o[2]), "+v"(o[3]));
#pragma unroll
  for (int d0 = 0; d0 < 8; ++d0) qr[d0] = *reinterpret_cast<const bf16x8*>(Qw + d0 * 16);
  if (QT) {
    float ss = 0.f;
#pragma unroll
    for (int d0 = 0; d0 < 8; ++d0)
#pragma unroll
      for (int j = 0; j < 8; ++j) { const float x = bf2f((bf16_t)qr[d0][j]); ss += x * x; }
    { auto rr = __builtin_amdgcn_permlane32_swap(__float_as_uint(ss), __float_as_uint(ss), false, false); ss = __uint_as_float(rr[0]) + __uint_as_float(rr[1]); }
    const float rn = rsqrtf(ss * (1.f / 128.f) + EPS);
    float x01[2][8];
#pragma unroll
    for (int d0 = 0; d0 < 8; ++d0) { const f32x4 g0 = *(const f32x4*)(qgain + d0 * 16 + hi * 8), g1 = *(const f32x4*)(qgain + d0 * 16 + hi * 8 + 4);
      float x[8];
#pragma unroll
      for (int j = 0; j < 8; ++j) x[j] = bf2f((bf16_t)qr[d0][j]) * rn * (j < 4 ? g0[j] : g1[j - 4]);
      if (QT == 2 && d0 < 2) {
#pragma unroll
        for (int j = 0; j < 8; ++j) x01[d0][j] = x[j];
      } else { u32x4 w = {cvtpk(x[0], x[1]), cvtpk(x[2], x[3]), cvtpk(x[4], x[5]), cvtpk(x[6], x[7])}; qr[d0] = *reinterpret_cast<bf16x8*>(&w); } }
    if (QT == 2) {
      float a[8], b[8];
#pragma unroll
      for (int j2 = 0; j2 < 4; ++j2) { const f32x4 cs = *(const f32x4*)(qcs + hi * 16 + 4 * j2);
#pragma unroll
        for (int q = 0; q < 2; ++q) { const int j = 2 * j2 + q; const float c = cs[2 * q], sn = cs[2 * q + 1], x1 = x01[0][j], x2 = x01[1][j]; a[j] = x1 * c - x2 * sn; b[j] = x2 * c + x1 * sn; } }
      { u32x4 w = {cvtpk(a[0], a[1]), cvtpk(a[2], a[3]), cvtpk(a[4], a[5]), cvtpk(a[6], a[7])}; qr[0] = *reinterpret_cast<bf16x8*>(&w); }
      { u32x4 w = {cvtpk(b[0], b[1]), cvtpk(b[2], b[3]), cvtpk(b[4], b[5]), cvtpk(b[6], b[7])}; qr[1] = *reinterpret_cast<bf16x8*>(&w); }
    }
  }
  const int sr = tid >> 4, sc = (tid & 15) * 8, vst0 = v_st(sr, sc), vst1 = v_st(32 + sr, sc);
  const int vb0 = (int)(uintptr_t)V_lds + v_rd_base(lane);
  struct { bf16x8 vs0, vs1, ks0, ks1; } sr_[2];
  const unsigned koff = (unsigned)(sr * LDK + sc) * 2u;
#define SLOAD(i, k0) do { const char* kb_ = (const char*)Kh + (size_t)(k0) * (LDK * 2); \
    sr_[i].vs0 = *reinterpret_cast<const bf16x8*>(kb_ + koff + VOFF * 2); sr_[i].vs1 = *reinterpret_cast<const bf16x8*>(kb_ + koff + (32 * LDK + VOFF) * 2); \
    sr_[i].ks0 = *reinterpret_cast<const bf16x8*>(kb_ + koff); sr_[i].ks1 = *reinterpret_cast<const bf16x8*>(kb_ + koff + 32 * LDK * 2); } while (0)
#define SWRITE(b, i) do { *(bf16x8*)(V_lds + (b) * SHM_V + vst0) = sr_[i].vs0;          \
    *(bf16x8*)(V_lds + (b) * SHM_V + vst1) = sr_[i].vs1; int kc = sc * 2;               \
    *(bf16x8*)(K_lds + (b) * SHM_K + KSWZ(sr, kc)) = sr_[i].ks0;                       \
    *(bf16x8*)(K_lds + (b) * SHM_K + KSWZ(32 + sr, kc)) = sr_[i].ks1; } while (0)
#define SWAIT() asm volatile("s_waitcnt vmcnt(4)" ::: "memory")
#define RESC(a) do { if (__any((a) < 1.f)) { if (hi == 0) al_l[r32] = (a); asm volatile("s_waitcnt lgkmcnt(0)" ::: "memory"); \
    _Pragma("unroll") for (int d = 0; d < 4; ++d) _Pragma("unroll") for (int r = 0; r < 16; ++r) o[d][r] *= al_l[crow(r, hi)]; } } while (0)
  f32x16 pA0, pA1, pB0, pB1; float mnA, mnB, alA, alB; bf16x8 pa0, pa1, pa2, pa3;
  unsigned long long mw = 0ull;
  constexpr int SE = 0, SO = 1;
  if (MASKED) mw = *(const unsigned long long*)((const char*)mbase + moff);
  SLOAD(SE, 0); asm volatile("s_waitcnt vmcnt(0)" ::: "memory"); SWRITE(0, SE); __syncthreads();
  qkt<MASKED>(pA0, pA1, K_lds, qr, r32, hi, mw);
  if (MASKED) mw = *(const unsigned long long*)((const char*)mbase + (moff + 8u));
  partialSM<MASKED>(pA0, pA1, m_reg, mnA, alA, mw, hi);
  SLOAD(SO, KVBLK); SLOAD(SE, (2 < NT ? 2 : NT - 1) * KVBLK);
  SWAIT();
  SWRITE(1, SO); __syncthreads();
  for (int j = 1; j + 1 < NT; j += 2) {
    SBAR(); qkt<MASKED>(pB0, pB1, K_lds + SHM_K, qr, r32, hi, mw);
    if (MASKED) mw = *(const unsigned long long*)((const char*)mbase + (moff + 8u * (unsigned)(j + 1)));
    finishSM(pA0, pA1, alA, l_reg, pa0, pa1, pa2, pa3); SBAR();
    SLOAD(SO, (j + 2) * KVBLK); SBAR();
    pv_d0(o, vb0, pa0, pa1, pa2, pa3); partialSM<MASKED>(pB0, pB1, m_reg, mnB, alB, mw, hi);
    __syncthreads(); if (MASKED) asm volatile("s_waitcnt vmcnt(5)" ::: "memory"); else SWAIT();
    SWRITE(0, SE);
    RESC(alB); __syncthreads();
    SBAR(); qkt<MASKED>(pA0, pA1, K_lds, qr, r32, hi, mw);
    if (MASKED) mw = *(const unsigned long long*)((const char*)mbase + (moff + 8u * (unsigned)(j + 2)));
    finishSM(pB0, pB1, alB, l_reg, pa0, pa1, pa2, pa3); SBAR();
    SLOAD(SE, (j + 3 < NT ? j + 3 : NT - 1) * KVBLK); SBAR();
    pv_d0(o, vb0 + SHM_V, pa0, pa1, pa2, pa3); partialSM<MASKED>(pA0, pA1, m_reg, mnA, alA, mw, hi);
    __syncthreads(); if (MASKED) asm volatile("s_waitcnt vmcnt(5)" ::: "memory"); else SWAIT();
    SWRITE(1, SO);
    RESC(alA); __syncthreads();
  }
  SBAR(); qkt<MASKED>(pB0, pB1, K_lds + SHM_K, qr, r32, hi, mw);
  finishSM(pA0, pA1, alA, l_reg, pa0, pa1, pa2, pa3); SBAR();
  pv_d0(o, vb0, pa0, pa1, pa2, pa3); partialSM<MASKED>(pB0, pB1, m_reg, mnB, alB, mw, hi);
  __syncthreads(); RESC(alB);
  finishSM(pB0, pB1, alB, l_reg, pa0, pa1, pa2, pa3); SBAR();
  pv_d0(o, vb0 + SHM_V, pa0, pa1, pa2, pa3);
  if (hi == 0) li_l[r32] = l_reg; asm volatile("s_waitcnt lgkmcnt(0)" ::: "memory");
  float rli[16];
#pragma unroll
  for (int r = 0; r < 16; ++r) rli[r] = __builtin_amdgcn_rcpf(li_l[crow(r, hi)]);
  __syncthreads();
  float* og_s = (float*)lds + wid * (32 * 132);
#pragma unroll
  for (int r = 0; r < 16; ++r) {
#pragma unroll
    for (int d0 = 0; d0 < 4; ++d0) og_s[crow(r, hi) * 132 + d0 * 32 + r32] = o[d0][r] * rli[r]; }
  asm volatile("" ::: "memory");
  { const int row = lane >> 1, half = lane & 1; const float* src = og_s + row * 132 + half * 64;
    f32x4 v[16]; float ss = 0.f;
#pragma unroll
    for (int i = 0; i < 16; ++i) { v[i] = *(const f32x4*)(src + 4 * i); ss += v[i][0] * v[i][0] + v[i][1] * v[i][1] + v[i][2] * v[i][2] + v[i][3] * v[i][3]; }
    ss += shx(ss, 1);
    const float rn = rsqrtf(ss * (1.f / 128.f) + EPS);
    const bf16_t* zp = Ow.zrow(row) + half * 64; bf16_t* gp = Ow.grow(row) + half * 64;
#pragma unroll
    for (int i = 0; i < 8; ++i) { float z[8], g[8]; ld8f(zp + 8 * i, z);
#pragma unroll
      for (int q = 0; q < 4; ++q) { g[q] = v[2 * i][q] * rn * siluf_(z[q]); g[4 + q] = v[2 * i + 1][q] * rn * siluf_(z[4 + q]); }
      st8f(gp + 8 * i, g); } }
  __syncthreads();
#undef SLOAD
#undef SWRITE
#undef SWAIT
#undef RESC
}
}
constexpr size_t al256(size_t x) { return (x + 255) / 256 * 256; }
constexpr size_t WS_CTL   = 0;
constexpr size_t CTL_BYTES = 65536;
constexpr size_t WS_WINT  = WS_CTL + CTL_BYTES;
constexpr size_t WS_WOUTT = WS_WINT + al256((size_t)DEPTH * NPAD * DM * 2);
constexpr size_t WS_WKVT  = WS_WOUTT + al256((size_t)DEPTH * DM * MIX * 2);
constexpr size_t WS_WGLUT = WS_WKVT + al256((size_t)DEPTH * 1024 * DM * 2);
constexpr size_t WS_MEMN  = WS_WGLUT + al256((size_t)DEPTH * 512 * 512 * 2);
constexpr size_t WS_KVMEM = WS_MEMN + al256((size_t)NB * MEML * DM * 2);
constexpr size_t WS_XN    = WS_KVMEM + al256((size_t)NB * MEML * DEPTH * 1024 * 2);
constexpr size_t WS_P     = WS_XN + al256((size_t)NTOK * DM * 2);
constexpr size_t WS_XBUF  = WS_P + al256((size_t)NTOK * NPAD * 2);
constexpr size_t WS_OCAT  = WS_XBUF + al256((size_t)NTOK * DM * 4);
constexpr size_t WS_MASK  = WS_OCAT + al256((size_t)NTOK * MIX * 2);
constexpr size_t WS_IW    = WS_MASK + al256((size_t)NTOK * 64 * 8);
constexpr size_t WS_YBUF  = WS_IW + al256((size_t)NTOK * 16 * 4);
constexpr size_t WS_ROPE  = WS_YBUF + al256((size_t)NTOK * 512 * 2);
constexpr size_t WS_S5P   = WS_ROPE + al256((size_t)NTOK * 48 * 4);
constexpr size_t S5P_BYTES = (size_t)DEPTH * 32 * (64 * 2 + 64 * 2 + 64 * 16 * 2) * 4;
constexpr size_t WS_GLAS  = WS_S5P + al256(S5P_BYTES);
constexpr size_t WS_GLAD  = WS_GLAS + al256((size_t)NB * 64 * 4 * 64 * 128 * 4);
constexpr size_t WS_IKC   = WS_GLAD + al256((size_t)NB * 64 * 4 * 64 * 4);
constexpr size_t WS_KVC   = WS_IKC + al256((size_t)NTOK * 64 * 2);
constexpr size_t WS_IQL   = WS_KVC + al256((size_t)NTOK * 256 * 2);
constexpr size_t WS_SSQ   = WS_IQL + al256((size_t)NTOK * 64 * 2);
constexpr size_t DSP_SLOT = (size_t)(256 * 128 + 512) * 4;
constexpr size_t WS_DSP   = WS_SSQ + 256;
constexpr size_t WS_END   = WS_DSP + al256((size_t)160 * 2 * DSP_SLOT);

struct Params {
    const float* x; const float* mem; const int* pos; const float* ln_gain; const float* w_in; const float* gla_w_up; const float* gla_b_up;
    const float* s5_a_re; const float* s5_a_im; const float* s5_log_step; const float* s5_b_re; const float* s5_b_im; const float* s5_c_re; const float* s5_c_im;
    const float* s5_d; const float* s5_w_glu; const float* dsa_q_norm; const float* dsa_k_norm; const float* mem_norm; const float* w_mem_kv;
    const float* mem_q_norm; const float* mem_k_norm; const float* out_norm; const float* w_out;
    float* out;
    char* ws;
    __device__ __forceinline__ unsigned* ctl_() const { return (unsigned*)(ws + WS_CTL); }
    __device__ __forceinline__ bf16_t* WinT_() const { return (bf16_t*)(ws + WS_WINT); }
    __device__ __forceinline__ bf16_t* WoutT_() const { return (bf16_t*)(ws + WS_WOUTT); }
    __device__ __forceinline__ bf16_t* WkvT_() const { return (bf16_t*)(ws + WS_WKVT); }
    __device__ __forceinline__ bf16_t* WgluT_() const { return (bf16_t*)(ws + WS_WGLUT); }
    __device__ __forceinline__ bf16_t* memn_() const { return (bf16_t*)(ws + WS_MEMN); }
    __device__ __forceinline__ bf16_t* kvmem_() const { return (bf16_t*)(ws + WS_KVMEM); }
    __device__ __forceinline__ bf16_t* xn_() const { return (bf16_t*)(ws + WS_XN); }
    __device__ __forceinline__ bf16_t* p_() const { return (bf16_t*)(ws + WS_P); }
    __device__ __forceinline__ bf16_t* xbuf_() const { return (bf16_t*)(ws + WS_XBUF); }
    __device__ __forceinline__ bf16_t* ocat_() const { return (bf16_t*)(ws + WS_OCAT); }
    __device__ __forceinline__ unsigned long long* mask_() const { return (unsigned long long*)(ws + WS_MASK); }
    __device__ __forceinline__ float* iw_() const { return (float*)(ws + WS_IW); }
    __device__ __forceinline__ bf16_t* ybuf_() const { return (bf16_t*)(ws + WS_YBUF); }
    __device__ __forceinline__ float* rope_() const { return (float*)(ws + WS_ROPE); }
    __device__ __forceinline__ float* s5p_() const { return (float*)(ws + WS_S5P); }
    __device__ __forceinline__ float* glas_() const { return (float*)(ws + WS_GLAS); }
    __device__ __forceinline__ float* glad_() const { return (float*)(ws + WS_GLAD); }
    __device__ __forceinline__ bf16_t* ikc_() const { return (bf16_t*)(ws + WS_IKC); }
    __device__ __forceinline__ bf16_t* kvc_() const { return (bf16_t*)(ws + WS_KVC); }
    __device__ __forceinline__ float* ssq_() const { return (float*)(ws + WS_SSQ); }
    __device__ __forceinline__ bf16_t* iql_() const { return (bf16_t*)(ws + WS_IQL); }
    __device__ __forceinline__ char* dsp_() const { return ws + WS_DSP; }
};

__device__ __forceinline__ void transpose_tiles(const float* __restrict__ src, int K, int Nsrc, int Ndst, const float* __restrict__ scale, bf16_t* __restrict__ dst,
                                                int tile, float* lds_tile  ) {
    const int tid = TIDX(), ntn = Ndst / 256;
    const int tk = tile / ntn, tn = tile % ntn, k0 = tk * 64, n0 = tn * 256;
    __syncthreads();
    { const int ty = tid >> 4, tx = tid & 15;
      f32x4 v[2][4];
#pragma unroll
      for (int i = 0; i < 2; ++i)
#pragma unroll
        for (int q = 0; q < 4; ++q) { const int k = k0 + ty + 32 * i, n = n0 + 4 * tx + 64 * q;
          v[i][q] = (f32x4){0.f, 0.f, 0.f, 0.f};
          if (n < Nsrc) v[i][q] = *(const f32x4*)(src + (size_t)k * Nsrc + n); }
#pragma unroll
      for (int i = 0; i < 2; ++i) { const float s = scale ? scale[k0 + ty + 32 * i] : 1.f;
#pragma unroll
        for (int q = 0; q < 4; ++q) { float* t = lds_tile + (ty + 32 * i) * 257 + 4 * tx + 64 * q; t[0] = v[i][q][0] * s; t[1] = v[i][q][1] * s; t[2] = v[i][q][2] * s; t[3] = v[i][q][3] * s; } } }
    __syncthreads();
    { const int n = tid >> 1, kh = (tid & 1) * 32;
#pragma unroll
      for (int j = 0; j < 4; ++j) { const int kb = kh + 8 * j; u32x4 w;
        w.x = pk2bf(lds_tile[(kb + 0) * 257 + n], lds_tile[(kb + 1) * 257 + n]); w.y = pk2bf(lds_tile[(kb + 2) * 257 + n], lds_tile[(kb + 3) * 257 + n]);
        w.z = pk2bf(lds_tile[(kb + 4) * 257 + n], lds_tile[(kb + 5) * 257 + n]); w.w = pk2bf(lds_tile[(kb + 6) * 257 + n], lds_tile[(kb + 7) * 257 + n]);
        *(u32x4*)(dst + (size_t)(n0 + n) * K + k0 + kb) = w; } }
}

__device__ __forceinline__ void rmsnorm_rows(const float* __restrict__ X, bf16_t* __restrict__ Y, int nrows) {
    const int wid = TIDX() >> 6, lane = TIDX() & 63;
    for (int row = blockIdx.x * 8 + wid; row < nrows; row += gridDim.x * 8) {
        const float* xr = X + (size_t)row * DM; f32x4 v[8]; float ss = 0.f;
#pragma unroll
        for (int i = 0; i < 8; ++i) { v[i] = *(const f32x4*)(xr + 4 * lane + 256 * i); ss += v[i][0] * v[i][0] + v[i][1] * v[i][1] + v[i][2] * v[i][2] + v[i][3] * v[i][3]; }
        ss = wave_sum(ss); const float r = rsqrtf(ss * (1.f / DM) + EPS);
        bf16_t* yr = Y + (size_t)row * DM;
#pragma unroll
        for (int i = 0; i < 8; ++i) { u32x2 w; w.x = pk2bf(v[i][0] * r, v[i][1] * r); w.y = pk2bf(v[i][2] * r, v[i][3] * r); *(u32x2*)(yr + 4 * lane + 256 * i) = w; }
    }
}

__device__ __forceinline__ void rmsnorm_rows16(const bf16_t* __restrict__ X, bf16_t* __restrict__ Y, int nrows) {
    const int wid = TIDX() >> 6, lane = TIDX() & 63;
    for (int row = blockIdx.x * 8 + wid; row < nrows; row += gridDim.x * 8) {
        const bf16_t* xr = X + (size_t)row * DM; float v[4][8]; float ss = 0.f;
#pragma unroll
        for (int i = 0; i < 4; ++i) { ld8f(xr + 8 * lane + 512 * i, v[i]);
#pragma unroll
            for (int j = 0; j < 8; ++j) ss += v[i][j] * v[i][j]; }
        ss = wave_sum(ss); const float r = rsqrtf(ss * (1.f / DM) + EPS);
        bf16_t* yr = Y + (size_t)row * DM;
#pragma unroll
        for (int i = 0; i < 4; ++i) { float o[8];
#pragma unroll
            for (int j = 0; j < 8; ++j) o[j] = v[i][j] * r;
            st8f(yr + 8 * lane + 512 * i, o); }
    }
}

__device__ __forceinline__ void rows_bf16_ssq(const float* __restrict__ X, bf16_t* __restrict__ Y, float* __restrict__ ssq, int nrows) {
    const int wid = TIDX() >> 6, lane = TIDX() & 63;
    for (int row = blockIdx.x * 8 + wid; row < nrows; row += gridDim.x * 8) {
        const float* xr = X + (size_t)row * DM; bf16_t* yr = Y + (size_t)row * DM; float ss = 0.f;
#pragma unroll
        for (int i = 0; i < 8; ++i) { const f32x4 v = *(const f32x4*)(xr + 4 * lane + 256 * i); ss += v[0] * v[0] + v[1] * v[1] + v[2] * v[2] + v[3] * v[3];
            u32x2 w; w.x = pk2bf(v[0], v[1]); w.y = pk2bf(v[2], v[3]); *(u32x2*)(yr + 4 * lane + 256 * i) = w; }
        ss = wave_sum(ss); if (lane < 32) ssq[(size_t)row * 32 + lane] = (lane == 0) ? ss : 0.f;
    }
}
__device__ __forceinline__ void phase_prologue1(const Params& P, char* lds) {
    float* tile = (float*)lds;
    constexpr int T_IN = (DM / 64) * (NPAD / 256), T_OUT = (MIX / 64) * (DM / 256), T_KV = (DM / 64) * (1024 / 256), T_GLU = 8 * 2;
    constexpr int TOT = DEPTH * (T_IN + T_OUT + T_KV + T_GLU);
    for (int u = blockIdx.x; u < TOT; u += gridDim.x) {
        int l = u / (T_IN + T_OUT + T_KV + T_GLU), r = u % (T_IN + T_OUT + T_KV + T_GLU);
        if (r < T_IN) transpose_tiles(P.w_in + (size_t)l * DM * NIN, DM, NIN, NPAD, P.ln_gain + l * DM, P.WinT_() + (size_t)l * NPAD * DM, r, tile);
        else if ((r -= T_IN) < T_OUT) transpose_tiles(P.w_out + (size_t)l * MIX * DM, MIX, DM, DM, P.out_norm + l * MIX, P.WoutT_() + (size_t)l * DM * MIX, r, tile);
        else if ((r -= T_OUT) < T_KV) transpose_tiles(P.w_mem_kv + (size_t)l * DM * 1024, DM, 1024, 1024, P.mem_norm + l * DM, P.WkvT_() + (size_t)l * 1024 * DM, r, tile);
        else { r -= T_KV; transpose_tiles(P.s5_w_glu + (size_t)l * 512 * 512, 512, 512, 512, nullptr, P.WgluT_() + (size_t)l * 512 * 512, r, tile); }
    }
    rmsnorm_rows(P.mem, P.memn_(), NB * MEML);
}
__device__ __forceinline__ void phase_rope_table(const Params& P) {
    for (int idx = blockIdx.x * NTHR + TIDX(); idx < NTOK * 24; idx += gridDim.x * NTHR) {
        const int tok = idx / 24, i = idx % 24;
        const float e = (i < 16) ? -((float)i * 2.0f / 32.0f) : -((float)(i - 16) * 2.0f / 16.0f);
        const float inv_freq = exp2f(e * 18.931568569324174f);
        const float ang = (float)P.pos[tok] * inv_freq;
        const double a = (double)ang; const double k = rint(a * 0.15915494309189535); const float rf = (float)fma(-k, 6.283185307179586, a);
        P.rope_()[(size_t)idx * 2] = cosf(rf); P.rope_()[(size_t)idx * 2 + 1] = sinf(rf);
    }
}

__device__ __forceinline__ void phase_rmsnorm_x(const Params& P, int layer) { if (layer == 0) rmsnorm_rows(P.x, P.xn_(), NTOK); else rmsnorm_rows16(P.xbuf_(), P.xn_(), NTOK); }

__device__ __forceinline__ void phase_memk_norm(const Params& P) {
    const int wid = TIDX() >> 6, lane = TIDX() & 63;
    for (int it = blockIdx.x * 8 + wid; it < NB * MEML * DEPTH * 4; it += gridDim.x * 8) {
        const int row = it / (DEPTH * 4), l = (it / 4) % DEPTH, h = it % 4;
        bf16_t* kp = P.kvmem_() + (size_t)row * (DEPTH * 1024) + l * 1024 + h * 128 + 2 * lane;
        const unsigned w = *(const unsigned*)kp; const float a = __uint_as_float(w << 16), b = __uint_as_float(w & 0xffff0000u);
        const float ss = wave_sum(a * a + b * b), r = rsqrtf(ss * (1.f / 128.f) + EPS);
        const float* g = P.mem_k_norm + l * 128 + 2 * lane;
        *(unsigned*)kp = pk2bf(a * r * g[0], b * r * g[1]);
    }
}

__device__ __forceinline__ float sum16(float v) { v += shx(v, 1); v += shx(v, 2); v += shx(v, 4); v += shx(v, 8); return v; }

__device__ __forceinline__ void head128_norm_rope_to(const bf16_t* hp, bf16_t* dp, int l16, const float* __restrict__ gain, const float* __restrict__ cs, bool rope, bool do_store) {
    float v[8]; ld8f(hp + 8 * l16, v);
    float ss = 0.f;
#pragma unroll
    for (int j = 0; j < 8; ++j) ss += v[j] * v[j];
    ss = sum16(ss); const float r = rsqrtf(ss * (1.f / 128.f) + EPS);
#pragma unroll
    for (int j = 0; j < 8; ++j) v[j] = v[j] * r * gain[8 * l16 + j];
    if (rope) {
        float o[8];
#pragma unroll
        for (int j = 0; j < 8; ++j) o[j] = shx(v[j], 2);
        if (l16 < 4) { const int fi = (l16 & 1) * 8;
#pragma unroll
            for (int j = 0; j < 8; ++j) { const float c = cs[(fi + j) * 2], s = cs[(fi + j) * 2 + 1];
                v[j] = (l16 < 2) ? (v[j] * c - o[j] * s) : (v[j] * c + o[j] * s); } }
    }
    if (do_store) st8f(dp + 8 * l16, v);
}
__device__ __forceinline__ void head128_norm_rope(bf16_t* hp, int l16, const float* __restrict__ gain, const float* __restrict__ cs, bool rope, bool do_store) { head128_norm_rope_to(hp, hp, l16, gain, cs, rope, do_store); }
__device__ __forceinline__ void rope16_inplace(bf16_t* ip, const float* __restrict__ cs) {
    float a[8], b[8]; ld8f(ip, a); ld8f(ip + 8, b);
#pragma unroll
    for (int j = 0; j < 8; ++j) { const float c = cs[2 * j], s = cs[2 * j + 1], x1 = a[j], x2 = b[j]; a[j] = x1 * c - x2 * s; b[j] = x2 * c + x1 * s; }
    st8f(ip, a); st8f(ip + 8, b);
}
struct PrepIn { u32x4 k, i0, i1, ik0, ik1, v; bf16_t w; f32x4 c32[4], c16[4]; };
__device__ __forceinline__ void prep_load(const Params& P, int tok, int lane, PrepIn& I) {
    const int l16 = lane & 15, grp = lane >> 4;
    const bf16_t* row = P.p_() + (size_t)tok * NPAD;
    I.k = *(const u32x4*)(row + C_DK + 8 * l16);
    I.i0 = *(const u32x4*)(row + C_DIQ + (lane >> 2) * 64); I.i1 = *(const u32x4*)(row + C_DIQ + (lane >> 2) * 64 + 8);
    I.ik0 = *(const u32x4*)(row + C_DIK + (lane & 3) * 16); I.ik1 = *(const u32x4*)(row + C_DIK + (lane & 3) * 16 + 8);
    I.v = *(const u32x4*)(row + C_DV + l16 * 8);
    I.w = row[C_DIW + l16];
    const float* cs32 = P.rope_() + (size_t)tok * 48;
#pragma unroll
    for (int i = 0; i < 4; ++i) { I.c32[i] = *(const f32x4*)(cs32 + (l16 & 1) * 16 + 4 * i); I.c16[i] = *(const f32x4*)(cs32 + 32 + 4 * i); }
}
__device__ __forceinline__ void unpack8(const u32x4 w, float (&v)[8]) {
    v[0] = __uint_as_float(w.x << 16); v[1] = __uint_as_float(w.x & 0xffff0000u); v[2] = __uint_as_float(w.y << 16); v[3] = __uint_as_float(w.y & 0xffff0000u);
    v[4] = __uint_as_float(w.z << 16); v[5] = __uint_as_float(w.z & 0xffff0000u); v[6] = __uint_as_float(w.w << 16); v[7] = __uint_as_float(w.w & 0xffff0000u); }
__device__ __forceinline__ void head128_nr(float (&v)[8], int l16, const float (&gain)[8], const f32x4 (&cs)[4], bool rope) {
    float ss = 0.f;
#pragma unroll
    for (int j = 0; j < 8; ++j) ss += v[j] * v[j];
    ss = sum16(ss); const float r = rsqrtf(ss * (1.f / 128.f) + EPS);
#pragma unroll
    for (int j = 0; j < 8; ++j) v[j] = v[j] * r * gain[j];
    if (rope) {
        float o[8];
#pragma unroll
        for (int j = 0; j < 8; ++j) o[j] = shx(v[j], 2);
        if (l16 < 4) {
#pragma unroll
            for (int j = 0; j < 8; ++j) { const float c = cs[j >> 1][(j & 1) * 2], s = cs[j >> 1][(j & 1) * 2 + 1];
                v[j] = (l16 < 2) ? (v[j] * c - o[j] * s) : (v[j] * c + o[j] * s); } }
    }
}
__device__ __forceinline__ void prep_finish(const Params& P, int tok, int lane, const PrepIn& I, const float (&gq)[8], const float (&gk)[8], const float (&gm)[8]) {
    const int l16 = lane & 15, grp = lane >> 4;
    bf16_t* row = P.p_() + (size_t)tok * NPAD;
    float k[8];
    unpack8(I.k, k);
    head128_nr(k, l16, gk, I.c32, true);
    if (grp == 0) st8f(P.kvc_() + (size_t)tok * 256 + 8 * l16, k);
    {
        float a[8], b[8]; unpack8(I.i0, a); unpack8(I.i1, b);
#pragma unroll
        for (int j = 0; j < 8; ++j) { const float c = I.c16[j >> 1][(j & 1) * 2], s = I.c16[j >> 1][(j & 1) * 2 + 1], x1 = a[j], x2 = b[j]; a[j] = x1 * c - x2 * s; b[j] = x2 * c + x1 * s; }
        if ((lane & 3) == 0) { st8f(row + C_DIQ + (lane >> 2) * 64, a); st8f(row + C_DIQ + (lane >> 2) * 64 + 8, b); } }
    {
        float a[8], b[8]; unpack8(I.ik0, a); unpack8(I.ik1, b);
        if ((lane & 3) == 0) {
#pragma unroll
            for (int j = 0; j < 8; ++j) { const float c = I.c16[j >> 1][(j & 1) * 2], s = I.c16[j >> 1][(j & 1) * 2 + 1], x1 = a[j], x2 = b[j]; a[j] = x1 * c - x2 * s; b[j] = x2 * c + x1 * s; } }
        if (lane < 4) { bf16_t* dst = P.ikc_() + (size_t)(tok >> 5) * 2048 + lane * 512 + (tok & 31) * 8; st8f(dst, a); st8f(dst + 256, b); } }
    if (lane >= 16 && lane < 32) *(u32x4*)(P.kvc_() + (size_t)tok * 256 + 128 + l16 * 8) = I.v;
    if (lane < 16) P.iw_()[(size_t)tok * 16 + lane] = bf2f(I.w) * (1.f / 32.f);
}
__device__ __forceinline__ void phase_prep(const Params& P, int layer) {
    const int wid = TIDX() >> 6, lane = TIDX() & 63, l16 = lane & 15;
    float gq[8], gk[8], gm[8];
#pragma unroll
    for (int j = 0; j < 8; ++j) { gq[j] = P.dsa_q_norm[layer * 128 + 8 * l16 + j]; gk[j] = P.dsa_k_norm[layer * 128 + 8 * l16 + j]; gm[j] = P.mem_q_norm[layer * 128 + 8 * l16 + j]; }
    const int stride = gridDim.x * 8;
    for (int tok = blockIdx.x * 8 + wid; tok < NTOK; tok += 2 * stride) {
        const int tok2 = tok + stride; const bool two = tok2 < NTOK;
        PrepIn A, B2;
        prep_load(P, tok, lane, A); prep_load(P, two ? tok2 : tok, lane, B2);
        prep_finish(P, tok, lane, A, gq, gk, gm);
        if (two) prep_finish(P, tok2, lane, B2, gq, gk, gm);
    }
}
struct MemOutRow { const bf16_t* zb; bf16_t* gb;
    __device__ __forceinline__ const bf16_t* zrow(int r) const { return zb + (size_t)r * NPAD; } __device__ __forceinline__ bf16_t* grow(int r) const { return gb + (size_t)r * MIX; } };
__device__ __forceinline__ void unit_mem_attn(const Params& P, int layer, int u, char* lds) {
    const int b = u >> 6, h = (u >> 4) & 3, qb = u & 15, tok0 = b * SEQ + qb * 256;
    const int wid = TIDX() >> 6, lane = TIDX() & 63, r32 = lane & 31, hi = lane >> 5;
    const bf16_t* Qw = P.p_() + (size_t)(tok0 + wid * 32 + r32) * NPAD + C_MQ + h * 128 + hi * 8;
    const bf16_t* Kh = P.kvmem_() + (size_t)(b * MEML) * (DEPTH * 1024) + layer * 1024 + h * 128;
    MemOutRow ow; ow.zb = P.p_() + (size_t)(tok0 + wid * 32) * NPAD + C_MZ + h * 128; ow.gb = P.xn_() + (size_t)(tok0 + wid * 32) * MIX + 1536 + h * 128;
    att::attn_body<false, DEPTH * 1024, 512, 1, MemOutRow>(Qw, P.mem_q_norm + layer * 128, nullptr, Kh, MEML / 64, nullptr, 0u, ow, lds);
}

__device__ __forceinline__ void phase_gate(const Params& P, int c_lo, int c_hi) {
    const int wid = TIDX() >> 6, lane = TIDX() & 63;
    const int c0 = lane * 32;
    const int seg = c0 >> 9, zc = (seg == 0 ? C_GZ : seg == 1 ? C_SZ : seg == 2 ? C_DZ : C_MZ) + (c0 & 511);
    const bool act = (c0 >= c_lo) && (c0 < c_hi);
    for (int tok = blockIdx.x * 8 + wid; tok < NTOK; tok += gridDim.x * 8) {
        if (!act) { bf16_t* gz_ = P.xn_() + (size_t)tok * MIX + c0; const u32x4 zz = {0u, 0u, 0u, 0u};
#pragma unroll
            for (int i = 0; i < 4; ++i) *(u32x4*)(gz_ + 8 * i) = zz;
            continue; }
        const bf16_t* op = P.ocat_() + (size_t)tok * MIX + c0; const bf16_t* zp = P.p_() + (size_t)tok * NPAD + zc; bf16_t* gp = P.xn_() + (size_t)tok * MIX + c0;
        float o[32]; float ss = 0.f;
#pragma unroll
        for (int i = 0; i < 4; ++i) { float v[8]; ld8f(op + 8 * i, v);
#pragma unroll
            for (int j = 0; j < 8; ++j) { o[8 * i + j] = v[j]; ss += v[j] * v[j]; } }
        ss += shx(ss, 1); ss += shx(ss, 2);
        const float r = rsqrtf(ss * (1.f / 128.f) + EPS);
#pragma unroll
        for (int i = 0; i < 4; ++i) { float z[8], g[8]; ld8f(zp + 8 * i, z);
#pragma unroll
            for (int j = 0; j < 8; ++j) g[j] = o[8 * i + j] * r * siluf_(z[j]);
            st8f(gp + 8 * i, g); }
    }
}

__device__ __forceinline__ void phase_gemm_in(const Params& P, int layer, char* lds) {
    pg8::Gemm g; g.A = P.xn_(); g.Bt = P.WinT_() + (size_t)layer * NPAD * DM; g.M = NTOK; g.N = NPAD; g.K = DM;
    pg8::StaticOrder S; S.init(g.M, g.N, (int)gridDim.x, (int)blockIdx.x);
    pg8::EpiBf16Plain E; E.O = P.p_(); E.ldc = NPAD;
    pg8::gemm_phase<pg8::EpiBf16Plain, pg8::StaticOrder, false>((PG8_LAS unsigned char*)lds, g, S, E, nullptr);
}
__device__ __forceinline__ void phase_gemm_out(const Params& P, int layer, char* lds) {
    pg8::Gemm g; g.A = P.xn_(); g.Bt = P.WoutT_() + (size_t)layer * DM * MIX; g.M = NTOK; g.N = DM; g.K = MIX;
    pg8::StaticOrder S; S.init(g.M, g.N, (int)gridDim.x, (int)blockIdx.x);
    pg8::EpiResidMix E; E.R = (layer == 0) ? (const void*)P.x : (const void*)P.xbuf_(); E.C = (layer == DEPTH - 1) ? (void*)P.out : (void*)P.xbuf_(); E.ldc = DM;
    E.r16 = (layer != 0); E.c16 = (layer != DEPTH - 1);
    pg8::gemm_phase<pg8::EpiResidMix, pg8::StaticOrder, false>((PG8_LAS unsigned char*)lds, g, S, E, nullptr);
}
__device__ __forceinline__ void phase_gemm_kv(const Params& P, char* lds) {
    pg8::Gemm g; g.A = P.memn_(); g.Bt = P.WkvT_(); g.M = NB * MEML; g.N = DEPTH * 1024; g.K = DM;
    pg8::StaticOrder S; S.init(g.M, g.N, (int)gridDim.x, (int)blockIdx.x);
    pg8::EpiBf16Plain E; E.O = P.kvmem_(); E.ldc = DEPTH * 1024;
    pg8::gemm_phase<pg8::EpiBf16Plain, pg8::StaticOrder, false>((PG8_LAS unsigned char*)lds, g, S, E, nullptr);
}
__device__ __forceinline__ void mma_tile(f32x16& acc, const char* A, int lda, const char* B, int ldb, int K, int lane) {
    const int r = lane & 31, kh = lane >> 5;
    const char* ap = A + r * lda + kh * 16; const char* bp = B + r * ldb + kh * 16;
    asm volatile("" : "+v"(acc));
    for (int k = 0; k < K; k += 16) {
        const bf16x8 a = *(const bf16x8*)(ap + k * 2); const bf16x8 b = *(const bf16x8*)(bp + k * 2);
        acc = __builtin_amdgcn_mfma_f32_32x32x16_bf16(a, b, acc, 0, 0, 0);
    }
}
__device__ __forceinline__ int crow32(int r, int hi) { return (r & 3) + 8 * (r >> 2) + 4 * hi; }
__device__ __forceinline__ float log_sigmoid_(float x) { return fminf(x, 0.f) - log1pf(__expf(-fabsf(x))); }

constexpr int GLA_ST = 144;
constexpr int GC_BST = 68;
constexpr int GC_B_BYTES = 4 * 64 * GC_BST * 4, GC_V_BYTES = 4 * 16384;
__device__ __forceinline__ float* gla_gb(const Params& P) { return (float*)((char*)P.ocat_() + (size_t)32 * 1024 * 1024); }
__device__ __forceinline__ float log_sigmoid_fast(float x) { return fminf(x, 0.f) - __logf(1.f + __expf(-fabsf(x))); }

__device__ __forceinline__ void unit_gla_a4(const Params& P, int layer, int ub, char* lds) {
    const int b = ub >> 6, n = ub & 63, tok0 = b * SEQ + n * 64;
    const int tid = TIDX(), wid = tid >> 6, lane = tid & 63, r32 = lane & 31, hi = lane >> 5, h = wid >> 1, eh = wid & 1;
    float* b_s = (float*)lds;
    char* V_s = lds;
    char* K_s = lds + GC_B_BYTES;
    float* glr_s = (float*)(lds + GC_B_BYTES + GC_V_BYTES);
    float* tot_s = glr_s + 1024;
    __syncthreads();
    const bf16_t* prow = P.p_() + (size_t)tok0 * NPAD;
    const bf16x8 glr_raw = *(const bf16x8*)(prow + (size_t)((tid & 127) >> 1) * NPAD + C_GLR + (tid & 1) * 8);
    const int gd = tid & 63, gh = (tid >> 6) & 3, gt = tid >> 8;
    float wu[16];
#pragma unroll
    for (int r = 0; r < 16; ++r) wu[r] = P.gla_w_up[((size_t)layer * 16 + r) * 256 + gh * 64 + gd];
    const float bias = P.gla_b_up[layer * 256 + gh * 64 + gd];
    bf16x8 kraw[4], vs[4][2];
    const int ks_ = tid >> 3, kc = (tid & 7) * 8;
#pragma unroll
    for (int hv = 0; hv < 4; ++hv) kraw[hv] = *(const bf16x8*)(prow + (size_t)ks_ * NPAD + C_GK + hv * 64 + kc);
    const int sr = tid >> 4, sc = (tid & 15) * 8;
#pragma unroll
    for (int hv = 0; hv < 4; ++hv) { vs[hv][0] = *(const bf16x8*)(prow + (size_t)sr * NPAD + C_GV + hv * 128 + sc); vs[hv][1] = *(const bf16x8*)(prow + (size_t)(32 + sr) * NPAD + C_GV + hv * 128 + sc); }
    if (tid < 128) {
#pragma unroll
        for (int j = 0; j < 8; ++j) glr_s[(tid >> 1) * 16 + (tid & 1) * 8 + j] = bf2f((bf16_t)glr_raw[j]); }
    __syncthreads();
    float gv[32]; float run = 0.f;
#pragma unroll
    for (int i = 0; i < 32; ++i) { const float* gr = glr_s + (gt * 32 + i) * 16; float a = bias;
#pragma unroll
        for (int r4 = 0; r4 < 4; ++r4) { const f32x4 g4 = *(const f32x4*)(gr + 4 * r4); a = fmaf(g4[0], wu[4 * r4], a); a = fmaf(g4[1], wu[4 * r4 + 1], a); a = fmaf(g4[2], wu[4 * r4 + 2], a); a = fmaf(g4[3], wu[4 * r4 + 3], a); }
        run += log_sigmoid_fast(a) * (1.f / 16.f); gv[i] = run; }
    if (gt == 0) tot_s[gh * 64 + gd] = run;
    __syncthreads();
    { const float off = gt ? tot_s[gh * 64 + gd] : 0.f; float* bp = b_s + (gh * 64 + gt * 32) * GC_BST + gd;
      float* gp = gla_gb(P) + (size_t)(tok0 + gt * 32) * 256 + gh * 64 + gd;
#pragma unroll
      for (int i = 0; i < 32; ++i) { const float v = gv[i] + off; bp[i * GC_BST] = v; gp[(size_t)i * 256] = v; }
      if (gt) P.glad_()[((size_t)((b * 64 + n) * 4 + gh)) * 64 + gd] = __expf(gv[31] + off); }
    __syncthreads();
#pragma unroll
    for (int hv = 0; hv < 4; ++hv) { const float* br = b_s + (hv * 64 + ks_) * GC_BST + kc; const float* bl = b_s + (hv * 64 + 63) * GC_BST + kc;
        const f32x4 b0 = *(const f32x4*)br, b1 = *(const f32x4*)(br + 4), l0 = *(const f32x4*)bl, l1 = *(const f32x4*)(bl + 4);
        float e[8];
#pragma unroll
        for (int j = 0; j < 8; ++j) e[j] = bf2f((bf16_t)kraw[hv][j]) * __expf((j < 4 ? l0[j] : l1[j - 4]) - (j < 4 ? b0[j] : b1[j - 4]));
        u32x4 w = {att::cvtpk(e[0], e[1]), att::cvtpk(e[2], e[3]), att::cvtpk(e[4], e[5]), att::cvtpk(e[6], e[7])};
        *(u32x4*)(K_s + hv * 16384 + att::v_st(ks_, kc)) = w; }
    __syncthreads();
    { const int vst0 = att::v_st(sr, sc), vst1 = att::v_st(32 + sr, sc);
#pragma unroll
      for (int hv = 0; hv < 4; ++hv) { *(bf16x8*)(V_s + hv * 16384 + vst0) = vs[hv][0]; *(bf16x8*)(V_s + hv * 16384 + vst1) = vs[hv][1]; } }
    __syncthreads();
    const int vb = (int)(uintptr_t)(V_s + h * 16384) + att::v_rd_base(lane), kb = (int)(uintptr_t)(K_s + h * 16384) + att::v_rd_base(lane);
    f32x16 acc[2][2] = {};
    asm volatile("" : "+v"(acc[0][0]), "+v"(acc[0][1]), "+v"(acc[1][0]), "+v"(acc[1][1]));
#define GA_PK(L, H) (bf16x8){L[0], L[1], L[2], L[3], H[0], H[1], H[2], H[3]}
#define GA_STEP(KS) do { \
    const s16x4 k0l = att::tr_read<att::v_rd_off(0, KS, 0)>(kb), k0h = att::tr_read<att::v_rd_off(0, KS, 1)>(kb), k1l = att::tr_read<att::v_rd_off(1, KS, 0)>(kb), k1h = att::tr_read<att::v_rd_off(1, KS, 1)>(kb); \
    s16x4 v0l, v0h, v1l, v1h; \
    if (eh == 0) { v0l = att::tr_read<att::v_rd_off(0, KS, 0)>(vb); v0h = att::tr_read<att::v_rd_off(0, KS, 1)>(vb); v1l = att::tr_read<att::v_rd_off(1, KS, 0)>(vb); v1h = att::tr_read<att::v_rd_off(1, KS, 1)>(vb); } \
    else         { v0l = att::tr_read<att::v_rd_off(2, KS, 0)>(vb); v0h = att::tr_read<att::v_rd_off(2, KS, 1)>(vb); v1l = att::tr_read<att::v_rd_off(3, KS, 0)>(vb); v1h = att::tr_read<att::v_rd_off(3, KS, 1)>(vb); } \
    asm volatile("s_waitcnt lgkmcnt(0)" ::: "memory"); __builtin_amdgcn_sched_barrier(0); \
    acc[0][0] = __builtin_amdgcn_mfma_f32_32x32x16_bf16(GA_PK(v0l, v0h), GA_PK(k0l, k0h), acc[0][0], 0, 0, 0); \
    acc[0][1] = __builtin_amdgcn_mfma_f32_32x32x16_bf16(GA_PK(v0l, v0h), GA_PK(k1l, k1h), acc[0][1], 0, 0, 0); \
    acc[1][0] = __builtin_amdgcn_mfma_f32_32x32x16_bf16(GA_PK(v1l, v1h), GA_PK(k0l, k0h), acc[1][0], 0, 0, 0); \
    acc[1][1] = __builtin_amdgcn_mfma_f32_32x32x16_bf16(GA_PK(v1l, v1h), GA_PK(k1l, k1h), acc[1][1], 0, 0, 0); } while (0)
    GA_STEP(0); GA_STEP(1); GA_STEP(2); GA_STEP(3);
#undef GA_STEP
#undef GA_PK
    float* dst = P.glas_() + ((size_t)((b * 64 + n) * 4 + h)) * 8192;
#pragma unroll
    for (int et = 0; et < 2; ++et)
#pragma unroll
        for (int dt = 0; dt < 2; ++dt)
#pragma unroll
            for (int r = 0; r < 16; ++r) dst[((eh * 2 + et) * 32 + att::crow(r, hi)) * 64 + dt * 32 + r32] = acc[et][dt][r];
    __syncthreads();
}

__device__ __forceinline__ void gla_scan_slice(const Params& P, int idx) {
    {
        const int el = idx & 8191, d = idx & 63, h = (idx >> 13) & 3, b = idx >> 15;
        bf16_t* gst = P.ocat_();
        float S = 0.f;
        for (int n0 = 0; n0 < 64; n0 += 8) {
            float ds[8], dc[8];
#pragma unroll
            for (int i = 0; i < 8; ++i) { const size_t cu = (size_t)((b * 64 + n0 + i) * 4 + h); ds[i] = P.glas_()[cu * 8192 + el]; dc[i] = P.glad_()[cu * 64 + d]; }
#pragma unroll
            for (int i = 0; i < 8; ++i) { const size_t cu = (size_t)((b * 64 + n0 + i) * 4 + h); gst[cu * 8192 + el] = f2bf(S); S = fmaf(dc[i], S, ds[i]); }
        }
    }
}

__device__ __forceinline__ void unit_gla_c4(const Params& P, int layer, int ub, char* lds) {
    const int b = ub >> 6, n = ub & 63, tok0 = b * SEQ + n * 64;
    const int tid = TIDX(), wid = tid >> 6, lane = tid & 63, r32 = lane & 31, hi = lane >> 5, h = wid >> 1, rh = wid & 1;
    float* b_s = (float*)lds;
    char* V_s = lds + GC_B_BYTES;
    __syncthreads();
    const bf16_t* prow = P.p_() + (size_t)tok0 * NPAD;
    bf16x8 qraw[4], kraw[2][4], vs[4][2];
    const int sr = tid >> 4, sc = (tid & 15) * 8;
#pragma unroll
    for (int hv = 0; hv < 4; ++hv) { vs[hv][0] = *(const bf16x8*)(prow + (size_t)sr * NPAD + C_GV + hv * 128 + sc); vs[hv][1] = *(const bf16x8*)(prow + (size_t)(32 + sr) * NPAD + C_GV + hv * 128 + sc); }
    f32x4 braw[8];
    { const float* gp = gla_gb(P) + (size_t)tok0 * 256 + tid * 4;
#pragma unroll
      for (int i = 0; i < 8; ++i) braw[i] = *(const f32x4*)(gp + i * 2048); }
    { const bf16_t* qp = prow + (size_t)(rh * 32 + r32) * NPAD + C_GQ + h * 64 + hi * 8;
#pragma unroll
      for (int d0 = 0; d0 < 4; ++d0) qraw[d0] = *(const bf16x8*)(qp + d0 * 16);
#pragma unroll
      for (int sh = 0; sh < 2; ++sh) { const bf16_t* kp = prow + (size_t)(sh * 32 + r32) * NPAD + C_GK + h * 64 + hi * 8;
#pragma unroll
          for (int d0 = 0; d0 < 4; ++d0) kraw[sh][d0] = *(const bf16x8*)(kp + d0 * 16); } }
    bf16x8 sfr[4][4];
    { const bf16_t* sp = P.ocat_() + ((size_t)((b * 64 + n) * 4 + h)) * 8192 + r32 * 64 + hi * 8;
#pragma unroll
      for (int eb = 0; eb < 4; ++eb)
#pragma unroll
          for (int ds = 0; ds < 4; ++ds) sfr[eb][ds] = *(const bf16x8*)(sp + eb * 32 * 64 + ds * 16); }
    { const int vst0 = att::v_st(sr, sc), vst1 = att::v_st(32 + sr, sc);
#pragma unroll
      for (int hv = 0; hv < 4; ++hv) { *(bf16x8*)(V_s + hv * 16384 + vst0) = vs[hv][0]; *(bf16x8*)(V_s + hv * 16384 + vst1) = vs[hv][1]; } }
#pragma unroll
    for (int i = 0; i < 8; ++i) { const int c = tid + 512 * i, t = c >> 6, c4 = c & 63;
        *(f32x4*)(b_s + ((c4 >> 4) * 64 + t) * GC_BST + (c4 & 15) * 4) = braw[i]; }
    __syncthreads();
    const float* bh = b_s + h * 64 * GC_BST + hi * 8;
    bf16x8 qe[4], qb[4], ke[2][4];
#pragma unroll
    for (int d0 = 0; d0 < 4; ++d0) {
        const f32x4 m0 = *(const f32x4*)(bh + 32 * GC_BST + d0 * 16), m1 = *(const f32x4*)(bh + 32 * GC_BST + d0 * 16 + 4);
        const f32x4 q0 = *(const f32x4*)(bh + (rh * 32 + r32) * GC_BST + d0 * 16), q1 = *(const f32x4*)(bh + (rh * 32 + r32) * GC_BST + d0 * 16 + 4);
        float e1[8], e2[8];
#pragma unroll
        for (int j = 0; j < 8; ++j) { const float mv = j < 4 ? m0[j] : m1[j - 4], bq = j < 4 ? q0[j] : q1[j - 4]; const float q = bf2f((bf16_t)qraw[d0][j]) * 0.125f;
            e1[j] = q * __expf(bq - mv); e2[j] = q * __expf(bq); }
        { u32x4 w = {att::cvtpk(e1[0], e1[1]), att::cvtpk(e1[2], e1[3]), att::cvtpk(e1[4], e1[5]), att::cvtpk(e1[6], e1[7])}; qe[d0] = *reinterpret_cast<bf16x8*>(&w); }
        { u32x4 w = {att::cvtpk(e2[0], e2[1]), att::cvtpk(e2[2], e2[3]), att::cvtpk(e2[4], e2[5]), att::cvtpk(e2[6], e2[7])}; qb[d0] = *reinterpret_cast<bf16x8*>(&w); }
#pragma unroll
        for (int sh = 0; sh < 2; ++sh) {
            const f32x4 k0 = *(const f32x4*)(bh + (sh * 32 + r32) * GC_BST + d0 * 16), k1 = *(const f32x4*)(bh + (sh * 32 + r32) * GC_BST + d0 * 16 + 4);
            float e3[8];
#pragma unroll
            for (int j = 0; j < 8; ++j) { const float mv = j < 4 ? m0[j] : m1[j - 4], bk = j < 4 ? k0[j] : k1[j - 4]; e3[j] = bf2f((bf16_t)kraw[sh][d0][j]) * __expf(mv - bk); }
            u32x4 w = {att::cvtpk(e3[0], e3[1]), att::cvtpk(e3[2], e3[3]), att::cvtpk(e3[4], e3[5]), att::cvtpk(e3[6], e3[7])}; ke[sh][d0] = *reinterpret_cast<bf16x8*>(&w); }
    }
    f32x16 p0 = {}, p1 = {};
    asm volatile("" : "+v"(p0), "+v"(p1));
#pragma unroll
    for (int d0 = 0; d0 < 4; ++d0) { p0 = __builtin_amdgcn_mfma_f32_32x32x16_bf16(ke[0][d0], qe[d0], p0, 0, 0, 0); p1 = __builtin_amdgcn_mfma_f32_32x32x16_bf16(ke[1][d0], qe[d0], p1, 0, 0, 0); }
    { const int t = rh * 32 + r32;
#pragma unroll
      for (int r = 0; r < 16; ++r) { const int s0 = att::crow(r, hi); p0[r] = (s0 <= t) ? p0[r] : 0.f; p1[r] = (32 + s0 <= t) ? p1[r] : 0.f; } }
    bf16x8 pa0, pa1, pa2, pa3;
#define GC_PK4(Pv, BASE, OUT) do { unsigned a0 = att::cvtpk(Pv[BASE + 0], Pv[BASE + 1]), a1 = att::cvtpk(Pv[BASE + 2], Pv[BASE + 3]);   \
    unsigned b0 = att::cvtpk(Pv[BASE + 4], Pv[BASE + 5]), b1 = att::cvtpk(Pv[BASE + 6], Pv[BASE + 7]);                              \
    auto r0 = __builtin_amdgcn_permlane32_swap(a0, b0, false, false); auto r1 = __builtin_amdgcn_permlane32_swap(a1, b1, false, false); \
    u32x4 w = {r0[0], r1[0], r0[1], r1[1]}; OUT = *reinterpret_cast<bf16x8*>(&w); } while (0)
    GC_PK4(p0, 0, pa0); GC_PK4(p0, 8, pa1); GC_PK4(p1, 0, pa2); GC_PK4(p1, 8, pa3);
#undef GC_PK4
    f32x16 o[4] = {};
    asm volatile("" : "+v"(o[0]), "+v"(o[1]), "+v"(o[2]), "+v"(o[3]));
    att::pv_d0(o, (int)(uintptr_t)(V_s + h * 16384) + att::v_rd_base(lane), pa0, pa1, pa2, pa3);
#pragma unroll
    for (int eb = 0; eb < 4; ++eb)
#pragma unroll
        for (int ds = 0; ds < 4; ++ds) o[eb] = __builtin_amdgcn_mfma_f32_32x32x16_bf16(qb[ds], sfr[eb][ds], o[eb], 0, 0, 0);
    __syncthreads();
    float* og_s = (float*)lds + wid * (32 * 132);
#pragma unroll
    for (int r = 0; r < 16; ++r) {
#pragma unroll
        for (int eb = 0; eb < 4; ++eb) og_s[att::crow(r, hi) * 132 + eb * 32 + r32] = o[eb][r]; }
    asm volatile("" ::: "memory");
    { const int row = lane >> 1, half = lane & 1; const float* src = og_s + row * 132 + half * 64;
      f32x4 v[16]; float ss = 0.f;
#pragma unroll
      for (int i = 0; i < 16; ++i) { v[i] = *(const f32x4*)(src + 4 * i); ss += v[i][0] * v[i][0] + v[i][1] * v[i][1] + v[i][2] * v[i][2] + v[i][3] * v[i][3]; }
      ss += shx(ss, 1);
      const float rn = rsqrtf(ss * (1.f / 128.f) + EPS);
      const size_t tok = (size_t)(tok0 + rh * 32 + row);
      const bf16_t* zp = P.p_() + tok * NPAD + C_GZ + h * 128 + half * 64; bf16_t* gp = P.xn_() + tok * MIX + h * 128 + half * 64;
#pragma unroll
      for (int i = 0; i < 8; ++i) { float z[8], g[8]; ld8f(zp + 8 * i, z);
#pragma unroll
          for (int q = 0; q < 4; ++q) { g[q] = v[2 * i][q] * rn * siluf_(z[q]); g[4 + q] = v[2 * i + 1][q] * rn * siluf_(z[4 + q]); }
          st8f(gp + 8 * i, g); } }
    __syncthreads();
}
constexpr int S5P_STRIDE = 2304;
__device__ __forceinline__ void phase_s5_params(const Params& P) {
    for (int idx = blockIdx.x * NTHR + TIDX(); idx < DEPTH * 32 * 64; idx += gridDim.x * NTHR) {
        const int p = idx & 63, lg = idx >> 6;
        const float ar = P.s5_a_re[idx], ai = P.s5_a_im[idx], step = expf(P.s5_log_step[lg]);
        const float mag = expf(ar * step), th = ai * step;
        const float lr = mag * cosf(th), li = mag * sinf(th);
        float* o = P.s5p_() + (size_t)lg * S5P_STRIDE;
        o[2 * p] = lr; o[2 * p + 1] = li;
        { const float mag512 = expf(512.f * ar * step); const double a = 512.0 * (double)th; const double k = rint(a * 0.15915494309189535); const float rf = (float)fma(-k, 6.283185307179586, a);
          o[128 + 2 * p] = mag512 * cosf(rf); o[128 + 2 * p + 1] = mag512 * sinf(rf); }
        const float xr = lr - 1.f, xi = li, den = 1.f / (ar * ar + ai * ai);
        const float fr = (xr * ar + xi * ai) * den, fi = (xi * ar - xr * ai) * den;
        for (int c = 0; c < 16; ++c) { const float br = P.s5_b_re[(size_t)idx * 16 + c], bi = P.s5_b_im[(size_t)idx * 16 + c];
            o[256 + (p * 16 + c) * 2] = fr * br - fi * bi; o[256 + (p * 16 + c) * 2 + 1] = fr * bi + fi * br; }
    }
}
__device__ __forceinline__ float gelu_tanh_(float x) { const float u = 0.7978845608028654f * (x + 0.044715f * x * x * x); const float e = __expf(-2.f * fabsf(u)); const float th = copysignf((1.f - e) / (1.f + e), u); return 0.5f * x * (1.f + th); }

constexpr int S5_XST = 272;
constexpr int S5_UST = 48;
__device__ __forceinline__ float partner32(float v, int hi) { auto rr = __builtin_amdgcn_permlane32_swap(__float_as_uint(v), __float_as_uint(v), false, false); return __uint_as_float(hi ? rr[0] : rr[1]); }
struct S5Ctx { float l0r, l0i, l1r, l1i, q0r, q0i, q1r, q1i, dsk; char* Cm; char* Bb; char* Xs; char* Us; int lane, hi, j, rho; const bf16_t* ubase; bf16_t* ybase; };
template <bool OUT> __device__ __forceinline__ void s5_tile(const S5Ctx& C, int tok0, float& x0r, float& x0i, float& x1r, float& x1i) {
    const int hi = C.hi, j = C.j, lane = C.lane;
    if (hi == 0) { const bf16_t* up = C.ubase + (size_t)(tok0 + j) * NPAD;
        const bf16x8 w0 = *(const bf16x8*)up, w1 = *(const bf16x8*)(up + 8);
        *(bf16x8*)(C.Us + C.rho * S5_UST) = w0; *(bf16x8*)(C.Us + C.rho * S5_UST + 16) = w1; }
    asm volatile("" ::: "memory");
    f32x16 a0 = {}, a1 = {}, a2 = {}, a3 = {};
    mma_tile(a0, C.Us, S5_UST, C.Bb, S5_UST, 16, lane); mma_tile(a1, C.Us, S5_UST, C.Bb + 32 * S5_UST, S5_UST, 16, lane);
    mma_tile(a2, C.Us, S5_UST, C.Bb + 64 * S5_UST, S5_UST, 16, lane); mma_tile(a3, C.Us, S5_UST, C.Bb + 96 * S5_UST, S5_UST, 16, lane);
    float s0r[16], s0i[16], s1r[16], s1i[16];
#pragma unroll
    for (int r = 0; r < 16; ++r) {
        const float n0r = fmaf(C.l0r, x0r, fmaf(-C.l0i, x0i, a0[r])), n0i = fmaf(C.l0r, x0i, fmaf(C.l0i, x0r, a1[r])); x0r = n0r; x0i = n0i; s0r[r] = n0r; s0i[r] = n0i;
        const float n1r = fmaf(C.l1r, x1r, fmaf(-C.l1i, x1i, a2[r])), n1i = fmaf(C.l1r, x1i, fmaf(C.l1i, x1r, a3[r])); x1r = n1r; x1i = n1i; s1r[r] = n1r; s1i[r] = n1i; }
    float z0r = partner32(x0r, hi), z0i = partner32(x0i, hi), z1r = partner32(x1r, hi), z1i = partner32(x1i, hi);
    if (hi == 0) { z0r = 0.f; z0i = 0.f; z1r = 0.f; z1i = 0.f; }
    if (!OUT) {
        x0r += C.q0r * z0r - C.q0i * z0i; x0i += C.q0r * z0i + C.q0i * z0r; x1r += C.q1r * z1r - C.q1i * z1i; x1i += C.q1r * z1i + C.q1i * z1r;
    } else {
#pragma unroll
        for (int r = 0; r < 16; ++r) {
            const float t0r = C.l0r * z0r - C.l0i * z0i, t0i = C.l0r * z0i + C.l0i * z0r; z0r = t0r; z0i = t0i; s0r[r] += t0r; s0i[r] += t0i;
            const float t1r = C.l1r * z1r - C.l1i * z1i, t1i = C.l1r * z1i + C.l1i * z1r; z1r = t1r; z1i = t1i; s1r[r] += t1r; s1i[r] += t1i; }
        x0r = s0r[15]; x0i = s0i[15]; x1r = s1r[15]; x1i = s1i[15];
#pragma unroll
        for (int r = 0; r < 16; ++r) { char* xr_ = C.Xs + (r + 16 * hi) * S5_XST;
            *(bf16_t*)(xr_ + j * 2) = f2bf(s0r[r]); *(bf16_t*)(xr_ + (64 + j) * 2) = f2bf(s0i[r]);
            *(bf16_t*)(xr_ + (32 + j) * 2) = f2bf(s1r[r]); *(bf16_t*)(xr_ + (96 + j) * 2) = f2bf(s1i[r]); }
        asm volatile("" ::: "memory");
        f32x16 acc = {}; mma_tile(acc, C.Xs, S5_XST, C.Cm, S5_XST, 128, lane);
        if (j < 16) {
#pragma unroll
            for (int r = 0; r < 16; ++r) { const int t = crow32(r, hi); const int rt = ((t & 15) & 3) + 8 * ((t & 15) >> 2) + 4 * (t >> 4);
                const float y = acc[r] + C.dsk * bf2f(*(const bf16_t*)(C.Us + rt * S5_UST + j * 2));
                C.ybase[(size_t)(tok0 + t) * 512 + j] = f2bf(gelu_tanh_(y)); } }
        asm volatile("" ::: "memory");
    }
    { const float e0r = partner32(x0r, hi), e0i = partner32(x0i, hi), e1r = partner32(x1r, hi), e1i = partner32(x1i, hi);
      if (hi == 0) { x0r = e0r; x0i = e0i; x1r = e1r; x1i = e1i; } else { x0r = 0.f; x0i = 0.f; x1r = 0.f; x1i = 0.f; } }
}
__device__ __forceinline__ void unit_s5(const Params& P, int layer, int u, char* lds) {
    const int b = u >> 5, g = u & 31, tid = TIDX(), wid = tid >> 6, lane = tid & 63, hi = lane >> 5, j = lane & 31;
    char* Cm = lds;
    char* Bb = Cm + 32 * S5_XST;
    float* ends = (float*)(Bb + 128 * S5_UST);
    char* wbase = (char*)(ends + 8 * 64 * 2) + wid * (32 * S5_XST + 32 * S5_UST);
    const float* sp = P.s5p_() + (size_t)(layer * 32 + g) * S5P_STRIDE;
    __syncthreads();
    for (int i = tid; i < 32 * 128; i += NTHR) { const int c = i >> 7, pp = i & 127; float v = 0.f;
        if (c < 16) v = (pp < 64) ? P.s5_c_re[((size_t)(layer * 32 + g) * 16 + c) * 64 + pp] : -P.s5_c_im[((size_t)(layer * 32 + g) * 16 + c) * 64 + (pp - 64)];
        *(bf16_t*)(Cm + c * S5_XST + pp * 2) = f2bf(v); }
    for (int i = tid; i < 128 * 16; i += NTHR) { const int n = i >> 4, c = i & 15, nt = n >> 5, jj = n & 31, p = (nt >> 1) * 32 + jj;
        *(bf16_t*)(Bb + n * S5_UST + c * 2) = f2bf(sp[256 + (p * 16 + c) * 2 + (nt & 1)]); }
    S5Ctx C; C.Cm = Cm; C.Bb = Bb; C.Xs = wbase; C.Us = wbase + 32 * S5_XST; C.lane = lane; C.hi = hi; C.j = j;
    C.l0r = sp[2 * j]; C.l0i = sp[2 * j + 1]; C.l1r = sp[2 * (32 + j)]; C.l1i = sp[2 * (32 + j) + 1];
    { float q0r = C.l0r, q0i = C.l0i, q1r = C.l1r, q1i = C.l1i;
#pragma unroll
      for (int k = 0; k < 4; ++k) { const float a = q0r * q0r - q0i * q0i, bb = (q0r + q0r) * q0i; q0r = a; q0i = bb; const float c = q1r * q1r - q1i * q1i, d = (q1r + q1r) * q1i; q1r = c; q1i = d; }
      C.q0r = q0r; C.q0i = q0i; C.q1r = q1r; C.q1i = q1i; }
    C.dsk = P.s5_d[layer * 512 + g * 16 + (lane & 15)];
    C.rho = ((j & 15) & 3) + 8 * ((j & 15) >> 2) + 4 * (j >> 4);
    const int tokw = b * SEQ + wid * 512;
    C.ubase = P.p_() + C_SU + g * 16; C.ybase = P.ybuf_() + g * 16;
    float x0r = 0.f, x0i = 0.f, x1r = 0.f, x1i = 0.f;
    __syncthreads();
    for (int sc = 0; sc < 16; ++sc) s5_tile<false>(C, tokw + sc * 32, x0r, x0i, x1r, x1i);
    if (hi == 0) { ends[(wid * 64 + j) * 2] = x0r; ends[(wid * 64 + j) * 2 + 1] = x0i; ends[(wid * 64 + 32 + j) * 2] = x1r; ends[(wid * 64 + 32 + j) * 2 + 1] = x1i; }
    __syncthreads();
    { const float p0r = sp[128 + 2 * j], p0i = sp[128 + 2 * j + 1], p1r = sp[128 + 2 * (32 + j)], p1i = sp[128 + 2 * (32 + j) + 1];
      x0r = 0.f; x0i = 0.f; x1r = 0.f; x1i = 0.f;
      for (int w = 0; w < wid; ++w) { const float e0r = ends[(w * 64 + j) * 2], e0i = ends[(w * 64 + j) * 2 + 1], e1r = ends[(w * 64 + 32 + j) * 2], e1i = ends[(w * 64 + 32 + j) * 2 + 1];
          const float n0r = p0r * x0r - p0i * x0i + e0r, n0i = p0r * x0i + p0i * x0r + e0i, n1r = p1r * x1r - p1i * x1i + e1r, n1i = p1r * x1i + p1i * x1r + e1i;
          x0r = n0r; x0i = n0i; x1r = n1r; x1i = n1i; }
      if (hi) { x0r = 0.f; x0i = 0.f; x1r = 0.f; x1i = 0.f; } }
    for (int sc = 0; sc < 16; ++sc) s5_tile<true>(C, tokw + sc * 32, x0r, x0i, x1r, x1i);
}
constexpr int TOPK = 256;
__device__ __forceinline__ unsigned f2key(float f) { const unsigned u = __float_as_uint(f); return u ^ ((u & 0x80000000u) ? 0xffffffffu : 0x80000000u); }

__device__ __forceinline__ float relu1(float x) { const int b = __float_as_int(x); return __int_as_float(b > 0 ? b : 0); }
#define DSA_MM(acc, rt, kk) acc = __builtin_amdgcn_mfma_f32_32x32x16_bf16(afr[rt][kk], bfr[kk], acc, 0, 0, 0)
#define DSA_HS(acc, rt, q) do { s0 = fmaf(relu1(acc[4 * (q)]), wv[rt][4 * (q)], s0); s1 = fmaf(relu1(acc[4 * (q) + 1]), wv[rt][4 * (q) + 1], s1); \
                                s0 = fmaf(relu1(acc[4 * (q) + 2]), wv[rt][4 * (q) + 2], s0); s1 = fmaf(relu1(acc[4 * (q) + 3]), wv[rt][4 * (q) + 3], s1); } while (0)
#define DSA_SG() __builtin_amdgcn_sched_barrier(0)
__device__ __forceinline__ void dsa_score_tile(const bf16x8 (&afr)[4][4], const f32x16 (&wv)[4], const bf16x8 (&bfr)[4], float* sc, int col, int hi) {
    f32x16 accA = {}, accB = {}; asm volatile("" : "+v"(accA), "+v"(accB));
    float s0, s1;
    DSA_MM(accA, 0, 0); DSA_MM(accA, 0, 1); DSA_MM(accA, 0, 2); DSA_MM(accA, 0, 3);
    s0 = 0.f; s1 = 0.f;
    DSA_MM(accB, 1, 0); DSA_HS(accA, 0, 0); DSA_SG(); DSA_MM(accB, 1, 1); DSA_HS(accA, 0, 1); DSA_SG();
    DSA_MM(accB, 1, 2); DSA_HS(accA, 0, 2); DSA_SG(); DSA_MM(accB, 1, 3); DSA_HS(accA, 0, 3); DSA_SG();
    sc[(0 + hi) * 4096 + col] = (s0 + s1) + 0.f;
    accA = (f32x16){}; asm volatile("" : "+v"(accA)); s0 = 0.f; s1 = 0.f;
    DSA_MM(accA, 2, 0); DSA_HS(accB, 1, 0); DSA_SG(); DSA_MM(accA, 2, 1); DSA_HS(accB, 1, 1); DSA_SG();
    DSA_MM(accA, 2, 2); DSA_HS(accB, 1, 2); DSA_SG(); DSA_MM(accA, 2, 3); DSA_HS(accB, 1, 3); DSA_SG();
    sc[(2 + hi) * 4096 + col] = (s0 + s1) + 0.f;
    accB = (f32x16){}; asm volatile("" : "+v"(accB)); s0 = 0.f; s1 = 0.f;
    DSA_MM(accB, 3, 0); DSA_HS(accA, 2, 0); DSA_SG(); DSA_MM(accB, 3, 1); DSA_HS(accA, 2, 1); DSA_SG();
    DSA_MM(accB, 3, 2); DSA_HS(accA, 2, 2); DSA_SG(); DSA_MM(accB, 3, 3); DSA_HS(accA, 2, 3); DSA_SG();
    sc[(4 + hi) * 4096 + col] = (s0 + s1) + 0.f;
    s0 = 0.f; s1 = 0.f;
    DSA_HS(accB, 3, 0); DSA_HS(accB, 3, 1); DSA_HS(accB, 3, 2); DSA_HS(accB, 3, 3);
    sc[(6 + hi) * 4096 + col] = (s0 + s1) + 0.f;
}
#define DSA_CNT4(K0, K1, K2, K3) asm volatile( \
    "v_cmp_ge_u32_e64 %[m0], %[k0], %[cd]\n\tv_cmp_ge_u32_e64 %[m1], %[k1], %[cd]\n\tv_cmp_ge_u32_e64 %[m2], %[k2], %[cd]\n\tv_cmp_ge_u32_e64 %[m3], %[k3], %[cd]\n\t" \
    "v_addc_co_u32_e64 %[a0], %[m0], %[a0], 0, %[m0]\n\tv_addc_co_u32_e64 %[a1], %[m1], %[a1], 0, %[m1]\n\t" \
    "v_addc_co_u32_e64 %[a0], %[m2], %[a0], 0, %[m2]\n\tv_addc_co_u32_e64 %[a1], %[m3], %[a1], 0, %[m3]" \
    : [a0] "+v"(c0), [a1] "+v"(c1), [m0] "=&s"(sm0), [m1] "=&s"(sm1), [m2] "=&s"(sm2), [m3] "=&s"(sm3) \
    : [k0] "v"(K0), [k1] "v"(K1), [k2] "v"(K2), [k3] "v"(K3), [cd] "v"(cand))
#define DSA_CNT8(J0) do { DSA_CNT4(key[(J0)], key[(J0) + 1], key[(J0) + 2], key[(J0) + 3]); DSA_CNT4(key[(J0) + 4], key[(J0) + 5], key[(J0) + 6], key[(J0) + 7]); } while (0)

template <int J> __device__ __forceinline__ void dsa_emit(const unsigned (&key)[64], unsigned T, unsigned& wlo, unsigned& whi) {
    const unsigned long long m = __ballot(key[J] >= T);
    asm("s_nop 1\n\tv_writelane_b32 %0, %2, %4\n\tv_writelane_b32 %1, %3, %4" : "+v"(wlo), "+v"(whi) : "s"((unsigned)m), "s"((unsigned)(m >> 32)), "n"(J));
    if constexpr (J + 1 < 64) dsa_emit<J + 1>(key, T, wlo, whi);
}
__device__ __forceinline__ void unit_dsa_index(const Params& P, int u, char* lds) {
    const int b = u & 3, t0 = (511 - (u >> 2)) * 8;
    const int tid = TIDX(), wid = tid >> 6, lane = tid & 63, r32 = lane & 31, hi = lane >> 5;
    float* sc = (float*)lds;
    const bf16_t* pb = P.p_() + (size_t)b * SEQ * NPAD;
    __syncthreads();
    TPU_START(101); TPU_START(110);
    {
        bf16x8 afr[4][4]; f32x16 wv[4];
        const int qsel = (r32 >> 2) & 1, head = (r32 & 3) + 4 * (r32 >> 3);
        char* qs = lds;
        const int ntile = (t0 + 7) / 32 + 1;
        const bf16_t* kp = P.ikc_() + (size_t)(b * (SEQ / 32)) * 2048 + lane * 8;
        bf16x8 b0[4], b1[4], b2[4];
#define DSA_LDB(dst, K) do { const bf16_t* kq_ = kp + (size_t)(wid + 8 * (K)) * 2048; _Pragma("unroll") for (int kk = 0; kk < 4; ++kk) dst[kk] = *(const bf16x8*)(kq_ + kk * 512); } while (0)
#define DSA_TILE(buf, K) dsa_score_tile(afr, wv, buf, sc, (wid + 8 * (K)) * 32 + r32, hi)
        const int nk = (ntile - wid + 7) >> 3;
        const int kl = nk > 0 ? nk - 1 : 0;
#define DSA_MIN(a) ((a) < kl ? (a) : kl)
        const int tk = tid >> 6, hd = (tid & 63) >> 2, dm = (tid & 3) * 16;
        const bf16_t* qsrc = pb + (size_t)(t0 + tk) * NPAD + C_DIQ + hd * 64 + dm;
        const u32x4 qa = *(const u32x4*)qsrc, qb2 = *(const u32x4*)(qsrc + 8);
#pragma unroll
        for (int rt = 0; rt < 4; ++rt) { const float* wp = P.iw_() + (size_t)(b * SEQ + t0 + 2 * rt + hi) * 16;
#pragma unroll
            for (int i = 0; i < 4; ++i) { const f32x4 w4 = *(const f32x4*)(wp + 4 * i); wv[rt][4 * i] = w4[0]; wv[rt][4 * i + 1] = w4[1]; wv[rt][4 * i + 2] = w4[2]; wv[rt][4 * i + 3] = w4[3]; } }
        DSA_LDB(b0, DSA_MIN(0)); DSA_LDB(b1, DSA_MIN(1));
        { char* dst = qs + tk * 2432 + hd * 144 + dm * 2; *(u32x4*)dst = qa; *(u32x4*)(dst + 16) = qb2; }
        __syncthreads();
#pragma unroll
        for (int rt = 0; rt < 4; ++rt) { const char* qp = qs + (2 * rt + qsel) * 2432 + head * 144 + hi * 16;
#pragma unroll
            for (int kk = 0; kk < 4; ++kk) afr[rt][kk] = *(const bf16x8*)(qp + kk * 32); }
        asm volatile("s_waitcnt lgkmcnt(0)" ::: "memory"); __syncthreads();
#if TPROBE == 110
        TPU_STOP(110);
#endif
#if TPROBE == 103
        TPU_START(103); asm volatile("s_waitcnt vmcnt(0)" ::: "memory"); TPU_STOP(103);
#endif
#if TPROBE == 104
        asm volatile("s_waitcnt vmcnt(0)" ::: "memory"); TPU_START(104);
#endif
        int k = 0;
        for (; k + 3 <= nk; k += 3) {
            DSA_LDB(b2, k + 2); DSA_TILE(b0, k);
            DSA_LDB(b0, DSA_MIN(k + 3)); DSA_TILE(b1, k + 1);
            DSA_LDB(b1, DSA_MIN(k + 4)); DSA_TILE(b2, k + 2);
        }
        if (k < nk) DSA_TILE(b0, k);
        if (k + 1 < nk) DSA_TILE(b1, k + 1);
#if TPROBE == 104
        asm volatile("s_waitcnt lgkmcnt(0)" ::: "memory"); TPU_STOP(104);
#endif
        TPU_START(111);
#undef DSA_TILE
#undef DSA_MIN
#undef DSA_TILE
#undef DSA_LDB
    }
    __syncthreads();
    TPU_STOP(111);
    TPU_STOP(101); TPU_START(102);
    {
        const int t = t0 + wid; const float* srow = sc + wid * 4096;
        unsigned key[64];
#pragma unroll
        for (int j = 0; j < 64; ++j) { const int s = j * 64 + lane; key[j] = (s <= t) ? f2key(srow[s]) : 0u; }
        unsigned long long* mout = P.mask_() + (size_t)(b * SEQ + t) * 64;
        unsigned long long myword = 0ull;
        TPU_START(105); TPU_START(106); TPU_START(107); TPU_START(108); TPU_START(109);
        if (t + 1 <= TOPK) {
#pragma unroll
            for (int j = 0; j < 64; ++j) { const unsigned long long m = __ballot(j * 64 + lane <= t); if (lane == j) myword = m; }
        } else {
            const int ngrp = t / 512 + 1;
#if TPROBE == 105
            asm volatile("" :: "v"(key[0]), "v"(key[63]));
#endif
            TPU_STOP(105);
            unsigned* hist = (unsigned*)(sc + wid * 4096);
            asm volatile("" ::: "memory");
            { const u32x4 zz4 = {0u, 0u, 0u, 0u};
#pragma unroll
              for (int i = 0; i < 16; ++i) *(u32x4*)(hist + (i * 64 + lane) * 4) = zz4; }
            asm volatile("" ::: "memory");
#define DSA_H8(J0) do { _Pragma("unroll") for (int jj = 0; jj < 8; ++jj) atomicAdd(hist + (key[(J0) + jj] >> 20), 1u); } while (0)
            DSA_H8(0);
            if (ngrp > 1) DSA_H8(8);
            if (ngrp > 2) DSA_H8(16);
            if (ngrp > 3) DSA_H8(24);
            if (ngrp > 4) DSA_H8(32);
            if (ngrp > 5) DSA_H8(40);
            if (ngrp > 6) DSA_H8(48);
            if (ngrp > 7) DSA_H8(56);
#undef DSA_H8
            asm volatile("" ::: "memory");
#if TPROBE == 106
            asm volatile("s_waitcnt lgkmcnt(0)" ::: "memory");
#endif
            TPU_STOP(106);
#define DSA_SUFFIX(s) do { _Pragma("unroll") for (int o = 1; o < 64; o <<= 1) { unsigned t_ = (unsigned)__builtin_amdgcn_ds_bpermute(((lane + o) & 63) << 2, (int)(s)); (s) += (lane + o < 64) ? t_ : 0u; } } while (0)
            unsigned mine = 0u;
#pragma unroll
            for (int i = 0; i < 16; ++i) { const u32x4 v4 = *(const u32x4*)(hist + lane * 64 + ((i + lane) & 15) * 4); mine += (v4[0] + v4[1]) + (v4[2] + v4[3]); }
            unsigned suf = mine; DSA_SUFFIX(suf);
            const unsigned long long mL = __ballot(suf - mine < (unsigned)TOPK && suf >= (unsigned)TOPK);
            const int Ls = (int)__builtin_ctzll(mL);
            const unsigned cntA = (unsigned)__builtin_amdgcn_readlane((int)(suf - mine), Ls);
            unsigned h2 = hist[Ls * 64 + lane]; unsigned suf2 = h2; DSA_SUFFIX(suf2);
            const unsigned long long mB = __ballot(cntA + suf2 - h2 < (unsigned)TOPK && cntA + suf2 >= (unsigned)TOPK);
            const int Bs = (int)__builtin_ctzll(mB);
            const unsigned bstar = (unsigned)(Ls * 64 + Bs);
            const unsigned cntAbove = cntA + (unsigned)__builtin_amdgcn_readlane((int)(suf2 - h2), Bs);
            const unsigned inbin = (unsigned)__builtin_amdgcn_readlane((int)h2, Bs);
#undef DSA_SUFFIX
            TPU_STOP(107);
            unsigned T = bstar << 20; int cntT = (int)(cntAbove + inbin);
            if (cntT != TOPK) {
                asm volatile("" ::: "memory");
                int nslot = 0;
#pragma unroll
                for (int j = 0; j < 64; ++j) { if ((key[j] >> 20) == bstar) { hist[nslot * 64 + lane] = key[j]; ++nslot; } }
                asm volatile("" ::: "memory");
                int R = nslot;
#pragma unroll
                for (int o = 32; o >= 1; o >>= 1) { const int other = __builtin_amdgcn_ds_bpermute(((lane ^ o) << 2), R); R = other > R ? other : R; }
                R = __builtin_amdgcn_readfirstlane(R);
                if (R <= 8) {
                    unsigned c[8];
#pragma unroll
                    for (int r = 0; r < 8; ++r) c[r] = (r < nslot) ? hist[r * 64 + lane] : 0u;
                    for (int bit = 19; bit >= 0; --bit) {
                        const unsigned cand = T | (1u << bit); int cnt = (int)cntAbove;
#pragma unroll
                        for (int r = 0; r < 8; ++r) cnt += __popcll(__ballot(c[r] >= cand));
                        if (cnt >= TOPK) { T = cand; cntT = cnt; if (cnt == TOPK) break; }
                    }
                } else {
                    for (int bit = 19; bit >= 0; --bit) {
                        const unsigned cand = T | (1u << bit); unsigned c0 = 0, c1 = 0; unsigned long long sm0, sm1, sm2, sm3;
                        DSA_CNT8(0);
                        if (ngrp > 1) DSA_CNT8(8);
                        if (ngrp > 2) DSA_CNT8(16);
                        if (ngrp > 3) DSA_CNT8(24);
                        if (ngrp > 4) DSA_CNT8(32);
                        if (ngrp > 5) DSA_CNT8(40);
                        if (ngrp > 6) DSA_CNT8(48);
                        if (ngrp > 7) DSA_CNT8(56);
                        const int cl = (int)(c0 + c1);
                        int cnt = 0;
#pragma unroll
                        for (int bb = 0; bb < 7; ++bb) cnt += __popcll(__ballot((cl >> bb) & 1)) << bb;
                        if (cnt >= TOPK) { T = cand; cntT = cnt; if (cnt == TOPK) break; }
                    }
                }
            }
            TPU_STOP(108);
            if (cntT == TOPK) {
                unsigned wlo = 0u, whi = 0u;
                dsa_emit<0>(key, T, wlo, whi);
                myword = ((unsigned long long)whi << 32) | wlo;
            } else {
                int ngt = 0;
#pragma unroll
                for (int j = 0; j < 64; ++j) ngt += __popcll(__ballot(key[j] > T));
                int need = TOPK - ngt;
#pragma unroll
                for (int j = 0; j < 64; ++j) { const unsigned long long eq = __ballot(key[j] == T), gt = __ballot(key[j] > T);
                    const int ne = __popcll(eq); unsigned long long take = eq;
                    if (ne > need) { take = 0ull; int left = need; unsigned long long e2 = eq;
                        while (left > 0) { const unsigned long long lowbit = e2 & (0ull - e2); take |= lowbit; e2 ^= lowbit; --left; } }
                    need -= (ne > need) ? need : ne;
                    const unsigned long long m = gt | take; if (lane == j) myword = m; }
            }
        }
        mout[lane] = myword;
        TPU_STOP(109);
    }
    TPU_STOP(102);
}

struct DsaOutRow { const bf16_t* zb; bf16_t* gb; int wid;
    __device__ __forceinline__ const bf16_t* zrow(int r) const { const int rho = wid * 32 + r; return zb + (size_t)(rho >> 2) * NPAD + (rho & 3) * 128; }
    __device__ __forceinline__ bf16_t* grow(int r) const { const int rho = wid * 32 + r; return gb + (size_t)(rho >> 2) * MIX + (rho & 3) * 128; } };
__device__ __forceinline__ void unit_dsa_attn(const Params& P, int cur_layer, int u, char* lds) {
    const int b = u & 3, qb = 63 - (u >> 2), t0 = qb * 64, tokb = b * SEQ;
    const int wid = TIDX() >> 6, lane = TIDX() & 63, r32 = lane & 31, hi = lane >> 5;
    const int rho = wid * 32 + r32, tq = t0 + (rho >> 2), hq = rho & 3;
    const bf16_t* Qw = P.p_() + (size_t)(tokb + tq) * NPAD + C_DQ + hq * 128 + hi * 8;
    const bf16_t* Kh = P.kvc_() + (size_t)tokb * 256;
    const unsigned moff = (unsigned)(tokb + tq) * 512u;
    DsaOutRow ow; ow.zb = P.p_() + (size_t)(tokb + t0) * NPAD + C_DZ; ow.gb = P.xn_() + (size_t)(tokb + t0) * MIX + 1024; ow.wid = wid;
    const int NT = (qb + 2) & ~1;
    att::attn_body<true, 256, 128, 2, DsaOutRow>(Qw, P.dsa_q_norm + cur_layer * 128, P.rope_() + (size_t)(tokb + tq) * 48, Kh, NT, P.mask_(), moff, ow, lds);
}
__device__ __forceinline__ void phase_gemm_glu(const Params& P, int layer, char* lds) {
    pg8::Gemm g; g.A = P.ybuf_(); g.Bt = P.WgluT_() + (size_t)layer * 512 * 512; g.M = NTOK; g.N = 512; g.K = 512;
    pg8::StaticOrder S; S.init(g.M, g.N, (int)gridDim.x, (int)blockIdx.x);
    pg8::EpiGlu E; E.Y = P.ybuf_(); E.ldy = 512; E.O = P.ocat_(); E.ldo = MIX; E.ooff = 512;
    pg8::gemm_phase<pg8::EpiGlu, pg8::StaticOrder, false>((PG8_LAS unsigned char*)lds, g, S, E, nullptr);
}

constexpr int CTL_Q0 = 4096;
struct OneUnit { int pm, pn; __device__ __forceinline__ bool next(int i, pg8::Unit& u) const { if (i) return false; u.pm = pm; u.pn = pn; return true; }
    __device__ __forceinline__ void a_ready(const pg8::Unit&) const {} __device__ __forceinline__ void done(const pg8::Unit&) const {} };
__device__ __forceinline__ int q_issue(unsigned* ctr) { return (int)__hip_atomic_fetch_add(ctr, 1u, __ATOMIC_RELAXED, __HIP_MEMORY_SCOPE_AGENT); }
#define Q_LOOP_BEGIN(ctr, total)  { unsigned* q_ctr_ = (ctr); const int q_total_ = (total); volatile int* q_b_ = (volatile int*)(lds + LDS_TAIL + 16); \
    for (;;) { __syncthreads(); if (TIDX() == 0) *q_b_ = q_issue(q_ctr_); __syncthreads(); const int item = __builtin_amdgcn_readfirstlane(*q_b_); if (item >= q_total_) break;
#define Q_LOOP_END  } }
__device__ __forceinline__ void unit_glu(const Params& P, int layer, int u, char* lds) {
    pg8::Gemm g; g.A = P.ybuf_(); g.Bt = P.WgluT_() + (size_t)layer * 512 * 512; g.M = NTOK; g.N = 512; g.K = 512;
    OneUnit S; S.pm = u >> 1; S.pn = u & 1;
    pg8::EpiGluGate E; E.Y = P.ybuf_(); E.Pz = P.p_(); E.G = P.xn_();
    pg8::gemm_phase<pg8::EpiGluGate, OneUnit, false>((PG8_LAS unsigned char*)lds, g, S, E, nullptr);
}
constexpr int LDS_TAIL = LDS_BYTES - 64;

__global__ __launch_bounds__(NTHR, 2) void k_mega(Params P) {
    extern __shared__ __attribute__((aligned(16))) char lds[];
    if (TIDX() == 0) *(uint4*)(lds + LDS_TAIL) = make_uint4(0u, 0u, 0u, 0u);
    __syncthreads();
    XcdBarrier bar = xcd_barrier_post(P.ctl_(), (volatile LAS unsigned*)(lds + LDS_TAIL));
    const int G = gridDim.x, B = blockIdx.x;
    phase_prologue1(P, lds); phase_rope_table(P); phase_s5_params(P); phase_rmsnorm_x(P, 0);
    xcd_barrier(bar);
    for (int layer = 0; layer < DEPTH; ++layer) {
        if (layer > 0) { phase_rmsnorm_x(P, layer); xcd_barrier(bar); }
        phase_gemm_in(P, layer, lds);
        if (layer == 0) phase_gemm_kv(P, lds);
        xcd_barrier(bar);
        phase_prep(P, layer);
        if (layer == 0) phase_memk_norm(P);
        for (int u = B; u < 256; u += G) unit_gla_a4(P, layer, u, lds);
        xcd_barrier(bar);
        Q_LOOP_BEGIN(P.ctl_() + CTL_Q0 + 64 * (layer * 2), 128 + 2048 + 256)
            if (item < 128) unit_s5(P, layer, item, lds);
            else if (item < 2176) unit_dsa_index(P, item - 128, lds);
            else gla_scan_slice(P, (item - 2176) * NTHR + TIDX());
        Q_LOOP_END
        xcd_barrier(bar);
        Q_LOOP_BEGIN(P.ctl_() + CTL_Q0 + 64 * (layer * 2 + 1), 256 + 256 + 128 + 256)
            if (item < 256) unit_dsa_attn(P, layer, item, lds);
            else if (item < 512) unit_gla_c4(P, layer, item - 256, lds);
            else if (item < 640) unit_glu(P, layer, item - 512, lds);
            else unit_mem_attn(P, layer, item - 640, lds);
        Q_LOOP_END
        xcd_barrier(bar);
        phase_gemm_out(P, layer, lds);
        xcd_barrier(bar);
    }
}

extern "C" void kernel_launch(void* const* d_in, const int* in_sizes, int n_in, void* d_out, int out_size, void* d_ws, size_t ws_size, hipStream_t stream) {
    if (n_in != 24 || ws_size < WS_END) { fprintf(stderr, "kernel_launch: unexpected n_in %d or ws_size %zu (< %zu)\n", n_in, ws_size, (size_t)WS_END); return; }
    Params P; memset(&P, 0, sizeof(P));
    P.x = (const float*)d_in[0]; P.mem = (const float*)d_in[1]; P.pos = (const int*)d_in[2]; P.ln_gain = (const float*)d_in[3]; P.w_in = (const float*)d_in[4];
    P.gla_w_up = (const float*)d_in[5]; P.gla_b_up = (const float*)d_in[6]; P.s5_a_re = (const float*)d_in[7]; P.s5_a_im = (const float*)d_in[8]; P.s5_log_step = (const float*)d_in[9];
    P.s5_b_re = (const float*)d_in[10]; P.s5_b_im = (const float*)d_in[11]; P.s5_c_re = (const float*)d_in[12]; P.s5_c_im = (const float*)d_in[13]; P.s5_d = (const float*)d_in[14];
    P.s5_w_glu = (const float*)d_in[15]; P.dsa_q_norm = (const float*)d_in[16]; P.dsa_k_norm = (const float*)d_in[17]; P.mem_norm = (const float*)d_in[18]; P.w_mem_kv = (const float*)d_in[19];
    P.mem_q_norm = (const float*)d_in[20]; P.mem_k_norm = (const float*)d_in[21]; P.out_norm = (const float*)d_in[22]; P.w_out = (const float*)d_in[23];
    P.out = (float*)d_out;
    char* ws = (char*)d_ws; P.ws = ws;
    static int grid = 0;
    if (!grid) {
        int dev = 0, cus = 0, per_cu = 0;
        (void)hipGetDevice(&dev); (void)hipDeviceGetAttribute(&cus, hipDeviceAttributeMultiprocessorCount, dev);
        (void)hipFuncSetAttribute((const void*)k_mega, hipFuncAttributeMaxDynamicSharedMemorySize, LDS_BYTES);
        (void)hipOccupancyMaxActiveBlocksPerMultiprocessor(&per_cu, (const void*)k_mega, NTHR, LDS_BYTES);
        if (per_cu < 1) fprintf(stderr, "kernel_launch: occupancy query reports %d blocks per CU\n", per_cu);
        grid = cus > 0 ? cus : 256;
    }
    (void)hipMemsetAsync(ws + WS_CTL, 0, CTL_BYTES, stream);
    hipLaunchKernelGGL(k_mega, dim3(grid), dim3(NTHR), LDS_BYTES, stream, P);
}
```

```cpp
#include <hip/hip_runtime.h>
#include <stdint.h>
#include <stdio.h>
#include <string.h>

constexpr int NB = 4, SEQ = 4096, NTOK = NB * SEQ, DM = 2048, DEPTH = 4, MEML = 256;
constexpr int NIN = 5984, NPAD = 6144, MIX = 2048;
constexpr int C_GQ = 0, C_GK = 256, C_GV = 512, C_GLR = 1024, C_GZ = 1040, C_SU = 1552, C_SZ = 2064, C_DQ = 2576, C_DK = 3088, C_DV = 3216,
              C_DIQ = 3344, C_DIK = 4368, C_DIW = 4432, C_DZ = 4448, C_MQ = 4960, C_MZ = 5472;
constexpr float EPS = 1e-6f;
constexpr int NTHR = 512;
constexpr int LDS_BYTES = 147456;

typedef unsigned short bf16_t;
typedef short bf16x8 __attribute__((ext_vector_type(8)));
typedef short s16x4 __attribute__((ext_vector_type(4)));
typedef float f32x4 __attribute__((ext_vector_type(4)));
typedef float f32x8 __attribute__((ext_vector_type(8)));
typedef float f32x16 __attribute__((ext_vector_type(16)));
typedef unsigned u32x4 __attribute__((ext_vector_type(4)));
typedef unsigned u32x2 __attribute__((ext_vector_type(2)));
#define LAS __attribute__((address_space(3)))

__device__ __forceinline__ float bf2f(bf16_t b) { return __uint_as_float(((unsigned)b) << 16); }
__device__ __forceinline__ bf16_t f2bf(float f) { unsigned u = __float_as_uint(f); u += 0x7FFFu + ((u >> 16) & 1u); return (bf16_t)(u >> 16); }
__device__ __forceinline__ unsigned pk2bf(float lo, float hi) { return (unsigned)f2bf(lo) | ((unsigned)f2bf(hi) << 16); }
__device__ __forceinline__ float sigmoidf_(float x) { return 1.f / (1.f + __expf(-x)); }
__device__ __forceinline__ float siluf_(float x) { return x / (1.f + __expf(-x)); }

__device__ __forceinline__ int TIDX() { int t = (int)threadIdx.x; asm volatile("" : "+v"(t)); return t; }
__device__ __forceinline__ float shx(float v, int m) { const int src = ((TIDX() & 63) ^ m) << 2; return __int_as_float(__builtin_amdgcn_ds_bpermute(src, __float_as_int(v))); }
__device__ __forceinline__ float wave_sum(float v) {
#pragma unroll
    for (int o = 32; o >= 1; o >>= 1) v += shx(v, o);
    return v;
}
__device__ __forceinline__ void ld8f(const bf16_t* p, float (&v)[8]) { const u32x4 w = *(const u32x4*)p;
#pragma unroll
    for (int j = 0; j < 4; ++j) { v[2 * j] = __uint_as_float(w[j] << 16); v[2 * j + 1] = __uint_as_float(w[j] & 0xffff0000u); } }
__device__ __forceinline__ void st8f(bf16_t* p, const float (&v)[8]) { u32x4 w; w.x = pk2bf(v[0], v[1]); w.y = pk2bf(v[2], v[3]); w.z = pk2bf(v[4], v[5]); w.w = pk2bf(v[6], v[7]); *(u32x4*)p = w; }
__device__ __forceinline__ float f2bf_f(float f) { return bf2f(f2bf(f)); }

#ifndef TPROBE
#define TPROBE 0
#endif
#if TPROBE
#define TPU_START(id) do { if (TPROBE == (id) && TIDX() == 0) *(volatile unsigned long long*)(lds + LDS_BYTES - 24) = __builtin_amdgcn_s_memrealtime(); } while (0)
#define TPU_STOP(id) do { if (TPROBE == (id) && TIDX() == 0) *(volatile unsigned long long*)(lds + LDS_BYTES - 32) += __builtin_amdgcn_s_memrealtime() - *(volatile unsigned long long*)(lds + LDS_BYTES - 24); } while (0)
#else
#define TPU_START(id) do {} while (0)
#define TPU_STOP(id) do {} while (0)
#endif
#define XB_TMO      128
#define XB_XCNT(j)  (256  + 64 * (j))
#define XB_XSUB(j)  (1280 + 64 * (j))
#define XB_XGEN(j)  (2304 + 64 * (j))
#define XB_TOP      3328
#define XB_TOPGEN   3392
#define XCD_BAR_WORDS 3456
#define XB_SPIN_CAP (1u << 18)

__device__ __forceinline__ unsigned xb_ld(unsigned* p)              { return __hip_atomic_load(p, __ATOMIC_RELAXED, __HIP_MEMORY_SCOPE_AGENT); }
__device__ __forceinline__ unsigned xb_add(unsigned* p, unsigned v) { return __hip_atomic_fetch_add(p, v, __ATOMIC_RELAXED, __HIP_MEMORY_SCOPE_AGENT); }
__device__ __forceinline__ unsigned xb_xcc_id() { return (unsigned)__builtin_amdgcn_s_getreg((3 << 11) | 20) & 0xFu; }
#define XB_SPIN(cond, bar) do { unsigned _sp = 0; while (cond) { __builtin_amdgcn_s_sleep(1); \
    if ((++_sp & 255u) == 0u) { if (xb_ld(&(bar)[XB_TMO])) break; if (_sp > XB_SPIN_CAP) { atomicAdd(&(bar)[XB_TMO], 1u); break; } } } } while (0)

struct XcdBarrier {
    unsigned* bar; unsigned x;
    volatile LAS unsigned* st;
};

__device__ __forceinline__ XcdBarrier xcd_barrier_post(unsigned* bar, volatile LAS unsigned* st) {
    XcdBarrier b; b.bar = bar; b.x = xb_xcc_id(); b.st = st;
    if (TIDX() == 0) (void)xb_add(&bar[XB_XCNT(b.x)], 1u);
    return b;
}
__device__ __forceinline__ void xcd_barrier_complete(unsigned* bar, unsigned x, unsigned& nloc, unsigned& nx) {
    const unsigned G = gridDim.x * gridDim.y * gridDim.z;
    unsigned sum, cnt, mine, sp = 0u;
    for (;;) {
        sum = 0u; cnt = 0u; mine = 0u;
#pragma unroll
        for (unsigned j = 0; j < 16; ++j) { const unsigned c = xb_ld(&bar[XB_XCNT(j)]); sum += c; cnt += (c > 0u) ? 1u : 0u; mine = (j == x) ? c : mine; }
        if (sum == G) break;
        __builtin_amdgcn_s_sleep(1);
        if ((++sp & 255u) == 0u) { if (xb_ld(&bar[XB_TMO])) break; if (sp > XB_SPIN_CAP) { atomicAdd(&bar[XB_TMO], 1u); break; } }
    }
    nloc = mine > 0u ? mine : 1u; nx = cnt > 0u ? cnt : 1u;
}

__device__ __forceinline__ void xcd_barrier(const XcdBarrier& b) {
    asm volatile("s_waitcnt vmcnt(0)" ::: "memory");
    __syncthreads();
    if (TIDX() == 0) {
        unsigned* bar = b.bar; const unsigned bx = xb_xcc_id();
        __builtin_amdgcn_s_waitcnt(0);
        unsigned nloc = b.st[0], nx = b.st[1];
        if (nloc == 0u) { xcd_barrier_complete(bar, bx, nloc, nx); b.st[0] = nloc; b.st[1] = nx; }
        const unsigned old = xb_add(&bar[XB_XSUB(bx)], 1u);
        const unsigned gen = old / nloc;
        if (old + 1u == (gen + 1u) * nloc) {
            __builtin_amdgcn_fence(__ATOMIC_RELEASE, "agent");
            asm volatile("s_waitcnt vmcnt(0)" ::: "memory");
            const unsigned og = xb_add(&bar[XB_TOP], 1u);
            const unsigned tg = og / nx;
            if (og + 1u == (tg + 1u) * nx) xb_add(&bar[XB_TOPGEN], 1u);
            else XB_SPIN(xb_ld(&bar[XB_TOPGEN]) == tg, bar);
            __builtin_amdgcn_fence(__ATOMIC_ACQUIRE, "agent");
            xb_add(&bar[XB_XGEN(bx)], 1u);
            asm volatile("s_waitcnt vmcnt(0)" ::: "memory");
        } else {
            XB_SPIN(xb_ld(&bar[XB_XGEN(bx)]) == gen, bar);
            __builtin_amdgcn_fence(__ATOMIC_ACQUIRE, "agent");
            asm volatile("s_waitcnt vmcnt(0)" ::: "memory");
        }
    }
    __syncthreads();
}
namespace pg8 {
#define PG8_LAS __attribute__((address_space(3)))
typedef float f32x2 __attribute__((ext_vector_type(2)));
typedef unsigned u32x4 __attribute__((ext_vector_type(4)));
constexpr int BM = 256, BK = 64, HALF = 128, HTB = HALF * BK * 2  , STAGE_BYTES = 8 * HTB, NXCD = 8, WGM = 8;

__host__ __device__ __forceinline__ int lds_byte(int r, int c) { const int st = (r >> 4) * 2 + (c >> 5), rr = r & 15, cc = c & 31, ob = rr * 64 + cc * 2; return st * 1024 + (ob ^ (((ob >> 9) & 1) << 5)); }
__host__ __device__ __forceinline__ void stage_rc(int b, int& R, int& C) { const int st = b / 1024, sb = b % 1024, swz = sb ^ (((sb >> 9) & 1) << 5); R = (st >> 1) * 16 + swz / 64; C = (st & 1) * 32 + (swz % 64) / 2; }
__host__ __device__ __forceinline__ int perm32(int rho) { const int n = rho >> 4, i = rho & 15; return 8 * (i >> 2) + 4 * n + (i & 3); }

struct Unit { int pm, pn; };
struct Gemm { const bf16_t* A; const bf16_t* Bt; int M, N, K; };

struct StaticOrder {
    int nM, nN, nwg, G, c;
    __host__ __device__ void init(int M, int N, int G_, int c_) { nM = M / BM; nN = N / BM; nwg = nM * nN; G = G_; c = c_; }
    __host__ __device__ bool next(int i, Unit& u) const {
        const long L = (long)i * G + c; if (L >= nwg) return false;
        int wgid = (int)L; { const int q = nwg / NXCD, r = nwg % NXCD, xcd = wgid % NXCD, off = wgid / NXCD; wgid = (xcd < r ? xcd * (q + 1) : r * (q + 1) + (xcd - r) * q) + off; }
        const int nig = WGM * nN, gid = wgid / nig, fm = gid * WGM, gsz = (nM - fm) < WGM ? (nM - fm) : WGM;
        u.pm = fm + ((wgid % nig) % gsz); u.pn = (wgid % nig) / gsz; return true;
    }
    __device__ __forceinline__ void a_ready(const Unit&) const {}
    __device__ __forceinline__ void done(const Unit&) const {}
};
__device__ __forceinline__ unsigned cvt_pk_bf16(float lo, float hi) { unsigned r; asm volatile("v_cvt_pk_bf16_f32 %0, %1, %2" : "=v"(r) : "v"(lo), "v"(hi)); return r; }
struct EpiBf16Plain {
    static constexpr bool PERM = true, AFTER_DRAIN = false;
    bf16_t* O; int ldc;
    __device__ __forceinline__ void operator()(const f32x4 (&acc)[2][2][4][2], const Unit& u, int wr, int wc, int fr, int fq) const {
        const int row0 = u.pm * BM + wr * 64 + fr, col0 = u.pn * BM + wc * 32 + 8 * fq;
#pragma unroll
        for (int ai = 0; ai < 2; ++ai)
#pragma unroll
            for (int m = 0; m < 4; ++m) { bf16_t* rowp = O + (size_t)(row0 + ai * HALF + m * 16) * ldc + col0;
#pragma unroll
                for (int bj = 0; bj < 2; ++bj) { const f32x4 v0 = acc[ai][bj][m][0], v1 = acc[ai][bj][m][1];
                    u32x4 w; w.x = cvt_pk_bf16(v0[0], v0[1]); w.y = cvt_pk_bf16(v0[2], v0[3]); w.z = cvt_pk_bf16(v1[0], v1[1]); w.w = cvt_pk_bf16(v1[2], v1[3]);
                    *(u32x4*)(rowp + bj * HALF) = w; } }
    }
};
struct EpiResid {
    static constexpr bool PERM = false, AFTER_DRAIN = false;
    const float* R; float* C; int ldc;
    __device__ __forceinline__ void operator()(const f32x4 (&acc)[2][2][4][2], const Unit& u, int wr, int wc, int fr, int fq) const {
        const int row0 = u.pm * BM + wr * 64 + fr, col0 = u.pn * BM + wc * 32 + 4 * fq;
#pragma unroll
        for (int ai = 0; ai < 2; ++ai)
#pragma unroll
            for (int m = 0; m < 4; ++m) { const size_t off = (size_t)(row0 + ai * HALF + m * 16) * ldc + col0;
#pragma unroll
                for (int bj = 0; bj < 2; ++bj)
#pragma unroll
                    for (int n = 0; n < 2; ++n) { const f32x4 r = *(const f32x4*)(R + off + bj * HALF + n * 16); *(f32x4*)(C + off + bj * HALF + n * 16) = acc[ai][bj][m][n] + r; } }
    }
};
struct EpiResidMix {
    static constexpr bool PERM = true, AFTER_DRAIN = false;
    const void* R; void* C; int ldc; int r16, c16;
    __device__ __forceinline__ void operator()(const f32x4 (&acc)[2][2][4][2], const Unit& u, int wr, int wc, int fr, int fq) const {
        const int row0 = u.pm * BM + wr * 64 + fr, col0 = u.pn * BM + wc * 32 + 8 * fq;
#pragma unroll
        for (int ai = 0; ai < 2; ++ai)
#pragma unroll
            for (int m = 0; m < 4; ++m) { const size_t off = (size_t)(row0 + ai * HALF + m * 16) * ldc + col0;
                f32x4 r0[2], r1[2];
                if (r16) {
#pragma unroll
                    for (int bj = 0; bj < 2; ++bj) { const u32x4 w = *(const u32x4*)((const bf16_t*)R + off + bj * HALF);
                        r0[bj] = f32x4{__uint_as_float(w.x << 16), __uint_as_float(w.x & 0xffff0000u), __uint_as_float(w.y << 16), __uint_as_float(w.y & 0xffff0000u)};
                        r1[bj] = f32x4{__uint_as_float(w.z << 16), __uint_as_float(w.z & 0xffff0000u), __uint_as_float(w.w << 16), __uint_as_float(w.w & 0xffff0000u)}; }
                } else {
#pragma unroll
                    for (int bj = 0; bj < 2; ++bj) { r0[bj] = *(const f32x4*)((const float*)R + off + bj * HALF); r1[bj] = *(const f32x4*)((const float*)R + off + bj * HALF + 4); }
                }
#pragma unroll
                for (int bj = 0; bj < 2; ++bj) { const f32x4 v0 = acc[ai][bj][m][0] + r0[bj], v1 = acc[ai][bj][m][1] + r1[bj];
                    if (c16) { u32x4 w; w.x = cvt_pk_bf16(v0[0], v0[1]); w.y = cvt_pk_bf16(v0[2], v0[3]); w.z = cvt_pk_bf16(v1[0], v1[1]); w.w = cvt_pk_bf16(v1[2], v1[3]);
                        *(u32x4*)((bf16_t*)C + off + bj * HALF) = w; }
                    else { *(f32x4*)((float*)C + off + bj * HALF) = v0; *(f32x4*)((float*)C + off + bj * HALF + 4) = v1; } } }
    }
};
struct EpiGlu {
    static constexpr bool PERM = true, AFTER_DRAIN = false;
    const bf16_t* Y; int ldy; bf16_t* O; int ldo; int ooff;
    __device__ __forceinline__ void operator()(const f32x4 (&acc)[2][2][4][2], const Unit& u, int wr, int wc, int fr, int fq) const {
        const int row0 = u.pm * BM + wr * 64 + fr, col0 = u.pn * BM + wc * 32 + 8 * fq;
#pragma unroll
        for (int ai = 0; ai < 2; ++ai)
#pragma unroll
            for (int m = 0; m < 4; ++m) { const int row = row0 + ai * HALF + m * 16;
#pragma unroll
                for (int bj = 0; bj < 2; ++bj) { const f32x4 v0 = acc[ai][bj][m][0], v1 = acc[ai][bj][m][1];
                    const u32x4 yw = *(const u32x4*)(Y + (size_t)row * ldy + col0 + bj * HALF);
                    float y[8], g[8];
#pragma unroll
                    for (int j = 0; j < 4; ++j) { y[2 * j] = __uint_as_float(yw[j] << 16); y[2 * j + 1] = __uint_as_float(yw[j] & 0xffff0000u); }
#pragma unroll
                    for (int j = 0; j < 4; ++j) { g[j] = 1.f / (1.f + __expf(-v0[j])); g[4 + j] = 1.f / (1.f + __expf(-v1[j])); }
                    u32x4 w; w.x = cvt_pk_bf16(y[0] * g[0], y[1] * g[1]); w.y = cvt_pk_bf16(y[2] * g[2], y[3] * g[3]); w.z = cvt_pk_bf16(y[4] * g[4], y[5] * g[5]); w.w = cvt_pk_bf16(y[6] * g[6], y[7] * g[7]);
                    *(u32x4*)(O + (size_t)row * ldo + ooff + col0 + bj * HALF) = w; } }
    }
};
struct EpiGluGate {
    static constexpr bool PERM = true, AFTER_DRAIN = true;
    const bf16_t* Y; const bf16_t* Pz; bf16_t* G;
    __device__ __forceinline__ void fused(const f32x4 (&acc)[2][2][4][2], const Unit& u, int wr, int wc, int fr, int fq, PG8_LAS unsigned char* lds, int wid, int lane) const {
        constexpr int TS = 528;
        const int row0 = wr * 64 + fr, col0 = wc * 32 + 8 * fq;
#pragma unroll
        for (int ai = 0; ai < 2; ++ai)
#pragma unroll
            for (int m = 0; m < 4; ++m) { const int rl = row0 + ai * HALF + m * 16; const size_t grow = (size_t)u.pm * BM + rl;
#pragma unroll
                for (int bj = 0; bj < 2; ++bj) { const f32x4 v0 = acc[ai][bj][m][0], v1 = acc[ai][bj][m][1];
                    const u32x4 yw = *(const u32x4*)(Y + grow * 512 + u.pn * BM + col0 + bj * HALF);
                    float y[8], g[8];
#pragma unroll
                    for (int j = 0; j < 4; ++j) { y[2 * j] = __uint_as_float(yw[j] << 16); y[2 * j + 1] = __uint_as_float(yw[j] & 0xffff0000u); }
#pragma unroll
                    for (int j = 0; j < 4; ++j) { g[j] = 1.f / (1.f + __expf(-v0[j])); g[4 + j] = 1.f / (1.f + __expf(-v1[j])); }
                    u32x4 w; w.x = cvt_pk_bf16(y[0] * g[0], y[1] * g[1]); w.y = cvt_pk_bf16(y[2] * g[2], y[3] * g[3]); w.z = cvt_pk_bf16(y[4] * g[4], y[5] * g[5]); w.w = cvt_pk_bf16(y[6] * g[6], y[7] * g[7]);
                    *(PG8_LAS u32x4*)(lds + rl * TS + (col0 + bj * HALF) * 2) = w; } }
        __syncthreads();
        { const int t = wid * 64 + lane, row = t >> 1, hd = t & 1; const PG8_LAS unsigned char* src = lds + row * TS + hd * 256;
          float ss = 0.f;
#pragma unroll
          for (int i = 0; i < 16; ++i) { const u32x4 w = *(const PG8_LAS u32x4*)(src + 16 * i);
#pragma unroll
              for (int j = 0; j < 4; ++j) { const float a = __uint_as_float(w[j] << 16), b = __uint_as_float(w[j] & 0xffff0000u); ss += a * a + b * b; } }
          const float rn = rsqrtf(ss * (1.f / 128.f) + 1e-6f);
          const size_t grow = (size_t)u.pm * BM + row; const int cb = u.pn * BM + hd * 128;
          const bf16_t* zp = Pz + grow * 6144 + 2064 + cb; bf16_t* gp = G + grow * 2048 + 512 + cb;
#pragma unroll
          for (int i = 0; i < 16; ++i) { const u32x4 w = *(const PG8_LAS u32x4*)(src + 16 * i); const u32x4 zw = *(const u32x4*)(zp + 8 * i); u32x4 o;
#pragma unroll
              for (int j = 0; j < 4; ++j) { const float a = __uint_as_float(w[j] << 16), b = __uint_as_float(w[j] & 0xffff0000u), za = __uint_as_float(zw[j] << 16), zb = __uint_as_float(zw[j] & 0xffff0000u);
                  o[j] = cvt_pk_bf16(a * rn * (za / (1.f + __expf(-za))), b * rn * (zb / (1.f + __expf(-zb)))); }
              *(u32x4*)(gp + 8 * i) = o; } }
        __syncthreads();
    }
};
struct EpiBf16Scale {
    static constexpr bool PERM = true, AFTER_DRAIN = false;
    bf16_t* O; int ldc; const float* ssq;
    __device__ __forceinline__ void operator()(const f32x4 (&acc)[2][2][4][2], const Unit& u, int wr, int wc, int fr, int fq) const {
        const int row0 = u.pm * BM + wr * 64 + fr, col0 = u.pn * BM + wc * 32 + 8 * fq;
#pragma unroll
        for (int ai = 0; ai < 2; ++ai)
#pragma unroll
            for (int m = 0; m < 4; ++m) { const int row = row0 + ai * HALF + m * 16; bf16_t* rowp = O + (size_t)row * ldc + col0;
                float ssum = 0.f; { const f32x4* sp_ = (const f32x4*)(ssq + (size_t)row * 32);
#pragma unroll
                    for (int q = 0; q < 8; ++q) { const f32x4 t4 = sp_[q]; ssum += (t4[0] + t4[1]) + (t4[2] + t4[3]); } }
                const float s = rsqrtf(ssum * (1.f / 2048.f) + 1e-6f);
#pragma unroll
                for (int bj = 0; bj < 2; ++bj) { const f32x4 v0 = acc[ai][bj][m][0] * s, v1 = acc[ai][bj][m][1] * s;
                    u32x4 w; w.x = cvt_pk_bf16(v0[0], v0[1]); w.y = cvt_pk_bf16(v0[2], v0[3]); w.z = cvt_pk_bf16(v1[0], v1[1]); w.w = cvt_pk_bf16(v1[2], v1[3]);
                    *(u32x4*)(rowp + bj * HALF) = w; } }
    }
};
struct EpiResidNext {
    static constexpr bool PERM = false, AFTER_DRAIN = false;
    const float* R; float* C; int ldc; bf16_t* XB; float* ssq;
    __device__ __forceinline__ void operator()(const f32x4 (&acc)[2][2][4][2], const Unit& u, int wr, int wc, int fr, int fq) const {
        const int row0 = u.pm * BM + wr * 64 + fr, col0 = u.pn * BM + wc * 32 + 4 * fq;
#pragma unroll
        for (int ai = 0; ai < 2; ++ai)
#pragma unroll
            for (int m = 0; m < 4; ++m) { const int row = row0 + ai * HALF + m * 16; const size_t off = (size_t)row * ldc + col0; float ss = 0.f;
#pragma unroll
                for (int bj = 0; bj < 2; ++bj)
#pragma unroll
                    for (int n = 0; n < 2; ++n) { const f32x4 r = *(const f32x4*)(R + off + bj * HALF + n * 16); const f32x4 v = acc[ai][bj][m][n] + r;
                        *(f32x4*)(C + off + bj * HALF + n * 16) = v;
                        if (XB) { u32x2 w; w.x = cvt_pk_bf16(v[0], v[1]); w.y = cvt_pk_bf16(v[2], v[3]); *(u32x2*)(XB + off + bj * HALF + n * 16) = w; }
                        ss += v[0] * v[0] + v[1] * v[1] + v[2] * v[2] + v[3] * v[3]; }
                if (ssq) { ss += shx(ss, 16); ss += shx(ss, 32); if (fq == 0) ssq[(size_t)row * 32 + u.pn * 4 + wc] = ss; } }
    }
};
template <class Epi, class Sched, bool STAMP = false>
__device__ __forceinline__ void gemm_phase(PG8_LAS unsigned char* lds, const Gemm g, const Sched& S, const Epi& E, unsigned long long* stamps) {
    const int tid = TIDX(), wid = __builtin_amdgcn_readfirstlane(tid >> 6), lane = tid & 63, wr = wid >> 2, wc = wid & 3, fr = lane & 15, fq = lane >> 4;
    const int K = g.K, nt = K / BK;
    int ts_lo = 0, ts_hi = 0, nts = 0; const unsigned long long rt_entry = STAMP ? (unsigned long long)wall_clock64() : 0ull;
#define PG8_STAMP() do { if (STAMP && wid == 0 && nts < 64) { const unsigned long long _c = (unsigned long long)clock64(); \
        ts_lo = (lane == nts) ? (int)(unsigned)_c : ts_lo; ts_hi = (lane == nts) ? (int)(unsigned)(_c >> 32) : ts_hi; ++nts; } } while (0)
    PG8_STAMP();
    unsigned voffA[2], voffB[2];
#pragma unroll
    for (int i = 0; i < 2; ++i) { int R, C; stage_rc(tid * 16 + i * 8192, R, C); const int Rb = Epi::PERM ? ((R & ~31) + perm32(R & 31)) : R;
        voffA[i] = (unsigned)(R * K + C) * 2u; voffB[i] = (unsigned)(Rb * K + C) * 2u; }
    const size_t kstep = (size_t)(BK * 2);
    const size_t hstep = (size_t)HALF * K * 2;
    const size_t tstep = 2 * hstep;
    const unsigned ldsw = (unsigned)wid * 1024u;
    const int aoff = lds_byte(wr * 64 + fr, fq * 8), boff = lds_byte(wc * 32 + fr, fq * 8);
#define PG8_SA(b, h) (((b) * 2 + (h)) * HTB)
#define PG8_SB(b, h) ((4 + (b) * 2 + (h)) * HTB)
#define PG8_STAGE(bufoff, gbase, voff) do { _Pragma("unroll") for (int _i = 0; _i < 2; ++_i) \
        __builtin_amdgcn_global_load_lds((const unsigned*)((const char*)(gbase) + (voff)[_i]), (PG8_LAS unsigned*)(lds + (bufoff) + ldsw + _i * 8192), 16, 0, 0); } while (0)
#define PG8_LDA(dst, b, h) do { _Pragma("unroll") for (int m = 0; m < 4; ++m) _Pragma("unroll") for (int k = 0; k < 2; ++k) dst[m][k] = *(const PG8_LAS bf16x8*)(lds + PG8_SA(b, h) + aoff + m * 2048 + k * 1024); } while (0)
#define PG8_LDB(dst, b, h) do { _Pragma("unroll") for (int n = 0; n < 2; ++n) _Pragma("unroll") for (int k = 0; k < 2; ++k) dst[n][k] = *(const PG8_LAS bf16x8*)(lds + PG8_SB(b, h) + boff + n * 2048 + k * 1024); } while (0)
#define PG8_MMA(ai, bj, At, Bt) do { __builtin_amdgcn_s_setprio(1); _Pragma("unroll") for (int m = 0; m < 4; ++m) _Pragma("unroll") for (int n = 0; n < 2; ++n) _Pragma("unroll") for (int k = 0; k < 2; ++k) \
        acc[ai][bj][m][n] = __builtin_amdgcn_mfma_f32_16x16x32_bf16(Bt[n][k], At[m][k], acc[ai][bj][m][n], 0, 0, 0); __builtin_amdgcn_s_setprio(0); } while (0)
#define PG8_WAIT_V(n) asm volatile("s_waitcnt vmcnt(" #n ")" ::: "memory")
#define PG8_WAIT_L(n) asm volatile("s_waitcnt lgkmcnt(" #n ")" ::: "memory")
#define PG8_BAR __builtin_amdgcn_s_barrier()
#define PG8_SCHED __builtin_amdgcn_sched_barrier(0)
    Unit cur, nxt; int ui = 0;
    if (!S.next(0, cur)) return;
    f32x4 acc[2][2][4][2];
#pragma unroll
    for (int a = 0; a < 2; ++a)
#pragma unroll
        for (int b = 0; b < 2; ++b)
#pragma unroll
            for (int m = 0; m < 4; ++m)
#pragma unroll
                for (int n = 0; n < 2; ++n) acc[a][b][m][n] = (f32x4){0.f, 0.f, 0.f, 0.f};
    bf16x8 At[4][2], B0[2][2], B1[2][2];
    const char* cA = (const char*)g.A + (size_t)cur.pm * tstep; const char* cB = (const char*)g.Bt + (size_t)cur.pn * tstep;
    S.a_ready(cur);
    PG8_STAGE(PG8_SB(0, 0), cB, voffB); PG8_STAGE(PG8_SA(0, 0), cA, voffA); PG8_STAGE(PG8_SB(0, 1), cB + hstep, voffB); PG8_STAGE(PG8_SA(0, 1), cA + hstep, voffA);
    if (wr == 1) PG8_BAR;
    PG8_WAIT_V(4); PG8_BAR;
    PG8_STAGE(PG8_SB(1, 0), cB + kstep, voffB); PG8_STAGE(PG8_SA(1, 0), cA + kstep, voffA); PG8_STAGE(PG8_SB(1, 1), cB + hstep + kstep, voffB);
    PG8_WAIT_V(6); PG8_BAR;
    PG8_STAMP();
    for (;;) {
        const bool has_next = S.next(ui + 1, nxt);
        const char* nA = has_next ? (const char*)g.A + (size_t)nxt.pm * tstep : cA; const char* nB = has_next ? (const char*)g.Bt + (size_t)nxt.pn * tstep : cB;
        for (int t = 0; t < nt; t += 2) {
            const bool last = (t == nt - 2);
            const char* a1 = cA + (size_t)(t + 1) * kstep;
            const char* a2 = last ? nA : cA + (size_t)(t + 2) * kstep; const char* b2 = last ? nB : cB + (size_t)(t + 2) * kstep;
            const char* a3 = a2 + kstep; const char* b3 = b2 + kstep;
            if (last && has_next) S.a_ready(nxt);
            PG8_LDB(B0, 0, 0); PG8_SCHED; PG8_LDA(At, 0, 0); PG8_STAGE(PG8_SA(1, 1), a1 + hstep, voffA);
            PG8_WAIT_L(8); PG8_BAR; PG8_WAIT_L(0); PG8_MMA(0, 0, At, B0); PG8_BAR; PG8_SCHED;
            PG8_LDB(B1, 0, 1); PG8_STAGE(PG8_SB(0, 0), b2, voffB);
            PG8_BAR; PG8_WAIT_L(0); PG8_MMA(0, 1, At, B1); PG8_BAR;
            PG8_LDA(At, 0, 1); PG8_STAGE(PG8_SA(0, 0), a2, voffA);
            PG8_BAR; PG8_WAIT_L(0); PG8_MMA(1, 0, At, B0); PG8_BAR; PG8_SCHED;
            PG8_STAGE(PG8_SB(0, 1), b2 + hstep, voffB);
            PG8_WAIT_V(6); PG8_BAR; PG8_MMA(1, 1, At, B1); PG8_BAR;
            PG8_LDB(B0, 1, 0); PG8_SCHED; PG8_LDA(At, 1, 0); PG8_STAGE(PG8_SA(0, 1), a2 + hstep, voffA);
            PG8_WAIT_L(8); PG8_BAR; PG8_WAIT_L(0); PG8_MMA(0, 0, At, B0); PG8_BAR; PG8_SCHED;
            PG8_LDB(B1, 1, 1); PG8_STAGE(PG8_SB(1, 0), b3, voffB);
            PG8_BAR; PG8_WAIT_L(0); PG8_MMA(0, 1, At, B1); PG8_BAR;
            PG8_LDA(At, 1, 1); PG8_STAGE(PG8_SA(1, 0), a3, voffA);
            PG8_BAR; PG8_WAIT_L(0); PG8_MMA(1, 0, At, B0); PG8_BAR; PG8_SCHED;
            PG8_STAGE(PG8_SB(1, 1), b3 + hstep, voffB);
            PG8_WAIT_V(6); PG8_BAR; PG8_MMA(1, 1, At, B1); PG8_BAR;
        }
        PG8_STAMP();
        if constexpr (!Epi::AFTER_DRAIN) { E(acc, cur, wr, wc, fr, fq); S.done(cur); }
        PG8_STAMP();
        if (!has_next) break;
#pragma unroll
        for (int a = 0; a < 2; ++a)
#pragma unroll
            for (int b = 0; b < 2; ++b)
#pragma unroll
                for (int m = 0; m < 4; ++m)
#pragma unroll
                    for (int n = 0; n < 2; ++n) acc[a][b][m][n] = (f32x4){0.f, 0.f, 0.f, 0.f};
        cur = nxt; cA = nA; cB = nB; ++ui;
    }
    PG8_WAIT_V(0);
    if (wr == 0) PG8_BAR;
    PG8_BAR;
    if constexpr (Epi::AFTER_DRAIN) { E.fused(acc, cur, wr, wc, fr, fq, lds, wid, lane); S.done(cur); }
    PG8_STAMP();
    if (STAMP && wid == 0) { stamps[lane] = lane < nts ? (((unsigned long long)(unsigned)ts_hi << 32) | (unsigned)ts_lo) : 0ull;
        if (lane == 62) stamps[62] = rt_entry; if (lane == 63) stamps[63] = (unsigned long long)wall_clock64(); }
#undef PG8_STAMP
#undef PG8_SA
#undef PG8_SB
#undef PG8_STAGE
#undef PG8_LDA
#undef PG8_LDB
#undef PG8_MMA
#undef PG8_WAIT_V
#undef PG8_WAIT_L
#undef PG8_BAR
#undef PG8_SCHED
}
}
namespace att {
constexpr int D = 128, NW = 8, QBLK = 32, KVBLK = 64;
constexpr float SCALE = 0.088388347648318440f, THR = 8.f;
constexpr int SHM_V = KVBLK * D * 2, SHM_K = KVBLK * D * 2, SHM_ATTN = 2 * SHM_V + 2 * SHM_K + NW * 64 * 4;
#define KSWZ(row, colB) ((row) * 256 + ((colB) ^ (((row) & 7) << 4)))
#define SBAR() __builtin_amdgcn_sched_barrier(0)
__device__ __forceinline__ int crow(int r, int hi) { return (r & 3) + 8 * (r >> 2) + 4 * hi; }
__device__ __forceinline__ unsigned cvtpk(float lo, float hi) { unsigned r; asm volatile("v_cvt_pk_bf16_f32 %0, %1, %2" : "=v"(r) : "v"(lo), "v"(hi)); return r; }

template <bool MASKED>
__device__ __forceinline__ void partialSM(f32x16& p0, f32x16& p1, float& m_reg, float& mn, float& alpha, unsigned long long mw, int hi) {
  constexpr float C = SCALE * 1.4426950408889634f;
  float pmax = p0[0];
#pragma unroll
  for (int r = 1; r < 16; ++r) pmax = fmaxf(pmax, p0[r]);
#pragma unroll
  for (int r = 0; r < 16; ++r) pmax = fmaxf(pmax, p1[r]);
  { auto rr = __builtin_amdgcn_permlane32_swap(__float_as_uint(pmax), __float_as_uint(pmax), false, false);
    pmax = fmaxf(__uint_as_float(rr[0]), __uint_as_float(rr[1])); }
  if (__builtin_expect(__all(pmax - m_reg <= THR / SCALE), 1)) { mn = m_reg; alpha = 1.f; }
  else { mn = fmaxf(m_reg, pmax); alpha = __builtin_amdgcn_exp2f((m_reg - mn) * C); m_reg = mn; }
  const float mnC = -mn * C;
#pragma unroll
  for (int r = 0; r < 16; ++r) p0[r] = fmaf(p0[r], C, mnC);
#pragma unroll
  for (int r = 0; r < 16; ++r) p1[r] = fmaf(p1[r], C, mnC);
#pragma unroll
  for (int r = 0; r < 16; ++r) p0[r] = __builtin_amdgcn_exp2f(p0[r]);
}
__device__ __forceinline__ void finishSM(f32x16& p0, f32x16& p1, float alpha, float& l_reg, bf16x8& pa0, bf16x8& pa1, bf16x8& pa2, bf16x8& pa3) {
#pragma unroll
  for (int r = 0; r < 16; ++r) p1[r] = __builtin_amdgcn_exp2f(p1[r]);
  float ps = 0;
#pragma unroll
  for (int r = 0; r < 16; ++r) ps += p0[r];
#pragma unroll
  for (int r = 0; r < 16; ++r) ps += p1[r];
  { auto rr = __builtin_amdgcn_permlane32_swap(__float_as_uint(ps), __float_as_uint(ps), false, false);
    ps = __uint_as_float(rr[0]) + __uint_as_float(rr[1]); }
  l_reg = l_reg * alpha + ps;
#define PK4(P, BASE, OUT) do { unsigned a0 = cvtpk(P[BASE + 0], P[BASE + 1]), a1 = cvtpk(P[BASE + 2], P[BASE + 3]);   \
    unsigned b0 = cvtpk(P[BASE + 4], P[BASE + 5]), b1 = cvtpk(P[BASE + 6], P[BASE + 7]);                              \
    auto r0 = __builtin_amdgcn_permlane32_swap(a0, b0, false, false); auto r1 = __builtin_amdgcn_permlane32_swap(a1, b1, false, false); \
    u32x4 w = {r0[0], r1[0], r0[1], r1[1]}; OUT = *reinterpret_cast<bf16x8*>(&w); } while (0)
  PK4(p0, 0, pa0); PK4(p0, 8, pa1); PK4(p1, 0, pa2); PK4(p1, 8, pa3);
#undef PK4
}
template <int R> __device__ __forceinline__ float mask_bias(unsigned nw) {
  unsigned t; constexpr int bit = (R & 3) + 8 * (R >> 2);
  asm("v_bfe_i32 %0, %1, %2, 1\n\tv_and_b32 %0, 0xff800000, %0" : "=v"(t) : "v"(nw), "n"(bit));
  return __uint_as_float(t);
}
template <bool MASKED>
__device__ __forceinline__ void qkt(f32x16& p0, f32x16& p1, const char* Ks, const bf16x8* qr, int r32, int hi, unsigned long long mw) {
  if (MASKED) {
    const unsigned n0 = ~((unsigned)mw >> (4 * hi)), n1 = ~((unsigned)(mw >> 32) >> (4 * hi));
#define MB_(R) p0[R] = mask_bias<R>(n0); p1[R] = mask_bias<R>(n1);
    MB_(0) MB_(1) MB_(2) MB_(3) MB_(4) MB_(5) MB_(6) MB_(7) MB_(8) MB_(9) MB_(10) MB_(11) MB_(12) MB_(13) MB_(14) MB_(15)
#undef MB_
  } else { p0 = f32x16{}; p1 = f32x16{}; }
  asm volatile("" : "+v"(p0), "+v"(p1));
#pragma unroll
  for (int d0 = 0; d0 < 8; ++d0) { const int cb = (d0 * 16 + hi * 8) * 2;
    bf16x8 b0 = *reinterpret_cast<const bf16x8*>(Ks + KSWZ(r32, cb));
    bf16x8 b1 = *reinterpret_cast<const bf16x8*>(Ks + KSWZ(32 + r32, cb));
    p0 = __builtin_amdgcn_mfma_f32_32x32x16_bf16(b0, qr[d0], p0, 0, 0, 0);
    p1 = __builtin_amdgcn_mfma_f32_32x32x16_bf16(b1, qr[d0], p1, 0, 0, 0); }
}
__device__ __forceinline__ int v_st(int k, int c) { const int kk = (k & ~0xC) | ((k & 4) << 1) | ((k & 8) >> 1); return ((kk >> 3) * 4 + (c >> 5)) * 512 + ((kk & 7) * 32 + (c & 31)) * 2; }
__device__ __forceinline__ int v_rd_base(int lane) { return ((lane & 3) << 3) | (((lane >> 2) & 3) << 6) | (((lane >> 4) & 1) << 5) | (((lane >> 5) & 1) << 8); }
constexpr int v_rd_off(int d0, int ks, int half) { return d0 * 512 + ks * 4096 + half * 2048; }
template <int OFF> __device__ __forceinline__ s16x4 tr_read(int vb) {
  s16x4 r; asm volatile("ds_read_b64_tr_b16 %0, %1 offset:%2" : "=&v"(r) : "v"(vb), "i"(OFF) : "memory"); return r;
}
template <int D0> __device__ __forceinline__ void pv_one(f32x16& od, int vb, bf16x8 pa0, bf16x8 pa1, bf16x8 pa2, bf16x8 pa3) {
  const s16x4 l0 = tr_read<v_rd_off(D0, 0, 0)>(vb), h0 = tr_read<v_rd_off(D0, 0, 1)>(vb), l1 = tr_read<v_rd_off(D0, 1, 0)>(vb), h1 = tr_read<v_rd_off(D0, 1, 1)>(vb);
  const s16x4 l2 = tr_read<v_rd_off(D0, 2, 0)>(vb), h2 = tr_read<v_rd_off(D0, 2, 1)>(vb), l3 = tr_read<v_rd_off(D0, 3, 0)>(vb), h3 = tr_read<v_rd_off(D0, 3, 1)>(vb);
  asm volatile("s_waitcnt lgkmcnt(0)" ::: "memory"); SBAR();
#define PK(L, H) (bf16x8){L[0], L[1], L[2], L[3], H[0], H[1], H[2], H[3]}
  od = __builtin_amdgcn_mfma_f32_32x32x16_bf16(pa0, PK(l0, h0), od, 0, 0, 0);
  od = __builtin_amdgcn_mfma_f32_32x32x16_bf16(pa1, PK(l1, h1), od, 0, 0, 0);
  od = __builtin_amdgcn_mfma_f32_32x32x16_bf16(pa2, PK(l2, h2), od, 0, 0, 0);
  od = __builtin_amdgcn_mfma_f32_32x32x16_bf16(pa3, PK(l3, h3), od, 0, 0, 0);
#undef PK
}
__device__ __forceinline__ void pv_d0(f32x16* o, int vb, bf16x8 pa0, bf16x8 pa1, bf16x8 pa2, bf16x8 pa3) {
  pv_one<0>(o[0], vb, pa0, pa1, pa2, pa3); pv_one<1>(o[1], vb, pa0, pa1, pa2, pa3); pv_one<2>(o[2], vb, pa0, pa1, pa2, pa3); pv_one<3>(o[3], vb, pa0, pa1, pa2, pa3);
}

template <bool MASKED, int LDK, int VOFF, int QT, class OutRow>
__device__ __forceinline__ void attn_body(const bf16_t* __restrict__ Qw, const float* __restrict__ qgain, const float* __restrict__ qcs, const bf16_t* __restrict__ Kh, int NT,
                                          const unsigned long long* __restrict__ mbase, unsigned moff, const OutRow& Ow, char* lds) {
  const int tid = TIDX(), wid = tid >> 6, lane = tid & 63, r32 = lane & 31, hi = lane >> 5;
  char* V_lds = lds; char* K_lds = lds + 2 * SHM_V;
  float* ws = (float*)(lds + 2 * SHM_V + 2 * SHM_K) + wid * 64; float* li_l = ws; float* al_l = ws + 32;
  float m_reg = -1e30f, l_reg = 0; f32x16 o[4] = {}; bf16x8 qr[8];
  asm volatile("" : "+v"(o[0]), "+v"(o[1]), "+v"(o[2]), "+v"(o[3]));
#pragma unroll
  for (int d0 = 0; d0 < 8; ++d0) qr[d0] = *reinterpret_cast<const bf16x8*>(Qw + d0 * 16);
  if (QT) {
    float ss = 0.f;
#pragma unroll
    for (int d0 = 0; d0 < 8; ++d0)
#pragma unroll
      for (int j = 0; j < 8; ++j) { const float x = bf2f((bf16_t)qr[d0][j]); ss += x * x; }
    { auto rr = __builtin_amdgcn_permlane32_swap(__float_as_uint(ss), __float_as_uint(ss), false, false); ss = __uint_as_float(rr[0]) + __uint_as_float(rr[1]); }
    const float rn = rsqrtf(ss * (1.f / 128.f) + EPS);
    float x01[2][8];
#pragma unroll
    for (int d0 = 0; d0 < 8; ++d0) { const f32x4 g0 = *(const f32x4*)(qgain + d0 * 16 + hi * 8), g1 = *(const f32x4*)(qgain + d0 * 16 + hi * 8 + 4);
      float x[8];
#pragma unroll
      for (int j = 0; j < 8; ++j) x[j] = bf2f((bf16_t)qr[d0][j]) * rn * (j < 4 ? g0[j] : g1[j - 4]);
      if (QT == 2 && d0 < 2) {
#pragma unroll
        for (int j = 0; j < 8; ++j) x01[d0][j] = x[j];
      } else { u32x4 w = {cvtpk(x[0], x[1]), cvtpk(x[2], x[3]), cvtpk(x[4], x[5]), cvtpk(x[6], x[7])}; qr[d0] = *reinterpret_cast<bf16x8*>(&w); } }
    if (QT == 2) {
      float a[8], b[8];
#pragma unroll
      for (int j2 = 0; j2 < 4; ++j2) { const f32x4 cs = *(const f32x4*)(qcs + hi * 16 + 4 * j2);
#pragma unroll
        for (int q = 0; q < 2; ++q) { const int j = 2 * j2 + q; const float c = cs[2 * q], sn = cs[2 * q + 1], x1 = x01[0][j], x2 = x01[1][j]; a[j] = x1 * c - x2 * sn; b[j] = x2 * c + x1 * sn; } }
      { u32x4 w = {cvtpk(a[0], a[1]), cvtpk(a[2], a[3]), cvtpk(a[4], a[5]), cvtpk(a[6], a[7])}; qr[0] = *reinterpret_cast<bf16x8*>(&w); }
      { u32x4 w = {cvtpk(b[0], b[1]), cvtpk(b[2], b[3]), cvtpk(b[4], b[5]), cvtpk(b[6], b[7])}; qr[1] = *reinterpret_cast<bf16x8*>(&w); }
    }
  }
  const int sr = tid >> 4, sc = (tid & 15) * 8, vst0 = v_st(sr, sc), vst1 = v_st(32 + sr, sc);
  const int vb0 = (int)(uintptr_t)V_lds + v_rd_base(lane);
  struct { bf16x8 vs0, vs1, ks0, ks1; } sr_[2];
  const unsigned koff = (unsigned)(sr * LDK + sc) * 2u;
#define SLOAD(i, k0) do { const char* kb_ = (const char*)Kh + (size_t)(k0) * (LDK * 2); \
    sr_[i].vs0 = *reinterpret_cast<const bf16x8*>(kb_ + koff + VOFF * 2); sr_[i].vs1 = *reinterpret_cast<const bf16x8*>(kb_ + koff + (32 * LDK + VOFF) * 2); \
    sr_[i].ks0 = *reinterpret_cast<const bf16x8*>(kb_ + koff); sr_[i].ks1 = *reinterpret_cast<const bf16x8*>(kb_ + koff + 32 * LDK * 2); } while (0)
#define SWRITE(b, i) do { *(bf16x8*)(V_lds + (b) * SHM_V + vst0) = sr_[i].vs0;          \
    *(bf16x8*)(V_lds + (b) * SHM_V + vst1) = sr_[i].vs1; int kc = sc * 2;               \
    *(bf16x8*)(K_lds + (b) * SHM_K + KSWZ(sr, kc)) = sr_[i].ks0;                       \
    *(bf16x8*)(K_lds + (b) * SHM_K + KSWZ(32 + sr, kc)) = sr_[i].ks1; } while (0)
#define SWAIT() asm volatile("s_waitcnt vmcnt(4)" ::: "memory")
#define RESC(a) do { if (__any((a) < 1.f)) { if (hi == 0) al_l[r32] = (a); asm volatile("s_waitcnt lgkmcnt(0)" ::: "memory"); \
    _Pragma("unroll") for (int d = 0; d < 4; ++d) _Pragma("unroll") for (int r = 0; r < 16; ++r) o[d][r] *= al_l[crow(r, hi)]; } } while (0)
  f32x16 pA0, pA1, pB0, pB1; float mnA, mnB, alA, alB; bf16x8 pa0, pa1, pa2, pa3;
  unsigned long long mw = 0ull;
  constexpr int SE = 0, SO = 1;
  if (MASKED) mw = *(const unsigned long long*)((const char*)mbase + moff);
  SLOAD(SE, 0); asm volatile("s_waitcnt vmcnt(0)" ::: "memory"); SWRITE(0, SE); __syncthreads();
  qkt<MASKED>(pA0, pA1, K_lds, qr, r32, hi, mw);
  if (MASKED) mw = *(const unsigned long long*)((const char*)mbase + (moff + 8u));
  partialSM<MASKED>(pA0, pA1, m_reg, mnA, alA, mw, hi);
  SLOAD(SO, KVBLK); SLOAD(SE, (2 < NT ? 2 : NT - 1) * KVBLK);
  SWAIT();
  SWRITE(1, SO); __syncthreads();
  for (int j = 1; j + 1 < NT; j += 2) {
    SBAR(); qkt<MASKED>(pB0, pB1, K_lds + SHM_K, qr, r32, hi, mw);
    if (MASKED) mw = *(const unsigned long long*)((const char*)mbase + (moff + 8u * (unsigned)(j + 1)));
    finishSM(pA0, pA1, alA, l_reg, pa0, pa1, pa2, pa3); SBAR();
    SLOAD(SO, (j + 2) * KVBLK); SBAR();
    pv_d0(o, vb0, pa0, pa1, pa2, pa3); partialSM<MASKED>(pB0, pB1, m_reg, mnB, alB, mw, hi);
    __syncthreads(); if (MASKED) asm volatile("s_waitcnt vmcnt(5)" ::: "memory"); else SWAIT();
    SWRITE(0, SE);
    RESC(alB); __syncthreads();
    SBAR(); qkt<MASKED>(pA0, pA1, K_lds, qr, r32, hi, mw);
    if (MASKED) mw = *(const unsigned long long*)((const char*)mbase + (moff + 8u * (unsigned)(j + 2)));
    finishSM(pB0, pB1, alB, l_reg, pa0, pa1, pa2, pa3); SBAR();
    SLOAD(SE, (j + 3 < NT ? j + 3 : NT - 1) * KVBLK); SBAR();
    pv_d0(o, vb0 + SHM_V, pa0, pa1, pa2, pa3); partialSM<MASKED>(pA0, pA1, m_reg, mnA, alA, mw, hi);
    __syncthreads(); if (MASKED) asm volatile("s_waitcnt vmcnt(5)" ::: "memory"); else SWAIT();
    SWRITE(1, SO);
    RESC(alA); __syncthreads();
  }
  SBAR(); qkt<MASKED>(pB0, pB1, K_lds + SHM_K, qr, r32, hi, mw);
  finishSM(pA0, pA1, alA, l_reg, pa0, pa1, pa2, pa3); SBAR();
  pv_d0(o, vb0, pa0, pa1, pa2, pa3); partialSM<MASKED>(pB0, pB1, m_reg, mnB, alB, mw, hi);
  __syncthreads(); RESC(alB);
  finishSM(pB0, pB1, alB, l_reg, pa0, pa1, pa2, pa3); SBAR();
  pv_d0(o, vb0 + SHM_V, pa0, pa1, pa2, pa3);
  if (hi == 0) li_l[r32] = l_reg; asm volatile("s_waitcnt lgkmcnt(0)" ::: "memory");
  float rli[16];
#pragma unroll
  for (int r = 0; r < 16; ++r) rli[r] = __builtin_amdgcn_rcpf(li_l[crow(r, hi)]);
  __syncthreads();
  float* og_s = (float*)lds + wid * (32 * 132);
#pragma unroll
  for (int r = 0; r < 16; ++r) {
#pragma unroll
    for (int d0 = 0; d0 < 4; ++d0) og_s[crow(r, hi) * 132 + d0 * 32 + r32] = o[d0][r] * rli[r]; }
  asm volatile("" ::: "memory");
  { const int row = lane >> 1, half = lane & 1; const float* src = og_s + row * 132 + half * 64;
    f32x4 v[16]; float ss = 0.f;
#pragma unroll
    for (int i = 0; i < 16; ++i) { v[i] = *(const f32x4*)(src + 4 * i); ss += v[i][0] * v[i][0] + v[i][1] * v[i][1] + v[i][2] * v[i][2] + v[i][3] * v[i][3]; }
    ss += shx(ss, 1);
    const float rn = rsqrtf(ss * (1.f / 128.f) + EPS);
    const bf16_t* zp = Ow.zrow(row) + half * 64; bf16_t* gp = Ow.grow(row) + half * 64;
#pragma unroll
    for (int i = 0; i < 8; ++i) { float z[8], g[8]; ld8f(zp + 8 * i, z);
#pragma unroll
      for (int q = 0; q < 4; ++q) { g[q] = v[2 * i][q] * rn * siluf_(z[q]); g[4 + q] = v[2 * i + 1][q] * rn * siluf_(z[4 + q]); }
      st8f(gp + 8 * i, g); } }
  __syncthreads();
#undef SLOAD
#undef SWRITE
#undef SWAIT
#undef RESC
}
}
constexpr size_t al256(size_t x) { return (x + 255) / 256 * 256; }
constexpr size_t WS_CTL   = 0;
constexpr size_t CTL_BYTES = 65536;
constexpr size_t WS_WINT  = WS_CTL + CTL_BYTES;
constexpr size_t WS_WOUTT = WS_WINT + al256((size_t)DEPTH * NPAD * DM * 2);
constexpr size_t WS_WKVT  = WS_WOUTT + al256((size_t)DEPTH * DM * MIX * 2);
constexpr size_t WS_WGLUT = WS_WKVT + al256((size_t)DEPTH * 1024 * DM * 2);
constexpr size_t WS_MEMN  = WS_WGLUT + al256((size_t)DEPTH * 512 * 512 * 2);
constexpr size_t WS_KVMEM = WS_MEMN + al256((size_t)NB * MEML * DM * 2);
constexpr size_t WS_XN    = WS_KVMEM + al256((size_t)NB * MEML * DEPTH * 1024 * 2);
constexpr size_t WS_P     = WS_XN + al256((size_t)NTOK * DM * 2);
constexpr size_t WS_XBUF  = WS_P + al256((size_t)NTOK * NPAD * 2);
constexpr size_t WS_OCAT  = WS_XBUF + al256((size_t)NTOK * DM * 4);
constexpr size_t WS_MASK  = WS_OCAT + al256((size_t)NTOK * MIX * 2);
constexpr size_t WS_IW    = WS_MASK + al256((size_t)NTOK * 64 * 8);
constexpr size_t WS_YBUF  = WS_IW + al256((size_t)NTOK * 16 * 4);
constexpr size_t WS_ROPE  = WS_YBUF + al256((size_t)NTOK * 512 * 2);
constexpr size_t WS_S5P   = WS_ROPE + al256((size_t)NTOK * 48 * 4);
constexpr size_t S5P_BYTES = (size_t)DEPTH * 32 * (64 * 2 + 64 * 2 + 64 * 16 * 2) * 4;
constexpr size_t WS_GLAS  = WS_S5P + al256(S5P_BYTES);
constexpr size_t WS_GLAD  = WS_GLAS + al256((size_t)NB * 64 * 4 * 64 * 128 * 4);
constexpr size_t WS_IKC   = WS_GLAD + al256((size_t)NB * 64 * 4 * 64 * 4);
constexpr size_t WS_KVC   = WS_IKC + al256((size_t)NTOK * 64 * 2);
constexpr size_t WS_IQL   = WS_KVC + al256((size_t)NTOK * 256 * 2);
constexpr size_t WS_SSQ   = WS_IQL + al256((size_t)NTOK * 64 * 2);
constexpr size_t DSP_SLOT = (size_t)(256 * 128 + 512) * 4;
constexpr size_t WS_DSP   = WS_SSQ + 256;
constexpr size_t WS_END   = WS_DSP + al256((size_t)160 * 2 * DSP_SLOT);

struct Params {
    const float* x; const float* mem; const int* pos; const float* ln_gain; const float* w_in; const float* gla_w_up; const float* gla_b_up;
    const float* s5_a_re; const float* s5_a_im; const float* s5_log_step; const float* s5_b_re; const float* s5_b_im; const float* s5_c_re; const float* s5_c_im;
    const float* s5_d; const float* s5_w_glu; const float* dsa_q_norm; const float* dsa_k_norm; const float* mem_norm; const float* w_mem_kv;
    const float* mem_q_norm; const float* mem_k_norm; const float* out_norm; const float* w_out;
    float* out;
    char* ws;
    __device__ __forceinline__ unsigned* ctl_() const { return (unsigned*)(ws + WS_CTL); }
    __device__ __forceinline__ bf16_t* WinT_() const { return (bf16_t*)(ws + WS_WINT); }
    __device__ __forceinline__ bf16_t* WoutT_() const { return (bf16_t*)(ws + WS_WOUTT); }
    __device__ __forceinline__ bf16_t* WkvT_() const { return (bf16_t*)(ws + WS_WKVT); }
    __device__ __forceinline__ bf16_t* WgluT_() const { return (bf16_t*)(ws + WS_WGLUT); }
    __device__ __forceinline__ bf16_t* memn_() const { return (bf16_t*)(ws + WS_MEMN); }
    __device__ __forceinline__ bf16_t* kvmem_() const { return (bf16_t*)(ws + WS_KVMEM); }
    __device__ __forceinline__ bf16_t* xn_() const { return (bf16_t*)(ws + WS_XN); }
    __device__ __forceinline__ bf16_t* p_() const { return (bf16_t*)(ws + WS_P); }
    __device__ __forceinline__ bf16_t* xbuf_() const { return (bf16_t*)(ws + WS_XBUF); }
    __device__ __forceinline__ bf16_t* ocat_() const { return (bf16_t*)(ws + WS_OCAT); }
    __device__ __forceinline__ unsigned long long* mask_() const { return (unsigned long long*)(ws + WS_MASK); }
    __device__ __forceinline__ float* iw_() const { return (float*)(ws + WS_IW); }
    __device__ __forceinline__ bf16_t* ybuf_() const { return (bf16_t*)(ws + WS_YBUF); }
    __device__ __forceinline__ float* rope_() const { return (float*)(ws + WS_ROPE); }
    __device__ __forceinline__ float* s5p_() const { return (float*)(ws + WS_S5P); }
    __device__ __forceinline__ float* glas_() const { return (float*)(ws + WS_GLAS); }
    __device__ __forceinline__ float* glad_() const { return (float*)(ws + WS_GLAD); }
    __device__ __forceinline__ bf16_t* ikc_() const { return (bf16_t*)(ws + WS_IKC); }
    __device__ __forceinline__ bf16_t* kvc_() const { return (bf16_t*)(ws + WS_KVC); }
    __device__ __forceinline__ float* ssq_() const { return (float*)(ws + WS_SSQ); }
    __device__ __forceinline__ bf16_t* iql_() const { return (bf16_t*)(ws + WS_IQL); }
    __device__ __forceinline__ char* dsp_() const { return ws + WS_DSP; }
};

__device__ __forceinline__ void transpose_tiles(const float* __restrict__ src, int K, int Nsrc, int Ndst, const float* __restrict__ scale, bf16_t* __restrict__ dst,
                                                int tile, float* lds_tile  ) {
    const int tid = TIDX(), ntn = Ndst / 256;
    const int tk = tile / ntn, tn = tile % ntn, k0 = tk * 64, n0 = tn * 256;
    __syncthreads();
    { const int ty = tid >> 4, tx = tid & 15;
      f32x4 v[2][4];
#pragma unroll
      for (int i = 0; i < 2; ++i)
#pragma unroll
        for (int q = 0; q < 4; ++q) { const int k = k0 + ty + 32 * i, n = n0 + 4 * tx + 64 * q;
          v[i][q] = (f32x4){0.f, 0.f, 0.f, 0.f};
          if (n < Nsrc) v[i][q] = *(const f32x4*)(src + (size_t)k * Nsrc + n); }
#pragma unroll
      for (int i = 0; i < 2; ++i) { const float s = scale ? scale[k0 + ty + 32 * i] : 1.f;
#pragma unroll
        for (int q = 0; q < 4; ++q) { float* t = lds_tile + (ty + 32 * i) * 257 + 4 * tx + 64 * q; t[0] = v[i][q][0] * s; t[1] = v[i][q][1] * s; t[2] = v[i][q][2] * s; t[3] = v[i][q][3] * s; } } }
    __syncthreads();
    { const int n = tid >> 1, kh = (tid & 1) * 32;
#pragma unroll
      for (int j = 0; j < 4; ++j) { const int kb = kh + 8 * j; u32x4 w;
        w.x = pk2bf(lds_tile[(kb + 0) * 257 + n], lds_tile[(kb + 1) * 257 + n]); w.y = pk2bf(lds_tile[(kb + 2) * 257 + n], lds_tile[(kb + 3) * 257 + n]);
        w.z = pk2bf(lds_tile[(kb + 4) * 257 + n], lds_tile[(kb + 5) * 257 + n]); w.w = pk2bf(lds_tile[(kb + 6) * 257 + n], lds_tile[(kb + 7) * 257 + n]);
        *(u32x4*)(dst + (size_t)(n0 + n) * K + k0 + kb) = w; } }
}

__device__ __forceinline__ void rmsnorm_rows(const float* __restrict__ X, bf16_t* __restrict__ Y, int nrows) {
    const int wid = TIDX() >> 6, lane = TIDX() & 63;
    for (int row = blockIdx.x * 8 + wid; row < nrows; row += gridDim.x * 8) {
        const float* xr = X + (size_t)row * DM; f32x4 v[8]; float ss = 0.f;
#pragma unroll
        for (int i = 0; i < 8; ++i) { v[i] = *(const f32x4*)(xr + 4 * lane + 256 * i); ss += v[i][0] * v[i][0] + v[i][1] * v[i][1] + v[i][2] * v[i][2] + v[i][3] * v[i][3]; }
        ss = wave_sum(ss); const float r = rsqrtf(ss * (1.f / DM) + EPS);
        bf16_t* yr = Y + (size_t)row * DM;
#pragma unroll
        for (int i = 0; i < 8; ++i) { u32x2 w; w.x = pk2bf(v[i][0] * r, v[i][1] * r); w.y = pk2bf(v[i][2] * r, v[i][3] * r); *(u32x2*)(yr + 4 * lane + 256 * i) = w; }
    }
}

__device__ __forceinline__ void rmsnorm_rows16(const bf16_t* __restrict__ X, bf16_t* __restrict__ Y, int nrows) {
    const int wid = TIDX() >> 6, lane = TIDX() & 63;
    for (int row = blockIdx.x * 8 + wid; row < nrows; row += gridDim.x * 8) {
        const bf16_t* xr = X + (size_t)row * DM; float v[4][8]; float ss = 0.f;
#pragma unroll
        for (int i = 0; i < 4; ++i) { ld8f(xr + 8 * lane + 512 * i, v[i]);
#pragma unroll
            for (int j = 0; j < 8; ++j) ss += v[i][j] * v[i][j]; }
        ss = wave_sum(ss); const float r = rsqrtf(ss * (1.f / DM) + EPS);
        bf16_t* yr = Y + (size_t)row * DM;
#pragma unroll
        for (int i = 0; i < 4; ++i) { float o[8];
#pragma unroll
            for (int j = 0; j < 8; ++j) o[j] = v[i][j] * r;
            st8f(yr + 8 * lane + 512 * i, o); }
    }
}

__device__ __forceinline__ void rows_bf16_ssq(const float* __restrict__ X, bf16_t* __restrict__ Y, float* __restrict__ ssq, int nrows) {
    const int wid = TIDX() >> 6, lane = TIDX() & 63;
    for (int row = blockIdx.x * 8 + wid; row < nrows; row += gridDim.x * 8) {
        const float* xr = X + (size_t)row * DM; bf16_t* yr = Y + (size_t)row * DM; float ss = 0.f;
#pragma unroll
        for (int i = 0; i < 8; ++i) { const f32x4 v = *(const f32x4*)(xr + 4 * lane + 256 * i); ss += v[0] * v[0] + v[1] * v[1] + v[2] * v[2] + v[3] * v[3];
            u32x2 w; w.x = pk2bf(v[0], v[1]); w.y = pk2bf(v[2], v[3]); *(u32x2*)(yr + 4 * lane + 256 * i) = w; }
        ss = wave_sum(ss); if (lane < 32) ssq[(size_t)row * 32 + lane] = (lane == 0) ? ss : 0.f;
    }
}
__device__ __forceinline__ void phase_prologue1(const Params& P, char* lds) {
    float* tile = (float*)lds;
    constexpr int T_IN = (DM / 64) * (NPAD / 256), T_OUT = (MIX / 64) * (DM / 256), T_KV = (DM / 64) * (1024 / 256), T_GLU = 8 * 2;
    constexpr int TOT = DEPTH * (T_IN + T_OUT + T_KV + T_GLU);
    for (int u = blockIdx.x; u < TOT; u += gridDim.x) {
        int l = u / (T_IN + T_OUT + T_KV + T_GLU), r = u % (T_IN + T_OUT + T_KV + T_GLU);
        if (r < T_IN) transpose_tiles(P.w_in + (size_t)l * DM * NIN, DM, NIN, NPAD, P.ln_gain + l * DM, P.WinT_() + (size_t)l * NPAD * DM, r, tile);
        else if ((r -= T_IN) < T_OUT) transpose_tiles(P.w_out + (size_t)l * MIX * DM, MIX, DM, DM, P.out_norm + l * MIX, P.WoutT_() + (size_t)l * DM * MIX, r, tile);
        else if ((r -= T_OUT) < T_KV) transpose_tiles(P.w_mem_kv + (size_t)l * DM * 1024, DM, 1024, 1024, P.mem_norm + l * DM, P.WkvT_() + (size_t)l * 1024 * DM, r, tile);
        else { r -= T_KV; transpose_tiles(P.s5_w_glu + (size_t)l * 512 * 512, 512, 512, 512, nullptr, P.WgluT_() + (size_t)l * 512 * 512, r, tile); }
    }
    rmsnorm_rows(P.mem, P.memn_(), NB * MEML);
}
__device__ __forceinline__ void phase_rope_table(const Params& P) {
    for (int idx = blockIdx.x * NTHR + TIDX(); idx < NTOK * 24; idx += gridDim.x * NTHR) {
        const int tok = idx / 24, i = idx % 24;
        const float e = (i < 16) ? -((float)i * 2.0f / 32.0f) : -((float)(i - 16) * 2.0f / 16.0f);
        const float inv_freq = exp2f(e * 18.931568569324174f);
        const float ang = (float)P.pos[tok] * inv_freq;
        const double a = (double)ang; const double k = rint(a * 0.15915494309189535); const float rf = (float)fma(-k, 6.283185307179586, a);
        P.rope_()[(size_t)idx * 2] = cosf(rf); P.rope_()[(size_t)idx * 2 + 1] = sinf(rf);
    }
}

__device__ __forceinline__ void phase_rmsnorm_x(const Params& P, int layer) { if (layer == 0) rmsnorm_rows(P.x, P.xn_(), NTOK); else rmsnorm_rows16(P.xbuf_(), P.xn_(), NTOK); }

__device__ __forceinline__ void phase_memk_norm(const Params& P) {
    const int wid = TIDX() >> 6, lane = TIDX() & 63;
    for (int it = blockIdx.x * 8 + wid; it < NB * MEML * DEPTH * 4; it += gridDim.x * 8) {
        const int row = it / (DEPTH * 4), l = (it / 4) % DEPTH, h = it % 4;
        bf16_t* kp = P.kvmem_() + (size_t)row * (DEPTH * 1024) + l * 1024 + h * 128 + 2 * lane;
        const unsigned w = *(const unsigned*)kp; const float a = __uint_as_float(w << 16), b = __uint_as_float(w & 0xffff0000u);
        const float ss = wave_sum(a * a + b * b), r = rsqrtf(ss * (1.f / 128.f) + EPS);
        const float* g = P.mem_k_norm + l * 128 + 2 * lane;
        *(unsigned*)kp = pk2bf(a * r * g[0], b * r * g[1]);
    }
}

__device__ __forceinline__ float sum16(float v) { v += shx(v, 1); v += shx(v, 2); v += shx(v, 4); v += shx(v, 8); return v; }

__device__ __forceinline__ void head128_norm_rope_to(const bf16_t* hp, bf16_t* dp, int l16, const float* __restrict__ gain, const float* __restrict__ cs, bool rope, bool do_store) {
    float v[8]; ld8f(hp + 8 * l16, v);
    float ss = 0.f;
#pragma unroll
    for (int j = 0; j < 8; ++j) ss += v[j] * v[j];
    ss = sum16(ss); const float r = rsqrtf(ss * (1.f / 128.f) + EPS);
#pragma unroll
    for (int j = 0; j < 8; ++j) v[j] = v[j] * r * gain[8 * l16 + j];
    if (rope) {
        float o[8];
#pragma unroll
        for (int j = 0; j < 8; ++j) o[j] = shx(v[j], 2);
        if (l16 < 4) { const int fi = (l16 & 1) * 8;
#pragma unroll
            for (int j = 0; j < 8; ++j) { const float c = cs[(fi + j) * 2], s = cs[(fi + j) * 2 + 1];
                v[j] = (l16 < 2) ? (v[j] * c - o[j] * s) : (v[j] * c + o[j] * s); } }
    }
    if (do_store) st8f(dp + 8 * l16, v);
}
__device__ __forceinline__ void head128_norm_rope(bf16_t* hp, int l16, const float* __restrict__ gain, const float* __restrict__ cs, bool rope, bool do_store) { head128_norm_rope_to(hp, hp, l16, gain, cs, rope, do_store); }
__device__ __forceinline__ void rope16_inplace(bf16_t* ip, const float* __restrict__ cs) {
    float a[8], b[8]; ld8f(ip, a); ld8f(ip + 8, b);
#pragma unroll
    for (int j = 0; j < 8; ++j) { const float c = cs[2 * j], s = cs[2 * j + 1], x1 = a[j], x2 = b[j]; a[j] = x1 * c - x2 * s; b[j] = x2 * c + x1 * s; }
    st8f(ip, a); st8f(ip + 8, b);
}
struct PrepIn { u32x4 k, i0, i1, ik0, ik1, v; bf16_t w; f32x4 c32[4], c16[4]; };
__device__ __forceinline__ void prep_load(const Params& P, int tok, int lane, PrepIn& I) {
    const int l16 = lane & 15, grp = lane >> 4;
    const bf16_t* row = P.p_() + (size_t)tok * NPAD;
    I.k = *(const u32x4*)(row + C_DK + 8 * l16);
    I.i0 = *(const u32x4*)(row + C_DIQ + (lane >> 2) * 64); I.i1 = *(const u32x4*)(row + C_DIQ + (lane >> 2) * 64 + 8);
    I.ik0 = *(const u32x4*)(row + C_DIK + (lane & 3) * 16); I.ik1 = *(const u32x4*)(row + C_DIK + (lane & 3) * 16 + 8);
    I.v = *(const u32x4*)(row + C_DV + l16 * 8);
    I.w = row[C_DIW + l16];
    const float* cs32 = P.rope_() + (size_t)tok * 48;
#pragma unroll
    for (int i = 0; i < 4; ++i) { I.c32[i] = *(const f32x4*)(cs32 + (l16 & 1) * 16 + 4 * i); I.c16[i] = *(const f32x4*)(cs32 + 32 + 4 * i); }
}
__device__ __forceinline__ void unpack8(const u32x4 w, float (&v)[8]) {
    v[0] = __uint_as_float(w.x << 16); v[1] = __uint_as_float(w.x & 0xffff0000u); v[2] = __uint_as_float(w.y << 16); v[3] = __uint_as_float(w.y & 0xffff0000u);
    v[4] = __uint_as_float(w.z << 16); v[5] = __uint_as_float(w.z & 0xffff0000u); v[6] = __uint_as_float(w.w << 16); v[7] = __uint_as_float(w.w & 0xffff0000u); }
__device__ __forceinline__ void head128_nr(float (&v)[8], int l16, const float (&gain)[8], const f32x4 (&cs)[4], bool rope) {
    float ss = 0.f;
#pragma unroll
    for (int j = 0; j < 8; ++j) ss += v[j] * v[j];
    ss = sum16(ss); const float r = rsqrtf(ss * (1.f / 128.f) + EPS);
#pragma unroll
    for (int j = 0; j < 8; ++j) v[j] = v[j] * r * gain[j];
    if (rope) {
        float o[8];
#pragma unroll
        for (int j = 0; j < 8; ++j) o[j] = shx(v[j], 2);
        if (l16 < 4) {
#pragma unroll
            for (int j = 0; j < 8; ++j) { const float c = cs[j >> 1][(j & 1) * 2], s = cs[j >> 1][(j & 1) * 2 + 1];
                v[j] = (l16 < 2) ? (v[j] * c - o[j] * s) : (v[j] * c + o[j] * s); } }
    }
}
__device__ __forceinline__ void prep_finish(const Params& P, int tok, int lane, const PrepIn& I, const float (&gq)[8], const float (&gk)[8], const float (&gm)[8]) {
    const int l16 = lane & 15, grp = lane >> 4;
    bf16_t* row = P.p_() + (size_t)tok * NPAD;
    float k[8];
    unpack8(I.k, k);
    head128_nr(k, l16, gk, I.c32, true);
    if (grp == 0) st8f(P.kvc_() + (size_t)tok * 256 + 8 * l16, k);
    {
        float a[8], b[8]; unpack8(I.i0, a); unpack8(I.i1, b);
#pragma unroll
        for (int j = 0; j < 8; ++j) { const float c = I.c16[j >> 1][(j & 1) * 2], s = I.c16[j >> 1][(j & 1) * 2 + 1], x1 = a[j], x2 = b[j]; a[j] = x1 * c - x2 * s; b[j] = x2 * c + x1 * s; }
        if ((lane & 3) == 0) { st8f(row + C_DIQ + (lane >> 2) * 64, a); st8f(row + C_DIQ + (lane >> 2) * 64 + 8, b); } }
    {
        float a[8], b[8]; unpack8(I.ik0, a); unpack8(I.ik1, b);
        if ((lane & 3) == 0) {
#pragma unroll
            for (int j = 0; j < 8; ++j) { const float c = I.c16[j >> 1][(j & 1) * 2], s = I.c16[j >> 1][(j & 1) * 2 + 1], x1 = a[j], x2 = b[j]; a[j] = x1 * c - x2 * s; b[j] = x2 * c + x1 * s; } }
        if (lane < 4) { bf16_t* dst = P.ikc_() + (size_t)(tok >> 5) * 2048 + lane * 512 + (tok & 31) * 8; st8f(dst, a); st8f(dst + 256, b); } }
    if (lane >= 16 && lane < 32) *(u32x4*)(P.kvc_() + (size_t)tok * 256 + 128 + l16 * 8) = I.v;
    if (lane < 16) P.iw_()[(size_t)tok * 16 + lane] = bf2f(I.w) * (1.f / 32.f);
}
__device__ __forceinline__ void phase_prep(const Params& P, int layer) {
    const int wid = TIDX() >> 6, lane = TIDX() & 63, l16 = lane & 15;
    float gq[8], gk[8], gm[8];
#pragma unroll
    for (int j = 0; j < 8; ++j) { gq[j] = P.dsa_q_norm[layer * 128 + 8 * l16 + j]; gk[j] = P.dsa_k_norm[layer * 128 + 8 * l16 + j]; gm[j] = P.mem_q_norm[layer * 128 + 8 * l16 + j]; }
    const int stride = gridDim.x * 8;
    for (int tok = blockIdx.x * 8 + wid; tok < NTOK; tok += 2 * stride) {
        const int tok2 = tok + stride; const bool two = tok2 < NTOK;
        PrepIn A, B2;
        prep_load(P, tok, lane, A); prep_load(P, two ? tok2 : tok, lane, B2);
        prep_finish(P, tok, lane, A, gq, gk, gm);
        if (two) prep_finish(P, tok2, lane, B2, gq, gk, gm);
    }
}
struct MemOutRow { const bf16_t* zb; bf16_t* gb;
    __device__ __forceinline__ const bf16_t* zrow(int r) const { return zb + (size_t)r * NPAD; } __device__ __forceinline__ bf16_t* grow(int r) const { return gb + (size_t)r * MIX; } };
__device__ __forceinline__ void unit_mem_attn(const Params& P, int layer, int u, char* lds) {
    const int b = u >> 6, h = (u >> 4) & 3, qb = u & 15, tok0 = b * SEQ + qb * 256;
    const int wid = TIDX() >> 6, lane = TIDX() & 63, r32 = lane & 31, hi = lane >> 5;
    const bf16_t* Qw = P.p_() + (size_t)(tok0 + wid * 32 + r32) * NPAD + C_MQ + h * 128 + hi * 8;
    const bf16_t* Kh = P.kvmem_() + (size_t)(b * MEML) * (DEPTH * 1024) + layer * 1024 + h * 128;
    MemOutRow ow; ow.zb = P.p_() + (size_t)(tok0 + wid * 32) * NPAD + C_MZ + h * 128; ow.gb = P.xn_() + (size_t)(tok0 + wid * 32) * MIX + 1536 + h * 128;
    att::attn_body<false, DEPTH * 1024, 512, 1, MemOutRow>(Qw, P.mem_q_norm + layer * 128, nullptr, Kh, MEML / 64, nullptr, 0u, ow, lds);
}

__device__ __forceinline__ void phase_gate(const Params& P, int c_lo, int c_hi) {
    const int wid = TIDX() >> 6, lane = TIDX() & 63;
    const int c0 = lane * 32;
    const int seg = c0 >> 9, zc = (seg == 0 ? C_GZ : seg == 1 ? C_SZ : seg == 2 ? C_DZ : C_MZ) + (c0 & 511);
    const bool act = (c0 >= c_lo) && (c0 < c_hi);
    for (int tok = blockIdx.x * 8 + wid; tok < NTOK; tok += gridDim.x * 8) {
        if (!act) { bf16_t* gz_ = P.xn_() + (size_t)tok * MIX + c0; const u32x4 zz = {0u, 0u, 0u, 0u};
#pragma unroll
            for (int i = 0; i < 4; ++i) *(u32x4*)(gz_ + 8 * i) = zz;
            continue; }
        const bf16_t* op = P.ocat_() + (size_t)tok * MIX + c0; const bf16_t* zp = P.p_() + (size_t)tok * NPAD + zc; bf16_t* gp = P.xn_() + (size_t)tok * MIX + c0;
        float o[32]; float ss = 0.f;
#pragma unroll
        for (int i = 0; i < 4; ++i) { float v[8]; ld8f(op + 8 * i, v);
#pragma unroll
            for (int j = 0; j < 8; ++j) { o[8 * i + j] = v[j]; ss += v[j] * v[j]; } }
        ss += shx(ss, 1); ss += shx(ss, 2);
        const float r = rsqrtf(ss * (1.f / 128.f) + EPS);
#pragma unroll
        for (int i = 0; i < 4; ++i) { float z[8], g[8]; ld8f(zp + 8 * i, z);
#pragma unroll
            for (int j = 0; j < 8; ++j) g[j] = o[8 * i + j] * r * siluf_(z[j]);
            st8f(gp + 8 * i, g); }
    }
}

__device__ __forceinline__ void phase_gemm_in(const Params& P, int layer, char* lds) {
    pg8::Gemm g; g.A = P.xn_(); g.Bt = P.WinT_() + (size_t)layer * NPAD * DM; g.M = NTOK; g.N = NPAD; g.K = DM;
    pg8::StaticOrder S; S.init(g.M, g.N, (int)gridDim.x, (int)blockIdx.x);
    pg8::EpiBf16Plain E; E.O = P.p_(); E.ldc = NPAD;
    pg8::gemm_phase<pg8::EpiBf16Plain, pg8::StaticOrder, false>((PG8_LAS unsigned char*)lds, g, S, E, nullptr);
}
__device__ __forceinline__ void phase_gemm_out(const Params& P, int layer, char* lds) {
    pg8::Gemm g; g.A = P.xn_(); g.Bt = P.WoutT_() + (size_t)layer * DM * MIX; g.M = NTOK; g.N = DM; g.K = MIX;
    pg8::StaticOrder S; S.init(g.M, g.N, (int)gridDim.x, (int)blockIdx.x);
    pg8::EpiResidMix E; E.R = (layer == 0) ? (const void*)P.x : (const void*)P.xbuf_(); E.C = (layer == DEPTH - 1) ? (void*)P.out : (void*)P.xbuf_(); E.ldc = DM;
    E.r16 = (layer != 0); E.c16 = (layer != DEPTH - 1);
    pg8::gemm_phase<pg8::EpiResidMix, pg8::StaticOrder, false>((PG8_LAS unsigned char*)lds, g, S, E, nullptr);
}
__device__ __forceinline__ void phase_gemm_kv(const Params& P, char* lds) {
    pg8::Gemm g; g.A = P.memn_(); g.Bt = P.WkvT_(); g.M = NB * MEML; g.N = DEPTH * 1024; g.K = DM;
    pg8::StaticOrder S; S.init(g.M, g.N, (int)gridDim.x, (int)blockIdx.x);
    pg8::EpiBf16Plain E; E.O = P.kvmem_(); E.ldc = DEPTH * 1024;
    pg8::gemm_phase<pg8::EpiBf16Plain, pg8::StaticOrder, false>((PG8_LAS unsigned char*)lds, g, S, E, nullptr);
}
__device__ __forceinline__ void mma_tile(f32x16& acc, const char* A, int lda, const char* B, int ldb, int K, int lane) {
    const int r = lane & 31, kh = lane >> 5;
    const char* ap = A + r * lda + kh * 16; const char* bp = B + r * ldb + kh * 16;
    asm volatile("" : "+v"(acc));
    for (int k = 0; k < K; k += 16) {
        const bf16x8 a = *(const bf16x8*)(ap + k * 2); const bf16x8 b = *(const bf16x8*)(bp + k * 2);
        acc = __builtin_amdgcn_mfma_f32_32x32x16_bf16(a, b, acc, 0, 0, 0);
    }
}
__device__ __forceinline__ int crow32(int r, int hi) { return (r & 3) + 8 * (r >> 2) + 4 * hi; }
__device__ __forceinline__ float log_sigmoid_(float x) { return fminf(x, 0.f) - log1pf(__expf(-fabsf(x))); }

constexpr int GLA_ST = 144;
constexpr int GC_BST = 68;
constexpr int GC_B_BYTES = 4 * 64 * GC_BST * 4, GC_V_BYTES = 4 * 16384;
__device__ __forceinline__ float* gla_gb(const Params& P) { return (float*)((char*)P.ocat_() + (size_t)32 * 1024 * 1024); }
__device__ __forceinline__ float log_sigmoid_fast(float x) { return fminf(x, 0.f) - __logf(1.f + __expf(-fabsf(x))); }

__device__ __forceinline__ void unit_gla_a4(const Params& P, int layer, int ub, char* lds) {
    const int b = ub >> 6, n = ub & 63, tok0 = b * SEQ + n * 64;
    const int tid = TIDX(), wid = tid >> 6, lane = tid & 63, r32 = lane & 31, hi = lane >> 5, h = wid >> 1, eh = wid & 1;
    float* b_s = (float*)lds;
    char* V_s = lds;
    char* K_s = lds + GC_B_BYTES;
    float* glr_s = (float*)(lds + GC_B_BYTES + GC_V_BYTES);
    float* tot_s = glr_s + 1024;
    __syncthreads();
    const bf16_t* prow = P.p_() + (size_t)tok0 * NPAD;
    const bf16x8 glr_raw = *(const bf16x8*)(prow + (size_t)((tid & 127) >> 1) * NPAD + C_GLR + (tid & 1) * 8);
    const int gd = tid & 63, gh = (tid >> 6) & 3, gt = tid >> 8;
    float wu[16];
#pragma unroll
    for (int r = 0; r < 16; ++r) wu[r] = P.gla_w_up[((size_t)layer * 16 + r) * 256 + gh * 64 + gd];
    const float bias = P.gla_b_up[layer * 256 + gh * 64 + gd];
    bf16x8 kraw[4], vs[4][2];
    const int ks_ = tid >> 3, kc = (tid & 7) * 8;
#pragma unroll
    for (int hv = 0; hv < 4; ++hv) kraw[hv] = *(const bf16x8*)(prow + (size_t)ks_ * NPAD + C_GK + hv * 64 + kc);
    const int sr = tid >> 4, sc = (tid & 15) * 8;
#pragma unroll
    for (int hv = 0; hv < 4; ++hv) { vs[hv][0] = *(const bf16x8*)(prow + (size_t)sr * NPAD + C_GV + hv * 128 + sc); vs[hv][1] = *(const bf16x8*)(prow + (size_t)(32 + sr) * NPAD + C_GV + hv * 128 + sc); }
    if (tid < 128) {
#pragma unroll
        for (int j = 0; j < 8; ++j) glr_s[(tid >> 1) * 16 + (tid & 1) * 8 + j] = bf2f((bf16_t)glr_raw[j]); }
    __syncthreads();
    float gv[32]; float run = 0.f;
#pragma unroll
    for (int i = 0; i < 32; ++i) { const float* gr = glr_s + (gt * 32 + i) * 16; float a = bias;
#pragma unroll
        for (int r4 = 0; r4 < 4; ++r4) { const f32x4 g4 = *(const f32x4*)(gr + 4 * r4); a = fmaf(g4[0], wu[4 * r4], a); a = fmaf(g4[1], wu[4 * r4 + 1], a); a = fmaf(g4[2], wu[4 * r4 + 2], a); a = fmaf(g4[3], wu[4 * r4 + 3], a); }
        run += log_sigmoid_fast(a) * (1.f / 16.f); gv[i] = run; }
    if (gt == 0) tot_s[gh * 64 + gd] = run;
    __syncthreads();
    { const float off = gt ? tot_s[gh * 64 + gd] : 0.f; float* bp = b_s + (gh * 64 + gt * 32) * GC_BST + gd;
      float* gp = gla_gb(P) + (size_t)(tok0 + gt * 32) * 256 + gh * 64 + gd;
#pragma unroll
      for (int i = 0; i < 32; ++i) { const float v = gv[i] + off; bp[i * GC_BST] = v; gp[(size_t)i * 256] = v; }
      if (gt) P.glad_()[((size_t)((b * 64 + n) * 4 + gh)) * 64 + gd] = __expf(gv[31] + off); }
    __syncthreads();
#pragma unroll
    for (int hv = 0; hv < 4; ++hv) { const float* br = b_s + (hv * 64 + ks_) * GC_BST + kc; const float* bl = b_s + (hv * 64 + 63) * GC_BST + kc;
        const f32x4 b0 = *(const f32x4*)br, b1 = *(const f32x4*)(br + 4), l0 = *(const f32x4*)bl, l1 = *(const f32x4*)(bl + 4);
        float e[8];
#pragma unroll
        for (int j = 0; j < 8; ++j) e[j] = bf2f((bf16_t)kraw[hv][j]) * __expf((j < 4 ? l0[j] : l1[j - 4]) - (j < 4 ? b0[j] : b1[j - 4]));
        u32x4 w = {att::cvtpk(e[0], e[1]), att::cvtpk(e[2], e[3]), att::cvtpk(e[4], e[5]), att::cvtpk(e[6], e[7])};
        *(u32x4*)(K_s + hv * 16384 + att::v_st(ks_, kc)) = w; }
    __syncthreads();
    { const int vst0 = att::v_st(sr, sc), vst1 = att::v_st(32 + sr, sc);
#pragma unroll
      for (int hv = 0; hv < 4; ++hv) { *(bf16x8*)(V_s + hv * 16384 + vst0) = vs[hv][0]; *(bf16x8*)(V_s + hv * 16384 + vst1) = vs[hv][1]; } }
    __syncthreads();
    const int vb = (int)(uintptr_t)(V_s + h * 16384) + att::v_rd_base(lane), kb = (int)(uintptr_t)(K_s + h * 16384) + att::v_rd_base(lane);
    f32x16 acc[2][2] = {};
    asm volatile("" : "+v"(acc[0][0]), "+v"(acc[0][1]), "+v"(acc[1][0]), "+v"(acc[1][1]));
#define GA_PK(L, H) (bf16x8){L[0], L[1], L[2], L[3], H[0], H[1], H[2], H[3]}
#define GA_STEP(KS) do { \
    const s16x4 k0l = att::tr_read<att::v_rd_off(0, KS, 0)>(kb), k0h = att::tr_read<att::v_rd_off(0, KS, 1)>(kb), k1l = att::tr_read<att::v_rd_off(1, KS, 0)>(kb), k1h = att::tr_read<att::v_rd_off(1, KS, 1)>(kb); \
    s16x4 v0l, v0h, v1l, v1h; \
    if (eh == 0) { v0l = att::tr_read<att::v_rd_off(0, KS, 0)>(vb); v0h = att::tr_read<att::v_rd_off(0, KS, 1)>(vb); v1l = att::tr_read<att::v_rd_off(1, KS, 0)>(vb); v1h = att::tr_read<att::v_rd_off(1, KS, 1)>(vb); } \
    else         { v0l = att::tr_read<att::v_rd_off(2, KS, 0)>(vb); v0h = att::tr_read<att::v_rd_off(2, KS, 1)>(vb); v1l = att::tr_read<att::v_rd_off(3, KS, 0)>(vb); v1h = att::tr_read<att::v_rd_off(3, KS, 1)>(vb); } \
    asm volatile("s_waitcnt lgkmcnt(0)" ::: "memory"); __builtin_amdgcn_sched_barrier(0); \
    acc[0][0] = __builtin_amdgcn_mfma_f32_32x32x16_bf16(GA_PK(v0l, v0h), GA_PK(k0l, k0h), acc[0][0], 0, 0, 0); \
    acc[0][1] = __builtin_amdgcn_mfma_f32_32x32x16_bf16(GA_PK(v0l, v0h), GA_PK(k1l, k1h), acc[0][1], 0, 0, 0); \
    acc[1][0] = __builtin_amdgcn_mfma_f32_32x32x16_bf16(GA_PK(v1l, v1h), GA_PK(k0l, k0h), acc[1][0], 0, 0, 0); \
    acc[1][1] = __builtin_amdgcn_mfma_f32_32x32x16_bf16(GA_PK(v1l, v1h), GA_PK(k1l, k1h), acc[1][1], 0, 0, 0); } while (0)
    GA_STEP(0); GA_STEP(1); GA_STEP(2); GA_STEP(3);
#undef GA_STEP
#undef GA_PK
    float* dst = P.glas_() + ((size_t)((b * 64 + n) * 4 + h)) * 8192;
#pragma unroll
    for (int et = 0; et < 2; ++et)
#pragma unroll
        for (int dt = 0; dt < 2; ++dt)
#pragma unroll
            for (int r = 0; r < 16; ++r) dst[((eh * 2 + et) * 32 + att::crow(r, hi)) * 64 + dt * 32 + r32] = acc[et][dt][r];
    __syncthreads();
}

__device__ __forceinline__ void gla_scan_slice(const Params& P, int idx) {
    {
        const int el = idx & 8191, d = idx & 63, h = (idx >> 13) & 3, b = idx >> 15;
        bf16_t* gst = P.ocat_();
        float S = 0.f;
        for (int n0 = 0; n0 < 64; n0 += 8) {
            float ds[8], dc[8];
#pragma unroll
            for (int i = 0; i < 8; ++i) { const size_t cu = (size_t)((b * 64 + n0 + i) * 4 + h); ds[i] = P.glas_()[cu * 8192 + el]; dc[i] = P.glad_()[cu * 64 + d]; }
#pragma unroll
            for (int i = 0; i < 8; ++i) { const size_t cu = (size_t)((b * 64 + n0 + i) * 4 + h); gst[cu * 8192 + el] = f2bf(S); S = fmaf(dc[i], S, ds[i]); }
        }
    }
}

__device__ __forceinline__ void unit_gla_c4(const Params& P, int layer, int ub, char* lds) {
    const int b = ub >> 6, n = ub & 63, tok0 = b * SEQ + n * 64;
    const int tid = TIDX(), wid = tid >> 6, lane = tid & 63, r32 = lane & 31, hi = lane >> 5, h = wid >> 1, rh = wid & 1;
    float* b_s = (float*)lds;
    char* V_s = lds + GC_B_BYTES;
    __syncthreads();
    const bf16_t* prow = P.p_() + (size_t)tok0 * NPAD;
    bf16x8 qraw[4], kraw[2][4], vs[4][2];
    const int sr = tid >> 4, sc = (tid & 15) * 8;
#pragma unroll
    for (int hv = 0; hv < 4; ++hv) { vs[hv][0] = *(const bf16x8*)(prow + (size_t)sr * NPAD + C_GV + hv * 128 + sc); vs[hv][1] = *(const bf16x8*)(prow + (size_t)(32 + sr) * NPAD + C_GV + hv * 128 + sc); }
    f32x4 braw[8];
    { const float* gp = gla_gb(P) + (size_t)tok0 * 256 + tid * 4;
#pragma unroll
      for (int i = 0; i < 8; ++i) braw[i] = *(const f32x4*)(gp + i * 2048); }
    { const bf16_t* qp = prow + (size_t)(rh * 32 + r32) * NPAD + C_GQ + h * 64 + hi * 8;
#pragma unroll
      for (int d0 = 0; d0 < 4; ++d0) qraw[d0] = *(const bf16x8*)(qp + d0 * 16);
#pragma unroll
      for (int sh = 0; sh < 2; ++sh) { const bf16_t* kp = prow + (size_t)(sh * 32 + r32) * NPAD + C_GK + h * 64 + hi * 8;
#pragma unroll
          for (int d0 = 0; d0 < 4; ++d0) kraw[sh][d0] = *(const bf16x8*)(kp + d0 * 16); } }
    bf16x8 sfr[4][4];
    { const bf16_t* sp = P.ocat_() + ((size_t)((b * 64 + n) * 4 + h)) * 8192 + r32 * 64 + hi * 8;
#pragma unroll
      for (int eb = 0; eb < 4; ++eb)
#pragma unroll
          for (int ds = 0; ds < 4; ++ds) sfr[eb][ds] = *(const bf16x8*)(sp + eb * 32 * 64 + ds * 16); }
    { const int vst0 = att::v_st(sr, sc), vst1 = att::v_st(32 + sr, sc);
#pragma unroll
      for (int hv = 0; hv < 4; ++hv) { *(bf16x8*)(V_s + hv * 16384 + vst0) = vs[hv][0]; *(bf16x8*)(V_s + hv * 16384 + vst1) = vs[hv][1]; } }
#pragma unroll
    for (int i = 0; i < 8; ++i) { const int c = tid + 512 * i, t = c >> 6, c4 = c & 63;
        *(f32x4*)(b_s + ((c4 >> 4) * 64 + t) * GC_BST + (c4 & 15) * 4) = braw[i]; }
    __syncthreads();
    const float* bh = b_s + h * 64 * GC_BST + hi * 8;
    bf16x8 qe[4], qb[4], ke[2][4];
#pragma unroll
    for (int d0 = 0; d0 < 4; ++d0) {
        const f32x4 m0 = *(const f32x4*)(bh + 32 * GC_BST + d0 * 16), m1 = *(const f32x4*)(bh + 32 * GC_BST + d0 * 16 + 4);
        const f32x4 q0 = *(const f32x4*)(bh + (rh * 32 + r32) * GC_BST + d0 * 16), q1 = *(const f32x4*)(bh + (rh * 32 + r32) * GC_BST + d0 * 16 + 4);
        float e1[8], e2[8];
#pragma unroll
        for (int j = 0; j < 8; ++j) { const float mv = j < 4 ? m0[j] : m1[j - 4], bq = j < 4 ? q0[j] : q1[j - 4]; const float q = bf2f((bf16_t)qraw[d0][j]) * 0.125f;
            e1[j] = q * __expf(bq - mv); e2[j] = q * __expf(bq); }
        { u32x4 w = {att::cvtpk(e1[0], e1[1]), att::cvtpk(e1[2], e1[3]), att::cvtpk(e1[4], e1[5]), att::cvtpk(e1[6], e1[7])}; qe[d0] = *reinterpret_cast<bf16x8*>(&w); }
        { u32x4 w = {att::cvtpk(e2[0], e2[1]), att::cvtpk(e2[2], e2[3]), att::cvtpk(e2[4], e2[5]), att::cvtpk(e2[6], e2[7])}; qb[d0] = *reinterpret_cast<bf16x8*>(&w); }
#pragma unroll
        for (int sh = 0; sh < 2; ++sh) {
            const f32x4 k0 = *(const f32x4*)(bh + (sh * 32 + r32) * GC_BST + d0 * 16), k1 = *(const f32x4*)(bh + (sh * 32 + r32) * GC_BST + d0 * 16 + 4);
            float e3[8];
#pragma unroll
            for (int j = 0; j < 8; ++j) { const float mv = j < 4 ? m0[j] : m1[j - 4], bk = j < 4 ? k0[j] : k1[j - 4]; e3[j] = bf2f((bf16_t)kraw[sh][d0][j]) * __expf(mv - bk); }
            u32x4 w = {att::cvtpk(e3[0], e3[1]), att::cvtpk(e3[2], e3[3]), att::cvtpk(e3[4], e3[5]), att::cvtpk(e3[6], e3[7])}; ke[sh][d0] = *reinterpret_cast<bf16x8*>(&w); }
    }
    f32x16 p0 = {}, p1 = {};
    asm volatile("" : "+v"(p0), "+v"(p1));
#pragma unroll
    for (int d0 = 0; d0 < 4; ++d0) { p0 = __builtin_amdgcn_mfma_f32_32x32x16_bf16(ke[0][d0], qe[d0], p0, 0, 0, 0); p1 = __builtin_amdgcn_mfma_f32_32x32x16_bf16(ke[1][d0], qe[d0], p1, 0, 0, 0); }
    { const int t = rh * 32 + r32;
#pragma unroll
      for (int r = 0; r < 16; ++r) { const int s0 = att::crow(r, hi); p0[r] = (s0 <= t) ? p0[r] : 0.f; p1[r] = (32 + s0 <= t) ? p1[r] : 0.f; } }
    bf16x8 pa0, pa1, pa2, pa3;
#define GC_PK4(Pv, BASE, OUT) do { unsigned a0 = att::cvtpk(Pv[BASE + 0], Pv[BASE + 1]), a1 = att::cvtpk(Pv[BASE + 2], Pv[BASE + 3]);   \
    unsigned b0 = att::cvtpk(Pv[BASE + 4], Pv[BASE + 5]), b1 = att::cvtpk(Pv[BASE + 6], Pv[BASE + 7]);                              \
    auto r0 = __builtin_amdgcn_permlane32_swap(a0, b0, false, false); auto r1 = __builtin_amdgcn_permlane32_swap(a1, b1, false, false); \
    u32x4 w = {r0[0], r1[0], r0[1], r1[1]}; OUT = *reinterpret_cast<bf16x8*>(&w); } while (0)
    GC_PK4(p0, 0, pa0); GC_PK4(p0, 8, pa1); GC_PK4(p1, 0, pa2); GC_PK4(p1, 8, pa3);
#undef GC_PK4
    f32x16 o[4] = {};
    asm volatile("" : "+v"(o[0]), "+v"(o[1]), "+v"(o[2]), "+v"(o[3]));
    att::pv_d0(o, (int)(uintptr_t)(V_s + h * 16384) + att::v_rd_base(lane), pa0, pa1, pa2, pa3);
#pragma unroll
    for (int eb = 0; eb < 4; ++eb)
#pragma unroll
        for (int ds = 0; ds < 4; ++ds) o[eb] = __builtin_amdgcn_mfma_f32_32x32x16_bf16(qb[ds], sfr[eb][ds], o[eb], 0, 0, 0);
    __syncthreads();
    float* og_s = (float*)lds + wid * (32 * 132);
#pragma unroll
    for (int r = 0; r < 16; ++r) {
#pragma unroll
        for (int eb = 0; eb < 4; ++eb) og_s[att::crow(r, hi) * 132 + eb * 32 + r32] = o[eb][r]; }
    asm volatile("" ::: "memory");
    { const int row = lane >> 1, half = lane & 1; const float* src = og_s + row * 132 + half * 64;
      f32x4 v[16]; float ss = 0.f;
#pragma unroll
      for (int i = 0; i < 16; ++i) { v[i] = *(const f32x4*)(src + 4 * i); ss += v[i][0] * v[i][0] + v[i][1] * v[i][1] + v[i][2] * v[i][2] + v[i][3] * v[i][3]; }
      ss += shx(ss, 1);
      const float rn = rsqrtf(ss * (1.f / 128.f) + EPS);
      const size_t tok = (size_t)(tok0 + rh * 32 + row);
      const bf16_t* zp = P.p_() + tok * NPAD + C_GZ + h * 128 + half * 64; bf16_t* gp = P.xn_() + tok * MIX + h * 128 + half * 64;
#pragma unroll
      for (int i = 0; i < 8; ++i) { float z[8], g[8]; ld8f(zp + 8 * i, z);
#pragma unroll
          for (int q = 0; q < 4; ++q) { g[q] = v[2 * i][q] * rn * siluf_(z[q]); g[4 + q] = v[2 * i + 1][q] * rn * siluf_(z[4 + q]); }
          st8f(gp + 8 * i, g); } }
    __syncthreads();
}
constexpr int S5P_STRIDE = 2304;
__device__ __forceinline__ void phase_s5_params(const Params& P) {
    for (int idx = blockIdx.x * NTHR + TIDX(); idx < DEPTH * 32 * 64; idx += gridDim.x * NTHR) {
        const int p = idx & 63, lg = idx >> 6;
        const float ar = P.s5_a_re[idx], ai = P.s5_a_im[idx], step = expf(P.s5_log_step[lg]);
        const float mag = expf(ar * step), th = ai * step;
        const float lr = mag * cosf(th), li = mag * sinf(th);
        float* o = P.s5p_() + (size_t)lg * S5P_STRIDE;
        o[2 * p] = lr; o[2 * p + 1] = li;
        { const float mag512 = expf(512.f * ar * step); const double a = 512.0 * (double)th; const double k = rint(a * 0.15915494309189535); const float rf = (float)fma(-k, 6.283185307179586, a);
          o[128 + 2 * p] = mag512 * cosf(rf); o[128 + 2 * p + 1] = mag512 * sinf(rf); }
        const float xr = lr - 1.f, xi = li, den = 1.f / (ar * ar + ai * ai);
        const float fr = (xr * ar + xi * ai) * den, fi = (xi * ar - xr * ai) * den;
        for (int c = 0; c < 16; ++c) { const float br = P.s5_b_re[(size_t)idx * 16 + c], bi = P.s5_b_im[(size_t)idx * 16 + c];
            o[256 + (p * 16 + c) * 2] = fr * br - fi * bi; o[256 + (p * 16 + c) * 2 + 1] = fr * bi + fi * br; }
    }
}
__device__ __forceinline__ float gelu_tanh_(float x) { const float u = 0.7978845608028654f * (x + 0.044715f * x * x * x); const float e = __expf(-2.f * fabsf(u)); const float th = copysignf((1.f - e) / (1.f + e), u); return 0.5f * x * (1.f + th); }

constexpr int S5_XST = 272;
constexpr int S5_UST = 48;
__device__ __forceinline__ float partner32(float v, int hi) { auto rr = __builtin_amdgcn_permlane32_swap(__float_as_uint(v), __float_as_uint(v), false, false); return __uint_as_float(hi ? rr[0] : rr[1]); }
struct S5Ctx { float l0r, l0i, l1r, l1i, q0r, q0i, q1r, q1i, dsk; char* Cm; char* Bb; char* Xs; char* Us; int lane, hi, j, rho; const bf16_t* ubase; bf16_t* ybase; };
template <bool OUT> __device__ __forceinline__ void s5_tile(const S5Ctx& C, int tok0, float& x0r, float& x0i, float& x1r, float& x1i) {
    const int hi = C.hi, j = C.j, lane = C.lane;
    if (hi == 0) { const bf16_t* up = C.ubase + (size_t)(tok0 + j) * NPAD;
        const bf16x8 w0 = *(const bf16x8*)up, w1 = *(const bf16x8*)(up + 8);
        *(bf16x8*)(C.Us + C.rho * S5_UST) = w0; *(bf16x8*)(C.Us + C.rho * S5_UST + 16) = w1; }
    asm volatile("" ::: "memory");
    f32x16 a0 = {}, a1 = {}, a2 = {}, a3 = {};
    mma_tile(a0, C.Us, S5_UST, C.Bb, S5_UST, 16, lane); mma_tile(a1, C.Us, S5_UST, C.Bb + 32 * S5_UST, S5_UST, 16, lane);
    mma_tile(a2, C.Us, S5_UST, C.Bb + 64 * S5_UST, S5_UST, 16, lane); mma_tile(a3, C.Us, S5_UST, C.Bb + 96 * S5_UST, S5_UST, 16, lane);
    float s0r[16], s0i[16], s1r[16], s1i[16];
#pragma unroll
    for (int r = 0; r < 16; ++r) {
        const float n0r = fmaf(C.l0r, x0r, fmaf(-C.l0i, x0i, a0[r])), n0i = fmaf(C.l0r, x0i, fmaf(C.l0i, x0r, a1[r])); x0r = n0r; x0i = n0i; s0r[r] = n0r; s0i[r] = n0i;
        const float n1r = fmaf(C.l1r, x1r, fmaf(-C.l1i, x1i, a2[r])), n1i = fmaf(C.l1r, x1i, fmaf(C.l1i, x1r, a3[r])); x1r = n1r; x1i = n1i; s1r[r] = n1r; s1i[r] = n1i; }
    float z0r = partner32(x0r, hi), z0i = partner32(x0i, hi), z1r = partner32(x1r, hi), z1i = partner32(x1i, hi);
    if (hi == 0) { z0r = 0.f; z0i = 0.f; z1r = 0.f; z1i = 0.f; }
    if (!OUT) {
        x0r += C.q0r * z0r - C.q0i * z0i; x0i += C.q0r * z0i + C.q0i * z0r; x1r += C.q1r * z1r - C.q1i * z1i; x1i += C.q1r * z1i + C.q1i * z1r;
    } else {
#pragma unroll
        for (int r = 0; r < 16; ++r) {
            const float t0r = C.l0r * z0r - C.l0i * z0i, t0i = C.l0r * z0i + C.l0i * z0r; z0r = t0r; z0i = t0i; s0r[r] += t0r; s0i[r] += t0i;
            const float t1r = C.l1r * z1r - C.l1i * z1i, t1i = C.l1r * z1i + C.l1i * z1r; z1r = t1r; z1i = t1i; s1r[r] += t1r; s1i[r] += t1i; }
        x0r = s0r[15]; x0i = s0i[15]; x1r = s1r[15]; x1i = s1i[15];
#pragma unroll
        for (int r = 0; r < 16; ++r) { char* xr_ = C.Xs + (r + 16 * hi) * S5_XST;
            *(bf16_t*)(xr_ + j * 2) = f2bf(s0r[r]); *(bf16_t*)(xr_ + (64 + j) * 2) = f2bf(s0i[r]);
            *(bf16_t*)(xr_ + (32 + j) * 2) = f2bf(s1r[r]); *(bf16_t*)(xr_ + (96 + j) * 2) = f2bf(s1i[r]); }
        asm volatile("" ::: "memory");
        f32x16 acc = {}; mma_tile(acc, C.Xs, S5_XST, C.Cm, S5_XST, 128, lane);
        if (j < 16) {
#pragma unroll
            for (int r = 0; r < 16; ++r) { const int t = crow32(r, hi); const int rt = ((t & 15) & 3) + 8 * ((t & 15) >> 2) + 4 * (t >> 4);
                const float y = acc[r] + C.dsk * bf2f(*(const bf16_t*)(C.Us + rt * S5_UST + j * 2));
                C.ybase[(size_t)(tok0 + t) * 512 + j] = f2bf(gelu_tanh_(y)); } }
        asm volatile("" ::: "memory");
    }
    { const float e0r = partner32(x0r, hi), e0i = partner32(x0i, hi), e1r = partner32(x1r, hi), e1i = partner32(x1i, hi);
      if (hi == 0) { x0r = e0r; x0i = e0i; x1r = e1r; x1i = e1i; } else { x0r = 0.f; x0i = 0.f; x1r = 0.f; x1i = 0.f; } }
}
__device__ __forceinline__ void unit_s5(const Params& P, int layer, int u, char* lds) {
    const int b = u >> 5, g = u & 31, tid = TIDX(), wid = tid >> 6, lane = tid & 63, hi = lane >> 5, j = lane & 31;
    char* Cm = lds;
    char* Bb = Cm + 32 * S5_XST;
    float* ends = (float*)(Bb + 128 * S5_UST);
    char* wbase = (char*)(ends + 8 * 64 * 2) + wid * (32 * S5_XST + 32 * S5_UST);
    const float* sp = P.s5p_() + (size_t)(layer * 32 + g) * S5P_STRIDE;
    __syncthreads();
    for (int i = tid; i < 32 * 128; i += NTHR) { const int c = i >> 7, pp = i & 127; float v = 0.f;
        if (c < 16) v = (pp < 64) ? P.s5_c_re[((size_t)(layer * 32 + g) * 16 + c) * 64 + pp] : -P.s5_c_im[((size_t)(layer * 32 + g) * 16 + c) * 64 + (pp - 64)];
        *(bf16_t*)(Cm + c * S5_XST + pp * 2) = f2bf(v); }
    for (int i = tid; i < 128 * 16; i += NTHR) { const int n = i >> 4, c = i & 15, nt = n >> 5, jj = n & 31, p = (nt >> 1) * 32 + jj;
        *(bf16_t*)(Bb + n * S5_UST + c * 2) = f2bf(sp[256 + (p * 16 + c) * 2 + (nt & 1)]); }
    S5Ctx C; C.Cm = Cm; C.Bb = Bb; C.Xs = wbase; C.Us = wbase + 32 * S5_XST; C.lane = lane; C.hi = hi; C.j = j;
    C.l0r = sp[2 * j]; C.l0i = sp[2 * j + 1]; C.l1r = sp[2 * (32 + j)]; C.l1i = sp[2 * (32 + j) + 1];
    { float q0r = C.l0r, q0i = C.l0i, q1r = C.l1r, q1i = C.l1i;
#pragma unroll
      for (int k = 0; k < 4; ++k) { const float a = q0r * q0r - q0i * q0i, bb = (q0r + q0r) * q0i; q0r = a; q0i = bb; const float c = q1r * q1r - q1i * q1i, d = (q1r + q1r) * q1i; q1r = c; q1i = d; }
      C.q0r = q0r; C.q0i = q0i; C.q1r = q1r; C.q1i = q1i; }
    C.dsk = P.s5_d[layer * 512 + g * 16 + (lane & 15)];
    C.rho = ((j & 15) & 3) + 8 * ((j & 15) >> 2) + 4 * (j >> 4);
    const int tokw = b * SEQ + wid * 512;
    C.ubase = P.p_() + C_SU + g * 16; C.ybase = P.ybuf_() + g * 16;
    float x0r = 0.f, x0i = 0.f, x1r = 0.f, x1i = 0.f;
    __syncthreads();
    for (int sc = 0; sc < 16; ++sc) s5_tile<false>(C, tokw + sc * 32, x0r, x0i, x1r, x1i);
    if (hi == 0) { ends[(wid * 64 + j) * 2] = x0r; ends[(wid * 64 + j) * 2 + 1] = x0i; ends[(wid * 64 + 32 + j) * 2] = x1r; ends[(wid * 64 + 32 + j) * 2 + 1] = x1i; }
    __syncthreads();
    { const float p0r = sp[128 + 2 * j], p0i = sp[128 + 2 * j + 1], p1r = sp[128 + 2 * (32 + j)], p1i = sp[128 + 2 * (32 + j) + 1];
      x0r = 0.f; x0i = 0.f; x1r = 0.f; x1i = 0.f;
      for (int w = 0; w < wid; ++w) { const float e0r = ends[(w * 64 + j) * 2], e0i = ends[(w * 64 + j) * 2 + 1], e1r = ends[(w * 64 + 32 + j) * 2], e1i = ends[(w * 64 + 32 + j) * 2 + 1];
          const float n0r = p0r * x0r - p0i * x0i + e0r, n0i = p0r * x0i + p0i * x0r + e0i, n1r = p1r * x1r - p1i * x1i + e1r, n1i = p1r * x1i + p1i * x1r + e1i;
          x0r = n0r; x0i = n0i; x1r = n1r; x1i = n1i; }
      if (hi) { x0r = 0.f; x0i = 0.f; x1r = 0.f; x1i = 0.f; } }
    for (int sc = 0; sc < 16; ++sc) s5_tile<true>(C, tokw + sc * 32, x0r, x0i, x1r, x1i);
}
constexpr int TOPK = 256;
__device__ __forceinline__ unsigned f2key(float f) { const unsigned u = __float_as_uint(f); return u ^ ((u & 0x80000000u) ? 0xffffffffu : 0x80000000u); }

__device__ __forceinline__ float relu1(float x) { const int b = __float_as_int(x); return __int_as_float(b > 0 ? b : 0); }
#define DSA_MM(acc, rt, kk) acc = __builtin_amdgcn_mfma_f32_32x32x16_bf16(afr[rt][kk], bfr[kk], acc, 0, 0, 0)
#define DSA_HS(acc, rt, q) do { s0 = fmaf(relu1(acc[4 * (q)]), wv[rt][4 * (q)], s0); s1 = fmaf(relu1(acc[4 * (q) + 1]), wv[rt][4 * (q) + 1], s1); \
                                s0 = fmaf(relu1(acc[4 * (q) + 2]), wv[rt][4 * (q) + 2], s0); s1 = fmaf(relu1(acc[4 * (q) + 3]), wv[rt][4 * (q) + 3], s1); } while (0)
#define DSA_SG() __builtin_amdgcn_sched_barrier(0)
__device__ __forceinline__ void dsa_score_tile(const bf16x8 (&afr)[4][4], const f32x16 (&wv)[4], const bf16x8 (&bfr)[4], float* sc, int col, int hi) {
    const f32x16 z16 = {};
#define DSA_M0(acc, rt) acc = __builtin_amdgcn_mfma_f32_32x32x16_bf16(afr[rt][0], bfr[0], z16, 0, 0, 0)
    f32x16 accA, accB;
    float s0, s1;
    DSA_M0(accA, 0); DSA_MM(accA, 0, 1); DSA_MM(accA, 0, 2); DSA_MM(accA, 0, 3);
    s0 = 0.f; s1 = 0.f;
    DSA_M0(accB, 1); DSA_HS(accA, 0, 0); DSA_SG(); DSA_MM(accB, 1, 1); DSA_HS(accA, 0, 1); DSA_SG();
    DSA_MM(accB, 1, 2); DSA_HS(accA, 0, 2); DSA_SG(); DSA_MM(accB, 1, 3); DSA_HS(accA, 0, 3); DSA_SG();
    sc[(0 + hi) * 4096 + col] = (s0 + s1) + 0.f;
    s0 = 0.f; s1 = 0.f;
    DSA_M0(accA, 2); DSA_HS(accB, 1, 0); DSA_SG(); DSA_MM(accA, 2, 1); DSA_HS(accB, 1, 1); DSA_SG();
    DSA_MM(accA, 2, 2); DSA_HS(accB, 1, 2); DSA_SG(); DSA_MM(accA, 2, 3); DSA_HS(accB, 1, 3); DSA_SG();
    sc[(2 + hi) * 4096 + col] = (s0 + s1) + 0.f;
    s0 = 0.f; s1 = 0.f;
    DSA_M0(accB, 3); DSA_HS(accA, 2, 0); DSA_SG(); DSA_MM(accB, 3, 1); DSA_HS(accA, 2, 1); DSA_SG();
    DSA_MM(accB, 3, 2); DSA_HS(accA, 2, 2); DSA_SG(); DSA_MM(accB, 3, 3); DSA_HS(accA, 2, 3); DSA_SG();
    asm volatile("" :: "v"(bfr[0]), "v"(bfr[1]), "v"(bfr[2]), "v"(bfr[3]));
    sc[(4 + hi) * 4096 + col] = (s0 + s1) + 0.f;
    s0 = 0.f; s1 = 0.f;
    DSA_HS(accB, 3, 0); DSA_HS(accB, 3, 1); DSA_HS(accB, 3, 2); DSA_HS(accB, 3, 3);
    sc[(6 + hi) * 4096 + col] = (s0 + s1) + 0.f;
#undef DSA_M0
}
#define DSA_CNT4(K0, K1, K2, K3) asm volatile( \
    "v_cmp_ge_u32_e64 %[m0], %[k0], %[cd]\n\tv_cmp_ge_u32_e64 %[m1], %[k1], %[cd]\n\tv_cmp_ge_u32_e64 %[m2], %[k2], %[cd]\n\tv_cmp_ge_u32_e64 %[m3], %[k3], %[cd]\n\t" \
    "v_addc_co_u32_e64 %[a0], %[m0], %[a0], 0, %[m0]\n\tv_addc_co_u32_e64 %[a1], %[m1], %[a1], 0, %[m1]\n\t" \
    "v_addc_co_u32_e64 %[a0], %[m2], %[a0], 0, %[m2]\n\tv_addc_co_u32_e64 %[a1], %[m3], %[a1], 0, %[m3]" \
    : [a0] "+v"(c0), [a1] "+v"(c1), [m0] "=&s"(sm0), [m1] "=&s"(sm1), [m2] "=&s"(sm2), [m3] "=&s"(sm3) \
    : [k0] "v"(K0), [k1] "v"(K1), [k2] "v"(K2), [k3] "v"(K3), [cd] "v"(cand))
#define DSA_CNT8(J0) do { DSA_CNT4(key[(J0)], key[(J0) + 1], key[(J0) + 2], key[(J0) + 3]); DSA_CNT4(key[(J0) + 4], key[(J0) + 5], key[(J0) + 6], key[(J0) + 7]); } while (0)

template <int J> __device__ __forceinline__ void dsa_emit(const unsigned (&key)[64], unsigned T, unsigned& wlo, unsigned& whi) {
    const unsigned long long m = __ballot(key[J] >= T);
    asm("s_nop 1\n\tv_writelane_b32 %0, %2, %4\n\tv_writelane_b32 %1, %3, %4" : "+v"(wlo), "+v"(whi) : "s"((unsigned)m), "s"((unsigned)(m >> 32)), "n"(J));
    if constexpr (J + 1 < 64) dsa_emit<J + 1>(key, T, wlo, whi);
}
__device__ __forceinline__ void unit_dsa_index(const Params& P, int u, char* lds) {
    const int b = u & 3, t0 = (511 - (u >> 2)) * 8;
    const int tid = TIDX(), wid = tid >> 6, lane = tid & 63, r32 = lane & 31, hi = lane >> 5;
    float* sc = (float*)lds;
    const bf16_t* pb = P.p_() + (size_t)b * SEQ * NPAD;
    __syncthreads();
    TPU_START(101); TPU_START(110);
    {
        bf16x8 afr[4][4]; f32x16 wv[4];
        const int qsel = (r32 >> 2) & 1, head = (r32 & 3) + 4 * (r32 >> 3);
        char* qs = lds;
        const int ntile = (t0 + 7) / 32 + 1;
        const bf16_t* kp = P.ikc_() + (size_t)(b * (SEQ / 32)) * 2048 + lane * 8;
        bf16x8 b0[4], b1[4], b2[4];
#define DSA_LDB(dst, K) do { const bf16_t* kq_ = kp + (size_t)(wid + 8 * (K)) * 2048; _Pragma("unroll") for (int kk = 0; kk < 4; ++kk) dst[kk] = *(const bf16x8*)(kq_ + kk * 512); } while (0)
#define DSA_TILE(buf, K) dsa_score_tile(afr, wv, buf, sc, (wid + 8 * (K)) * 32 + r32, hi)
        const int nk = (ntile - wid + 7) >> 3;
        const int kl = nk > 0 ? nk - 1 : 0;
#define DSA_MIN(a) ((a) < kl ? (a) : kl)
        const int tk = tid >> 6, hd = (tid & 63) >> 2, dm = (tid & 3) * 16;
        const bf16_t* qsrc = pb + (size_t)(t0 + tk) * NPAD + C_DIQ + hd * 64 + dm;
        const u32x4 qa = *(const u32x4*)qsrc, qb2 = *(const u32x4*)(qsrc + 8);
#pragma unroll
        for (int rt = 0; rt < 4; ++rt) { const float* wp = P.iw_() + (size_t)(b * SEQ + t0 + 2 * rt + hi) * 16;
#pragma unroll
            for (int i = 0; i < 4; ++i) { const f32x4 w4 = *(const f32x4*)(wp + 4 * i); wv[rt][4 * i] = w4[0]; wv[rt][4 * i + 1] = w4[1]; wv[rt][4 * i + 2] = w4[2]; wv[rt][4 * i + 3] = w4[3]; } }
        DSA_LDB(b0, DSA_MIN(0)); DSA_LDB(b1, DSA_MIN(1));
        { char* dst = qs + tk * 2432 + hd * 144 + dm * 2; *(u32x4*)dst = qa; *(u32x4*)(dst + 16) = qb2; }
        __syncthreads();
#pragma unroll
        for (int rt = 0; rt < 4; ++rt) { const char* qp = qs + (2 * rt + qsel) * 2432 + head * 144 + hi * 16;
#pragma unroll
            for (int kk = 0; kk < 4; ++kk) afr[rt][kk] = *(const bf16x8*)(qp + kk * 32); }
        asm volatile("s_waitcnt lgkmcnt(0)" ::: "memory"); __syncthreads();
#if TPROBE == 110
        TPU_STOP(110);
#endif
#if TPROBE == 103
        TPU_START(103); asm volatile("s_waitcnt vmcnt(0)" ::: "memory"); TPU_STOP(103);
#endif
#if TPROBE == 104
        asm volatile("s_waitcnt vmcnt(0)" ::: "memory"); TPU_START(104);
#endif
        int k = 0;
        for (; k + 3 <= nk; k += 3) {
            DSA_LDB(b2, k + 2); DSA_TILE(b0, k);
            DSA_LDB(b0, DSA_MIN(k + 3)); DSA_TILE(b1, k + 1);
            DSA_LDB(b1, DSA_MIN(k + 4)); DSA_TILE(b2, k + 2);
        }
        if (k < nk) DSA_TILE(b0, k);
        if (k + 1 < nk) DSA_TILE(b1, k + 1);
#if TPROBE == 104
        asm volatile("s_waitcnt lgkmcnt(0)" ::: "memory"); TPU_STOP(104);
#endif
        TPU_START(111);
#undef DSA_TILE
#undef DSA_MIN
#undef DSA_TILE
#undef DSA_LDB
    }
    __syncthreads();
    TPU_STOP(111);
    TPU_STOP(101); TPU_START(102);
    {
        const int t = t0 + wid; const float* srow = sc + wid * 4096;
        unsigned key[64];
#pragma unroll
        for (int j = 0; j < 64; ++j) { const int s = j * 64 + lane; key[j] = (s <= t) ? f2key(srow[s]) : 0u; }
        unsigned long long* mout = P.mask_() + (size_t)(b * SEQ + t) * 64;
        unsigned long long myword = 0ull;
        TPU_START(105); TPU_START(106); TPU_START(107); TPU_START(108); TPU_START(109);
        if (t + 1 <= TOPK) {
#pragma unroll
            for (int j = 0; j < 64; ++j) { const unsigned long long m = __ballot(j * 64 + lane <= t); if (lane == j) myword = m; }
        } else {
            const int ngrp = t / 512 + 1;
#if TPROBE == 105
            asm volatile("" :: "v"(key[0]), "v"(key[63]));
#endif
            TPU_STOP(105);
            unsigned* hist = (unsigned*)(sc + wid * 4096);
            asm volatile("" ::: "memory");
            { const u32x4 zz4 = {0u, 0u, 0u, 0u};
#pragma unroll
              for (int i = 0; i < 16; ++i) *(u32x4*)(hist + (i * 64 + lane) * 4) = zz4; }
            asm volatile("" ::: "memory");
#define DSA_H8(J0) do { _Pragma("unroll") for (int jj = 0; jj < 8; ++jj) atomicAdd(hist + (key[(J0) + jj] >> 20), 1u); } while (0)
            DSA_H8(0);
            if (ngrp > 1) DSA_H8(8);
            if (ngrp > 2) DSA_H8(16);
            if (ngrp > 3) DSA_H8(24);
            if (ngrp > 4) DSA_H8(32);
            if (ngrp > 5) DSA_H8(40);
            if (ngrp > 6) DSA_H8(48);
            if (ngrp > 7) DSA_H8(56);
#undef DSA_H8
            asm volatile("" ::: "memory");
#if TPROBE == 106
            asm volatile("s_waitcnt lgkmcnt(0)" ::: "memory");
#endif
            TPU_STOP(106);
#define DSA_SUFFIX(s) do { _Pragma("unroll") for (int o = 1; o < 64; o <<= 1) { unsigned t_ = (unsigned)__builtin_amdgcn_ds_bpermute(((lane + o) & 63) << 2, (int)(s)); (s) += (lane + o < 64) ? t_ : 0u; } } while (0)
            unsigned mine = 0u;
#pragma unroll
            for (int i = 0; i < 16; ++i) { const u32x4 v4 = *(const u32x4*)(hist + lane * 64 + ((i + lane) & 15) * 4); mine += (v4[0] + v4[1]) + (v4[2] + v4[3]); }
            unsigned suf = mine; DSA_SUFFIX(suf);
            const unsigned long long mL = __ballot(suf - mine < (unsigned)TOPK && suf >= (unsigned)TOPK);
            const int Ls = (int)__builtin_ctzll(mL);
            const unsigned cntA = (unsigned)__builtin_amdgcn_readlane((int)(suf - mine), Ls);
            unsigned h2 = hist[Ls * 64 + lane]; unsigned suf2 = h2; DSA_SUFFIX(suf2);
            const unsigned long long mB = __ballot(cntA + suf2 - h2 < (unsigned)TOPK && cntA + suf2 >= (unsigned)TOPK);
            const int Bs = (int)__builtin_ctzll(mB);
            const unsigned bstar = (unsigned)(Ls * 64 + Bs);
            const unsigned cntAbove = cntA + (unsigned)__builtin_amdgcn_readlane((int)(suf2 - h2), Bs);
            const unsigned inbin = (unsigned)__builtin_amdgcn_readlane((int)h2, Bs);
#undef DSA_SUFFIX
            TPU_STOP(107);
            unsigned T = bstar << 20; int cntT = (int)(cntAbove + inbin);
            if (cntT != TOPK) {
                asm volatile("" ::: "memory");
                int nslot = 0;
#pragma unroll
                for (int j = 0; j < 64; ++j) { if ((key[j] >> 20) == bstar) { hist[nslot * 64 + lane] = key[j]; ++nslot; } }
                asm volatile("" ::: "memory");
                int R = nslot;
#pragma unroll
                for (int o = 32; o >= 1; o >>= 1) { const int other = __builtin_amdgcn_ds_bpermute(((lane ^ o) << 2), R); R = other > R ? other : R; }
                R = __builtin_amdgcn_readfirstlane(R);
                if (R <= 8) {
                    unsigned c[8];
#pragma unroll
                    for (int r = 0; r < 8; ++r) c[r] = (r < nslot) ? hist[r * 64 + lane] : 0u;
                    for (int bit = 19; bit >= 0; --bit) {
                        const unsigned cand = T | (1u << bit); int cnt = (int)cntAbove;
#pragma unroll
                        for (int r = 0; r < 8; ++r) cnt += __popcll(__ballot(c[r] >= cand));
                        if (cnt >= TOPK) { T = cand; cntT = cnt; if (cnt == TOPK) break; }
                    }
                } else {
                    for (int bit = 19; bit >= 0; --bit) {
                        const unsigned cand = T | (1u << bit); unsigned c0 = 0, c1 = 0; unsigned long long sm0, sm1, sm2, sm3;
                        DSA_CNT8(0);
                        if (ngrp > 1) DSA_CNT8(8);
                        if (ngrp > 2) DSA_CNT8(16);
                        if (ngrp > 3) DSA_CNT8(24);
                        if (ngrp > 4) DSA_CNT8(32);
                        if (ngrp > 5) DSA_CNT8(40);
                        if (ngrp > 6) DSA_CNT8(48);
                        if (ngrp > 7) DSA_CNT8(56);
                        const int cl = (int)(c0 + c1);
                        int cnt = 0;
#pragma unroll
                        for (int bb = 0; bb < 7; ++bb) cnt += __popcll(__ballot((cl >> bb) & 1)) << bb;
                        if (cnt >= TOPK) { T = cand; cntT = cnt; if (cnt == TOPK) break; }
                    }
                }
            }
            TPU_STOP(108);
            if (cntT == TOPK) {
                unsigned wlo = 0u, whi = 0u;
                dsa_emit<0>(key, T, wlo, whi);
                myword = ((unsigned long long)whi << 32) | wlo;
            } else {
                int ngt = 0;
#pragma unroll
                for (int j = 0; j < 64; ++j) ngt += __popcll(__ballot(key[j] > T));
                int need = TOPK - ngt;
#pragma unroll
                for (int j = 0; j < 64; ++j) { const unsigned long long eq = __ballot(key[j] == T), gt = __ballot(key[j] > T);
                    const int ne = __popcll(eq); unsigned long long take = eq;
                    if (ne > need) { take = 0ull; int left = need; unsigned long long e2 = eq;
                        while (left > 0) { const unsigned long long lowbit = e2 & (0ull - e2); take |= lowbit; e2 ^= lowbit; --left; } }
                    need -= (ne > need) ? need : ne;
                    const unsigned long long m = gt | take; if (lane == j) myword = m; }
            }
        }
        mout[lane] = myword;
        TPU_STOP(109);
    }
    TPU_STOP(102);
}

struct DsaOutRow { const bf16_t* zb; bf16_t* gb; int wid;
    __device__ __forceinline__ const bf16_t* zrow(int r) const { const int rho = wid * 32 + r; return zb + (size_t)(rho >> 2) * NPAD + (rho & 3) * 128; }
    __device__ __forceinline__ bf16_t* grow(int r) const { const int rho = wid * 32 + r; return gb + (size_t)(rho >> 2) * MIX + (rho & 3) * 128; } };
__device__ __forceinline__ void unit_dsa_attn(const Params& P, int cur_layer, int u, char* lds) {
    const int b = u & 3, qb = 63 - (u >> 2), t0 = qb * 64, tokb = b * SEQ;
    const int wid = TIDX() >> 6, lane = TIDX() & 63, r32 = lane & 31, hi = lane >> 5;
    const int rho = wid * 32 + r32, tq = t0 + (rho >> 2), hq = rho & 3;
    const bf16_t* Qw = P.p_() + (size_t)(tokb + tq) * NPAD + C_DQ + hq * 128 + hi * 8;
    const bf16_t* Kh = P.kvc_() + (size_t)tokb * 256;
    const unsigned moff = (unsigned)(tokb + tq) * 512u;
    DsaOutRow ow; ow.zb = P.p_() + (size_t)(tokb + t0) * NPAD + C_DZ; ow.gb = P.xn_() + (size_t)(tokb + t0) * MIX + 1024; ow.wid = wid;
    const int NT = (qb + 2) & ~1;
    att::attn_body<true, 256, 128, 2, DsaOutRow>(Qw, P.dsa_q_norm + cur_layer * 128, P.rope_() + (size_t)(tokb + tq) * 48, Kh, NT, P.mask_(), moff, ow, lds);
}
__device__ __forceinline__ void phase_gemm_glu(const Params& P, int layer, char* lds) {
    pg8::Gemm g; g.A = P.ybuf_(); g.Bt = P.WgluT_() + (size_t)layer * 512 * 512; g.M = NTOK; g.N = 512; g.K = 512;
    pg8::StaticOrder S; S.init(g.M, g.N, (int)gridDim.x, (int)blockIdx.x);
    pg8::EpiGlu E; E.Y = P.ybuf_(); E.ldy = 512; E.O = P.ocat_(); E.ldo = MIX; E.ooff = 512;
    pg8::gemm_phase<pg8::EpiGlu, pg8::StaticOrder, false>((PG8_LAS unsigned char*)lds, g, S, E, nullptr);
}

constexpr int CTL_Q0 = 4096;
struct OneUnit { int pm, pn; __device__ __forceinline__ bool next(int i, pg8::Unit& u) const { if (i) return false; u.pm = pm; u.pn = pn; return true; }
    __device__ __forceinline__ void a_ready(const pg8::Unit&) const {} __device__ __forceinline__ void done(const pg8::Unit&) const {} };
__device__ __forceinline__ int q_issue(unsigned* ctr) { return (int)__hip_atomic_fetch_add(ctr, 1u, __ATOMIC_RELAXED, __HIP_MEMORY_SCOPE_AGENT); }
#define Q_LOOP_BEGIN(ctr, total)  { unsigned* q_ctr_ = (ctr); const int q_total_ = (total); volatile int* q_b_ = (volatile int*)(lds + LDS_TAIL + 16); \
    for (;;) { __syncthreads(); if (TIDX() == 0) *q_b_ = q_issue(q_ctr_); __syncthreads(); const int item = __builtin_amdgcn_readfirstlane(*q_b_); if (item >= q_total_) break;
#define Q_LOOP_END  } }
__device__ __forceinline__ void unit_glu(const Params& P, int layer, int u, char* lds) {
    pg8::Gemm g; g.A = P.ybuf_(); g.Bt = P.WgluT_() + (size_t)layer * 512 * 512; g.M = NTOK; g.N = 512; g.K = 512;
    OneUnit S; S.pm = u >> 1; S.pn = u & 1;
    pg8::EpiGluGate E; E.Y = P.ybuf_(); E.Pz = P.p_(); E.G = P.xn_();
    pg8::gemm_phase<pg8::EpiGluGate, OneUnit, false>((PG8_LAS unsigned char*)lds, g, S, E, nullptr);
}
constexpr int LDS_TAIL = LDS_BYTES - 64;

__global__ __launch_bounds__(NTHR, 2) void k_mega(Params P) {
    extern __shared__ __attribute__((aligned(16))) char lds[];
    if (TIDX() == 0) *(uint4*)(lds + LDS_TAIL) = make_uint4(0u, 0u, 0u, 0u);
    __syncthreads();
    XcdBarrier bar = xcd_barrier_post(P.ctl_(), (volatile LAS unsigned*)(lds + LDS_TAIL));
    const int G = gridDim.x, B = blockIdx.x;
    phase_prologue1(P, lds); phase_rope_table(P); phase_s5_params(P); phase_rmsnorm_x(P, 0);
    xcd_barrier(bar);
    for (int layer = 0; layer < DEPTH; ++layer) {
        if (layer > 0) { phase_rmsnorm_x(P, layer); xcd_barrier(bar); }
        phase_gemm_in(P, layer, lds);
        if (layer == 0) phase_gemm_kv(P, lds);
        xcd_barrier(bar);
        phase_prep(P, layer);
        if (layer == 0) phase_memk_norm(P);
        for (int u = B; u < 256; u += G) unit_gla_a4(P, layer, u, lds);
        xcd_barrier(bar);
        Q_LOOP_BEGIN(P.ctl_() + CTL_Q0 + 64 * (layer * 2), 128 + 2048 + 256)
            if (item < 128) unit_s5(P, layer, item, lds);
            else if (item < 2176) unit_dsa_index(P, item - 128, lds);
            else gla_scan_slice(P, (item - 2176) * NTHR + TIDX());
        Q_LOOP_END
        xcd_barrier(bar);
        Q_LOOP_BEGIN(P.ctl_() + CTL_Q0 + 64 * (layer * 2 + 1), 256 + 256 + 128 + 256)
            if (item < 256) unit_dsa_attn(P, layer, item, lds);
            else if (item < 512) unit_gla_c4(P, layer, item - 256, lds);
            else if (item < 640) unit_glu(P, layer, item - 512, lds);
            else unit_mem_attn(P, layer, item - 640, lds);
        Q_LOOP_END
        xcd_barrier(bar);
        phase_gemm_out(P, layer, lds);
        xcd_barrier(bar);
    }
}

extern "C" void kernel_launch(void* const* d_in, const int* in_sizes, int n_in, void* d_out, int out_size, void* d_ws, size_t ws_size, hipStream_t stream) {
    if (n_in != 24 || ws_size < WS_END) { fprintf(stderr, "kernel_launch: unexpected n_in %d or ws_size %zu (< %zu)\n", n_in, ws_size, (size_t)WS_END); return; }
    Params P; memset(&P, 0, sizeof(P));
    P.x = (const float*)d_in[0]; P.mem = (const float*)d_in[1]; P.pos = (const int*)d_in[2]; P.ln_gain = (const float*)d_in[3]; P.w_in = (const float*)d_in[4];
    P.gla_w_up = (const float*)d_in[5]; P.gla_b_up = (const float*)d_in[6]; P.s5_a_re = (const float*)d_in[7]; P.s5_a_im = (const float*)d_in[8]; P.s5_log_step = (const float*)d_in[9];
    P.s5_b_re = (const float*)d_in[10]; P.s5_b_im = (const float*)d_in[11]; P.s5_c_re = (const float*)d_in[12]; P.s5_c_im = (const float*)d_in[13]; P.s5_d = (const float*)d_in[14];
    P.s5_w_glu = (const float*)d_in[15]; P.dsa_q_norm = (const float*)d_in[16]; P.dsa_k_norm = (const float*)d_in[17]; P.mem_norm = (const float*)d_in[18]; P.w_mem_kv = (const float*)d_in[19];
    P.mem_q_norm = (const float*)d_in[20]; P.mem_k_norm = (const float*)d_in[21]; P.out_norm = (const float*)d_in[22]; P.w_out = (const float*)d_in[23];
    P.out = (float*)d_out;
    char* ws = (char*)d_ws; P.ws = ws;
    static int grid = 0;
    if (!grid) {
        int dev = 0, cus = 0, per_cu = 0;
        (void)hipGetDevice(&dev); (void)hipDeviceGetAttribute(&cus, hipDeviceAttributeMultiprocessorCount, dev);
        (void)hipFuncSetAttribute((const void*)k_mega, hipFuncAttributeMaxDynamicSharedMemorySize, LDS_BYTES);
        (void)hipOccupancyMaxActiveBlocksPerMultiprocessor(&per_cu, (const void*)k_mega, NTHR, LDS_BYTES);
        if (per_cu < 1) fprintf(stderr, "kernel_launch: occupancy query reports %d blocks per CU\n", per_cu);
        grid = cus > 0 ? cus : 256;
    }
    (void)hipMemsetAsync(ws + WS_CTL, 0, CTL_BYTES, stream);
    hipLaunchKernelGGL(k_mega, dim3(grid), dim3(NTHR), LDS_BYTES, stream, P);
}
```

```cpp
#include <hip/hip_runtime.h>
#include <stdint.h>
#include <stdio.h>
#include <string.h>

constexpr int NB = 4, SEQ = 4096, NTOK = NB * SEQ, DM = 2048, DEPTH = 4, MEML = 256;
constexpr int NIN = 5984, NPAD = 6144, MIX = 2048;
constexpr int C_GQ = 0, C_GK = 256, C_GV = 512, C_GLR = 1024, C_GZ = 1040, C_SU = 1552, C_SZ = 2064, C_DQ = 2576, C_DK = 3088, C_DV = 3216,
              C_DIQ = 3344, C_DIK = 4368, C_DIW = 4432, C_DZ = 4448, C_MQ = 4960, C_MZ = 5472;
constexpr float EPS = 1e-6f;
constexpr int NTHR = 512;
constexpr int LDS_BYTES = 147456;

typedef unsigned short bf16_t;
typedef short bf16x8 __attribute__((ext_vector_type(8)));
typedef short s16x4 __attribute__((ext_vector_type(4)));
typedef float f32x4 __attribute__((ext_vector_type(4)));
typedef float f32x8 __attribute__((ext_vector_type(8)));
typedef float f32x16 __attribute__((ext_vector_type(16)));
typedef unsigned u32x4 __attribute__((ext_vector_type(4)));
typedef unsigned u32x2 __attribute__((ext_vector_type(2)));
#define LAS __attribute__((address_space(3)))

__device__ __forceinline__ float bf2f(bf16_t b) { return __uint_as_float(((unsigned)b) << 16); }
__device__ __forceinline__ bf16_t f2bf(float f) { unsigned u = __float_as_uint(f); u += 0x7FFFu + ((u >> 16) & 1u); return (bf16_t)(u >> 16); }
__device__ __forceinline__ unsigned pk2bf(float lo, float hi) { return (unsigned)f2bf(lo) | ((unsigned)f2bf(hi) << 16); }
__device__ __forceinline__ float sigmoidf_(float x) { return __builtin_amdgcn_rcpf(1.f + __expf(-x)); }
__device__ __forceinline__ float siluf_(float x) { return x * __builtin_amdgcn_rcpf(1.f + __expf(-x)); }

__device__ __forceinline__ int TIDX() { int t = (int)threadIdx.x; asm volatile("" : "+v"(t)); return t; }
__device__ __forceinline__ float shx(float v, int m) { const int src = ((TIDX() & 63) ^ m) << 2; return __int_as_float(__builtin_amdgcn_ds_bpermute(src, __float_as_int(v))); }
__device__ __forceinline__ float wave_sum(float v) {
#pragma unroll
    for (int o = 32; o >= 1; o >>= 1) v += shx(v, o);
    return v;
}
__device__ __forceinline__ void ld8f(const bf16_t* p, float (&v)[8]) { const u32x4 w = *(const u32x4*)p;
#pragma unroll
    for (int j = 0; j < 4; ++j) { v[2 * j] = __uint_as_float(w[j] << 16); v[2 * j + 1] = __uint_as_float(w[j] & 0xffff0000u); } }
__device__ __forceinline__ void st8f(bf16_t* p, const float (&v)[8]) { u32x4 w; w.x = pk2bf(v[0], v[1]); w.y = pk2bf(v[2], v[3]); w.z = pk2bf(v[4], v[5]); w.w = pk2bf(v[6], v[7]); *(u32x4*)p = w; }
__device__ __forceinline__ float f2bf_f(float f) { return bf2f(f2bf(f)); }

#ifndef TPROBE
#define TPROBE 0
#endif
#if TPROBE
#define TPU_START(id) do { if (TPROBE == (id) && TIDX() == 0) *(volatile unsigned long long*)(lds + LDS_BYTES - 24) = __builtin_amdgcn_s_memrealtime(); } while (0)
#define TPU_STOP(id) do { if (TPROBE == (id) && TIDX() == 0) *(volatile unsigned long long*)(lds + LDS_BYTES - 32) += __builtin_amdgcn_s_memrealtime() - *(volatile unsigned long long*)(lds + LDS_BYTES - 24); } while (0)
#else
#define TPU_START(id) do {} while (0)
#define TPU_STOP(id) do {} while (0)
#endif
#define XB_TMO      128
#define XB_XCNT(j)  (256  + 64 * (j))
#define XB_XSUB(j)  (1280 + 64 * (j))
#define XB_XGEN(j)  (2304 + 64 * (j))
#define XB_TOP      3328
#define XB_TOPGEN   3392
#define XCD_BAR_WORDS 3456
#define XB_SPIN_CAP (1u << 18)

__device__ __forceinline__ unsigned xb_ld(unsigned* p)              { return __hip_atomic_load(p, __ATOMIC_RELAXED, __HIP_MEMORY_SCOPE_AGENT); }
__device__ __forceinline__ unsigned xb_add(unsigned* p, unsigned v) { return __hip_atomic_fetch_add(p, v, __ATOMIC_RELAXED, __HIP_MEMORY_SCOPE_AGENT); }
__device__ __forceinline__ unsigned xb_xcc_id() { return (unsigned)__builtin_amdgcn_s_getreg((3 << 11) | 20) & 0xFu; }
#define XB_SPIN(cond, bar) do { unsigned _sp = 0; while (cond) { __builtin_amdgcn_s_sleep(1); \
    if ((++_sp & 255u) == 0u) { if (xb_ld(&(bar)[XB_TMO])) break; if (_sp > XB_SPIN_CAP) { atomicAdd(&(bar)[XB_TMO], 1u); break; } } } } while (0)

struct XcdBarrier {
    unsigned* bar; unsigned x;
    volatile LAS unsigned* st;
};

__device__ __forceinline__ XcdBarrier xcd_barrier_post(unsigned* bar, volatile LAS unsigned* st) {
    XcdBarrier b; b.bar = bar; b.x = xb_xcc_id(); b.st = st;
    if (TIDX() == 0) (void)xb_add(&bar[XB_XCNT(b.x)], 1u);
    return b;
}
__device__ __forceinline__ void xcd_barrier_complete(unsigned* bar, unsigned x, unsigned& nloc, unsigned& nx) {
    const unsigned G = gridDim.x * gridDim.y * gridDim.z;
    unsigned sum, cnt, mine, sp = 0u;
    for (;;) {
        sum = 0u; cnt = 0u; mine = 0u;
#pragma unroll
        for (unsigned j = 0; j < 16; ++j) { const unsigned c = xb_ld(&bar[XB_XCNT(j)]); sum += c; cnt += (c > 0u) ? 1u : 0u; mine = (j == x) ? c : mine; }
        if (sum == G) break;
        __builtin_amdgcn_s_sleep(1);
        if ((++sp & 255u) == 0u) { if (xb_ld(&bar[XB_TMO])) break; if (sp > XB_SPIN_CAP) { atomicAdd(&bar[XB_TMO], 1u); break; } }
    }
    nloc = mine > 0u ? mine : 1u; nx = cnt > 0u ? cnt : 1u;
}

__device__ __forceinline__ void xcd_barrier(const XcdBarrier& b) {
    asm volatile("s_waitcnt vmcnt(0)" ::: "memory");
    __syncthreads();
    if (TIDX() == 0) {
        unsigned* bar = b.bar; const unsigned bx = xb_xcc_id();
        __builtin_amdgcn_s_waitcnt(0);
        unsigned nloc = b.st[0], nx = b.st[1];
        if (nloc == 0u) { xcd_barrier_complete(bar, bx, nloc, nx); b.st[0] = nloc; b.st[1] = nx; }
        const unsigned old = xb_add(&bar[XB_XSUB(bx)], 1u);
        const unsigned gen = old / nloc;
        if (old + 1u == (gen + 1u) * nloc) {
            __builtin_amdgcn_fence(__ATOMIC_RELEASE, "agent");
            asm volatile("s_waitcnt vmcnt(0)" ::: "memory");
            const unsigned og = xb_add(&bar[XB_TOP], 1u);
            const unsigned tg = og / nx;
            if (og + 1u == (tg + 1u) * nx) xb_add(&bar[XB_TOPGEN], 1u);
            else XB_SPIN(xb_ld(&bar[XB_TOPGEN]) == tg, bar);
            __builtin_amdgcn_fence(__ATOMIC_ACQUIRE, "agent");
            xb_add(&bar[XB_XGEN(bx)], 1u);
            asm volatile("s_waitcnt vmcnt(0)" ::: "memory");
        } else {
            XB_SPIN(xb_ld(&bar[XB_XGEN(bx)]) == gen, bar);
            __builtin_amdgcn_fence(__ATOMIC_ACQUIRE, "agent");
            asm volatile("s_waitcnt vmcnt(0)" ::: "memory");
        }
    }
    __syncthreads();
}
namespace pg8 {
#define PG8_LAS __attribute__((address_space(3)))
typedef float f32x2 __attribute__((ext_vector_type(2)));
typedef unsigned u32x4 __attribute__((ext_vector_type(4)));
constexpr int BM = 256, BK = 64, HALF = 128, HTB = HALF * BK * 2  , STAGE_BYTES = 8 * HTB, NXCD = 8, WGM = 8;

__host__ __device__ __forceinline__ int lds_byte(int r, int c) { const int st = (r >> 4) * 2 + (c >> 5), rr = r & 15, cc = c & 31, ob = rr * 64 + cc * 2; return st * 1024 + (ob ^ (((ob >> 9) & 1) << 5)); }
__host__ __device__ __forceinline__ void stage_rc(int b, int& R, int& C) { const int st = b / 1024, sb = b % 1024, swz = sb ^ (((sb >> 9) & 1) << 5); R = (st >> 1) * 16 + swz / 64; C = (st & 1) * 32 + (swz % 64) / 2; }
__host__ __device__ __forceinline__ int perm32(int rho) { const int n = rho >> 4, i = rho & 15; return 8 * (i >> 2) + 4 * n + (i & 3); }

struct Unit { int pm, pn; };
struct Gemm { const bf16_t* A; const bf16_t* Bt; int M, N, K; };

struct StaticOrder {
    int nM, nN, nwg, G, c;
    __host__ __device__ void init(int M, int N, int G_, int c_) { nM = M / BM; nN = N / BM; nwg = nM * nN; G = G_; c = c_; }
    __host__ __device__ bool next(int i, Unit& u) const {
        const long L = (long)i * G + c; if (L >= nwg) return false;
        int wgid = (int)L; { const int q = nwg / NXCD, r = nwg % NXCD, xcd = wgid % NXCD, off = wgid / NXCD; wgid = (xcd < r ? xcd * (q + 1) : r * (q + 1) + (xcd - r) * q) + off; }
        const int nig = WGM * nN, gid = wgid / nig, fm = gid * WGM, gsz = (nM - fm) < WGM ? (nM - fm) : WGM;
        u.pm = fm + ((wgid % nig) % gsz); u.pn = (wgid % nig) / gsz; return true;
    }
    __device__ __forceinline__ void a_ready(const Unit&) const {}
    __device__ __forceinline__ void done(const Unit&) const {}
};
__device__ __forceinline__ unsigned cvt_pk_bf16(float lo, float hi) { unsigned r; asm volatile("v_cvt_pk_bf16_f32 %0, %1, %2" : "=v"(r) : "v"(lo), "v"(hi)); return r; }
struct EpiBf16Plain {
    static constexpr bool PERM = true, AFTER_DRAIN = false;
    bf16_t* O; int ldc;
    __device__ __forceinline__ void operator()(const f32x4 (&acc)[2][2][4][2], const Unit& u, int wr, int wc, int fr, int fq) const {
        const int row0 = u.pm * BM + wr * 64 + fr, col0 = u.pn * BM + wc * 32 + 8 * fq;
#pragma unroll
        for (int ai = 0; ai < 2; ++ai)
#pragma unroll
            for (int m = 0; m < 4; ++m) { bf16_t* rowp = O + (size_t)(row0 + ai * HALF + m * 16) * ldc + col0;
#pragma unroll
                for (int bj = 0; bj < 2; ++bj) { const f32x4 v0 = acc[ai][bj][m][0], v1 = acc[ai][bj][m][1];
                    u32x4 w; w.x = cvt_pk_bf16(v0[0], v0[1]); w.y = cvt_pk_bf16(v0[2], v0[3]); w.z = cvt_pk_bf16(v1[0], v1[1]); w.w = cvt_pk_bf16(v1[2], v1[3]);
                    *(u32x4*)(rowp + bj * HALF) = w; } }
    }
};
struct EpiResid {
    static constexpr bool PERM = false, AFTER_DRAIN = false;
    const float* R; float* C; int ldc;
    __device__ __forceinline__ void operator()(const f32x4 (&acc)[2][2][4][2], const Unit& u, int wr, int wc, int fr, int fq) const {
        const int row0 = u.pm * BM + wr * 64 + fr, col0 = u.pn * BM + wc * 32 + 4 * fq;
#pragma unroll
        for (int ai = 0; ai < 2; ++ai)
#pragma unroll
            for (int m = 0; m < 4; ++m) { const size_t off = (size_t)(row0 + ai * HALF + m * 16) * ldc + col0;
#pragma unroll
                for (int bj = 0; bj < 2; ++bj)
#pragma unroll
                    for (int n = 0; n < 2; ++n) { const f32x4 r = *(const f32x4*)(R + off + bj * HALF + n * 16); *(f32x4*)(C + off + bj * HALF + n * 16) = acc[ai][bj][m][n] + r; } }
    }
};
struct EpiResidMix {
    static constexpr bool PERM = true, AFTER_DRAIN = false;
    const void* R; void* C; int ldc; int r16, c16;
    __device__ __forceinline__ void operator()(const f32x4 (&acc)[2][2][4][2], const Unit& u, int wr, int wc, int fr, int fq) const {
        const int row0 = u.pm * BM + wr * 64 + fr, col0 = u.pn * BM + wc * 32 + 8 * fq;
#pragma unroll
        for (int ai = 0; ai < 2; ++ai)
#pragma unroll
            for (int m = 0; m < 4; ++m) { const size_t off = (size_t)(row0 + ai * HALF + m * 16) * ldc + col0;
                f32x4 r0[2], r1[2];
                if (r16) {
#pragma unroll
                    for (int bj = 0; bj < 2; ++bj) { const u32x4 w = *(const u32x4*)((const bf16_t*)R + off + bj * HALF);
                        r0[bj] = f32x4{__uint_as_float(w.x << 16), __uint_as_float(w.x & 0xffff0000u), __uint_as_float(w.y << 16), __uint_as_float(w.y & 0xffff0000u)};
                        r1[bj] = f32x4{__uint_as_float(w.z << 16), __uint_as_float(w.z & 0xffff0000u), __uint_as_float(w.w << 16), __uint_as_float(w.w & 0xffff0000u)}; }
                } else {
#pragma unroll
                    for (int bj = 0; bj < 2; ++bj) { r0[bj] = *(const f32x4*)((const float*)R + off + bj * HALF); r1[bj] = *(const f32x4*)((const float*)R + off + bj * HALF + 4); }
                }
#pragma unroll
                for (int bj = 0; bj < 2; ++bj) { const f32x4 v0 = acc[ai][bj][m][0] + r0[bj], v1 = acc[ai][bj][m][1] + r1[bj];
                    if (c16) { u32x4 w; w.x = cvt_pk_bf16(v0[0], v0[1]); w.y = cvt_pk_bf16(v0[2], v0[3]); w.z = cvt_pk_bf16(v1[0], v1[1]); w.w = cvt_pk_bf16(v1[2], v1[3]);
                        *(u32x4*)((bf16_t*)C + off + bj * HALF) = w; }
                    else { *(f32x4*)((float*)C + off + bj * HALF) = v0; *(f32x4*)((float*)C + off + bj * HALF + 4) = v1; } } }
    }
};
struct EpiGlu {
    static constexpr bool PERM = true, AFTER_DRAIN = false;
    const bf16_t* Y; int ldy; bf16_t* O; int ldo; int ooff;
    __device__ __forceinline__ void operator()(const f32x4 (&acc)[2][2][4][2], const Unit& u, int wr, int wc, int fr, int fq) const {
        const int row0 = u.pm * BM + wr * 64 + fr, col0 = u.pn * BM + wc * 32 + 8 * fq;
#pragma unroll
        for (int ai = 0; ai < 2; ++ai)
#pragma unroll
            for (int m = 0; m < 4; ++m) { const int row = row0 + ai * HALF + m * 16;
#pragma unroll
                for (int bj = 0; bj < 2; ++bj) { const f32x4 v0 = acc[ai][bj][m][0], v1 = acc[ai][bj][m][1];
                    const u32x4 yw = *(const u32x4*)(Y + (size_t)row * ldy + col0 + bj * HALF);
                    float y[8], g[8];
#pragma unroll
                    for (int j = 0; j < 4; ++j) { y[2 * j] = __uint_as_float(yw[j] << 16); y[2 * j + 1] = __uint_as_float(yw[j] & 0xffff0000u); }
#pragma unroll
                    for (int j = 0; j < 4; ++j) { g[j] = __builtin_amdgcn_rcpf(1.f + __expf(-v0[j])); g[4 + j] = __builtin_amdgcn_rcpf(1.f + __expf(-v1[j])); }
                    u32x4 w; w.x = cvt_pk_bf16(y[0] * g[0], y[1] * g[1]); w.y = cvt_pk_bf16(y[2] * g[2], y[3] * g[3]); w.z = cvt_pk_bf16(y[4] * g[4], y[5] * g[5]); w.w = cvt_pk_bf16(y[6] * g[6], y[7] * g[7]);
                    *(u32x4*)(O + (size_t)row * ldo + ooff + col0 + bj * HALF) = w; } }
    }
};
struct EpiGluGate {
    static constexpr bool PERM = true, AFTER_DRAIN = true;
    const bf16_t* Y; const bf16_t* Pz; bf16_t* G;
    __device__ __forceinline__ void fused(const f32x4 (&acc)[2][2][4][2], const Unit& u, int wr, int wc, int fr, int fq, PG8_LAS unsigned char* lds, int wid, int lane) const {
        constexpr int TS = 528;
        const int row0 = wr * 64 + fr, col0 = wc * 32 + 8 * fq;
#pragma unroll
        for (int ai = 0; ai < 2; ++ai)
#pragma unroll
            for (int m = 0; m < 4; ++m) { const int rl = row0 + ai * HALF + m * 16; const size_t grow = (size_t)u.pm * BM + rl;
#pragma unroll
                for (int bj = 0; bj < 2; ++bj) { const f32x4 v0 = acc[ai][bj][m][0], v1 = acc[ai][bj][m][1];
                    const u32x4 yw = *(const u32x4*)(Y + grow * 512 + u.pn * BM + col0 + bj * HALF);
                    float y[8], g[8];
#pragma unroll
                    for (int j = 0; j < 4; ++j) { y[2 * j] = __uint_as_float(yw[j] << 16); y[2 * j + 1] = __uint_as_float(yw[j] & 0xffff0000u); }
#pragma unroll
                    for (int j = 0; j < 4; ++j) { g[j] = __builtin_amdgcn_rcpf(1.f + __expf(-v0[j])); g[4 + j] = __builtin_amdgcn_rcpf(1.f + __expf(-v1[j])); }
                    u32x4 w; w.x = cvt_pk_bf16(y[0] * g[0], y[1] * g[1]); w.y = cvt_pk_bf16(y[2] * g[2], y[3] * g[3]); w.z = cvt_pk_bf16(y[4] * g[4], y[5] * g[5]); w.w = cvt_pk_bf16(y[6] * g[6], y[7] * g[7]);
                    *(PG8_LAS u32x4*)(lds + rl * TS + (col0 + bj * HALF) * 2) = w; } }
        __syncthreads();
        { const int t = wid * 64 + lane, row = t >> 1, hd = t & 1; const PG8_LAS unsigned char* src = lds + row * TS + hd * 256;
          float ss = 0.f;
#pragma unroll
          for (int i = 0; i < 16; ++i) { const u32x4 w = *(const PG8_LAS u32x4*)(src + 16 * i);
#pragma unroll
              for (int j = 0; j < 4; ++j) { const float a = __uint_as_float(w[j] << 16), b = __uint_as_float(w[j] & 0xffff0000u); ss += a * a + b * b; } }
          const float rn = rsqrtf(ss * (1.f / 128.f) + 1e-6f);
          const size_t grow = (size_t)u.pm * BM + row; const int cb = u.pn * BM + hd * 128;
          const bf16_t* zp = Pz + grow * 6144 + 2064 + cb; bf16_t* gp = G + grow * 2048 + 512 + cb;
#pragma unroll
          for (int i = 0; i < 16; ++i) { const u32x4 w = *(const PG8_LAS u32x4*)(src + 16 * i); const u32x4 zw = *(const u32x4*)(zp + 8 * i); u32x4 o;
#pragma unroll
              for (int j = 0; j < 4; ++j) { const float a = __uint_as_float(w[j] << 16), b = __uint_as_float(w[j] & 0xffff0000u), za = __uint_as_float(zw[j] << 16), zb = __uint_as_float(zw[j] & 0xffff0000u);
                  o[j] = cvt_pk_bf16(a * rn * (za * __builtin_amdgcn_rcpf(1.f + __expf(-za))), b * rn * (zb * __builtin_amdgcn_rcpf(1.f + __expf(-zb)))); }
              *(u32x4*)(gp + 8 * i) = o; } }
        __syncthreads();
    }
};
struct EpiBf16Scale {
    static constexpr bool PERM = true, AFTER_DRAIN = false;
    bf16_t* O; int ldc; const float* ssq;
    __device__ __forceinline__ void operator()(const f32x4 (&acc)[2][2][4][2], const Unit& u, int wr, int wc, int fr, int fq) const {
        const int row0 = u.pm * BM + wr * 64 + fr, col0 = u.pn * BM + wc * 32 + 8 * fq;
#pragma unroll
        for (int ai = 0; ai < 2; ++ai)
#pragma unroll
            for (int m = 0; m < 4; ++m) { const int row = row0 + ai * HALF + m * 16; bf16_t* rowp = O + (size_t)row * ldc + col0;
                float ssum = 0.f; { const f32x4* sp_ = (const f32x4*)(ssq + (size_t)row * 32);
#pragma unroll
                    for (int q = 0; q < 8; ++q) { const f32x4 t4 = sp_[q]; ssum += (t4[0] + t4[1]) + (t4[2] + t4[3]); } }
                const float s = rsqrtf(ssum * (1.f / 2048.f) + 1e-6f);
#pragma unroll
                for (int bj = 0; bj < 2; ++bj) { const f32x4 v0 = acc[ai][bj][m][0] * s, v1 = acc[ai][bj][m][1] * s;
                    u32x4 w; w.x = cvt_pk_bf16(v0[0], v0[1]); w.y = cvt_pk_bf16(v0[2], v0[3]); w.z = cvt_pk_bf16(v1[0], v1[1]); w.w = cvt_pk_bf16(v1[2], v1[3]);
                    *(u32x4*)(rowp + bj * HALF) = w; } }
    }
};
struct EpiResidNext {
    static constexpr bool PERM = false, AFTER_DRAIN = false;
    const float* R; float* C; int ldc; bf16_t* XB; float* ssq;
    __device__ __forceinline__ void operator()(const f32x4 (&acc)[2][2][4][2], const Unit& u, int wr, int wc, int fr, int fq) const {
        const int row0 = u.pm * BM + wr * 64 + fr, col0 = u.pn * BM + wc * 32 + 4 * fq;
#pragma unroll
        for (int ai = 0; ai < 2; ++ai)
#pragma unroll
            for (int m = 0; m < 4; ++m) { const int row = row0 + ai * HALF + m * 16; const size_t off = (size_t)row * ldc + col0; float ss = 0.f;
#pragma unroll
                for (int bj = 0; bj < 2; ++bj)
#pragma unroll
                    for (int n = 0; n < 2; ++n) { const f32x4 r = *(const f32x4*)(R + off + bj * HALF + n * 16); const f32x4 v = acc[ai][bj][m][n] + r;
                        *(f32x4*)(C + off + bj * HALF + n * 16) = v;
                        if (XB) { u32x2 w; w.x = cvt_pk_bf16(v[0], v[1]); w.y = cvt_pk_bf16(v[2], v[3]); *(u32x2*)(XB + off + bj * HALF + n * 16) = w; }
                        ss += v[0] * v[0] + v[1] * v[1] + v[2] * v[2] + v[3] * v[3]; }
                if (ssq) { ss += shx(ss, 16); ss += shx(ss, 32); if (fq == 0) ssq[(size_t)row * 32 + u.pn * 4 + wc] = ss; } }
    }
};
template <class Epi, class Sched, bool STAMP = false>
__device__ __forceinline__ void gemm_phase(PG8_LAS unsigned char* lds, const Gemm g, const Sched& S, const Epi& E, unsigned long long* stamps) {
    const int tid = TIDX(), wid = __builtin_amdgcn_readfirstlane(tid >> 6), lane = tid & 63, wr = wid >> 2, wc = wid & 3, fr = lane & 15, fq = lane >> 4;
    const int K = g.K, nt = K / BK;
    int ts_lo = 0, ts_hi = 0, nts = 0; const unsigned long long rt_entry = STAMP ? (unsigned long long)wall_clock64() : 0ull;
#define PG8_STAMP() do { if (STAMP && wid == 0 && nts < 64) { const unsigned long long _c = (unsigned long long)clock64(); \
        ts_lo = (lane == nts) ? (int)(unsigned)_c : ts_lo; ts_hi = (lane == nts) ? (int)(unsigned)(_c >> 32) : ts_hi; ++nts; } } while (0)
    PG8_STAMP();
    unsigned voffA[2], voffB[2];
#pragma unroll
    for (int i = 0; i < 2; ++i) { int R, C; stage_rc(tid * 16 + i * 8192, R, C); const int Rb = Epi::PERM ? ((R & ~31) + perm32(R & 31)) : R;
        voffA[i] = (unsigned)(R * K + C) * 2u; voffB[i] = (unsigned)(Rb * K + C) * 2u; }
    const size_t kstep = (size_t)(BK * 2);
    const size_t hstep = (size_t)HALF * K * 2;
    const size_t tstep = 2 * hstep;
    const unsigned ldsw = (unsigned)wid * 1024u;
    const int aoff = lds_byte(wr * 64 + fr, fq * 8), boff = lds_byte(wc * 32 + fr, fq * 8);
#define PG8_SA(b, h) (((b) * 2 + (h)) * HTB)
#define PG8_SB(b, h) ((4 + (b) * 2 + (h)) * HTB)
#define PG8_STAGE(bufoff, gbase, voff) do { _Pragma("unroll") for (int _i = 0; _i < 2; ++_i) \
        __builtin_amdgcn_global_load_lds((const unsigned*)((const char*)(gbase) + (voff)[_i]), (PG8_LAS unsigned*)(lds + (bufoff) + ldsw + _i * 8192), 16, 0, 0); } while (0)
#define PG8_LDA(dst, b, h) do { _Pragma("unroll") for (int m = 0; m < 4; ++m) _Pragma("unroll") for (int k = 0; k < 2; ++k) dst[m][k] = *(const PG8_LAS bf16x8*)(lds + PG8_SA(b, h) + aoff + m * 2048 + k * 1024); } while (0)
#define PG8_LDB(dst, b, h) do { _Pragma("unroll") for (int n = 0; n < 2; ++n) _Pragma("unroll") for (int k = 0; k < 2; ++k) dst[n][k] = *(const PG8_LAS bf16x8*)(lds + PG8_SB(b, h) + boff + n * 2048 + k * 1024); } while (0)
#define PG8_MMA(ai, bj, At, Bt) do { __builtin_amdgcn_s_setprio(1); _Pragma("unroll") for (int m = 0; m < 4; ++m) _Pragma("unroll") for (int n = 0; n < 2; ++n) _Pragma("unroll") for (int k = 0; k < 2; ++k) \
        acc[ai][bj][m][n] = __builtin_amdgcn_mfma_f32_16x16x32_bf16(Bt[n][k], At[m][k], acc[ai][bj][m][n], 0, 0, 0); __builtin_amdgcn_s_setprio(0); } while (0)
#define PG8_WAIT_V(n) asm volatile("s_waitcnt vmcnt(" #n ")" ::: "memory")
#define PG8_WAIT_L(n) asm volatile("s_waitcnt lgkmcnt(" #n ")" ::: "memory")
#define PG8_BAR __builtin_amdgcn_s_barrier()
#define PG8_SCHED __builtin_amdgcn_sched_barrier(0)
    Unit cur, nxt; int ui = 0;
    if (!S.next(0, cur)) return;
    f32x4 acc[2][2][4][2];
#pragma unroll
    for (int a = 0; a < 2; ++a)
#pragma unroll
        for (int b = 0; b < 2; ++b)
#pragma unroll
            for (int m = 0; m < 4; ++m)
#pragma unroll
                for (int n = 0; n < 2; ++n) acc[a][b][m][n] = (f32x4){0.f, 0.f, 0.f, 0.f};
    bf16x8 At[4][2], B0[2][2], B1[2][2];
    const char* cA = (const char*)g.A + (size_t)cur.pm * tstep; const char* cB = (const char*)g.Bt + (size_t)cur.pn * tstep;
    S.a_ready(cur);
    PG8_STAGE(PG8_SB(0, 0), cB, voffB); PG8_STAGE(PG8_SA(0, 0), cA, voffA); PG8_STAGE(PG8_SB(0, 1), cB + hstep, voffB); PG8_STAGE(PG8_SA(0, 1), cA + hstep, voffA);
    if (wr == 1) PG8_BAR;
    PG8_WAIT_V(4); PG8_BAR;
    PG8_STAGE(PG8_SB(1, 0), cB + kstep, voffB); PG8_STAGE(PG8_SA(1, 0), cA + kstep, voffA); PG8_STAGE(PG8_SB(1, 1), cB + hstep + kstep, voffB);
    PG8_WAIT_V(6); PG8_BAR;
    PG8_STAMP();
    for (;;) {
        const bool has_next = S.next(ui + 1, nxt);
        const char* nA = has_next ? (const char*)g.A + (size_t)nxt.pm * tstep : cA; const char* nB = has_next ? (const char*)g.Bt + (size_t)nxt.pn * tstep : cB;
        for (int t = 0; t < nt; t += 2) {
            const bool last = (t == nt - 2);
            const char* a1 = cA + (size_t)(t + 1) * kstep;
            const char* a2 = last ? nA : cA + (size_t)(t + 2) * kstep; const char* b2 = last ? nB : cB + (size_t)(t + 2) * kstep;
            const char* a3 = a2 + kstep; const char* b3 = b2 + kstep;
            if (last && has_next) S.a_ready(nxt);
            PG8_LDB(B0, 0, 0); PG8_SCHED; PG8_LDA(At, 0, 0); PG8_STAGE(PG8_SA(1, 1), a1 + hstep, voffA);
            PG8_WAIT_L(8); PG8_BAR; PG8_WAIT_L(0); PG8_MMA(0, 0, At, B0); PG8_BAR; PG8_SCHED;
            PG8_LDB(B1, 0, 1); PG8_STAGE(PG8_SB(0, 0), b2, voffB);
            PG8_BAR; PG8_WAIT_L(0); PG8_MMA(0, 1, At, B1); PG8_BAR;
            PG8_LDA(At, 0, 1); PG8_STAGE(PG8_SA(0, 0), a2, voffA);
            PG8_BAR; PG8_WAIT_L(0); PG8_MMA(1, 0, At, B0); PG8_BAR; PG8_SCHED;
            PG8_STAGE(PG8_SB(0, 1), b2 + hstep, voffB);
            PG8_WAIT_V(6); PG8_BAR; PG8_MMA(1, 1, At, B1); PG8_BAR;
            PG8_LDB(B0, 1, 0); PG8_SCHED; PG8_LDA(At, 1, 0); PG8_STAGE(PG8_SA(0, 1), a2 + hstep, voffA);
            PG8_WAIT_L(8); PG8_BAR; PG8_WAIT_L(0); PG8_MMA(0, 0, At, B0); PG8_BAR; PG8_SCHED;
            PG8_LDB(B1, 1, 1); PG8_STAGE(PG8_SB(1, 0), b3, voffB);
            PG8_BAR; PG8_WAIT_L(0); PG8_MMA(0, 1, At, B1); PG8_BAR;
            PG8_LDA(At, 1, 1); PG8_STAGE(PG8_SA(1, 0), a3, voffA);
            PG8_BAR; PG8_WAIT_L(0); PG8_MMA(1, 0, At, B0); PG8_BAR; PG8_SCHED;
            PG8_STAGE(PG8_SB(1, 1), b3 + hstep, voffB);
            PG8_WAIT_V(6); PG8_BAR; PG8_MMA(1, 1, At, B1); PG8_BAR;
        }
        PG8_STAMP();
        if constexpr (!Epi::AFTER_DRAIN) { E(acc, cur, wr, wc, fr, fq); S.done(cur); }
        PG8_STAMP();
        if (!has_next) break;
#pragma unroll
        for (int a = 0; a < 2; ++a)
#pragma unroll
            for (int b = 0; b < 2; ++b)
#pragma unroll
                for (int m = 0; m < 4; ++m)
#pragma unroll
                    for (int n = 0; n < 2; ++n) acc[a][b][m][n] = (f32x4){0.f, 0.f, 0.f, 0.f};
        cur = nxt; cA = nA; cB = nB; ++ui;
    }
    PG8_WAIT_V(0);
    if (wr == 0) PG8_BAR;
    PG8_BAR;
    if constexpr (Epi::AFTER_DRAIN) { E.fused(acc, cur, wr, wc, fr, fq, lds, wid, lane); S.done(cur); }
    PG8_STAMP();
    if (STAMP && wid == 0) { stamps[lane] = lane < nts ? (((unsigned long long)(unsigned)ts_hi << 32) | (unsigned)ts_lo) : 0ull;
        if (lane == 62) stamps[62] = rt_entry; if (lane == 63) stamps[63] = (unsigned long long)wall_clock64(); }
#undef PG8_STAMP
#undef PG8_SA
#undef PG8_SB
#undef PG8_STAGE
#undef PG8_LDA
#undef PG8_LDB
#undef PG8_MMA
#undef PG8_WAIT_V
#undef PG8_WAIT_L
#undef PG8_BAR
#undef PG8_SCHED
}
}
namespace att {
constexpr int D = 128, NW = 8, QBLK = 32, KVBLK = 64;
constexpr float SCALE = 0.088388347648318440f, THR = 8.f;
constexpr int SHM_V = KVBLK * D * 2, SHM_K = KVBLK * D * 2, SHM_ATTN = 2 * SHM_V + 2 * SHM_K + NW * 64 * 4;
#define KSWZ(row, colB) ((row) * 256 + ((colB) ^ (((row) & 7) << 4)))
#define SBAR() __builtin_amdgcn_sched_barrier(0)
__device__ __forceinline__ int crow(int r, int hi) { return (r & 3) + 8 * (r >> 2) + 4 * hi; }
__device__ __forceinline__ unsigned cvtpk(float lo, float hi) { unsigned r; asm volatile("v_cvt_pk_bf16_f32 %0, %1, %2" : "=v"(r) : "v"(lo), "v"(hi)); return r; }

template <bool MASKED>
__device__ __forceinline__ void partialSM(f32x16& p0, f32x16& p1, float& m_reg, float& mn, float& alpha, unsigned long long mw, int hi) {
  constexpr float C = SCALE * 1.4426950408889634f;
  float pmax = p0[0];
#pragma unroll
  for (int r = 1; r < 16; ++r) pmax = fmaxf(pmax, p0[r]);
#pragma unroll
  for (int r = 0; r < 16; ++r) pmax = fmaxf(pmax, p1[r]);
  { auto rr = __builtin_amdgcn_permlane32_swap(__float_as_uint(pmax), __float_as_uint(pmax), false, false);
    pmax = fmaxf(__uint_as_float(rr[0]), __uint_as_float(rr[1])); }
  if (__builtin_expect(__all(pmax - m_reg <= THR / SCALE), 1)) { mn = m_reg; alpha = 1.f; }
  else { mn = fmaxf(m_reg, pmax); alpha = __builtin_amdgcn_exp2f((m_reg - mn) * C); m_reg = mn; }
  const float mnC = -mn * C;
#pragma unroll
  for (int r = 0; r < 16; ++r) p0[r] = fmaf(p0[r], C, mnC);
#pragma unroll
  for (int r = 0; r < 16; ++r) p1[r] = fmaf(p1[r], C, mnC);
#pragma unroll
  for (int r = 0; r < 16; ++r) p0[r] = __builtin_amdgcn_exp2f(p0[r]);
}
__device__ __forceinline__ void finishSM(f32x16& p0, f32x16& p1, float alpha, float& l_reg, bf16x8& pa0, bf16x8& pa1, bf16x8& pa2, bf16x8& pa3) {
#pragma unroll
  for (int r = 0; r < 16; ++r) p1[r] = __builtin_amdgcn_exp2f(p1[r]);
  float ps = 0;
#pragma unroll
  for (int r = 0; r < 16; ++r) ps += p0[r];
#pragma unroll
  for (int r = 0; r < 16; ++r) ps += p1[r];
  { auto rr = __builtin_amdgcn_permlane32_swap(__float_as_uint(ps), __float_as_uint(ps), false, false);
    ps = __uint_as_float(rr[0]) + __uint_as_float(rr[1]); }
  l_reg = l_reg * alpha + ps;
#define PK4(P, BASE, OUT) do { unsigned a0 = cvtpk(P[BASE + 0], P[BASE + 1]), a1 = cvtpk(P[BASE + 2], P[BASE + 3]);   \
    unsigned b0 = cvtpk(P[BASE + 4], P[BASE + 5]), b1 = cvtpk(P[BASE + 6], P[BASE + 7]);                              \
    auto r0 = __builtin_amdgcn_permlane32_swap(a0, b0, false, false); auto r1 = __builtin_amdgcn_permlane32_swap(a1, b1, false, false); \
    u32x4 w = {r0[0], r1[0], r0[1], r1[1]}; OUT = *reinterpret_cast<bf16x8*>(&w); } while (0)
  PK4(p0, 0, pa0); PK4(p0, 8, pa1); PK4(p1, 0, pa2); PK4(p1, 8, pa3);
#undef PK4
}
template <int R> __device__ __forceinline__ float mask_bias(unsigned nw) {
  unsigned t; constexpr int bit = (R & 3) + 8 * (R >> 2);
  asm("v_bfe_i32 %0, %1, %2, 1\n\tv_and_b32 %0, 0xff800000, %0" : "=v"(t) : "v"(nw), "n"(bit));
  return __uint_as_float(t);
}
template <bool MASKED>
__device__ __forceinline__ void qkt(f32x16& p0, f32x16& p1, const char* Ks, const bf16x8* qr, int r32, int hi, unsigned long long mw) {
  if (MASKED) {
    const unsigned n0 = ~((unsigned)mw >> (4 * hi)), n1 = ~((unsigned)(mw >> 32) >> (4 * hi));
#define MB_(R) p0[R] = mask_bias<R>(n0); p1[R] = mask_bias<R>(n1);
    MB_(0) MB_(1) MB_(2) MB_(3) MB_(4) MB_(5) MB_(6) MB_(7) MB_(8) MB_(9) MB_(10) MB_(11) MB_(12) MB_(13) MB_(14) MB_(15)
#undef MB_
  } else { p0 = f32x16{}; p1 = f32x16{}; }
  asm volatile("" : "+v"(p0), "+v"(p1));
#pragma unroll
  for (int d0 = 0; d0 < 8; ++d0) { const int cb = (d0 * 16 + hi * 8) * 2;
    bf16x8 b0 = *reinterpret_cast<const bf16x8*>(Ks + KSWZ(r32, cb));
    bf16x8 b1 = *reinterpret_cast<const bf16x8*>(Ks + KSWZ(32 + r32, cb));
    p0 = __builtin_amdgcn_mfma_f32_32x32x16_bf16(b0, qr[d0], p0, 0, 0, 0);
    p1 = __builtin_amdgcn_mfma_f32_32x32x16_bf16(b1, qr[d0], p1, 0, 0, 0); }
}
__device__ __forceinline__ int v_st(int k, int c) { const int kk = (k & ~0xC) | ((k & 4) << 1) | ((k & 8) >> 1); return ((kk >> 3) * 4 + (c >> 5)) * 512 + ((kk & 7) * 32 + (c & 31)) * 2; }
__device__ __forceinline__ int v_rd_base(int lane) { return ((lane & 3) << 3) | (((lane >> 2) & 3) << 6) | (((lane >> 4) & 1) << 5) | (((lane >> 5) & 1) << 8); }
constexpr int v_rd_off(int d0, int ks, int half) { return d0 * 512 + ks * 4096 + half * 2048; }
template <int OFF> __device__ __forceinline__ s16x4 tr_read(int vb) {
  s16x4 r; asm volatile("ds_read_b64_tr_b16 %0, %1 offset:%2" : "=&v"(r) : "v"(vb), "i"(OFF) : "memory"); return r;
}
template <int D0> __device__ __forceinline__ void pv_one(f32x16& od, int vb, bf16x8 pa0, bf16x8 pa1, bf16x8 pa2, bf16x8 pa3) {
  const s16x4 l0 = tr_read<v_rd_off(D0, 0, 0)>(vb), h0 = tr_read<v_rd_off(D0, 0, 1)>(vb), l1 = tr_read<v_rd_off(D0, 1, 0)>(vb), h1 = tr_read<v_rd_off(D0, 1, 1)>(vb);
  const s16x4 l2 = tr_read<v_rd_off(D0, 2, 0)>(vb), h2 = tr_read<v_rd_off(D0, 2, 1)>(vb), l3 = tr_read<v_rd_off(D0, 3, 0)>(vb), h3 = tr_read<v_rd_off(D0, 3, 1)>(vb);
  asm volatile("s_waitcnt lgkmcnt(0)" ::: "memory"); SBAR();
#define PK(L, H) (bf16x8){L[0], L[1], L[2], L[3], H[0], H[1], H[2], H[3]}
  od = __builtin_amdgcn_mfma_f32_32x32x16_bf16(pa0, PK(l0, h0), od, 0, 0, 0);
  od = __builtin_amdgcn_mfma_f32_32x32x16_bf16(pa1, PK(l1, h1), od, 0, 0, 0);
  od = __builtin_amdgcn_mfma_f32_32x32x16_bf16(pa2, PK(l2, h2), od, 0, 0, 0);
  od = __builtin_amdgcn_mfma_f32_32x32x16_bf16(pa3, PK(l3, h3), od, 0, 0, 0);
#undef PK
}
__device__ __forceinline__ void pv_d0(f32x16* o, int vb, bf16x8 pa0, bf16x8 pa1, bf16x8 pa2, bf16x8 pa3) {
  pv_one<0>(o[0], vb, pa0, pa1, pa2, pa3); pv_one<1>(o[1], vb, pa0, pa1, pa2, pa3); pv_one<2>(o[2], vb, pa0, pa1, pa2, pa3); pv_one<3>(o[3], vb, pa0, pa1, pa2, pa3);
}

template <bool MASKED, int LDK, int VOFF, int QT, class OutRow>
__device__ __forceinline__ void attn_body(const bf16_t* __restrict__ Qw, const float* __restrict__ qgain, const float* __restrict__ qcs, const bf16_t* __restrict__ Kh, int NT,
                                          const unsigned long long* __restrict__ mbase, unsigned moff, const OutRow& Ow, char* lds) {
  const int tid = TIDX(), wid = tid >> 6, lane = tid & 63, r32 = lane & 31, hi = lane >> 5;
  char* V_lds = lds; char* K_lds = lds + 2 * SHM_V;
  float* ws = (float*)(lds + 2 * SHM_V + 2 * SHM_K) + wid * 64; float* li_l = ws; float* al_l = ws + 32;
  float m_reg = -1e30f, l_reg = 0; f32x16 o[4] = {}; bf16x8 qr[8];
  asm volatile("" : "+v"(o[0]), "+v"(o[1]), "+v"(o[2]), "+v"(o[3]));
#pragma unroll
  for (int d0 = 0; d0 < 8; ++d0) qr[d0] = *reinterpret_cast<const bf16x8*>(Qw + d0 * 16);
  if (QT) {
    float ss = 0.f;
#pragma unroll
    for (int d0 = 0; d0 < 8; ++d0)
#pragma unroll
      for (int j = 0; j < 8; ++j) { const float x = bf2f((bf16_t)qr[d0][j]); ss += x * x; }
    { auto rr = __builtin_amdgcn_permlane32_swap(__float_as_uint(ss), __float_as_uint(ss), false, false); ss = __uint_as_float(rr[0]) + __uint_as_float(rr[1]); }
    const float rn = rsqrtf(ss * (1.f / 128.f) + EPS);
    float x01[2][8];
#pragma unroll
    for (int d0 = 0; d0 < 8; ++d0) { const f32x4 g0 = *(const f32x4*)(qgain + d0 * 16 + hi * 8), g1 = *(const f32x4*)(qgain + d0 * 16 + hi * 8 + 4);
      float x[8];
#pragma unroll
      for (int j = 0; j < 8; ++j) x[j] = bf2f((bf16_t)qr[d0][j]) * rn * (j < 4 ? g0[j] : g1[j - 4]);
      if (QT == 2 && d0 < 2) {
#pragma unroll
        for (int j = 0; j < 8; ++j) x01[d0][j] = x[j];
      } else { u32x4 w = {cvtpk(x[0], x[1]), cvtpk(x[2], x[3]), cvtpk(x[4], x[5]), cvtpk(x[6], x[7])}; qr[d0] = *reinterpret_cast<bf16x8*>(&w); } }
    if (QT == 2) {
      float a[8], b[8];
#pragma unroll
      for (int j2 = 0; j2 < 4; ++j2) { const f32x4 cs = *(const f32x4*)(qcs + hi * 16 + 4 * j2);
#pragma unroll
        for (int q = 0; q < 2; ++q) { const int j = 2 * j2 + q; const float c = cs[2 * q], sn = cs[2 * q + 1], x1 = x01[0][j], x2 = x01[1][j]; a[j] = x1 * c - x2 * sn; b[j] = x2 * c + x1 * sn; } }
      { u32x4 w = {cvtpk(a[0], a[1]), cvtpk(a[2], a[3]), cvtpk(a[4], a[5]), cvtpk(a[6], a[7])}; qr[0] = *reinterpret_cast<bf16x8*>(&w); }
      { u32x4 w = {cvtpk(b[0], b[1]), cvtpk(b[2], b[3]), cvtpk(b[4], b[5]), cvtpk(b[6], b[7])}; qr[1] = *reinterpret_cast<bf16x8*>(&w); }
    }
  }
  const int sr = tid >> 4, sc = (tid & 15) * 8, vst0 = v_st(sr, sc), vst1 = v_st(32 + sr, sc);
  const int vb0 = (int)(uintptr_t)V_lds + v_rd_base(lane);
  struct { bf16x8 vs0, vs1, ks0, ks1; } sr_[2];
  const unsigned koff = (unsigned)(sr * LDK + sc) * 2u;
#define SLOAD(i, k0) do { const char* kb_ = (const char*)Kh + (size_t)(k0) * (LDK * 2); \
    sr_[i].vs0 = *reinterpret_cast<const bf16x8*>(kb_ + koff + VOFF * 2); sr_[i].vs1 = *reinterpret_cast<const bf16x8*>(kb_ + koff + (32 * LDK + VOFF) * 2); \
    sr_[i].ks0 = *reinterpret_cast<const bf16x8*>(kb_ + koff); sr_[i].ks1 = *reinterpret_cast<const bf16x8*>(kb_ + koff + 32 * LDK * 2); } while (0)
#define SWRITE(b, i) do { *(bf16x8*)(V_lds + (b) * SHM_V + vst0) = sr_[i].vs0;          \
    *(bf16x8*)(V_lds + (b) * SHM_V + vst1) = sr_[i].vs1; int kc = sc * 2;               \
    *(bf16x8*)(K_lds + (b) * SHM_K + KSWZ(sr, kc)) = sr_[i].ks0;                       \
    *(bf16x8*)(K_lds + (b) * SHM_K + KSWZ(32 + sr, kc)) = sr_[i].ks1; } while (0)
#define SWAIT() asm volatile("s_waitcnt vmcnt(4)" ::: "memory")
#define RESC(a) do { if (__any((a) < 1.f)) { if (hi == 0) al_l[r32] = (a); asm volatile("s_waitcnt lgkmcnt(0)" ::: "memory"); \
    _Pragma("unroll") for (int d = 0; d < 4; ++d) _Pragma("unroll") for (int r = 0; r < 16; ++r) o[d][r] *= al_l[crow(r, hi)]; } } while (0)
  f32x16 pA0, pA1, pB0, pB1; float mnA, mnB, alA, alB; bf16x8 pa0, pa1, pa2, pa3;
  unsigned long long mw = 0ull;
  constexpr int SE = 0, SO = 1;
  if (MASKED) mw = *(const unsigned long long*)((const char*)mbase + moff);
  SLOAD(SE, 0); asm volatile("s_waitcnt vmcnt(0)" ::: "memory"); SWRITE(0, SE); __syncthreads();
  qkt<MASKED>(pA0, pA1, K_lds, qr, r32, hi, mw);
  if (MASKED) mw = *(const unsigned long long*)((const char*)mbase + (moff + 8u));
  partialSM<MASKED>(pA0, pA1, m_reg, mnA, alA, mw, hi);
  SLOAD(SO, KVBLK); SLOAD(SE, (2 < NT ? 2 : NT - 1) * KVBLK);
  SWAIT();
  SWRITE(1, SO); __syncthreads();
  for (int j = 1; j + 1 < NT; j += 2) {
    SBAR(); qkt<MASKED>(pB0, pB1, K_lds + SHM_K, qr, r32, hi, mw);
    if (MASKED) mw = *(const unsigned long long*)((const char*)mbase + (moff + 8u * (unsigned)(j + 1)));
    finishSM(pA0, pA1, alA, l_reg, pa0, pa1, pa2, pa3); SBAR();
    SLOAD(SO, (j + 2) * KVBLK); SBAR();
    pv_d0(o, vb0, pa0, pa1, pa2, pa3); partialSM<MASKED>(pB0, pB1, m_reg, mnB, alB, mw, hi);
    __syncthreads(); if (MASKED) asm volatile("s_waitcnt vmcnt(5)" ::: "memory"); else SWAIT();
    SWRITE(0, SE);
    RESC(alB); __syncthreads();
    SBAR(); qkt<MASKED>(pA0, pA1, K_lds, qr, r32, hi, mw);
    if (MASKED) mw = *(const unsigned long long*)((const char*)mbase + (moff + 8u * (unsigned)(j + 2)));
    finishSM(pB0, pB1, alB, l_reg, pa0, pa1, pa2, pa3); SBAR();
    SLOAD(SE, (j + 3 < NT ? j + 3 : NT - 1) * KVBLK); SBAR();
    pv_d0(o, vb0 + SHM_V, pa0, pa1, pa2, pa3); partialSM<MASKED>(pA0, pA1, m_reg, mnA, alA, mw, hi);
    __syncthreads(); if (MASKED) asm volatile("s_waitcnt vmcnt(5)" ::: "memory"); else SWAIT();
    SWRITE(1, SO);
    RESC(alA); __syncthreads();
  }
  SBAR(); qkt<MASKED>(pB0, pB1, K_lds + SHM_K, qr, r32, hi, mw);
  finishSM(pA0, pA1, alA, l_reg, pa0, pa1, pa2, pa3); SBAR();
  pv_d0(o, vb0, pa0, pa1, pa2, pa3); partialSM<MASKED>(pB0, pB1, m_reg, mnB, alB, mw, hi);
  __syncthreads(); RESC(alB);
  finishSM(pB0, pB1, alB, l_reg, pa0, pa1, pa2, pa3); SBAR();
  pv_d0(o, vb0 + SHM_V, pa0, pa1, pa2, pa3);
  if (hi == 0) li_l[r32] = l_reg; asm volatile("s_waitcnt lgkmcnt(0)" ::: "memory");
  float rli[16];
#pragma unroll
  for (int r = 0; r < 16; ++r) rli[r] = __builtin_amdgcn_rcpf(li_l[crow(r, hi)]);
  __syncthreads();
  float* og_s = (float*)lds + wid * (32 * 132);
#pragma unroll
  for (int r = 0; r < 16; ++r) {
#pragma unroll
    for (int d0 = 0; d0 < 4; ++d0) og_s[crow(r, hi) * 132 + d0 * 32 + r32] = o[d0][r] * rli[r]; }
  asm volatile("" ::: "memory");
  { const int row = lane >> 1, half = lane & 1; const float* src = og_s + row * 132 + half * 64;
    f32x4 v[16]; float ss = 0.f;
#pragma unroll
    for (int i = 0; i < 16; ++i) { v[i] = *(const f32x4*)(src + 4 * i); ss += v[i][0] * v[i][0] + v[i][1] * v[i][1] + v[i][2] * v[i][2] + v[i][3] * v[i][3]; }
    ss += shx(ss, 1);
    const float rn = rsqrtf(ss * (1.f / 128.f) + EPS);
    const bf16_t* zp = Ow.zrow(row) + half * 64; bf16_t* gp = Ow.grow(row) + half * 64;
#pragma unroll
    for (int i = 0; i < 8; ++i) { float z[8], g[8]; ld8f(zp + 8 * i, z);
#pragma unroll
      for (int q = 0; q < 4; ++q) { g[q] = v[2 * i][q] * rn * siluf_(z[q]); g[4 + q] = v[2 * i + 1][q] * rn * siluf_(z[4 + q]); }
      st8f(gp + 8 * i, g); } }
  __syncthreads();
#undef SLOAD
#undef SWRITE
#undef SWAIT
#undef RESC
}
}
constexpr size_t al256(size_t x) { return (x + 255) / 256 * 256; }
constexpr size_t WS_CTL   = 0;
constexpr size_t CTL_BYTES = 65536;
constexpr size_t WS_WINT  = WS_CTL + CTL_BYTES;
constexpr size_t WS_WOUTT = WS_WINT + al256((size_t)DEPTH * NPAD * DM * 2);
constexpr size_t WS_WKVT  = WS_WOUTT + al256((size_t)DEPTH * DM * MIX * 2);
constexpr size_t WS_WGLUT = WS_WKVT + al256((size_t)DEPTH * 1024 * DM * 2);
constexpr size_t WS_MEMN  = WS_WGLUT + al256((size_t)DEPTH * 512 * 512 * 2);
constexpr size_t WS_KVMEM = WS_MEMN + al256((size_t)NB * MEML * DM * 2);
constexpr size_t WS_XN    = WS_KVMEM + al256((size_t)NB * MEML * DEPTH * 1024 * 2);
constexpr size_t WS_P     = WS_XN + al256((size_t)NTOK * DM * 2);
constexpr size_t WS_XBUF  = WS_P + al256((size_t)NTOK * NPAD * 2);
constexpr size_t WS_OCAT  = WS_XBUF + al256((size_t)NTOK * DM * 4);
constexpr size_t WS_MASK  = WS_OCAT + al256((size_t)NTOK * MIX * 2);
constexpr size_t WS_IW    = WS_MASK + al256((size_t)NTOK * 64 * 8);
constexpr size_t WS_YBUF  = WS_IW + al256((size_t)NTOK * 16 * 4);
constexpr size_t WS_ROPE  = WS_YBUF + al256((size_t)NTOK * 512 * 2);
constexpr size_t WS_S5P   = WS_ROPE + al256((size_t)NTOK * 48 * 4);
constexpr size_t S5P_BYTES = (size_t)DEPTH * 32 * (64 * 2 + 64 * 2 + 64 * 16 * 2) * 4;
constexpr size_t WS_GLAS  = WS_S5P + al256(S5P_BYTES);
constexpr size_t WS_GLAD  = WS_GLAS + al256((size_t)NB * 64 * 4 * 64 * 128 * 4);
constexpr size_t WS_IKC   = WS_GLAD + al256((size_t)NB * 64 * 4 * 64 * 4);
constexpr size_t WS_KVC   = WS_IKC + al256((size_t)NTOK * 64 * 2);
constexpr size_t WS_IQL   = WS_KVC + al256((size_t)NTOK * 256 * 2);
constexpr size_t WS_SSQ   = WS_IQL + al256((size_t)NTOK * 64 * 2);
constexpr size_t DSP_SLOT = (size_t)(256 * 128 + 512) * 4;
constexpr size_t WS_DSP   = WS_SSQ + 256;
constexpr size_t WS_END   = WS_DSP + al256((size_t)160 * 2 * DSP_SLOT);

struct Params {
    const float* x; const float* mem; const int* pos; const float* ln_gain; const float* w_in; const float* gla_w_up; const float* gla_b_up;
    const float* s5_a_re; const float* s5_a_im; const float* s5_log_step; const float* s5_b_re; const float* s5_b_im; const float* s5_c_re; const float* s5_c_im;
    const float* s5_d; const float* s5_w_glu; const float* dsa_q_norm; const float* dsa_k_norm; const float* mem_norm; const float* w_mem_kv;
    const float* mem_q_norm; const float* mem_k_norm; const float* out_norm; const float* w_out;
    float* out;
    char* ws;
    __device__ __forceinline__ unsigned* ctl_() const { return (unsigned*)(ws + WS_CTL); }
    __device__ __forceinline__ bf16_t* WinT_() const { return (bf16_t*)(ws + WS_WINT); }
    __device__ __forceinline__ bf16_t* WoutT_() const { return (bf16_t*)(ws + WS_WOUTT); }
    __device__ __forceinline__ bf16_t* WkvT_() const { return (bf16_t*)(ws + WS_WKVT); }
    __device__ __forceinline__ bf16_t* WgluT_() const { return (bf16_t*)(ws + WS_WGLUT); }
    __device__ __forceinline__ bf16_t* memn_() const { return (bf16_t*)(ws + WS_MEMN); }
    __device__ __forceinline__ bf16_t* kvmem_() const { return (bf16_t*)(ws + WS_KVMEM); }
    __device__ __forceinline__ bf16_t* xn_() const { return (bf16_t*)(ws + WS_XN); }
    __device__ __forceinline__ bf16_t* p_() const { return (bf16_t*)(ws + WS_P); }
    __device__ __forceinline__ bf16_t* xbuf_() const { return (bf16_t*)(ws + WS_XBUF); }
    __device__ __forceinline__ bf16_t* ocat_() const { return (bf16_t*)(ws + WS_OCAT); }
    __device__ __forceinline__ unsigned long long* mask_() const { return (unsigned long long*)(ws + WS_MASK); }
    __device__ __forceinline__ float* iw_() const { return (float*)(ws + WS_IW); }
    __device__ __forceinline__ bf16_t* ybuf_() const { return (bf16_t*)(ws + WS_YBUF); }
    __device__ __forceinline__ float* rope_() const { return (float*)(ws + WS_ROPE); }
    __device__ __forceinline__ float* s5p_() const { return (float*)(ws + WS_S5P); }
    __device__ __forceinline__ float* glas_() const { return (float*)(ws + WS_GLAS); }
    __device__ __forceinline__ float* glad_() const { return (float*)(ws + WS_GLAD); }
    __device__ __forceinline__ bf16_t* ikc_() const { return (bf16_t*)(ws + WS_IKC); }
    __device__ __forceinline__ bf16_t* kvc_() const { return (bf16_t*)(ws + WS_KVC); }
    __device__ __forceinline__ float* ssq_() const { return (float*)(ws + WS_SSQ); }
    __device__ __forceinline__ bf16_t* iql_() const { return (bf16_t*)(ws + WS_IQL); }
    __device__ __forceinline__ char* dsp_() const { return ws + WS_DSP; }
};

__device__ __forceinline__ void transpose_tiles(const float* __restrict__ src, int K, int Nsrc, int Ndst, const float* __restrict__ scale, bf16_t* __restrict__ dst,
                                                int tile, float* lds_tile  ) {
    const int tid = TIDX(), ntn = Ndst / 256;
    const int tk = tile / ntn, tn = tile % ntn, k0 = tk * 64, n0 = tn * 256;
    __syncthreads();
    { const int ty = tid >> 4, tx = tid & 15;
      f32x4 v[2][4];
#pragma unroll
      for (int i = 0; i < 2; ++i)
#pragma unroll
        for (int q = 0; q < 4; ++q) { const int k = k0 + ty + 32 * i, n = n0 + 4 * tx + 64 * q;
          v[i][q] = (f32x4){0.f, 0.f, 0.f, 0.f};
          if (n < Nsrc) v[i][q] = *(const f32x4*)(src + (size_t)k * Nsrc + n); }
#pragma unroll
      for (int i = 0; i < 2; ++i) { const float s = scale ? scale[k0 + ty + 32 * i] : 1.f;
#pragma unroll
        for (int q = 0; q < 4; ++q) { float* t = lds_tile + (ty + 32 * i) * 257 + 4 * tx + 64 * q; t[0] = v[i][q][0] * s; t[1] = v[i][q][1] * s; t[2] = v[i][q][2] * s; t[3] = v[i][q][3] * s; } } }
    __syncthreads();
    { const int n = tid >> 1, kh = (tid & 1) * 32;
#pragma unroll
      for (int j = 0; j < 4; ++j) { const int kb = kh + 8 * j; u32x4 w;
        w.x = pk2bf(lds_tile[(kb + 0) * 257 + n], lds_tile[(kb + 1) * 257 + n]); w.y = pk2bf(lds_tile[(kb + 2) * 257 + n], lds_tile[(kb + 3) * 257 + n]);
        w.z = pk2bf(lds_tile[(kb + 4) * 257 + n], lds_tile[(kb + 5) * 257 + n]); w.w = pk2bf(lds_tile[(kb + 6) * 257 + n], lds_tile[(kb + 7) * 257 + n]);
        *(u32x4*)(dst + (size_t)(n0 + n) * K + k0 + kb) = w; } }
}

__device__ __forceinline__ void rmsnorm_rows(const float* __restrict__ X, bf16_t* __restrict__ Y, int nrows) {
    const int wid = TIDX() >> 6, lane = TIDX() & 63;
    for (int row = blockIdx.x * 8 + wid; row < nrows; row += gridDim.x * 8) {
        const float* xr = X + (size_t)row * DM; f32x4 v[8]; float ss = 0.f;
#pragma unroll
        for (int i = 0; i < 8; ++i) { v[i] = *(const f32x4*)(xr + 4 * lane + 256 * i); ss += v[i][0] * v[i][0] + v[i][1] * v[i][1] + v[i][2] * v[i][2] + v[i][3] * v[i][3]; }
        ss = wave_sum(ss); const float r = rsqrtf(ss * (1.f / DM) + EPS);
        bf16_t* yr = Y + (size_t)row * DM;
#pragma unroll
        for (int i = 0; i < 8; ++i) { u32x2 w; w.x = pk2bf(v[i][0] * r, v[i][1] * r); w.y = pk2bf(v[i][2] * r, v[i][3] * r); *(u32x2*)(yr + 4 * lane + 256 * i) = w; }
    }
}

__device__ __forceinline__ void rmsnorm_rows16(const bf16_t* __restrict__ X, bf16_t* __restrict__ Y, int nrows) {
    const int wid = TIDX() >> 6, lane = TIDX() & 63;
    for (int row = blockIdx.x * 8 + wid; row < nrows; row += gridDim.x * 8) {
        const bf16_t* xr = X + (size_t)row * DM; float v[4][8]; float ss = 0.f;
#pragma unroll
        for (int i = 0; i < 4; ++i) { ld8f(xr + 8 * lane + 512 * i, v[i]);
#pragma unroll
            for (int j = 0; j < 8; ++j) ss += v[i][j] * v[i][j]; }
        ss = wave_sum(ss); const float r = rsqrtf(ss * (1.f / DM) + EPS);
        bf16_t* yr = Y + (size_t)row * DM;
#pragma unroll
        for (int i = 0; i < 4; ++i) { float o[8];
#pragma unroll
            for (int j = 0; j < 8; ++j) o[j] = v[i][j] * r;
            st8f(yr + 8 * lane + 512 * i, o); }
    }
}

__device__ __forceinline__ void rows_bf16_ssq(const float* __restrict__ X, bf16_t* __restrict__ Y, float* __restrict__ ssq, int nrows) {
    const int wid = TIDX() >> 6, lane = TIDX() & 63;
    for (int row = blockIdx.x * 8 + wid; row < nrows; row += gridDim.x * 8) {
        const float* xr = X + (size_t)row * DM; bf16_t* yr = Y + (size_t)row * DM; float ss = 0.f;
#pragma unroll
        for (int i = 0; i < 8; ++i) { const f32x4 v = *(const f32x4*)(xr + 4 * lane + 256 * i); ss += v[0] * v[0] + v[1] * v[1] + v[2] * v[2] + v[3] * v[3];
            u32x2 w; w.x = pk2bf(v[0], v[1]); w.y = pk2bf(v[2], v[3]); *(u32x2*)(yr + 4 * lane + 256 * i) = w; }
        ss = wave_sum(ss); if (lane < 32) ssq[(size_t)row * 32 + lane] = (lane == 0) ? ss : 0.f;
    }
}
__device__ __forceinline__ void phase_prologue1(const Params& P, char* lds) {
    float* tile = (float*)lds;
    constexpr int T_IN = (DM / 64) * (NPAD / 256), T_OUT = (MIX / 64) * (DM / 256), T_KV = (DM / 64) * (1024 / 256), T_GLU = 8 * 2;
    constexpr int TOT = DEPTH * (T_IN + T_OUT + T_KV + T_GLU);
    for (int u = blockIdx.x; u < TOT; u += gridDim.x) {
        int l = u / (T_IN + T_OUT + T_KV + T_GLU), r = u % (T_IN + T_OUT + T_KV + T_GLU);
        if (r < T_IN) transpose_tiles(P.w_in + (size_t)l * DM * NIN, DM, NIN, NPAD, P.ln_gain + l * DM, P.WinT_() + (size_t)l * NPAD * DM, r, tile);
        else if ((r -= T_IN) < T_OUT) transpose_tiles(P.w_out + (size_t)l * MIX * DM, MIX, DM, DM, P.out_norm + l * MIX, P.WoutT_() + (size_t)l * DM * MIX, r, tile);
        else if ((r -= T_OUT) < T_KV) transpose_tiles(P.w_mem_kv + (size_t)l * DM * 1024, DM, 1024, 1024, P.mem_norm + l * DM, P.WkvT_() + (size_t)l * 1024 * DM, r, tile);
        else { r -= T_KV; transpose_tiles(P.s5_w_glu + (size_t)l * 512 * 512, 512, 512, 512, nullptr, P.WgluT_() + (size_t)l * 512 * 512, r, tile); }
    }
    rmsnorm_rows(P.mem, P.memn_(), NB * MEML);
}
__device__ __forceinline__ void phase_rope_table(const Params& P) {
    for (int idx = blockIdx.x * NTHR + TIDX(); idx < NTOK * 24; idx += gridDim.x * NTHR) {
        const int tok = idx / 24, i = idx % 24;
        const float e = (i < 16) ? -((float)i * 2.0f / 32.0f) : -((float)(i - 16) * 2.0f / 16.0f);
        const float inv_freq = exp2f(e * 18.931568569324174f);
        const float ang = (float)P.pos[tok] * inv_freq;
        const double a = (double)ang; const double k = rint(a * 0.15915494309189535); const float rf = (float)fma(-k, 6.283185307179586, a);
        P.rope_()[(size_t)idx * 2] = cosf(rf); P.rope_()[(size_t)idx * 2 + 1] = sinf(rf);
    }
}

__device__ __forceinline__ void phase_rmsnorm_x(const Params& P, int layer) { if (layer == 0) rmsnorm_rows(P.x, P.xn_(), NTOK); else rmsnorm_rows16(P.xbuf_(), P.xn_(), NTOK); }

__device__ __forceinline__ void phase_memk_norm(const Params& P) {
    const int wid = TIDX() >> 6, lane = TIDX() & 63;
    for (int it = blockIdx.x * 8 + wid; it < NB * MEML * DEPTH * 4; it += gridDim.x * 8) {
        const int row = it / (DEPTH * 4), l = (it / 4) % DEPTH, h = it % 4;
        bf16_t* kp = P.kvmem_() + (size_t)row * (DEPTH * 1024) + l * 1024 + h * 128 + 2 * lane;
        const unsigned w = *(const unsigned*)kp; const float a = __uint_as_float(w << 16), b = __uint_as_float(w & 0xffff0000u);
        const float ss = wave_sum(a * a + b * b), r = rsqrtf(ss * (1.f / 128.f) + EPS);
        const float* g = P.mem_k_norm + l * 128 + 2 * lane;
        *(unsigned*)kp = pk2bf(a * r * g[0], b * r * g[1]);
    }
}

__device__ __forceinline__ float sum16(float v) { v += shx(v, 1); v += shx(v, 2); v += shx(v, 4); v += shx(v, 8); return v; }

__device__ __forceinline__ void head128_norm_rope_to(const bf16_t* hp, bf16_t* dp, int l16, const float* __restrict__ gain, const float* __restrict__ cs, bool rope, bool do_store) {
    float v[8]; ld8f(hp + 8 * l16, v);
    float ss = 0.f;
#pragma unroll
    for (int j = 0; j < 8; ++j) ss += v[j] * v[j];
    ss = sum16(ss); const float r = rsqrtf(ss * (1.f / 128.f) + EPS);
#pragma unroll
    for (int j = 0; j < 8; ++j) v[j] = v[j] * r * gain[8 * l16 + j];
    if (rope) {
        float o[8];
#pragma unroll
        for (int j = 0; j < 8; ++j) o[j] = shx(v[j], 2);
        if (l16 < 4) { const int fi = (l16 & 1) * 8;
#pragma unroll
            for (int j = 0; j < 8; ++j) { const float c = cs[(fi + j) * 2], s = cs[(fi + j) * 2 + 1];
                v[j] = (l16 < 2) ? (v[j] * c - o[j] * s) : (v[j] * c + o[j] * s); } }
    }
    if (do_store) st8f(dp + 8 * l16, v);
}
__device__ __forceinline__ void head128_norm_rope(bf16_t* hp, int l16, const float* __restrict__ gain, const float* __restrict__ cs, bool rope, bool do_store) { head128_norm_rope_to(hp, hp, l16, gain, cs, rope, do_store); }
__device__ __forceinline__ void rope16_inplace(bf16_t* ip, const float* __restrict__ cs) {
    float a[8], b[8]; ld8f(ip, a); ld8f(ip + 8, b);
#pragma unroll
    for (int j = 0; j < 8; ++j) { const float c = cs[2 * j], s = cs[2 * j + 1], x1 = a[j], x2 = b[j]; a[j] = x1 * c - x2 * s; b[j] = x2 * c + x1 * s; }
    st8f(ip, a); st8f(ip + 8, b);
}
struct PrepIn { u32x4 k, i0, i1, ik0, ik1, v; bf16_t w; f32x4 c32[4], c16[4]; };
__device__ __forceinline__ void prep_load(const Params& P, int tok, int lane, PrepIn& I) {
    const int l16 = lane & 15, grp = lane >> 4;
    const bf16_t* row = P.p_() + (size_t)tok * NPAD;
    I.k = *(const u32x4*)(row + C_DK + 8 * l16);
    I.i0 = *(const u32x4*)(row + C_DIQ + (lane >> 2) * 64); I.i1 = *(const u32x4*)(row + C_DIQ + (lane >> 2) * 64 + 8);
    I.ik0 = *(const u32x4*)(row + C_DIK + (lane & 3) * 16); I.ik1 = *(const u32x4*)(row + C_DIK + (lane & 3) * 16 + 8);
    I.v = *(const u32x4*)(row + C_DV + l16 * 8);
    I.w = row[C_DIW + l16];
    const float* cs32 = P.rope_() + (size_t)tok * 48;
#pragma unroll
    for (int i = 0; i < 4; ++i) { I.c32[i] = *(const f32x4*)(cs32 + (l16 & 1) * 16 + 4 * i); I.c16[i] = *(const f32x4*)(cs32 + 32 + 4 * i); }
}
__device__ __forceinline__ void unpack8(const u32x4 w, float (&v)[8]) {
    v[0] = __uint_as_float(w.x << 16); v[1] = __uint_as_float(w.x & 0xffff0000u); v[2] = __uint_as_float(w.y << 16); v[3] = __uint_as_float(w.y & 0xffff0000u);
    v[4] = __uint_as_float(w.z << 16); v[5] = __uint_as_float(w.z & 0xffff0000u); v[6] = __uint_as_float(w.w << 16); v[7] = __uint_as_float(w.w & 0xffff0000u); }
__device__ __forceinline__ void head128_nr(float (&v)[8], int l16, const float (&gain)[8], const f32x4 (&cs)[4], bool rope) {
    float ss = 0.f;
#pragma unroll
    for (int j = 0; j < 8; ++j) ss += v[j] * v[j];
    ss = sum16(ss); const float r = rsqrtf(ss * (1.f / 128.f) + EPS);
#pragma unroll
    for (int j = 0; j < 8; ++j) v[j] = v[j] * r * gain[j];
    if (rope) {
        float o[8];
#pragma unroll
        for (int j = 0; j < 8; ++j) o[j] = shx(v[j], 2);
        if (l16 < 4) {
#pragma unroll
            for (int j = 0; j < 8; ++j) { const float c = cs[j >> 1][(j & 1) * 2], s = cs[j >> 1][(j & 1) * 2 + 1];
                v[j] = (l16 < 2) ? (v[j] * c - o[j] * s) : (v[j] * c + o[j] * s); } }
    }
}
__device__ __forceinline__ void prep_finish(const Params& P, int tok, int lane, const PrepIn& I, const float (&gq)[8], const float (&gk)[8], const float (&gm)[8]) {
    const int l16 = lane & 15, grp = lane >> 4;
    bf16_t* row = P.p_() + (size_t)tok * NPAD;
    float k[8];
    unpack8(I.k, k);
    head128_nr(k, l16, gk, I.c32, true);
    if (grp == 0) st8f(P.kvc_() + (size_t)tok * 256 + 8 * l16, k);
    {
        float a[8], b[8]; unpack8(I.i0, a); unpack8(I.i1, b);
#pragma unroll
        for (int j = 0; j < 8; ++j) { const float c = I.c16[j >> 1][(j & 1) * 2], s = I.c16[j >> 1][(j & 1) * 2 + 1], x1 = a[j], x2 = b[j]; a[j] = x1 * c - x2 * s; b[j] = x2 * c + x1 * s; }
        if ((lane & 3) == 0) { st8f(row + C_DIQ + (lane >> 2) * 64, a); st8f(row + C_DIQ + (lane >> 2) * 64 + 8, b); } }
    {
        float a[8], b[8]; unpack8(I.ik0, a); unpack8(I.ik1, b);
        if ((lane & 3) == 0) {
#pragma unroll
            for (int j = 0; j < 8; ++j) { const float c = I.c16[j >> 1][(j & 1) * 2], s = I.c16[j >> 1][(j & 1) * 2 + 1], x1 = a[j], x2 = b[j]; a[j] = x1 * c - x2 * s; b[j] = x2 * c + x1 * s; } }
        if (lane < 4) { bf16_t* dst = P.ikc_() + (size_t)(tok >> 5) * 2048 + lane * 512 + (tok & 31) * 8; st8f(dst, a); st8f(dst + 256, b); } }
    if (lane >= 16 && lane < 32) *(u32x4*)(P.kvc_() + (size_t)tok * 256 + 128 + l16 * 8) = I.v;
    if (lane < 16) P.iw_()[(size_t)tok * 16 + lane] = bf2f(I.w) * (1.f / 32.f);
}
__device__ __forceinline__ void phase_prep(const Params& P, int layer) {
    const int wid = TIDX() >> 6, lane = TIDX() & 63, l16 = lane & 15;
    float gq[8], gk[8], gm[8];
#pragma unroll
    for (int j = 0; j < 8; ++j) { gq[j] = P.dsa_q_norm[layer * 128 + 8 * l16 + j]; gk[j] = P.dsa_k_norm[layer * 128 + 8 * l16 + j]; gm[j] = P.mem_q_norm[layer * 128 + 8 * l16 + j]; }
    const int stride = gridDim.x * 8;
    for (int tok = blockIdx.x * 8 + wid; tok < NTOK; tok += 2 * stride) {
        const int tok2 = tok + stride; const bool two = tok2 < NTOK;
        PrepIn A, B2;
        prep_load(P, tok, lane, A); prep_load(P, two ? tok2 : tok, lane, B2);
        prep_finish(P, tok, lane, A, gq, gk, gm);
        if (two) prep_finish(P, tok2, lane, B2, gq, gk, gm);
    }
}
struct MemOutRow { const bf16_t* zb; bf16_t* gb;
    __device__ __forceinline__ const bf16_t* zrow(int r) const { return zb + (size_t)r * NPAD; } __device__ __forceinline__ bf16_t* grow(int r) const { return gb + (size_t)r * MIX; } };
__device__ __forceinline__ void unit_mem_attn(const Params& P, int layer, int u, char* lds) {
    const int b = u >> 6, h = (u >> 4) & 3, qb = u & 15, tok0 = b * SEQ + qb * 256;
    const int wid = TIDX() >> 6, lane = TIDX() & 63, r32 = lane & 31, hi = lane >> 5;
    const bf16_t* Qw = P.p_() + (size_t)(tok0 + wid * 32 + r32) * NPAD + C_MQ + h * 128 + hi * 8;
    const bf16_t* Kh = P.kvmem_() + (size_t)(b * MEML) * (DEPTH * 1024) + layer * 1024 + h * 128;
    MemOutRow ow; ow.zb = P.p_() + (size_t)(tok0 + wid * 32) * NPAD + C_MZ + h * 128; ow.gb = P.xn_() + (size_t)(tok0 + wid * 32) * MIX + 1536 + h * 128;
    att::attn_body<false, DEPTH * 1024, 512, 1, MemOutRow>(Qw, P.mem_q_norm + layer * 128, nullptr, Kh, MEML / 64, nullptr, 0u, ow, lds);
}

__device__ __forceinline__ void phase_gate(const Params& P, int c_lo, int c_hi) {
    const int wid = TIDX() >> 6, lane = TIDX() & 63;
    const int c0 = lane * 32;
    const int seg = c0 >> 9, zc = (seg == 0 ? C_GZ : seg == 1 ? C_SZ : seg == 2 ? C_DZ : C_MZ) + (c0 & 511);
    const bool act = (c0 >= c_lo) && (c0 < c_hi);
    for (int tok = blockIdx.x * 8 + wid; tok < NTOK; tok += gridDim.x * 8) {
        if (!act) { bf16_t* gz_ = P.xn_() + (size_t)tok * MIX + c0; const u32x4 zz = {0u, 0u, 0u, 0u};
#pragma unroll
            for (int i = 0; i < 4; ++i) *(u32x4*)(gz_ + 8 * i) = zz;
            continue; }
        const bf16_t* op = P.ocat_() + (size_t)tok * MIX + c0; const bf16_t* zp = P.p_() + (size_t)tok * NPAD + zc; bf16_t* gp = P.xn_() + (size_t)tok * MIX + c0;
        float o[32]; float ss = 0.f;
#pragma unroll
        for (int i = 0; i < 4; ++i) { float v[8]; ld8f(op + 8 * i, v);
#pragma unroll
            for (int j = 0; j < 8; ++j) { o[8 * i + j] = v[j]; ss += v[j] * v[j]; } }
        ss += shx(ss, 1); ss += shx(ss, 2);
        const float r = rsqrtf(ss * (1.f / 128.f) + EPS);
#pragma unroll
        for (int i = 0; i < 4; ++i) { float z[8], g[8]; ld8f(zp + 8 * i, z);
#pragma unroll
            for (int j = 0; j < 8; ++j) g[j] = o[8 * i + j] * r * siluf_(z[j]);
            st8f(gp + 8 * i, g); }
    }
}

__device__ __forceinline__ void phase_gemm_in(const Params& P, int layer, char* lds) {
    pg8::Gemm g; g.A = P.xn_(); g.Bt = P.WinT_() + (size_t)layer * NPAD * DM; g.M = NTOK; g.N = NPAD; g.K = DM;
    pg8::StaticOrder S; S.init(g.M, g.N, (int)gridDim.x, (int)blockIdx.x);
    pg8::EpiBf16Plain E; E.O = P.p_(); E.ldc = NPAD;
    pg8::gemm_phase<pg8::EpiBf16Plain, pg8::StaticOrder, false>((PG8_LAS unsigned char*)lds, g, S, E, nullptr);
}
__device__ __forceinline__ void phase_gemm_out(const Params& P, int layer, char* lds) {
    pg8::Gemm g; g.A = P.xn_(); g.Bt = P.WoutT_() + (size_t)layer * DM * MIX; g.M = NTOK; g.N = DM; g.K = MIX;
    pg8::StaticOrder S; S.init(g.M, g.N, (int)gridDim.x, (int)blockIdx.x);
    pg8::EpiResidMix E; E.R = (layer == 0) ? (const void*)P.x : (const void*)P.xbuf_(); E.C = (layer == DEPTH - 1) ? (void*)P.out : (void*)P.xbuf_(); E.ldc = DM;
    E.r16 = (layer != 0); E.c16 = (layer != DEPTH - 1);
    pg8::gemm_phase<pg8::EpiResidMix, pg8::StaticOrder, false>((PG8_LAS unsigned char*)lds, g, S, E, nullptr);
}
__device__ __forceinline__ void phase_gemm_kv(const Params& P, char* lds) {
    pg8::Gemm g; g.A = P.memn_(); g.Bt = P.WkvT_(); g.M = NB * MEML; g.N = DEPTH * 1024; g.K = DM;
    pg8::StaticOrder S; S.init(g.M, g.N, (int)gridDim.x, (int)blockIdx.x);
    pg8::EpiBf16Plain E; E.O = P.kvmem_(); E.ldc = DEPTH * 1024;
    pg8::gemm_phase<pg8::EpiBf16Plain, pg8::StaticOrder, false>((PG8_LAS unsigned char*)lds, g, S, E, nullptr);
}
__device__ __forceinline__ void mma_tile(f32x16& acc, const char* A, int lda, const char* B, int ldb, int K, int lane) {
    const int r = lane & 31, kh = lane >> 5;
    const char* ap = A + r * lda + kh * 16; const char* bp = B + r * ldb + kh * 16;
    asm volatile("" : "+v"(acc));
    for (int k = 0; k < K; k += 16) {
        const bf16x8 a = *(const bf16x8*)(ap + k * 2); const bf16x8 b = *(const bf16x8*)(bp + k * 2);
        acc = __builtin_amdgcn_mfma_f32_32x32x16_bf16(a, b, acc, 0, 0, 0);
    }
}
__device__ __forceinline__ int crow32(int r, int hi) { return (r & 3) + 8 * (r >> 2) + 4 * hi; }
__device__ __forceinline__ float log_sigmoid_(float x) { return fminf(x, 0.f) - log1pf(__expf(-fabsf(x))); }

constexpr int GLA_ST = 144;
constexpr int GC_BST = 68;
constexpr int GC_B_BYTES = 4 * 64 * GC_BST * 4, GC_V_BYTES = 4 * 16384;
__device__ __forceinline__ float* gla_gb(const Params& P) { return (float*)((char*)P.ocat_() + (size_t)32 * 1024 * 1024); }
__device__ __forceinline__ float log_sigmoid_fast(float x) { return fminf(x, 0.f) - __logf(1.f + __expf(-fabsf(x))); }

__device__ __forceinline__ void unit_gla_a4(const Params& P, int layer, int ub, char* lds) {
    const int b = ub >> 6, n = ub & 63, tok0 = b * SEQ + n * 64;
    const int tid = TIDX(), wid = tid >> 6, lane = tid & 63, r32 = lane & 31, hi = lane >> 5, h = wid >> 1, eh = wid & 1;
    float* b_s = (float*)lds;
    char* V_s = lds;
    char* K_s = lds + GC_B_BYTES;
    float* glr_s = (float*)(lds + GC_B_BYTES + GC_V_BYTES);
    float* tot_s = glr_s + 1024;
    __syncthreads();
    const bf16_t* prow = P.p_() + (size_t)tok0 * NPAD;
    const bf16x8 glr_raw = *(const bf16x8*)(prow + (size_t)((tid & 127) >> 1) * NPAD + C_GLR + (tid & 1) * 8);
    const int gd = tid & 63, gh = (tid >> 6) & 3, gt = tid >> 8;
    float wu[16];
#pragma unroll
    for (int r = 0; r < 16; ++r) wu[r] = P.gla_w_up[((size_t)layer * 16 + r) * 256 + gh * 64 + gd];
    const float bias = P.gla_b_up[layer * 256 + gh * 64 + gd];
    bf16x8 kraw[4], vs[4][2];
    const int ks_ = tid >> 3, kc = (tid & 7) * 8;
#pragma unroll
    for (int hv = 0; hv < 4; ++hv) kraw[hv] = *(const bf16x8*)(prow + (size_t)ks_ * NPAD + C_GK + hv * 64 + kc);
    const int sr = tid >> 4, sc = (tid & 15) * 8;
#pragma unroll
    for (int hv = 0; hv < 4; ++hv) { vs[hv][0] = *(const bf16x8*)(prow + (size_t)sr * NPAD + C_GV + hv * 128 + sc); vs[hv][1] = *(const bf16x8*)(prow + (size_t)(32 + sr) * NPAD + C_GV + hv * 128 + sc); }
    if (tid < 128) {
#pragma unroll
        for (int j = 0; j < 8; ++j) glr_s[(tid >> 1) * 16 + (tid & 1) * 8 + j] = bf2f((bf16_t)glr_raw[j]); }
    __syncthreads();
    float gv[32]; float run = 0.f;
#pragma unroll
    for (int i = 0; i < 32; ++i) { const float* gr = glr_s + (gt * 32 + i) * 16; float a = bias;
#pragma unroll
        for (int r4 = 0; r4 < 4; ++r4) { const f32x4 g4 = *(const f32x4*)(gr + 4 * r4); a = fmaf(g4[0], wu[4 * r4], a); a = fmaf(g4[1], wu[4 * r4 + 1], a); a = fmaf(g4[2], wu[4 * r4 + 2], a); a = fmaf(g4[3], wu[4 * r4 + 3], a); }
        run += log_sigmoid_fast(a) * (1.f / 16.f); gv[i] = run; }
    if (gt == 0) tot_s[gh * 64 + gd] = run;
    __syncthreads();
    { const float off = gt ? tot_s[gh * 64 + gd] : 0.f; float* bp = b_s + (gh * 64 + gt * 32) * GC_BST + gd;
      float* gp = gla_gb(P) + (size_t)(tok0 + gt * 32) * 256 + gh * 64 + gd;
#pragma unroll
      for (int i = 0; i < 32; ++i) { const float v = gv[i] + off; bp[i * GC_BST] = v; gp[(size_t)i * 256] = v; }
      if (gt) P.glad_()[((size_t)((b * 64 + n) * 4 + gh)) * 64 + gd] = __expf(gv[31] + off); }
    __syncthreads();
#pragma unroll
    for (int hv = 0; hv < 4; ++hv) { const float* br = b_s + (hv * 64 + ks_) * GC_BST + kc; const float* bl = b_s + (hv * 64 + 63) * GC_BST + kc;
        const f32x4 b0 = *(const f32x4*)br, b1 = *(const f32x4*)(br + 4), l0 = *(const f32x4*)bl, l1 = *(const f32x4*)(bl + 4);
        float e[8];
#pragma unroll
        for (int j = 0; j < 8; ++j) e[j] = bf2f((bf16_t)kraw[hv][j]) * __expf((j < 4 ? l0[j] : l1[j - 4]) - (j < 4 ? b0[j] : b1[j - 4]));
        u32x4 w = {att::cvtpk(e[0], e[1]), att::cvtpk(e[2], e[3]), att::cvtpk(e[4], e[5]), att::cvtpk(e[6], e[7])};
        *(u32x4*)(K_s + hv * 16384 + att::v_st(ks_, kc)) = w; }
    __syncthreads();
    { const int vst0 = att::v_st(sr, sc), vst1 = att::v_st(32 + sr, sc);
#pragma unroll
      for (int hv = 0; hv < 4; ++hv) { *(bf16x8*)(V_s + hv * 16384 + vst0) = vs[hv][0]; *(bf16x8*)(V_s + hv * 16384 + vst1) = vs[hv][1]; } }
    __syncthreads();
    const int vb = (int)(uintptr_t)(V_s + h * 16384) + att::v_rd_base(lane), kb = (int)(uintptr_t)(K_s + h * 16384) + att::v_rd_base(lane);
    f32x16 acc[2][2] = {};
    asm volatile("" : "+v"(acc[0][0]), "+v"(acc[0][1]), "+v"(acc[1][0]), "+v"(acc[1][1]));
#define GA_PK(L, H) (bf16x8){L[0], L[1], L[2], L[3], H[0], H[1], H[2], H[3]}
#define GA_STEP(KS) do { \
    const s16x4 k0l = att::tr_read<att::v_rd_off(0, KS, 0)>(kb), k0h = att::tr_read<att::v_rd_off(0, KS, 1)>(kb), k1l = att::tr_read<att::v_rd_off(1, KS, 0)>(kb), k1h = att::tr_read<att::v_rd_off(1, KS, 1)>(kb); \
    s16x4 v0l, v0h, v1l, v1h; \
    if (eh == 0) { v0l = att::tr_read<att::v_rd_off(0, KS, 0)>(vb); v0h = att::tr_read<att::v_rd_off(0, KS, 1)>(vb); v1l = att::tr_read<att::v_rd_off(1, KS, 0)>(vb); v1h = att::tr_read<att::v_rd_off(1, KS, 1)>(vb); } \
    else         { v0l = att::tr_read<att::v_rd_off(2, KS, 0)>(vb); v0h = att::tr_read<att::v_rd_off(2, KS, 1)>(vb); v1l = att::tr_read<att::v_rd_off(3, KS, 0)>(vb); v1h = att::tr_read<att::v_rd_off(3, KS, 1)>(vb); } \
    asm volatile("s_waitcnt lgkmcnt(0)" ::: "memory"); __builtin_amdgcn_sched_barrier(0); \
    acc[0][0] = __builtin_amdgcn_mfma_f32_32x32x16_bf16(GA_PK(v0l, v0h), GA_PK(k0l, k0h), acc[0][0], 0, 0, 0); \
    acc[0][1] = __builtin_amdgcn_mfma_f32_32x32x16_bf16(GA_PK(v0l, v0h), GA_PK(k1l, k1h), acc[0][1], 0, 0, 0); \
    acc[1][0] = __builtin_amdgcn_mfma_f32_32x32x16_bf16(GA_PK(v1l, v1h), GA_PK(k0l, k0h), acc[1][0], 0, 0, 0); \
    acc[1][1] = __builtin_amdgcn_mfma_f32_32x32x16_bf16(GA_PK(v1l, v1h), GA_PK(k1l, k1h), acc[1][1], 0, 0, 0); } while (0)
    GA_STEP(0); GA_STEP(1); GA_STEP(2); GA_STEP(3);
#undef GA_STEP
#undef GA_PK
    float* dst = P.glas_() + ((size_t)((b * 64 + n) * 4 + h)) * 8192;
#pragma unroll
    for (int et = 0; et < 2; ++et)
#pragma unroll
        for (int dt = 0; dt < 2; ++dt)
#pragma unroll
            for (int r = 0; r < 16; ++r) dst[((eh * 2 + et) * 32 + att::crow(r, hi)) * 64 + dt * 32 + r32] = acc[et][dt][r];
    __syncthreads();
}

__device__ __forceinline__ void gla_scan_slice(const Params& P, int idx) {
    {
        const int el = idx & 8191, d = idx & 63, h = (idx >> 13) & 3, b = idx >> 15;
        bf16_t* gst = P.ocat_();
        float S = 0.f;
        for (int n0 = 0; n0 < 64; n0 += 8) {
            float ds[8], dc[8];
#pragma unroll
            for (int i = 0; i < 8; ++i) { const size_t cu = (size_t)((b * 64 + n0 + i) * 4 + h); ds[i] = P.glas_()[cu * 8192 + el]; dc[i] = P.glad_()[cu * 64 + d]; }
#pragma unroll
            for (int i = 0; i < 8; ++i) { const size_t cu = (size_t)((b * 64 + n0 + i) * 4 + h); gst[cu * 8192 + el] = f2bf(S); S = fmaf(dc[i], S, ds[i]); }
        }
    }
}

__device__ __forceinline__ void unit_gla_c4(const Params& P, int layer, int ub, char* lds) {
    const int b = ub >> 6, n = ub & 63, tok0 = b * SEQ + n * 64;
    const int tid = TIDX(), wid = tid >> 6, lane = tid & 63, r32 = lane & 31, hi = lane >> 5, h = wid >> 1, rh = wid & 1;
    float* b_s = (float*)lds;
    char* V_s = lds + GC_B_BYTES;
    __syncthreads();
    const bf16_t* prow = P.p_() + (size_t)tok0 * NPAD;
    bf16x8 qraw[4], kraw[2][4], vs[4][2];
    const int sr = tid >> 4, sc = (tid & 15) * 8;
#pragma unroll
    for (int hv = 0; hv < 4; ++hv) { vs[hv][0] = *(const bf16x8*)(prow + (size_t)sr * NPAD + C_GV + hv * 128 + sc); vs[hv][1] = *(const bf16x8*)(prow + (size_t)(32 + sr) * NPAD + C_GV + hv * 128 + sc); }
    f32x4 braw[8];
    { const float* gp = gla_gb(P) + (size_t)tok0 * 256 + tid * 4;
#pragma unroll
      for (int i = 0; i < 8; ++i) braw[i] = *(const f32x4*)(gp + i * 2048); }
    { const bf16_t* qp = prow + (size_t)(rh * 32 + r32) * NPAD + C_GQ + h * 64 + hi * 8;
#pragma unroll
      for (int d0 = 0; d0 < 4; ++d0) qraw[d0] = *(const bf16x8*)(qp + d0 * 16);
#pragma unroll
      for (int sh = 0; sh < 2; ++sh) { const bf16_t* kp = prow + (size_t)(sh * 32 + r32) * NPAD + C_GK + h * 64 + hi * 8;
#pragma unroll
          for (int d0 = 0; d0 < 4; ++d0) kraw[sh][d0] = *(const bf16x8*)(kp + d0 * 16); } }
    bf16x8 sfr[4][4];
    { const bf16_t* sp = P.ocat_() + ((size_t)((b * 64 + n) * 4 + h)) * 8192 + r32 * 64 + hi * 8;
#pragma unroll
      for (int eb = 0; eb < 4; ++eb)
#pragma unroll
          for (int ds = 0; ds < 4; ++ds) sfr[eb][ds] = *(const bf16x8*)(sp + eb * 32 * 64 + ds * 16); }
    { const int vst0 = att::v_st(sr, sc), vst1 = att::v_st(32 + sr, sc);
#pragma unroll
      for (int hv = 0; hv < 4; ++hv) { *(bf16x8*)(V_s + hv * 16384 + vst0) = vs[hv][0]; *(bf16x8*)(V_s + hv * 16384 + vst1) = vs[hv][1]; } }
#pragma unroll
    for (int i = 0; i < 8; ++i) { const int c = tid + 512 * i, t = c >> 6, c4 = c & 63;
        *(f32x4*)(b_s + ((c4 >> 4) * 64 + t) * GC_BST + (c4 & 15) * 4) = braw[i]; }
    __syncthreads();
    const float* bh = b_s + h * 64 * GC_BST + hi * 8;
    bf16x8 qe[4], qb[4], ke[2][4];
#pragma unroll
    for (int d0 = 0; d0 < 4; ++d0) {
        const f32x4 m0 = *(const f32x4*)(bh + 32 * GC_BST + d0 * 16), m1 = *(const f32x4*)(bh + 32 * GC_BST + d0 * 16 + 4);
        const f32x4 q0 = *(const f32x4*)(bh + (rh * 32 + r32) * GC_BST + d0 * 16), q1 = *(const f32x4*)(bh + (rh * 32 + r32) * GC_BST + d0 * 16 + 4);
        float e1[8], e2[8];
#pragma unroll
        for (int j = 0; j < 8; ++j) { const float mv = j < 4 ? m0[j] : m1[j - 4], bq = j < 4 ? q0[j] : q1[j - 4]; const float q = bf2f((bf16_t)qraw[d0][j]) * 0.125f;
            e1[j] = q * __expf(bq - mv); e2[j] = q * __expf(bq); }
        { u32x4 w = {att::cvtpk(e1[0], e1[1]), att::cvtpk(e1[2], e1[3]), att::cvtpk(e1[4], e1[5]), att::cvtpk(e1[6], e1[7])}; qe[d0] = *reinterpret_cast<bf16x8*>(&w); }
        { u32x4 w = {att::cvtpk(e2[0], e2[1]), att::cvtpk(e2[2], e2[3]), att::cvtpk(e2[4], e2[5]), att::cvtpk(e2[6], e2[7])}; qb[d0] = *reinterpret_cast<bf16x8*>(&w); }
#pragma unroll
        for (int sh = 0; sh < 2; ++sh) {
            const f32x4 k0 = *(const f32x4*)(bh + (sh * 32 + r32) * GC_BST + d0 * 16), k1 = *(const f32x4*)(bh + (sh * 32 + r32) * GC_BST + d0 * 16 + 4);
            float e3[8];
#pragma unroll
            for (int j = 0; j < 8; ++j) { const float mv = j < 4 ? m0[j] : m1[j - 4], bk = j < 4 ? k0[j] : k1[j - 4]; e3[j] = bf2f((bf16_t)kraw[sh][d0][j]) * __expf(mv - bk); }
            u32x4 w = {att::cvtpk(e3[0], e3[1]), att::cvtpk(e3[2], e3[3]), att::cvtpk(e3[4], e3[5]), att::cvtpk(e3[6], e3[7])}; ke[sh][d0] = *reinterpret_cast<bf16x8*>(&w); }
    }
    f32x16 p0 = {}, p1 = {};
    asm volatile("" : "+v"(p0), "+v"(p1));
#pragma unroll
    for (int d0 = 0; d0 < 4; ++d0) { p0 = __builtin_amdgcn_mfma_f32_32x32x16_bf16(ke[0][d0], qe[d0], p0, 0, 0, 0); p1 = __builtin_amdgcn_mfma_f32_32x32x16_bf16(ke[1][d0], qe[d0], p1, 0, 0, 0); }
    { const int t = rh * 32 + r32;
#pragma unroll
      for (int r = 0; r < 16; ++r) { const int s0 = att::crow(r, hi); p0[r] = (s0 <= t) ? p0[r] : 0.f; p1[r] = (32 + s0 <= t) ? p1[r] : 0.f; } }
    bf16x8 pa0, pa1, pa2, pa3;
#define GC_PK4(Pv, BASE, OUT) do { unsigned a0 = att::cvtpk(Pv[BASE + 0], Pv[BASE + 1]), a1 = att::cvtpk(Pv[BASE + 2], Pv[BASE + 3]);   \
    unsigned b0 = att::cvtpk(Pv[BASE + 4], Pv[BASE + 5]), b1 = att::cvtpk(Pv[BASE + 6], Pv[BASE + 7]);                              \
    auto r0 = __builtin_amdgcn_permlane32_swap(a0, b0, false, false); auto r1 = __builtin_amdgcn_permlane32_swap(a1, b1, false, false); \
    u32x4 w = {r0[0], r1[0], r0[1], r1[1]}; OUT = *reinterpret_cast<bf16x8*>(&w); } while (0)
    GC_PK4(p0, 0, pa0); GC_PK4(p0, 8, pa1); GC_PK4(p1, 0, pa2); GC_PK4(p1, 8, pa3);
#undef GC_PK4
    f32x16 o[4] = {};
    asm volatile("" : "+v"(o[0]), "+v"(o[1]), "+v"(o[2]), "+v"(o[3]));
    att::pv_d0(o, (int)(uintptr_t)(V_s + h * 16384) + att::v_rd_base(lane), pa0, pa1, pa2, pa3);
#pragma unroll
    for (int eb = 0; eb < 4; ++eb)
#pragma unroll
        for (int ds = 0; ds < 4; ++ds) o[eb] = __builtin_amdgcn_mfma_f32_32x32x16_bf16(qb[ds], sfr[eb][ds], o[eb], 0, 0, 0);
    __syncthreads();
    float* og_s = (float*)lds + wid * (32 * 132);
#pragma unroll
    for (int r = 0; r < 16; ++r) {
#pragma unroll
        for (int eb = 0; eb < 4; ++eb) og_s[att::crow(r, hi) * 132 + eb * 32 + r32] = o[eb][r]; }
    asm volatile("" ::: "memory");
    { const int row = lane >> 1, half = lane & 1; const float* src = og_s + row * 132 + half * 64;
      f32x4 v[16]; float ss = 0.f;
#pragma unroll
      for (int i = 0; i < 16; ++i) { v[i] = *(const f32x4*)(src + 4 * i); ss += v[i][0] * v[i][0] + v[i][1] * v[i][1] + v[i][2] * v[i][2] + v[i][3] * v[i][3]; }
      ss += shx(ss, 1);
      const float rn = rsqrtf(ss * (1.f / 128.f) + EPS);
      const size_t tok = (size_t)(tok0 + rh * 32 + row);
      const bf16_t* zp = P.p_() + tok * NPAD + C_GZ + h * 128 + half * 64; bf16_t* gp = P.xn_() + tok * MIX + h * 128 + half * 64;
#pragma unroll
      for (int i = 0; i < 8; ++i) { float z[8], g[8]; ld8f(zp + 8 * i, z);
#pragma unroll
          for (int q = 0; q < 4; ++q) { g[q] = v[2 * i][q] * rn * siluf_(z[q]); g[4 + q] = v[2 * i + 1][q] * rn * siluf_(z[4 + q]); }
          st8f(gp + 8 * i, g); } }
    __syncthreads();
}
constexpr int S5P_STRIDE = 2304;
__device__ __forceinline__ void phase_s5_params(const Params& P) {
    for (int idx = blockIdx.x * NTHR + TIDX(); idx < DEPTH * 32 * 64; idx += gridDim.x * NTHR) {
        const int p = idx & 63, lg = idx >> 6;
        const float ar = P.s5_a_re[idx], ai = P.s5_a_im[idx], step = expf(P.s5_log_step[lg]);
        const float mag = expf(ar * step), th = ai * step;
        const float lr = mag * cosf(th), li = mag * sinf(th);
        float* o = P.s5p_() + (size_t)lg * S5P_STRIDE;
        o[2 * p] = lr; o[2 * p + 1] = li;
        { const float mag512 = expf(512.f * ar * step); const double a = 512.0 * (double)th; const double k = rint(a * 0.15915494309189535); const float rf = (float)fma(-k, 6.283185307179586, a);
          o[128 + 2 * p] = mag512 * cosf(rf); o[128 + 2 * p + 1] = mag512 * sinf(rf); }
        const float xr = lr - 1.f, xi = li, den = 1.f / (ar * ar + ai * ai);
        const float fr = (xr * ar + xi * ai) * den, fi = (xi * ar - xr * ai) * den;
        for (int c = 0; c < 16; ++c) { const float br = P.s5_b_re[(size_t)idx * 16 + c], bi = P.s5_b_im[(size_t)idx * 16 + c];
            o[256 + (p * 16 + c) * 2] = fr * br - fi * bi; o[256 + (p * 16 + c) * 2 + 1] = fr * bi + fi * br; }
    }
}
__device__ __forceinline__ float gelu_tanh_(float x) { const float u = 0.7978845608028654f * (x + 0.044715f * x * x * x); const float e = __expf(-2.f * fabsf(u)); const float th = copysignf((1.f - e) * __builtin_amdgcn_rcpf(1.f + e), u); return 0.5f * x * (1.f + th); }

constexpr int S5_XST = 272;
constexpr int S5_UST = 48;
__device__ __forceinline__ float partner32(float v, int hi) { auto rr = __builtin_amdgcn_permlane32_swap(__float_as_uint(v), __float_as_uint(v), false, false); return __uint_as_float(hi ? rr[0] : rr[1]); }
struct S5Ctx { float l0r, l0i, l1r, l1i, q0r, q0i, q1r, q1i, dsk; char* Cm; char* Bb; char* Xs; char* Us; int lane, hi, j, rho; const bf16_t* ubase; bf16_t* ybase; };
template <bool OUT> __device__ __forceinline__ void s5_tile(const S5Ctx& C, int tok0, float& x0r, float& x0i, float& x1r, float& x1i) {
    const int hi = C.hi, j = C.j, lane = C.lane;
    if (hi == 0) { const bf16_t* up = C.ubase + (size_t)(tok0 + j) * NPAD;
        const bf16x8 w0 = *(const bf16x8*)up, w1 = *(const bf16x8*)(up + 8);
        *(bf16x8*)(C.Us + C.rho * S5_UST) = w0; *(bf16x8*)(C.Us + C.rho * S5_UST + 16) = w1; }
    asm volatile("" ::: "memory");
    f32x16 a0 = {}, a1 = {}, a2 = {}, a3 = {};
    mma_tile(a0, C.Us, S5_UST, C.Bb, S5_UST, 16, lane); mma_tile(a1, C.Us, S5_UST, C.Bb + 32 * S5_UST, S5_UST, 16, lane);
    mma_tile(a2, C.Us, S5_UST, C.Bb + 64 * S5_UST, S5_UST, 16, lane); mma_tile(a3, C.Us, S5_UST, C.Bb + 96 * S5_UST, S5_UST, 16, lane);
    float s0r[16], s0i[16], s1r[16], s1i[16];
#pragma unroll
    for (int r = 0; r < 16; ++r) {
        const float n0r = fmaf(C.l0r, x0r, fmaf(-C.l0i, x0i, a0[r])), n0i = fmaf(C.l0r, x0i, fmaf(C.l0i, x0r, a1[r])); x0r = n0r; x0i = n0i; s0r[r] = n0r; s0i[r] = n0i;
        const float n1r = fmaf(C.l1r, x1r, fmaf(-C.l1i, x1i, a2[r])), n1i = fmaf(C.l1r, x1i, fmaf(C.l1i, x1r, a3[r])); x1r = n1r; x1i = n1i; s1r[r] = n1r; s1i[r] = n1i; }
    float z0r = partner32(x0r, hi), z0i = partner32(x0i, hi), z1r = partner32(x1r, hi), z1i = partner32(x1i, hi);
    if (hi == 0) { z0r = 0.f; z0i = 0.f; z1r = 0.f; z1i = 0.f; }
    if (!OUT) {
        x0r += C.q0r * z0r - C.q0i * z0i; x0i += C.q0r * z0i + C.q0i * z0r; x1r += C.q1r * z1r - C.q1i * z1i; x1i += C.q1r * z1i + C.q1i * z1r;
    } else {
#pragma unroll
        for (int r = 0; r < 16; ++r) {
            const float t0r = C.l0r * z0r - C.l0i * z0i, t0i = C.l0r * z0i + C.l0i * z0r; z0r = t0r; z0i = t0i; s0r[r] += t0r; s0i[r] += t0i;
            const float t1r = C.l1r * z1r - C.l1i * z1i, t1i = C.l1r * z1i + C.l1i * z1r; z1r = t1r; z1i = t1i; s1r[r] += t1r; s1i[r] += t1i; }
        x0r = s0r[15]; x0i = s0i[15]; x1r = s1r[15]; x1i = s1i[15];
#pragma unroll
        for (int r = 0; r < 16; ++r) { char* xr_ = C.Xs + (r + 16 * hi) * S5_XST;
            *(bf16_t*)(xr_ + j * 2) = f2bf(s0r[r]); *(bf16_t*)(xr_ + (64 + j) * 2) = f2bf(s0i[r]);
            *(bf16_t*)(xr_ + (32 + j) * 2) = f2bf(s1r[r]); *(bf16_t*)(xr_ + (96 + j) * 2) = f2bf(s1i[r]); }
        asm volatile("" ::: "memory");
        f32x16 acc = {}; mma_tile(acc, C.Xs, S5_XST, C.Cm, S5_XST, 128, lane);
        if (j < 16) {
#pragma unroll
            for (int r = 0; r < 16; ++r) { const int t = crow32(r, hi); const int rt = ((t & 15) & 3) + 8 * ((t & 15) >> 2) + 4 * (t >> 4);
                const float y = acc[r] + C.dsk * bf2f(*(const bf16_t*)(C.Us + rt * S5_UST + j * 2));
                C.ybase[(size_t)(tok0 + t) * 512 + j] = f2bf(gelu_tanh_(y)); } }
        asm volatile("" ::: "memory");
    }
    { const float e0r = partner32(x0r, hi), e0i = partner32(x0i, hi), e1r = partner32(x1r, hi), e1i = partner32(x1i, hi);
      if (hi == 0) { x0r = e0r; x0i = e0i; x1r = e1r; x1i = e1i; } else { x0r = 0.f; x0i = 0.f; x1r = 0.f; x1i = 0.f; } }
}
__device__ __forceinline__ void unit_s5(const Params& P, int layer, int u, char* lds) {
    const int b = u >> 5, g = u & 31, tid = TIDX(), wid = tid >> 6, lane = tid & 63, hi = lane >> 5, j = lane & 31;
    char* Cm = lds;
    char* Bb = Cm + 32 * S5_XST;
    float* ends = (float*)(Bb + 128 * S5_UST);
    char* wbase = (char*)(ends + 8 * 64 * 2) + wid * (32 * S5_XST + 32 * S5_UST);
    const float* sp = P.s5p_() + (size_t)(layer * 32 + g) * S5P_STRIDE;
    __syncthreads();
    for (int i = tid; i < 32 * 128; i += NTHR) { const int c = i >> 7, pp = i & 127; float v = 0.f;
        if (c < 16) v = (pp < 64) ? P.s5_c_re[((size_t)(layer * 32 + g) * 16 + c) * 64 + pp] : -P.s5_c_im[((size_t)(layer * 32 + g) * 16 + c) * 64 + (pp - 64)];
        *(bf16_t*)(Cm + c * S5_XST + pp * 2) = f2bf(v); }
    for (int i = tid; i < 128 * 16; i += NTHR) { const int n = i >> 4, c = i & 15, nt = n >> 5, jj = n & 31, p = (nt >> 1) * 32 + jj;
        *(bf16_t*)(Bb + n * S5_UST + c * 2) = f2bf(sp[256 + (p * 16 + c) * 2 + (nt & 1)]); }
    S5Ctx C; C.Cm = Cm; C.Bb = Bb; C.Xs = wbase; C.Us = wbase + 32 * S5_XST; C.lane = lane; C.hi = hi; C.j = j;
    C.l0r = sp[2 * j]; C.l0i = sp[2 * j + 1]; C.l1r = sp[2 * (32 + j)]; C.l1i = sp[2 * (32 + j) + 1];
    { float q0r = C.l0r, q0i = C.l0i, q1r = C.l1r, q1i = C.l1i;
#pragma unroll
      for (int k = 0; k < 4; ++k) { const float a = q0r * q0r - q0i * q0i, bb = (q0r + q0r) * q0i; q0r = a; q0i = bb; const float c = q1r * q1r - q1i * q1i, d = (q1r + q1r) * q1i; q1r = c; q1i = d; }
      C.q0r = q0r; C.q0i = q0i; C.q1r = q1r; C.q1i = q1i; }
    C.dsk = P.s5_d[layer * 512 + g * 16 + (lane & 15)];
    C.rho = ((j & 15) & 3) + 8 * ((j & 15) >> 2) + 4 * (j >> 4);
    const int tokw = b * SEQ + wid * 512;
    C.ubase = P.p_() + C_SU + g * 16; C.ybase = P.ybuf_() + g * 16;
    float x0r = 0.f, x0i = 0.f, x1r = 0.f, x1i = 0.f;
    __syncthreads();
    for (int sc = 0; sc < 16; ++sc) s5_tile<false>(C, tokw + sc * 32, x0r, x0i, x1r, x1i);
    if (hi == 0) { ends[(wid * 64 + j) * 2] = x0r; ends[(wid * 64 + j) * 2 + 1] = x0i; ends[(wid * 64 + 32 + j) * 2] = x1r; ends[(wid * 64 + 32 + j) * 2 + 1] = x1i; }
    __syncthreads();
    { const float p0r = sp[128 + 2 * j], p0i = sp[128 + 2 * j + 1], p1r = sp[128 + 2 * (32 + j)], p1i = sp[128 + 2 * (32 + j) + 1];
      x0r = 0.f; x0i = 0.f; x1r = 0.f; x1i = 0.f;
      for (int w = 0; w < wid; ++w) { const float e0r = ends[(w * 64 + j) * 2], e0i = ends[(w * 64 + j) * 2 + 1], e1r = ends[(w * 64 + 32 + j) * 2], e1i = ends[(w * 64 + 32 + j) * 2 + 1];
          const float n0r = p0r * x0r - p0i * x0i + e0r, n0i = p0r * x0i + p0i * x0r + e0i, n1r = p1r * x1r - p1i * x1i + e1r, n1i = p1r * x1i + p1i * x1r + e1i;
          x0r = n0r; x0i = n0i; x1r = n1r; x1i = n1i; }
      if (hi) { x0r = 0.f; x0i = 0.f; x1r = 0.f; x1i = 0.f; } }
    for (int sc = 0; sc < 16; ++sc) s5_tile<true>(C, tokw + sc * 32, x0r, x0i, x1r, x1i);
}
constexpr int TOPK = 256;
__device__ __forceinline__ unsigned f2key(float f) { const unsigned u = __float_as_uint(f); return u ^ ((u & 0x80000000u) ? 0xffffffffu : 0x80000000u); }

__device__ __forceinline__ float relu1(float x) { const int b = __float_as_int(x); return __int_as_float(b > 0 ? b : 0); }
#define DSA_MM(acc, rt, kk) acc = __builtin_amdgcn_mfma_f32_32x32x16_bf16(afr[rt][kk], bfr[kk], acc, 0, 0, 0)
#define DSA_HS(acc, rt, q) do { s0 = fmaf(relu1(acc[4 * (q)]), wv[rt][4 * (q)], s0); s1 = fmaf(relu1(acc[4 * (q) + 1]), wv[rt][4 * (q) + 1], s1); \
                                s0 = fmaf(relu1(acc[4 * (q) + 2]), wv[rt][4 * (q) + 2], s0); s1 = fmaf(relu1(acc[4 * (q) + 3]), wv[rt][4 * (q) + 3], s1); } while (0)
#define DSA_SG() __builtin_amdgcn_sched_barrier(0)
__device__ __forceinline__ void dsa_score_tile(const bf16x8 (&afr)[4][4], const f32x16 (&wv)[4], const bf16x8 (&bfr)[4], float* sc, int col, int hi) {
    const f32x16 z16 = {};
#define DSA_M0(acc, rt) acc = __builtin_amdgcn_mfma_f32_32x32x16_bf16(afr[rt][0], bfr[0], z16, 0, 0, 0)
    f32x16 accA, accB;
    float s0, s1;
    DSA_M0(accA, 0); DSA_MM(accA, 0, 1); DSA_MM(accA, 0, 2); DSA_MM(accA, 0, 3);
    s0 = 0.f; s1 = 0.f;
    DSA_M0(accB, 1); DSA_HS(accA, 0, 0); DSA_SG(); DSA_MM(accB, 1, 1); DSA_HS(accA, 0, 1); DSA_SG();
    DSA_MM(accB, 1, 2); DSA_HS(accA, 0, 2); DSA_SG(); DSA_MM(accB, 1, 3); DSA_HS(accA, 0, 3); DSA_SG();
    sc[(0 + hi) * 4096 + col] = (s0 + s1) + 0.f;
    s0 = 0.f; s1 = 0.f;
    DSA_M0(accA, 2); DSA_HS(accB, 1, 0); DSA_SG(); DSA_MM(accA, 2, 1); DSA_HS(accB, 1, 1); DSA_SG();
    DSA_MM(accA, 2, 2); DSA_HS(accB, 1, 2); DSA_SG(); DSA_MM(accA, 2, 3); DSA_HS(accB, 1, 3); DSA_SG();
    sc[(2 + hi) * 4096 + col] = (s0 + s1) + 0.f;
    s0 = 0.f; s1 = 0.f;
    DSA_M0(accB, 3); DSA_HS(accA, 2, 0); DSA_SG(); DSA_MM(accB, 3, 1); DSA_HS(accA, 2, 1); DSA_SG();
    DSA_MM(accB, 3, 2); DSA_HS(accA, 2, 2); DSA_SG(); DSA_MM(accB, 3, 3); DSA_HS(accA, 2, 3); DSA_SG();
    asm volatile("" :: "v"(bfr[0]), "v"(bfr[1]), "v"(bfr[2]), "v"(bfr[3]));
    sc[(4 + hi) * 4096 + col] = (s0 + s1) + 0.f;
    s0 = 0.f; s1 = 0.f;
    DSA_HS(accB, 3, 0); DSA_HS(accB, 3, 1); DSA_HS(accB, 3, 2); DSA_HS(accB, 3, 3);
    sc[(6 + hi) * 4096 + col] = (s0 + s1) + 0.f;
#undef DSA_M0
}
#define DSA_CNT4(K0, K1, K2, K3) asm volatile( \
    "v_cmp_ge_u32_e64 %[m0], %[k0], %[cd]\n\tv_cmp_ge_u32_e64 %[m1], %[k1], %[cd]\n\tv_cmp_ge_u32_e64 %[m2], %[k2], %[cd]\n\tv_cmp_ge_u32_e64 %[m3], %[k3], %[cd]\n\t" \
    "v_addc_co_u32_e64 %[a0], %[m0], %[a0], 0, %[m0]\n\tv_addc_co_u32_e64 %[a1], %[m1], %[a1], 0, %[m1]\n\t" \
    "v_addc_co_u32_e64 %[a0], %[m2], %[a0], 0, %[m2]\n\tv_addc_co_u32_e64 %[a1], %[m3], %[a1], 0, %[m3]" \
    : [a0] "+v"(c0), [a1] "+v"(c1), [m0] "=&s"(sm0), [m1] "=&s"(sm1), [m2] "=&s"(sm2), [m3] "=&s"(sm3) \
    : [k0] "v"(K0), [k1] "v"(K1), [k2] "v"(K2), [k3] "v"(K3), [cd] "v"(cand))
#define DSA_CNT8(J0) do { DSA_CNT4(key[(J0)], key[(J0) + 1], key[(J0) + 2], key[(J0) + 3]); DSA_CNT4(key[(J0) + 4], key[(J0) + 5], key[(J0) + 6], key[(J0) + 7]); } while (0)

template <int J> __device__ __forceinline__ void dsa_emit(const unsigned (&key)[64], unsigned T, unsigned& wlo, unsigned& whi) {
    const unsigned long long m = __ballot(key[J] >= T);
    asm("s_nop 1\n\tv_writelane_b32 %0, %2, %4\n\tv_writelane_b32 %1, %3, %4" : "+v"(wlo), "+v"(whi) : "s"((unsigned)m), "s"((unsigned)(m >> 32)), "n"(J));
    if constexpr (J + 1 < 64) dsa_emit<J + 1>(key, T, wlo, whi);
}
__device__ __forceinline__ void unit_dsa_index(const Params& P, int u, char* lds) {
    const int b = u & 3, t0 = (511 - (u >> 2)) * 8;
    const int tid = TIDX(), wid = tid >> 6, lane = tid & 63, r32 = lane & 31, hi = lane >> 5;
    float* sc = (float*)lds;
    const bf16_t* pb = P.p_() + (size_t)b * SEQ * NPAD;
    __syncthreads();
    TPU_START(101); TPU_START(110);
    {
        bf16x8 afr[4][4]; f32x16 wv[4];
        const int qsel = (r32 >> 2) & 1, head = (r32 & 3) + 4 * (r32 >> 3);
        char* qs = lds;
        const int ntile = (t0 + 7) / 32 + 1;
        const bf16_t* kp = P.ikc_() + (size_t)(b * (SEQ / 32)) * 2048 + lane * 8;
        bf16x8 b0[4], b1[4], b2[4];
#define DSA_LDB(dst, K) do { const bf16_t* kq_ = kp + (size_t)(wid + 8 * (K)) * 2048; _Pragma("unroll") for (int kk = 0; kk < 4; ++kk) dst[kk] = *(const bf16x8*)(kq_ + kk * 512); } while (0)
#define DSA_TILE(buf, K) dsa_score_tile(afr, wv, buf, sc, (wid + 8 * (K)) * 32 + r32, hi)
        const int nk = (ntile - wid + 7) >> 3;
        const int kl = nk > 0 ? nk - 1 : 0;
#define DSA_MIN(a) ((a) < kl ? (a) : kl)
        const int tk = tid >> 6, hd = (tid & 63) >> 2, dm = (tid & 3) * 16;
        const bf16_t* qsrc = pb + (size_t)(t0 + tk) * NPAD + C_DIQ + hd * 64 + dm;
        const u32x4 qa = *(const u32x4*)qsrc, qb2 = *(const u32x4*)(qsrc + 8);
#pragma unroll
        for (int rt = 0; rt < 4; ++rt) { const float* wp = P.iw_() + (size_t)(b * SEQ + t0 + 2 * rt + hi) * 16;
#pragma unroll
            for (int i = 0; i < 4; ++i) { const f32x4 w4 = *(const f32x4*)(wp + 4 * i); wv[rt][4 * i] = w4[0]; wv[rt][4 * i + 1] = w4[1]; wv[rt][4 * i + 2] = w4[2]; wv[rt][4 * i + 3] = w4[3]; } }
        DSA_LDB(b0, DSA_MIN(0)); DSA_LDB(b1, DSA_MIN(1));
        { char* dst = qs + tk * 2432 + hd * 144 + dm * 2; *(u32x4*)dst = qa; *(u32x4*)(dst + 16) = qb2; }
        __syncthreads();
#pragma unroll
        for (int rt = 0; rt < 4; ++rt) { const char* qp = qs + (2 * rt + qsel) * 2432 + head * 144 + hi * 16;
#pragma unroll
            for (int kk = 0; kk < 4; ++kk) afr[rt][kk] = *(const bf16x8*)(qp + kk * 32); }
        asm volatile("s_waitcnt lgkmcnt(0)" ::: "memory"); __syncthreads();
#if TPROBE == 110
        TPU_STOP(110);
#endif
#if TPROBE == 103
        TPU_START(103); asm volatile("s_waitcnt vmcnt(0)" ::: "memory"); TPU_STOP(103);
#endif
#if TPROBE == 104
        asm volatile("s_waitcnt vmcnt(0)" ::: "memory"); TPU_START(104);
#endif
        int k = 0;
        for (; k + 3 <= nk; k += 3) {
            DSA_LDB(b2, k + 2); DSA_TILE(b0, k);
            DSA_LDB(b0, DSA_MIN(k + 3)); DSA_TILE(b1, k + 1);
            DSA_LDB(b1, DSA_MIN(k + 4)); DSA_TILE(b2, k + 2);
        }
        if (k < nk) DSA_TILE(b0, k);
        if (k + 1 < nk) DSA_TILE(b1, k + 1);
#if TPROBE == 104
        asm volatile("s_waitcnt lgkmcnt(0)" ::: "memory"); TPU_STOP(104);
#endif
        TPU_START(111);
#undef DSA_TILE
#undef DSA_MIN
#undef DSA_TILE
#undef DSA_LDB
    }
    __syncthreads();
    TPU_STOP(111);
    TPU_STOP(101); TPU_START(102);
    {
        const int t = t0 + wid; const float* srow = sc + wid * 4096;
        unsigned key[64];
#pragma unroll
        for (int j = 0; j < 64; ++j) { const int s = j * 64 + lane; key[j] = (s <= t) ? f2key(srow[s]) : 0u; }
        unsigned long long* mout = P.mask_() + (size_t)(b * SEQ + t) * 64;
        unsigned long long myword = 0ull;
        TPU_START(105); TPU_START(106); TPU_START(107); TPU_START(108); TPU_START(109);
        if (t + 1 <= TOPK) {
#pragma unroll
            for (int j = 0; j < 64; ++j) { const unsigned long long m = __ballot(j * 64 + lane <= t); if (lane == j) myword = m; }
        } else {
            const int ngrp = t / 512 + 1;
#if TPROBE == 105
            asm volatile("" :: "v"(key[0]), "v"(key[63]));
#endif
            TPU_STOP(105);
            unsigned* hist = (unsigned*)(sc + wid * 4096);
            asm volatile("" ::: "memory");
            { const u32x4 zz4 = {0u, 0u, 0u, 0u};
#pragma unroll
              for (int i = 0; i < 16; ++i) *(u32x4*)(hist + (i * 64 + lane) * 4) = zz4; }
            asm volatile("" ::: "memory");
#define DSA_H8(J0) do { _Pragma("unroll") for (int jj = 0; jj < 8; ++jj) atomicAdd(hist + (key[(J0) + jj] >> 20), 1u); } while (0)
            DSA_H8(0);
            if (ngrp > 1) DSA_H8(8);
            if (ngrp > 2) DSA_H8(16);
            if (ngrp > 3) DSA_H8(24);
            if (ngrp > 4) DSA_H8(32);
            if (ngrp > 5) DSA_H8(40);
            if (ngrp > 6) DSA_H8(48);
            if (ngrp > 7) DSA_H8(56);
#undef DSA_H8
            asm volatile("" ::: "memory");
#if TPROBE == 106
            asm volatile("s_waitcnt lgkmcnt(0)" ::: "memory");
#endif
            TPU_STOP(106);
#define DSA_SUFFIX(s) do { _Pragma("unroll") for (int o = 1; o < 64; o <<= 1) { unsigned t_ = (unsigned)__builtin_amdgcn_ds_bpermute(((lane + o) & 63) << 2, (int)(s)); (s) += (lane + o < 64) ? t_ : 0u; } } while (0)
            unsigned mine = 0u;
#pragma unroll
            for (int i = 0; i < 16; ++i) { const u32x4 v4 = *(const u32x4*)(hist + lane * 64 + ((i + lane) & 15) * 4); mine += (v4[0] + v4[1]) + (v4[2] + v4[3]); }
            unsigned suf = mine; DSA_SUFFIX(suf);
            const unsigned long long mL = __ballot(suf - mine < (unsigned)TOPK && suf >= (unsigned)TOPK);
            const int Ls = (int)__builtin_ctzll(mL);
            const unsigned cntA = (unsigned)__builtin_amdgcn_readlane((int)(suf - mine), Ls);
            unsigned h2 = hist[Ls * 64 + lane]; unsigned suf2 = h2; DSA_SUFFIX(suf2);
            const unsigned long long mB = __ballot(cntA + suf2 - h2 < (unsigned)TOPK && cntA + suf2 >= (unsigned)TOPK);
            const int Bs = (int)__builtin_ctzll(mB);
            const unsigned bstar = (unsigned)(Ls * 64 + Bs);
            const unsigned cntAbove = cntA + (unsigned)__builtin_amdgcn_readlane((int)(suf2 - h2), Bs);
            const unsigned inbin = (unsigned)__builtin_amdgcn_readlane((int)h2, Bs);
#undef DSA_SUFFIX
            TPU_STOP(107);
            unsigned T = bstar << 20; int cntT = (int)(cntAbove + inbin);
            if (cntT != TOPK) {
                asm volatile("" ::: "memory");
                int nslot = 0;
#pragma unroll
                for (int j = 0; j < 64; ++j) { if ((key[j] >> 20) == bstar) { hist[nslot * 64 + lane] = key[j]; ++nslot; } }
                asm volatile("" ::: "memory");
                int R = nslot;
#pragma unroll
                for (int o = 32; o >= 1; o >>= 1) { const int other = __builtin_amdgcn_ds_bpermute(((lane ^ o) << 2), R); R = other > R ? other : R; }
                R = __builtin_amdgcn_readfirstlane(R);
                if (R <= 8) {
                    unsigned c[8];
#pragma unroll
                    for (int r = 0; r < 8; ++r) c[r] = (r < nslot) ? hist[r * 64 + lane] : 0u;
                    for (int bit = 19; bit >= 0; --bit) {
                        const unsigned cand = T | (1u << bit); int cnt = (int)cntAbove;
#pragma unroll
                        for (int r = 0; r < 8; ++r) cnt += __popcll(__ballot(c[r] >= cand));
                        if (cnt >= TOPK) { T = cand; cntT = cnt; if (cnt == TOPK) break; }
                    }
                } else {
                    for (int bit = 19; bit >= 0; --bit) {
                        const unsigned cand = T | (1u << bit); unsigned c0 = 0, c1 = 0; unsigned long long sm0, sm1, sm2, sm3;
                        DSA_CNT8(0);
                        if (ngrp > 1) DSA_CNT8(8);
                        if (ngrp > 2) DSA_CNT8(16);
                        if (ngrp > 3) DSA_CNT8(24);
                        if (ngrp > 4) DSA_CNT8(32);
                        if (ngrp > 5) DSA_CNT8(40);
                        if (ngrp > 6) DSA_CNT8(48);
                        if (ngrp > 7) DSA_CNT8(56);
                        const int cl = (int)(c0 + c1);
                        int cnt = 0;
#pragma unroll
                        for (int bb = 0; bb < 7; ++bb) cnt += __popcll(__ballot((cl >> bb) & 1)) << bb;
                        if (cnt >= TOPK) { T = cand; cntT = cnt; if (cnt == TOPK) break; }
                    }
                }
            }
            TPU_STOP(108);
            if (cntT == TOPK) {
                unsigned wlo = 0u, whi = 0u;
                dsa_emit<0>(key, T, wlo, whi);
                myword = ((unsigned long long)whi << 32) | wlo;
            } else {
                int ngt = 0;
#pragma unroll
                for (int j = 0; j < 64; ++j) ngt += __popcll(__ballot(key[j] > T));
                int need = TOPK - ngt;
#pragma unroll
                for (int j = 0; j < 64; ++j) { const unsigned long long eq = __ballot(key[j] == T), gt = __ballot(key[j] > T);
                    const int ne = __popcll(eq); unsigned long long take = eq;
                    if (ne > need) { take = 0ull; int left = need; unsigned long long e2 = eq;
                        while (left > 0) { const unsigned long long lowbit = e2 & (0ull - e2); take |= lowbit; e2 ^= lowbit; --left; } }
                    need -= (ne > need) ? need : ne;
                    const unsigned long long m = gt | take; if (lane == j) myword = m; }
            }
        }
        mout[lane] = myword;
        TPU_STOP(109);
    }
    TPU_STOP(102);
}

struct DsaOutRow { const bf16_t* zb; bf16_t* gb; int wid;
    __device__ __forceinline__ const bf16_t* zrow(int r) const { const int rho = wid * 32 + r; return zb + (size_t)(rho >> 2) * NPAD + (rho & 3) * 128; }
    __device__ __forceinline__ bf16_t* grow(int r) const { const int rho = wid * 32 + r; return gb + (size_t)(rho >> 2) * MIX + (rho & 3) * 128; } };
__device__ __forceinline__ void unit_dsa_attn(const Params& P, int cur_layer, int u, char* lds) {
    const int b = u & 3, qb = 63 - (u >> 2), t0 = qb * 64, tokb = b * SEQ;
    const int wid = TIDX() >> 6, lane = TIDX() & 63, r32 = lane & 31, hi = lane >> 5;
    const int rho = wid * 32 + r32, tq = t0 + (rho >> 2), hq = rho & 3;
    const bf16_t* Qw = P.p_() + (size_t)(tokb + tq) * NPAD + C_DQ + hq * 128 + hi * 8;
    const bf16_t* Kh = P.kvc_() + (size_t)tokb * 256;
    const unsigned moff = (unsigned)(tokb + tq) * 512u;
    DsaOutRow ow; ow.zb = P.p_() + (size_t)(tokb + t0) * NPAD + C_DZ; ow.gb = P.xn_() + (size_t)(tokb + t0) * MIX + 1024; ow.wid = wid;
    const int NT = (qb + 2) & ~1;
    att::attn_body<true, 256, 128, 2, DsaOutRow>(Qw, P.dsa_q_norm + cur_layer * 128, P.rope_() + (size_t)(tokb + tq) * 48, Kh, NT, P.mask_(), moff, ow, lds);
}
__device__ __forceinline__ void phase_gemm_glu(const Params& P, int layer, char* lds) {
    pg8::Gemm g; g.A = P.ybuf_(); g.Bt = P.WgluT_() + (size_t)layer * 512 * 512; g.M = NTOK; g.N = 512; g.K = 512;
    pg8::StaticOrder S; S.init(g.M, g.N, (int)gridDim.x, (int)blockIdx.x);
    pg8::EpiGlu E; E.Y = P.ybuf_(); E.ldy = 512; E.O = P.ocat_(); E.ldo = MIX; E.ooff = 512;
    pg8::gemm_phase<pg8::EpiGlu, pg8::StaticOrder, false>((PG8_LAS unsigned char*)lds, g, S, E, nullptr);
}

constexpr int CTL_Q0 = 4096;
struct OneUnit { int pm, pn; __device__ __forceinline__ bool next(int i, pg8::Unit& u) const { if (i) return false; u.pm = pm; u.pn = pn; return true; }
    __device__ __forceinline__ void a_ready(const pg8::Unit&) const {} __device__ __forceinline__ void done(const pg8::Unit&) const {} };
__device__ __forceinline__ int q_issue(unsigned* ctr) { return (int)__hip_atomic_fetch_add(ctr, 1u, __ATOMIC_RELAXED, __HIP_MEMORY_SCOPE_AGENT); }
#define Q_LOOP_BEGIN(ctr, total)  { unsigned* q_ctr_ = (ctr); const int q_total_ = (total); volatile int* q_b_ = (volatile int*)(lds + LDS_TAIL + 16); \
    for (;;) { __syncthreads(); if (TIDX() == 0) *q_b_ = q_issue(q_ctr_); __syncthreads(); const int item = __builtin_amdgcn_readfirstlane(*q_b_); if (item >= q_total_) break;
#define Q_LOOP_END  } }
__device__ __forceinline__ void unit_glu(const Params& P, int layer, int u, char* lds) {
    pg8::Gemm g; g.A = P.ybuf_(); g.Bt = P.WgluT_() + (size_t)layer * 512 * 512; g.M = NTOK; g.N = 512; g.K = 512;
    OneUnit S; S.pm = u >> 1; S.pn = u & 1;
    pg8::EpiGluGate E; E.Y = P.ybuf_(); E.Pz = P.p_(); E.G = P.xn_();
    pg8::gemm_phase<pg8::EpiGluGate, OneUnit, false>((PG8_LAS unsigned char*)lds, g, S, E, nullptr);
}
constexpr int LDS_TAIL = LDS_BYTES - 64;

__global__ __launch_bounds__(NTHR, 2) void k_mega(Params P) {
    extern __shared__ __attribute__((aligned(16))) char lds[];
    if (TIDX() == 0) *(uint4*)(lds + LDS_TAIL) = make_uint4(0u, 0u, 0u, 0u);
    __syncthreads();
    XcdBarrier bar = xcd_barrier_post(P.ctl_(), (volatile LAS unsigned*)(lds + LDS_TAIL));
    const int G = gridDim.x, B = blockIdx.x;
    phase_prologue1(P, lds); phase_rope_table(P); phase_s5_params(P); phase_rmsnorm_x(P, 0);
    xcd_barrier(bar);
    for (int layer = 0; layer < DEPTH; ++layer) {
        if (layer > 0) { phase_rmsnorm_x(P, layer); xcd_barrier(bar); }
        phase_gemm_in(P, layer, lds);
        if (layer == 0) phase_gemm_kv(P, lds);
        xcd_barrier(bar);
        phase_prep(P, layer);
        if (layer == 0) phase_memk_norm(P);
        for (int u = B; u < 256; u += G) unit_gla_a4(P, layer, u, lds);
        xcd_barrier(bar);
        Q_LOOP_BEGIN(P.ctl_() + CTL_Q0 + 64 * (layer * 2), 128 + 2048 + 256)
            if (item < 128) unit_s5(P, layer, item, lds);
            else if (item < 2176) unit_dsa_index(P, item - 128, lds);
            else gla_scan_slice(P, (item - 2176) * NTHR + TIDX());
        Q_LOOP_END
        xcd_barrier(bar);
        Q_LOOP_BEGIN(P.ctl_() + CTL_Q0 + 64 * (layer * 2 + 1), 256 + 256 + 128 + 256)
            if (item < 256) unit_dsa_attn(P, layer, item, lds);
            else if (item < 512) unit_gla_c4(P, layer, item - 256, lds);
            else if (item < 640) unit_glu(P, layer, item - 512, lds);
            else unit_mem_attn(P, layer, item - 640, lds);
        Q_LOOP_END
        xcd_barrier(bar);
        phase_gemm_out(P, layer, lds);
        xcd_barrier(bar);
    }
}

extern "C" void kernel_launch(void* const* d_in, const int* in_sizes, int n_in, void* d_out, int out_size, void* d_ws, size_t ws_size, hipStream_t stream) {
    if (n_in != 24 || ws_size < WS_END) { fprintf(stderr, "kernel_launch: unexpected n_in %d or ws_size %zu (< %zu)\n", n_in, ws_size, (size_t)WS_END); return; }
    Params P; memset(&P, 0, sizeof(P));
    P.x = (const float*)d_in[0]; P.mem = (const float*)d_in[1]; P.pos = (const int*)d_in[2]; P.ln_gain = (const float*)d_in[3]; P.w_in = (const float*)d_in[4];
    P.gla_w_up = (const float*)d_in[5]; P.gla_b_up = (const float*)d_in[6]; P.s5_a_re = (const float*)d_in[7]; P.s5_a_im = (const float*)d_in[8]; P.s5_log_step = (const float*)d_in[9];
    P.s5_b_re = (const float*)d_in[10]; P.s5_b_im = (const float*)d_in[11]; P.s5_c_re = (const float*)d_in[12]; P.s5_c_im = (const float*)d_in[13]; P.s5_d = (const float*)d_in[14];
    P.s5_w_glu = (const float*)d_in[15]; P.dsa_q_norm = (const float*)d_in[16]; P.dsa_k_norm = (const float*)d_in[17]; P.mem_norm = (const float*)d_in[18]; P.w_mem_kv = (const float*)d_in[19];
    P.mem_q_norm = (const float*)d_in[20]; P.mem_k_norm = (const float*)d_in[21]; P.out_norm = (const float*)d_in[22]; P.w_out = (const float*)d_in[23];
    P.out = (float*)d_out;
    char* ws = (char*)d_ws; P.ws = ws;
    static int grid = 0;
    if (!grid) {
        int dev = 0, cus = 0, per_cu = 0;
        (void)hipGetDevice(&dev); (void)hipDeviceGetAttribute(&cus, hipDeviceAttributeMultiprocessorCount, dev);
        (void)hipFuncSetAttribute((const void*)k_mega, hipFuncAttributeMaxDynamicSharedMemorySize, LDS_BYTES);
        (void)hipOccupancyMaxActiveBlocksPerMultiprocessor(&per_cu, (const void*)k_mega, NTHR, LDS_BYTES);
        if (per_cu < 1) fprintf(stderr, "kernel_launch: occupancy query reports %d blocks per CU\n", per_cu);
        grid = cus > 0 ? cus : 256;
    }
    (void)hipMemsetAsync(ws + WS_CTL, 0, CTL_BYTES, stream);
    hipLaunchKernelGGL(k_mega, dim3(grid), dim3(NTHR), LDS_BYTES, stream, P);
}
```

```cpp
#include <hip/hip_runtime.h>
#include <stdint.h>
#include <stdio.h>
#include <string.h>

constexpr int NB = 4, SEQ = 4096, NTOK = NB * SEQ, DM = 2048, DEPTH = 4, MEML = 256;
constexpr int NIN = 5984, NPAD = 6144, MIX = 2048;
constexpr int C_GQ = 0, C_GK = 256, C_GV = 512, C_GLR = 1024, C_GZ = 1040, C_SU = 1552, C_SZ = 2064, C_DQ = 2576, C_DK = 3088, C_DV = 3216,
              C_DIQ = 3344, C_DIK = 4368, C_DIW = 4432, C_DZ = 4448, C_MQ = 4960, C_MZ = 5472;
constexpr float EPS = 1e-6f;
constexpr int NTHR = 512;
constexpr int LDS_BYTES = 147456;

typedef unsigned short bf16_t;
typedef short bf16x8 __attribute__((ext_vector_type(8)));
typedef short s16x4 __attribute__((ext_vector_type(4)));
typedef float f32x4 __attribute__((ext_vector_type(4)));
typedef float f32x8 __attribute__((ext_vector_type(8)));
typedef float f32x16 __attribute__((ext_vector_type(16)));
typedef unsigned u32x4 __attribute__((ext_vector_type(4)));
typedef unsigned u32x2 __attribute__((ext_vector_type(2)));
#define LAS __attribute__((address_space(3)))

__device__ __forceinline__ float bf2f(bf16_t b) { return __uint_as_float(((unsigned)b) << 16); }
__device__ __forceinline__ bf16_t f2bf(float f) { unsigned u = __float_as_uint(f); u += 0x7FFFu + ((u >> 16) & 1u); return (bf16_t)(u >> 16); }
__device__ __forceinline__ unsigned pk2bf(float lo, float hi) { return (unsigned)f2bf(lo) | ((unsigned)f2bf(hi) << 16); }
__device__ __forceinline__ float sigmoidf_(float x) { return __builtin_amdgcn_rcpf(1.f + __expf(-x)); }
__device__ __forceinline__ float siluf_(float x) { return x * __builtin_amdgcn_rcpf(1.f + __expf(-x)); }

__device__ __forceinline__ int TIDX() { int t = (int)threadIdx.x; asm volatile("" : "+v"(t)); return t; }
__device__ __forceinline__ float shx(float v, int m) { const int src = ((TIDX() & 63) ^ m) << 2; return __int_as_float(__builtin_amdgcn_ds_bpermute(src, __float_as_int(v))); }
__device__ __forceinline__ float wave_sum(float v) {
#pragma unroll
    for (int o = 32; o >= 1; o >>= 1) v += shx(v, o);
    return v;
}
__device__ __forceinline__ void ld8f(const bf16_t* p, float (&v)[8]) { const u32x4 w = *(const u32x4*)p;
#pragma unroll
    for (int j = 0; j < 4; ++j) { v[2 * j] = __uint_as_float(w[j] << 16); v[2 * j + 1] = __uint_as_float(w[j] & 0xffff0000u); } }
__device__ __forceinline__ void st8f(bf16_t* p, const float (&v)[8]) { u32x4 w; w.x = pk2bf(v[0], v[1]); w.y = pk2bf(v[2], v[3]); w.z = pk2bf(v[4], v[5]); w.w = pk2bf(v[6], v[7]); *(u32x4*)p = w; }
__device__ __forceinline__ float f2bf_f(float f) { return bf2f(f2bf(f)); }

#ifndef TPROBE
#define TPROBE 0
#endif
#if TPROBE
#define TPU_START(id) do { if (TPROBE == (id) && TIDX() == 0) *(volatile unsigned long long*)(lds + LDS_BYTES - 24) = __builtin_amdgcn_s_memrealtime(); } while (0)
#define TPU_STOP(id) do { if (TPROBE == (id) && TIDX() == 0) *(volatile unsigned long long*)(lds + LDS_BYTES - 32) += __builtin_amdgcn_s_memrealtime() - *(volatile unsigned long long*)(lds + LDS_BYTES - 24); } while (0)
#else
#define TPU_START(id) do {} while (0)
#define TPU_STOP(id) do {} while (0)
#endif
#define XB_TMO      128
#define XB_XCNT(j)  (256  + 64 * (j))
#define XB_XSUB(j)  (1280 + 64 * (j))
#define XB_XGEN(j)  (2304 + 64 * (j))
#define XB_TOP      3328
#define XB_TOPGEN   3392
#define XCD_BAR_WORDS 3456
#define XB_SPIN_CAP (1u << 18)

__device__ __forceinline__ unsigned xb_ld(unsigned* p)              { return __hip_atomic_load(p, __ATOMIC_RELAXED, __HIP_MEMORY_SCOPE_AGENT); }
__device__ __forceinline__ unsigned xb_add(unsigned* p, unsigned v) { return __hip_atomic_fetch_add(p, v, __ATOMIC_RELAXED, __HIP_MEMORY_SCOPE_AGENT); }
__device__ __forceinline__ unsigned xb_xcc_id() { return (unsigned)__builtin_amdgcn_s_getreg((3 << 11) | 20) & 0xFu; }
#define XB_SPIN(cond, bar) do { unsigned _sp = 0; while (cond) { __builtin_amdgcn_s_sleep(1); \
    if ((++_sp & 255u) == 0u) { if (xb_ld(&(bar)[XB_TMO])) break; if (_sp > XB_SPIN_CAP) { atomicAdd(&(bar)[XB_TMO], 1u); break; } } } } while (0)

struct XcdBarrier {
    unsigned* bar; unsigned x;
    volatile LAS unsigned* st;
};

__device__ __forceinline__ XcdBarrier xcd_barrier_post(unsigned* bar, volatile LAS unsigned* st) {
    XcdBarrier b; b.bar = bar; b.x = xb_xcc_id(); b.st = st;
    if (TIDX() == 0) (void)xb_add(&bar[XB_XCNT(b.x)], 1u);
    return b;
}
__device__ __forceinline__ void xcd_barrier_complete(unsigned* bar, unsigned x, unsigned& nloc, unsigned& nx) {
    const unsigned G = gridDim.x * gridDim.y * gridDim.z;
    unsigned sum, cnt, mine, sp = 0u;
    for (;;) {
        sum = 0u; cnt = 0u; mine = 0u;
#pragma unroll
        for (unsigned j = 0; j < 16; ++j) { const unsigned c = xb_ld(&bar[XB_XCNT(j)]); sum += c; cnt += (c > 0u) ? 1u : 0u; mine = (j == x) ? c : mine; }
        if (sum == G) break;
        __builtin_amdgcn_s_sleep(1);
        if ((++sp & 255u) == 0u) { if (xb_ld(&bar[XB_TMO])) break; if (sp > XB_SPIN_CAP) { atomicAdd(&bar[XB_TMO], 1u); break; } }
    }
    nloc = mine > 0u ? mine : 1u; nx = cnt > 0u ? cnt : 1u;
}

__device__ __forceinline__ void xcd_barrier(const XcdBarrier& b) {
    asm volatile("s_waitcnt vmcnt(0)" ::: "memory");
    __syncthreads();
    if (TIDX() == 0) {
        unsigned* bar = b.bar; const unsigned bx = xb_xcc_id();
        __builtin_amdgcn_s_waitcnt(0);
        unsigned nloc = b.st[0], nx = b.st[1];
        if (nloc == 0u) { xcd_barrier_complete(bar, bx, nloc, nx); b.st[0] = nloc; b.st[1] = nx; }
        const unsigned old = xb_add(&bar[XB_XSUB(bx)], 1u);
        const unsigned gen = old / nloc;
        if (old + 1u == (gen + 1u) * nloc) {
            __builtin_amdgcn_fence(__ATOMIC_RELEASE, "agent");
            asm volatile("s_waitcnt vmcnt(0)" ::: "memory");
            const unsigned og = xb_add(&bar[XB_TOP], 1u);
            const unsigned tg = og / nx;
            if (og + 1u == (tg + 1u) * nx) xb_add(&bar[XB_TOPGEN], 1u);
            else XB_SPIN(xb_ld(&bar[XB_TOPGEN]) == tg, bar);
            __builtin_amdgcn_fence(__ATOMIC_ACQUIRE, "agent");
            xb_add(&bar[XB_XGEN(bx)], 1u);
            asm volatile("s_waitcnt vmcnt(0)" ::: "memory");
        } else {
            XB_SPIN(xb_ld(&bar[XB_XGEN(bx)]) == gen, bar);
            __builtin_amdgcn_fence(__ATOMIC_ACQUIRE, "agent");
            asm volatile("s_waitcnt vmcnt(0)" ::: "memory");
        }
    }
    __syncthreads();
}
namespace pg8 {
#define PG8_LAS __attribute__((address_space(3)))
typedef float f32x2 __attribute__((ext_vector_type(2)));
typedef unsigned u32x4 __attribute__((ext_vector_type(4)));
constexpr int BM = 256, BK = 64, HALF = 128, HTB = HALF * BK * 2  , STAGE_BYTES = 8 * HTB, NXCD = 8, WGM = 8;

__host__ __device__ __forceinline__ int lds_byte(int r, int c) { const int st = (r >> 4) * 2 + (c >> 5), rr = r & 15, cc = c & 31, ob = rr * 64 + cc * 2; return st * 1024 + (ob ^ (((ob >> 9) & 1) << 5)); }
__host__ __device__ __forceinline__ void stage_rc(int b, int& R, int& C) { const int st = b / 1024, sb = b % 1024, swz = sb ^ (((sb >> 9) & 1) << 5); R = (st >> 1) * 16 + swz / 64; C = (st & 1) * 32 + (swz % 64) / 2; }
__host__ __device__ __forceinline__ int perm32(int rho) { const int n = rho >> 4, i = rho & 15; return 8 * (i >> 2) + 4 * n + (i & 3); }

struct Unit { int pm, pn; };
struct Gemm { const bf16_t* A; const bf16_t* Bt; int M, N, K; };

struct StaticOrder {
    int nM, nN, nwg, G, c;
    __host__ __device__ void init(int M, int N, int G_, int c_) { nM = M / BM; nN = N / BM; nwg = nM * nN; G = G_; c = c_; }
    __host__ __device__ bool next(int i, Unit& u) const {
        const long L = (long)i * G + c; if (L >= nwg) return false;
        int wgid = (int)L; { const int q = nwg / NXCD, r = nwg % NXCD, xcd = wgid % NXCD, off = wgid / NXCD; wgid = (xcd < r ? xcd * (q + 1) : r * (q + 1) + (xcd - r) * q) + off; }
        const int nig = WGM * nN, gid = wgid / nig, fm = gid * WGM, gsz = (nM - fm) < WGM ? (nM - fm) : WGM;
        u.pm = fm + ((wgid % nig) % gsz); u.pn = (wgid % nig) / gsz; return true;
    }
    __device__ __forceinline__ void a_ready(const Unit&) const {}
    __device__ __forceinline__ void done(const Unit&) const {}
};
__device__ __forceinline__ unsigned cvt_pk_bf16(float lo, float hi) { unsigned r; asm volatile("v_cvt_pk_bf16_f32 %0, %1, %2" : "=v"(r) : "v"(lo), "v"(hi)); return r; }
struct EpiBf16Plain {
    static constexpr bool PERM = true, AFTER_DRAIN = false;
    bf16_t* O; int ldc;
    __device__ __forceinline__ void operator()(const f32x4 (&acc)[2][2][4][2], const Unit& u, int wr, int wc, int fr, int fq) const {
        const int row0 = u.pm * BM + wr * 64 + fr, col0 = u.pn * BM + wc * 32 + 8 * fq;
#pragma unroll
        for (int ai = 0; ai < 2; ++ai)
#pragma unroll
            for (int m = 0; m < 4; ++m) { bf16_t* rowp = O + (size_t)(row0 + ai * HALF + m * 16) * ldc + col0;
#pragma unroll
                for (int bj = 0; bj < 2; ++bj) { const f32x4 v0 = acc[ai][bj][m][0], v1 = acc[ai][bj][m][1];
                    u32x4 w; w.x = cvt_pk_bf16(v0[0], v0[1]); w.y = cvt_pk_bf16(v0[2], v0[3]); w.z = cvt_pk_bf16(v1[0], v1[1]); w.w = cvt_pk_bf16(v1[2], v1[3]);
                    *(u32x4*)(rowp + bj * HALF) = w; } }
    }
};
struct EpiResid {
    static constexpr bool PERM = false, AFTER_DRAIN = false;
    const float* R; float* C; int ldc;
    __device__ __forceinline__ void operator()(const f32x4 (&acc)[2][2][4][2], const Unit& u, int wr, int wc, int fr, int fq) const {
        const int row0 = u.pm * BM + wr * 64 + fr, col0 = u.pn * BM + wc * 32 + 4 * fq;
#pragma unroll
        for (int ai = 0; ai < 2; ++ai)
#pragma unroll
            for (int m = 0; m < 4; ++m) { const size_t off = (size_t)(row0 + ai * HALF + m * 16) * ldc + col0;
#pragma unroll
                for (int bj = 0; bj < 2; ++bj)
#pragma unroll
                    for (int n = 0; n < 2; ++n) { const f32x4 r = *(const f32x4*)(R + off + bj * HALF + n * 16); *(f32x4*)(C + off + bj * HALF + n * 16) = acc[ai][bj][m][n] + r; } }
    }
};
struct EpiResidMix {
    static constexpr bool PERM = true, AFTER_DRAIN = false;
    const void* R; void* C; int ldc; int r16, c16;
    __device__ __forceinline__ void operator()(const f32x4 (&acc)[2][2][4][2], const Unit& u, int wr, int wc, int fr, int fq) const {
        const int row0 = u.pm * BM + wr * 64 + fr, col0 = u.pn * BM + wc * 32 + 8 * fq;
#pragma unroll
        for (int ai = 0; ai < 2; ++ai)
#pragma unroll
            for (int m = 0; m < 4; ++m) { const size_t off = (size_t)(row0 + ai * HALF + m * 16) * ldc + col0;
                f32x4 r0[2], r1[2];
                if (r16) {
#pragma unroll
                    for (int bj = 0; bj < 2; ++bj) { const u32x4 w = *(const u32x4*)((const bf16_t*)R + off + bj * HALF);
                        r0[bj] = f32x4{__uint_as_float(w.x << 16), __uint_as_float(w.x & 0xffff0000u), __uint_as_float(w.y << 16), __uint_as_float(w.y & 0xffff0000u)};
                        r1[bj] = f32x4{__uint_as_float(w.z << 16), __uint_as_float(w.z & 0xffff0000u), __uint_as_float(w.w << 16), __uint_as_float(w.w & 0xffff0000u)}; }
                } else {
#pragma unroll
                    for (int bj = 0; bj < 2; ++bj) { r0[bj] = *(const f32x4*)((const float*)R + off + bj * HALF); r1[bj] = *(const f32x4*)((const float*)R + off + bj * HALF + 4); }
                }
#pragma unroll
                for (int bj = 0; bj < 2; ++bj) { const f32x4 v0 = acc[ai][bj][m][0] + r0[bj], v1 = acc[ai][bj][m][1] + r1[bj];
                    if (c16) { u32x4 w; w.x = cvt_pk_bf16(v0[0], v0[1]); w.y = cvt_pk_bf16(v0[2], v0[3]); w.z = cvt_pk_bf16(v1[0], v1[1]); w.w = cvt_pk_bf16(v1[2], v1[3]);
                        *(u32x4*)((bf16_t*)C + off + bj * HALF) = w; }
                    else { *(f32x4*)((float*)C + off + bj * HALF) = v0; *(f32x4*)((float*)C + off + bj * HALF + 4) = v1; } } }
    }
};
struct EpiGlu {
    static constexpr bool PERM = true, AFTER_DRAIN = false;
    const bf16_t* Y; int ldy; bf16_t* O; int ldo; int ooff;
    __device__ __forceinline__ void operator()(const f32x4 (&acc)[2][2][4][2], const Unit& u, int wr, int wc, int fr, int fq) const {
        const int row0 = u.pm * BM + wr * 64 + fr, col0 = u.pn * BM + wc * 32 + 8 * fq;
#pragma unroll
        for (int ai = 0; ai < 2; ++ai)
#pragma unroll
            for (int m = 0; m < 4; ++m) { const int row = row0 + ai * HALF + m * 16;
#pragma unroll
                for (int bj = 0; bj < 2; ++bj) { const f32x4 v0 = acc[ai][bj][m][0], v1 = acc[ai][bj][m][1];
                    const u32x4 yw = *(const u32x4*)(Y + (size_t)row * ldy + col0 + bj * HALF);
                    float y[8], g[8];
#pragma unroll
                    for (int j = 0; j < 4; ++j) { y[2 * j] = __uint_as_float(yw[j] << 16); y[2 * j + 1] = __uint_as_float(yw[j] & 0xffff0000u); }
#pragma unroll
                    for (int j = 0; j < 4; ++j) { g[j] = __builtin_amdgcn_rcpf(1.f + __expf(-v0[j])); g[4 + j] = __builtin_amdgcn_rcpf(1.f + __expf(-v1[j])); }
                    u32x4 w; w.x = cvt_pk_bf16(y[0] * g[0], y[1] * g[1]); w.y = cvt_pk_bf16(y[2] * g[2], y[3] * g[3]); w.z = cvt_pk_bf16(y[4] * g[4], y[5] * g[5]); w.w = cvt_pk_bf16(y[6] * g[6], y[7] * g[7]);
                    *(u32x4*)(O + (size_t)row * ldo + ooff + col0 + bj * HALF) = w; } }
    }
};
struct EpiGluGate {
    static constexpr bool PERM = true, AFTER_DRAIN = true;
    const bf16_t* Y; const bf16_t* Pz; bf16_t* G;
    __device__ __forceinline__ void fused(const f32x4 (&acc)[2][2][4][2], const Unit& u, int wr, int wc, int fr, int fq, PG8_LAS unsigned char* lds, int wid, int lane) const {
        constexpr int TS = 528;
        const int row0 = wr * 64 + fr, col0 = wc * 32 + 8 * fq;
#pragma unroll
        for (int ai = 0; ai < 2; ++ai)
#pragma unroll
            for (int m = 0; m < 4; ++m) { const int rl = row0 + ai * HALF + m * 16; const size_t grow = (size_t)u.pm * BM + rl;
#pragma unroll
                for (int bj = 0; bj < 2; ++bj) { const f32x4 v0 = acc[ai][bj][m][0], v1 = acc[ai][bj][m][1];
                    const u32x4 yw = *(const u32x4*)(Y + grow * 512 + u.pn * BM + col0 + bj * HALF);
                    float y[8], g[8];
#pragma unroll
                    for (int j = 0; j < 4; ++j) { y[2 * j] = __uint_as_float(yw[j] << 16); y[2 * j + 1] = __uint_as_float(yw[j] & 0xffff0000u); }
#pragma unroll
                    for (int j = 0; j < 4; ++j) { g[j] = __builtin_amdgcn_rcpf(1.f + __expf(-v0[j])); g[4 + j] = __builtin_amdgcn_rcpf(1.f + __expf(-v1[j])); }
                    u32x4 w; w.x = cvt_pk_bf16(y[0] * g[0], y[1] * g[1]); w.y = cvt_pk_bf16(y[2] * g[2], y[3] * g[3]); w.z = cvt_pk_bf16(y[4] * g[4], y[5] * g[5]); w.w = cvt_pk_bf16(y[6] * g[6], y[7] * g[7]);
                    *(PG8_LAS u32x4*)(lds + rl * TS + (col0 + bj * HALF) * 2) = w; } }
        __syncthreads();
        { const int t = wid * 64 + lane, row = t >> 1, hd = t & 1; const PG8_LAS unsigned char* src = lds + row * TS + hd * 256;
          float ss = 0.f;
#pragma unroll
          for (int i = 0; i < 16; ++i) { const u32x4 w = *(const PG8_LAS u32x4*)(src + 16 * i);
#pragma unroll
              for (int j = 0; j < 4; ++j) { const float a = __uint_as_float(w[j] << 16), b = __uint_as_float(w[j] & 0xffff0000u); ss += a * a + b * b; } }
          const float rn = rsqrtf(ss * (1.f / 128.f) + 1e-6f);
          const size_t grow = (size_t)u.pm * BM + row; const int cb = u.pn * BM + hd * 128;
          const bf16_t* zp = Pz + grow * 6144 + 2064 + cb; bf16_t* gp = G + grow * 2048 + 512 + cb;
#pragma unroll
          for (int i = 0; i < 16; ++i) { const u32x4 w = *(const PG8_LAS u32x4*)(src + 16 * i); const u32x4 zw = *(const u32x4*)(zp + 8 * i); u32x4 o;
#pragma unroll
              for (int j = 0; j < 4; ++j) { const float a = __uint_as_float(w[j] << 16), b = __uint_as_float(w[j] & 0xffff0000u), za = __uint_as_float(zw[j] << 16), zb = __uint_as_float(zw[j] & 0xffff0000u);
                  o[j] = cvt_pk_bf16(a * rn * (za * __builtin_amdgcn_rcpf(1.f + __expf(-za))), b * rn * (zb * __builtin_amdgcn_rcpf(1.f + __expf(-zb)))); }
              *(u32x4*)(gp + 8 * i) = o; } }
        __syncthreads();
    }
};
struct EpiBf16Scale {
    static constexpr bool PERM = true, AFTER_DRAIN = false;
    bf16_t* O; int ldc; const float* ssq;
    __device__ __forceinline__ void operator()(const f32x4 (&acc)[2][2][4][2], const Unit& u, int wr, int wc, int fr, int fq) const {
        const int row0 = u.pm * BM + wr * 64 + fr, col0 = u.pn * BM + wc * 32 + 8 * fq;
#pragma unroll
        for (int ai = 0; ai < 2; ++ai)
#pragma unroll
            for (int m = 0; m < 4; ++m) { const int row = row0 + ai * HALF + m * 16; bf16_t* rowp = O + (size_t)row * ldc + col0;
                float ssum = 0.f; { const f32x4* sp_ = (const f32x4*)(ssq + (size_t)row * 32);
#pragma unroll
                    for (int q = 0; q < 8; ++q) { const f32x4 t4 = sp_[q]; ssum += (t4[0] + t4[1]) + (t4[2] + t4[3]); } }
                const float s = rsqrtf(ssum * (1.f / 2048.f) + 1e-6f);
#pragma unroll
                for (int bj = 0; bj < 2; ++bj) { const f32x4 v0 = acc[ai][bj][m][0] * s, v1 = acc[ai][bj][m][1] * s;
                    u32x4 w; w.x = cvt_pk_bf16(v0[0], v0[1]); w.y = cvt_pk_bf16(v0[2], v0[3]); w.z = cvt_pk_bf16(v1[0], v1[1]); w.w = cvt_pk_bf16(v1[2], v1[3]);
                    *(u32x4*)(rowp + bj * HALF) = w; } }
    }
};
struct EpiResidNext {
    static constexpr bool PERM = false, AFTER_DRAIN = false;
    const float* R; float* C; int ldc; bf16_t* XB; float* ssq;
    __device__ __forceinline__ void operator()(const f32x4 (&acc)[2][2][4][2], const Unit& u, int wr, int wc, int fr, int fq) const {
        const int row0 = u.pm * BM + wr * 64 + fr, col0 = u.pn * BM + wc * 32 + 4 * fq;
#pragma unroll
        for (int ai = 0; ai < 2; ++ai)
#pragma unroll
            for (int m = 0; m < 4; ++m) { const int row = row0 + ai * HALF + m * 16; const size_t off = (size_t)row * ldc + col0; float ss = 0.f;
#pragma unroll
                for (int bj = 0; bj < 2; ++bj)
#pragma unroll
                    for (int n = 0; n < 2; ++n) { const f32x4 r = *(const f32x4*)(R + off + bj * HALF + n * 16); const f32x4 v = acc[ai][bj][m][n] + r;
                        *(f32x4*)(C + off + bj * HALF + n * 16) = v;
                        if (XB) { u32x2 w; w.x = cvt_pk_bf16(v[0], v[1]); w.y = cvt_pk_bf16(v[2], v[3]); *(u32x2*)(XB + off + bj * HALF + n * 16) = w; }
                        ss += v[0] * v[0] + v[1] * v[1] + v[2] * v[2] + v[3] * v[3]; }
                if (ssq) { ss += shx(ss, 16); ss += shx(ss, 32); if (fq == 0) ssq[(size_t)row * 32 + u.pn * 4 + wc] = ss; } }
    }
};
template <class Epi, class Sched, bool STAMP = false>
__device__ __forceinline__ void gemm_phase(PG8_LAS unsigned char* lds, const Gemm g, const Sched& S, const Epi& E, unsigned long long* stamps) {
    const int tid = TIDX(), wid = __builtin_amdgcn_readfirstlane(tid >> 6), lane = tid & 63, wr = wid >> 2, wc = wid & 3, fr = lane & 15, fq = lane >> 4;
    const int K = g.K, nt = K / BK;
    int ts_lo = 0, ts_hi = 0, nts = 0; const unsigned long long rt_entry = STAMP ? (unsigned long long)wall_clock64() : 0ull;
#define PG8_STAMP() do { if (STAMP && wid == 0 && nts < 64) { const unsigned long long _c = (unsigned long long)clock64(); \
        ts_lo = (lane == nts) ? (int)(unsigned)_c : ts_lo; ts_hi = (lane == nts) ? (int)(unsigned)(_c >> 32) : ts_hi; ++nts; } } while (0)
    PG8_STAMP();
    unsigned voffA[2], voffB[2];
#pragma unroll
    for (int i = 0; i < 2; ++i) { int R, C; stage_rc(tid * 16 + i * 8192, R, C); const int Rb = Epi::PERM ? ((R & ~31) + perm32(R & 31)) : R;
        voffA[i] = (unsigned)(R * K + C) * 2u; voffB[i] = (unsigned)(Rb * K + C) * 2u; }
    const size_t kstep = (size_t)(BK * 2);
    const size_t hstep = (size_t)HALF * K * 2;
    const size_t tstep = 2 * hstep;
    const unsigned ldsw = (unsigned)wid * 1024u;
    const int aoff = lds_byte(wr * 64 + fr, fq * 8), boff = lds_byte(wc * 32 + fr, fq * 8);
#define PG8_SA(b, h) (((b) * 2 + (h)) * HTB)
#define PG8_SB(b, h) ((4 + (b) * 2 + (h)) * HTB)
#define PG8_STAGE(bufoff, gbase, voff) do { _Pragma("unroll") for (int _i = 0; _i < 2; ++_i) \
        __builtin_amdgcn_global_load_lds((const unsigned*)((const char*)(gbase) + (voff)[_i]), (PG8_LAS unsigned*)(lds + (bufoff) + ldsw + _i * 8192), 16, 0, 0); } while (0)
#define PG8_LDA(dst, b, h) do { _Pragma("unroll") for (int m = 0; m < 4; ++m) _Pragma("unroll") for (int k = 0; k < 2; ++k) dst[m][k] = *(const PG8_LAS bf16x8*)(lds + PG8_SA(b, h) + aoff + m * 2048 + k * 1024); } while (0)
#define PG8_LDB(dst, b, h) do { _Pragma("unroll") for (int n = 0; n < 2; ++n) _Pragma("unroll") for (int k = 0; k < 2; ++k) dst[n][k] = *(const PG8_LAS bf16x8*)(lds + PG8_SB(b, h) + boff + n * 2048 + k * 1024); } while (0)
#define PG8_MMA(ai, bj, At, Bt) do { __builtin_amdgcn_s_setprio(1); _Pragma("unroll") for (int m = 0; m < 4; ++m) _Pragma("unroll") for (int n = 0; n < 2; ++n) _Pragma("unroll") for (int k = 0; k < 2; ++k) \
        acc[ai][bj][m][n] = __builtin_amdgcn_mfma_f32_16x16x32_bf16(Bt[n][k], At[m][k], acc[ai][bj][m][n], 0, 0, 0); __builtin_amdgcn_s_setprio(0); } while (0)
#define PG8_WAIT_V(n) asm volatile("s_waitcnt vmcnt(" #n ")" ::: "memory")
#define PG8_WAIT_L(n) asm volatile("s_waitcnt lgkmcnt(" #n ")" ::: "memory")
#define PG8_BAR __builtin_amdgcn_s_barrier()
#define PG8_SCHED __builtin_amdgcn_sched_barrier(0)
    Unit cur, nxt; int ui = 0;
    if (!S.next(0, cur)) return;
    f32x4 acc[2][2][4][2];
#pragma unroll
    for (int a = 0; a < 2; ++a)
#pragma unroll
        for (int b = 0; b < 2; ++b)
#pragma unroll
            for (int m = 0; m < 4; ++m)
#pragma unroll
                for (int n = 0; n < 2; ++n) acc[a][b][m][n] = (f32x4){0.f, 0.f, 0.f, 0.f};
    bf16x8 At[4][2], B0[2][2], B1[2][2];
    const char* cA = (const char*)g.A + (size_t)cur.pm * tstep; const char* cB = (const char*)g.Bt + (size_t)cur.pn * tstep;
    S.a_ready(cur);
    PG8_STAGE(PG8_SB(0, 0), cB, voffB); PG8_STAGE(PG8_SA(0, 0), cA, voffA); PG8_STAGE(PG8_SB(0, 1), cB + hstep, voffB); PG8_STAGE(PG8_SA(0, 1), cA + hstep, voffA);
    if (wr == 1) PG8_BAR;
    PG8_WAIT_V(4); PG8_BAR;
    PG8_STAGE(PG8_SB(1, 0), cB + kstep, voffB); PG8_STAGE(PG8_SA(1, 0), cA + kstep, voffA); PG8_STAGE(PG8_SB(1, 1), cB + hstep + kstep, voffB);
    PG8_WAIT_V(6); PG8_BAR;
    PG8_STAMP();
    for (;;) {
        const bool has_next = S.next(ui + 1, nxt);
        const char* nA = has_next ? (const char*)g.A + (size_t)nxt.pm * tstep : cA; const char* nB = has_next ? (const char*)g.Bt + (size_t)nxt.pn * tstep : cB;
        for (int t = 0; t < nt; t += 2) {
            const bool last = (t == nt - 2);
            const char* a1 = cA + (size_t)(t + 1) * kstep;
            const char* a2 = last ? nA : cA + (size_t)(t + 2) * kstep; const char* b2 = last ? nB : cB + (size_t)(t + 2) * kstep;
            const char* a3 = a2 + kstep; const char* b3 = b2 + kstep;
            if (last && has_next) S.a_ready(nxt);
            PG8_LDB(B0, 0, 0); PG8_SCHED; PG8_LDA(At, 0, 0); PG8_STAGE(PG8_SA(1, 1), a1 + hstep, voffA);
            PG8_WAIT_L(8); PG8_BAR; PG8_WAIT_L(0); PG8_MMA(0, 0, At, B0); PG8_BAR; PG8_SCHED;
            PG8_LDB(B1, 0, 1); PG8_STAGE(PG8_SB(0, 0), b2, voffB);
            PG8_BAR; PG8_WAIT_L(0); PG8_MMA(0, 1, At, B1); PG8_BAR;
            PG8_LDA(At, 0, 1); PG8_STAGE(PG8_SA(0, 0), a2, voffA);
            PG8_BAR; PG8_WAIT_L(0); PG8_MMA(1, 0, At, B0); PG8_BAR; PG8_SCHED;
            PG8_STAGE(PG8_SB(0, 1), b2 + hstep, voffB);
            PG8_WAIT_V(6); PG8_BAR; PG8_MMA(1, 1, At, B1); PG8_BAR;
            PG8_LDB(B0, 1, 0); PG8_SCHED; PG8_LDA(At, 1, 0); PG8_STAGE(PG8_SA(0, 1), a2 + hstep, voffA);
            PG8_WAIT_L(8); PG8_BAR; PG8_WAIT_L(0); PG8_MMA(0, 0, At, B0); PG8_BAR; PG8_SCHED;
            PG8_LDB(B1, 1, 1); PG8_STAGE(PG8_SB(1, 0), b3, voffB);
            PG8_BAR; PG8_WAIT_L(0); PG8_MMA(0, 1, At, B1); PG8_BAR;
            PG8_LDA(At, 1, 1); PG8_STAGE(PG8_SA(1, 0), a3, voffA);
            PG8_BAR; PG8_WAIT_L(0); PG8_MMA(1, 0, At, B0); PG8_BAR; PG8_SCHED;
            PG8_STAGE(PG8_SB(1, 1), b3 + hstep, voffB);
            PG8_WAIT_V(6); PG8_BAR; PG8_MMA(1, 1, At, B1); PG8_BAR;
        }
        PG8_STAMP();
        if constexpr (!Epi::AFTER_DRAIN) { E(acc, cur, wr, wc, fr, fq); S.done(cur); }
        PG8_STAMP();
        if (!has_next) break;
#pragma unroll
        for (int a = 0; a < 2; ++a)
#pragma unroll
            for (int b = 0; b < 2; ++b)
#pragma unroll
                for (int m = 0; m < 4; ++m)
#pragma unroll
                    for (int n = 0; n < 2; ++n) acc[a][b][m][n] = (f32x4){0.f, 0.f, 0.f, 0.f};
        cur = nxt; cA = nA; cB = nB; ++ui;
    }
    PG8_WAIT_V(0);
    if (wr == 0) PG8_BAR;
    PG8_BAR;
    if constexpr (Epi::AFTER_DRAIN) { E.fused(acc, cur, wr, wc, fr, fq, lds, wid, lane); S.done(cur); }
    PG8_STAMP();
    if (STAMP && wid == 0) { stamps[lane] = lane < nts ? (((unsigned long long)(unsigned)ts_hi << 32) | (unsigned)ts_lo) : 0ull;
        if (lane == 62) stamps[62] = rt_entry; if (lane == 63) stamps[63] = (unsigned long long)wall_clock64(); }
#undef PG8_STAMP
#undef PG8_SA
#undef PG8_SB
#undef PG8_STAGE
#undef PG8_LDA
#undef PG8_LDB
#undef PG8_MMA
#undef PG8_WAIT_V
#undef PG8_WAIT_L
#undef PG8_BAR
#undef PG8_SCHED
}
}
namespace att {
constexpr int D = 128, NW = 8, QBLK = 32, KVBLK = 64;
constexpr float SCALE = 0.088388347648318440f, THR = 8.f;
constexpr int SHM_V = KVBLK * D * 2, SHM_K = KVBLK * D * 2, SHM_ATTN = 2 * SHM_V + 2 * SHM_K + NW * 64 * 4;
#define KSWZ(row, colB) ((row) * 256 + ((colB) ^ (((row) & 7) << 4)))
#define SBAR() __builtin_amdgcn_sched_barrier(0)
__device__ __forceinline__ int crow(int r, int hi) { return (r & 3) + 8 * (r >> 2) + 4 * hi; }
__device__ __forceinline__ unsigned cvtpk(float lo, float hi) { unsigned r; asm volatile("v_cvt_pk_bf16_f32 %0, %1, %2" : "=v"(r) : "v"(lo), "v"(hi)); return r; }

template <bool MASKED>
__device__ __forceinline__ void partialSM(f32x16& p0, f32x16& p1, float& m_reg, float& mn, float& alpha, unsigned long long mw, int hi) {
  constexpr float C = SCALE * 1.4426950408889634f;
  float pmax = p0[0];
#pragma unroll
  for (int r = 1; r < 16; ++r) pmax = fmaxf(pmax, p0[r]);
#pragma unroll
  for (int r = 0; r < 16; ++r) pmax = fmaxf(pmax, p1[r]);
  { auto rr = __builtin_amdgcn_permlane32_swap(__float_as_uint(pmax), __float_as_uint(pmax), false, false);
    pmax = fmaxf(__uint_as_float(rr[0]), __uint_as_float(rr[1])); }
  if (__builtin_expect(__all(pmax - m_reg <= THR / SCALE), 1)) { mn = m_reg; alpha = 1.f; }
  else { mn = fmaxf(m_reg, pmax); alpha = __builtin_amdgcn_exp2f((m_reg - mn) * C); m_reg = mn; }
  const float mnC = -mn * C;
#pragma unroll
  for (int r = 0; r < 16; ++r) p0[r] = fmaf(p0[r], C, mnC);
#pragma unroll
  for (int r = 0; r < 16; ++r) p1[r] = fmaf(p1[r], C, mnC);
#pragma unroll
  for (int r = 0; r < 16; ++r) p0[r] = __builtin_amdgcn_exp2f(p0[r]);
}
__device__ __forceinline__ void finishSM(f32x16& p0, f32x16& p1, float alpha, float& l_reg, bf16x8& pa0, bf16x8& pa1, bf16x8& pa2, bf16x8& pa3) {
#pragma unroll
  for (int r = 0; r < 16; ++r) p1[r] = __builtin_amdgcn_exp2f(p1[r]);
  float ps = 0;
#pragma unroll
  for (int r = 0; r < 16; ++r) ps += p0[r];
#pragma unroll
  for (int r = 0; r < 16; ++r) ps += p1[r];
  { auto rr = __builtin_amdgcn_permlane32_swap(__float_as_uint(ps), __float_as_uint(ps), false, false);
    ps = __uint_as_float(rr[0]) + __uint_as_float(rr[1]); }
  l_reg = l_reg * alpha + ps;
#define PK4(P, BASE, OUT) do { unsigned a0 = cvtpk(P[BASE + 0], P[BASE + 1]), a1 = cvtpk(P[BASE + 2], P[BASE + 3]);   \
    unsigned b0 = cvtpk(P[BASE + 4], P[BASE + 5]), b1 = cvtpk(P[BASE + 6], P[BASE + 7]);                              \
    auto r0 = __builtin_amdgcn_permlane32_swap(a0, b0, false, false); auto r1 = __builtin_amdgcn_permlane32_swap(a1, b1, false, false); \
    u32x4 w = {r0[0], r1[0], r0[1], r1[1]}; OUT = *reinterpret_cast<bf16x8*>(&w); } while (0)
  PK4(p0, 0, pa0); PK4(p0, 8, pa1); PK4(p1, 0, pa2); PK4(p1, 8, pa3);
#undef PK4
}
template <int R> __device__ __forceinline__ float mask_bias(unsigned nw) {
  unsigned t; constexpr int bit = (R & 3) + 8 * (R >> 2);
  asm("v_bfe_i32 %0, %1, %2, 1\n\tv_and_b32 %0, 0xff800000, %0" : "=v"(t) : "v"(nw), "n"(bit));
  return __uint_as_float(t);
}
template <bool MASKED>
__device__ __forceinline__ void qkt(f32x16& p0, f32x16& p1, const char* Ks, const bf16x8* qr, int r32, int hi, unsigned long long mw) {
  if (MASKED) {
    const unsigned n0 = ~((unsigned)mw >> (4 * hi)), n1 = ~((unsigned)(mw >> 32) >> (4 * hi));
#define MB_(R) p0[R] = mask_bias<R>(n0); p1[R] = mask_bias<R>(n1);
    MB_(0) MB_(1) MB_(2) MB_(3) MB_(4) MB_(5) MB_(6) MB_(7) MB_(8) MB_(9) MB_(10) MB_(11) MB_(12) MB_(13) MB_(14) MB_(15)
#undef MB_
  } else { p0 = f32x16{}; p1 = f32x16{}; }
  asm volatile("" : "+v"(p0), "+v"(p1));
#pragma unroll
  for (int d0 = 0; d0 < 8; ++d0) { const int cb = (d0 * 16 + hi * 8) * 2;
    bf16x8 b0 = *reinterpret_cast<const bf16x8*>(Ks + KSWZ(r32, cb));
    bf16x8 b1 = *reinterpret_cast<const bf16x8*>(Ks + KSWZ(32 + r32, cb));
    p0 = __builtin_amdgcn_mfma_f32_32x32x16_bf16(b0, qr[d0], p0, 0, 0, 0);
    p1 = __builtin_amdgcn_mfma_f32_32x32x16_bf16(b1, qr[d0], p1, 0, 0, 0); }
}
__device__ __forceinline__ int v_st(int k, int c) { const int kk = (k & ~0xC) | ((k & 4) << 1) | ((k & 8) >> 1); return ((kk >> 3) * 4 + (c >> 5)) * 512 + ((kk & 7) * 32 + (c & 31)) * 2; }
__device__ __forceinline__ int v_rd_base(int lane) { return ((lane & 3) << 3) | (((lane >> 2) & 3) << 6) | (((lane >> 4) & 1) << 5) | (((lane >> 5) & 1) << 8); }
constexpr int v_rd_off(int d0, int ks, int half) { return d0 * 512 + ks * 4096 + half * 2048; }
template <int OFF> __device__ __forceinline__ s16x4 tr_read(int vb) {
  s16x4 r; asm volatile("ds_read_b64_tr_b16 %0, %1 offset:%2" : "=&v"(r) : "v"(vb), "i"(OFF) : "memory"); return r;
}
template <int D0> __device__ __forceinline__ void pv_one(f32x16& od, int vb, bf16x8 pa0, bf16x8 pa1, bf16x8 pa2, bf16x8 pa3) {
  const s16x4 l0 = tr_read<v_rd_off(D0, 0, 0)>(vb), h0 = tr_read<v_rd_off(D0, 0, 1)>(vb), l1 = tr_read<v_rd_off(D0, 1, 0)>(vb), h1 = tr_read<v_rd_off(D0, 1, 1)>(vb);
  const s16x4 l2 = tr_read<v_rd_off(D0, 2, 0)>(vb), h2 = tr_read<v_rd_off(D0, 2, 1)>(vb), l3 = tr_read<v_rd_off(D0, 3, 0)>(vb), h3 = tr_read<v_rd_off(D0, 3, 1)>(vb);
  asm volatile("s_waitcnt lgkmcnt(0)" ::: "memory"); SBAR();
#define PK(L, H) (bf16x8){L[0], L[1], L[2], L[3], H[0], H[1], H[2], H[3]}
  od = __builtin_amdgcn_mfma_f32_32x32x16_bf16(pa0, PK(l0, h0), od, 0, 0, 0);
  od = __builtin_amdgcn_mfma_f32_32x32x16_bf16(pa1, PK(l1, h1), od, 0, 0, 0);
  od = __builtin_amdgcn_mfma_f32_32x32x16_bf16(pa2, PK(l2, h2), od, 0, 0, 0);
  od = __builtin_amdgcn_mfma_f32_32x32x16_bf16(pa3, PK(l3, h3), od, 0, 0, 0);
#undef PK
}
__device__ __forceinline__ void pv_d0(f32x16* o, int vb, bf16x8 pa0, bf16x8 pa1, bf16x8 pa2, bf16x8 pa3) {
  pv_one<0>(o[0], vb, pa0, pa1, pa2, pa3); pv_one<1>(o[1], vb, pa0, pa1, pa2, pa3); pv_one<2>(o[2], vb, pa0, pa1, pa2, pa3); pv_one<3>(o[3], vb, pa0, pa1, pa2, pa3);
}

template <bool MASKED, int LDK, int VOFF, int QT, class OutRow>
__device__ __forceinline__ void attn_body(const bf16_t* __restrict__ Qw, const float* __restrict__ qgain, const float* __restrict__ qcs, const bf16_t* __restrict__ Kh, int NT,
                                          const unsigned long long* __restrict__ mbase, unsigned moff, const OutRow& Ow, char* lds) {
  const int tid = TIDX(), wid = tid >> 6, lane = tid & 63, r32 = lane & 31, hi = lane >> 5;
  char* V_lds = lds; char* K_lds = lds + 2 * SHM_V;
  float* ws = (float*)(lds + 2 * SHM_V + 2 * SHM_K) + wid * 64; float* li_l = ws; float* al_l = ws + 32;
  float m_reg = -1e30f, l_reg = 0; f32x16 o[4] = {}; bf16x8 qr[8];
  asm volatile("" : "+v"(o[0]), "+v"(o[1]), "+v"(o[2]), "+v"(o[3]));
#pragma unroll
  for (int d0 = 0; d0 < 8; ++d0) qr[d0] = *reinterpret_cast<const bf16x8*>(Qw + d0 * 16);
  if (QT) {
    float ss = 0.f;
#pragma unroll
    for (int d0 = 0; d0 < 8; ++d0)
#pragma unroll
      for (int j = 0; j < 8; ++j) { const float x = bf2f((bf16_t)qr[d0][j]); ss += x * x; }
    { auto rr = __builtin_amdgcn_permlane32_swap(__float_as_uint(ss), __float_as_uint(ss), false, false); ss = __uint_as_float(rr[0]) + __uint_as_float(rr[1]); }
    const float rn = rsqrtf(ss * (1.f / 128.f) + EPS);
    float x01[2][8];
#pragma unroll
    for (int d0 = 0; d0 < 8; ++d0) { const f32x4 g0 = *(const f32x4*)(qgain + d0 * 16 + hi * 8), g1 = *(const f32x4*)(qgain + d0 * 16 + hi * 8 + 4);
      float x[8];
#pragma unroll
      for (int j = 0; j < 8; ++j) x[j] = bf2f((bf16_t)qr[d0][j]) * rn * (j < 4 ? g0[j] : g1[j - 4]);
      if (QT == 2 && d0 < 2) {
#pragma unroll
        for (int j = 0; j < 8; ++j) x01[d0][j] = x[j];
      } else { u32x4 w = {cvtpk(x[0], x[1]), cvtpk(x[2], x[3]), cvtpk(x[4], x[5]), cvtpk(x[6], x[7])}; qr[d0] = *reinterpret_cast<bf16x8*>(&w); } }
    if (QT == 2) {
      float a[8], b[8];
#pragma unroll
      for (int j2 = 0; j2 < 4; ++j2) { const f32x4 cs = *(const f32x4*)(qcs + hi * 16 + 4 * j2);
#pragma unroll
        for (int q = 0; q < 2; ++q) { const int j = 2 * j2 + q; const float c = cs[2 * q], sn = cs[2 * q + 1], x1 = x01[0][j], x2 = x01[1][j]; a[j] = x1 * c - x2 * sn; b[j] = x2 * c + x1 * sn; } }
      { u32x4 w = {cvtpk(a[0], a[1]), cvtpk(a[2], a[3]), cvtpk(a[4], a[5]), cvtpk(a[6], a[7])}; qr[0] = *reinterpret_cast<bf16x8*>(&w); }
      { u32x4 w = {cvtpk(b[0], b[1]), cvtpk(b[2], b[3]), cvtpk(b[4], b[5]), cvtpk(b[6], b[7])}; qr[1] = *reinterpret_cast<bf16x8*>(&w); }
    }
  }
  const int sr = tid >> 4, sc = (tid & 15) * 8, vst0 = v_st(sr, sc), vst1 = v_st(32 + sr, sc);
  const int vb0 = (int)(uintptr_t)V_lds + v_rd_base(lane);
  struct { bf16x8 vs0, vs1, ks0, ks1; } sr_[2];
  const unsigned koff = (unsigned)(sr * LDK + sc) * 2u;
#define SLOAD(i, k0) do { const char* kb_ = (const char*)Kh + (size_t)(k0) * (LDK * 2); \
    sr_[i].vs0 = *reinterpret_cast<const bf16x8*>(kb_ + koff + VOFF * 2); sr_[i].vs1 = *reinterpret_cast<const bf16x8*>(kb_ + koff + (32 * LDK + VOFF) * 2); \
    sr_[i].ks0 = *reinterpret_cast<const bf16x8*>(kb_ + koff); sr_[i].ks1 = *reinterpret_cast<const bf16x8*>(kb_ + koff + 32 * LDK * 2); } while (0)
#define SWRITE(b, i) do { *(bf16x8*)(V_lds + (b) * SHM_V + vst0) = sr_[i].vs0;          \
    *(bf16x8*)(V_lds + (b) * SHM_V + vst1) = sr_[i].vs1; int kc = sc * 2;               \
    *(bf16x8*)(K_lds + (b) * SHM_K + KSWZ(sr, kc)) = sr_[i].ks0;                       \
    *(bf16x8*)(K_lds + (b) * SHM_K + KSWZ(32 + sr, kc)) = sr_[i].ks1; } while (0)
#define SWAIT() asm volatile("s_waitcnt vmcnt(4)" ::: "memory")
#define RESC(a) do { if (__any((a) < 1.f)) { if (hi == 0) al_l[r32] = (a); asm volatile("s_waitcnt lgkmcnt(0)" ::: "memory"); \
    _Pragma("unroll") for (int d = 0; d < 4; ++d) _Pragma("unroll") for (int r = 0; r < 16; ++r) o[d][r] *= al_l[crow(r, hi)]; } } while (0)
  f32x16 pA0, pA1, pB0, pB1; float mnA, mnB, alA, alB; bf16x8 pa0, pa1, pa2, pa3;
  unsigned long long mw = 0ull;
  constexpr int SE = 0, SO = 1;
  if (MASKED) mw = *(const unsigned long long*)((const char*)mbase + moff);
  SLOAD(SE, 0); SLOAD(SO, KVBLK);
  SWAIT(); SWRITE(0, SE); __syncthreads();
  qkt<MASKED>(pA0, pA1, K_lds, qr, r32, hi, mw);
  if (MASKED) mw = *(const unsigned long long*)((const char*)mbase + (moff + 8u));
  partialSM<MASKED>(pA0, pA1, m_reg, mnA, alA, mw, hi);
  SLOAD(SE, (2 < NT ? 2 : NT - 1) * KVBLK);
  SWAIT();
  SWRITE(1, SO); __syncthreads();
  for (int j = 1; j + 1 < NT; j += 2) {
    SBAR(); qkt<MASKED>(pB0, pB1, K_lds + SHM_K, qr, r32, hi, mw);
    if (MASKED) mw = *(const unsigned long long*)((const char*)mbase + (moff + 8u * (unsigned)(j + 1)));
    finishSM(pA0, pA1, alA, l_reg, pa0, pa1, pa2, pa3); SBAR();
    SLOAD(SO, (j + 2) * KVBLK); SBAR();
    pv_d0(o, vb0, pa0, pa1, pa2, pa3); partialSM<MASKED>(pB0, pB1, m_reg, mnB, alB, mw, hi);
    __syncthreads(); if (MASKED) asm volatile("s_waitcnt vmcnt(5)" ::: "memory"); else SWAIT();
    SWRITE(0, SE);
    RESC(alB); __syncthreads();
    SBAR(); qkt<MASKED>(pA0, pA1, K_lds, qr, r32, hi, mw);
    if (MASKED) mw = *(const unsigned long long*)((const char*)mbase + (moff + 8u * (unsigned)(j + 2)));
    finishSM(pB0, pB1, alB, l_reg, pa0, pa1, pa2, pa3); SBAR();
    SLOAD(SE, (j + 3 < NT ? j + 3 : NT - 1) * KVBLK); SBAR();
    pv_d0(o, vb0 + SHM_V, pa0, pa1, pa2, pa3); partialSM<MASKED>(pA0, pA1, m_reg, mnA, alA, mw, hi);
    __syncthreads(); if (MASKED) asm volatile("s_waitcnt vmcnt(5)" ::: "memory"); else SWAIT();
    SWRITE(1, SO);
    RESC(alA); __syncthreads();
  }
  SBAR(); qkt<MASKED>(pB0, pB1, K_lds + SHM_K, qr, r32, hi, mw);
  finishSM(pA0, pA1, alA, l_reg, pa0, pa1, pa2, pa3); SBAR();
  pv_d0(o, vb0, pa0, pa1, pa2, pa3); partialSM<MASKED>(pB0, pB1, m_reg, mnB, alB, mw, hi);
  __syncthreads(); RESC(alB);
  finishSM(pB0, pB1, alB, l_reg, pa0, pa1, pa2, pa3); SBAR();
  pv_d0(o, vb0 + SHM_V, pa0, pa1, pa2, pa3);
  if (hi == 0) li_l[r32] = l_reg; asm volatile("s_waitcnt lgkmcnt(0)" ::: "memory");
  float rli[16];
#pragma unroll
  for (int r = 0; r < 16; ++r) rli[r] = __builtin_amdgcn_rcpf(li_l[crow(r, hi)]);
  __syncthreads();
  float* og_s = (float*)lds + wid * (32 * 132);
#pragma unroll
  for (int r = 0; r < 16; ++r) {
#pragma unroll
    for (int d0 = 0; d0 < 4; ++d0) og_s[crow(r, hi) * 132 + d0 * 32 + r32] = o[d0][r] * rli[r]; }
  asm volatile("" ::: "memory");
  { const int row = lane >> 1, half = lane & 1; const float* src = og_s + row * 132 + half * 64;
    f32x4 v[16]; float ss = 0.f;
#pragma unroll
    for (int i = 0; i < 16; ++i) { v[i] = *(const f32x4*)(src + 4 * i); ss += v[i][0] * v[i][0] + v[i][1] * v[i][1] + v[i][2] * v[i][2] + v[i][3] * v[i][3]; }
    ss += shx(ss, 1);
    const float rn = rsqrtf(ss * (1.f / 128.f) + EPS);
    const bf16_t* zp = Ow.zrow(row) + half * 64; bf16_t* gp = Ow.grow(row) + half * 64;
#pragma unroll
    for (int i = 0; i < 8; ++i) { float z[8], g[8]; ld8f(zp + 8 * i, z);
#pragma unroll
      for (int q = 0; q < 4; ++q) { g[q] = v[2 * i][q] * rn * siluf_(z[q]); g[4 + q] = v[2 * i + 1][q] * rn * siluf_(z[4 + q]); }
      st8f(gp + 8 * i, g); } }
  __syncthreads();
#undef SLOAD
#undef SWRITE
#undef SWAIT
#undef RESC
}
}
constexpr size_t al256(size_t x) { return (x + 255) / 256 * 256; }
constexpr size_t WS_CTL   = 0;
constexpr size_t CTL_BYTES = 65536;
constexpr size_t WS_WINT  = WS_CTL + CTL_BYTES;
constexpr size_t WS_WOUTT = WS_WINT + al256((size_t)DEPTH * NPAD * DM * 2);
constexpr size_t WS_WKVT  = WS_WOUTT + al256((size_t)DEPTH * DM * MIX * 2);
constexpr size_t WS_WGLUT = WS_WKVT + al256((size_t)DEPTH * 1024 * DM * 2);
constexpr size_t WS_MEMN  = WS_WGLUT + al256((size_t)DEPTH * 512 * 512 * 2);
constexpr size_t WS_KVMEM = WS_MEMN + al256((size_t)NB * MEML * DM * 2);
constexpr size_t WS_XN    = WS_KVMEM + al256((size_t)NB * MEML * DEPTH * 1024 * 2);
constexpr size_t WS_P     = WS_XN + al256((size_t)NTOK * DM * 2);
constexpr size_t WS_XBUF  = WS_P + al256((size_t)NTOK * NPAD * 2);
constexpr size_t WS_OCAT  = WS_XBUF + al256((size_t)NTOK * DM * 4);
constexpr size_t WS_MASK  = WS_OCAT + al256((size_t)NTOK * MIX * 2);
constexpr size_t WS_IW    = WS_MASK + al256((size_t)NTOK * 64 * 8);
constexpr size_t WS_YBUF  = WS_IW + al256((size_t)NTOK * 16 * 4);
constexpr size_t WS_ROPE  = WS_YBUF + al256((size_t)NTOK * 512 * 2);
constexpr size_t WS_S5P   = WS_ROPE + al256((size_t)NTOK * 48 * 4);
constexpr size_t S5P_BYTES = (size_t)DEPTH * 32 * (64 * 2 + 64 * 2 + 64 * 16 * 2) * 4;
constexpr size_t WS_GLAS  = WS_S5P + al256(S5P_BYTES);
constexpr size_t WS_GLAD  = WS_GLAS + al256((size_t)NB * 64 * 4 * 64 * 128 * 4);
constexpr size_t WS_IKC   = WS_GLAD + al256((size_t)NB * 64 * 4 * 64 * 4);
constexpr size_t WS_KVC   = WS_IKC + al256((size_t)NTOK * 64 * 2);
constexpr size_t WS_IQL   = WS_KVC + al256((size_t)NTOK * 256 * 2);
constexpr size_t WS_SSQ   = WS_IQL + al256((size_t)NTOK * 64 * 2);
constexpr size_t DSP_SLOT = (size_t)(256 * 128 + 512) * 4;
constexpr size_t WS_DSP   = WS_SSQ + 256;
constexpr size_t WS_END   = WS_DSP + al256((size_t)160 * 2 * DSP_SLOT);

struct Params {
    const float* x; const float* mem; const int* pos; const float* ln_gain; const float* w_in; const float* gla_w_up; const float* gla_b_up;
    const float* s5_a_re; const float* s5_a_im; const float* s5_log_step; const float* s5_b_re; const float* s5_b_im; const float* s5_c_re; const float* s5_c_im;
    const float* s5_d; const float* s5_w_glu; const float* dsa_q_norm; const float* dsa_k_norm; const float* mem_norm; const float* w_mem_kv;
    const float* mem_q_norm; const float* mem_k_norm; const float* out_norm; const float* w_out;
    float* out;
    char* ws;
    __device__ __forceinline__ unsigned* ctl_() const { return (unsigned*)(ws + WS_CTL); }
    __device__ __forceinline__ bf16_t* WinT_() const { return (bf16_t*)(ws + WS_WINT); }
    __device__ __forceinline__ bf16_t* WoutT_() const { return (bf16_t*)(ws + WS_WOUTT); }
    __device__ __forceinline__ bf16_t* WkvT_() const { return (bf16_t*)(ws + WS_WKVT); }
    __device__ __forceinline__ bf16_t* WgluT_() const { return (bf16_t*)(ws + WS_WGLUT); }
    __device__ __forceinline__ bf16_t* memn_() const { return (bf16_t*)(ws + WS_MEMN); }
    __device__ __forceinline__ bf16_t* kvmem_() const { return (bf16_t*)(ws + WS_KVMEM); }
    __device__ __forceinline__ bf16_t* xn_() const { return (bf16_t*)(ws + WS_XN); }
    __device__ __forceinline__ bf16_t* p_() const { return (bf16_t*)(ws + WS_P); }
    __device__ __forceinline__ bf16_t* xbuf_() const { return (bf16_t*)(ws + WS_XBUF); }
    __device__ __forceinline__ bf16_t* ocat_() const { return (bf16_t*)(ws + WS_OCAT); }
    __device__ __forceinline__ unsigned long long* mask_() const { return (unsigned long long*)(ws + WS_MASK); }
    __device__ __forceinline__ float* iw_() const { return (float*)(ws + WS_IW); }
    __device__ __forceinline__ bf16_t* ybuf_() const { return (bf16_t*)(ws + WS_YBUF); }
    __device__ __forceinline__ float* rope_() const { return (float*)(ws + WS_ROPE); }
    __device__ __forceinline__ float* s5p_() const { return (float*)(ws + WS_S5P); }
    __device__ __forceinline__ float* glas_() const { return (float*)(ws + WS_GLAS); }
    __device__ __forceinline__ float* glad_() const { return (float*)(ws + WS_GLAD); }
    __device__ __forceinline__ bf16_t* ikc_() const { return (bf16_t*)(ws + WS_IKC); }
    __device__ __forceinline__ bf16_t* kvc_() const { return (bf16_t*)(ws + WS_KVC); }
    __device__ __forceinline__ float* ssq_() const { return (float*)(ws + WS_SSQ); }
    __device__ __forceinline__ bf16_t* iql_() const { return (bf16_t*)(ws + WS_IQL); }
    __device__ __forceinline__ char* dsp_() const { return ws + WS_DSP; }
};

__device__ __forceinline__ void transpose_tiles(const float* __restrict__ src, int K, int Nsrc, int Ndst, const float* __restrict__ scale, bf16_t* __restrict__ dst,
                                                int tile, float* lds_tile  ) {
    const int tid = TIDX(), ntn = Ndst / 256;
    const int tk = tile / ntn, tn = tile % ntn, k0 = tk * 64, n0 = tn * 256;
    __syncthreads();
    { const int ty = tid >> 4, tx = tid & 15;
      f32x4 v[2][4];
#pragma unroll
      for (int i = 0; i < 2; ++i)
#pragma unroll
        for (int q = 0; q < 4; ++q) { const int k = k0 + ty + 32 * i, n = n0 + 4 * tx + 64 * q;
          v[i][q] = (f32x4){0.f, 0.f, 0.f, 0.f};
          if (n < Nsrc) v[i][q] = *(const f32x4*)(src + (size_t)k * Nsrc + n); }
#pragma unroll
      for (int i = 0; i < 2; ++i) { const float s = scale ? scale[k0 + ty + 32 * i] : 1.f;
#pragma unroll
        for (int q = 0; q < 4; ++q) { float* t = lds_tile + (ty + 32 * i) * 257 + 4 * tx + 64 * q; t[0] = v[i][q][0] * s; t[1] = v[i][q][1] * s; t[2] = v[i][q][2] * s; t[3] = v[i][q][3] * s; } } }
    __syncthreads();
    { const int n = tid >> 1, kh = (tid & 1) * 32;
#pragma unroll
      for (int j = 0; j < 4; ++j) { const int kb = kh + 8 * j; u32x4 w;
        w.x = pk2bf(lds_tile[(kb + 0) * 257 + n], lds_tile[(kb + 1) * 257 + n]); w.y = pk2bf(lds_tile[(kb + 2) * 257 + n], lds_tile[(kb + 3) * 257 + n]);
        w.z = pk2bf(lds_tile[(kb + 4) * 257 + n], lds_tile[(kb + 5) * 257 + n]); w.w = pk2bf(lds_tile[(kb + 6) * 257 + n], lds_tile[(kb + 7) * 257 + n]);
        *(u32x4*)(dst + (size_t)(n0 + n) * K + k0 + kb) = w; } }
}

__device__ __forceinline__ void rmsnorm_rows(const float* __restrict__ X, bf16_t* __restrict__ Y, int nrows) {
    const int wid = TIDX() >> 6, lane = TIDX() & 63;
    for (int row = blockIdx.x * 8 + wid; row < nrows; row += gridDim.x * 8) {
        const float* xr = X + (size_t)row * DM; f32x4 v[8]; float ss = 0.f;
#pragma unroll
        for (int i = 0; i < 8; ++i) { v[i] = *(const f32x4*)(xr + 4 * lane + 256 * i); ss += v[i][0] * v[i][0] + v[i][1] * v[i][1] + v[i][2] * v[i][2] + v[i][3] * v[i][3]; }
        ss = wave_sum(ss); const float r = rsqrtf(ss * (1.f / DM) + EPS);
        bf16_t* yr = Y + (size_t)row * DM;
#pragma unroll
        for (int i = 0; i < 8; ++i) { u32x2 w; w.x = pk2bf(v[i][0] * r, v[i][1] * r); w.y = pk2bf(v[i][2] * r, v[i][3] * r); *(u32x2*)(yr + 4 * lane + 256 * i) = w; }
    }
}

__device__ __forceinline__ void rmsnorm_rows16(const bf16_t* __restrict__ X, bf16_t* __restrict__ Y, int nrows) {
    const int wid = TIDX() >> 6, lane = TIDX() & 63;
    for (int row = blockIdx.x * 8 + wid; row < nrows; row += gridDim.x * 8) {
        const bf16_t* xr = X + (size_t)row * DM; float v[4][8]; float ss = 0.f;
#pragma unroll
        for (int i = 0; i < 4; ++i) { ld8f(xr + 8 * lane + 512 * i, v[i]);
#pragma unroll
            for (int j = 0; j < 8; ++j) ss += v[i][j] * v[i][j]; }
        ss = wave_sum(ss); const float r = rsqrtf(ss * (1.f / DM) + EPS);
        bf16_t* yr = Y + (size_t)row * DM;
#pragma unroll
        for (int i = 0; i < 4; ++i) { float o[8];
#pragma unroll
            for (int j = 0; j < 8; ++j) o[j] = v[i][j] * r;
            st8f(yr + 8 * lane + 512 * i, o); }
    }
}

__device__ __forceinline__ void rows_bf16_ssq(const float* __restrict__ X, bf16_t* __restrict__ Y, float* __restrict__ ssq, int nrows) {
    const int wid = TIDX() >> 6, lane = TIDX() & 63;
    for (int row = blockIdx.x * 8 + wid; row < nrows; row += gridDim.x * 8) {
        const float* xr = X + (size_t)row * DM; bf16_t* yr = Y + (size_t)row * DM; float ss = 0.f;
#pragma unroll
        for (int i = 0; i < 8; ++i) { const f32x4 v = *(const f32x4*)(xr + 4 * lane + 256 * i); ss += v[0] * v[0] + v[1] * v[1] + v[2] * v[2] + v[3] * v[3];
            u32x2 w; w.x = pk2bf(v[0], v[1]); w.y = pk2bf(v[2], v[3]); *(u32x2*)(yr + 4 * lane + 256 * i) = w; }
        ss = wave_sum(ss); if (lane < 32) ssq[(size_t)row * 32 + lane] = (lane == 0) ? ss : 0.f;
    }
}
__device__ __forceinline__ void phase_prologue1(const Params& P, char* lds) {
    float* tile = (float*)lds;
    constexpr int T_IN = (DM / 64) * (NPAD / 256), T_OUT = (MIX / 64) * (DM / 256), T_KV = (DM / 64) * (1024 / 256), T_GLU = 8 * 2;
    constexpr int TOT = DEPTH * (T_IN + T_OUT + T_KV + T_GLU);
    for (int u = blockIdx.x; u < TOT; u += gridDim.x) {
        int l = u / (T_IN + T_OUT + T_KV + T_GLU), r = u % (T_IN + T_OUT + T_KV + T_GLU);
        if (r < T_IN) transpose_tiles(P.w_in + (size_t)l * DM * NIN, DM, NIN, NPAD, P.ln_gain + l * DM, P.WinT_() + (size_t)l * NPAD * DM, r, tile);
        else if ((r -= T_IN) < T_OUT) transpose_tiles(P.w_out + (size_t)l * MIX * DM, MIX, DM, DM, P.out_norm + l * MIX, P.WoutT_() + (size_t)l * DM * MIX, r, tile);
        else if ((r -= T_OUT) < T_KV) transpose_tiles(P.w_mem_kv + (size_t)l * DM * 1024, DM, 1024, 1024, P.mem_norm + l * DM, P.WkvT_() + (size_t)l * 1024 * DM, r, tile);
        else { r -= T_KV; transpose_tiles(P.s5_w_glu + (size_t)l * 512 * 512, 512, 512, 512, nullptr, P.WgluT_() + (size_t)l * 512 * 512, r, tile); }
    }
    rmsnorm_rows(P.mem, P.memn_(), NB * MEML);
}
__device__ __forceinline__ void phase_rope_table(const Params& P) {
    for (int idx = blockIdx.x * NTHR + TIDX(); idx < NTOK * 24; idx += gridDim.x * NTHR) {
        const int tok = idx / 24, i = idx % 24;
        const float e = (i < 16) ? -((float)i * 2.0f / 32.0f) : -((float)(i - 16) * 2.0f / 16.0f);
        const float inv_freq = exp2f(e * 18.931568569324174f);
        const float ang = (float)P.pos[tok] * inv_freq;
        const double a = (double)ang; const double k = rint(a * 0.15915494309189535); const float rf = (float)fma(-k, 6.283185307179586, a);
        P.rope_()[(size_t)idx * 2] = cosf(rf); P.rope_()[(size_t)idx * 2 + 1] = sinf(rf);
    }
}

__device__ __forceinline__ void phase_rmsnorm_x(const Params& P, int layer) { if (layer == 0) rmsnorm_rows(P.x, P.xn_(), NTOK); else rmsnorm_rows16(P.xbuf_(), P.xn_(), NTOK); }

__device__ __forceinline__ void phase_memk_norm(const Params& P) {
    const int wid = TIDX() >> 6, lane = TIDX() & 63;
    for (int it = blockIdx.x * 8 + wid; it < NB * MEML * DEPTH * 4; it += gridDim.x * 8) {
        const int row = it / (DEPTH * 4), l = (it / 4) % DEPTH, h = it % 4;
        bf16_t* kp = P.kvmem_() + (size_t)row * (DEPTH * 1024) + l * 1024 + h * 128 + 2 * lane;
        const unsigned w = *(const unsigned*)kp; const float a = __uint_as_float(w << 16), b = __uint_as_float(w & 0xffff0000u);
        const float ss = wave_sum(a * a + b * b), r = rsqrtf(ss * (1.f / 128.f) + EPS);
        const float* g = P.mem_k_norm + l * 128 + 2 * lane;
        *(unsigned*)kp = pk2bf(a * r * g[0], b * r * g[1]);
    }
}

__device__ __forceinline__ float sum16(float v) { v += shx(v, 1); v += shx(v, 2); v += shx(v, 4); v += shx(v, 8); return v; }

__device__ __forceinline__ void head128_norm_rope_to(const bf16_t* hp, bf16_t* dp, int l16, const float* __restrict__ gain, const float* __restrict__ cs, bool rope, bool do_store) {
    float v[8]; ld8f(hp + 8 * l16, v);
    float ss = 0.f;
#pragma unroll
    for (int j = 0; j < 8; ++j) ss += v[j] * v[j];
    ss = sum16(ss); const float r = rsqrtf(ss * (1.f / 128.f) + EPS);
#pragma unroll
    for (int j = 0; j < 8; ++j) v[j] = v[j] * r * gain[8 * l16 + j];
    if (rope) {
        float o[8];
#pragma unroll
        for (int j = 0; j < 8; ++j) o[j] = shx(v[j], 2);
        if (l16 < 4) { const int fi = (l16 & 1) * 8;
#pragma unroll
            for (int j = 0; j < 8; ++j) { const float c = cs[(fi + j) * 2], s = cs[(fi + j) * 2 + 1];
                v[j] = (l16 < 2) ? (v[j] * c - o[j] * s) : (v[j] * c + o[j] * s); } }
    }
    if (do_store) st8f(dp + 8 * l16, v);
}
__device__ __forceinline__ void head128_norm_rope(bf16_t* hp, int l16, const float* __restrict__ gain, const float* __restrict__ cs, bool rope, bool do_store) { head128_norm_rope_to(hp, hp, l16, gain, cs, rope, do_store); }
__device__ __forceinline__ void rope16_inplace(bf16_t* ip, const float* __restrict__ cs) {
    float a[8], b[8]; ld8f(ip, a); ld8f(ip + 8, b);
#pragma unroll
    for (int j = 0; j < 8; ++j) { const float c = cs[2 * j], s = cs[2 * j + 1], x1 = a[j], x2 = b[j]; a[j] = x1 * c - x2 * s; b[j] = x2 * c + x1 * s; }
    st8f(ip, a); st8f(ip + 8, b);
}
struct PrepIn { u32x4 k, i0, i1, ik0, ik1, v; bf16_t w; f32x4 c32[4], c16[4]; };
__device__ __forceinline__ void prep_load(const Params& P, int tok, int lane, PrepIn& I) {
    const int l16 = lane & 15, grp = lane >> 4;
    const bf16_t* row = P.p_() + (size_t)tok * NPAD;
    I.k = *(const u32x4*)(row + C_DK + 8 * l16);
    I.i0 = *(const u32x4*)(row + C_DIQ + (lane >> 2) * 64); I.i1 = *(const u32x4*)(row + C_DIQ + (lane >> 2) * 64 + 8);
    I.ik0 = *(const u32x4*)(row + C_DIK + (lane & 3) * 16); I.ik1 = *(const u32x4*)(row + C_DIK + (lane & 3) * 16 + 8);
    I.v = *(const u32x4*)(row + C_DV + l16 * 8);
    I.w = row[C_DIW + l16];
    const float* cs32 = P.rope_() + (size_t)tok * 48;
#pragma unroll
    for (int i = 0; i < 4; ++i) { I.c32[i] = *(const f32x4*)(cs32 + (l16 & 1) * 16 + 4 * i); I.c16[i] = *(const f32x4*)(cs32 + 32 + 4 * i); }
}
__device__ __forceinline__ void unpack8(const u32x4 w, float (&v)[8]) {
    v[0] = __uint_as_float(w.x << 16); v[1] = __uint_as_float(w.x & 0xffff0000u); v[2] = __uint_as_float(w.y << 16); v[3] = __uint_as_float(w.y & 0xffff0000u);
    v[4] = __uint_as_float(w.z << 16); v[5] = __uint_as_float(w.z & 0xffff0000u); v[6] = __uint_as_float(w.w << 16); v[7] = __uint_as_float(w.w & 0xffff0000u); }
__device__ __forceinline__ void head128_nr(float (&v)[8], int l16, const float (&gain)[8], const f32x4 (&cs)[4], bool rope) {
    float ss = 0.f;
#pragma unroll
    for (int j = 0; j < 8; ++j) ss += v[j] * v[j];
    ss = sum16(ss); const float r = rsqrtf(ss * (1.f / 128.f) + EPS);
#pragma unroll
    for (int j = 0; j < 8; ++j) v[j] = v[j] * r * gain[j];
    if (rope) {
        float o[8];
#pragma unroll
        for (int j = 0; j < 8; ++j) o[j] = shx(v[j], 2);
        if (l16 < 4) {
#pragma unroll
            for (int j = 0; j < 8; ++j) { const float c = cs[j >> 1][(j & 1) * 2], s = cs[j >> 1][(j & 1) * 2 + 1];
                v[j] = (l16 < 2) ? (v[j] * c - o[j] * s) : (v[j] * c + o[j] * s); } }
    }
}
__device__ __forceinline__ void prep_finish(const Params& P, int tok, int lane, const PrepIn& I, const float (&gq)[8], const float (&gk)[8], const float (&gm)[8]) {
    const int l16 = lane & 15, grp = lane >> 4;
    bf16_t* row = P.p_() + (size_t)tok * NPAD;
    float k[8];
    unpack8(I.k, k);
    head128_nr(k, l16, gk, I.c32, true);
    if (grp == 0) st8f(P.kvc_() + (size_t)tok * 256 + 8 * l16, k);
    {
        float a[8], b[8]; unpack8(I.i0, a); unpack8(I.i1, b);
#pragma unroll
        for (int j = 0; j < 8; ++j) { const float c = I.c16[j >> 1][(j & 1) * 2], s = I.c16[j >> 1][(j & 1) * 2 + 1], x1 = a[j], x2 = b[j]; a[j] = x1 * c - x2 * s; b[j] = x2 * c + x1 * s; }
        if ((lane & 3) == 0) { st8f(row + C_DIQ + (lane >> 2) * 64, a); st8f(row + C_DIQ + (lane >> 2) * 64 + 8, b); } }
    {
        float a[8], b[8]; unpack8(I.ik0, a); unpack8(I.ik1, b);
        if ((lane & 3) == 0) {
#pragma unroll
            for (int j = 0; j < 8; ++j) { const float c = I.c16[j >> 1][(j & 1) * 2], s = I.c16[j >> 1][(j & 1) * 2 + 1], x1 = a[j], x2 = b[j]; a[j] = x1 * c - x2 * s; b[j] = x2 * c + x1 * s; } }
        if (lane < 4) { bf16_t* dst = P.ikc_() + (size_t)(tok >> 5) * 2048 + lane * 512 + (tok & 31) * 8; st8f(dst, a); st8f(dst + 256, b); } }
    if (lane >= 16 && lane < 32) *(u32x4*)(P.kvc_() + (size_t)tok * 256 + 128 + l16 * 8) = I.v;
    if (lane < 16) P.iw_()[(size_t)tok * 16 + lane] = bf2f(I.w) * (1.f / 32.f);
}
__device__ __forceinline__ void phase_prep(const Params& P, int layer) {
    const int wid = TIDX() >> 6, lane = TIDX() & 63, l16 = lane & 15;
    float gq[8], gk[8], gm[8];
#pragma unroll
    for (int j = 0; j < 8; ++j) { gq[j] = P.dsa_q_norm[layer * 128 + 8 * l16 + j]; gk[j] = P.dsa_k_norm[layer * 128 + 8 * l16 + j]; gm[j] = P.mem_q_norm[layer * 128 + 8 * l16 + j]; }
    const int stride = gridDim.x * 8;
    for (int tok = blockIdx.x * 8 + wid; tok < NTOK; tok += 2 * stride) {
        const int tok2 = tok + stride; const bool two = tok2 < NTOK;
        PrepIn A, B2;
        prep_load(P, tok, lane, A); prep_load(P, two ? tok2 : tok, lane, B2);
        prep_finish(P, tok, lane, A, gq, gk, gm);
        if (two) prep_finish(P, tok2, lane, B2, gq, gk, gm);
    }
}
struct MemOutRow { const bf16_t* zb; bf16_t* gb;
    __device__ __forceinline__ const bf16_t* zrow(int r) const { return zb + (size_t)r * NPAD; } __device__ __forceinline__ bf16_t* grow(int r) const { return gb + (size_t)r * MIX; } };
__device__ __forceinline__ void unit_mem_attn(const Params& P, int layer, int u, char* lds) {
    const int b = u >> 6, h = (u >> 4) & 3, qb = u & 15, tok0 = b * SEQ + qb * 256;
    const int wid = TIDX() >> 6, lane = TIDX() & 63, r32 = lane & 31, hi = lane >> 5;
    const bf16_t* Qw = P.p_() + (size_t)(tok0 + wid * 32 + r32) * NPAD + C_MQ + h * 128 + hi * 8;
    const bf16_t* Kh = P.kvmem_() + (size_t)(b * MEML) * (DEPTH * 1024) + layer * 1024 + h * 128;
    MemOutRow ow; ow.zb = P.p_() + (size_t)(tok0 + wid * 32) * NPAD + C_MZ + h * 128; ow.gb = P.xn_() + (size_t)(tok0 + wid * 32) * MIX + 1536 + h * 128;
    att::attn_body<false, DEPTH * 1024, 512, 1, MemOutRow>(Qw, P.mem_q_norm + layer * 128, nullptr, Kh, MEML / 64, nullptr, 0u, ow, lds);
}

__device__ __forceinline__ void phase_gate(const Params& P, int c_lo, int c_hi) {
    const int wid = TIDX() >> 6, lane = TIDX() & 63;
    const int c0 = lane * 32;
    const int seg = c0 >> 9, zc = (seg == 0 ? C_GZ : seg == 1 ? C_SZ : seg == 2 ? C_DZ : C_MZ) + (c0 & 511);
    const bool act = (c0 >= c_lo) && (c0 < c_hi);
    for (int tok = blockIdx.x * 8 + wid; tok < NTOK; tok += gridDim.x * 8) {
        if (!act) { bf16_t* gz_ = P.xn_() + (size_t)tok * MIX + c0; const u32x4 zz = {0u, 0u, 0u, 0u};
#pragma unroll
            for (int i = 0; i < 4; ++i) *(u32x4*)(gz_ + 8 * i) = zz;
            continue; }
        const bf16_t* op = P.ocat_() + (size_t)tok * MIX + c0; const bf16_t* zp = P.p_() + (size_t)tok * NPAD + zc; bf16_t* gp = P.xn_() + (size_t)tok * MIX + c0;
        float o[32]; float ss = 0.f;
#pragma unroll
        for (int i = 0; i < 4; ++i) { float v[8]; ld8f(op + 8 * i, v);
#pragma unroll
            for (int j = 0; j < 8; ++j) { o[8 * i + j] = v[j]; ss += v[j] * v[j]; } }
        ss += shx(ss, 1); ss += shx(ss, 2);
        const float r = rsqrtf(ss * (1.f / 128.f) + EPS);
#pragma unroll
        for (int i = 0; i < 4; ++i) { float z[8], g[8]; ld8f(zp + 8 * i, z);
#pragma unroll
            for (int j = 0; j < 8; ++j) g[j] = o[8 * i + j] * r * siluf_(z[j]);
            st8f(gp + 8 * i, g); }
    }
}

__device__ __forceinline__ void phase_gemm_in(const Params& P, int layer, char* lds) {
    pg8::Gemm g; g.A = P.xn_(); g.Bt = P.WinT_() + (size_t)layer * NPAD * DM; g.M = NTOK; g.N = NPAD; g.K = DM;
    pg8::StaticOrder S; S.init(g.M, g.N, (int)gridDim.x, (int)blockIdx.x);
    pg8::EpiBf16Plain E; E.O = P.p_(); E.ldc = NPAD;
    pg8::gemm_phase<pg8::EpiBf16Plain, pg8::StaticOrder, false>((PG8_LAS unsigned char*)lds, g, S, E, nullptr);
}
__device__ __forceinline__ void phase_gemm_out(const Params& P, int layer, char* lds) {
    pg8::Gemm g; g.A = P.xn_(); g.Bt = P.WoutT_() + (size_t)layer * DM * MIX; g.M = NTOK; g.N = DM; g.K = MIX;
    pg8::StaticOrder S; S.init(g.M, g.N, (int)gridDim.x, (int)blockIdx.x);
    pg8::EpiResidMix E; E.R = (layer == 0) ? (const void*)P.x : (const void*)P.xbuf_(); E.C = (layer == DEPTH - 1) ? (void*)P.out : (void*)P.xbuf_(); E.ldc = DM;
    E.r16 = (layer != 0); E.c16 = (layer != DEPTH - 1);
    pg8::gemm_phase<pg8::EpiResidMix, pg8::StaticOrder, false>((PG8_LAS unsigned char*)lds, g, S, E, nullptr);
}
__device__ __forceinline__ void phase_gemm_kv(const Params& P, char* lds) {
    pg8::Gemm g; g.A = P.memn_(); g.Bt = P.WkvT_(); g.M = NB * MEML; g.N = DEPTH * 1024; g.K = DM;
    pg8::StaticOrder S; S.init(g.M, g.N, (int)gridDim.x, (int)blockIdx.x);
    pg8::EpiBf16Plain E; E.O = P.kvmem_(); E.ldc = DEPTH * 1024;
    pg8::gemm_phase<pg8::EpiBf16Plain, pg8::StaticOrder, false>((PG8_LAS unsigned char*)lds, g, S, E, nullptr);
}
__device__ __forceinline__ void mma_tile(f32x16& acc, const char* A, int lda, const char* B, int ldb, int K, int lane) {
    const int r = lane & 31, kh = lane >> 5;
    const char* ap = A + r * lda + kh * 16; const char* bp = B + r * ldb + kh * 16;
    asm volatile("" : "+v"(acc));
    for (int k = 0; k < K; k += 16) {
        const bf16x8 a = *(const bf16x8*)(ap + k * 2); const bf16x8 b = *(const bf16x8*)(bp + k * 2);
        acc = __builtin_amdgcn_mfma_f32_32x32x16_bf16(a, b, acc, 0, 0, 0);
    }
}
__device__ __forceinline__ int crow32(int r, int hi) { return (r & 3) + 8 * (r >> 2) + 4 * hi; }
__device__ __forceinline__ float log_sigmoid_(float x) { return fminf(x, 0.f) - log1pf(__expf(-fabsf(x))); }

constexpr int GLA_ST = 144;
constexpr int GC_BST = 68;
constexpr int GC_B_BYTES = 4 * 64 * GC_BST * 4, GC_V_BYTES = 4 * 16384;
__device__ __forceinline__ float* gla_gb(const Params& P) { return (float*)((char*)P.ocat_() + (size_t)32 * 1024 * 1024); }
__device__ __forceinline__ float log_sigmoid_fast(float x) { return fminf(x, 0.f) - __logf(1.f + __expf(-fabsf(x))); }

__device__ __forceinline__ void unit_gla_a4(const Params& P, int layer, int ub, char* lds) {
    const int b = ub >> 6, n = ub & 63, tok0 = b * SEQ + n * 64;
    const int tid = TIDX(), wid = tid >> 6, lane = tid & 63, r32 = lane & 31, hi = lane >> 5, h = wid >> 1, eh = wid & 1;
    float* b_s = (float*)lds;
    char* V_s = lds;
    char* K_s = lds + GC_B_BYTES;
    float* glr_s = (float*)(lds + GC_B_BYTES + GC_V_BYTES);
    float* tot_s = glr_s + 1024;
    __syncthreads();
    const bf16_t* prow = P.p_() + (size_t)tok0 * NPAD;
    const bf16x8 glr_raw = *(const bf16x8*)(prow + (size_t)((tid & 127) >> 1) * NPAD + C_GLR + (tid & 1) * 8);
    const int gd = tid & 63, gh = (tid >> 6) & 3, gt = tid >> 8;
    float wu[16];
#pragma unroll
    for (int r = 0; r < 16; ++r) wu[r] = P.gla_w_up[((size_t)layer * 16 + r) * 256 + gh * 64 + gd];
    const float bias = P.gla_b_up[layer * 256 + gh * 64 + gd];
    bf16x8 kraw[4], vs[4][2];
    const int ks_ = tid >> 3, kc = (tid & 7) * 8;
#pragma unroll
    for (int hv = 0; hv < 4; ++hv) kraw[hv] = *(const bf16x8*)(prow + (size_t)ks_ * NPAD + C_GK + hv * 64 + kc);
    const int sr = tid >> 4, sc = (tid & 15) * 8;
#pragma unroll
    for (int hv = 0; hv < 4; ++hv) { vs[hv][0] = *(const bf16x8*)(prow + (size_t)sr * NPAD + C_GV + hv * 128 + sc); vs[hv][1] = *(const bf16x8*)(prow + (size_t)(32 + sr) * NPAD + C_GV + hv * 128 + sc); }
    if (tid < 128) {
#pragma unroll
        for (int j = 0; j < 8; ++j) glr_s[(tid >> 1) * 16 + (tid & 1) * 8 + j] = bf2f((bf16_t)glr_raw[j]); }
    __syncthreads();
    float gv[32]; float run = 0.f;
#pragma unroll
    for (int i = 0; i < 32; ++i) { const float* gr = glr_s + (gt * 32 + i) * 16; float a = bias;
#pragma unroll
        for (int r4 = 0; r4 < 4; ++r4) { const f32x4 g4 = *(const f32x4*)(gr + 4 * r4); a = fmaf(g4[0], wu[4 * r4], a); a = fmaf(g4[1], wu[4 * r4 + 1], a); a = fmaf(g4[2], wu[4 * r4 + 2], a); a = fmaf(g4[3], wu[4 * r4 + 3], a); }
        run += log_sigmoid_fast(a) * (1.f / 16.f); gv[i] = run; }
    if (gt == 0) tot_s[gh * 64 + gd] = run;
    __syncthreads();
    { const float off = gt ? tot_s[gh * 64 + gd] : 0.f; float* bp = b_s + (gh * 64 + gt * 32) * GC_BST + gd;
      float* gp = gla_gb(P) + (size_t)(tok0 + gt * 32) * 256 + gh * 64 + gd;
#pragma unroll
      for (int i = 0; i < 32; ++i) { const float v = gv[i] + off; bp[i * GC_BST] = v; gp[(size_t)i * 256] = v; }
      if (gt) P.glad_()[((size_t)((b * 64 + n) * 4 + gh)) * 64 + gd] = __expf(gv[31] + off); }
    __syncthreads();
#pragma unroll
    for (int hv = 0; hv < 4; ++hv) { const float* br = b_s + (hv * 64 + ks_) * GC_BST + kc; const float* bl = b_s + (hv * 64 + 63) * GC_BST + kc;
        const f32x4 b0 = *(const f32x4*)br, b1 = *(const f32x4*)(br + 4), l0 = *(const f32x4*)bl, l1 = *(const f32x4*)(bl + 4);
        float e[8];
#pragma unroll
        for (int j = 0; j < 8; ++j) e[j] = bf2f((bf16_t)kraw[hv][j]) * __expf((j < 4 ? l0[j] : l1[j - 4]) - (j < 4 ? b0[j] : b1[j - 4]));
        u32x4 w = {att::cvtpk(e[0], e[1]), att::cvtpk(e[2], e[3]), att::cvtpk(e[4], e[5]), att::cvtpk(e[6], e[7])};
        *(u32x4*)(K_s + hv * 16384 + att::v_st(ks_, kc)) = w; }
    __syncthreads();
    { const int vst0 = att::v_st(sr, sc), vst1 = att::v_st(32 + sr, sc);
#pragma unroll
      for (int hv = 0; hv < 4; ++hv) { *(bf16x8*)(V_s + hv * 16384 + vst0) = vs[hv][0]; *(bf16x8*)(V_s + hv * 16384 + vst1) = vs[hv][1]; } }
    __syncthreads();
    const int vb = (int)(uintptr_t)(V_s + h * 16384) + att::v_rd_base(lane), kb = (int)(uintptr_t)(K_s + h * 16384) + att::v_rd_base(lane);
    f32x16 acc[2][2] = {};
    asm volatile("" : "+v"(acc[0][0]), "+v"(acc[0][1]), "+v"(acc[1][0]), "+v"(acc[1][1]));
#define GA_PK(L, H) (bf16x8){L[0], L[1], L[2], L[3], H[0], H[1], H[2], H[3]}
#define GA_STEP(KS) do { \
    const s16x4 k0l = att::tr_read<att::v_rd_off(0, KS, 0)>(kb), k0h = att::tr_read<att::v_rd_off(0, KS, 1)>(kb), k1l = att::tr_read<att::v_rd_off(1, KS, 0)>(kb), k1h = att::tr_read<att::v_rd_off(1, KS, 1)>(kb); \
    s16x4 v0l, v0h, v1l, v1h; \
    if (eh == 0) { v0l = att::tr_read<att::v_rd_off(0, KS, 0)>(vb); v0h = att::tr_read<att::v_rd_off(0, KS, 1)>(vb); v1l = att::tr_read<att::v_rd_off(1, KS, 0)>(vb); v1h = att::tr_read<att::v_rd_off(1, KS, 1)>(vb); } \
    else         { v0l = att::tr_read<att::v_rd_off(2, KS, 0)>(vb); v0h = att::tr_read<att::v_rd_off(2, KS, 1)>(vb); v1l = att::tr_read<att::v_rd_off(3, KS, 0)>(vb); v1h = att::tr_read<att::v_rd_off(3, KS, 1)>(vb); } \
    asm volatile("s_waitcnt lgkmcnt(0)" ::: "memory"); __builtin_amdgcn_sched_barrier(0); \
    acc[0][0] = __builtin_amdgcn_mfma_f32_32x32x16_bf16(GA_PK(v0l, v0h), GA_PK(k0l, k0h), acc[0][0], 0, 0, 0); \
    acc[0][1] = __builtin_amdgcn_mfma_f32_32x32x16_bf16(GA_PK(v0l, v0h), GA_PK(k1l, k1h), acc[0][1], 0, 0, 0); \
    acc[1][0] = __builtin_amdgcn_mfma_f32_32x32x16_bf16(GA_PK(v1l, v1h), GA_PK(k0l, k0h), acc[1][0], 0, 0, 0); \
    acc[1][1] = __builtin_amdgcn_mfma_f32_32x32x16_bf16(GA_PK(v1l, v1h), GA_PK(k1l, k1h), acc[1][1], 0, 0, 0); } while (0)
    GA_STEP(0); GA_STEP(1); GA_STEP(2); GA_STEP(3);
#undef GA_STEP
#undef GA_PK
    float* dst = P.glas_() + ((size_t)((b * 64 + n) * 4 + h)) * 8192;
#pragma unroll
    for (int et = 0; et < 2; ++et)
#pragma unroll
        for (int dt = 0; dt < 2; ++dt)
#pragma unroll
            for (int r = 0; r < 16; ++r) dst[((eh * 2 + et) * 32 + att::crow(r, hi)) * 64 + dt * 32 + r32] = acc[et][dt][r];
    __syncthreads();
}

__device__ __forceinline__ void gla_scan_slice(const Params& P, int idx) {
    {
        const int el = idx & 8191, d = idx & 63, h = (idx >> 13) & 3, b = idx >> 15;
        bf16_t* gst = P.ocat_();
        float S = 0.f;
        for (int n0 = 0; n0 < 64; n0 += 8) {
            float ds[8], dc[8];
#pragma unroll
            for (int i = 0; i < 8; ++i) { const size_t cu = (size_t)((b * 64 + n0 + i) * 4 + h); ds[i] = P.glas_()[cu * 8192 + el]; dc[i] = P.glad_()[cu * 64 + d]; }
#pragma unroll
            for (int i = 0; i < 8; ++i) { const size_t cu = (size_t)((b * 64 + n0 + i) * 4 + h); gst[cu * 8192 + el] = f2bf(S); S = fmaf(dc[i], S, ds[i]); }
        }
    }
}

__device__ __forceinline__ void unit_gla_c4(const Params& P, int layer, int ub, char* lds) {
    const int b = ub >> 6, n = ub & 63, tok0 = b * SEQ + n * 64;
    const int tid = TIDX(), wid = tid >> 6, lane = tid & 63, r32 = lane & 31, hi = lane >> 5, h = wid >> 1, rh = wid & 1;
    float* b_s = (float*)lds;
    char* V_s = lds + GC_B_BYTES;
    __syncthreads();
    const bf16_t* prow = P.p_() + (size_t)tok0 * NPAD;
    bf16x8 qraw[4], kraw[2][4], vs[4][2];
    const int sr = tid >> 4, sc = (tid & 15) * 8;
#pragma unroll
    for (int hv = 0; hv < 4; ++hv) { vs[hv][0] = *(const bf16x8*)(prow + (size_t)sr * NPAD + C_GV + hv * 128 + sc); vs[hv][1] = *(const bf16x8*)(prow + (size_t)(32 + sr) * NPAD + C_GV + hv * 128 + sc); }
    f32x4 braw[8];
    { const float* gp = gla_gb(P) + (size_t)tok0 * 256 + tid * 4;
#pragma unroll
      for (int i = 0; i < 8; ++i) braw[i] = *(const f32x4*)(gp + i * 2048); }
    { const bf16_t* qp = prow + (size_t)(rh * 32 + r32) * NPAD + C_GQ + h * 64 + hi * 8;
#pragma unroll
      for (int d0 = 0; d0 < 4; ++d0) qraw[d0] = *(const bf16x8*)(qp + d0 * 16);
#pragma unroll
      for (int sh = 0; sh < 2; ++sh) { const bf16_t* kp = prow + (size_t)(sh * 32 + r32) * NPAD + C_GK + h * 64 + hi * 8;
#pragma unroll
          for (int d0 = 0; d0 < 4; ++d0) kraw[sh][d0] = *(const bf16x8*)(kp + d0 * 16); } }
    bf16x8 sfr[4][4];
    { const bf16_t* sp = P.ocat_() + ((size_t)((b * 64 + n) * 4 + h)) * 8192 + r32 * 64 + hi * 8;
#pragma unroll
      for (int eb = 0; eb < 4; ++eb)
#pragma unroll
          for (int ds = 0; ds < 4; ++ds) sfr[eb][ds] = *(const bf16x8*)(sp + eb * 32 * 64 + ds * 16); }
    { const int vst0 = att::v_st(sr, sc), vst1 = att::v_st(32 + sr, sc);
#pragma unroll
      for (int hv = 0; hv < 4; ++hv) { *(bf16x8*)(V_s + hv * 16384 + vst0) = vs[hv][0]; *(bf16x8*)(V_s + hv * 16384 + vst1) = vs[hv][1]; } }
#pragma unroll
    for (int i = 0; i < 8; ++i) { const int c = tid + 512 * i, t = c >> 6, c4 = c & 63;
        *(f32x4*)(b_s + ((c4 >> 4) * 64 + t) * GC_BST + (c4 & 15) * 4) = braw[i]; }
    __syncthreads();
    const float* bh = b_s + h * 64 * GC_BST + hi * 8;
    bf16x8 qe[4], qb[4], ke[2][4];
#pragma unroll
    for (int d0 = 0; d0 < 4; ++d0) {
        const f32x4 m0 = *(const f32x4*)(bh + 32 * GC_BST + d0 * 16), m1 = *(const f32x4*)(bh + 32 * GC_BST + d0 * 16 + 4);
        const f32x4 q0 = *(const f32x4*)(bh + (rh * 32 + r32) * GC_BST + d0 * 16), q1 = *(const f32x4*)(bh + (rh * 32 + r32) * GC_BST + d0 * 16 + 4);
        float e1[8], e2[8];
#pragma unroll
        for (int j = 0; j < 8; ++j) { const float mv = j < 4 ? m0[j] : m1[j - 4], bq = j < 4 ? q0[j] : q1[j - 4]; const float q = bf2f((bf16_t)qraw[d0][j]) * 0.125f;
            e1[j] = q * __expf(bq - mv); e2[j] = q * __expf(bq); }
        { u32x4 w = {att::cvtpk(e1[0], e1[1]), att::cvtpk(e1[2], e1[3]), att::cvtpk(e1[4], e1[5]), att::cvtpk(e1[6], e1[7])}; qe[d0] = *reinterpret_cast<bf16x8*>(&w); }
        { u32x4 w = {att::cvtpk(e2[0], e2[1]), att::cvtpk(e2[2], e2[3]), att::cvtpk(e2[4], e2[5]), att::cvtpk(e2[6], e2[7])}; qb[d0] = *reinterpret_cast<bf16x8*>(&w); }
#pragma unroll
        for (int sh = 0; sh < 2; ++sh) {
            const f32x4 k0 = *(const f32x4*)(bh + (sh * 32 + r32) * GC_BST + d0 * 16), k1 = *(const f32x4*)(bh + (sh * 32 + r32) * GC_BST + d0 * 16 + 4);
            float e3[8];
#pragma unroll
            for (int j = 0; j < 8; ++j) { const float mv = j < 4 ? m0[j] : m1[j - 4], bk = j < 4 ? k0[j] : k1[j - 4]; e3[j] = bf2f((bf16_t)kraw[sh][d0][j]) * __expf(mv - bk); }
            u32x4 w = {att::cvtpk(e3[0], e3[1]), att::cvtpk(e3[2], e3[3]), att::cvtpk(e3[4], e3[5]), att::cvtpk(e3[6], e3[7])}; ke[sh][d0] = *reinterpret_cast<bf16x8*>(&w); }
    }
    f32x16 p0 = {}, p1 = {};
    asm volatile("" : "+v"(p0), "+v"(p1));
#pragma unroll
    for (int d0 = 0; d0 < 4; ++d0) { p0 = __builtin_amdgcn_mfma_f32_32x32x16_bf16(ke[0][d0], qe[d0], p0, 0, 0, 0); p1 = __builtin_amdgcn_mfma_f32_32x32x16_bf16(ke[1][d0], qe[d0], p1, 0, 0, 0); }
    { const int t = rh * 32 + r32;
#pragma unroll
      for (int r = 0; r < 16; ++r) { const int s0 = att::crow(r, hi); p0[r] = (s0 <= t) ? p0[r] : 0.f; p1[r] = (32 + s0 <= t) ? p1[r] : 0.f; } }
    bf16x8 pa0, pa1, pa2, pa3;
#define GC_PK4(Pv, BASE, OUT) do { unsigned a0 = att::cvtpk(Pv[BASE + 0], Pv[BASE + 1]), a1 = att::cvtpk(Pv[BASE + 2], Pv[BASE + 3]);   \
    unsigned b0 = att::cvtpk(Pv[BASE + 4], Pv[BASE + 5]), b1 = att::cvtpk(Pv[BASE + 6], Pv[BASE + 7]);                              \
    auto r0 = __builtin_amdgcn_permlane32_swap(a0, b0, false, false); auto r1 = __builtin_amdgcn_permlane32_swap(a1, b1, false, false); \
    u32x4 w = {r0[0], r1[0], r0[1], r1[1]}; OUT = *reinterpret_cast<bf16x8*>(&w); } while (0)
    GC_PK4(p0, 0, pa0); GC_PK4(p0, 8, pa1); GC_PK4(p1, 0, pa2); GC_PK4(p1, 8, pa3);
#undef GC_PK4
    f32x16 o[4] = {};
    asm volatile("" : "+v"(o[0]), "+v"(o[1]), "+v"(o[2]), "+v"(o[3]));
    att::pv_d0(o, (int)(uintptr_t)(V_s + h * 16384) + att::v_rd_base(lane), pa0, pa1, pa2, pa3);
#pragma unroll
    for (int eb = 0; eb < 4; ++eb)
#pragma unroll
        for (int ds = 0; ds < 4; ++ds) o[eb] = __builtin_amdgcn_mfma_f32_32x32x16_bf16(qb[ds], sfr[eb][ds], o[eb], 0, 0, 0);
    __syncthreads();
    float* og_s = (float*)lds + wid * (32 * 132);
#pragma unroll
    for (int r = 0; r < 16; ++r) {
#pragma unroll
        for (int eb = 0; eb < 4; ++eb) og_s[att::crow(r, hi) * 132 + eb * 32 + r32] = o[eb][r]; }
    asm volatile("" ::: "memory");
    { const int row = lane >> 1, half = lane & 1; const float* src = og_s + row * 132 + half * 64;
      f32x4 v[16]; float ss = 0.f;
#pragma unroll
      for (int i = 0; i < 16; ++i) { v[i] = *(const f32x4*)(src + 4 * i); ss += v[i][0] * v[i][0] + v[i][1] * v[i][1] + v[i][2] * v[i][2] + v[i][3] * v[i][3]; }
      ss += shx(ss, 1);
      const float rn = rsqrtf(ss * (1.f / 128.f) + EPS);
      const size_t tok = (size_t)(tok0 + rh * 32 + row);
      const bf16_t* zp = P.p_() + tok * NPAD + C_GZ + h * 128 + half * 64; bf16_t* gp = P.xn_() + tok * MIX + h * 128 + half * 64;
#pragma unroll
      for (int i = 0; i < 8; ++i) { float z[8], g[8]; ld8f(zp + 8 * i, z);
#pragma unroll
          for (int q = 0; q < 4; ++q) { g[q] = v[2 * i][q] * rn * siluf_(z[q]); g[4 + q] = v[2 * i + 1][q] * rn * siluf_(z[4 + q]); }
          st8f(gp + 8 * i, g); } }
    __syncthreads();
}
constexpr int S5P_STRIDE = 2304;
__device__ __forceinline__ void phase_s5_params(const Params& P) {
    for (int idx = blockIdx.x * NTHR + TIDX(); idx < DEPTH * 32 * 64; idx += gridDim.x * NTHR) {
        const int p = idx & 63, lg = idx >> 6;
        const float ar = P.s5_a_re[idx], ai = P.s5_a_im[idx], step = expf(P.s5_log_step[lg]);
        const float mag = expf(ar * step), th = ai * step;
        const float lr = mag * cosf(th), li = mag * sinf(th);
        float* o = P.s5p_() + (size_t)lg * S5P_STRIDE;
        o[2 * p] = lr; o[2 * p + 1] = li;
        { const float mag512 = expf(512.f * ar * step); const double a = 512.0 * (double)th; const double k = rint(a * 0.15915494309189535); const float rf = (float)fma(-k, 6.283185307179586, a);
          o[128 + 2 * p] = mag512 * cosf(rf); o[128 + 2 * p + 1] = mag512 * sinf(rf); }
        const float xr = lr - 1.f, xi = li, den = 1.f / (ar * ar + ai * ai);
        const float fr = (xr * ar + xi * ai) * den, fi = (xi * ar - xr * ai) * den;
        for (int c = 0; c < 16; ++c) { const float br = P.s5_b_re[(size_t)idx * 16 + c], bi = P.s5_b_im[(size_t)idx * 16 + c];
            o[256 + (p * 16 + c) * 2] = fr * br - fi * bi; o[256 + (p * 16 + c) * 2 + 1] = fr * bi + fi * br; }
    }
}
__device__ __forceinline__ float gelu_tanh_(float x) { const float u = 0.7978845608028654f * (x + 0.044715f * x * x * x); const float e = __expf(-2.f * fabsf(u)); const float th = copysignf((1.f - e) * __builtin_amdgcn_rcpf(1.f + e), u); return 0.5f * x * (1.f + th); }

constexpr int S5_XST = 272;
constexpr int S5_UST = 48;
__device__ __forceinline__ float partner32(float v, int hi) { auto rr = __builtin_amdgcn_permlane32_swap(__float_as_uint(v), __float_as_uint(v), false, false); return __uint_as_float(hi ? rr[0] : rr[1]); }
struct S5Ctx { float l0r, l0i, l1r, l1i, q0r, q0i, q1r, q1i, dsk; char* Cm; char* Bb; char* Xs; char* Us; int lane, hi, j, rho; const bf16_t* ubase; bf16_t* ybase; };
template <bool OUT> __device__ __forceinline__ void s5_tile(const S5Ctx& C, int tok0, float& x0r, float& x0i, float& x1r, float& x1i) {
    const int hi = C.hi, j = C.j, lane = C.lane;
    if (hi == 0) { const bf16_t* up = C.ubase + (size_t)(tok0 + j) * NPAD;
        const bf16x8 w0 = *(const bf16x8*)up, w1 = *(const bf16x8*)(up + 8);
        *(bf16x8*)(C.Us + C.rho * S5_UST) = w0; *(bf16x8*)(C.Us + C.rho * S5_UST + 16) = w1; }
    asm volatile("" ::: "memory");
    f32x16 a0 = {}, a1 = {}, a2 = {}, a3 = {};
    mma_tile(a0, C.Us, S5_UST, C.Bb, S5_UST, 16, lane); mma_tile(a1, C.Us, S5_UST, C.Bb + 32 * S5_UST, S5_UST, 16, lane);
    mma_tile(a2, C.Us, S5_UST, C.Bb + 64 * S5_UST, S5_UST, 16, lane); mma_tile(a3, C.Us, S5_UST, C.Bb + 96 * S5_UST, S5_UST, 16, lane);
    float s0r[16], s0i[16], s1r[16], s1i[16];
#pragma unroll
    for (int r = 0; r < 16; ++r) {
        const float n0r = fmaf(C.l0r, x0r, fmaf(-C.l0i, x0i, a0[r])), n0i = fmaf(C.l0r, x0i, fmaf(C.l0i, x0r, a1[r])); x0r = n0r; x0i = n0i; s0r[r] = n0r; s0i[r] = n0i;
        const float n1r = fmaf(C.l1r, x1r, fmaf(-C.l1i, x1i, a2[r])), n1i = fmaf(C.l1r, x1i, fmaf(C.l1i, x1r, a3[r])); x1r = n1r; x1i = n1i; s1r[r] = n1r; s1i[r] = n1i; }
    float z0r = partner32(x0r, hi), z0i = partner32(x0i, hi), z1r = partner32(x1r, hi), z1i = partner32(x1i, hi);
    if (hi == 0) { z0r = 0.f; z0i = 0.f; z1r = 0.f; z1i = 0.f; }
    if (!OUT) {
        x0r += C.q0r * z0r - C.q0i * z0i; x0i += C.q0r * z0i + C.q0i * z0r; x1r += C.q1r * z1r - C.q1i * z1i; x1i += C.q1r * z1i + C.q1i * z1r;
    } else {
#pragma unroll
        for (int r = 0; r < 16; ++r) {
            const float t0r = C.l0r * z0r - C.l0i * z0i, t0i = C.l0r * z0i + C.l0i * z0r; z0r = t0r; z0i = t0i; s0r[r] += t0r; s0i[r] += t0i;
            const float t1r = C.l1r * z1r - C.l1i * z1i, t1i = C.l1r * z1i + C.l1i * z1r; z1r = t1r; z1i = t1i; s1r[r] += t1r; s1i[r] += t1i; }
        x0r = s0r[15]; x0i = s0i[15]; x1r = s1r[15]; x1i = s1i[15];
#pragma unroll
        for (int r = 0; r < 16; ++r) { char* xr_ = C.Xs + (r + 16 * hi) * S5_XST;
            *(bf16_t*)(xr_ + j * 2) = f2bf(s0r[r]); *(bf16_t*)(xr_ + (64 + j) * 2) = f2bf(s0i[r]);
            *(bf16_t*)(xr_ + (32 + j) * 2) = f2bf(s1r[r]); *(bf16_t*)(xr_ + (96 + j) * 2) = f2bf(s1i[r]); }
        asm volatile("" ::: "memory");
        f32x16 acc = {}; mma_tile(acc, C.Xs, S5_XST, C.Cm, S5_XST, 128, lane);
        if (j < 16) {
#pragma unroll
            for (int r = 0; r < 16; ++r) { const int t = crow32(r, hi); const int rt = ((t & 15) & 3) + 8 * ((t & 15) >> 2) + 4 * (t >> 4);
                const float y = acc[r] + C.dsk * bf2f(*(const bf16_t*)(C.Us + rt * S5_UST + j * 2));
                C.ybase[(size_t)(tok0 + t) * 512 + j] = f2bf(gelu_tanh_(y)); } }
        asm volatile("" ::: "memory");
    }
    { const float e0r = partner32(x0r, hi), e0i = partner32(x0i, hi), e1r = partner32(x1r, hi), e1i = partner32(x1i, hi);
      if (hi == 0) { x0r = e0r; x0i = e0i; x1r = e1r; x1i = e1i; } else { x0r = 0.f; x0i = 0.f; x1r = 0.f; x1i = 0.f; } }
}
__device__ __forceinline__ void unit_s5(const Params& P, int layer, int u, char* lds) {
    const int b = u >> 5, g = u & 31, tid = TIDX(), wid = tid >> 6, lane = tid & 63, hi = lane >> 5, j = lane & 31;
    char* Cm = lds;
    char* Bb = Cm + 32 * S5_XST;
    float* ends = (float*)(Bb + 128 * S5_UST);
    char* wbase = (char*)(ends + 8 * 64 * 2) + wid * (32 * S5_XST + 32 * S5_UST);
    const float* sp = P.s5p_() + (size_t)(layer * 32 + g) * S5P_STRIDE;
    __syncthreads();
    for (int i = tid; i < 32 * 128; i += NTHR) { const int c = i >> 7, pp = i & 127; float v = 0.f;
        if (c < 16) v = (pp < 64) ? P.s5_c_re[((size_t)(layer * 32 + g) * 16 + c) * 64 + pp] : -P.s5_c_im[((size_t)(layer * 32 + g) * 16 + c) * 64 + (pp - 64)];
        *(bf16_t*)(Cm + c * S5_XST + pp * 2) = f2bf(v); }
    for (int i = tid; i < 128 * 16; i += NTHR) { const int n = i >> 4, c = i & 15, nt = n >> 5, jj = n & 31, p = (nt >> 1) * 32 + jj;
        *(bf16_t*)(Bb + n * S5_UST + c * 2) = f2bf(sp[256 + (p * 16 + c) * 2 + (nt & 1)]); }
    S5Ctx C; C.Cm = Cm; C.Bb = Bb; C.Xs = wbase; C.Us = wbase + 32 * S5_XST; C.lane = lane; C.hi = hi; C.j = j;
    C.l0r = sp[2 * j]; C.l0i = sp[2 * j + 1]; C.l1r = sp[2 * (32 + j)]; C.l1i = sp[2 * (32 + j) + 1];
    { float q0r = C.l0r, q0i = C.l0i, q1r = C.l1r, q1i = C.l1i;
#pragma unroll
      for (int k = 0; k < 4; ++k) { const float a = q0r * q0r - q0i * q0i, bb = (q0r + q0r) * q0i; q0r = a; q0i = bb; const float c = q1r * q1r - q1i * q1i, d = (q1r + q1r) * q1i; q1r = c; q1i = d; }
      C.q0r = q0r; C.q0i = q0i; C.q1r = q1r; C.q1i = q1i; }
    C.dsk = P.s5_d[layer * 512 + g * 16 + (lane & 15)];
    C.rho = ((j & 15) & 3) + 8 * ((j & 15) >> 2) + 4 * (j >> 4);
    const int tokw = b * SEQ + wid * 512;
    C.ubase = P.p_() + C_SU + g * 16; C.ybase = P.ybuf_() + g * 16;
    float x0r = 0.f, x0i = 0.f, x1r = 0.f, x1i = 0.f;
    __syncthreads();
    for (int sc = 0; sc < 16; ++sc) s5_tile<false>(C, tokw + sc * 32, x0r, x0i, x1r, x1i);
    if (hi == 0) { ends[(wid * 64 + j) * 2] = x0r; ends[(wid * 64 + j) * 2 + 1] = x0i; ends[(wid * 64 + 32 + j) * 2] = x1r; ends[(wid * 64 + 32 + j) * 2 + 1] = x1i; }
    __syncthreads();
    { const float p0r = sp[128 + 2 * j], p0i = sp[128 + 2 * j + 1], p1r = sp[128 + 2 * (32 + j)], p1i = sp[128 + 2 * (32 + j) + 1];
      x0r = 0.f; x0i = 0.f; x1r = 0.f; x1i = 0.f;
      for (int w = 0; w < wid; ++w) { const float e0r = ends[(w * 64 + j) * 2], e0i = ends[(w * 64 + j) * 2 + 1], e1r = ends[(w * 64 + 32 + j) * 2], e1i = ends[(w * 64 + 32 + j) * 2 + 1];
          const float n0r = p0r * x0r - p0i * x0i + e0r, n0i = p0r * x0i + p0i * x0r + e0i, n1r = p1r * x1r - p1i * x1i + e1r, n1i = p1r * x1i + p1i * x1r + e1i;
          x0r = n0r; x0i = n0i; x1r = n1r; x1i = n1i; }
      if (hi) { x0r = 0.f; x0i = 0.f; x1r = 0.f; x1i = 0.f; } }
    for (int sc = 0; sc < 16; ++sc) s5_tile<true>(C, tokw + sc * 32, x0r, x0i, x1r, x1i);
}
constexpr int TOPK = 256;
__device__ __forceinline__ unsigned f2key(float f) { const unsigned u = __float_as_uint(f); return u ^ ((u & 0x80000000u) ? 0xffffffffu : 0x80000000u); }

__device__ __forceinline__ float relu1(float x) { const int b = __float_as_int(x); return __int_as_float(b > 0 ? b : 0); }
#define DSA_MM(acc, rt, kk) acc = __builtin_amdgcn_mfma_f32_32x32x16_bf16(afr[rt][kk], bfr[kk], acc, 0, 0, 0)
#define DSA_HS(acc, rt, q) do { s0 = fmaf(relu1(acc[4 * (q)]), wv[rt][4 * (q)], s0); s1 = fmaf(relu1(acc[4 * (q) + 1]), wv[rt][4 * (q) + 1], s1); \
                                s0 = fmaf(relu1(acc[4 * (q) + 2]), wv[rt][4 * (q) + 2], s0); s1 = fmaf(relu1(acc[4 * (q) + 3]), wv[rt][4 * (q) + 3], s1); } while (0)
#define DSA_SG() __builtin_amdgcn_sched_barrier(0)
__device__ __forceinline__ void dsa_score_tile(const bf16x8 (&afr)[4][4], const f32x16 (&wv)[4], const bf16x8 (&bfr)[4], float* sc, int col, int hi) {
    const f32x16 z16 = {};
#define DSA_M0(acc, rt) acc = __builtin_amdgcn_mfma_f32_32x32x16_bf16(afr[rt][0], bfr[0], z16, 0, 0, 0)
    f32x16 accA, accB;
    float s0, s1;
    DSA_M0(accA, 0); DSA_MM(accA, 0, 1); DSA_MM(accA, 0, 2); DSA_MM(accA, 0, 3);
    s0 = 0.f; s1 = 0.f;
    DSA_M0(accB, 1); DSA_HS(accA, 0, 0); DSA_SG(); DSA_MM(accB, 1, 1); DSA_HS(accA, 0, 1); DSA_SG();
    DSA_MM(accB, 1, 2); DSA_HS(accA, 0, 2); DSA_SG(); DSA_MM(accB, 1, 3); DSA_HS(accA, 0, 3); DSA_SG();
    sc[(0 + hi) * 4096 + col] = (s0 + s1) + 0.f;
    s0 = 0.f; s1 = 0.f;
    DSA_M0(accA, 2); DSA_HS(accB, 1, 0); DSA_SG(); DSA_MM(accA, 2, 1); DSA_HS(accB, 1, 1); DSA_SG();
    DSA_MM(accA, 2, 2); DSA_HS(accB, 1, 2); DSA_SG(); DSA_MM(accA, 2, 3); DSA_HS(accB, 1, 3); DSA_SG();
    sc[(2 + hi) * 4096 + col] = (s0 + s1) + 0.f;
    s0 = 0.f; s1 = 0.f;
    DSA_M0(accB, 3); DSA_HS(accA, 2, 0); DSA_SG(); DSA_MM(accB, 3, 1); DSA_HS(accA, 2, 1); DSA_SG();
    DSA_MM(accB, 3, 2); DSA_HS(accA, 2, 2); DSA_SG(); DSA_MM(accB, 3, 3); DSA_HS(accA, 2, 3); DSA_SG();
    asm volatile("" :: "v"(bfr[0]), "v"(bfr[1]), "v"(bfr[2]), "v"(bfr[3]));
    sc[(4 + hi) * 4096 + col] = (s0 + s1) + 0.f;
    s0 = 0.f; s1 = 0.f;
    DSA_HS(accB, 3, 0); DSA_HS(accB, 3, 1); DSA_HS(accB, 3, 2); DSA_HS(accB, 3, 3);
    sc[(6 + hi) * 4096 + col] = (s0 + s1) + 0.f;
#undef DSA_M0
}
#define DSA_CNT4(K0, K1, K2, K3) asm volatile( \
    "v_cmp_ge_u32_e64 %[m0], %[k0], %[cd]\n\tv_cmp_ge_u32_e64 %[m1], %[k1], %[cd]\n\tv_cmp_ge_u32_e64 %[m2], %[k2], %[cd]\n\tv_cmp_ge_u32_e64 %[m3], %[k3], %[cd]\n\t" \
    "v_addc_co_u32_e64 %[a0], %[m0], %[a0], 0, %[m0]\n\tv_addc_co_u32_e64 %[a1], %[m1], %[a1], 0, %[m1]\n\t" \
    "v_addc_co_u32_e64 %[a0], %[m2], %[a0], 0, %[m2]\n\tv_addc_co_u32_e64 %[a1], %[m3], %[a1], 0, %[m3]" \
    : [a0] "+v"(c0), [a1] "+v"(c1), [m0] "=&s"(sm0), [m1] "=&s"(sm1), [m2] "=&s"(sm2), [m3] "=&s"(sm3) \
    : [k0] "v"(K0), [k1] "v"(K1), [k2] "v"(K2), [k3] "v"(K3), [cd] "v"(cand))
#define DSA_CNT8(J0) do { DSA_CNT4(key[(J0)], key[(J0) + 1], key[(J0) + 2], key[(J0) + 3]); DSA_CNT4(key[(J0) + 4], key[(J0) + 5], key[(J0) + 6], key[(J0) + 7]); } while (0)

template <int J> __device__ __forceinline__ void dsa_emit(const unsigned (&key)[64], unsigned T, unsigned& wlo, unsigned& whi) {
    const unsigned long long m = __ballot(key[J] >= T);
    asm("s_nop 1\n\tv_writelane_b32 %0, %2, %4\n\tv_writelane_b32 %1, %3, %4" : "+v"(wlo), "+v"(whi) : "s"((unsigned)m), "s"((unsigned)(m >> 32)), "n"(J));
    if constexpr (J + 1 < 64) dsa_emit<J + 1>(key, T, wlo, whi);
}
__device__ __forceinline__ void unit_dsa_index(const Params& P, int u, char* lds) {
    const int b = u & 3, t0 = (511 - (u >> 2)) * 8;
    const int tid = TIDX(), wid = tid >> 6, lane = tid & 63, r32 = lane & 31, hi = lane >> 5;
    float* sc = (float*)lds;
    const bf16_t* pb = P.p_() + (size_t)b * SEQ * NPAD;
    __syncthreads();
    TPU_START(101); TPU_START(110);
    {
        bf16x8 afr[4][4]; f32x16 wv[4];
        const int qsel = (r32 >> 2) & 1, head = (r32 & 3) + 4 * (r32 >> 3);
        char* qs = lds;
        const int ntile = (t0 + 7) / 32 + 1;
        const bf16_t* kp = P.ikc_() + (size_t)(b * (SEQ / 32)) * 2048 + lane * 8;
        bf16x8 b0[4], b1[4], b2[4];
#define DSA_LDB(dst, K) do { const bf16_t* kq_ = kp + (size_t)(wid + 8 * (K)) * 2048; _Pragma("unroll") for (int kk = 0; kk < 4; ++kk) dst[kk] = *(const bf16x8*)(kq_ + kk * 512); } while (0)
#define DSA_TILE(buf, K) dsa_score_tile(afr, wv, buf, sc, (wid + 8 * (K)) * 32 + r32, hi)
        const int nk = (ntile - wid + 7) >> 3;
        const int kl = nk > 0 ? nk - 1 : 0;
#define DSA_MIN(a) ((a) < kl ? (a) : kl)
        const int tk = tid >> 6, hd = (tid & 63) >> 2, dm = (tid & 3) * 16;
        const bf16_t* qsrc = pb + (size_t)(t0 + tk) * NPAD + C_DIQ + hd * 64 + dm;
        const u32x4 qa = *(const u32x4*)qsrc, qb2 = *(const u32x4*)(qsrc + 8);
#pragma unroll
        for (int rt = 0; rt < 4; ++rt) { const float* wp = P.iw_() + (size_t)(b * SEQ + t0 + 2 * rt + hi) * 16;
#pragma unroll
            for (int i = 0; i < 4; ++i) { const f32x4 w4 = *(const f32x4*)(wp + 4 * i); wv[rt][4 * i] = w4[0]; wv[rt][4 * i + 1] = w4[1]; wv[rt][4 * i + 2] = w4[2]; wv[rt][4 * i + 3] = w4[3]; } }
        DSA_LDB(b0, DSA_MIN(0)); DSA_LDB(b1, DSA_MIN(1));
        { char* dst = qs + tk * 2432 + hd * 144 + dm * 2; *(u32x4*)dst = qa; *(u32x4*)(dst + 16) = qb2; }
        __syncthreads();
#pragma unroll
        for (int rt = 0; rt < 4; ++rt) { const char* qp = qs + (2 * rt + qsel) * 2432 + head * 144 + hi * 16;
#pragma unroll
            for (int kk = 0; kk < 4; ++kk) afr[rt][kk] = *(const bf16x8*)(qp + kk * 32); }
        asm volatile("s_waitcnt lgkmcnt(0)" ::: "memory"); __syncthreads();
#if TPROBE == 110
        TPU_STOP(110);
#endif
#if TPROBE == 103
        TPU_START(103); asm volatile("s_waitcnt vmcnt(0)" ::: "memory"); TPU_STOP(103);
#endif
#if TPROBE == 104
        asm volatile("s_waitcnt vmcnt(0)" ::: "memory"); TPU_START(104);
#endif
        int k = 0;
        for (; k + 3 <= nk; k += 3) {
            DSA_LDB(b2, k + 2); DSA_TILE(b0, k);
            DSA_LDB(b0, DSA_MIN(k + 3)); DSA_TILE(b1, k + 1);
            DSA_LDB(b1, DSA_MIN(k + 4)); DSA_TILE(b2, k + 2);
        }
        if (k < nk) DSA_TILE(b0, k);
        if (k + 1 < nk) DSA_TILE(b1, k + 1);
#if TPROBE == 104
        asm volatile("s_waitcnt lgkmcnt(0)" ::: "memory"); TPU_STOP(104);
#endif
        TPU_START(111);
#undef DSA_TILE
#undef DSA_MIN
#undef DSA_TILE
#undef DSA_LDB
    }
    __syncthreads();
    TPU_STOP(111);
    TPU_STOP(101); TPU_START(102);
    {
        const int t = t0 + wid; const float* srow = sc + wid * 4096;
        unsigned key[64];
#pragma unroll
        for (int j = 0; j < 64; ++j) { const int s = j * 64 + lane; key[j] = (s <= t) ? f2key(srow[s]) : 0u; }
        unsigned long long* mout = P.mask_() + (size_t)(b * SEQ + t) * 64;
        unsigned long long myword = 0ull;
        TPU_START(105); TPU_START(106); TPU_START(107); TPU_START(108); TPU_START(109);
        if (t + 1 <= TOPK) {
#pragma unroll
            for (int j = 0; j < 64; ++j) { const unsigned long long m = __ballot(j * 64 + lane <= t); if (lane == j) myword = m; }
        } else {
            const int ngrp = t / 512 + 1;
#if TPROBE == 105
            asm volatile("" :: "v"(key[0]), "v"(key[63]));
#endif
            TPU_STOP(105);
            unsigned* hist = (unsigned*)(sc + wid * 4096);
            asm volatile("" ::: "memory");
            { const u32x4 zz4 = {0u, 0u, 0u, 0u};
#pragma unroll
              for (int i = 0; i < 16; ++i) *(u32x4*)(hist + (i * 64 + lane) * 4) = zz4; }
            asm volatile("" ::: "memory");
#define DSA_H8(J0) do { _Pragma("unroll") for (int jj = 0; jj < 8; ++jj) atomicAdd(hist + (key[(J0) + jj] >> 20), 1u); } while (0)
            DSA_H8(0);
            if (ngrp > 1) DSA_H8(8);
            if (ngrp > 2) DSA_H8(16);
            if (ngrp > 3) DSA_H8(24);
            if (ngrp > 4) DSA_H8(32);
            if (ngrp > 5) DSA_H8(40);
            if (ngrp > 6) DSA_H8(48);
            if (ngrp > 7) DSA_H8(56);
#undef DSA_H8
            asm volatile("" ::: "memory");
#if TPROBE == 106
            asm volatile("s_waitcnt lgkmcnt(0)" ::: "memory");
#endif
            TPU_STOP(106);
#define DSA_SUFFIX(s) do { _Pragma("unroll") for (int o = 1; o < 64; o <<= 1) { unsigned t_ = (unsigned)__builtin_amdgcn_ds_bpermute(((lane + o) & 63) << 2, (int)(s)); (s) += (lane + o < 64) ? t_ : 0u; } } while (0)
            unsigned mine = 0u;
#pragma unroll
            for (int i = 0; i < 16; ++i) { const u32x4 v4 = *(const u32x4*)(hist + lane * 64 + ((i + lane) & 15) * 4); mine += (v4[0] + v4[1]) + (v4[2] + v4[3]); }
            unsigned suf = mine; DSA_SUFFIX(suf);
            const unsigned long long mL = __ballot(suf - mine < (unsigned)TOPK && suf >= (unsigned)TOPK);
            const int Ls = (int)__builtin_ctzll(mL);
            const unsigned cntA = (unsigned)__builtin_amdgcn_readlane((int)(suf - mine), Ls);
            unsigned h2 = hist[Ls * 64 + lane]; unsigned suf2 = h2; DSA_SUFFIX(suf2);
            const unsigned long long mB = __ballot(cntA + suf2 - h2 < (unsigned)TOPK && cntA + suf2 >= (unsigned)TOPK);
            const int Bs = (int)__builtin_ctzll(mB);
            const unsigned bstar = (unsigned)(Ls * 64 + Bs);
            const unsigned cntAbove = cntA + (unsigned)__builtin_amdgcn_readlane((int)(suf2 - h2), Bs);
            const unsigned inbin = (unsigned)__builtin_amdgcn_readlane((int)h2, Bs);
#undef DSA_SUFFIX
            TPU_STOP(107);
            unsigned T = bstar << 20; int cntT = (int)(cntAbove + inbin);
            if (cntT != TOPK) {
                asm volatile("" ::: "memory");
                int nslot = 0;
#pragma unroll
                for (int j = 0; j < 64; ++j) { if ((key[j] >> 20) == bstar) { hist[nslot * 64 + lane] = key[j]; ++nslot; } }
                asm volatile("" ::: "memory");
                int R = nslot;
#pragma unroll
                for (int o = 32; o >= 1; o >>= 1) { const int other = __builtin_amdgcn_ds_bpermute(((lane ^ o) << 2), R); R = other > R ? other : R; }
                R = __builtin_amdgcn_readfirstlane(R);
                if (R <= 8) {
                    unsigned c[8];
#pragma unroll
                    for (int r = 0; r < 8; ++r) c[r] = (r < nslot) ? hist[r * 64 + lane] : 0u;
                    for (int bit = 19; bit >= 0; --bit) {
                        const unsigned cand = T | (1u << bit); int cnt = (int)cntAbove;
#pragma unroll
                        for (int r = 0; r < 8; ++r) cnt += __popcll(__ballot(c[r] >= cand));
                        if (cnt >= TOPK) { T = cand; cntT = cnt; if (cnt == TOPK) break; }
                    }
                } else {
                    for (int bit = 19; bit >= 0; --bit) {
                        const unsigned cand = T | (1u << bit); unsigned c0 = 0, c1 = 0; unsigned long long sm0, sm1, sm2, sm3;
                        DSA_CNT8(0);
                        if (ngrp > 1) DSA_CNT8(8);
                        if (ngrp > 2) DSA_CNT8(16);
                        if (ngrp > 3) DSA_CNT8(24);
                        if (ngrp > 4) DSA_CNT8(32);
                        if (ngrp > 5) DSA_CNT8(40);
                        if (ngrp > 6) DSA_CNT8(48);
                        if (ngrp > 7) DSA_CNT8(56);
                        const int cl = (int)(c0 + c1);
                        int cnt = 0;
#pragma unroll
                        for (int bb = 0; bb < 7; ++bb) cnt += __popcll(__ballot((cl >> bb) & 1)) << bb;
                        if (cnt >= TOPK) { T = cand; cntT = cnt; if (cnt == TOPK) break; }
                    }
                }
            }
            TPU_STOP(108);
            if (cntT == TOPK) {
                unsigned wlo = 0u, whi = 0u;
                dsa_emit<0>(key, T, wlo, whi);
                myword = ((unsigned long long)whi << 32) | wlo;
            } else {
                int ngt = 0;
#pragma unroll
                for (int j = 0; j < 64; ++j) ngt += __popcll(__ballot(key[j] > T));
                int need = TOPK - ngt;
#pragma unroll
                for (int j = 0; j < 64; ++j) { const unsigned long long eq = __ballot(key[j] == T), gt = __ballot(key[j] > T);
                    const int ne = __popcll(eq); unsigned long long take = eq;
                    if (ne > need) { take = 0ull; int left = need; unsigned long long e2 = eq;
                        while (left > 0) { const unsigned long long lowbit = e2 & (0ull - e2); take |= lowbit; e2 ^= lowbit; --left; } }
                    need -= (ne > need) ? need : ne;
                    const unsigned long long m = gt | take; if (lane == j) myword = m; }
            }
        }
        mout[lane] = myword;
        TPU_STOP(109);
    }
    TPU_STOP(102);
}

struct DsaOutRow { const bf16_t* zb; bf16_t* gb; int wid;
    __device__ __forceinline__ const bf16_t* zrow(int r) const { const int rho = wid * 32 + r; return zb + (size_t)(rho >> 2) * NPAD + (rho & 3) * 128; }
    __device__ __forceinline__ bf16_t* grow(int r) const { const int rho = wid * 32 + r; return gb + (size_t)(rho >> 2) * MIX + (rho & 3) * 128; } };
__device__ __forceinline__ void unit_dsa_attn(const Params& P, int cur_layer, int u, char* lds) {
    const int b = u & 3, qb = 63 - (u >> 2), t0 = qb * 64, tokb = b * SEQ;
    const int wid = TIDX() >> 6, lane = TIDX() & 63, r32 = lane & 31, hi = lane >> 5;
    const int rho = wid * 32 + r32, tq = t0 + (rho >> 2), hq = rho & 3;
    const bf16_t* Qw = P.p_() + (size_t)(tokb + tq) * NPAD + C_DQ + hq * 128 + hi * 8;
    const bf16_t* Kh = P.kvc_() + (size_t)tokb * 256;
    const unsigned moff = (unsigned)(tokb + tq) * 512u;
    DsaOutRow ow; ow.zb = P.p_() + (size_t)(tokb + t0) * NPAD + C_DZ; ow.gb = P.xn_() + (size_t)(tokb + t0) * MIX + 1024; ow.wid = wid;
    const int NT = (qb + 2) & ~1;
    att::attn_body<true, 256, 128, 2, DsaOutRow>(Qw, P.dsa_q_norm + cur_layer * 128, P.rope_() + (size_t)(tokb + tq) * 48, Kh, NT, P.mask_(), moff, ow, lds);
}
__device__ __forceinline__ void phase_gemm_glu(const Params& P, int layer, char* lds) {
    pg8::Gemm g; g.A = P.ybuf_(); g.Bt = P.WgluT_() + (size_t)layer * 512 * 512; g.M = NTOK; g.N = 512; g.K = 512;
    pg8::StaticOrder S; S.init(g.M, g.N, (int)gridDim.x, (int)blockIdx.x);
    pg8::EpiGlu E; E.Y = P.ybuf_(); E.ldy = 512; E.O = P.ocat_(); E.ldo = MIX; E.ooff = 512;
    pg8::gemm_phase<pg8::EpiGlu, pg8::StaticOrder, false>((PG8_LAS unsigned char*)lds, g, S, E, nullptr);
}

constexpr int CTL_Q0 = 4096;
struct OneUnit { int pm, pn; __device__ __forceinline__ bool next(int i, pg8::Unit& u) const { if (i) return false; u.pm = pm; u.pn = pn; return true; }
    __device__ __forceinline__ void a_ready(const pg8::Unit&) const {} __device__ __forceinline__ void done(const pg8::Unit&) const {} };
__device__ __forceinline__ int q_issue(unsigned* ctr) { return (int)__hip_atomic_fetch_add(ctr, 1u, __ATOMIC_RELAXED, __HIP_MEMORY_SCOPE_AGENT); }
#define Q_LOOP_BEGIN(ctr, total)  { unsigned* q_ctr_ = (ctr); const int q_total_ = (total); volatile int* q_b_ = (volatile int*)(lds + LDS_TAIL + 16); \
    for (;;) { __syncthreads(); if (TIDX() == 0) *q_b_ = q_issue(q_ctr_); __syncthreads(); const int item = __builtin_amdgcn_readfirstlane(*q_b_); if (item >= q_total_) break;
#define Q_LOOP_END  } }
__device__ __forceinline__ void unit_glu(const Params& P, int layer, int u, char* lds) {
    pg8::Gemm g; g.A = P.ybuf_(); g.Bt = P.WgluT_() + (size_t)layer * 512 * 512; g.M = NTOK; g.N = 512; g.K = 512;
    OneUnit S; S.pm = u >> 1; S.pn = u & 1;
    pg8::EpiGluGate E; E.Y = P.ybuf_(); E.Pz = P.p_(); E.G = P.xn_();
    pg8::gemm_phase<pg8::EpiGluGate, OneUnit, false>((PG8_LAS unsigned char*)lds, g, S, E, nullptr);
}
constexpr int LDS_TAIL = LDS_BYTES - 64;

__global__ __launch_bounds__(NTHR, 2) void k_mega(Params P) {
    extern __shared__ __attribute__((aligned(16))) char lds[];
    if (TIDX() == 0) *(uint4*)(lds + LDS_TAIL) = make_uint4(0u, 0u, 0u, 0u);
    __syncthreads();
    XcdBarrier bar = xcd_barrier_post(P.ctl_(), (volatile LAS unsigned*)(lds + LDS_TAIL));
    const int G = gridDim.x, B = blockIdx.x;
    phase_prologue1(P, lds); phase_rope_table(P); phase_s5_params(P); phase_rmsnorm_x(P, 0);
    xcd_barrier(bar);
    for (int layer = 0; layer < DEPTH; ++layer) {
        if (layer > 0) { phase_rmsnorm_x(P, layer); xcd_barrier(bar); }
        phase_gemm_in(P, layer, lds);
        if (layer == 0) phase_gemm_kv(P, lds);
        xcd_barrier(bar);
        phase_prep(P, layer);
        if (layer == 0) phase_memk_norm(P);
        for (int u = B; u < 256; u += G) unit_gla_a4(P, layer, u, lds);
        xcd_barrier(bar);
        Q_LOOP_BEGIN(P.ctl_() + CTL_Q0 + 64 * (layer * 2), 128 + 2048 + 256)
            if (item < 128) unit_s5(P, layer, item, lds);
            else if (item < 2176) unit_dsa_index(P, item - 128, lds);
            else gla_scan_slice(P, (item - 2176) * NTHR + TIDX());
        Q_LOOP_END
        xcd_barrier(bar);
        Q_LOOP_BEGIN(P.ctl_() + CTL_Q0 + 64 * (layer * 2 + 1), 256 + 256 + 128 + 256)
            if (item < 256) unit_dsa_attn(P, layer, item, lds);
            else if (item < 512) unit_gla_c4(P, layer, item - 256, lds);
            else if (item < 640) unit_glu(P, layer, item - 512, lds);
            else unit_mem_attn(P, layer, item - 640, lds);
        Q_LOOP_END
        xcd_barrier(bar);
        phase_gemm_out(P, layer, lds);
        xcd_barrier(bar);
    }
}

extern "C" void kernel_launch(void* const* d_in, const int* in_sizes, int n_in, void* d_out, int out_size, void* d_ws, size_t ws_size, hipStream_t stream) {
    if (n_in != 24 || ws_size < WS_END) { fprintf(stderr, "kernel_launch: unexpected n_in %d or ws_size %zu (< %zu)\n", n_in, ws_size, (size_t)WS_END); return; }
    Params P; memset(&P, 0, sizeof(P));
    P.x = (const float*)d_in[0]; P.mem = (const float*)d_in[1]; P.pos = (const int*)d_in[2]; P.ln_gain = (const float*)d_in[3]; P.w_in = (const float*)d_in[4];
    P.gla_w_up = (const float*)d_in[5]; P.gla_b_up = (const float*)d_in[6]; P.s5_a_re = (const float*)d_in[7]; P.s5_a_im = (const float*)d_in[8]; P.s5_log_step = (const float*)d_in[9];
    P.s5_b_re = (const float*)d_in[10]; P.s5_b_im = (const float*)d_in[11]; P.s5_c_re = (const float*)d_in[12]; P.s5_c_im = (const float*)d_in[13]; P.s5_d = (const float*)d_in[14];
    P.s5_w_glu = (const float*)d_in[15]; P.dsa_q_norm = (const float*)d_in[16]; P.dsa_k_norm = (const float*)d_in[17]; P.mem_norm = (const float*)d_in[18]; P.w_mem_kv = (const float*)d_in[19];
    P.mem_q_norm = (const float*)d_in[20]; P.mem_k_norm = (const float*)d_in[21]; P.out_norm = (const float*)d_in[22]; P.w_out = (const float*)d_in[23];
    P.out = (float*)d_out;
    char* ws = (char*)d_ws; P.ws = ws;
    static int grid = 0;
    if (!grid) {
        int dev = 0, cus = 0, per_cu = 0;
        (void)hipGetDevice(&dev); (void)hipDeviceGetAttribute(&cus, hipDeviceAttributeMultiprocessorCount, dev);
        (void)hipFuncSetAttribute((const void*)k_mega, hipFuncAttributeMaxDynamicSharedMemorySize, LDS_BYTES);
        (void)hipOccupancyMaxActiveBlocksPerMultiprocessor(&per_cu, (const void*)k_mega, NTHR, LDS_BYTES);
        if (per_cu < 1) fprintf(stderr, "kernel_launch: occupancy query reports %d blocks per CU\n", per_cu);
        grid = cus > 0 ? cus : 256;
    }
    (void)hipMemsetAsync(ws + WS_CTL, 0, CTL_BYTES, stream);
    hipLaunchKernelGGL(k_mega, dim3(grid), dim3(NTHR), LDS_BYTES, stream, P);
}
```

```cpp
#include <hip/hip_runtime.h>
#include <stdint.h>
#include <stdio.h>
#include <string.h>

constexpr int NB = 4, SEQ = 4096, NTOK = NB * SEQ, DM = 2048, DEPTH = 4, MEML = 256;
constexpr int NIN = 5984, NPAD = 6144, MIX = 2048;
constexpr int C_GQ = 0, C_GK = 256, C_GV = 512, C_GLR = 1024, C_GZ = 1040, C_SU = 1552, C_SZ = 2064, C_DQ = 2576, C_DK = 3088, C_DV = 3216,
              C_DIQ = 3344, C_DIK = 4368, C_DIW = 4432, C_DZ = 4448, C_MQ = 4960, C_MZ = 5472;
constexpr float EPS = 1e-6f;
constexpr int NTHR = 512;
constexpr int LDS_BYTES = 147456;

typedef unsigned short bf16_t;
typedef short bf16x8 __attribute__((ext_vector_type(8)));
typedef short s16x4 __attribute__((ext_vector_type(4)));
typedef float f32x4 __attribute__((ext_vector_type(4)));
typedef float f32x8 __attribute__((ext_vector_type(8)));
typedef float f32x16 __attribute__((ext_vector_type(16)));
typedef unsigned u32x4 __attribute__((ext_vector_type(4)));
typedef unsigned u32x2 __attribute__((ext_vector_type(2)));
#define LAS __attribute__((address_space(3)))

__device__ __forceinline__ float bf2f(bf16_t b) { return __uint_as_float(((unsigned)b) << 16); }
__device__ __forceinline__ bf16_t f2bf(float f) { unsigned u = __float_as_uint(f); u += 0x7FFFu + ((u >> 16) & 1u); return (bf16_t)(u >> 16); }
__device__ __forceinline__ unsigned pk2bf(float lo, float hi) { return (unsigned)f2bf(lo) | ((unsigned)f2bf(hi) << 16); }
__device__ __forceinline__ float sigmoidf_(float x) { return __builtin_amdgcn_rcpf(1.f + __expf(-x)); }
__device__ __forceinline__ float siluf_(float x) { return x * __builtin_amdgcn_rcpf(1.f + __expf(-x)); }

__device__ __forceinline__ int TIDX() { int t = (int)threadIdx.x; asm volatile("" : "+v"(t)); return t; }
__device__ __forceinline__ float shx(float v, int m) { const int src = ((TIDX() & 63) ^ m) << 2; return __int_as_float(__builtin_amdgcn_ds_bpermute(src, __float_as_int(v))); }
__device__ __forceinline__ float wave_sum(float v) {
#pragma unroll
    for (int o = 32; o >= 1; o >>= 1) v += shx(v, o);
    return v;
}
__device__ __forceinline__ void ld8f(const bf16_t* p, float (&v)[8]) { const u32x4 w = *(const u32x4*)p;
#pragma unroll
    for (int j = 0; j < 4; ++j) { v[2 * j] = __uint_as_float(w[j] << 16); v[2 * j + 1] = __uint_as_float(w[j] & 0xffff0000u); } }
__device__ __forceinline__ void st8f(bf16_t* p, const float (&v)[8]) { u32x4 w; w.x = pk2bf(v[0], v[1]); w.y = pk2bf(v[2], v[3]); w.z = pk2bf(v[4], v[5]); w.w = pk2bf(v[6], v[7]); *(u32x4*)p = w; }
__device__ __forceinline__ float f2bf_f(float f) { return bf2f(f2bf(f)); }

#ifndef TPROBE
#define TPROBE 0
#endif
#if TPROBE
#define TPU_START(id) do { if (TPROBE == (id) && TIDX() == 0) *(volatile unsigned long long*)(lds + LDS_BYTES - 24) = __builtin_amdgcn_s_memrealtime(); } while (0)
#define TPU_STOP(id) do { if (TPROBE == (id) && TIDX() == 0) *(volatile unsigned long long*)(lds + LDS_BYTES - 32) += __builtin_amdgcn_s_memrealtime() - *(volatile unsigned long long*)(lds + LDS_BYTES - 24); } while (0)
#else
#define TPU_START(id) do {} while (0)
#define TPU_STOP(id) do {} while (0)
#endif
#define XB_TMO      128
#define XB_XCNT(j)  (256  + 64 * (j))
#define XB_XSUB(j)  (1280 + 64 * (j))
#define XB_XGEN(j)  (2304 + 64 * (j))
#define XB_TOP      3328
#define XB_TOPGEN   3392
#define XCD_BAR_WORDS 3456
#define XB_SPIN_CAP (1u << 18)

__device__ __forceinline__ unsigned xb_ld(unsigned* p)              { return __hip_atomic_load(p, __ATOMIC_RELAXED, __HIP_MEMORY_SCOPE_AGENT); }
__device__ __forceinline__ unsigned xb_add(unsigned* p, unsigned v) { return __hip_atomic_fetch_add(p, v, __ATOMIC_RELAXED, __HIP_MEMORY_SCOPE_AGENT); }
__device__ __forceinline__ unsigned xb_xcc_id() { return (unsigned)__builtin_amdgcn_s_getreg((3 << 11) | 20) & 0xFu; }
#define XB_SPIN(cond, bar) do { unsigned _sp = 0; while (cond) { __builtin_amdgcn_s_sleep(1); \
    if ((++_sp & 255u) == 0u) { if (xb_ld(&(bar)[XB_TMO])) break; if (_sp > XB_SPIN_CAP) { atomicAdd(&(bar)[XB_TMO], 1u); break; } } } } while (0)

struct XcdBarrier {
    unsigned* bar; unsigned x;
    volatile LAS unsigned* st;
};

__device__ __forceinline__ XcdBarrier xcd_barrier_post(unsigned* bar, volatile LAS unsigned* st) {
    XcdBarrier b; b.bar = bar; b.x = xb_xcc_id(); b.st = st;
    if (TIDX() == 0) (void)xb_add(&bar[XB_XCNT(b.x)], 1u);
    return b;
}
__device__ __forceinline__ void xcd_barrier_complete(unsigned* bar, unsigned x, unsigned& nloc, unsigned& nx) {
    const unsigned G = gridDim.x * gridDim.y * gridDim.z;
    unsigned sum, cnt, mine, sp = 0u;
    for (;;) {
        sum = 0u; cnt = 0u; mine = 0u;
#pragma unroll
        for (unsigned j = 0; j < 16; ++j) { const unsigned c = xb_ld(&bar[XB_XCNT(j)]); sum += c; cnt += (c > 0u) ? 1u : 0u; mine = (j == x) ? c : mine; }
        if (sum == G) break;
        __builtin_amdgcn_s_sleep(1);
        if ((++sp & 255u) == 0u) { if (xb_ld(&bar[XB_TMO])) break; if (sp > XB_SPIN_CAP) { atomicAdd(&bar[XB_TMO], 1u); break; } }
    }
    nloc = mine > 0u ? mine : 1u; nx = cnt > 0u ? cnt : 1u;
}

__device__ __forceinline__ void xcd_barrier(const XcdBarrier& b) {
    asm volatile("s_waitcnt vmcnt(0)" ::: "memory");
    __syncthreads();
    if (TIDX() == 0) {
        unsigned* bar = b.bar; const unsigned bx = xb_xcc_id();
        __builtin_amdgcn_s_waitcnt(0);
        unsigned nloc = b.st[0], nx = b.st[1];
        if (nloc == 0u) { xcd_barrier_complete(bar, bx, nloc, nx); b.st[0] = nloc; b.st[1] = nx; }
        const unsigned old = xb_add(&bar[XB_XSUB(bx)], 1u);
        const unsigned gen = old / nloc;
        if (old + 1u == (gen + 1u) * nloc) {
            __builtin_amdgcn_fence(__ATOMIC_RELEASE, "agent");
            asm volatile("s_waitcnt vmcnt(0)" ::: "memory");
            const unsigned og = xb_add(&bar[XB_TOP], 1u);
            const unsigned tg = og / nx;
            if (og + 1u == (tg + 1u) * nx) xb_add(&bar[XB_TOPGEN], 1u);
            else XB_SPIN(xb_ld(&bar[XB_TOPGEN]) == tg, bar);
            __builtin_amdgcn_fence(__ATOMIC_ACQUIRE, "agent");
            xb_add(&bar[XB_XGEN(bx)], 1u);
            asm volatile("s_waitcnt vmcnt(0)" ::: "memory");
        } else {
            XB_SPIN(xb_ld(&bar[XB_XGEN(bx)]) == gen, bar);
            __builtin_amdgcn_fence(__ATOMIC_ACQUIRE, "agent");
            asm volatile("s_waitcnt vmcnt(0)" ::: "memory");
        }
    }
    __syncthreads();
}
namespace pg8 {
#define PG8_LAS __attribute__((address_space(3)))
typedef float f32x2 __attribute__((ext_vector_type(2)));
typedef unsigned u32x4 __attribute__((ext_vector_type(4)));
constexpr int BM = 256, BK = 64, HALF = 128, HTB = HALF * BK * 2  , STAGE_BYTES = 8 * HTB, NXCD = 8, WGM = 8;

__host__ __device__ __forceinline__ int lds_byte(int r, int c) { const int st = (r >> 4) * 2 + (c >> 5), rr = r & 15, cc = c & 31, ob = rr * 64 + cc * 2; return st * 1024 + (ob ^ (((ob >> 9) & 1) << 5)); }
__host__ __device__ __forceinline__ void stage_rc(int b, int& R, int& C) { const int st = b / 1024, sb = b % 1024, swz = sb ^ (((sb >> 9) & 1) << 5); R = (st >> 1) * 16 + swz / 64; C = (st & 1) * 32 + (swz % 64) / 2; }
__host__ __device__ __forceinline__ int perm32(int rho) { const int n = rho >> 4, i = rho & 15; return 8 * (i >> 2) + 4 * n + (i & 3); }

struct Unit { int pm, pn; };
struct Gemm { const bf16_t* A; const bf16_t* Bt; int M, N, K; };

struct StaticOrder {
    int nM, nN, nwg, G, c;
    __host__ __device__ void init(int M, int N, int G_, int c_) { nM = M / BM; nN = N / BM; nwg = nM * nN; G = G_; c = c_; }
    __host__ __device__ bool next(int i, Unit& u) const {
        const long L = (long)i * G + c; if (L >= nwg) return false;
        int wgid = (int)L; { const int q = nwg / NXCD, r = nwg % NXCD, xcd = wgid % NXCD, off = wgid / NXCD; wgid = (xcd < r ? xcd * (q + 1) : r * (q + 1) + (xcd - r) * q) + off; }
        const int nig = WGM * nN, gid = wgid / nig, fm = gid * WGM, gsz = (nM - fm) < WGM ? (nM - fm) : WGM;
        u.pm = fm + ((wgid % nig) % gsz); u.pn = (wgid % nig) / gsz; return true;
    }
    __device__ __forceinline__ void a_ready(const Unit&) const {}
    __device__ __forceinline__ void done(const Unit&) const {}
};
__device__ __forceinline__ unsigned cvt_pk_bf16(float lo, float hi) { unsigned r; asm volatile("v_cvt_pk_bf16_f32 %0, %1, %2" : "=v"(r) : "v"(lo), "v"(hi)); return r; }
struct EpiBf16Plain {
    static constexpr bool PERM = true, AFTER_DRAIN = false;
    bf16_t* O; int ldc;
    __device__ __forceinline__ void operator()(const f32x4 (&acc)[2][2][4][2], const Unit& u, int wr, int wc, int fr, int fq) const {
        const int row0 = u.pm * BM + wr * 64 + fr, col0 = u.pn * BM + wc * 32 + 8 * fq;
#pragma unroll
        for (int ai = 0; ai < 2; ++ai)
#pragma unroll
            for (int m = 0; m < 4; ++m) { bf16_t* rowp = O + (size_t)(row0 + ai * HALF + m * 16) * ldc + col0;
#pragma unroll
                for (int bj = 0; bj < 2; ++bj) { const f32x4 v0 = acc[ai][bj][m][0], v1 = acc[ai][bj][m][1];
                    u32x4 w; w.x = cvt_pk_bf16(v0[0], v0[1]); w.y = cvt_pk_bf16(v0[2], v0[3]); w.z = cvt_pk_bf16(v1[0], v1[1]); w.w = cvt_pk_bf16(v1[2], v1[3]);
                    *(u32x4*)(rowp + bj * HALF) = w; } }
    }
};
struct EpiResid {
    static constexpr bool PERM = false, AFTER_DRAIN = false;
    const float* R; float* C; int ldc;
    __device__ __forceinline__ void operator()(const f32x4 (&acc)[2][2][4][2], const Unit& u, int wr, int wc, int fr, int fq) const {
        const int row0 = u.pm * BM + wr * 64 + fr, col0 = u.pn * BM + wc * 32 + 4 * fq;
#pragma unroll
        for (int ai = 0; ai < 2; ++ai)
#pragma unroll
            for (int m = 0; m < 4; ++m) { const size_t off = (size_t)(row0 + ai * HALF + m * 16) * ldc + col0;
#pragma unroll
                for (int bj = 0; bj < 2; ++bj)
#pragma unroll
                    for (int n = 0; n < 2; ++n) { const f32x4 r = *(const f32x4*)(R + off + bj * HALF + n * 16); *(f32x4*)(C + off + bj * HALF + n * 16) = acc[ai][bj][m][n] + r; } }
    }
};
struct EpiResidMix {
    static constexpr bool PERM = true, AFTER_DRAIN = false;
    const void* R; void* C; int ldc; int r16, c16;
    __device__ __forceinline__ void operator()(const f32x4 (&acc)[2][2][4][2], const Unit& u, int wr, int wc, int fr, int fq) const {
        const int row0 = u.pm * BM + wr * 64 + fr, col0 = u.pn * BM + wc * 32 + 8 * fq;
#pragma unroll
        for (int ai = 0; ai < 2; ++ai)
#pragma unroll
            for (int m = 0; m < 4; ++m) { const size_t off = (size_t)(row0 + ai * HALF + m * 16) * ldc + col0;
                f32x4 r0[2], r1[2];
                if (r16) {
#pragma unroll
                    for (int bj = 0; bj < 2; ++bj) { const u32x4 w = *(const u32x4*)((const bf16_t*)R + off + bj * HALF);
                        r0[bj] = f32x4{__uint_as_float(w.x << 16), __uint_as_float(w.x & 0xffff0000u), __uint_as_float(w.y << 16), __uint_as_float(w.y & 0xffff0000u)};
                        r1[bj] = f32x4{__uint_as_float(w.z << 16), __uint_as_float(w.z & 0xffff0000u), __uint_as_float(w.w << 16), __uint_as_float(w.w & 0xffff0000u)}; }
                } else {
#pragma unroll
                    for (int bj = 0; bj < 2; ++bj) { r0[bj] = *(const f32x4*)((const float*)R + off + bj * HALF); r1[bj] = *(const f32x4*)((const float*)R + off + bj * HALF + 4); }
                }
#pragma unroll
                for (int bj = 0; bj < 2; ++bj) { const f32x4 v0 = acc[ai][bj][m][0] + r0[bj], v1 = acc[ai][bj][m][1] + r1[bj];
                    if (c16) { u32x4 w; w.x = cvt_pk_bf16(v0[0], v0[1]); w.y = cvt_pk_bf16(v0[2], v0[3]); w.z = cvt_pk_bf16(v1[0], v1[1]); w.w = cvt_pk_bf16(v1[2], v1[3]);
                        *(u32x4*)((bf16_t*)C + off + bj * HALF) = w; }
                    else { *(f32x4*)((float*)C + off + bj * HALF) = v0; *(f32x4*)((float*)C + off + bj * HALF + 4) = v1; } } }
    }
};
struct EpiGlu {
    static constexpr bool PERM = true, AFTER_DRAIN = false;
    const bf16_t* Y; int ldy; bf16_t* O; int ldo; int ooff;
    __device__ __forceinline__ void operator()(const f32x4 (&acc)[2][2][4][2], const Unit& u, int wr, int wc, int fr, int fq) const {
        const int row0 = u.pm * BM + wr * 64 + fr, col0 = u.pn * BM + wc * 32 + 8 * fq;
#pragma unroll
        for (int ai = 0; ai < 2; ++ai)
#pragma unroll
            for (int m = 0; m < 4; ++m) { const int row = row0 + ai * HALF + m * 16;
#pragma unroll
                for (int bj = 0; bj < 2; ++bj) { const f32x4 v0 = acc[ai][bj][m][0], v1 = acc[ai][bj][m][1];
                    const u32x4 yw = *(const u32x4*)(Y + (size_t)row * ldy + col0 + bj * HALF);
                    float y[8], g[8];
#pragma unroll
                    for (int j = 0; j < 4; ++j) { y[2 * j] = __uint_as_float(yw[j] << 16); y[2 * j + 1] = __uint_as_float(yw[j] & 0xffff0000u); }
#pragma unroll
                    for (int j = 0; j < 4; ++j) { g[j] = __builtin_amdgcn_rcpf(1.f + __expf(-v0[j])); g[4 + j] = __builtin_amdgcn_rcpf(1.f + __expf(-v1[j])); }
                    u32x4 w; w.x = cvt_pk_bf16(y[0] * g[0], y[1] * g[1]); w.y = cvt_pk_bf16(y[2] * g[2], y[3] * g[3]); w.z = cvt_pk_bf16(y[4] * g[4], y[5] * g[5]); w.w = cvt_pk_bf16(y[6] * g[6], y[7] * g[7]);
                    *(u32x4*)(O + (size_t)row * ldo + ooff + col0 + bj * HALF) = w; } }
    }
};
struct EpiGluGate {
    static constexpr bool PERM = true, AFTER_DRAIN = true;
    const bf16_t* Y; const bf16_t* Pz; bf16_t* G;
    __device__ __forceinline__ void fused(const f32x4 (&acc)[2][2][4][2], const Unit& u, int wr, int wc, int fr, int fq, PG8_LAS unsigned char* lds, int wid, int lane) const {
        constexpr int TS = 528;
        const int row0 = wr * 64 + fr, col0 = wc * 32 + 8 * fq;
#pragma unroll
        for (int ai = 0; ai < 2; ++ai)
#pragma unroll
            for (int m = 0; m < 4; ++m) { const int rl = row0 + ai * HALF + m * 16; const size_t grow = (size_t)u.pm * BM + rl;
#pragma unroll
                for (int bj = 0; bj < 2; ++bj) { const f32x4 v0 = acc[ai][bj][m][0], v1 = acc[ai][bj][m][1];
                    const u32x4 yw = *(const u32x4*)(Y + grow * 512 + u.pn * BM + col0 + bj * HALF);
                    float y[8], g[8];
#pragma unroll
                    for (int j = 0; j < 4; ++j) { y[2 * j] = __uint_as_float(yw[j] << 16); y[2 * j + 1] = __uint_as_float(yw[j] & 0xffff0000u); }
#pragma unroll
                    for (int j = 0; j < 4; ++j) { g[j] = __builtin_amdgcn_rcpf(1.f + __expf(-v0[j])); g[4 + j] = __builtin_amdgcn_rcpf(1.f + __expf(-v1[j])); }
                    u32x4 w; w.x = cvt_pk_bf16(y[0] * g[0], y[1] * g[1]); w.y = cvt_pk_bf16(y[2] * g[2], y[3] * g[3]); w.z = cvt_pk_bf16(y[4] * g[4], y[5] * g[5]); w.w = cvt_pk_bf16(y[6] * g[6], y[7] * g[7]);
                    *(PG8_LAS u32x4*)(lds + rl * TS + (col0 + bj * HALF) * 2) = w; } }
        __syncthreads();
        { const int t = wid * 64 + lane, row = t >> 1, hd = t & 1; const PG8_LAS unsigned char* src = lds + row * TS + hd * 256;
          float ss = 0.f;
#pragma unroll
          for (int i = 0; i < 16; ++i) { const u32x4 w = *(const PG8_LAS u32x4*)(src + 16 * i);
#pragma unroll
              for (int j = 0; j < 4; ++j) { const float a = __uint_as_float(w[j] << 16), b = __uint_as_float(w[j] & 0xffff0000u); ss += a * a + b * b; } }
          const float rn = rsqrtf(ss * (1.f / 128.f) + 1e-6f);
          const size_t grow = (size_t)u.pm * BM + row; const int cb = u.pn * BM + hd * 128;
          const bf16_t* zp = Pz + grow * 6144 + 2064 + cb; bf16_t* gp = G + grow * 2048 + 512 + cb;
#pragma unroll
          for (int i = 0; i < 16; ++i) { const u32x4 w = *(const PG8_LAS u32x4*)(src + 16 * i); const u32x4 zw = *(const u32x4*)(zp + 8 * i); u32x4 o;
#pragma unroll
              for (int j = 0; j < 4; ++j) { const float a = __uint_as_float(w[j] << 16), b = __uint_as_float(w[j] & 0xffff0000u), za = __uint_as_float(zw[j] << 16), zb = __uint_as_float(zw[j] & 0xffff0000u);
                  o[j] = cvt_pk_bf16(a * rn * (za * __builtin_amdgcn_rcpf(1.f + __expf(-za))), b * rn * (zb * __builtin_amdgcn_rcpf(1.f + __expf(-zb)))); }
              *(u32x4*)(gp + 8 * i) = o; } }
        __syncthreads();
    }
};
struct EpiBf16Scale {
    static constexpr bool PERM = true, AFTER_DRAIN = false;
    bf16_t* O; int ldc; const float* ssq;
    __device__ __forceinline__ void operator()(const f32x4 (&acc)[2][2][4][2], const Unit& u, int wr, int wc, int fr, int fq) const {
        const int row0 = u.pm * BM + wr * 64 + fr, col0 = u.pn * BM + wc * 32 + 8 * fq;
#pragma unroll
        for (int ai = 0; ai < 2; ++ai)
#pragma unroll
            for (int m = 0; m < 4; ++m) { const int row = row0 + ai * HALF + m * 16; bf16_t* rowp = O + (size_t)row * ldc + col0;
                float ssum = 0.f; { const f32x4* sp_ = (const f32x4*)(ssq + (size_t)row * 32);
#pragma unroll
                    for (int q = 0; q < 8; ++q) { const f32x4 t4 = sp_[q]; ssum += (t4[0] + t4[1]) + (t4[2] + t4[3]); } }
                const float s = rsqrtf(ssum * (1.f / 2048.f) + 1e-6f);
#pragma unroll
                for (int bj = 0; bj < 2; ++bj) { const f32x4 v0 = acc[ai][bj][m][0] * s, v1 = acc[ai][bj][m][1] * s;
                    u32x4 w; w.x = cvt_pk_bf16(v0[0], v0[1]); w.y = cvt_pk_bf16(v0[2], v0[3]); w.z = cvt_pk_bf16(v1[0], v1[1]); w.w = cvt_pk_bf16(v1[2], v1[3]);
                    *(u32x4*)(rowp + bj * HALF) = w; } }
    }
};
struct EpiResidNext {
    static constexpr bool PERM = false, AFTER_DRAIN = false;
    const float* R; float* C; int ldc; bf16_t* XB; float* ssq;
    __device__ __forceinline__ void operator()(const f32x4 (&acc)[2][2][4][2], const Unit& u, int wr, int wc, int fr, int fq) const {
        const int row0 = u.pm * BM + wr * 64 + fr, col0 = u.pn * BM + wc * 32 + 4 * fq;
#pragma unroll
        for (int ai = 0; ai < 2; ++ai)
#pragma unroll
            for (int m = 0; m < 4; ++m) { const int row = row0 + ai * HALF + m * 16; const size_t off = (size_t)row * ldc + col0; float ss = 0.f;
#pragma unroll
                for (int bj = 0; bj < 2; ++bj)
#pragma unroll
                    for (int n = 0; n < 2; ++n) { const f32x4 r = *(const f32x4*)(R + off + bj * HALF + n * 16); const f32x4 v = acc[ai][bj][m][n] + r;
                        *(f32x4*)(C + off + bj * HALF + n * 16) = v;
                        if (XB) { u32x2 w; w.x = cvt_pk_bf16(v[0], v[1]); w.y = cvt_pk_bf16(v[2], v[3]); *(u32x2*)(XB + off + bj * HALF + n * 16) = w; }
                        ss += v[0] * v[0] + v[1] * v[1] + v[2] * v[2] + v[3] * v[3]; }
                if (ssq) { ss += shx(ss, 16); ss += shx(ss, 32); if (fq == 0) ssq[(size_t)row * 32 + u.pn * 4 + wc] = ss; } }
    }
};
template <class Epi, class Sched, bool STAMP = false>
__device__ __forceinline__ void gemm_phase(PG8_LAS unsigned char* lds, const Gemm g, const Sched& S, const Epi& E, unsigned long long* stamps) {
    const int tid = TIDX(), wid = __builtin_amdgcn_readfirstlane(tid >> 6), lane = tid & 63, wr = wid >> 2, wc = wid & 3, fr = lane & 15, fq = lane >> 4;
    const int K = g.K, nt = K / BK;
    int ts_lo = 0, ts_hi = 0, nts = 0; const unsigned long long rt_entry = STAMP ? (unsigned long long)wall_clock64() : 0ull;
#define PG8_STAMP() do { if (STAMP && wid == 0 && nts < 64) { const unsigned long long _c = (unsigned long long)clock64(); \
        ts_lo = (lane == nts) ? (int)(unsigned)_c : ts_lo; ts_hi = (lane == nts) ? (int)(unsigned)(_c >> 32) : ts_hi; ++nts; } } while (0)
    PG8_STAMP();
    unsigned voffA[2], voffB[2];
#pragma unroll
    for (int i = 0; i < 2; ++i) { int R, C; stage_rc(tid * 16 + i * 8192, R, C); const int Rb = Epi::PERM ? ((R & ~31) + perm32(R & 31)) : R;
        voffA[i] = (unsigned)(R * K + C) * 2u; voffB[i] = (unsigned)(Rb * K + C) * 2u; }
    const size_t kstep = (size_t)(BK * 2);
    const size_t hstep = (size_t)HALF * K * 2;
    const size_t tstep = 2 * hstep;
    const unsigned ldsw = (unsigned)wid * 1024u;
    const int aoff = lds_byte(wr * 64 + fr, fq * 8), boff = lds_byte(wc * 32 + fr, fq * 8);
#define PG8_SA(b, h) (((b) * 2 + (h)) * HTB)
#define PG8_SB(b, h) ((4 + (b) * 2 + (h)) * HTB)
#define PG8_STAGE(bufoff, gbase, voff) do { _Pragma("unroll") for (int _i = 0; _i < 2; ++_i) \
        __builtin_amdgcn_global_load_lds((const unsigned*)((const char*)(gbase) + (voff)[_i]), (PG8_LAS unsigned*)(lds + (bufoff) + ldsw + _i * 8192), 16, 0, 0); } while (0)
#define PG8_LDA(dst, b, h) do { _Pragma("unroll") for (int m = 0; m < 4; ++m) _Pragma("unroll") for (int k = 0; k < 2; ++k) dst[m][k] = *(const PG8_LAS bf16x8*)(lds + PG8_SA(b, h) + aoff + m * 2048 + k * 1024); } while (0)
#define PG8_LDB(dst, b, h) do { _Pragma("unroll") for (int n = 0; n < 2; ++n) _Pragma("unroll") for (int k = 0; k < 2; ++k) dst[n][k] = *(const PG8_LAS bf16x8*)(lds + PG8_SB(b, h) + boff + n * 2048 + k * 1024); } while (0)
#define PG8_MMA(ai, bj, At, Bt) do { __builtin_amdgcn_s_setprio(1); _Pragma("unroll") for (int m = 0; m < 4; ++m) _Pragma("unroll") for (int n = 0; n < 2; ++n) _Pragma("unroll") for (int k = 0; k < 2; ++k) \
        acc[ai][bj][m][n] = __builtin_amdgcn_mfma_f32_16x16x32_bf16(Bt[n][k], At[m][k], acc[ai][bj][m][n], 0, 0, 0); __builtin_amdgcn_s_setprio(0); } while (0)
#define PG8_WAIT_V(n) asm volatile("s_waitcnt vmcnt(" #n ")" ::: "memory")
#define PG8_WAIT_L(n) asm volatile("s_waitcnt lgkmcnt(" #n ")" ::: "memory")
#define PG8_BAR __builtin_amdgcn_s_barrier()
#define PG8_SCHED __builtin_amdgcn_sched_barrier(0)
    Unit cur, nxt; int ui = 0;
    if (!S.next(0, cur)) return;
    f32x4 acc[2][2][4][2];
#pragma unroll
    for (int a = 0; a < 2; ++a)
#pragma unroll
        for (int b = 0; b < 2; ++b)
#pragma unroll
            for (int m = 0; m < 4; ++m)
#pragma unroll
                for (int n = 0; n < 2; ++n) acc[a][b][m][n] = (f32x4){0.f, 0.f, 0.f, 0.f};
    bf16x8 At[4][2], B0[2][2], B1[2][2];
    const char* cA = (const char*)g.A + (size_t)cur.pm * tstep; const char* cB = (const char*)g.Bt + (size_t)cur.pn * tstep;
    S.a_ready(cur);
    PG8_STAGE(PG8_SB(0, 0), cB, voffB); PG8_STAGE(PG8_SA(0, 0), cA, voffA); PG8_STAGE(PG8_SB(0, 1), cB + hstep, voffB); PG8_STAGE(PG8_SA(0, 1), cA + hstep, voffA);
    if (wr == 1) PG8_BAR;
    PG8_WAIT_V(4); PG8_BAR;
    PG8_STAGE(PG8_SB(1, 0), cB + kstep, voffB); PG8_STAGE(PG8_SA(1, 0), cA + kstep, voffA); PG8_STAGE(PG8_SB(1, 1), cB + hstep + kstep, voffB);
    PG8_WAIT_V(6); PG8_BAR;
    PG8_STAMP();
    for (;;) {
        const bool has_next = S.next(ui + 1, nxt);
        const char* nA = has_next ? (const char*)g.A + (size_t)nxt.pm * tstep : cA; const char* nB = has_next ? (const char*)g.Bt + (size_t)nxt.pn * tstep : cB;
        for (int t = 0; t < nt; t += 2) {
            const bool last = (t == nt - 2);
            const char* a1 = cA + (size_t)(t + 1) * kstep;
            const char* a2 = last ? nA : cA + (size_t)(t + 2) * kstep; const char* b2 = last ? nB : cB + (size_t)(t + 2) * kstep;
            const char* a3 = a2 + kstep; const char* b3 = b2 + kstep;
            if (last && has_next) S.a_ready(nxt);
            PG8_LDB(B0, 0, 0); PG8_SCHED; PG8_LDA(At, 0, 0); PG8_STAGE(PG8_SA(1, 1), a1 + hstep, voffA);
            PG8_WAIT_L(8); PG8_BAR; PG8_WAIT_L(0); PG8_MMA(0, 0, At, B0); PG8_BAR; PG8_SCHED;
            PG8_LDB(B1, 0, 1); PG8_STAGE(PG8_SB(0, 0), b2, voffB);
            PG8_BAR; PG8_WAIT_L(0); PG8_MMA(0, 1, At, B1); PG8_BAR;
            PG8_LDA(At, 0, 1); PG8_STAGE(PG8_SA(0, 0), a2, voffA);
            PG8_BAR; PG8_WAIT_L(0); PG8_MMA(1, 0, At, B0); PG8_BAR; PG8_SCHED;
            PG8_STAGE(PG8_SB(0, 1), b2 + hstep, voffB);
            PG8_WAIT_V(6); PG8_BAR; PG8_MMA(1, 1, At, B1); PG8_BAR;
            PG8_LDB(B0, 1, 0); PG8_SCHED; PG8_LDA(At, 1, 0); PG8_STAGE(PG8_SA(0, 1), a2 + hstep, voffA);
            PG8_WAIT_L(8); PG8_BAR; PG8_WAIT_L(0); PG8_MMA(0, 0, At, B0); PG8_BAR; PG8_SCHED;
            PG8_LDB(B1, 1, 1); PG8_STAGE(PG8_SB(1, 0), b3, voffB);
            PG8_BAR; PG8_WAIT_L(0); PG8_MMA(0, 1, At, B1); PG8_BAR;
            PG8_LDA(At, 1, 1); PG8_STAGE(PG8_SA(1, 0), a3, voffA);
            PG8_BAR; PG8_WAIT_L(0); PG8_MMA(1, 0, At, B0); PG8_BAR; PG8_SCHED;
            PG8_STAGE(PG8_SB(1, 1), b3 + hstep, voffB);
            PG8_WAIT_V(6); PG8_BAR; PG8_MMA(1, 1, At, B1); PG8_BAR;
        }
        PG8_STAMP();
        if constexpr (!Epi::AFTER_DRAIN) { E(acc, cur, wr, wc, fr, fq); S.done(cur); }
        PG8_STAMP();
        if (!has_next) break;
#pragma unroll
        for (int a = 0; a < 2; ++a)
#pragma unroll
            for (int b = 0; b < 2; ++b)
#pragma unroll
                for (int m = 0; m < 4; ++m)
#pragma unroll
                    for (int n = 0; n < 2; ++n) acc[a][b][m][n] = (f32x4){0.f, 0.f, 0.f, 0.f};
        cur = nxt; cA = nA; cB = nB; ++ui;
    }
    PG8_WAIT_V(0);
    if (wr == 0) PG8_BAR;
    PG8_BAR;
    if constexpr (Epi::AFTER_DRAIN) { E.fused(acc, cur, wr, wc, fr, fq, lds, wid, lane); S.done(cur); }
    PG8_STAMP();
    if (STAMP && wid == 0) { stamps[lane] = lane < nts ? (((unsigned long long)(unsigned)ts_hi << 32) | (unsigned)ts_lo) : 0ull;
        if (lane == 62) stamps[62] = rt_entry; if (lane == 63) stamps[63] = (unsigned long long)wall_clock64(); }
#undef PG8_STAMP
#undef PG8_SA
#undef PG8_SB
#undef PG8_STAGE
#undef PG8_LDA
#undef PG8_LDB
#undef PG8_MMA
#undef PG8_WAIT_V
#undef PG8_WAIT_L
#undef PG8_BAR
#undef PG8_SCHED
}
}
namespace att {
constexpr int D = 128, NW = 8, QBLK = 32, KVBLK = 64;
constexpr float SCALE = 0.088388347648318440f, THR = 8.f;
constexpr int SHM_V = KVBLK * D * 2, SHM_K = KVBLK * D * 2, SHM_ATTN = 2 * SHM_V + 2 * SHM_K + NW * 64 * 4;
#define KSWZ(row, colB) ((row) * 256 + ((colB) ^ (((row) & 7) << 4)))
#define SBAR() __builtin_amdgcn_sched_barrier(0)
__device__ __forceinline__ int crow(int r, int hi) { return (r & 3) + 8 * (r >> 2) + 4 * hi; }
__device__ __forceinline__ unsigned cvtpk(float lo, float hi) { unsigned r; asm volatile("v_cvt_pk_bf16_f32 %0, %1, %2" : "=v"(r) : "v"(lo), "v"(hi)); return r; }

template <bool MASKED>
__device__ __forceinline__ void partialSM(f32x16& p0, f32x16& p1, float& m_reg, float& mn, float& alpha, unsigned long long mw, int hi) {
  constexpr float C = SCALE * 1.4426950408889634f;
  float pmax = p0[0];
#pragma unroll
  for (int r = 1; r < 16; ++r) pmax = fmaxf(pmax, p0[r]);
#pragma unroll
  for (int r = 0; r < 16; ++r) pmax = fmaxf(pmax, p1[r]);
  { auto rr = __builtin_amdgcn_permlane32_swap(__float_as_uint(pmax), __float_as_uint(pmax), false, false);
    pmax = fmaxf(__uint_as_float(rr[0]), __uint_as_float(rr[1])); }
  if (__builtin_expect(__all(pmax - m_reg <= THR / SCALE), 1)) { mn = m_reg; alpha = 1.f; }
  else { mn = fmaxf(m_reg, pmax); alpha = __builtin_amdgcn_exp2f((m_reg - mn) * C); m_reg = mn; }
  const float mnC = -mn * C;
#pragma unroll
  for (int r = 0; r < 16; ++r) p0[r] = fmaf(p0[r], C, mnC);
#pragma unroll
  for (int r = 0; r < 16; ++r) p1[r] = fmaf(p1[r], C, mnC);
#pragma unroll
  for (int r = 0; r < 16; ++r) p0[r] = __builtin_amdgcn_exp2f(p0[r]);
}
__device__ __forceinline__ void finishSM(f32x16& p0, f32x16& p1, float alpha, float& l_reg, bf16x8& pa0, bf16x8& pa1, bf16x8& pa2, bf16x8& pa3) {
#pragma unroll
  for (int r = 0; r < 16; ++r) p1[r] = __builtin_amdgcn_exp2f(p1[r]);
  float ps = 0;
#pragma unroll
  for (int r = 0; r < 16; ++r) ps += p0[r];
#pragma unroll
  for (int r = 0; r < 16; ++r) ps += p1[r];
  { auto rr = __builtin_amdgcn_permlane32_swap(__float_as_uint(ps), __float_as_uint(ps), false, false);
    ps = __uint_as_float(rr[0]) + __uint_as_float(rr[1]); }
  l_reg = l_reg * alpha + ps;
#define PK4(P, BASE, OUT) do { unsigned a0 = cvtpk(P[BASE + 0], P[BASE + 1]), a1 = cvtpk(P[BASE + 2], P[BASE + 3]);   \
    unsigned b0 = cvtpk(P[BASE + 4], P[BASE + 5]), b1 = cvtpk(P[BASE + 6], P[BASE + 7]);                              \
    auto r0 = __builtin_amdgcn_permlane32_swap(a0, b0, false, false); auto r1 = __builtin_amdgcn_permlane32_swap(a1, b1, false, false); \
    u32x4 w = {r0[0], r1[0], r0[1], r1[1]}; OUT = *reinterpret_cast<bf16x8*>(&w); } while (0)
  PK4(p0, 0, pa0); PK4(p0, 8, pa1); PK4(p1, 0, pa2); PK4(p1, 8, pa3);
#undef PK4
}
template <int R> __device__ __forceinline__ float mask_bias(unsigned nw) {
  unsigned t; constexpr int bit = (R & 3) + 8 * (R >> 2);
  asm("v_bfe_i32 %0, %1, %2, 1\n\tv_and_b32 %0, 0xff800000, %0" : "=v"(t) : "v"(nw), "n"(bit));
  return __uint_as_float(t);
}
template <bool MASKED>
__device__ __forceinline__ void qkt(f32x16& p0, f32x16& p1, const char* Ks, const bf16x8* qr, int r32, int hi, unsigned long long mw) {
  if (MASKED) {
    const unsigned n0 = ~((unsigned)mw >> (4 * hi)), n1 = ~((unsigned)(mw >> 32) >> (4 * hi));
#define MB_(R) p0[R] = mask_bias<R>(n0); p1[R] = mask_bias<R>(n1);
    MB_(0) MB_(1) MB_(2) MB_(3) MB_(4) MB_(5) MB_(6) MB_(7) MB_(8) MB_(9) MB_(10) MB_(11) MB_(12) MB_(13) MB_(14) MB_(15)
#undef MB_
  } else { p0 = f32x16{}; p1 = f32x16{}; }
  asm volatile("" : "+v"(p0), "+v"(p1));
#pragma unroll
  for (int d0 = 0; d0 < 8; ++d0) { const int cb = (d0 * 16 + hi * 8) * 2;
    bf16x8 b0 = *reinterpret_cast<const bf16x8*>(Ks + KSWZ(r32, cb));
    bf16x8 b1 = *reinterpret_cast<const bf16x8*>(Ks + KSWZ(32 + r32, cb));
    p0 = __builtin_amdgcn_mfma_f32_32x32x16_bf16(b0, qr[d0], p0, 0, 0, 0);
    p1 = __builtin_amdgcn_mfma_f32_32x32x16_bf16(b1, qr[d0], p1, 0, 0, 0); }
}
__device__ __forceinline__ int v_st(int k, int c) { const int kk = (k & ~0xC) | ((k & 4) << 1) | ((k & 8) >> 1); return ((kk >> 3) * 4 + (c >> 5)) * 512 + ((kk & 7) * 32 + (c & 31)) * 2; }
__device__ __forceinline__ int v_rd_base(int lane) { return ((lane & 3) << 3) | (((lane >> 2) & 3) << 6) | (((lane >> 4) & 1) << 5) | (((lane >> 5) & 1) << 8); }
constexpr int v_rd_off(int d0, int ks, int half) { return d0 * 512 + ks * 4096 + half * 2048; }
template <int OFF> __device__ __forceinline__ s16x4 tr_read(int vb) {
  s16x4 r; asm volatile("ds_read_b64_tr_b16 %0, %1 offset:%2" : "=&v"(r) : "v"(vb), "i"(OFF) : "memory"); return r;
}
template <int D0> __device__ __forceinline__ void pv_one(f32x16& od, int vb, bf16x8 pa0, bf16x8 pa1, bf16x8 pa2, bf16x8 pa3) {
  const s16x4 l0 = tr_read<v_rd_off(D0, 0, 0)>(vb), h0 = tr_read<v_rd_off(D0, 0, 1)>(vb), l1 = tr_read<v_rd_off(D0, 1, 0)>(vb), h1 = tr_read<v_rd_off(D0, 1, 1)>(vb);
  const s16x4 l2 = tr_read<v_rd_off(D0, 2, 0)>(vb), h2 = tr_read<v_rd_off(D0, 2, 1)>(vb), l3 = tr_read<v_rd_off(D0, 3, 0)>(vb), h3 = tr_read<v_rd_off(D0, 3, 1)>(vb);
  asm volatile("s_waitcnt lgkmcnt(0)" ::: "memory"); SBAR();
#define PK(L, H) (bf16x8){L[0], L[1], L[2], L[3], H[0], H[1], H[2], H[3]}
  od = __builtin_amdgcn_mfma_f32_32x32x16_bf16(pa0, PK(l0, h0), od, 0, 0, 0);
  od = __builtin_amdgcn_mfma_f32_32x32x16_bf16(pa1, PK(l1, h1), od, 0, 0, 0);
  od = __builtin_amdgcn_mfma_f32_32x32x16_bf16(pa2, PK(l2, h2), od, 0, 0, 0);
  od = __builtin_amdgcn_mfma_f32_32x32x16_bf16(pa3, PK(l3, h3), od, 0, 0, 0);
#undef PK
}
__device__ __forceinline__ void pv_d0(f32x16* o, int vb, bf16x8 pa0, bf16x8 pa1, bf16x8 pa2, bf16x8 pa3) {
  pv_one<0>(o[0], vb, pa0, pa1, pa2, pa3); pv_one<1>(o[1], vb, pa0, pa1, pa2, pa3); pv_one<2>(o[2], vb, pa0, pa1, pa2, pa3); pv_one<3>(o[3], vb, pa0, pa1, pa2, pa3);
}

template <bool MASKED, int LDK, int VOFF, int QT, class OutRow>
__device__ __forceinline__ void attn_body(const bf16_t* __restrict__ Qw, const float* __restrict__ qgain, const float* __restrict__ qcs, const bf16_t* __restrict__ Kh, int NT,
                                          const unsigned long long* __restrict__ mbase, unsigned moff, const OutRow& Ow, char* lds) {
  const int tid = TIDX(), wid = tid >> 6, lane = tid & 63, r32 = lane & 31, hi = lane >> 5;
  char* V_lds = lds; char* K_lds = lds + 2 * SHM_V;
  float* ws = (float*)(lds + 2 * SHM_V + 2 * SHM_K) + wid * 64; float* li_l = ws; float* al_l = ws + 32;
  float m_reg = -1e30f, l_reg = 0; f32x16 o[4] = {}; bf16x8 qr[8];
  asm volatile("" : "+v"(o[0]), "+v"(o[1]), "+v"(o[2]), "+v"(o[3]));
#pragma unroll
  for (int d0 = 0; d0 < 8; ++d0) qr[d0] = *reinterpret_cast<const bf16x8*>(Qw + d0 * 16);
  if (QT) {
    float ss = 0.f;
#pragma unroll
    for (int d0 = 0; d0 < 8; ++d0)
#pragma unroll
      for (int j = 0; j < 8; ++j) { const float x = bf2f((bf16_t)qr[d0][j]); ss += x * x; }
    { auto rr = __builtin_amdgcn_permlane32_swap(__float_as_uint(ss), __float_as_uint(ss), false, false); ss = __uint_as_float(rr[0]) + __uint_as_float(rr[1]); }
    const float rn = rsqrtf(ss * (1.f / 128.f) + EPS);
    float x01[2][8];
#pragma unroll
    for (int d0 = 0; d0 < 8; ++d0) { const f32x4 g0 = *(const f32x4*)(qgain + d0 * 16 + hi * 8), g1 = *(const f32x4*)(qgain + d0 * 16 + hi * 8 + 4);
      float x[8];
#pragma unroll
      for (int j = 0; j < 8; ++j) x[j] = bf2f((bf16_t)qr[d0][j]) * rn * (j < 4 ? g0[j] : g1[j - 4]);
      if (QT == 2 && d0 < 2) {
#pragma unroll
        for (int j = 0; j < 8; ++j) x01[d0][j] = x[j];
      } else { u32x4 w = {cvtpk(x[0], x[1]), cvtpk(x[2], x[3]), cvtpk(x[4], x[5]), cvtpk(x[6], x[7])}; qr[d0] = *reinterpret_cast<bf16x8*>(&w); } }
    if (QT == 2) {
      float a[8], b[8];
#pragma unroll
      for (int j2 = 0; j2 < 4; ++j2) { const f32x4 cs = *(const f32x4*)(qcs + hi * 16 + 4 * j2);
#pragma unroll
        for (int q = 0; q < 2; ++q) { const int j = 2 * j2 + q; const float c = cs[2 * q], sn = cs[2 * q + 1], x1 = x01[0][j], x2 = x01[1][j]; a[j] = x1 * c - x2 * sn; b[j] = x2 * c + x1 * sn; } }
      { u32x4 w = {cvtpk(a[0], a[1]), cvtpk(a[2], a[3]), cvtpk(a[4], a[5]), cvtpk(a[6], a[7])}; qr[0] = *reinterpret_cast<bf16x8*>(&w); }
      { u32x4 w = {cvtpk(b[0], b[1]), cvtpk(b[2], b[3]), cvtpk(b[4], b[5]), cvtpk(b[6], b[7])}; qr[1] = *reinterpret_cast<bf16x8*>(&w); }
    }
  }
  const int sr = tid >> 4, sc = (tid & 15) * 8, vst0 = v_st(sr, sc), vst1 = v_st(32 + sr, sc);
  const int vb0 = (int)(uintptr_t)V_lds + v_rd_base(lane);
  struct { bf16x8 vs0, vs1, ks0, ks1; } sr_[2];
  const unsigned koff = (unsigned)(sr * LDK + sc) * 2u;
#define SLOAD(i, k0) do { const char* kb_ = (const char*)Kh + (size_t)(k0) * (LDK * 2); \
    sr_[i].vs0 = *reinterpret_cast<const bf16x8*>(kb_ + koff + VOFF * 2); sr_[i].vs1 = *reinterpret_cast<const bf16x8*>(kb_ + koff + (32 * LDK + VOFF) * 2); \
    sr_[i].ks0 = *reinterpret_cast<const bf16x8*>(kb_ + koff); sr_[i].ks1 = *reinterpret_cast<const bf16x8*>(kb_ + koff + 32 * LDK * 2); } while (0)
#define SWRITE(b, i) do { *(bf16x8*)(V_lds + (b) * SHM_V + vst0) = sr_[i].vs0;          \
    *(bf16x8*)(V_lds + (b) * SHM_V + vst1) = sr_[i].vs1; int kc = sc * 2;               \
    *(bf16x8*)(K_lds + (b) * SHM_K + KSWZ(sr, kc)) = sr_[i].ks0;                       \
    *(bf16x8*)(K_lds + (b) * SHM_K + KSWZ(32 + sr, kc)) = sr_[i].ks1; } while (0)
#define SWAIT() asm volatile("s_waitcnt vmcnt(4)" ::: "memory")
#define RESC(a) do { if (__any((a) < 1.f)) { if (hi == 0) al_l[r32] = (a); asm volatile("s_waitcnt lgkmcnt(0)" ::: "memory"); \
    _Pragma("unroll") for (int d = 0; d < 4; ++d) _Pragma("unroll") for (int r = 0; r < 16; ++r) o[d][r] *= al_l[crow(r, hi)]; } } while (0)
  f32x16 pA0, pA1, pB0, pB1; float mnA, mnB, alA, alB; bf16x8 pa0, pa1, pa2, pa3;
  unsigned long long mw = 0ull;
  constexpr int SE = 0, SO = 1;
  if (MASKED) mw = *(const unsigned long long*)((const char*)mbase + moff);
  SLOAD(SE, 0); SLOAD(SO, KVBLK);
  SWAIT(); SWRITE(0, SE); __syncthreads();
  qkt<MASKED>(pA0, pA1, K_lds, qr, r32, hi, mw);
  if (MASKED) mw = *(const unsigned long long*)((const char*)mbase + (moff + 8u));
  partialSM<MASKED>(pA0, pA1, m_reg, mnA, alA, mw, hi);
  SLOAD(SE, (2 < NT ? 2 : NT - 1) * KVBLK);
  SWAIT();
  SWRITE(1, SO); __syncthreads();
  for (int j = 1; j + 1 < NT; j += 2) {
    SBAR(); qkt<MASKED>(pB0, pB1, K_lds + SHM_K, qr, r32, hi, mw);
    if (MASKED) mw = *(const unsigned long long*)((const char*)mbase + (moff + 8u * (unsigned)(j + 1)));
    finishSM(pA0, pA1, alA, l_reg, pa0, pa1, pa2, pa3); SBAR();
    SLOAD(SO, (j + 2) * KVBLK); SBAR();
    pv_d0(o, vb0, pa0, pa1, pa2, pa3); partialSM<MASKED>(pB0, pB1, m_reg, mnB, alB, mw, hi);
    __syncthreads(); if (MASKED) asm volatile("s_waitcnt vmcnt(5)" ::: "memory"); else SWAIT();
    SWRITE(0, SE);
    RESC(alB); __syncthreads();
    SBAR(); qkt<MASKED>(pA0, pA1, K_lds, qr, r32, hi, mw);
    if (MASKED) mw = *(const unsigned long long*)((const char*)mbase + (moff + 8u * (unsigned)(j + 2)));
    finishSM(pB0, pB1, alB, l_reg, pa0, pa1, pa2, pa3); SBAR();
    SLOAD(SE, (j + 3 < NT ? j + 3 : NT - 1) * KVBLK); SBAR();
    pv_d0(o, vb0 + SHM_V, pa0, pa1, pa2, pa3); partialSM<MASKED>(pA0, pA1, m_reg, mnA, alA, mw, hi);
    __syncthreads(); if (MASKED) asm volatile("s_waitcnt vmcnt(5)" ::: "memory"); else SWAIT();
    SWRITE(1, SO);
    RESC(alA); __syncthreads();
  }
  SBAR(); qkt<MASKED>(pB0, pB1, K_lds + SHM_K, qr, r32, hi, mw);
  finishSM(pA0, pA1, alA, l_reg, pa0, pa1, pa2, pa3); SBAR();
  pv_d0(o, vb0, pa0, pa1, pa2, pa3); partialSM<MASKED>(pB0, pB1, m_reg, mnB, alB, mw, hi);
  __syncthreads(); RESC(alB);
  finishSM(pB0, pB1, alB, l_reg, pa0, pa1, pa2, pa3); SBAR();
  pv_d0(o, vb0 + SHM_V, pa0, pa1, pa2, pa3);
  if (hi == 0) li_l[r32] = l_reg; asm volatile("s_waitcnt lgkmcnt(0)" ::: "memory");
  float rli[16];
#pragma unroll
  for (int r = 0; r < 16; ++r) rli[r] = __builtin_amdgcn_rcpf(li_l[crow(r, hi)]);
  __syncthreads();
  float* og_s = (float*)lds + wid * (32 * 132);
#pragma unroll
  for (int r = 0; r < 16; ++r) {
#pragma unroll
    for (int d0 = 0; d0 < 4; ++d0) og_s[crow(r, hi) * 132 + d0 * 32 + r32] = o[d0][r] * rli[r]; }
  asm volatile("" ::: "memory");
  { const int row = lane >> 1, half = lane & 1; const float* src = og_s + row * 132 + half * 64;
    f32x4 v[16]; float ss = 0.f;
#pragma unroll
    for (int i = 0; i < 16; ++i) { v[i] = *(const f32x4*)(src + 4 * i); ss += v[i][0] * v[i][0] + v[i][1] * v[i][1] + v[i][2] * v[i][2] + v[i][3] * v[i][3]; }
    ss += shx(ss, 1);
    const float rn = rsqrtf(ss * (1.f / 128.f) + EPS);
    const bf16_t* zp = Ow.zrow(row) + half * 64; bf16_t* gp = Ow.grow(row) + half * 64;
#pragma unroll
    for (int i = 0; i < 8; ++i) { float z[8], g[8]; ld8f(zp + 8 * i, z);
#pragma unroll
      for (int q = 0; q < 4; ++q) { g[q] = v[2 * i][q] * rn * siluf_(z[q]); g[4 + q] = v[2 * i + 1][q] * rn * siluf_(z[4 + q]); }
      st8f(gp + 8 * i, g); } }
  __syncthreads();
#undef SLOAD
#undef SWRITE
#undef SWAIT
#undef RESC
}
}
constexpr size_t al256(size_t x) { return (x + 255) / 256 * 256; }
constexpr size_t WS_CTL   = 0;
constexpr size_t CTL_BYTES = 65536;
constexpr size_t WS_WINT  = WS_CTL + CTL_BYTES;
constexpr size_t WS_WOUTT = WS_WINT + al256((size_t)DEPTH * NPAD * DM * 2);
constexpr size_t WS_WKVT  = WS_WOUTT + al256((size_t)DEPTH * DM * MIX * 2);
constexpr size_t WS_WGLUT = WS_WKVT + al256((size_t)DEPTH * 1024 * DM * 2);
constexpr size_t WS_MEMN  = WS_WGLUT + al256((size_t)DEPTH * 512 * 512 * 2);
constexpr size_t WS_KVMEM = WS_MEMN + al256((size_t)NB * MEML * DM * 2);
constexpr size_t WS_XN    = WS_KVMEM + al256((size_t)NB * MEML * DEPTH * 1024 * 2);
constexpr size_t WS_P     = WS_XN + al256((size_t)NTOK * DM * 2);
constexpr size_t WS_XBUF  = WS_P + al256((size_t)NTOK * NPAD * 2);
constexpr size_t WS_OCAT  = WS_XBUF + al256((size_t)NTOK * DM * 4);
constexpr size_t WS_MASK  = WS_OCAT + al256((size_t)NTOK * MIX * 2);
constexpr size_t WS_IW    = WS_MASK + al256((size_t)NTOK * 64 * 8);
constexpr size_t WS_YBUF  = WS_IW + al256((size_t)NTOK * 16 * 4);
constexpr size_t WS_ROPE  = WS_YBUF + al256((size_t)NTOK * 512 * 2);
constexpr size_t WS_S5P   = WS_ROPE + al256((size_t)NTOK * 48 * 4);
constexpr size_t S5P_BYTES = (size_t)DEPTH * 32 * (64 * 2 + 64 * 2 + 64 * 16 * 2) * 4;
constexpr size_t WS_GLAS  = WS_S5P + al256(S5P_BYTES);
constexpr size_t WS_GLAD  = WS_GLAS + al256((size_t)NB * 64 * 4 * 64 * 128 * 4);
constexpr size_t WS_IKC   = WS_GLAD + al256((size_t)NB * 64 * 4 * 64 * 4);
constexpr size_t WS_KVC   = WS_IKC + al256((size_t)NTOK * 64 * 2);
constexpr size_t WS_IQL   = WS_KVC + al256((size_t)NTOK * 256 * 2);
constexpr size_t WS_SSQ   = WS_IQL + al256((size_t)NTOK * 64 * 2);
constexpr size_t DSP_SLOT = (size_t)(256 * 128 + 512) * 4;
constexpr size_t WS_DSP   = WS_SSQ + 256;
constexpr size_t WS_END   = WS_DSP + al256((size_t)160 * 2 * DSP_SLOT);

struct Params {
    const float* x; const float* mem; const int* pos; const float* ln_gain; const float* w_in; const float* gla_w_up; const float* gla_b_up;
    const float* s5_a_re; const float* s5_a_im; const float* s5_log_step; const float* s5_b_re; const float* s5_b_im; const float* s5_c_re; const float* s5_c_im;
    const float* s5_d; const float* s5_w_glu; const float* dsa_q_norm; const float* dsa_k_norm; const float* mem_norm; const float* w_mem_kv;
    const float* mem_q_norm; const float* mem_k_norm; const float* out_norm; const float* w_out;
    float* out;
    char* ws;
    __device__ __forceinline__ unsigned* ctl_() const { return (unsigned*)(ws + WS_CTL); }
    __device__ __forceinline__ bf16_t* WinT_() const { return (bf16_t*)(ws + WS_WINT); }
    __device__ __forceinline__ bf16_t* WoutT_() const { return (bf16_t*)(ws + WS_WOUTT); }
    __device__ __forceinline__ bf16_t* WkvT_() const { return (bf16_t*)(ws + WS_WKVT); }
    __device__ __forceinline__ bf16_t* WgluT_() const { return (bf16_t*)(ws + WS_WGLUT); }
    __device__ __forceinline__ bf16_t* memn_() const { return (bf16_t*)(ws + WS_MEMN); }
    __device__ __forceinline__ bf16_t* kvmem_() const { return (bf16_t*)(ws + WS_KVMEM); }
    __device__ __forceinline__ bf16_t* xn_() const { return (bf16_t*)(ws + WS_XN); }
    __device__ __forceinline__ bf16_t* p_() const { return (bf16_t*)(ws + WS_P); }
    __device__ __forceinline__ bf16_t* xbuf_() const { return (bf16_t*)(ws + WS_XBUF); }
    __device__ __forceinline__ bf16_t* ocat_() const { return (bf16_t*)(ws + WS_OCAT); }
    __device__ __forceinline__ unsigned long long* mask_() const { return (unsigned long long*)(ws + WS_MASK); }
    __device__ __forceinline__ float* iw_() const { return (float*)(ws + WS_IW); }
    __device__ __forceinline__ bf16_t* ybuf_() const { return (bf16_t*)(ws + WS_YBUF); }
    __device__ __forceinline__ float* rope_() const { return (float*)(ws + WS_ROPE); }
    __device__ __forceinline__ float* s5p_() const { return (float*)(ws + WS_S5P); }
    __device__ __forceinline__ float* glas_() const { return (float*)(ws + WS_GLAS); }
    __device__ __forceinline__ float* glad_() const { return (float*)(ws + WS_GLAD); }
    __device__ __forceinline__ bf16_t* ikc_() const { return (bf16_t*)(ws + WS_IKC); }
    __device__ __forceinline__ bf16_t* kvc_() const { return (bf16_t*)(ws + WS_KVC); }
    __device__ __forceinline__ float* ssq_() const { return (float*)(ws + WS_SSQ); }
    __device__ __forceinline__ bf16_t* iql_() const { return (bf16_t*)(ws + WS_IQL); }
    __device__ __forceinline__ char* dsp_() const { return ws + WS_DSP; }
};

__device__ __forceinline__ void transpose_tiles(const float* __restrict__ src, int K, int Nsrc, int Ndst, const float* __restrict__ scale, bf16_t* __restrict__ dst,
                                                int tile, float* lds_tile  ) {
    const int tid = TIDX(), ntn = Ndst / 256;
    const int tk = tile / ntn, tn = tile % ntn, k0 = tk * 64, n0 = tn * 256;
    __syncthreads();
    { const int ty = tid >> 4, tx = tid & 15;
      f32x4 v[2][4];
#pragma unroll
      for (int i = 0; i < 2; ++i)
#pragma unroll
        for (int q = 0; q < 4; ++q) { const int k = k0 + ty + 32 * i, n = n0 + 4 * tx + 64 * q;
          v[i][q] = (f32x4){0.f, 0.f, 0.f, 0.f};
          if (n < Nsrc) v[i][q] = *(const f32x4*)(src + (size_t)k * Nsrc + n); }
#pragma unroll
      for (int i = 0; i < 2; ++i) { const float s = scale ? scale[k0 + ty + 32 * i] : 1.f;
#pragma unroll
        for (int q = 0; q < 4; ++q) { float* t = lds_tile + (ty + 32 * i) * 257 + 4 * tx + 64 * q; t[0] = v[i][q][0] * s; t[1] = v[i][q][1] * s; t[2] = v[i][q][2] * s; t[3] = v[i][q][3] * s; } } }
    __syncthreads();
    { const int n = tid >> 1, kh = (tid & 1) * 32;
#pragma unroll
      for (int j = 0; j < 4; ++j) { const int kb = kh + 8 * j; u32x4 w;
        w.x = pk2bf(lds_tile[(kb + 0) * 257 + n], lds_tile[(kb + 1) * 257 + n]); w.y = pk2bf(lds_tile[(kb + 2) * 257 + n], lds_tile[(kb + 3) * 257 + n]);
        w.z = pk2bf(lds_tile[(kb + 4) * 257 + n], lds_tile[(kb + 5) * 257 + n]); w.w = pk2bf(lds_tile[(kb + 6) * 257 + n], lds_tile[(kb + 7) * 257 + n]);
        *(u32x4*)(dst + (size_t)(n0 + n) * K + k0 + kb) = w; } }
}

__device__ __forceinline__ void rmsnorm_rows(const float* __restrict__ X, bf16_t* __restrict__ Y, int nrows) {
    const int wid = TIDX() >> 6, lane = TIDX() & 63;
    for (int row = blockIdx.x * 8 + wid; row < nrows; row += gridDim.x * 8) {
        const float* xr = X + (size_t)row * DM; f32x4 v[8]; float ss = 0.f;
#pragma unroll
        for (int i = 0; i < 8; ++i) { v[i] = *(const f32x4*)(xr + 4 * lane + 256 * i); ss += v[i][0] * v[i][0] + v[i][1] * v[i][1] + v[i][2] * v[i][2] + v[i][3] * v[i][3]; }
        ss = wave_sum(ss); const float r = rsqrtf(ss * (1.f / DM) + EPS);
        bf16_t* yr = Y + (size_t)row * DM;
#pragma unroll
        for (int i = 0; i < 8; ++i) { u32x2 w; w.x = pk2bf(v[i][0] * r, v[i][1] * r); w.y = pk2bf(v[i][2] * r, v[i][3] * r); *(u32x2*)(yr + 4 * lane + 256 * i) = w; }
    }
}

__device__ __forceinline__ void rmsnorm_rows16(const bf16_t* __restrict__ X, bf16_t* __restrict__ Y, int nrows) {
    const int wid = TIDX() >> 6, lane = TIDX() & 63;
    for (int row = blockIdx.x * 8 + wid; row < nrows; row += gridDim.x * 8) {
        const bf16_t* xr = X + (size_t)row * DM; float v[4][8]; float ss = 0.f;
#pragma unroll
        for (int i = 0; i < 4; ++i) { ld8f(xr + 8 * lane + 512 * i, v[i]);
#pragma unroll
            for (int j = 0; j < 8; ++j) ss += v[i][j] * v[i][j]; }
        ss = wave_sum(ss); const float r = rsqrtf(ss * (1.f / DM) + EPS);
        bf16_t* yr = Y + (size_t)row * DM;
#pragma unroll
        for (int i = 0; i < 4; ++i) { float o[8];
#pragma unroll
            for (int j = 0; j < 8; ++j) o[j] = v[i][j] * r;
            st8f(yr + 8 * lane + 512 * i, o); }
    }
}

__device__ __forceinline__ void rows_bf16_ssq(const float* __restrict__ X, bf16_t* __restrict__ Y, float* __restrict__ ssq, int nrows) {
    const int wid = TIDX() >> 6, lane = TIDX() & 63;
    for (int row = blockIdx.x * 8 + wid; row < nrows; row += gridDim.x * 8) {
        const float* xr = X + (size_t)row * DM; bf16_t* yr = Y + (size_t)row * DM; float ss = 0.f;
#pragma unroll
        for (int i = 0; i < 8; ++i) { const f32x4 v = *(const f32x4*)(xr + 4 * lane + 256 * i); ss += v[0] * v[0] + v[1] * v[1] + v[2] * v[2] + v[3] * v[3];
            u32x2 w; w.x = pk2bf(v[0], v[1]); w.y = pk2bf(v[2], v[3]); *(u32x2*)(yr + 4 * lane + 256 * i) = w; }
        ss = wave_sum(ss); if (lane < 32) ssq[(size_t)row * 32 + lane] = (lane == 0) ? ss : 0.f;
    }
}
__device__ __forceinline__ void phase_prologue1(const Params& P, char* lds) {
    float* tile = (float*)lds;
    constexpr int T_IN = (DM / 64) * (NPAD / 256), T_OUT = (MIX / 64) * (DM / 256), T_KV = (DM / 64) * (1024 / 256), T_GLU = 8 * 2;
    constexpr int TOT = DEPTH * (T_IN + T_OUT + T_KV + T_GLU);
    for (int u = blockIdx.x; u < TOT; u += gridDim.x) {
        int l = u / (T_IN + T_OUT + T_KV + T_GLU), r = u % (T_IN + T_OUT + T_KV + T_GLU);
        if (r < T_IN) transpose_tiles(P.w_in + (size_t)l * DM * NIN, DM, NIN, NPAD, P.ln_gain + l * DM, P.WinT_() + (size_t)l * NPAD * DM, r, tile);
        else if ((r -= T_IN) < T_OUT) transpose_tiles(P.w_out + (size_t)l * MIX * DM, MIX, DM, DM, P.out_norm + l * MIX, P.WoutT_() + (size_t)l * DM * MIX, r, tile);
        else if ((r -= T_OUT) < T_KV) transpose_tiles(P.w_mem_kv + (size_t)l * DM * 1024, DM, 1024, 1024, P.mem_norm + l * DM, P.WkvT_() + (size_t)l * 1024 * DM, r, tile);
        else { r -= T_KV; transpose_tiles(P.s5_w_glu + (size_t)l * 512 * 512, 512, 512, 512, nullptr, P.WgluT_() + (size_t)l * 512 * 512, r, tile); }
    }
    rmsnorm_rows(P.mem, P.memn_(), NB * MEML);
}
__device__ __forceinline__ void phase_rope_table(const Params& P) {
    for (int idx = blockIdx.x * NTHR + TIDX(); idx < NTOK * 24; idx += gridDim.x * NTHR) {
        const int tok = idx / 24, i = idx % 24;
        const float e = (i < 16) ? -((float)i * 2.0f / 32.0f) : -((float)(i - 16) * 2.0f / 16.0f);
        const float inv_freq = exp2f(e * 18.931568569324174f);
        const float ang = (float)P.pos[tok] * inv_freq;
        const double a = (double)ang; const double k = rint(a * 0.15915494309189535); const float rf = (float)fma(-k, 6.283185307179586, a);
        P.rope_()[(size_t)idx * 2] = cosf(rf); P.rope_()[(size_t)idx * 2 + 1] = sinf(rf);
    }
}

__device__ __forceinline__ void phase_rmsnorm_x(const Params& P, int layer) { if (layer == 0) rmsnorm_rows(P.x, P.xn_(), NTOK); else rmsnorm_rows16(P.xbuf_(), P.xn_(), NTOK); }

__device__ __forceinline__ void phase_memk_norm(const Params& P) {
    const int wid = TIDX() >> 6, lane = TIDX() & 63;
    for (int it = blockIdx.x * 8 + wid; it < NB * MEML * DEPTH * 4; it += gridDim.x * 8) {
        const int row = it / (DEPTH * 4), l = (it / 4) % DEPTH, h = it % 4;
        bf16_t* kp = P.kvmem_() + (size_t)row * (DEPTH * 1024) + l * 1024 + h * 128 + 2 * lane;
        const unsigned w = *(const unsigned*)kp; const float a = __uint_as_float(w << 16), b = __uint_as_float(w & 0xffff0000u);
        const float ss = wave_sum(a * a + b * b), r = rsqrtf(ss * (1.f / 128.f) + EPS);
        const float* g = P.mem_k_norm + l * 128 + 2 * lane;
        *(unsigned*)kp = pk2bf(a * r * g[0], b * r * g[1]);
    }
}

__device__ __forceinline__ float sum16(float v) { v += shx(v, 1); v += shx(v, 2); v += shx(v, 4); v += shx(v, 8); return v; }

__device__ __forceinline__ void head128_norm_rope_to(const bf16_t* hp, bf16_t* dp, int l16, const float* __restrict__ gain, const float* __restrict__ cs, bool rope, bool do_store) {
    float v[8]; ld8f(hp + 8 * l16, v);
    float ss = 0.f;
#pragma unroll
    for (int j = 0; j < 8; ++j) ss += v[j] * v[j];
    ss = sum16(ss); const float r = rsqrtf(ss * (1.f / 128.f) + EPS);
#pragma unroll
    for (int j = 0; j < 8; ++j) v[j] = v[j] * r * gain[8 * l16 + j];
    if (rope) {
        float o[8];
#pragma unroll
        for (int j = 0; j < 8; ++j) o[j] = shx(v[j], 2);
        if (l16 < 4) { const int fi = (l16 & 1) * 8;
#pragma unroll
            for (int j = 0; j < 8; ++j) { const float c = cs[(fi + j) * 2], s = cs[(fi + j) * 2 + 1];
                v[j] = (l16 < 2) ? (v[j] * c - o[j] * s) : (v[j] * c + o[j] * s); } }
    }
    if (do_store) st8f(dp + 8 * l16, v);
}
__device__ __forceinline__ void head128_norm_rope(bf16_t* hp, int l16, const float* __restrict__ gain, const float* __restrict__ cs, bool rope, bool do_store) { head128_norm_rope_to(hp, hp, l16, gain, cs, rope, do_store); }
__device__ __forceinline__ void rope16_inplace(bf16_t* ip, const float* __restrict__ cs) {
    float a[8], b[8]; ld8f(ip, a); ld8f(ip + 8, b);
#pragma unroll
    for (int j = 0; j < 8; ++j) { const float c = cs[2 * j], s = cs[2 * j + 1], x1 = a[j], x2 = b[j]; a[j] = x1 * c - x2 * s; b[j] = x2 * c + x1 * s; }
    st8f(ip, a); st8f(ip + 8, b);
}
struct PrepIn { u32x4 k, i0, i1, ik0, ik1, v; bf16_t w; f32x4 c32[4], c16[4]; };
__device__ __forceinline__ void prep_load(const Params& P, int tok, int lane, PrepIn& I) {
    const int l16 = lane & 15, grp = lane >> 4;
    const bf16_t* row = P.p_() + (size_t)tok * NPAD;
    I.k = *(const u32x4*)(row + C_DK + 8 * l16);
    I.i0 = *(const u32x4*)(row + C_DIQ + (lane >> 2) * 64); I.i1 = *(const u32x4*)(row + C_DIQ + (lane >> 2) * 64 + 8);
    I.ik0 = *(const u32x4*)(row + C_DIK + (lane & 3) * 16); I.ik1 = *(const u32x4*)(row + C_DIK + (lane & 3) * 16 + 8);
    I.v = *(const u32x4*)(row + C_DV + l16 * 8);
    I.w = row[C_DIW + l16];
    const float* cs32 = P.rope_() + (size_t)tok * 48;
#pragma unroll
    for (int i = 0; i < 4; ++i) { I.c32[i] = *(const f32x4*)(cs32 + (l16 & 1) * 16 + 4 * i); I.c16[i] = *(const f32x4*)(cs32 + 32 + 4 * i); }
}
__device__ __forceinline__ void unpack8(const u32x4 w, float (&v)[8]) {
    v[0] = __uint_as_float(w.x << 16); v[1] = __uint_as_float(w.x & 0xffff0000u); v[2] = __uint_as_float(w.y << 16); v[3] = __uint_as_float(w.y & 0xffff0000u);
    v[4] = __uint_as_float(w.z << 16); v[5] = __uint_as_float(w.z & 0xffff0000u); v[6] = __uint_as_float(w.w << 16); v[7] = __uint_as_float(w.w & 0xffff0000u); }
__device__ __forceinline__ void head128_nr(float (&v)[8], int l16, const float (&gain)[8], const f32x4 (&cs)[4], bool rope) {
    float ss = 0.f;
#pragma unroll
    for (int j = 0; j < 8; ++j) ss += v[j] * v[j];
    ss = sum16(ss); const float r = rsqrtf(ss * (1.f / 128.f) + EPS);
#pragma unroll
    for (int j = 0; j < 8; ++j) v[j] = v[j] * r * gain[j];
    if (rope) {
        float o[8];
#pragma unroll
        for (int j = 0; j < 8; ++j) o[j] = shx(v[j], 2);
        if (l16 < 4) {
#pragma unroll
            for (int j = 0; j < 8; ++j) { const float c = cs[j >> 1][(j & 1) * 2], s = cs[j >> 1][(j & 1) * 2 + 1];
                v[j] = (l16 < 2) ? (v[j] * c - o[j] * s) : (v[j] * c + o[j] * s); } }
    }
}
__device__ __forceinline__ void prep_finish(const Params& P, int tok, int lane, const PrepIn& I, const float (&gq)[8], const float (&gk)[8], const float (&gm)[8]) {
    const int l16 = lane & 15, grp = lane >> 4;
    bf16_t* row = P.p_() + (size_t)tok * NPAD;
    float k[8];
    unpack8(I.k, k);
    head128_nr(k, l16, gk, I.c32, true);
    if (grp == 0) st8f(P.kvc_() + (size_t)tok * 256 + 8 * l16, k);
    {
        float a[8], b[8]; unpack8(I.i0, a); unpack8(I.i1, b);
#pragma unroll
        for (int j = 0; j < 8; ++j) { const float c = I.c16[j >> 1][(j & 1) * 2], s = I.c16[j >> 1][(j & 1) * 2 + 1], x1 = a[j], x2 = b[j]; a[j] = x1 * c - x2 * s; b[j] = x2 * c + x1 * s; }
        if ((lane & 3) == 0) { st8f(row + C_DIQ + (lane >> 2) * 64, a); st8f(row + C_DIQ + (lane >> 2) * 64 + 8, b); } }
    {
        float a[8], b[8]; unpack8(I.ik0, a); unpack8(I.ik1, b);
        if ((lane & 3) == 0) {
#pragma unroll
            for (int j = 0; j < 8; ++j) { const float c = I.c16[j >> 1][(j & 1) * 2], s = I.c16[j >> 1][(j & 1) * 2 + 1], x1 = a[j], x2 = b[j]; a[j] = x1 * c - x2 * s; b[j] = x2 * c + x1 * s; } }
        if (lane < 4) { bf16_t* dst = P.ikc_() + (size_t)(tok >> 5) * 2048 + lane * 512 + (tok & 31) * 8; st8f(dst, a); st8f(dst + 256, b); } }
    if (lane >= 16 && lane < 32) *(u32x4*)(P.kvc_() + (size_t)tok * 256 + 128 + l16 * 8) = I.v;
    if (lane < 16) P.iw_()[(size_t)tok * 16 + lane] = bf2f(I.w) * (1.f / 32.f);
}
__device__ __forceinline__ void phase_prep(const Params& P, int layer) {
    const int wid = TIDX() >> 6, lane = TIDX() & 63, l16 = lane & 15;
    float gq[8], gk[8], gm[8];
#pragma unroll
    for (int j = 0; j < 8; ++j) { gq[j] = P.dsa_q_norm[layer * 128 + 8 * l16 + j]; gk[j] = P.dsa_k_norm[layer * 128 + 8 * l16 + j]; gm[j] = P.mem_q_norm[layer * 128 + 8 * l16 + j]; }
    const int stride = gridDim.x * 8;
    for (int tok = blockIdx.x * 8 + wid; tok < NTOK; tok += 2 * stride) {
        const int tok2 = tok + stride; const bool two = tok2 < NTOK;
        PrepIn A, B2;
        prep_load(P, tok, lane, A); prep_load(P, two ? tok2 : tok, lane, B2);
        prep_finish(P, tok, lane, A, gq, gk, gm);
        if (two) prep_finish(P, tok2, lane, B2, gq, gk, gm);
    }
}
struct MemOutRow { const bf16_t* zb; bf16_t* gb;
    __device__ __forceinline__ const bf16_t* zrow(int r) const { return zb + (size_t)r * NPAD; } __device__ __forceinline__ bf16_t* grow(int r) const { return gb + (size_t)r * MIX; } };
__device__ __forceinline__ void unit_mem_attn(const Params& P, int layer, int u, char* lds) {
    const int b = u >> 6, h = (u >> 4) & 3, qb = u & 15, tok0 = b * SEQ + qb * 256;
    const int wid = TIDX() >> 6, lane = TIDX() & 63, r32 = lane & 31, hi = lane >> 5;
    const bf16_t* Qw = P.p_() + (size_t)(tok0 + wid * 32 + r32) * NPAD + C_MQ + h * 128 + hi * 8;
    const bf16_t* Kh = P.kvmem_() + (size_t)(b * MEML) * (DEPTH * 1024) + layer * 1024 + h * 128;
    MemOutRow ow; ow.zb = P.p_() + (size_t)(tok0 + wid * 32) * NPAD + C_MZ + h * 128; ow.gb = P.xn_() + (size_t)(tok0 + wid * 32) * MIX + 1536 + h * 128;
    att::attn_body<false, DEPTH * 1024, 512, 1, MemOutRow>(Qw, P.mem_q_norm + layer * 128, nullptr, Kh, MEML / 64, nullptr, 0u, ow, lds);
}

__device__ __forceinline__ void phase_gate(const Params& P, int c_lo, int c_hi) {
    const int wid = TIDX() >> 6, lane = TIDX() & 63;
    const int c0 = lane * 32;
    const int seg = c0 >> 9, zc = (seg == 0 ? C_GZ : seg == 1 ? C_SZ : seg == 2 ? C_DZ : C_MZ) + (c0 & 511);
    const bool act = (c0 >= c_lo) && (c0 < c_hi);
    for (int tok = blockIdx.x * 8 + wid; tok < NTOK; tok += gridDim.x * 8) {
        if (!act) { bf16_t* gz_ = P.xn_() + (size_t)tok * MIX + c0; const u32x4 zz = {0u, 0u, 0u, 0u};
#pragma unroll
            for (int i = 0; i < 4; ++i) *(u32x4*)(gz_ + 8 * i) = zz;
            continue; }
        const bf16_t* op = P.ocat_() + (size_t)tok * MIX + c0; const bf16_t* zp = P.p_() + (size_t)tok * NPAD + zc; bf16_t* gp = P.xn_() + (size_t)tok * MIX + c0;
        float o[32]; float ss = 0.f;
#pragma unroll
        for (int i = 0; i < 4; ++i) { float v[8]; ld8f(op + 8 * i, v);
#pragma unroll
            for (int j = 0; j < 8; ++j) { o[8 * i + j] = v[j]; ss += v[j] * v[j]; } }
        ss += shx(ss, 1); ss += shx(ss, 2);
        const float r = rsqrtf(ss * (1.f / 128.f) + EPS);
#pragma unroll
        for (int i = 0; i < 4; ++i) { float z[8], g[8]; ld8f(zp + 8 * i, z);
#pragma unroll
            for (int j = 0; j < 8; ++j) g[j] = o[8 * i + j] * r * siluf_(z[j]);
            st8f(gp + 8 * i, g); }
    }
}

__device__ __forceinline__ void phase_gemm_in(const Params& P, int layer, char* lds) {
    pg8::Gemm g; g.A = P.xn_(); g.Bt = P.WinT_() + (size_t)layer * NPAD * DM; g.M = NTOK; g.N = NPAD; g.K = DM;
    pg8::StaticOrder S; S.init(g.M, g.N, (int)gridDim.x, (int)blockIdx.x);
    pg8::EpiBf16Plain E; E.O = P.p_(); E.ldc = NPAD;
    pg8::gemm_phase<pg8::EpiBf16Plain, pg8::StaticOrder, false>((PG8_LAS unsigned char*)lds, g, S, E, nullptr);
}
__device__ __forceinline__ void phase_gemm_out(const Params& P, int layer, char* lds) {
    pg8::Gemm g; g.A = P.xn_(); g.Bt = P.WoutT_() + (size_t)layer * DM * MIX; g.M = NTOK; g.N = DM; g.K = MIX;
    pg8::StaticOrder S; S.init(g.M, g.N, (int)gridDim.x, (int)blockIdx.x);
    pg8::EpiResidMix E; E.R = (layer == 0) ? (const void*)P.x : (const void*)P.xbuf_(); E.C = (layer == DEPTH - 1) ? (void*)P.out : (void*)P.xbuf_(); E.ldc = DM;
    E.r16 = (layer != 0); E.c16 = (layer != DEPTH - 1);
    pg8::gemm_phase<pg8::EpiResidMix, pg8::StaticOrder, false>((PG8_LAS unsigned char*)lds, g, S, E, nullptr);
}
__device__ __forceinline__ void phase_gemm_kv(const Params& P, char* lds) {
    pg8::Gemm g; g.A = P.memn_(); g.Bt = P.WkvT_(); g.M = NB * MEML; g.N = DEPTH * 1024; g.K = DM;
    pg8::StaticOrder S; S.init(g.M, g.N, (int)gridDim.x, (int)blockIdx.x);
    pg8::EpiBf16Plain E; E.O = P.kvmem_(); E.ldc = DEPTH * 1024;
    pg8::gemm_phase<pg8::EpiBf16Plain, pg8::StaticOrder, false>((PG8_LAS unsigned char*)lds, g, S, E, nullptr);
}
__device__ __forceinline__ void mma_tile(f32x16& acc, const char* A, int lda, const char* B, int ldb, int K, int lane) {
    const int r = lane & 31, kh = lane >> 5;
    const char* ap = A + r * lda + kh * 16; const char* bp = B + r * ldb + kh * 16;
    asm volatile("" : "+v"(acc));
    for (int k = 0; k < K; k += 16) {
        const bf16x8 a = *(const bf16x8*)(ap + k * 2); const bf16x8 b = *(const bf16x8*)(bp + k * 2);
        acc = __builtin_amdgcn_mfma_f32_32x32x16_bf16(a, b, acc, 0, 0, 0);
    }
}
__device__ __forceinline__ int crow32(int r, int hi) { return (r & 3) + 8 * (r >> 2) + 4 * hi; }
__device__ __forceinline__ float log_sigmoid_(float x) { return fminf(x, 0.f) - log1pf(__expf(-fabsf(x))); }

constexpr int GLA_ST = 144;
constexpr int GC_BST = 68;
constexpr int GC_B_BYTES = 4 * 64 * GC_BST * 4, GC_V_BYTES = 4 * 16384;
__device__ __forceinline__ float* gla_gb(const Params& P) { return (float*)((char*)P.ocat_() + (size_t)32 * 1024 * 1024); }
__device__ __forceinline__ float log_sigmoid_fast(float x) { return fminf(x, 0.f) - __logf(1.f + __expf(-fabsf(x))); }

__device__ __forceinline__ void unit_gla_a4(const Params& P, int layer, int ub, char* lds) {
    const int b = ub >> 6, n = ub & 63, tok0 = b * SEQ + n * 64;
    const int tid = TIDX(), wid = tid >> 6, lane = tid & 63, r32 = lane & 31, hi = lane >> 5, h = wid >> 1, eh = wid & 1;
    float* b_s = (float*)lds;
    char* V_s = lds;
    char* K_s = lds + GC_B_BYTES;
    float* glr_s = (float*)(lds + GC_B_BYTES + GC_V_BYTES);
    float* tot_s = glr_s + 1024;
    __syncthreads();
    const bf16_t* prow = P.p_() + (size_t)tok0 * NPAD;
    const bf16x8 glr_raw = *(const bf16x8*)(prow + (size_t)((tid & 127) >> 1) * NPAD + C_GLR + (tid & 1) * 8);
    const int gd = tid & 63, gh = (tid >> 6) & 3, gt = tid >> 8;
    float wu[16];
#pragma unroll
    for (int r = 0; r < 16; ++r) wu[r] = P.gla_w_up[((size_t)layer * 16 + r) * 256 + gh * 64 + gd];
    const float bias = P.gla_b_up[layer * 256 + gh * 64 + gd];
    bf16x8 kraw[4], vs[4][2];
    const int ks_ = tid >> 3, kc = (tid & 7) * 8;
#pragma unroll
    for (int hv = 0; hv < 4; ++hv) kraw[hv] = *(const bf16x8*)(prow + (size_t)ks_ * NPAD + C_GK + hv * 64 + kc);
    const int sr = tid >> 4, sc = (tid & 15) * 8;
#pragma unroll
    for (int hv = 0; hv < 4; ++hv) { vs[hv][0] = *(const bf16x8*)(prow + (size_t)sr * NPAD + C_GV + hv * 128 + sc); vs[hv][1] = *(const bf16x8*)(prow + (size_t)(32 + sr) * NPAD + C_GV + hv * 128 + sc); }
    if (tid < 128) {
#pragma unroll
        for (int j = 0; j < 8; ++j) glr_s[(tid >> 1) * 16 + (tid & 1) * 8 + j] = bf2f((bf16_t)glr_raw[j]); }
    __syncthreads();
    float gv[32]; float run = 0.f;
#pragma unroll
    for (int i = 0; i < 32; ++i) { const float* gr = glr_s + (gt * 32 + i) * 16; float a = bias;
#pragma unroll
        for (int r4 = 0; r4 < 4; ++r4) { const f32x4 g4 = *(const f32x4*)(gr + 4 * r4); a = fmaf(g4[0], wu[4 * r4], a); a = fmaf(g4[1], wu[4 * r4 + 1], a); a = fmaf(g4[2], wu[4 * r4 + 2], a); a = fmaf(g4[3], wu[4 * r4 + 3], a); }
        run += log_sigmoid_fast(a) * (1.f / 16.f); gv[i] = run; }
    if (gt == 0) tot_s[gh * 64 + gd] = run;
    __syncthreads();
    { const float off = gt ? tot_s[gh * 64 + gd] : 0.f; float* bp = b_s + (gh * 64 + gt * 32) * GC_BST + gd;
      float* gp = gla_gb(P) + (size_t)(tok0 + gt * 32) * 256 + gh * 64 + gd;
#pragma unroll
      for (int i = 0; i < 32; ++i) { const float v = gv[i] + off; bp[i * GC_BST] = v; gp[(size_t)i * 256] = v; }
      if (gt) P.glad_()[((size_t)((b * 64 + n) * 4 + gh)) * 64 + gd] = __expf(gv[31] + off); }
    __syncthreads();
#pragma unroll
    for (int hv = 0; hv < 4; ++hv) { const float* br = b_s + (hv * 64 + ks_) * GC_BST + kc; const float* bl = b_s + (hv * 64 + 63) * GC_BST + kc;
        const f32x4 b0 = *(const f32x4*)br, b1 = *(const f32x4*)(br + 4), l0 = *(const f32x4*)bl, l1 = *(const f32x4*)(bl + 4);
        float e[8];
#pragma unroll
        for (int j = 0; j < 8; ++j) e[j] = bf2f((bf16_t)kraw[hv][j]) * __expf((j < 4 ? l0[j] : l1[j - 4]) - (j < 4 ? b0[j] : b1[j - 4]));
        u32x4 w = {att::cvtpk(e[0], e[1]), att::cvtpk(e[2], e[3]), att::cvtpk(e[4], e[5]), att::cvtpk(e[6], e[7])};
        *(u32x4*)(K_s + hv * 16384 + att::v_st(ks_, kc)) = w; }
    __syncthreads();
    { const int vst0 = att::v_st(sr, sc), vst1 = att::v_st(32 + sr, sc);
#pragma unroll
      for (int hv = 0; hv < 4; ++hv) { *(bf16x8*)(V_s + hv * 16384 + vst0) = vs[hv][0]; *(bf16x8*)(V_s + hv * 16384 + vst1) = vs[hv][1]; } }
    __syncthreads();
    const int vb = (int)(uintptr_t)(V_s + h * 16384) + att::v_rd_base(lane), kb = (int)(uintptr_t)(K_s + h * 16384) + att::v_rd_base(lane);
    f32x16 acc[2][2] = {};
    asm volatile("" : "+v"(acc[0][0]), "+v"(acc[0][1]), "+v"(acc[1][0]), "+v"(acc[1][1]));
#define GA_PK(L, H) (bf16x8){L[0], L[1], L[2], L[3], H[0], H[1], H[2], H[3]}
#define GA_STEP(KS) do { \
    const s16x4 k0l = att::tr_read<att::v_rd_off(0, KS, 0)>(kb), k0h = att::tr_read<att::v_rd_off(0, KS, 1)>(kb), k1l = att::tr_read<att::v_rd_off(1, KS, 0)>(kb), k1h = att::tr_read<att::v_rd_off(1, KS, 1)>(kb); \
    s16x4 v0l, v0h, v1l, v1h; \
    if (eh == 0) { v0l = att::tr_read<att::v_rd_off(0, KS, 0)>(vb); v0h = att::tr_read<att::v_rd_off(0, KS, 1)>(vb); v1l = att::tr_read<att::v_rd_off(1, KS, 0)>(vb); v1h = att::tr_read<att::v_rd_off(1, KS, 1)>(vb); } \
    else         { v0l = att::tr_read<att::v_rd_off(2, KS, 0)>(vb); v0h = att::tr_read<att::v_rd_off(2, KS, 1)>(vb); v1l = att::tr_read<att::v_rd_off(3, KS, 0)>(vb); v1h = att::tr_read<att::v_rd_off(3, KS, 1)>(vb); } \
    asm volatile("s_waitcnt lgkmcnt(0)" ::: "memory"); __builtin_amdgcn_sched_barrier(0); \
    acc[0][0] = __builtin_amdgcn_mfma_f32_32x32x16_bf16(GA_PK(v0l, v0h), GA_PK(k0l, k0h), acc[0][0], 0, 0, 0); \
    acc[0][1] = __builtin_amdgcn_mfma_f32_32x32x16_bf16(GA_PK(v0l, v0h), GA_PK(k1l, k1h), acc[0][1], 0, 0, 0); \
    acc[1][0] = __builtin_amdgcn_mfma_f32_32x32x16_bf16(GA_PK(v1l, v1h), GA_PK(k0l, k0h), acc[1][0], 0, 0, 0); \
    acc[1][1] = __builtin_amdgcn_mfma_f32_32x32x16_bf16(GA_PK(v1l, v1h), GA_PK(k1l, k1h), acc[1][1], 0, 0, 0); } while (0)
    GA_STEP(0); GA_STEP(1); GA_STEP(2); GA_STEP(3);
#undef GA_STEP
#undef GA_PK
    float* dst = P.glas_() + ((size_t)((b * 64 + n) * 4 + h)) * 8192;
#pragma unroll
    for (int et = 0; et < 2; ++et)
#pragma unroll
        for (int dt = 0; dt < 2; ++dt)
#pragma unroll
            for (int r = 0; r < 16; ++r) dst[((eh * 2 + et) * 32 + att::crow(r, hi)) * 64 + dt * 32 + r32] = acc[et][dt][r];
    __syncthreads();
}

__device__ __forceinline__ void gla_scan_slice(const Params& P, int idx) {
    {
        const int el = idx & 8191, d = idx & 63, h = (idx >> 13) & 3, b = idx >> 15;
        bf16_t* gst = P.ocat_();
        float S = 0.f;
        for (int n0 = 0; n0 < 64; n0 += 8) {
            float ds[8], dc[8];
#pragma unroll
            for (int i = 0; i < 8; ++i) { const size_t cu = (size_t)((b * 64 + n0 + i) * 4 + h); ds[i] = P.glas_()[cu * 8192 + el]; dc[i] = P.glad_()[cu * 64 + d]; }
#pragma unroll
            for (int i = 0; i < 8; ++i) { const size_t cu = (size_t)((b * 64 + n0 + i) * 4 + h); gst[cu * 8192 + el] = f2bf(S); S = fmaf(dc[i], S, ds[i]); }
        }
    }
}

__device__ __forceinline__ void unit_gla_c4(const Params& P, int layer, int ub, char* lds) {
    const int b = ub >> 6, n = ub & 63, tok0 = b * SEQ + n * 64;
    const int tid = TIDX(), wid = tid >> 6, lane = tid & 63, r32 = lane & 31, hi = lane >> 5, h = wid >> 1, rh = wid & 1;
    float* b_s = (float*)lds;
    char* V_s = lds + GC_B_BYTES;
    __syncthreads();
    const bf16_t* prow = P.p_() + (size_t)tok0 * NPAD;
    bf16x8 qraw[4], kraw[2][4], vs[4][2];
    const int sr = tid >> 4, sc = (tid & 15) * 8;
#pragma unroll
    for (int hv = 0; hv < 4; ++hv) { vs[hv][0] = *(const bf16x8*)(prow + (size_t)sr * NPAD + C_GV + hv * 128 + sc); vs[hv][1] = *(const bf16x8*)(prow + (size_t)(32 + sr) * NPAD + C_GV + hv * 128 + sc); }
    f32x4 braw[8];
    { const float* gp = gla_gb(P) + (size_t)tok0 * 256 + tid * 4;
#pragma unroll
      for (int i = 0; i < 8; ++i) braw[i] = *(const f32x4*)(gp + i * 2048); }
    { const bf16_t* qp = prow + (size_t)(rh * 32 + r32) * NPAD + C_GQ + h * 64 + hi * 8;
#pragma unroll
      for (int d0 = 0; d0 < 4; ++d0) qraw[d0] = *(const bf16x8*)(qp + d0 * 16);
#pragma unroll
      for (int sh = 0; sh < 2; ++sh) { const bf16_t* kp = prow + (size_t)(sh * 32 + r32) * NPAD + C_GK + h * 64 + hi * 8;
#pragma unroll
          for (int d0 = 0; d0 < 4; ++d0) kraw[sh][d0] = *(const bf16x8*)(kp + d0 * 16); } }
    bf16x8 sfr[4][4];
    { const bf16_t* sp = P.ocat_() + ((size_t)((b * 64 + n) * 4 + h)) * 8192 + r32 * 64 + hi * 8;
#pragma unroll
      for (int eb = 0; eb < 4; ++eb)
#pragma unroll
          for (int ds = 0; ds < 4; ++ds) sfr[eb][ds] = *(const bf16x8*)(sp + eb * 32 * 64 + ds * 16); }
    { const int vst0 = att::v_st(sr, sc), vst1 = att::v_st(32 + sr, sc);
#pragma unroll
      for (int hv = 0; hv < 4; ++hv) { *(bf16x8*)(V_s + hv * 16384 + vst0) = vs[hv][0]; *(bf16x8*)(V_s + hv * 16384 + vst1) = vs[hv][1]; } }
#pragma unroll
    for (int i = 0; i < 8; ++i) { const int c = tid + 512 * i, t = c >> 6, c4 = c & 63;
        *(f32x4*)(b_s + ((c4 >> 4) * 64 + t) * GC_BST + (c4 & 15) * 4) = braw[i]; }
    __syncthreads();
    const float* bh = b_s + h * 64 * GC_BST + hi * 8;
    bf16x8 qe[4], qb[4], ke[2][4];
#pragma unroll
    for (int d0 = 0; d0 < 4; ++d0) {
        const f32x4 m0 = *(const f32x4*)(bh + 32 * GC_BST + d0 * 16), m1 = *(const f32x4*)(bh + 32 * GC_BST + d0 * 16 + 4);
        const f32x4 q0 = *(const f32x4*)(bh + (rh * 32 + r32) * GC_BST + d0 * 16), q1 = *(const f32x4*)(bh + (rh * 32 + r32) * GC_BST + d0 * 16 + 4);
        float e1[8], e2[8];
#pragma unroll
        for (int j = 0; j < 8; ++j) { const float mv = j < 4 ? m0[j] : m1[j - 4], bq = j < 4 ? q0[j] : q1[j - 4]; const float q = bf2f((bf16_t)qraw[d0][j]) * 0.125f;
            e1[j] = q * __expf(bq - mv); e2[j] = q * __expf(bq); }
        { u32x4 w = {att::cvtpk(e1[0], e1[1]), att::cvtpk(e1[2], e1[3]), att::cvtpk(e1[4], e1[5]), att::cvtpk(e1[6], e1[7])}; qe[d0] = *reinterpret_cast<bf16x8*>(&w); }
        { u32x4 w = {att::cvtpk(e2[0], e2[1]), att::cvtpk(e2[2], e2[3]), att::cvtpk(e2[4], e2[5]), att::cvtpk(e2[6], e2[7])}; qb[d0] = *reinterpret_cast<bf16x8*>(&w); }
#pragma unroll
        for (int sh = 0; sh < 2; ++sh) {
            const f32x4 k0 = *(const f32x4*)(bh + (sh * 32 + r32) * GC_BST + d0 * 16), k1 = *(const f32x4*)(bh + (sh * 32 + r32) * GC_BST + d0 * 16 + 4);
            float e3[8];
#pragma unroll
            for (int j = 0; j < 8; ++j) { const float mv = j < 4 ? m0[j] : m1[j - 4], bk = j < 4 ? k0[j] : k1[j - 4]; e3[j] = bf2f((bf16_t)kraw[sh][d0][j]) * __expf(mv - bk); }
            u32x4 w = {att::cvtpk(e3[0], e3[1]), att::cvtpk(e3[2], e3[3]), att::cvtpk(e3[4], e3[5]), att::cvtpk(e3[6], e3[7])}; ke[sh][d0] = *reinterpret_cast<bf16x8*>(&w); }
    }
    f32x16 p0 = {}, p1 = {};
    asm volatile("" : "+v"(p0), "+v"(p1));
#pragma unroll
    for (int d0 = 0; d0 < 4; ++d0) { p0 = __builtin_amdgcn_mfma_f32_32x32x16_bf16(ke[0][d0], qe[d0], p0, 0, 0, 0); p1 = __builtin_amdgcn_mfma_f32_32x32x16_bf16(ke[1][d0], qe[d0], p1, 0, 0, 0); }
    { const int t = rh * 32 + r32;
#pragma unroll
      for (int r = 0; r < 16; ++r) { const int s0 = att::crow(r, hi); p0[r] = (s0 <= t) ? p0[r] : 0.f; p1[r] = (32 + s0 <= t) ? p1[r] : 0.f; } }
    bf16x8 pa0, pa1, pa2, pa3;
#define GC_PK4(Pv, BASE, OUT) do { unsigned a0 = att::cvtpk(Pv[BASE + 0], Pv[BASE + 1]), a1 = att::cvtpk(Pv[BASE + 2], Pv[BASE + 3]);   \
    unsigned b0 = att::cvtpk(Pv[BASE + 4], Pv[BASE + 5]), b1 = att::cvtpk(Pv[BASE + 6], Pv[BASE + 7]);                              \
    auto r0 = __builtin_amdgcn_permlane32_swap(a0, b0, false, false); auto r1 = __builtin_amdgcn_permlane32_swap(a1, b1, false, false); \
    u32x4 w = {r0[0], r1[0], r0[1], r1[1]}; OUT = *reinterpret_cast<bf16x8*>(&w); } while (0)
    GC_PK4(p0, 0, pa0); GC_PK4(p0, 8, pa1); GC_PK4(p1, 0, pa2); GC_PK4(p1, 8, pa3);
#undef GC_PK4
    f32x16 o[4] = {};
    asm volatile("" : "+v"(o[0]), "+v"(o[1]), "+v"(o[2]), "+v"(o[3]));
    att::pv_d0(o, (int)(uintptr_t)(V_s + h * 16384) + att::v_rd_base(lane), pa0, pa1, pa2, pa3);
#pragma unroll
    for (int eb = 0; eb < 4; ++eb)
#pragma unroll
        for (int ds = 0; ds < 4; ++ds) o[eb] = __builtin_amdgcn_mfma_f32_32x32x16_bf16(qb[ds], sfr[eb][ds], o[eb], 0, 0, 0);
    __syncthreads();
    float* og_s = (float*)lds + wid * (32 * 132);
#pragma unroll
    for (int r = 0; r < 16; ++r) {
#pragma unroll
        for (int eb = 0; eb < 4; ++eb) og_s[att::crow(r, hi) * 132 + eb * 32 + r32] = o[eb][r]; }
    asm volatile("" ::: "memory");
    { const int row = lane >> 1, half = lane & 1; const float* src = og_s + row * 132 + half * 64;
      f32x4 v[16]; float ss = 0.f;
#pragma unroll
      for (int i = 0; i < 16; ++i) { v[i] = *(const f32x4*)(src + 4 * i); ss += v[i][0] * v[i][0] + v[i][1] * v[i][1] + v[i][2] * v[i][2] + v[i][3] * v[i][3]; }
      ss += shx(ss, 1);
      const float rn = rsqrtf(ss * (1.f / 128.f) + EPS);
      const size_t tok = (size_t)(tok0 + rh * 32 + row);
      const bf16_t* zp = P.p_() + tok * NPAD + C_GZ + h * 128 + half * 64; bf16_t* gp = P.xn_() + tok * MIX + h * 128 + half * 64;
#pragma unroll
      for (int i = 0; i < 8; ++i) { float z[8], g[8]; ld8f(zp + 8 * i, z);
#pragma unroll
          for (int q = 0; q < 4; ++q) { g[q] = v[2 * i][q] * rn * siluf_(z[q]); g[4 + q] = v[2 * i + 1][q] * rn * siluf_(z[4 + q]); }
          st8f(gp + 8 * i, g); } }
    __syncthreads();
}
constexpr int S5P_STRIDE = 2304;
__device__ __forceinline__ void phase_s5_params(const Params& P) {
    for (int idx = blockIdx.x * NTHR + TIDX(); idx < DEPTH * 32 * 64; idx += gridDim.x * NTHR) {
        const int p = idx & 63, lg = idx >> 6;
        const float ar = P.s5_a_re[idx], ai = P.s5_a_im[idx], step = expf(P.s5_log_step[lg]);
        const float mag = expf(ar * step), th = ai * step;
        const float lr = mag * cosf(th), li = mag * sinf(th);
        float* o = P.s5p_() + (size_t)lg * S5P_STRIDE;
        o[2 * p] = lr; o[2 * p + 1] = li;
        { const float mag512 = expf(512.f * ar * step); const double a = 512.0 * (double)th; const double k = rint(a * 0.15915494309189535); const float rf = (float)fma(-k, 6.283185307179586, a);
          o[128 + 2 * p] = mag512 * cosf(rf); o[128 + 2 * p + 1] = mag512 * sinf(rf); }
        const float xr = lr - 1.f, xi = li, den = 1.f / (ar * ar + ai * ai);
        const float fr = (xr * ar + xi * ai) * den, fi = (xi * ar - xr * ai) * den;
        for (int c = 0; c < 16; ++c) { const float br = P.s5_b_re[(size_t)idx * 16 + c], bi = P.s5_b_im[(size_t)idx * 16 + c];
            o[256 + (p * 16 + c) * 2] = fr * br - fi * bi; o[256 + (p * 16 + c) * 2 + 1] = fr * bi + fi * br; }
    }
}
__device__ __forceinline__ float gelu_tanh_(float x) { const float u = 0.7978845608028654f * (x + 0.044715f * x * x * x); const float e = __expf(-2.f * fabsf(u)); const float th = copysignf((1.f - e) * __builtin_amdgcn_rcpf(1.f + e), u); return 0.5f * x * (1.f + th); }

constexpr int S5_XST = 272;
constexpr int S5_UST = 48;
__device__ __forceinline__ float partner32(float v, int hi) { auto rr = __builtin_amdgcn_permlane32_swap(__float_as_uint(v), __float_as_uint(v), false, false); return __uint_as_float(hi ? rr[0] : rr[1]); }
struct S5Ctx { float l0r, l0i, l1r, l1i, q0r, q0i, q1r, q1i, dsk; char* Cm; char* Bb; char* Xs; char* Us; int lane, hi, j, rho; const bf16_t* ubase; bf16_t* ybase; };
template <bool OUT> __device__ __forceinline__ void s5_tile(const S5Ctx& C, int tok0, float& x0r, float& x0i, float& x1r, float& x1i) {
    const int hi = C.hi, j = C.j, lane = C.lane;
    if (hi == 0) { const bf16_t* up = C.ubase + (size_t)(tok0 + j) * NPAD;
        const bf16x8 w0 = *(const bf16x8*)up, w1 = *(const bf16x8*)(up + 8);
        *(bf16x8*)(C.Us + C.rho * S5_UST) = w0; *(bf16x8*)(C.Us + C.rho * S5_UST + 16) = w1; }
    asm volatile("" ::: "memory");
    f32x16 a0 = {}, a1 = {}, a2 = {}, a3 = {};
    mma_tile(a0, C.Us, S5_UST, C.Bb, S5_UST, 16, lane); mma_tile(a1, C.Us, S5_UST, C.Bb + 32 * S5_UST, S5_UST, 16, lane);
    mma_tile(a2, C.Us, S5_UST, C.Bb + 64 * S5_UST, S5_UST, 16, lane); mma_tile(a3, C.Us, S5_UST, C.Bb + 96 * S5_UST, S5_UST, 16, lane);
    float s0r[16], s0i[16], s1r[16], s1i[16];
#pragma unroll
    for (int r = 0; r < 16; ++r) {
        const float n0r = fmaf(C.l0r, x0r, fmaf(-C.l0i, x0i, a0[r])), n0i = fmaf(C.l0r, x0i, fmaf(C.l0i, x0r, a1[r])); x0r = n0r; x0i = n0i; s0r[r] = n0r; s0i[r] = n0i;
        const float n1r = fmaf(C.l1r, x1r, fmaf(-C.l1i, x1i, a2[r])), n1i = fmaf(C.l1r, x1i, fmaf(C.l1i, x1r, a3[r])); x1r = n1r; x1i = n1i; s1r[r] = n1r; s1i[r] = n1i; }
    float z0r = partner32(x0r, hi), z0i = partner32(x0i, hi), z1r = partner32(x1r, hi), z1i = partner32(x1i, hi);
    if (hi == 0) { z0r = 0.f; z0i = 0.f; z1r = 0.f; z1i = 0.f; }
    if (!OUT) {
        x0r += C.q0r * z0r - C.q0i * z0i; x0i += C.q0r * z0i + C.q0i * z0r; x1r += C.q1r * z1r - C.q1i * z1i; x1i += C.q1r * z1i + C.q1i * z1r;
    } else {
#pragma unroll
        for (int r = 0; r < 16; ++r) {
            const float t0r = C.l0r * z0r - C.l0i * z0i, t0i = C.l0r * z0i + C.l0i * z0r; z0r = t0r; z0i = t0i; s0r[r] += t0r; s0i[r] += t0i;
            const float t1r = C.l1r * z1r - C.l1i * z1i, t1i = C.l1r * z1i + C.l1i * z1r; z1r = t1r; z1i = t1i; s1r[r] += t1r; s1i[r] += t1i; }
        x0r = s0r[15]; x0i = s0i[15]; x1r = s1r[15]; x1i = s1i[15];
#pragma unroll
        for (int r = 0; r < 16; ++r) { char* xr_ = C.Xs + (r + 16 * hi) * S5_XST;
            *(bf16_t*)(xr_ + j * 2) = f2bf(s0r[r]); *(bf16_t*)(xr_ + (64 + j) * 2) = f2bf(s0i[r]);
            *(bf16_t*)(xr_ + (32 + j) * 2) = f2bf(s1r[r]); *(bf16_t*)(xr_ + (96 + j) * 2) = f2bf(s1i[r]); }
        asm volatile("" ::: "memory");
        f32x16 acc = {}; mma_tile(acc, C.Xs, S5_XST, C.Cm, S5_XST, 128, lane);
        if (j < 16) {
#pragma unroll
            for (int r = 0; r < 16; ++r) { const int t = crow32(r, hi); const int rt = ((t & 15) & 3) + 8 * ((t & 15) >> 2) + 4 * (t >> 4);
                const float y = acc[r] + C.dsk * bf2f(*(const bf16_t*)(C.Us + rt * S5_UST + j * 2));
                C.ybase[(size_t)(tok0 + t) * 512 + j] = f2bf(gelu_tanh_(y)); } }
        asm volatile("" ::: "memory");
    }
    { const float e0r = partner32(x0r, hi), e0i = partner32(x0i, hi), e1r = partner32(x1r, hi), e1i = partner32(x1i, hi);
      if (hi == 0) { x0r = e0r; x0i = e0i; x1r = e1r; x1i = e1i; } else { x0r = 0.f; x0i = 0.f; x1r = 0.f; x1i = 0.f; } }
}
__device__ __forceinline__ void unit_s5(const Params& P, int layer, int u, char* lds) {
    const int b = u >> 5, g = u & 31, tid = TIDX(), wid = tid >> 6, lane = tid & 63, hi = lane >> 5, j = lane & 31;
    char* Cm = lds;
    char* Bb = Cm + 32 * S5_XST;
    float* ends = (float*)(Bb + 128 * S5_UST);
    char* wbase = (char*)(ends + 8 * 64 * 2) + wid * (32 * S5_XST + 32 * S5_UST);
    const float* sp = P.s5p_() + (size_t)(layer * 32 + g) * S5P_STRIDE;
    __syncthreads();
    for (int i = tid; i < 32 * 128; i += NTHR) { const int c = i >> 7, pp = i & 127; float v = 0.f;
        if (c < 16) v = (pp < 64) ? P.s5_c_re[((size_t)(layer * 32 + g) * 16 + c) * 64 + pp] : -P.s5_c_im[((size_t)(layer * 32 + g) * 16 + c) * 64 + (pp - 64)];
        *(bf16_t*)(Cm + c * S5_XST + pp * 2) = f2bf(v); }
    for (int i = tid; i < 128 * 16; i += NTHR) { const int n = i >> 4, c = i & 15, nt = n >> 5, jj = n & 31, p = (nt >> 1) * 32 + jj;
        *(bf16_t*)(Bb + n * S5_UST + c * 2) = f2bf(sp[256 + (p * 16 + c) * 2 + (nt & 1)]); }
    S5Ctx C; C.Cm = Cm; C.Bb = Bb; C.Xs = wbase; C.Us = wbase + 32 * S5_XST; C.lane = lane; C.hi = hi; C.j = j;
    C.l0r = sp[2 * j]; C.l0i = sp[2 * j + 1]; C.l1r = sp[2 * (32 + j)]; C.l1i = sp[2 * (32 + j) + 1];
    { float q0r = C.l0r, q0i = C.l0i, q1r = C.l1r, q1i = C.l1i;
#pragma unroll
      for (int k = 0; k < 4; ++k) { const float a = q0r * q0r - q0i * q0i, bb = (q0r + q0r) * q0i; q0r = a; q0i = bb; const float c = q1r * q1r - q1i * q1i, d = (q1r + q1r) * q1i; q1r = c; q1i = d; }
      C.q0r = q0r; C.q0i = q0i; C.q1r = q1r; C.q1i = q1i; }
    C.dsk = P.s5_d[layer * 512 + g * 16 + (lane & 15)];
    C.rho = ((j & 15) & 3) + 8 * ((j & 15) >> 2) + 4 * (j >> 4);
    const int tokw = b * SEQ + wid * 512;
    C.ubase = P.p_() + C_SU + g * 16; C.ybase = P.ybuf_() + g * 16;
    float x0r = 0.f, x0i = 0.f, x1r = 0.f, x1i = 0.f;
    __syncthreads();
    for (int sc = 0; sc < 16; ++sc) s5_tile<false>(C, tokw + sc * 32, x0r, x0i, x1r, x1i);
    if (hi == 0) { ends[(wid * 64 + j) * 2] = x0r; ends[(wid * 64 + j) * 2 + 1] = x0i; ends[(wid * 64 + 32 + j) * 2] = x1r; ends[(wid * 64 + 32 + j) * 2 + 1] = x1i; }
    __syncthreads();
    { const float p0r = sp[128 + 2 * j], p0i = sp[128 + 2 * j + 1], p1r = sp[128 + 2 * (32 + j)], p1i = sp[128 + 2 * (32 + j) + 1];
      x0r = 0.f; x0i = 0.f; x1r = 0.f; x1i = 0.f;
      for (int w = 0; w < wid; ++w) { const float e0r = ends[(w * 64 + j) * 2], e0i = ends[(w * 64 + j) * 2 + 1], e1r = ends[(w * 64 + 32 + j) * 2], e1i = ends[(w * 64 + 32 + j) * 2 + 1];
          const float n0r = p0r * x0r - p0i * x0i + e0r, n0i = p0r * x0i + p0i * x0r + e0i, n1r = p1r * x1r - p1i * x1i + e1r, n1i = p1r * x1i + p1i * x1r + e1i;
          x0r = n0r; x0i = n0i; x1r = n1r; x1i = n1i; }
      if (hi) { x0r = 0.f; x0i = 0.f; x1r = 0.f; x1i = 0.f; } }
    for (int sc = 0; sc < 16; ++sc) s5_tile<true>(C, tokw + sc * 32, x0r, x0i, x1r, x1i);
}
constexpr int TOPK = 256;
__device__ __forceinline__ unsigned f2key(float f) { const unsigned u = __float_as_uint(f); return u ^ ((u & 0x80000000u) ? 0xffffffffu : 0x80000000u); }

__device__ __forceinline__ float relu1(float x) { const int b = __float_as_int(x); return __int_as_float(b > 0 ? b : 0); }
#define DSA_MM(acc, rt, kk) acc = __builtin_amdgcn_mfma_f32_32x32x16_bf16(afr[rt][kk], bfr[kk], acc, 0, 0, 0)
#define DSA_HS(acc, rt, q) do { s0 = fmaf(relu1(acc[4 * (q)]), wv[rt][4 * (q)], s0); s1 = fmaf(relu1(acc[4 * (q) + 1]), wv[rt][4 * (q) + 1], s1); \
                                s0 = fmaf(relu1(acc[4 * (q) + 2]), wv[rt][4 * (q) + 2], s0); s1 = fmaf(relu1(acc[4 * (q) + 3]), wv[rt][4 * (q) + 3], s1); } while (0)
#define DSA_SG() __builtin_amdgcn_sched_barrier(0)
__device__ __forceinline__ void dsa_score_tile(const bf16x8 (&afr)[4][4], const f32x16 (&wv)[4], const bf16x8 (&bfr)[4], float* sc, int col, int hi) {
    const f32x16 z16 = {};
#define DSA_M0(acc, rt) acc = __builtin_amdgcn_mfma_f32_32x32x16_bf16(afr[rt][0], bfr[0], z16, 0, 0, 0)
    f32x16 accA, accB;
    float s0, s1;
    DSA_M0(accA, 0); DSA_MM(accA, 0, 1); DSA_MM(accA, 0, 2); DSA_MM(accA, 0, 3);
    s0 = 0.f; s1 = 0.f;
    DSA_M0(accB, 1); DSA_HS(accA, 0, 0); DSA_SG(); DSA_MM(accB, 1, 1); DSA_HS(accA, 0, 1); DSA_SG();
    DSA_MM(accB, 1, 2); DSA_HS(accA, 0, 2); DSA_SG(); DSA_MM(accB, 1, 3); DSA_HS(accA, 0, 3); DSA_SG();
    sc[(0 + hi) * 4096 + col] = (s0 + s1) + 0.f;
    s0 = 0.f; s1 = 0.f;
    DSA_M0(accA, 2); DSA_HS(accB, 1, 0); DSA_SG(); DSA_MM(accA, 2, 1); DSA_HS(accB, 1, 1); DSA_SG();
    DSA_MM(accA, 2, 2); DSA_HS(accB, 1, 2); DSA_SG(); DSA_MM(accA, 2, 3); DSA_HS(accB, 1, 3); DSA_SG();
    sc[(2 + hi) * 4096 + col] = (s0 + s1) + 0.f;
    s0 = 0.f; s1 = 0.f;
    DSA_M0(accB, 3); DSA_HS(accA, 2, 0); DSA_SG(); DSA_MM(accB, 3, 1); DSA_HS(accA, 2, 1); DSA_SG();
    DSA_MM(accB, 3, 2); DSA_HS(accA, 2, 2); DSA_SG(); DSA_MM(accB, 3, 3); DSA_HS(accA, 2, 3); DSA_SG();
    asm volatile("" :: "v"(bfr[0]), "v"(bfr[1]), "v"(bfr[2]), "v"(bfr[3]));
    sc[(4 + hi) * 4096 + col] = (s0 + s1) + 0.f;
    s0 = 0.f; s1 = 0.f;
    DSA_HS(accB, 3, 0); DSA_HS(accB, 3, 1); DSA_HS(accB, 3, 2); DSA_HS(accB, 3, 3);
    sc[(6 + hi) * 4096 + col] = (s0 + s1) + 0.f;
#undef DSA_M0
}
#define DSA_CNT4(K0, K1, K2, K3) asm volatile( \
    "v_cmp_ge_u32_e64 %[m0], %[k0], %[cd]\n\tv_cmp_ge_u32_e64 %[m1], %[k1], %[cd]\n\tv_cmp_ge_u32_e64 %[m2], %[k2], %[cd]\n\tv_cmp_ge_u32_e64 %[m3], %[k3], %[cd]\n\t" \
    "v_addc_co_u32_e64 %[a0], %[m0], %[a0], 0, %[m0]\n\tv_addc_co_u32_e64 %[a1], %[m1], %[a1], 0, %[m1]\n\t" \
    "v_addc_co_u32_e64 %[a0], %[m2], %[a0], 0, %[m2]\n\tv_addc_co_u32_e64 %[a1], %[m3], %[a1], 0, %[m3]" \
    : [a0] "+v"(c0), [a1] "+v"(c1), [m0] "=&s"(sm0), [m1] "=&s"(sm1), [m2] "=&s"(sm2), [m3] "=&s"(sm3) \
    : [k0] "v"(K0), [k1] "v"(K1), [k2] "v"(K2), [k3] "v"(K3), [cd] "v"(cand))
#define DSA_CNT8(J0) do { DSA_CNT4(key[(J0)], key[(J0) + 1], key[(J0) + 2], key[(J0) + 3]); DSA_CNT4(key[(J0) + 4], key[(J0) + 5], key[(J0) + 6], key[(J0) + 7]); } while (0)

template <int J, int JEND> __device__ __forceinline__ void dsa_emit(const unsigned (&key)[64], unsigned T, unsigned& wlo, unsigned& whi) {
    const unsigned long long m = __ballot(key[J] >= T);
    asm("s_nop 1\n\tv_writelane_b32 %0, %2, %4\n\tv_writelane_b32 %1, %3, %4" : "+v"(wlo), "+v"(whi) : "s"((unsigned)m), "s"((unsigned)(m >> 32)), "n"(J));
    if constexpr (J + 1 < JEND) dsa_emit<J + 1, JEND>(key, T, wlo, whi);
}
__device__ __forceinline__ void unit_dsa_index(const Params& P, int u, char* lds) {
    const int b = u & 3, t0 = (511 - (u >> 2)) * 8;
    const int tid = TIDX(), wid = tid >> 6, lane = tid & 63, r32 = lane & 31, hi = lane >> 5;
    float* sc = (float*)lds;
    const bf16_t* pb = P.p_() + (size_t)b * SEQ * NPAD;
    __syncthreads();
    TPU_START(101); TPU_START(110);
    {
        bf16x8 afr[4][4]; f32x16 wv[4];
        const int qsel = (r32 >> 2) & 1, head = (r32 & 3) + 4 * (r32 >> 3);
        char* qs = lds;
        const int ntile = (t0 + 7) / 32 + 1;
        const bf16_t* kp = P.ikc_() + (size_t)(b * (SEQ / 32)) * 2048 + lane * 8;
        bf16x8 b0[4], b1[4], b2[4];
#define DSA_LDB(dst, K) do { const bf16_t* kq_ = kp + (size_t)(wid + 8 * (K)) * 2048; _Pragma("unroll") for (int kk = 0; kk < 4; ++kk) dst[kk] = *(const bf16x8*)(kq_ + kk * 512); } while (0)
#define DSA_TILE(buf, K) dsa_score_tile(afr, wv, buf, sc, (wid + 8 * (K)) * 32 + r32, hi)
        const int nk = (ntile - wid + 7) >> 3;
        const int kl = nk > 0 ? nk - 1 : 0;
#define DSA_MIN(a) ((a) < kl ? (a) : kl)
        const int tk = tid >> 6, hd = (tid & 63) >> 2, dm = (tid & 3) * 16;
        const bf16_t* qsrc = pb + (size_t)(t0 + tk) * NPAD + C_DIQ + hd * 64 + dm;
        const u32x4 qa = *(const u32x4*)qsrc, qb2 = *(const u32x4*)(qsrc + 8);
#pragma unroll
        for (int rt = 0; rt < 4; ++rt) { const float* wp = P.iw_() + (size_t)(b * SEQ + t0 + 2 * rt + hi) * 16;
#pragma unroll
            for (int i = 0; i < 4; ++i) { const f32x4 w4 = *(const f32x4*)(wp + 4 * i); wv[rt][4 * i] = w4[0]; wv[rt][4 * i + 1] = w4[1]; wv[rt][4 * i + 2] = w4[2]; wv[rt][4 * i + 3] = w4[3]; } }
        DSA_LDB(b0, DSA_MIN(0)); DSA_LDB(b1, DSA_MIN(1));
        { char* dst = qs + tk * 2432 + hd * 144 + dm * 2; *(u32x4*)dst = qa; *(u32x4*)(dst + 16) = qb2; }
        __syncthreads();
#pragma unroll
        for (int rt = 0; rt < 4; ++rt) { const char* qp = qs + (2 * rt + qsel) * 2432 + head * 144 + hi * 16;
#pragma unroll
            for (int kk = 0; kk < 4; ++kk) afr[rt][kk] = *(const bf16x8*)(qp + kk * 32); }
        asm volatile("s_waitcnt lgkmcnt(0)" ::: "memory"); __syncthreads();
#if TPROBE == 110
        TPU_STOP(110);
#endif
#if TPROBE == 103
        TPU_START(103); asm volatile("s_waitcnt vmcnt(0)" ::: "memory"); TPU_STOP(103);
#endif
#if TPROBE == 104
        asm volatile("s_waitcnt vmcnt(0)" ::: "memory"); TPU_START(104);
#endif
        int k = 0;
        for (; k + 3 <= nk; k += 3) {
            DSA_LDB(b2, k + 2); DSA_TILE(b0, k);
            DSA_LDB(b0, DSA_MIN(k + 3)); DSA_TILE(b1, k + 1);
            DSA_LDB(b1, DSA_MIN(k + 4)); DSA_TILE(b2, k + 2);
        }
        if (k < nk) DSA_TILE(b0, k);
        if (k + 1 < nk) DSA_TILE(b1, k + 1);
#if TPROBE == 104
        asm volatile("s_waitcnt lgkmcnt(0)" ::: "memory"); TPU_STOP(104);
#endif
        TPU_START(111);
#undef DSA_TILE
#undef DSA_MIN
#undef DSA_TILE
#undef DSA_LDB
    }
    __syncthreads();
    TPU_STOP(111);
    TPU_STOP(101); TPU_START(102);
    {
        const int t = t0 + wid; const float* srow = sc + wid * 4096;
        unsigned key[64];
        {
            const int gfull = (t + 1) >> 9, gany = t / 512 + 1;
#pragma unroll
            for (int g = 0; g < 8; ++g) {
                if (g < gfull) {
#pragma unroll
                    for (int jj = 0; jj < 8; ++jj) key[8 * g + jj] = f2key(srow[(8 * g + jj) * 64 + lane]);
                } else if (g < gany) {
#pragma unroll
                    for (int jj = 0; jj < 8; ++jj) { const int s = (8 * g + jj) * 64 + lane; key[8 * g + jj] = (s <= t) ? f2key(srow[s]) : 0u; }
                } else {
#pragma unroll
                    for (int jj = 0; jj < 8; ++jj) key[8 * g + jj] = 0u;
                }
            }
        }
        unsigned long long* mout = P.mask_() + (size_t)(b * SEQ + t) * 64;
        unsigned long long myword = 0ull;
        TPU_START(105); TPU_START(106); TPU_START(107); TPU_START(108); TPU_START(109);
        if (t + 1 <= TOPK) {
#pragma unroll
            for (int j = 0; j < 64; ++j) { const unsigned long long m = __ballot(j * 64 + lane <= t); if (lane == j) myword = m; }
        } else {
            const int ngrp = t / 512 + 1;
#if TPROBE == 105
            asm volatile("" :: "v"(key[0]), "v"(key[63]));
#endif
            TPU_STOP(105);
            unsigned* hist = (unsigned*)(sc + wid * 4096);
            asm volatile("" ::: "memory");
            { const u32x4 zz4 = {0u, 0u, 0u, 0u};
#pragma unroll
              for (int i = 0; i < 16; ++i) *(u32x4*)(hist + (i * 64 + lane) * 4) = zz4; }
            asm volatile("" ::: "memory");
#define DSA_H8(J0) do { _Pragma("unroll") for (int jj = 0; jj < 8; ++jj) atomicAdd(hist + (key[(J0) + jj] >> 20), 1u); } while (0)
            DSA_H8(0);
            if (ngrp > 1) DSA_H8(8);
            if (ngrp > 2) DSA_H8(16);
            if (ngrp > 3) DSA_H8(24);
            if (ngrp > 4) DSA_H8(32);
            if (ngrp > 5) DSA_H8(40);
            if (ngrp > 6) DSA_H8(48);
            if (ngrp > 7) DSA_H8(56);
#undef DSA_H8
            asm volatile("" ::: "memory");
#if TPROBE == 106
            asm volatile("s_waitcnt lgkmcnt(0)" ::: "memory");
#endif
            TPU_STOP(106);
#define DSA_SUFFIX(s) do { _Pragma("unroll") for (int o = 1; o < 64; o <<= 1) { unsigned t_ = (unsigned)__builtin_amdgcn_ds_bpermute(((lane + o) & 63) << 2, (int)(s)); (s) += (lane + o < 64) ? t_ : 0u; } } while (0)
            unsigned mine = 0u;
#pragma unroll
            for (int i = 0; i < 16; ++i) { const u32x4 v4 = *(const u32x4*)(hist + lane * 64 + ((i + lane) & 15) * 4); mine += (v4[0] + v4[1]) + (v4[2] + v4[3]); }
            unsigned suf = mine; DSA_SUFFIX(suf);
            const unsigned long long mL = __ballot(suf - mine < (unsigned)TOPK && suf >= (unsigned)TOPK);
            const int Ls = (int)__builtin_ctzll(mL);
            const unsigned cntA = (unsigned)__builtin_amdgcn_readlane((int)(suf - mine), Ls);
            unsigned h2 = hist[Ls * 64 + lane]; unsigned suf2 = h2; DSA_SUFFIX(suf2);
            const unsigned long long mB = __ballot(cntA + suf2 - h2 < (unsigned)TOPK && cntA + suf2 >= (unsigned)TOPK);
            const int Bs = (int)__builtin_ctzll(mB);
            const unsigned bstar = (unsigned)(Ls * 64 + Bs);
            const unsigned cntAbove = cntA + (unsigned)__builtin_amdgcn_readlane((int)(suf2 - h2), Bs);
            const unsigned inbin = (unsigned)__builtin_amdgcn_readlane((int)h2, Bs);
#undef DSA_SUFFIX
            TPU_STOP(107);
            unsigned T = bstar << 20; int cntT = (int)(cntAbove + inbin);
            if (cntT != TOPK) {
                asm volatile("" ::: "memory");
                int nslot = 0;
#pragma unroll
                for (int g = 0; g < 8; ++g) { if (g < ngrp) {
#pragma unroll
                    for (int jj = 0; jj < 8; ++jj) { const int j = 8 * g + jj; if ((key[j] >> 20) == bstar) { hist[nslot * 64 + lane] = key[j]; ++nslot; } } } }
                asm volatile("" ::: "memory");
                int R = nslot;
#pragma unroll
                for (int o = 32; o >= 1; o >>= 1) { const int other = __builtin_amdgcn_ds_bpermute(((lane ^ o) << 2), R); R = other > R ? other : R; }
                R = __builtin_amdgcn_readfirstlane(R);
                if (R <= 8) {
                    unsigned c[8];
#pragma unroll
                    for (int r = 0; r < 8; ++r) c[r] = (r < nslot) ? hist[r * 64 + lane] : 0u;
                    for (int bit = 19; bit >= 0; --bit) {
                        const unsigned cand = T | (1u << bit); int cnt = (int)cntAbove;
#pragma unroll
                        for (int r = 0; r < 8; ++r) cnt += __popcll(__ballot(c[r] >= cand));
                        if (cnt >= TOPK) { T = cand; cntT = cnt; if (cnt == TOPK) break; }
                    }
                } else {
                    for (int bit = 19; bit >= 0; --bit) {
                        const unsigned cand = T | (1u << bit); unsigned c0 = 0, c1 = 0; unsigned long long sm0, sm1, sm2, sm3;
                        DSA_CNT8(0);
                        if (ngrp > 1) DSA_CNT8(8);
                        if (ngrp > 2) DSA_CNT8(16);
                        if (ngrp > 3) DSA_CNT8(24);
                        if (ngrp > 4) DSA_CNT8(32);
                        if (ngrp > 5) DSA_CNT8(40);
                        if (ngrp > 6) DSA_CNT8(48);
                        if (ngrp > 7) DSA_CNT8(56);
                        const int cl = (int)(c0 + c1);
                        int cnt = 0;
#pragma unroll
                        for (int bb = 0; bb < 7; ++bb) cnt += __popcll(__ballot((cl >> bb) & 1)) << bb;
                        if (cnt >= TOPK) { T = cand; cntT = cnt; if (cnt == TOPK) break; }
                    }
                }
            }
            TPU_STOP(108);
            if (cntT == TOPK) {
                unsigned wlo = 0u, whi = 0u;
                dsa_emit<0, 8>(key, T, wlo, whi);
                if (ngrp > 1) dsa_emit<8, 16>(key, T, wlo, whi);
                if (ngrp > 2) dsa_emit<16, 24>(key, T, wlo, whi);
                if (ngrp > 3) dsa_emit<24, 32>(key, T, wlo, whi);
                if (ngrp > 4) dsa_emit<32, 40>(key, T, wlo, whi);
                if (ngrp > 5) dsa_emit<40, 48>(key, T, wlo, whi);
                if (ngrp > 6) dsa_emit<48, 56>(key, T, wlo, whi);
                if (ngrp > 7) dsa_emit<56, 64>(key, T, wlo, whi);
                myword = ((unsigned long long)whi << 32) | wlo;
            } else {
                int ngt = 0;
#pragma unroll
                for (int j = 0; j < 64; ++j) ngt += __popcll(__ballot(key[j] > T));
                int need = TOPK - ngt;
#pragma unroll
                for (int j = 0; j < 64; ++j) { const unsigned long long eq = __ballot(key[j] == T), gt = __ballot(key[j] > T);
                    const int ne = __popcll(eq); unsigned long long take = eq;
                    if (ne > need) { take = 0ull; int left = need; unsigned long long e2 = eq;
                        while (left > 0) { const unsigned long long lowbit = e2 & (0ull - e2); take |= lowbit; e2 ^= lowbit; --left; } }
                    need -= (ne > need) ? need : ne;
                    const unsigned long long m = gt | take; if (lane == j) myword = m; }
            }
        }
        mout[lane] = myword;
        TPU_STOP(109);
    }
    TPU_STOP(102);
}

struct DsaOutRow { const bf16_t* zb; bf16_t* gb; int wid;
    __device__ __forceinline__ const bf16_t* zrow(int r) const { const int rho = wid * 32 + r; return zb + (size_t)(rho >> 2) * NPAD + (rho & 3) * 128; }
    __device__ __forceinline__ bf16_t* grow(int r) const { const int rho = wid * 32 + r; return gb + (size_t)(rho >> 2) * MIX + (rho & 3) * 128; } };
__device__ __forceinline__ void unit_dsa_attn(const Params& P, int cur_layer, int u, char* lds) {
    const int b = u & 3, qb = 63 - (u >> 2), t0 = qb * 64, tokb = b * SEQ;
    const int wid = TIDX() >> 6, lane = TIDX() & 63, r32 = lane & 31, hi = lane >> 5;
    const int rho = wid * 32 + r32, tq = t0 + (rho >> 2), hq = rho & 3;
    const bf16_t* Qw = P.p_() + (size_t)(tokb + tq) * NPAD + C_DQ + hq * 128 + hi * 8;
    const bf16_t* Kh = P.kvc_() + (size_t)tokb * 256;
    const unsigned moff = (unsigned)(tokb + tq) * 512u;
    DsaOutRow ow; ow.zb = P.p_() + (size_t)(tokb + t0) * NPAD + C_DZ; ow.gb = P.xn_() + (size_t)(tokb + t0) * MIX + 1024; ow.wid = wid;
    const int NT = (qb + 2) & ~1;
    att::attn_body<true, 256, 128, 2, DsaOutRow>(Qw, P.dsa_q_norm + cur_layer * 128, P.rope_() + (size_t)(tokb + tq) * 48, Kh, NT, P.mask_(), moff, ow, lds);
}
__device__ __forceinline__ void phase_gemm_glu(const Params& P, int layer, char* lds) {
    pg8::Gemm g; g.A = P.ybuf_(); g.Bt = P.WgluT_() + (size_t)layer * 512 * 512; g.M = NTOK; g.N = 512; g.K = 512;
    pg8::StaticOrder S; S.init(g.M, g.N, (int)gridDim.x, (int)blockIdx.x);
    pg8::EpiGlu E; E.Y = P.ybuf_(); E.ldy = 512; E.O = P.ocat_(); E.ldo = MIX; E.ooff = 512;
    pg8::gemm_phase<pg8::EpiGlu, pg8::StaticOrder, false>((PG8_LAS unsigned char*)lds, g, S, E, nullptr);
}

constexpr int CTL_Q0 = 4096;
struct OneUnit { int pm, pn; __device__ __forceinline__ bool next(int i, pg8::Unit& u) const { if (i) return false; u.pm = pm; u.pn = pn; return true; }
    __device__ __forceinline__ void a_ready(const pg8::Unit&) const {} __device__ __forceinline__ void done(const pg8::Unit&) const {} };
__device__ __forceinline__ int q_issue(unsigned* ctr) { return (int)__hip_atomic_fetch_add(ctr, 1u, __ATOMIC_RELAXED, __HIP_MEMORY_SCOPE_AGENT); }
#define Q_LOOP_BEGIN(ctr, total)  { unsigned* q_ctr_ = (ctr); const int q_total_ = (total); volatile int* q_b_ = (volatile int*)(lds + LDS_TAIL + 16); \
    for (;;) { __syncthreads(); if (TIDX() == 0) *q_b_ = q_issue(q_ctr_); __syncthreads(); const int item = __builtin_amdgcn_readfirstlane(*q_b_); if (item >= q_total_) break;
#define Q_LOOP_END  } }
__device__ __forceinline__ void unit_glu(const Params& P, int layer, int u, char* lds) {
    pg8::Gemm g; g.A = P.ybuf_(); g.Bt = P.WgluT_() + (size_t)layer * 512 * 512; g.M = NTOK; g.N = 512; g.K = 512;
    OneUnit S; S.pm = u >> 1; S.pn = u & 1;
    pg8::EpiGluGate E; E.Y = P.ybuf_(); E.Pz = P.p_(); E.G = P.xn_();
    pg8::gemm_phase<pg8::EpiGluGate, OneUnit, false>((PG8_LAS unsigned char*)lds, g, S, E, nullptr);
}
constexpr int LDS_TAIL = LDS_BYTES - 64;

__global__ __launch_bounds__(NTHR, 2) void k_mega(Params P) {
    extern __shared__ __attribute__((aligned(16))) char lds[];
    if (TIDX() == 0) *(uint4*)(lds + LDS_TAIL) = make_uint4(0u, 0u, 0u, 0u);
    __syncthreads();
    XcdBarrier bar = xcd_barrier_post(P.ctl_(), (volatile LAS unsigned*)(lds + LDS_TAIL));
    const int G = gridDim.x, B = blockIdx.x;
    phase_prologue1(P, lds); phase_rope_table(P); phase_s5_params(P); phase_rmsnorm_x(P, 0);
    xcd_barrier(bar);
    for (int layer = 0; layer < DEPTH; ++layer) {
        if (layer > 0) { phase_rmsnorm_x(P, layer); xcd_barrier(bar); }
        phase_gemm_in(P, layer, lds);
        if (layer == 0) phase_gemm_kv(P, lds);
        xcd_barrier(bar);
        phase_prep(P, layer);
        if (layer == 0) phase_memk_norm(P);
        for (int u = B; u < 256; u += G) unit_gla_a4(P, layer, u, lds);
        xcd_barrier(bar);
        Q_LOOP_BEGIN(P.ctl_() + CTL_Q0 + 64 * (layer * 2), 128 + 2048 + 256)
            if (item < 128) unit_s5(P, layer, item, lds);
            else if (item < 2176) unit_dsa_index(P, item - 128, lds);
            else gla_scan_slice(P, (item - 2176) * NTHR + TIDX());
        Q_LOOP_END
        xcd_barrier(bar);
        Q_LOOP_BEGIN(P.ctl_() + CTL_Q0 + 64 * (layer * 2 + 1), 256 + 256 + 128 + 256)
            if (item < 256) unit_dsa_attn(P, layer, item, lds);
            else if (item < 512) unit_gla_c4(P, layer, item - 256, lds);
            else if (item < 640) unit_glu(P, layer, item - 512, lds);
            else unit_mem_attn(P, layer, item - 640, lds);
        Q_LOOP_END
        xcd_barrier(bar);
        phase_gemm_out(P, layer, lds);
        xcd_barrier(bar);
    }
}

extern "C" void kernel_launch(void* const* d_in, const int* in_sizes, int n_in, void* d_out, int out_size, void* d_ws, size_t ws_size, hipStream_t stream) {
    if (n_in != 24 || ws_size < WS_END) { fprintf(stderr, "kernel_launch: unexpected n_in %d or ws_size %zu (< %zu)\n", n_in, ws_size, (size_t)WS_END); return; }
    Params P; memset(&P, 0, sizeof(P));
    P.x = (const float*)d_in[0]; P.mem = (const float*)d_in[1]; P.pos = (const int*)d_in[2]; P.ln_gain = (const float*)d_in[3]; P.w_in = (const float*)d_in[4];
    P.gla_w_up = (const float*)d_in[5]; P.gla_b_up = (const float*)d_in[6]; P.s5_a_re = (const float*)d_in[7]; P.s5_a_im = (const float*)d_in[8]; P.s5_log_step = (const float*)d_in[9];
    P.s5_b_re = (const float*)d_in[10]; P.s5_b_im = (const float*)d_in[11]; P.s5_c_re = (const float*)d_in[12]; P.s5_c_im = (const float*)d_in[13]; P.s5_d = (const float*)d_in[14];
    P.s5_w_glu = (const float*)d_in[15]; P.dsa_q_norm = (const float*)d_in[16]; P.dsa_k_norm = (const float*)d_in[17]; P.mem_norm = (const float*)d_in[18]; P.w_mem_kv = (const float*)d_in[19];
    P.mem_q_norm = (const float*)d_in[20]; P.mem_k_norm = (const float*)d_in[21]; P.out_norm = (const float*)d_in[22]; P.w_out = (const float*)d_in[23];
    P.out = (float*)d_out;
    char* ws = (char*)d_ws; P.ws = ws;
    static int grid = 0;
    if (!grid) {
        int dev = 0, cus = 0, per_cu = 0;
        (void)hipGetDevice(&dev); (void)hipDeviceGetAttribute(&cus, hipDeviceAttributeMultiprocessorCount, dev);
        (void)hipFuncSetAttribute((const void*)k_mega, hipFuncAttributeMaxDynamicSharedMemorySize, LDS_BYTES);
        (void)hipOccupancyMaxActiveBlocksPerMultiprocessor(&per_cu, (const void*)k_mega, NTHR, LDS_BYTES);
        if (per_cu < 1) fprintf(stderr, "kernel_launch: occupancy query reports %d blocks per CU\n", per_cu);
        grid = cus > 0 ? cus : 256;
    }
    (void)hipMemsetAsync(ws + WS_CTL, 0, CTL_BYTES, stream);
    hipLaunchKernelGGL(k_mega, dim3(grid), dim3(NTHR), LDS_BYTES, stream, P);
}
```

```cpp
#include <hip/hip_runtime.h>
#include <stdint.h>
#include <stdio.h>
#include <string.h>

constexpr int NB = 4, SEQ = 4096, NTOK = NB * SEQ, DM = 2048, DEPTH = 4, MEML = 256;
constexpr int NIN = 5984, NPAD = 6144, MIX = 2048;
constexpr int C_GQ = 0, C_GK = 256, C_GV = 512, C_GLR = 1024, C_GZ = 1040, C_SU = 1552, C_SZ = 2064, C_DQ = 2576, C_DK = 3088, C_DV = 3216,
              C_DIQ = 3344, C_DIK = 4368, C_DIW = 4432, C_DZ = 4448, C_MQ = 4960, C_MZ = 5472;
constexpr float EPS = 1e-6f;
constexpr int NTHR = 512;
constexpr int LDS_BYTES = 147456;

typedef unsigned short bf16_t;
typedef short bf16x8 __attribute__((ext_vector_type(8)));
typedef short s16x4 __attribute__((ext_vector_type(4)));
typedef float f32x4 __attribute__((ext_vector_type(4)));
typedef float f32x8 __attribute__((ext_vector_type(8)));
typedef float f32x16 __attribute__((ext_vector_type(16)));
typedef unsigned u32x4 __attribute__((ext_vector_type(4)));
typedef unsigned u32x2 __attribute__((ext_vector_type(2)));
#define LAS __attribute__((address_space(3)))

__device__ __forceinline__ float bf2f(bf16_t b) { return __uint_as_float(((unsigned)b) << 16); }
__device__ __forceinline__ bf16_t f2bf(float f) { unsigned u = __float_as_uint(f); u += 0x7FFFu + ((u >> 16) & 1u); return (bf16_t)(u >> 16); }
__device__ __forceinline__ unsigned pk2bf(float lo, float hi) { return (unsigned)f2bf(lo) | ((unsigned)f2bf(hi) << 16); }
__device__ __forceinline__ float sigmoidf_(float x) { return __builtin_amdgcn_rcpf(1.f + __expf(-x)); }
__device__ __forceinline__ float siluf_(float x) { return x * __builtin_amdgcn_rcpf(1.f + __expf(-x)); }

__device__ __forceinline__ int TIDX() { int t = (int)threadIdx.x; asm volatile("" : "+v"(t)); return t; }
__device__ __forceinline__ float shx(float v, int m) { const int src = ((TIDX() & 63) ^ m) << 2; return __int_as_float(__builtin_amdgcn_ds_bpermute(src, __float_as_int(v))); }
__device__ __forceinline__ float wave_sum(float v) {
#pragma unroll
    for (int o = 32; o >= 1; o >>= 1) v += shx(v, o);
    return v;
}
__device__ __forceinline__ void ld8f(const bf16_t* p, float (&v)[8]) { const u32x4 w = *(const u32x4*)p;
#pragma unroll
    for (int j = 0; j < 4; ++j) { v[2 * j] = __uint_as_float(w[j] << 16); v[2 * j + 1] = __uint_as_float(w[j] & 0xffff0000u); } }
__device__ __forceinline__ void st8f(bf16_t* p, const float (&v)[8]) { u32x4 w; w.x = pk2bf(v[0], v[1]); w.y = pk2bf(v[2], v[3]); w.z = pk2bf(v[4], v[5]); w.w = pk2bf(v[6], v[7]); *(u32x4*)p = w; }
__device__ __forceinline__ float f2bf_f(float f) { return bf2f(f2bf(f)); }

#ifndef TPROBE
#define TPROBE 0
#endif
#if TPROBE
#define TPU_START(id) do { if (TPROBE == (id) && TIDX() == 0) *(volatile unsigned long long*)(lds + LDS_BYTES - 24) = __builtin_amdgcn_s_memrealtime(); } while (0)
#define TPU_STOP(id) do { if (TPROBE == (id) && TIDX() == 0) *(volatile unsigned long long*)(lds + LDS_BYTES - 32) += __builtin_amdgcn_s_memrealtime() - *(volatile unsigned long long*)(lds + LDS_BYTES - 24); } while (0)
#else
#define TPU_START(id) do {} while (0)
#define TPU_STOP(id) do {} while (0)
#endif
#define XB_TMO      128
#define XB_XCNT(j)  (256  + 64 * (j))
#define XB_XSUB(j)  (1280 + 64 * (j))
#define XB_XGEN(j)  (2304 + 64 * (j))
#define XB_TOP      3328
#define XB_TOPGEN   3392
#define XCD_BAR_WORDS 3456
#define XB_SPIN_CAP (1u << 18)

__device__ __forceinline__ unsigned xb_ld(unsigned* p)              { return __hip_atomic_load(p, __ATOMIC_RELAXED, __HIP_MEMORY_SCOPE_AGENT); }
__device__ __forceinline__ unsigned xb_add(unsigned* p, unsigned v) { return __hip_atomic_fetch_add(p, v, __ATOMIC_RELAXED, __HIP_MEMORY_SCOPE_AGENT); }
__device__ __forceinline__ unsigned xb_xcc_id() { return (unsigned)__builtin_amdgcn_s_getreg((3 << 11) | 20) & 0xFu; }
#define XB_SPIN(cond, bar) do { unsigned _sp = 0; while (cond) { __builtin_amdgcn_s_sleep(1); \
    if ((++_sp & 255u) == 0u) { if (xb_ld(&(bar)[XB_TMO])) break; if (_sp > XB_SPIN_CAP) { atomicAdd(&(bar)[XB_TMO], 1u); break; } } } } while (0)

struct XcdBarrier {
    unsigned* bar; unsigned x;
    volatile LAS unsigned* st;
};

__device__ __forceinline__ XcdBarrier xcd_barrier_post(unsigned* bar, volatile LAS unsigned* st) {
    XcdBarrier b; b.bar = bar; b.x = xb_xcc_id(); b.st = st;
    if (TIDX() == 0) (void)xb_add(&bar[XB_XCNT(b.x)], 1u);
    return b;
}
__device__ __forceinline__ void xcd_barrier_complete(unsigned* bar, unsigned x, unsigned& nloc, unsigned& nx) {
    const unsigned G = gridDim.x * gridDim.y * gridDim.z;
    unsigned sum, cnt, mine, sp = 0u;
    for (;;) {
        sum = 0u; cnt = 0u; mine = 0u;
#pragma unroll
        for (unsigned j = 0; j < 16; ++j) { const unsigned c = xb_ld(&bar[XB_XCNT(j)]); sum += c; cnt += (c > 0u) ? 1u : 0u; mine = (j == x) ? c : mine; }
        if (sum == G) break;
        __builtin_amdgcn_s_sleep(1);
        if ((++sp & 255u) == 0u) { if (xb_ld(&bar[XB_TMO])) break; if (sp > XB_SPIN_CAP) { atomicAdd(&bar[XB_TMO], 1u); break; } }
    }
    nloc = mine > 0u ? mine : 1u; nx = cnt > 0u ? cnt : 1u;
}

__device__ __forceinline__ void xcd_barrier(const XcdBarrier& b) {
    asm volatile("s_waitcnt vmcnt(0)" ::: "memory");
    __syncthreads();
    if (TIDX() == 0) {
        unsigned* bar = b.bar; const unsigned bx = xb_xcc_id();
        __builtin_amdgcn_s_waitcnt(0);
        unsigned nloc = b.st[0], nx = b.st[1];
        if (nloc == 0u) { xcd_barrier_complete(bar, bx, nloc, nx); b.st[0] = nloc; b.st[1] = nx; }
        const unsigned old = xb_add(&bar[XB_XSUB(bx)], 1u);
        const unsigned gen = old / nloc;
        if (old + 1u == (gen + 1u) * nloc) {
            __builtin_amdgcn_fence(__ATOMIC_RELEASE, "agent");
            asm volatile("s_waitcnt vmcnt(0)" ::: "memory");
            const unsigned og = xb_add(&bar[XB_TOP], 1u);
            const unsigned tg = og / nx;
            if (og + 1u == (tg + 1u) * nx) xb_add(&bar[XB_TOPGEN], 1u);
            else XB_SPIN(xb_ld(&bar[XB_TOPGEN]) == tg, bar);
            __builtin_amdgcn_fence(__ATOMIC_ACQUIRE, "agent");
            xb_add(&bar[XB_XGEN(bx)], 1u);
            asm volatile("s_waitcnt vmcnt(0)" ::: "memory");
        } else {
            XB_SPIN(xb_ld(&bar[XB_XGEN(bx)]) == gen, bar);
            __builtin_amdgcn_fence(__ATOMIC_ACQUIRE, "agent");
            asm volatile("s_waitcnt vmcnt(0)" ::: "memory");
        }
    }
    __syncthreads();
}
namespace pg8 {
#define PG8_LAS __attribute__((address_space(3)))
typedef float f32x2 __attribute__((ext_vector_type(2)));
typedef unsigned u32x4 __attribute__((ext_vector_type(4)));
constexpr int BM = 256, BK = 64, HALF = 128, HTB = HALF * BK * 2  , STAGE_BYTES = 8 * HTB, NXCD = 8, WGM = 8;

__host__ __device__ __forceinline__ int lds_byte(int r, int c) { const int st = (r >> 4) * 2 + (c >> 5), rr = r & 15, cc = c & 31, ob = rr * 64 + cc * 2; return st * 1024 + (ob ^ (((ob >> 9) & 1) << 5)); }
__host__ __device__ __forceinline__ void stage_rc(int b, int& R, int& C) { const int st = b / 1024, sb = b % 1024, swz = sb ^ (((sb >> 9) & 1) << 5); R = (st >> 1) * 16 + swz / 64; C = (st & 1) * 32 + (swz % 64) / 2; }
__host__ __device__ __forceinline__ int perm32(int rho) { const int n = rho >> 4, i = rho & 15; return 8 * (i >> 2) + 4 * n + (i & 3); }

struct Unit { int pm, pn; };
struct Gemm { const bf16_t* A; const bf16_t* Bt; int M, N, K; };

struct StaticOrder {
    int nM, nN, nwg, G, c;
    __host__ __device__ void init(int M, int N, int G_, int c_) { nM = M / BM; nN = N / BM; nwg = nM * nN; G = G_; c = c_; }
    __host__ __device__ bool next(int i, Unit& u) const {
        const long L = (long)i * G + c; if (L >= nwg) return false;
        int wgid = (int)L; { const int q = nwg / NXCD, r = nwg % NXCD, xcd = wgid % NXCD, off = wgid / NXCD; wgid = (xcd < r ? xcd * (q + 1) : r * (q + 1) + (xcd - r) * q) + off; }
        const int nig = WGM * nN, gid = wgid / nig, fm = gid * WGM, gsz = (nM - fm) < WGM ? (nM - fm) : WGM;
        u.pm = fm + ((wgid % nig) % gsz); u.pn = (wgid % nig) / gsz; return true;
    }
    __device__ __forceinline__ void a_ready(const Unit&) const {}
    __device__ __forceinline__ void done(const Unit&) const {}
};
__device__ __forceinline__ unsigned cvt_pk_bf16(float lo, float hi) { unsigned r; asm volatile("v_cvt_pk_bf16_f32 %0, %1, %2" : "=v"(r) : "v"(lo), "v"(hi)); return r; }
struct EpiBf16Plain {
    static constexpr bool PERM = true, AFTER_DRAIN = false;
    bf16_t* O; int ldc;
    __device__ __forceinline__ void operator()(const f32x4 (&acc)[2][2][4][2], const Unit& u, int wr, int wc, int fr, int fq) const {
        const int row0 = u.pm * BM + wr * 64 + fr, col0 = u.pn * BM + wc * 32 + 8 * fq;
#pragma unroll
        for (int ai = 0; ai < 2; ++ai)
#pragma unroll
            for (int m = 0; m < 4; ++m) { bf16_t* rowp = O + (size_t)(row0 + ai * HALF + m * 16) * ldc + col0;
#pragma unroll
                for (int bj = 0; bj < 2; ++bj) { const f32x4 v0 = acc[ai][bj][m][0], v1 = acc[ai][bj][m][1];
                    u32x4 w; w.x = cvt_pk_bf16(v0[0], v0[1]); w.y = cvt_pk_bf16(v0[2], v0[3]); w.z = cvt_pk_bf16(v1[0], v1[1]); w.w = cvt_pk_bf16(v1[2], v1[3]);
                    *(u32x4*)(rowp + bj * HALF) = w; } }
    }
};
struct EpiResid {
    static constexpr bool PERM = false, AFTER_DRAIN = false;
    const float* R; float* C; int ldc;
    __device__ __forceinline__ void operator()(const f32x4 (&acc)[2][2][4][2], const Unit& u, int wr, int wc, int fr, int fq) const {
        const int row0 = u.pm * BM + wr * 64 + fr, col0 = u.pn * BM + wc * 32 + 4 * fq;
#pragma unroll
        for (int ai = 0; ai < 2; ++ai)
#pragma unroll
            for (int m = 0; m < 4; ++m) { const size_t off = (size_t)(row0 + ai * HALF + m * 16) * ldc + col0;
#pragma unroll
                for (int bj = 0; bj < 2; ++bj)
#pragma unroll
                    for (int n = 0; n < 2; ++n) { const f32x4 r = *(const f32x4*)(R + off + bj * HALF + n * 16); *(f32x4*)(C + off + bj * HALF + n * 16) = acc[ai][bj][m][n] + r; } }
    }
};
struct EpiResidMix {
    static constexpr bool PERM = true, AFTER_DRAIN = false;
    const void* R; void* C; int ldc; int r16, c16;
    __device__ __forceinline__ void operator()(const f32x4 (&acc)[2][2][4][2], const Unit& u, int wr, int wc, int fr, int fq) const {
        const int row0 = u.pm * BM + wr * 64 + fr, col0 = u.pn * BM + wc * 32 + 8 * fq;
#pragma unroll
        for (int ai = 0; ai < 2; ++ai)
#pragma unroll
            for (int m = 0; m < 4; ++m) { const size_t off = (size_t)(row0 + ai * HALF + m * 16) * ldc + col0;
                f32x4 r0[2], r1[2];
                if (r16) {
#pragma unroll
                    for (int bj = 0; bj < 2; ++bj) { const u32x4 w = *(const u32x4*)((const bf16_t*)R + off + bj * HALF);
                        r0[bj] = f32x4{__uint_as_float(w.x << 16), __uint_as_float(w.x & 0xffff0000u), __uint_as_float(w.y << 16), __uint_as_float(w.y & 0xffff0000u)};
                        r1[bj] = f32x4{__uint_as_float(w.z << 16), __uint_as_float(w.z & 0xffff0000u), __uint_as_float(w.w << 16), __uint_as_float(w.w & 0xffff0000u)}; }
                } else {
#pragma unroll
                    for (int bj = 0; bj < 2; ++bj) { r0[bj] = *(const f32x4*)((const float*)R + off + bj * HALF); r1[bj] = *(const f32x4*)((const float*)R + off + bj * HALF + 4); }
                }
#pragma unroll
                for (int bj = 0; bj < 2; ++bj) { const f32x4 v0 = acc[ai][bj][m][0] + r0[bj], v1 = acc[ai][bj][m][1] + r1[bj];
                    if (c16) { u32x4 w; w.x = cvt_pk_bf16(v0[0], v0[1]); w.y = cvt_pk_bf16(v0[2], v0[3]); w.z = cvt_pk_bf16(v1[0], v1[1]); w.w = cvt_pk_bf16(v1[2], v1[3]);
                        *(u32x4*)((bf16_t*)C + off + bj * HALF) = w; }
                    else { *(f32x4*)((float*)C + off + bj * HALF) = v0; *(f32x4*)((float*)C + off + bj * HALF + 4) = v1; } } }
    }
};
struct EpiGlu {
    static constexpr bool PERM = true, AFTER_DRAIN = false;
    const bf16_t* Y; int ldy; bf16_t* O; int ldo; int ooff;
    __device__ __forceinline__ void operator()(const f32x4 (&acc)[2][2][4][2], const Unit& u, int wr, int wc, int fr, int fq) const {
        const int row0 = u.pm * BM + wr * 64 + fr, col0 = u.pn * BM + wc * 32 + 8 * fq;
#pragma unroll
        for (int ai = 0; ai < 2; ++ai)
#pragma unroll
            for (int m = 0; m < 4; ++m) { const int row = row0 + ai * HALF + m * 16;
#pragma unroll
                for (int bj = 0; bj < 2; ++bj) { const f32x4 v0 = acc[ai][bj][m][0], v1 = acc[ai][bj][m][1];
                    const u32x4 yw = *(const u32x4*)(Y + (size_t)row * ldy + col0 + bj * HALF);
                    float y[8], g[8];
#pragma unroll
                    for (int j = 0; j < 4; ++j) { y[2 * j] = __uint_as_float(yw[j] << 16); y[2 * j + 1] = __uint_as_float(yw[j] & 0xffff0000u); }
#pragma unroll
                    for (int j = 0; j < 4; ++j) { g[j] = __builtin_amdgcn_rcpf(1.f + __expf(-v0[j])); g[4 + j] = __builtin_amdgcn_rcpf(1.f + __expf(-v1[j])); }
                    u32x4 w; w.x = cvt_pk_bf16(y[0] * g[0], y[1] * g[1]); w.y = cvt_pk_bf16(y[2] * g[2], y[3] * g[3]); w.z = cvt_pk_bf16(y[4] * g[4], y[5] * g[5]); w.w = cvt_pk_bf16(y[6] * g[6], y[7] * g[7]);
                    *(u32x4*)(O + (size_t)row * ldo + ooff + col0 + bj * HALF) = w; } }
    }
};
struct EpiGluGate {
    static constexpr bool PERM = true, AFTER_DRAIN = true;
    const bf16_t* Y; const bf16_t* Pz; bf16_t* G;
    __device__ __forceinline__ void fused(const f32x4 (&acc)[2][2][4][2], const Unit& u, int wr, int wc, int fr, int fq, PG8_LAS unsigned char* lds, int wid, int lane) const {
        constexpr int TS = 528;
        const int row0 = wr * 64 + fr, col0 = wc * 32 + 8 * fq;
#pragma unroll
        for (int ai = 0; ai < 2; ++ai)
#pragma unroll
            for (int m = 0; m < 4; ++m) { const int rl = row0 + ai * HALF + m * 16; const size_t grow = (size_t)u.pm * BM + rl;
#pragma unroll
                for (int bj = 0; bj < 2; ++bj) { const f32x4 v0 = acc[ai][bj][m][0], v1 = acc[ai][bj][m][1];
                    const u32x4 yw = *(const u32x4*)(Y + grow * 512 + u.pn * BM + col0 + bj * HALF);
                    float y[8], g[8];
#pragma unroll
                    for (int j = 0; j < 4; ++j) { y[2 * j] = __uint_as_float(yw[j] << 16); y[2 * j + 1] = __uint_as_float(yw[j] & 0xffff0000u); }
#pragma unroll
                    for (int j = 0; j < 4; ++j) { g[j] = __builtin_amdgcn_rcpf(1.f + __expf(-v0[j])); g[4 + j] = __builtin_amdgcn_rcpf(1.f + __expf(-v1[j])); }
                    u32x4 w; w.x = cvt_pk_bf16(y[0] * g[0], y[1] * g[1]); w.y = cvt_pk_bf16(y[2] * g[2], y[3] * g[3]); w.z = cvt_pk_bf16(y[4] * g[4], y[5] * g[5]); w.w = cvt_pk_bf16(y[6] * g[6], y[7] * g[7]);
                    *(PG8_LAS u32x4*)(lds + rl * TS + (col0 + bj * HALF) * 2) = w; } }
        __syncthreads();
        { const int t = wid * 64 + lane, row = t >> 1, hd = t & 1; const PG8_LAS unsigned char* src = lds + row * TS + hd * 256;
          float ss = 0.f;
#pragma unroll
          for (int i = 0; i < 16; ++i) { const u32x4 w = *(const PG8_LAS u32x4*)(src + 16 * i);
#pragma unroll
              for (int j = 0; j < 4; ++j) { const float a = __uint_as_float(w[j] << 16), b = __uint_as_float(w[j] & 0xffff0000u); ss += a * a + b * b; } }
          const float rn = rsqrtf(ss * (1.f / 128.f) + 1e-6f);
          const size_t grow = (size_t)u.pm * BM + row; const int cb = u.pn * BM + hd * 128;
          const bf16_t* zp = Pz + grow * 6144 + 2064 + cb; bf16_t* gp = G + grow * 2048 + 512 + cb;
#pragma unroll
          for (int i = 0; i < 16; ++i) { const u32x4 w = *(const PG8_LAS u32x4*)(src + 16 * i); const u32x4 zw = *(const u32x4*)(zp + 8 * i); u32x4 o;
#pragma unroll
              for (int j = 0; j < 4; ++j) { const float a = __uint_as_float(w[j] << 16), b = __uint_as_float(w[j] & 0xffff0000u), za = __uint_as_float(zw[j] << 16), zb = __uint_as_float(zw[j] & 0xffff0000u);
                  o[j] = cvt_pk_bf16(a * rn * (za * __builtin_amdgcn_rcpf(1.f + __expf(-za))), b * rn * (zb * __builtin_amdgcn_rcpf(1.f + __expf(-zb)))); }
              *(u32x4*)(gp + 8 * i) = o; } }
        __syncthreads();
    }
};
struct EpiBf16Scale {
    static constexpr bool PERM = true, AFTER_DRAIN = false;
    bf16_t* O; int ldc; const float* ssq;
    __device__ __forceinline__ void operator()(const f32x4 (&acc)[2][2][4][2], const Unit& u, int wr, int wc, int fr, int fq) const {
        const int row0 = u.pm * BM + wr * 64 + fr, col0 = u.pn * BM + wc * 32 + 8 * fq;
#pragma unroll
        for (int ai = 0; ai < 2; ++ai)
#pragma unroll
            for (int m = 0; m < 4; ++m) { const int row = row0 + ai * HALF + m * 16; bf16_t* rowp = O + (size_t)row * ldc + col0;
                float ssum = 0.f; { const f32x4* sp_ = (const f32x4*)(ssq + (size_t)row * 32);
#pragma unroll
                    for (int q = 0; q < 8; ++q) { const f32x4 t4 = sp_[q]; ssum += (t4[0] + t4[1]) + (t4[2] + t4[3]); } }
                const float s = rsqrtf(ssum * (1.f / 2048.f) + 1e-6f);
#pragma unroll
                for (int bj = 0; bj < 2; ++bj) { const f32x4 v0 = acc[ai][bj][m][0] * s, v1 = acc[ai][bj][m][1] * s;
                    u32x4 w; w.x = cvt_pk_bf16(v0[0], v0[1]); w.y = cvt_pk_bf16(v0[2], v0[3]); w.z = cvt_pk_bf16(v1[0], v1[1]); w.w = cvt_pk_bf16(v1[2], v1[3]);
                    *(u32x4*)(rowp + bj * HALF) = w; } }
    }
};
struct EpiResidNext {
    static constexpr bool PERM = false, AFTER_DRAIN = false;
    const float* R; float* C; int ldc; bf16_t* XB; float* ssq;
    __device__ __forceinline__ void operator()(const f32x4 (&acc)[2][2][4][2], const Unit& u, int wr, int wc, int fr, int fq) const {
        const int row0 = u.pm * BM + wr * 64 + fr, col0 = u.pn * BM + wc * 32 + 4 * fq;
#pragma unroll
        for (int ai = 0; ai < 2; ++ai)
#pragma unroll
            for (int m = 0; m < 4; ++m) { const int row = row0 + ai * HALF + m * 16; const size_t off = (size_t)row * ldc + col0; float ss = 0.f;
#pragma unroll
                for (int bj = 0; bj < 2; ++bj)
#pragma unroll
                    for (int n = 0; n < 2; ++n) { const f32x4 r = *(const f32x4*)(R + off + bj * HALF + n * 16); const f32x4 v = acc[ai][bj][m][n] + r;
                        *(f32x4*)(C + off + bj * HALF + n * 16) = v;
                        if (XB) { u32x2 w; w.x = cvt_pk_bf16(v[0], v[1]); w.y = cvt_pk_bf16(v[2], v[3]); *(u32x2*)(XB + off + bj * HALF + n * 16) = w; }
                        ss += v[0] * v[0] + v[1] * v[1] + v[2] * v[2] + v[3] * v[3]; }
                if (ssq) { ss += shx(ss, 16); ss += shx(ss, 32); if (fq == 0) ssq[(size_t)row * 32 + u.pn * 4 + wc] = ss; } }
    }
};
template <class Epi, class Sched, bool STAMP = false>
__device__ __forceinline__ void gemm_phase(PG8_LAS unsigned char* lds, const Gemm g, const Sched& S, const Epi& E, unsigned long long* stamps) {
    const int tid = TIDX(), wid = __builtin_amdgcn_readfirstlane(tid >> 6), lane = tid & 63, wr = wid >> 2, wc = wid & 3, fr = lane & 15, fq = lane >> 4;
    const int K = g.K, nt = K / BK;
    int ts_lo = 0, ts_hi = 0, nts = 0; const unsigned long long rt_entry = STAMP ? (unsigned long long)wall_clock64() : 0ull;
#define PG8_STAMP() do { if (STAMP && wid == 0 && nts < 64) { const unsigned long long _c = (unsigned long long)clock64(); \
        ts_lo = (lane == nts) ? (int)(unsigned)_c : ts_lo; ts_hi = (lane == nts) ? (int)(unsigned)(_c >> 32) : ts_hi; ++nts; } } while (0)
    PG8_STAMP();
    unsigned voffA[2], voffB[2];
#pragma unroll
    for (int i = 0; i < 2; ++i) { int R, C; stage_rc(tid * 16 + i * 8192, R, C); const int Rb = Epi::PERM ? ((R & ~31) + perm32(R & 31)) : R;
        voffA[i] = (unsigned)(R * K + C) * 2u; voffB[i] = (unsigned)(Rb * K + C) * 2u; }
    const size_t kstep = (size_t)(BK * 2);
    const size_t hstep = (size_t)HALF * K * 2;
    const size_t tstep = 2 * hstep;
    const unsigned ldsw = (unsigned)wid * 1024u;
    const int aoff = lds_byte(wr * 64 + fr, fq * 8), boff = lds_byte(wc * 32 + fr, fq * 8);
#define PG8_SA(b, h) (((b) * 2 + (h)) * HTB)
#define PG8_SB(b, h) ((4 + (b) * 2 + (h)) * HTB)
#define PG8_STAGE(bufoff, gbase, voff) do { _Pragma("unroll") for (int _i = 0; _i < 2; ++_i) \
        __builtin_amdgcn_global_load_lds((const unsigned*)((const char*)(gbase) + (voff)[_i]), (PG8_LAS unsigned*)(lds + (bufoff) + ldsw + _i * 8192), 16, 0, 0); } while (0)
#define PG8_LDA(dst, b, h) do { _Pragma("unroll") for (int m = 0; m < 4; ++m) _Pragma("unroll") for (int k = 0; k < 2; ++k) dst[m][k] = *(const PG8_LAS bf16x8*)(lds + PG8_SA(b, h) + aoff + m * 2048 + k * 1024); } while (0)
#define PG8_LDB(dst, b, h) do { _Pragma("unroll") for (int n = 0; n < 2; ++n) _Pragma("unroll") for (int k = 0; k < 2; ++k) dst[n][k] = *(const PG8_LAS bf16x8*)(lds + PG8_SB(b, h) + boff + n * 2048 + k * 1024); } while (0)
#define PG8_MMA(ai, bj, At, Bt) do { __builtin_amdgcn_s_setprio(1); _Pragma("unroll") for (int m = 0; m < 4; ++m) _Pragma("unroll") for (int n = 0; n < 2; ++n) _Pragma("unroll") for (int k = 0; k < 2; ++k) \
        acc[ai][bj][m][n] = __builtin_amdgcn_mfma_f32_16x16x32_bf16(Bt[n][k], At[m][k], acc[ai][bj][m][n], 0, 0, 0); __builtin_amdgcn_s_setprio(0); } while (0)
#define PG8_WAIT_V(n) asm volatile("s_waitcnt vmcnt(" #n ")" ::: "memory")
#define PG8_WAIT_L(n) asm volatile("s_waitcnt lgkmcnt(" #n ")" ::: "memory")
#define PG8_BAR __builtin_amdgcn_s_barrier()
#define PG8_SCHED __builtin_amdgcn_sched_barrier(0)
    Unit cur, nxt; int ui = 0;
    if (!S.next(0, cur)) return;
    f32x4 acc[2][2][4][2];
#pragma unroll
    for (int a = 0; a < 2; ++a)
#pragma unroll
        for (int b = 0; b < 2; ++b)
#pragma unroll
            for (int m = 0; m < 4; ++m)
#pragma unroll
                for (int n = 0; n < 2; ++n) acc[a][b][m][n] = (f32x4){0.f, 0.f, 0.f, 0.f};
    bf16x8 At[4][2], B0[2][2], B1[2][2];
    const char* cA = (const char*)g.A + (size_t)cur.pm * tstep; const char* cB = (const char*)g.Bt + (size_t)cur.pn * tstep;
    S.a_ready(cur);
    PG8_STAGE(PG8_SB(0, 0), cB, voffB); PG8_STAGE(PG8_SA(0, 0), cA, voffA); PG8_STAGE(PG8_SB(0, 1), cB + hstep, voffB); PG8_STAGE(PG8_SA(0, 1), cA + hstep, voffA);
    if (wr == 1) PG8_BAR;
    PG8_WAIT_V(4); PG8_BAR;
    PG8_STAGE(PG8_SB(1, 0), cB + kstep, voffB); PG8_STAGE(PG8_SA(1, 0), cA + kstep, voffA); PG8_STAGE(PG8_SB(1, 1), cB + hstep + kstep, voffB);
    PG8_WAIT_V(6); PG8_BAR;
    PG8_STAMP();
    for (;;) {
        const bool has_next = S.next(ui + 1, nxt);
        const char* nA = has_next ? (const char*)g.A + (size_t)nxt.pm * tstep : cA; const char* nB = has_next ? (const char*)g.Bt + (size_t)nxt.pn * tstep : cB;
        for (int t = 0; t < nt; t += 2) {
            const bool last = (t == nt - 2);
            const char* a1 = cA + (size_t)(t + 1) * kstep;
            const char* a2 = last ? nA : cA + (size_t)(t + 2) * kstep; const char* b2 = last ? nB : cB + (size_t)(t + 2) * kstep;
            const char* a3 = a2 + kstep; const char* b3 = b2 + kstep;
            if (last && has_next) S.a_ready(nxt);
            PG8_LDB(B0, 0, 0); PG8_SCHED; PG8_LDA(At, 0, 0); PG8_STAGE(PG8_SA(1, 1), a1 + hstep, voffA);
            PG8_WAIT_L(8); PG8_BAR; PG8_WAIT_L(0); PG8_MMA(0, 0, At, B0); PG8_BAR; PG8_SCHED;
            PG8_LDB(B1, 0, 1); PG8_STAGE(PG8_SB(0, 0), b2, voffB);
            PG8_BAR; PG8_WAIT_L(0); PG8_MMA(0, 1, At, B1); PG8_BAR;
            PG8_LDA(At, 0, 1); PG8_STAGE(PG8_SA(0, 0), a2, voffA);
            PG8_BAR; PG8_WAIT_L(0); PG8_MMA(1, 0, At, B0); PG8_BAR; PG8_SCHED;
            PG8_STAGE(PG8_SB(0, 1), b2 + hstep, voffB);
            PG8_WAIT_V(6); PG8_BAR; PG8_MMA(1, 1, At, B1); PG8_BAR;
            PG8_LDB(B0, 1, 0); PG8_SCHED; PG8_LDA(At, 1, 0); PG8_STAGE(PG8_SA(0, 1), a2 + hstep, voffA);
            PG8_WAIT_L(8); PG8_BAR; PG8_WAIT_L(0); PG8_MMA(0, 0, At, B0); PG8_BAR; PG8_SCHED;
            PG8_LDB(B1, 1, 1); PG8_STAGE(PG8_SB(1, 0), b3, voffB);
            PG8_BAR; PG8_WAIT_L(0); PG8_MMA(0, 1, At, B1); PG8_BAR;
            PG8_LDA(At, 1, 1); PG8_STAGE(PG8_SA(1, 0), a3, voffA);
            PG8_BAR; PG8_WAIT_L(0); PG8_MMA(1, 0, At, B0); PG8_BAR; PG8_SCHED;
            PG8_STAGE(PG8_SB(1, 1), b3 + hstep, voffB);
            PG8_WAIT_V(6); PG8_BAR; PG8_MMA(1, 1, At, B1); PG8_BAR;
        }
        PG8_STAMP();
        if constexpr (!Epi::AFTER_DRAIN) { E(acc, cur, wr, wc, fr, fq); S.done(cur); }
        PG8_STAMP();
        if (!has_next) break;
#pragma unroll
        for (int a = 0; a < 2; ++a)
#pragma unroll
            for (int b = 0; b < 2; ++b)
#pragma unroll
                for (int m = 0; m < 4; ++m)
#pragma unroll
                    for (int n = 0; n < 2; ++n) acc[a][b][m][n] = (f32x4){0.f, 0.f, 0.f, 0.f};
        cur = nxt; cA = nA; cB = nB; ++ui;
    }
    PG8_WAIT_V(0);
    if (wr == 0) PG8_BAR;
    PG8_BAR;
    if constexpr (Epi::AFTER_DRAIN) { E.fused(acc, cur, wr, wc, fr, fq, lds, wid, lane); S.done(cur); }
    PG8_STAMP();
    if (STAMP && wid == 0) { stamps[lane] = lane < nts ? (((unsigned long long)(unsigned)ts_hi << 32) | (unsigned)ts_lo) : 0ull;
        if (lane == 62) stamps[62] = rt_entry; if (lane == 63) stamps[63] = (unsigned long long)wall_clock64(); }
#undef PG8_STAMP
#undef PG8_SA
#undef PG8_SB
#undef PG8_STAGE
#undef PG8_LDA
#undef PG8_LDB
#undef PG8_MMA
#undef PG8_WAIT_V
#undef PG8_WAIT_L
#undef PG8_BAR
#undef PG8_SCHED
}
}
namespace att {
constexpr int D = 128, NW = 8, QBLK = 32, KVBLK = 64;
constexpr float SCALE = 0.088388347648318440f, THR = 8.f;
constexpr int SHM_V = KVBLK * D * 2, SHM_K = KVBLK * D * 2, SHM_ATTN = 2 * SHM_V + 2 * SHM_K + NW * 64 * 4;
#define KSWZ(row, colB) ((row) * 256 + ((colB) ^ (((row) & 7) << 4)))
#define SBAR() __builtin_amdgcn_sched_barrier(0)
__device__ __forceinline__ int crow(int r, int hi) { return (r & 3) + 8 * (r >> 2) + 4 * hi; }
__device__ __forceinline__ unsigned cvtpk(float lo, float hi) { unsigned r; asm volatile("v_cvt_pk_bf16_f32 %0, %1, %2" : "=v"(r) : "v"(lo), "v"(hi)); return r; }

template <bool MASKED>
__device__ __forceinline__ void partialSM(f32x16& p0, f32x16& p1, float& m_reg, float& mn, float& alpha, unsigned long long mw, int hi) {
  constexpr float C = SCALE * 1.4426950408889634f;
  float pmax = p0[0];
#pragma unroll
  for (int r = 1; r < 16; ++r) pmax = fmaxf(pmax, p0[r]);
#pragma unroll
  for (int r = 0; r < 16; ++r) pmax = fmaxf(pmax, p1[r]);
  { auto rr = __builtin_amdgcn_permlane32_swap(__float_as_uint(pmax), __float_as_uint(pmax), false, false);
    pmax = fmaxf(__uint_as_float(rr[0]), __uint_as_float(rr[1])); }
  if (__builtin_expect(__all(pmax - m_reg <= THR / SCALE), 1)) { mn = m_reg; alpha = 1.f; }
  else { mn = fmaxf(m_reg, pmax); alpha = __builtin_amdgcn_exp2f((m_reg - mn) * C); m_reg = mn; }
  const float mnC = -mn * C;
#pragma unroll
  for (int r = 0; r < 16; ++r) p0[r] = fmaf(p0[r], C, mnC);
#pragma unroll
  for (int r = 0; r < 16; ++r) p1[r] = fmaf(p1[r], C, mnC);
#pragma unroll
  for (int r = 0; r < 16; ++r) p0[r] = __builtin_amdgcn_exp2f(p0[r]);
}
__device__ __forceinline__ void finishSM(f32x16& p0, f32x16& p1, float alpha, float& l_reg, bf16x8& pa0, bf16x8& pa1, bf16x8& pa2, bf16x8& pa3) {
#pragma unroll
  for (int r = 0; r < 16; ++r) p1[r] = __builtin_amdgcn_exp2f(p1[r]);
  float ps = 0;
#pragma unroll
  for (int r = 0; r < 16; ++r) ps += p0[r];
#pragma unroll
  for (int r = 0; r < 16; ++r) ps += p1[r];
  { auto rr = __builtin_amdgcn_permlane32_swap(__float_as_uint(ps), __float_as_uint(ps), false, false);
    ps = __uint_as_float(rr[0]) + __uint_as_float(rr[1]); }
  l_reg = l_reg * alpha + ps;
#define PK4(P, BASE, OUT) do { unsigned a0 = cvtpk(P[BASE + 0], P[BASE + 1]), a1 = cvtpk(P[BASE + 2], P[BASE + 3]);   \
    unsigned b0 = cvtpk(P[BASE + 4], P[BASE + 5]), b1 = cvtpk(P[BASE + 6], P[BASE + 7]);                              \
    auto r0 = __builtin_amdgcn_permlane32_swap(a0, b0, false, false); auto r1 = __builtin_amdgcn_permlane32_swap(a1, b1, false, false); \
    u32x4 w = {r0[0], r1[0], r0[1], r1[1]}; OUT = *reinterpret_cast<bf16x8*>(&w); } while (0)
  PK4(p0, 0, pa0); PK4(p0, 8, pa1); PK4(p1, 0, pa2); PK4(p1, 8, pa3);
#undef PK4
}
template <int R> __device__ __forceinline__ float mask_bias(unsigned nw) {
  unsigned t; constexpr int bit = (R & 3) + 8 * (R >> 2);
  asm("v_bfe_i32 %0, %1, %2, 1\n\tv_and_b32 %0, 0xff800000, %0" : "=v"(t) : "v"(nw), "n"(bit));
  return __uint_as_float(t);
}
template <bool MASKED>
__device__ __forceinline__ void qkt(f32x16& p0, f32x16& p1, const char* Ks, const bf16x8* qr, int r32, int hi, unsigned long long mw) {
  if (MASKED) {
    const unsigned n0 = ~((unsigned)mw >> (4 * hi)), n1 = ~((unsigned)(mw >> 32) >> (4 * hi));
#define MB_(R) p0[R] = mask_bias<R>(n0); p1[R] = mask_bias<R>(n1);
    MB_(0) MB_(1) MB_(2) MB_(3) MB_(4) MB_(5) MB_(6) MB_(7) MB_(8) MB_(9) MB_(10) MB_(11) MB_(12) MB_(13) MB_(14) MB_(15)
#undef MB_
  } else { p0 = f32x16{}; p1 = f32x16{}; }
  asm volatile("" : "+v"(p0), "+v"(p1));
#pragma unroll
  for (int d0 = 0; d0 < 8; ++d0) { const int cb = (d0 * 16 + hi * 8) * 2;
    bf16x8 b0 = *reinterpret_cast<const bf16x8*>(Ks + KSWZ(r32, cb));
    bf16x8 b1 = *reinterpret_cast<const bf16x8*>(Ks + KSWZ(32 + r32, cb));
    p0 = __builtin_amdgcn_mfma_f32_32x32x16_bf16(b0, qr[d0], p0, 0, 0, 0);
    p1 = __builtin_amdgcn_mfma_f32_32x32x16_bf16(b1, qr[d0], p1, 0, 0, 0); }
}
__device__ __forceinline__ int v_st(int k, int c) { const int kk = (k & ~0xC) | ((k & 4) << 1) | ((k & 8) >> 1); return ((kk >> 3) * 4 + (c >> 5)) * 512 + ((kk & 7) * 32 + (c & 31)) * 2; }
__device__ __forceinline__ int v_rd_base(int lane) { return ((lane & 3) << 3) | (((lane >> 2) & 3) << 6) | (((lane >> 4) & 1) << 5) | (((lane >> 5) & 1) << 8); }
constexpr int v_rd_off(int d0, int ks, int half) { return d0 * 512 + ks * 4096 + half * 2048; }
template <int OFF> __device__ __forceinline__ s16x4 tr_read(int vb) {
  s16x4 r; asm volatile("ds_read_b64_tr_b16 %0, %1 offset:%2" : "=&v"(r) : "v"(vb), "i"(OFF) : "memory"); return r;
}
template <int D0> __device__ __forceinline__ void pv_one(f32x16& od, int vb, bf16x8 pa0, bf16x8 pa1, bf16x8 pa2, bf16x8 pa3) {
  const s16x4 l0 = tr_read<v_rd_off(D0, 0, 0)>(vb), h0 = tr_read<v_rd_off(D0, 0, 1)>(vb), l1 = tr_read<v_rd_off(D0, 1, 0)>(vb), h1 = tr_read<v_rd_off(D0, 1, 1)>(vb);
  const s16x4 l2 = tr_read<v_rd_off(D0, 2, 0)>(vb), h2 = tr_read<v_rd_off(D0, 2, 1)>(vb), l3 = tr_read<v_rd_off(D0, 3, 0)>(vb), h3 = tr_read<v_rd_off(D0, 3, 1)>(vb);
  asm volatile("s_waitcnt lgkmcnt(0)" ::: "memory"); SBAR();
#define PK(L, H) (bf16x8){L[0], L[1], L[2], L[3], H[0], H[1], H[2], H[3]}
  od = __builtin_amdgcn_mfma_f32_32x32x16_bf16(pa0, PK(l0, h0), od, 0, 0, 0);
  od = __builtin_amdgcn_mfma_f32_32x32x16_bf16(pa1, PK(l1, h1), od, 0, 0, 0);
  od = __builtin_amdgcn_mfma_f32_32x32x16_bf16(pa2, PK(l2, h2), od, 0, 0, 0);
  od = __builtin_amdgcn_mfma_f32_32x32x16_bf16(pa3, PK(l3, h3), od, 0, 0, 0);
#undef PK
}
__device__ __forceinline__ void pv_d0(f32x16* o, int vb, bf16x8 pa0, bf16x8 pa1, bf16x8 pa2, bf16x8 pa3) {
  pv_one<0>(o[0], vb, pa0, pa1, pa2, pa3); pv_one<1>(o[1], vb, pa0, pa1, pa2, pa3); pv_one<2>(o[2], vb, pa0, pa1, pa2, pa3); pv_one<3>(o[3], vb, pa0, pa1, pa2, pa3);
}

template <bool MASKED, int LDK, int VOFF, int QT, class OutRow>
__device__ __forceinline__ void attn_body(const bf16_t* __restrict__ Qw, const float* __restrict__ qgain, const float* __restrict__ qcs, const bf16_t* __restrict__ Kh, int NT,
                                          const unsigned long long* __restrict__ mbase, unsigned moff, const OutRow& Ow, char* lds) {
  const int tid = TIDX(), wid = tid >> 6, lane = tid & 63, r32 = lane & 31, hi = lane >> 5;
  char* V_lds = lds; char* K_lds = lds + 2 * SHM_V;
  float* ws = (float*)(lds + 2 * SHM_V + 2 * SHM_K) + wid * 64; float* li_l = ws; float* al_l = ws + 32;
  float m_reg = -1e30f, l_reg = 0; f32x16 o[4] = {}; bf16x8 qr[8];
  asm volatile("" : "+v"(o[0]), "+v"(o[1]), "+v"(o[2]), "+v"(o[3]));
#pragma unroll
  for (int d0 = 0; d0 < 8; ++d0) qr[d0] = *reinterpret_cast<const bf16x8*>(Qw + d0 * 16);
  if (QT) {
    float ss = 0.f;
#pragma unroll
    for (int d0 = 0; d0 < 8; ++d0)
#pragma unroll
      for (int j = 0; j < 8; ++j) { const float x = bf2f((bf16_t)qr[d0][j]); ss += x * x; }
    { auto rr = __builtin_amdgcn_permlane32_swap(__float_as_uint(ss), __float_as_uint(ss), false, false); ss = __uint_as_float(rr[0]) + __uint_as_float(rr[1]); }
    const float rn = rsqrtf(ss * (1.f / 128.f) + EPS);
    float x01[2][8];
#pragma unroll
    for (int d0 = 0; d0 < 8; ++d0) { const f32x4 g0 = *(const f32x4*)(qgain + d0 * 16 + hi * 8), g1 = *(const f32x4*)(qgain + d0 * 16 + hi * 8 + 4);
      float x[8];
#pragma unroll
      for (int j = 0; j < 8; ++j) x[j] = bf2f((bf16_t)qr[d0][j]) * rn * (j < 4 ? g0[j] : g1[j - 4]);
      if (QT == 2 && d0 < 2) {
#pragma unroll
        for (int j = 0; j < 8; ++j) x01[d0][j] = x[j];
      } else { u32x4 w = {cvtpk(x[0], x[1]), cvtpk(x[2], x[3]), cvtpk(x[4], x[5]), cvtpk(x[6], x[7])}; qr[d0] = *reinterpret_cast<bf16x8*>(&w); } }
    if (QT == 2) {
      float a[8], b[8];
#pragma unroll
      for (int j2 = 0; j2 < 4; ++j2) { const f32x4 cs = *(const f32x4*)(qcs + hi * 16 + 4 * j2);
#pragma unroll
        for (int q = 0; q < 2; ++q) { const int j = 2 * j2 + q; const float c = cs[2 * q], sn = cs[2 * q + 1], x1 = x01[0][j], x2 = x01[1][j]; a[j] = x1 * c - x2 * sn; b[j] = x2 * c + x1 * sn; } }
      { u32x4 w = {cvtpk(a[0], a[1]), cvtpk(a[2], a[3]), cvtpk(a[4], a[5]), cvtpk(a[6], a[7])}; qr[0] = *reinterpret_cast<bf16x8*>(&w); }
      { u32x4 w = {cvtpk(b[0], b[1]), cvtpk(b[2], b[3]), cvtpk(b[4], b[5]), cvtpk(b[6], b[7])}; qr[1] = *reinterpret_cast<bf16x8*>(&w); }
    }
  }
  const int sr = tid >> 4, sc = (tid & 15) * 8, vst0 = v_st(sr, sc), vst1 = v_st(32 + sr, sc);
  const int vb0 = (int)(uintptr_t)V_lds + v_rd_base(lane);
  struct { bf16x8 vs0, vs1, ks0, ks1; } sr_[2];
  const unsigned koff = (unsigned)(sr * LDK + sc) * 2u;
#define SLOAD(i, k0) do { const char* kb_ = (const char*)Kh + (size_t)(k0) * (LDK * 2); \
    sr_[i].vs0 = *reinterpret_cast<const bf16x8*>(kb_ + koff + VOFF * 2); sr_[i].vs1 = *reinterpret_cast<const bf16x8*>(kb_ + koff + (32 * LDK + VOFF) * 2); \
    sr_[i].ks0 = *reinterpret_cast<const bf16x8*>(kb_ + koff); sr_[i].ks1 = *reinterpret_cast<const bf16x8*>(kb_ + koff + 32 * LDK * 2); } while (0)
#define SWRITE(b, i) do { *(bf16x8*)(V_lds + (b) * SHM_V + vst0) = sr_[i].vs0;          \
    *(bf16x8*)(V_lds + (b) * SHM_V + vst1) = sr_[i].vs1; int kc = sc * 2;               \
    *(bf16x8*)(K_lds + (b) * SHM_K + KSWZ(sr, kc)) = sr_[i].ks0;                       \
    *(bf16x8*)(K_lds + (b) * SHM_K + KSWZ(32 + sr, kc)) = sr_[i].ks1; } while (0)
#define SWAIT() asm volatile("s_waitcnt vmcnt(4)" ::: "memory")
#define RESC(a) do { if (__any((a) < 1.f)) { if (hi == 0) al_l[r32] = (a); asm volatile("s_waitcnt lgkmcnt(0)" ::: "memory"); \
    _Pragma("unroll") for (int d = 0; d < 4; ++d) _Pragma("unroll") for (int r = 0; r < 16; ++r) o[d][r] *= al_l[crow(r, hi)]; } } while (0)
  f32x16 pA0, pA1, pB0, pB1; float mnA, mnB, alA, alB; bf16x8 pa0, pa1, pa2, pa3;
  unsigned long long mw = 0ull;
  constexpr int SE = 0, SO = 1;
  if (MASKED) mw = *(const unsigned long long*)((const char*)mbase + moff);
  SLOAD(SE, 0); SLOAD(SO, KVBLK);
  SWAIT(); SWRITE(0, SE); __syncthreads();
  qkt<MASKED>(pA0, pA1, K_lds, qr, r32, hi, mw);
  if (MASKED) mw = *(const unsigned long long*)((const char*)mbase + (moff + 8u));
  partialSM<MASKED>(pA0, pA1, m_reg, mnA, alA, mw, hi);
  SLOAD(SE, (2 < NT ? 2 : NT - 1) * KVBLK);
  SWAIT();
  SWRITE(1, SO); __syncthreads();
  if (MASKED) TPU_START(120);
  for (int j = 1; j + 1 < NT; j += 2) {
    SBAR(); qkt<MASKED>(pB0, pB1, K_lds + SHM_K, qr, r32, hi, mw);
    if (MASKED) mw = *(const unsigned long long*)((const char*)mbase + (moff + 8u * (unsigned)(j + 1)));
    finishSM(pA0, pA1, alA, l_reg, pa0, pa1, pa2, pa3); SBAR();
    SLOAD(SO, (j + 2) * KVBLK); SBAR();
    pv_d0(o, vb0, pa0, pa1, pa2, pa3); partialSM<MASKED>(pB0, pB1, m_reg, mnB, alB, mw, hi);
    __syncthreads(); if (MASKED) asm volatile("s_waitcnt vmcnt(5)" ::: "memory"); else SWAIT();
    SWRITE(0, SE);
    RESC(alB); __syncthreads();
    SBAR(); qkt<MASKED>(pA0, pA1, K_lds, qr, r32, hi, mw);
    if (MASKED) mw = *(const unsigned long long*)((const char*)mbase + (moff + 8u * (unsigned)(j + 2)));
    finishSM(pB0, pB1, alB, l_reg, pa0, pa1, pa2, pa3); SBAR();
    SLOAD(SE, (j + 3 < NT ? j + 3 : NT - 1) * KVBLK); SBAR();
    pv_d0(o, vb0 + SHM_V, pa0, pa1, pa2, pa3); partialSM<MASKED>(pA0, pA1, m_reg, mnA, alA, mw, hi);
    __syncthreads(); if (MASKED) asm volatile("s_waitcnt vmcnt(5)" ::: "memory"); else SWAIT();
    SWRITE(1, SO);
    RESC(alA); __syncthreads();
  }
  SBAR(); qkt<MASKED>(pB0, pB1, K_lds + SHM_K, qr, r32, hi, mw);
  finishSM(pA0, pA1, alA, l_reg, pa0, pa1, pa2, pa3); SBAR();
  pv_d0(o, vb0, pa0, pa1, pa2, pa3); partialSM<MASKED>(pB0, pB1, m_reg, mnB, alB, mw, hi);
  __syncthreads(); RESC(alB);
  finishSM(pB0, pB1, alB, l_reg, pa0, pa1, pa2, pa3); SBAR();
  pv_d0(o, vb0 + SHM_V, pa0, pa1, pa2, pa3);
  if (MASKED) TPU_STOP(120);
  if (MASKED) TPU_START(121);
  u32x4 zr[8];
#pragma unroll
  for (int i = 0; i < 8; ++i) zr[i] = *(const u32x4*)(Ow.zrow(4 * i + (lane >> 4)) + 8 * (lane & 15));
  if (hi == 0) li_l[r32] = l_reg; asm volatile("s_waitcnt lgkmcnt(0)" ::: "memory");
  float rli[16];
#pragma unroll
  for (int r = 0; r < 16; ++r) rli[r] = __builtin_amdgcn_rcpf(li_l[crow(r, hi)]);
  __syncthreads();
  float* og_s = (float*)lds + wid * (32 * 132);
#pragma unroll
  for (int r = 0; r < 16; ++r) {
#pragma unroll
    for (int d0 = 0; d0 < 4; ++d0) og_s[crow(r, hi) * 132 + d0 * 32 + r32] = o[d0][r] * rli[r]; }
  asm volatile("" ::: "memory");
  { const int row = lane >> 1, half = lane & 1; const float* src = og_s + row * 132 + half * 64;
    float ss = 0.f;
#pragma unroll
    for (int i = 0; i < 16; ++i) { const f32x4 v = *(const f32x4*)(src + 4 * i); ss += v[0] * v[0] + v[1] * v[1] + v[2] * v[2] + v[3] * v[3]; }
    ss += shx(ss, 1);
    if (half == 0) og_s[row * 132 + 128] = rsqrtf(ss * (1.f / 128.f) + EPS); }
  asm volatile("s_waitcnt lgkmcnt(0)" ::: "memory");
#pragma unroll
  for (int i = 0; i < 8; ++i) { const int row = 4 * i + (lane >> 4), c8 = 8 * (lane & 15); const float* src = og_s + row * 132 + c8;
    const f32x4 a = *(const f32x4*)src, b2 = *(const f32x4*)(src + 4); const float rn = og_s[row * 132 + 128];
    float z[8], g[8];
    z[0] = __uint_as_float(zr[i].x << 16); z[1] = __uint_as_float(zr[i].x & 0xffff0000u); z[2] = __uint_as_float(zr[i].y << 16); z[3] = __uint_as_float(zr[i].y & 0xffff0000u);
    z[4] = __uint_as_float(zr[i].z << 16); z[5] = __uint_as_float(zr[i].z & 0xffff0000u); z[6] = __uint_as_float(zr[i].w << 16); z[7] = __uint_as_float(zr[i].w & 0xffff0000u);
#pragma unroll
    for (int q = 0; q < 4; ++q) { g[q] = a[q] * rn * siluf_(z[q]); g[4 + q] = b2[q] * rn * siluf_(z[4 + q]); }
    st8f(Ow.grow(row) + c8, g); }
  __syncthreads();
  if (MASKED) TPU_STOP(121);
#undef SLOAD
#undef SWRITE
#undef SWAIT
#undef RESC
}
}
constexpr size_t al256(size_t x) { return (x + 255) / 256 * 256; }
constexpr size_t WS_CTL   = 0;
constexpr size_t CTL_BYTES = 65536;
constexpr size_t WS_WINT  = WS_CTL + CTL_BYTES;
constexpr size_t WS_WOUTT = WS_WINT + al256((size_t)DEPTH * NPAD * DM * 2);
constexpr size_t WS_WKVT  = WS_WOUTT + al256((size_t)DEPTH * DM * MIX * 2);
constexpr size_t WS_WGLUT = WS_WKVT + al256((size_t)DEPTH * 1024 * DM * 2);
constexpr size_t WS_MEMN  = WS_WGLUT + al256((size_t)DEPTH * 512 * 512 * 2);
constexpr size_t WS_KVMEM = WS_MEMN + al256((size_t)NB * MEML * DM * 2);
constexpr size_t WS_XN    = WS_KVMEM + al256((size_t)NB * MEML * DEPTH * 1024 * 2);
constexpr size_t WS_P     = WS_XN + al256((size_t)NTOK * DM * 2);
constexpr size_t WS_XBUF  = WS_P + al256((size_t)NTOK * NPAD * 2);
constexpr size_t WS_OCAT  = WS_XBUF + al256((size_t)NTOK * DM * 4);
constexpr size_t WS_MASK  = WS_OCAT + al256((size_t)NTOK * MIX * 2);
constexpr size_t WS_IW    = WS_MASK + al256((size_t)NTOK * 64 * 8);
constexpr size_t WS_YBUF  = WS_IW + al256((size_t)NTOK * 16 * 4);
constexpr size_t WS_ROPE  = WS_YBUF + al256((size_t)NTOK * 512 * 2);
constexpr size_t WS_S5P   = WS_ROPE + al256((size_t)NTOK * 48 * 4);
constexpr size_t S5P_BYTES = (size_t)DEPTH * 32 * (64 * 2 + 64 * 2 + 64 * 16 * 2) * 4;
constexpr size_t WS_GLAS  = WS_S5P + al256(S5P_BYTES);
constexpr size_t WS_GLAD  = WS_GLAS + al256((size_t)NB * 64 * 4 * 64 * 128 * 4);
constexpr size_t WS_IKC   = WS_GLAD + al256((size_t)NB * 64 * 4 * 64 * 4);
constexpr size_t WS_KVC   = WS_IKC + al256((size_t)NTOK * 64 * 2);
constexpr size_t WS_IQL   = WS_KVC + al256((size_t)NTOK * 256 * 2);
constexpr size_t WS_SSQ   = WS_IQL + al256((size_t)NTOK * 64 * 2);
constexpr size_t DSP_SLOT = (size_t)(256 * 128 + 512) * 4;
constexpr size_t WS_DSP   = WS_SSQ + 256;
constexpr size_t WS_END   = WS_DSP + al256((size_t)160 * 2 * DSP_SLOT);

struct Params {
    const float* x; const float* mem; const int* pos; const float* ln_gain; const float* w_in; const float* gla_w_up; const float* gla_b_up;
    const float* s5_a_re; const float* s5_a_im; const float* s5_log_step; const float* s5_b_re; const float* s5_b_im; const float* s5_c_re; const float* s5_c_im;
    const float* s5_d; const float* s5_w_glu; const float* dsa_q_norm; const float* dsa_k_norm; const float* mem_norm; const float* w_mem_kv;
    const float* mem_q_norm; const float* mem_k_norm; const float* out_norm; const float* w_out;
    float* out;
    char* ws;
    __device__ __forceinline__ unsigned* ctl_() const { return (unsigned*)(ws + WS_CTL); }
    __device__ __forceinline__ bf16_t* WinT_() const { return (bf16_t*)(ws + WS_WINT); }
    __device__ __forceinline__ bf16_t* WoutT_() const { return (bf16_t*)(ws + WS_WOUTT); }
    __device__ __forceinline__ bf16_t* WkvT_() const { return (bf16_t*)(ws + WS_WKVT); }
    __device__ __forceinline__ bf16_t* WgluT_() const { return (bf16_t*)(ws + WS_WGLUT); }
    __device__ __forceinline__ bf16_t* memn_() const { return (bf16_t*)(ws + WS_MEMN); }
    __device__ __forceinline__ bf16_t* kvmem_() const { return (bf16_t*)(ws + WS_KVMEM); }
    __device__ __forceinline__ bf16_t* xn_() const { return (bf16_t*)(ws + WS_XN); }
    __device__ __forceinline__ bf16_t* p_() const { return (bf16_t*)(ws + WS_P); }
    __device__ __forceinline__ bf16_t* xbuf_() const { return (bf16_t*)(ws + WS_XBUF); }
    __device__ __forceinline__ bf16_t* ocat_() const { return (bf16_t*)(ws + WS_OCAT); }
    __device__ __forceinline__ unsigned long long* mask_() const { return (unsigned long long*)(ws + WS_MASK); }
    __device__ __forceinline__ float* iw_() const { return (float*)(ws + WS_IW); }
    __device__ __forceinline__ bf16_t* ybuf_() const { return (bf16_t*)(ws + WS_YBUF); }
    __device__ __forceinline__ float* rope_() const { return (float*)(ws + WS_ROPE); }
    __device__ __forceinline__ float* s5p_() const { return (float*)(ws + WS_S5P); }
    __device__ __forceinline__ float* glas_() const { return (float*)(ws + WS_GLAS); }
    __device__ __forceinline__ float* glad_() const { return (float*)(ws + WS_GLAD); }
    __device__ __forceinline__ bf16_t* ikc_() const { return (bf16_t*)(ws + WS_IKC); }
    __device__ __forceinline__ bf16_t* kvc_() const { return (bf16_t*)(ws + WS_KVC); }
    __device__ __forceinline__ float* ssq_() const { return (float*)(ws + WS_SSQ); }
    __device__ __forceinline__ bf16_t* iql_() const { return (bf16_t*)(ws + WS_IQL); }
    __device__ __forceinline__ char* dsp_() const { return ws + WS_DSP; }
};

__device__ __forceinline__ void transpose_tiles(const float* __restrict__ src, int K, int Nsrc, int Ndst, const float* __restrict__ scale, bf16_t* __restrict__ dst,
                                                int tile, float* lds_tile  ) {
    const int tid = TIDX(), ntn = Ndst / 256;
    const int tk = tile / ntn, tn = tile % ntn, k0 = tk * 64, n0 = tn * 256;
    __syncthreads();
    { const int ty = tid >> 4, tx = tid & 15;
      f32x4 v[2][4];
#pragma unroll
      for (int i = 0; i < 2; ++i)
#pragma unroll
        for (int q = 0; q < 4; ++q) { const int k = k0 + ty + 32 * i, n = n0 + 4 * tx + 64 * q;
          v[i][q] = (f32x4){0.f, 0.f, 0.f, 0.f};
          if (n < Nsrc) v[i][q] = *(const f32x4*)(src + (size_t)k * Nsrc + n); }
#pragma unroll
      for (int i = 0; i < 2; ++i) { const float s = scale ? scale[k0 + ty + 32 * i] : 1.f;
#pragma unroll
        for (int q = 0; q < 4; ++q) { float* t = lds_tile + (ty + 32 * i) * 257 + 4 * tx + 64 * q; t[0] = v[i][q][0] * s; t[1] = v[i][q][1] * s; t[2] = v[i][q][2] * s; t[3] = v[i][q][3] * s; } } }
    __syncthreads();
    { const int n = tid >> 1, kh = (tid & 1) * 32;
#pragma unroll
      for (int j = 0; j < 4; ++j) { const int kb = kh + 8 * j; u32x4 w;
        w.x = pk2bf(lds_tile[(kb + 0) * 257 + n], lds_tile[(kb + 1) * 257 + n]); w.y = pk2bf(lds_tile[(kb + 2) * 257 + n], lds_tile[(kb + 3) * 257 + n]);
        w.z = pk2bf(lds_tile[(kb + 4) * 257 + n], lds_tile[(kb + 5) * 257 + n]); w.w = pk2bf(lds_tile[(kb + 6) * 257 + n], lds_tile[(kb + 7) * 257 + n]);
        *(u32x4*)(dst + (size_t)(n0 + n) * K + k0 + kb) = w; } }
}

__device__ __forceinline__ void rmsnorm_rows(const float* __restrict__ X, bf16_t* __restrict__ Y, int nrows) {
    const int wid = TIDX() >> 6, lane = TIDX() & 63;
    for (int row = blockIdx.x * 8 + wid; row < nrows; row += gridDim.x * 8) {
        const float* xr = X + (size_t)row * DM; f32x4 v[8]; float ss = 0.f;
#pragma unroll
        for (int i = 0; i < 8; ++i) { v[i] = *(const f32x4*)(xr + 4 * lane + 256 * i); ss += v[i][0] * v[i][0] + v[i][1] * v[i][1] + v[i][2] * v[i][2] + v[i][3] * v[i][3]; }
        ss = wave_sum(ss); const float r = rsqrtf(ss * (1.f / DM) + EPS);
        bf16_t* yr = Y + (size_t)row * DM;
#pragma unroll
        for (int i = 0; i < 8; ++i) { u32x2 w; w.x = pk2bf(v[i][0] * r, v[i][1] * r); w.y = pk2bf(v[i][2] * r, v[i][3] * r); *(u32x2*)(yr + 4 * lane + 256 * i) = w; }
    }
}

__device__ __forceinline__ void rmsnorm_rows16(const bf16_t* __restrict__ X, bf16_t* __restrict__ Y, int nrows) {
    const int wid = TIDX() >> 6, lane = TIDX() & 63;
    for (int row = blockIdx.x * 8 + wid; row < nrows; row += gridDim.x * 8) {
        const bf16_t* xr = X + (size_t)row * DM; float v[4][8]; float ss = 0.f;
#pragma unroll
        for (int i = 0; i < 4; ++i) { ld8f(xr + 8 * lane + 512 * i, v[i]);
#pragma unroll
            for (int j = 0; j < 8; ++j) ss += v[i][j] * v[i][j]; }
        ss = wave_sum(ss); const float r = rsqrtf(ss * (1.f / DM) + EPS);
        bf16_t* yr = Y + (size_t)row * DM;
#pragma unroll
        for (int i = 0; i < 4; ++i) { float o[8];
#pragma unroll
            for (int j = 0; j < 8; ++j) o[j] = v[i][j] * r;
            st8f(yr + 8 * lane + 512 * i, o); }
    }
}

__device__ __forceinline__ void rows_bf16_ssq(const float* __restrict__ X, bf16_t* __restrict__ Y, float* __restrict__ ssq, int nrows) {
    const int wid = TIDX() >> 6, lane = TIDX() & 63;
    for (int row = blockIdx.x * 8 + wid; row < nrows; row += gridDim.x * 8) {
        const float* xr = X + (size_t)row * DM; bf16_t* yr = Y + (size_t)row * DM; float ss = 0.f;
#pragma unroll
        for (int i = 0; i < 8; ++i) { const f32x4 v = *(const f32x4*)(xr + 4 * lane + 256 * i); ss += v[0] * v[0] + v[1] * v[1] + v[2] * v[2] + v[3] * v[3];
            u32x2 w; w.x = pk2bf(v[0], v[1]); w.y = pk2bf(v[2], v[3]); *(u32x2*)(yr + 4 * lane + 256 * i) = w; }
        ss = wave_sum(ss); if (lane < 32) ssq[(size_t)row * 32 + lane] = (lane == 0) ? ss : 0.f;
    }
}
__device__ __forceinline__ void phase_prologue1(const Params& P, char* lds) {
    float* tile = (float*)lds;
    constexpr int T_IN = (DM / 64) * (NPAD / 256), T_OUT = (MIX / 64) * (DM / 256), T_KV = (DM / 64) * (1024 / 256), T_GLU = 8 * 2;
    constexpr int TOT = DEPTH * (T_IN + T_OUT + T_KV + T_GLU);
    for (int u = blockIdx.x; u < TOT; u += gridDim.x) {
        int l = u / (T_IN + T_OUT + T_KV + T_GLU), r = u % (T_IN + T_OUT + T_KV + T_GLU);
        if (r < T_IN) transpose_tiles(P.w_in + (size_t)l * DM * NIN, DM, NIN, NPAD, P.ln_gain + l * DM, P.WinT_() + (size_t)l * NPAD * DM, r, tile);
        else if ((r -= T_IN) < T_OUT) transpose_tiles(P.w_out + (size_t)l * MIX * DM, MIX, DM, DM, P.out_norm + l * MIX, P.WoutT_() + (size_t)l * DM * MIX, r, tile);
        else if ((r -= T_OUT) < T_KV) transpose_tiles(P.w_mem_kv + (size_t)l * DM * 1024, DM, 1024, 1024, P.mem_norm + l * DM, P.WkvT_() + (size_t)l * 1024 * DM, r, tile);
        else { r -= T_KV; transpose_tiles(P.s5_w_glu + (size_t)l * 512 * 512, 512, 512, 512, nullptr, P.WgluT_() + (size_t)l * 512 * 512, r, tile); }
    }
    rmsnorm_rows(P.mem, P.memn_(), NB * MEML);
}
__device__ __forceinline__ void phase_rope_table(const Params& P) {
    for (int idx = blockIdx.x * NTHR + TIDX(); idx < NTOK * 24; idx += gridDim.x * NTHR) {
        const int tok = idx / 24, i = idx % 24;
        const float e = (i < 16) ? -((float)i * 2.0f / 32.0f) : -((float)(i - 16) * 2.0f / 16.0f);
        const float inv_freq = exp2f(e * 18.931568569324174f);
        const float ang = (float)P.pos[tok] * inv_freq;
        const double a = (double)ang; const double k = rint(a * 0.15915494309189535); const float rf = (float)fma(-k, 6.283185307179586, a);
        P.rope_()[(size_t)idx * 2] = cosf(rf); P.rope_()[(size_t)idx * 2 + 1] = sinf(rf);
    }
}

__device__ __forceinline__ void phase_rmsnorm_x(const Params& P, int layer) { if (layer == 0) rmsnorm_rows(P.x, P.xn_(), NTOK); else rmsnorm_rows16(P.xbuf_(), P.xn_(), NTOK); }

__device__ __forceinline__ void phase_memk_norm(const Params& P) {
    const int wid = TIDX() >> 6, lane = TIDX() & 63;
    for (int it = blockIdx.x * 8 + wid; it < NB * MEML * DEPTH * 4; it += gridDim.x * 8) {
        const int row = it / (DEPTH * 4), l = (it / 4) % DEPTH, h = it % 4;
        bf16_t* kp = P.kvmem_() + (size_t)row * (DEPTH * 1024) + l * 1024 + h * 128 + 2 * lane;
        const unsigned w = *(const unsigned*)kp; const float a = __uint_as_float(w << 16), b = __uint_as_float(w & 0xffff0000u);
        const float ss = wave_sum(a * a + b * b), r = rsqrtf(ss * (1.f / 128.f) + EPS);
        const float* g = P.mem_k_norm + l * 128 + 2 * lane;
        *(unsigned*)kp = pk2bf(a * r * g[0], b * r * g[1]);
    }
}

__device__ __forceinline__ float sum16(float v) { v += shx(v, 1); v += shx(v, 2); v += shx(v, 4); v += shx(v, 8); return v; }

__device__ __forceinline__ void head128_norm_rope_to(const bf16_t* hp, bf16_t* dp, int l16, const float* __restrict__ gain, const float* __restrict__ cs, bool rope, bool do_store) {
    float v[8]; ld8f(hp + 8 * l16, v);
    float ss = 0.f;
#pragma unroll
    for (int j = 0; j < 8; ++j) ss += v[j] * v[j];
    ss = sum16(ss); const float r = rsqrtf(ss * (1.f / 128.f) + EPS);
#pragma unroll
    for (int j = 0; j < 8; ++j) v[j] = v[j] * r * gain[8 * l16 + j];
    if (rope) {
        float o[8];
#pragma unroll
        for (int j = 0; j < 8; ++j) o[j] = shx(v[j], 2);
        if (l16 < 4) { const int fi = (l16 & 1) * 8;
#pragma unroll
            for (int j = 0; j < 8; ++j) { const float c = cs[(fi + j) * 2], s = cs[(fi + j) * 2 + 1];
                v[j] = (l16 < 2) ? (v[j] * c - o[j] * s) : (v[j] * c + o[j] * s); } }
    }
    if (do_store) st8f(dp + 8 * l16, v);
}
__device__ __forceinline__ void head128_norm_rope(bf16_t* hp, int l16, const float* __restrict__ gain, const float* __restrict__ cs, bool rope, bool do_store) { head128_norm_rope_to(hp, hp, l16, gain, cs, rope, do_store); }
__device__ __forceinline__ void rope16_inplace(bf16_t* ip, const float* __restrict__ cs) {
    float a[8], b[8]; ld8f(ip, a); ld8f(ip + 8, b);
#pragma unroll
    for (int j = 0; j < 8; ++j) { const float c = cs[2 * j], s = cs[2 * j + 1], x1 = a[j], x2 = b[j]; a[j] = x1 * c - x2 * s; b[j] = x2 * c + x1 * s; }
    st8f(ip, a); st8f(ip + 8, b);
}
struct PrepIn { u32x4 k, i0, i1, ik0, ik1, v; bf16_t w; f32x4 c32[4], c16[4]; };
__device__ __forceinline__ void prep_load(const Params& P, int tok, int lane, PrepIn& I) {
    const int l16 = lane & 15, grp = lane >> 4;
    const bf16_t* row = P.p_() + (size_t)tok * NPAD;
    I.k = *(const u32x4*)(row + C_DK + 8 * l16);
    I.i0 = *(const u32x4*)(row + C_DIQ + (lane >> 2) * 64); I.i1 = *(const u32x4*)(row + C_DIQ + (lane >> 2) * 64 + 8);
    I.ik0 = *(const u32x4*)(row + C_DIK + (lane & 3) * 16); I.ik1 = *(const u32x4*)(row + C_DIK + (lane & 3) * 16 + 8);
    I.v = *(const u32x4*)(row + C_DV + l16 * 8);
    I.w = row[C_DIW + l16];
    const float* cs32 = P.rope_() + (size_t)tok * 48;
#pragma unroll
    for (int i = 0; i < 4; ++i) { I.c32[i] = *(const f32x4*)(cs32 + (l16 & 1) * 16 + 4 * i); I.c16[i] = *(const f32x4*)(cs32 + 32 + 4 * i); }
}
__device__ __forceinline__ void unpack8(const u32x4 w, float (&v)[8]) {
    v[0] = __uint_as_float(w.x << 16); v[1] = __uint_as_float(w.x & 0xffff0000u); v[2] = __uint_as_float(w.y << 16); v[3] = __uint_as_float(w.y & 0xffff0000u);
    v[4] = __uint_as_float(w.z << 16); v[5] = __uint_as_float(w.z & 0xffff0000u); v[6] = __uint_as_float(w.w << 16); v[7] = __uint_as_float(w.w & 0xffff0000u); }
__device__ __forceinline__ void head128_nr(float (&v)[8], int l16, const float (&gain)[8], const f32x4 (&cs)[4], bool rope) {
    float ss = 0.f;
#pragma unroll
    for (int j = 0; j < 8; ++j) ss += v[j] * v[j];
    ss = sum16(ss); const float r = rsqrtf(ss * (1.f / 128.f) + EPS);
#pragma unroll
    for (int j = 0; j < 8; ++j) v[j] = v[j] * r * gain[j];
    if (rope) {
        float o[8];
#pragma unroll
        for (int j = 0; j < 8; ++j) o[j] = shx(v[j], 2);
        if (l16 < 4) {
#pragma unroll
            for (int j = 0; j < 8; ++j) { const float c = cs[j >> 1][(j & 1) * 2], s = cs[j >> 1][(j & 1) * 2 + 1];
                v[j] = (l16 < 2) ? (v[j] * c - o[j] * s) : (v[j] * c + o[j] * s); } }
    }
}
__device__ __forceinline__ void prep_finish(const Params& P, int tok, int lane, const PrepIn& I, const float (&gq)[8], const float (&gk)[8], const float (&gm)[8]) {
    const int l16 = lane & 15, grp = lane >> 4;
    bf16_t* row = P.p_() + (size_t)tok * NPAD;
    float k[8];
    unpack8(I.k, k);
    head128_nr(k, l16, gk, I.c32, true);
    if (grp == 0) st8f(P.kvc_() + (size_t)tok * 256 + 8 * l16, k);
    {
        float a[8], b[8]; unpack8(I.i0, a); unpack8(I.i1, b);
#pragma unroll
        for (int j = 0; j < 8; ++j) { const float c = I.c16[j >> 1][(j & 1) * 2], s = I.c16[j >> 1][(j & 1) * 2 + 1], x1 = a[j], x2 = b[j]; a[j] = x1 * c - x2 * s; b[j] = x2 * c + x1 * s; }
        if ((lane & 3) == 0) { st8f(row + C_DIQ + (lane >> 2) * 64, a); st8f(row + C_DIQ + (lane >> 2) * 64 + 8, b); } }
    {
        float a[8], b[8]; unpack8(I.ik0, a); unpack8(I.ik1, b);
        if ((lane & 3) == 0) {
#pragma unroll
            for (int j = 0; j < 8; ++j) { const float c = I.c16[j >> 1][(j & 1) * 2], s = I.c16[j >> 1][(j & 1) * 2 + 1], x1 = a[j], x2 = b[j]; a[j] = x1 * c - x2 * s; b[j] = x2 * c + x1 * s; } }
        if (lane < 4) { bf16_t* dst = P.ikc_() + (size_t)(tok >> 5) * 2048 + lane * 512 + (tok & 31) * 8; st8f(dst, a); st8f(dst + 256, b); } }
    if (lane >= 16 && lane < 32) *(u32x4*)(P.kvc_() + (size_t)tok * 256 + 128 + l16 * 8) = I.v;
    if (lane < 16) P.iw_()[(size_t)tok * 16 + lane] = bf2f(I.w) * (1.f / 32.f);
}
__device__ __forceinline__ void phase_prep(const Params& P, int layer) {
    const int wid = TIDX() >> 6, lane = TIDX() & 63, l16 = lane & 15;
    float gq[8], gk[8], gm[8];
#pragma unroll
    for (int j = 0; j < 8; ++j) { gq[j] = P.dsa_q_norm[layer * 128 + 8 * l16 + j]; gk[j] = P.dsa_k_norm[layer * 128 + 8 * l16 + j]; gm[j] = P.mem_q_norm[layer * 128 + 8 * l16 + j]; }
    const int stride = gridDim.x * 8;
    for (int tok = blockIdx.x * 8 + wid; tok < NTOK; tok += 2 * stride) {
        const int tok2 = tok + stride; const bool two = tok2 < NTOK;
        PrepIn A, B2;
        prep_load(P, tok, lane, A); prep_load(P, two ? tok2 : tok, lane, B2);
        prep_finish(P, tok, lane, A, gq, gk, gm);
        if (two) prep_finish(P, tok2, lane, B2, gq, gk, gm);
    }
}
struct MemOutRow { const bf16_t* zb; bf16_t* gb;
    __device__ __forceinline__ const bf16_t* zrow(int r) const { return zb + (size_t)r * NPAD; } __device__ __forceinline__ bf16_t* grow(int r) const { return gb + (size_t)r * MIX; } };
__device__ __forceinline__ void unit_mem_attn(const Params& P, int layer, int u, char* lds) {
    const int b = u >> 6, h = (u >> 4) & 3, qb = u & 15, tok0 = b * SEQ + qb * 256;
    const int wid = TIDX() >> 6, lane = TIDX() & 63, r32 = lane & 31, hi = lane >> 5;
    const bf16_t* Qw = P.p_() + (size_t)(tok0 + wid * 32 + r32) * NPAD + C_MQ + h * 128 + hi * 8;
    const bf16_t* Kh = P.kvmem_() + (size_t)(b * MEML) * (DEPTH * 1024) + layer * 1024 + h * 128;
    MemOutRow ow; ow.zb = P.p_() + (size_t)(tok0 + wid * 32) * NPAD + C_MZ + h * 128; ow.gb = P.xn_() + (size_t)(tok0 + wid * 32) * MIX + 1536 + h * 128;
    att::attn_body<false, DEPTH * 1024, 512, 1, MemOutRow>(Qw, P.mem_q_norm + layer * 128, nullptr, Kh, MEML / 64, nullptr, 0u, ow, lds);
}

__device__ __forceinline__ void phase_gate(const Params& P, int c_lo, int c_hi) {
    const int wid = TIDX() >> 6, lane = TIDX() & 63;
    const int c0 = lane * 32;
    const int seg = c0 >> 9, zc = (seg == 0 ? C_GZ : seg == 1 ? C_SZ : seg == 2 ? C_DZ : C_MZ) + (c0 & 511);
    const bool act = (c0 >= c_lo) && (c0 < c_hi);
    for (int tok = blockIdx.x * 8 + wid; tok < NTOK; tok += gridDim.x * 8) {
        if (!act) { bf16_t* gz_ = P.xn_() + (size_t)tok * MIX + c0; const u32x4 zz = {0u, 0u, 0u, 0u};
#pragma unroll
            for (int i = 0; i < 4; ++i) *(u32x4*)(gz_ + 8 * i) = zz;
            continue; }
        const bf16_t* op = P.ocat_() + (size_t)tok * MIX + c0; const bf16_t* zp = P.p_() + (size_t)tok * NPAD + zc; bf16_t* gp = P.xn_() + (size_t)tok * MIX + c0;
        float o[32]; float ss = 0.f;
#pragma unroll
        for (int i = 0; i < 4; ++i) { float v[8]; ld8f(op + 8 * i, v);
#pragma unroll
            for (int j = 0; j < 8; ++j) { o[8 * i + j] = v[j]; ss += v[j] * v[j]; } }
        ss += shx(ss, 1); ss += shx(ss, 2);
        const float r = rsqrtf(ss * (1.f / 128.f) + EPS);
#pragma unroll
        for (int i = 0; i < 4; ++i) { float z[8], g[8]; ld8f(zp + 8 * i, z);
#pragma unroll
            for (int j = 0; j < 8; ++j) g[j] = o[8 * i + j] * r * siluf_(z[j]);
            st8f(gp + 8 * i, g); }
    }
}

__device__ __forceinline__ void phase_gemm_in(const Params& P, int layer, char* lds) {
    pg8::Gemm g; g.A = P.xn_(); g.Bt = P.WinT_() + (size_t)layer * NPAD * DM; g.M = NTOK; g.N = NPAD; g.K = DM;
    pg8::StaticOrder S; S.init(g.M, g.N, (int)gridDim.x, (int)blockIdx.x);
    pg8::EpiBf16Plain E; E.O = P.p_(); E.ldc = NPAD;
    pg8::gemm_phase<pg8::EpiBf16Plain, pg8::StaticOrder, false>((PG8_LAS unsigned char*)lds, g, S, E, nullptr);
}
__device__ __forceinline__ void phase_gemm_out(const Params& P, int layer, char* lds) {
    pg8::Gemm g; g.A = P.xn_(); g.Bt = P.WoutT_() + (size_t)layer * DM * MIX; g.M = NTOK; g.N = DM; g.K = MIX;
    pg8::StaticOrder S; S.init(g.M, g.N, (int)gridDim.x, (int)blockIdx.x);
    pg8::EpiResidMix E; E.R = (layer == 0) ? (const void*)P.x : (const void*)P.xbuf_(); E.C = (layer == DEPTH - 1) ? (void*)P.out : (void*)P.xbuf_(); E.ldc = DM;
    E.r16 = (layer != 0); E.c16 = (layer != DEPTH - 1);
    pg8::gemm_phase<pg8::EpiResidMix, pg8::StaticOrder, false>((PG8_LAS unsigned char*)lds, g, S, E, nullptr);
}
__device__ __forceinline__ void phase_gemm_kv(const Params& P, char* lds) {
    pg8::Gemm g; g.A = P.memn_(); g.Bt = P.WkvT_(); g.M = NB * MEML; g.N = DEPTH * 1024; g.K = DM;
    pg8::StaticOrder S; S.init(g.M, g.N, (int)gridDim.x, (int)blockIdx.x);
    pg8::EpiBf16Plain E; E.O = P.kvmem_(); E.ldc = DEPTH * 1024;
    pg8::gemm_phase<pg8::EpiBf16Plain, pg8::StaticOrder, false>((PG8_LAS unsigned char*)lds, g, S, E, nullptr);
}
__device__ __forceinline__ void mma_tile(f32x16& acc, const char* A, int lda, const char* B, int ldb, int K, int lane) {
    const int r = lane & 31, kh = lane >> 5;
    const char* ap = A + r * lda + kh * 16; const char* bp = B + r * ldb + kh * 16;
    asm volatile("" : "+v"(acc));
    for (int k = 0; k < K; k += 16) {
        const bf16x8 a = *(const bf16x8*)(ap + k * 2); const bf16x8 b = *(const bf16x8*)(bp + k * 2);
        acc = __builtin_amdgcn_mfma_f32_32x32x16_bf16(a, b, acc, 0, 0, 0);
    }
}
__device__ __forceinline__ int crow32(int r, int hi) { return (r & 3) + 8 * (r >> 2) + 4 * hi; }
__device__ __forceinline__ float log_sigmoid_(float x) { return fminf(x, 0.f) - log1pf(__expf(-fabsf(x))); }

constexpr int GLA_ST = 144;
constexpr int GC_BST = 68;
constexpr int GC_B_BYTES = 4 * 64 * GC_BST * 4, GC_V_BYTES = 4 * 16384;
__device__ __forceinline__ float* gla_gb(const Params& P) { return (float*)((char*)P.ocat_() + (size_t)32 * 1024 * 1024); }
__device__ __forceinline__ float log_sigmoid_fast(float x) { return fminf(x, 0.f) - __logf(1.f + __expf(-fabsf(x))); }

__device__ __forceinline__ void unit_gla_a4(const Params& P, int layer, int ub, char* lds) {
    const int b = ub >> 6, n = ub & 63, tok0 = b * SEQ + n * 64;
    const int tid = TIDX(), wid = tid >> 6, lane = tid & 63, r32 = lane & 31, hi = lane >> 5, h = wid >> 1, eh = wid & 1;
    float* b_s = (float*)lds;
    char* V_s = lds;
    char* K_s = lds + GC_B_BYTES;
    float* glr_s = (float*)(lds + GC_B_BYTES + GC_V_BYTES);
    float* tot_s = glr_s + 1024;
    __syncthreads();
    const bf16_t* prow = P.p_() + (size_t)tok0 * NPAD;
    const bf16x8 glr_raw = *(const bf16x8*)(prow + (size_t)((tid & 127) >> 1) * NPAD + C_GLR + (tid & 1) * 8);
    const int gd = tid & 63, gh = (tid >> 6) & 3, gt = tid >> 8;
    float wu[16];
#pragma unroll
    for (int r = 0; r < 16; ++r) wu[r] = P.gla_w_up[((size_t)layer * 16 + r) * 256 + gh * 64 + gd];
    const float bias = P.gla_b_up[layer * 256 + gh * 64 + gd];
    bf16x8 kraw[4], vs[4][2];
    const int ks_ = tid >> 3, kc = (tid & 7) * 8;
#pragma unroll
    for (int hv = 0; hv < 4; ++hv) kraw[hv] = *(const bf16x8*)(prow + (size_t)ks_ * NPAD + C_GK + hv * 64 + kc);
    const int sr = tid >> 4, sc = (tid & 15) * 8;
#pragma unroll
    for (int hv = 0; hv < 4; ++hv) { vs[hv][0] = *(const bf16x8*)(prow + (size_t)sr * NPAD + C_GV + hv * 128 + sc); vs[hv][1] = *(const bf16x8*)(prow + (size_t)(32 + sr) * NPAD + C_GV + hv * 128 + sc); }
    if (tid < 128) {
#pragma unroll
        for (int j = 0; j < 8; ++j) glr_s[(tid >> 1) * 16 + (tid & 1) * 8 + j] = bf2f((bf16_t)glr_raw[j]); }
    __syncthreads();
    float gv[32]; float run = 0.f;
#pragma unroll
    for (int i = 0; i < 32; ++i) { const float* gr = glr_s + (gt * 32 + i) * 16; float a = bias;
#pragma unroll
        for (int r4 = 0; r4 < 4; ++r4) { const f32x4 g4 = *(const f32x4*)(gr + 4 * r4); a = fmaf(g4[0], wu[4 * r4], a); a = fmaf(g4[1], wu[4 * r4 + 1], a); a = fmaf(g4[2], wu[4 * r4 + 2], a); a = fmaf(g4[3], wu[4 * r4 + 3], a); }
        run += log_sigmoid_fast(a) * (1.f / 16.f); gv[i] = run; }
    if (gt == 0) tot_s[gh * 64 + gd] = run;
    __syncthreads();
    { const float off = gt ? tot_s[gh * 64 + gd] : 0.f; float* bp = b_s + (gh * 64 + gt * 32) * GC_BST + gd;
      float* gp = gla_gb(P) + (size_t)(tok0 + gt * 32) * 256 + gh * 64 + gd;
#pragma unroll
      for (int i = 0; i < 32; ++i) { const float v = gv[i] + off; bp[i * GC_BST] = v; gp[(size_t)i * 256] = v; }
      if (gt) P.glad_()[((size_t)((b * 64 + n) * 4 + gh)) * 64 + gd] = __expf(gv[31] + off); }
    __syncthreads();
#pragma unroll
    for (int hv = 0; hv < 4; ++hv) { const float* br = b_s + (hv * 64 + ks_) * GC_BST + kc; const float* bl = b_s + (hv * 64 + 63) * GC_BST + kc;
        const f32x4 b0 = *(const f32x4*)br, b1 = *(const f32x4*)(br + 4), l0 = *(const f32x4*)bl, l1 = *(const f32x4*)(bl + 4);
        float e[8];
#pragma unroll
        for (int j = 0; j < 8; ++j) e[j] = bf2f((bf16_t)kraw[hv][j]) * __expf((j < 4 ? l0[j] : l1[j - 4]) - (j < 4 ? b0[j] : b1[j - 4]));
        u32x4 w = {att::cvtpk(e[0], e[1]), att::cvtpk(e[2], e[3]), att::cvtpk(e[4], e[5]), att::cvtpk(e[6], e[7])};
        *(u32x4*)(K_s + hv * 16384 + att::v_st(ks_, kc)) = w; }
    __syncthreads();
    { const int vst0 = att::v_st(sr, sc), vst1 = att::v_st(32 + sr, sc);
#pragma unroll
      for (int hv = 0; hv < 4; ++hv) { *(bf16x8*)(V_s + hv * 16384 + vst0) = vs[hv][0]; *(bf16x8*)(V_s + hv * 16384 + vst1) = vs[hv][1]; } }
    __syncthreads();
    const int vb = (int)(uintptr_t)(V_s + h * 16384) + att::v_rd_base(lane), kb = (int)(uintptr_t)(K_s + h * 16384) + att::v_rd_base(lane);
    f32x16 acc[2][2] = {};
    asm volatile("" : "+v"(acc[0][0]), "+v"(acc[0][1]), "+v"(acc[1][0]), "+v"(acc[1][1]));
#define GA_PK(L, H) (bf16x8){L[0], L[1], L[2], L[3], H[0], H[1], H[2], H[3]}
#define GA_STEP(KS) do { \
    const s16x4 k0l = att::tr_read<att::v_rd_off(0, KS, 0)>(kb), k0h = att::tr_read<att::v_rd_off(0, KS, 1)>(kb), k1l = att::tr_read<att::v_rd_off(1, KS, 0)>(kb), k1h = att::tr_read<att::v_rd_off(1, KS, 1)>(kb); \
    s16x4 v0l, v0h, v1l, v1h; \
    if (eh == 0) { v0l = att::tr_read<att::v_rd_off(0, KS, 0)>(vb); v0h = att::tr_read<att::v_rd_off(0, KS, 1)>(vb); v1l = att::tr_read<att::v_rd_off(1, KS, 0)>(vb); v1h = att::tr_read<att::v_rd_off(1, KS, 1)>(vb); } \
    else         { v0l = att::tr_read<att::v_rd_off(2, KS, 0)>(vb); v0h = att::tr_read<att::v_rd_off(2, KS, 1)>(vb); v1l = att::tr_read<att::v_rd_off(3, KS, 0)>(vb); v1h = att::tr_read<att::v_rd_off(3, KS, 1)>(vb); } \
    asm volatile("s_waitcnt lgkmcnt(0)" ::: "memory"); __builtin_amdgcn_sched_barrier(0); \
    acc[0][0] = __builtin_amdgcn_mfma_f32_32x32x16_bf16(GA_PK(v0l, v0h), GA_PK(k0l, k0h), acc[0][0], 0, 0, 0); \
    acc[0][1] = __builtin_amdgcn_mfma_f32_32x32x16_bf16(GA_PK(v0l, v0h), GA_PK(k1l, k1h), acc[0][1], 0, 0, 0); \
    acc[1][0] = __builtin_amdgcn_mfma_f32_32x32x16_bf16(GA_PK(v1l, v1h), GA_PK(k0l, k0h), acc[1][0], 0, 0, 0); \
    acc[1][1] = __builtin_amdgcn_mfma_f32_32x32x16_bf16(GA_PK(v1l, v1h), GA_PK(k1l, k1h), acc[1][1], 0, 0, 0); } while (0)
    GA_STEP(0); GA_STEP(1); GA_STEP(2); GA_STEP(3);
#undef GA_STEP
#undef GA_PK
    float* dst = P.glas_() + ((size_t)((b * 64 + n) * 4 + h)) * 8192;
#pragma unroll
    for (int et = 0; et < 2; ++et)
#pragma unroll
        for (int dt = 0; dt < 2; ++dt)
#pragma unroll
            for (int r = 0; r < 16; ++r) dst[((eh * 2 + et) * 32 + att::crow(r, hi)) * 64 + dt * 32 + r32] = acc[et][dt][r];
    __syncthreads();
}

__device__ __forceinline__ void gla_scan_slice(const Params& P, int idx) {
    {
        const int el = idx & 8191, d = idx & 63, h = (idx >> 13) & 3, b = idx >> 15;
        bf16_t* gst = P.ocat_();
        float S = 0.f;
        for (int n0 = 0; n0 < 64; n0 += 8) {
            float ds[8], dc[8];
#pragma unroll
            for (int i = 0; i < 8; ++i) { const size_t cu = (size_t)((b * 64 + n0 + i) * 4 + h); ds[i] = P.glas_()[cu * 8192 + el]; dc[i] = P.glad_()[cu * 64 + d]; }
#pragma unroll
            for (int i = 0; i < 8; ++i) { const size_t cu = (size_t)((b * 64 + n0 + i) * 4 + h); gst[cu * 8192 + el] = f2bf(S); S = fmaf(dc[i], S, ds[i]); }
        }
    }
}

__device__ __forceinline__ void unit_gla_c4(const Params& P, int layer, int ub, char* lds) {
    const int b = ub >> 6, n = ub & 63, tok0 = b * SEQ + n * 64;
    const int tid = TIDX(), wid = tid >> 6, lane = tid & 63, r32 = lane & 31, hi = lane >> 5, h = wid >> 1, rh = wid & 1;
    float* b_s = (float*)lds;
    char* V_s = lds + GC_B_BYTES;
    __syncthreads();
    const bf16_t* prow = P.p_() + (size_t)tok0 * NPAD;
    bf16x8 qraw[4], kraw[2][4], vs[4][2];
    const int sr = tid >> 4, sc = (tid & 15) * 8;
#pragma unroll
    for (int hv = 0; hv < 4; ++hv) { vs[hv][0] = *(const bf16x8*)(prow + (size_t)sr * NPAD + C_GV + hv * 128 + sc); vs[hv][1] = *(const bf16x8*)(prow + (size_t)(32 + sr) * NPAD + C_GV + hv * 128 + sc); }
    f32x4 braw[8];
    { const float* gp = gla_gb(P) + (size_t)tok0 * 256 + tid * 4;
#pragma unroll
      for (int i = 0; i < 8; ++i) braw[i] = *(const f32x4*)(gp + i * 2048); }
    { const bf16_t* qp = prow + (size_t)(rh * 32 + r32) * NPAD + C_GQ + h * 64 + hi * 8;
#pragma unroll
      for (int d0 = 0; d0 < 4; ++d0) qraw[d0] = *(const bf16x8*)(qp + d0 * 16);
#pragma unroll
      for (int sh = 0; sh < 2; ++sh) { const bf16_t* kp = prow + (size_t)(sh * 32 + r32) * NPAD + C_GK + h * 64 + hi * 8;
#pragma unroll
          for (int d0 = 0; d0 < 4; ++d0) kraw[sh][d0] = *(const bf16x8*)(kp + d0 * 16); } }
    bf16x8 sfr[4][4];
    { const bf16_t* sp = P.ocat_() + ((size_t)((b * 64 + n) * 4 + h)) * 8192 + r32 * 64 + hi * 8;
#pragma unroll
      for (int eb = 0; eb < 4; ++eb)
#pragma unroll
          for (int ds = 0; ds < 4; ++ds) sfr[eb][ds] = *(const bf16x8*)(sp + eb * 32 * 64 + ds * 16); }
    { const int vst0 = att::v_st(sr, sc), vst1 = att::v_st(32 + sr, sc);
#pragma unroll
      for (int hv = 0; hv < 4; ++hv) { *(bf16x8*)(V_s + hv * 16384 + vst0) = vs[hv][0]; *(bf16x8*)(V_s + hv * 16384 + vst1) = vs[hv][1]; } }
#pragma unroll
    for (int i = 0; i < 8; ++i) { const int c = tid + 512 * i, t = c >> 6, c4 = c & 63;
        *(f32x4*)(b_s + ((c4 >> 4) * 64 + t) * GC_BST + (c4 & 15) * 4) = braw[i]; }
    __syncthreads();
    const float* bh = b_s + h * 64 * GC_BST + hi * 8;
    bf16x8 qe[4], qb[4], ke[2][4];
#pragma unroll
    for (int d0 = 0; d0 < 4; ++d0) {
        const f32x4 m0 = *(const f32x4*)(bh + 32 * GC_BST + d0 * 16), m1 = *(const f32x4*)(bh + 32 * GC_BST + d0 * 16 + 4);
        const f32x4 q0 = *(const f32x4*)(bh + (rh * 32 + r32) * GC_BST + d0 * 16), q1 = *(const f32x4*)(bh + (rh * 32 + r32) * GC_BST + d0 * 16 + 4);
        float e1[8], e2[8];
#pragma unroll
        for (int j = 0; j < 8; ++j) { const float mv = j < 4 ? m0[j] : m1[j - 4], bq = j < 4 ? q0[j] : q1[j - 4]; const float q = bf2f((bf16_t)qraw[d0][j]) * 0.125f;
            e1[j] = q * __expf(bq - mv); e2[j] = q * __expf(bq); }
        { u32x4 w = {att::cvtpk(e1[0], e1[1]), att::cvtpk(e1[2], e1[3]), att::cvtpk(e1[4], e1[5]), att::cvtpk(e1[6], e1[7])}; qe[d0] = *reinterpret_cast<bf16x8*>(&w); }
        { u32x4 w = {att::cvtpk(e2[0], e2[1]), att::cvtpk(e2[2], e2[3]), att::cvtpk(e2[4], e2[5]), att::cvtpk(e2[6], e2[7])}; qb[d0] = *reinterpret_cast<bf16x8*>(&w); }
#pragma unroll
        for (int sh = 0; sh < 2; ++sh) {
            const f32x4 k0 = *(const f32x4*)(bh + (sh * 32 + r32) * GC_BST + d0 * 16), k1 = *(const f32x4*)(bh + (sh * 32 + r32) * GC_BST + d0 * 16 + 4);
            float e3[8];
#pragma unroll
            for (int j = 0; j < 8; ++j) { const float mv = j < 4 ? m0[j] : m1[j - 4], bk = j < 4 ? k0[j] : k1[j - 4]; e3[j] = bf2f((bf16_t)kraw[sh][d0][j]) * __expf(mv - bk); }
            u32x4 w = {att::cvtpk(e3[0], e3[1]), att::cvtpk(e3[2], e3[3]), att::cvtpk(e3[4], e3[5]), att::cvtpk(e3[6], e3[7])}; ke[sh][d0] = *reinterpret_cast<bf16x8*>(&w); }
    }
    f32x16 p0 = {}, p1 = {};
    asm volatile("" : "+v"(p0), "+v"(p1));
#pragma unroll
    for (int d0 = 0; d0 < 4; ++d0) { p0 = __builtin_amdgcn_mfma_f32_32x32x16_bf16(ke[0][d0], qe[d0], p0, 0, 0, 0); p1 = __builtin_amdgcn_mfma_f32_32x32x16_bf16(ke[1][d0], qe[d0], p1, 0, 0, 0); }
    { const int t = rh * 32 + r32;
#pragma unroll
      for (int r = 0; r < 16; ++r) { const int s0 = att::crow(r, hi); p0[r] = (s0 <= t) ? p0[r] : 0.f; p1[r] = (32 + s0 <= t) ? p1[r] : 0.f; } }
    bf16x8 pa0, pa1, pa2, pa3;
#define GC_PK4(Pv, BASE, OUT) do { unsigned a0 = att::cvtpk(Pv[BASE + 0], Pv[BASE + 1]), a1 = att::cvtpk(Pv[BASE + 2], Pv[BASE + 3]);   \
    unsigned b0 = att::cvtpk(Pv[BASE + 4], Pv[BASE + 5]), b1 = att::cvtpk(Pv[BASE + 6], Pv[BASE + 7]);                              \
    auto r0 = __builtin_amdgcn_permlane32_swap(a0, b0, false, false); auto r1 = __builtin_amdgcn_permlane32_swap(a1, b1, false, false); \
    u32x4 w = {r0[0], r1[0], r0[1], r1[1]}; OUT = *reinterpret_cast<bf16x8*>(&w); } while (0)
    GC_PK4(p0, 0, pa0); GC_PK4(p0, 8, pa1); GC_PK4(p1, 0, pa2); GC_PK4(p1, 8, pa3);
#undef GC_PK4
    f32x16 o[4] = {};
    asm volatile("" : "+v"(o[0]), "+v"(o[1]), "+v"(o[2]), "+v"(o[3]));
    att::pv_d0(o, (int)(uintptr_t)(V_s + h * 16384) + att::v_rd_base(lane), pa0, pa1, pa2, pa3);
#pragma unroll
    for (int eb = 0; eb < 4; ++eb)
#pragma unroll
        for (int ds = 0; ds < 4; ++ds) o[eb] = __builtin_amdgcn_mfma_f32_32x32x16_bf16(qb[ds], sfr[eb][ds], o[eb], 0, 0, 0);
    u32x4 zr[8];
#pragma unroll
    for (int i = 0; i < 8; ++i) zr[i] = *(const u32x4*)(P.p_() + (size_t)(tok0 + rh * 32 + 4 * i + (lane >> 4)) * NPAD + C_GZ + h * 128 + 8 * (lane & 15));
    __syncthreads();
    float* og_s = (float*)lds + wid * (32 * 132);
#pragma unroll
    for (int r = 0; r < 16; ++r) {
#pragma unroll
        for (int eb = 0; eb < 4; ++eb) og_s[att::crow(r, hi) * 132 + eb * 32 + r32] = o[eb][r]; }
    asm volatile("" ::: "memory");
    { const int row = lane >> 1, half = lane & 1; const float* src = og_s + row * 132 + half * 64;
      float ss = 0.f;
#pragma unroll
      for (int i = 0; i < 16; ++i) { const f32x4 v = *(const f32x4*)(src + 4 * i); ss += v[0] * v[0] + v[1] * v[1] + v[2] * v[2] + v[3] * v[3]; }
      ss += shx(ss, 1);
      if (half == 0) og_s[row * 132 + 128] = rsqrtf(ss * (1.f / 128.f) + EPS); }
    asm volatile("s_waitcnt lgkmcnt(0)" ::: "memory");
#pragma unroll
    for (int i = 0; i < 8; ++i) { const int row = 4 * i + (lane >> 4), c8 = 8 * (lane & 15); const float* src = og_s + row * 132 + c8;
      const f32x4 a = *(const f32x4*)src, b2 = *(const f32x4*)(src + 4); const float rn = og_s[row * 132 + 128];
      float z[8], gg[8];
      z[0] = __uint_as_float(zr[i].x << 16); z[1] = __uint_as_float(zr[i].x & 0xffff0000u); z[2] = __uint_as_float(zr[i].y << 16); z[3] = __uint_as_float(zr[i].y & 0xffff0000u);
      z[4] = __uint_as_float(zr[i].z << 16); z[5] = __uint_as_float(zr[i].z & 0xffff0000u); z[6] = __uint_as_float(zr[i].w << 16); z[7] = __uint_as_float(zr[i].w & 0xffff0000u);
#pragma unroll
      for (int q = 0; q < 4; ++q) { gg[q] = a[q] * rn * siluf_(z[q]); gg[4 + q] = b2[q] * rn * siluf_(z[4 + q]); }
      st8f(P.xn_() + (size_t)(tok0 + rh * 32 + row) * MIX + h * 128 + c8, gg); }
    __syncthreads();
}
constexpr int S5P_STRIDE = 2304;
__device__ __forceinline__ void phase_s5_params(const Params& P) {
    for (int idx = blockIdx.x * NTHR + TIDX(); idx < DEPTH * 32 * 64; idx += gridDim.x * NTHR) {
        const int p = idx & 63, lg = idx >> 6;
        const float ar = P.s5_a_re[idx], ai = P.s5_a_im[idx], step = expf(P.s5_log_step[lg]);
        const float mag = expf(ar * step), th = ai * step;
        const float lr = mag * cosf(th), li = mag * sinf(th);
        float* o = P.s5p_() + (size_t)lg * S5P_STRIDE;
        o[2 * p] = lr; o[2 * p + 1] = li;
        { const float mag512 = expf(512.f * ar * step); const double a = 512.0 * (double)th; const double k = rint(a * 0.15915494309189535); const float rf = (float)fma(-k, 6.283185307179586, a);
          o[128 + 2 * p] = mag512 * cosf(rf); o[128 + 2 * p + 1] = mag512 * sinf(rf); }
        const float xr = lr - 1.f, xi = li, den = 1.f / (ar * ar + ai * ai);
        const float fr = (xr * ar + xi * ai) * den, fi = (xi * ar - xr * ai) * den;
        for (int c = 0; c < 16; ++c) { const float br = P.s5_b_re[(size_t)idx * 16 + c], bi = P.s5_b_im[(size_t)idx * 16 + c];
            o[256 + (p * 16 + c) * 2] = fr * br - fi * bi; o[256 + (p * 16 + c) * 2 + 1] = fr * bi + fi * br; }
    }
}
__device__ __forceinline__ float gelu_tanh_(float x) { const float u = 0.7978845608028654f * (x + 0.044715f * x * x * x); const float e = __expf(-2.f * fabsf(u)); const float th = copysignf((1.f - e) * __builtin_amdgcn_rcpf(1.f + e), u); return 0.5f * x * (1.f + th); }

constexpr int S5_XST = 272;
constexpr int S5_UST = 48;
__device__ __forceinline__ float partner32(float v, int hi) { auto rr = __builtin_amdgcn_permlane32_swap(__float_as_uint(v), __float_as_uint(v), false, false); return __uint_as_float(hi ? rr[0] : rr[1]); }
struct S5Ctx { float l0r, l0i, l1r, l1i, q0r, q0i, q1r, q1i, dsk; char* Cm; char* Bb; char* Xs; char* Us; int lane, hi, j, rho; const bf16_t* ubase; bf16_t* ybase; };
template <bool OUT> __device__ __forceinline__ void s5_tile(const S5Ctx& C, int tok0, float& x0r, float& x0i, float& x1r, float& x1i) {
    const int hi = C.hi, j = C.j, lane = C.lane;
    if (hi == 0) { const bf16_t* up = C.ubase + (size_t)(tok0 + j) * NPAD;
        const bf16x8 w0 = *(const bf16x8*)up, w1 = *(const bf16x8*)(up + 8);
        *(bf16x8*)(C.Us + C.rho * S5_UST) = w0; *(bf16x8*)(C.Us + C.rho * S5_UST + 16) = w1; }
    asm volatile("" ::: "memory");
    f32x16 a0 = {}, a1 = {}, a2 = {}, a3 = {};
    mma_tile(a0, C.Us, S5_UST, C.Bb, S5_UST, 16, lane); mma_tile(a1, C.Us, S5_UST, C.Bb + 32 * S5_UST, S5_UST, 16, lane);
    mma_tile(a2, C.Us, S5_UST, C.Bb + 64 * S5_UST, S5_UST, 16, lane); mma_tile(a3, C.Us, S5_UST, C.Bb + 96 * S5_UST, S5_UST, 16, lane);
    float s0r[16], s0i[16], s1r[16], s1i[16];
#pragma unroll
    for (int r = 0; r < 16; ++r) {
        const float n0r = fmaf(C.l0r, x0r, fmaf(-C.l0i, x0i, a0[r])), n0i = fmaf(C.l0r, x0i, fmaf(C.l0i, x0r, a1[r])); x0r = n0r; x0i = n0i; s0r[r] = n0r; s0i[r] = n0i;
        const float n1r = fmaf(C.l1r, x1r, fmaf(-C.l1i, x1i, a2[r])), n1i = fmaf(C.l1r, x1i, fmaf(C.l1i, x1r, a3[r])); x1r = n1r; x1i = n1i; s1r[r] = n1r; s1i[r] = n1i; }
    float z0r = partner32(x0r, hi), z0i = partner32(x0i, hi), z1r = partner32(x1r, hi), z1i = partner32(x1i, hi);
    if (hi == 0) { z0r = 0.f; z0i = 0.f; z1r = 0.f; z1i = 0.f; }
    if (!OUT) {
        x0r += C.q0r * z0r - C.q0i * z0i; x0i += C.q0r * z0i + C.q0i * z0r; x1r += C.q1r * z1r - C.q1i * z1i; x1i += C.q1r * z1i + C.q1i * z1r;
    } else {
#pragma unroll
        for (int r = 0; r < 16; ++r) {
            const float t0r = C.l0r * z0r - C.l0i * z0i, t0i = C.l0r * z0i + C.l0i * z0r; z0r = t0r; z0i = t0i; s0r[r] += t0r; s0i[r] += t0i;
            const float t1r = C.l1r * z1r - C.l1i * z1i, t1i = C.l1r * z1i + C.l1i * z1r; z1r = t1r; z1i = t1i; s1r[r] += t1r; s1i[r] += t1i; }
        x0r = s0r[15]; x0i = s0i[15]; x1r = s1r[15]; x1i = s1i[15];
#pragma unroll
        for (int r = 0; r < 16; ++r) { char* xr_ = C.Xs + (r + 16 * hi) * S5_XST;
            *(bf16_t*)(xr_ + j * 2) = f2bf(s0r[r]); *(bf16_t*)(xr_ + (64 + j) * 2) = f2bf(s0i[r]);
            *(bf16_t*)(xr_ + (32 + j) * 2) = f2bf(s1r[r]); *(bf16_t*)(xr_ + (96 + j) * 2) = f2bf(s1i[r]); }
        asm volatile("" ::: "memory");
        f32x16 acc = {}; mma_tile(acc, C.Xs, S5_XST, C.Cm, S5_XST, 128, lane);
        if (j < 16) {
#pragma unroll
            for (int r = 0; r < 16; ++r) { const int t = crow32(r, hi); const int rt = ((t & 15) & 3) + 8 * ((t & 15) >> 2) + 4 * (t >> 4);
                const float y = acc[r] + C.dsk * bf2f(*(const bf16_t*)(C.Us + rt * S5_UST + j * 2));
                C.ybase[(size_t)(tok0 + t) * 512 + j] = f2bf(gelu_tanh_(y)); } }
        asm volatile("" ::: "memory");
    }
    { const float e0r = partner32(x0r, hi), e0i = partner32(x0i, hi), e1r = partner32(x1r, hi), e1i = partner32(x1i, hi);
      if (hi == 0) { x0r = e0r; x0i = e0i; x1r = e1r; x1i = e1i; } else { x0r = 0.f; x0i = 0.f; x1r = 0.f; x1i = 0.f; } }
}
__device__ __forceinline__ void unit_s5(const Params& P, int layer, int u, char* lds) {
    const int b = u >> 5, g = u & 31, tid = TIDX(), wid = tid >> 6, lane = tid & 63, hi = lane >> 5, j = lane & 31;
    char* Cm = lds;
    char* Bb = Cm + 32 * S5_XST;
    float* ends = (float*)(Bb + 128 * S5_UST);
    char* wbase = (char*)(ends + 8 * 64 * 2) + wid * (32 * S5_XST + 32 * S5_UST);
    const float* sp = P.s5p_() + (size_t)(layer * 32 + g) * S5P_STRIDE;
    __syncthreads();
    for (int i = tid; i < 32 * 128; i += NTHR) { const int c = i >> 7, pp = i & 127; float v = 0.f;
        if (c < 16) v = (pp < 64) ? P.s5_c_re[((size_t)(layer * 32 + g) * 16 + c) * 64 + pp] : -P.s5_c_im[((size_t)(layer * 32 + g) * 16 + c) * 64 + (pp - 64)];
        *(bf16_t*)(Cm + c * S5_XST + pp * 2) = f2bf(v); }
    for (int i = tid; i < 128 * 16; i += NTHR) { const int n = i >> 4, c = i & 15, nt = n >> 5, jj = n & 31, p = (nt >> 1) * 32 + jj;
        *(bf16_t*)(Bb + n * S5_UST + c * 2) = f2bf(sp[256 + (p * 16 + c) * 2 + (nt & 1)]); }
    S5Ctx C; C.Cm = Cm; C.Bb = Bb; C.Xs = wbase; C.Us = wbase + 32 * S5_XST; C.lane = lane; C.hi = hi; C.j = j;
    C.l0r = sp[2 * j]; C.l0i = sp[2 * j + 1]; C.l1r = sp[2 * (32 + j)]; C.l1i = sp[2 * (32 + j) + 1];
    { float q0r = C.l0r, q0i = C.l0i, q1r = C.l1r, q1i = C.l1i;
#pragma unroll
      for (int k = 0; k < 4; ++k) { const float a = q0r * q0r - q0i * q0i, bb = (q0r + q0r) * q0i; q0r = a; q0i = bb; const float c = q1r * q1r - q1i * q1i, d = (q1r + q1r) * q1i; q1r = c; q1i = d; }
      C.q0r = q0r; C.q0i = q0i; C.q1r = q1r; C.q1i = q1i; }
    C.dsk = P.s5_d[layer * 512 + g * 16 + (lane & 15)];
    C.rho = ((j & 15) & 3) + 8 * ((j & 15) >> 2) + 4 * (j >> 4);
    const int tokw = b * SEQ + wid * 512;
    C.ubase = P.p_() + C_SU + g * 16; C.ybase = P.ybuf_() + g * 16;
    float x0r = 0.f, x0i = 0.f, x1r = 0.f, x1i = 0.f;
    __syncthreads();
    for (int sc = 0; sc < 16; ++sc) s5_tile<false>(C, tokw + sc * 32, x0r, x0i, x1r, x1i);
    if (hi == 0) { ends[(wid * 64 + j) * 2] = x0r; ends[(wid * 64 + j) * 2 + 1] = x0i; ends[(wid * 64 + 32 + j) * 2] = x1r; ends[(wid * 64 + 32 + j) * 2 + 1] = x1i; }
    __syncthreads();
    { const float p0r = sp[128 + 2 * j], p0i = sp[128 + 2 * j + 1], p1r = sp[128 + 2 * (32 + j)], p1i = sp[128 + 2 * (32 + j) + 1];
      x0r = 0.f; x0i = 0.f; x1r = 0.f; x1i = 0.f;
      for (int w = 0; w < wid; ++w) { const float e0r = ends[(w * 64 + j) * 2], e0i = ends[(w * 64 + j) * 2 + 1], e1r = ends[(w * 64 + 32 + j) * 2], e1i = ends[(w * 64 + 32 + j) * 2 + 1];
          const float n0r = p0r * x0r - p0i * x0i + e0r, n0i = p0r * x0i + p0i * x0r + e0i, n1r = p1r * x1r - p1i * x1i + e1r, n1i = p1r * x1i + p1i * x1r + e1i;
          x0r = n0r; x0i = n0i; x1r = n1r; x1i = n1i; }
      if (hi) { x0r = 0.f; x0i = 0.f; x1r = 0.f; x1i = 0.f; } }
    for (int sc = 0; sc < 16; ++sc) s5_tile<true>(C, tokw + sc * 32, x0r, x0i, x1r, x1i);
}
constexpr int TOPK = 256;
__device__ __forceinline__ unsigned f2key(float f) { const unsigned u = __float_as_uint(f); return u ^ ((u & 0x80000000u) ? 0xffffffffu : 0x80000000u); }

__device__ __forceinline__ float relu1(float x) { const int b = __float_as_int(x); return __int_as_float(b > 0 ? b : 0); }
#define DSA_MM(acc, rt, kk) acc = __builtin_amdgcn_mfma_f32_32x32x16_bf16(afr[rt][kk], bfr[kk], acc, 0, 0, 0)
#define DSA_HS(acc, rt, q) do { s0 = fmaf(relu1(acc[4 * (q)]), wv[rt][4 * (q)], s0); s1 = fmaf(relu1(acc[4 * (q) + 1]), wv[rt][4 * (q) + 1], s1); \
                                s0 = fmaf(relu1(acc[4 * (q) + 2]), wv[rt][4 * (q) + 2], s0); s1 = fmaf(relu1(acc[4 * (q) + 3]), wv[rt][4 * (q) + 3], s1); } while (0)
#define DSA_SG() __builtin_amdgcn_sched_barrier(0)
__device__ __forceinline__ void dsa_score_tile(const bf16x8 (&afr)[4][4], const f32x16 (&wv)[4], const bf16x8 (&bfr)[4], float* sc, int col, int hi) {
    const f32x16 z16 = {};
#define DSA_M0(acc, rt) acc = __builtin_amdgcn_mfma_f32_32x32x16_bf16(afr[rt][0], bfr[0], z16, 0, 0, 0)
    f32x16 accA, accB;
    float s0, s1;
    DSA_M0(accA, 0); DSA_MM(accA, 0, 1); DSA_MM(accA, 0, 2); DSA_MM(accA, 0, 3);
    s0 = 0.f; s1 = 0.f;
    DSA_M0(accB, 1); DSA_HS(accA, 0, 0); DSA_SG(); DSA_MM(accB, 1, 1); DSA_HS(accA, 0, 1); DSA_SG();
    DSA_MM(accB, 1, 2); DSA_HS(accA, 0, 2); DSA_SG(); DSA_MM(accB, 1, 3); DSA_HS(accA, 0, 3); DSA_SG();
    sc[(0 + hi) * 4096 + col] = (s0 + s1) + 0.f;
    s0 = 0.f; s1 = 0.f;
    DSA_M0(accA, 2); DSA_HS(accB, 1, 0); DSA_SG(); DSA_MM(accA, 2, 1); DSA_HS(accB, 1, 1); DSA_SG();
    DSA_MM(accA, 2, 2); DSA_HS(accB, 1, 2); DSA_SG(); DSA_MM(accA, 2, 3); DSA_HS(accB, 1, 3); DSA_SG();
    sc[(2 + hi) * 4096 + col] = (s0 + s1) + 0.f;
    s0 = 0.f; s1 = 0.f;
    DSA_M0(accB, 3); DSA_HS(accA, 2, 0); DSA_SG(); DSA_MM(accB, 3, 1); DSA_HS(accA, 2, 1); DSA_SG();
    DSA_MM(accB, 3, 2); DSA_HS(accA, 2, 2); DSA_SG(); DSA_MM(accB, 3, 3); DSA_HS(accA, 2, 3); DSA_SG();
    asm volatile("" :: "v"(bfr[0]), "v"(bfr[1]), "v"(bfr[2]), "v"(bfr[3]));
    sc[(4 + hi) * 4096 + col] = (s0 + s1) + 0.f;
    s0 = 0.f; s1 = 0.f;
    DSA_HS(accB, 3, 0); DSA_HS(accB, 3, 1); DSA_HS(accB, 3, 2); DSA_HS(accB, 3, 3);
    sc[(6 + hi) * 4096 + col] = (s0 + s1) + 0.f;
#undef DSA_M0
}
#define DSA_CNT4(K0, K1, K2, K3) asm volatile( \
    "v_cmp_ge_u32_e64 %[m0], %[k0], %[cd]\n\tv_cmp_ge_u32_e64 %[m1], %[k1], %[cd]\n\tv_cmp_ge_u32_e64 %[m2], %[k2], %[cd]\n\tv_cmp_ge_u32_e64 %[m3], %[k3], %[cd]\n\t" \
    "v_addc_co_u32_e64 %[a0], %[m0], %[a0], 0, %[m0]\n\tv_addc_co_u32_e64 %[a1], %[m1], %[a1], 0, %[m1]\n\t" \
    "v_addc_co_u32_e64 %[a0], %[m2], %[a0], 0, %[m2]\n\tv_addc_co_u32_e64 %[a1], %[m3], %[a1], 0, %[m3]" \
    : [a0] "+v"(c0), [a1] "+v"(c1), [m0] "=&s"(sm0), [m1] "=&s"(sm1), [m2] "=&s"(sm2), [m3] "=&s"(sm3) \
    : [k0] "v"(K0), [k1] "v"(K1), [k2] "v"(K2), [k3] "v"(K3), [cd] "v"(cand))
#define DSA_CNT8(J0) do { DSA_CNT4(key[(J0)], key[(J0) + 1], key[(J0) + 2], key[(J0) + 3]); DSA_CNT4(key[(J0) + 4], key[(J0) + 5], key[(J0) + 6], key[(J0) + 7]); } while (0)

template <int J, int JEND> __device__ __forceinline__ void dsa_emit(const unsigned (&key)[64], unsigned T, unsigned& wlo, unsigned& whi) {
    const unsigned long long m = __ballot(key[J] >= T);
    asm("s_nop 1\n\tv_writelane_b32 %0, %2, %4\n\tv_writelane_b32 %1, %3, %4" : "+v"(wlo), "+v"(whi) : "s"((unsigned)m), "s"((unsigned)(m >> 32)), "n"(J));
    if constexpr (J + 1 < JEND) dsa_emit<J + 1, JEND>(key, T, wlo, whi);
}
__device__ __forceinline__ void unit_dsa_index(const Params& P, int u, char* lds) {
    const int b = u & 3, t0 = (511 - (u >> 2)) * 8;
    const int tid = TIDX(), wid = tid >> 6, lane = tid & 63, r32 = lane & 31, hi = lane >> 5;
    float* sc = (float*)lds;
    const bf16_t* pb = P.p_() + (size_t)b * SEQ * NPAD;
    __syncthreads();
    TPU_START(101); TPU_START(110);
    {
        bf16x8 afr[4][4]; f32x16 wv[4];
        const int qsel = (r32 >> 2) & 1, head = (r32 & 3) + 4 * (r32 >> 3);
        char* qs = lds;
        const int ntile = (t0 + 7) / 32 + 1;
        const bf16_t* kp = P.ikc_() + (size_t)(b * (SEQ / 32)) * 2048 + lane * 8;
        bf16x8 b0[4], b1[4], b2[4];
#define DSA_LDB(dst, K) do { const bf16_t* kq_ = kp + (size_t)(wid + 8 * (K)) * 2048; _Pragma("unroll") for (int kk = 0; kk < 4; ++kk) dst[kk] = *(const bf16x8*)(kq_ + kk * 512); } while (0)
#define DSA_TILE(buf, K) dsa_score_tile(afr, wv, buf, sc, (wid + 8 * (K)) * 32 + r32, hi)
        const int nk = (ntile - wid + 7) >> 3;
        const int kl = nk > 0 ? nk - 1 : 0;
#define DSA_MIN(a) ((a) < kl ? (a) : kl)
        const int tk = tid >> 6, hd = (tid & 63) >> 2, dm = (tid & 3) * 16;
        const bf16_t* qsrc = pb + (size_t)(t0 + tk) * NPAD + C_DIQ + hd * 64 + dm;
        const u32x4 qa = *(const u32x4*)qsrc, qb2 = *(const u32x4*)(qsrc + 8);
#pragma unroll
        for (int rt = 0; rt < 4; ++rt) { const float* wp = P.iw_() + (size_t)(b * SEQ + t0 + 2 * rt + hi) * 16;
#pragma unroll
            for (int i = 0; i < 4; ++i) { const f32x4 w4 = *(const f32x4*)(wp + 4 * i); wv[rt][4 * i] = w4[0]; wv[rt][4 * i + 1] = w4[1]; wv[rt][4 * i + 2] = w4[2]; wv[rt][4 * i + 3] = w4[3]; } }
        DSA_LDB(b0, DSA_MIN(0)); DSA_LDB(b1, DSA_MIN(1));
        { char* dst = qs + tk * 2432 + hd * 144 + dm * 2; *(u32x4*)dst = qa; *(u32x4*)(dst + 16) = qb2; }
        __syncthreads();
#pragma unroll
        for (int rt = 0; rt < 4; ++rt) { const char* qp = qs + (2 * rt + qsel) * 2432 + head * 144 + hi * 16;
#pragma unroll
            for (int kk = 0; kk < 4; ++kk) afr[rt][kk] = *(const bf16x8*)(qp + kk * 32); }
        asm volatile("s_waitcnt lgkmcnt(0)" ::: "memory"); __syncthreads();
#if TPROBE == 110
        TPU_STOP(110);
#endif
#if TPROBE == 103
        TPU_START(103); asm volatile("s_waitcnt vmcnt(0)" ::: "memory"); TPU_STOP(103);
#endif
#if TPROBE == 104
        asm volatile("s_waitcnt vmcnt(0)" ::: "memory"); TPU_START(104);
#endif
        int k = 0;
        for (; k + 3 <= nk; k += 3) {
            DSA_LDB(b2, k + 2); DSA_TILE(b0, k);
            DSA_LDB(b0, DSA_MIN(k + 3)); DSA_TILE(b1, k + 1);
            DSA_LDB(b1, DSA_MIN(k + 4)); DSA_TILE(b2, k + 2);
        }
        if (k < nk) DSA_TILE(b0, k);
        if (k + 1 < nk) DSA_TILE(b1, k + 1);
#if TPROBE == 104
        asm volatile("s_waitcnt lgkmcnt(0)" ::: "memory"); TPU_STOP(104);
#endif
        TPU_START(111);
#undef DSA_TILE
#undef DSA_MIN
#undef DSA_TILE
#undef DSA_LDB
    }
    __syncthreads();
    TPU_STOP(111);
    TPU_STOP(101); TPU_START(102);
    {
        const int t = t0 + wid; const float* srow = sc + wid * 4096;
        unsigned key[64];
        {
            const int gfull = (t + 1) >> 9, gany = t / 512 + 1;
#pragma unroll
            for (int g = 0; g < 8; ++g) {
                if (g < gfull) {
#pragma unroll
                    for (int jj = 0; jj < 8; ++jj) key[8 * g + jj] = f2key(srow[(8 * g + jj) * 64 + lane]);
                } else if (g < gany) {
#pragma unroll
                    for (int jj = 0; jj < 8; ++jj) { const int s = (8 * g + jj) * 64 + lane; key[8 * g + jj] = (s <= t) ? f2key(srow[s]) : 0u; }
                } else {
#pragma unroll
                    for (int jj = 0; jj < 8; ++jj) key[8 * g + jj] = 0u;
                }
            }
        }
        unsigned long long* mout = P.mask_() + (size_t)(b * SEQ + t) * 64;
        unsigned long long myword = 0ull;
        TPU_START(105); TPU_START(106); TPU_START(107); TPU_START(108); TPU_START(109);
        if (t + 1 <= TOPK) {
#pragma unroll
            for (int j = 0; j < 64; ++j) { const unsigned long long m = __ballot(j * 64 + lane <= t); if (lane == j) myword = m; }
        } else {
            const int ngrp = t / 512 + 1;
#if TPROBE == 105
            asm volatile("" :: "v"(key[0]), "v"(key[63]));
#endif
            TPU_STOP(105);
            unsigned* hist = (unsigned*)(sc + wid * 4096);
            asm volatile("" ::: "memory");
            { const u32x4 zz4 = {0u, 0u, 0u, 0u};
#pragma unroll
              for (int i = 0; i < 16; ++i) *(u32x4*)(hist + (i * 64 + lane) * 4) = zz4; }
            asm volatile("" ::: "memory");
#define DSA_H8(J0) do { _Pragma("unroll") for (int jj = 0; jj < 8; ++jj) atomicAdd(hist + (key[(J0) + jj] >> 20), 1u); } while (0)
            DSA_H8(0);
            if (ngrp > 1) DSA_H8(8);
            if (ngrp > 2) DSA_H8(16);
            if (ngrp > 3) DSA_H8(24);
            if (ngrp > 4) DSA_H8(32);
            if (ngrp > 5) DSA_H8(40);
            if (ngrp > 6) DSA_H8(48);
            if (ngrp > 7) DSA_H8(56);
#undef DSA_H8
            asm volatile("" ::: "memory");
#if TPROBE == 106
            asm volatile("s_waitcnt lgkmcnt(0)" ::: "memory");
#endif
            TPU_STOP(106);
#define DSA_SUFFIX(s) do { _Pragma("unroll") for (int o = 1; o < 64; o <<= 1) { unsigned t_ = (unsigned)__builtin_amdgcn_ds_bpermute(((lane + o) & 63) << 2, (int)(s)); (s) += (lane + o < 64) ? t_ : 0u; } } while (0)
            unsigned mine = 0u;
#pragma unroll
            for (int i = 0; i < 16; ++i) { const u32x4 v4 = *(const u32x4*)(hist + lane * 64 + ((i + lane) & 15) * 4); mine += (v4[0] + v4[1]) + (v4[2] + v4[3]); }
            unsigned suf = mine; DSA_SUFFIX(suf);
            const unsigned long long mL = __ballot(suf - mine < (unsigned)TOPK && suf >= (unsigned)TOPK);
            const int Ls = (int)__builtin_ctzll(mL);
            const unsigned cntA = (unsigned)__builtin_amdgcn_readlane((int)(suf - mine), Ls);
            unsigned h2 = hist[Ls * 64 + lane]; unsigned suf2 = h2; DSA_SUFFIX(suf2);
            const unsigned long long mB = __ballot(cntA + suf2 - h2 < (unsigned)TOPK && cntA + suf2 >= (unsigned)TOPK);
            const int Bs = (int)__builtin_ctzll(mB);
            const unsigned bstar = (unsigned)(Ls * 64 + Bs);
            const unsigned cntAbove = cntA + (unsigned)__builtin_amdgcn_readlane((int)(suf2 - h2), Bs);
            const unsigned inbin = (unsigned)__builtin_amdgcn_readlane((int)h2, Bs);
#undef DSA_SUFFIX
            TPU_STOP(107);
            unsigned T = bstar << 20; int cntT = (int)(cntAbove + inbin);
            if (cntT != TOPK) {
                asm volatile("" ::: "memory");
                int nslot = 0;
#pragma unroll
                for (int g = 0; g < 8; ++g) { if (g < ngrp) {
#pragma unroll
                    for (int jj = 0; jj < 8; ++jj) { const int j = 8 * g + jj; if ((key[j] >> 20) == bstar) { hist[nslot * 64 + lane] = key[j]; ++nslot; } } } }
                asm volatile("" ::: "memory");
                int R = nslot;
#pragma unroll
                for (int o = 32; o >= 1; o >>= 1) { const int other = __builtin_amdgcn_ds_bpermute(((lane ^ o) << 2), R); R = other > R ? other : R; }
                R = __builtin_amdgcn_readfirstlane(R);
                if (R <= 8) {
                    unsigned c[8];
#pragma unroll
                    for (int r = 0; r < 8; ++r) c[r] = (r < nslot) ? hist[r * 64 + lane] : 0u;
                    for (int bit = 19; bit >= 0; --bit) {
                        const unsigned cand = T | (1u << bit); int cnt = (int)cntAbove;
#pragma unroll
                        for (int r = 0; r < 8; ++r) cnt += __popcll(__ballot(c[r] >= cand));
                        if (cnt >= TOPK) { T = cand; cntT = cnt; if (cnt == TOPK) break; }
                    }
                } else {
                    for (int bit = 19; bit >= 0; --bit) {
                        const unsigned cand = T | (1u << bit); unsigned c0 = 0, c1 = 0; unsigned long long sm0, sm1, sm2, sm3;
                        DSA_CNT8(0);
                        if (ngrp > 1) DSA_CNT8(8);
                        if (ngrp > 2) DSA_CNT8(16);
                        if (ngrp > 3) DSA_CNT8(24);
                        if (ngrp > 4) DSA_CNT8(32);
                        if (ngrp > 5) DSA_CNT8(40);
                        if (ngrp > 6) DSA_CNT8(48);
                        if (ngrp > 7) DSA_CNT8(56);
                        const int cl = (int)(c0 + c1);
                        int cnt = 0;
#pragma unroll
                        for (int bb = 0; bb < 7; ++bb) cnt += __popcll(__ballot((cl >> bb) & 1)) << bb;
                        if (cnt >= TOPK) { T = cand; cntT = cnt; if (cnt == TOPK) break; }
                    }
                }
            }
            TPU_STOP(108);
            if (cntT == TOPK) {
                unsigned wlo = 0u, whi = 0u;
                dsa_emit<0, 8>(key, T, wlo, whi);
                if (ngrp > 1) dsa_emit<8, 16>(key, T, wlo, whi);
                if (ngrp > 2) dsa_emit<16, 24>(key, T, wlo, whi);
                if (ngrp > 3) dsa_emit<24, 32>(key, T, wlo, whi);
                if (ngrp > 4) dsa_emit<32, 40>(key, T, wlo, whi);
                if (ngrp > 5) dsa_emit<40, 48>(key, T, wlo, whi);
                if (ngrp > 6) dsa_emit<48, 56>(key, T, wlo, whi);
                if (ngrp > 7) dsa_emit<56, 64>(key, T, wlo, whi);
                myword = ((unsigned long long)whi << 32) | wlo;
            } else {
                int ngt = 0;
#pragma unroll
                for (int j = 0; j < 64; ++j) ngt += __popcll(__ballot(key[j] > T));
                int need = TOPK - ngt;
#pragma unroll
                for (int j = 0; j < 64; ++j) { const unsigned long long eq = __ballot(key[j] == T), gt = __ballot(key[j] > T);
                    const int ne = __popcll(eq); unsigned long long take = eq;
                    if (ne > need) { take = 0ull; int left = need; unsigned long long e2 = eq;
                        while (left > 0) { const unsigned long long lowbit = e2 & (0ull - e2); take |= lowbit; e2 ^= lowbit; --left; } }
                    need -= (ne > need) ? need : ne;
                    const unsigned long long m = gt | take; if (lane == j) myword = m; }
            }
        }
        mout[lane] = myword;
        TPU_STOP(109);
    }
    TPU_STOP(102);
}

struct DsaOutRow { const bf16_t* zb; bf16_t* gb; int wid;
    __device__ __forceinline__ const bf16_t* zrow(int r) const { const int rho = wid * 32 + r; return zb + (size_t)(rho >> 2) * NPAD + (rho & 3) * 128; }
    __device__ __forceinline__ bf16_t* grow(int r) const { const int rho = wid * 32 + r; return gb + (size_t)(rho >> 2) * MIX + (rho & 3) * 128; } };
__device__ __forceinline__ void unit_dsa_attn(const Params& P, int cur_layer, int u, char* lds) {
    const int b = u & 3, qb = 63 - (u >> 2), t0 = qb * 64, tokb = b * SEQ;
    const int wid = TIDX() >> 6, lane = TIDX() & 63, r32 = lane & 31, hi = lane >> 5;
    const int rho = wid * 32 + r32, tq = t0 + (rho >> 2), hq = rho & 3;
    const bf16_t* Qw = P.p_() + (size_t)(tokb + tq) * NPAD + C_DQ + hq * 128 + hi * 8;
    const bf16_t* Kh = P.kvc_() + (size_t)tokb * 256;
    const unsigned moff = (unsigned)(tokb + tq) * 512u;
    DsaOutRow ow; ow.zb = P.p_() + (size_t)(tokb + t0) * NPAD + C_DZ; ow.gb = P.xn_() + (size_t)(tokb + t0) * MIX + 1024; ow.wid = wid;
    const int NT = (qb + 2) & ~1;
    att::attn_body<true, 256, 128, 2, DsaOutRow>(Qw, P.dsa_q_norm + cur_layer * 128, P.rope_() + (size_t)(tokb + tq) * 48, Kh, NT, P.mask_(), moff, ow, lds);
}
__device__ __forceinline__ void phase_gemm_glu(const Params& P, int layer, char* lds) {
    pg8::Gemm g; g.A = P.ybuf_(); g.Bt = P.WgluT_() + (size_t)layer * 512 * 512; g.M = NTOK; g.N = 512; g.K = 512;
    pg8::StaticOrder S; S.init(g.M, g.N, (int)gridDim.x, (int)blockIdx.x);
    pg8::EpiGlu E; E.Y = P.ybuf_(); E.ldy = 512; E.O = P.ocat_(); E.ldo = MIX; E.ooff = 512;
    pg8::gemm_phase<pg8::EpiGlu, pg8::StaticOrder, false>((PG8_LAS unsigned char*)lds, g, S, E, nullptr);
}

constexpr int CTL_Q0 = 4096;
struct OneUnit { int pm, pn; __device__ __forceinline__ bool next(int i, pg8::Unit& u) const { if (i) return false; u.pm = pm; u.pn = pn; return true; }
    __device__ __forceinline__ void a_ready(const pg8::Unit&) const {} __device__ __forceinline__ void done(const pg8::Unit&) const {} };
__device__ __forceinline__ int q_issue(unsigned* ctr) { return (int)__hip_atomic_fetch_add(ctr, 1u, __ATOMIC_RELAXED, __HIP_MEMORY_SCOPE_AGENT); }
#define Q_LOOP_BEGIN(ctr, total)  { unsigned* q_ctr_ = (ctr); const int q_total_ = (total); volatile int* q_b_ = (volatile int*)(lds + LDS_TAIL + 16); \
    for (;;) { __syncthreads(); if (TIDX() == 0) *q_b_ = q_issue(q_ctr_); __syncthreads(); const int item = __builtin_amdgcn_readfirstlane(*q_b_); if (item >= q_total_) break;
#define Q_LOOP_END  } }
__device__ __forceinline__ void unit_glu(const Params& P, int layer, int u, char* lds) {
    pg8::Gemm g; g.A = P.ybuf_(); g.Bt = P.WgluT_() + (size_t)layer * 512 * 512; g.M = NTOK; g.N = 512; g.K = 512;
    OneUnit S; S.pm = u >> 1; S.pn = u & 1;
    pg8::EpiGluGate E; E.Y = P.ybuf_(); E.Pz = P.p_(); E.G = P.xn_();
    pg8::gemm_phase<pg8::EpiGluGate, OneUnit, false>((PG8_LAS unsigned char*)lds, g, S, E, nullptr);
}
constexpr int LDS_TAIL = LDS_BYTES - 64;

__global__ __launch_bounds__(NTHR, 2) void k_mega(Params P) {
    extern __shared__ __attribute__((aligned(16))) char lds[];
    if (TIDX() == 0) *(uint4*)(lds + LDS_TAIL) = make_uint4(0u, 0u, 0u, 0u);
    __syncthreads();
    XcdBarrier bar = xcd_barrier_post(P.ctl_(), (volatile LAS unsigned*)(lds + LDS_TAIL));
    const int G = gridDim.x, B = blockIdx.x;
    phase_prologue1(P, lds); phase_rope_table(P); phase_s5_params(P); phase_rmsnorm_x(P, 0);
    xcd_barrier(bar);
    for (int layer = 0; layer < DEPTH; ++layer) {
        if (layer > 0) { phase_rmsnorm_x(P, layer); xcd_barrier(bar); }
        phase_gemm_in(P, layer, lds);
        if (layer == 0) phase_gemm_kv(P, lds);
        xcd_barrier(bar);
        phase_prep(P, layer);
        if (layer == 0) phase_memk_norm(P);
        for (int u = B; u < 256; u += G) unit_gla_a4(P, layer, u, lds);
        xcd_barrier(bar);
        Q_LOOP_BEGIN(P.ctl_() + CTL_Q0 + 64 * (layer * 2), 128 + 2048 + 256)
            if (item < 128) unit_s5(P, layer, item, lds);
            else if (item < 2176) unit_dsa_index(P, item - 128, lds);
            else gla_scan_slice(P, (item - 2176) * NTHR + TIDX());
        Q_LOOP_END
        xcd_barrier(bar);
        Q_LOOP_BEGIN(P.ctl_() + CTL_Q0 + 64 * (layer * 2 + 1), 256 + 256 + 128 + 256)
            if (item < 256) unit_dsa_attn(P, layer, item, lds);
            else if (item < 512) unit_gla_c4(P, layer, item - 256, lds);
            else if (item < 640) unit_glu(P, layer, item - 512, lds);
            else unit_mem_attn(P, layer, item - 640, lds);
        Q_LOOP_END
        xcd_barrier(bar);
        phase_gemm_out(P, layer, lds);
        xcd_barrier(bar);
    }
}

extern "C" void kernel_launch(void* const* d_in, const int* in_sizes, int n_in, void* d_out, int out_size, void* d_ws, size_t ws_size, hipStream_t stream) {
    if (n_in != 24 || ws_size < WS_END) { fprintf(stderr, "kernel_launch: unexpected n_in %d or ws_size %zu (< %zu)\n", n_in, ws_size, (size_t)WS_END); return; }
    Params P; memset(&P, 0, sizeof(P));
    P.x = (const float*)d_in[0]; P.mem = (const float*)d_in[1]; P.pos = (const int*)d_in[2]; P.ln_gain = (const float*)d_in[3]; P.w_in = (const float*)d_in[4];
    P.gla_w_up = (const float*)d_in[5]; P.gla_b_up = (const float*)d_in[6]; P.s5_a_re = (const float*)d_in[7]; P.s5_a_im = (const float*)d_in[8]; P.s5_log_step = (const float*)d_in[9];
    P.s5_b_re = (const float*)d_in[10]; P.s5_b_im = (const float*)d_in[11]; P.s5_c_re = (const float*)d_in[12]; P.s5_c_im = (const float*)d_in[13]; P.s5_d = (const float*)d_in[14];
    P.s5_w_glu = (const float*)d_in[15]; P.dsa_q_norm = (const float*)d_in[16]; P.dsa_k_norm = (const float*)d_in[17]; P.mem_norm = (const float*)d_in[18]; P.w_mem_kv = (const float*)d_in[19];
    P.mem_q_norm = (const float*)d_in[20]; P.mem_k_norm = (const float*)d_in[21]; P.out_norm = (const float*)d_in[22]; P.w_out = (const float*)d_in[23];
    P.out = (float*)d_out;
    char* ws = (char*)d_ws; P.ws = ws;
    static int grid = 0;
    if (!grid) {
        int dev = 0, cus = 0, per_cu = 0;
        (void)hipGetDevice(&dev); (void)hipDeviceGetAttribute(&cus, hipDeviceAttributeMultiprocessorCount, dev);
        (void)hipFuncSetAttribute((const void*)k_mega, hipFuncAttributeMaxDynamicSharedMemorySize, LDS_BYTES);
        (void)hipOccupancyMaxActiveBlocksPerMultiprocessor(&per_cu, (const void*)k_mega, NTHR, LDS_BYTES);
        if (per_cu < 1) fprintf(stderr, "kernel_launch: occupancy query reports %d blocks per CU\n", per_cu);
        grid = cus > 0 ? cus : 256;
    }
    (void)hipMemsetAsync(ws + WS_CTL, 0, CTL_BYTES, stream);
    hipLaunchKernelGGL(k_mega, dim3(grid), dim3(NTHR), LDS_BYTES, stream, P);
}
```

```cpp
#include <hip/hip_runtime.h>
#include <stdint.h>
#include <stdio.h>
#include <string.h>

constexpr int NB = 4, SEQ = 4096, NTOK = NB * SEQ, DM = 2048, DEPTH = 4, MEML = 256;
constexpr int NIN = 5984, NPAD = 6144, MIX = 2048;
constexpr int C_GQ = 0, C_GK = 256, C_GV = 512, C_GLR = 1024, C_GZ = 1040, C_SU = 1552, C_SZ = 2064, C_DQ = 2576, C_DK = 3088, C_DV = 3216,
              C_DIQ = 3344, C_DIK = 4368, C_DIW = 4432, C_DZ = 4448, C_MQ = 4960, C_MZ = 5472;
constexpr float EPS = 1e-6f;
constexpr int NTHR = 512;
constexpr int LDS_BYTES = 147456;

typedef unsigned short bf16_t;
typedef short bf16x8 __attribute__((ext_vector_type(8)));
typedef short s16x4 __attribute__((ext_vector_type(4)));
typedef float f32x4 __attribute__((ext_vector_type(4)));
typedef float f32x8 __attribute__((ext_vector_type(8)));
typedef float f32x16 __attribute__((ext_vector_type(16)));
typedef unsigned u32x4 __attribute__((ext_vector_type(4)));
typedef unsigned u32x2 __attribute__((ext_vector_type(2)));
#define LAS __attribute__((address_space(3)))

__device__ __forceinline__ float bf2f(bf16_t b) { return __uint_as_float(((unsigned)b) << 16); }
__device__ __forceinline__ unsigned pk2bf(float lo, float hi) { unsigned r; asm("v_cvt_pk_bf16_f32 %0, %1, %2" : "=v"(r) : "v"(lo), "v"(hi)); return r; }
__device__ __forceinline__ bf16_t f2bf(float f) { return (bf16_t)pk2bf(f, f); }
__device__ __forceinline__ float sigmoidf_(float x) { return __builtin_amdgcn_rcpf(1.f + __expf(-x)); }
__device__ __forceinline__ float siluf_(float x) { return x * __builtin_amdgcn_rcpf(1.f + __expf(-x)); }

__device__ __forceinline__ int TIDX() { int t = (int)threadIdx.x; asm volatile("" : "+v"(t)); return t; }
__device__ __forceinline__ float shx(float v, int m) { const int src = ((TIDX() & 63) ^ m) << 2; return __int_as_float(__builtin_amdgcn_ds_bpermute(src, __float_as_int(v))); }
__device__ __forceinline__ float wave_sum(float v) {
#pragma unroll
    for (int o = 32; o >= 1; o >>= 1) v += shx(v, o);
    return v;
}
__device__ __forceinline__ void ld8f(const bf16_t* p, float (&v)[8]) { const u32x4 w = *(const u32x4*)p;
#pragma unroll
    for (int j = 0; j < 4; ++j) { v[2 * j] = __uint_as_float(w[j] << 16); v[2 * j + 1] = __uint_as_float(w[j] & 0xffff0000u); } }
__device__ __forceinline__ void st8f(bf16_t* p, const float (&v)[8]) { u32x4 w; w.x = pk2bf(v[0], v[1]); w.y = pk2bf(v[2], v[3]); w.z = pk2bf(v[4], v[5]); w.w = pk2bf(v[6], v[7]); *(u32x4*)p = w; }
__device__ __forceinline__ float f2bf_f(float f) { return bf2f(f2bf(f)); }

#ifndef TPROBE
#define TPROBE 0
#endif
#if TPROBE
#define TPU_START(id) do { if (TPROBE == (id) && TIDX() == 0) *(volatile unsigned long long*)(lds + LDS_BYTES - 24) = __builtin_amdgcn_s_memrealtime(); } while (0)
#define TPU_STOP(id) do { if (TPROBE == (id) && TIDX() == 0) *(volatile unsigned long long*)(lds + LDS_BYTES - 32) += __builtin_amdgcn_s_memrealtime() - *(volatile unsigned long long*)(lds + LDS_BYTES - 24); } while (0)
#else
#define TPU_START(id) do {} while (0)
#define TPU_STOP(id) do {} while (0)
#endif
#define XB_TMO      128
#define XB_XCNT(j)  (256  + 64 * (j))
#define XB_XSUB(j)  (1280 + 64 * (j))
#define XB_XGEN(j)  (2304 + 64 * (j))
#define XB_TOP      3328
#define XB_TOPGEN   3392
#define XCD_BAR_WORDS 3456
#define XB_SPIN_CAP (1u << 18)

__device__ __forceinline__ unsigned xb_ld(unsigned* p)              { return __hip_atomic_load(p, __ATOMIC_RELAXED, __HIP_MEMORY_SCOPE_AGENT); }
__device__ __forceinline__ unsigned xb_add(unsigned* p, unsigned v) { return __hip_atomic_fetch_add(p, v, __ATOMIC_RELAXED, __HIP_MEMORY_SCOPE_AGENT); }
__device__ __forceinline__ unsigned xb_xcc_id() { return (unsigned)__builtin_amdgcn_s_getreg((3 << 11) | 20) & 0xFu; }
#define XB_SPIN(cond, bar) do { unsigned _sp = 0; while (cond) { __builtin_amdgcn_s_sleep(1); \
    if ((++_sp & 255u) == 0u) { if (xb_ld(&(bar)[XB_TMO])) break; if (_sp > XB_SPIN_CAP) { atomicAdd(&(bar)[XB_TMO], 1u); break; } } } } while (0)

struct XcdBarrier {
    unsigned* bar; unsigned x;
    volatile LAS unsigned* st;
};

__device__ __forceinline__ XcdBarrier xcd_barrier_post(unsigned* bar, volatile LAS unsigned* st) {
    XcdBarrier b; b.bar = bar; b.x = xb_xcc_id(); b.st = st;
    if (TIDX() == 0) (void)xb_add(&bar[XB_XCNT(b.x)], 1u);
    return b;
}
__device__ __forceinline__ void xcd_barrier_complete(unsigned* bar, unsigned x, unsigned& nloc, unsigned& nx) {
    const unsigned G = gridDim.x * gridDim.y * gridDim.z;
    unsigned sum, cnt, mine, sp = 0u;
    for (;;) {
        sum = 0u; cnt = 0u; mine = 0u;
#pragma unroll
        for (unsigned j = 0; j < 16; ++j) { const unsigned c = xb_ld(&bar[XB_XCNT(j)]); sum += c; cnt += (c > 0u) ? 1u : 0u; mine = (j == x) ? c : mine; }
        if (sum == G) break;
        __builtin_amdgcn_s_sleep(1);
        if ((++sp & 255u) == 0u) { if (xb_ld(&bar[XB_TMO])) break; if (sp > XB_SPIN_CAP) { atomicAdd(&bar[XB_TMO], 1u); break; } }
    }
    nloc = mine > 0u ? mine : 1u; nx = cnt > 0u ? cnt : 1u;
}

__device__ __forceinline__ void xcd_barrier(const XcdBarrier& b) {
    asm volatile("s_waitcnt vmcnt(0)" ::: "memory");
    __syncthreads();
    if (TIDX() == 0) {
        unsigned* bar = b.bar; const unsigned bx = xb_xcc_id();
        __builtin_amdgcn_s_waitcnt(0);
        unsigned nloc = b.st[0], nx = b.st[1];
        if (nloc == 0u) { xcd_barrier_complete(bar, bx, nloc, nx); b.st[0] = nloc; b.st[1] = nx; }
        const unsigned old = xb_add(&bar[XB_XSUB(bx)], 1u);
        const unsigned gen = old / nloc;
        if (old + 1u == (gen + 1u) * nloc) {
            __builtin_amdgcn_fence(__ATOMIC_RELEASE, "agent");
            asm volatile("s_waitcnt vmcnt(0)" ::: "memory");
            const unsigned og = xb_add(&bar[XB_TOP], 1u);
            const unsigned tg = og / nx;
            if (og + 1u == (tg + 1u) * nx) xb_add(&bar[XB_TOPGEN], 1u);
            else XB_SPIN(xb_ld(&bar[XB_TOPGEN]) == tg, bar);
            __builtin_amdgcn_fence(__ATOMIC_ACQUIRE, "agent");
            xb_add(&bar[XB_XGEN(bx)], 1u);
            asm volatile("s_waitcnt vmcnt(0)" ::: "memory");
        } else {
            XB_SPIN(xb_ld(&bar[XB_XGEN(bx)]) == gen, bar);
            __builtin_amdgcn_fence(__ATOMIC_ACQUIRE, "agent");
            asm volatile("s_waitcnt vmcnt(0)" ::: "memory");
        }
    }
    __syncthreads();
}
namespace pg8 {
#define PG8_LAS __attribute__((address_space(3)))
typedef float f32x2 __attribute__((ext_vector_type(2)));
typedef unsigned u32x4 __attribute__((ext_vector_type(4)));
constexpr int BM = 256, BK = 64, HALF = 128, HTB = HALF * BK * 2  , STAGE_BYTES = 8 * HTB, NXCD = 8, WGM = 8;

__host__ __device__ __forceinline__ int lds_byte(int r, int c) { const int st = (r >> 4) * 2 + (c >> 5), rr = r & 15, cc = c & 31, ob = rr * 64 + cc * 2; return st * 1024 + (ob ^ (((ob >> 9) & 1) << 5)); }
__host__ __device__ __forceinline__ void stage_rc(int b, int& R, int& C) { const int st = b / 1024, sb = b % 1024, swz = sb ^ (((sb >> 9) & 1) << 5); R = (st >> 1) * 16 + swz / 64; C = (st & 1) * 32 + (swz % 64) / 2; }
__host__ __device__ __forceinline__ int perm32(int rho) { const int n = rho >> 4, i = rho & 15; return 8 * (i >> 2) + 4 * n + (i & 3); }

struct Unit { int pm, pn; };
struct Gemm { const bf16_t* A; const bf16_t* Bt; int M, N, K; };

struct StaticOrder {
    int nM, nN, nwg, G, c;
    __host__ __device__ void init(int M, int N, int G_, int c_) { nM = M / BM; nN = N / BM; nwg = nM * nN; G = G_; c = c_; }
    __host__ __device__ bool next(int i, Unit& u) const {
        const long L = (long)i * G + c; if (L >= nwg) return false;
        int wgid = (int)L; { const int q = nwg / NXCD, r = nwg % NXCD, xcd = wgid % NXCD, off = wgid / NXCD; wgid = (xcd < r ? xcd * (q + 1) : r * (q + 1) + (xcd - r) * q) + off; }
        const int nig = WGM * nN, gid = wgid / nig, fm = gid * WGM, gsz = (nM - fm) < WGM ? (nM - fm) : WGM;
        u.pm = fm + ((wgid % nig) % gsz); u.pn = (wgid % nig) / gsz; return true;
    }
    __device__ __forceinline__ void a_ready(const Unit&) const {}
    __device__ __forceinline__ void done(const Unit&) const {}
};
__device__ __forceinline__ unsigned cvt_pk_bf16(float lo, float hi) { unsigned r; asm volatile("v_cvt_pk_bf16_f32 %0, %1, %2" : "=v"(r) : "v"(lo), "v"(hi)); return r; }
struct EpiBf16Plain {
    static constexpr bool PERM = true, AFTER_DRAIN = false;
    bf16_t* O; int ldc;
    __device__ __forceinline__ void operator()(const f32x4 (&acc)[2][2][4][2], const Unit& u, int wr, int wc, int fr, int fq) const {
        const int row0 = u.pm * BM + wr * 64 + fr, col0 = u.pn * BM + wc * 32 + 8 * fq;
#pragma unroll
        for (int ai = 0; ai < 2; ++ai)
#pragma unroll
            for (int m = 0; m < 4; ++m) { bf16_t* rowp = O + (size_t)(row0 + ai * HALF + m * 16) * ldc + col0;
#pragma unroll
                for (int bj = 0; bj < 2; ++bj) { const f32x4 v0 = acc[ai][bj][m][0], v1 = acc[ai][bj][m][1];
                    u32x4 w; w.x = cvt_pk_bf16(v0[0], v0[1]); w.y = cvt_pk_bf16(v0[2], v0[3]); w.z = cvt_pk_bf16(v1[0], v1[1]); w.w = cvt_pk_bf16(v1[2], v1[3]);
                    *(u32x4*)(rowp + bj * HALF) = w; } }
    }
};
struct EpiResid {
    static constexpr bool PERM = false, AFTER_DRAIN = false;
    const float* R; float* C; int ldc;
    __device__ __forceinline__ void operator()(const f32x4 (&acc)[2][2][4][2], const Unit& u, int wr, int wc, int fr, int fq) const {
        const int row0 = u.pm * BM + wr * 64 + fr, col0 = u.pn * BM + wc * 32 + 4 * fq;
#pragma unroll
        for (int ai = 0; ai < 2; ++ai)
#pragma unroll
            for (int m = 0; m < 4; ++m) { const size_t off = (size_t)(row0 + ai * HALF + m * 16) * ldc + col0;
#pragma unroll
                for (int bj = 0; bj < 2; ++bj)
#pragma unroll
                    for (int n = 0; n < 2; ++n) { const f32x4 r = *(const f32x4*)(R + off + bj * HALF + n * 16); *(f32x4*)(C + off + bj * HALF + n * 16) = acc[ai][bj][m][n] + r; } }
    }
};
struct EpiResidMix {
    static constexpr bool PERM = true, AFTER_DRAIN = false;
    const void* R; void* C; int ldc; int r16, c16;
    __device__ __forceinline__ void operator()(const f32x4 (&acc)[2][2][4][2], const Unit& u, int wr, int wc, int fr, int fq) const {
        const int row0 = u.pm * BM + wr * 64 + fr, col0 = u.pn * BM + wc * 32 + 8 * fq;
#pragma unroll
        for (int ai = 0; ai < 2; ++ai)
#pragma unroll
            for (int m = 0; m < 4; ++m) { const size_t off = (size_t)(row0 + ai * HALF + m * 16) * ldc + col0;
                f32x4 r0[2], r1[2];
                if (r16) {
#pragma unroll
                    for (int bj = 0; bj < 2; ++bj) { const u32x4 w = *(const u32x4*)((const bf16_t*)R + off + bj * HALF);
                        r0[bj] = f32x4{__uint_as_float(w.x << 16), __uint_as_float(w.x & 0xffff0000u), __uint_as_float(w.y << 16), __uint_as_float(w.y & 0xffff0000u)};
                        r1[bj] = f32x4{__uint_as_float(w.z << 16), __uint_as_float(w.z & 0xffff0000u), __uint_as_float(w.w << 16), __uint_as_float(w.w & 0xffff0000u)}; }
                } else {
#pragma unroll
                    for (int bj = 0; bj < 2; ++bj) { r0[bj] = *(const f32x4*)((const float*)R + off + bj * HALF); r1[bj] = *(const f32x4*)((const float*)R + off + bj * HALF + 4); }
                }
#pragma unroll
                for (int bj = 0; bj < 2; ++bj) { const f32x4 v0 = acc[ai][bj][m][0] + r0[bj], v1 = acc[ai][bj][m][1] + r1[bj];
                    if (c16) { u32x4 w; w.x = cvt_pk_bf16(v0[0], v0[1]); w.y = cvt_pk_bf16(v0[2], v0[3]); w.z = cvt_pk_bf16(v1[0], v1[1]); w.w = cvt_pk_bf16(v1[2], v1[3]);
                        *(u32x4*)((bf16_t*)C + off + bj * HALF) = w; }
                    else { *(f32x4*)((float*)C + off + bj * HALF) = v0; *(f32x4*)((float*)C + off + bj * HALF + 4) = v1; } } }
    }
};
struct EpiGlu {
    static constexpr bool PERM = true, AFTER_DRAIN = false;
    const bf16_t* Y; int ldy; bf16_t* O; int ldo; int ooff;
    __device__ __forceinline__ void operator()(const f32x4 (&acc)[2][2][4][2], const Unit& u, int wr, int wc, int fr, int fq) const {
        const int row0 = u.pm * BM + wr * 64 + fr, col0 = u.pn * BM + wc * 32 + 8 * fq;
#pragma unroll
        for (int ai = 0; ai < 2; ++ai)
#pragma unroll
            for (int m = 0; m < 4; ++m) { const int row = row0 + ai * HALF + m * 16;
#pragma unroll
                for (int bj = 0; bj < 2; ++bj) { const f32x4 v0 = acc[ai][bj][m][0], v1 = acc[ai][bj][m][1];
                    const u32x4 yw = *(const u32x4*)(Y + (size_t)row * ldy + col0 + bj * HALF);
                    float y[8], g[8];
#pragma unroll
                    for (int j = 0; j < 4; ++j) { y[2 * j] = __uint_as_float(yw[j] << 16); y[2 * j + 1] = __uint_as_float(yw[j] & 0xffff0000u); }
#pragma unroll
                    for (int j = 0; j < 4; ++j) { g[j] = __builtin_amdgcn_rcpf(1.f + __expf(-v0[j])); g[4 + j] = __builtin_amdgcn_rcpf(1.f + __expf(-v1[j])); }
                    u32x4 w; w.x = cvt_pk_bf16(y[0] * g[0], y[1] * g[1]); w.y = cvt_pk_bf16(y[2] * g[2], y[3] * g[3]); w.z = cvt_pk_bf16(y[4] * g[4], y[5] * g[5]); w.w = cvt_pk_bf16(y[6] * g[6], y[7] * g[7]);
                    *(u32x4*)(O + (size_t)row * ldo + ooff + col0 + bj * HALF) = w; } }
    }
};
struct EpiGluGate {
    static constexpr bool PERM = true, AFTER_DRAIN = true;
    const bf16_t* Y; const bf16_t* Pz; bf16_t* G;
    __device__ __forceinline__ void fused(const f32x4 (&acc)[2][2][4][2], const Unit& u, int wr, int wc, int fr, int fq, PG8_LAS unsigned char* lds, int wid, int lane) const {
        constexpr int TS = 528;
        const int row0 = wr * 64 + fr, col0 = wc * 32 + 8 * fq;
#pragma unroll
        for (int ai = 0; ai < 2; ++ai)
#pragma unroll
            for (int m = 0; m < 4; ++m) { const int rl = row0 + ai * HALF + m * 16; const size_t grow = (size_t)u.pm * BM + rl;
#pragma unroll
                for (int bj = 0; bj < 2; ++bj) { const f32x4 v0 = acc[ai][bj][m][0], v1 = acc[ai][bj][m][1];
                    const u32x4 yw = *(const u32x4*)(Y + grow * 512 + u.pn * BM + col0 + bj * HALF);
                    float y[8], g[8];
#pragma unroll
                    for (int j = 0; j < 4; ++j) { y[2 * j] = __uint_as_float(yw[j] << 16); y[2 * j + 1] = __uint_as_float(yw[j] & 0xffff0000u); }
#pragma unroll
                    for (int j = 0; j < 4; ++j) { g[j] = __builtin_amdgcn_rcpf(1.f + __expf(-v0[j])); g[4 + j] = __builtin_amdgcn_rcpf(1.f + __expf(-v1[j])); }
                    u32x4 w; w.x = cvt_pk_bf16(y[0] * g[0], y[1] * g[1]); w.y = cvt_pk_bf16(y[2] * g[2], y[3] * g[3]); w.z = cvt_pk_bf16(y[4] * g[4], y[5] * g[5]); w.w = cvt_pk_bf16(y[6] * g[6], y[7] * g[7]);
                    *(PG8_LAS u32x4*)(lds + rl * TS + (col0 + bj * HALF) * 2) = w; } }
        __syncthreads();
        { const int t = wid * 64 + lane, row = t >> 1, hd = t & 1; const PG8_LAS unsigned char* src = lds + row * TS + hd * 256;
          float ss = 0.f;
#pragma unroll
          for (int i = 0; i < 16; ++i) { const u32x4 w = *(const PG8_LAS u32x4*)(src + 16 * i);
#pragma unroll
              for (int j = 0; j < 4; ++j) { const float a = __uint_as_float(w[j] << 16), b = __uint_as_float(w[j] & 0xffff0000u); ss += a * a + b * b; } }
          const float rn = rsqrtf(ss * (1.f / 128.f) + 1e-6f);
          const size_t grow = (size_t)u.pm * BM + row; const int cb = u.pn * BM + hd * 128;
          const bf16_t* zp = Pz + grow * 6144 + 2064 + cb; bf16_t* gp = G + grow * 2048 + 512 + cb;
#pragma unroll
          for (int i = 0; i < 16; ++i) { const u32x4 w = *(const PG8_LAS u32x4*)(src + 16 * i); const u32x4 zw = *(const u32x4*)(zp + 8 * i); u32x4 o;
#pragma unroll
              for (int j = 0; j < 4; ++j) { const float a = __uint_as_float(w[j] << 16), b = __uint_as_float(w[j] & 0xffff0000u), za = __uint_as_float(zw[j] << 16), zb = __uint_as_float(zw[j] & 0xffff0000u);
                  o[j] = cvt_pk_bf16(a * rn * (za * __builtin_amdgcn_rcpf(1.f + __expf(-za))), b * rn * (zb * __builtin_amdgcn_rcpf(1.f + __expf(-zb)))); }
              *(u32x4*)(gp + 8 * i) = o; } }
        __syncthreads();
    }
};
struct EpiBf16Scale {
    static constexpr bool PERM = true, AFTER_DRAIN = false;
    bf16_t* O; int ldc; const float* ssq;
    __device__ __forceinline__ void operator()(const f32x4 (&acc)[2][2][4][2], const Unit& u, int wr, int wc, int fr, int fq) const {
        const int row0 = u.pm * BM + wr * 64 + fr, col0 = u.pn * BM + wc * 32 + 8 * fq;
#pragma unroll
        for (int ai = 0; ai < 2; ++ai)
#pragma unroll
            for (int m = 0; m < 4; ++m) { const int row = row0 + ai * HALF + m * 16; bf16_t* rowp = O + (size_t)row * ldc + col0;
                float ssum = 0.f; { const f32x4* sp_ = (const f32x4*)(ssq + (size_t)row * 32);
#pragma unroll
                    for (int q = 0; q < 8; ++q) { const f32x4 t4 = sp_[q]; ssum += (t4[0] + t4[1]) + (t4[2] + t4[3]); } }
                const float s = rsqrtf(ssum * (1.f / 2048.f) + 1e-6f);
#pragma unroll
                for (int bj = 0; bj < 2; ++bj) { const f32x4 v0 = acc[ai][bj][m][0] * s, v1 = acc[ai][bj][m][1] * s;
                    u32x4 w; w.x = cvt_pk_bf16(v0[0], v0[1]); w.y = cvt_pk_bf16(v0[2], v0[3]); w.z = cvt_pk_bf16(v1[0], v1[1]); w.w = cvt_pk_bf16(v1[2], v1[3]);
                    *(u32x4*)(rowp + bj * HALF) = w; } }
    }
};
struct EpiResidNext {
    static constexpr bool PERM = false, AFTER_DRAIN = false;
    const float* R; float* C; int ldc; bf16_t* XB; float* ssq;
    __device__ __forceinline__ void operator()(const f32x4 (&acc)[2][2][4][2], const Unit& u, int wr, int wc, int fr, int fq) const {
        const int row0 = u.pm * BM + wr * 64 + fr, col0 = u.pn * BM + wc * 32 + 4 * fq;
#pragma unroll
        for (int ai = 0; ai < 2; ++ai)
#pragma unroll
            for (int m = 0; m < 4; ++m) { const int row = row0 + ai * HALF + m * 16; const size_t off = (size_t)row * ldc + col0; float ss = 0.f;
#pragma unroll
                for (int bj = 0; bj < 2; ++bj)
#pragma unroll
                    for (int n = 0; n < 2; ++n) { const f32x4 r = *(const f32x4*)(R + off + bj * HALF + n * 16); const f32x4 v = acc[ai][bj][m][n] + r;
                        *(f32x4*)(C + off + bj * HALF + n * 16) = v;
                        if (XB) { u32x2 w; w.x = cvt_pk_bf16(v[0], v[1]); w.y = cvt_pk_bf16(v[2], v[3]); *(u32x2*)(XB + off + bj * HALF + n * 16) = w; }
                        ss += v[0] * v[0] + v[1] * v[1] + v[2] * v[2] + v[3] * v[3]; }
                if (ssq) { ss += shx(ss, 16); ss += shx(ss, 32); if (fq == 0) ssq[(size_t)row * 32 + u.pn * 4 + wc] = ss; } }
    }
};
template <class Epi, class Sched, bool STAMP = false>
__device__ __forceinline__ void gemm_phase(PG8_LAS unsigned char* lds, const Gemm g, const Sched& S, const Epi& E, unsigned long long* stamps) {
    const int tid = TIDX(), wid = __builtin_amdgcn_readfirstlane(tid >> 6), lane = tid & 63, wr = wid >> 2, wc = wid & 3, fr = lane & 15, fq = lane >> 4;
    const int K = g.K, nt = K / BK;
    int ts_lo = 0, ts_hi = 0, nts = 0; const unsigned long long rt_entry = STAMP ? (unsigned long long)wall_clock64() : 0ull;
#define PG8_STAMP() do { if (STAMP && wid == 0 && nts < 64) { const unsigned long long _c = (unsigned long long)clock64(); \
        ts_lo = (lane == nts) ? (int)(unsigned)_c : ts_lo; ts_hi = (lane == nts) ? (int)(unsigned)(_c >> 32) : ts_hi; ++nts; } } while (0)
    PG8_STAMP();
    unsigned voffA[2], voffB[2];
#pragma unroll
    for (int i = 0; i < 2; ++i) { int R, C; stage_rc(tid * 16 + i * 8192, R, C); const int Rb = Epi::PERM ? ((R & ~31) + perm32(R & 31)) : R;
        voffA[i] = (unsigned)(R * K + C) * 2u; voffB[i] = (unsigned)(Rb * K + C) * 2u; }
    const size_t kstep = (size_t)(BK * 2);
    const size_t hstep = (size_t)HALF * K * 2;
    const size_t tstep = 2 * hstep;
    const unsigned ldsw = (unsigned)wid * 1024u;
    const int aoff = lds_byte(wr * 64 + fr, fq * 8), boff = lds_byte(wc * 32 + fr, fq * 8);
#define PG8_SA(b, h) (((b) * 2 + (h)) * HTB)
#define PG8_SB(b, h) ((4 + (b) * 2 + (h)) * HTB)
#define PG8_STAGE(bufoff, gbase, voff) do { _Pragma("unroll") for (int _i = 0; _i < 2; ++_i) \
        __builtin_amdgcn_global_load_lds((const unsigned*)((const char*)(gbase) + (voff)[_i]), (PG8_LAS unsigned*)(lds + (bufoff) + ldsw + _i * 8192), 16, 0, 0); } while (0)
#define PG8_LDA(dst, b, h) do { _Pragma("unroll") for (int m = 0; m < 4; ++m) _Pragma("unroll") for (int k = 0; k < 2; ++k) dst[m][k] = *(const PG8_LAS bf16x8*)(lds + PG8_SA(b, h) + aoff + m * 2048 + k * 1024); } while (0)
#define PG8_LDB(dst, b, h) do { _Pragma("unroll") for (int n = 0; n < 2; ++n) _Pragma("unroll") for (int k = 0; k < 2; ++k) dst[n][k] = *(const PG8_LAS bf16x8*)(lds + PG8_SB(b, h) + boff + n * 2048 + k * 1024); } while (0)
#define PG8_MMA(ai, bj, At, Bt) do { __builtin_amdgcn_s_setprio(1); _Pragma("unroll") for (int m = 0; m < 4; ++m) _Pragma("unroll") for (int n = 0; n < 2; ++n) _Pragma("unroll") for (int k = 0; k < 2; ++k) \
        acc[ai][bj][m][n] = __builtin_amdgcn_mfma_f32_16x16x32_bf16(Bt[n][k], At[m][k], acc[ai][bj][m][n], 0, 0, 0); __builtin_amdgcn_s_setprio(0); } while (0)
#define PG8_WAIT_V(n) asm volatile("s_waitcnt vmcnt(" #n ")" ::: "memory")
#define PG8_WAIT_L(n) asm volatile("s_waitcnt lgkmcnt(" #n ")" ::: "memory")
#define PG8_BAR __builtin_amdgcn_s_barrier()
#define PG8_SCHED __builtin_amdgcn_sched_barrier(0)
    Unit cur, nxt; int ui = 0;
    if (!S.next(0, cur)) return;
    f32x4 acc[2][2][4][2];
#pragma unroll
    for (int a = 0; a < 2; ++a)
#pragma unroll
        for (int b = 0; b < 2; ++b)
#pragma unroll
            for (int m = 0; m < 4; ++m)
#pragma unroll
                for (int n = 0; n < 2; ++n) acc[a][b][m][n] = (f32x4){0.f, 0.f, 0.f, 0.f};
    bf16x8 At[4][2], B0[2][2], B1[2][2];
    const char* cA = (const char*)g.A + (size_t)cur.pm * tstep; const char* cB = (const char*)g.Bt + (size_t)cur.pn * tstep;
    S.a_ready(cur);
    PG8_STAGE(PG8_SB(0, 0), cB, voffB); PG8_STAGE(PG8_SA(0, 0), cA, voffA); PG8_STAGE(PG8_SB(0, 1), cB + hstep, voffB); PG8_STAGE(PG8_SA(0, 1), cA + hstep, voffA);
    if (wr == 1) PG8_BAR;
    PG8_WAIT_V(4); PG8_BAR;
    PG8_STAGE(PG8_SB(1, 0), cB + kstep, voffB); PG8_STAGE(PG8_SA(1, 0), cA + kstep, voffA); PG8_STAGE(PG8_SB(1, 1), cB + hstep + kstep, voffB);
    PG8_WAIT_V(6); PG8_BAR;
    PG8_STAMP();
    for (;;) {
        const bool has_next = S.next(ui + 1, nxt);
        const char* nA = has_next ? (const char*)g.A + (size_t)nxt.pm * tstep : cA; const char* nB = has_next ? (const char*)g.Bt + (size_t)nxt.pn * tstep : cB;
        for (int t = 0; t < nt; t += 2) {
            const bool last = (t == nt - 2);
            const char* a1 = cA + (size_t)(t + 1) * kstep;
            const char* a2 = last ? nA : cA + (size_t)(t + 2) * kstep; const char* b2 = last ? nB : cB + (size_t)(t + 2) * kstep;
            const char* a3 = a2 + kstep; const char* b3 = b2 + kstep;
            if (last && has_next) S.a_ready(nxt);
            PG8_LDB(B0, 0, 0); PG8_SCHED; PG8_LDA(At, 0, 0); PG8_STAGE(PG8_SA(1, 1), a1 + hstep, voffA);
            PG8_WAIT_L(8); PG8_BAR; PG8_WAIT_L(0); PG8_MMA(0, 0, At, B0); PG8_BAR; PG8_SCHED;
            PG8_LDB(B1, 0, 1); PG8_STAGE(PG8_SB(0, 0), b2, voffB);
            PG8_BAR; PG8_WAIT_L(0); PG8_MMA(0, 1, At, B1); PG8_BAR;
            PG8_LDA(At, 0, 1); PG8_STAGE(PG8_SA(0, 0), a2, voffA);
            PG8_BAR; PG8_WAIT_L(0); PG8_MMA(1, 0, At, B0); PG8_BAR; PG8_SCHED;
            PG8_STAGE(PG8_SB(0, 1), b2 + hstep, voffB);
            PG8_WAIT_V(6); PG8_BAR; PG8_MMA(1, 1, At, B1); PG8_BAR;
            PG8_LDB(B0, 1, 0); PG8_SCHED; PG8_LDA(At, 1, 0); PG8_STAGE(PG8_SA(0, 1), a2 + hstep, voffA);
            PG8_WAIT_L(8); PG8_BAR; PG8_WAIT_L(0); PG8_MMA(0, 0, At, B0); PG8_BAR; PG8_SCHED;
            PG8_LDB(B1, 1, 1); PG8_STAGE(PG8_SB(1, 0), b3, voffB);
            PG8_BAR; PG8_WAIT_L(0); PG8_MMA(0, 1, At, B1); PG8_BAR;
            PG8_LDA(At, 1, 1); PG8_STAGE(PG8_SA(1, 0), a3, voffA);
            PG8_BAR; PG8_WAIT_L(0); PG8_MMA(1, 0, At, B0); PG8_BAR; PG8_SCHED;
            PG8_STAGE(PG8_SB(1, 1), b3 + hstep, voffB);
            PG8_WAIT_V(6); PG8_BAR; PG8_MMA(1, 1, At, B1); PG8_BAR;
        }
        PG8_STAMP();
        if constexpr (!Epi::AFTER_DRAIN) { E(acc, cur, wr, wc, fr, fq); S.done(cur); }
        PG8_STAMP();
        if (!has_next) break;
#pragma unroll
        for (int a = 0; a < 2; ++a)
#pragma unroll
            for (int b = 0; b < 2; ++b)
#pragma unroll
                for (int m = 0; m < 4; ++m)
#pragma unroll
                    for (int n = 0; n < 2; ++n) acc[a][b][m][n] = (f32x4){0.f, 0.f, 0.f, 0.f};
        cur = nxt; cA = nA; cB = nB; ++ui;
    }
    PG8_WAIT_V(0);
    if (wr == 0) PG8_BAR;
    PG8_BAR;
    if constexpr (Epi::AFTER_DRAIN) { E.fused(acc, cur, wr, wc, fr, fq, lds, wid, lane); S.done(cur); }
    PG8_STAMP();
    if (STAMP && wid == 0) { stamps[lane] = lane < nts ? (((unsigned long long)(unsigned)ts_hi << 32) | (unsigned)ts_lo) : 0ull;
        if (lane == 62) stamps[62] = rt_entry; if (lane == 63) stamps[63] = (unsigned long long)wall_clock64(); }
#undef PG8_STAMP
#undef PG8_SA
#undef PG8_SB
#undef PG8_STAGE
#undef PG8_LDA
#undef PG8_LDB
#undef PG8_MMA
#undef PG8_WAIT_V
#undef PG8_WAIT_L
#undef PG8_BAR
#undef PG8_SCHED
}
}
namespace att {
constexpr int D = 128, NW = 8, QBLK = 32, KVBLK = 64;
constexpr float SCALE = 0.088388347648318440f, THR = 8.f;
constexpr int SHM_V = KVBLK * D * 2, SHM_K = KVBLK * D * 2, SHM_ATTN = 2 * SHM_V + 2 * SHM_K + NW * 64 * 4;
#define KSWZ(row, colB) ((row) * 256 + ((colB) ^ (((row) & 7) << 4)))
#define SBAR() __builtin_amdgcn_sched_barrier(0)
__device__ __forceinline__ int crow(int r, int hi) { return (r & 3) + 8 * (r >> 2) + 4 * hi; }
__device__ __forceinline__ unsigned cvtpk(float lo, float hi) { unsigned r; asm volatile("v_cvt_pk_bf16_f32 %0, %1, %2" : "=v"(r) : "v"(lo), "v"(hi)); return r; }

template <bool MASKED>
__device__ __forceinline__ void partialSM(f32x16& p0, f32x16& p1, float& m_reg, float& mn, float& alpha, unsigned long long mw, int hi) {
  constexpr float C = SCALE * 1.4426950408889634f;
  float pmax = p0[0];
#pragma unroll
  for (int r = 1; r < 16; ++r) pmax = fmaxf(pmax, p0[r]);
#pragma unroll
  for (int r = 0; r < 16; ++r) pmax = fmaxf(pmax, p1[r]);
  { auto rr = __builtin_amdgcn_permlane32_swap(__float_as_uint(pmax), __float_as_uint(pmax), false, false);
    pmax = fmaxf(__uint_as_float(rr[0]), __uint_as_float(rr[1])); }
  if (__builtin_expect(__all(pmax - m_reg <= THR / SCALE), 1)) { mn = m_reg; alpha = 1.f; }
  else { mn = fmaxf(m_reg, pmax); alpha = __builtin_amdgcn_exp2f((m_reg - mn) * C); m_reg = mn; }
  const float mnC = -mn * C;
#pragma unroll
  for (int r = 0; r < 16; ++r) p0[r] = fmaf(p0[r], C, mnC);
#pragma unroll
  for (int r = 0; r < 16; ++r) p1[r] = fmaf(p1[r], C, mnC);
#pragma unroll
  for (int r = 0; r < 16; ++r) p0[r] = __builtin_amdgcn_exp2f(p0[r]);
}
__device__ __forceinline__ void finishSM(f32x16& p0, f32x16& p1, float alpha, float& l_reg, bf16x8& pa0, bf16x8& pa1, bf16x8& pa2, bf16x8& pa3) {
#pragma unroll
  for (int r = 0; r < 16; ++r) p1[r] = __builtin_amdgcn_exp2f(p1[r]);
  float ps = 0;
#pragma unroll
  for (int r = 0; r < 16; ++r) ps += p0[r];
#pragma unroll
  for (int r = 0; r < 16; ++r) ps += p1[r];
  { auto rr = __builtin_amdgcn_permlane32_swap(__float_as_uint(ps), __float_as_uint(ps), false, false);
    ps = __uint_as_float(rr[0]) + __uint_as_float(rr[1]); }
  l_reg = l_reg * alpha + ps;
#define PK4(P, BASE, OUT) do { unsigned a0 = cvtpk(P[BASE + 0], P[BASE + 1]), a1 = cvtpk(P[BASE + 2], P[BASE + 3]);   \
    unsigned b0 = cvtpk(P[BASE + 4], P[BASE + 5]), b1 = cvtpk(P[BASE + 6], P[BASE + 7]);                              \
    auto r0 = __builtin_amdgcn_permlane32_swap(a0, b0, false, false); auto r1 = __builtin_amdgcn_permlane32_swap(a1, b1, false, false); \
    u32x4 w = {r0[0], r1[0], r0[1], r1[1]}; OUT = *reinterpret_cast<bf16x8*>(&w); } while (0)
  PK4(p0, 0, pa0); PK4(p0, 8, pa1); PK4(p1, 0, pa2); PK4(p1, 8, pa3);
#undef PK4
}
template <int R> __device__ __forceinline__ float mask_bias(unsigned nw) {
  unsigned t; constexpr int bit = (R & 3) + 8 * (R >> 2);
  asm("v_bfe_i32 %0, %1, %2, 1\n\tv_and_b32 %0, 0xff800000, %0" : "=v"(t) : "v"(nw), "n"(bit));
  return __uint_as_float(t);
}
template <bool MASKED>
__device__ __forceinline__ void qkt(f32x16& p0, f32x16& p1, const char* Ks, const bf16x8* qr, int r32, int hi, unsigned long long mw) {
  if (MASKED) {
    const unsigned n0 = ~((unsigned)mw >> (4 * hi)), n1 = ~((unsigned)(mw >> 32) >> (4 * hi));
#define MB_(R) p0[R] = mask_bias<R>(n0); p1[R] = mask_bias<R>(n1);
    MB_(0) MB_(1) MB_(2) MB_(3) MB_(4) MB_(5) MB_(6) MB_(7) MB_(8) MB_(9) MB_(10) MB_(11) MB_(12) MB_(13) MB_(14) MB_(15)
#undef MB_
  } else { p0 = f32x16{}; p1 = f32x16{}; }
  asm volatile("" : "+v"(p0), "+v"(p1));
#pragma unroll
  for (int d0 = 0; d0 < 8; ++d0) { const int cb = (d0 * 16 + hi * 8) * 2;
    bf16x8 b0 = *reinterpret_cast<const bf16x8*>(Ks + KSWZ(r32, cb));
    bf16x8 b1 = *reinterpret_cast<const bf16x8*>(Ks + KSWZ(32 + r32, cb));
    p0 = __builtin_amdgcn_mfma_f32_32x32x16_bf16(b0, qr[d0], p0, 0, 0, 0);
    p1 = __builtin_amdgcn_mfma_f32_32x32x16_bf16(b1, qr[d0], p1, 0, 0, 0); }
}
__device__ __forceinline__ int v_st(int k, int c) { const int kk = (k & ~0xC) | ((k & 4) << 1) | ((k & 8) >> 1); return ((kk >> 3) * 4 + (c >> 5)) * 512 + ((kk & 7) * 32 + (c & 31)) * 2; }
__device__ __forceinline__ int v_rd_base(int lane) { return ((lane & 3) << 3) | (((lane >> 2) & 3) << 6) | (((lane >> 4) & 1) << 5) | (((lane >> 5) & 1) << 8); }
constexpr int v_rd_off(int d0, int ks, int half) { return d0 * 512 + ks * 4096 + half * 2048; }
template <int OFF> __device__ __forceinline__ s16x4 tr_read(int vb) {
  s16x4 r; asm volatile("ds_read_b64_tr_b16 %0, %1 offset:%2" : "=&v"(r) : "v"(vb), "i"(OFF) : "memory"); return r;
}
template <int D0> __device__ __forceinline__ void pv_one(f32x16& od, int vb, bf16x8 pa0, bf16x8 pa1, bf16x8 pa2, bf16x8 pa3) {
  const s16x4 l0 = tr_read<v_rd_off(D0, 0, 0)>(vb), h0 = tr_read<v_rd_off(D0, 0, 1)>(vb), l1 = tr_read<v_rd_off(D0, 1, 0)>(vb), h1 = tr_read<v_rd_off(D0, 1, 1)>(vb);
  const s16x4 l2 = tr_read<v_rd_off(D0, 2, 0)>(vb), h2 = tr_read<v_rd_off(D0, 2, 1)>(vb), l3 = tr_read<v_rd_off(D0, 3, 0)>(vb), h3 = tr_read<v_rd_off(D0, 3, 1)>(vb);
  asm volatile("s_waitcnt lgkmcnt(0)" ::: "memory"); SBAR();
#define PK(L, H) (bf16x8){L[0], L[1], L[2], L[3], H[0], H[1], H[2], H[3]}
  od = __builtin_amdgcn_mfma_f32_32x32x16_bf16(pa0, PK(l0, h0), od, 0, 0, 0);
  od = __builtin_amdgcn_mfma_f32_32x32x16_bf16(pa1, PK(l1, h1), od, 0, 0, 0);
  od = __builtin_amdgcn_mfma_f32_32x32x16_bf16(pa2, PK(l2, h2), od, 0, 0, 0);
  od = __builtin_amdgcn_mfma_f32_32x32x16_bf16(pa3, PK(l3, h3), od, 0, 0, 0);
#undef PK
}
__device__ __forceinline__ void pv_d0(f32x16* o, int vb, bf16x8 pa0, bf16x8 pa1, bf16x8 pa2, bf16x8 pa3) {
  pv_one<0>(o[0], vb, pa0, pa1, pa2, pa3); pv_one<1>(o[1], vb, pa0, pa1, pa2, pa3); pv_one<2>(o[2], vb, pa0, pa1, pa2, pa3); pv_one<3>(o[3], vb, pa0, pa1, pa2, pa3);
}

template <bool MASKED, int LDK, int VOFF, int QT, class OutRow>
__device__ __forceinline__ void attn_body(const bf16_t* __restrict__ Qw, const float* __restrict__ qgain, const float* __restrict__ qcs, const bf16_t* __restrict__ Kh, int NT,
                                          const unsigned long long* __restrict__ mbase, unsigned moff, const OutRow& Ow, char* lds) {
  const int tid = TIDX(), wid = tid >> 6, lane = tid & 63, r32 = lane & 31, hi = lane >> 5;
  char* V_lds = lds; char* K_lds = lds + 2 * SHM_V;
  float* ws = (float*)(lds + 2 * SHM_V + 2 * SHM_K) + wid * 64; float* li_l = ws; float* al_l = ws + 32;
  float m_reg = -1e30f, l_reg = 0; f32x16 o[4] = {}; bf16x8 qr[8];
  asm volatile("" : "+v"(o[0]), "+v"(o[1]), "+v"(o[2]), "+v"(o[3]));
#pragma unroll
  for (int d0 = 0; d0 < 8; ++d0) qr[d0] = *reinterpret_cast<const bf16x8*>(Qw + d0 * 16);
  if (QT) {
    float ss = 0.f;
#pragma unroll
    for (int d0 = 0; d0 < 8; ++d0)
#pragma unroll
      for (int j = 0; j < 8; ++j) { const float x = bf2f((bf16_t)qr[d0][j]); ss += x * x; }
    { auto rr = __builtin_amdgcn_permlane32_swap(__float_as_uint(ss), __float_as_uint(ss), false, false); ss = __uint_as_float(rr[0]) + __uint_as_float(rr[1]); }
    const float rn = rsqrtf(ss * (1.f / 128.f) + EPS);
    float x01[2][8];
#pragma unroll
    for (int d0 = 0; d0 < 8; ++d0) { const f32x4 g0 = *(const f32x4*)(qgain + d0 * 16 + hi * 8), g1 = *(const f32x4*)(qgain + d0 * 16 + hi * 8 + 4);
      float x[8];
#pragma unroll
      for (int j = 0; j < 8; ++j) x[j] = bf2f((bf16_t)qr[d0][j]) * rn * (j < 4 ? g0[j] : g1[j - 4]);
      if (QT == 2 && d0 < 2) {
#pragma unroll
        for (int j = 0; j < 8; ++j) x01[d0][j] = x[j];
      } else { u32x4 w = {cvtpk(x[0], x[1]), cvtpk(x[2], x[3]), cvtpk(x[4], x[5]), cvtpk(x[6], x[7])}; qr[d0] = *reinterpret_cast<bf16x8*>(&w); } }
    if (QT == 2) {
      float a[8], b[8];
#pragma unroll
      for (int j2 = 0; j2 < 4; ++j2) { const f32x4 cs = *(const f32x4*)(qcs + hi * 16 + 4 * j2);
#pragma unroll
        for (int q = 0; q < 2; ++q) { const int j = 2 * j2 + q; const float c = cs[2 * q], sn = cs[2 * q + 1], x1 = x01[0][j], x2 = x01[1][j]; a[j] = x1 * c - x2 * sn; b[j] = x2 * c + x1 * sn; } }
      { u32x4 w = {cvtpk(a[0], a[1]), cvtpk(a[2], a[3]), cvtpk(a[4], a[5]), cvtpk(a[6], a[7])}; qr[0] = *reinterpret_cast<bf16x8*>(&w); }
      { u32x4 w = {cvtpk(b[0], b[1]), cvtpk(b[2], b[3]), cvtpk(b[4], b[5]), cvtpk(b[6], b[7])}; qr[1] = *reinterpret_cast<bf16x8*>(&w); }
    }
  }
  const int sr = tid >> 4, sc = (tid & 15) * 8, vst0 = v_st(sr, sc), vst1 = v_st(32 + sr, sc);
  const int vb0 = (int)(uintptr_t)V_lds + v_rd_base(lane);
  struct { bf16x8 vs0, vs1, ks0, ks1; } sr_[2];
  const unsigned koff = (unsigned)(sr * LDK + sc) * 2u;
#define SLOAD(i, k0) do { const char* kb_ = (const char*)Kh + (size_t)(k0) * (LDK * 2); \
    sr_[i].vs0 = *reinterpret_cast<const bf16x8*>(kb_ + koff + VOFF * 2); sr_[i].vs1 = *reinterpret_cast<const bf16x8*>(kb_ + koff + (32 * LDK + VOFF) * 2); \
    sr_[i].ks0 = *reinterpret_cast<const bf16x8*>(kb_ + koff); sr_[i].ks1 = *reinterpret_cast<const bf16x8*>(kb_ + koff + 32 * LDK * 2); } while (0)
#define SWRITE(b, i) do { *(bf16x8*)(V_lds + (b) * SHM_V + vst0) = sr_[i].vs0;          \
    *(bf16x8*)(V_lds + (b) * SHM_V + vst1) = sr_[i].vs1; int kc = sc * 2;               \
    *(bf16x8*)(K_lds + (b) * SHM_K + KSWZ(sr, kc)) = sr_[i].ks0;                       \
    *(bf16x8*)(K_lds + (b) * SHM_K + KSWZ(32 + sr, kc)) = sr_[i].ks1; } while (0)
#define SWAIT() asm volatile("s_waitcnt vmcnt(4)" ::: "memory")
#define RESC(a) do { if (__any((a) < 1.f)) { if (hi == 0) al_l[r32] = (a); asm volatile("s_waitcnt lgkmcnt(0)" ::: "memory"); \
    _Pragma("unroll") for (int d = 0; d < 4; ++d) _Pragma("unroll") for (int r = 0; r < 16; ++r) o[d][r] *= al_l[crow(r, hi)]; } } while (0)
  f32x16 pA0, pA1, pB0, pB1; float mnA, mnB, alA, alB; bf16x8 pa0, pa1, pa2, pa3;
  unsigned long long mw = 0ull;
  constexpr int SE = 0, SO = 1;
  if (MASKED) mw = *(const unsigned long long*)((const char*)mbase + moff);
  SLOAD(SE, 0); SLOAD(SO, KVBLK);
  SWAIT(); SWRITE(0, SE); __syncthreads();
  qkt<MASKED>(pA0, pA1, K_lds, qr, r32, hi, mw);
  if (MASKED) mw = *(const unsigned long long*)((const char*)mbase + (moff + 8u));
  partialSM<MASKED>(pA0, pA1, m_reg, mnA, alA, mw, hi);
  SLOAD(SE, (2 < NT ? 2 : NT - 1) * KVBLK);
  SWAIT();
  SWRITE(1, SO); __syncthreads();
  if (MASKED) TPU_START(120);
  for (int j = 1; j + 1 < NT; j += 2) {
    SBAR(); qkt<MASKED>(pB0, pB1, K_lds + SHM_K, qr, r32, hi, mw);
    if (MASKED) mw = *(const unsigned long long*)((const char*)mbase + (moff + 8u * (unsigned)(j + 1)));
    finishSM(pA0, pA1, alA, l_reg, pa0, pa1, pa2, pa3); SBAR();
    SLOAD(SO, (j + 2) * KVBLK); SBAR();
    pv_d0(o, vb0, pa0, pa1, pa2, pa3); partialSM<MASKED>(pB0, pB1, m_reg, mnB, alB, mw, hi);
    __syncthreads(); if (MASKED) asm volatile("s_waitcnt vmcnt(5)" ::: "memory"); else SWAIT();
    SWRITE(0, SE);
    RESC(alB); __syncthreads();
    SBAR(); qkt<MASKED>(pA0, pA1, K_lds, qr, r32, hi, mw);
    if (MASKED) mw = *(const unsigned long long*)((const char*)mbase + (moff + 8u * (unsigned)(j + 2)));
    finishSM(pB0, pB1, alB, l_reg, pa0, pa1, pa2, pa3); SBAR();
    SLOAD(SE, (j + 3 < NT ? j + 3 : NT - 1) * KVBLK); SBAR();
    pv_d0(o, vb0 + SHM_V, pa0, pa1, pa2, pa3); partialSM<MASKED>(pA0, pA1, m_reg, mnA, alA, mw, hi);
    __syncthreads(); if (MASKED) asm volatile("s_waitcnt vmcnt(5)" ::: "memory"); else SWAIT();
    SWRITE(1, SO);
    RESC(alA); __syncthreads();
  }
  SBAR(); qkt<MASKED>(pB0, pB1, K_lds + SHM_K, qr, r32, hi, mw);
  finishSM(pA0, pA1, alA, l_reg, pa0, pa1, pa2, pa3); SBAR();
  pv_d0(o, vb0, pa0, pa1, pa2, pa3); partialSM<MASKED>(pB0, pB1, m_reg, mnB, alB, mw, hi);
  __syncthreads(); RESC(alB);
  finishSM(pB0, pB1, alB, l_reg, pa0, pa1, pa2, pa3); SBAR();
  pv_d0(o, vb0 + SHM_V, pa0, pa1, pa2, pa3);
  if (MASKED) TPU_STOP(120);
  if (MASKED) TPU_START(121);
  u32x4 zr[8];
#pragma unroll
  for (int i = 0; i < 8; ++i) zr[i] = *(const u32x4*)(Ow.zrow(4 * i + (lane >> 4)) + 8 * (lane & 15));
  if (hi == 0) li_l[r32] = l_reg; asm volatile("s_waitcnt lgkmcnt(0)" ::: "memory");
  float rli[16];
#pragma unroll
  for (int r = 0; r < 16; ++r) rli[r] = __builtin_amdgcn_rcpf(li_l[crow(r, hi)]);
  __syncthreads();
  float* og_s = (float*)lds + wid * (32 * 132);
#pragma unroll
  for (int r = 0; r < 16; ++r) {
#pragma unroll
    for (int d0 = 0; d0 < 4; ++d0) og_s[crow(r, hi) * 132 + d0 * 32 + r32] = o[d0][r] * rli[r]; }
  asm volatile("" ::: "memory");
  { const int row = lane >> 1, half = lane & 1; const float* src = og_s + row * 132 + half * 64;
    float ss = 0.f;
#pragma unroll
    for (int i = 0; i < 16; ++i) { const f32x4 v = *(const f32x4*)(src + 4 * i); ss += v[0] * v[0] + v[1] * v[1] + v[2] * v[2] + v[3] * v[3]; }
    ss += shx(ss, 1);
    if (half == 0) og_s[row * 132 + 128] = rsqrtf(ss * (1.f / 128.f) + EPS); }
  asm volatile("s_waitcnt lgkmcnt(0)" ::: "memory");
#pragma unroll
  for (int i = 0; i < 8; ++i) { const int row = 4 * i + (lane >> 4), c8 = 8 * (lane & 15); const float* src = og_s + row * 132 + c8;
    const f32x4 a = *(const f32x4*)src, b2 = *(const f32x4*)(src + 4); const float rn = og_s[row * 132 + 128];
    float z[8], g[8];
    z[0] = __uint_as_float(zr[i].x << 16); z[1] = __uint_as_float(zr[i].x & 0xffff0000u); z[2] = __uint_as_float(zr[i].y << 16); z[3] = __uint_as_float(zr[i].y & 0xffff0000u);
    z[4] = __uint_as_float(zr[i].z << 16); z[5] = __uint_as_float(zr[i].z & 0xffff0000u); z[6] = __uint_as_float(zr[i].w << 16); z[7] = __uint_as_float(zr[i].w & 0xffff0000u);
#pragma unroll
    for (int q = 0; q < 4; ++q) { g[q] = a[q] * rn * siluf_(z[q]); g[4 + q] = b2[q] * rn * siluf_(z[4 + q]); }
    st8f(Ow.grow(row) + c8, g); }
  __syncthreads();
  if (MASKED) TPU_STOP(121);
#undef SLOAD
#undef SWRITE
#undef SWAIT
#undef RESC
}
}
constexpr size_t al256(size_t x) { return (x + 255) / 256 * 256; }
constexpr size_t WS_CTL   = 0;
constexpr size_t CTL_BYTES = 65536;
constexpr size_t WS_WINT  = WS_CTL + CTL_BYTES;
constexpr size_t WS_WOUTT = WS_WINT + al256((size_t)DEPTH * NPAD * DM * 2);
constexpr size_t WS_WKVT  = WS_WOUTT + al256((size_t)DEPTH * DM * MIX * 2);
constexpr size_t WS_WGLUT = WS_WKVT + al256((size_t)DEPTH * 1024 * DM * 2);
constexpr size_t WS_MEMN  = WS_WGLUT + al256((size_t)DEPTH * 512 * 512 * 2);
constexpr size_t WS_KVMEM = WS_MEMN + al256((size_t)NB * MEML * DM * 2);
constexpr size_t WS_XN    = WS_KVMEM + al256((size_t)NB * MEML * DEPTH * 1024 * 2);
constexpr size_t WS_P     = WS_XN + al256((size_t)NTOK * DM * 2);
constexpr size_t WS_XBUF  = WS_P + al256((size_t)NTOK * NPAD * 2);
constexpr size_t WS_OCAT  = WS_XBUF + al256((size_t)NTOK * DM * 4);
constexpr size_t WS_MASK  = WS_OCAT + al256((size_t)NTOK * MIX * 2);
constexpr size_t WS_IW    = WS_MASK + al256((size_t)NTOK * 64 * 8);
constexpr size_t WS_YBUF  = WS_IW + al256((size_t)NTOK * 16 * 4);
constexpr size_t WS_ROPE  = WS_YBUF + al256((size_t)NTOK * 512 * 2);
constexpr size_t WS_S5P   = WS_ROPE + al256((size_t)NTOK * 48 * 4);
constexpr size_t S5P_BYTES = (size_t)DEPTH * 32 * (64 * 2 + 64 * 2 + 64 * 16 * 2) * 4;
constexpr size_t WS_GLAS  = WS_S5P + al256(S5P_BYTES);
constexpr size_t WS_GLAD  = WS_GLAS + al256((size_t)NB * 64 * 4 * 64 * 128 * 4);
constexpr size_t WS_IKC   = WS_GLAD + al256((size_t)NB * 64 * 4 * 64 * 4);
constexpr size_t WS_KVC   = WS_IKC + al256((size_t)NTOK * 64 * 2);
constexpr size_t WS_IQL   = WS_KVC + al256((size_t)NTOK * 256 * 2);
constexpr size_t WS_SSQ   = WS_IQL + al256((size_t)NTOK * 64 * 2);
constexpr size_t DSP_SLOT = (size_t)(256 * 128 + 512) * 4;
constexpr size_t WS_DSP   = WS_SSQ + 256;
constexpr size_t WS_END   = WS_DSP + al256((size_t)160 * 2 * DSP_SLOT);

struct Params {
    const float* x; const float* mem; const int* pos; const float* ln_gain; const float* w_in; const float* gla_w_up; const float* gla_b_up;
    const float* s5_a_re; const float* s5_a_im; const float* s5_log_step; const float* s5_b_re; const float* s5_b_im; const float* s5_c_re; const float* s5_c_im;
    const float* s5_d; const float* s5_w_glu; const float* dsa_q_norm; const float* dsa_k_norm; const float* mem_norm; const float* w_mem_kv;
    const float* mem_q_norm; const float* mem_k_norm; const float* out_norm; const float* w_out;
    float* out;
    char* ws;
    __device__ __forceinline__ unsigned* ctl_() const { return (unsigned*)(ws + WS_CTL); }
    __device__ __forceinline__ bf16_t* WinT_() const { return (bf16_t*)(ws + WS_WINT); }
    __device__ __forceinline__ bf16_t* WoutT_() const { return (bf16_t*)(ws + WS_WOUTT); }
    __device__ __forceinline__ bf16_t* WkvT_() const { return (bf16_t*)(ws + WS_WKVT); }
    __device__ __forceinline__ bf16_t* WgluT_() const { return (bf16_t*)(ws + WS_WGLUT); }
    __device__ __forceinline__ bf16_t* memn_() const { return (bf16_t*)(ws + WS_MEMN); }
    __device__ __forceinline__ bf16_t* kvmem_() const { return (bf16_t*)(ws + WS_KVMEM); }
    __device__ __forceinline__ bf16_t* xn_() const { return (bf16_t*)(ws + WS_XN); }
    __device__ __forceinline__ bf16_t* p_() const { return (bf16_t*)(ws + WS_P); }
    __device__ __forceinline__ bf16_t* xbuf_() const { return (bf16_t*)(ws + WS_XBUF); }
    __device__ __forceinline__ bf16_t* ocat_() const { return (bf16_t*)(ws + WS_OCAT); }
    __device__ __forceinline__ unsigned long long* mask_() const { return (unsigned long long*)(ws + WS_MASK); }
    __device__ __forceinline__ float* iw_() const { return (float*)(ws + WS_IW); }
    __device__ __forceinline__ bf16_t* ybuf_() const { return (bf16_t*)(ws + WS_YBUF); }
    __device__ __forceinline__ float* rope_() const { return (float*)(ws + WS_ROPE); }
    __device__ __forceinline__ float* s5p_() const { return (float*)(ws + WS_S5P); }
    __device__ __forceinline__ float* glas_() const { return (float*)(ws + WS_GLAS); }
    __device__ __forceinline__ float* glad_() const { return (float*)(ws + WS_GLAD); }
    __device__ __forceinline__ bf16_t* ikc_() const { return (bf16_t*)(ws + WS_IKC); }
    __device__ __forceinline__ bf16_t* kvc_() const { return (bf16_t*)(ws + WS_KVC); }
    __device__ __forceinline__ float* ssq_() const { return (float*)(ws + WS_SSQ); }
    __device__ __forceinline__ bf16_t* iql_() const { return (bf16_t*)(ws + WS_IQL); }
    __device__ __forceinline__ char* dsp_() const { return ws + WS_DSP; }
};

__device__ __forceinline__ void transpose_tiles(const float* __restrict__ src, int K, int Nsrc, int Ndst, const float* __restrict__ scale, bf16_t* __restrict__ dst,
                                                int tile, float* lds_tile  ) {
    const int tid = TIDX(), ntn = Ndst / 256;
    const int tk = tile / ntn, tn = tile % ntn, k0 = tk * 64, n0 = tn * 256;
    __syncthreads();
    { const int ty = tid >> 4, tx = tid & 15;
      f32x4 v[2][4];
#pragma unroll
      for (int i = 0; i < 2; ++i)
#pragma unroll
        for (int q = 0; q < 4; ++q) { const int k = k0 + ty + 32 * i, n = n0 + 4 * tx + 64 * q;
          v[i][q] = (f32x4){0.f, 0.f, 0.f, 0.f};
          if (n < Nsrc) v[i][q] = *(const f32x4*)(src + (size_t)k * Nsrc + n); }
#pragma unroll
      for (int i = 0; i < 2; ++i) { const float s = scale ? scale[k0 + ty + 32 * i] : 1.f;
#pragma unroll
        for (int q = 0; q < 4; ++q) { float* t = lds_tile + (ty + 32 * i) * 257 + 4 * tx + 64 * q; t[0] = v[i][q][0] * s; t[1] = v[i][q][1] * s; t[2] = v[i][q][2] * s; t[3] = v[i][q][3] * s; } } }
    __syncthreads();
    { const int n = tid >> 1, kh = (tid & 1) * 32;
#pragma unroll
      for (int j = 0; j < 4; ++j) { const int kb = kh + 8 * j; u32x4 w;
        w.x = pk2bf(lds_tile[(kb + 0) * 257 + n], lds_tile[(kb + 1) * 257 + n]); w.y = pk2bf(lds_tile[(kb + 2) * 257 + n], lds_tile[(kb + 3) * 257 + n]);
        w.z = pk2bf(lds_tile[(kb + 4) * 257 + n], lds_tile[(kb + 5) * 257 + n]); w.w = pk2bf(lds_tile[(kb + 6) * 257 + n], lds_tile[(kb + 7) * 257 + n]);
        *(u32x4*)(dst + (size_t)(n0 + n) * K + k0 + kb) = w; } }
}

__device__ __forceinline__ void rmsnorm_rows(const float* __restrict__ X, bf16_t* __restrict__ Y, int nrows) {
    const int wid = TIDX() >> 6, lane = TIDX() & 63;
    for (int row = blockIdx.x * 8 + wid; row < nrows; row += gridDim.x * 8) {
        const float* xr = X + (size_t)row * DM; f32x4 v[8]; float ss = 0.f;
#pragma unroll
        for (int i = 0; i < 8; ++i) { v[i] = *(const f32x4*)(xr + 4 * lane + 256 * i); ss += v[i][0] * v[i][0] + v[i][1] * v[i][1] + v[i][2] * v[i][2] + v[i][3] * v[i][3]; }
        ss = wave_sum(ss); const float r = rsqrtf(ss * (1.f / DM) + EPS);
        bf16_t* yr = Y + (size_t)row * DM;
#pragma unroll
        for (int i = 0; i < 8; ++i) { u32x2 w; w.x = pk2bf(v[i][0] * r, v[i][1] * r); w.y = pk2bf(v[i][2] * r, v[i][3] * r); *(u32x2*)(yr + 4 * lane + 256 * i) = w; }
    }
}

__device__ __forceinline__ void rmsnorm_rows16(const bf16_t* __restrict__ X, bf16_t* __restrict__ Y, int nrows) {
    const int wid = TIDX() >> 6, lane = TIDX() & 63;
    for (int row = blockIdx.x * 8 + wid; row < nrows; row += gridDim.x * 8) {
        const bf16_t* xr = X + (size_t)row * DM; float v[4][8]; float ss = 0.f;
#pragma unroll
        for (int i = 0; i < 4; ++i) { ld8f(xr + 8 * lane + 512 * i, v[i]);
#pragma unroll
            for (int j = 0; j < 8; ++j) ss += v[i][j] * v[i][j]; }
        ss = wave_sum(ss); const float r = rsqrtf(ss * (1.f / DM) + EPS);
        bf16_t* yr = Y + (size_t)row * DM;
#pragma unroll
        for (int i = 0; i < 4; ++i) { float o[8];
#pragma unroll
            for (int j = 0; j < 8; ++j) o[j] = v[i][j] * r;
            st8f(yr + 8 * lane + 512 * i, o); }
    }
}

__device__ __forceinline__ void rows_bf16_ssq(const float* __restrict__ X, bf16_t* __restrict__ Y, float* __restrict__ ssq, int nrows) {
    const int wid = TIDX() >> 6, lane = TIDX() & 63;
    for (int row = blockIdx.x * 8 + wid; row < nrows; row += gridDim.x * 8) {
        const float* xr = X + (size_t)row * DM; bf16_t* yr = Y + (size_t)row * DM; float ss = 0.f;
#pragma unroll
        for (int i = 0; i < 8; ++i) { const f32x4 v = *(const f32x4*)(xr + 4 * lane + 256 * i); ss += v[0] * v[0] + v[1] * v[1] + v[2] * v[2] + v[3] * v[3];
            u32x2 w; w.x = pk2bf(v[0], v[1]); w.y = pk2bf(v[2], v[3]); *(u32x2*)(yr + 4 * lane + 256 * i) = w; }
        ss = wave_sum(ss); if (lane < 32) ssq[(size_t)row * 32 + lane] = (lane == 0) ? ss : 0.f;
    }
}
__device__ __forceinline__ void phase_prologue1(const Params& P, char* lds) {
    float* tile = (float*)lds;
    constexpr int T_IN = (DM / 64) * (NPAD / 256), T_OUT = (MIX / 64) * (DM / 256), T_KV = (DM / 64) * (1024 / 256), T_GLU = 8 * 2;
    constexpr int TOT = DEPTH * (T_IN + T_OUT + T_KV + T_GLU);
    for (int u = blockIdx.x; u < TOT; u += gridDim.x) {
        int l = u / (T_IN + T_OUT + T_KV + T_GLU), r = u % (T_IN + T_OUT + T_KV + T_GLU);
        if (r < T_IN) transpose_tiles(P.w_in + (size_t)l * DM * NIN, DM, NIN, NPAD, P.ln_gain + l * DM, P.WinT_() + (size_t)l * NPAD * DM, r, tile);
        else if ((r -= T_IN) < T_OUT) transpose_tiles(P.w_out + (size_t)l * MIX * DM, MIX, DM, DM, P.out_norm + l * MIX, P.WoutT_() + (size_t)l * DM * MIX, r, tile);
        else if ((r -= T_OUT) < T_KV) transpose_tiles(P.w_mem_kv + (size_t)l * DM * 1024, DM, 1024, 1024, P.mem_norm + l * DM, P.WkvT_() + (size_t)l * 1024 * DM, r, tile);
        else { r -= T_KV; transpose_tiles(P.s5_w_glu + (size_t)l * 512 * 512, 512, 512, 512, nullptr, P.WgluT_() + (size_t)l * 512 * 512, r, tile); }
    }
    rmsnorm_rows(P.mem, P.memn_(), NB * MEML);
}
__device__ __forceinline__ void phase_rope_table(const Params& P) {
    for (int idx = blockIdx.x * NTHR + TIDX(); idx < NTOK * 24; idx += gridDim.x * NTHR) {
        const int tok = idx / 24, i = idx % 24;
        const float e = (i < 16) ? -((float)i * 2.0f / 32.0f) : -((float)(i - 16) * 2.0f / 16.0f);
        const float inv_freq = exp2f(e * 18.931568569324174f);
        const float ang = (float)P.pos[tok] * inv_freq;
        const double a = (double)ang; const double k = rint(a * 0.15915494309189535); const float rf = (float)fma(-k, 6.283185307179586, a);
        P.rope_()[(size_t)idx * 2] = cosf(rf); P.rope_()[(size_t)idx * 2 + 1] = sinf(rf);
    }
}

__device__ __forceinline__ void phase_rmsnorm_x(const Params& P, int layer) { if (layer == 0) rmsnorm_rows(P.x, P.xn_(), NTOK); else rmsnorm_rows16(P.xbuf_(), P.xn_(), NTOK); }

__device__ __forceinline__ void phase_memk_norm(const Params& P) {
    const int wid = TIDX() >> 6, lane = TIDX() & 63;
    for (int it = blockIdx.x * 8 + wid; it < NB * MEML * DEPTH * 4; it += gridDim.x * 8) {
        const int row = it / (DEPTH * 4), l = (it / 4) % DEPTH, h = it % 4;
        bf16_t* kp = P.kvmem_() + (size_t)row * (DEPTH * 1024) + l * 1024 + h * 128 + 2 * lane;
        const unsigned w = *(const unsigned*)kp; const float a = __uint_as_float(w << 16), b = __uint_as_float(w & 0xffff0000u);
        const float ss = wave_sum(a * a + b * b), r = rsqrtf(ss * (1.f / 128.f) + EPS);
        const float* g = P.mem_k_norm + l * 128 + 2 * lane;
        *(unsigned*)kp = pk2bf(a * r * g[0], b * r * g[1]);
    }
}

__device__ __forceinline__ float sum16(float v) { v += shx(v, 1); v += shx(v, 2); v += shx(v, 4); v += shx(v, 8); return v; }

__device__ __forceinline__ void head128_norm_rope_to(const bf16_t* hp, bf16_t* dp, int l16, const float* __restrict__ gain, const float* __restrict__ cs, bool rope, bool do_store) {
    float v[8]; ld8f(hp + 8 * l16, v);
    float ss = 0.f;
#pragma unroll
    for (int j = 0; j < 8; ++j) ss += v[j] * v[j];
    ss = sum16(ss); const float r = rsqrtf(ss * (1.f / 128.f) + EPS);
#pragma unroll
    for (int j = 0; j < 8; ++j) v[j] = v[j] * r * gain[8 * l16 + j];
    if (rope) {
        float o[8];
#pragma unroll
        for (int j = 0; j < 8; ++j) o[j] = shx(v[j], 2);
        if (l16 < 4) { const int fi = (l16 & 1) * 8;
#pragma unroll
            for (int j = 0; j < 8; ++j) { const float c = cs[(fi + j) * 2], s = cs[(fi + j) * 2 + 1];
                v[j] = (l16 < 2) ? (v[j] * c - o[j] * s) : (v[j] * c + o[j] * s); } }
    }
    if (do_store) st8f(dp + 8 * l16, v);
}
__device__ __forceinline__ void head128_norm_rope(bf16_t* hp, int l16, const float* __restrict__ gain, const float* __restrict__ cs, bool rope, bool do_store) { head128_norm_rope_to(hp, hp, l16, gain, cs, rope, do_store); }
__device__ __forceinline__ void rope16_inplace(bf16_t* ip, const float* __restrict__ cs) {
    float a[8], b[8]; ld8f(ip, a); ld8f(ip + 8, b);
#pragma unroll
    for (int j = 0; j < 8; ++j) { const float c = cs[2 * j], s = cs[2 * j + 1], x1 = a[j], x2 = b[j]; a[j] = x1 * c - x2 * s; b[j] = x2 * c + x1 * s; }
    st8f(ip, a); st8f(ip + 8, b);
}
struct PrepIn { u32x4 k, i0, i1, ik0, ik1, v; bf16_t w; f32x4 c32[4], c16[4]; };
__device__ __forceinline__ void prep_load(const Params& P, int tok, int lane, PrepIn& I) {
    const int l16 = lane & 15, grp = lane >> 4;
    const bf16_t* row = P.p_() + (size_t)tok * NPAD;
    I.k = *(const u32x4*)(row + C_DK + 8 * l16);
    I.i0 = *(const u32x4*)(row + C_DIQ + (lane >> 2) * 64); I.i1 = *(const u32x4*)(row + C_DIQ + (lane >> 2) * 64 + 8);
    I.ik0 = *(const u32x4*)(row + C_DIK + (lane & 3) * 16); I.ik1 = *(const u32x4*)(row + C_DIK + (lane & 3) * 16 + 8);
    I.v = *(const u32x4*)(row + C_DV + l16 * 8);
    I.w = row[C_DIW + l16];
    const float* cs32 = P.rope_() + (size_t)tok * 48;
#pragma unroll
    for (int i = 0; i < 4; ++i) { I.c32[i] = *(const f32x4*)(cs32 + (l16 & 1) * 16 + 4 * i); I.c16[i] = *(const f32x4*)(cs32 + 32 + 4 * i); }
}
__device__ __forceinline__ void unpack8(const u32x4 w, float (&v)[8]) {
    v[0] = __uint_as_float(w.x << 16); v[1] = __uint_as_float(w.x & 0xffff0000u); v[2] = __uint_as_float(w.y << 16); v[3] = __uint_as_float(w.y & 0xffff0000u);
    v[4] = __uint_as_float(w.z << 16); v[5] = __uint_as_float(w.z & 0xffff0000u); v[6] = __uint_as_float(w.w << 16); v[7] = __uint_as_float(w.w & 0xffff0000u); }
__device__ __forceinline__ void head128_nr(float (&v)[8], int l16, const float (&gain)[8], const f32x4 (&cs)[4], bool rope) {
    float ss = 0.f;
#pragma unroll
    for (int j = 0; j < 8; ++j) ss += v[j] * v[j];
    ss = sum16(ss); const float r = rsqrtf(ss * (1.f / 128.f) + EPS);
#pragma unroll
    for (int j = 0; j < 8; ++j) v[j] = v[j] * r * gain[j];
    if (rope) {
        float o[8];
#pragma unroll
        for (int j = 0; j < 8; ++j) o[j] = shx(v[j], 2);
        if (l16 < 4) {
#pragma unroll
            for (int j = 0; j < 8; ++j) { const float c = cs[j >> 1][(j & 1) * 2], s = cs[j >> 1][(j & 1) * 2 + 1];
                v[j] = (l16 < 2) ? (v[j] * c - o[j] * s) : (v[j] * c + o[j] * s); } }
    }
}
__device__ __forceinline__ void prep_finish(const Params& P, int tok, int lane, const PrepIn& I, const float (&gq)[8], const float (&gk)[8], const float (&gm)[8]) {
    const int l16 = lane & 15, grp = lane >> 4;
    bf16_t* row = P.p_() + (size_t)tok * NPAD;
    float k[8];
    unpack8(I.k, k);
    head128_nr(k, l16, gk, I.c32, true);
    if (grp == 0) st8f(P.kvc_() + (size_t)tok * 256 + 8 * l16, k);
    {
        float a[8], b[8]; unpack8(I.i0, a); unpack8(I.i1, b);
#pragma unroll
        for (int j = 0; j < 8; ++j) { const float c = I.c16[j >> 1][(j & 1) * 2], s = I.c16[j >> 1][(j & 1) * 2 + 1], x1 = a[j], x2 = b[j]; a[j] = x1 * c - x2 * s; b[j] = x2 * c + x1 * s; }
        if ((lane & 3) == 0) { st8f(row + C_DIQ + (lane >> 2) * 64, a); st8f(row + C_DIQ + (lane >> 2) * 64 + 8, b); } }
    {
        float a[8], b[8]; unpack8(I.ik0, a); unpack8(I.ik1, b);
        if ((lane & 3) == 0) {
#pragma unroll
            for (int j = 0; j < 8; ++j) { const float c = I.c16[j >> 1][(j & 1) * 2], s = I.c16[j >> 1][(j & 1) * 2 + 1], x1 = a[j], x2 = b[j]; a[j] = x1 * c - x2 * s; b[j] = x2 * c + x1 * s; } }
        if (lane < 4) { bf16_t* dst = P.ikc_() + (size_t)(tok >> 5) * 2048 + lane * 512 + (tok & 31) * 8; st8f(dst, a); st8f(dst + 256, b); } }
    if (lane >= 16 && lane < 32) *(u32x4*)(P.kvc_() + (size_t)tok * 256 + 128 + l16 * 8) = I.v;
    if (lane < 16) P.iw_()[(size_t)tok * 16 + lane] = bf2f(I.w) * (1.f / 32.f);
}
__device__ __forceinline__ void phase_prep(const Params& P, int layer) {
    const int wid = TIDX() >> 6, lane = TIDX() & 63, l16 = lane & 15;
    float gq[8], gk[8], gm[8];
#pragma unroll
    for (int j = 0; j < 8; ++j) { gq[j] = P.dsa_q_norm[layer * 128 + 8 * l16 + j]; gk[j] = P.dsa_k_norm[layer * 128 + 8 * l16 + j]; gm[j] = P.mem_q_norm[layer * 128 + 8 * l16 + j]; }
    const int stride = gridDim.x * 8;
    for (int tok = blockIdx.x * 8 + wid; tok < NTOK; tok += 2 * stride) {
        const int tok2 = tok + stride; const bool two = tok2 < NTOK;
        PrepIn A, B2;
        prep_load(P, tok, lane, A); prep_load(P, two ? tok2 : tok, lane, B2);
        prep_finish(P, tok, lane, A, gq, gk, gm);
        if (two) prep_finish(P, tok2, lane, B2, gq, gk, gm);
    }
}
struct MemOutRow { const bf16_t* zb; bf16_t* gb;
    __device__ __forceinline__ const bf16_t* zrow(int r) const { return zb + (size_t)r * NPAD; } __device__ __forceinline__ bf16_t* grow(int r) const { return gb + (size_t)r * MIX; } };
__device__ __forceinline__ void unit_mem_attn(const Params& P, int layer, int u, char* lds) {
    const int b = u >> 6, h = (u >> 4) & 3, qb = u & 15, tok0 = b * SEQ + qb * 256;
    const int wid = TIDX() >> 6, lane = TIDX() & 63, r32 = lane & 31, hi = lane >> 5;
    const bf16_t* Qw = P.p_() + (size_t)(tok0 + wid * 32 + r32) * NPAD + C_MQ + h * 128 + hi * 8;
    const bf16_t* Kh = P.kvmem_() + (size_t)(b * MEML) * (DEPTH * 1024) + layer * 1024 + h * 128;
    MemOutRow ow; ow.zb = P.p_() + (size_t)(tok0 + wid * 32) * NPAD + C_MZ + h * 128; ow.gb = P.xn_() + (size_t)(tok0 + wid * 32) * MIX + 1536 + h * 128;
    att::attn_body<false, DEPTH * 1024, 512, 1, MemOutRow>(Qw, P.mem_q_norm + layer * 128, nullptr, Kh, MEML / 64, nullptr, 0u, ow, lds);
}

__device__ __forceinline__ void phase_gate(const Params& P, int c_lo, int c_hi) {
    const int wid = TIDX() >> 6, lane = TIDX() & 63;
    const int c0 = lane * 32;
    const int seg = c0 >> 9, zc = (seg == 0 ? C_GZ : seg == 1 ? C_SZ : seg == 2 ? C_DZ : C_MZ) + (c0 & 511);
    const bool act = (c0 >= c_lo) && (c0 < c_hi);
    for (int tok = blockIdx.x * 8 + wid; tok < NTOK; tok += gridDim.x * 8) {
        if (!act) { bf16_t* gz_ = P.xn_() + (size_t)tok * MIX + c0; const u32x4 zz = {0u, 0u, 0u, 0u};
#pragma unroll
            for (int i = 0; i < 4; ++i) *(u32x4*)(gz_ + 8 * i) = zz;
            continue; }
        const bf16_t* op = P.ocat_() + (size_t)tok * MIX + c0; const bf16_t* zp = P.p_() + (size_t)tok * NPAD + zc; bf16_t* gp = P.xn_() + (size_t)tok * MIX + c0;
        float o[32]; float ss = 0.f;
#pragma unroll
        for (int i = 0; i < 4; ++i) { float v[8]; ld8f(op + 8 * i, v);
#pragma unroll
            for (int j = 0; j < 8; ++j) { o[8 * i + j] = v[j]; ss += v[j] * v[j]; } }
        ss += shx(ss, 1); ss += shx(ss, 2);
        const float r = rsqrtf(ss * (1.f / 128.f) + EPS);
#pragma unroll
        for (int i = 0; i < 4; ++i) { float z[8], g[8]; ld8f(zp + 8 * i, z);
#pragma unroll
            for (int j = 0; j < 8; ++j) g[j] = o[8 * i + j] * r * siluf_(z[j]);
            st8f(gp + 8 * i, g); }
    }
}

__device__ __forceinline__ void phase_gemm_in(const Params& P, int layer, char* lds) {
    pg8::Gemm g; g.A = P.xn_(); g.Bt = P.WinT_() + (size_t)layer * NPAD * DM; g.M = NTOK; g.N = NPAD; g.K = DM;
    pg8::StaticOrder S; S.init(g.M, g.N, (int)gridDim.x, (int)blockIdx.x);
    pg8::EpiBf16Plain E; E.O = P.p_(); E.ldc = NPAD;
    pg8::gemm_phase<pg8::EpiBf16Plain, pg8::StaticOrder, false>((PG8_LAS unsigned char*)lds, g, S, E, nullptr);
}
__device__ __forceinline__ void phase_gemm_out(const Params& P, int layer, char* lds) {
    pg8::Gemm g; g.A = P.xn_(); g.Bt = P.WoutT_() + (size_t)layer * DM * MIX; g.M = NTOK; g.N = DM; g.K = MIX;
    pg8::StaticOrder S; S.init(g.M, g.N, (int)gridDim.x, (int)blockIdx.x);
    pg8::EpiResidMix E; E.R = (layer == 0) ? (const void*)P.x : (const void*)P.xbuf_(); E.C = (layer == DEPTH - 1) ? (void*)P.out : (void*)P.xbuf_(); E.ldc = DM;
    E.r16 = (layer != 0); E.c16 = (layer != DEPTH - 1);
    pg8::gemm_phase<pg8::EpiResidMix, pg8::StaticOrder, false>((PG8_LAS unsigned char*)lds, g, S, E, nullptr);
}
__device__ __forceinline__ void phase_gemm_kv(const Params& P, char* lds) {
    pg8::Gemm g; g.A = P.memn_(); g.Bt = P.WkvT_(); g.M = NB * MEML; g.N = DEPTH * 1024; g.K = DM;
    pg8::StaticOrder S; S.init(g.M, g.N, (int)gridDim.x, (int)blockIdx.x);
    pg8::EpiBf16Plain E; E.O = P.kvmem_(); E.ldc = DEPTH * 1024;
    pg8::gemm_phase<pg8::EpiBf16Plain, pg8::StaticOrder, false>((PG8_LAS unsigned char*)lds, g, S, E, nullptr);
}
__device__ __forceinline__ void mma_tile(f32x16& acc, const char* A, int lda, const char* B, int ldb, int K, int lane) {
    const int r = lane & 31, kh = lane >> 5;
    const char* ap = A + r * lda + kh * 16; const char* bp = B + r * ldb + kh * 16;
    asm volatile("" : "+v"(acc));
    for (int k = 0; k < K; k += 16) {
        const bf16x8 a = *(const bf16x8*)(ap + k * 2); const bf16x8 b = *(const bf16x8*)(bp + k * 2);
        acc = __builtin_amdgcn_mfma_f32_32x32x16_bf16(a, b, acc, 0, 0, 0);
    }
}
__device__ __forceinline__ int crow32(int r, int hi) { return (r & 3) + 8 * (r >> 2) + 4 * hi; }
__device__ __forceinline__ float log_sigmoid_(float x) { return fminf(x, 0.f) - log1pf(__expf(-fabsf(x))); }

constexpr int GLA_ST = 144;
constexpr int GC_BST = 68;
constexpr int GC_B_BYTES = 4 * 64 * GC_BST * 4, GC_V_BYTES = 4 * 16384;
__device__ __forceinline__ float* gla_gb(const Params& P) { return (float*)((char*)P.ocat_() + (size_t)32 * 1024 * 1024); }
__device__ __forceinline__ float log_sigmoid_fast(float x) { return fminf(x, 0.f) - __logf(1.f + __expf(-fabsf(x))); }

__device__ __forceinline__ void unit_gla_a4(const Params& P, int layer, int ub, char* lds) {
    const int b = ub >> 6, n = ub & 63, tok0 = b * SEQ + n * 64;
    const int tid = TIDX(), wid = tid >> 6, lane = tid & 63, r32 = lane & 31, hi = lane >> 5, h = wid >> 1, eh = wid & 1;
    float* b_s = (float*)lds;
    char* V_s = lds;
    char* K_s = lds + GC_B_BYTES;
    float* glr_s = (float*)(lds + GC_B_BYTES + GC_V_BYTES);
    float* tot_s = glr_s + 1024;
    __syncthreads();
    const bf16_t* prow = P.p_() + (size_t)tok0 * NPAD;
    const bf16x8 glr_raw = *(const bf16x8*)(prow + (size_t)((tid & 127) >> 1) * NPAD + C_GLR + (tid & 1) * 8);
    const int gd = tid & 63, gh = (tid >> 6) & 3, gt = tid >> 8;
    float wu[16];
#pragma unroll
    for (int r = 0; r < 16; ++r) wu[r] = P.gla_w_up[((size_t)layer * 16 + r) * 256 + gh * 64 + gd];
    const float bias = P.gla_b_up[layer * 256 + gh * 64 + gd];
    bf16x8 kraw[4], vs[4][2];
    const int ks_ = tid >> 3, kc = (tid & 7) * 8;
#pragma unroll
    for (int hv = 0; hv < 4; ++hv) kraw[hv] = *(const bf16x8*)(prow + (size_t)ks_ * NPAD + C_GK + hv * 64 + kc);
    const int sr = tid >> 4, sc = (tid & 15) * 8;
#pragma unroll
    for (int hv = 0; hv < 4; ++hv) { vs[hv][0] = *(const bf16x8*)(prow + (size_t)sr * NPAD + C_GV + hv * 128 + sc); vs[hv][1] = *(const bf16x8*)(prow + (size_t)(32 + sr) * NPAD + C_GV + hv * 128 + sc); }
    if (tid < 128) {
#pragma unroll
        for (int j = 0; j < 8; ++j) glr_s[(tid >> 1) * 16 + (tid & 1) * 8 + j] = bf2f((bf16_t)glr_raw[j]); }
    __syncthreads();
    float gv[32]; float run = 0.f;
#pragma unroll
    for (int i = 0; i < 32; ++i) { const float* gr = glr_s + (gt * 32 + i) * 16; float a = bias;
#pragma unroll
        for (int r4 = 0; r4 < 4; ++r4) { const f32x4 g4 = *(const f32x4*)(gr + 4 * r4); a = fmaf(g4[0], wu[4 * r4], a); a = fmaf(g4[1], wu[4 * r4 + 1], a); a = fmaf(g4[2], wu[4 * r4 + 2], a); a = fmaf(g4[3], wu[4 * r4 + 3], a); }
        run += log_sigmoid_fast(a) * (1.f / 16.f); gv[i] = run; }
    if (gt == 0) tot_s[gh * 64 + gd] = run;
    __syncthreads();
    { const float off = gt ? tot_s[gh * 64 + gd] : 0.f; float* bp = b_s + (gh * 64 + gt * 32) * GC_BST + gd;
      float* gp = gla_gb(P) + (size_t)(tok0 + gt * 32) * 256 + gh * 64 + gd;
#pragma unroll
      for (int i = 0; i < 32; ++i) { const float v = gv[i] + off; bp[i * GC_BST] = v; gp[(size_t)i * 256] = v; }
      if (gt) P.glad_()[((size_t)((b * 64 + n) * 4 + gh)) * 64 + gd] = __expf(gv[31] + off); }
    __syncthreads();
#pragma unroll
    for (int hv = 0; hv < 4; ++hv) { const float* br = b_s + (hv * 64 + ks_) * GC_BST + kc; const float* bl = b_s + (hv * 64 + 63) * GC_BST + kc;
        const f32x4 b0 = *(const f32x4*)br, b1 = *(const f32x4*)(br + 4), l0 = *(const f32x4*)bl, l1 = *(const f32x4*)(bl + 4);
        float e[8];
#pragma unroll
        for (int j = 0; j < 8; ++j) e[j] = bf2f((bf16_t)kraw[hv][j]) * __expf((j < 4 ? l0[j] : l1[j - 4]) - (j < 4 ? b0[j] : b1[j - 4]));
        u32x4 w = {att::cvtpk(e[0], e[1]), att::cvtpk(e[2], e[3]), att::cvtpk(e[4], e[5]), att::cvtpk(e[6], e[7])};
        *(u32x4*)(K_s + hv * 16384 + att::v_st(ks_, kc)) = w; }
    __syncthreads();
    { const int vst0 = att::v_st(sr, sc), vst1 = att::v_st(32 + sr, sc);
#pragma unroll
      for (int hv = 0; hv < 4; ++hv) { *(bf16x8*)(V_s + hv * 16384 + vst0) = vs[hv][0]; *(bf16x8*)(V_s + hv * 16384 + vst1) = vs[hv][1]; } }
    __syncthreads();
    const int vb = (int)(uintptr_t)(V_s + h * 16384) + att::v_rd_base(lane), kb = (int)(uintptr_t)(K_s + h * 16384) + att::v_rd_base(lane);
    f32x16 acc[2][2] = {};
    asm volatile("" : "+v"(acc[0][0]), "+v"(acc[0][1]), "+v"(acc[1][0]), "+v"(acc[1][1]));
#define GA_PK(L, H) (bf16x8){L[0], L[1], L[2], L[3], H[0], H[1], H[2], H[3]}
#define GA_STEP(KS) do { \
    const s16x4 k0l = att::tr_read<att::v_rd_off(0, KS, 0)>(kb), k0h = att::tr_read<att::v_rd_off(0, KS, 1)>(kb), k1l = att::tr_read<att::v_rd_off(1, KS, 0)>(kb), k1h = att::tr_read<att::v_rd_off(1, KS, 1)>(kb); \
    s16x4 v0l, v0h, v1l, v1h; \
    if (eh == 0) { v0l = att::tr_read<att::v_rd_off(0, KS, 0)>(vb); v0h = att::tr_read<att::v_rd_off(0, KS, 1)>(vb); v1l = att::tr_read<att::v_rd_off(1, KS, 0)>(vb); v1h = att::tr_read<att::v_rd_off(1, KS, 1)>(vb); } \
    else         { v0l = att::tr_read<att::v_rd_off(2, KS, 0)>(vb); v0h = att::tr_read<att::v_rd_off(2, KS, 1)>(vb); v1l = att::tr_read<att::v_rd_off(3, KS, 0)>(vb); v1h = att::tr_read<att::v_rd_off(3, KS, 1)>(vb); } \
    asm volatile("s_waitcnt lgkmcnt(0)" ::: "memory"); __builtin_amdgcn_sched_barrier(0); \
    acc[0][0] = __builtin_amdgcn_mfma_f32_32x32x16_bf16(GA_PK(v0l, v0h), GA_PK(k0l, k0h), acc[0][0], 0, 0, 0); \
    acc[0][1] = __builtin_amdgcn_mfma_f32_32x32x16_bf16(GA_PK(v0l, v0h), GA_PK(k1l, k1h), acc[0][1], 0, 0, 0); \
    acc[1][0] = __builtin_amdgcn_mfma_f32_32x32x16_bf16(GA_PK(v1l, v1h), GA_PK(k0l, k0h), acc[1][0], 0, 0, 0); \
    acc[1][1] = __builtin_amdgcn_mfma_f32_32x32x16_bf16(GA_PK(v1l, v1h), GA_PK(k1l, k1h), acc[1][1], 0, 0, 0); } while (0)
    GA_STEP(0); GA_STEP(1); GA_STEP(2); GA_STEP(3);
#undef GA_STEP
#undef GA_PK
    float* dst = P.glas_() + ((size_t)((b * 64 + n) * 4 + h)) * 8192;
#pragma unroll
    for (int et = 0; et < 2; ++et)
#pragma unroll
        for (int dt = 0; dt < 2; ++dt)
#pragma unroll
            for (int r = 0; r < 16; ++r) dst[((eh * 2 + et) * 32 + att::crow(r, hi)) * 64 + dt * 32 + r32] = acc[et][dt][r];
    __syncthreads();
}

__device__ __forceinline__ void gla_scan_slice(const Params& P, int idx) {
    {
        const int el = idx & 8191, d = idx & 63, h = (idx >> 13) & 3, b = idx >> 15;
        bf16_t* gst = P.ocat_();
        float S = 0.f;
        for (int n0 = 0; n0 < 64; n0 += 8) {
            float ds[8], dc[8];
#pragma unroll
            for (int i = 0; i < 8; ++i) { const size_t cu = (size_t)((b * 64 + n0 + i) * 4 + h); ds[i] = P.glas_()[cu * 8192 + el]; dc[i] = P.glad_()[cu * 64 + d]; }
#pragma unroll
            for (int i = 0; i < 8; ++i) { const size_t cu = (size_t)((b * 64 + n0 + i) * 4 + h); gst[cu * 8192 + el] = f2bf(S); S = fmaf(dc[i], S, ds[i]); }
        }
    }
}

__device__ __forceinline__ void unit_gla_c4(const Params& P, int layer, int ub, char* lds) {
    const int b = ub >> 6, n = ub & 63, tok0 = b * SEQ + n * 64;
    const int tid = TIDX(), wid = tid >> 6, lane = tid & 63, r32 = lane & 31, hi = lane >> 5, h = wid >> 1, rh = wid & 1;
    float* b_s = (float*)lds;
    char* V_s = lds + GC_B_BYTES;
    __syncthreads();
    const bf16_t* prow = P.p_() + (size_t)tok0 * NPAD;
    bf16x8 qraw[4], kraw[2][4], vs[4][2];
    const int sr = tid >> 4, sc = (tid & 15) * 8;
#pragma unroll
    for (int hv = 0; hv < 4; ++hv) { vs[hv][0] = *(const bf16x8*)(prow + (size_t)sr * NPAD + C_GV + hv * 128 + sc); vs[hv][1] = *(const bf16x8*)(prow + (size_t)(32 + sr) * NPAD + C_GV + hv * 128 + sc); }
    f32x4 braw[8];
    { const float* gp = gla_gb(P) + (size_t)tok0 * 256 + tid * 4;
#pragma unroll
      for (int i = 0; i < 8; ++i) braw[i] = *(const f32x4*)(gp + i * 2048); }
    { const bf16_t* qp = prow + (size_t)(rh * 32 + r32) * NPAD + C_GQ + h * 64 + hi * 8;
#pragma unroll
      for (int d0 = 0; d0 < 4; ++d0) qraw[d0] = *(const bf16x8*)(qp + d0 * 16);
#pragma unroll
      for (int sh = 0; sh < 2; ++sh) { const bf16_t* kp = prow + (size_t)(sh * 32 + r32) * NPAD + C_GK + h * 64 + hi * 8;
#pragma unroll
          for (int d0 = 0; d0 < 4; ++d0) kraw[sh][d0] = *(const bf16x8*)(kp + d0 * 16); } }
    bf16x8 sfr[4][4];
    { const bf16_t* sp = P.ocat_() + ((size_t)((b * 64 + n) * 4 + h)) * 8192 + r32 * 64 + hi * 8;
#pragma unroll
      for (int eb = 0; eb < 4; ++eb)
#pragma unroll
          for (int ds = 0; ds < 4; ++ds) sfr[eb][ds] = *(const bf16x8*)(sp + eb * 32 * 64 + ds * 16); }
    { const int vst0 = att::v_st(sr, sc), vst1 = att::v_st(32 + sr, sc);
#pragma unroll
      for (int hv = 0; hv < 4; ++hv) { *(bf16x8*)(V_s + hv * 16384 + vst0) = vs[hv][0]; *(bf16x8*)(V_s + hv * 16384 + vst1) = vs[hv][1]; } }
#pragma unroll
    for (int i = 0; i < 8; ++i) { const int c = tid + 512 * i, t = c >> 6, c4 = c & 63;
        *(f32x4*)(b_s + ((c4 >> 4) * 64 + t) * GC_BST + (c4 & 15) * 4) = braw[i]; }
    __syncthreads();
    const float* bh = b_s + h * 64 * GC_BST + hi * 8;
    bf16x8 qe[4], qb[4], ke[2][4];
#pragma unroll
    for (int d0 = 0; d0 < 4; ++d0) {
        const f32x4 m0 = *(const f32x4*)(bh + 32 * GC_BST + d0 * 16), m1 = *(const f32x4*)(bh + 32 * GC_BST + d0 * 16 + 4);
        const f32x4 q0 = *(const f32x4*)(bh + (rh * 32 + r32) * GC_BST + d0 * 16), q1 = *(const f32x4*)(bh + (rh * 32 + r32) * GC_BST + d0 * 16 + 4);
        float e1[8], e2[8];
#pragma unroll
        for (int j = 0; j < 8; ++j) { const float mv = j < 4 ? m0[j] : m1[j - 4], bq = j < 4 ? q0[j] : q1[j - 4]; const float q = bf2f((bf16_t)qraw[d0][j]) * 0.125f;
            e1[j] = q * __expf(bq - mv); e2[j] = q * __expf(bq); }
        { u32x4 w = {att::cvtpk(e1[0], e1[1]), att::cvtpk(e1[2], e1[3]), att::cvtpk(e1[4], e1[5]), att::cvtpk(e1[6], e1[7])}; qe[d0] = *reinterpret_cast<bf16x8*>(&w); }
        { u32x4 w = {att::cvtpk(e2[0], e2[1]), att::cvtpk(e2[2], e2[3]), att::cvtpk(e2[4], e2[5]), att::cvtpk(e2[6], e2[7])}; qb[d0] = *reinterpret_cast<bf16x8*>(&w); }
#pragma unroll
        for (int sh = 0; sh < 2; ++sh) {
            const f32x4 k0 = *(const f32x4*)(bh + (sh * 32 + r32) * GC_BST + d0 * 16), k1 = *(const f32x4*)(bh + (sh * 32 + r32) * GC_BST + d0 * 16 + 4);
            float e3[8];
#pragma unroll
            for (int j = 0; j < 8; ++j) { const float mv = j < 4 ? m0[j] : m1[j - 4], bk = j < 4 ? k0[j] : k1[j - 4]; e3[j] = bf2f((bf16_t)kraw[sh][d0][j]) * __expf(mv - bk); }
            u32x4 w = {att::cvtpk(e3[0], e3[1]), att::cvtpk(e3[2], e3[3]), att::cvtpk(e3[4], e3[5]), att::cvtpk(e3[6], e3[7])}; ke[sh][d0] = *reinterpret_cast<bf16x8*>(&w); }
    }
    f32x16 p0 = {}, p1 = {};
    asm volatile("" : "+v"(p0), "+v"(p1));
#pragma unroll
    for (int d0 = 0; d0 < 4; ++d0) { p0 = __builtin_amdgcn_mfma_f32_32x32x16_bf16(ke[0][d0], qe[d0], p0, 0, 0, 0); p1 = __builtin_amdgcn_mfma_f32_32x32x16_bf16(ke[1][d0], qe[d0], p1, 0, 0, 0); }
    { const int t = rh * 32 + r32;
#pragma unroll
      for (int r = 0; r < 16; ++r) { const int s0 = att::crow(r, hi); p0[r] = (s0 <= t) ? p0[r] : 0.f; p1[r] = (32 + s0 <= t) ? p1[r] : 0.f; } }
    bf16x8 pa0, pa1, pa2, pa3;
#define GC_PK4(Pv, BASE, OUT) do { unsigned a0 = att::cvtpk(Pv[BASE + 0], Pv[BASE + 1]), a1 = att::cvtpk(Pv[BASE + 2], Pv[BASE + 3]);   \
    unsigned b0 = att::cvtpk(Pv[BASE + 4], Pv[BASE + 5]), b1 = att::cvtpk(Pv[BASE + 6], Pv[BASE + 7]);                              \
    auto r0 = __builtin_amdgcn_permlane32_swap(a0, b0, false, false); auto r1 = __builtin_amdgcn_permlane32_swap(a1, b1, false, false); \
    u32x4 w = {r0[0], r1[0], r0[1], r1[1]}; OUT = *reinterpret_cast<bf16x8*>(&w); } while (0)
    GC_PK4(p0, 0, pa0); GC_PK4(p0, 8, pa1); GC_PK4(p1, 0, pa2); GC_PK4(p1, 8, pa3);
#undef GC_PK4
    f32x16 o[4] = {};
    asm volatile("" : "+v"(o[0]), "+v"(o[1]), "+v"(o[2]), "+v"(o[3]));
    att::pv_d0(o, (int)(uintptr_t)(V_s + h * 16384) + att::v_rd_base(lane), pa0, pa1, pa2, pa3);
#pragma unroll
    for (int eb = 0; eb < 4; ++eb)
#pragma unroll
        for (int ds = 0; ds < 4; ++ds) o[eb] = __builtin_amdgcn_mfma_f32_32x32x16_bf16(qb[ds], sfr[eb][ds], o[eb], 0, 0, 0);
    u32x4 zr[8];
#pragma unroll
    for (int i = 0; i < 8; ++i) zr[i] = *(const u32x4*)(P.p_() + (size_t)(tok0 + rh * 32 + 4 * i + (lane >> 4)) * NPAD + C_GZ + h * 128 + 8 * (lane & 15));
    __syncthreads();
    float* og_s = (float*)lds + wid * (32 * 132);
#pragma unroll
    for (int r = 0; r < 16; ++r) {
#pragma unroll
        for (int eb = 0; eb < 4; ++eb) og_s[att::crow(r, hi) * 132 + eb * 32 + r32] = o[eb][r]; }
    asm volatile("" ::: "memory");
    { const int row = lane >> 1, half = lane & 1; const float* src = og_s + row * 132 + half * 64;
      float ss = 0.f;
#pragma unroll
      for (int i = 0; i < 16; ++i) { const f32x4 v = *(const f32x4*)(src + 4 * i); ss += v[0] * v[0] + v[1] * v[1] + v[2] * v[2] + v[3] * v[3]; }
      ss += shx(ss, 1);
      if (half == 0) og_s[row * 132 + 128] = rsqrtf(ss * (1.f / 128.f) + EPS); }
    asm volatile("s_waitcnt lgkmcnt(0)" ::: "memory");
#pragma unroll
    for (int i = 0; i < 8; ++i) { const int row = 4 * i + (lane >> 4), c8 = 8 * (lane & 15); const float* src = og_s + row * 132 + c8;
      const f32x4 a = *(const f32x4*)src, b2 = *(const f32x4*)(src + 4); const float rn = og_s[row * 132 + 128];
      float z[8], gg[8];
      z[0] = __uint_as_float(zr[i].x << 16); z[1] = __uint_as_float(zr[i].x & 0xffff0000u); z[2] = __uint_as_float(zr[i].y << 16); z[3] = __uint_as_float(zr[i].y & 0xffff0000u);
      z[4] = __uint_as_float(zr[i].z << 16); z[5] = __uint_as_float(zr[i].z & 0xffff0000u); z[6] = __uint_as_float(zr[i].w << 16); z[7] = __uint_as_float(zr[i].w & 0xffff0000u);
#pragma unroll
      for (int q = 0; q < 4; ++q) { gg[q] = a[q] * rn * siluf_(z[q]); gg[4 + q] = b2[q] * rn * siluf_(z[4 + q]); }
      st8f(P.xn_() + (size_t)(tok0 + rh * 32 + row) * MIX + h * 128 + c8, gg); }
    __syncthreads();
}
constexpr int S5P_STRIDE = 2304;
__device__ __forceinline__ void phase_s5_params(const Params& P) {
    for (int idx = blockIdx.x * NTHR + TIDX(); idx < DEPTH * 32 * 64; idx += gridDim.x * NTHR) {
        const int p = idx & 63, lg = idx >> 6;
        const float ar = P.s5_a_re[idx], ai = P.s5_a_im[idx], step = expf(P.s5_log_step[lg]);
        const float mag = expf(ar * step), th = ai * step;
        const float lr = mag * cosf(th), li = mag * sinf(th);
        float* o = P.s5p_() + (size_t)lg * S5P_STRIDE;
        o[2 * p] = lr; o[2 * p + 1] = li;
        { const float mag512 = expf(512.f * ar * step); const double a = 512.0 * (double)th; const double k = rint(a * 0.15915494309189535); const float rf = (float)fma(-k, 6.283185307179586, a);
          o[128 + 2 * p] = mag512 * cosf(rf); o[128 + 2 * p + 1] = mag512 * sinf(rf); }
        const float xr = lr - 1.f, xi = li, den = 1.f / (ar * ar + ai * ai);
        const float fr = (xr * ar + xi * ai) * den, fi = (xi * ar - xr * ai) * den;
        for (int c = 0; c < 16; ++c) { const float br = P.s5_b_re[(size_t)idx * 16 + c], bi = P.s5_b_im[(size_t)idx * 16 + c];
            o[256 + (p * 16 + c) * 2] = fr * br - fi * bi; o[256 + (p * 16 + c) * 2 + 1] = fr * bi + fi * br; }
    }
}
__device__ __forceinline__ float gelu_tanh_(float x) { const float u = 0.7978845608028654f * (x + 0.044715f * x * x * x); const float e = __expf(-2.f * fabsf(u)); const float th = copysignf((1.f - e) * __builtin_amdgcn_rcpf(1.f + e), u); return 0.5f * x * (1.f + th); }

constexpr int S5_XST = 272;
constexpr int S5_UST = 48;
__device__ __forceinline__ float partner32(float v, int hi) { auto rr = __builtin_amdgcn_permlane32_swap(__float_as_uint(v), __float_as_uint(v), false, false); return __uint_as_float(hi ? rr[0] : rr[1]); }
struct S5Ctx { float l0r, l0i, l1r, l1i, q0r, q0i, q1r, q1i, dsk; char* Cm; char* Bb; char* Xs; char* Us; int lane, hi, j, rho; const bf16_t* ubase; bf16_t* ybase; };
template <bool OUT> __device__ __forceinline__ void s5_tile(const S5Ctx& C, int tok0, const bf16x8 w0, const bf16x8 w1, float& x0r, float& x0i, float& x1r, float& x1i) {
    const int hi = C.hi, j = C.j, lane = C.lane;
    if (hi == 0) { *(bf16x8*)(C.Us + C.rho * S5_UST) = w0; *(bf16x8*)(C.Us + C.rho * S5_UST + 16) = w1; }
    asm volatile("" ::: "memory");
    f32x16 a0 = {}, a1 = {}, a2 = {}, a3 = {};
    mma_tile(a0, C.Us, S5_UST, C.Bb, S5_UST, 16, lane); mma_tile(a1, C.Us, S5_UST, C.Bb + 32 * S5_UST, S5_UST, 16, lane);
    mma_tile(a2, C.Us, S5_UST, C.Bb + 64 * S5_UST, S5_UST, 16, lane); mma_tile(a3, C.Us, S5_UST, C.Bb + 96 * S5_UST, S5_UST, 16, lane);
    float s0r[16], s0i[16], s1r[16], s1i[16];
#pragma unroll
    for (int r = 0; r < 16; ++r) {
        const float n0r = fmaf(C.l0r, x0r, fmaf(-C.l0i, x0i, a0[r])), n0i = fmaf(C.l0r, x0i, fmaf(C.l0i, x0r, a1[r])); x0r = n0r; x0i = n0i; s0r[r] = n0r; s0i[r] = n0i;
        const float n1r = fmaf(C.l1r, x1r, fmaf(-C.l1i, x1i, a2[r])), n1i = fmaf(C.l1r, x1i, fmaf(C.l1i, x1r, a3[r])); x1r = n1r; x1i = n1i; s1r[r] = n1r; s1i[r] = n1i; }
    float z0r = partner32(x0r, hi), z0i = partner32(x0i, hi), z1r = partner32(x1r, hi), z1i = partner32(x1i, hi);
    if (hi == 0) { z0r = 0.f; z0i = 0.f; z1r = 0.f; z1i = 0.f; }
    if (!OUT) {
        x0r += C.q0r * z0r - C.q0i * z0i; x0i += C.q0r * z0i + C.q0i * z0r; x1r += C.q1r * z1r - C.q1i * z1i; x1i += C.q1r * z1i + C.q1i * z1r;
    } else {
#pragma unroll
        for (int r = 0; r < 16; ++r) {
            const float t0r = C.l0r * z0r - C.l0i * z0i, t0i = C.l0r * z0i + C.l0i * z0r; z0r = t0r; z0i = t0i; s0r[r] += t0r; s0i[r] += t0i;
            const float t1r = C.l1r * z1r - C.l1i * z1i, t1i = C.l1r * z1i + C.l1i * z1r; z1r = t1r; z1i = t1i; s1r[r] += t1r; s1i[r] += t1i; }
        x0r = s0r[15]; x0i = s0i[15]; x1r = s1r[15]; x1i = s1i[15];
#pragma unroll
        for (int r = 0; r < 16; ++r) { char* xr_ = C.Xs + (r + 16 * hi) * S5_XST;
            *(bf16_t*)(xr_ + j * 2) = f2bf(s0r[r]); *(bf16_t*)(xr_ + (64 + j) * 2) = f2bf(s0i[r]);
            *(bf16_t*)(xr_ + (32 + j) * 2) = f2bf(s1r[r]); *(bf16_t*)(xr_ + (96 + j) * 2) = f2bf(s1i[r]); }
        asm volatile("" ::: "memory");
        f32x16 acc = {}; mma_tile(acc, C.Xs, S5_XST, C.Cm, S5_XST, 128, lane);
        if (j < 16) {
#pragma unroll
            for (int r = 0; r < 16; ++r) { const int t = crow32(r, hi); const int rt = ((t & 15) & 3) + 8 * ((t & 15) >> 2) + 4 * (t >> 4);
                const float y = acc[r] + C.dsk * bf2f(*(const bf16_t*)(C.Us + rt * S5_UST + j * 2));
                C.ybase[(size_t)(tok0 + t) * 512 + j] = f2bf(gelu_tanh_(y)); } }
        asm volatile("" ::: "memory");
    }
    { const float e0r = partner32(x0r, hi), e0i = partner32(x0i, hi), e1r = partner32(x1r, hi), e1i = partner32(x1i, hi);
      if (hi == 0) { x0r = e0r; x0i = e0i; x1r = e1r; x1i = e1i; } else { x0r = 0.f; x0i = 0.f; x1r = 0.f; x1i = 0.f; } }
}
__device__ __forceinline__ void unit_s5(const Params& P, int layer, int u, char* lds) {
    const int b = u >> 5, g = u & 31, tid = TIDX(), wid = tid >> 6, lane = tid & 63, hi = lane >> 5, j = lane & 31;
    char* Cm = lds;
    char* Bb = Cm + 32 * S5_XST;
    float* ends = (float*)(Bb + 128 * S5_UST);
    char* wbase = (char*)(ends + 8 * 64 * 2) + wid * (32 * S5_XST + 32 * S5_UST);
    const float* sp = P.s5p_() + (size_t)(layer * 32 + g) * S5P_STRIDE;
    __syncthreads();
    for (int i = tid; i < 32 * 128; i += NTHR) { const int c = i >> 7, pp = i & 127; float v = 0.f;
        if (c < 16) v = (pp < 64) ? P.s5_c_re[((size_t)(layer * 32 + g) * 16 + c) * 64 + pp] : -P.s5_c_im[((size_t)(layer * 32 + g) * 16 + c) * 64 + (pp - 64)];
        *(bf16_t*)(Cm + c * S5_XST + pp * 2) = f2bf(v); }
    for (int i = tid; i < 128 * 16; i += NTHR) { const int n = i >> 4, c = i & 15, nt = n >> 5, jj = n & 31, p = (nt >> 1) * 32 + jj;
        *(bf16_t*)(Bb + n * S5_UST + c * 2) = f2bf(sp[256 + (p * 16 + c) * 2 + (nt & 1)]); }
    S5Ctx C; C.Cm = Cm; C.Bb = Bb; C.Xs = wbase; C.Us = wbase + 32 * S5_XST; C.lane = lane; C.hi = hi; C.j = j;
    C.l0r = sp[2 * j]; C.l0i = sp[2 * j + 1]; C.l1r = sp[2 * (32 + j)]; C.l1i = sp[2 * (32 + j) + 1];
    { float q0r = C.l0r, q0i = C.l0i, q1r = C.l1r, q1i = C.l1i;
#pragma unroll
      for (int k = 0; k < 4; ++k) { const float a = q0r * q0r - q0i * q0i, bb = (q0r + q0r) * q0i; q0r = a; q0i = bb; const float c = q1r * q1r - q1i * q1i, d = (q1r + q1r) * q1i; q1r = c; q1i = d; }
      C.q0r = q0r; C.q0i = q0i; C.q1r = q1r; C.q1i = q1i; }
    C.dsk = P.s5_d[layer * 512 + g * 16 + (lane & 15)];
    C.rho = ((j & 15) & 3) + 8 * ((j & 15) >> 2) + 4 * (j >> 4);
    const int tokw = b * SEQ + wid * 512;
    C.ubase = P.p_() + C_SU + g * 16; C.ybase = P.ybuf_() + g * 16;
    float x0r = 0.f, x0i = 0.f, x1r = 0.f, x1i = 0.f;
    __syncthreads();
    const bf16_t* urow = C.ubase + (size_t)(tokw + j) * NPAD;
    { bf16x8 w0 = *(const bf16x8*)urow, w1 = *(const bf16x8*)(urow + 8);
      for (int sc = 0; sc < 16; ++sc) { const bf16_t* un = urow + (size_t)((sc < 15 ? sc + 1 : 15) * 32) * NPAD;
          const bf16x8 n0 = *(const bf16x8*)un, n1 = *(const bf16x8*)(un + 8);
          s5_tile<false>(C, tokw + sc * 32, w0, w1, x0r, x0i, x1r, x1i); w0 = n0; w1 = n1; } }
    if (hi == 0) { ends[(wid * 64 + j) * 2] = x0r; ends[(wid * 64 + j) * 2 + 1] = x0i; ends[(wid * 64 + 32 + j) * 2] = x1r; ends[(wid * 64 + 32 + j) * 2 + 1] = x1i; }
    __syncthreads();
    { const float p0r = sp[128 + 2 * j], p0i = sp[128 + 2 * j + 1], p1r = sp[128 + 2 * (32 + j)], p1i = sp[128 + 2 * (32 + j) + 1];
      x0r = 0.f; x0i = 0.f; x1r = 0.f; x1i = 0.f;
      for (int w = 0; w < wid; ++w) { const float e0r = ends[(w * 64 + j) * 2], e0i = ends[(w * 64 + j) * 2 + 1], e1r = ends[(w * 64 + 32 + j) * 2], e1i = ends[(w * 64 + 32 + j) * 2 + 1];
          const float n0r = p0r * x0r - p0i * x0i + e0r, n0i = p0r * x0i + p0i * x0r + e0i, n1r = p1r * x1r - p1i * x1i + e1r, n1i = p1r * x1i + p1i * x1r + e1i;
          x0r = n0r; x0i = n0i; x1r = n1r; x1i = n1i; }
      if (hi) { x0r = 0.f; x0i = 0.f; x1r = 0.f; x1i = 0.f; } }
    { bf16x8 w0 = *(const bf16x8*)urow, w1 = *(const bf16x8*)(urow + 8);
      for (int sc = 0; sc < 16; ++sc) { const bf16_t* un = urow + (size_t)((sc < 15 ? sc + 1 : 15) * 32) * NPAD;
          const bf16x8 n0 = *(const bf16x8*)un, n1 = *(const bf16x8*)(un + 8);
          s5_tile<true>(C, tokw + sc * 32, w0, w1, x0r, x0i, x1r, x1i); w0 = n0; w1 = n1; } }
}
constexpr int TOPK = 256;
__device__ __forceinline__ unsigned f2key(float f) { const unsigned u = __float_as_uint(f); return u ^ ((u & 0x80000000u) ? 0xffffffffu : 0x80000000u); }

__device__ __forceinline__ float relu1(float x) { const int b = __float_as_int(x); return __int_as_float(b > 0 ? b : 0); }
#define DSA_MM(acc, rt, kk) acc = __builtin_amdgcn_mfma_f32_32x32x16_bf16(afr[rt][kk], bfr[kk], acc, 0, 0, 0)
#define DSA_HS(acc, rt, q) do { s0 = fmaf(relu1(acc[4 * (q)]), wv[rt][4 * (q)], s0); s1 = fmaf(relu1(acc[4 * (q) + 1]), wv[rt][4 * (q) + 1], s1); \
                                s0 = fmaf(relu1(acc[4 * (q) + 2]), wv[rt][4 * (q) + 2], s0); s1 = fmaf(relu1(acc[4 * (q) + 3]), wv[rt][4 * (q) + 3], s1); } while (0)
#define DSA_SG() __builtin_amdgcn_sched_barrier(0)
__device__ __forceinline__ void dsa_score_tile(const bf16x8 (&afr)[4][4], const f32x16 (&wv)[4], const bf16x8 (&bfr)[4], float* sc, int col, int hi) {
    const f32x16 z16 = {};
#define DSA_M0(acc, rt) acc = __builtin_amdgcn_mfma_f32_32x32x16_bf16(afr[rt][0], bfr[0], z16, 0, 0, 0)
    f32x16 accA, accB;
    float s0, s1;
    DSA_M0(accA, 0); DSA_MM(accA, 0, 1); DSA_MM(accA, 0, 2); DSA_MM(accA, 0, 3);
    s0 = 0.f; s1 = 0.f;
    DSA_M0(accB, 1); DSA_HS(accA, 0, 0); DSA_SG(); DSA_MM(accB, 1, 1); DSA_HS(accA, 0, 1); DSA_SG();
    DSA_MM(accB, 1, 2); DSA_HS(accA, 0, 2); DSA_SG(); DSA_MM(accB, 1, 3); DSA_HS(accA, 0, 3); DSA_SG();
    sc[(0 + hi) * 4096 + col] = (s0 + s1) + 0.f;
    s0 = 0.f; s1 = 0.f;
    DSA_M0(accA, 2); DSA_HS(accB, 1, 0); DSA_SG(); DSA_MM(accA, 2, 1); DSA_HS(accB, 1, 1); DSA_SG();
    DSA_MM(accA, 2, 2); DSA_HS(accB, 1, 2); DSA_SG(); DSA_MM(accA, 2, 3); DSA_HS(accB, 1, 3); DSA_SG();
    sc[(2 + hi) * 4096 + col] = (s0 + s1) + 0.f;
    s0 = 0.f; s1 = 0.f;
    DSA_M0(accB, 3); DSA_HS(accA, 2, 0); DSA_SG(); DSA_MM(accB, 3, 1); DSA_HS(accA, 2, 1); DSA_SG();
    DSA_MM(accB, 3, 2); DSA_HS(accA, 2, 2); DSA_SG(); DSA_MM(accB, 3, 3); DSA_HS(accA, 2, 3); DSA_SG();
    asm volatile("" :: "v"(bfr[0]), "v"(bfr[1]), "v"(bfr[2]), "v"(bfr[3]));
    sc[(4 + hi) * 4096 + col] = (s0 + s1) + 0.f;
    s0 = 0.f; s1 = 0.f;
    DSA_HS(accB, 3, 0); DSA_HS(accB, 3, 1); DSA_HS(accB, 3, 2); DSA_HS(accB, 3, 3);
    sc[(6 + hi) * 4096 + col] = (s0 + s1) + 0.f;
#undef DSA_M0
}
#define DSA_CNT4(K0, K1, K2, K3) asm volatile( \
    "v_cmp_ge_u32_e64 %[m0], %[k0], %[cd]\n\tv_cmp_ge_u32_e64 %[m1], %[k1], %[cd]\n\tv_cmp_ge_u32_e64 %[m2], %[k2], %[cd]\n\tv_cmp_ge_u32_e64 %[m3], %[k3], %[cd]\n\t" \
    "v_addc_co_u32_e64 %[a0], %[m0], %[a0], 0, %[m0]\n\tv_addc_co_u32_e64 %[a1], %[m1], %[a1], 0, %[m1]\n\t" \
    "v_addc_co_u32_e64 %[a0], %[m2], %[a0], 0, %[m2]\n\tv_addc_co_u32_e64 %[a1], %[m3], %[a1], 0, %[m3]" \
    : [a0] "+v"(c0), [a1] "+v"(c1), [m0] "=&s"(sm0), [m1] "=&s"(sm1), [m2] "=&s"(sm2), [m3] "=&s"(sm3) \
    : [k0] "v"(K0), [k1] "v"(K1), [k2] "v"(K2), [k3] "v"(K3), [cd] "v"(cand))
#define DSA_CNT8(J0) do { DSA_CNT4(key[(J0)], key[(J0) + 1], key[(J0) + 2], key[(J0) + 3]); DSA_CNT4(key[(J0) + 4], key[(J0) + 5], key[(J0) + 6], key[(J0) + 7]); } while (0)

template <int J, int JEND> __device__ __forceinline__ void dsa_emit(const unsigned (&key)[64], unsigned T, unsigned& wlo, unsigned& whi) {
    const unsigned long long m = __ballot(key[J] >= T);
    asm("s_nop 1\n\tv_writelane_b32 %0, %2, %4\n\tv_writelane_b32 %1, %3, %4" : "+v"(wlo), "+v"(whi) : "s"((unsigned)m), "s"((unsigned)(m >> 32)), "n"(J));
    if constexpr (J + 1 < JEND) dsa_emit<J + 1, JEND>(key, T, wlo, whi);
}
__device__ __forceinline__ void unit_dsa_index(const Params& P, int u, char* lds) {
    const int b = u & 3, t0 = (511 - (u >> 2)) * 8;
    const int tid = TIDX(), wid = tid >> 6, lane = tid & 63, r32 = lane & 31, hi = lane >> 5;
    float* sc = (float*)lds;
    const bf16_t* pb = P.p_() + (size_t)b * SEQ * NPAD;
    __syncthreads();
    TPU_START(101); TPU_START(110);
    {
        bf16x8 afr[4][4]; f32x16 wv[4];
        const int qsel = (r32 >> 2) & 1, head = (r32 & 3) + 4 * (r32 >> 3);
        char* qs = lds;
        const int ntile = (t0 + 7) / 32 + 1;
        const bf16_t* kp = P.ikc_() + (size_t)(b * (SEQ / 32)) * 2048 + lane * 8;
        bf16x8 b0[4], b1[4], b2[4];
#define DSA_LDB(dst, K) do { const bf16_t* kq_ = kp + (size_t)(wid + 8 * (K)) * 2048; _Pragma("unroll") for (int kk = 0; kk < 4; ++kk) dst[kk] = *(const bf16x8*)(kq_ + kk * 512); } while (0)
#define DSA_TILE(buf, K) dsa_score_tile(afr, wv, buf, sc, (wid + 8 * (K)) * 32 + r32, hi)
        const int nk = (ntile - wid + 7) >> 3;
        const int kl = nk > 0 ? nk - 1 : 0;
#define DSA_MIN(a) ((a) < kl ? (a) : kl)
        const int tk = tid >> 6, hd = (tid & 63) >> 2, dm = (tid & 3) * 16;
        const bf16_t* qsrc = pb + (size_t)(t0 + tk) * NPAD + C_DIQ + hd * 64 + dm;
        const u32x4 qa = *(const u32x4*)qsrc, qb2 = *(const u32x4*)(qsrc + 8);
#pragma unroll
        for (int rt = 0; rt < 4; ++rt) { const float* wp = P.iw_() + (size_t)(b * SEQ + t0 + 2 * rt + hi) * 16;
#pragma unroll
            for (int i = 0; i < 4; ++i) { const f32x4 w4 = *(const f32x4*)(wp + 4 * i); wv[rt][4 * i] = w4[0]; wv[rt][4 * i + 1] = w4[1]; wv[rt][4 * i + 2] = w4[2]; wv[rt][4 * i + 3] = w4[3]; } }
        DSA_LDB(b0, DSA_MIN(0)); DSA_LDB(b1, DSA_MIN(1));
        { char* dst = qs + tk * 2432 + hd * 144 + dm * 2; *(u32x4*)dst = qa; *(u32x4*)(dst + 16) = qb2; }
        __syncthreads();
#pragma unroll
        for (int rt = 0; rt < 4; ++rt) { const char* qp = qs + (2 * rt + qsel) * 2432 + head * 144 + hi * 16;
#pragma unroll
            for (int kk = 0; kk < 4; ++kk) afr[rt][kk] = *(const bf16x8*)(qp + kk * 32); }
        asm volatile("s_waitcnt lgkmcnt(0)" ::: "memory"); __syncthreads();
#if TPROBE == 110
        TPU_STOP(110);
#endif
#if TPROBE == 103
        TPU_START(103); asm volatile("s_waitcnt vmcnt(0)" ::: "memory"); TPU_STOP(103);
#endif
#if TPROBE == 104
        asm volatile("s_waitcnt vmcnt(0)" ::: "memory"); TPU_START(104);
#endif
        int k = 0;
        for (; k + 3 <= nk; k += 3) {
            DSA_LDB(b2, k + 2); DSA_TILE(b0, k);
            DSA_LDB(b0, DSA_MIN(k + 3)); DSA_TILE(b1, k + 1);
            DSA_LDB(b1, DSA_MIN(k + 4)); DSA_TILE(b2, k + 2);
        }
        if (k < nk) DSA_TILE(b0, k);
        if (k + 1 < nk) DSA_TILE(b1, k + 1);
#if TPROBE == 104
        asm volatile("s_waitcnt lgkmcnt(0)" ::: "memory"); TPU_STOP(104);
#endif
        TPU_START(111);
#undef DSA_TILE
#undef DSA_MIN
#undef DSA_TILE
#undef DSA_LDB
    }
    __syncthreads();
    TPU_STOP(111);
    TPU_STOP(101); TPU_START(102);
    {
        const int t = t0 + wid; const float* srow = sc + wid * 4096;
        unsigned key[64];
        {
            const int gfull = (t + 1) >> 9, gany = t / 512 + 1;
#pragma unroll
            for (int g = 0; g < 8; ++g) {
                if (g < gfull) {
#pragma unroll
                    for (int jj = 0; jj < 8; ++jj) key[8 * g + jj] = f2key(srow[(8 * g + jj) * 64 + lane]);
                } else if (g < gany) {
#pragma unroll
                    for (int jj = 0; jj < 8; ++jj) { const int s = (8 * g + jj) * 64 + lane; key[8 * g + jj] = (s <= t) ? f2key(srow[s]) : 0u; }
                } else {
#pragma unroll
                    for (int jj = 0; jj < 8; ++jj) key[8 * g + jj] = 0u;
                }
            }
        }
        unsigned long long* mout = P.mask_() + (size_t)(b * SEQ + t) * 64;
        unsigned long long myword = 0ull;
        TPU_START(105); TPU_START(106); TPU_START(107); TPU_START(108); TPU_START(109);
        if (t + 1 <= TOPK) {
#pragma unroll
            for (int j = 0; j < 64; ++j) { const unsigned long long m = __ballot(j * 64 + lane <= t); if (lane == j) myword = m; }
        } else {
            const int ngrp = t / 512 + 1;
#if TPROBE == 105
            asm volatile("" :: "v"(key[0]), "v"(key[63]));
#endif
            TPU_STOP(105);
            unsigned* hist = (unsigned*)(sc + wid * 4096);
            asm volatile("" ::: "memory");
            { const u32x4 zz4 = {0u, 0u, 0u, 0u};
#pragma unroll
              for (int i = 0; i < 16; ++i) *(u32x4*)(hist + (i * 64 + lane) * 4) = zz4; }
            asm volatile("" ::: "memory");
#define DSA_H8(J0) do { _Pragma("unroll") for (int jj = 0; jj < 8; ++jj) atomicAdd(hist + (key[(J0) + jj] >> 20), 1u); } while (0)
            DSA_H8(0);
            if (ngrp > 1) DSA_H8(8);
            if (ngrp > 2) DSA_H8(16);
            if (ngrp > 3) DSA_H8(24);
            if (ngrp > 4) DSA_H8(32);
            if (ngrp > 5) DSA_H8(40);
            if (ngrp > 6) DSA_H8(48);
            if (ngrp > 7) DSA_H8(56);
#undef DSA_H8
            asm volatile("" ::: "memory");
#if TPROBE == 106
            asm volatile("s_waitcnt lgkmcnt(0)" ::: "memory");
#endif
            TPU_STOP(106);
#define DSA_SUFFIX(s) do { _Pragma("unroll") for (int o = 1; o < 64; o <<= 1) { unsigned t_ = (unsigned)__builtin_amdgcn_ds_bpermute(((lane + o) & 63) << 2, (int)(s)); (s) += (lane + o < 64) ? t_ : 0u; } } while (0)
            unsigned mine = 0u;
#pragma unroll
            for (int i = 0; i < 16; ++i) { const u32x4 v4 = *(const u32x4*)(hist + lane * 64 + ((i + lane) & 15) * 4); mine += (v4[0] + v4[1]) + (v4[2] + v4[3]); }
            unsigned suf = mine; DSA_SUFFIX(suf);
            const unsigned long long mL = __ballot(suf - mine < (unsigned)TOPK && suf >= (unsigned)TOPK);
            const int Ls = (int)__builtin_ctzll(mL);
            const unsigned cntA = (unsigned)__builtin_amdgcn_readlane((int)(suf - mine), Ls);
            unsigned h2 = hist[Ls * 64 + lane]; unsigned suf2 = h2; DSA_SUFFIX(suf2);
            const unsigned long long mB = __ballot(cntA + suf2 - h2 < (unsigned)TOPK && cntA + suf2 >= (unsigned)TOPK);
            const int Bs = (int)__builtin_ctzll(mB);
            const unsigned bstar = (unsigned)(Ls * 64 + Bs);
            const unsigned cntAbove = cntA + (unsigned)__builtin_amdgcn_readlane((int)(suf2 - h2), Bs);
            const unsigned inbin = (unsigned)__builtin_amdgcn_readlane((int)h2, Bs);
#undef DSA_SUFFIX
            TPU_STOP(107);
            unsigned T = bstar << 20; int cntT = (int)(cntAbove + inbin);
            if (cntT != TOPK) {
                asm volatile("" ::: "memory");
                int nslot = 0;
#pragma unroll
                for (int g = 0; g < 8; ++g) { if (g < ngrp) {
#pragma unroll
                    for (int jj = 0; jj < 8; ++jj) { const int j = 8 * g + jj; if ((key[j] >> 20) == bstar) { hist[nslot * 64 + lane] = key[j]; ++nslot; } } } }
                asm volatile("" ::: "memory");
                int R = nslot;
#pragma unroll
                for (int o = 32; o >= 1; o >>= 1) { const int other = __builtin_amdgcn_ds_bpermute(((lane ^ o) << 2), R); R = other > R ? other : R; }
                R = __builtin_amdgcn_readfirstlane(R);
                if (R <= 8) {
                    unsigned c[8];
#pragma unroll
                    for (int r = 0; r < 8; ++r) c[r] = (r < nslot) ? hist[r * 64 + lane] : 0u;
                    for (int bit = 19; bit >= 0; --bit) {
                        const unsigned cand = T | (1u << bit); int cnt = (int)cntAbove;
#pragma unroll
                        for (int r = 0; r < 8; ++r) cnt += __popcll(__ballot(c[r] >= cand));
                        if (cnt >= TOPK) { T = cand; cntT = cnt; if (cnt == TOPK) break; }
                    }
                } else {
                    for (int bit = 19; bit >= 0; --bit) {
                        const unsigned cand = T | (1u << bit); unsigned c0 = 0, c1 = 0; unsigned long long sm0, sm1, sm2, sm3;
                        DSA_CNT8(0);
                        if (ngrp > 1) DSA_CNT8(8);
                        if (ngrp > 2) DSA_CNT8(16);
                        if (ngrp > 3) DSA_CNT8(24);
                        if (ngrp > 4) DSA_CNT8(32);
                        if (ngrp > 5) DSA_CNT8(40);
                        if (ngrp > 6) DSA_CNT8(48);
                        if (ngrp > 7) DSA_CNT8(56);
                        const int cl = (int)(c0 + c1);
                        int cnt = 0;
#pragma unroll
                        for (int bb = 0; bb < 7; ++bb) cnt += __popcll(__ballot((cl >> bb) & 1)) << bb;
                        if (cnt >= TOPK) { T = cand; cntT = cnt; if (cnt == TOPK) break; }
                    }
                }
            }
            TPU_STOP(108);
            if (cntT == TOPK) {
                unsigned wlo = 0u, whi = 0u;
                dsa_emit<0, 8>(key, T, wlo, whi);
                if (ngrp > 1) dsa_emit<8, 16>(key, T, wlo, whi);
                if (ngrp > 2) dsa_emit<16, 24>(key, T, wlo, whi);
                if (ngrp > 3) dsa_emit<24, 32>(key, T, wlo, whi);
                if (ngrp > 4) dsa_emit<32, 40>(key, T, wlo, whi);
                if (ngrp > 5) dsa_emit<40, 48>(key, T, wlo, whi);
                if (ngrp > 6) dsa_emit<48, 56>(key, T, wlo, whi);
                if (ngrp > 7) dsa_emit<56, 64>(key, T, wlo, whi);
                myword = ((unsigned long long)whi << 32) | wlo;
            } else {
                int ngt = 0;
#pragma unroll
                for (int j = 0; j < 64; ++j) ngt += __popcll(__ballot(key[j] > T));
                int need = TOPK - ngt;
#pragma unroll
                for (int j = 0; j < 64; ++j) { const unsigned long long eq = __ballot(key[j] == T), gt = __ballot(key[j] > T);
                    const int ne = __popcll(eq); unsigned long long take = eq;
                    if (ne > need) { take = 0ull; int left = need; unsigned long long e2 = eq;
                        while (left > 0) { const unsigned long long lowbit = e2 & (0ull - e2); take |= lowbit; e2 ^= lowbit; --left; } }
                    need -= (ne > need) ? need : ne;
                    const unsigned long long m = gt | take; if (lane == j) myword = m; }
            }
        }
        mout[lane] = myword;
        TPU_STOP(109);
    }
    TPU_STOP(102);
}

struct DsaOutRow { const bf16_t* zb; bf16_t* gb; int wid;
    __device__ __forceinline__ const bf16_t* zrow(int r) const { const int rho = wid * 32 + r; return zb + (size_t)(rho >> 2) * NPAD + (rho & 3) * 128; }
    __device__ __forceinline__ bf16_t* grow(int r) const { const int rho = wid * 32 + r; return gb + (size_t)(rho >> 2) * MIX + (rho & 3) * 128; } };
__device__ __forceinline__ void unit_dsa_attn(const Params& P, int cur_layer, int u, char* lds) {
    const int b = u & 3, qb = 63 - (u >> 2), t0 = qb * 64, tokb = b * SEQ;
    const int wid = TIDX() >> 6, lane = TIDX() & 63, r32 = lane & 31, hi = lane >> 5;
    const int rho = wid * 32 + r32, tq = t0 + (rho >> 2), hq = rho & 3;
    const bf16_t* Qw = P.p_() + (size_t)(tokb + tq) * NPAD + C_DQ + hq * 128 + hi * 8;
    const bf16_t* Kh = P.kvc_() + (size_t)tokb * 256;
    const unsigned moff = (unsigned)(tokb + tq) * 512u;
    DsaOutRow ow; ow.zb = P.p_() + (size_t)(tokb + t0) * NPAD + C_DZ; ow.gb = P.xn_() + (size_t)(tokb + t0) * MIX + 1024; ow.wid = wid;
    const int NT = (qb + 2) & ~1;
    att::attn_body<true, 256, 128, 2, DsaOutRow>(Qw, P.dsa_q_norm + cur_layer * 128, P.rope_() + (size_t)(tokb + tq) * 48, Kh, NT, P.mask_(), moff, ow, lds);
}
__device__ __forceinline__ void phase_gemm_glu(const Params& P, int layer, char* lds) {
    pg8::Gemm g; g.A = P.ybuf_(); g.Bt = P.WgluT_() + (size_t)layer * 512 * 512; g.M = NTOK; g.N = 512; g.K = 512;
    pg8::StaticOrder S; S.init(g.M, g.N, (int)gridDim.x, (int)blockIdx.x);
    pg8::EpiGlu E; E.Y = P.ybuf_(); E.ldy = 512; E.O = P.ocat_(); E.ldo = MIX; E.ooff = 512;
    pg8::gemm_phase<pg8::EpiGlu, pg8::StaticOrder, false>((PG8_LAS unsigned char*)lds, g, S, E, nullptr);
}

constexpr int CTL_Q0 = 4096;
struct OneUnit { int pm, pn; __device__ __forceinline__ bool next(int i, pg8::Unit& u) const { if (i) return false; u.pm = pm; u.pn = pn; return true; }
    __device__ __forceinline__ void a_ready(const pg8::Unit&) const {} __device__ __forceinline__ void done(const pg8::Unit&) const {} };
__device__ __forceinline__ int q_issue(unsigned* ctr) { return (int)__hip_atomic_fetch_add(ctr, 1u, __ATOMIC_RELAXED, __HIP_MEMORY_SCOPE_AGENT); }
#define Q_LOOP_BEGIN(ctr, total)  { unsigned* q_ctr_ = (ctr); const int q_total_ = (total); volatile int* q_b_ = (volatile int*)(lds + LDS_TAIL + 16); \
    for (;;) { __syncthreads(); if (TIDX() == 0) *q_b_ = q_issue(q_ctr_); __syncthreads(); const int item = __builtin_amdgcn_readfirstlane(*q_b_); if (item >= q_total_) break;
#define Q_LOOP_END  } }
__device__ __forceinline__ void unit_glu(const Params& P, int layer, int u, char* lds) {
    pg8::Gemm g; g.A = P.ybuf_(); g.Bt = P.WgluT_() + (size_t)layer * 512 * 512; g.M = NTOK; g.N = 512; g.K = 512;
    OneUnit S; S.pm = u >> 1; S.pn = u & 1;
    pg8::EpiGluGate E; E.Y = P.ybuf_(); E.Pz = P.p_(); E.G = P.xn_();
    pg8::gemm_phase<pg8::EpiGluGate, OneUnit, false>((PG8_LAS unsigned char*)lds, g, S, E, nullptr);
}
constexpr int LDS_TAIL = LDS_BYTES - 64;

__global__ __launch_bounds__(NTHR, 2) void k_mega(Params P) {
    extern __shared__ __attribute__((aligned(16))) char lds[];
    if (TIDX() == 0) *(uint4*)(lds + LDS_TAIL) = make_uint4(0u, 0u, 0u, 0u);
    __syncthreads();
    XcdBarrier bar = xcd_barrier_post(P.ctl_(), (volatile LAS unsigned*)(lds + LDS_TAIL));
    const int G = gridDim.x, B = blockIdx.x;
    phase_prologue1(P, lds); phase_rope_table(P); phase_s5_params(P); phase_rmsnorm_x(P, 0);
    xcd_barrier(bar);
    for (int layer = 0; layer < DEPTH; ++layer) {
        if (layer > 0) { phase_rmsnorm_x(P, layer); xcd_barrier(bar); }
        phase_gemm_in(P, layer, lds);
        if (layer == 0) phase_gemm_kv(P, lds);
        xcd_barrier(bar);
        phase_prep(P, layer);
        if (layer == 0) phase_memk_norm(P);
        for (int u = B; u < 256; u += G) unit_gla_a4(P, layer, u, lds);
        xcd_barrier(bar);
        Q_LOOP_BEGIN(P.ctl_() + CTL_Q0 + 64 * (layer * 2), 128 + 2048 + 256)
            if (item < 128) unit_s5(P, layer, item, lds);
            else if (item < 2176) unit_dsa_index(P, item - 128, lds);
            else gla_scan_slice(P, (item - 2176) * NTHR + TIDX());
        Q_LOOP_END
        xcd_barrier(bar);
        Q_LOOP_BEGIN(P.ctl_() + CTL_Q0 + 64 * (layer * 2 + 1), 256 + 256 + 128 + 256)
            if (item < 256) unit_dsa_attn(P, layer, item, lds);
            else if (item < 512) unit_gla_c4(P, layer, item - 256, lds);
            else if (item < 640) unit_glu(P, layer, item - 512, lds);
            else unit_mem_attn(P, layer, item - 640, lds);
        Q_LOOP_END
        xcd_barrier(bar);
        phase_gemm_out(P, layer, lds);
        xcd_barrier(bar);
    }
}

extern "C" void kernel_launch(void* const* d_in, const int* in_sizes, int n_in, void* d_out, int out_size, void* d_ws, size_t ws_size, hipStream_t stream) {
    if (n_in != 24 || ws_size < WS_END) { fprintf(stderr, "kernel_launch: unexpected n_in %d or ws_size %zu (< %zu)\n", n_in, ws_size, (size_t)WS_END); return; }
    Params P; memset(&P, 0, sizeof(P));
    P.x = (const float*)d_in[0]; P.mem = (const float*)d_in[1]; P.pos = (const int*)d_in[2]; P.ln_gain = (const float*)d_in[3]; P.w_in = (const float*)d_in[4];
    P.gla_w_up = (const float*)d_in[5]; P.gla_b_up = (const float*)d_in[6]; P.s5_a_re = (const float*)d_in[7]; P.s5_a_im = (const float*)d_in[8]; P.s5_log_step = (const float*)d_in[9];
    P.s5_b_re = (const float*)d_in[10]; P.s5_b_im = (const float*)d_in[11]; P.s5_c_re = (const float*)d_in[12]; P.s5_c_im = (const float*)d_in[13]; P.s5_d = (const float*)d_in[14];
    P.s5_w_glu = (const float*)d_in[15]; P.dsa_q_norm = (const float*)d_in[16]; P.dsa_k_norm = (const float*)d_in[17]; P.mem_norm = (const float*)d_in[18]; P.w_mem_kv = (const float*)d_in[19];
    P.mem_q_norm = (const float*)d_in[20]; P.mem_k_norm = (const float*)d_in[21]; P.out_norm = (const float*)d_in[22]; P.w_out = (const float*)d_in[23];
    P.out = (float*)d_out;
    char* ws = (char*)d_ws; P.ws = ws;
    static int grid = 0;
    if (!grid) {
        int dev = 0, cus = 0, per_cu = 0;
        (void)hipGetDevice(&dev); (void)hipDeviceGetAttribute(&cus, hipDeviceAttributeMultiprocessorCount, dev);
        (void)hipFuncSetAttribute((const void*)k_mega, hipFuncAttributeMaxDynamicSharedMemorySize, LDS_BYTES);
        (void)hipOccupancyMaxActiveBlocksPerMultiprocessor(&per_cu, (const void*)k_mega, NTHR, LDS_BYTES);
        if (per_cu < 1) fprintf(stderr, "kernel_launch: occupancy query reports %d blocks per CU\n", per_cu);
        grid = cus > 0 ? cus : 256;
    }
    (void)hipMemsetAsync(ws + WS_CTL, 0, CTL_BYTES, stream);
    hipLaunchKernelGGL(k_mega, dim3(grid), dim3(NTHR), LDS_BYTES, stream, P);
}
```

```cpp
#include <hip/hip_runtime.h>
#include <stdint.h>
#include <stdio.h>
#include <string.h>

constexpr int NB = 4, SEQ = 4096, NTOK = NB * SEQ, DM = 2048, DEPTH = 4, MEML = 256;
constexpr int NIN = 5984, NPAD = 6144, MIX = 2048;
constexpr int C_GQ = 0, C_GK = 256, C_GV = 512, C_GLR = 1024, C_GZ = 1040, C_SU = 1552, C_SZ = 2064, C_DQ = 2576, C_DK = 3088, C_DV = 3216,
              C_DIQ = 3344, C_DIK = 4368, C_DIW = 4432, C_DZ = 4448, C_MQ = 4960, C_MZ = 5472;
constexpr float EPS = 1e-6f;
constexpr int NTHR = 512;
constexpr int LDS_BYTES = 147456;

typedef unsigned short bf16_t;
typedef short bf16x8 __attribute__((ext_vector_type(8)));
typedef short s16x4 __attribute__((ext_vector_type(4)));
typedef float f32x4 __attribute__((ext_vector_type(4)));
typedef float f32x8 __attribute__((ext_vector_type(8)));
typedef float f32x16 __attribute__((ext_vector_type(16)));
typedef unsigned u32x4 __attribute__((ext_vector_type(4)));
typedef unsigned u32x2 __attribute__((ext_vector_type(2)));
#define LAS __attribute__((address_space(3)))

__device__ __forceinline__ float bf2f(bf16_t b) { return __uint_as_float(((unsigned)b) << 16); }
__device__ __forceinline__ unsigned pk2bf(float lo, float hi) { unsigned r; asm("v_cvt_pk_bf16_f32 %0, %1, %2" : "=v"(r) : "v"(lo), "v"(hi)); return r; }
__device__ __forceinline__ bf16_t f2bf(float f) { return (bf16_t)pk2bf(f, f); }
__device__ __forceinline__ float sigmoidf_(float x) { return __builtin_amdgcn_rcpf(1.f + __expf(-x)); }
__device__ __forceinline__ float siluf_(float x) { return x * __builtin_amdgcn_rcpf(1.f + __expf(-x)); }

__device__ __forceinline__ int TIDX() { int t = (int)threadIdx.x; asm volatile("" : "+v"(t)); return t; }
__device__ __forceinline__ float shx(float v, int m) { const int src = ((TIDX() & 63) ^ m) << 2; return __int_as_float(__builtin_amdgcn_ds_bpermute(src, __float_as_int(v))); }
__device__ __forceinline__ float wave_sum(float v) {
#pragma unroll
    for (int o = 32; o >= 1; o >>= 1) v += shx(v, o);
    return v;
}
__device__ __forceinline__ void ld8f(const bf16_t* p, float (&v)[8]) { const u32x4 w = *(const u32x4*)p;
#pragma unroll
    for (int j = 0; j < 4; ++j) { v[2 * j] = __uint_as_float(w[j] << 16); v[2 * j + 1] = __uint_as_float(w[j] & 0xffff0000u); } }
__device__ __forceinline__ void st8f(bf16_t* p, const float (&v)[8]) { u32x4 w; w.x = pk2bf(v[0], v[1]); w.y = pk2bf(v[2], v[3]); w.z = pk2bf(v[4], v[5]); w.w = pk2bf(v[6], v[7]); *(u32x4*)p = w; }
__device__ __forceinline__ float f2bf_f(float f) { return bf2f(f2bf(f)); }

#ifndef TPROBE
#define TPROBE 0
#endif
#if TPROBE
#define TPU_START(id) do { if (TPROBE == (id) && TIDX() == 0) *(volatile unsigned long long*)(lds + LDS_BYTES - 24) = __builtin_amdgcn_s_memrealtime(); } while (0)
#define TPU_STOP(id) do { if (TPROBE == (id) && TIDX() == 0) *(volatile unsigned long long*)(lds + LDS_BYTES - 32) += __builtin_amdgcn_s_memrealtime() - *(volatile unsigned long long*)(lds + LDS_BYTES - 24); } while (0)
#else
#define TPU_START(id) do {} while (0)
#define TPU_STOP(id) do {} while (0)
#endif
#define XB_TMO      128
#define XB_XCNT(j)  (256  + 64 * (j))
#define XB_XSUB(j)  (1280 + 64 * (j))
#define XB_XGEN(j)  (2304 + 64 * (j))
#define XB_TOP      3328
#define XB_TOPGEN   3392
#define XCD_BAR_WORDS 3456
#define XB_SPIN_CAP (1u << 18)

__device__ __forceinline__ unsigned xb_ld(unsigned* p)              { return __hip_atomic_load(p, __ATOMIC_RELAXED, __HIP_MEMORY_SCOPE_AGENT); }
__device__ __forceinline__ unsigned xb_add(unsigned* p, unsigned v) { return __hip_atomic_fetch_add(p, v, __ATOMIC_RELAXED, __HIP_MEMORY_SCOPE_AGENT); }
__device__ __forceinline__ unsigned xb_xcc_id() { return (unsigned)__builtin_amdgcn_s_getreg((3 << 11) | 20) & 0xFu; }
#define XB_SPIN(cond, bar) do { unsigned _sp = 0; while (cond) { __builtin_amdgcn_s_sleep(1); \
    if ((++_sp & 255u) == 0u) { if (xb_ld(&(bar)[XB_TMO])) break; if (_sp > XB_SPIN_CAP) { atomicAdd(&(bar)[XB_TMO], 1u); break; } } } } while (0)

struct XcdBarrier {
    unsigned* bar; unsigned x;
    volatile LAS unsigned* st;
};

__device__ __forceinline__ XcdBarrier xcd_barrier_post(unsigned* bar, volatile LAS unsigned* st) {
    XcdBarrier b; b.bar = bar; b.x = xb_xcc_id(); b.st = st;
    if (TIDX() == 0) (void)xb_add(&bar[XB_XCNT(b.x)], 1u);
    return b;
}
__device__ __forceinline__ void xcd_barrier_complete(unsigned* bar, unsigned x, unsigned& nloc, unsigned& nx) {
    const unsigned G = gridDim.x * gridDim.y * gridDim.z;
    unsigned sum, cnt, mine, sp = 0u;
    for (;;) {
        sum = 0u; cnt = 0u; mine = 0u;
#pragma unroll
        for (unsigned j = 0; j < 16; ++j) { const unsigned c = xb_ld(&bar[XB_XCNT(j)]); sum += c; cnt += (c > 0u) ? 1u : 0u; mine = (j == x) ? c : mine; }
        if (sum == G) break;
        __builtin_amdgcn_s_sleep(1);
        if ((++sp & 255u) == 0u) { if (xb_ld(&bar[XB_TMO])) break; if (sp > XB_SPIN_CAP) { atomicAdd(&bar[XB_TMO], 1u); break; } }
    }
    nloc = mine > 0u ? mine : 1u; nx = cnt > 0u ? cnt : 1u;
}

__device__ __forceinline__ void xcd_barrier(const XcdBarrier& b) {
    asm volatile("s_waitcnt vmcnt(0)" ::: "memory");
    __syncthreads();
    if (TIDX() == 0) {
        unsigned* bar = b.bar; const unsigned bx = xb_xcc_id();
        __builtin_amdgcn_s_waitcnt(0);
        unsigned nloc = b.st[0], nx = b.st[1];
        if (nloc == 0u) { xcd_barrier_complete(bar, bx, nloc, nx); b.st[0] = nloc; b.st[1] = nx; }
        const unsigned old = xb_add(&bar[XB_XSUB(bx)], 1u);
        const unsigned gen = old / nloc;
        if (old + 1u == (gen + 1u) * nloc) {
            __builtin_amdgcn_fence(__ATOMIC_RELEASE, "agent");
            asm volatile("s_waitcnt vmcnt(0)" ::: "memory");
            const unsigned og = xb_add(&bar[XB_TOP], 1u);
            const unsigned tg = og / nx;
            if (og + 1u == (tg + 1u) * nx) xb_add(&bar[XB_TOPGEN], 1u);
            else XB_SPIN(xb_ld(&bar[XB_TOPGEN]) == tg, bar);
            __builtin_amdgcn_fence(__ATOMIC_ACQUIRE, "agent");
            xb_add(&bar[XB_XGEN(bx)], 1u);
            asm volatile("s_waitcnt vmcnt(0)" ::: "memory");
        } else {
            XB_SPIN(xb_ld(&bar[XB_XGEN(bx)]) == gen, bar);
            __builtin_amdgcn_fence(__ATOMIC_ACQUIRE, "agent");
            asm volatile("s_waitcnt vmcnt(0)" ::: "memory");
        }
    }
    __syncthreads();
}
namespace pg8 {
#define PG8_LAS __attribute__((address_space(3)))
typedef float f32x2 __attribute__((ext_vector_type(2)));
typedef unsigned u32x4 __attribute__((ext_vector_type(4)));
constexpr int BM = 256, BK = 64, HALF = 128, HTB = HALF * BK * 2  , STAGE_BYTES = 8 * HTB, NXCD = 8, WGM = 8;

__host__ __device__ __forceinline__ int lds_byte(int r, int c) { const int st = (r >> 4) * 2 + (c >> 5), rr = r & 15, cc = c & 31, ob = rr * 64 + cc * 2; return st * 1024 + (ob ^ (((ob >> 9) & 1) << 5)); }
__host__ __device__ __forceinline__ void stage_rc(int b, int& R, int& C) { const int st = b / 1024, sb = b % 1024, swz = sb ^ (((sb >> 9) & 1) << 5); R = (st >> 1) * 16 + swz / 64; C = (st & 1) * 32 + (swz % 64) / 2; }
__host__ __device__ __forceinline__ int perm32(int rho) { const int n = rho >> 4, i = rho & 15; return 8 * (i >> 2) + 4 * n + (i & 3); }

struct Unit { int pm, pn; };
struct Gemm { const bf16_t* A; const bf16_t* Bt; int M, N, K; };

struct StaticOrder {
    int nM, nN, nwg, G, c;
    __host__ __device__ void init(int M, int N, int G_, int c_) { nM = M / BM; nN = N / BM; nwg = nM * nN; G = G_; c = c_; }
    __host__ __device__ bool next(int i, Unit& u) const {
        const long L = (long)i * G + c; if (L >= nwg) return false;
        int wgid = (int)L; { const int q = nwg / NXCD, r = nwg % NXCD, xcd = wgid % NXCD, off = wgid / NXCD; wgid = (xcd < r ? xcd * (q + 1) : r * (q + 1) + (xcd - r) * q) + off; }
        const int nig = WGM * nN, gid = wgid / nig, fm = gid * WGM, gsz = (nM - fm) < WGM ? (nM - fm) : WGM;
        u.pm = fm + ((wgid % nig) % gsz); u.pn = (wgid % nig) / gsz; return true;
    }
    __device__ __forceinline__ void a_ready(const Unit&) const {}
    __device__ __forceinline__ void done(const Unit&) const {}
};
__device__ __forceinline__ unsigned cvt_pk_bf16(float lo, float hi) { unsigned r; asm volatile("v_cvt_pk_bf16_f32 %0, %1, %2" : "=v"(r) : "v"(lo), "v"(hi)); return r; }
struct EpiBf16Plain {
    static constexpr bool PERM = true, AFTER_DRAIN = false;
    bf16_t* O; int ldc;
    __device__ __forceinline__ void operator()(const f32x4 (&acc)[2][2][4][2], const Unit& u, int wr, int wc, int fr, int fq) const {
        const int row0 = u.pm * BM + wr * 64 + fr, col0 = u.pn * BM + wc * 32 + 8 * fq;
#pragma unroll
        for (int ai = 0; ai < 2; ++ai)
#pragma unroll
            for (int m = 0; m < 4; ++m) { bf16_t* rowp = O + (size_t)(row0 + ai * HALF + m * 16) * ldc + col0;
#pragma unroll
                for (int bj = 0; bj < 2; ++bj) { const f32x4 v0 = acc[ai][bj][m][0], v1 = acc[ai][bj][m][1];
                    u32x4 w; w.x = cvt_pk_bf16(v0[0], v0[1]); w.y = cvt_pk_bf16(v0[2], v0[3]); w.z = cvt_pk_bf16(v1[0], v1[1]); w.w = cvt_pk_bf16(v1[2], v1[3]);
                    *(u32x4*)(rowp + bj * HALF) = w; } }
    }
};
struct EpiResid {
    static constexpr bool PERM = false, AFTER_DRAIN = false;
    const float* R; float* C; int ldc;
    __device__ __forceinline__ void operator()(const f32x4 (&acc)[2][2][4][2], const Unit& u, int wr, int wc, int fr, int fq) const {
        const int row0 = u.pm * BM + wr * 64 + fr, col0 = u.pn * BM + wc * 32 + 4 * fq;
#pragma unroll
        for (int ai = 0; ai < 2; ++ai)
#pragma unroll
            for (int m = 0; m < 4; ++m) { const size_t off = (size_t)(row0 + ai * HALF + m * 16) * ldc + col0;
#pragma unroll
                for (int bj = 0; bj < 2; ++bj)
#pragma unroll
                    for (int n = 0; n < 2; ++n) { const f32x4 r = *(const f32x4*)(R + off + bj * HALF + n * 16); *(f32x4*)(C + off + bj * HALF + n * 16) = acc[ai][bj][m][n] + r; } }
    }
};
struct EpiResidMix {
    static constexpr bool PERM = true, AFTER_DRAIN = false;
    const void* R; void* C; int ldc; int r16, c16;
    __device__ __forceinline__ void operator()(const f32x4 (&acc)[2][2][4][2], const Unit& u, int wr, int wc, int fr, int fq) const {
        const int row0 = u.pm * BM + wr * 64 + fr, col0 = u.pn * BM + wc * 32 + 8 * fq;
#pragma unroll
        for (int ai = 0; ai < 2; ++ai)
#pragma unroll
            for (int m = 0; m < 4; ++m) { const size_t off = (size_t)(row0 + ai * HALF + m * 16) * ldc + col0;
                f32x4 r0[2], r1[2];
                if (r16) {
#pragma unroll
                    for (int bj = 0; bj < 2; ++bj) { const u32x4 w = *(const u32x4*)((const bf16_t*)R + off + bj * HALF);
                        r0[bj] = f32x4{__uint_as_float(w.x << 16), __uint_as_float(w.x & 0xffff0000u), __uint_as_float(w.y << 16), __uint_as_float(w.y & 0xffff0000u)};
                        r1[bj] = f32x4{__uint_as_float(w.z << 16), __uint_as_float(w.z & 0xffff0000u), __uint_as_float(w.w << 16), __uint_as_float(w.w & 0xffff0000u)}; }
                } else {
#pragma unroll
                    for (int bj = 0; bj < 2; ++bj) { r0[bj] = *(const f32x4*)((const float*)R + off + bj * HALF); r1[bj] = *(const f32x4*)((const float*)R + off + bj * HALF + 4); }
                }
#pragma unroll
                for (int bj = 0; bj < 2; ++bj) { const f32x4 v0 = acc[ai][bj][m][0] + r0[bj], v1 = acc[ai][bj][m][1] + r1[bj];
                    if (c16) { u32x4 w; w.x = cvt_pk_bf16(v0[0], v0[1]); w.y = cvt_pk_bf16(v0[2], v0[3]); w.z = cvt_pk_bf16(v1[0], v1[1]); w.w = cvt_pk_bf16(v1[2], v1[3]);
                        *(u32x4*)((bf16_t*)C + off + bj * HALF) = w; }
                    else { *(f32x4*)((float*)C + off + bj * HALF) = v0; *(f32x4*)((float*)C + off + bj * HALF + 4) = v1; } } }
    }
};
struct EpiGlu {
    static constexpr bool PERM = true, AFTER_DRAIN = false;
    const bf16_t* Y; int ldy; bf16_t* O; int ldo; int ooff;
    __device__ __forceinline__ void operator()(const f32x4 (&acc)[2][2][4][2], const Unit& u, int wr, int wc, int fr, int fq) const {
        const int row0 = u.pm * BM + wr * 64 + fr, col0 = u.pn * BM + wc * 32 + 8 * fq;
#pragma unroll
        for (int ai = 0; ai < 2; ++ai)
#pragma unroll
            for (int m = 0; m < 4; ++m) { const int row = row0 + ai * HALF + m * 16;
#pragma unroll
                for (int bj = 0; bj < 2; ++bj) { const f32x4 v0 = acc[ai][bj][m][0], v1 = acc[ai][bj][m][1];
                    const u32x4 yw = *(const u32x4*)(Y + (size_t)row * ldy + col0 + bj * HALF);
                    float y[8], g[8];
#pragma unroll
                    for (int j = 0; j < 4; ++j) { y[2 * j] = __uint_as_float(yw[j] << 16); y[2 * j + 1] = __uint_as_float(yw[j] & 0xffff0000u); }
#pragma unroll
                    for (int j = 0; j < 4; ++j) { g[j] = __builtin_amdgcn_rcpf(1.f + __expf(-v0[j])); g[4 + j] = __builtin_amdgcn_rcpf(1.f + __expf(-v1[j])); }
                    u32x4 w; w.x = cvt_pk_bf16(y[0] * g[0], y[1] * g[1]); w.y = cvt_pk_bf16(y[2] * g[2], y[3] * g[3]); w.z = cvt_pk_bf16(y[4] * g[4], y[5] * g[5]); w.w = cvt_pk_bf16(y[6] * g[6], y[7] * g[7]);
                    *(u32x4*)(O + (size_t)row * ldo + ooff + col0 + bj * HALF) = w; } }
    }
};
struct EpiGluGate {
    static constexpr bool PERM = true, AFTER_DRAIN = true;
    const bf16_t* Y; const bf16_t* Pz; bf16_t* G;
    __device__ __forceinline__ void fused(const f32x4 (&acc)[2][2][4][2], const Unit& u, int wr, int wc, int fr, int fq, PG8_LAS unsigned char* lds, int wid, int lane) const {
        constexpr int TS = 528;
        TPU_START(130);
        const int row0 = wr * 64 + fr, col0 = wc * 32 + 8 * fq;
#pragma unroll
        for (int ai = 0; ai < 2; ++ai)
#pragma unroll
            for (int m = 0; m < 4; ++m) { const int rl = row0 + ai * HALF + m * 16; const size_t grow = (size_t)u.pm * BM + rl;
#pragma unroll
                for (int bj = 0; bj < 2; ++bj) { const f32x4 v0 = acc[ai][bj][m][0], v1 = acc[ai][bj][m][1];
                    const u32x4 yw = *(const u32x4*)(Y + grow * 512 + u.pn * BM + col0 + bj * HALF);
                    float y[8], g[8];
#pragma unroll
                    for (int j = 0; j < 4; ++j) { y[2 * j] = __uint_as_float(yw[j] << 16); y[2 * j + 1] = __uint_as_float(yw[j] & 0xffff0000u); }
#pragma unroll
                    for (int j = 0; j < 4; ++j) { g[j] = __builtin_amdgcn_rcpf(1.f + __expf(-v0[j])); g[4 + j] = __builtin_amdgcn_rcpf(1.f + __expf(-v1[j])); }
                    u32x4 w; w.x = cvt_pk_bf16(y[0] * g[0], y[1] * g[1]); w.y = cvt_pk_bf16(y[2] * g[2], y[3] * g[3]); w.z = cvt_pk_bf16(y[4] * g[4], y[5] * g[5]); w.w = cvt_pk_bf16(y[6] * g[6], y[7] * g[7]);
                    *(PG8_LAS u32x4*)(lds + rl * TS + (col0 + bj * HALF) * 2) = w; } }
        u32x4 zr[16];
#pragma unroll
        for (int i = 0; i < 16; ++i) { const size_t grow = (size_t)u.pm * BM + wid * 32 + 2 * i + (lane >> 5);
            zr[i] = *(const u32x4*)(Pz + grow * 6144 + 2064 + u.pn * BM + 8 * (lane & 31)); }
        __syncthreads();
        { const int t = wid * 64 + lane, row = t >> 1, hd = t & 1; const PG8_LAS unsigned char* src = lds + row * TS + hd * 256;
          float ss = 0.f;
#pragma unroll
          for (int i = 0; i < 16; ++i) { const u32x4 w = *(const PG8_LAS u32x4*)(src + 16 * i);
#pragma unroll
              for (int j = 0; j < 4; ++j) { const float a = __uint_as_float(w[j] << 16), b = __uint_as_float(w[j] & 0xffff0000u); ss += a * a + b * b; } }
          *(PG8_LAS float*)(lds + row * TS + 512 + hd * 4) = rsqrtf(ss * (1.f / 128.f) + 1e-6f); }
        asm volatile("s_waitcnt lgkmcnt(0)" ::: "memory");
#pragma unroll
        for (int i = 0; i < 16; ++i) { const int row = wid * 32 + 2 * i + (lane >> 5), c8 = 8 * (lane & 31);
            const u32x4 w = *(const PG8_LAS u32x4*)(lds + row * TS + c8 * 2); const float rn = *(const PG8_LAS float*)(lds + row * TS + 512 + (c8 >> 7) * 4);
            const u32x4 zw = zr[i]; u32x4 o;
#pragma unroll
            for (int j = 0; j < 4; ++j) { const float a = __uint_as_float(w[j] << 16), b = __uint_as_float(w[j] & 0xffff0000u), za = __uint_as_float(zw[j] << 16), zb = __uint_as_float(zw[j] & 0xffff0000u);
                o[j] = cvt_pk_bf16(a * rn * (za * __builtin_amdgcn_rcpf(1.f + __expf(-za))), b * rn * (zb * __builtin_amdgcn_rcpf(1.f + __expf(-zb)))); }
            *(u32x4*)(G + ((size_t)u.pm * BM + row) * 2048 + 512 + u.pn * BM + c8) = o; }
        __syncthreads();
        TPU_STOP(130);
    }
};
struct EpiBf16Scale {
    static constexpr bool PERM = true, AFTER_DRAIN = false;
    bf16_t* O; int ldc; const float* ssq;
    __device__ __forceinline__ void operator()(const f32x4 (&acc)[2][2][4][2], const Unit& u, int wr, int wc, int fr, int fq) const {
        const int row0 = u.pm * BM + wr * 64 + fr, col0 = u.pn * BM + wc * 32 + 8 * fq;
#pragma unroll
        for (int ai = 0; ai < 2; ++ai)
#pragma unroll
            for (int m = 0; m < 4; ++m) { const int row = row0 + ai * HALF + m * 16; bf16_t* rowp = O + (size_t)row * ldc + col0;
                float ssum = 0.f; { const f32x4* sp_ = (const f32x4*)(ssq + (size_t)row * 32);
#pragma unroll
                    for (int q = 0; q < 8; ++q) { const f32x4 t4 = sp_[q]; ssum += (t4[0] + t4[1]) + (t4[2] + t4[3]); } }
                const float s = rsqrtf(ssum * (1.f / 2048.f) + 1e-6f);
#pragma unroll
                for (int bj = 0; bj < 2; ++bj) { const f32x4 v0 = acc[ai][bj][m][0] * s, v1 = acc[ai][bj][m][1] * s;
                    u32x4 w; w.x = cvt_pk_bf16(v0[0], v0[1]); w.y = cvt_pk_bf16(v0[2], v0[3]); w.z = cvt_pk_bf16(v1[0], v1[1]); w.w = cvt_pk_bf16(v1[2], v1[3]);
                    *(u32x4*)(rowp + bj * HALF) = w; } }
    }
};
struct EpiResidNext {
    static constexpr bool PERM = false, AFTER_DRAIN = false;
    const float* R; float* C; int ldc; bf16_t* XB; float* ssq;
    __device__ __forceinline__ void operator()(const f32x4 (&acc)[2][2][4][2], const Unit& u, int wr, int wc, int fr, int fq) const {
        const int row0 = u.pm * BM + wr * 64 + fr, col0 = u.pn * BM + wc * 32 + 4 * fq;
#pragma unroll
        for (int ai = 0; ai < 2; ++ai)
#pragma unroll
            for (int m = 0; m < 4; ++m) { const int row = row0 + ai * HALF + m * 16; const size_t off = (size_t)row * ldc + col0; float ss = 0.f;
#pragma unroll
                for (int bj = 0; bj < 2; ++bj)
#pragma unroll
                    for (int n = 0; n < 2; ++n) { const f32x4 r = *(const f32x4*)(R + off + bj * HALF + n * 16); const f32x4 v = acc[ai][bj][m][n] + r;
                        *(f32x4*)(C + off + bj * HALF + n * 16) = v;
                        if (XB) { u32x2 w; w.x = cvt_pk_bf16(v[0], v[1]); w.y = cvt_pk_bf16(v[2], v[3]); *(u32x2*)(XB + off + bj * HALF + n * 16) = w; }
                        ss += v[0] * v[0] + v[1] * v[1] + v[2] * v[2] + v[3] * v[3]; }
                if (ssq) { ss += shx(ss, 16); ss += shx(ss, 32); if (fq == 0) ssq[(size_t)row * 32 + u.pn * 4 + wc] = ss; } }
    }
};
template <class Epi, class Sched, bool STAMP = false>
__device__ __forceinline__ void gemm_phase(PG8_LAS unsigned char* lds, const Gemm g, const Sched& S, const Epi& E, unsigned long long* stamps) {
    const int tid = TIDX(), wid = __builtin_amdgcn_readfirstlane(tid >> 6), lane = tid & 63, wr = wid >> 2, wc = wid & 3, fr = lane & 15, fq = lane >> 4;
    const int K = g.K, nt = K / BK;
    int ts_lo = 0, ts_hi = 0, nts = 0; const unsigned long long rt_entry = STAMP ? (unsigned long long)wall_clock64() : 0ull;
#define PG8_STAMP() do { if (STAMP && wid == 0 && nts < 64) { const unsigned long long _c = (unsigned long long)clock64(); \
        ts_lo = (lane == nts) ? (int)(unsigned)_c : ts_lo; ts_hi = (lane == nts) ? (int)(unsigned)(_c >> 32) : ts_hi; ++nts; } } while (0)
    PG8_STAMP();
    unsigned voffA[2], voffB[2];
#pragma unroll
    for (int i = 0; i < 2; ++i) { int R, C; stage_rc(tid * 16 + i * 8192, R, C); const int Rb = Epi::PERM ? ((R & ~31) + perm32(R & 31)) : R;
        voffA[i] = (unsigned)(R * K + C) * 2u; voffB[i] = (unsigned)(Rb * K + C) * 2u; }
    const size_t kstep = (size_t)(BK * 2);
    const size_t hstep = (size_t)HALF * K * 2;
    const size_t tstep = 2 * hstep;
    const unsigned ldsw = (unsigned)wid * 1024u;
    const int aoff = lds_byte(wr * 64 + fr, fq * 8), boff = lds_byte(wc * 32 + fr, fq * 8);
#define PG8_SA(b, h) (((b) * 2 + (h)) * HTB)
#define PG8_SB(b, h) ((4 + (b) * 2 + (h)) * HTB)
#define PG8_STAGE(bufoff, gbase, voff) do { _Pragma("unroll") for (int _i = 0; _i < 2; ++_i) \
        __builtin_amdgcn_global_load_lds((const unsigned*)((const char*)(gbase) + (voff)[_i]), (PG8_LAS unsigned*)(lds + (bufoff) + ldsw + _i * 8192), 16, 0, 0); } while (0)
#define PG8_LDA(dst, b, h) do { _Pragma("unroll") for (int m = 0; m < 4; ++m) _Pragma("unroll") for (int k = 0; k < 2; ++k) dst[m][k] = *(const PG8_LAS bf16x8*)(lds + PG8_SA(b, h) + aoff + m * 2048 + k * 1024); } while (0)
#define PG8_LDB(dst, b, h) do { _Pragma("unroll") for (int n = 0; n < 2; ++n) _Pragma("unroll") for (int k = 0; k < 2; ++k) dst[n][k] = *(const PG8_LAS bf16x8*)(lds + PG8_SB(b, h) + boff + n * 2048 + k * 1024); } while (0)
#define PG8_MMA(ai, bj, At, Bt) do { __builtin_amdgcn_s_setprio(1); _Pragma("unroll") for (int m = 0; m < 4; ++m) _Pragma("unroll") for (int n = 0; n < 2; ++n) _Pragma("unroll") for (int k = 0; k < 2; ++k) \
        acc[ai][bj][m][n] = __builtin_amdgcn_mfma_f32_16x16x32_bf16(Bt[n][k], At[m][k], acc[ai][bj][m][n], 0, 0, 0); __builtin_amdgcn_s_setprio(0); } while (0)
#define PG8_WAIT_V(n) asm volatile("s_waitcnt vmcnt(" #n ")" ::: "memory")
#define PG8_WAIT_L(n) asm volatile("s_waitcnt lgkmcnt(" #n ")" ::: "memory")
#define PG8_BAR __builtin_amdgcn_s_barrier()
#define PG8_SCHED __builtin_amdgcn_sched_barrier(0)
    Unit cur, nxt; int ui = 0;
    if (!S.next(0, cur)) return;
    f32x4 acc[2][2][4][2];
#pragma unroll
    for (int a = 0; a < 2; ++a)
#pragma unroll
        for (int b = 0; b < 2; ++b)
#pragma unroll
            for (int m = 0; m < 4; ++m)
#pragma unroll
                for (int n = 0; n < 2; ++n) acc[a][b][m][n] = (f32x4){0.f, 0.f, 0.f, 0.f};
    bf16x8 At[4][2], B0[2][2], B1[2][2];
    const char* cA = (const char*)g.A + (size_t)cur.pm * tstep; const char* cB = (const char*)g.Bt + (size_t)cur.pn * tstep;
    S.a_ready(cur);
    PG8_STAGE(PG8_SB(0, 0), cB, voffB); PG8_STAGE(PG8_SA(0, 0), cA, voffA); PG8_STAGE(PG8_SB(0, 1), cB + hstep, voffB); PG8_STAGE(PG8_SA(0, 1), cA + hstep, voffA);
    if (wr == 1) PG8_BAR;
    PG8_WAIT_V(4); PG8_BAR;
    PG8_STAGE(PG8_SB(1, 0), cB + kstep, voffB); PG8_STAGE(PG8_SA(1, 0), cA + kstep, voffA); PG8_STAGE(PG8_SB(1, 1), cB + hstep + kstep, voffB);
    PG8_WAIT_V(6); PG8_BAR;
    PG8_STAMP();
    for (;;) {
        const bool has_next = S.next(ui + 1, nxt);
        const char* nA = has_next ? (const char*)g.A + (size_t)nxt.pm * tstep : cA; const char* nB = has_next ? (const char*)g.Bt + (size_t)nxt.pn * tstep : cB;
        for (int t = 0; t < nt; t += 2) {
            const bool last = (t == nt - 2);
            const char* a1 = cA + (size_t)(t + 1) * kstep;
            const char* a2 = last ? nA : cA + (size_t)(t + 2) * kstep; const char* b2 = last ? nB : cB + (size_t)(t + 2) * kstep;
            const char* a3 = a2 + kstep; const char* b3 = b2 + kstep;
            if (last && has_next) S.a_ready(nxt);
            PG8_LDB(B0, 0, 0); PG8_SCHED; PG8_LDA(At, 0, 0); PG8_STAGE(PG8_SA(1, 1), a1 + hstep, voffA);
            PG8_WAIT_L(8); PG8_BAR; PG8_WAIT_L(0); PG8_MMA(0, 0, At, B0); PG8_BAR; PG8_SCHED;
            PG8_LDB(B1, 0, 1); PG8_STAGE(PG8_SB(0, 0), b2, voffB);
            PG8_BAR; PG8_WAIT_L(0); PG8_MMA(0, 1, At, B1); PG8_BAR;
            PG8_LDA(At, 0, 1); PG8_STAGE(PG8_SA(0, 0), a2, voffA);
            PG8_BAR; PG8_WAIT_L(0); PG8_MMA(1, 0, At, B0); PG8_BAR; PG8_SCHED;
            PG8_STAGE(PG8_SB(0, 1), b2 + hstep, voffB);
            PG8_WAIT_V(6); PG8_BAR; PG8_MMA(1, 1, At, B1); PG8_BAR;
            PG8_LDB(B0, 1, 0); PG8_SCHED; PG8_LDA(At, 1, 0); PG8_STAGE(PG8_SA(0, 1), a2 + hstep, voffA);
            PG8_WAIT_L(8); PG8_BAR; PG8_WAIT_L(0); PG8_MMA(0, 0, At, B0); PG8_BAR; PG8_SCHED;
            PG8_LDB(B1, 1, 1); PG8_STAGE(PG8_SB(1, 0), b3, voffB);
            PG8_BAR; PG8_WAIT_L(0); PG8_MMA(0, 1, At, B1); PG8_BAR;
            PG8_LDA(At, 1, 1); PG8_STAGE(PG8_SA(1, 0), a3, voffA);
            PG8_BAR; PG8_WAIT_L(0); PG8_MMA(1, 0, At, B0); PG8_BAR; PG8_SCHED;
            PG8_STAGE(PG8_SB(1, 1), b3 + hstep, voffB);
            PG8_WAIT_V(6); PG8_BAR; PG8_MMA(1, 1, At, B1); PG8_BAR;
        }
        PG8_STAMP();
        if constexpr (!Epi::AFTER_DRAIN) { E(acc, cur, wr, wc, fr, fq); S.done(cur); }
        PG8_STAMP();
        if (!has_next) break;
#pragma unroll
        for (int a = 0; a < 2; ++a)
#pragma unroll
            for (int b = 0; b < 2; ++b)
#pragma unroll
                for (int m = 0; m < 4; ++m)
#pragma unroll
                    for (int n = 0; n < 2; ++n) acc[a][b][m][n] = (f32x4){0.f, 0.f, 0.f, 0.f};
        cur = nxt; cA = nA; cB = nB; ++ui;
    }
    PG8_WAIT_V(0);
    if (wr == 0) PG8_BAR;
    PG8_BAR;
    if constexpr (Epi::AFTER_DRAIN) { E.fused(acc, cur, wr, wc, fr, fq, lds, wid, lane); S.done(cur); }
    PG8_STAMP();
    if (STAMP && wid == 0) { stamps[lane] = lane < nts ? (((unsigned long long)(unsigned)ts_hi << 32) | (unsigned)ts_lo) : 0ull;
        if (lane == 62) stamps[62] = rt_entry; if (lane == 63) stamps[63] = (unsigned long long)wall_clock64(); }
#undef PG8_STAMP
#undef PG8_SA
#undef PG8_SB
#undef PG8_STAGE
#undef PG8_LDA
#undef PG8_LDB
#undef PG8_MMA
#undef PG8_WAIT_V
#undef PG8_WAIT_L
#undef PG8_BAR
#undef PG8_SCHED
}
}
namespace att {
constexpr int D = 128, NW = 8, QBLK = 32, KVBLK = 64;
constexpr float SCALE = 0.088388347648318440f, THR = 8.f;
constexpr int SHM_V = KVBLK * D * 2, SHM_K = KVBLK * D * 2, SHM_ATTN = 2 * SHM_V + 2 * SHM_K + NW * 64 * 4;
#define KSWZ(row, colB) ((row) * 256 + ((colB) ^ (((row) & 7) << 4)))
#define SBAR() __builtin_amdgcn_sched_barrier(0)
__device__ __forceinline__ int crow(int r, int hi) { return (r & 3) + 8 * (r >> 2) + 4 * hi; }
__device__ __forceinline__ unsigned cvtpk(float lo, float hi) { unsigned r; asm volatile("v_cvt_pk_bf16_f32 %0, %1, %2" : "=v"(r) : "v"(lo), "v"(hi)); return r; }

template <bool MASKED>
__device__ __forceinline__ void partialSM(f32x16& p0, f32x16& p1, float& m_reg, float& mn, float& alpha, unsigned long long mw, int hi) {
  constexpr float C = SCALE * 1.4426950408889634f;
  float pmax = p0[0];
#pragma unroll
  for (int r = 1; r < 16; ++r) pmax = fmaxf(pmax, p0[r]);
#pragma unroll
  for (int r = 0; r < 16; ++r) pmax = fmaxf(pmax, p1[r]);
  { auto rr = __builtin_amdgcn_permlane32_swap(__float_as_uint(pmax), __float_as_uint(pmax), false, false);
    pmax = fmaxf(__uint_as_float(rr[0]), __uint_as_float(rr[1])); }
  if (__builtin_expect(__all(pmax - m_reg <= THR / SCALE), 1)) { mn = m_reg; alpha = 1.f; }
  else { mn = fmaxf(m_reg, pmax); alpha = __builtin_amdgcn_exp2f((m_reg - mn) * C); m_reg = mn; }
  const float mnC = -mn * C;
#pragma unroll
  for (int r = 0; r < 16; ++r) p0[r] = fmaf(p0[r], C, mnC);
#pragma unroll
  for (int r = 0; r < 16; ++r) p1[r] = fmaf(p1[r], C, mnC);
#pragma unroll
  for (int r = 0; r < 16; ++r) p0[r] = __builtin_amdgcn_exp2f(p0[r]);
}
__device__ __forceinline__ void finishSM(f32x16& p0, f32x16& p1, float alpha, float& l_reg, bf16x8& pa0, bf16x8& pa1, bf16x8& pa2, bf16x8& pa3) {
#pragma unroll
  for (int r = 0; r < 16; ++r) p1[r] = __builtin_amdgcn_exp2f(p1[r]);
  float ps = 0;
#pragma unroll
  for (int r = 0; r < 16; ++r) ps += p0[r];
#pragma unroll
  for (int r = 0; r < 16; ++r) ps += p1[r];
  { auto rr = __builtin_amdgcn_permlane32_swap(__float_as_uint(ps), __float_as_uint(ps), false, false);
    ps = __uint_as_float(rr[0]) + __uint_as_float(rr[1]); }
  l_reg = l_reg * alpha + ps;
#define PK4(P, BASE, OUT) do { unsigned a0 = cvtpk(P[BASE + 0], P[BASE + 1]), a1 = cvtpk(P[BASE + 2], P[BASE + 3]);   \
    unsigned b0 = cvtpk(P[BASE + 4], P[BASE + 5]), b1 = cvtpk(P[BASE + 6], P[BASE + 7]);                              \
    auto r0 = __builtin_amdgcn_permlane32_swap(a0, b0, false, false); auto r1 = __builtin_amdgcn_permlane32_swap(a1, b1, false, false); \
    u32x4 w = {r0[0], r1[0], r0[1], r1[1]}; OUT = *reinterpret_cast<bf16x8*>(&w); } while (0)
  PK4(p0, 0, pa0); PK4(p0, 8, pa1); PK4(p1, 0, pa2); PK4(p1, 8, pa3);
#undef PK4
}
template <int R> __device__ __forceinline__ float mask_bias(unsigned nw) {
  unsigned t; constexpr int bit = (R & 3) + 8 * (R >> 2);
  asm("v_bfe_i32 %0, %1, %2, 1\n\tv_and_b32 %0, 0xff800000, %0" : "=v"(t) : "v"(nw), "n"(bit));
  return __uint_as_float(t);
}
template <bool MASKED>
__device__ __forceinline__ void qkt(f32x16& p0, f32x16& p1, const char* Ks, const bf16x8* qr, int r32, int hi, unsigned long long mw) {
  if (MASKED) {
    const unsigned n0 = ~((unsigned)mw >> (4 * hi)), n1 = ~((unsigned)(mw >> 32) >> (4 * hi));
#define MB_(R) p0[R] = mask_bias<R>(n0); p1[R] = mask_bias<R>(n1);
    MB_(0) MB_(1) MB_(2) MB_(3) MB_(4) MB_(5) MB_(6) MB_(7) MB_(8) MB_(9) MB_(10) MB_(11) MB_(12) MB_(13) MB_(14) MB_(15)
#undef MB_
  } else { p0 = f32x16{}; p1 = f32x16{}; }
  asm volatile("" : "+v"(p0), "+v"(p1));
#pragma unroll
  for (int d0 = 0; d0 < 8; ++d0) { const int cb = (d0 * 16 + hi * 8) * 2;
    bf16x8 b0 = *reinterpret_cast<const bf16x8*>(Ks + KSWZ(r32, cb));
    bf16x8 b1 = *reinterpret_cast<const bf16x8*>(Ks + KSWZ(32 + r32, cb));
    p0 = __builtin_amdgcn_mfma_f32_32x32x16_bf16(b0, qr[d0], p0, 0, 0, 0);
    p1 = __builtin_amdgcn_mfma_f32_32x32x16_bf16(b1, qr[d0], p1, 0, 0, 0); }
}
__device__ __forceinline__ int v_st(int k, int c) { const int kk = (k & ~0xC) | ((k & 4) << 1) | ((k & 8) >> 1); return ((kk >> 3) * 4 + (c >> 5)) * 512 + ((kk & 7) * 32 + (c & 31)) * 2; }
__device__ __forceinline__ int v_rd_base(int lane) { return ((lane & 3) << 3) | (((lane >> 2) & 3) << 6) | (((lane >> 4) & 1) << 5) | (((lane >> 5) & 1) << 8); }
constexpr int v_rd_off(int d0, int ks, int half) { return d0 * 512 + ks * 4096 + half * 2048; }
template <int OFF> __device__ __forceinline__ s16x4 tr_read(int vb) {
  s16x4 r; asm volatile("ds_read_b64_tr_b16 %0, %1 offset:%2" : "=&v"(r) : "v"(vb), "i"(OFF) : "memory"); return r;
}
template <int D0> __device__ __forceinline__ void pv_one(f32x16& od, int vb, bf16x8 pa0, bf16x8 pa1, bf16x8 pa2, bf16x8 pa3) {
  const s16x4 l0 = tr_read<v_rd_off(D0, 0, 0)>(vb), h0 = tr_read<v_rd_off(D0, 0, 1)>(vb), l1 = tr_read<v_rd_off(D0, 1, 0)>(vb), h1 = tr_read<v_rd_off(D0, 1, 1)>(vb);
  const s16x4 l2 = tr_read<v_rd_off(D0, 2, 0)>(vb), h2 = tr_read<v_rd_off(D0, 2, 1)>(vb), l3 = tr_read<v_rd_off(D0, 3, 0)>(vb), h3 = tr_read<v_rd_off(D0, 3, 1)>(vb);
  asm volatile("s_waitcnt lgkmcnt(0)" ::: "memory"); SBAR();
#define PK(L, H) (bf16x8){L[0], L[1], L[2], L[3], H[0], H[1], H[2], H[3]}
  od = __builtin_amdgcn_mfma_f32_32x32x16_bf16(pa0, PK(l0, h0), od, 0, 0, 0);
  od = __builtin_amdgcn_mfma_f32_32x32x16_bf16(pa1, PK(l1, h1), od, 0, 0, 0);
  od = __builtin_amdgcn_mfma_f32_32x32x16_bf16(pa2, PK(l2, h2), od, 0, 0, 0);
  od = __builtin_amdgcn_mfma_f32_32x32x16_bf16(pa3, PK(l3, h3), od, 0, 0, 0);
#undef PK
}
__device__ __forceinline__ void pv_d0(f32x16* o, int vb, bf16x8 pa0, bf16x8 pa1, bf16x8 pa2, bf16x8 pa3) {
  pv_one<0>(o[0], vb, pa0, pa1, pa2, pa3); pv_one<1>(o[1], vb, pa0, pa1, pa2, pa3); pv_one<2>(o[2], vb, pa0, pa1, pa2, pa3); pv_one<3>(o[3], vb, pa0, pa1, pa2, pa3);
}

template <bool MASKED, int LDK, int VOFF, int QT, class OutRow>
__device__ __forceinline__ void attn_body(const bf16_t* __restrict__ Qw, const float* __restrict__ qgain, const float* __restrict__ qcs, const bf16_t* __restrict__ Kh, int NT,
                                          const unsigned long long* __restrict__ mbase, unsigned moff, const OutRow& Ow, char* lds) {
  const int tid = TIDX(), wid = tid >> 6, lane = tid & 63, r32 = lane & 31, hi = lane >> 5;
  char* V_lds = lds; char* K_lds = lds + 2 * SHM_V;
  float* ws = (float*)(lds + 2 * SHM_V + 2 * SHM_K) + wid * 64; float* li_l = ws; float* al_l = ws + 32;
  float m_reg = -1e30f, l_reg = 0; f32x16 o[4] = {}; bf16x8 qr[8];
  asm volatile("" : "+v"(o[0]), "+v"(o[1]), "+v"(o[2]), "+v"(o[3]));
#pragma unroll
  for (int d0 = 0; d0 < 8; ++d0) qr[d0] = *reinterpret_cast<const bf16x8*>(Qw + d0 * 16);
  if (QT) {
    float ss = 0.f;
#pragma unroll
    for (int d0 = 0; d0 < 8; ++d0)
#pragma unroll
      for (int j = 0; j < 8; ++j) { const float x = bf2f((bf16_t)qr[d0][j]); ss += x * x; }
    { auto rr = __builtin_amdgcn_permlane32_swap(__float_as_uint(ss), __float_as_uint(ss), false, false); ss = __uint_as_float(rr[0]) + __uint_as_float(rr[1]); }
    const float rn = rsqrtf(ss * (1.f / 128.f) + EPS);
    float x01[2][8];
#pragma unroll
    for (int d0 = 0; d0 < 8; ++d0) { const f32x4 g0 = *(const f32x4*)(qgain + d0 * 16 + hi * 8), g1 = *(const f32x4*)(qgain + d0 * 16 + hi * 8 + 4);
      float x[8];
#pragma unroll
      for (int j = 0; j < 8; ++j) x[j] = bf2f((bf16_t)qr[d0][j]) * rn * (j < 4 ? g0[j] : g1[j - 4]);
      if (QT == 2 && d0 < 2) {
#pragma unroll
        for (int j = 0; j < 8; ++j) x01[d0][j] = x[j];
      } else { u32x4 w = {cvtpk(x[0], x[1]), cvtpk(x[2], x[3]), cvtpk(x[4], x[5]), cvtpk(x[6], x[7])}; qr[d0] = *reinterpret_cast<bf16x8*>(&w); } }
    if (QT == 2) {
      float a[8], b[8];
#pragma unroll
      for (int j2 = 0; j2 < 4; ++j2) { const f32x4 cs = *(const f32x4*)(qcs + hi * 16 + 4 * j2);
#pragma unroll
        for (int q = 0; q < 2; ++q) { const int j = 2 * j2 + q; const float c = cs[2 * q], sn = cs[2 * q + 1], x1 = x01[0][j], x2 = x01[1][j]; a[j] = x1 * c - x2 * sn; b[j] = x2 * c + x1 * sn; } }
      { u32x4 w = {cvtpk(a[0], a[1]), cvtpk(a[2], a[3]), cvtpk(a[4], a[5]), cvtpk(a[6], a[7])}; qr[0] = *reinterpret_cast<bf16x8*>(&w); }
      { u32x4 w = {cvtpk(b[0], b[1]), cvtpk(b[2], b[3]), cvtpk(b[4], b[5]), cvtpk(b[6], b[7])}; qr[1] = *reinterpret_cast<bf16x8*>(&w); }
    }
  }
  const int sr = tid >> 4, sc = (tid & 15) * 8, vst0 = v_st(sr, sc), vst1 = v_st(32 + sr, sc);
  const int vb0 = (int)(uintptr_t)V_lds + v_rd_base(lane);
  struct { bf16x8 vs0, vs1, ks0, ks1; } sr_[2];
  const unsigned koff = (unsigned)(sr * LDK + sc) * 2u;
#define SLOAD(i, k0) do { const char* kb_ = (const char*)Kh + (size_t)(k0) * (LDK * 2); \
    sr_[i].vs0 = *reinterpret_cast<const bf16x8*>(kb_ + koff + VOFF * 2); sr_[i].vs1 = *reinterpret_cast<const bf16x8*>(kb_ + koff + (32 * LDK + VOFF) * 2); \
    sr_[i].ks0 = *reinterpret_cast<const bf16x8*>(kb_ + koff); sr_[i].ks1 = *reinterpret_cast<const bf16x8*>(kb_ + koff + 32 * LDK * 2); } while (0)
#define SWRITE(b, i) do { *(bf16x8*)(V_lds + (b) * SHM_V + vst0) = sr_[i].vs0;          \
    *(bf16x8*)(V_lds + (b) * SHM_V + vst1) = sr_[i].vs1; int kc = sc * 2;               \
    *(bf16x8*)(K_lds + (b) * SHM_K + KSWZ(sr, kc)) = sr_[i].ks0;                       \
    *(bf16x8*)(K_lds + (b) * SHM_K + KSWZ(32 + sr, kc)) = sr_[i].ks1; } while (0)
#define SWAIT() asm volatile("s_waitcnt vmcnt(4)" ::: "memory")
#define RESC(a) do { if (__any((a) < 1.f)) { if (hi == 0) al_l[r32] = (a); asm volatile("s_waitcnt lgkmcnt(0)" ::: "memory"); \
    _Pragma("unroll") for (int d = 0; d < 4; ++d) _Pragma("unroll") for (int r = 0; r < 16; ++r) o[d][r] *= al_l[crow(r, hi)]; } } while (0)
  f32x16 pA0, pA1, pB0, pB1; float mnA, mnB, alA, alB; bf16x8 pa0, pa1, pa2, pa3;
  unsigned long long mw = 0ull;
  constexpr int SE = 0, SO = 1;
  if (MASKED) mw = *(const unsigned long long*)((const char*)mbase + moff);
  SLOAD(SE, 0); SLOAD(SO, KVBLK);
  SWAIT(); SWRITE(0, SE); __syncthreads();
  qkt<MASKED>(pA0, pA1, K_lds, qr, r32, hi, mw);
  if (MASKED) mw = *(const unsigned long long*)((const char*)mbase + (moff + 8u));
  partialSM<MASKED>(pA0, pA1, m_reg, mnA, alA, mw, hi);
  SLOAD(SE, (2 < NT ? 2 : NT - 1) * KVBLK);
  SWAIT();
  SWRITE(1, SO); __syncthreads();
  if (MASKED) TPU_START(120);
  for (int j = 1; j + 1 < NT; j += 2) {
    SBAR(); qkt<MASKED>(pB0, pB1, K_lds + SHM_K, qr, r32, hi, mw);
    if (MASKED) mw = *(const unsigned long long*)((const char*)mbase + (moff + 8u * (unsigned)(j + 1)));
    finishSM(pA0, pA1, alA, l_reg, pa0, pa1, pa2, pa3); SBAR();
    SLOAD(SO, (j + 2) * KVBLK); SBAR();
    pv_d0(o, vb0, pa0, pa1, pa2, pa3); partialSM<MASKED>(pB0, pB1, m_reg, mnB, alB, mw, hi);
    __syncthreads(); if (MASKED) asm volatile("s_waitcnt vmcnt(5)" ::: "memory"); else SWAIT();
    SWRITE(0, SE);
    RESC(alB); __syncthreads();
    SBAR(); qkt<MASKED>(pA0, pA1, K_lds, qr, r32, hi, mw);
    if (MASKED) mw = *(const unsigned long long*)((const char*)mbase + (moff + 8u * (unsigned)(j + 2)));
    finishSM(pB0, pB1, alB, l_reg, pa0, pa1, pa2, pa3); SBAR();
    SLOAD(SE, (j + 3 < NT ? j + 3 : NT - 1) * KVBLK); SBAR();
    pv_d0(o, vb0 + SHM_V, pa0, pa1, pa2, pa3); partialSM<MASKED>(pA0, pA1, m_reg, mnA, alA, mw, hi);
    __syncthreads(); if (MASKED) asm volatile("s_waitcnt vmcnt(5)" ::: "memory"); else SWAIT();
    SWRITE(1, SO);
    RESC(alA); __syncthreads();
  }
  SBAR(); qkt<MASKED>(pB0, pB1, K_lds + SHM_K, qr, r32, hi, mw);
  finishSM(pA0, pA1, alA, l_reg, pa0, pa1, pa2, pa3); SBAR();
  pv_d0(o, vb0, pa0, pa1, pa2, pa3); partialSM<MASKED>(pB0, pB1, m_reg, mnB, alB, mw, hi);
  __syncthreads(); RESC(alB);
  finishSM(pB0, pB1, alB, l_reg, pa0, pa1, pa2, pa3); SBAR();
  pv_d0(o, vb0 + SHM_V, pa0, pa1, pa2, pa3);
  if (MASKED) TPU_STOP(120);
  if (MASKED) TPU_START(121);
  u32x4 zr[8];
#pragma unroll
  for (int i = 0; i < 8; ++i) zr[i] = *(const u32x4*)(Ow.zrow(4 * i + (lane >> 4)) + 8 * (lane & 15));
  if (hi == 0) li_l[r32] = l_reg; asm volatile("s_waitcnt lgkmcnt(0)" ::: "memory");
  float rli[16];
#pragma unroll
  for (int r = 0; r < 16; ++r) rli[r] = __builtin_amdgcn_rcpf(li_l[crow(r, hi)]);
  __syncthreads();
  float* og_s = (float*)lds + wid * (32 * 132);
#pragma unroll
  for (int r = 0; r < 16; ++r) {
#pragma unroll
    for (int d0 = 0; d0 < 4; ++d0) og_s[crow(r, hi) * 132 + d0 * 32 + r32] = o[d0][r] * rli[r]; }
  asm volatile("" ::: "memory");
  { const int row = lane >> 1, half = lane & 1; const float* src = og_s + row * 132 + half * 64;
    float ss = 0.f;
#pragma unroll
    for (int i = 0; i < 16; ++i) { const f32x4 v = *(const f32x4*)(src + 4 * i); ss += v[0] * v[0] + v[1] * v[1] + v[2] * v[2] + v[3] * v[3]; }
    ss += shx(ss, 1);
    if (half == 0) og_s[row * 132 + 128] = rsqrtf(ss * (1.f / 128.f) + EPS); }
  asm volatile("s_waitcnt lgkmcnt(0)" ::: "memory");
#pragma unroll
  for (int i = 0; i < 8; ++i) { const int row = 4 * i + (lane >> 4), c8 = 8 * (lane & 15); const float* src = og_s + row * 132 + c8;
    const f32x4 a = *(const f32x4*)src, b2 = *(const f32x4*)(src + 4); const float rn = og_s[row * 132 + 128];
    float z[8], g[8];
    z[0] = __uint_as_float(zr[i].x << 16); z[1] = __uint_as_float(zr[i].x & 0xffff0000u); z[2] = __uint_as_float(zr[i].y << 16); z[3] = __uint_as_float(zr[i].y & 0xffff0000u);
    z[4] = __uint_as_float(zr[i].z << 16); z[5] = __uint_as_float(zr[i].z & 0xffff0000u); z[6] = __uint_as_float(zr[i].w << 16); z[7] = __uint_as_float(zr[i].w & 0xffff0000u);
#pragma unroll
    for (int q = 0; q < 4; ++q) { g[q] = a[q] * rn * siluf_(z[q]); g[4 + q] = b2[q] * rn * siluf_(z[4 + q]); }
    st8f(Ow.grow(row) + c8, g); }
  __syncthreads();
  if (MASKED) TPU_STOP(121);
#undef SLOAD
#undef SWRITE
#undef SWAIT
#undef RESC
}
}
constexpr size_t al256(size_t x) { return (x + 255) / 256 * 256; }
constexpr size_t WS_CTL   = 0;
constexpr size_t CTL_BYTES = 65536;
constexpr size_t WS_WINT  = WS_CTL + CTL_BYTES;
constexpr size_t WS_WOUTT = WS_WINT + al256((size_t)DEPTH * NPAD * DM * 2);
constexpr size_t WS_WKVT  = WS_WOUTT + al256((size_t)DEPTH * DM * MIX * 2);
constexpr size_t WS_WGLUT = WS_WKVT + al256((size_t)DEPTH * 1024 * DM * 2);
constexpr size_t WS_MEMN  = WS_WGLUT + al256((size_t)DEPTH * 512 * 512 * 2);
constexpr size_t WS_KVMEM = WS_MEMN + al256((size_t)NB * MEML * DM * 2);
constexpr size_t WS_XN    = WS_KVMEM + al256((size_t)NB * MEML * DEPTH * 1024 * 2);
constexpr size_t WS_P     = WS_XN + al256((size_t)NTOK * DM * 2);
constexpr size_t WS_XBUF  = WS_P + al256((size_t)NTOK * NPAD * 2);
constexpr size_t WS_OCAT  = WS_XBUF + al256((size_t)NTOK * DM * 4);
constexpr size_t WS_MASK  = WS_OCAT + al256((size_t)NTOK * MIX * 2);
constexpr size_t WS_IW    = WS_MASK + al256((size_t)NTOK * 64 * 8);
constexpr size_t WS_YBUF  = WS_IW + al256((size_t)NTOK * 16 * 4);
constexpr size_t WS_ROPE  = WS_YBUF + al256((size_t)NTOK * 512 * 2);
constexpr size_t WS_S5P   = WS_ROPE + al256((size_t)NTOK * 48 * 4);
constexpr size_t S5P_BYTES = (size_t)DEPTH * 32 * (64 * 2 + 64 * 2 + 64 * 16 * 2) * 4;
constexpr size_t WS_GLAS  = WS_S5P + al256(S5P_BYTES);
constexpr size_t WS_GLAD  = WS_GLAS + al256((size_t)NB * 64 * 4 * 64 * 128 * 4);
constexpr size_t WS_IKC   = WS_GLAD + al256((size_t)NB * 64 * 4 * 64 * 4);
constexpr size_t WS_KVC   = WS_IKC + al256((size_t)NTOK * 64 * 2);
constexpr size_t WS_IQL   = WS_KVC + al256((size_t)NTOK * 256 * 2);
constexpr size_t WS_SSQ   = WS_IQL + al256((size_t)NTOK * 64 * 2);
constexpr size_t DSP_SLOT = (size_t)(256 * 128 + 512) * 4;
constexpr size_t WS_DSP   = WS_SSQ + 256;
constexpr size_t WS_END   = WS_DSP + al256((size_t)160 * 2 * DSP_SLOT);

struct Params {
    const float* x; const float* mem; const int* pos; const float* ln_gain; const float* w_in; const float* gla_w_up; const float* gla_b_up;
    const float* s5_a_re; const float* s5_a_im; const float* s5_log_step; const float* s5_b_re; const float* s5_b_im; const float* s5_c_re; const float* s5_c_im;
    const float* s5_d; const float* s5_w_glu; const float* dsa_q_norm; const float* dsa_k_norm; const float* mem_norm; const float* w_mem_kv;
    const float* mem_q_norm; const float* mem_k_norm; const float* out_norm; const float* w_out;
    float* out;
    char* ws;
    __device__ __forceinline__ unsigned* ctl_() const { return (unsigned*)(ws + WS_CTL); }
    __device__ __forceinline__ bf16_t* WinT_() const { return (bf16_t*)(ws + WS_WINT); }
    __device__ __forceinline__ bf16_t* WoutT_() const { return (bf16_t*)(ws + WS_WOUTT); }
    __device__ __forceinline__ bf16_t* WkvT_() const { return (bf16_t*)(ws + WS_WKVT); }
    __device__ __forceinline__ bf16_t* WgluT_() const { return (bf16_t*)(ws + WS_WGLUT); }
    __device__ __forceinline__ bf16_t* memn_() const { return (bf16_t*)(ws + WS_MEMN); }
    __device__ __forceinline__ bf16_t* kvmem_() const { return (bf16_t*)(ws + WS_KVMEM); }
    __device__ __forceinline__ bf16_t* xn_() const { return (bf16_t*)(ws + WS_XN); }
    __device__ __forceinline__ bf16_t* p_() const { return (bf16_t*)(ws + WS_P); }
    __device__ __forceinline__ bf16_t* xbuf_() const { return (bf16_t*)(ws + WS_XBUF); }
    __device__ __forceinline__ bf16_t* ocat_() const { return (bf16_t*)(ws + WS_OCAT); }
    __device__ __forceinline__ unsigned long long* mask_() const { return (unsigned long long*)(ws + WS_MASK); }
    __device__ __forceinline__ float* iw_() const { return (float*)(ws + WS_IW); }
    __device__ __forceinline__ bf16_t* ybuf_() const { return (bf16_t*)(ws + WS_YBUF); }
    __device__ __forceinline__ float* rope_() const { return (float*)(ws + WS_ROPE); }
    __device__ __forceinline__ float* s5p_() const { return (float*)(ws + WS_S5P); }
    __device__ __forceinline__ float* glas_() const { return (float*)(ws + WS_GLAS); }
    __device__ __forceinline__ float* glad_() const { return (float*)(ws + WS_GLAD); }
    __device__ __forceinline__ bf16_t* ikc_() const { return (bf16_t*)(ws + WS_IKC); }
    __device__ __forceinline__ bf16_t* kvc_() const { return (bf16_t*)(ws + WS_KVC); }
    __device__ __forceinline__ float* ssq_() const { return (float*)(ws + WS_SSQ); }
    __device__ __forceinline__ bf16_t* iql_() const { return (bf16_t*)(ws + WS_IQL); }
    __device__ __forceinline__ char* dsp_() const { return ws + WS_DSP; }
};

__device__ __forceinline__ void transpose_tiles(const float* __restrict__ src, int K, int Nsrc, int Ndst, const float* __restrict__ scale, bf16_t* __restrict__ dst,
                                                int tile, float* lds_tile  ) {
    const int tid = TIDX(), ntn = Ndst / 256;
    const int tk = tile / ntn, tn = tile % ntn, k0 = tk * 64, n0 = tn * 256;
    __syncthreads();
    { const int ty = tid >> 4, tx = tid & 15;
      f32x4 v[2][4];
#pragma unroll
      for (int i = 0; i < 2; ++i)
#pragma unroll
        for (int q = 0; q < 4; ++q) { const int k = k0 + ty + 32 * i, n = n0 + 4 * tx + 64 * q;
          v[i][q] = (f32x4){0.f, 0.f, 0.f, 0.f};
          if (n < Nsrc) v[i][q] = *(const f32x4*)(src + (size_t)k * Nsrc + n); }
#pragma unroll
      for (int i = 0; i < 2; ++i) { const float s = scale ? scale[k0 + ty + 32 * i] : 1.f;
#pragma unroll
        for (int q = 0; q < 4; ++q) { float* t = lds_tile + (ty + 32 * i) * 257 + 4 * tx + 64 * q; t[0] = v[i][q][0] * s; t[1] = v[i][q][1] * s; t[2] = v[i][q][2] * s; t[3] = v[i][q][3] * s; } } }
    __syncthreads();
    { const int n = tid >> 1, kh = (tid & 1) * 32;
#pragma unroll
      for (int j = 0; j < 4; ++j) { const int kb = kh + 8 * j; u32x4 w;
        w.x = pk2bf(lds_tile[(kb + 0) * 257 + n], lds_tile[(kb + 1) * 257 + n]); w.y = pk2bf(lds_tile[(kb + 2) * 257 + n], lds_tile[(kb + 3) * 257 + n]);
        w.z = pk2bf(lds_tile[(kb + 4) * 257 + n], lds_tile[(kb + 5) * 257 + n]); w.w = pk2bf(lds_tile[(kb + 6) * 257 + n], lds_tile[(kb + 7) * 257 + n]);
        *(u32x4*)(dst + (size_t)(n0 + n) * K + k0 + kb) = w; } }
}

__device__ __forceinline__ void rmsnorm_rows(const float* __restrict__ X, bf16_t* __restrict__ Y, int nrows) {
    const int wid = TIDX() >> 6, lane = TIDX() & 63;
    for (int row = blockIdx.x * 8 + wid; row < nrows; row += gridDim.x * 8) {
        const float* xr = X + (size_t)row * DM; f32x4 v[8]; float ss = 0.f;
#pragma unroll
        for (int i = 0; i < 8; ++i) { v[i] = *(const f32x4*)(xr + 4 * lane + 256 * i); ss += v[i][0] * v[i][0] + v[i][1] * v[i][1] + v[i][2] * v[i][2] + v[i][3] * v[i][3]; }
        ss = wave_sum(ss); const float r = rsqrtf(ss * (1.f / DM) + EPS);
        bf16_t* yr = Y + (size_t)row * DM;
#pragma unroll
        for (int i = 0; i < 8; ++i) { u32x2 w; w.x = pk2bf(v[i][0] * r, v[i][1] * r); w.y = pk2bf(v[i][2] * r, v[i][3] * r); *(u32x2*)(yr + 4 * lane + 256 * i) = w; }
    }
}

__device__ __forceinline__ void rmsnorm_rows16(const bf16_t* __restrict__ X, bf16_t* __restrict__ Y, int nrows) {
    const int wid = TIDX() >> 6, lane = TIDX() & 63;
    for (int row = blockIdx.x * 8 + wid; row < nrows; row += gridDim.x * 8) {
        const bf16_t* xr = X + (size_t)row * DM; float v[4][8]; float ss = 0.f;
#pragma unroll
        for (int i = 0; i < 4; ++i) { ld8f(xr + 8 * lane + 512 * i, v[i]);
#pragma unroll
            for (int j = 0; j < 8; ++j) ss += v[i][j] * v[i][j]; }
        ss = wave_sum(ss); const float r = rsqrtf(ss * (1.f / DM) + EPS);
        bf16_t* yr = Y + (size_t)row * DM;
#pragma unroll
        for (int i = 0; i < 4; ++i) { float o[8];
#pragma unroll
            for (int j = 0; j < 8; ++j) o[j] = v[i][j] * r;
            st8f(yr + 8 * lane + 512 * i, o); }
    }
}

__device__ __forceinline__ void rows_bf16_ssq(const float* __restrict__ X, bf16_t* __restrict__ Y, float* __restrict__ ssq, int nrows) {
    const int wid = TIDX() >> 6, lane = TIDX() & 63;
    for (int row = blockIdx.x * 8 + wid; row < nrows; row += gridDim.x * 8) {
        const float* xr = X + (size_t)row * DM; bf16_t* yr = Y + (size_t)row * DM; float ss = 0.f;
#pragma unroll
        for (int i = 0; i < 8; ++i) { const f32x4 v = *(const f32x4*)(xr + 4 * lane + 256 * i); ss += v[0] * v[0] + v[1] * v[1] + v[2] * v[2] + v[3] * v[3];
            u32x2 w; w.x = pk2bf(v[0], v[1]); w.y = pk2bf(v[2], v[3]); *(u32x2*)(yr + 4 * lane + 256 * i) = w; }
        ss = wave_sum(ss); if (lane < 32) ssq[(size_t)row * 32 + lane] = (lane == 0) ? ss : 0.f;
    }
}
__device__ __forceinline__ void phase_prologue1(const Params& P, char* lds) {
    float* tile = (float*)lds;
    constexpr int T_IN = (DM / 64) * (NPAD / 256), T_OUT = (MIX / 64) * (DM / 256), T_KV = (DM / 64) * (1024 / 256), T_GLU = 8 * 2;
    constexpr int TOT = DEPTH * (T_IN + T_OUT + T_KV + T_GLU);
    for (int u = blockIdx.x; u < TOT; u += gridDim.x) {
        int l = u / (T_IN + T_OUT + T_KV + T_GLU), r = u % (T_IN + T_OUT + T_KV + T_GLU);
        if (r < T_IN) transpose_tiles(P.w_in + (size_t)l * DM * NIN, DM, NIN, NPAD, P.ln_gain + l * DM, P.WinT_() + (size_t)l * NPAD * DM, r, tile);
        else if ((r -= T_IN) < T_OUT) transpose_tiles(P.w_out + (size_t)l * MIX * DM, MIX, DM, DM, P.out_norm + l * MIX, P.WoutT_() + (size_t)l * DM * MIX, r, tile);
        else if ((r -= T_OUT) < T_KV) transpose_tiles(P.w_mem_kv + (size_t)l * DM * 1024, DM, 1024, 1024, P.mem_norm + l * DM, P.WkvT_() + (size_t)l * 1024 * DM, r, tile);
        else { r -= T_KV; transpose_tiles(P.s5_w_glu + (size_t)l * 512 * 512, 512, 512, 512, nullptr, P.WgluT_() + (size_t)l * 512 * 512, r, tile); }
    }
    rmsnorm_rows(P.mem, P.memn_(), NB * MEML);
}
__device__ __forceinline__ void phase_rope_table(const Params& P) {
    for (int idx = blockIdx.x * NTHR + TIDX(); idx < NTOK * 24; idx += gridDim.x * NTHR) {
        const int tok = idx / 24, i = idx % 24;
        const float e = (i < 16) ? -((float)i * 2.0f / 32.0f) : -((float)(i - 16) * 2.0f / 16.0f);
        const float inv_freq = exp2f(e * 18.931568569324174f);
        const float ang = (float)P.pos[tok] * inv_freq;
        const double a = (double)ang; const double k = rint(a * 0.15915494309189535); const float rf = (float)fma(-k, 6.283185307179586, a);
        P.rope_()[(size_t)idx * 2] = cosf(rf); P.rope_()[(size_t)idx * 2 + 1] = sinf(rf);
    }
}

__device__ __forceinline__ void phase_rmsnorm_x(const Params& P, int layer) { if (layer == 0) rmsnorm_rows(P.x, P.xn_(), NTOK); else rmsnorm_rows16(P.xbuf_(), P.xn_(), NTOK); }

__device__ __forceinline__ void phase_memk_norm(const Params& P) {
    const int wid = TIDX() >> 6, lane = TIDX() & 63;
    for (int it = blockIdx.x * 8 + wid; it < NB * MEML * DEPTH * 4; it += gridDim.x * 8) {
        const int row = it / (DEPTH * 4), l = (it / 4) % DEPTH, h = it % 4;
        bf16_t* kp = P.kvmem_() + (size_t)row * (DEPTH * 1024) + l * 1024 + h * 128 + 2 * lane;
        const unsigned w = *(const unsigned*)kp; const float a = __uint_as_float(w << 16), b = __uint_as_float(w & 0xffff0000u);
        const float ss = wave_sum(a * a + b * b), r = rsqrtf(ss * (1.f / 128.f) + EPS);
        const float* g = P.mem_k_norm + l * 128 + 2 * lane;
        *(unsigned*)kp = pk2bf(a * r * g[0], b * r * g[1]);
    }
}

__device__ __forceinline__ float sum16(float v) { v += shx(v, 1); v += shx(v, 2); v += shx(v, 4); v += shx(v, 8); return v; }

__device__ __forceinline__ void head128_norm_rope_to(const bf16_t* hp, bf16_t* dp, int l16, const float* __restrict__ gain, const float* __restrict__ cs, bool rope, bool do_store) {
    float v[8]; ld8f(hp + 8 * l16, v);
    float ss = 0.f;
#pragma unroll
    for (int j = 0; j < 8; ++j) ss += v[j] * v[j];
    ss = sum16(ss); const float r = rsqrtf(ss * (1.f / 128.f) + EPS);
#pragma unroll
    for (int j = 0; j < 8; ++j) v[j] = v[j] * r * gain[8 * l16 + j];
    if (rope) {
        float o[8];
#pragma unroll
        for (int j = 0; j < 8; ++j) o[j] = shx(v[j], 2);
        if (l16 < 4) { const int fi = (l16 & 1) * 8;
#pragma unroll
            for (int j = 0; j < 8; ++j) { const float c = cs[(fi + j) * 2], s = cs[(fi + j) * 2 + 1];
                v[j] = (l16 < 2) ? (v[j] * c - o[j] * s) : (v[j] * c + o[j] * s); } }
    }
    if (do_store) st8f(dp + 8 * l16, v);
}
__device__ __forceinline__ void head128_norm_rope(bf16_t* hp, int l16, const float* __restrict__ gain, const float* __restrict__ cs, bool rope, bool do_store) { head128_norm_rope_to(hp, hp, l16, gain, cs, rope, do_store); }
__device__ __forceinline__ void rope16_inplace(bf16_t* ip, const float* __restrict__ cs) {
    float a[8], b[8]; ld8f(ip, a); ld8f(ip + 8, b);
#pragma unroll
    for (int j = 0; j < 8; ++j) { const float c = cs[2 * j], s = cs[2 * j + 1], x1 = a[j], x2 = b[j]; a[j] = x1 * c - x2 * s; b[j] = x2 * c + x1 * s; }
    st8f(ip, a); st8f(ip + 8, b);
}
struct PrepIn { u32x4 k, i0, i1, ik0, ik1, v; bf16_t w; f32x4 c32[4], c16[4]; };
__device__ __forceinline__ void prep_load(const Params& P, int tok, int lane, PrepIn& I) {
    const int l16 = lane & 15, grp = lane >> 4;
    const bf16_t* row = P.p_() + (size_t)tok * NPAD;
    I.k = *(const u32x4*)(row + C_DK + 8 * l16);
    I.i0 = *(const u32x4*)(row + C_DIQ + (lane >> 2) * 64); I.i1 = *(const u32x4*)(row + C_DIQ + (lane >> 2) * 64 + 8);
    I.ik0 = *(const u32x4*)(row + C_DIK + (lane & 3) * 16); I.ik1 = *(const u32x4*)(row + C_DIK + (lane & 3) * 16 + 8);
    I.v = *(const u32x4*)(row + C_DV + l16 * 8);
    I.w = row[C_DIW + l16];
    const float* cs32 = P.rope_() + (size_t)tok * 48;
#pragma unroll
    for (int i = 0; i < 4; ++i) { I.c32[i] = *(const f32x4*)(cs32 + (l16 & 1) * 16 + 4 * i); I.c16[i] = *(const f32x4*)(cs32 + 32 + 4 * i); }
}
__device__ __forceinline__ void unpack8(const u32x4 w, float (&v)[8]) {
    v[0] = __uint_as_float(w.x << 16); v[1] = __uint_as_float(w.x & 0xffff0000u); v[2] = __uint_as_float(w.y << 16); v[3] = __uint_as_float(w.y & 0xffff0000u);
    v[4] = __uint_as_float(w.z << 16); v[5] = __uint_as_float(w.z & 0xffff0000u); v[6] = __uint_as_float(w.w << 16); v[7] = __uint_as_float(w.w & 0xffff0000u); }
__device__ __forceinline__ void head128_nr(float (&v)[8], int l16, const float (&gain)[8], const f32x4 (&cs)[4], bool rope) {
    float ss = 0.f;
#pragma unroll
    for (int j = 0; j < 8; ++j) ss += v[j] * v[j];
    ss = sum16(ss); const float r = rsqrtf(ss * (1.f / 128.f) + EPS);
#pragma unroll
    for (int j = 0; j < 8; ++j) v[j] = v[j] * r * gain[j];
    if (rope) {
        float o[8];
#pragma unroll
        for (int j = 0; j < 8; ++j) o[j] = shx(v[j], 2);
        if (l16 < 4) {
#pragma unroll
            for (int j = 0; j < 8; ++j) { const float c = cs[j >> 1][(j & 1) * 2], s = cs[j >> 1][(j & 1) * 2 + 1];
                v[j] = (l16 < 2) ? (v[j] * c - o[j] * s) : (v[j] * c + o[j] * s); } }
    }
}
__device__ __forceinline__ void prep_finish(const Params& P, int tok, int lane, const PrepIn& I, const float (&gq)[8], const float (&gk)[8], const float (&gm)[8]) {
    const int l16 = lane & 15, grp = lane >> 4;
    bf16_t* row = P.p_() + (size_t)tok * NPAD;
    float k[8];
    unpack8(I.k, k);
    head128_nr(k, l16, gk, I.c32, true);
    if (grp == 0) st8f(P.kvc_() + (size_t)tok * 256 + 8 * l16, k);
    {
        float a[8], b[8]; unpack8(I.i0, a); unpack8(I.i1, b);
#pragma unroll
        for (int j = 0; j < 8; ++j) { const float c = I.c16[j >> 1][(j & 1) * 2], s = I.c16[j >> 1][(j & 1) * 2 + 1], x1 = a[j], x2 = b[j]; a[j] = x1 * c - x2 * s; b[j] = x2 * c + x1 * s; }
        if ((lane & 3) == 0) { st8f(row + C_DIQ + (lane >> 2) * 64, a); st8f(row + C_DIQ + (lane >> 2) * 64 + 8, b); } }
    {
        float a[8], b[8]; unpack8(I.ik0, a); unpack8(I.ik1, b);
        if ((lane & 3) == 0) {
#pragma unroll
            for (int j = 0; j < 8; ++j) { const float c = I.c16[j >> 1][(j & 1) * 2], s = I.c16[j >> 1][(j & 1) * 2 + 1], x1 = a[j], x2 = b[j]; a[j] = x1 * c - x2 * s; b[j] = x2 * c + x1 * s; } }
        if (lane < 4) { bf16_t* dst = P.ikc_() + (size_t)(tok >> 5) * 2048 + lane * 512 + (tok & 31) * 8; st8f(dst, a); st8f(dst + 256, b); } }
    if (lane >= 16 && lane < 32) *(u32x4*)(P.kvc_() + (size_t)tok * 256 + 128 + l16 * 8) = I.v;
    if (lane < 16) P.iw_()[(size_t)tok * 16 + lane] = bf2f(I.w) * (1.f / 32.f);
}
__device__ __forceinline__ void phase_prep(const Params& P, int layer) {
    const int wid = TIDX() >> 6, lane = TIDX() & 63, l16 = lane & 15;
    float gq[8], gk[8], gm[8];
#pragma unroll
    for (int j = 0; j < 8; ++j) { gq[j] = P.dsa_q_norm[layer * 128 + 8 * l16 + j]; gk[j] = P.dsa_k_norm[layer * 128 + 8 * l16 + j]; gm[j] = P.mem_q_norm[layer * 128 + 8 * l16 + j]; }
    const int stride = gridDim.x * 8;
    for (int tok = blockIdx.x * 8 + wid; tok < NTOK; tok += 2 * stride) {
        const int tok2 = tok + stride; const bool two = tok2 < NTOK;
        PrepIn A, B2;
        prep_load(P, tok, lane, A); prep_load(P, two ? tok2 : tok, lane, B2);
        prep_finish(P, tok, lane, A, gq, gk, gm);
        if (two) prep_finish(P, tok2, lane, B2, gq, gk, gm);
    }
}
struct MemOutRow { const bf16_t* zb; bf16_t* gb;
    __device__ __forceinline__ const bf16_t* zrow(int r) const { return zb + (size_t)r * NPAD; } __device__ __forceinline__ bf16_t* grow(int r) const { return gb + (size_t)r * MIX; } };
__device__ __forceinline__ void unit_mem_attn(const Params& P, int layer, int u, char* lds) {
    const int b = u >> 6, h = (u >> 4) & 3, qb = u & 15, tok0 = b * SEQ + qb * 256;
    const int wid = TIDX() >> 6, lane = TIDX() & 63, r32 = lane & 31, hi = lane >> 5;
    const bf16_t* Qw = P.p_() + (size_t)(tok0 + wid * 32 + r32) * NPAD + C_MQ + h * 128 + hi * 8;
    const bf16_t* Kh = P.kvmem_() + (size_t)(b * MEML) * (DEPTH * 1024) + layer * 1024 + h * 128;
    MemOutRow ow; ow.zb = P.p_() + (size_t)(tok0 + wid * 32) * NPAD + C_MZ + h * 128; ow.gb = P.xn_() + (size_t)(tok0 + wid * 32) * MIX + 1536 + h * 128;
    att::attn_body<false, DEPTH * 1024, 512, 1, MemOutRow>(Qw, P.mem_q_norm + layer * 128, nullptr, Kh, MEML / 64, nullptr, 0u, ow, lds);
}

__device__ __forceinline__ void phase_gate(const Params& P, int c_lo, int c_hi) {
    const int wid = TIDX() >> 6, lane = TIDX() & 63;
    const int c0 = lane * 32;
    const int seg = c0 >> 9, zc = (seg == 0 ? C_GZ : seg == 1 ? C_SZ : seg == 2 ? C_DZ : C_MZ) + (c0 & 511);
    const bool act = (c0 >= c_lo) && (c0 < c_hi);
    for (int tok = blockIdx.x * 8 + wid; tok < NTOK; tok += gridDim.x * 8) {
        if (!act) { bf16_t* gz_ = P.xn_() + (size_t)tok * MIX + c0; const u32x4 zz = {0u, 0u, 0u, 0u};
#pragma unroll
            for (int i = 0; i < 4; ++i) *(u32x4*)(gz_ + 8 * i) = zz;
            continue; }
        const bf16_t* op = P.ocat_() + (size_t)tok * MIX + c0; const bf16_t* zp = P.p_() + (size_t)tok * NPAD + zc; bf16_t* gp = P.xn_() + (size_t)tok * MIX + c0;
        float o[32]; float ss = 0.f;
#pragma unroll
        for (int i = 0; i < 4; ++i) { float v[8]; ld8f(op + 8 * i, v);
#pragma unroll
            for (int j = 0; j < 8; ++j) { o[8 * i + j] = v[j]; ss += v[j] * v[j]; } }
        ss += shx(ss, 1); ss += shx(ss, 2);
        const float r = rsqrtf(ss * (1.f / 128.f) + EPS);
#pragma unroll
        for (int i = 0; i < 4; ++i) { float z[8], g[8]; ld8f(zp + 8 * i, z);
#pragma unroll
            for (int j = 0; j < 8; ++j) g[j] = o[8 * i + j] * r * siluf_(z[j]);
            st8f(gp + 8 * i, g); }
    }
}

__device__ __forceinline__ void phase_gemm_in(const Params& P, int layer, char* lds) {
    pg8::Gemm g; g.A = P.xn_(); g.Bt = P.WinT_() + (size_t)layer * NPAD * DM; g.M = NTOK; g.N = NPAD; g.K = DM;
    pg8::StaticOrder S; S.init(g.M, g.N, (int)gridDim.x, (int)blockIdx.x);
    pg8::EpiBf16Plain E; E.O = P.p_(); E.ldc = NPAD;
    pg8::gemm_phase<pg8::EpiBf16Plain, pg8::StaticOrder, false>((PG8_LAS unsigned char*)lds, g, S, E, nullptr);
}
__device__ __forceinline__ void phase_gemm_out(const Params& P, int layer, char* lds) {
    pg8::Gemm g; g.A = P.xn_(); g.Bt = P.WoutT_() + (size_t)layer * DM * MIX; g.M = NTOK; g.N = DM; g.K = MIX;
    pg8::StaticOrder S; S.init(g.M, g.N, (int)gridDim.x, (int)blockIdx.x);
    pg8::EpiResidMix E; E.R = (layer == 0) ? (const void*)P.x : (const void*)P.xbuf_(); E.C = (layer == DEPTH - 1) ? (void*)P.out : (void*)P.xbuf_(); E.ldc = DM;
    E.r16 = (layer != 0); E.c16 = (layer != DEPTH - 1);
    pg8::gemm_phase<pg8::EpiResidMix, pg8::StaticOrder, false>((PG8_LAS unsigned char*)lds, g, S, E, nullptr);
}
__device__ __forceinline__ void phase_gemm_kv(const Params& P, char* lds) {
    pg8::Gemm g; g.A = P.memn_(); g.Bt = P.WkvT_(); g.M = NB * MEML; g.N = DEPTH * 1024; g.K = DM;
    pg8::StaticOrder S; S.init(g.M, g.N, (int)gridDim.x, (int)blockIdx.x);
    pg8::EpiBf16Plain E; E.O = P.kvmem_(); E.ldc = DEPTH * 1024;
    pg8::gemm_phase<pg8::EpiBf16Plain, pg8::StaticOrder, false>((PG8_LAS unsigned char*)lds, g, S, E, nullptr);
}
__device__ __forceinline__ void mma_tile(f32x16& acc, const char* A, int lda, const char* B, int ldb, int K, int lane) {
    const int r = lane & 31, kh = lane >> 5;
    const char* ap = A + r * lda + kh * 16; const char* bp = B + r * ldb + kh * 16;
    asm volatile("" : "+v"(acc));
    for (int k = 0; k < K; k += 16) {
        const bf16x8 a = *(const bf16x8*)(ap + k * 2); const bf16x8 b = *(const bf16x8*)(bp + k * 2);
        acc = __builtin_amdgcn_mfma_f32_32x32x16_bf16(a, b, acc, 0, 0, 0);
    }
}
__device__ __forceinline__ int crow32(int r, int hi) { return (r & 3) + 8 * (r >> 2) + 4 * hi; }
__device__ __forceinline__ float log_sigmoid_(float x) { return fminf(x, 0.f) - log1pf(__expf(-fabsf(x))); }

constexpr int GLA_ST = 144;
constexpr int GC_BST = 68;
constexpr int GC_B_BYTES = 4 * 64 * GC_BST * 4, GC_V_BYTES = 4 * 16384;
__device__ __forceinline__ float* gla_gb(const Params& P) { return (float*)((char*)P.ocat_() + (size_t)32 * 1024 * 1024); }
__device__ __forceinline__ float log_sigmoid_fast(float x) { return fminf(x, 0.f) - __logf(1.f + __expf(-fabsf(x))); }

__device__ __forceinline__ void unit_gla_a4(const Params& P, int layer, int ub, char* lds) {
    const int b = ub >> 6, n = ub & 63, tok0 = b * SEQ + n * 64;
    const int tid = TIDX(), wid = tid >> 6, lane = tid & 63, r32 = lane & 31, hi = lane >> 5, h = wid >> 1, eh = wid & 1;
    float* b_s = (float*)lds;
    char* V_s = lds;
    char* K_s = lds + GC_B_BYTES;
    float* glr_s = (float*)(lds + GC_B_BYTES + GC_V_BYTES);
    float* tot_s = glr_s + 1024;
    __syncthreads();
    const bf16_t* prow = P.p_() + (size_t)tok0 * NPAD;
    const bf16x8 glr_raw = *(const bf16x8*)(prow + (size_t)((tid & 127) >> 1) * NPAD + C_GLR + (tid & 1) * 8);
    const int gd = tid & 63, gh = (tid >> 6) & 3, gt = tid >> 8;
    float wu[16];
#pragma unroll
    for (int r = 0; r < 16; ++r) wu[r] = P.gla_w_up[((size_t)layer * 16 + r) * 256 + gh * 64 + gd];
    const float bias = P.gla_b_up[layer * 256 + gh * 64 + gd];
    bf16x8 kraw[4], vs[4][2];
    const int ks_ = tid >> 3, kc = (tid & 7) * 8;
#pragma unroll
    for (int hv = 0; hv < 4; ++hv) kraw[hv] = *(const bf16x8*)(prow + (size_t)ks_ * NPAD + C_GK + hv * 64 + kc);
    const int sr = tid >> 4, sc = (tid & 15) * 8;
#pragma unroll
    for (int hv = 0; hv < 4; ++hv) { vs[hv][0] = *(const bf16x8*)(prow + (size_t)sr * NPAD + C_GV + hv * 128 + sc); vs[hv][1] = *(const bf16x8*)(prow + (size_t)(32 + sr) * NPAD + C_GV + hv * 128 + sc); }
    if (tid < 128) {
#pragma unroll
        for (int j = 0; j < 8; ++j) glr_s[(tid >> 1) * 16 + (tid & 1) * 8 + j] = bf2f((bf16_t)glr_raw[j]); }
    __syncthreads();
    float gv[32]; float run = 0.f;
#pragma unroll
    for (int i = 0; i < 32; ++i) { const float* gr = glr_s + (gt * 32 + i) * 16; float a = bias;
#pragma unroll
        for (int r4 = 0; r4 < 4; ++r4) { const f32x4 g4 = *(const f32x4*)(gr + 4 * r4); a = fmaf(g4[0], wu[4 * r4], a); a = fmaf(g4[1], wu[4 * r4 + 1], a); a = fmaf(g4[2], wu[4 * r4 + 2], a); a = fmaf(g4[3], wu[4 * r4 + 3], a); }
        run += log_sigmoid_fast(a) * (1.f / 16.f); gv[i] = run; }
    if (gt == 0) tot_s[gh * 64 + gd] = run;
    __syncthreads();
    { const float off = gt ? tot_s[gh * 64 + gd] : 0.f; float* bp = b_s + (gh * 64 + gt * 32) * GC_BST + gd;
      float* gp = gla_gb(P) + (size_t)(tok0 + gt * 32) * 256 + gh * 64 + gd;
#pragma unroll
      for (int i = 0; i < 32; ++i) { const float v = gv[i] + off; bp[i * GC_BST] = v; gp[(size_t)i * 256] = v; }
      if (gt) P.glad_()[((size_t)((b * 64 + n) * 4 + gh)) * 64 + gd] = __expf(gv[31] + off); }
    __syncthreads();
#pragma unroll
    for (int hv = 0; hv < 4; ++hv) { const float* br = b_s + (hv * 64 + ks_) * GC_BST + kc; const float* bl = b_s + (hv * 64 + 63) * GC_BST + kc;
        const f32x4 b0 = *(const f32x4*)br, b1 = *(const f32x4*)(br + 4), l0 = *(const f32x4*)bl, l1 = *(const f32x4*)(bl + 4);
        float e[8];
#pragma unroll
        for (int j = 0; j < 8; ++j) e[j] = bf2f((bf16_t)kraw[hv][j]) * __expf((j < 4 ? l0[j] : l1[j - 4]) - (j < 4 ? b0[j] : b1[j - 4]));
        u32x4 w = {att::cvtpk(e[0], e[1]), att::cvtpk(e[2], e[3]), att::cvtpk(e[4], e[5]), att::cvtpk(e[6], e[7])};
        *(u32x4*)(K_s + hv * 16384 + att::v_st(ks_, kc)) = w; }
    __syncthreads();
    { const int vst0 = att::v_st(sr, sc), vst1 = att::v_st(32 + sr, sc);
#pragma unroll
      for (int hv = 0; hv < 4; ++hv) { *(bf16x8*)(V_s + hv * 16384 + vst0) = vs[hv][0]; *(bf16x8*)(V_s + hv * 16384 + vst1) = vs[hv][1]; } }
    __syncthreads();
    const int vb = (int)(uintptr_t)(V_s + h * 16384) + att::v_rd_base(lane), kb = (int)(uintptr_t)(K_s + h * 16384) + att::v_rd_base(lane);
    f32x16 acc[2][2] = {};
    asm volatile("" : "+v"(acc[0][0]), "+v"(acc[0][1]), "+v"(acc[1][0]), "+v"(acc[1][1]));
#define GA_PK(L, H) (bf16x8){L[0], L[1], L[2], L[3], H[0], H[1], H[2], H[3]}
#define GA_STEP(KS) do { \
    const s16x4 k0l = att::tr_read<att::v_rd_off(0, KS, 0)>(kb), k0h = att::tr_read<att::v_rd_off(0, KS, 1)>(kb), k1l = att::tr_read<att::v_rd_off(1, KS, 0)>(kb), k1h = att::tr_read<att::v_rd_off(1, KS, 1)>(kb); \
    s16x4 v0l, v0h, v1l, v1h; \
    if (eh == 0) { v0l = att::tr_read<att::v_rd_off(0, KS, 0)>(vb); v0h = att::tr_read<att::v_rd_off(0, KS, 1)>(vb); v1l = att::tr_read<att::v_rd_off(1, KS, 0)>(vb); v1h = att::tr_read<att::v_rd_off(1, KS, 1)>(vb); } \
    else         { v0l = att::tr_read<att::v_rd_off(2, KS, 0)>(vb); v0h = att::tr_read<att::v_rd_off(2, KS, 1)>(vb); v1l = att::tr_read<att::v_rd_off(3, KS, 0)>(vb); v1h = att::tr_read<att::v_rd_off(3, KS, 1)>(vb); } \
    asm volatile("s_waitcnt lgkmcnt(0)" ::: "memory"); __builtin_amdgcn_sched_barrier(0); \
    acc[0][0] = __builtin_amdgcn_mfma_f32_32x32x16_bf16(GA_PK(v0l, v0h), GA_PK(k0l, k0h), acc[0][0], 0, 0, 0); \
    acc[0][1] = __builtin_amdgcn_mfma_f32_32x32x16_bf16(GA_PK(v0l, v0h), GA_PK(k1l, k1h), acc[0][1], 0, 0, 0); \
    acc[1][0] = __builtin_amdgcn_mfma_f32_32x32x16_bf16(GA_PK(v1l, v1h), GA_PK(k0l, k0h), acc[1][0], 0, 0, 0); \
    acc[1][1] = __builtin_amdgcn_mfma_f32_32x32x16_bf16(GA_PK(v1l, v1h), GA_PK(k1l, k1h), acc[1][1], 0, 0, 0); } while (0)
    GA_STEP(0); GA_STEP(1); GA_STEP(2); GA_STEP(3);
#undef GA_STEP
#undef GA_PK
    float* dst = P.glas_() + ((size_t)((b * 64 + n) * 4 + h)) * 8192;
#pragma unroll
    for (int et = 0; et < 2; ++et)
#pragma unroll
        for (int dt = 0; dt < 2; ++dt)
#pragma unroll
            for (int r = 0; r < 16; ++r) dst[((eh * 2 + et) * 32 + att::crow(r, hi)) * 64 + dt * 32 + r32] = acc[et][dt][r];
    __syncthreads();
}

__device__ __forceinline__ void gla_scan_slice(const Params& P, int idx) {
    {
        const int el = idx & 8191, d = idx & 63, h = (idx >> 13) & 3, b = idx >> 15;
        bf16_t* gst = P.ocat_();
        float S = 0.f;
        for (int n0 = 0; n0 < 64; n0 += 8) {
            float ds[8], dc[8];
#pragma unroll
            for (int i = 0; i < 8; ++i) { const size_t cu = (size_t)((b * 64 + n0 + i) * 4 + h); ds[i] = P.glas_()[cu * 8192 + el]; dc[i] = P.glad_()[cu * 64 + d]; }
#pragma unroll
            for (int i = 0; i < 8; ++i) { const size_t cu = (size_t)((b * 64 + n0 + i) * 4 + h); gst[cu * 8192 + el] = f2bf(S); S = fmaf(dc[i], S, ds[i]); }
        }
    }
}

__device__ __forceinline__ void unit_gla_c4(const Params& P, int layer, int ub, char* lds) {
    const int b = ub >> 6, n = ub & 63, tok0 = b * SEQ + n * 64;
    const int tid = TIDX(), wid = tid >> 6, lane = tid & 63, r32 = lane & 31, hi = lane >> 5, h = wid >> 1, rh = wid & 1;
    float* b_s = (float*)lds;
    char* V_s = lds + GC_B_BYTES;
    __syncthreads();
    const bf16_t* prow = P.p_() + (size_t)tok0 * NPAD;
    bf16x8 qraw[4], kraw[2][4], vs[4][2];
    const int sr = tid >> 4, sc = (tid & 15) * 8;
#pragma unroll
    for (int hv = 0; hv < 4; ++hv) { vs[hv][0] = *(const bf16x8*)(prow + (size_t)sr * NPAD + C_GV + hv * 128 + sc); vs[hv][1] = *(const bf16x8*)(prow + (size_t)(32 + sr) * NPAD + C_GV + hv * 128 + sc); }
    f32x4 braw[8];
    { const float* gp = gla_gb(P) + (size_t)tok0 * 256 + tid * 4;
#pragma unroll
      for (int i = 0; i < 8; ++i) braw[i] = *(const f32x4*)(gp + i * 2048); }
    { const bf16_t* qp = prow + (size_t)(rh * 32 + r32) * NPAD + C_GQ + h * 64 + hi * 8;
#pragma unroll
      for (int d0 = 0; d0 < 4; ++d0) qraw[d0] = *(const bf16x8*)(qp + d0 * 16);
#pragma unroll
      for (int sh = 0; sh < 2; ++sh) { const bf16_t* kp = prow + (size_t)(sh * 32 + r32) * NPAD + C_GK + h * 64 + hi * 8;
#pragma unroll
          for (int d0 = 0; d0 < 4; ++d0) kraw[sh][d0] = *(const bf16x8*)(kp + d0 * 16); } }
    bf16x8 sfr[4][4];
    { const bf16_t* sp = P.ocat_() + ((size_t)((b * 64 + n) * 4 + h)) * 8192 + r32 * 64 + hi * 8;
#pragma unroll
      for (int eb = 0; eb < 4; ++eb)
#pragma unroll
          for (int ds = 0; ds < 4; ++ds) sfr[eb][ds] = *(const bf16x8*)(sp + eb * 32 * 64 + ds * 16); }
    { const int vst0 = att::v_st(sr, sc), vst1 = att::v_st(32 + sr, sc);
#pragma unroll
      for (int hv = 0; hv < 4; ++hv) { *(bf16x8*)(V_s + hv * 16384 + vst0) = vs[hv][0]; *(bf16x8*)(V_s + hv * 16384 + vst1) = vs[hv][1]; } }
#pragma unroll
    for (int i = 0; i < 8; ++i) { const int c = tid + 512 * i, t = c >> 6, c4 = c & 63;
        *(f32x4*)(b_s + ((c4 >> 4) * 64 + t) * GC_BST + (c4 & 15) * 4) = braw[i]; }
    __syncthreads();
    const float* bh = b_s + h * 64 * GC_BST + hi * 8;
    bf16x8 qe[4], qb[4], ke[2][4];
#pragma unroll
    for (int d0 = 0; d0 < 4; ++d0) {
        const f32x4 m0 = *(const f32x4*)(bh + 32 * GC_BST + d0 * 16), m1 = *(const f32x4*)(bh + 32 * GC_BST + d0 * 16 + 4);
        const f32x4 q0 = *(const f32x4*)(bh + (rh * 32 + r32) * GC_BST + d0 * 16), q1 = *(const f32x4*)(bh + (rh * 32 + r32) * GC_BST + d0 * 16 + 4);
        float e1[8], e2[8];
#pragma unroll
        for (int j = 0; j < 8; ++j) { const float mv = j < 4 ? m0[j] : m1[j - 4], bq = j < 4 ? q0[j] : q1[j - 4]; const float q = bf2f((bf16_t)qraw[d0][j]) * 0.125f;
            e1[j] = q * __expf(bq - mv); e2[j] = q * __expf(bq); }
        { u32x4 w = {att::cvtpk(e1[0], e1[1]), att::cvtpk(e1[2], e1[3]), att::cvtpk(e1[4], e1[5]), att::cvtpk(e1[6], e1[7])}; qe[d0] = *reinterpret_cast<bf16x8*>(&w); }
        { u32x4 w = {att::cvtpk(e2[0], e2[1]), att::cvtpk(e2[2], e2[3]), att::cvtpk(e2[4], e2[5]), att::cvtpk(e2[6], e2[7])}; qb[d0] = *reinterpret_cast<bf16x8*>(&w); }
#pragma unroll
        for (int sh = 0; sh < 2; ++sh) {
            const f32x4 k0 = *(const f32x4*)(bh + (sh * 32 + r32) * GC_BST + d0 * 16), k1 = *(const f32x4*)(bh + (sh * 32 + r32) * GC_BST + d0 * 16 + 4);
            float e3[8];
#pragma unroll
            for (int j = 0; j < 8; ++j) { const float mv = j < 4 ? m0[j] : m1[j - 4], bk = j < 4 ? k0[j] : k1[j - 4]; e3[j] = bf2f((bf16_t)kraw[sh][d0][j]) * __expf(mv - bk); }
            u32x4 w = {att::cvtpk(e3[0], e3[1]), att::cvtpk(e3[2], e3[3]), att::cvtpk(e3[4], e3[5]), att::cvtpk(e3[6], e3[7])}; ke[sh][d0] = *reinterpret_cast<bf16x8*>(&w); }
    }
    f32x16 p0 = {}, p1 = {};
    asm volatile("" : "+v"(p0), "+v"(p1));
#pragma unroll
    for (int d0 = 0; d0 < 4; ++d0) { p0 = __builtin_amdgcn_mfma_f32_32x32x16_bf16(ke[0][d0], qe[d0], p0, 0, 0, 0); p1 = __builtin_amdgcn_mfma_f32_32x32x16_bf16(ke[1][d0], qe[d0], p1, 0, 0, 0); }
    { const int t = rh * 32 + r32;
#pragma unroll
      for (int r = 0; r < 16; ++r) { const int s0 = att::crow(r, hi); p0[r] = (s0 <= t) ? p0[r] : 0.f; p1[r] = (32 + s0 <= t) ? p1[r] : 0.f; } }
    bf16x8 pa0, pa1, pa2, pa3;
#define GC_PK4(Pv, BASE, OUT) do { unsigned a0 = att::cvtpk(Pv[BASE + 0], Pv[BASE + 1]), a1 = att::cvtpk(Pv[BASE + 2], Pv[BASE + 3]);   \
    unsigned b0 = att::cvtpk(Pv[BASE + 4], Pv[BASE + 5]), b1 = att::cvtpk(Pv[BASE + 6], Pv[BASE + 7]);                              \
    auto r0 = __builtin_amdgcn_permlane32_swap(a0, b0, false, false); auto r1 = __builtin_amdgcn_permlane32_swap(a1, b1, false, false); \
    u32x4 w = {r0[0], r1[0], r0[1], r1[1]}; OUT = *reinterpret_cast<bf16x8*>(&w); } while (0)
    GC_PK4(p0, 0, pa0); GC_PK4(p0, 8, pa1); GC_PK4(p1, 0, pa2); GC_PK4(p1, 8, pa3);
#undef GC_PK4
    f32x16 o[4] = {};
    asm volatile("" : "+v"(o[0]), "+v"(o[1]), "+v"(o[2]), "+v"(o[3]));
    att::pv_d0(o, (int)(uintptr_t)(V_s + h * 16384) + att::v_rd_base(lane), pa0, pa1, pa2, pa3);
#pragma unroll
    for (int eb = 0; eb < 4; ++eb)
#pragma unroll
        for (int ds = 0; ds < 4; ++ds) o[eb] = __builtin_amdgcn_mfma_f32_32x32x16_bf16(qb[ds], sfr[eb][ds], o[eb], 0, 0, 0);
    u32x4 zr[8];
#pragma unroll
    for (int i = 0; i < 8; ++i) zr[i] = *(const u32x4*)(P.p_() + (size_t)(tok0 + rh * 32 + 4 * i + (lane >> 4)) * NPAD + C_GZ + h * 128 + 8 * (lane & 15));
    __syncthreads();
    float* og_s = (float*)lds + wid * (32 * 132);
#pragma unroll
    for (int r = 0; r < 16; ++r) {
#pragma unroll
        for (int eb = 0; eb < 4; ++eb) og_s[att::crow(r, hi) * 132 + eb * 32 + r32] = o[eb][r]; }
    asm volatile("" ::: "memory");
    { const int row = lane >> 1, half = lane & 1; const float* src = og_s + row * 132 + half * 64;
      float ss = 0.f;
#pragma unroll
      for (int i = 0; i < 16; ++i) { const f32x4 v = *(const f32x4*)(src + 4 * i); ss += v[0] * v[0] + v[1] * v[1] + v[2] * v[2] + v[3] * v[3]; }
      ss += shx(ss, 1);
      if (half == 0) og_s[row * 132 + 128] = rsqrtf(ss * (1.f / 128.f) + EPS); }
    asm volatile("s_waitcnt lgkmcnt(0)" ::: "memory");
#pragma unroll
    for (int i = 0; i < 8; ++i) { const int row = 4 * i + (lane >> 4), c8 = 8 * (lane & 15); const float* src = og_s + row * 132 + c8;
      const f32x4 a = *(const f32x4*)src, b2 = *(const f32x4*)(src + 4); const float rn = og_s[row * 132 + 128];
      float z[8], gg[8];
      z[0] = __uint_as_float(zr[i].x << 16); z[1] = __uint_as_float(zr[i].x & 0xffff0000u); z[2] = __uint_as_float(zr[i].y << 16); z[3] = __uint_as_float(zr[i].y & 0xffff0000u);
      z[4] = __uint_as_float(zr[i].z << 16); z[5] = __uint_as_float(zr[i].z & 0xffff0000u); z[6] = __uint_as_float(zr[i].w << 16); z[7] = __uint_as_float(zr[i].w & 0xffff0000u);
#pragma unroll
      for (int q = 0; q < 4; ++q) { gg[q] = a[q] * rn * siluf_(z[q]); gg[4 + q] = b2[q] * rn * siluf_(z[4 + q]); }
      st8f(P.xn_() + (size_t)(tok0 + rh * 32 + row) * MIX + h * 128 + c8, gg); }
    __syncthreads();
}
constexpr int S5P_STRIDE = 2304;
__device__ __forceinline__ void phase_s5_params(const Params& P) {
    for (int idx = blockIdx.x * NTHR + TIDX(); idx < DEPTH * 32 * 64; idx += gridDim.x * NTHR) {
        const int p = idx & 63, lg = idx >> 6;
        const float ar = P.s5_a_re[idx], ai = P.s5_a_im[idx], step = expf(P.s5_log_step[lg]);
        const float mag = expf(ar * step), th = ai * step;
        const float lr = mag * cosf(th), li = mag * sinf(th);
        float* o = P.s5p_() + (size_t)lg * S5P_STRIDE;
        o[2 * p] = lr; o[2 * p + 1] = li;
        { const float mag512 = expf(512.f * ar * step); const double a = 512.0 * (double)th; const double k = rint(a * 0.15915494309189535); const float rf = (float)fma(-k, 6.283185307179586, a);
          o[128 + 2 * p] = mag512 * cosf(rf); o[128 + 2 * p + 1] = mag512 * sinf(rf); }
        const float xr = lr - 1.f, xi = li, den = 1.f / (ar * ar + ai * ai);
        const float fr = (xr * ar + xi * ai) * den, fi = (xi * ar - xr * ai) * den;
        for (int c = 0; c < 16; ++c) { const float br = P.s5_b_re[(size_t)idx * 16 + c], bi = P.s5_b_im[(size_t)idx * 16 + c];
            o[256 + (p * 16 + c) * 2] = fr * br - fi * bi; o[256 + (p * 16 + c) * 2 + 1] = fr * bi + fi * br; }
    }
}
__device__ __forceinline__ float gelu_tanh_(float x) { const float u = 0.7978845608028654f * (x + 0.044715f * x * x * x); const float e = __expf(-2.f * fabsf(u)); const float th = copysignf((1.f - e) * __builtin_amdgcn_rcpf(1.f + e), u); return 0.5f * x * (1.f + th); }

constexpr int S5_XST = 272;
constexpr int S5_UST = 48;
__device__ __forceinline__ float partner32(float v, int hi) { auto rr = __builtin_amdgcn_permlane32_swap(__float_as_uint(v), __float_as_uint(v), false, false); return __uint_as_float(hi ? rr[0] : rr[1]); }
struct S5Ctx { float l0r, l0i, l1r, l1i, q0r, q0i, q1r, q1i, dsk; char* Cm; char* Bb; char* Xs; char* Us; int lane, hi, j, rho; const bf16_t* ubase; bf16_t* ybase; };
template <bool OUT> __device__ __forceinline__ void s5_tile(const S5Ctx& C, int tok0, const bf16x8 w0, const bf16x8 w1, float& x0r, float& x0i, float& x1r, float& x1i) {
    const int hi = C.hi, j = C.j, lane = C.lane;
    if (hi == 0) { *(bf16x8*)(C.Us + C.rho * S5_UST) = w0; *(bf16x8*)(C.Us + C.rho * S5_UST + 16) = w1; }
    asm volatile("" ::: "memory");
    f32x16 a0 = {}, a1 = {}, a2 = {}, a3 = {};
    mma_tile(a0, C.Us, S5_UST, C.Bb, S5_UST, 16, lane); mma_tile(a1, C.Us, S5_UST, C.Bb + 32 * S5_UST, S5_UST, 16, lane);
    mma_tile(a2, C.Us, S5_UST, C.Bb + 64 * S5_UST, S5_UST, 16, lane); mma_tile(a3, C.Us, S5_UST, C.Bb + 96 * S5_UST, S5_UST, 16, lane);
    float s0r[16], s0i[16], s1r[16], s1i[16];
#pragma unroll
    for (int r = 0; r < 16; ++r) {
        const float n0r = fmaf(C.l0r, x0r, fmaf(-C.l0i, x0i, a0[r])), n0i = fmaf(C.l0r, x0i, fmaf(C.l0i, x0r, a1[r])); x0r = n0r; x0i = n0i; s0r[r] = n0r; s0i[r] = n0i;
        const float n1r = fmaf(C.l1r, x1r, fmaf(-C.l1i, x1i, a2[r])), n1i = fmaf(C.l1r, x1i, fmaf(C.l1i, x1r, a3[r])); x1r = n1r; x1i = n1i; s1r[r] = n1r; s1i[r] = n1i; }
    float z0r = partner32(x0r, hi), z0i = partner32(x0i, hi), z1r = partner32(x1r, hi), z1i = partner32(x1i, hi);
    if (hi == 0) { z0r = 0.f; z0i = 0.f; z1r = 0.f; z1i = 0.f; }
    if (!OUT) {
        x0r += C.q0r * z0r - C.q0i * z0i; x0i += C.q0r * z0i + C.q0i * z0r; x1r += C.q1r * z1r - C.q1i * z1i; x1i += C.q1r * z1i + C.q1i * z1r;
    } else {
#pragma unroll
        for (int r = 0; r < 16; ++r) {
            const float t0r = C.l0r * z0r - C.l0i * z0i, t0i = C.l0r * z0i + C.l0i * z0r; z0r = t0r; z0i = t0i; s0r[r] += t0r; s0i[r] += t0i;
            const float t1r = C.l1r * z1r - C.l1i * z1i, t1i = C.l1r * z1i + C.l1i * z1r; z1r = t1r; z1i = t1i; s1r[r] += t1r; s1i[r] += t1i; }
        x0r = s0r[15]; x0i = s0i[15]; x1r = s1r[15]; x1i = s1i[15];
#pragma unroll
        for (int r = 0; r < 16; ++r) { char* xr_ = C.Xs + (r + 16 * hi) * S5_XST;
            *(bf16_t*)(xr_ + j * 2) = f2bf(s0r[r]); *(bf16_t*)(xr_ + (64 + j) * 2) = f2bf(s0i[r]);
            *(bf16_t*)(xr_ + (32 + j) * 2) = f2bf(s1r[r]); *(bf16_t*)(xr_ + (96 + j) * 2) = f2bf(s1i[r]); }
        asm volatile("" ::: "memory");
        f32x16 acc = {}; mma_tile(acc, C.Xs, S5_XST, C.Cm, S5_XST, 128, lane);
        if (j < 16) {
#pragma unroll
            for (int r = 0; r < 16; ++r) { const int t = crow32(r, hi); const int rt = ((t & 15) & 3) + 8 * ((t & 15) >> 2) + 4 * (t >> 4);
                const float y = acc[r] + C.dsk * bf2f(*(const bf16_t*)(C.Us + rt * S5_UST + j * 2));
                C.ybase[(size_t)(tok0 + t) * 512 + j] = f2bf(gelu_tanh_(y)); } }
        asm volatile("" ::: "memory");
    }
    { const float e0r = partner32(x0r, hi), e0i = partner32(x0i, hi), e1r = partner32(x1r, hi), e1i = partner32(x1i, hi);
      if (hi == 0) { x0r = e0r; x0i = e0i; x1r = e1r; x1i = e1i; } else { x0r = 0.f; x0i = 0.f; x1r = 0.f; x1i = 0.f; } }
}
__device__ __forceinline__ void unit_s5(const Params& P, int layer, int u, char* lds) {
    const int b = u >> 5, g = u & 31, tid = TIDX(), wid = tid >> 6, lane = tid & 63, hi = lane >> 5, j = lane & 31;
    char* Cm = lds;
    char* Bb = Cm + 32 * S5_XST;
    float* ends = (float*)(Bb + 128 * S5_UST);
    char* wbase = (char*)(ends + 8 * 64 * 2) + wid * (32 * S5_XST + 32 * S5_UST);
    const float* sp = P.s5p_() + (size_t)(layer * 32 + g) * S5P_STRIDE;
    __syncthreads();
    for (int i = tid; i < 32 * 128; i += NTHR) { const int c = i >> 7, pp = i & 127; float v = 0.f;
        if (c < 16) v = (pp < 64) ? P.s5_c_re[((size_t)(layer * 32 + g) * 16 + c) * 64 + pp] : -P.s5_c_im[((size_t)(layer * 32 + g) * 16 + c) * 64 + (pp - 64)];
        *(bf16_t*)(Cm + c * S5_XST + pp * 2) = f2bf(v); }
    for (int i = tid; i < 128 * 16; i += NTHR) { const int n = i >> 4, c = i & 15, nt = n >> 5, jj = n & 31, p = (nt >> 1) * 32 + jj;
        *(bf16_t*)(Bb + n * S5_UST + c * 2) = f2bf(sp[256 + (p * 16 + c) * 2 + (nt & 1)]); }
    S5Ctx C; C.Cm = Cm; C.Bb = Bb; C.Xs = wbase; C.Us = wbase + 32 * S5_XST; C.lane = lane; C.hi = hi; C.j = j;
    C.l0r = sp[2 * j]; C.l0i = sp[2 * j + 1]; C.l1r = sp[2 * (32 + j)]; C.l1i = sp[2 * (32 + j) + 1];
    { float q0r = C.l0r, q0i = C.l0i, q1r = C.l1r, q1i = C.l1i;
#pragma unroll
      for (int k = 0; k < 4; ++k) { const float a = q0r * q0r - q0i * q0i, bb = (q0r + q0r) * q0i; q0r = a; q0i = bb; const float c = q1r * q1r - q1i * q1i, d = (q1r + q1r) * q1i; q1r = c; q1i = d; }
      C.q0r = q0r; C.q0i = q0i; C.q1r = q1r; C.q1i = q1i; }
    C.dsk = P.s5_d[layer * 512 + g * 16 + (lane & 15)];
    C.rho = ((j & 15) & 3) + 8 * ((j & 15) >> 2) + 4 * (j >> 4);
    const int tokw = b * SEQ + wid * 512;
    C.ubase = P.p_() + C_SU + g * 16; C.ybase = P.ybuf_() + g * 16;
    float x0r = 0.f, x0i = 0.f, x1r = 0.f, x1i = 0.f;
    __syncthreads();
    const bf16_t* urow = C.ubase + (size_t)(tokw + j) * NPAD;
    { bf16x8 w0 = *(const bf16x8*)urow, w1 = *(const bf16x8*)(urow + 8);
      for (int sc = 0; sc < 16; ++sc) { const bf16_t* un = urow + (size_t)((sc < 15 ? sc + 1 : 15) * 32) * NPAD;
          const bf16x8 n0 = *(const bf16x8*)un, n1 = *(const bf16x8*)(un + 8);
          s5_tile<false>(C, tokw + sc * 32, w0, w1, x0r, x0i, x1r, x1i); w0 = n0; w1 = n1; } }
    if (hi == 0) { ends[(wid * 64 + j) * 2] = x0r; ends[(wid * 64 + j) * 2 + 1] = x0i; ends[(wid * 64 + 32 + j) * 2] = x1r; ends[(wid * 64 + 32 + j) * 2 + 1] = x1i; }
    __syncthreads();
    { const float p0r = sp[128 + 2 * j], p0i = sp[128 + 2 * j + 1], p1r = sp[128 + 2 * (32 + j)], p1i = sp[128 + 2 * (32 + j) + 1];
      x0r = 0.f; x0i = 0.f; x1r = 0.f; x1i = 0.f;
      for (int w = 0; w < wid; ++w) { const float e0r = ends[(w * 64 + j) * 2], e0i = ends[(w * 64 + j) * 2 + 1], e1r = ends[(w * 64 + 32 + j) * 2], e1i = ends[(w * 64 + 32 + j) * 2 + 1];
          const float n0r = p0r * x0r - p0i * x0i + e0r, n0i = p0r * x0i + p0i * x0r + e0i, n1r = p1r * x1r - p1i * x1i + e1r, n1i = p1r * x1i + p1i * x1r + e1i;
          x0r = n0r; x0i = n0i; x1r = n1r; x1i = n1i; }
      if (hi) { x0r = 0.f; x0i = 0.f; x1r = 0.f; x1i = 0.f; } }
    { bf16x8 w0 = *(const bf16x8*)urow, w1 = *(const bf16x8*)(urow + 8);
      for (int sc = 0; sc < 16; ++sc) { const bf16_t* un = urow + (size_t)((sc < 15 ? sc + 1 : 15) * 32) * NPAD;
          const bf16x8 n0 = *(const bf16x8*)un, n1 = *(const bf16x8*)(un + 8);
          s5_tile<true>(C, tokw + sc * 32, w0, w1, x0r, x0i, x1r, x1i); w0 = n0; w1 = n1; } }
}
constexpr int TOPK = 256;
__device__ __forceinline__ unsigned f2key(float f) { const unsigned u = __float_as_uint(f); return u ^ ((u & 0x80000000u) ? 0xffffffffu : 0x80000000u); }

__device__ __forceinline__ float relu1(float x) { const int b = __float_as_int(x); return __int_as_float(b > 0 ? b : 0); }
#define DSA_MM(acc, rt, kk) acc = __builtin_amdgcn_mfma_f32_32x32x16_bf16(afr[rt][kk], bfr[kk], acc, 0, 0, 0)
#define DSA_HS(acc, rt, q) do { s0 = fmaf(relu1(acc[4 * (q)]), wv[rt][4 * (q)], s0); s1 = fmaf(relu1(acc[4 * (q) + 1]), wv[rt][4 * (q) + 1], s1); \
                                s0 = fmaf(relu1(acc[4 * (q) + 2]), wv[rt][4 * (q) + 2], s0); s1 = fmaf(relu1(acc[4 * (q) + 3]), wv[rt][4 * (q) + 3], s1); } while (0)
#define DSA_SG() __builtin_amdgcn_sched_barrier(0)
__device__ __forceinline__ void dsa_score_tile(const bf16x8 (&afr)[4][4], const f32x16 (&wv)[4], const bf16x8 (&bfr)[4], float* sc, int col, int hi) {
    const f32x16 z16 = {};
#define DSA_M0(acc, rt) acc = __builtin_amdgcn_mfma_f32_32x32x16_bf16(afr[rt][0], bfr[0], z16, 0, 0, 0)
    f32x16 accA, accB;
    float s0, s1;
    DSA_M0(accA, 0); DSA_MM(accA, 0, 1); DSA_MM(accA, 0, 2); DSA_MM(accA, 0, 3);
    s0 = 0.f; s1 = 0.f;
    DSA_M0(accB, 1); DSA_HS(accA, 0, 0); DSA_SG(); DSA_MM(accB, 1, 1); DSA_HS(accA, 0, 1); DSA_SG();
    DSA_MM(accB, 1, 2); DSA_HS(accA, 0, 2); DSA_SG(); DSA_MM(accB, 1, 3); DSA_HS(accA, 0, 3); DSA_SG();
    sc[(0 + hi) * 4096 + col] = (s0 + s1) + 0.f;
    s0 = 0.f; s1 = 0.f;
    DSA_M0(accA, 2); DSA_HS(accB, 1, 0); DSA_SG(); DSA_MM(accA, 2, 1); DSA_HS(accB, 1, 1); DSA_SG();
    DSA_MM(accA, 2, 2); DSA_HS(accB, 1, 2); DSA_SG(); DSA_MM(accA, 2, 3); DSA_HS(accB, 1, 3); DSA_SG();
    sc[(2 + hi) * 4096 + col] = (s0 + s1) + 0.f;
    s0 = 0.f; s1 = 0.f;
    DSA_M0(accB, 3); DSA_HS(accA, 2, 0); DSA_SG(); DSA_MM(accB, 3, 1); DSA_HS(accA, 2, 1); DSA_SG();
    DSA_MM(accB, 3, 2); DSA_HS(accA, 2, 2); DSA_SG(); DSA_MM(accB, 3, 3); DSA_HS(accA, 2, 3); DSA_SG();
    asm volatile("" :: "v"(bfr[0]), "v"(bfr[1]), "v"(bfr[2]), "v"(bfr[3]));
    sc[(4 + hi) * 4096 + col] = (s0 + s1) + 0.f;
    s0 = 0.f; s1 = 0.f;
    DSA_HS(accB, 3, 0); DSA_HS(accB, 3, 1); DSA_HS(accB, 3, 2); DSA_HS(accB, 3, 3);
    sc[(6 + hi) * 4096 + col] = (s0 + s1) + 0.f;
#undef DSA_M0
}
#define DSA_CNT4(K0, K1, K2, K3) asm volatile( \
    "v_cmp_ge_u32_e64 %[m0], %[k0], %[cd]\n\tv_cmp_ge_u32_e64 %[m1], %[k1], %[cd]\n\tv_cmp_ge_u32_e64 %[m2], %[k2], %[cd]\n\tv_cmp_ge_u32_e64 %[m3], %[k3], %[cd]\n\t" \
    "v_addc_co_u32_e64 %[a0], %[m0], %[a0], 0, %[m0]\n\tv_addc_co_u32_e64 %[a1], %[m1], %[a1], 0, %[m1]\n\t" \
    "v_addc_co_u32_e64 %[a0], %[m2], %[a0], 0, %[m2]\n\tv_addc_co_u32_e64 %[a1], %[m3], %[a1], 0, %[m3]" \
    : [a0] "+v"(c0), [a1] "+v"(c1), [m0] "=&s"(sm0), [m1] "=&s"(sm1), [m2] "=&s"(sm2), [m3] "=&s"(sm3) \
    : [k0] "v"(K0), [k1] "v"(K1), [k2] "v"(K2), [k3] "v"(K3), [cd] "v"(cand))
#define DSA_CNT8(J0) do { DSA_CNT4(key[(J0)], key[(J0) + 1], key[(J0) + 2], key[(J0) + 3]); DSA_CNT4(key[(J0) + 4], key[(J0) + 5], key[(J0) + 6], key[(J0) + 7]); } while (0)

template <int J, int JEND> __device__ __forceinline__ void dsa_emit(const unsigned (&key)[64], unsigned T, unsigned& wlo, unsigned& whi) {
    const unsigned long long m = __ballot(key[J] >= T);
    asm("s_nop 1\n\tv_writelane_b32 %0, %2, %4\n\tv_writelane_b32 %1, %3, %4" : "+v"(wlo), "+v"(whi) : "s"((unsigned)m), "s"((unsigned)(m >> 32)), "n"(J));
    if constexpr (J + 1 < JEND) dsa_emit<J + 1, JEND>(key, T, wlo, whi);
}
__device__ __forceinline__ void unit_dsa_index(const Params& P, int u, char* lds) {
    const int b = u & 3, t0 = (511 - (u >> 2)) * 8;
    const int tid = TIDX(), wid = tid >> 6, lane = tid & 63, r32 = lane & 31, hi = lane >> 5;
    float* sc = (float*)lds;
    const bf16_t* pb = P.p_() + (size_t)b * SEQ * NPAD;
    __syncthreads();
    TPU_START(101); TPU_START(110);
    {
        bf16x8 afr[4][4]; f32x16 wv[4];
        const int qsel = (r32 >> 2) & 1, head = (r32 & 3) + 4 * (r32 >> 3);
        char* qs = lds;
        const int ntile = (t0 + 7) / 32 + 1;
        const bf16_t* kp = P.ikc_() + (size_t)(b * (SEQ / 32)) * 2048 + lane * 8;
        bf16x8 b0[4], b1[4], b2[4];
#define DSA_LDB(dst, K) do { const bf16_t* kq_ = kp + (size_t)(wid + 8 * (K)) * 2048; _Pragma("unroll") for (int kk = 0; kk < 4; ++kk) dst[kk] = *(const bf16x8*)(kq_ + kk * 512); } while (0)
#define DSA_TILE(buf, K) dsa_score_tile(afr, wv, buf, sc, (wid + 8 * (K)) * 32 + r32, hi)
        const int nk = (ntile - wid + 7) >> 3;
        const int kl = nk > 0 ? nk - 1 : 0;
#define DSA_MIN(a) ((a) < kl ? (a) : kl)
        const int tk = tid >> 6, hd = (tid & 63) >> 2, dm = (tid & 3) * 16;
        const bf16_t* qsrc = pb + (size_t)(t0 + tk) * NPAD + C_DIQ + hd * 64 + dm;
        const u32x4 qa = *(const u32x4*)qsrc, qb2 = *(const u32x4*)(qsrc + 8);
#pragma unroll
        for (int rt = 0; rt < 4; ++rt) { const float* wp = P.iw_() + (size_t)(b * SEQ + t0 + 2 * rt + hi) * 16;
#pragma unroll
            for (int i = 0; i < 4; ++i) { const f32x4 w4 = *(const f32x4*)(wp + 4 * i); wv[rt][4 * i] = w4[0]; wv[rt][4 * i + 1] = w4[1]; wv[rt][4 * i + 2] = w4[2]; wv[rt][4 * i + 3] = w4[3]; } }
        DSA_LDB(b0, DSA_MIN(0)); DSA_LDB(b1, DSA_MIN(1));
        { char* dst = qs + tk * 2432 + hd * 144 + dm * 2; *(u32x4*)dst = qa; *(u32x4*)(dst + 16) = qb2; }
        __syncthreads();
#pragma unroll
        for (int rt = 0; rt < 4; ++rt) { const char* qp = qs + (2 * rt + qsel) * 2432 + head * 144 + hi * 16;
#pragma unroll
            for (int kk = 0; kk < 4; ++kk) afr[rt][kk] = *(const bf16x8*)(qp + kk * 32); }
        asm volatile("s_waitcnt lgkmcnt(0)" ::: "memory"); __syncthreads();
#if TPROBE == 110
        TPU_STOP(110);
#endif
#if TPROBE == 103
        TPU_START(103); asm volatile("s_waitcnt vmcnt(0)" ::: "memory"); TPU_STOP(103);
#endif
#if TPROBE == 104
        asm volatile("s_waitcnt vmcnt(0)" ::: "memory"); TPU_START(104);
#endif
        int k = 0;
        for (; k + 3 <= nk; k += 3) {
            DSA_LDB(b2, k + 2); DSA_TILE(b0, k);
            DSA_LDB(b0, DSA_MIN(k + 3)); DSA_TILE(b1, k + 1);
            DSA_LDB(b1, DSA_MIN(k + 4)); DSA_TILE(b2, k + 2);
        }
        if (k < nk) DSA_TILE(b0, k);
        if (k + 1 < nk) DSA_TILE(b1, k + 1);
#if TPROBE == 104
        asm volatile("s_waitcnt lgkmcnt(0)" ::: "memory"); TPU_STOP(104);
#endif
        TPU_START(111);
#undef DSA_TILE
#undef DSA_MIN
#undef DSA_TILE
#undef DSA_LDB
    }
    __syncthreads();
    TPU_STOP(111);
    TPU_STOP(101); TPU_START(102);
    {
        const int t = t0 + wid; const float* srow = sc + wid * 4096;
        unsigned key[64];
        {
            const int gfull = (t + 1) >> 9, gany = t / 512 + 1;
#pragma unroll
            for (int g = 0; g < 8; ++g) {
                if (g < gfull) {
#pragma unroll
                    for (int jj = 0; jj < 8; ++jj) key[8 * g + jj] = f2key(srow[(8 * g + jj) * 64 + lane]);
                } else if (g < gany) {
#pragma unroll
                    for (int jj = 0; jj < 8; ++jj) { const int s = (8 * g + jj) * 64 + lane; key[8 * g + jj] = (s <= t) ? f2key(srow[s]) : 0u; }
                } else {
#pragma unroll
                    for (int jj = 0; jj < 8; ++jj) key[8 * g + jj] = 0u;
                }
            }
        }
        unsigned long long* mout = P.mask_() + (size_t)(b * SEQ + t) * 64;
        unsigned long long myword = 0ull;
        TPU_START(105); TPU_START(106); TPU_START(107); TPU_START(108); TPU_START(109);
        if (t + 1 <= TOPK) {
#pragma unroll
            for (int j = 0; j < 64; ++j) { const unsigned long long m = __ballot(j * 64 + lane <= t); if (lane == j) myword = m; }
        } else {
            const int ngrp = t / 512 + 1;
#if TPROBE == 105
            asm volatile("" :: "v"(key[0]), "v"(key[63]));
#endif
            TPU_STOP(105);
            unsigned* hist = (unsigned*)(sc + wid * 4096);
            asm volatile("" ::: "memory");
            { const u32x4 zz4 = {0u, 0u, 0u, 0u};
#pragma unroll
              for (int i = 0; i < 16; ++i) *(u32x4*)(hist + (i * 64 + lane) * 4) = zz4; }
            asm volatile("" ::: "memory");
#define DSA_H8(J0) do { _Pragma("unroll") for (int jj = 0; jj < 8; ++jj) atomicAdd(hist + (key[(J0) + jj] >> 20), 1u); } while (0)
            DSA_H8(0);
            if (ngrp > 1) DSA_H8(8);
            if (ngrp > 2) DSA_H8(16);
            if (ngrp > 3) DSA_H8(24);
            if (ngrp > 4) DSA_H8(32);
            if (ngrp > 5) DSA_H8(40);
            if (ngrp > 6) DSA_H8(48);
            if (ngrp > 7) DSA_H8(56);
#undef DSA_H8
            asm volatile("" ::: "memory");
#if TPROBE == 106
            asm volatile("s_waitcnt lgkmcnt(0)" ::: "memory");
#endif
            TPU_STOP(106);
#define DSA_SUFFIX(s) do { _Pragma("unroll") for (int o = 1; o < 64; o <<= 1) { unsigned t_ = (unsigned)__builtin_amdgcn_ds_bpermute(((lane + o) & 63) << 2, (int)(s)); (s) += (lane + o < 64) ? t_ : 0u; } } while (0)
            unsigned mine = 0u;
#pragma unroll
            for (int i = 0; i < 16; ++i) { const u32x4 v4 = *(const u32x4*)(hist + lane * 64 + ((i + lane) & 15) * 4); mine += (v4[0] + v4[1]) + (v4[2] + v4[3]); }
            unsigned suf = mine; DSA_SUFFIX(suf);
            const unsigned long long mL = __ballot(suf - mine < (unsigned)TOPK && suf >= (unsigned)TOPK);
            const int Ls = (int)__builtin_ctzll(mL);
            const unsigned cntA = (unsigned)__builtin_amdgcn_readlane((int)(suf - mine), Ls);
            unsigned h2 = hist[Ls * 64 + lane]; unsigned suf2 = h2; DSA_SUFFIX(suf2);
            const unsigned long long mB = __ballot(cntA + suf2 - h2 < (unsigned)TOPK && cntA + suf2 >= (unsigned)TOPK);
            const int Bs = (int)__builtin_ctzll(mB);
            const unsigned bstar = (unsigned)(Ls * 64 + Bs);
            const unsigned cntAbove = cntA + (unsigned)__builtin_amdgcn_readlane((int)(suf2 - h2), Bs);
            const unsigned inbin = (unsigned)__builtin_amdgcn_readlane((int)h2, Bs);
#undef DSA_SUFFIX
            TPU_STOP(107);
            unsigned T = bstar << 20; int cntT = (int)(cntAbove + inbin);
            if (cntT != TOPK) {
                asm volatile("" ::: "memory");
                int nslot = 0;
#pragma unroll
                for (int g = 0; g < 8; ++g) { if (g < ngrp) {
#pragma unroll
                    for (int jj = 0; jj < 8; ++jj) { const int j = 8 * g + jj; if ((key[j] >> 20) == bstar) { hist[nslot * 64 + lane] = key[j]; ++nslot; } } } }
                asm volatile("" ::: "memory");
                int R = nslot;
#pragma unroll
                for (int o = 32; o >= 1; o >>= 1) { const int other = __builtin_amdgcn_ds_bpermute(((lane ^ o) << 2), R); R = other > R ? other : R; }
                R = __builtin_amdgcn_readfirstlane(R);
                if (R <= 8) {
                    unsigned c[8];
#pragma unroll
                    for (int r = 0; r < 8; ++r) c[r] = (r < nslot) ? hist[r * 64 + lane] : 0u;
                    for (int bit = 19; bit >= 0; --bit) {
                        const unsigned cand = T | (1u << bit); int cnt = (int)cntAbove;
#pragma unroll
                        for (int r = 0; r < 8; ++r) cnt += __popcll(__ballot(c[r] >= cand));
                        if (cnt >= TOPK) { T = cand; cntT = cnt; if (cnt == TOPK) break; }
                    }
                } else {
                    for (int bit = 19; bit >= 0; --bit) {
                        const unsigned cand = T | (1u << bit); unsigned c0 = 0, c1 = 0; unsigned long long sm0, sm1, sm2, sm3;
                        DSA_CNT8(0);
                        if (ngrp > 1) DSA_CNT8(8);
                        if (ngrp > 2) DSA_CNT8(16);
                        if (ngrp > 3) DSA_CNT8(24);
                        if (ngrp > 4) DSA_CNT8(32);
                        if (ngrp > 5) DSA_CNT8(40);
                        if (ngrp > 6) DSA_CNT8(48);
                        if (ngrp > 7) DSA_CNT8(56);
                        const int cl = (int)(c0 + c1);
                        int cnt = 0;
#pragma unroll
                        for (int bb = 0; bb < 7; ++bb) cnt += __popcll(__ballot((cl >> bb) & 1)) << bb;
                        if (cnt >= TOPK) { T = cand; cntT = cnt; if (cnt == TOPK) break; }
                    }
                }
            }
            TPU_STOP(108);
            if (cntT == TOPK) {
                unsigned wlo = 0u, whi = 0u;
                dsa_emit<0, 8>(key, T, wlo, whi);
                if (ngrp > 1) dsa_emit<8, 16>(key, T, wlo, whi);
                if (ngrp > 2) dsa_emit<16, 24>(key, T, wlo, whi);
                if (ngrp > 3) dsa_emit<24, 32>(key, T, wlo, whi);
                if (ngrp > 4) dsa_emit<32, 40>(key, T, wlo, whi);
                if (ngrp > 5) dsa_emit<40, 48>(key, T, wlo, whi);
                if (ngrp > 6) dsa_emit<48, 56>(key, T, wlo, whi);
                if (ngrp > 7) dsa_emit<56, 64>(key, T, wlo, whi);
                myword = ((unsigned long long)whi << 32) | wlo;
            } else {
                int ngt = 0;
#pragma unroll
                for (int j = 0; j < 64; ++j) ngt += __popcll(__ballot(key[j] > T));
                int need = TOPK - ngt;
#pragma unroll
                for (int j = 0; j < 64; ++j) { const unsigned long long eq = __ballot(key[j] == T), gt = __ballot(key[j] > T);
                    const int ne = __popcll(eq); unsigned long long take = eq;
                    if (ne > need) { take = 0ull; int left = need; unsigned long long e2 = eq;
                        while (left > 0) { const unsigned long long lowbit = e2 & (0ull - e2); take |= lowbit; e2 ^= lowbit; --left; } }
                    need -= (ne > need) ? need : ne;
                    const unsigned long long m = gt | take; if (lane == j) myword = m; }
            }
        }
        mout[lane] = myword;
        TPU_STOP(109);
    }
    TPU_STOP(102);
}

struct DsaOutRow { const bf16_t* zb; bf16_t* gb; int wid;
    __device__ __forceinline__ const bf16_t* zrow(int r) const { const int rho = wid * 32 + r; return zb + (size_t)(rho >> 2) * NPAD + (rho & 3) * 128; }
    __device__ __forceinline__ bf16_t* grow(int r) const { const int rho = wid * 32 + r; return gb + (size_t)(rho >> 2) * MIX + (rho & 3) * 128; } };
__device__ __forceinline__ void unit_dsa_attn(const Params& P, int cur_layer, int u, char* lds) {
    const int b = u & 3, qb = 63 - (u >> 2), t0 = qb * 64, tokb = b * SEQ;
    const int wid = TIDX() >> 6, lane = TIDX() & 63, r32 = lane & 31, hi = lane >> 5;
    const int rho = wid * 32 + r32, tq = t0 + (rho >> 2), hq = rho & 3;
    const bf16_t* Qw = P.p_() + (size_t)(tokb + tq) * NPAD + C_DQ + hq * 128 + hi * 8;
    const bf16_t* Kh = P.kvc_() + (size_t)tokb * 256;
    const unsigned moff = (unsigned)(tokb + tq) * 512u;
    DsaOutRow ow; ow.zb = P.p_() + (size_t)(tokb + t0) * NPAD + C_DZ; ow.gb = P.xn_() + (size_t)(tokb + t0) * MIX + 1024; ow.wid = wid;
    const int NT = (qb + 2) & ~1;
    att::attn_body<true, 256, 128, 2, DsaOutRow>(Qw, P.dsa_q_norm + cur_layer * 128, P.rope_() + (size_t)(tokb + tq) * 48, Kh, NT, P.mask_(), moff, ow, lds);
}
__device__ __forceinline__ void phase_gemm_glu(const Params& P, int layer, char* lds) {
    pg8::Gemm g; g.A = P.ybuf_(); g.Bt = P.WgluT_() + (size_t)layer * 512 * 512; g.M = NTOK; g.N = 512; g.K = 512;
    pg8::StaticOrder S; S.init(g.M, g.N, (int)gridDim.x, (int)blockIdx.x);
    pg8::EpiGlu E; E.Y = P.ybuf_(); E.ldy = 512; E.O = P.ocat_(); E.ldo = MIX; E.ooff = 512;
    pg8::gemm_phase<pg8::EpiGlu, pg8::StaticOrder, false>((PG8_LAS unsigned char*)lds, g, S, E, nullptr);
}

constexpr int CTL_Q0 = 4096;
struct OneUnit { int pm, pn; __device__ __forceinline__ bool next(int i, pg8::Unit& u) const { if (i) return false; u.pm = pm; u.pn = pn; return true; }
    __device__ __forceinline__ void a_ready(const pg8::Unit&) const {} __device__ __forceinline__ void done(const pg8::Unit&) const {} };
__device__ __forceinline__ int q_issue(unsigned* ctr) { return (int)__hip_atomic_fetch_add(ctr, 1u, __ATOMIC_RELAXED, __HIP_MEMORY_SCOPE_AGENT); }
#define Q_LOOP_BEGIN(ctr, total)  { unsigned* q_ctr_ = (ctr); const int q_total_ = (total); volatile int* q_b_ = (volatile int*)(lds + LDS_TAIL + 16); \
    for (;;) { __syncthreads(); if (TIDX() == 0) *q_b_ = q_issue(q_ctr_); __syncthreads(); const int item = __builtin_amdgcn_readfirstlane(*q_b_); if (item >= q_total_) break;
#define Q_LOOP_END  } }
__device__ __forceinline__ void unit_glu(const Params& P, int layer, int u, char* lds) {
    pg8::Gemm g; g.A = P.ybuf_(); g.Bt = P.WgluT_() + (size_t)layer * 512 * 512; g.M = NTOK; g.N = 512; g.K = 512;
    OneUnit S; S.pm = u >> 1; S.pn = u & 1;
    pg8::EpiGluGate E; E.Y = P.ybuf_(); E.Pz = P.p_(); E.G = P.xn_();
    pg8::gemm_phase<pg8::EpiGluGate, OneUnit, false>((PG8_LAS unsigned char*)lds, g, S, E, nullptr);
}
constexpr int LDS_TAIL = LDS_BYTES - 64;

__global__ __launch_bounds__(NTHR, 2) void k_mega(Params P) {
    extern __shared__ __attribute__((aligned(16))) char lds[];
    if (TIDX() == 0) *(uint4*)(lds + LDS_TAIL) = make_uint4(0u, 0u, 0u, 0u);
    __syncthreads();
    XcdBarrier bar = xcd_barrier_post(P.ctl_(), (volatile LAS unsigned*)(lds + LDS_TAIL));
    const int G = gridDim.x, B = blockIdx.x;
    phase_prologue1(P, lds); phase_rope_table(P); phase_s5_params(P); phase_rmsnorm_x(P, 0);
    xcd_barrier(bar);
    for (int layer = 0; layer < DEPTH; ++layer) {
        if (layer > 0) { phase_rmsnorm_x(P, layer); xcd_barrier(bar); }
        phase_gemm_in(P, layer, lds);
        if (layer == 0) phase_gemm_kv(P, lds);
        xcd_barrier(bar);
        phase_prep(P, layer);
        if (layer == 0) phase_memk_norm(P);
        for (int u = B; u < 256; u += G) unit_gla_a4(P, layer, u, lds);
        xcd_barrier(bar);
        Q_LOOP_BEGIN(P.ctl_() + CTL_Q0 + 64 * (layer * 2), 128 + 2048 + 256)
            if (item < 128) unit_s5(P, layer, item, lds);
            else if (item < 2176) unit_dsa_index(P, item - 128, lds);
            else gla_scan_slice(P, (item - 2176) * NTHR + TIDX());
        Q_LOOP_END
        xcd_barrier(bar);
        Q_LOOP_BEGIN(P.ctl_() + CTL_Q0 + 64 * (layer * 2 + 1), 256 + 256 + 128 + 256)
            if (item < 256) unit_dsa_attn(P, layer, item, lds);
            else if (item < 512) unit_gla_c4(P, layer, item - 256, lds);
            else if (item < 640) unit_glu(P, layer, item - 512, lds);
            else unit_mem_attn(P, layer, item - 640, lds);
        Q_LOOP_END
        xcd_barrier(bar);
        phase_gemm_out(P, layer, lds);
        xcd_barrier(bar);
    }
}

extern "C" void kernel_launch(void* const* d_in, const int* in_sizes, int n_in, void* d_out, int out_size, void* d_ws, size_t ws_size, hipStream_t stream) {
    if (n_in != 24 || ws_size < WS_END) { fprintf(stderr, "kernel_launch: unexpected n_in %d or ws_size %zu (< %zu)\n", n_in, ws_size, (size_t)WS_END); return; }
    Params P; memset(&P, 0, sizeof(P));
    P.x = (const float*)d_in[0]; P.mem = (const float*)d_in[1]; P.pos = (const int*)d_in[2]; P.ln_gain = (const float*)d_in[3]; P.w_in = (const float*)d_in[4];
    P.gla_w_up = (const float*)d_in[5]; P.gla_b_up = (const float*)d_in[6]; P.s5_a_re = (const float*)d_in[7]; P.s5_a_im = (const float*)d_in[8]; P.s5_log_step = (const float*)d_in[9];
    P.s5_b_re = (const float*)d_in[10]; P.s5_b_im = (const float*)d_in[11]; P.s5_c_re = (const float*)d_in[12]; P.s5_c_im = (const float*)d_in[13]; P.s5_d = (const float*)d_in[14];
    P.s5_w_glu = (const float*)d_in[15]; P.dsa_q_norm = (const float*)d_in[16]; P.dsa_k_norm = (const float*)d_in[17]; P.mem_norm = (const float*)d_in[18]; P.w_mem_kv = (const float*)d_in[19];
    P.mem_q_norm = (const float*)d_in[20]; P.mem_k_norm = (const float*)d_in[21]; P.out_norm = (const float*)d_in[22]; P.w_out = (const float*)d_in[23];
    P.out = (float*)d_out;
    char* ws = (char*)d_ws; P.ws = ws;
    static int grid = 0;
    if (!grid) {
        int dev = 0, cus = 0, per_cu = 0;
        (void)hipGetDevice(&dev); (void)hipDeviceGetAttribute(&cus, hipDeviceAttributeMultiprocessorCount, dev);
        (void)hipFuncSetAttribute((const void*)k_mega, hipFuncAttributeMaxDynamicSharedMemorySize, LDS_BYTES);
        (void)hipOccupancyMaxActiveBlocksPerMultiprocessor(&per_cu, (const void*)k_mega, NTHR, LDS_BYTES);
        if (per_cu < 1) fprintf(stderr, "kernel_launch: occupancy query reports %d blocks per CU\n", per_cu);
        grid = cus > 0 ? cus : 256;
    }
    (void)hipMemsetAsync(ws + WS_CTL, 0, CTL_BYTES, stream);
    hipLaunchKernelGGL(k_mega, dim3(grid), dim3(NTHR), LDS_BYTES, stream, P);
}
```

```cpp
#include <hip/hip_runtime.h>
#include <stdint.h>
#include <stdio.h>
#include <string.h>

constexpr int NB = 4, SEQ = 4096, NTOK = NB * SEQ, DM = 2048, DEPTH = 4, MEML = 256;
constexpr int NIN = 5984, NPAD = 6144, MIX = 2048;
constexpr int C_GQ = 0, C_GK = 256, C_GV = 512, C_GLR = 1024, C_GZ = 1040, C_SU = 1552, C_SZ = 2064, C_DQ = 2576, C_DK = 3088, C_DV = 3216,
              C_DIQ = 3344, C_DIK = 4368, C_DIW = 4432, C_DZ = 4448, C_MQ = 4960, C_MZ = 5472;
constexpr float EPS = 1e-6f;
constexpr int NTHR = 512;
constexpr int LDS_BYTES = 147456;

typedef unsigned short bf16_t;
typedef short bf16x8 __attribute__((ext_vector_type(8)));
typedef short s16x4 __attribute__((ext_vector_type(4)));
typedef float f32x4 __attribute__((ext_vector_type(4)));
typedef float f32x8 __attribute__((ext_vector_type(8)));
typedef float f32x16 __attribute__((ext_vector_type(16)));
typedef unsigned u32x4 __attribute__((ext_vector_type(4)));
typedef unsigned u32x2 __attribute__((ext_vector_type(2)));
#define LAS __attribute__((address_space(3)))

__device__ __forceinline__ float bf2f(bf16_t b) { return __uint_as_float(((unsigned)b) << 16); }
__device__ __forceinline__ unsigned pk2bf(float lo, float hi) { unsigned r; asm("v_cvt_pk_bf16_f32 %0, %1, %2" : "=v"(r) : "v"(lo), "v"(hi)); return r; }
__device__ __forceinline__ bf16_t f2bf(float f) { return (bf16_t)pk2bf(f, f); }
__device__ __forceinline__ float sigmoidf_(float x) { return __builtin_amdgcn_rcpf(1.f + __expf(-x)); }
__device__ __forceinline__ float siluf_(float x) { return x * __builtin_amdgcn_rcpf(1.f + __expf(-x)); }

__device__ __forceinline__ int TIDX() { int t = (int)threadIdx.x; asm volatile("" : "+v"(t)); return t; }
__device__ __forceinline__ float shx(float v, int m) { const int src = ((TIDX() & 63) ^ m) << 2; return __int_as_float(__builtin_amdgcn_ds_bpermute(src, __float_as_int(v))); }
__device__ __forceinline__ float wave_sum(float v) {
#pragma unroll
    for (int o = 32; o >= 1; o >>= 1) v += shx(v, o);
    return v;
}
__device__ __forceinline__ void ld8f(const bf16_t* p, float (&v)[8]) { const u32x4 w = *(const u32x4*)p;
#pragma unroll
    for (int j = 0; j < 4; ++j) { v[2 * j] = __uint_as_float(w[j] << 16); v[2 * j + 1] = __uint_as_float(w[j] & 0xffff0000u); } }
__device__ __forceinline__ void st8f(bf16_t* p, const float (&v)[8]) { u32x4 w; w.x = pk2bf(v[0], v[1]); w.y = pk2bf(v[2], v[3]); w.z = pk2bf(v[4], v[5]); w.w = pk2bf(v[6], v[7]); *(u32x4*)p = w; }
__device__ __forceinline__ float f2bf_f(float f) { return bf2f(f2bf(f)); }

#ifndef TPROBE
#define TPROBE 0
#endif
#if TPROBE
#define TPU_START(id) do { if (TPROBE == (id) && TIDX() == 0) *(volatile unsigned long long*)(lds + LDS_BYTES - 24) = __builtin_amdgcn_s_memrealtime(); } while (0)
#define TPU_STOP(id) do { if (TPROBE == (id) && TIDX() == 0) *(volatile unsigned long long*)(lds + LDS_BYTES - 32) += __builtin_amdgcn_s_memrealtime() - *(volatile unsigned long long*)(lds + LDS_BYTES - 24); } while (0)
#else
#define TPU_START(id) do {} while (0)
#define TPU_STOP(id) do {} while (0)
#endif
#define XB_TMO      128
#define XB_XCNT(j)  (256  + 64 * (j))
#define XB_XSUB(j)  (1280 + 64 * (j))
#define XB_XGEN(j)  (2304 + 64 * (j))
#define XB_TOP      3328
#define XB_TOPGEN   3392
#define XCD_BAR_WORDS 3456
#define XB_SPIN_CAP (1u << 18)

__device__ __forceinline__ unsigned xb_ld(unsigned* p)              { return __hip_atomic_load(p, __ATOMIC_RELAXED, __HIP_MEMORY_SCOPE_AGENT); }
__device__ __forceinline__ unsigned xb_add(unsigned* p, unsigned v) { return __hip_atomic_fetch_add(p, v, __ATOMIC_RELAXED, __HIP_MEMORY_SCOPE_AGENT); }
__device__ __forceinline__ unsigned xb_xcc_id() { return (unsigned)__builtin_amdgcn_s_getreg((3 << 11) | 20) & 0xFu; }
#define XB_SPIN(cond, bar) do { unsigned _sp = 0; while (cond) { __builtin_amdgcn_s_sleep(1); \
    if ((++_sp & 255u) == 0u) { if (xb_ld(&(bar)[XB_TMO])) break; if (_sp > XB_SPIN_CAP) { atomicAdd(&(bar)[XB_TMO], 1u); break; } } } } while (0)

struct XcdBarrier {
    unsigned* bar; unsigned x;
    volatile LAS unsigned* st;
};

__device__ __forceinline__ XcdBarrier xcd_barrier_post(unsigned* bar, volatile LAS unsigned* st) {
    XcdBarrier b; b.bar = bar; b.x = xb_xcc_id(); b.st = st;
    if (TIDX() == 0) (void)xb_add(&bar[XB_XCNT(b.x)], 1u);
    return b;
}
__device__ __forceinline__ void xcd_barrier_complete(unsigned* bar, unsigned x, unsigned& nloc, unsigned& nx) {
    const unsigned G = gridDim.x * gridDim.y * gridDim.z;
    unsigned sum, cnt, mine, sp = 0u;
    for (;;) {
        sum = 0u; cnt = 0u; mine = 0u;
#pragma unroll
        for (unsigned j = 0; j < 16; ++j) { const unsigned c = xb_ld(&bar[XB_XCNT(j)]); sum += c; cnt += (c > 0u) ? 1u : 0u; mine = (j == x) ? c : mine; }
        if (sum == G) break;
        __builtin_amdgcn_s_sleep(1);
        if ((++sp & 255u) == 0u) { if (xb_ld(&bar[XB_TMO])) break; if (sp > XB_SPIN_CAP) { atomicAdd(&bar[XB_TMO], 1u); break; } }
    }
    nloc = mine > 0u ? mine : 1u; nx = cnt > 0u ? cnt : 1u;
}

__device__ __forceinline__ void xcd_barrier(const XcdBarrier& b) {
    asm volatile("s_waitcnt vmcnt(0)" ::: "memory");
    __syncthreads();
    if (TIDX() == 0) {
        unsigned* bar = b.bar; const unsigned bx = xb_xcc_id();
        __builtin_amdgcn_s_waitcnt(0);
        unsigned nloc = b.st[0], nx = b.st[1];
        if (nloc == 0u) { xcd_barrier_complete(bar, bx, nloc, nx); b.st[0] = nloc; b.st[1] = nx; }
        const unsigned old = xb_add(&bar[XB_XSUB(bx)], 1u);
        const unsigned gen = old / nloc;
        if (old + 1u == (gen + 1u) * nloc) {
            __builtin_amdgcn_fence(__ATOMIC_RELEASE, "agent");
            asm volatile("s_waitcnt vmcnt(0)" ::: "memory");
            const unsigned og = xb_add(&bar[XB_TOP], 1u);
            const unsigned tg = og / nx;
            if (og + 1u == (tg + 1u) * nx) xb_add(&bar[XB_TOPGEN], 1u);
            else XB_SPIN(xb_ld(&bar[XB_TOPGEN]) == tg, bar);
            __builtin_amdgcn_fence(__ATOMIC_ACQUIRE, "agent");
            xb_add(&bar[XB_XGEN(bx)], 1u);
            asm volatile("s_waitcnt vmcnt(0)" ::: "memory");
        } else {
            XB_SPIN(xb_ld(&bar[XB_XGEN(bx)]) == gen, bar);
            __builtin_amdgcn_fence(__ATOMIC_ACQUIRE, "agent");
            asm volatile("s_waitcnt vmcnt(0)" ::: "memory");
        }
    }
    __syncthreads();
}
namespace pg8 {
#define PG8_LAS __attribute__((address_space(3)))
typedef float f32x2 __attribute__((ext_vector_type(2)));
typedef unsigned u32x4 __attribute__((ext_vector_type(4)));
constexpr int BM = 256, BK = 64, HALF = 128, HTB = HALF * BK * 2  , STAGE_BYTES = 8 * HTB, NXCD = 8, WGM = 8;

__host__ __device__ __forceinline__ int lds_byte(int r, int c) { const int st = (r >> 4) * 2 + (c >> 5), rr = r & 15, cc = c & 31, ob = rr * 64 + cc * 2; return st * 1024 + (ob ^ (((ob >> 9) & 1) << 5)); }
__host__ __device__ __forceinline__ void stage_rc(int b, int& R, int& C) { const int st = b / 1024, sb = b % 1024, swz = sb ^ (((sb >> 9) & 1) << 5); R = (st >> 1) * 16 + swz / 64; C = (st & 1) * 32 + (swz % 64) / 2; }
__host__ __device__ __forceinline__ int perm32(int rho) { const int n = rho >> 4, i = rho & 15; return 8 * (i >> 2) + 4 * n + (i & 3); }

struct Unit { int pm, pn; };
struct Gemm { const bf16_t* A; const bf16_t* Bt; int M, N, K; };

struct StaticOrder {
    int nM, nN, nwg, G, c;
    __host__ __device__ void init(int M, int N, int G_, int c_) { nM = M / BM; nN = N / BM; nwg = nM * nN; G = G_; c = c_; }
    __host__ __device__ bool next(int i, Unit& u) const {
        const long L = (long)i * G + c; if (L >= nwg) return false;
        int wgid = (int)L; { const int q = nwg / NXCD, r = nwg % NXCD, xcd = wgid % NXCD, off = wgid / NXCD; wgid = (xcd < r ? xcd * (q + 1) : r * (q + 1) + (xcd - r) * q) + off; }
        const int nig = WGM * nN, gid = wgid / nig, fm = gid * WGM, gsz = (nM - fm) < WGM ? (nM - fm) : WGM;
        u.pm = fm + ((wgid % nig) % gsz); u.pn = (wgid % nig) / gsz; return true;
    }
    __device__ __forceinline__ void a_ready(const Unit&) const {}
    __device__ __forceinline__ void done(const Unit&) const {}
};
__device__ __forceinline__ unsigned cvt_pk_bf16(float lo, float hi) { unsigned r; asm volatile("v_cvt_pk_bf16_f32 %0, %1, %2" : "=v"(r) : "v"(lo), "v"(hi)); return r; }
struct EpiBf16Plain {
    static constexpr bool PERM = true, AFTER_DRAIN = false;
    bf16_t* O; int ldc;
    __device__ __forceinline__ void operator()(const f32x4 (&acc)[2][2][4][2], const Unit& u, int wr, int wc, int fr, int fq) const {
        const int row0 = u.pm * BM + wr * 64 + fr, col0 = u.pn * BM + wc * 32 + 8 * fq;
#pragma unroll
        for (int ai = 0; ai < 2; ++ai)
#pragma unroll
            for (int m = 0; m < 4; ++m) { bf16_t* rowp = O + (size_t)(row0 + ai * HALF + m * 16) * ldc + col0;
#pragma unroll
                for (int bj = 0; bj < 2; ++bj) { const f32x4 v0 = acc[ai][bj][m][0], v1 = acc[ai][bj][m][1];
                    u32x4 w; w.x = cvt_pk_bf16(v0[0], v0[1]); w.y = cvt_pk_bf16(v0[2], v0[3]); w.z = cvt_pk_bf16(v1[0], v1[1]); w.w = cvt_pk_bf16(v1[2], v1[3]);
                    *(u32x4*)(rowp + bj * HALF) = w; } }
    }
};
struct EpiResid {
    static constexpr bool PERM = false, AFTER_DRAIN = false;
    const float* R; float* C; int ldc;
    __device__ __forceinline__ void operator()(const f32x4 (&acc)[2][2][4][2], const Unit& u, int wr, int wc, int fr, int fq) const {
        const int row0 = u.pm * BM + wr * 64 + fr, col0 = u.pn * BM + wc * 32 + 4 * fq;
#pragma unroll
        for (int ai = 0; ai < 2; ++ai)
#pragma unroll
            for (int m = 0; m < 4; ++m) { const size_t off = (size_t)(row0 + ai * HALF + m * 16) * ldc + col0;
#pragma unroll
                for (int bj = 0; bj < 2; ++bj)
#pragma unroll
                    for (int n = 0; n < 2; ++n) { const f32x4 r = *(const f32x4*)(R + off + bj * HALF + n * 16); *(f32x4*)(C + off + bj * HALF + n * 16) = acc[ai][bj][m][n] + r; } }
    }
};
struct EpiResidMix {
    static constexpr bool PERM = true, AFTER_DRAIN = false;
    const void* R; void* C; int ldc; int r16, c16;
    __device__ __forceinline__ void operator()(const f32x4 (&acc)[2][2][4][2], const Unit& u, int wr, int wc, int fr, int fq) const {
        const int row0 = u.pm * BM + wr * 64 + fr, col0 = u.pn * BM + wc * 32 + 8 * fq;
#pragma unroll
        for (int ai = 0; ai < 2; ++ai)
#pragma unroll
            for (int m = 0; m < 4; ++m) { const size_t off = (size_t)(row0 + ai * HALF + m * 16) * ldc + col0;
                f32x4 r0[2], r1[2];
                if (r16) {
#pragma unroll
                    for (int bj = 0; bj < 2; ++bj) { const u32x4 w = *(const u32x4*)((const bf16_t*)R + off + bj * HALF);
                        r0[bj] = f32x4{__uint_as_float(w.x << 16), __uint_as_float(w.x & 0xffff0000u), __uint_as_float(w.y << 16), __uint_as_float(w.y & 0xffff0000u)};
                        r1[bj] = f32x4{__uint_as_float(w.z << 16), __uint_as_float(w.z & 0xffff0000u), __uint_as_float(w.w << 16), __uint_as_float(w.w & 0xffff0000u)}; }
                } else {
#pragma unroll
                    for (int bj = 0; bj < 2; ++bj) { r0[bj] = *(const f32x4*)((const float*)R + off + bj * HALF); r1[bj] = *(const f32x4*)((const float*)R + off + bj * HALF + 4); }
                }
#pragma unroll
                for (int bj = 0; bj < 2; ++bj) { const f32x4 v0 = acc[ai][bj][m][0] + r0[bj], v1 = acc[ai][bj][m][1] + r1[bj];
                    if (c16) { u32x4 w; w.x = cvt_pk_bf16(v0[0], v0[1]); w.y = cvt_pk_bf16(v0[2], v0[3]); w.z = cvt_pk_bf16(v1[0], v1[1]); w.w = cvt_pk_bf16(v1[2], v1[3]);
                        *(u32x4*)((bf16_t*)C + off + bj * HALF) = w; }
                    else { *(f32x4*)((float*)C + off + bj * HALF) = v0; *(f32x4*)((float*)C + off + bj * HALF + 4) = v1; } } }
    }
};
struct EpiGlu {
    static constexpr bool PERM = true, AFTER_DRAIN = false;
    const bf16_t* Y; int ldy; bf16_t* O; int ldo; int ooff;
    __device__ __forceinline__ void operator()(const f32x4 (&acc)[2][2][4][2], const Unit& u, int wr, int wc, int fr, int fq) const {
        const int row0 = u.pm * BM + wr * 64 + fr, col0 = u.pn * BM + wc * 32 + 8 * fq;
#pragma unroll
        for (int ai = 0; ai < 2; ++ai)
#pragma unroll
            for (int m = 0; m < 4; ++m) { const int row = row0 + ai * HALF + m * 16;
#pragma unroll
                for (int bj = 0; bj < 2; ++bj) { const f32x4 v0 = acc[ai][bj][m][0], v1 = acc[ai][bj][m][1];
                    const u32x4 yw = *(const u32x4*)(Y + (size_t)row * ldy + col0 + bj * HALF);
                    float y[8], g[8];
#pragma unroll
                    for (int j = 0; j < 4; ++j) { y[2 * j] = __uint_as_float(yw[j] << 16); y[2 * j + 1] = __uint_as_float(yw[j] & 0xffff0000u); }
#pragma unroll
                    for (int j = 0; j < 4; ++j) { g[j] = __builtin_amdgcn_rcpf(1.f + __expf(-v0[j])); g[4 + j] = __builtin_amdgcn_rcpf(1.f + __expf(-v1[j])); }
                    u32x4 w; w.x = cvt_pk_bf16(y[0] * g[0], y[1] * g[1]); w.y = cvt_pk_bf16(y[2] * g[2], y[3] * g[3]); w.z = cvt_pk_bf16(y[4] * g[4], y[5] * g[5]); w.w = cvt_pk_bf16(y[6] * g[6], y[7] * g[7]);
                    *(u32x4*)(O + (size_t)row * ldo + ooff + col0 + bj * HALF) = w; } }
    }
};
struct EpiGluGate {
    static constexpr bool PERM = true, AFTER_DRAIN = true;
    const bf16_t* Y; const bf16_t* Pz; bf16_t* G;
    __device__ __forceinline__ void fused(const f32x4 (&acc)[2][2][4][2], const Unit& u, int wr, int wc, int fr, int fq, PG8_LAS unsigned char* lds, int wid, int lane) const {
        constexpr int TS = 528;
        TPU_START(130);
        const int row0 = wr * 64 + fr, col0 = wc * 32 + 8 * fq;
#pragma unroll
        for (int ai = 0; ai < 2; ++ai)
#pragma unroll
            for (int m = 0; m < 4; ++m) { const int rl = row0 + ai * HALF + m * 16; const size_t grow = (size_t)u.pm * BM + rl;
#pragma unroll
                for (int bj = 0; bj < 2; ++bj) { const f32x4 v0 = acc[ai][bj][m][0], v1 = acc[ai][bj][m][1];
                    const u32x4 yw = *(const u32x4*)(Y + grow * 512 + u.pn * BM + col0 + bj * HALF);
                    float y[8], g[8];
#pragma unroll
                    for (int j = 0; j < 4; ++j) { y[2 * j] = __uint_as_float(yw[j] << 16); y[2 * j + 1] = __uint_as_float(yw[j] & 0xffff0000u); }
#pragma unroll
                    for (int j = 0; j < 4; ++j) { g[j] = __builtin_amdgcn_rcpf(1.f + __expf(-v0[j])); g[4 + j] = __builtin_amdgcn_rcpf(1.f + __expf(-v1[j])); }
                    u32x4 w; w.x = cvt_pk_bf16(y[0] * g[0], y[1] * g[1]); w.y = cvt_pk_bf16(y[2] * g[2], y[3] * g[3]); w.z = cvt_pk_bf16(y[4] * g[4], y[5] * g[5]); w.w = cvt_pk_bf16(y[6] * g[6], y[7] * g[7]);
                    *(PG8_LAS u32x4*)(lds + rl * TS + (col0 + bj * HALF) * 2) = w; } }
        u32x4 zr[16];
#pragma unroll
        for (int i = 0; i < 16; ++i) { const size_t grow = (size_t)u.pm * BM + wid * 32 + 2 * i + (lane >> 5);
            zr[i] = *(const u32x4*)(Pz + grow * 6144 + 2064 + u.pn * BM + 8 * (lane & 31)); }
        __syncthreads();
        { const int t = wid * 64 + lane, row = t >> 1, hd = t & 1; const PG8_LAS unsigned char* src = lds + row * TS + hd * 256;
          float ss = 0.f;
#pragma unroll
          for (int i = 0; i < 16; ++i) { const u32x4 w = *(const PG8_LAS u32x4*)(src + 16 * i);
#pragma unroll
              for (int j = 0; j < 4; ++j) { const float a = __uint_as_float(w[j] << 16), b = __uint_as_float(w[j] & 0xffff0000u); ss += a * a + b * b; } }
          *(PG8_LAS float*)(lds + row * TS + 512 + hd * 4) = rsqrtf(ss * (1.f / 128.f) + 1e-6f); }
        asm volatile("s_waitcnt lgkmcnt(0)" ::: "memory");
#pragma unroll
        for (int i = 0; i < 16; ++i) { const int row = wid * 32 + 2 * i + (lane >> 5), c8 = 8 * (lane & 31);
            const u32x4 w = *(const PG8_LAS u32x4*)(lds + row * TS + c8 * 2); const float rn = *(const PG8_LAS float*)(lds + row * TS + 512 + (c8 >> 7) * 4);
            const u32x4 zw = zr[i]; u32x4 o;
#pragma unroll
            for (int j = 0; j < 4; ++j) { const float a = __uint_as_float(w[j] << 16), b = __uint_as_float(w[j] & 0xffff0000u), za = __uint_as_float(zw[j] << 16), zb = __uint_as_float(zw[j] & 0xffff0000u);
                o[j] = cvt_pk_bf16(a * rn * (za * __builtin_amdgcn_rcpf(1.f + __expf(-za))), b * rn * (zb * __builtin_amdgcn_rcpf(1.f + __expf(-zb)))); }
            *(u32x4*)(G + ((size_t)u.pm * BM + row) * 2048 + 512 + u.pn * BM + c8) = o; }
        __syncthreads();
        TPU_STOP(130);
    }
};
struct EpiBf16Scale {
    static constexpr bool PERM = true, AFTER_DRAIN = false;
    bf16_t* O; int ldc; const float* ssq;
    __device__ __forceinline__ void operator()(const f32x4 (&acc)[2][2][4][2], const Unit& u, int wr, int wc, int fr, int fq) const {
        const int row0 = u.pm * BM + wr * 64 + fr, col0 = u.pn * BM + wc * 32 + 8 * fq;
#pragma unroll
        for (int ai = 0; ai < 2; ++ai)
#pragma unroll
            for (int m = 0; m < 4; ++m) { const int row = row0 + ai * HALF + m * 16; bf16_t* rowp = O + (size_t)row * ldc + col0;
                float ssum = 0.f; { const f32x4* sp_ = (const f32x4*)(ssq + (size_t)row * 32);
#pragma unroll
                    for (int q = 0; q < 8; ++q) { const f32x4 t4 = sp_[q]; ssum += (t4[0] + t4[1]) + (t4[2] + t4[3]); } }
                const float s = rsqrtf(ssum * (1.f / 2048.f) + 1e-6f);
#pragma unroll
                for (int bj = 0; bj < 2; ++bj) { const f32x4 v0 = acc[ai][bj][m][0] * s, v1 = acc[ai][bj][m][1] * s;
                    u32x4 w; w.x = cvt_pk_bf16(v0[0], v0[1]); w.y = cvt_pk_bf16(v0[2], v0[3]); w.z = cvt_pk_bf16(v1[0], v1[1]); w.w = cvt_pk_bf16(v1[2], v1[3]);
                    *(u32x4*)(rowp + bj * HALF) = w; } }
    }
};
struct EpiResidNext {
    static constexpr bool PERM = false, AFTER_DRAIN = false;
    const float* R; float* C; int ldc; bf16_t* XB; float* ssq;
    __device__ __forceinline__ void operator()(const f32x4 (&acc)[2][2][4][2], const Unit& u, int wr, int wc, int fr, int fq) const {
        const int row0 = u.pm * BM + wr * 64 + fr, col0 = u.pn * BM + wc * 32 + 4 * fq;
#pragma unroll
        for (int ai = 0; ai < 2; ++ai)
#pragma unroll
            for (int m = 0; m < 4; ++m) { const int row = row0 + ai * HALF + m * 16; const size_t off = (size_t)row * ldc + col0; float ss = 0.f;
#pragma unroll
                for (int bj = 0; bj < 2; ++bj)
#pragma unroll
                    for (int n = 0; n < 2; ++n) { const f32x4 r = *(const f32x4*)(R + off + bj * HALF + n * 16); const f32x4 v = acc[ai][bj][m][n] + r;
                        *(f32x4*)(C + off + bj * HALF + n * 16) = v;
                        if (XB) { u32x2 w; w.x = cvt_pk_bf16(v[0], v[1]); w.y = cvt_pk_bf16(v[2], v[3]); *(u32x2*)(XB + off + bj * HALF + n * 16) = w; }
                        ss += v[0] * v[0] + v[1] * v[1] + v[2] * v[2] + v[3] * v[3]; }
                if (ssq) { ss += shx(ss, 16); ss += shx(ss, 32); if (fq == 0) ssq[(size_t)row * 32 + u.pn * 4 + wc] = ss; } }
    }
};
template <class Epi, class Sched, bool STAMP = false>
__device__ __forceinline__ void gemm_phase(PG8_LAS unsigned char* lds, const Gemm g, const Sched& S, const Epi& E, unsigned long long* stamps) {
    const int tid = TIDX(), wid = __builtin_amdgcn_readfirstlane(tid >> 6), lane = tid & 63, wr = wid >> 2, wc = wid & 3, fr = lane & 15, fq = lane >> 4;
    const int K = g.K, nt = K / BK;
    int ts_lo = 0, ts_hi = 0, nts = 0; const unsigned long long rt_entry = STAMP ? (unsigned long long)wall_clock64() : 0ull;
#define PG8_STAMP() do { if (STAMP && wid == 0 && nts < 64) { const unsigned long long _c = (unsigned long long)clock64(); \
        ts_lo = (lane == nts) ? (int)(unsigned)_c : ts_lo; ts_hi = (lane == nts) ? (int)(unsigned)(_c >> 32) : ts_hi; ++nts; } } while (0)
    PG8_STAMP();
    unsigned voffA[2], voffB[2];
#pragma unroll
    for (int i = 0; i < 2; ++i) { int R, C; stage_rc(tid * 16 + i * 8192, R, C); const int Rb = Epi::PERM ? ((R & ~31) + perm32(R & 31)) : R;
        voffA[i] = (unsigned)(R * K + C) * 2u; voffB[i] = (unsigned)(Rb * K + C) * 2u; }
    const size_t kstep = (size_t)(BK * 2);
    const size_t hstep = (size_t)HALF * K * 2;
    const size_t tstep = 2 * hstep;
    const unsigned ldsw = (unsigned)wid * 1024u;
    const int aoff = lds_byte(wr * 64 + fr, fq * 8), boff = lds_byte(wc * 32 + fr, fq * 8);
#define PG8_SA(b, h) (((b) * 2 + (h)) * HTB)
#define PG8_SB(b, h) ((4 + (b) * 2 + (h)) * HTB)
#define PG8_STAGE(bufoff, gbase, voff) do { _Pragma("unroll") for (int _i = 0; _i < 2; ++_i) \
        __builtin_amdgcn_global_load_lds((const unsigned*)((const char*)(gbase) + (voff)[_i]), (PG8_LAS unsigned*)(lds + (bufoff) + ldsw + _i * 8192), 16, 0, 0); } while (0)
#define PG8_LDA(dst, b, h) do { _Pragma("unroll") for (int m = 0; m < 4; ++m) _Pragma("unroll") for (int k = 0; k < 2; ++k) dst[m][k] = *(const PG8_LAS bf16x8*)(lds + PG8_SA(b, h) + aoff + m * 2048 + k * 1024); } while (0)
#define PG8_LDB(dst, b, h) do { _Pragma("unroll") for (int n = 0; n < 2; ++n) _Pragma("unroll") for (int k = 0; k < 2; ++k) dst[n][k] = *(const PG8_LAS bf16x8*)(lds + PG8_SB(b, h) + boff + n * 2048 + k * 1024); } while (0)
#define PG8_MMA(ai, bj, At, Bt) do { __builtin_amdgcn_s_setprio(1); _Pragma("unroll") for (int m = 0; m < 4; ++m) _Pragma("unroll") for (int n = 0; n < 2; ++n) _Pragma("unroll") for (int k = 0; k < 2; ++k) \
        acc[ai][bj][m][n] = __builtin_amdgcn_mfma_f32_16x16x32_bf16(Bt[n][k], At[m][k], acc[ai][bj][m][n], 0, 0, 0); __builtin_amdgcn_s_setprio(0); } while (0)
#define PG8_WAIT_V(n) asm volatile("s_waitcnt vmcnt(" #n ")" ::: "memory")
#define PG8_WAIT_L(n) asm volatile("s_waitcnt lgkmcnt(" #n ")" ::: "memory")
#define PG8_BAR __builtin_amdgcn_s_barrier()
#define PG8_SCHED __builtin_amdgcn_sched_barrier(0)
    Unit cur, nxt; int ui = 0;
    if (!S.next(0, cur)) return;
    f32x4 acc[2][2][4][2];
#pragma unroll
    for (int a = 0; a < 2; ++a)
#pragma unroll
        for (int b = 0; b < 2; ++b)
#pragma unroll
            for (int m = 0; m < 4; ++m)
#pragma unroll
                for (int n = 0; n < 2; ++n) acc[a][b][m][n] = (f32x4){0.f, 0.f, 0.f, 0.f};
    bf16x8 At[4][2], B0[2][2], B1[2][2];
    const char* cA = (const char*)g.A + (size_t)cur.pm * tstep; const char* cB = (const char*)g.Bt + (size_t)cur.pn * tstep;
    S.a_ready(cur);
    PG8_STAGE(PG8_SB(0, 0), cB, voffB); PG8_STAGE(PG8_SA(0, 0), cA, voffA); PG8_STAGE(PG8_SB(0, 1), cB + hstep, voffB); PG8_STAGE(PG8_SA(0, 1), cA + hstep, voffA);
    if (wr == 1) PG8_BAR;
    PG8_WAIT_V(4); PG8_BAR;
    PG8_STAGE(PG8_SB(1, 0), cB + kstep, voffB); PG8_STAGE(PG8_SA(1, 0), cA + kstep, voffA); PG8_STAGE(PG8_SB(1, 1), cB + hstep + kstep, voffB);
    PG8_WAIT_V(6); PG8_BAR;
    PG8_STAMP();
    for (;;) {
        const bool has_next = S.next(ui + 1, nxt);
        const char* nA = has_next ? (const char*)g.A + (size_t)nxt.pm * tstep : cA; const char* nB = has_next ? (const char*)g.Bt + (size_t)nxt.pn * tstep : cB;
        for (int t = 0; t < nt; t += 2) {
            const bool last = (t == nt - 2);
            const char* a1 = cA + (size_t)(t + 1) * kstep;
            const char* a2 = last ? nA : cA + (size_t)(t + 2) * kstep; const char* b2 = last ? nB : cB + (size_t)(t + 2) * kstep;
            const char* a3 = a2 + kstep; const char* b3 = b2 + kstep;
            if (last && has_next) S.a_ready(nxt);
            PG8_LDB(B0, 0, 0); PG8_SCHED; PG8_LDA(At, 0, 0); PG8_STAGE(PG8_SA(1, 1), a1 + hstep, voffA);
            PG8_WAIT_L(8); PG8_BAR; PG8_WAIT_L(0); PG8_MMA(0, 0, At, B0); PG8_BAR; PG8_SCHED;
            PG8_LDB(B1, 0, 1); PG8_STAGE(PG8_SB(0, 0), b2, voffB);
            PG8_BAR; PG8_WAIT_L(0); PG8_MMA(0, 1, At, B1); PG8_BAR;
            PG8_LDA(At, 0, 1); PG8_STAGE(PG8_SA(0, 0), a2, voffA);
            PG8_BAR; PG8_WAIT_L(0); PG8_MMA(1, 0, At, B0); PG8_BAR; PG8_SCHED;
            PG8_STAGE(PG8_SB(0, 1), b2 + hstep, voffB);
            PG8_WAIT_V(6); PG8_BAR; PG8_MMA(1, 1, At, B1); PG8_BAR;
            PG8_LDB(B0, 1, 0); PG8_SCHED; PG8_LDA(At, 1, 0); PG8_STAGE(PG8_SA(0, 1), a2 + hstep, voffA);
            PG8_WAIT_L(8); PG8_BAR; PG8_WAIT_L(0); PG8_MMA(0, 0, At, B0); PG8_BAR; PG8_SCHED;
            PG8_LDB(B1, 1, 1); PG8_STAGE(PG8_SB(1, 0), b3, voffB);
            PG8_BAR; PG8_WAIT_L(0); PG8_MMA(0, 1, At, B1); PG8_BAR;
            PG8_LDA(At, 1, 1); PG8_STAGE(PG8_SA(1, 0), a3, voffA);
            PG8_BAR; PG8_WAIT_L(0); PG8_MMA(1, 0, At, B0); PG8_BAR; PG8_SCHED;
            PG8_STAGE(PG8_SB(1, 1), b3 + hstep, voffB);
            PG8_WAIT_V(6); PG8_BAR; PG8_MMA(1, 1, At, B1); PG8_BAR;
        }
        PG8_STAMP();
        if constexpr (!Epi::AFTER_DRAIN) { E(acc, cur, wr, wc, fr, fq); S.done(cur); }
        PG8_STAMP();
        if (!has_next) break;
#pragma unroll
        for (int a = 0; a < 2; ++a)
#pragma unroll
            for (int b = 0; b < 2; ++b)
#pragma unroll
                for (int m = 0; m < 4; ++m)
#pragma unroll
                    for (int n = 0; n < 2; ++n) acc[a][b][m][n] = (f32x4){0.f, 0.f, 0.f, 0.f};
        cur = nxt; cA = nA; cB = nB; ++ui;
    }
    PG8_WAIT_V(0);
    if (wr == 0) PG8_BAR;
    PG8_BAR;
    if constexpr (Epi::AFTER_DRAIN) { E.fused(acc, cur, wr, wc, fr, fq, lds, wid, lane); S.done(cur); }
    PG8_STAMP();
    if (STAMP && wid == 0) { stamps[lane] = lane < nts ? (((unsigned long long)(unsigned)ts_hi << 32) | (unsigned)ts_lo) : 0ull;
        if (lane == 62) stamps[62] = rt_entry; if (lane == 63) stamps[63] = (unsigned long long)wall_clock64(); }
#undef PG8_STAMP
#undef PG8_SA
#undef PG8_SB
#undef PG8_STAGE
#undef PG8_LDA
#undef PG8_LDB
#undef PG8_MMA
#undef PG8_WAIT_V
#undef PG8_WAIT_L
#undef PG8_BAR
#undef PG8_SCHED
}
}
namespace att {
constexpr int D = 128, NW = 8, QBLK = 32, KVBLK = 64;
constexpr float SCALE = 0.088388347648318440f, THR = 8.f;
constexpr int SHM_V = KVBLK * D * 2, SHM_K = KVBLK * D * 2, SHM_ATTN = 2 * SHM_V + 2 * SHM_K + NW * 64 * 4;
#define KSWZ(row, colB) ((row) * 256 + ((colB) ^ (((row) & 7) << 4)))
#define SBAR() __builtin_amdgcn_sched_barrier(0)
__device__ __forceinline__ int crow(int r, int hi) { return (r & 3) + 8 * (r >> 2) + 4 * hi; }
__device__ __forceinline__ unsigned cvtpk(float lo, float hi) { unsigned r; asm volatile("v_cvt_pk_bf16_f32 %0, %1, %2" : "=v"(r) : "v"(lo), "v"(hi)); return r; }

template <bool MASKED>
__device__ __forceinline__ void partialSM(f32x16& p0, f32x16& p1, float& m_reg, float& mn, float& alpha, unsigned long long mw, int hi) {
  constexpr float C = SCALE * 1.4426950408889634f;
  float pmax = p0[0];
#pragma unroll
  for (int r = 1; r < 16; ++r) pmax = fmaxf(pmax, p0[r]);
#pragma unroll
  for (int r = 0; r < 16; ++r) pmax = fmaxf(pmax, p1[r]);
  { auto rr = __builtin_amdgcn_permlane32_swap(__float_as_uint(pmax), __float_as_uint(pmax), false, false);
    pmax = fmaxf(__uint_as_float(rr[0]), __uint_as_float(rr[1])); }
  if (__builtin_expect(__all(pmax - m_reg <= THR / SCALE), 1)) { mn = m_reg; alpha = 1.f; }
  else { mn = fmaxf(m_reg, pmax); alpha = __builtin_amdgcn_exp2f((m_reg - mn) * C); m_reg = mn; }
  const float mnC = -mn * C;
#pragma unroll
  for (int r = 0; r < 16; ++r) p0[r] = fmaf(p0[r], C, mnC);
#pragma unroll
  for (int r = 0; r < 16; ++r) p1[r] = fmaf(p1[r], C, mnC);
#pragma unroll
  for (int r = 0; r < 16; ++r) p0[r] = __builtin_amdgcn_exp2f(p0[r]);
}
__device__ __forceinline__ void finishSM(f32x16& p0, f32x16& p1, float alpha, float& l_reg, bf16x8& pa0, bf16x8& pa1, bf16x8& pa2, bf16x8& pa3) {
#pragma unroll
  for (int r = 0; r < 16; ++r) p1[r] = __builtin_amdgcn_exp2f(p1[r]);
  float ps = 0;
#pragma unroll
  for (int r = 0; r < 16; ++r) ps += p0[r];
#pragma unroll
  for (int r = 0; r < 16; ++r) ps += p1[r];
  { auto rr = __builtin_amdgcn_permlane32_swap(__float_as_uint(ps), __float_as_uint(ps), false, false);
    ps = __uint_as_float(rr[0]) + __uint_as_float(rr[1]); }
  l_reg = l_reg * alpha + ps;
#define PK4(P, BASE, OUT) do { unsigned a0 = cvtpk(P[BASE + 0], P[BASE + 1]), a1 = cvtpk(P[BASE + 2], P[BASE + 3]);   \
    unsigned b0 = cvtpk(P[BASE + 4], P[BASE + 5]), b1 = cvtpk(P[BASE + 6], P[BASE + 7]);                              \
    auto r0 = __builtin_amdgcn_permlane32_swap(a0, b0, false, false); auto r1 = __builtin_amdgcn_permlane32_swap(a1, b1, false, false); \
    u32x4 w = {r0[0], r1[0], r0[1], r1[1]}; OUT = *reinterpret_cast<bf16x8*>(&w); } while (0)
  PK4(p0, 0, pa0); PK4(p0, 8, pa1); PK4(p1, 0, pa2); PK4(p1, 8, pa3);
#undef PK4
}
template <int R> __device__ __forceinline__ float mask_bias(unsigned nw) {
  unsigned t; constexpr int bit = (R & 3) + 8 * (R >> 2);
  asm("v_bfe_i32 %0, %1, %2, 1\n\tv_and_b32 %0, 0xff800000, %0" : "=v"(t) : "v"(nw), "n"(bit));
  return __uint_as_float(t);
}
template <bool MASKED>
__device__ __forceinline__ void qkt(f32x16& p0, f32x16& p1, const char* Ks, const bf16x8* qr, int r32, int hi, unsigned long long mw) {
  if (MASKED) {
    const unsigned n0 = ~((unsigned)mw >> (4 * hi)), n1 = ~((unsigned)(mw >> 32) >> (4 * hi));
#define MB_(R) p0[R] = mask_bias<R>(n0); p1[R] = mask_bias<R>(n1);
    MB_(0) MB_(1) MB_(2) MB_(3) MB_(4) MB_(5) MB_(6) MB_(7) MB_(8) MB_(9) MB_(10) MB_(11) MB_(12) MB_(13) MB_(14) MB_(15)
#undef MB_
  } else { p0 = f32x16{}; p1 = f32x16{}; }
  asm volatile("" : "+v"(p0), "+v"(p1));
#pragma unroll
  for (int d0 = 0; d0 < 8; ++d0) { const int cb = (d0 * 16 + hi * 8) * 2;
    bf16x8 b0 = *reinterpret_cast<const bf16x8*>(Ks + KSWZ(r32, cb));
    bf16x8 b1 = *reinterpret_cast<const bf16x8*>(Ks + KSWZ(32 + r32, cb));
    p0 = __builtin_amdgcn_mfma_f32_32x32x16_bf16(b0, qr[d0], p0, 0, 0, 0);
    p1 = __builtin_amdgcn_mfma_f32_32x32x16_bf16(b1, qr[d0], p1, 0, 0, 0); }
}
__device__ __forceinline__ int v_st(int k, int c) { const int kk = (k & ~0xC) | ((k & 4) << 1) | ((k & 8) >> 1); return ((kk >> 3) * 4 + (c >> 5)) * 512 + ((kk & 7) * 32 + (c & 31)) * 2; }
__device__ __forceinline__ int v_rd_base(int lane) { return ((lane & 3) << 3) | (((lane >> 2) & 3) << 6) | (((lane >> 4) & 1) << 5) | (((lane >> 5) & 1) << 8); }
constexpr int v_rd_off(int d0, int ks, int half) { return d0 * 512 + ks * 4096 + half * 2048; }
template <int OFF> __device__ __forceinline__ s16x4 tr_read(int vb) {
  s16x4 r; asm volatile("ds_read_b64_tr_b16 %0, %1 offset:%2" : "=&v"(r) : "v"(vb), "i"(OFF) : "memory"); return r;
}
template <int D0> __device__ __forceinline__ void pv_one(f32x16& od, int vb, bf16x8 pa0, bf16x8 pa1, bf16x8 pa2, bf16x8 pa3) {
  const s16x4 l0 = tr_read<v_rd_off(D0, 0, 0)>(vb), h0 = tr_read<v_rd_off(D0, 0, 1)>(vb), l1 = tr_read<v_rd_off(D0, 1, 0)>(vb), h1 = tr_read<v_rd_off(D0, 1, 1)>(vb);
  const s16x4 l2 = tr_read<v_rd_off(D0, 2, 0)>(vb), h2 = tr_read<v_rd_off(D0, 2, 1)>(vb), l3 = tr_read<v_rd_off(D0, 3, 0)>(vb), h3 = tr_read<v_rd_off(D0, 3, 1)>(vb);
  asm volatile("s_waitcnt lgkmcnt(0)" ::: "memory"); SBAR();
#define PK(L, H) (bf16x8){L[0], L[1], L[2], L[3], H[0], H[1], H[2], H[3]}
  od = __builtin_amdgcn_mfma_f32_32x32x16_bf16(pa0, PK(l0, h0), od, 0, 0, 0);
  od = __builtin_amdgcn_mfma_f32_32x32x16_bf16(pa1, PK(l1, h1), od, 0, 0, 0);
  od = __builtin_amdgcn_mfma_f32_32x32x16_bf16(pa2, PK(l2, h2), od, 0, 0, 0);
  od = __builtin_amdgcn_mfma_f32_32x32x16_bf16(pa3, PK(l3, h3), od, 0, 0, 0);
#undef PK
}
__device__ __forceinline__ void pv_d0(f32x16* o, int vb, bf16x8 pa0, bf16x8 pa1, bf16x8 pa2, bf16x8 pa3) {
  pv_one<0>(o[0], vb, pa0, pa1, pa2, pa3); pv_one<1>(o[1], vb, pa0, pa1, pa2, pa3); pv_one<2>(o[2], vb, pa0, pa1, pa2, pa3); pv_one<3>(o[3], vb, pa0, pa1, pa2, pa3);
}

template <bool MASKED, int LDK, int VOFF, int QT, class OutRow>
__device__ __forceinline__ void attn_body(const bf16_t* __restrict__ Qw, const float* __restrict__ qgain, const float* __restrict__ qcs, const bf16_t* __restrict__ Kh, int NT,
                                          const unsigned long long* __restrict__ mbase, unsigned moff, const OutRow& Ow, char* lds) {
  const int tid = TIDX(), wid = tid >> 6, lane = tid & 63, r32 = lane & 31, hi = lane >> 5;
  char* V_lds = lds; char* K_lds = lds + 2 * SHM_V;
  float* ws = (float*)(lds + 2 * SHM_V + 2 * SHM_K) + wid * 64; float* li_l = ws; float* al_l = ws + 32;
  float m_reg = -1e30f, l_reg = 0; f32x16 o[4] = {}; bf16x8 qr[8];
  asm volatile("" : "+v"(o[0]), "+v"(o[1]), "+v"(o[2]), "+v"(o[3]));
#pragma unroll
  for (int d0 = 0; d0 < 8; ++d0) qr[d0] = *reinterpret_cast<const bf16x8*>(Qw + d0 * 16);
  if (QT) {
    float ss = 0.f;
#pragma unroll
    for (int d0 = 0; d0 < 8; ++d0)
#pragma unroll
      for (int j = 0; j < 8; ++j) { const float x = bf2f((bf16_t)qr[d0][j]); ss += x * x; }
    { auto rr = __builtin_amdgcn_permlane32_swap(__float_as_uint(ss), __float_as_uint(ss), false, false); ss = __uint_as_float(rr[0]) + __uint_as_float(rr[1]); }
    const float rn = rsqrtf(ss * (1.f / 128.f) + EPS);
    float x01[2][8];
#pragma unroll
    for (int d0 = 0; d0 < 8; ++d0) { const f32x4 g0 = *(const f32x4*)(qgain + d0 * 16 + hi * 8), g1 = *(const f32x4*)(qgain + d0 * 16 + hi * 8 + 4);
      float x[8];
#pragma unroll
      for (int j = 0; j < 8; ++j) x[j] = bf2f((bf16_t)qr[d0][j]) * rn * (j < 4 ? g0[j] : g1[j - 4]);
      if (QT == 2 && d0 < 2) {
#pragma unroll
        for (int j = 0; j < 8; ++j) x01[d0][j] = x[j];
      } else { u32x4 w = {cvtpk(x[0], x[1]), cvtpk(x[2], x[3]), cvtpk(x[4], x[5]), cvtpk(x[6], x[7])}; qr[d0] = *reinterpret_cast<bf16x8*>(&w); } }
    if (QT == 2) {
      float a[8], b[8];
#pragma unroll
      for (int j2 = 0; j2 < 4; ++j2) { const f32x4 cs = *(const f32x4*)(qcs + hi * 16 + 4 * j2);
#pragma unroll
        for (int q = 0; q < 2; ++q) { const int j = 2 * j2 + q; const float c = cs[2 * q], sn = cs[2 * q + 1], x1 = x01[0][j], x2 = x01[1][j]; a[j] = x1 * c - x2 * sn; b[j] = x2 * c + x1 * sn; } }
      { u32x4 w = {cvtpk(a[0], a[1]), cvtpk(a[2], a[3]), cvtpk(a[4], a[5]), cvtpk(a[6], a[7])}; qr[0] = *reinterpret_cast<bf16x8*>(&w); }
      { u32x4 w = {cvtpk(b[0], b[1]), cvtpk(b[2], b[3]), cvtpk(b[4], b[5]), cvtpk(b[6], b[7])}; qr[1] = *reinterpret_cast<bf16x8*>(&w); }
    }
  }
  const int sr = tid >> 4, sc = (tid & 15) * 8, vst0 = v_st(sr, sc), vst1 = v_st(32 + sr, sc);
  const int vb0 = (int)(uintptr_t)V_lds + v_rd_base(lane);
  struct { bf16x8 vs0, vs1, ks0, ks1; } sr_[2];
  const unsigned koff = (unsigned)(sr * LDK + sc) * 2u;
#define SLOAD(i, k0) do { const char* kb_ = (const char*)Kh + (size_t)(k0) * (LDK * 2); \
    sr_[i].vs0 = *reinterpret_cast<const bf16x8*>(kb_ + koff + VOFF * 2); sr_[i].vs1 = *reinterpret_cast<const bf16x8*>(kb_ + koff + (32 * LDK + VOFF) * 2); \
    sr_[i].ks0 = *reinterpret_cast<const bf16x8*>(kb_ + koff); sr_[i].ks1 = *reinterpret_cast<const bf16x8*>(kb_ + koff + 32 * LDK * 2); } while (0)
#define SWRITE(b, i) do { *(bf16x8*)(V_lds + (b) * SHM_V + vst0) = sr_[i].vs0;          \
    *(bf16x8*)(V_lds + (b) * SHM_V + vst1) = sr_[i].vs1; int kc = sc * 2;               \
    *(bf16x8*)(K_lds + (b) * SHM_K + KSWZ(sr, kc)) = sr_[i].ks0;                       \
    *(bf16x8*)(K_lds + (b) * SHM_K + KSWZ(32 + sr, kc)) = sr_[i].ks1; } while (0)
#define SWAIT() asm volatile("s_waitcnt vmcnt(4)" ::: "memory")
#define RESC(a) do { if (__any((a) < 1.f)) { if (hi == 0) al_l[r32] = (a); asm volatile("s_waitcnt lgkmcnt(0)" ::: "memory"); \
    _Pragma("unroll") for (int d = 0; d < 4; ++d) _Pragma("unroll") for (int r = 0; r < 16; ++r) o[d][r] *= al_l[crow(r, hi)]; } } while (0)
  f32x16 pA0, pA1, pB0, pB1; float mnA, mnB, alA, alB; bf16x8 pa0, pa1, pa2, pa3;
  unsigned long long mw = 0ull;
  constexpr int SE = 0, SO = 1;
  if (MASKED) mw = *(const unsigned long long*)((const char*)mbase + moff);
  SLOAD(SE, 0); SLOAD(SO, KVBLK);
  SWAIT(); SWRITE(0, SE); __syncthreads();
  qkt<MASKED>(pA0, pA1, K_lds, qr, r32, hi, mw);
  if (MASKED) mw = *(const unsigned long long*)((const char*)mbase + (moff + 8u));
  partialSM<MASKED>(pA0, pA1, m_reg, mnA, alA, mw, hi);
  SLOAD(SE, (2 < NT ? 2 : NT - 1) * KVBLK);
  SWAIT();
  SWRITE(1, SO); __syncthreads();
  if (MASKED) TPU_START(120);
  for (int j = 1; j + 1 < NT; j += 2) {
    SBAR(); qkt<MASKED>(pB0, pB1, K_lds + SHM_K, qr, r32, hi, mw);
    if (MASKED) mw = *(const unsigned long long*)((const char*)mbase + (moff + 8u * (unsigned)(j + 1)));
    finishSM(pA0, pA1, alA, l_reg, pa0, pa1, pa2, pa3); SBAR();
    SLOAD(SO, (j + 2) * KVBLK); SBAR();
    pv_d0(o, vb0, pa0, pa1, pa2, pa3); partialSM<MASKED>(pB0, pB1, m_reg, mnB, alB, mw, hi);
    __syncthreads(); if (MASKED) asm volatile("s_waitcnt vmcnt(5)" ::: "memory"); else SWAIT();
    SWRITE(0, SE);
    RESC(alB); __syncthreads();
    SBAR(); qkt<MASKED>(pA0, pA1, K_lds, qr, r32, hi, mw);
    if (MASKED) mw = *(const unsigned long long*)((const char*)mbase + (moff + 8u * (unsigned)(j + 2)));
    finishSM(pB0, pB1, alB, l_reg, pa0, pa1, pa2, pa3); SBAR();
    SLOAD(SE, (j + 3 < NT ? j + 3 : NT - 1) * KVBLK); SBAR();
    pv_d0(o, vb0 + SHM_V, pa0, pa1, pa2, pa3); partialSM<MASKED>(pA0, pA1, m_reg, mnA, alA, mw, hi);
    __syncthreads(); if (MASKED) asm volatile("s_waitcnt vmcnt(5)" ::: "memory"); else SWAIT();
    SWRITE(1, SO);
    RESC(alA); __syncthreads();
  }
  SBAR(); qkt<MASKED>(pB0, pB1, K_lds + SHM_K, qr, r32, hi, mw);
  finishSM(pA0, pA1, alA, l_reg, pa0, pa1, pa2, pa3); SBAR();
  pv_d0(o, vb0, pa0, pa1, pa2, pa3); partialSM<MASKED>(pB0, pB1, m_reg, mnB, alB, mw, hi);
  __syncthreads(); RESC(alB);
  finishSM(pB0, pB1, alB, l_reg, pa0, pa1, pa2, pa3); SBAR();
  pv_d0(o, vb0 + SHM_V, pa0, pa1, pa2, pa3);
  if (MASKED) TPU_STOP(120);
  if (MASKED) TPU_START(121);
  u32x4 zr[8];
#pragma unroll
  for (int i = 0; i < 8; ++i) zr[i] = *(const u32x4*)(Ow.zrow(4 * i + (lane >> 4)) + 8 * (lane & 15));
  if (hi == 0) li_l[r32] = l_reg; asm volatile("s_waitcnt lgkmcnt(0)" ::: "memory");
  float rli[16];
#pragma unroll
  for (int r = 0; r < 16; ++r) rli[r] = __builtin_amdgcn_rcpf(li_l[crow(r, hi)]);
  __syncthreads();
  float* og_s = (float*)lds + wid * (32 * 132);
#pragma unroll
  for (int r = 0; r < 16; ++r) {
#pragma unroll
    for (int d0 = 0; d0 < 4; ++d0) og_s[crow(r, hi) * 132 + d0 * 32 + r32] = o[d0][r] * rli[r]; }
  asm volatile("" ::: "memory");
  { const int row = lane >> 1, half = lane & 1; const float* src = og_s + row * 132 + half * 64;
    float ss = 0.f;
#pragma unroll
    for (int i = 0; i < 16; ++i) { const f32x4 v = *(const f32x4*)(src + 4 * i); ss += v[0] * v[0] + v[1] * v[1] + v[2] * v[2] + v[3] * v[3]; }
    ss += shx(ss, 1);
    if (half == 0) og_s[row * 132 + 128] = rsqrtf(ss * (1.f / 128.f) + EPS); }
  asm volatile("s_waitcnt lgkmcnt(0)" ::: "memory");
#pragma unroll
  for (int i = 0; i < 8; ++i) { const int row = 4 * i + (lane >> 4), c8 = 8 * (lane & 15); const float* src = og_s + row * 132 + c8;
    const f32x4 a = *(const f32x4*)src, b2 = *(const f32x4*)(src + 4); const float rn = og_s[row * 132 + 128];
    float z[8], g[8];
    z[0] = __uint_as_float(zr[i].x << 16); z[1] = __uint_as_float(zr[i].x & 0xffff0000u); z[2] = __uint_as_float(zr[i].y << 16); z[3] = __uint_as_float(zr[i].y & 0xffff0000u);
    z[4] = __uint_as_float(zr[i].z << 16); z[5] = __uint_as_float(zr[i].z & 0xffff0000u); z[6] = __uint_as_float(zr[i].w << 16); z[7] = __uint_as_float(zr[i].w & 0xffff0000u);
#pragma unroll
    for (int q = 0; q < 4; ++q) { g[q] = a[q] * rn * siluf_(z[q]); g[4 + q] = b2[q] * rn * siluf_(z[4 + q]); }
    st8f(Ow.grow(row) + c8, g); }
  __syncthreads();
  if (MASKED) TPU_STOP(121);
#undef SLOAD
#undef SWRITE
#undef SWAIT
#undef RESC
}
}
constexpr size_t al256(size_t x) { return (x + 255) / 256 * 256; }
constexpr size_t WS_CTL   = 0;
constexpr size_t CTL_BYTES = 65536;
constexpr size_t WS_WINT  = WS_CTL + CTL_BYTES;
constexpr size_t WS_WOUTT = WS_WINT + al256((size_t)DEPTH * NPAD * DM * 2);
constexpr size_t WS_WKVT  = WS_WOUTT + al256((size_t)DEPTH * DM * MIX * 2);
constexpr size_t WS_WGLUT = WS_WKVT + al256((size_t)DEPTH * 1024 * DM * 2);
constexpr size_t WS_MEMN  = WS_WGLUT + al256((size_t)DEPTH * 512 * 512 * 2);
constexpr size_t WS_KVMEM = WS_MEMN + al256((size_t)NB * MEML * DM * 2);
constexpr size_t WS_XN    = WS_KVMEM + al256((size_t)NB * MEML * DEPTH * 1024 * 2);
constexpr size_t WS_P     = WS_XN + al256((size_t)NTOK * DM * 2);
constexpr size_t WS_XBUF  = WS_P + al256((size_t)NTOK * NPAD * 2);
constexpr size_t WS_OCAT  = WS_XBUF + al256((size_t)NTOK * DM * 4);
constexpr size_t WS_MASK  = WS_OCAT + al256((size_t)NTOK * MIX * 2);
constexpr size_t WS_IW    = WS_MASK + al256((size_t)NTOK * 64 * 8);
constexpr size_t WS_YBUF  = WS_IW + al256((size_t)NTOK * 16 * 4);
constexpr size_t WS_ROPE  = WS_YBUF + al256((size_t)NTOK * 512 * 2);
constexpr size_t WS_S5P   = WS_ROPE + al256((size_t)NTOK * 48 * 4);
constexpr size_t S5P_BYTES = (size_t)DEPTH * 32 * (64 * 2 + 64 * 2 + 64 * 16 * 2) * 4;
constexpr size_t WS_GLAS  = WS_S5P + al256(S5P_BYTES);
constexpr size_t WS_GLAD  = WS_GLAS + al256((size_t)NB * 64 * 4 * 64 * 128 * 4);
constexpr size_t WS_IKC   = WS_GLAD + al256((size_t)NB * 64 * 4 * 64 * 4);
constexpr size_t WS_KVC   = WS_IKC + al256((size_t)NTOK * 64 * 2);
constexpr size_t WS_IQL   = WS_KVC + al256((size_t)NTOK * 256 * 2);
constexpr size_t WS_SSQ   = WS_IQL + al256((size_t)NTOK * 64 * 2);
constexpr size_t DSP_SLOT = (size_t)(256 * 128 + 512) * 4;
constexpr size_t WS_DSP   = WS_SSQ + 256;
constexpr size_t WS_END   = WS_DSP + al256((size_t)160 * 2 * DSP_SLOT);

struct Params {
    const float* x; const float* mem; const int* pos; const float* ln_gain; const float* w_in; const float* gla_w_up; const float* gla_b_up;
    const float* s5_a_re; const float* s5_a_im; const float* s5_log_step; const float* s5_b_re; const float* s5_b_im; const float* s5_c_re; const float* s5_c_im;
    const float* s5_d; const float* s5_w_glu; const float* dsa_q_norm; const float* dsa_k_norm; const float* mem_norm; const float* w_mem_kv;
    const float* mem_q_norm; const float* mem_k_norm; const float* out_norm; const float* w_out;
    float* out;
    char* ws;
    __device__ __forceinline__ unsigned* ctl_() const { return (unsigned*)(ws + WS_CTL); }
    __device__ __forceinline__ bf16_t* WinT_() const { return (bf16_t*)(ws + WS_WINT); }
    __device__ __forceinline__ bf16_t* WoutT_() const { return (bf16_t*)(ws + WS_WOUTT); }
    __device__ __forceinline__ bf16_t* WkvT_() const { return (bf16_t*)(ws + WS_WKVT); }
    __device__ __forceinline__ bf16_t* WgluT_() const { return (bf16_t*)(ws + WS_WGLUT); }
    __device__ __forceinline__ bf16_t* memn_() const { return (bf16_t*)(ws + WS_MEMN); }
    __device__ __forceinline__ bf16_t* kvmem_() const { return (bf16_t*)(ws + WS_KVMEM); }
    __device__ __forceinline__ bf16_t* xn_() const { return (bf16_t*)(ws + WS_XN); }
    __device__ __forceinline__ bf16_t* p_() const { return (bf16_t*)(ws + WS_P); }
    __device__ __forceinline__ bf16_t* xbuf_() const { return (bf16_t*)(ws + WS_XBUF); }
    __device__ __forceinline__ bf16_t* ocat_() const { return (bf16_t*)(ws + WS_OCAT); }
    __device__ __forceinline__ unsigned long long* mask_() const { return (unsigned long long*)(ws + WS_MASK); }
    __device__ __forceinline__ float* iw_() const { return (float*)(ws + WS_IW); }
    __device__ __forceinline__ bf16_t* ybuf_() const { return (bf16_t*)(ws + WS_YBUF); }
    __device__ __forceinline__ float* rope_() const { return (float*)(ws + WS_ROPE); }
    __device__ __forceinline__ float* s5p_() const { return (float*)(ws + WS_S5P); }
    __device__ __forceinline__ float* glas_() const { return (float*)(ws + WS_GLAS); }
    __device__ __forceinline__ float* glad_() const { return (float*)(ws + WS_GLAD); }
    __device__ __forceinline__ bf16_t* ikc_() const { return (bf16_t*)(ws + WS_IKC); }
    __device__ __forceinline__ bf16_t* kvc_() const { return (bf16_t*)(ws + WS_KVC); }
    __device__ __forceinline__ float* ssq_() const { return (float*)(ws + WS_SSQ); }
    __device__ __forceinline__ bf16_t* iql_() const { return (bf16_t*)(ws + WS_IQL); }
    __device__ __forceinline__ char* dsp_() const { return ws + WS_DSP; }
};

__device__ __forceinline__ void transpose_tiles(const float* __restrict__ src, int K, int Nsrc, int Ndst, const float* __restrict__ scale, bf16_t* __restrict__ dst,
                                                int tile, float* lds_tile  ) {
    const int tid = TIDX(), ntn = Ndst / 256;
    const int tk = tile / ntn, tn = tile % ntn, k0 = tk * 64, n0 = tn * 256;
    __syncthreads();
    { const int ty = tid >> 4, tx = tid & 15;
      f32x4 v[2][4];
#pragma unroll
      for (int i = 0; i < 2; ++i)
#pragma unroll
        for (int q = 0; q < 4; ++q) { const int k = k0 + ty + 32 * i, n = n0 + 4 * tx + 64 * q;
          v[i][q] = (f32x4){0.f, 0.f, 0.f, 0.f};
          if (n < Nsrc) v[i][q] = *(const f32x4*)(src + (size_t)k * Nsrc + n); }
#pragma unroll
      for (int i = 0; i < 2; ++i) { const float s = scale ? scale[k0 + ty + 32 * i] : 1.f;
#pragma unroll
        for (int q = 0; q < 4; ++q) { float* t = lds_tile + (ty + 32 * i) * 257 + 4 * tx + 64 * q; t[0] = v[i][q][0] * s; t[1] = v[i][q][1] * s; t[2] = v[i][q][2] * s; t[3] = v[i][q][3] * s; } } }
    __syncthreads();
    { const int n = tid >> 1, kh = (tid & 1) * 32;
#pragma unroll
      for (int j = 0; j < 4; ++j) { const int kb = kh + 8 * j; u32x4 w;
        w.x = pk2bf(lds_tile[(kb + 0) * 257 + n], lds_tile[(kb + 1) * 257 + n]); w.y = pk2bf(lds_tile[(kb + 2) * 257 + n], lds_tile[(kb + 3) * 257 + n]);
        w.z = pk2bf(lds_tile[(kb + 4) * 257 + n], lds_tile[(kb + 5) * 257 + n]); w.w = pk2bf(lds_tile[(kb + 6) * 257 + n], lds_tile[(kb + 7) * 257 + n]);
        *(u32x4*)(dst + (size_t)(n0 + n) * K + k0 + kb) = w; } }
}

__device__ __forceinline__ void rmsnorm_rows(const float* __restrict__ X, bf16_t* __restrict__ Y, int nrows) {
    const int wid = TIDX() >> 6, lane = TIDX() & 63;
    for (int row = blockIdx.x * 8 + wid; row < nrows; row += gridDim.x * 8) {
        const float* xr = X + (size_t)row * DM; f32x4 v[8]; float ss = 0.f;
#pragma unroll
        for (int i = 0; i < 8; ++i) { v[i] = *(const f32x4*)(xr + 4 * lane + 256 * i); ss += v[i][0] * v[i][0] + v[i][1] * v[i][1] + v[i][2] * v[i][2] + v[i][3] * v[i][3]; }
        ss = wave_sum(ss); const float r = rsqrtf(ss * (1.f / DM) + EPS);
        bf16_t* yr = Y + (size_t)row * DM;
#pragma unroll
        for (int i = 0; i < 8; ++i) { u32x2 w; w.x = pk2bf(v[i][0] * r, v[i][1] * r); w.y = pk2bf(v[i][2] * r, v[i][3] * r); *(u32x2*)(yr + 4 * lane + 256 * i) = w; }
    }
}

__device__ __forceinline__ void rmsnorm_rows16(const bf16_t* __restrict__ X, bf16_t* __restrict__ Y, int nrows) {
    const int wid = TIDX() >> 6, lane = TIDX() & 63;
    for (int row = blockIdx.x * 8 + wid; row < nrows; row += gridDim.x * 8) {
        const bf16_t* xr = X + (size_t)row * DM; float v[4][8]; float ss = 0.f;
#pragma unroll
        for (int i = 0; i < 4; ++i) { ld8f(xr + 8 * lane + 512 * i, v[i]);
#pragma unroll
            for (int j = 0; j < 8; ++j) ss += v[i][j] * v[i][j]; }
        ss = wave_sum(ss); const float r = rsqrtf(ss * (1.f / DM) + EPS);
        bf16_t* yr = Y + (size_t)row * DM;
#pragma unroll
        for (int i = 0; i < 4; ++i) { float o[8];
#pragma unroll
            for (int j = 0; j < 8; ++j) o[j] = v[i][j] * r;
            st8f(yr + 8 * lane + 512 * i, o); }
    }
}

__device__ __forceinline__ void rows_bf16_ssq(const float* __restrict__ X, bf16_t* __restrict__ Y, float* __restrict__ ssq, int nrows) {
    const int wid = TIDX() >> 6, lane = TIDX() & 63;
    for (int row = blockIdx.x * 8 + wid; row < nrows; row += gridDim.x * 8) {
        const float* xr = X + (size_t)row * DM; bf16_t* yr = Y + (size_t)row * DM; float ss = 0.f;
#pragma unroll
        for (int i = 0; i < 8; ++i) { const f32x4 v = *(const f32x4*)(xr + 4 * lane + 256 * i); ss += v[0] * v[0] + v[1] * v[1] + v[2] * v[2] + v[3] * v[3];
            u32x2 w; w.x = pk2bf(v[0], v[1]); w.y = pk2bf(v[2], v[3]); *(u32x2*)(yr + 4 * lane + 256 * i) = w; }
        ss = wave_sum(ss); if (lane < 32) ssq[(size_t)row * 32 + lane] = (lane == 0) ? ss : 0.f;
    }
}
__device__ __forceinline__ void phase_prologue1(const Params& P, char* lds) {
    float* tile = (float*)lds;
    constexpr int T_IN = (DM / 64) * (NPAD / 256), T_OUT = (MIX / 64) * (DM / 256), T_KV = (DM / 64) * (1024 / 256), T_GLU = 8 * 2;
    constexpr int TOT = DEPTH * (T_IN + T_OUT + T_KV + T_GLU);
    for (int u = blockIdx.x; u < TOT; u += gridDim.x) {
        int l = u / (T_IN + T_OUT + T_KV + T_GLU), r = u % (T_IN + T_OUT + T_KV + T_GLU);
        if (r < T_IN) transpose_tiles(P.w_in + (size_t)l * DM * NIN, DM, NIN, NPAD, P.ln_gain + l * DM, P.WinT_() + (size_t)l * NPAD * DM, r, tile);
        else if ((r -= T_IN) < T_OUT) transpose_tiles(P.w_out + (size_t)l * MIX * DM, MIX, DM, DM, P.out_norm + l * MIX, P.WoutT_() + (size_t)l * DM * MIX, r, tile);
        else if ((r -= T_OUT) < T_KV) transpose_tiles(P.w_mem_kv + (size_t)l * DM * 1024, DM, 1024, 1024, P.mem_norm + l * DM, P.WkvT_() + (size_t)l * 1024 * DM, r, tile);
        else { r -= T_KV; transpose_tiles(P.s5_w_glu + (size_t)l * 512 * 512, 512, 512, 512, nullptr, P.WgluT_() + (size_t)l * 512 * 512, r, tile); }
    }
    rmsnorm_rows(P.mem, P.memn_(), NB * MEML);
}
__device__ __forceinline__ void phase_rope_table(const Params& P) {
    for (int idx = blockIdx.x * NTHR + TIDX(); idx < NTOK * 24; idx += gridDim.x * NTHR) {
        const int tok = idx / 24, i = idx % 24;
        const float e = (i < 16) ? -((float)i * 2.0f / 32.0f) : -((float)(i - 16) * 2.0f / 16.0f);
        const float inv_freq = exp2f(e * 18.931568569324174f);
        const float ang = (float)P.pos[tok] * inv_freq;
        const double a = (double)ang; const double k = rint(a * 0.15915494309189535); const float rf = (float)fma(-k, 6.283185307179586, a);
        P.rope_()[(size_t)idx * 2] = cosf(rf); P.rope_()[(size_t)idx * 2 + 1] = sinf(rf);
    }
}

__device__ __forceinline__ void phase_rmsnorm_x(const Params& P, int layer) { if (layer == 0) rmsnorm_rows(P.x, P.xn_(), NTOK); else rmsnorm_rows16(P.xbuf_(), P.xn_(), NTOK); }

__device__ __forceinline__ void phase_memk_norm(const Params& P) {
    const int wid = TIDX() >> 6, lane = TIDX() & 63;
    for (int it = blockIdx.x * 8 + wid; it < NB * MEML * DEPTH * 4; it += gridDim.x * 8) {
        const int row = it / (DEPTH * 4), l = (it / 4) % DEPTH, h = it % 4;
        bf16_t* kp = P.kvmem_() + (size_t)row * (DEPTH * 1024) + l * 1024 + h * 128 + 2 * lane;
        const unsigned w = *(const unsigned*)kp; const float a = __uint_as_float(w << 16), b = __uint_as_float(w & 0xffff0000u);
        const float ss = wave_sum(a * a + b * b), r = rsqrtf(ss * (1.f / 128.f) + EPS);
        const float* g = P.mem_k_norm + l * 128 + 2 * lane;
        *(unsigned*)kp = pk2bf(a * r * g[0], b * r * g[1]);
    }
}

__device__ __forceinline__ float sum16(float v) { v += shx(v, 1); v += shx(v, 2); v += shx(v, 4); v += shx(v, 8); return v; }

__device__ __forceinline__ void head128_norm_rope_to(const bf16_t* hp, bf16_t* dp, int l16, const float* __restrict__ gain, const float* __restrict__ cs, bool rope, bool do_store) {
    float v[8]; ld8f(hp + 8 * l16, v);
    float ss = 0.f;
#pragma unroll
    for (int j = 0; j < 8; ++j) ss += v[j] * v[j];
    ss = sum16(ss); const float r = rsqrtf(ss * (1.f / 128.f) + EPS);
#pragma unroll
    for (int j = 0; j < 8; ++j) v[j] = v[j] * r * gain[8 * l16 + j];
    if (rope) {
        float o[8];
#pragma unroll
        for (int j = 0; j < 8; ++j) o[j] = shx(v[j], 2);
        if (l16 < 4) { const int fi = (l16 & 1) * 8;
#pragma unroll
            for (int j = 0; j < 8; ++j) { const float c = cs[(fi + j) * 2], s = cs[(fi + j) * 2 + 1];
                v[j] = (l16 < 2) ? (v[j] * c - o[j] * s) : (v[j] * c + o[j] * s); } }
    }
    if (do_store) st8f(dp + 8 * l16, v);
}
__device__ __forceinline__ void head128_norm_rope(bf16_t* hp, int l16, const float* __restrict__ gain, const float* __restrict__ cs, bool rope, bool do_store) { head128_norm_rope_to(hp, hp, l16, gain, cs, rope, do_store); }
__device__ __forceinline__ void rope16_inplace(bf16_t* ip, const float* __restrict__ cs) {
    float a[8], b[8]; ld8f(ip, a); ld8f(ip + 8, b);
#pragma unroll
    for (int j = 0; j < 8; ++j) { const float c = cs[2 * j], s = cs[2 * j + 1], x1 = a[j], x2 = b[j]; a[j] = x1 * c - x2 * s; b[j] = x2 * c + x1 * s; }
    st8f(ip, a); st8f(ip + 8, b);
}
struct PrepIn { u32x4 k, ik0, ik1, v; bf16_t w; f32x4 c32[4], c16[4]; };
__device__ __forceinline__ void prep_load(const Params& P, int tok, int lane, PrepIn& I) {
    const int l16 = lane & 15, grp = lane >> 4;
    const bf16_t* row = P.p_() + (size_t)tok * NPAD;
    I.k = *(const u32x4*)(row + C_DK + 8 * l16);
    I.ik0 = *(const u32x4*)(row + C_DIK + (lane & 3) * 16); I.ik1 = *(const u32x4*)(row + C_DIK + (lane & 3) * 16 + 8);
    I.v = *(const u32x4*)(row + C_DV + l16 * 8);
    I.w = row[C_DIW + l16];
    const float* cs32 = P.rope_() + (size_t)tok * 48;
#pragma unroll
    for (int i = 0; i < 4; ++i) { I.c32[i] = *(const f32x4*)(cs32 + (l16 & 1) * 16 + 4 * i); I.c16[i] = *(const f32x4*)(cs32 + 32 + 4 * i); }
}
__device__ __forceinline__ void unpack8(const u32x4 w, float (&v)[8]) {
    v[0] = __uint_as_float(w.x << 16); v[1] = __uint_as_float(w.x & 0xffff0000u); v[2] = __uint_as_float(w.y << 16); v[3] = __uint_as_float(w.y & 0xffff0000u);
    v[4] = __uint_as_float(w.z << 16); v[5] = __uint_as_float(w.z & 0xffff0000u); v[6] = __uint_as_float(w.w << 16); v[7] = __uint_as_float(w.w & 0xffff0000u); }
__device__ __forceinline__ void head128_nr(float (&v)[8], int l16, const float (&gain)[8], const f32x4 (&cs)[4], bool rope) {
    float ss = 0.f;
#pragma unroll
    for (int j = 0; j < 8; ++j) ss += v[j] * v[j];
    ss = sum16(ss); const float r = rsqrtf(ss * (1.f / 128.f) + EPS);
#pragma unroll
    for (int j = 0; j < 8; ++j) v[j] = v[j] * r * gain[j];
    if (rope) {
        float o[8];
#pragma unroll
        for (int j = 0; j < 8; ++j) o[j] = shx(v[j], 2);
        if (l16 < 4) {
#pragma unroll
            for (int j = 0; j < 8; ++j) { const float c = cs[j >> 1][(j & 1) * 2], s = cs[j >> 1][(j & 1) * 2 + 1];
                v[j] = (l16 < 2) ? (v[j] * c - o[j] * s) : (v[j] * c + o[j] * s); } }
    }
}
__device__ __forceinline__ void prep_finish(const Params& P, int tok, int lane, const PrepIn& I, const float (&gq)[8], const float (&gk)[8], const float (&gm)[8]) {
    const int l16 = lane & 15, grp = lane >> 4;
    bf16_t* row = P.p_() + (size_t)tok * NPAD;
    float k[8];
    unpack8(I.k, k);
    head128_nr(k, l16, gk, I.c32, true);
    if (grp == 0) st8f(P.kvc_() + (size_t)tok * 256 + 8 * l16, k);
    {
        float a[8], b[8]; unpack8(I.ik0, a); unpack8(I.ik1, b);
        if ((lane & 3) == 0) {
#pragma unroll
            for (int j = 0; j < 8; ++j) { const float c = I.c16[j >> 1][(j & 1) * 2], s = I.c16[j >> 1][(j & 1) * 2 + 1], x1 = a[j], x2 = b[j]; a[j] = x1 * c - x2 * s; b[j] = x2 * c + x1 * s; } }
        if (lane < 4) { bf16_t* dst = P.ikc_() + (size_t)(tok >> 5) * 2048 + lane * 512 + (tok & 31) * 8; st8f(dst, a); st8f(dst + 256, b); } }
    if (lane >= 16 && lane < 32) *(u32x4*)(P.kvc_() + (size_t)tok * 256 + 128 + l16 * 8) = I.v;
    if (lane < 16) P.iw_()[(size_t)tok * 16 + lane] = bf2f(I.w) * (1.f / 32.f);
}
__device__ __forceinline__ void phase_prep(const Params& P, int layer) {
    const int wid = TIDX() >> 6, lane = TIDX() & 63, l16 = lane & 15;
    float gq[8], gk[8], gm[8];
#pragma unroll
    for (int j = 0; j < 8; ++j) { gq[j] = P.dsa_q_norm[layer * 128 + 8 * l16 + j]; gk[j] = P.dsa_k_norm[layer * 128 + 8 * l16 + j]; gm[j] = P.mem_q_norm[layer * 128 + 8 * l16 + j]; }
    const int stride = gridDim.x * 8;
    for (int tok = blockIdx.x * 8 + wid; tok < NTOK; tok += 2 * stride) {
        const int tok2 = tok + stride; const bool two = tok2 < NTOK;
        PrepIn A, B2;
        prep_load(P, tok, lane, A); prep_load(P, two ? tok2 : tok, lane, B2);
        prep_finish(P, tok, lane, A, gq, gk, gm);
        if (two) prep_finish(P, tok2, lane, B2, gq, gk, gm);
    }
}
struct MemOutRow { const bf16_t* zb; bf16_t* gb;
    __device__ __forceinline__ const bf16_t* zrow(int r) const { return zb + (size_t)r * NPAD; } __device__ __forceinline__ bf16_t* grow(int r) const { return gb + (size_t)r * MIX; } };
__device__ __forceinline__ void unit_mem_attn(const Params& P, int layer, int u, char* lds) {
    const int b = u >> 6, h = (u >> 4) & 3, qb = u & 15, tok0 = b * SEQ + qb * 256;
    const int wid = TIDX() >> 6, lane = TIDX() & 63, r32 = lane & 31, hi = lane >> 5;
    const bf16_t* Qw = P.p_() + (size_t)(tok0 + wid * 32 + r32) * NPAD + C_MQ + h * 128 + hi * 8;
    const bf16_t* Kh = P.kvmem_() + (size_t)(b * MEML) * (DEPTH * 1024) + layer * 1024 + h * 128;
    MemOutRow ow; ow.zb = P.p_() + (size_t)(tok0 + wid * 32) * NPAD + C_MZ + h * 128; ow.gb = P.xn_() + (size_t)(tok0 + wid * 32) * MIX + 1536 + h * 128;
    att::attn_body<false, DEPTH * 1024, 512, 1, MemOutRow>(Qw, P.mem_q_norm + layer * 128, nullptr, Kh, MEML / 64, nullptr, 0u, ow, lds);
}

__device__ __forceinline__ void phase_gate(const Params& P, int c_lo, int c_hi) {
    const int wid = TIDX() >> 6, lane = TIDX() & 63;
    const int c0 = lane * 32;
    const int seg = c0 >> 9, zc = (seg == 0 ? C_GZ : seg == 1 ? C_SZ : seg == 2 ? C_DZ : C_MZ) + (c0 & 511);
    const bool act = (c0 >= c_lo) && (c0 < c_hi);
    for (int tok = blockIdx.x * 8 + wid; tok < NTOK; tok += gridDim.x * 8) {
        if (!act) { bf16_t* gz_ = P.xn_() + (size_t)tok * MIX + c0; const u32x4 zz = {0u, 0u, 0u, 0u};
#pragma unroll
            for (int i = 0; i < 4; ++i) *(u32x4*)(gz_ + 8 * i) = zz;
            continue; }
        const bf16_t* op = P.ocat_() + (size_t)tok * MIX + c0; const bf16_t* zp = P.p_() + (size_t)tok * NPAD + zc; bf16_t* gp = P.xn_() + (size_t)tok * MIX + c0;
        float o[32]; float ss = 0.f;
#pragma unroll
        for (int i = 0; i < 4; ++i) { float v[8]; ld8f(op + 8 * i, v);
#pragma unroll
            for (int j = 0; j < 8; ++j) { o[8 * i + j] = v[j]; ss += v[j] * v[j]; } }
        ss += shx(ss, 1); ss += shx(ss, 2);
        const float r = rsqrtf(ss * (1.f / 128.f) + EPS);
#pragma unroll
        for (int i = 0; i < 4; ++i) { float z[8], g[8]; ld8f(zp + 8 * i, z);
#pragma unroll
            for (int j = 0; j < 8; ++j) g[j] = o[8 * i + j] * r * siluf_(z[j]);
            st8f(gp + 8 * i, g); }
    }
}

__device__ __forceinline__ void phase_gemm_in(const Params& P, int layer, char* lds) {
    pg8::Gemm g; g.A = P.xn_(); g.Bt = P.WinT_() + (size_t)layer * NPAD * DM; g.M = NTOK; g.N = NPAD; g.K = DM;
    pg8::StaticOrder S; S.init(g.M, g.N, (int)gridDim.x, (int)blockIdx.x);
    pg8::EpiBf16Plain E; E.O = P.p_(); E.ldc = NPAD;
    pg8::gemm_phase<pg8::EpiBf16Plain, pg8::StaticOrder, false>((PG8_LAS unsigned char*)lds, g, S, E, nullptr);
}
__device__ __forceinline__ void phase_gemm_out(const Params& P, int layer, char* lds) {
    pg8::Gemm g; g.A = P.xn_(); g.Bt = P.WoutT_() + (size_t)layer * DM * MIX; g.M = NTOK; g.N = DM; g.K = MIX;
    pg8::StaticOrder S; S.init(g.M, g.N, (int)gridDim.x, (int)blockIdx.x);
    pg8::EpiResidMix E; E.R = (layer == 0) ? (const void*)P.x : (const void*)P.xbuf_(); E.C = (layer == DEPTH - 1) ? (void*)P.out : (void*)P.xbuf_(); E.ldc = DM;
    E.r16 = (layer != 0); E.c16 = (layer != DEPTH - 1);
    pg8::gemm_phase<pg8::EpiResidMix, pg8::StaticOrder, false>((PG8_LAS unsigned char*)lds, g, S, E, nullptr);
}
__device__ __forceinline__ void phase_gemm_kv(const Params& P, char* lds) {
    pg8::Gemm g; g.A = P.memn_(); g.Bt = P.WkvT_(); g.M = NB * MEML; g.N = DEPTH * 1024; g.K = DM;
    pg8::StaticOrder S; S.init(g.M, g.N, (int)gridDim.x, (int)blockIdx.x);
    pg8::EpiBf16Plain E; E.O = P.kvmem_(); E.ldc = DEPTH * 1024;
    pg8::gemm_phase<pg8::EpiBf16Plain, pg8::StaticOrder, false>((PG8_LAS unsigned char*)lds, g, S, E, nullptr);
}
__device__ __forceinline__ void mma_tile(f32x16& acc, const char* A, int lda, const char* B, int ldb, int K, int lane) {
    const int r = lane & 31, kh = lane >> 5;
    const char* ap = A + r * lda + kh * 16; const char* bp = B + r * ldb + kh * 16;
    asm volatile("" : "+v"(acc));
    for (int k = 0; k < K; k += 16) {
        const bf16x8 a = *(const bf16x8*)(ap + k * 2); const bf16x8 b = *(const bf16x8*)(bp + k * 2);
        acc = __builtin_amdgcn_mfma_f32_32x32x16_bf16(a, b, acc, 0, 0, 0);
    }
}
__device__ __forceinline__ int crow32(int r, int hi) { return (r & 3) + 8 * (r >> 2) + 4 * hi; }
__device__ __forceinline__ float log_sigmoid_(float x) { return fminf(x, 0.f) - log1pf(__expf(-fabsf(x))); }

constexpr int GLA_ST = 144;
constexpr int GC_BST = 68;
constexpr int GC_B_BYTES = 4 * 64 * GC_BST * 4, GC_V_BYTES = 4 * 16384;
__device__ __forceinline__ float* gla_gb(const Params& P) { return (float*)((char*)P.ocat_() + (size_t)32 * 1024 * 1024); }
__device__ __forceinline__ float log_sigmoid_fast(float x) { return fminf(x, 0.f) - __logf(1.f + __expf(-fabsf(x))); }

__device__ __forceinline__ void unit_gla_a4(const Params& P, int layer, int ub, char* lds) {
    const int b = ub >> 6, n = ub & 63, tok0 = b * SEQ + n * 64;
    const int tid = TIDX(), wid = tid >> 6, lane = tid & 63, r32 = lane & 31, hi = lane >> 5, h = wid >> 1, eh = wid & 1;
    float* b_s = (float*)lds;
    char* V_s = lds;
    char* K_s = lds + GC_B_BYTES;
    float* glr_s = (float*)(lds + GC_B_BYTES + GC_V_BYTES);
    float* tot_s = glr_s + 1024;
    __syncthreads();
    const bf16_t* prow = P.p_() + (size_t)tok0 * NPAD;
    const bf16x8 glr_raw = *(const bf16x8*)(prow + (size_t)((tid & 127) >> 1) * NPAD + C_GLR + (tid & 1) * 8);
    const int gd = tid & 63, gh = (tid >> 6) & 3, gt = tid >> 8;
    float wu[16];
#pragma unroll
    for (int r = 0; r < 16; ++r) wu[r] = P.gla_w_up[((size_t)layer * 16 + r) * 256 + gh * 64 + gd];
    const float bias = P.gla_b_up[layer * 256 + gh * 64 + gd];
    bf16x8 kraw[4], vs[4][2];
    const int ks_ = tid >> 3, kc = (tid & 7) * 8;
#pragma unroll
    for (int hv = 0; hv < 4; ++hv) kraw[hv] = *(const bf16x8*)(prow + (size_t)ks_ * NPAD + C_GK + hv * 64 + kc);
    const int sr = tid >> 4, sc = (tid & 15) * 8;
#pragma unroll
    for (int hv = 0; hv < 4; ++hv) { vs[hv][0] = *(const bf16x8*)(prow + (size_t)sr * NPAD + C_GV + hv * 128 + sc); vs[hv][1] = *(const bf16x8*)(prow + (size_t)(32 + sr) * NPAD + C_GV + hv * 128 + sc); }
    if (tid < 128) {
#pragma unroll
        for (int j = 0; j < 8; ++j) glr_s[(tid >> 1) * 16 + (tid & 1) * 8 + j] = bf2f((bf16_t)glr_raw[j]); }
    __syncthreads();
    float gv[32]; float run = 0.f;
#pragma unroll
    for (int i = 0; i < 32; ++i) { const float* gr = glr_s + (gt * 32 + i) * 16; float a = bias;
#pragma unroll
        for (int r4 = 0; r4 < 4; ++r4) { const f32x4 g4 = *(const f32x4*)(gr + 4 * r4); a = fmaf(g4[0], wu[4 * r4], a); a = fmaf(g4[1], wu[4 * r4 + 1], a); a = fmaf(g4[2], wu[4 * r4 + 2], a); a = fmaf(g4[3], wu[4 * r4 + 3], a); }
        run += log_sigmoid_fast(a) * (1.f / 16.f); gv[i] = run; }
    if (gt == 0) tot_s[gh * 64 + gd] = run;
    __syncthreads();
    { const float off = gt ? tot_s[gh * 64 + gd] : 0.f; float* bp = b_s + (gh * 64 + gt * 32) * GC_BST + gd;
      float* gp = gla_gb(P) + (size_t)(tok0 + gt * 32) * 256 + gh * 64 + gd;
#pragma unroll
      for (int i = 0; i < 32; ++i) { const float v = gv[i] + off; bp[i * GC_BST] = v; gp[(size_t)i * 256] = v; }
      if (gt) P.glad_()[((size_t)((b * 64 + n) * 4 + gh)) * 64 + gd] = __expf(gv[31] + off); }
    __syncthreads();
#pragma unroll
    for (int hv = 0; hv < 4; ++hv) { const float* br = b_s + (hv * 64 + ks_) * GC_BST + kc; const float* bl = b_s + (hv * 64 + 63) * GC_BST + kc;
        const f32x4 b0 = *(const f32x4*)br, b1 = *(const f32x4*)(br + 4), l0 = *(const f32x4*)bl, l1 = *(const f32x4*)(bl + 4);
        float e[8];
#pragma unroll
        for (int j = 0; j < 8; ++j) e[j] = bf2f((bf16_t)kraw[hv][j]) * __expf((j < 4 ? l0[j] : l1[j - 4]) - (j < 4 ? b0[j] : b1[j - 4]));
        u32x4 w = {att::cvtpk(e[0], e[1]), att::cvtpk(e[2], e[3]), att::cvtpk(e[4], e[5]), att::cvtpk(e[6], e[7])};
        *(u32x4*)(K_s + hv * 16384 + att::v_st(ks_, kc)) = w; }
    __syncthreads();
    { const int vst0 = att::v_st(sr, sc), vst1 = att::v_st(32 + sr, sc);
#pragma unroll
      for (int hv = 0; hv < 4; ++hv) { *(bf16x8*)(V_s + hv * 16384 + vst0) = vs[hv][0]; *(bf16x8*)(V_s + hv * 16384 + vst1) = vs[hv][1]; } }
    __syncthreads();
    const int vb = (int)(uintptr_t)(V_s + h * 16384) + att::v_rd_base(lane), kb = (int)(uintptr_t)(K_s + h * 16384) + att::v_rd_base(lane);
    f32x16 acc[2][2] = {};
    asm volatile("" : "+v"(acc[0][0]), "+v"(acc[0][1]), "+v"(acc[1][0]), "+v"(acc[1][1]));
#define GA_PK(L, H) (bf16x8){L[0], L[1], L[2], L[3], H[0], H[1], H[2], H[3]}
#define GA_STEP(KS) do { \
    const s16x4 k0l = att::tr_read<att::v_rd_off(0, KS, 0)>(kb), k0h = att::tr_read<att::v_rd_off(0, KS, 1)>(kb), k1l = att::tr_read<att::v_rd_off(1, KS, 0)>(kb), k1h = att::tr_read<att::v_rd_off(1, KS, 1)>(kb); \
    s16x4 v0l, v0h, v1l, v1h; \
    if (eh == 0) { v0l = att::tr_read<att::v_rd_off(0, KS, 0)>(vb); v0h = att::tr_read<att::v_rd_off(0, KS, 1)>(vb); v1l = att::tr_read<att::v_rd_off(1, KS, 0)>(vb); v1h = att::tr_read<att::v_rd_off(1, KS, 1)>(vb); } \
    else         { v0l = att::tr_read<att::v_rd_off(2, KS, 0)>(vb); v0h = att::tr_read<att::v_rd_off(2, KS, 1)>(vb); v1l = att::tr_read<att::v_rd_off(3, KS, 0)>(vb); v1h = att::tr_read<att::v_rd_off(3, KS, 1)>(vb); } \
    asm volatile("s_waitcnt lgkmcnt(0)" ::: "memory"); __builtin_amdgcn_sched_barrier(0); \
    acc[0][0] = __builtin_amdgcn_mfma_f32_32x32x16_bf16(GA_PK(v0l, v0h), GA_PK(k0l, k0h), acc[0][0], 0, 0, 0); \
    acc[0][1] = __builtin_amdgcn_mfma_f32_32x32x16_bf16(GA_PK(v0l, v0h), GA_PK(k1l, k1h), acc[0][1], 0, 0, 0); \
    acc[1][0] = __builtin_amdgcn_mfma_f32_32x32x16_bf16(GA_PK(v1l, v1h), GA_PK(k0l, k0h), acc[1][0], 0, 0, 0); \
    acc[1][1] = __builtin_amdgcn_mfma_f32_32x32x16_bf16(GA_PK(v1l, v1h), GA_PK(k1l, k1h), acc[1][1], 0, 0, 0); } while (0)
    GA_STEP(0); GA_STEP(1); GA_STEP(2); GA_STEP(3);
#undef GA_STEP
#undef GA_PK
    float* dst = P.glas_() + ((size_t)((b * 64 + n) * 4 + h)) * 8192;
#pragma unroll
    for (int et = 0; et < 2; ++et)
#pragma unroll
        for (int dt = 0; dt < 2; ++dt)
#pragma unroll
            for (int r = 0; r < 16; ++r) dst[((eh * 2 + et) * 32 + att::crow(r, hi)) * 64 + dt * 32 + r32] = acc[et][dt][r];
    __syncthreads();
}

__device__ __forceinline__ void gla_scan_slice(const Params& P, int idx) {
    {
        const int el = idx & 8191, d = idx & 63, h = (idx >> 13) & 3, b = idx >> 15;
        bf16_t* gst = P.ocat_();
        float S = 0.f;
        for (int n0 = 0; n0 < 64; n0 += 8) {
            float ds[8], dc[8];
#pragma unroll
            for (int i = 0; i < 8; ++i) { const size_t cu = (size_t)((b * 64 + n0 + i) * 4 + h); ds[i] = P.glas_()[cu * 8192 + el]; dc[i] = P.glad_()[cu * 64 + d]; }
#pragma unroll
            for (int i = 0; i < 8; ++i) { const size_t cu = (size_t)((b * 64 + n0 + i) * 4 + h); gst[cu * 8192 + el] = f2bf(S); S = fmaf(dc[i], S, ds[i]); }
        }
    }
}

__device__ __forceinline__ void unit_gla_c4(const Params& P, int layer, int ub, char* lds) {
    const int b = ub >> 6, n = ub & 63, tok0 = b * SEQ + n * 64;
    const int tid = TIDX(), wid = tid >> 6, lane = tid & 63, r32 = lane & 31, hi = lane >> 5, h = wid >> 1, rh = wid & 1;
    float* b_s = (float*)lds;
    char* V_s = lds + GC_B_BYTES;
    __syncthreads();
    const bf16_t* prow = P.p_() + (size_t)tok0 * NPAD;
    bf16x8 qraw[4], kraw[2][4], vs[4][2];
    const int sr = tid >> 4, sc = (tid & 15) * 8;
#pragma unroll
    for (int hv = 0; hv < 4; ++hv) { vs[hv][0] = *(const bf16x8*)(prow + (size_t)sr * NPAD + C_GV + hv * 128 + sc); vs[hv][1] = *(const bf16x8*)(prow + (size_t)(32 + sr) * NPAD + C_GV + hv * 128 + sc); }
    f32x4 braw[8];
    { const float* gp = gla_gb(P) + (size_t)tok0 * 256 + tid * 4;
#pragma unroll
      for (int i = 0; i < 8; ++i) braw[i] = *(const f32x4*)(gp + i * 2048); }
    { const bf16_t* qp = prow + (size_t)(rh * 32 + r32) * NPAD + C_GQ + h * 64 + hi * 8;
#pragma unroll
      for (int d0 = 0; d0 < 4; ++d0) qraw[d0] = *(const bf16x8*)(qp + d0 * 16);
#pragma unroll
      for (int sh = 0; sh < 2; ++sh) { const bf16_t* kp = prow + (size_t)(sh * 32 + r32) * NPAD + C_GK + h * 64 + hi * 8;
#pragma unroll
          for (int d0 = 0; d0 < 4; ++d0) kraw[sh][d0] = *(const bf16x8*)(kp + d0 * 16); } }
    bf16x8 sfr[4][4];
    { const bf16_t* sp = P.ocat_() + ((size_t)((b * 64 + n) * 4 + h)) * 8192 + r32 * 64 + hi * 8;
#pragma unroll
      for (int eb = 0; eb < 4; ++eb)
#pragma unroll
          for (int ds = 0; ds < 4; ++ds) sfr[eb][ds] = *(const bf16x8*)(sp + eb * 32 * 64 + ds * 16); }
    { const int vst0 = att::v_st(sr, sc), vst1 = att::v_st(32 + sr, sc);
#pragma unroll
      for (int hv = 0; hv < 4; ++hv) { *(bf16x8*)(V_s + hv * 16384 + vst0) = vs[hv][0]; *(bf16x8*)(V_s + hv * 16384 + vst1) = vs[hv][1]; } }
#pragma unroll
    for (int i = 0; i < 8; ++i) { const int c = tid + 512 * i, t = c >> 6, c4 = c & 63;
        *(f32x4*)(b_s + ((c4 >> 4) * 64 + t) * GC_BST + (c4 & 15) * 4) = braw[i]; }
    __syncthreads();
    const float* bh = b_s + h * 64 * GC_BST + hi * 8;
    bf16x8 qe[4], qb[4], ke[2][4];
#pragma unroll
    for (int d0 = 0; d0 < 4; ++d0) {
        const f32x4 m0 = *(const f32x4*)(bh + 32 * GC_BST + d0 * 16), m1 = *(const f32x4*)(bh + 32 * GC_BST + d0 * 16 + 4);
        const f32x4 q0 = *(const f32x4*)(bh + (rh * 32 + r32) * GC_BST + d0 * 16), q1 = *(const f32x4*)(bh + (rh * 32 + r32) * GC_BST + d0 * 16 + 4);
        float e1[8], e2[8];
#pragma unroll
        for (int j = 0; j < 8; ++j) { const float mv = j < 4 ? m0[j] : m1[j - 4], bq = j < 4 ? q0[j] : q1[j - 4]; const float q = bf2f((bf16_t)qraw[d0][j]) * 0.125f;
            e1[j] = q * __expf(bq - mv); e2[j] = q * __expf(bq); }
        { u32x4 w = {att::cvtpk(e1[0], e1[1]), att::cvtpk(e1[2], e1[3]), att::cvtpk(e1[4], e1[5]), att::cvtpk(e1[6], e1[7])}; qe[d0] = *reinterpret_cast<bf16x8*>(&w); }
        { u32x4 w = {att::cvtpk(e2[0], e2[1]), att::cvtpk(e2[2], e2[3]), att::cvtpk(e2[4], e2[5]), att::cvtpk(e2[6], e2[7])}; qb[d0] = *reinterpret_cast<bf16x8*>(&w); }
#pragma unroll
        for (int sh = 0; sh < 2; ++sh) {
            const f32x4 k0 = *(const f32x4*)(bh + (sh * 32 + r32) * GC_BST + d0 * 16), k1 = *(const f32x4*)(bh + (sh * 32 + r32) * GC_BST + d0 * 16 + 4);
            float e3[8];
#pragma unroll
            for (int j = 0; j < 8; ++j) { const float mv = j < 4 ? m0[j] : m1[j - 4], bk = j < 4 ? k0[j] : k1[j - 4]; e3[j] = bf2f((bf16_t)kraw[sh][d0][j]) * __expf(mv - bk); }
            u32x4 w = {att::cvtpk(e3[0], e3[1]), att::cvtpk(e3[2], e3[3]), att::cvtpk(e3[4], e3[5]), att::cvtpk(e3[6], e3[7])}; ke[sh][d0] = *reinterpret_cast<bf16x8*>(&w); }
    }
    f32x16 p0 = {}, p1 = {};
    asm volatile("" : "+v"(p0), "+v"(p1));
#pragma unroll
    for (int d0 = 0; d0 < 4; ++d0) { p0 = __builtin_amdgcn_mfma_f32_32x32x16_bf16(ke[0][d0], qe[d0], p0, 0, 0, 0); p1 = __builtin_amdgcn_mfma_f32_32x32x16_bf16(ke[1][d0], qe[d0], p1, 0, 0, 0); }
    { const int t = rh * 32 + r32;
#pragma unroll
      for (int r = 0; r < 16; ++r) { const int s0 = att::crow(r, hi); p0[r] = (s0 <= t) ? p0[r] : 0.f; p1[r] = (32 + s0 <= t) ? p1[r] : 0.f; } }
    bf16x8 pa0, pa1, pa2, pa3;
#define GC_PK4(Pv, BASE, OUT) do { unsigned a0 = att::cvtpk(Pv[BASE + 0], Pv[BASE + 1]), a1 = att::cvtpk(Pv[BASE + 2], Pv[BASE + 3]);   \
    unsigned b0 = att::cvtpk(Pv[BASE + 4], Pv[BASE + 5]), b1 = att::cvtpk(Pv[BASE + 6], Pv[BASE + 7]);                              \
    auto r0 = __builtin_amdgcn_permlane32_swap(a0, b0, false, false); auto r1 = __builtin_amdgcn_permlane32_swap(a1, b1, false, false); \
    u32x4 w = {r0[0], r1[0], r0[1], r1[1]}; OUT = *reinterpret_cast<bf16x8*>(&w); } while (0)
    GC_PK4(p0, 0, pa0); GC_PK4(p0, 8, pa1); GC_PK4(p1, 0, pa2); GC_PK4(p1, 8, pa3);
#undef GC_PK4
    f32x16 o[4] = {};
    asm volatile("" : "+v"(o[0]), "+v"(o[1]), "+v"(o[2]), "+v"(o[3]));
    att::pv_d0(o, (int)(uintptr_t)(V_s + h * 16384) + att::v_rd_base(lane), pa0, pa1, pa2, pa3);
#pragma unroll
    for (int eb = 0; eb < 4; ++eb)
#pragma unroll
        for (int ds = 0; ds < 4; ++ds) o[eb] = __builtin_amdgcn_mfma_f32_32x32x16_bf16(qb[ds], sfr[eb][ds], o[eb], 0, 0, 0);
    u32x4 zr[8];
#pragma unroll
    for (int i = 0; i < 8; ++i) zr[i] = *(const u32x4*)(P.p_() + (size_t)(tok0 + rh * 32 + 4 * i + (lane >> 4)) * NPAD + C_GZ + h * 128 + 8 * (lane & 15));
    __syncthreads();
    float* og_s = (float*)lds + wid * (32 * 132);
#pragma unroll
    for (int r = 0; r < 16; ++r) {
#pragma unroll
        for (int eb = 0; eb < 4; ++eb) og_s[att::crow(r, hi) * 132 + eb * 32 + r32] = o[eb][r]; }
    asm volatile("" ::: "memory");
    { const int row = lane >> 1, half = lane & 1; const float* src = og_s + row * 132 + half * 64;
      float ss = 0.f;
#pragma unroll
      for (int i = 0; i < 16; ++i) { const f32x4 v = *(const f32x4*)(src + 4 * i); ss += v[0] * v[0] + v[1] * v[1] + v[2] * v[2] + v[3] * v[3]; }
      ss += shx(ss, 1);
      if (half == 0) og_s[row * 132 + 128] = rsqrtf(ss * (1.f / 128.f) + EPS); }
    asm volatile("s_waitcnt lgkmcnt(0)" ::: "memory");
#pragma unroll
    for (int i = 0; i < 8; ++i) { const int row = 4 * i + (lane >> 4), c8 = 8 * (lane & 15); const float* src = og_s + row * 132 + c8;
      const f32x4 a = *(const f32x4*)src, b2 = *(const f32x4*)(src + 4); const float rn = og_s[row * 132 + 128];
      float z[8], gg[8];
      z[0] = __uint_as_float(zr[i].x << 16); z[1] = __uint_as_float(zr[i].x & 0xffff0000u); z[2] = __uint_as_float(zr[i].y << 16); z[3] = __uint_as_float(zr[i].y & 0xffff0000u);
      z[4] = __uint_as_float(zr[i].z << 16); z[5] = __uint_as_float(zr[i].z & 0xffff0000u); z[6] = __uint_as_float(zr[i].w << 16); z[7] = __uint_as_float(zr[i].w & 0xffff0000u);
#pragma unroll
      for (int q = 0; q < 4; ++q) { gg[q] = a[q] * rn * siluf_(z[q]); gg[4 + q] = b2[q] * rn * siluf_(z[4 + q]); }
      st8f(P.xn_() + (size_t)(tok0 + rh * 32 + row) * MIX + h * 128 + c8, gg); }
    __syncthreads();
}
constexpr int S5P_STRIDE = 2304;
__device__ __forceinline__ void phase_s5_params(const Params& P) {
    for (int idx = blockIdx.x * NTHR + TIDX(); idx < DEPTH * 32 * 64; idx += gridDim.x * NTHR) {
        const int p = idx & 63, lg = idx >> 6;
        const float ar = P.s5_a_re[idx], ai = P.s5_a_im[idx], step = expf(P.s5_log_step[lg]);
        const float mag = expf(ar * step), th = ai * step;
        const float lr = mag * cosf(th), li = mag * sinf(th);
        float* o = P.s5p_() + (size_t)lg * S5P_STRIDE;
        o[2 * p] = lr; o[2 * p + 1] = li;
        { const float mag512 = expf(512.f * ar * step); const double a = 512.0 * (double)th; const double k = rint(a * 0.15915494309189535); const float rf = (float)fma(-k, 6.283185307179586, a);
          o[128 + 2 * p] = mag512 * cosf(rf); o[128 + 2 * p + 1] = mag512 * sinf(rf); }
        const float xr = lr - 1.f, xi = li, den = 1.f / (ar * ar + ai * ai);
        const float fr = (xr * ar + xi * ai) * den, fi = (xi * ar - xr * ai) * den;
        for (int c = 0; c < 16; ++c) { const float br = P.s5_b_re[(size_t)idx * 16 + c], bi = P.s5_b_im[(size_t)idx * 16 + c];
            o[256 + (p * 16 + c) * 2] = fr * br - fi * bi; o[256 + (p * 16 + c) * 2 + 1] = fr * bi + fi * br; }
    }
}
__device__ __forceinline__ float gelu_tanh_(float x) { const float u = 0.7978845608028654f * (x + 0.044715f * x * x * x); const float e = __expf(-2.f * fabsf(u)); const float th = copysignf((1.f - e) * __builtin_amdgcn_rcpf(1.f + e), u); return 0.5f * x * (1.f + th); }

constexpr int S5_XST = 272;
constexpr int S5_UST = 48;
__device__ __forceinline__ float partner32(float v, int hi) { auto rr = __builtin_amdgcn_permlane32_swap(__float_as_uint(v), __float_as_uint(v), false, false); return __uint_as_float(hi ? rr[0] : rr[1]); }
struct S5Ctx { float l0r, l0i, l1r, l1i, q0r, q0i, q1r, q1i, dsk; char* Cm; char* Bb; char* Xs; char* Us; int lane, hi, j, rho; const bf16_t* ubase; bf16_t* ybase; };
template <bool OUT> __device__ __forceinline__ void s5_tile(const S5Ctx& C, int tok0, const bf16x8 w0, const bf16x8 w1, float& x0r, float& x0i, float& x1r, float& x1i) {
    const int hi = C.hi, j = C.j, lane = C.lane;
    if (hi == 0) { *(bf16x8*)(C.Us + C.rho * S5_UST) = w0; *(bf16x8*)(C.Us + C.rho * S5_UST + 16) = w1; }
    asm volatile("" ::: "memory");
    f32x16 a0 = {}, a1 = {}, a2 = {}, a3 = {};
    mma_tile(a0, C.Us, S5_UST, C.Bb, S5_UST, 16, lane); mma_tile(a1, C.Us, S5_UST, C.Bb + 32 * S5_UST, S5_UST, 16, lane);
    mma_tile(a2, C.Us, S5_UST, C.Bb + 64 * S5_UST, S5_UST, 16, lane); mma_tile(a3, C.Us, S5_UST, C.Bb + 96 * S5_UST, S5_UST, 16, lane);
    float s0r[16], s0i[16], s1r[16], s1i[16];
#pragma unroll
    for (int r = 0; r < 16; ++r) {
        const float n0r = fmaf(C.l0r, x0r, fmaf(-C.l0i, x0i, a0[r])), n0i = fmaf(C.l0r, x0i, fmaf(C.l0i, x0r, a1[r])); x0r = n0r; x0i = n0i; s0r[r] = n0r; s0i[r] = n0i;
        const float n1r = fmaf(C.l1r, x1r, fmaf(-C.l1i, x1i, a2[r])), n1i = fmaf(C.l1r, x1i, fmaf(C.l1i, x1r, a3[r])); x1r = n1r; x1i = n1i; s1r[r] = n1r; s1i[r] = n1i; }
    float z0r = partner32(x0r, hi), z0i = partner32(x0i, hi), z1r = partner32(x1r, hi), z1i = partner32(x1i, hi);
    if (hi == 0) { z0r = 0.f; z0i = 0.f; z1r = 0.f; z1i = 0.f; }
    if (!OUT) {
        x0r += C.q0r * z0r - C.q0i * z0i; x0i += C.q0r * z0i + C.q0i * z0r; x1r += C.q1r * z1r - C.q1i * z1i; x1i += C.q1r * z1i + C.q1i * z1r;
    } else {
#pragma unroll
        for (int r = 0; r < 16; ++r) {
            const float t0r = C.l0r * z0r - C.l0i * z0i, t0i = C.l0r * z0i + C.l0i * z0r; z0r = t0r; z0i = t0i; s0r[r] += t0r; s0i[r] += t0i;
            const float t1r = C.l1r * z1r - C.l1i * z1i, t1i = C.l1r * z1i + C.l1i * z1r; z1r = t1r; z1i = t1i; s1r[r] += t1r; s1i[r] += t1i; }
        x0r = s0r[15]; x0i = s0i[15]; x1r = s1r[15]; x1i = s1i[15];
#pragma unroll
        for (int r = 0; r < 16; ++r) { char* xr_ = C.Xs + (r + 16 * hi) * S5_XST;
            *(bf16_t*)(xr_ + j * 2) = f2bf(s0r[r]); *(bf16_t*)(xr_ + (64 + j) * 2) = f2bf(s0i[r]);
            *(bf16_t*)(xr_ + (32 + j) * 2) = f2bf(s1r[r]); *(bf16_t*)(xr_ + (96 + j) * 2) = f2bf(s1i[r]); }
        asm volatile("" ::: "memory");
        f32x16 acc = {}; mma_tile(acc, C.Xs, S5_XST, C.Cm, S5_XST, 128, lane);
        if (j < 16) {
#pragma unroll
            for (int r = 0; r < 16; ++r) { const int t = crow32(r, hi); const int rt = ((t & 15) & 3) + 8 * ((t & 15) >> 2) + 4 * (t >> 4);
                const float y = acc[r] + C.dsk * bf2f(*(const bf16_t*)(C.Us + rt * S5_UST + j * 2));
                C.ybase[(size_t)(tok0 + t) * 512 + j] = f2bf(gelu_tanh_(y)); } }
        asm volatile("" ::: "memory");
    }
    { const float e0r = partner32(x0r, hi), e0i = partner32(x0i, hi), e1r = partner32(x1r, hi), e1i = partner32(x1i, hi);
      if (hi == 0) { x0r = e0r; x0i = e0i; x1r = e1r; x1i = e1i; } else { x0r = 0.f; x0i = 0.f; x1r = 0.f; x1i = 0.f; } }
}
__device__ __forceinline__ void unit_s5(const Params& P, int layer, int u, char* lds) {
    const int b = u >> 5, g = u & 31, tid = TIDX(), wid = tid >> 6, lane = tid & 63, hi = lane >> 5, j = lane & 31;
    char* Cm = lds;
    char* Bb = Cm + 32 * S5_XST;
    float* ends = (float*)(Bb + 128 * S5_UST);
    char* wbase = (char*)(ends + 8 * 64 * 2) + wid * (32 * S5_XST + 32 * S5_UST);
    const float* sp = P.s5p_() + (size_t)(layer * 32 + g) * S5P_STRIDE;
    __syncthreads();
    for (int i = tid; i < 32 * 128; i += NTHR) { const int c = i >> 7, pp = i & 127; float v = 0.f;
        if (c < 16) v = (pp < 64) ? P.s5_c_re[((size_t)(layer * 32 + g) * 16 + c) * 64 + pp] : -P.s5_c_im[((size_t)(layer * 32 + g) * 16 + c) * 64 + (pp - 64)];
        *(bf16_t*)(Cm + c * S5_XST + pp * 2) = f2bf(v); }
    for (int i = tid; i < 128 * 16; i += NTHR) { const int n = i >> 4, c = i & 15, nt = n >> 5, jj = n & 31, p = (nt >> 1) * 32 + jj;
        *(bf16_t*)(Bb + n * S5_UST + c * 2) = f2bf(sp[256 + (p * 16 + c) * 2 + (nt & 1)]); }
    S5Ctx C; C.Cm = Cm; C.Bb = Bb; C.Xs = wbase; C.Us = wbase + 32 * S5_XST; C.lane = lane; C.hi = hi; C.j = j;
    C.l0r = sp[2 * j]; C.l0i = sp[2 * j + 1]; C.l1r = sp[2 * (32 + j)]; C.l1i = sp[2 * (32 + j) + 1];
    { float q0r = C.l0r, q0i = C.l0i, q1r = C.l1r, q1i = C.l1i;
#pragma unroll
      for (int k = 0; k < 4; ++k) { const float a = q0r * q0r - q0i * q0i, bb = (q0r + q0r) * q0i; q0r = a; q0i = bb; const float c = q1r * q1r - q1i * q1i, d = (q1r + q1r) * q1i; q1r = c; q1i = d; }
      C.q0r = q0r; C.q0i = q0i; C.q1r = q1r; C.q1i = q1i; }
    C.dsk = P.s5_d[layer * 512 + g * 16 + (lane & 15)];
    C.rho = ((j & 15) & 3) + 8 * ((j & 15) >> 2) + 4 * (j >> 4);
    const int tokw = b * SEQ + wid * 512;
    C.ubase = P.p_() + C_SU + g * 16; C.ybase = P.ybuf_() + g * 16;
    float x0r = 0.f, x0i = 0.f, x1r = 0.f, x1i = 0.f;
    __syncthreads();
    const bf16_t* urow = C.ubase + (size_t)(tokw + j) * NPAD;
    { bf16x8 w0 = *(const bf16x8*)urow, w1 = *(const bf16x8*)(urow + 8);
      for (int sc = 0; sc < 16; ++sc) { const bf16_t* un = urow + (size_t)((sc < 15 ? sc + 1 : 15) * 32) * NPAD;
          const bf16x8 n0 = *(const bf16x8*)un, n1 = *(const bf16x8*)(un + 8);
          s5_tile<false>(C, tokw + sc * 32, w0, w1, x0r, x0i, x1r, x1i); w0 = n0; w1 = n1; } }
    if (hi == 0) { ends[(wid * 64 + j) * 2] = x0r; ends[(wid * 64 + j) * 2 + 1] = x0i; ends[(wid * 64 + 32 + j) * 2] = x1r; ends[(wid * 64 + 32 + j) * 2 + 1] = x1i; }
    __syncthreads();
    { const float p0r = sp[128 + 2 * j], p0i = sp[128 + 2 * j + 1], p1r = sp[128 + 2 * (32 + j)], p1i = sp[128 + 2 * (32 + j) + 1];
      x0r = 0.f; x0i = 0.f; x1r = 0.f; x1i = 0.f;
      for (int w = 0; w < wid; ++w) { const float e0r = ends[(w * 64 + j) * 2], e0i = ends[(w * 64 + j) * 2 + 1], e1r = ends[(w * 64 + 32 + j) * 2], e1i = ends[(w * 64 + 32 + j) * 2 + 1];
          const float n0r = p0r * x0r - p0i * x0i + e0r, n0i = p0r * x0i + p0i * x0r + e0i, n1r = p1r * x1r - p1i * x1i + e1r, n1i = p1r * x1i + p1i * x1r + e1i;
          x0r = n0r; x0i = n0i; x1r = n1r; x1i = n1i; }
      if (hi) { x0r = 0.f; x0i = 0.f; x1r = 0.f; x1i = 0.f; } }
    { bf16x8 w0 = *(const bf16x8*)urow, w1 = *(const bf16x8*)(urow + 8);
      for (int sc = 0; sc < 16; ++sc) { const bf16_t* un = urow + (size_t)((sc < 15 ? sc + 1 : 15) * 32) * NPAD;
          const bf16x8 n0 = *(const bf16x8*)un, n1 = *(const bf16x8*)(un + 8);
          s5_tile<true>(C, tokw + sc * 32, w0, w1, x0r, x0i, x1r, x1i); w0 = n0; w1 = n1; } }
}
constexpr int TOPK = 256;
__device__ __forceinline__ unsigned f2key(float f) { const unsigned u = __float_as_uint(f); return u ^ ((u & 0x80000000u) ? 0xffffffffu : 0x80000000u); }

__device__ __forceinline__ float relu1(float x) { const int b = __float_as_int(x); return __int_as_float(b > 0 ? b : 0); }
#define DSA_MM(acc, rt, kk) acc = __builtin_amdgcn_mfma_f32_32x32x16_bf16(afr[rt][kk], bfr[kk], acc, 0, 0, 0)
#define DSA_HS(acc, rt, q) do { s0 = fmaf(relu1(acc[4 * (q)]), wv[rt][4 * (q)], s0); s1 = fmaf(relu1(acc[4 * (q) + 1]), wv[rt][4 * (q) + 1], s1); \
                                s0 = fmaf(relu1(acc[4 * (q) + 2]), wv[rt][4 * (q) + 2], s0); s1 = fmaf(relu1(acc[4 * (q) + 3]), wv[rt][4 * (q) + 3], s1); } while (0)
#define DSA_SG() __builtin_amdgcn_sched_barrier(0)
__device__ __forceinline__ void dsa_score_tile(const bf16x8 (&afr)[4][4], const f32x16 (&wv)[4], const bf16x8 (&bfr)[4], float* sc, int col, int hi) {
    const f32x16 z16 = {};
#define DSA_M0(acc, rt) acc = __builtin_amdgcn_mfma_f32_32x32x16_bf16(afr[rt][0], bfr[0], z16, 0, 0, 0)
    f32x16 accA, accB;
    float s0, s1;
    DSA_M0(accA, 0); DSA_MM(accA, 0, 1); DSA_MM(accA, 0, 2); DSA_MM(accA, 0, 3);
    s0 = 0.f; s1 = 0.f;
    DSA_M0(accB, 1); DSA_HS(accA, 0, 0); DSA_SG(); DSA_MM(accB, 1, 1); DSA_HS(accA, 0, 1); DSA_SG();
    DSA_MM(accB, 1, 2); DSA_HS(accA, 0, 2); DSA_SG(); DSA_MM(accB, 1, 3); DSA_HS(accA, 0, 3); DSA_SG();
    sc[(0 + hi) * 4096 + col] = (s0 + s1) + 0.f;
    s0 = 0.f; s1 = 0.f;
    DSA_M0(accA, 2); DSA_HS(accB, 1, 0); DSA_SG(); DSA_MM(accA, 2, 1); DSA_HS(accB, 1, 1); DSA_SG();
    DSA_MM(accA, 2, 2); DSA_HS(accB, 1, 2); DSA_SG(); DSA_MM(accA, 2, 3); DSA_HS(accB, 1, 3); DSA_SG();
    sc[(2 + hi) * 4096 + col] = (s0 + s1) + 0.f;
    s0 = 0.f; s1 = 0.f;
    DSA_M0(accB, 3); DSA_HS(accA, 2, 0); DSA_SG(); DSA_MM(accB, 3, 1); DSA_HS(accA, 2, 1); DSA_SG();
    DSA_MM(accB, 3, 2); DSA_HS(accA, 2, 2); DSA_SG(); DSA_MM(accB, 3, 3); DSA_HS(accA, 2, 3); DSA_SG();
    asm volatile("" :: "v"(bfr[0]), "v"(bfr[1]), "v"(bfr[2]), "v"(bfr[3]));
    sc[(4 + hi) * 4096 + col] = (s0 + s1) + 0.f;
    s0 = 0.f; s1 = 0.f;
    DSA_HS(accB, 3, 0); DSA_HS(accB, 3, 1); DSA_HS(accB, 3, 2); DSA_HS(accB, 3, 3);
    sc[(6 + hi) * 4096 + col] = (s0 + s1) + 0.f;
#undef DSA_M0
}
#define DSA_CNT4(K0, K1, K2, K3) asm volatile( \
    "v_cmp_ge_u32_e64 %[m0], %[k0], %[cd]\n\tv_cmp_ge_u32_e64 %[m1], %[k1], %[cd]\n\tv_cmp_ge_u32_e64 %[m2], %[k2], %[cd]\n\tv_cmp_ge_u32_e64 %[m3], %[k3], %[cd]\n\t" \
    "v_addc_co_u32_e64 %[a0], %[m0], %[a0], 0, %[m0]\n\tv_addc_co_u32_e64 %[a1], %[m1], %[a1], 0, %[m1]\n\t" \
    "v_addc_co_u32_e64 %[a0], %[m2], %[a0], 0, %[m2]\n\tv_addc_co_u32_e64 %[a1], %[m3], %[a1], 0, %[m3]" \
    : [a0] "+v"(c0), [a1] "+v"(c1), [m0] "=&s"(sm0), [m1] "=&s"(sm1), [m2] "=&s"(sm2), [m3] "=&s"(sm3) \
    : [k0] "v"(K0), [k1] "v"(K1), [k2] "v"(K2), [k3] "v"(K3), [cd] "v"(cand))
#define DSA_CNT8(J0) do { DSA_CNT4(key[(J0)], key[(J0) + 1], key[(J0) + 2], key[(J0) + 3]); DSA_CNT4(key[(J0) + 4], key[(J0) + 5], key[(J0) + 6], key[(J0) + 7]); } while (0)

template <int J, int JEND> __device__ __forceinline__ void dsa_emit(const unsigned (&key)[64], unsigned T, unsigned& wlo, unsigned& whi) {
    const unsigned long long m = __ballot(key[J] >= T);
    asm("s_nop 1\n\tv_writelane_b32 %0, %2, %4\n\tv_writelane_b32 %1, %3, %4" : "+v"(wlo), "+v"(whi) : "s"((unsigned)m), "s"((unsigned)(m >> 32)), "n"(J));
    if constexpr (J + 1 < JEND) dsa_emit<J + 1, JEND>(key, T, wlo, whi);
}
__device__ __forceinline__ void unit_dsa_index(const Params& P, int u, char* lds) {
    const int b = u & 3, t0 = (511 - (u >> 2)) * 8;
    const int tid = TIDX(), wid = tid >> 6, lane = tid & 63, r32 = lane & 31, hi = lane >> 5;
    float* sc = (float*)lds;
    const bf16_t* pb = P.p_() + (size_t)b * SEQ * NPAD;
    __syncthreads();
    TPU_START(101); TPU_START(110);
    {
        bf16x8 afr[4][4]; f32x16 wv[4];
        const int qsel = (r32 >> 2) & 1, head = (r32 & 3) + 4 * (r32 >> 3);
        char* qs = lds;
        const int ntile = (t0 + 7) / 32 + 1;
        const bf16_t* kp = P.ikc_() + (size_t)(b * (SEQ / 32)) * 2048 + lane * 8;
        bf16x8 b0[4], b1[4], b2[4];
#define DSA_LDB(dst, K) do { const bf16_t* kq_ = kp + (size_t)(wid + 8 * (K)) * 2048; _Pragma("unroll") for (int kk = 0; kk < 4; ++kk) dst[kk] = *(const bf16x8*)(kq_ + kk * 512); } while (0)
#define DSA_TILE(buf, K) dsa_score_tile(afr, wv, buf, sc, (wid + 8 * (K)) * 32 + r32, hi)
        const int nk = (ntile - wid + 7) >> 3;
        const int kl = nk > 0 ? nk - 1 : 0;
#define DSA_MIN(a) ((a) < kl ? (a) : kl)
        const int tk = tid >> 6, hd = (tid & 63) >> 2, dm = (tid & 3) * 16;
        const bf16_t* qsrc = pb + (size_t)(t0 + tk) * NPAD + C_DIQ + hd * 64 + dm;
        u32x4 qa = *(const u32x4*)qsrc, qb2 = *(const u32x4*)(qsrc + 8);
        f32x4 qcs[4];
#pragma unroll
        for (int i = 0; i < 4; ++i) qcs[i] = *(const f32x4*)(P.rope_() + (size_t)(b * SEQ + t0 + tk) * 48 + 32 + 4 * i);
#pragma unroll
        for (int rt = 0; rt < 4; ++rt) { const float* wp = P.iw_() + (size_t)(b * SEQ + t0 + 2 * rt + hi) * 16;
#pragma unroll
            for (int i = 0; i < 4; ++i) { const f32x4 w4 = *(const f32x4*)(wp + 4 * i); wv[rt][4 * i] = w4[0]; wv[rt][4 * i + 1] = w4[1]; wv[rt][4 * i + 2] = w4[2]; wv[rt][4 * i + 3] = w4[3]; } }
        DSA_LDB(b0, DSA_MIN(0)); DSA_LDB(b1, DSA_MIN(1));
        if (dm == 0) {
            u32x4 ra, rb;
#pragma unroll
            for (int i = 0; i < 4; ++i) { const float c0 = qcs[i][0], s0 = qcs[i][1], c1 = qcs[i][2], s1 = qcs[i][3];
                const float a0 = __uint_as_float(qa[i] << 16), a1 = __uint_as_float(qa[i] & 0xffff0000u), b0_ = __uint_as_float(qb2[i] << 16), b1_ = __uint_as_float(qb2[i] & 0xffff0000u);
                ra[i] = pk2bf(a0 * c0 - b0_ * s0, a1 * c1 - b1_ * s1); rb[i] = pk2bf(b0_ * c0 + a0 * s0, b1_ * c1 + a1 * s1); }
            qa = ra; qb2 = rb; }
        { char* dst = qs + tk * 2432 + hd * 144 + dm * 2; *(u32x4*)dst = qa; *(u32x4*)(dst + 16) = qb2; }
        __syncthreads();
#pragma unroll
        for (int rt = 0; rt < 4; ++rt) { const char* qp = qs + (2 * rt + qsel) * 2432 + head * 144 + hi * 16;
#pragma unroll
            for (int kk = 0; kk < 4; ++kk) afr[rt][kk] = *(const bf16x8*)(qp + kk * 32); }
        asm volatile("s_waitcnt lgkmcnt(0)" ::: "memory"); __syncthreads();
#if TPROBE == 110
        TPU_STOP(110);
#endif
#if TPROBE == 103
        TPU_START(103); asm volatile("s_waitcnt vmcnt(0)" ::: "memory"); TPU_STOP(103);
#endif
#if TPROBE == 104
        asm volatile("s_waitcnt vmcnt(0)" ::: "memory"); TPU_START(104);
#endif
        int k = 0;
        for (; k + 3 <= nk; k += 3) {
            DSA_LDB(b2, k + 2); DSA_TILE(b0, k);
            DSA_LDB(b0, DSA_MIN(k + 3)); DSA_TILE(b1, k + 1);
            DSA_LDB(b1, DSA_MIN(k + 4)); DSA_TILE(b2, k + 2);
        }
        if (k < nk) DSA_TILE(b0, k);
        if (k + 1 < nk) DSA_TILE(b1, k + 1);
#if TPROBE == 104
        asm volatile("s_waitcnt lgkmcnt(0)" ::: "memory"); TPU_STOP(104);
#endif
        TPU_START(111);
#undef DSA_TILE
#undef DSA_MIN
#undef DSA_TILE
#undef DSA_LDB
    }
    __syncthreads();
    TPU_STOP(111);
    TPU_STOP(101); TPU_START(102);
    {
        const int t = t0 + wid; const float* srow = sc + wid * 4096;
        unsigned key[64];
        {
            const int gfull = (t + 1) >> 9, gany = t / 512 + 1;
#pragma unroll
            for (int g = 0; g < 8; ++g) {
                if (g < gfull) {
#pragma unroll
                    for (int jj = 0; jj < 8; ++jj) key[8 * g + jj] = f2key(srow[(8 * g + jj) * 64 + lane]);
                } else if (g < gany) {
#pragma unroll
                    for (int jj = 0; jj < 8; ++jj) { const int s = (8 * g + jj) * 64 + lane; key[8 * g + jj] = (s <= t) ? f2key(srow[s]) : 0u; }
                } else {
#pragma unroll
                    for (int jj = 0; jj < 8; ++jj) key[8 * g + jj] = 0u;
                }
            }
        }
        unsigned long long* mout = P.mask_() + (size_t)(b * SEQ + t) * 64;
        unsigned long long myword = 0ull;
        TPU_START(105); TPU_START(106); TPU_START(107); TPU_START(108); TPU_START(109);
        if (t + 1 <= TOPK) {
#pragma unroll
            for (int j = 0; j < 64; ++j) { const unsigned long long m = __ballot(j * 64 + lane <= t); if (lane == j) myword = m; }
        } else {
            const int ngrp = t / 512 + 1;
#if TPROBE == 105
            asm volatile("" :: "v"(key[0]), "v"(key[63]));
#endif
            TPU_STOP(105);
            unsigned* hist = (unsigned*)(sc + wid * 4096);
            asm volatile("" ::: "memory");
            { const u32x4 zz4 = {0u, 0u, 0u, 0u};
#pragma unroll
              for (int i = 0; i < 16; ++i) *(u32x4*)(hist + (i * 64 + lane) * 4) = zz4; }
            asm volatile("" ::: "memory");
#define DSA_H8(J0) do { _Pragma("unroll") for (int jj = 0; jj < 8; ++jj) atomicAdd(hist + (key[(J0) + jj] >> 20), 1u); } while (0)
            DSA_H8(0);
            if (ngrp > 1) DSA_H8(8);
            if (ngrp > 2) DSA_H8(16);
            if (ngrp > 3) DSA_H8(24);
            if (ngrp > 4) DSA_H8(32);
            if (ngrp > 5) DSA_H8(40);
            if (ngrp > 6) DSA_H8(48);
            if (ngrp > 7) DSA_H8(56);
#undef DSA_H8
            asm volatile("" ::: "memory");
#if TPROBE == 106
            asm volatile("s_waitcnt lgkmcnt(0)" ::: "memory");
#endif
            TPU_STOP(106);
#define DSA_SUFFIX(s) do { _Pragma("unroll") for (int o = 1; o < 64; o <<= 1) { unsigned t_ = (unsigned)__builtin_amdgcn_ds_bpermute(((lane + o) & 63) << 2, (int)(s)); (s) += (lane + o < 64) ? t_ : 0u; } } while (0)
            unsigned mine = 0u;
#pragma unroll
            for (int i = 0; i < 16; ++i) { const u32x4 v4 = *(const u32x4*)(hist + lane * 64 + ((i + lane) & 15) * 4); mine += (v4[0] + v4[1]) + (v4[2] + v4[3]); }
            unsigned suf = mine; DSA_SUFFIX(suf);
            const unsigned long long mL = __ballot(suf - mine < (unsigned)TOPK && suf >= (unsigned)TOPK);
            const int Ls = (int)__builtin_ctzll(mL);
            const unsigned cntA = (unsigned)__builtin_amdgcn_readlane((int)(suf - mine), Ls);
            unsigned h2 = hist[Ls * 64 + lane]; unsigned suf2 = h2; DSA_SUFFIX(suf2);
            const unsigned long long mB = __ballot(cntA + suf2 - h2 < (unsigned)TOPK && cntA + suf2 >= (unsigned)TOPK);
            const int Bs = (int)__builtin_ctzll(mB);
            const unsigned bstar = (unsigned)(Ls * 64 + Bs);
            const unsigned cntAbove = cntA + (unsigned)__builtin_amdgcn_readlane((int)(suf2 - h2), Bs);
            const unsigned inbin = (unsigned)__builtin_amdgcn_readlane((int)h2, Bs);
#undef DSA_SUFFIX
            TPU_STOP(107);
            unsigned T = bstar << 20; int cntT = (int)(cntAbove + inbin);
            if (cntT != TOPK) {
                asm volatile("" ::: "memory");
                int nslot = 0;
#pragma unroll
                for (int g = 0; g < 8; ++g) { if (g < ngrp) {
#pragma unroll
                    for (int jj = 0; jj < 8; ++jj) { const int j = 8 * g + jj; if ((key[j] >> 20) == bstar) { hist[nslot * 64 + lane] = key[j]; ++nslot; } } } }
                asm volatile("" ::: "memory");
                int R = nslot;
#pragma unroll
                for (int o = 32; o >= 1; o >>= 1) { const int other = __builtin_amdgcn_ds_bpermute(((lane ^ o) << 2), R); R = other > R ? other : R; }
                R = __builtin_amdgcn_readfirstlane(R);
                if (R <= 8) {
                    unsigned c[8];
#pragma unroll
                    for (int r = 0; r < 8; ++r) c[r] = (r < nslot) ? hist[r * 64 + lane] : 0u;
                    for (int bit = 19; bit >= 0; --bit) {
                        const unsigned cand = T | (1u << bit); int cnt = (int)cntAbove;
#pragma unroll
                        for (int r = 0; r < 8; ++r) cnt += __popcll(__ballot(c[r] >= cand));
                        if (cnt >= TOPK) { T = cand; cntT = cnt; if (cnt == TOPK) break; }
                    }
                } else {
                    for (int bit = 19; bit >= 0; --bit) {
                        const unsigned cand = T | (1u << bit); unsigned c0 = 0, c1 = 0; unsigned long long sm0, sm1, sm2, sm3;
                        DSA_CNT8(0);
                        if (ngrp > 1) DSA_CNT8(8);
                        if (ngrp > 2) DSA_CNT8(16);
                        if (ngrp > 3) DSA_CNT8(24);
                        if (ngrp > 4) DSA_CNT8(32);
                        if (ngrp > 5) DSA_CNT8(40);
                        if (ngrp > 6) DSA_CNT8(48);
                        if (ngrp > 7) DSA_CNT8(56);
                        const int cl = (int)(c0 + c1);
                        int cnt = 0;
#pragma unroll
                        for (int bb = 0; bb < 7; ++bb) cnt += __popcll(__ballot((cl >> bb) & 1)) << bb;
                        if (cnt >= TOPK) { T = cand; cntT = cnt; if (cnt == TOPK) break; }
                    }
                }
            }
            TPU_STOP(108);
            if (cntT == TOPK) {
                unsigned wlo = 0u, whi = 0u;
                dsa_emit<0, 8>(key, T, wlo, whi);
                if (ngrp > 1) dsa_emit<8, 16>(key, T, wlo, whi);
                if (ngrp > 2) dsa_emit<16, 24>(key, T, wlo, whi);
                if (ngrp > 3) dsa_emit<24, 32>(key, T, wlo, whi);
                if (ngrp > 4) dsa_emit<32, 40>(key, T, wlo, whi);
                if (ngrp > 5) dsa_emit<40, 48>(key, T, wlo, whi);
                if (ngrp > 6) dsa_emit<48, 56>(key, T, wlo, whi);
                if (ngrp > 7) dsa_emit<56, 64>(key, T, wlo, whi);
                myword = ((unsigned long long)whi << 32) | wlo;
            } else {
                int ngt = 0;
#pragma unroll
                for (int j = 0; j < 64; ++j) ngt += __popcll(__ballot(key[j] > T));
                int need = TOPK - ngt;
#pragma unroll
                for (int j = 0; j < 64; ++j) { const unsigned long long eq = __ballot(key[j] == T), gt = __ballot(key[j] > T);
                    const int ne = __popcll(eq); unsigned long long take = eq;
                    if (ne > need) { take = 0ull; int left = need; unsigned long long e2 = eq;
                        while (left > 0) { const unsigned long long lowbit = e2 & (0ull - e2); take |= lowbit; e2 ^= lowbit; --left; } }
                    need -= (ne > need) ? need : ne;
                    const unsigned long long m = gt | take; if (lane == j) myword = m; }
            }
        }
        mout[lane] = myword;
        TPU_STOP(109);
    }
    TPU_STOP(102);
}

struct DsaOutRow { const bf16_t* zb; bf16_t* gb; int wid;
    __device__ __forceinline__ const bf16_t* zrow(int r) const { const int rho = wid * 32 + r; return zb + (size_t)(rho >> 2) * NPAD + (rho & 3) * 128; }
    __device__ __forceinline__ bf16_t* grow(int r) const { const int rho = wid * 32 + r; return gb + (size_t)(rho >> 2) * MIX + (rho & 3) * 128; } };
__device__ __forceinline__ void unit_dsa_attn(const Params& P, int cur_layer, int u, char* lds) {
    const int b = u & 3, qb = 63 - (u >> 2), t0 = qb * 64, tokb = b * SEQ;
    const int wid = TIDX() >> 6, lane = TIDX() & 63, r32 = lane & 31, hi = lane >> 5;
    const int rho = wid * 32 + r32, tq = t0 + (rho >> 2), hq = rho & 3;
    const bf16_t* Qw = P.p_() + (size_t)(tokb + tq) * NPAD + C_DQ + hq * 128 + hi * 8;
    const bf16_t* Kh = P.kvc_() + (size_t)tokb * 256;
    const unsigned moff = (unsigned)(tokb + tq) * 512u;
    DsaOutRow ow; ow.zb = P.p_() + (size_t)(tokb + t0) * NPAD + C_DZ; ow.gb = P.xn_() + (size_t)(tokb + t0) * MIX + 1024; ow.wid = wid;
    const int NT = (qb + 2) & ~1;
    att::attn_body<true, 256, 128, 2, DsaOutRow>(Qw, P.dsa_q_norm + cur_layer * 128, P.rope_() + (size_t)(tokb + tq) * 48, Kh, NT, P.mask_(), moff, ow, lds);
}
__device__ __forceinline__ void phase_gemm_glu(const Params& P, int layer, char* lds) {
    pg8::Gemm g; g.A = P.ybuf_(); g.Bt = P.WgluT_() + (size_t)layer * 512 * 512; g.M = NTOK; g.N = 512; g.K = 512;
    pg8::StaticOrder S; S.init(g.M, g.N, (int)gridDim.x, (int)blockIdx.x);
    pg8::EpiGlu E; E.Y = P.ybuf_(); E.ldy = 512; E.O = P.ocat_(); E.ldo = MIX; E.ooff = 512;
    pg8::gemm_phase<pg8::EpiGlu, pg8::StaticOrder, false>((PG8_LAS unsigned char*)lds, g, S, E, nullptr);
}

constexpr int CTL_Q0 = 4096;
struct OneUnit { int pm, pn; __device__ __forceinline__ bool next(int i, pg8::Unit& u) const { if (i) return false; u.pm = pm; u.pn = pn; return true; }
    __device__ __forceinline__ void a_ready(const pg8::Unit&) const {} __device__ __forceinline__ void done(const pg8::Unit&) const {} };
__device__ __forceinline__ int q_issue(unsigned* ctr) { return (int)__hip_atomic_fetch_add(ctr, 1u, __ATOMIC_RELAXED, __HIP_MEMORY_SCOPE_AGENT); }
#define Q_LOOP_BEGIN(ctr, total)  { unsigned* q_ctr_ = (ctr); const int q_total_ = (total); volatile int* q_b_ = (volatile int*)(lds + LDS_TAIL + 16); \
    for (;;) { __syncthreads(); if (TIDX() == 0) *q_b_ = q_issue(q_ctr_); __syncthreads(); const int item = __builtin_amdgcn_readfirstlane(*q_b_); if (item >= q_total_) break;
#define Q_LOOP_END  } }
__device__ __forceinline__ void unit_glu(const Params& P, int layer, int u, char* lds) {
    pg8::Gemm g; g.A = P.ybuf_(); g.Bt = P.WgluT_() + (size_t)layer * 512 * 512; g.M = NTOK; g.N = 512; g.K = 512;
    OneUnit S; S.pm = u >> 1; S.pn = u & 1;
    pg8::EpiGluGate E; E.Y = P.ybuf_(); E.Pz = P.p_(); E.G = P.xn_();
    pg8::gemm_phase<pg8::EpiGluGate, OneUnit, false>((PG8_LAS unsigned char*)lds, g, S, E, nullptr);
}
constexpr int LDS_TAIL = LDS_BYTES - 64;

__global__ __launch_bounds__(NTHR, 2) void k_mega(Params P) {
    extern __shared__ __attribute__((aligned(16))) char lds[];
    if (TIDX() == 0) *(uint4*)(lds + LDS_TAIL) = make_uint4(0u, 0u, 0u, 0u);
    __syncthreads();
    XcdBarrier bar = xcd_barrier_post(P.ctl_(), (volatile LAS unsigned*)(lds + LDS_TAIL));
    const int G = gridDim.x, B = blockIdx.x;
    phase_prologue1(P, lds); phase_rope_table(P); phase_s5_params(P); phase_rmsnorm_x(P, 0);
    xcd_barrier(bar);
    for (int layer = 0; layer < DEPTH; ++layer) {
        if (layer > 0) { phase_rmsnorm_x(P, layer); xcd_barrier(bar); }
        phase_gemm_in(P, layer, lds);
        if (layer == 0) phase_gemm_kv(P, lds);
        xcd_barrier(bar);
        phase_prep(P, layer);
        if (layer == 0) phase_memk_norm(P);
        for (int u = B; u < 256; u += G) unit_gla_a4(P, layer, u, lds);
        xcd_barrier(bar);
        Q_LOOP_BEGIN(P.ctl_() + CTL_Q0 + 64 * (layer * 2), 128 + 2048 + 256)
            if (item < 128) unit_s5(P, layer, item, lds);
            else if (item < 2176) unit_dsa_index(P, item - 128, lds);
            else gla_scan_slice(P, (item - 2176) * NTHR + TIDX());
        Q_LOOP_END
        xcd_barrier(bar);
        Q_LOOP_BEGIN(P.ctl_() + CTL_Q0 + 64 * (layer * 2 + 1), 256 + 256 + 128 + 256)
            if (item < 256) unit_dsa_attn(P, layer, item, lds);
            else if (item < 512) unit_gla_c4(P, layer, item - 256, lds);
            else if (item < 640) unit_glu(P, layer, item - 512, lds);
            else unit_mem_attn(P, layer, item - 640, lds);
        Q_LOOP_END
        xcd_barrier(bar);
        phase_gemm_out(P, layer, lds);
        xcd_barrier(bar);
    }
}

extern "C" void kernel_launch(void* const* d_in, const int* in_sizes, int n_in, void* d_out, int out_size, void* d_ws, size_t ws_size, hipStream_t stream) {
    if (n_in != 24 || ws_size < WS_END) { fprintf(stderr, "kernel_launch: unexpected n_in %d or ws_size %zu (< %zu)\n", n_in, ws_size, (size_t)WS_END); return; }
    Params P; memset(&P, 0, sizeof(P));
    P.x = (const float*)d_in[0]; P.mem = (const float*)d_in[1]; P.pos = (const int*)d_in[2]; P.ln_gain = (const float*)d_in[3]; P.w_in = (const float*)d_in[4];
    P.gla_w_up = (const float*)d_in[5]; P.gla_b_up = (const float*)d_in[6]; P.s5_a_re = (const float*)d_in[7]; P.s5_a_im = (const float*)d_in[8]; P.s5_log_step = (const float*)d_in[9];
    P.s5_b_re = (const float*)d_in[10]; P.s5_b_im = (const float*)d_in[11]; P.s5_c_re = (const float*)d_in[12]; P.s5_c_im = (const float*)d_in[13]; P.s5_d = (const float*)d_in[14];
    P.s5_w_glu = (const float*)d_in[15]; P.dsa_q_norm = (const float*)d_in[16]; P.dsa_k_norm = (const float*)d_in[17]; P.mem_norm = (const float*)d_in[18]; P.w_mem_kv = (const float*)d_in[19];
    P.mem_q_norm = (const float*)d_in[20]; P.mem_k_norm = (const float*)d_in[21]; P.out_norm = (const float*)d_in[22]; P.w_out = (const float*)d_in[23];
    P.out = (float*)d_out;
    char* ws = (char*)d_ws; P.ws = ws;
    static int grid = 0;
    if (!grid) {
        int dev = 0, cus = 0, per_cu = 0;
        (void)hipGetDevice(&dev); (void)hipDeviceGetAttribute(&cus, hipDeviceAttributeMultiprocessorCount, dev);
        (void)hipFuncSetAttribute((const void*)k_mega, hipFuncAttributeMaxDynamicSharedMemorySize, LDS_BYTES);
        (void)hipOccupancyMaxActiveBlocksPerMultiprocessor(&per_cu, (const void*)k_mega, NTHR, LDS_BYTES);
        if (per_cu < 1) fprintf(stderr, "kernel_launch: occupancy query reports %d blocks per CU\n", per_cu);
        grid = cus > 0 ? cus : 256;
    }
    (void)hipMemsetAsync(ws + WS_CTL, 0, CTL_BYTES, stream);
    hipLaunchKernelGGL(k_mega, dim3(grid), dim3(NTHR), LDS_BYTES, stream, P);
}
```

```cpp
#include <hip/hip_runtime.h>
#include <stdint.h>
#include <stdio.h>
#include <string.h>

constexpr int NB = 4, SEQ = 4096, NTOK = NB * SEQ, DM = 2048, DEPTH = 4, MEML = 256;
constexpr int NIN = 5984, NPAD = 6144, MIX = 2048;
constexpr int C_GQ = 0, C_GK = 256, C_GV = 512, C_GLR = 1024, C_GZ = 1040, C_SU = 1552, C_SZ = 2064, C_DQ = 2576, C_DK = 3088, C_DV = 3216,
              C_DIQ = 3344, C_DIK = 4368, C_DIW = 4432, C_DZ = 4448, C_MQ = 4960, C_MZ = 5472;
constexpr float EPS = 1e-6f;
constexpr int NTHR = 512;
constexpr int LDS_BYTES = 147456;

typedef unsigned short bf16_t;
typedef short bf16x8 __attribute__((ext_vector_type(8)));
typedef short s16x4 __attribute__((ext_vector_type(4)));
typedef float f32x2 __attribute__((ext_vector_type(2)));
typedef float f32x4 __attribute__((ext_vector_type(4)));
typedef float f32x8 __attribute__((ext_vector_type(8)));
typedef float f32x16 __attribute__((ext_vector_type(16)));
typedef unsigned u32x4 __attribute__((ext_vector_type(4)));
typedef unsigned u32x2 __attribute__((ext_vector_type(2)));
#define LAS __attribute__((address_space(3)))

__device__ __forceinline__ float bf2f(bf16_t b) { return __uint_as_float(((unsigned)b) << 16); }
__device__ __forceinline__ unsigned pk2bf(float lo, float hi) { unsigned r; asm("v_cvt_pk_bf16_f32 %0, %1, %2" : "=v"(r) : "v"(lo), "v"(hi)); return r; }
__device__ __forceinline__ bf16_t f2bf(float f) { return (bf16_t)pk2bf(f, f); }
__device__ __forceinline__ float sigmoidf_(float x) { return __builtin_amdgcn_rcpf(1.f + __expf(-x)); }
__device__ __forceinline__ float siluf_(float x) { return x * __builtin_amdgcn_rcpf(1.f + __expf(-x)); }

__device__ __forceinline__ int TIDX() { int t = (int)threadIdx.x; asm volatile("" : "+v"(t)); return t; }
__device__ __forceinline__ float shx(float v, int m) { const int src = ((TIDX() & 63) ^ m) << 2; return __int_as_float(__builtin_amdgcn_ds_bpermute(src, __float_as_int(v))); }
#define WS_DPP_(v, ctrl, rmask, bc) __builtin_bit_cast(float, __builtin_amdgcn_update_dpp(0, __builtin_bit_cast(int, v), (ctrl), (rmask), 0xf, (bc)))
__device__ __forceinline__ float wave_sum(float v) {
    v += WS_DPP_(v, 0x111, 0xf, true); v += WS_DPP_(v, 0x112, 0xf, true); v += WS_DPP_(v, 0x114, 0xf, true); v += WS_DPP_(v, 0x118, 0xf, true);
    v += WS_DPP_(v, 0x142, 0xa, false); v += WS_DPP_(v, 0x143, 0xc, false);
    return __builtin_bit_cast(float, __builtin_amdgcn_readlane(__builtin_bit_cast(int, v), 63));
}
#undef WS_DPP_
__device__ __forceinline__ void ld8f(const bf16_t* p, float (&v)[8]) { const u32x4 w = *(const u32x4*)p;
#pragma unroll
    for (int j = 0; j < 4; ++j) { v[2 * j] = __uint_as_float(w[j] << 16); v[2 * j + 1] = __uint_as_float(w[j] & 0xffff0000u); } }
__device__ __forceinline__ void st8f(bf16_t* p, const float (&v)[8]) { u32x4 w; w.x = pk2bf(v[0], v[1]); w.y = pk2bf(v[2], v[3]); w.z = pk2bf(v[4], v[5]); w.w = pk2bf(v[6], v[7]); *(u32x4*)p = w; }
__device__ __forceinline__ float f2bf_f(float f) { return bf2f(f2bf(f)); }

#ifndef TPROBE
#define TPROBE 0
#endif
#if TPROBE
#define TPU_START(id) do { if (TPROBE == (id) && TIDX() == 0) *(volatile unsigned long long*)(lds + LDS_BYTES - 24) = __builtin_amdgcn_s_memrealtime(); } while (0)
#define TPU_STOP(id) do { if (TPROBE == (id) && TIDX() == 0) *(volatile unsigned long long*)(lds + LDS_BYTES - 32) += __builtin_amdgcn_s_memrealtime() - *(volatile unsigned long long*)(lds + LDS_BYTES - 24); } while (0)
#else
#define TPU_START(id) do {} while (0)
#define TPU_STOP(id) do {} while (0)
#endif
#define XB_TMO      128
#define XB_XCNT(j)  (256  + 64 * (j))
#define XB_XSUB(j)  (1280 + 64 * (j))
#define XB_XGEN(j)  (2304 + 64 * (j))
#define XB_TOP      3328
#define XB_TOPGEN   3392
#define XCD_BAR_WORDS 3456
#define XB_SPIN_CAP (1u << 18)

__device__ __forceinline__ unsigned xb_ld(unsigned* p)              { return __hip_atomic_load(p, __ATOMIC_RELAXED, __HIP_MEMORY_SCOPE_AGENT); }
__device__ __forceinline__ unsigned xb_add(unsigned* p, unsigned v) { return __hip_atomic_fetch_add(p, v, __ATOMIC_RELAXED, __HIP_MEMORY_SCOPE_AGENT); }
__device__ __forceinline__ unsigned xb_xcc_id() { return (unsigned)__builtin_amdgcn_s_getreg((3 << 11) | 20) & 0xFu; }
#define XB_SPIN(cond, bar) do { unsigned _sp = 0; while (cond) { __builtin_amdgcn_s_sleep(1); \
    if ((++_sp & 255u) == 0u) { if (xb_ld(&(bar)[XB_TMO])) break; if (_sp > XB_SPIN_CAP) { atomicAdd(&(bar)[XB_TMO], 1u); break; } } } } while (0)

struct XcdBarrier {
    unsigned* bar; unsigned x;
    volatile LAS unsigned* st;
};

__device__ __forceinline__ XcdBarrier xcd_barrier_post(unsigned* bar, volatile LAS unsigned* st) {
    XcdBarrier b; b.bar = bar; b.x = xb_xcc_id(); b.st = st;
    if (TIDX() == 0) (void)xb_add(&bar[XB_XCNT(b.x)], 1u);
    return b;
}
__device__ __forceinline__ void xcd_barrier_complete(unsigned* bar, unsigned x, unsigned& nloc, unsigned& nx) {
    const unsigned G = gridDim.x * gridDim.y * gridDim.z;
    unsigned sum, cnt, mine, sp = 0u;
    for (;;) {
        sum = 0u; cnt = 0u; mine = 0u;
#pragma unroll
        for (unsigned j = 0; j < 16; ++j) { const unsigned c = xb_ld(&bar[XB_XCNT(j)]); sum += c; cnt += (c > 0u) ? 1u : 0u; mine = (j == x) ? c : mine; }
        if (sum == G) break;
        __builtin_amdgcn_s_sleep(1);
        if ((++sp & 255u) == 0u) { if (xb_ld(&bar[XB_TMO])) break; if (sp > XB_SPIN_CAP) { atomicAdd(&bar[XB_TMO], 1u); break; } }
    }
    nloc = mine > 0u ? mine : 1u; nx = cnt > 0u ? cnt : 1u;
}

__device__ __forceinline__ void xcd_barrier(const XcdBarrier& b) {
    asm volatile("s_waitcnt vmcnt(0)" ::: "memory");
    __syncthreads();
    if (TIDX() == 0) {
        unsigned* bar = b.bar; const unsigned bx = xb_xcc_id();
        __builtin_amdgcn_s_waitcnt(0);
        unsigned nloc = b.st[0], nx = b.st[1];
        if (nloc == 0u) { xcd_barrier_complete(bar, bx, nloc, nx); b.st[0] = nloc; b.st[1] = nx; }
        const unsigned old = xb_add(&bar[XB_XSUB(bx)], 1u);
        const unsigned gen = old / nloc;
        if (old + 1u == (gen + 1u) * nloc) {
            __builtin_amdgcn_fence(__ATOMIC_RELEASE, "agent");
            asm volatile("s_waitcnt vmcnt(0)" ::: "memory");
            const unsigned og = xb_add(&bar[XB_TOP], 1u);
            const unsigned tg = og / nx;
            if (og + 1u == (tg + 1u) * nx) xb_add(&bar[XB_TOPGEN], 1u);
            else XB_SPIN(xb_ld(&bar[XB_TOPGEN]) == tg, bar);
            __builtin_amdgcn_fence(__ATOMIC_ACQUIRE, "agent");
            xb_add(&bar[XB_XGEN(bx)], 1u);
            asm volatile("s_waitcnt vmcnt(0)" ::: "memory");
        } else {
            XB_SPIN(xb_ld(&bar[XB_XGEN(bx)]) == gen, bar);
            __builtin_amdgcn_fence(__ATOMIC_ACQUIRE, "agent");
            asm volatile("s_waitcnt vmcnt(0)" ::: "memory");
        }
    }
    __syncthreads();
}
namespace pg8 {
#define PG8_LAS __attribute__((address_space(3)))
typedef float f32x2 __attribute__((ext_vector_type(2)));
typedef unsigned u32x4 __attribute__((ext_vector_type(4)));
constexpr int BM = 256, BK = 64, HALF = 128, HTB = HALF * BK * 2  , STAGE_BYTES = 8 * HTB, NXCD = 8, WGM = 8;

__host__ __device__ __forceinline__ int lds_byte(int r, int c) { const int st = (r >> 4) * 2 + (c >> 5), rr = r & 15, cc = c & 31, ob = rr * 64 + cc * 2; return st * 1024 + (ob ^ (((ob >> 9) & 1) << 5)); }
__host__ __device__ __forceinline__ void stage_rc(int b, int& R, int& C) { const int st = b / 1024, sb = b % 1024, swz = sb ^ (((sb >> 9) & 1) << 5); R = (st >> 1) * 16 + swz / 64; C = (st & 1) * 32 + (swz % 64) / 2; }
__host__ __device__ __forceinline__ int perm32(int rho) { const int n = rho >> 4, i = rho & 15; return 8 * (i >> 2) + 4 * n + (i & 3); }

struct Unit { int pm, pn; };
struct Gemm { const bf16_t* A; const bf16_t* Bt; int M, N, K; };

struct StaticOrder {
    int nM, nN, nwg, G, c;
    __host__ __device__ void init(int M, int N, int G_, int c_) { nM = M / BM; nN = N / BM; nwg = nM * nN; G = G_; c = c_; }
    __host__ __device__ bool next(int i, Unit& u) const {
        const long L = (long)i * G + c; if (L >= nwg) return false;
        int wgid = (int)L; { const int q = nwg / NXCD, r = nwg % NXCD, xcd = wgid % NXCD, off = wgid / NXCD; wgid = (xcd < r ? xcd * (q + 1) : r * (q + 1) + (xcd - r) * q) + off; }
        const int nig = WGM * nN, gid = wgid / nig, fm = gid * WGM, gsz = (nM - fm) < WGM ? (nM - fm) : WGM;
        u.pm = fm + ((wgid % nig) % gsz); u.pn = (wgid % nig) / gsz; return true;
    }
    __device__ __forceinline__ void a_ready(const Unit&) const {}
    __device__ __forceinline__ void done(const Unit&) const {}
};
__device__ __forceinline__ unsigned cvt_pk_bf16(float lo, float hi) { unsigned r; asm volatile("v_cvt_pk_bf16_f32 %0, %1, %2" : "=v"(r) : "v"(lo), "v"(hi)); return r; }
struct EpiBf16Plain {
    static constexpr bool PERM = true, AFTER_DRAIN = false;
    bf16_t* O; int ldc;
    __device__ __forceinline__ void operator()(const f32x4 (&acc)[2][2][4][2], const Unit& u, int wr, int wc, int fr, int fq) const {
        const int row0 = u.pm * BM + wr * 64 + fr, col0 = u.pn * BM + wc * 32 + 8 * fq;
#pragma unroll
        for (int ai = 0; ai < 2; ++ai)
#pragma unroll
            for (int m = 0; m < 4; ++m) { bf16_t* rowp = O + (size_t)(row0 + ai * HALF + m * 16) * ldc + col0;
#pragma unroll
                for (int bj = 0; bj < 2; ++bj) { const f32x4 v0 = acc[ai][bj][m][0], v1 = acc[ai][bj][m][1];
                    u32x4 w; w.x = cvt_pk_bf16(v0[0], v0[1]); w.y = cvt_pk_bf16(v0[2], v0[3]); w.z = cvt_pk_bf16(v1[0], v1[1]); w.w = cvt_pk_bf16(v1[2], v1[3]);
                    *(u32x4*)(rowp + bj * HALF) = w; } }
    }
};
struct EpiResid {
    static constexpr bool PERM = false, AFTER_DRAIN = false;
    const float* R; float* C; int ldc;
    __device__ __forceinline__ void operator()(const f32x4 (&acc)[2][2][4][2], const Unit& u, int wr, int wc, int fr, int fq) const {
        const int row0 = u.pm * BM + wr * 64 + fr, col0 = u.pn * BM + wc * 32 + 4 * fq;
#pragma unroll
        for (int ai = 0; ai < 2; ++ai)
#pragma unroll
            for (int m = 0; m < 4; ++m) { const size_t off = (size_t)(row0 + ai * HALF + m * 16) * ldc + col0;
#pragma unroll
                for (int bj = 0; bj < 2; ++bj)
#pragma unroll
                    for (int n = 0; n < 2; ++n) { const f32x4 r = *(const f32x4*)(R + off + bj * HALF + n * 16); *(f32x4*)(C + off + bj * HALF + n * 16) = acc[ai][bj][m][n] + r; } }
    }
};
struct EpiResidMix {
    static constexpr bool PERM = true, AFTER_DRAIN = false;
    const void* R; void* C; int ldc; int r16, c16;
    __device__ __forceinline__ void operator()(const f32x4 (&acc)[2][2][4][2], const Unit& u, int wr, int wc, int fr, int fq) const {
        const int row0 = u.pm * BM + wr * 64 + fr, col0 = u.pn * BM + wc * 32 + 8 * fq;
#pragma unroll
        for (int ai = 0; ai < 2; ++ai)
#pragma unroll
            for (int m = 0; m < 4; ++m) { const size_t off = (size_t)(row0 + ai * HALF + m * 16) * ldc + col0;
                f32x4 r0[2], r1[2];
                if (r16) {
#pragma unroll
                    for (int bj = 0; bj < 2; ++bj) { const u32x4 w = *(const u32x4*)((const bf16_t*)R + off + bj * HALF);
                        r0[bj] = f32x4{__uint_as_float(w.x << 16), __uint_as_float(w.x & 0xffff0000u), __uint_as_float(w.y << 16), __uint_as_float(w.y & 0xffff0000u)};
                        r1[bj] = f32x4{__uint_as_float(w.z << 16), __uint_as_float(w.z & 0xffff0000u), __uint_as_float(w.w << 16), __uint_as_float(w.w & 0xffff0000u)}; }
                } else {
#pragma unroll
                    for (int bj = 0; bj < 2; ++bj) { r0[bj] = *(const f32x4*)((const float*)R + off + bj * HALF); r1[bj] = *(const f32x4*)((const float*)R + off + bj * HALF + 4); }
                }
#pragma unroll
                for (int bj = 0; bj < 2; ++bj) { const f32x4 v0 = acc[ai][bj][m][0] + r0[bj], v1 = acc[ai][bj][m][1] + r1[bj];
                    if (c16) { u32x4 w; w.x = cvt_pk_bf16(v0[0], v0[1]); w.y = cvt_pk_bf16(v0[2], v0[3]); w.z = cvt_pk_bf16(v1[0], v1[1]); w.w = cvt_pk_bf16(v1[2], v1[3]);
                        *(u32x4*)((bf16_t*)C + off + bj * HALF) = w; }
                    else { *(f32x4*)((float*)C + off + bj * HALF) = v0; *(f32x4*)((float*)C + off + bj * HALF + 4) = v1; } } }
    }
};
struct EpiGlu {
    static constexpr bool PERM = true, AFTER_DRAIN = false;
    const bf16_t* Y; int ldy; bf16_t* O; int ldo; int ooff;
    __device__ __forceinline__ void operator()(const f32x4 (&acc)[2][2][4][2], const Unit& u, int wr, int wc, int fr, int fq) const {
        const int row0 = u.pm * BM + wr * 64 + fr, col0 = u.pn * BM + wc * 32 + 8 * fq;
#pragma unroll
        for (int ai = 0; ai < 2; ++ai)
#pragma unroll
            for (int m = 0; m < 4; ++m) { const int row = row0 + ai * HALF + m * 16;
#pragma unroll
                for (int bj = 0; bj < 2; ++bj) { const f32x4 v0 = acc[ai][bj][m][0], v1 = acc[ai][bj][m][1];
                    const u32x4 yw = *(const u32x4*)(Y + (size_t)row * ldy + col0 + bj * HALF);
                    float y[8], g[8];
#pragma unroll
                    for (int j = 0; j < 4; ++j) { y[2 * j] = __uint_as_float(yw[j] << 16); y[2 * j + 1] = __uint_as_float(yw[j] & 0xffff0000u); }
#pragma unroll
                    for (int j = 0; j < 4; ++j) { g[j] = __builtin_amdgcn_rcpf(1.f + __expf(-v0[j])); g[4 + j] = __builtin_amdgcn_rcpf(1.f + __expf(-v1[j])); }
                    u32x4 w; w.x = cvt_pk_bf16(y[0] * g[0], y[1] * g[1]); w.y = cvt_pk_bf16(y[2] * g[2], y[3] * g[3]); w.z = cvt_pk_bf16(y[4] * g[4], y[5] * g[5]); w.w = cvt_pk_bf16(y[6] * g[6], y[7] * g[7]);
                    *(u32x4*)(O + (size_t)row * ldo + ooff + col0 + bj * HALF) = w; } }
    }
};
struct EpiGluGate {
    static constexpr bool PERM = true, AFTER_DRAIN = true;
    const bf16_t* Y; const bf16_t* Pz; bf16_t* G;
    __device__ __forceinline__ void fused(const f32x4 (&acc)[2][2][4][2], const Unit& u, int wr, int wc, int fr, int fq, PG8_LAS unsigned char* lds, int wid, int lane) const {
        constexpr int TS = 528;
        TPU_START(130);
        const int row0 = wr * 64 + fr, col0 = wc * 32 + 8 * fq;
#pragma unroll
        for (int ai = 0; ai < 2; ++ai)
#pragma unroll
            for (int m = 0; m < 4; ++m) { const int rl = row0 + ai * HALF + m * 16; const size_t grow = (size_t)u.pm * BM + rl;
#pragma unroll
                for (int bj = 0; bj < 2; ++bj) { const f32x4 v0 = acc[ai][bj][m][0], v1 = acc[ai][bj][m][1];
                    const u32x4 yw = *(const u32x4*)(Y + grow * 512 + u.pn * BM + col0 + bj * HALF);
                    float y[8], g[8];
#pragma unroll
                    for (int j = 0; j < 4; ++j) { y[2 * j] = __uint_as_float(yw[j] << 16); y[2 * j + 1] = __uint_as_float(yw[j] & 0xffff0000u); }
#pragma unroll
                    for (int j = 0; j < 4; ++j) { g[j] = __builtin_amdgcn_rcpf(1.f + __expf(-v0[j])); g[4 + j] = __builtin_amdgcn_rcpf(1.f + __expf(-v1[j])); }
                    u32x4 w; w.x = cvt_pk_bf16(y[0] * g[0], y[1] * g[1]); w.y = cvt_pk_bf16(y[2] * g[2], y[3] * g[3]); w.z = cvt_pk_bf16(y[4] * g[4], y[5] * g[5]); w.w = cvt_pk_bf16(y[6] * g[6], y[7] * g[7]);
                    *(PG8_LAS u32x4*)(lds + rl * TS + (col0 + bj * HALF) * 2) = w; } }
        u32x4 zr[16];
#pragma unroll
        for (int i = 0; i < 16; ++i) { const size_t grow = (size_t)u.pm * BM + wid * 32 + 2 * i + (lane >> 5);
            zr[i] = *(const u32x4*)(Pz + grow * 6144 + 2064 + u.pn * BM + 8 * (lane & 31)); }
        __syncthreads();
        { const int t = wid * 64 + lane, row = t >> 1, hd = t & 1; const PG8_LAS unsigned char* src = lds + row * TS + hd * 256;
          float ss = 0.f;
#pragma unroll
          for (int i = 0; i < 16; ++i) { const u32x4 w = *(const PG8_LAS u32x4*)(src + 16 * i);
#pragma unroll
              for (int j = 0; j < 4; ++j) { const float a = __uint_as_float(w[j] << 16), b = __uint_as_float(w[j] & 0xffff0000u); ss += a * a + b * b; } }
          *(PG8_LAS float*)(lds + row * TS + 512 + hd * 4) = rsqrtf(ss * (1.f / 128.f) + 1e-6f); }
        asm volatile("s_waitcnt lgkmcnt(0)" ::: "memory");
#pragma unroll
        for (int i = 0; i < 16; ++i) { const int row = wid * 32 + 2 * i + (lane >> 5), c8 = 8 * (lane & 31);
            const u32x4 w = *(const PG8_LAS u32x4*)(lds + row * TS + c8 * 2); const float rn = *(const PG8_LAS float*)(lds + row * TS + 512 + (c8 >> 7) * 4);
            const u32x4 zw = zr[i]; u32x4 o;
#pragma unroll
            for (int j = 0; j < 4; ++j) { const float a = __uint_as_float(w[j] << 16), b = __uint_as_float(w[j] & 0xffff0000u), za = __uint_as_float(zw[j] << 16), zb = __uint_as_float(zw[j] & 0xffff0000u);
                o[j] = cvt_pk_bf16(a * rn * (za * __builtin_amdgcn_rcpf(1.f + __expf(-za))), b * rn * (zb * __builtin_amdgcn_rcpf(1.f + __expf(-zb)))); }
            *(u32x4*)(G + ((size_t)u.pm * BM + row) * 2048 + 512 + u.pn * BM + c8) = o; }
        __syncthreads();
        TPU_STOP(130);
    }
};
struct EpiBf16Scale {
    static constexpr bool PERM = true, AFTER_DRAIN = false;
    bf16_t* O; int ldc; const float* ssq;
    __device__ __forceinline__ void operator()(const f32x4 (&acc)[2][2][4][2], const Unit& u, int wr, int wc, int fr, int fq) const {
        const int row0 = u.pm * BM + wr * 64 + fr, col0 = u.pn * BM + wc * 32 + 8 * fq;
#pragma unroll
        for (int ai = 0; ai < 2; ++ai)
#pragma unroll
            for (int m = 0; m < 4; ++m) { const int row = row0 + ai * HALF + m * 16; bf16_t* rowp = O + (size_t)row * ldc + col0;
                float ssum = 0.f; { const f32x4* sp_ = (const f32x4*)(ssq + (size_t)row * 32);
#pragma unroll
                    for (int q = 0; q < 8; ++q) { const f32x4 t4 = sp_[q]; ssum += (t4[0] + t4[1]) + (t4[2] + t4[3]); } }
                const float s = rsqrtf(ssum * (1.f / 2048.f) + 1e-6f);
#pragma unroll
                for (int bj = 0; bj < 2; ++bj) { const f32x4 v0 = acc[ai][bj][m][0] * s, v1 = acc[ai][bj][m][1] * s;
                    u32x4 w; w.x = cvt_pk_bf16(v0[0], v0[1]); w.y = cvt_pk_bf16(v0[2], v0[3]); w.z = cvt_pk_bf16(v1[0], v1[1]); w.w = cvt_pk_bf16(v1[2], v1[3]);
                    *(u32x4*)(rowp + bj * HALF) = w; } }
    }
};
struct EpiResidNext {
    static constexpr bool PERM = false, AFTER_DRAIN = false;
    const float* R; float* C; int ldc; bf16_t* XB; float* ssq;
    __device__ __forceinline__ void operator()(const f32x4 (&acc)[2][2][4][2], const Unit& u, int wr, int wc, int fr, int fq) const {
        const int row0 = u.pm * BM + wr * 64 + fr, col0 = u.pn * BM + wc * 32 + 4 * fq;
#pragma unroll
        for (int ai = 0; ai < 2; ++ai)
#pragma unroll
            for (int m = 0; m < 4; ++m) { const int row = row0 + ai * HALF + m * 16; const size_t off = (size_t)row * ldc + col0; float ss = 0.f;
#pragma unroll
                for (int bj = 0; bj < 2; ++bj)
#pragma unroll
                    for (int n = 0; n < 2; ++n) { const f32x4 r = *(const f32x4*)(R + off + bj * HALF + n * 16); const f32x4 v = acc[ai][bj][m][n] + r;
                        *(f32x4*)(C + off + bj * HALF + n * 16) = v;
                        if (XB) { u32x2 w; w.x = cvt_pk_bf16(v[0], v[1]); w.y = cvt_pk_bf16(v[2], v[3]); *(u32x2*)(XB + off + bj * HALF + n * 16) = w; }
                        ss += v[0] * v[0] + v[1] * v[1] + v[2] * v[2] + v[3] * v[3]; }
                if (ssq) { ss += shx(ss, 16); ss += shx(ss, 32); if (fq == 0) ssq[(size_t)row * 32 + u.pn * 4 + wc] = ss; } }
    }
};
template <class Epi, class Sched, bool STAMP = false>
__device__ __forceinline__ void gemm_phase(PG8_LAS unsigned char* lds, const Gemm g, const Sched& S, const Epi& E, unsigned long long* stamps) {
    const int tid = TIDX(), wid = __builtin_amdgcn_readfirstlane(tid >> 6), lane = tid & 63, wr = wid >> 2, wc = wid & 3, fr = lane & 15, fq = lane >> 4;
    const int K = g.K, nt = K / BK;
    int ts_lo = 0, ts_hi = 0, nts = 0; const unsigned long long rt_entry = STAMP ? (unsigned long long)wall_clock64() : 0ull;
#define PG8_STAMP() do { if (STAMP && wid == 0 && nts < 64) { const unsigned long long _c = (unsigned long long)clock64(); \
        ts_lo = (lane == nts) ? (int)(unsigned)_c : ts_lo; ts_hi = (lane == nts) ? (int)(unsigned)(_c >> 32) : ts_hi; ++nts; } } while (0)
    PG8_STAMP();
    unsigned voffA[2], voffB[2];
#pragma unroll
    for (int i = 0; i < 2; ++i) { int R, C; stage_rc(tid * 16 + i * 8192, R, C); const int Rb = Epi::PERM ? ((R & ~31) + perm32(R & 31)) : R;
        voffA[i] = (unsigned)(R * K + C) * 2u; voffB[i] = (unsigned)(Rb * K + C) * 2u; }
    const size_t kstep = (size_t)(BK * 2);
    const size_t hstep = (size_t)HALF * K * 2;
    const size_t tstep = 2 * hstep;
    const unsigned ldsw = (unsigned)wid * 1024u;
    const int aoff = lds_byte(wr * 64 + fr, fq * 8), boff = lds_byte(wc * 32 + fr, fq * 8);
#define PG8_SA(b, h) (((b) * 2 + (h)) * HTB)
#define PG8_SB(b, h) ((4 + (b) * 2 + (h)) * HTB)
#define PG8_STAGE(bufoff, gbase, voff) do { _Pragma("unroll") for (int _i = 0; _i < 2; ++_i) \
        __builtin_amdgcn_global_load_lds((const unsigned*)((const char*)(gbase) + (voff)[_i]), (PG8_LAS unsigned*)(lds + (bufoff) + ldsw + _i * 8192), 16, 0, 0); } while (0)
#define PG8_LDA(dst, b, h) do { _Pragma("unroll") for (int m = 0; m < 4; ++m) _Pragma("unroll") for (int k = 0; k < 2; ++k) dst[m][k] = *(const PG8_LAS bf16x8*)(lds + PG8_SA(b, h) + aoff + m * 2048 + k * 1024); } while (0)
#define PG8_LDB(dst, b, h) do { _Pragma("unroll") for (int n = 0; n < 2; ++n) _Pragma("unroll") for (int k = 0; k < 2; ++k) dst[n][k] = *(const PG8_LAS bf16x8*)(lds + PG8_SB(b, h) + boff + n * 2048 + k * 1024); } while (0)
#define PG8_MMA(ai, bj, At, Bt) do { __builtin_amdgcn_s_setprio(1); _Pragma("unroll") for (int m = 0; m < 4; ++m) _Pragma("unroll") for (int n = 0; n < 2; ++n) _Pragma("unroll") for (int k = 0; k < 2; ++k) \
        acc[ai][bj][m][n] = __builtin_amdgcn_mfma_f32_16x16x32_bf16(Bt[n][k], At[m][k], acc[ai][bj][m][n], 0, 0, 0); __builtin_amdgcn_s_setprio(0); } while (0)
#define PG8_WAIT_V(n) asm volatile("s_waitcnt vmcnt(" #n ")" ::: "memory")
#define PG8_WAIT_L(n) asm volatile("s_waitcnt lgkmcnt(" #n ")" ::: "memory")
#define PG8_BAR __builtin_amdgcn_s_barrier()
#define PG8_SCHED __builtin_amdgcn_sched_barrier(0)
    Unit cur, nxt; int ui = 0;
    if (!S.next(0, cur)) return;
    f32x4 acc[2][2][4][2];
#pragma unroll
    for (int a = 0; a < 2; ++a)
#pragma unroll
        for (int b = 0; b < 2; ++b)
#pragma unroll
            for (int m = 0; m < 4; ++m)
#pragma unroll
                for (int n = 0; n < 2; ++n) acc[a][b][m][n] = (f32x4){0.f, 0.f, 0.f, 0.f};
    bf16x8 At[4][2], B0[2][2], B1[2][2];
    const char* cA = (const char*)g.A + (size_t)cur.pm * tstep; const char* cB = (const char*)g.Bt + (size_t)cur.pn * tstep;
    S.a_ready(cur);
    PG8_STAGE(PG8_SB(0, 0), cB, voffB); PG8_STAGE(PG8_SA(0, 0), cA, voffA); PG8_STAGE(PG8_SB(0, 1), cB + hstep, voffB); PG8_STAGE(PG8_SA(0, 1), cA + hstep, voffA);
    if (wr == 1) PG8_BAR;
    PG8_WAIT_V(4); PG8_BAR;
    PG8_STAGE(PG8_SB(1, 0), cB + kstep, voffB); PG8_STAGE(PG8_SA(1, 0), cA + kstep, voffA); PG8_STAGE(PG8_SB(1, 1), cB + hstep + kstep, voffB);
    PG8_WAIT_V(6); PG8_BAR;
    PG8_STAMP();
    for (;;) {
        const bool has_next = S.next(ui + 1, nxt);
        const char* nA = has_next ? (const char*)g.A + (size_t)nxt.pm * tstep : cA; const char* nB = has_next ? (const char*)g.Bt + (size_t)nxt.pn * tstep : cB;
        for (int t = 0; t < nt; t += 2) {
            const bool last = (t == nt - 2);
            const char* a1 = cA + (size_t)(t + 1) * kstep;
            const char* a2 = last ? nA : cA + (size_t)(t + 2) * kstep; const char* b2 = last ? nB : cB + (size_t)(t + 2) * kstep;
            const char* a3 = a2 + kstep; const char* b3 = b2 + kstep;
            if (last && has_next) S.a_ready(nxt);
            PG8_LDB(B0, 0, 0); PG8_SCHED; PG8_LDA(At, 0, 0); PG8_STAGE(PG8_SA(1, 1), a1 + hstep, voffA);
            PG8_WAIT_L(8); PG8_BAR; PG8_WAIT_L(0); PG8_MMA(0, 0, At, B0); PG8_BAR; PG8_SCHED;
            PG8_LDB(B1, 0, 1); PG8_STAGE(PG8_SB(0, 0), b2, voffB);
            PG8_BAR; PG8_WAIT_L(0); PG8_MMA(0, 1, At, B1); PG8_BAR;
            PG8_LDA(At, 0, 1); PG8_STAGE(PG8_SA(0, 0), a2, voffA);
            PG8_BAR; PG8_WAIT_L(0); PG8_MMA(1, 0, At, B0); PG8_BAR; PG8_SCHED;
            PG8_STAGE(PG8_SB(0, 1), b2 + hstep, voffB);
            PG8_WAIT_V(6); PG8_BAR; PG8_MMA(1, 1, At, B1); PG8_BAR;
            PG8_LDB(B0, 1, 0); PG8_SCHED; PG8_LDA(At, 1, 0); PG8_STAGE(PG8_SA(0, 1), a2 + hstep, voffA);
            PG8_WAIT_L(8); PG8_BAR; PG8_WAIT_L(0); PG8_MMA(0, 0, At, B0); PG8_BAR; PG8_SCHED;
            PG8_LDB(B1, 1, 1); PG8_STAGE(PG8_SB(1, 0), b3, voffB);
            PG8_BAR; PG8_WAIT_L(0); PG8_MMA(0, 1, At, B1); PG8_BAR;
            PG8_LDA(At, 1, 1); PG8_STAGE(PG8_SA(1, 0), a3, voffA);
            PG8_BAR; PG8_WAIT_L(0); PG8_MMA(1, 0, At, B0); PG8_BAR; PG8_SCHED;
            PG8_STAGE(PG8_SB(1, 1), b3 + hstep, voffB);
            PG8_WAIT_V(6); PG8_BAR; PG8_MMA(1, 1, At, B1); PG8_BAR;
        }
        PG8_STAMP();
        if constexpr (!Epi::AFTER_DRAIN) { E(acc, cur, wr, wc, fr, fq); S.done(cur); }
        PG8_STAMP();
        if (!has_next) break;
#pragma unroll
        for (int a = 0; a < 2; ++a)
#pragma unroll
            for (int b = 0; b < 2; ++b)
#pragma unroll
                for (int m = 0; m < 4; ++m)
#pragma unroll
                    for (int n = 0; n < 2; ++n) acc[a][b][m][n] = (f32x4){0.f, 0.f, 0.f, 0.f};
        cur = nxt; cA = nA; cB = nB; ++ui;
    }
    PG8_WAIT_V(0);
    if (wr == 0) PG8_BAR;
    PG8_BAR;
    if constexpr (Epi::AFTER_DRAIN) { E.fused(acc, cur, wr, wc, fr, fq, lds, wid, lane); S.done(cur); }
    PG8_STAMP();
    if (STAMP && wid == 0) { stamps[lane] = lane < nts ? (((unsigned long long)(unsigned)ts_hi << 32) | (unsigned)ts_lo) : 0ull;
        if (lane == 62) stamps[62] = rt_entry; if (lane == 63) stamps[63] = (unsigned long long)wall_clock64(); }
#undef PG8_STAMP
#undef PG8_SA
#undef PG8_SB
#undef PG8_STAGE
#undef PG8_LDA
#undef PG8_LDB
#undef PG8_MMA
#undef PG8_WAIT_V
#undef PG8_WAIT_L
#undef PG8_BAR
#undef PG8_SCHED
}
}
namespace att {
constexpr int D = 128, NW = 8, QBLK = 32, KVBLK = 64;
constexpr float SCALE = 0.088388347648318440f, THR = 8.f;
constexpr int SHM_V = KVBLK * D * 2, SHM_K = KVBLK * D * 2, SHM_ATTN = 2 * SHM_V + 2 * SHM_K + NW * 64 * 4;
#define KSWZ(row, colB) ((row) * 256 + ((colB) ^ (((row) & 7) << 4)))
#define SBAR() __builtin_amdgcn_sched_barrier(0)
__device__ __forceinline__ int crow(int r, int hi) { return (r & 3) + 8 * (r >> 2) + 4 * hi; }
__device__ __forceinline__ unsigned cvtpk(float lo, float hi) { unsigned r; asm volatile("v_cvt_pk_bf16_f32 %0, %1, %2" : "=v"(r) : "v"(lo), "v"(hi)); return r; }

template <bool MASKED>
__device__ __forceinline__ void partialSM(f32x16& p0, f32x16& p1, float& m_reg, float& mn, float& alpha, unsigned long long mw, int hi) {
  constexpr float C = SCALE * 1.4426950408889634f;
  float pmax = p0[0];
#pragma unroll
  for (int r = 1; r < 16; ++r) pmax = fmaxf(pmax, p0[r]);
#pragma unroll
  for (int r = 0; r < 16; ++r) pmax = fmaxf(pmax, p1[r]);
  { auto rr = __builtin_amdgcn_permlane32_swap(__float_as_uint(pmax), __float_as_uint(pmax), false, false);
    pmax = fmaxf(__uint_as_float(rr[0]), __uint_as_float(rr[1])); }
  if (__builtin_expect(__all(pmax - m_reg <= THR / SCALE), 1)) { mn = m_reg; alpha = 1.f; }
  else { mn = fmaxf(m_reg, pmax); alpha = __builtin_amdgcn_exp2f((m_reg - mn) * C); m_reg = mn; }
  const float mnC = -mn * C;
#pragma unroll
  for (int r = 0; r < 16; ++r) p0[r] = fmaf(p0[r], C, mnC);
#pragma unroll
  for (int r = 0; r < 16; ++r) p1[r] = fmaf(p1[r], C, mnC);
#pragma unroll
  for (int r = 0; r < 16; ++r) p0[r] = __builtin_amdgcn_exp2f(p0[r]);
}
__device__ __forceinline__ void finishSM(f32x16& p0, f32x16& p1, float alpha, float& l_reg, bf16x8& pa0, bf16x8& pa1, bf16x8& pa2, bf16x8& pa3) {
#pragma unroll
  for (int r = 0; r < 16; ++r) p1[r] = __builtin_amdgcn_exp2f(p1[r]);
  float ps = 0;
#pragma unroll
  for (int r = 0; r < 16; ++r) ps += p0[r];
#pragma unroll
  for (int r = 0; r < 16; ++r) ps += p1[r];
  { auto rr = __builtin_amdgcn_permlane32_swap(__float_as_uint(ps), __float_as_uint(ps), false, false);
    ps = __uint_as_float(rr[0]) + __uint_as_float(rr[1]); }
  l_reg = l_reg * alpha + ps;
#define PK4(P, BASE, OUT) do { unsigned a0 = cvtpk(P[BASE + 0], P[BASE + 1]), a1 = cvtpk(P[BASE + 2], P[BASE + 3]);   \
    unsigned b0 = cvtpk(P[BASE + 4], P[BASE + 5]), b1 = cvtpk(P[BASE + 6], P[BASE + 7]);                              \
    auto r0 = __builtin_amdgcn_permlane32_swap(a0, b0, false, false); auto r1 = __builtin_amdgcn_permlane32_swap(a1, b1, false, false); \
    u32x4 w = {r0[0], r1[0], r0[1], r1[1]}; OUT = *reinterpret_cast<bf16x8*>(&w); } while (0)
  PK4(p0, 0, pa0); PK4(p0, 8, pa1); PK4(p1, 0, pa2); PK4(p1, 8, pa3);
#undef PK4
}
template <int R> __device__ __forceinline__ float mask_bias(unsigned nw) {
  unsigned t; constexpr int bit = (R & 3) + 8 * (R >> 2);
  asm("v_bfe_i32 %0, %1, %2, 1\n\tv_and_b32 %0, 0xff800000, %0" : "=v"(t) : "v"(nw), "n"(bit));
  return __uint_as_float(t);
}
template <bool MASKED>
__device__ __forceinline__ void qkt(f32x16& p0, f32x16& p1, const char* Ks, const bf16x8* qr, int r32, int hi, unsigned long long mw) {
  if (MASKED) {
    const unsigned n0 = ~((unsigned)mw >> (4 * hi)), n1 = ~((unsigned)(mw >> 32) >> (4 * hi));
#define MB_(R) p0[R] = mask_bias<R>(n0); p1[R] = mask_bias<R>(n1);
    MB_(0) MB_(1) MB_(2) MB_(3) MB_(4) MB_(5) MB_(6) MB_(7) MB_(8) MB_(9) MB_(10) MB_(11) MB_(12) MB_(13) MB_(14) MB_(15)
#undef MB_
  } else { p0 = f32x16{}; p1 = f32x16{}; }
  asm volatile("" : "+v"(p0), "+v"(p1));
#pragma unroll
  for (int d0 = 0; d0 < 8; ++d0) { const int cb = (d0 * 16 + hi * 8) * 2;
    bf16x8 b0 = *reinterpret_cast<const bf16x8*>(Ks + KSWZ(r32, cb));
    bf16x8 b1 = *reinterpret_cast<const bf16x8*>(Ks + KSWZ(32 + r32, cb));
    p0 = __builtin_amdgcn_mfma_f32_32x32x16_bf16(b0, qr[d0], p0, 0, 0, 0);
    p1 = __builtin_amdgcn_mfma_f32_32x32x16_bf16(b1, qr[d0], p1, 0, 0, 0); }
}
__device__ __forceinline__ int v_st(int k, int c) { const int kk = (k & ~0xC) | ((k & 4) << 1) | ((k & 8) >> 1); return ((kk >> 3) * 4 + (c >> 5)) * 512 + ((kk & 7) * 32 + (c & 31)) * 2; }
__device__ __forceinline__ int v_rd_base(int lane) { return ((lane & 3) << 3) | (((lane >> 2) & 3) << 6) | (((lane >> 4) & 1) << 5) | (((lane >> 5) & 1) << 8); }
constexpr int v_rd_off(int d0, int ks, int half) { return d0 * 512 + ks * 4096 + half * 2048; }
template <int OFF> __device__ __forceinline__ s16x4 tr_read(int vb) {
  s16x4 r; asm volatile("ds_read_b64_tr_b16 %0, %1 offset:%2" : "=&v"(r) : "v"(vb), "i"(OFF) : "memory"); return r;
}
template <int D0> __device__ __forceinline__ void pv_one(f32x16& od, int vb, bf16x8 pa0, bf16x8 pa1, bf16x8 pa2, bf16x8 pa3) {
  const s16x4 l0 = tr_read<v_rd_off(D0, 0, 0)>(vb), h0 = tr_read<v_rd_off(D0, 0, 1)>(vb), l1 = tr_read<v_rd_off(D0, 1, 0)>(vb), h1 = tr_read<v_rd_off(D0, 1, 1)>(vb);
  const s16x4 l2 = tr_read<v_rd_off(D0, 2, 0)>(vb), h2 = tr_read<v_rd_off(D0, 2, 1)>(vb), l3 = tr_read<v_rd_off(D0, 3, 0)>(vb), h3 = tr_read<v_rd_off(D0, 3, 1)>(vb);
  asm volatile("s_waitcnt lgkmcnt(0)" ::: "memory"); SBAR();
#define PK(L, H) (bf16x8){L[0], L[1], L[2], L[3], H[0], H[1], H[2], H[3]}
  od = __builtin_amdgcn_mfma_f32_32x32x16_bf16(pa0, PK(l0, h0), od, 0, 0, 0);
  od = __builtin_amdgcn_mfma_f32_32x32x16_bf16(pa1, PK(l1, h1), od, 0, 0, 0);
  od = __builtin_amdgcn_mfma_f32_32x32x16_bf16(pa2, PK(l2, h2), od, 0, 0, 0);
  od = __builtin_amdgcn_mfma_f32_32x32x16_bf16(pa3, PK(l3, h3), od, 0, 0, 0);
#undef PK
}
__device__ __forceinline__ void pv_d0(f32x16* o, int vb, bf16x8 pa0, bf16x8 pa1, bf16x8 pa2, bf16x8 pa3) {
  pv_one<0>(o[0], vb, pa0, pa1, pa2, pa3); pv_one<1>(o[1], vb, pa0, pa1, pa2, pa3); pv_one<2>(o[2], vb, pa0, pa1, pa2, pa3); pv_one<3>(o[3], vb, pa0, pa1, pa2, pa3);
}

template <bool MASKED, int LDK, int VOFF, int QT, class OutRow>
__device__ __forceinline__ void attn_body(const bf16_t* __restrict__ Qw, const float* __restrict__ qgain, const float* __restrict__ qcs, const bf16_t* __restrict__ Kh, int NT,
                                          const unsigned long long* __restrict__ mbase, unsigned moff, const OutRow& Ow, char* lds) {
  const int tid = TIDX(), wid = tid >> 6, lane = tid & 63, r32 = lane & 31, hi = lane >> 5;
  char* V_lds = lds; char* K_lds = lds + 2 * SHM_V;
  float* ws = (float*)(lds + 2 * SHM_V + 2 * SHM_K) + wid * 64; float* li_l = ws; float* al_l = ws + 32;
  float m_reg = -1e30f, l_reg = 0; f32x16 o[4] = {}; bf16x8 qr[8];
  asm volatile("" : "+v"(o[0]), "+v"(o[1]), "+v"(o[2]), "+v"(o[3]));
#pragma unroll
  for (int d0 = 0; d0 < 8; ++d0) qr[d0] = *reinterpret_cast<const bf16x8*>(Qw + d0 * 16);
  const int sr = tid >> 4, sc = (tid & 15) * 8, vst0 = v_st(sr, sc), vst1 = v_st(32 + sr, sc);
  const int vb0 = (int)(uintptr_t)V_lds + v_rd_base(lane);
  struct { bf16x8 vs0, vs1, ks0, ks1; } sr_[2];
  const unsigned koff = (unsigned)(sr * LDK + sc) * 2u;
#define SLOAD(i, k0) do { const char* kb_ = (const char*)Kh + (size_t)(k0) * (LDK * 2); \
    sr_[i].vs0 = *reinterpret_cast<const bf16x8*>(kb_ + koff + VOFF * 2); sr_[i].vs1 = *reinterpret_cast<const bf16x8*>(kb_ + koff + (32 * LDK + VOFF) * 2); \
    sr_[i].ks0 = *reinterpret_cast<const bf16x8*>(kb_ + koff); sr_[i].ks1 = *reinterpret_cast<const bf16x8*>(kb_ + koff + 32 * LDK * 2); } while (0)
#define SWRITE(b, i) do { *(bf16x8*)(V_lds + (b) * SHM_V + vst0) = sr_[i].vs0;          \
    *(bf16x8*)(V_lds + (b) * SHM_V + vst1) = sr_[i].vs1; int kc = sc * 2;               \
    *(bf16x8*)(K_lds + (b) * SHM_K + KSWZ(sr, kc)) = sr_[i].ks0;                       \
    *(bf16x8*)(K_lds + (b) * SHM_K + KSWZ(32 + sr, kc)) = sr_[i].ks1; } while (0)
#define SWAIT() asm volatile("s_waitcnt vmcnt(4)" ::: "memory")
#define RESC(a) do { if (__any((a) < 1.f)) { if (hi == 0) al_l[r32] = (a); asm volatile("s_waitcnt lgkmcnt(0)" ::: "memory"); \
    _Pragma("unroll") for (int d = 0; d < 4; ++d) _Pragma("unroll") for (int r = 0; r < 16; ++r) o[d][r] *= al_l[crow(r, hi)]; } } while (0)
  f32x16 pA0, pA1, pB0, pB1; float mnA, mnB, alA, alB; bf16x8 pa0, pa1, pa2, pa3;
  unsigned long long mw = 0ull;
  constexpr int SE = 0, SO = 1;
  if (!MASKED) { SLOAD(SE, 0); SLOAD(SO, KVBLK); }
  if (QT) {
    float ss = 0.f;
#pragma unroll
    for (int d0 = 0; d0 < 8; ++d0)
#pragma unroll
      for (int j = 0; j < 8; ++j) { const float x = bf2f((bf16_t)qr[d0][j]); ss += x * x; }
    { auto rr = __builtin_amdgcn_permlane32_swap(__float_as_uint(ss), __float_as_uint(ss), false, false); ss = __uint_as_float(rr[0]) + __uint_as_float(rr[1]); }
    const float rn = rsqrtf(ss * (1.f / 128.f) + EPS);
    float x01[2][8];
#pragma unroll
    for (int d0 = 0; d0 < 8; ++d0) { const f32x4 g0 = *(const f32x4*)(qgain + d0 * 16 + hi * 8), g1 = *(const f32x4*)(qgain + d0 * 16 + hi * 8 + 4);
      float x[8];
#pragma unroll
      for (int j = 0; j < 8; ++j) x[j] = bf2f((bf16_t)qr[d0][j]) * rn * (j < 4 ? g0[j] : g1[j - 4]);
      if (QT == 2 && d0 < 2) {
#pragma unroll
        for (int j = 0; j < 8; ++j) x01[d0][j] = x[j];
      } else { u32x4 w = {cvtpk(x[0], x[1]), cvtpk(x[2], x[3]), cvtpk(x[4], x[5]), cvtpk(x[6], x[7])}; qr[d0] = *reinterpret_cast<bf16x8*>(&w); } }
    if (QT == 2) {
      float a[8], b[8];
#pragma unroll
      for (int j2 = 0; j2 < 4; ++j2) { const f32x4 cs = *(const f32x4*)(qcs + hi * 16 + 4 * j2);
#pragma unroll
        for (int q = 0; q < 2; ++q) { const int j = 2 * j2 + q; const float c = cs[2 * q], sn = cs[2 * q + 1], x1 = x01[0][j], x2 = x01[1][j]; a[j] = x1 * c - x2 * sn; b[j] = x2 * c + x1 * sn; } }
      { u32x4 w = {cvtpk(a[0], a[1]), cvtpk(a[2], a[3]), cvtpk(a[4], a[5]), cvtpk(a[6], a[7])}; qr[0] = *reinterpret_cast<bf16x8*>(&w); }
      { u32x4 w = {cvtpk(b[0], b[1]), cvtpk(b[2], b[3]), cvtpk(b[4], b[5]), cvtpk(b[6], b[7])}; qr[1] = *reinterpret_cast<bf16x8*>(&w); }
    }
  }
  if (MASKED) { mw = *(const unsigned long long*)((const char*)mbase + moff);
    SLOAD(SE, 0); SLOAD(SO, KVBLK); }
  SWAIT(); SWRITE(0, SE); __syncthreads();
  qkt<MASKED>(pA0, pA1, K_lds, qr, r32, hi, mw);
  if (MASKED) mw = *(const unsigned long long*)((const char*)mbase + (moff + 8u));
  partialSM<MASKED>(pA0, pA1, m_reg, mnA, alA, mw, hi);
  SLOAD(SE, (2 < NT ? 2 : NT - 1) * KVBLK);
  SWAIT();
  SWRITE(1, SO); __syncthreads();
  if (MASKED) TPU_START(120);
  for (int j = 1; j + 1 < NT; j += 2) {
    SBAR(); qkt<MASKED>(pB0, pB1, K_lds + SHM_K, qr, r32, hi, mw);
    if (MASKED) mw = *(const unsigned long long*)((const char*)mbase + (moff + 8u * (unsigned)(j + 1)));
    finishSM(pA0, pA1, alA, l_reg, pa0, pa1, pa2, pa3); SBAR();
    SLOAD(SO, (j + 2) * KVBLK); SBAR();
    pv_d0(o, vb0, pa0, pa1, pa2, pa3); partialSM<MASKED>(pB0, pB1, m_reg, mnB, alB, mw, hi);
    __syncthreads(); if (MASKED) asm volatile("s_waitcnt vmcnt(5)" ::: "memory"); else SWAIT();
    SWRITE(0, SE);
    RESC(alB); __syncthreads();
    SBAR(); qkt<MASKED>(pA0, pA1, K_lds, qr, r32, hi, mw);
    if (MASKED) mw = *(const unsigned long long*)((const char*)mbase + (moff + 8u * (unsigned)(j + 2)));
    finishSM(pB0, pB1, alB, l_reg, pa0, pa1, pa2, pa3); SBAR();
    SLOAD(SE, (j + 3 < NT ? j + 3 : NT - 1) * KVBLK); SBAR();
    pv_d0(o, vb0 + SHM_V, pa0, pa1, pa2, pa3); partialSM<MASKED>(pA0, pA1, m_reg, mnA, alA, mw, hi);
    __syncthreads(); if (MASKED) asm volatile("s_waitcnt vmcnt(5)" ::: "memory"); else SWAIT();
    SWRITE(1, SO);
    RESC(alA); __syncthreads();
  }
  SBAR(); qkt<MASKED>(pB0, pB1, K_lds + SHM_K, qr, r32, hi, mw);
  finishSM(pA0, pA1, alA, l_reg, pa0, pa1, pa2, pa3); SBAR();
  pv_d0(o, vb0, pa0, pa1, pa2, pa3); partialSM<MASKED>(pB0, pB1, m_reg, mnB, alB, mw, hi);
  __syncthreads(); RESC(alB);
  finishSM(pB0, pB1, alB, l_reg, pa0, pa1, pa2, pa3); SBAR();
  pv_d0(o, vb0 + SHM_V, pa0, pa1, pa2, pa3);
  if (MASKED) TPU_STOP(120);
  if (MASKED) TPU_START(121);
  u32x4 zr[8];
#pragma unroll
  for (int i = 0; i < 8; ++i) zr[i] = *(const u32x4*)(Ow.zrow(4 * i + (lane >> 4)) + 8 * (lane & 15));
  if (hi == 0) li_l[r32] = l_reg; asm volatile("s_waitcnt lgkmcnt(0)" ::: "memory");
  float rli[16];
#pragma unroll
  for (int r = 0; r < 16; ++r) rli[r] = __builtin_amdgcn_rcpf(li_l[crow(r, hi)]);
  __syncthreads();
  float* og_s = (float*)lds + wid * (32 * 132);
#pragma unroll
  for (int r = 0; r < 16; ++r) {
#pragma unroll
    for (int d0 = 0; d0 < 4; ++d0) og_s[crow(r, hi) * 132 + d0 * 32 + r32] = o[d0][r] * rli[r]; }
  asm volatile("" ::: "memory");
  { const int row = lane >> 1, half = lane & 1; const float* src = og_s + row * 132 + half * 64;
    float ss = 0.f;
#pragma unroll
    for (int i = 0; i < 16; ++i) { const f32x4 v = *(const f32x4*)(src + 4 * i); ss += v[0] * v[0] + v[1] * v[1] + v[2] * v[2] + v[3] * v[3]; }
    ss += shx(ss, 1);
    if (half == 0) og_s[row * 132 + 128] = rsqrtf(ss * (1.f / 128.f) + EPS); }
  asm volatile("s_waitcnt lgkmcnt(0)" ::: "memory");
#pragma unroll
  for (int i = 0; i < 8; ++i) { const int row = 4 * i + (lane >> 4), c8 = 8 * (lane & 15); const float* src = og_s + row * 132 + c8;
    const f32x4 a = *(const f32x4*)src, b2 = *(const f32x4*)(src + 4); const float rn = og_s[row * 132 + 128];
    float z[8], g[8];
    z[0] = __uint_as_float(zr[i].x << 16); z[1] = __uint_as_float(zr[i].x & 0xffff0000u); z[2] = __uint_as_float(zr[i].y << 16); z[3] = __uint_as_float(zr[i].y & 0xffff0000u);
    z[4] = __uint_as_float(zr[i].z << 16); z[5] = __uint_as_float(zr[i].z & 0xffff0000u); z[6] = __uint_as_float(zr[i].w << 16); z[7] = __uint_as_float(zr[i].w & 0xffff0000u);
#pragma unroll
    for (int q = 0; q < 4; ++q) { g[q] = a[q] * rn * siluf_(z[q]); g[4 + q] = b2[q] * rn * siluf_(z[4 + q]); }
    st8f(Ow.grow(row) + c8, g); }
  __syncthreads();
  if (MASKED) TPU_STOP(121);
#undef SLOAD
#undef SWRITE
#undef SWAIT
#undef RESC
}
}
constexpr size_t al256(size_t x) { return (x + 255) / 256 * 256; }
constexpr size_t WS_CTL   = 0;
constexpr size_t CTL_BYTES = 65536;
constexpr size_t WS_WINT  = WS_CTL + CTL_BYTES;
constexpr size_t WS_WOUTT = WS_WINT + al256((size_t)DEPTH * NPAD * DM * 2);
constexpr size_t WS_WKVT  = WS_WOUTT + al256((size_t)DEPTH * DM * MIX * 2);
constexpr size_t WS_WGLUT = WS_WKVT + al256((size_t)DEPTH * 1024 * DM * 2);
constexpr size_t WS_MEMN  = WS_WGLUT + al256((size_t)DEPTH * 512 * 512 * 2);
constexpr size_t WS_KVMEM = WS_MEMN + al256((size_t)NB * MEML * DM * 2);
constexpr size_t WS_XN    = WS_KVMEM + al256((size_t)NB * MEML * DEPTH * 1024 * 2);
constexpr size_t WS_P     = WS_XN + al256((size_t)NTOK * DM * 2);
constexpr size_t WS_XBUF  = WS_P + al256((size_t)NTOK * NPAD * 2);
constexpr size_t WS_OCAT  = WS_XBUF + al256((size_t)NTOK * DM * 4);
constexpr size_t WS_MASK  = WS_OCAT + al256((size_t)NTOK * MIX * 2);
constexpr size_t WS_IW    = WS_MASK + al256((size_t)NTOK * 64 * 8);
constexpr size_t WS_YBUF  = WS_IW + al256((size_t)NTOK * 16 * 4);
constexpr size_t WS_ROPE  = WS_YBUF + al256((size_t)NTOK * 512 * 2);
constexpr size_t WS_S5P   = WS_ROPE + al256((size_t)NTOK * 48 * 4);
constexpr size_t S5P_BYTES = (size_t)DEPTH * 32 * (64 * 2 + 64 * 2 + 64 * 16 * 2) * 4;
constexpr size_t WS_GLAS  = WS_S5P + al256(S5P_BYTES);
constexpr size_t WS_GLAD  = WS_GLAS + al256((size_t)NB * 64 * 4 * 64 * 128 * 4);
constexpr size_t WS_IKC   = WS_GLAD + al256((size_t)NB * 64 * 4 * 64 * 4);
constexpr size_t WS_KVC   = WS_IKC + al256((size_t)NTOK * 64 * 2);
constexpr size_t WS_IQL   = WS_KVC + al256((size_t)NTOK * 256 * 2);
constexpr size_t WS_SSQ   = WS_IQL + al256((size_t)NTOK * 64 * 2);
constexpr size_t DSP_SLOT = (size_t)(256 * 128 + 512) * 4;
constexpr size_t WS_DSP   = WS_SSQ + 256;
constexpr size_t WS_END   = WS_DSP + al256((size_t)160 * 2 * DSP_SLOT);

struct Params {
    const float* x; const float* mem; const int* pos; const float* ln_gain; const float* w_in; const float* gla_w_up; const float* gla_b_up;
    const float* s5_a_re; const float* s5_a_im; const float* s5_log_step; const float* s5_b_re; const float* s5_b_im; const float* s5_c_re; const float* s5_c_im;
    const float* s5_d; const float* s5_w_glu; const float* dsa_q_norm; const float* dsa_k_norm; const float* mem_norm; const float* w_mem_kv;
    const float* mem_q_norm; const float* mem_k_norm; const float* out_norm; const float* w_out;
    float* out;
    char* ws;
    __device__ __forceinline__ unsigned* ctl_() const { return (unsigned*)(ws + WS_CTL); }
    __device__ __forceinline__ bf16_t* WinT_() const { return (bf16_t*)(ws + WS_WINT); }
    __device__ __forceinline__ bf16_t* WoutT_() const { return (bf16_t*)(ws + WS_WOUTT); }
    __device__ __forceinline__ bf16_t* WkvT_() const { return (bf16_t*)(ws + WS_WKVT); }
    __device__ __forceinline__ bf16_t* WgluT_() const { return (bf16_t*)(ws + WS_WGLUT); }
    __device__ __forceinline__ bf16_t* memn_() const { return (bf16_t*)(ws + WS_MEMN); }
    __device__ __forceinline__ bf16_t* kvmem_() const { return (bf16_t*)(ws + WS_KVMEM); }
    __device__ __forceinline__ bf16_t* xn_() const { return (bf16_t*)(ws + WS_XN); }
    __device__ __forceinline__ bf16_t* p_() const { return (bf16_t*)(ws + WS_P); }
    __device__ __forceinline__ bf16_t* xbuf_() const { return (bf16_t*)(ws + WS_XBUF); }
    __device__ __forceinline__ bf16_t* ocat_() const { return (bf16_t*)(ws + WS_OCAT); }
    __device__ __forceinline__ unsigned long long* mask_() const { return (unsigned long long*)(ws + WS_MASK); }
    __device__ __forceinline__ float* iw_() const { return (float*)(ws + WS_IW); }
    __device__ __forceinline__ bf16_t* ybuf_() const { return (bf16_t*)(ws + WS_YBUF); }
    __device__ __forceinline__ float* rope_() const { return (float*)(ws + WS_ROPE); }
    __device__ __forceinline__ float* s5p_() const { return (float*)(ws + WS_S5P); }
    __device__ __forceinline__ float* glas_() const { return (float*)(ws + WS_GLAS); }
    __device__ __forceinline__ float* glad_() const { return (float*)(ws + WS_GLAD); }
    __device__ __forceinline__ bf16_t* ikc_() const { return (bf16_t*)(ws + WS_IKC); }
    __device__ __forceinline__ bf16_t* kvc_() const { return (bf16_t*)(ws + WS_KVC); }
    __device__ __forceinline__ float* ssq_() const { return (float*)(ws + WS_SSQ); }
    __device__ __forceinline__ bf16_t* iql_() const { return (bf16_t*)(ws + WS_IQL); }
    __device__ __forceinline__ char* dsp_() const { return ws + WS_DSP; }
};

__device__ __forceinline__ void transpose_tiles(const float* __restrict__ src, int K, int Nsrc, int Ndst, const float* __restrict__ scale, bf16_t* __restrict__ dst,
                                                int tile, float* lds_tile  ) {
    const int tid = TIDX(), ntn = Ndst / 256;
    const int tk = tile / ntn, tn = tile % ntn, k0 = tk * 64, n0 = tn * 256;
    __syncthreads();
    { const int ty = tid >> 4, tx = tid & 15;
      f32x4 v[2][4];
#pragma unroll
      for (int i = 0; i < 2; ++i)
#pragma unroll
        for (int q = 0; q < 4; ++q) { const int k = k0 + ty + 32 * i, n = n0 + 4 * tx + 64 * q;
          v[i][q] = (f32x4){0.f, 0.f, 0.f, 0.f};
          if (n < Nsrc) v[i][q] = *(const f32x4*)(src + (size_t)k * Nsrc + n); }
#pragma unroll
      for (int i = 0; i < 2; ++i) { const float s = scale ? scale[k0 + ty + 32 * i] : 1.f;
#pragma unroll
        for (int q = 0; q < 4; ++q) { float* t = lds_tile + (ty + 32 * i) * 257 + 4 * tx + 64 * q; t[0] = v[i][q][0] * s; t[1] = v[i][q][1] * s; t[2] = v[i][q][2] * s; t[3] = v[i][q][3] * s; } } }
    __syncthreads();
    { const int n = tid >> 1, kh = (tid & 1) * 32;
#pragma unroll
      for (int j = 0; j < 4; ++j) { const int kb = kh + 8 * j; u32x4 w;
        w.x = pk2bf(lds_tile[(kb + 0) * 257 + n], lds_tile[(kb + 1) * 257 + n]); w.y = pk2bf(lds_tile[(kb + 2) * 257 + n], lds_tile[(kb + 3) * 257 + n]);
        w.z = pk2bf(lds_tile[(kb + 4) * 257 + n], lds_tile[(kb + 5) * 257 + n]); w.w = pk2bf(lds_tile[(kb + 6) * 257 + n], lds_tile[(kb + 7) * 257 + n]);
        *(u32x4*)(dst + (size_t)(n0 + n) * K + k0 + kb) = w; } }
}

__device__ __forceinline__ void rmsnorm_rows(const float* __restrict__ X, bf16_t* __restrict__ Y, int nrows) {
    const int wid = TIDX() >> 6, lane = TIDX() & 63;
    for (int row = blockIdx.x * 8 + wid; row < nrows; row += gridDim.x * 8) {
        const float* xr = X + (size_t)row * DM; f32x4 v[8]; float ss = 0.f;
#pragma unroll
        for (int i = 0; i < 8; ++i) { v[i] = *(const f32x4*)(xr + 4 * lane + 256 * i); ss += v[i][0] * v[i][0] + v[i][1] * v[i][1] + v[i][2] * v[i][2] + v[i][3] * v[i][3]; }
        ss = wave_sum(ss); const float r = rsqrtf(ss * (1.f / DM) + EPS);
        bf16_t* yr = Y + (size_t)row * DM;
#pragma unroll
        for (int i = 0; i < 8; ++i) { u32x2 w; w.x = pk2bf(v[i][0] * r, v[i][1] * r); w.y = pk2bf(v[i][2] * r, v[i][3] * r); *(u32x2*)(yr + 4 * lane + 256 * i) = w; }
    }
}

__device__ __forceinline__ void rmsnorm_rows16(const bf16_t* __restrict__ X, bf16_t* __restrict__ Y, int nrows) {
    const int wid = TIDX() >> 6, lane = TIDX() & 63;
    for (int row = blockIdx.x * 8 + wid; row < nrows; row += gridDim.x * 8) {
        const bf16_t* xr = X + (size_t)row * DM; float v[4][8]; float ss = 0.f;
#pragma unroll
        for (int i = 0; i < 4; ++i) { ld8f(xr + 8 * lane + 512 * i, v[i]);
#pragma unroll
            for (int j = 0; j < 8; ++j) ss += v[i][j] * v[i][j]; }
        ss = wave_sum(ss); const float r = rsqrtf(ss * (1.f / DM) + EPS);
        bf16_t* yr = Y + (size_t)row * DM;
#pragma unroll
        for (int i = 0; i < 4; ++i) { float o[8];
#pragma unroll
            for (int j = 0; j < 8; ++j) o[j] = v[i][j] * r;
            st8f(yr + 8 * lane + 512 * i, o); }
    }
}

__device__ __forceinline__ void rows_bf16_ssq(const float* __restrict__ X, bf16_t* __restrict__ Y, float* __restrict__ ssq, int nrows) {
    const int wid = TIDX() >> 6, lane = TIDX() & 63;
    for (int row = blockIdx.x * 8 + wid; row < nrows; row += gridDim.x * 8) {
        const float* xr = X + (size_t)row * DM; bf16_t* yr = Y + (size_t)row * DM; float ss = 0.f;
#pragma unroll
        for (int i = 0; i < 8; ++i) { const f32x4 v = *(const f32x4*)(xr + 4 * lane + 256 * i); ss += v[0] * v[0] + v[1] * v[1] + v[2] * v[2] + v[3] * v[3];
            u32x2 w; w.x = pk2bf(v[0], v[1]); w.y = pk2bf(v[2], v[3]); *(u32x2*)(yr + 4 * lane + 256 * i) = w; }
        ss = wave_sum(ss); if (lane < 32) ssq[(size_t)row * 32 + lane] = (lane == 0) ? ss : 0.f;
    }
}
__device__ __forceinline__ void phase_prologue1(const Params& P, char* lds) {
    float* tile = (float*)lds;
    constexpr int T_IN = (DM / 64) * (NPAD / 256), T_OUT = (MIX / 64) * (DM / 256), T_KV = (DM / 64) * (1024 / 256), T_GLU = 8 * 2;
    constexpr int TOT = DEPTH * (T_IN + T_OUT + T_KV + T_GLU);
    for (int u = blockIdx.x; u < TOT; u += gridDim.x) {
        int l = u / (T_IN + T_OUT + T_KV + T_GLU), r = u % (T_IN + T_OUT + T_KV + T_GLU);
        if (r < T_IN) transpose_tiles(P.w_in + (size_t)l * DM * NIN, DM, NIN, NPAD, P.ln_gain + l * DM, P.WinT_() + (size_t)l * NPAD * DM, r, tile);
        else if ((r -= T_IN) < T_OUT) transpose_tiles(P.w_out + (size_t)l * MIX * DM, MIX, DM, DM, P.out_norm + l * MIX, P.WoutT_() + (size_t)l * DM * MIX, r, tile);
        else if ((r -= T_OUT) < T_KV) transpose_tiles(P.w_mem_kv + (size_t)l * DM * 1024, DM, 1024, 1024, P.mem_norm + l * DM, P.WkvT_() + (size_t)l * 1024 * DM, r, tile);
        else { r -= T_KV; transpose_tiles(P.s5_w_glu + (size_t)l * 512 * 512, 512, 512, 512, nullptr, P.WgluT_() + (size_t)l * 512 * 512, r, tile); }
    }
    rmsnorm_rows(P.mem, P.memn_(), NB * MEML);
}
__device__ __forceinline__ void phase_rope_table(const Params& P) {
    for (int idx = blockIdx.x * NTHR + TIDX(); idx < NTOK * 24; idx += gridDim.x * NTHR) {
        const int tok = idx / 24, i = idx % 24;
        const float e = (i < 16) ? -((float)i * 2.0f / 32.0f) : -((float)(i - 16) * 2.0f / 16.0f);
        const float inv_freq = exp2f(e * 18.931568569324174f);
        const float ang = (float)P.pos[tok] * inv_freq;
        const double a = (double)ang; const double k = rint(a * 0.15915494309189535); const float rf = (float)fma(-k, 6.283185307179586, a);
        P.rope_()[(size_t)idx * 2] = cosf(rf); P.rope_()[(size_t)idx * 2 + 1] = sinf(rf);
    }
}

__device__ __forceinline__ void phase_rmsnorm_x(const Params& P, int layer) { if (layer == 0) rmsnorm_rows(P.x, P.xn_(), NTOK); else rmsnorm_rows16(P.xbuf_(), P.xn_(), NTOK); }

__device__ __forceinline__ void phase_memk_norm(const Params& P) {
    const int wid = TIDX() >> 6, lane = TIDX() & 63;
    for (int it = blockIdx.x * 8 + wid; it < NB * MEML * DEPTH * 4; it += gridDim.x * 8) {
        const int row = it / (DEPTH * 4), l = (it / 4) % DEPTH, h = it % 4;
        bf16_t* kp = P.kvmem_() + (size_t)row * (DEPTH * 1024) + l * 1024 + h * 128 + 2 * lane;
        const unsigned w = *(const unsigned*)kp; const float a = __uint_as_float(w << 16), b = __uint_as_float(w & 0xffff0000u);
        const float ss = wave_sum(a * a + b * b), r = rsqrtf(ss * (1.f / 128.f) + EPS);
        const float* g = P.mem_k_norm + l * 128 + 2 * lane;
        *(unsigned*)kp = pk2bf(a * r * g[0], b * r * g[1]);
    }
}

__device__ __forceinline__ float sum16(float v) { v += shx(v, 1); v += shx(v, 2); v += shx(v, 4); v += shx(v, 8); return v; }

__device__ __forceinline__ void head128_norm_rope_to(const bf16_t* hp, bf16_t* dp, int l16, const float* __restrict__ gain, const float* __restrict__ cs, bool rope, bool do_store) {
    float v[8]; ld8f(hp + 8 * l16, v);
    float ss = 0.f;
#pragma unroll
    for (int j = 0; j < 8; ++j) ss += v[j] * v[j];
    ss = sum16(ss); const float r = rsqrtf(ss * (1.f / 128.f) + EPS);
#pragma unroll
    for (int j = 0; j < 8; ++j) v[j] = v[j] * r * gain[8 * l16 + j];
    if (rope) {
        float o[8];
#pragma unroll
        for (int j = 0; j < 8; ++j) o[j] = shx(v[j], 2);
        if (l16 < 4) { const int fi = (l16 & 1) * 8;
#pragma unroll
            for (int j = 0; j < 8; ++j) { const float c = cs[(fi + j) * 2], s = cs[(fi + j) * 2 + 1];
                v[j] = (l16 < 2) ? (v[j] * c - o[j] * s) : (v[j] * c + o[j] * s); } }
    }
    if (do_store) st8f(dp + 8 * l16, v);
}
__device__ __forceinline__ void head128_norm_rope(bf16_t* hp, int l16, const float* __restrict__ gain, const float* __restrict__ cs, bool rope, bool do_store) { head128_norm_rope_to(hp, hp, l16, gain, cs, rope, do_store); }
__device__ __forceinline__ void rope16_inplace(bf16_t* ip, const float* __restrict__ cs) {
    float a[8], b[8]; ld8f(ip, a); ld8f(ip + 8, b);
#pragma unroll
    for (int j = 0; j < 8; ++j) { const float c = cs[2 * j], s = cs[2 * j + 1], x1 = a[j], x2 = b[j]; a[j] = x1 * c - x2 * s; b[j] = x2 * c + x1 * s; }
    st8f(ip, a); st8f(ip + 8, b);
}
struct PrepIn { u32x4 k, ik0, ik1, v; bf16_t w; f32x4 c32[4], c16[4]; };
__device__ __forceinline__ void prep_load(const Params& P, int tok, int lane, PrepIn& I) {
    const int l16 = lane & 15, grp = lane >> 4;
    const bf16_t* row = P.p_() + (size_t)tok * NPAD;
    I.k = *(const u32x4*)(row + C_DK + 8 * l16);
    I.ik0 = *(const u32x4*)(row + C_DIK + (lane & 3) * 16); I.ik1 = *(const u32x4*)(row + C_DIK + (lane & 3) * 16 + 8);
    I.v = *(const u32x4*)(row + C_DV + l16 * 8);
    I.w = row[C_DIW + l16];
    const float* cs32 = P.rope_() + (size_t)tok * 48;
#pragma unroll
    for (int i = 0; i < 4; ++i) { I.c32[i] = *(const f32x4*)(cs32 + (l16 & 1) * 16 + 4 * i); I.c16[i] = *(const f32x4*)(cs32 + 32 + 4 * i); }
}
__device__ __forceinline__ void unpack8(const u32x4 w, float (&v)[8]) {
    v[0] = __uint_as_float(w.x << 16); v[1] = __uint_as_float(w.x & 0xffff0000u); v[2] = __uint_as_float(w.y << 16); v[3] = __uint_as_float(w.y & 0xffff0000u);
    v[4] = __uint_as_float(w.z << 16); v[5] = __uint_as_float(w.z & 0xffff0000u); v[6] = __uint_as_float(w.w << 16); v[7] = __uint_as_float(w.w & 0xffff0000u); }
__device__ __forceinline__ void head128_nr(float (&v)[8], int l16, const float (&gain)[8], const f32x4 (&cs)[4], bool rope) {
    float ss = 0.f;
#pragma unroll
    for (int j = 0; j < 8; ++j) ss += v[j] * v[j];
    ss = sum16(ss); const float r = rsqrtf(ss * (1.f / 128.f) + EPS);
#pragma unroll
    for (int j = 0; j < 8; ++j) v[j] = v[j] * r * gain[j];
    if (rope) {
        float o[8];
#pragma unroll
        for (int j = 0; j < 8; ++j) o[j] = shx(v[j], 2);
        if (l16 < 4) {
#pragma unroll
            for (int j = 0; j < 8; ++j) { const float c = cs[j >> 1][(j & 1) * 2], s = cs[j >> 1][(j & 1) * 2 + 1];
                v[j] = (l16 < 2) ? (v[j] * c - o[j] * s) : (v[j] * c + o[j] * s); } }
    }
}
__device__ __forceinline__ void prep_finish(const Params& P, int tok, int lane, const PrepIn& I, const float (&gq)[8], const float (&gk)[8], const float (&gm)[8]) {
    const int l16 = lane & 15, grp = lane >> 4;
    bf16_t* row = P.p_() + (size_t)tok * NPAD;
    float k[8];
    unpack8(I.k, k);
    head128_nr(k, l16, gk, I.c32, true);
    if (grp == 0) st8f(P.kvc_() + (size_t)tok * 256 + 8 * l16, k);
    {
        float a[8], b[8]; unpack8(I.ik0, a); unpack8(I.ik1, b);
        if ((lane & 3) == 0) {
#pragma unroll
            for (int j = 0; j < 8; ++j) { const float c = I.c16[j >> 1][(j & 1) * 2], s = I.c16[j >> 1][(j & 1) * 2 + 1], x1 = a[j], x2 = b[j]; a[j] = x1 * c - x2 * s; b[j] = x2 * c + x1 * s; } }
        if (lane < 4) { bf16_t* dst = P.ikc_() + (size_t)(tok >> 5) * 2048 + lane * 512 + (tok & 31) * 8; st8f(dst, a); st8f(dst + 256, b); } }
    if (lane >= 16 && lane < 32) *(u32x4*)(P.kvc_() + (size_t)tok * 256 + 128 + l16 * 8) = I.v;
    if (lane < 16) P.iw_()[(size_t)tok * 16 + lane] = bf2f(I.w) * (1.f / 32.f);
}
__device__ __forceinline__ void phase_prep(const Params& P, int layer) {
    const int wid = TIDX() >> 6, lane = TIDX() & 63, l16 = lane & 15;
    float gq[8], gk[8], gm[8];
#pragma unroll
    for (int j = 0; j < 8; ++j) { gq[j] = P.dsa_q_norm[layer * 128 + 8 * l16 + j]; gk[j] = P.dsa_k_norm[layer * 128 + 8 * l16 + j]; gm[j] = P.mem_q_norm[layer * 128 + 8 * l16 + j]; }
    const int stride = gridDim.x * 8;
    for (int tok = blockIdx.x * 8 + wid; tok < NTOK; tok += 2 * stride) {
        const int tok2 = tok + stride; const bool two = tok2 < NTOK;
        PrepIn A, B2;
        prep_load(P, tok, lane, A); prep_load(P, two ? tok2 : tok, lane, B2);
        prep_finish(P, tok, lane, A, gq, gk, gm);
        if (two) prep_finish(P, tok2, lane, B2, gq, gk, gm);
    }
}
struct MemOutRow { const bf16_t* zb; bf16_t* gb;
    __device__ __forceinline__ const bf16_t* zrow(int r) const { return zb + (size_t)r * NPAD; } __device__ __forceinline__ bf16_t* grow(int r) const { return gb + (size_t)r * MIX; } };
__device__ __forceinline__ void unit_mem_attn(const Params& P, int layer, int u, char* lds) {
    const int b = u >> 6, h = (u >> 4) & 3, qb = u & 15, tok0 = b * SEQ + qb * 256;
    const int wid = TIDX() >> 6, lane = TIDX() & 63, r32 = lane & 31, hi = lane >> 5;
    const bf16_t* Qw = P.p_() + (size_t)(tok0 + wid * 32 + r32) * NPAD + C_MQ + h * 128 + hi * 8;
    const bf16_t* Kh = P.kvmem_() + (size_t)(b * MEML) * (DEPTH * 1024) + layer * 1024 + h * 128;
    MemOutRow ow; ow.zb = P.p_() + (size_t)(tok0 + wid * 32) * NPAD + C_MZ + h * 128; ow.gb = P.xn_() + (size_t)(tok0 + wid * 32) * MIX + 1536 + h * 128;
    att::attn_body<false, DEPTH * 1024, 512, 1, MemOutRow>(Qw, P.mem_q_norm + layer * 128, nullptr, Kh, MEML / 64, nullptr, 0u, ow, lds);
}

__device__ __forceinline__ void phase_gate(const Params& P, int c_lo, int c_hi) {
    const int wid = TIDX() >> 6, lane = TIDX() & 63;
    const int c0 = lane * 32;
    const int seg = c0 >> 9, zc = (seg == 0 ? C_GZ : seg == 1 ? C_SZ : seg == 2 ? C_DZ : C_MZ) + (c0 & 511);
    const bool act = (c0 >= c_lo) && (c0 < c_hi);
    for (int tok = blockIdx.x * 8 + wid; tok < NTOK; tok += gridDim.x * 8) {
        if (!act) { bf16_t* gz_ = P.xn_() + (size_t)tok * MIX + c0; const u32x4 zz = {0u, 0u, 0u, 0u};
#pragma unroll
            for (int i = 0; i < 4; ++i) *(u32x4*)(gz_ + 8 * i) = zz;
            continue; }
        const bf16_t* op = P.ocat_() + (size_t)tok * MIX + c0; const bf16_t* zp = P.p_() + (size_t)tok * NPAD + zc; bf16_t* gp = P.xn_() + (size_t)tok * MIX + c0;
        float o[32]; float ss = 0.f;
#pragma unroll
        for (int i = 0; i < 4; ++i) { float v[8]; ld8f(op + 8 * i, v);
#pragma unroll
            for (int j = 0; j < 8; ++j) { o[8 * i + j] = v[j]; ss += v[j] * v[j]; } }
        ss += shx(ss, 1); ss += shx(ss, 2);
        const float r = rsqrtf(ss * (1.f / 128.f) + EPS);
#pragma unroll
        for (int i = 0; i < 4; ++i) { float z[8], g[8]; ld8f(zp + 8 * i, z);
#pragma unroll
            for (int j = 0; j < 8; ++j) g[j] = o[8 * i + j] * r * siluf_(z[j]);
            st8f(gp + 8 * i, g); }
    }
}

__device__ __forceinline__ void phase_gemm_in(const Params& P, int layer, char* lds) {
    pg8::Gemm g; g.A = P.xn_(); g.Bt = P.WinT_() + (size_t)layer * NPAD * DM; g.M = NTOK; g.N = NPAD; g.K = DM;
    pg8::StaticOrder S; S.init(g.M, g.N, (int)gridDim.x, (int)blockIdx.x);
    pg8::EpiBf16Plain E; E.O = P.p_(); E.ldc = NPAD;
    pg8::gemm_phase<pg8::EpiBf16Plain, pg8::StaticOrder, false>((PG8_LAS unsigned char*)lds, g, S, E, nullptr);
}
__device__ __forceinline__ void phase_gemm_out(const Params& P, int layer, char* lds) {
    pg8::Gemm g; g.A = P.xn_(); g.Bt = P.WoutT_() + (size_t)layer * DM * MIX; g.M = NTOK; g.N = DM; g.K = MIX;
    pg8::StaticOrder S; S.init(g.M, g.N, (int)gridDim.x, (int)blockIdx.x);
    pg8::EpiResidMix E; E.R = (layer == 0) ? (const void*)P.x : (const void*)P.xbuf_(); E.C = (layer == DEPTH - 1) ? (void*)P.out : (void*)P.xbuf_(); E.ldc = DM;
    E.r16 = (layer != 0); E.c16 = (layer != DEPTH - 1);
    pg8::gemm_phase<pg8::EpiResidMix, pg8::StaticOrder, false>((PG8_LAS unsigned char*)lds, g, S, E, nullptr);
}
__device__ __forceinline__ void phase_gemm_kv(const Params& P, char* lds) {
    pg8::Gemm g; g.A = P.memn_(); g.Bt = P.WkvT_(); g.M = NB * MEML; g.N = DEPTH * 1024; g.K = DM;
    pg8::StaticOrder S; S.init(g.M, g.N, (int)gridDim.x, (int)blockIdx.x);
    pg8::EpiBf16Plain E; E.O = P.kvmem_(); E.ldc = DEPTH * 1024;
    pg8::gemm_phase<pg8::EpiBf16Plain, pg8::StaticOrder, false>((PG8_LAS unsigned char*)lds, g, S, E, nullptr);
}
__device__ __forceinline__ void mma_tile(f32x16& acc, const char* A, int lda, const char* B, int ldb, int K, int lane) {
    const int r = lane & 31, kh = lane >> 5;
    const char* ap = A + r * lda + kh * 16; const char* bp = B + r * ldb + kh * 16;
    asm volatile("" : "+v"(acc));
    for (int k = 0; k < K; k += 16) {
        const bf16x8 a = *(const bf16x8*)(ap + k * 2); const bf16x8 b = *(const bf16x8*)(bp + k * 2);
        acc = __builtin_amdgcn_mfma_f32_32x32x16_bf16(a, b, acc, 0, 0, 0);
    }
}
__device__ __forceinline__ int crow32(int r, int hi) { return (r & 3) + 8 * (r >> 2) + 4 * hi; }
__device__ __forceinline__ float log_sigmoid_(float x) { return fminf(x, 0.f) - log1pf(__expf(-fabsf(x))); }

constexpr int GLA_ST = 144;
constexpr int GC_BST = 68;
constexpr int GC_B_BYTES = 4 * 64 * GC_BST * 4, GC_V_BYTES = 4 * 16384;
__device__ __forceinline__ float* gla_gb(const Params& P) { return (float*)((char*)P.ocat_() + (size_t)32 * 1024 * 1024); }
__device__ __forceinline__ float gla_partner32(float v, int hi) { auto rr = __builtin_amdgcn_permlane32_swap(__float_as_uint(v), __float_as_uint(v), false, false); return __uint_as_float(hi ? rr[0] : rr[1]); }
__device__ __forceinline__ float log_sigmoid_fast(float x) { return fminf(x, 0.f) - 0.6931471805599453f * __builtin_amdgcn_logf(1.f + __builtin_amdgcn_exp2f(-1.4426950408889634f * fabsf(x))); }

__device__ __forceinline__ void unit_gla_a4(const Params& P, int layer, int ub, char* lds) {
    const int b = ub >> 6, n = ub & 63, tok0 = b * SEQ + n * 64;
    const int tid = TIDX(), wid = tid >> 6, lane = tid & 63, r32 = lane & 31, hi = lane >> 5, h = wid >> 1, eh = wid & 1;
    float* b_s = (float*)lds;
    char* V_s = lds;
    char* K_s = lds + GC_B_BYTES;
    __syncthreads();
    const bf16_t* prow = P.p_() + (size_t)tok0 * NPAD;
    const int gcol = wid * 32 + r32;
    const bf16x8 ag0 = *(const bf16x8*)(prow + (size_t)r32 * NPAD + C_GLR + hi * 8), ag1 = *(const bf16x8*)(prow + (size_t)(32 + r32) * NPAD + C_GLR + hi * 8);
    float wuf[8];
#pragma unroll
    for (int j = 0; j < 8; ++j) wuf[j] = P.gla_w_up[((size_t)layer * 16 + hi * 8 + j) * 256 + gcol];
    const float bias = P.gla_b_up[layer * 256 + gcol];
    bf16x8 kraw[4], vs[4][2];
    const int ks_ = tid >> 3, kc = (tid & 7) * 8;
#pragma unroll
    for (int hv = 0; hv < 4; ++hv) kraw[hv] = *(const bf16x8*)(prow + (size_t)ks_ * NPAD + C_GK + hv * 64 + kc);
    const int sr = tid >> 4, sc = (tid & 15) * 8;
#pragma unroll
    for (int hv = 0; hv < 4; ++hv) { vs[hv][0] = *(const bf16x8*)(prow + (size_t)sr * NPAD + C_GV + hv * 128 + sc); vs[hv][1] = *(const bf16x8*)(prow + (size_t)(32 + sr) * NPAD + C_GV + hv * 128 + sc); }
    {   u32x4 bw_ = {pk2bf(wuf[0], wuf[1]), pk2bf(wuf[2], wuf[3]), pk2bf(wuf[4], wuf[5]), pk2bf(wuf[6], wuf[7])}; const bf16x8 bw = *reinterpret_cast<const bf16x8*>(&bw_);
        f32x16 ga[2] = {};
        asm volatile("" : "+v"(ga[0]), "+v"(ga[1]));
        ga[0] = __builtin_amdgcn_mfma_f32_32x32x16_bf16(ag0, bw, ga[0], 0, 0, 0); ga[1] = __builtin_amdgcn_mfma_f32_32x32x16_bf16(ag1, bw, ga[1], 0, 0, 0);
        float tot[2][4], ptot[2][4];
#pragma unroll
        for (int rt = 0; rt < 2; ++rt)
#pragma unroll
            for (int q = 0; q < 4; ++q) { float run = 0.f;
#pragma unroll
                for (int i = 0; i < 4; ++i) { run += log_sigmoid_fast(ga[rt][4 * q + i] + bias) * (1.f / 16.f); ga[rt][4 * q + i] = run; }
                tot[rt][q] = run; ptot[rt][q] = gla_partner32(run, hi); }
        float running = 0.f;
#pragma unroll
        for (int rt = 0; rt < 2; ++rt)
#pragma unroll
            for (int q = 0; q < 4; ++q) { const float off = running + (hi ? ptot[rt][q] : 0.f); running += tot[rt][q] + ptot[rt][q];
#pragma unroll
                for (int i = 0; i < 4; ++i) ga[rt][4 * q + i] += off; }
        const int gh = gcol >> 6, gd = gcol & 63;
        float* bp = b_s + (gh * 64) * GC_BST + gd; float* gp = gla_gb(P) + (size_t)tok0 * 256 + gcol;
#pragma unroll
        for (int rt = 0; rt < 2; ++rt)
#pragma unroll
            for (int r = 0; r < 16; ++r) { const int t = 32 * rt + att::crow(r, hi); const float v = ga[rt][r] * 1.4426950408889634f; bp[t * GC_BST] = v; gp[(size_t)t * 256] = v; }
        if (hi) P.glad_()[((size_t)((b * 64 + n) * 4 + gh)) * 64 + gd] = __builtin_amdgcn_exp2f(ga[1][15] * 1.4426950408889634f); }
    __syncthreads();
#pragma unroll
    for (int hv = 0; hv < 4; ++hv) { const float* br = b_s + (hv * 64 + ks_) * GC_BST + kc; const float* bl = b_s + (hv * 64 + 63) * GC_BST + kc;
        const f32x4 b0 = *(const f32x4*)br, b1 = *(const f32x4*)(br + 4), l0 = *(const f32x4*)bl, l1 = *(const f32x4*)(bl + 4);
        float e[8];
#pragma unroll
        for (int j = 0; j < 8; ++j) e[j] = bf2f((bf16_t)kraw[hv][j]) * __builtin_amdgcn_exp2f((j < 4 ? l0[j] : l1[j - 4]) - (j < 4 ? b0[j] : b1[j - 4]));
        u32x4 w = {att::cvtpk(e[0], e[1]), att::cvtpk(e[2], e[3]), att::cvtpk(e[4], e[5]), att::cvtpk(e[6], e[7])};
        *(u32x4*)(K_s + hv * 16384 + att::v_st(ks_, kc)) = w; }
    __syncthreads();
    { const int vst0 = att::v_st(sr, sc), vst1 = att::v_st(32 + sr, sc);
#pragma unroll
      for (int hv = 0; hv < 4; ++hv) { *(bf16x8*)(V_s + hv * 16384 + vst0) = vs[hv][0]; *(bf16x8*)(V_s + hv * 16384 + vst1) = vs[hv][1]; } }
    __syncthreads();
    const int vb = (int)(uintptr_t)(V_s + h * 16384) + att::v_rd_base(lane), kb = (int)(uintptr_t)(K_s + h * 16384) + att::v_rd_base(lane);
    f32x16 acc[2][2] = {};
    asm volatile("" : "+v"(acc[0][0]), "+v"(acc[0][1]), "+v"(acc[1][0]), "+v"(acc[1][1]));
#define GA_PK(L, H) (bf16x8){L[0], L[1], L[2], L[3], H[0], H[1], H[2], H[3]}
#define GA_STEP(KS) do { \
    const s16x4 k0l = att::tr_read<att::v_rd_off(0, KS, 0)>(kb), k0h = att::tr_read<att::v_rd_off(0, KS, 1)>(kb), k1l = att::tr_read<att::v_rd_off(1, KS, 0)>(kb), k1h = att::tr_read<att::v_rd_off(1, KS, 1)>(kb); \
    s16x4 v0l, v0h, v1l, v1h; \
    if (eh == 0) { v0l = att::tr_read<att::v_rd_off(0, KS, 0)>(vb); v0h = att::tr_read<att::v_rd_off(0, KS, 1)>(vb); v1l = att::tr_read<att::v_rd_off(1, KS, 0)>(vb); v1h = att::tr_read<att::v_rd_off(1, KS, 1)>(vb); } \
    else         { v0l = att::tr_read<att::v_rd_off(2, KS, 0)>(vb); v0h = att::tr_read<att::v_rd_off(2, KS, 1)>(vb); v1l = att::tr_read<att::v_rd_off(3, KS, 0)>(vb); v1h = att::tr_read<att::v_rd_off(3, KS, 1)>(vb); } \
    asm volatile("s_waitcnt lgkmcnt(0)" ::: "memory"); __builtin_amdgcn_sched_barrier(0); \
    acc[0][0] = __builtin_amdgcn_mfma_f32_32x32x16_bf16(GA_PK(v0l, v0h), GA_PK(k0l, k0h), acc[0][0], 0, 0, 0); \
    acc[0][1] = __builtin_amdgcn_mfma_f32_32x32x16_bf16(GA_PK(v0l, v0h), GA_PK(k1l, k1h), acc[0][1], 0, 0, 0); \
    acc[1][0] = __builtin_amdgcn_mfma_f32_32x32x16_bf16(GA_PK(v1l, v1h), GA_PK(k0l, k0h), acc[1][0], 0, 0, 0); \
    acc[1][1] = __builtin_amdgcn_mfma_f32_32x32x16_bf16(GA_PK(v1l, v1h), GA_PK(k1l, k1h), acc[1][1], 0, 0, 0); } while (0)
    GA_STEP(0); GA_STEP(1); GA_STEP(2); GA_STEP(3);
#undef GA_STEP
#undef GA_PK
    float* dst = P.glas_() + ((size_t)((b * 64 + n) * 4 + h)) * 8192;
#pragma unroll
    for (int et = 0; et < 2; ++et)
#pragma unroll
        for (int dt = 0; dt < 2; ++dt)
#pragma unroll
            for (int r = 0; r < 16; ++r) dst[((eh * 2 + et) * 32 + att::crow(r, hi)) * 64 + dt * 32 + r32] = acc[et][dt][r];
    __syncthreads();
}

__device__ __forceinline__ void gla_scan_slice(const Params& P, int idx) {
    {
        const int el = (idx & 4095) * 2, d = el & 63, h = (idx >> 12) & 3, b = idx >> 14;
        bf16_t* gst = P.ocat_();
        float S0 = 0.f, S1 = 0.f;
        for (int n0 = 0; n0 < 64; n0 += 8) {
            f32x2 ds[8], dc[8];
#pragma unroll
            for (int i = 0; i < 8; ++i) { const size_t cu = (size_t)((b * 64 + n0 + i) * 4 + h); ds[i] = *(const f32x2*)(P.glas_() + cu * 8192 + el); dc[i] = *(const f32x2*)(P.glad_() + cu * 64 + d); }
#pragma unroll
            for (int i = 0; i < 8; ++i) { const size_t cu = (size_t)((b * 64 + n0 + i) * 4 + h); *(unsigned*)(gst + cu * 8192 + el) = pk2bf(S0, S1); S0 = fmaf(dc[i][0], S0, ds[i][0]); S1 = fmaf(dc[i][1], S1, ds[i][1]); }
        }
    }
}

__device__ __forceinline__ void unit_gla_c4(const Params& P, int layer, int ub, char* lds) {
    const int b = ub >> 6, n = ub & 63, tok0 = b * SEQ + n * 64;
    const int tid = TIDX(), wid = tid >> 6, lane = tid & 63, r32 = lane & 31, hi = lane >> 5, h = wid >> 1, rh = wid & 1;
    float* b_s = (float*)lds;
    char* V_s = lds + GC_B_BYTES;
    __syncthreads();
    const bf16_t* prow = P.p_() + (size_t)tok0 * NPAD;
    bf16x8 qraw[4], kraw[2][4], vs[4][2];
    const int sr = tid >> 4, sc = (tid & 15) * 8;
#pragma unroll
    for (int hv = 0; hv < 4; ++hv) { vs[hv][0] = *(const bf16x8*)(prow + (size_t)sr * NPAD + C_GV + hv * 128 + sc); vs[hv][1] = *(const bf16x8*)(prow + (size_t)(32 + sr) * NPAD + C_GV + hv * 128 + sc); }
    f32x4 braw[8];
    { const float* gp = gla_gb(P) + (size_t)tok0 * 256 + tid * 4;
#pragma unroll
      for (int i = 0; i < 8; ++i) braw[i] = *(const f32x4*)(gp + i * 2048); }
    { const bf16_t* qp = prow + (size_t)(rh * 32 + r32) * NPAD + C_GQ + h * 64 + hi * 8;
#pragma unroll
      for (int d0 = 0; d0 < 4; ++d0) qraw[d0] = *(const bf16x8*)(qp + d0 * 16);
#pragma unroll
      for (int sh = 0; sh < 2; ++sh) { const bf16_t* kp = prow + (size_t)(sh * 32 + r32) * NPAD + C_GK + h * 64 + hi * 8;
#pragma unroll
          for (int d0 = 0; d0 < 4; ++d0) kraw[sh][d0] = *(const bf16x8*)(kp + d0 * 16); } }
    bf16x8 sfr[4][4];
    { const bf16_t* sp = P.ocat_() + ((size_t)((b * 64 + n) * 4 + h)) * 8192 + r32 * 64 + hi * 8;
#pragma unroll
      for (int eb = 0; eb < 4; ++eb)
#pragma unroll
          for (int ds = 0; ds < 4; ++ds) sfr[eb][ds] = *(const bf16x8*)(sp + eb * 32 * 64 + ds * 16); }
    { const int vst0 = att::v_st(sr, sc), vst1 = att::v_st(32 + sr, sc);
#pragma unroll
      for (int hv = 0; hv < 4; ++hv) { *(bf16x8*)(V_s + hv * 16384 + vst0) = vs[hv][0]; *(bf16x8*)(V_s + hv * 16384 + vst1) = vs[hv][1]; } }
#pragma unroll
    for (int i = 0; i < 8; ++i) { const int c = tid + 512 * i, t = c >> 6, c4 = c & 63;
        *(f32x4*)(b_s + ((c4 >> 4) * 64 + t) * GC_BST + (c4 & 15) * 4) = braw[i]; }
    __syncthreads();
    const float* bh = b_s + h * 64 * GC_BST + hi * 8;
    bf16x8 qe[4], qb[4], ke[2][4];
#pragma unroll
    for (int d0 = 0; d0 < 4; ++d0) {
        const f32x4 m0 = *(const f32x4*)(bh + 32 * GC_BST + d0 * 16), m1 = *(const f32x4*)(bh + 32 * GC_BST + d0 * 16 + 4);
        const f32x4 q0 = *(const f32x4*)(bh + (rh * 32 + r32) * GC_BST + d0 * 16), q1 = *(const f32x4*)(bh + (rh * 32 + r32) * GC_BST + d0 * 16 + 4);
        float e1[8], e2[8];
#pragma unroll
        for (int j = 0; j < 8; ++j) { const float mv = j < 4 ? m0[j] : m1[j - 4], bq = j < 4 ? q0[j] : q1[j - 4]; const float q = bf2f((bf16_t)qraw[d0][j]) * 0.125f;
            e1[j] = q * __builtin_amdgcn_exp2f(bq - mv); e2[j] = q * __builtin_amdgcn_exp2f(bq); }
        { u32x4 w = {att::cvtpk(e1[0], e1[1]), att::cvtpk(e1[2], e1[3]), att::cvtpk(e1[4], e1[5]), att::cvtpk(e1[6], e1[7])}; qe[d0] = *reinterpret_cast<bf16x8*>(&w); }
        { u32x4 w = {att::cvtpk(e2[0], e2[1]), att::cvtpk(e2[2], e2[3]), att::cvtpk(e2[4], e2[5]), att::cvtpk(e2[6], e2[7])}; qb[d0] = *reinterpret_cast<bf16x8*>(&w); }
#pragma unroll
        for (int sh = 0; sh < 2; ++sh) {
            const f32x4 k0 = *(const f32x4*)(bh + (sh * 32 + r32) * GC_BST + d0 * 16), k1 = *(const f32x4*)(bh + (sh * 32 + r32) * GC_BST + d0 * 16 + 4);
            float e3[8];
#pragma unroll
            for (int j = 0; j < 8; ++j) { const float mv = j < 4 ? m0[j] : m1[j - 4], bk = j < 4 ? k0[j] : k1[j - 4]; e3[j] = bf2f((bf16_t)kraw[sh][d0][j]) * __builtin_amdgcn_exp2f(mv - bk); }
            u32x4 w = {att::cvtpk(e3[0], e3[1]), att::cvtpk(e3[2], e3[3]), att::cvtpk(e3[4], e3[5]), att::cvtpk(e3[6], e3[7])}; ke[sh][d0] = *reinterpret_cast<bf16x8*>(&w); }
    }
    f32x16 p0 = {}, p1 = {};
    asm volatile("" : "+v"(p0), "+v"(p1));
#pragma unroll
    for (int d0 = 0; d0 < 4; ++d0) { p0 = __builtin_amdgcn_mfma_f32_32x32x16_bf16(ke[0][d0], qe[d0], p0, 0, 0, 0); p1 = __builtin_amdgcn_mfma_f32_32x32x16_bf16(ke[1][d0], qe[d0], p1, 0, 0, 0); }
    { const int t = rh * 32 + r32;
#pragma unroll
      for (int r = 0; r < 16; ++r) { const int s0 = att::crow(r, hi); p0[r] = (s0 <= t) ? p0[r] : 0.f; p1[r] = (32 + s0 <= t) ? p1[r] : 0.f; } }
    bf16x8 pa0, pa1, pa2, pa3;
#define GC_PK4(Pv, BASE, OUT) do { unsigned a0 = att::cvtpk(Pv[BASE + 0], Pv[BASE + 1]), a1 = att::cvtpk(Pv[BASE + 2], Pv[BASE + 3]);   \
    unsigned b0 = att::cvtpk(Pv[BASE + 4], Pv[BASE + 5]), b1 = att::cvtpk(Pv[BASE + 6], Pv[BASE + 7]);                              \
    auto r0 = __builtin_amdgcn_permlane32_swap(a0, b0, false, false); auto r1 = __builtin_amdgcn_permlane32_swap(a1, b1, false, false); \
    u32x4 w = {r0[0], r1[0], r0[1], r1[1]}; OUT = *reinterpret_cast<bf16x8*>(&w); } while (0)
    GC_PK4(p0, 0, pa0); GC_PK4(p0, 8, pa1); GC_PK4(p1, 0, pa2); GC_PK4(p1, 8, pa3);
#undef GC_PK4
    f32x16 o[4] = {};
    asm volatile("" : "+v"(o[0]), "+v"(o[1]), "+v"(o[2]), "+v"(o[3]));
    att::pv_d0(o, (int)(uintptr_t)(V_s + h * 16384) + att::v_rd_base(lane), pa0, pa1, pa2, pa3);
#pragma unroll
    for (int eb = 0; eb < 4; ++eb)
#pragma unroll
        for (int ds = 0; ds < 4; ++ds) o[eb] = __builtin_amdgcn_mfma_f32_32x32x16_bf16(qb[ds], sfr[eb][ds], o[eb], 0, 0, 0);
    u32x4 zr[8];
#pragma unroll
    for (int i = 0; i < 8; ++i) zr[i] = *(const u32x4*)(P.p_() + (size_t)(tok0 + rh * 32 + 4 * i + (lane >> 4)) * NPAD + C_GZ + h * 128 + 8 * (lane & 15));
    __syncthreads();
    float* og_s = (float*)lds + wid * (32 * 132);
#pragma unroll
    for (int r = 0; r < 16; ++r) {
#pragma unroll
        for (int eb = 0; eb < 4; ++eb) og_s[att::crow(r, hi) * 132 + eb * 32 + r32] = o[eb][r]; }
    asm volatile("" ::: "memory");
    { const int row = lane >> 1, half = lane & 1; const float* src = og_s + row * 132 + half * 64;
      float ss = 0.f;
#pragma unroll
      for (int i = 0; i < 16; ++i) { const f32x4 v = *(const f32x4*)(src + 4 * i); ss += v[0] * v[0] + v[1] * v[1] + v[2] * v[2] + v[3] * v[3]; }
      ss += shx(ss, 1);
      if (half == 0) og_s[row * 132 + 128] = rsqrtf(ss * (1.f / 128.f) + EPS); }
    asm volatile("s_waitcnt lgkmcnt(0)" ::: "memory");
#pragma unroll
    for (int i = 0; i < 8; ++i) { const int row = 4 * i + (lane >> 4), c8 = 8 * (lane & 15); const float* src = og_s + row * 132 + c8;
      const f32x4 a = *(const f32x4*)src, b2 = *(const f32x4*)(src + 4); const float rn = og_s[row * 132 + 128];
      float z[8], gg[8];
      z[0] = __uint_as_float(zr[i].x << 16); z[1] = __uint_as_float(zr[i].x & 0xffff0000u); z[2] = __uint_as_float(zr[i].y << 16); z[3] = __uint_as_float(zr[i].y & 0xffff0000u);
      z[4] = __uint_as_float(zr[i].z << 16); z[5] = __uint_as_float(zr[i].z & 0xffff0000u); z[6] = __uint_as_float(zr[i].w << 16); z[7] = __uint_as_float(zr[i].w & 0xffff0000u);
#pragma unroll
      for (int q = 0; q < 4; ++q) { gg[q] = a[q] * rn * siluf_(z[q]); gg[4 + q] = b2[q] * rn * siluf_(z[4 + q]); }
      st8f(P.xn_() + (size_t)(tok0 + rh * 32 + row) * MIX + h * 128 + c8, gg); }
    __syncthreads();
}
constexpr int S5P_STRIDE = 2304;
__device__ __forceinline__ void phase_s5_params(const Params& P) {
    for (int idx = blockIdx.x * NTHR + TIDX(); idx < DEPTH * 32 * 64; idx += gridDim.x * NTHR) {
        const int p = idx & 63, lg = idx >> 6;
        const float ar = P.s5_a_re[idx], ai = P.s5_a_im[idx], step = expf(P.s5_log_step[lg]);
        const float mag = expf(ar * step), th = ai * step;
        const float lr = mag * cosf(th), li = mag * sinf(th);
        float* o = P.s5p_() + (size_t)lg * S5P_STRIDE;
        o[2 * p] = lr; o[2 * p + 1] = li;
        { const float mag512 = expf(512.f * ar * step); const double a = 512.0 * (double)th; const double k = rint(a * 0.15915494309189535); const float rf = (float)fma(-k, 6.283185307179586, a);
          o[128 + 2 * p] = mag512 * cosf(rf); o[128 + 2 * p + 1] = mag512 * sinf(rf); }
        const float xr = lr - 1.f, xi = li, den = 1.f / (ar * ar + ai * ai);
        const float fr = (xr * ar + xi * ai) * den, fi = (xi * ar - xr * ai) * den;
        for (int c = 0; c < 16; ++c) { const float br = P.s5_b_re[(size_t)idx * 16 + c], bi = P.s5_b_im[(size_t)idx * 16 + c];
            o[256 + (p * 16 + c) * 2] = fr * br - fi * bi; o[256 + (p * 16 + c) * 2 + 1] = fr * bi + fi * br; }
    }
}
__device__ __forceinline__ float gelu_tanh_(float x) {
    const float t = x * fmaf(-0.1029432395800235f, x * x, -2.302208198144325f); return x * __builtin_amdgcn_rcpf(1.f + __builtin_amdgcn_exp2f(t)); }

constexpr int S5_XST = 272;
constexpr int S5_UST = 48;
__device__ __forceinline__ float partner32(float v, int hi) { auto rr = __builtin_amdgcn_permlane32_swap(__float_as_uint(v), __float_as_uint(v), false, false); return __uint_as_float(hi ? rr[0] : rr[1]); }
struct S5Ctx { float l0r, l0i, l1r, l1i, q0r, q0i, q1r, q1i, dsk; float p0r[16], p0i[16], p1r[16], p1i[16];     char* Cm; char* Bb; char* Xs; char* Us; int lane, hi, j, rho; const bf16_t* ubase; bf16_t* ybase; };
template <bool OUT> __device__ __forceinline__ void s5_tile(const S5Ctx& C, const f32x16& z16, int tok0, const bf16x8 w0, const bf16x8 w1, float& x0r, float& x0i, float& x1r, float& x1i) {
    const int hi = C.hi, j = C.j, lane = C.lane;
    if (hi == 0) { *(bf16x8*)(C.Us + C.rho * S5_UST) = w0; *(bf16x8*)(C.Us + C.rho * S5_UST + 16) = w1; }
    asm volatile("" ::: "memory");
    f32x16 a0, a1, a2, a3;
    { const int r_ = lane & 31, kh_ = lane >> 5;
      const bf16x8 ua = *(const bf16x8*)(C.Us + r_ * S5_UST + kh_ * 16);
      const bf16x8 f0 = *(const bf16x8*)(C.Bb + r_ * S5_UST + kh_ * 16), f1 = *(const bf16x8*)(C.Bb + (32 + r_) * S5_UST + kh_ * 16);
      const bf16x8 f2 = *(const bf16x8*)(C.Bb + (64 + r_) * S5_UST + kh_ * 16), f3 = *(const bf16x8*)(C.Bb + (96 + r_) * S5_UST + kh_ * 16);
      a0 = __builtin_amdgcn_mfma_f32_32x32x16_bf16(ua, f0, z16, 0, 0, 0); a1 = __builtin_amdgcn_mfma_f32_32x32x16_bf16(ua, f1, z16, 0, 0, 0);
      a2 = __builtin_amdgcn_mfma_f32_32x32x16_bf16(ua, f2, z16, 0, 0, 0); a3 = __builtin_amdgcn_mfma_f32_32x32x16_bf16(ua, f3, z16, 0, 0, 0); }
    float s0r[16], s0i[16], s1r[16], s1i[16];
#pragma unroll
    for (int r = 0; r < 16; ++r) {
        const float n0r = fmaf(C.l0r, x0r, fmaf(-C.l0i, x0i, a0[r])), n0i = fmaf(C.l0r, x0i, fmaf(C.l0i, x0r, a1[r])); x0r = n0r; x0i = n0i; s0r[r] = n0r; s0i[r] = n0i;
        const float n1r = fmaf(C.l1r, x1r, fmaf(-C.l1i, x1i, a2[r])), n1i = fmaf(C.l1r, x1i, fmaf(C.l1i, x1r, a3[r])); x1r = n1r; x1i = n1i; s1r[r] = n1r; s1i[r] = n1i; }
    float z0r = partner32(x0r, hi), z0i = partner32(x0i, hi), z1r = partner32(x1r, hi), z1i = partner32(x1i, hi);
    if (hi == 0) { z0r = 0.f; z0i = 0.f; z1r = 0.f; z1i = 0.f; }
    if (!OUT) {
        x0r += C.q0r * z0r - C.q0i * z0i; x0i += C.q0r * z0i + C.q0i * z0r; x1r += C.q1r * z1r - C.q1i * z1i; x1i += C.q1r * z1i + C.q1i * z1r;
    } else {
#pragma unroll
        for (int r = 0; r < 16; ++r) {
            s0r[r] = fmaf(C.p0r[r], z0r, fmaf(-C.p0i[r], z0i, s0r[r])); s0i[r] = fmaf(C.p0r[r], z0i, fmaf(C.p0i[r], z0r, s0i[r]));
            s1r[r] = fmaf(C.p1r[r], z1r, fmaf(-C.p1i[r], z1i, s1r[r])); s1i[r] = fmaf(C.p1r[r], z1i, fmaf(C.p1i[r], z1r, s1i[r])); }
        x0r = s0r[15]; x0i = s0i[15]; x1r = s1r[15]; x1i = s1i[15];
#pragma unroll
        for (int r = 0; r < 16; ++r) { char* xr_ = C.Xs + (r + 16 * hi) * S5_XST;
            *(bf16_t*)(xr_ + j * 2) = f2bf(s0r[r]); *(bf16_t*)(xr_ + (64 + j) * 2) = f2bf(s0i[r]);
            *(bf16_t*)(xr_ + (32 + j) * 2) = f2bf(s1r[r]); *(bf16_t*)(xr_ + (96 + j) * 2) = f2bf(s1i[r]); }
        asm volatile("" ::: "memory");
        f32x16 acc;
        { const int r_ = lane & 31, kh_ = lane >> 5; const char* ap = C.Xs + r_ * S5_XST + kh_ * 16; const char* bp = C.Cm + r_ * S5_XST + kh_ * 16;
          acc = __builtin_amdgcn_mfma_f32_32x32x16_bf16(*(const bf16x8*)ap, *(const bf16x8*)bp, z16, 0, 0, 0);
#pragma unroll
          for (int k = 16; k < 128; k += 16) acc = __builtin_amdgcn_mfma_f32_32x32x16_bf16(*(const bf16x8*)(ap + k * 2), *(const bf16x8*)(bp + k * 2), acc, 0, 0, 0); }
        {
            const int c = j & 15; const bool up = j >= 16;
#pragma unroll
            for (int r2 = 0; r2 < 8; ++r2) {
                const float hv = __int_as_float(__builtin_amdgcn_ds_bpermute((lane - 16) << 2, __float_as_int(acc[8 + r2])));
                const float a = up ? hv : acc[r2];
                const int t = crow32(r2, hi) + (up ? 16 : 0); const int rt = ((t & 15) & 3) + 8 * ((t & 15) >> 2) + 4 * (t >> 4);
                const float y = a + C.dsk * bf2f(*(const bf16_t*)(C.Us + rt * S5_UST + c * 2));
                C.ybase[(size_t)(tok0 + t) * 512 + c] = f2bf(gelu_tanh_(y)); } }
        asm volatile("" ::: "memory");
    }
    { const float e0r = partner32(x0r, hi), e0i = partner32(x0i, hi), e1r = partner32(x1r, hi), e1i = partner32(x1i, hi);
      if (hi == 0) { x0r = e0r; x0i = e0i; x1r = e1r; x1i = e1i; } else { x0r = 0.f; x0i = 0.f; x1r = 0.f; x1i = 0.f; } }
}
__device__ __forceinline__ void unit_s5(const Params& P, int layer, int u, char* lds) {
    const int b = u >> 5, g = u & 31, tid = TIDX(), wid = tid >> 6, lane = tid & 63, hi = lane >> 5, j = lane & 31;
    char* Cm = lds;
    char* Bb = Cm + 32 * S5_XST;
    float* ends = (float*)(Bb + 128 * S5_UST);
    char* wbase = (char*)(ends + 8 * 64 * 2) + wid * (32 * S5_XST + 32 * S5_UST);
    const float* sp = P.s5p_() + (size_t)(layer * 32 + g) * S5P_STRIDE;
    __syncthreads();
    for (int i = tid; i < 32 * 128; i += NTHR) { const int c = i >> 7, pp = i & 127; float v = 0.f;
        if (c < 16) v = (pp < 64) ? P.s5_c_re[((size_t)(layer * 32 + g) * 16 + c) * 64 + pp] : -P.s5_c_im[((size_t)(layer * 32 + g) * 16 + c) * 64 + (pp - 64)];
        *(bf16_t*)(Cm + c * S5_XST + pp * 2) = f2bf(v); }
    for (int i = tid; i < 128 * 16; i += NTHR) { const int n = i >> 4, c = i & 15, nt = n >> 5, jj = n & 31, p = (nt >> 1) * 32 + jj;
        *(bf16_t*)(Bb + n * S5_UST + c * 2) = f2bf(sp[256 + (p * 16 + c) * 2 + (nt & 1)]); }
    S5Ctx C; C.Cm = Cm; C.Bb = Bb; C.Xs = wbase; C.Us = wbase + 32 * S5_XST; C.lane = lane; C.hi = hi; C.j = j;
    C.l0r = sp[2 * j]; C.l0i = sp[2 * j + 1]; C.l1r = sp[2 * (32 + j)]; C.l1i = sp[2 * (32 + j) + 1];
    { float q0r = C.l0r, q0i = C.l0i, q1r = C.l1r, q1i = C.l1i;
#pragma unroll
      for (int k = 0; k < 4; ++k) { const float a = q0r * q0r - q0i * q0i, bb = (q0r + q0r) * q0i; q0r = a; q0i = bb; const float c = q1r * q1r - q1i * q1i, d = (q1r + q1r) * q1i; q1r = c; q1i = d; }
      C.q0r = q0r; C.q0i = q0i; C.q1r = q1r; C.q1i = q1i; }
    { float a0r = C.l0r, a0i = C.l0i, a1r = C.l1r, a1i = C.l1i;
#pragma unroll
      for (int r = 0; r < 16; ++r) { C.p0r[r] = a0r; C.p0i[r] = a0i; C.p1r[r] = a1r; C.p1i[r] = a1i;
          const float n0r = a0r * C.l0r - a0i * C.l0i, n0i = a0r * C.l0i + a0i * C.l0r, n1r = a1r * C.l1r - a1i * C.l1i, n1i = a1r * C.l1i + a1i * C.l1r;
          a0r = n0r; a0i = n0i; a1r = n1r; a1i = n1i; } }
    C.dsk = P.s5_d[layer * 512 + g * 16 + (lane & 15)];
    C.rho = ((j & 15) & 3) + 8 * ((j & 15) >> 2) + 4 * (j >> 4);
    const int tokw = b * SEQ + wid * 512;
    C.ubase = P.p_() + C_SU + g * 16; C.ybase = P.ybuf_() + g * 16;
    float x0r = 0.f, x0i = 0.f, x1r = 0.f, x1i = 0.f;
    f32x16 z16 = {}; asm volatile("" : "+v"(z16));
    __syncthreads();
    const bf16_t* urow = C.ubase + (size_t)(tokw + j) * NPAD;
    { bf16x8 w0 = *(const bf16x8*)urow, w1 = *(const bf16x8*)(urow + 8);
      for (int sc = 0; sc < 16; ++sc) { const bf16_t* un = urow + (size_t)((sc < 15 ? sc + 1 : 15) * 32) * NPAD;
          const bf16x8 n0 = *(const bf16x8*)un, n1 = *(const bf16x8*)(un + 8);
          s5_tile<false>(C, z16, tokw + sc * 32, w0, w1, x0r, x0i, x1r, x1i); w0 = n0; w1 = n1; } }
    if (hi == 0) { ends[(wid * 64 + j) * 2] = x0r; ends[(wid * 64 + j) * 2 + 1] = x0i; ends[(wid * 64 + 32 + j) * 2] = x1r; ends[(wid * 64 + 32 + j) * 2 + 1] = x1i; }
    __syncthreads();
    { const float p0r = sp[128 + 2 * j], p0i = sp[128 + 2 * j + 1], p1r = sp[128 + 2 * (32 + j)], p1i = sp[128 + 2 * (32 + j) + 1];
      x0r = 0.f; x0i = 0.f; x1r = 0.f; x1i = 0.f;
      for (int w = 0; w < wid; ++w) { const float e0r = ends[(w * 64 + j) * 2], e0i = ends[(w * 64 + j) * 2 + 1], e1r = ends[(w * 64 + 32 + j) * 2], e1i = ends[(w * 64 + 32 + j) * 2 + 1];
          const float n0r = p0r * x0r - p0i * x0i + e0r, n0i = p0r * x0i + p0i * x0r + e0i, n1r = p1r * x1r - p1i * x1i + e1r, n1i = p1r * x1i + p1i * x1r + e1i;
          x0r = n0r; x0i = n0i; x1r = n1r; x1i = n1i; }
      if (hi) { x0r = 0.f; x0i = 0.f; x1r = 0.f; x1i = 0.f; } }
    { bf16x8 w0 = *(const bf16x8*)urow, w1 = *(const bf16x8*)(urow + 8);
      for (int sc = 0; sc < 16; ++sc) { const bf16_t* un = urow + (size_t)((sc < 15 ? sc + 1 : 15) * 32) * NPAD;
          const bf16x8 n0 = *(const bf16x8*)un, n1 = *(const bf16x8*)(un + 8);
          s5_tile<true>(C, z16, tokw + sc * 32, w0, w1, x0r, x0i, x1r, x1i); w0 = n0; w1 = n1; } }
}
constexpr int TOPK = 256;
__device__ __forceinline__ unsigned f2key(float f) { const unsigned u = __float_as_uint(f); return u ^ ((u & 0x80000000u) ? 0xffffffffu : 0x80000000u); }

__device__ __forceinline__ float relu1(float x) { const int b = __float_as_int(x); return __int_as_float(b > 0 ? b : 0); }
#define DSA_MM(acc, rt, kk) acc = __builtin_amdgcn_mfma_f32_32x32x16_bf16(afr[rt][kk], bfr[kk], acc, 0, 0, 0)
#define DSA_HS(acc, rt, q) do { s0 = fmaf(relu1(acc[4 * (q)]), wv[rt][4 * (q)], s0); s1 = fmaf(relu1(acc[4 * (q) + 1]), wv[rt][4 * (q) + 1], s1); \
                                s0 = fmaf(relu1(acc[4 * (q) + 2]), wv[rt][4 * (q) + 2], s0); s1 = fmaf(relu1(acc[4 * (q) + 3]), wv[rt][4 * (q) + 3], s1); } while (0)
#define DSA_SG() __builtin_amdgcn_sched_barrier(0)
__device__ __forceinline__ void dsa_score_tile(const bf16x8 (&afr)[4][4], const f32x16 (&wv)[4], const bf16x8 (&bfr)[4], float* sc, int col, int hi) {
    const f32x16 z16 = {};
#define DSA_M0(acc, rt) acc = __builtin_amdgcn_mfma_f32_32x32x16_bf16(afr[rt][0], bfr[0], z16, 0, 0, 0)
    f32x16 accA, accB;
    float s0, s1;
    DSA_M0(accA, 0); DSA_MM(accA, 0, 1); DSA_MM(accA, 0, 2); DSA_MM(accA, 0, 3);
    s0 = 0.f; s1 = 0.f;
    DSA_M0(accB, 1); DSA_HS(accA, 0, 0); DSA_SG(); DSA_MM(accB, 1, 1); DSA_HS(accA, 0, 1); DSA_SG();
    DSA_MM(accB, 1, 2); DSA_HS(accA, 0, 2); DSA_SG(); DSA_MM(accB, 1, 3); DSA_HS(accA, 0, 3); DSA_SG();
    sc[(0 + hi) * 4096 + col] = (s0 + s1) + 0.f;
    s0 = 0.f; s1 = 0.f;
    DSA_M0(accA, 2); DSA_HS(accB, 1, 0); DSA_SG(); DSA_MM(accA, 2, 1); DSA_HS(accB, 1, 1); DSA_SG();
    DSA_MM(accA, 2, 2); DSA_HS(accB, 1, 2); DSA_SG(); DSA_MM(accA, 2, 3); DSA_HS(accB, 1, 3); DSA_SG();
    sc[(2 + hi) * 4096 + col] = (s0 + s1) + 0.f;
    s0 = 0.f; s1 = 0.f;
    DSA_M0(accB, 3); DSA_HS(accA, 2, 0); DSA_SG(); DSA_MM(accB, 3, 1); DSA_HS(accA, 2, 1); DSA_SG();
    DSA_MM(accB, 3, 2); DSA_HS(accA, 2, 2); DSA_SG(); DSA_MM(accB, 3, 3); DSA_HS(accA, 2, 3); DSA_SG();
    asm volatile("" :: "v"(bfr[0]), "v"(bfr[1]), "v"(bfr[2]), "v"(bfr[3]));
    sc[(4 + hi) * 4096 + col] = (s0 + s1) + 0.f;
    s0 = 0.f; s1 = 0.f;
    DSA_HS(accB, 3, 0); DSA_HS(accB, 3, 1); DSA_HS(accB, 3, 2); DSA_HS(accB, 3, 3);
    sc[(6 + hi) * 4096 + col] = (s0 + s1) + 0.f;
#undef DSA_M0
}
#define DSA_CNT4(K0, K1, K2, K3) asm volatile( \
    "v_cmp_ge_u32_e64 %[m0], %[k0], %[cd]\n\tv_cmp_ge_u32_e64 %[m1], %[k1], %[cd]\n\tv_cmp_ge_u32_e64 %[m2], %[k2], %[cd]\n\tv_cmp_ge_u32_e64 %[m3], %[k3], %[cd]\n\t" \
    "v_addc_co_u32_e64 %[a0], %[m0], %[a0], 0, %[m0]\n\tv_addc_co_u32_e64 %[a1], %[m1], %[a1], 0, %[m1]\n\t" \
    "v_addc_co_u32_e64 %[a0], %[m2], %[a0], 0, %[m2]\n\tv_addc_co_u32_e64 %[a1], %[m3], %[a1], 0, %[m3]" \
    : [a0] "+v"(c0), [a1] "+v"(c1), [m0] "=&s"(sm0), [m1] "=&s"(sm1), [m2] "=&s"(sm2), [m3] "=&s"(sm3) \
    : [k0] "v"(K0), [k1] "v"(K1), [k2] "v"(K2), [k3] "v"(K3), [cd] "v"(cand))
#define DSA_CNT8(J0) do { DSA_CNT4(key[(J0)], key[(J0) + 1], key[(J0) + 2], key[(J0) + 3]); DSA_CNT4(key[(J0) + 4], key[(J0) + 5], key[(J0) + 6], key[(J0) + 7]); } while (0)

template <int J, int JEND> __device__ __forceinline__ void dsa_emit(const unsigned (&key)[64], unsigned T, unsigned& wlo, unsigned& whi) {
    const unsigned long long m0 = __ballot(key[J] >= T), m1 = __ballot(key[J + 1] >= T), m2 = __ballot(key[J + 2] >= T), m3 = __ballot(key[J + 3] >= T);
    asm("s_nop 1\n\tv_writelane_b32 %0, %2, %10\n\tv_writelane_b32 %1, %3, %10\n\tv_writelane_b32 %0, %4, %11\n\tv_writelane_b32 %1, %5, %11\n\t"
        "v_writelane_b32 %0, %6, %12\n\tv_writelane_b32 %1, %7, %12\n\tv_writelane_b32 %0, %8, %13\n\tv_writelane_b32 %1, %9, %13"
        : "+v"(wlo), "+v"(whi)
        : "s"((unsigned)m0), "s"((unsigned)(m0 >> 32)), "s"((unsigned)m1), "s"((unsigned)(m1 >> 32)), "s"((unsigned)m2), "s"((unsigned)(m2 >> 32)), "s"((unsigned)m3), "s"((unsigned)(m3 >> 32)),
          "n"(J), "n"(J + 1), "n"(J + 2), "n"(J + 3));
    if constexpr (J + 4 < JEND) dsa_emit<J + 4, JEND>(key, T, wlo, whi);
}
__device__ __forceinline__ void unit_dsa_index(const Params& P, int u, char* lds) {
    const int b = u & 3, t0 = (511 - (u >> 2)) * 8;
    const int tid = TIDX(), wid = tid >> 6, lane = tid & 63, r32 = lane & 31, hi = lane >> 5;
    float* sc = (float*)lds;
    const bf16_t* pb = P.p_() + (size_t)b * SEQ * NPAD;
    __syncthreads();
    TPU_START(101); TPU_START(110);
    if (t0 + 7 >= TOPK) {
        bf16x8 afr[4][4]; f32x16 wv[4];
        const int qsel = (r32 >> 2) & 1, head = (r32 & 3) + 4 * (r32 >> 3);
        char* qs = lds;
        const int ntile = (t0 + 7) / 32 + 1;
        const bf16_t* kp = P.ikc_() + (size_t)(b * (SEQ / 32)) * 2048 + lane * 8;
        bf16x8 b0[4], b1[4], b2[4];
#define DSA_LDB(dst, K) do { const bf16_t* kq_ = kp + (size_t)(wid + 8 * (K)) * 2048; _Pragma("unroll") for (int kk = 0; kk < 4; ++kk) dst[kk] = *(const bf16x8*)(kq_ + kk * 512); } while (0)
#define DSA_TILE(buf, K) dsa_score_tile(afr, wv, buf, sc, (wid + 8 * (K)) * 32 + r32, hi)
        const int nk = (ntile - wid + 7) >> 3;
        const int kl = nk > 0 ? nk - 1 : 0;
#define DSA_MIN(a) ((a) < kl ? (a) : kl)
        const int tk = tid >> 6, hd = (tid & 63) >> 2, dm = (tid & 3) * 16;
        const bf16_t* qsrc = pb + (size_t)(t0 + tk) * NPAD + C_DIQ + hd * 64 + dm;
        u32x4 qa = *(const u32x4*)qsrc, qb2 = *(const u32x4*)(qsrc + 8);
        f32x4 qcs[4];
#pragma unroll
        for (int i = 0; i < 4; ++i) qcs[i] = *(const f32x4*)(P.rope_() + (size_t)(b * SEQ + t0 + tk) * 48 + 32 + 4 * i);
#pragma unroll
        for (int rt = 0; rt < 4; ++rt) { const float* wp = P.iw_() + (size_t)(b * SEQ + t0 + 2 * rt + hi) * 16;
#pragma unroll
            for (int i = 0; i < 4; ++i) { const f32x4 w4 = *(const f32x4*)(wp + 4 * i); wv[rt][4 * i] = w4[0]; wv[rt][4 * i + 1] = w4[1]; wv[rt][4 * i + 2] = w4[2]; wv[rt][4 * i + 3] = w4[3]; } }
        DSA_LDB(b0, DSA_MIN(0)); DSA_LDB(b1, DSA_MIN(1));
        if (dm == 0) {
            u32x4 ra, rb;
#pragma unroll
            for (int i = 0; i < 4; ++i) { const float c0 = qcs[i][0], s0 = qcs[i][1], c1 = qcs[i][2], s1 = qcs[i][3];
                const float a0 = __uint_as_float(qa[i] << 16), a1 = __uint_as_float(qa[i] & 0xffff0000u), b0_ = __uint_as_float(qb2[i] << 16), b1_ = __uint_as_float(qb2[i] & 0xffff0000u);
                ra[i] = pk2bf(a0 * c0 - b0_ * s0, a1 * c1 - b1_ * s1); rb[i] = pk2bf(b0_ * c0 + a0 * s0, b1_ * c1 + a1 * s1); }
            qa = ra; qb2 = rb; }
        { char* dst = qs + tk * 2432 + hd * 144 + dm * 2; *(u32x4*)dst = qa; *(u32x4*)(dst + 16) = qb2; }
        __syncthreads();
#pragma unroll
        for (int rt = 0; rt < 4; ++rt) { const char* qp = qs + (2 * rt + qsel) * 2432 + head * 144 + hi * 16;
#pragma unroll
            for (int kk = 0; kk < 4; ++kk) afr[rt][kk] = *(const bf16x8*)(qp + kk * 32); }
        asm volatile("s_waitcnt lgkmcnt(0)" ::: "memory"); __syncthreads();
#if TPROBE == 110
        TPU_STOP(110);
#endif
#if TPROBE == 103
        TPU_START(103); asm volatile("s_waitcnt vmcnt(0)" ::: "memory"); TPU_STOP(103);
#endif
#if TPROBE == 104
        asm volatile("s_waitcnt vmcnt(0)" ::: "memory"); TPU_START(104);
#endif
        int k = 0;
        for (; k + 3 <= nk; k += 3) {
            DSA_LDB(b2, k + 2); DSA_TILE(b0, k);
            DSA_LDB(b0, DSA_MIN(k + 3)); DSA_TILE(b1, k + 1);
            DSA_LDB(b1, DSA_MIN(k + 4)); DSA_TILE(b2, k + 2);
        }
        if (k < nk) DSA_TILE(b0, k);
        if (k + 1 < nk) DSA_TILE(b1, k + 1);
#if TPROBE == 104
        asm volatile("s_waitcnt lgkmcnt(0)" ::: "memory"); TPU_STOP(104);
#endif
        TPU_START(111);
#undef DSA_TILE
#undef DSA_MIN
#undef DSA_TILE
#undef DSA_LDB
    }
    __syncthreads();
    TPU_STOP(111);
    TPU_STOP(101); TPU_START(102);
    {
        const int t = t0 + wid; const float* srow = sc + wid * 4096;
        unsigned key[64];
        {
            const int gfull = (t + 1) >> 9, gany = t / 512 + 1;
#pragma unroll
            for (int g = 0; g < 8; ++g) {
                if (g < gfull) {
#pragma unroll
                    for (int jj = 0; jj < 8; ++jj) key[8 * g + jj] = f2key(srow[(8 * g + jj) * 64 + lane]);
                } else if (g < gany) {
#pragma unroll
                    for (int jj = 0; jj < 8; ++jj) { const int s = (8 * g + jj) * 64 + lane; key[8 * g + jj] = (s <= t) ? f2key(srow[s]) : 0u; }
                } else {
#pragma unroll
                    for (int jj = 0; jj < 8; ++jj) key[8 * g + jj] = 0u;
                }
            }
        }
        unsigned long long* mout = P.mask_() + (size_t)(b * SEQ + t) * 64;
        unsigned long long myword = 0ull;
        TPU_START(105); TPU_START(106); TPU_START(107); TPU_START(108); TPU_START(109);
        if (t + 1 <= TOPK) {
#pragma unroll
            for (int j = 0; j < 64; ++j) { const unsigned long long m = __ballot(j * 64 + lane <= t); if (lane == j) myword = m; }
        } else {
            const int ngrp = t / 512 + 1;
#if TPROBE == 105
            asm volatile("" :: "v"(key[0]), "v"(key[63]));
#endif
            TPU_STOP(105);
            unsigned* hist = (unsigned*)(sc + wid * 4096);
            asm volatile("" ::: "memory");
            { const u32x4 zz4 = {0u, 0u, 0u, 0u};
#pragma unroll
              for (int i = 0; i < 16; ++i) *(u32x4*)(hist + (i * 64 + lane) * 4) = zz4; }
            asm volatile("" ::: "memory");
#define DSA_H8(J0) do { _Pragma("unroll") for (int jj = 0; jj < 8; ++jj) atomicAdd(hist + (key[(J0) + jj] >> 20), 1u); } while (0)
            DSA_H8(0);
            if (ngrp > 1) DSA_H8(8);
            if (ngrp > 2) DSA_H8(16);
            if (ngrp > 3) DSA_H8(24);
            if (ngrp > 4) DSA_H8(32);
            if (ngrp > 5) DSA_H8(40);
            if (ngrp > 6) DSA_H8(48);
            if (ngrp > 7) DSA_H8(56);
#undef DSA_H8
            asm volatile("" ::: "memory");
#if TPROBE == 106
            asm volatile("s_waitcnt lgkmcnt(0)" ::: "memory");
#endif
            TPU_STOP(106);
#define DSA_DPP_(v, ctrl, rmask, bc) ((unsigned)__builtin_amdgcn_update_dpp(0, (int)(v), (ctrl), (rmask), 0xf, (bc)))
#define DSA_SUFFIX(s) do { unsigned p_ = (s); p_ += DSA_DPP_(p_, 0x111, 0xf, true); p_ += DSA_DPP_(p_, 0x112, 0xf, true); p_ += DSA_DPP_(p_, 0x114, 0xf, true); p_ += DSA_DPP_(p_, 0x118, 0xf, true); \
    p_ += DSA_DPP_(p_, 0x142, 0xa, false); p_ += DSA_DPP_(p_, 0x143, 0xc, false); \
    (s) = (unsigned)__builtin_amdgcn_readlane((int)p_, 63) - p_ + (s); } while (0)
            unsigned mine = 0u;
#pragma unroll
            for (int i = 0; i < 16; ++i) { const u32x4 v4 = *(const u32x4*)(hist + lane * 64 + ((i + lane) & 15) * 4); mine += (v4[0] + v4[1]) + (v4[2] + v4[3]); }
            unsigned suf = mine; DSA_SUFFIX(suf);
            const unsigned long long mL = __ballot(suf - mine < (unsigned)TOPK && suf >= (unsigned)TOPK);
            const int Ls = (int)__builtin_ctzll(mL);
            const unsigned cntA = (unsigned)__builtin_amdgcn_readlane((int)(suf - mine), Ls);
            unsigned h2 = hist[Ls * 64 + lane]; unsigned suf2 = h2; DSA_SUFFIX(suf2);
            const unsigned long long mB = __ballot(cntA + suf2 - h2 < (unsigned)TOPK && cntA + suf2 >= (unsigned)TOPK);
            const int Bs = (int)__builtin_ctzll(mB);
            const unsigned bstar = (unsigned)(Ls * 64 + Bs);
            const unsigned cntAbove = cntA + (unsigned)__builtin_amdgcn_readlane((int)(suf2 - h2), Bs);
            const unsigned inbin = (unsigned)__builtin_amdgcn_readlane((int)h2, Bs);
#undef DSA_SUFFIX
#undef DSA_DPP_
            TPU_STOP(107);
            unsigned T = bstar << 20; int cntT = (int)(cntAbove + inbin);
            if (cntT != TOPK) {
                asm volatile("" ::: "memory");
                int nslot = 0;
#pragma unroll
                for (int g = 0; g < 8; ++g) { if (g < ngrp) {
#pragma unroll
                    for (int jj = 0; jj < 8; ++jj) { const int j = 8 * g + jj; if ((key[j] >> 20) == bstar) { hist[nslot * 64 + lane] = key[j]; ++nslot; } } } }
                asm volatile("" ::: "memory");
                int R = nslot;
#pragma unroll
                for (int o = 32; o >= 1; o >>= 1) { const int other = __builtin_amdgcn_ds_bpermute(((lane ^ o) << 2), R); R = other > R ? other : R; }
                R = __builtin_amdgcn_readfirstlane(R);
                if (R <= 8) {
                    unsigned c[8];
#pragma unroll
                    for (int r = 0; r < 8; ++r) c[r] = (r < nslot) ? hist[r * 64 + lane] : 0u;
#define DSA_BISECT(NR) for (int bit = 19; bit >= 0; --bit) { const unsigned cand = T | (1u << bit); int cnt = (int)cntAbove; \
                        _Pragma("unroll") for (int r = 0; r < (NR); ++r) cnt += __popcll(__ballot(c[r] >= cand)); \
                        if (cnt >= TOPK) { T = cand; cntT = cnt; if (cnt == TOPK) break; } }
                    if (R <= 2) { DSA_BISECT(2) } else if (R <= 4) { DSA_BISECT(4) } else { DSA_BISECT(8) }
#undef DSA_BISECT
                } else {
                    for (int bit = 19; bit >= 0; --bit) {
                        const unsigned cand = T | (1u << bit); unsigned c0 = 0, c1 = 0; unsigned long long sm0, sm1, sm2, sm3;
                        DSA_CNT8(0);
                        if (ngrp > 1) DSA_CNT8(8);
                        if (ngrp > 2) DSA_CNT8(16);
                        if (ngrp > 3) DSA_CNT8(24);
                        if (ngrp > 4) DSA_CNT8(32);
                        if (ngrp > 5) DSA_CNT8(40);
                        if (ngrp > 6) DSA_CNT8(48);
                        if (ngrp > 7) DSA_CNT8(56);
                        const int cl = (int)(c0 + c1);
                        int cnt = 0;
#pragma unroll
                        for (int bb = 0; bb < 7; ++bb) cnt += __popcll(__ballot((cl >> bb) & 1)) << bb;
                        if (cnt >= TOPK) { T = cand; cntT = cnt; if (cnt == TOPK) break; }
                    }
                }
            }
            TPU_STOP(108);
            if (cntT == TOPK) {
                unsigned wlo = 0u, whi = 0u;
                dsa_emit<0, 8>(key, T, wlo, whi);
                if (ngrp > 1) dsa_emit<8, 16>(key, T, wlo, whi);
                if (ngrp > 2) dsa_emit<16, 24>(key, T, wlo, whi);
                if (ngrp > 3) dsa_emit<24, 32>(key, T, wlo, whi);
                if (ngrp > 4) dsa_emit<32, 40>(key, T, wlo, whi);
                if (ngrp > 5) dsa_emit<40, 48>(key, T, wlo, whi);
                if (ngrp > 6) dsa_emit<48, 56>(key, T, wlo, whi);
                if (ngrp > 7) dsa_emit<56, 64>(key, T, wlo, whi);
                myword = ((unsigned long long)whi << 32) | wlo;
            } else {
                int ngt = 0;
#pragma unroll
                for (int j = 0; j < 64; ++j) ngt += __popcll(__ballot(key[j] > T));
                int need = TOPK - ngt;
#pragma unroll
                for (int j = 0; j < 64; ++j) { const unsigned long long eq = __ballot(key[j] == T), gt = __ballot(key[j] > T);
                    const int ne = __popcll(eq); unsigned long long take = eq;
                    if (ne > need) { take = 0ull; int left = need; unsigned long long e2 = eq;
                        while (left > 0) { const unsigned long long lowbit = e2 & (0ull - e2); take |= lowbit; e2 ^= lowbit; --left; } }
                    need -= (ne > need) ? need : ne;
                    const unsigned long long m = gt | take; if (lane == j) myword = m; }
            }
        }
        mout[lane] = myword;
        TPU_STOP(109);
    }
    TPU_STOP(102);
}

struct DsaOutRow { const bf16_t* zb; bf16_t* gb; int wid;
    __device__ __forceinline__ const bf16_t* zrow(int r) const { const int rho = wid * 32 + r; return zb + (size_t)(rho >> 2) * NPAD + (rho & 3) * 128; }
    __device__ __forceinline__ bf16_t* grow(int r) const { const int rho = wid * 32 + r; return gb + (size_t)(rho >> 2) * MIX + (rho & 3) * 128; } };
__device__ __forceinline__ void unit_dsa_attn(const Params& P, int cur_layer, int u, char* lds) {
    const int b = u & 3, qb = 63 - (u >> 2), t0 = qb * 64, tokb = b * SEQ;
    const int wid = TIDX() >> 6, lane = TIDX() & 63, r32 = lane & 31, hi = lane >> 5;
    const int rho = wid * 32 + r32, tq = t0 + (rho >> 2), hq = rho & 3;
    const bf16_t* Qw = P.p_() + (size_t)(tokb + tq) * NPAD + C_DQ + hq * 128 + hi * 8;
    const bf16_t* Kh = P.kvc_() + (size_t)tokb * 256;
    const unsigned moff = (unsigned)(tokb + tq) * 512u;
    DsaOutRow ow; ow.zb = P.p_() + (size_t)(tokb + t0) * NPAD + C_DZ; ow.gb = P.xn_() + (size_t)(tokb + t0) * MIX + 1024; ow.wid = wid;
    const int NT = (qb + 2) & ~1;
    att::attn_body<true, 256, 128, 2, DsaOutRow>(Qw, P.dsa_q_norm + cur_layer * 128, P.rope_() + (size_t)(tokb + tq) * 48, Kh, NT, P.mask_(), moff, ow, lds);
}
__device__ __forceinline__ void phase_gemm_glu(const Params& P, int layer, char* lds) {
    pg8::Gemm g; g.A = P.ybuf_(); g.Bt = P.WgluT_() + (size_t)layer * 512 * 512; g.M = NTOK; g.N = 512; g.K = 512;
    pg8::StaticOrder S; S.init(g.M, g.N, (int)gridDim.x, (int)blockIdx.x);
    pg8::EpiGlu E; E.Y = P.ybuf_(); E.ldy = 512; E.O = P.ocat_(); E.ldo = MIX; E.ooff = 512;
    pg8::gemm_phase<pg8::EpiGlu, pg8::StaticOrder, false>((PG8_LAS unsigned char*)lds, g, S, E, nullptr);
}

constexpr int CTL_Q0 = 4096;
struct OneUnit { int pm, pn; __device__ __forceinline__ bool next(int i, pg8::Unit& u) const { if (i) return false; u.pm = pm; u.pn = pn; return true; }
    __device__ __forceinline__ void a_ready(const pg8::Unit&) const {} __device__ __forceinline__ void done(const pg8::Unit&) const {} };
__device__ __forceinline__ int q_issue(unsigned* ctr) { return (int)__hip_atomic_fetch_add(ctr, 1u, __ATOMIC_RELAXED, __HIP_MEMORY_SCOPE_AGENT); }
#define Q_LOOP_BEGIN(ctr, total)  { unsigned* q_ctr_ = (ctr); const int q_total_ = (total); volatile int* q_b_ = (volatile int*)(lds + LDS_TAIL + 16); \
    for (;;) { __syncthreads(); if (TIDX() == 0) *q_b_ = q_issue(q_ctr_); __syncthreads(); const int item = __builtin_amdgcn_readfirstlane(*q_b_); if (item >= q_total_) break;
#define Q_LOOP_END  } }
__device__ __forceinline__ void unit_glu(const Params& P, int layer, int u, char* lds) {
    pg8::Gemm g; g.A = P.ybuf_(); g.Bt = P.WgluT_() + (size_t)layer * 512 * 512; g.M = NTOK; g.N = 512; g.K = 512;
    OneUnit S; S.pm = u >> 1; S.pn = u & 1;
    pg8::EpiGluGate E; E.Y = P.ybuf_(); E.Pz = P.p_(); E.G = P.xn_();
    pg8::gemm_phase<pg8::EpiGluGate, OneUnit, false>((PG8_LAS unsigned char*)lds, g, S, E, nullptr);
}
constexpr int LDS_TAIL = LDS_BYTES - 64;

__global__ __launch_bounds__(NTHR, 2) void k_mega(Params P) {
    extern __shared__ __attribute__((aligned(16))) char lds[];
    if (TIDX() == 0) *(uint4*)(lds + LDS_TAIL) = make_uint4(0u, 0u, 0u, 0u);
    __syncthreads();
    XcdBarrier bar = xcd_barrier_post(P.ctl_(), (volatile LAS unsigned*)(lds + LDS_TAIL));
    const int G = gridDim.x, B = blockIdx.x;
    phase_prologue1(P, lds); phase_rope_table(P); phase_s5_params(P); phase_rmsnorm_x(P, 0);
    xcd_barrier(bar);
    for (int layer = 0; layer < DEPTH; ++layer) {
        if (layer > 0) { phase_rmsnorm_x(P, layer); xcd_barrier(bar); }
        phase_gemm_in(P, layer, lds);
        if (layer == 0) phase_gemm_kv(P, lds);
        xcd_barrier(bar);
        phase_prep(P, layer);
        if (layer == 0) phase_memk_norm(P);
        for (int u = B; u < 256; u += G) unit_gla_a4(P, layer, u, lds);
        xcd_barrier(bar);
        Q_LOOP_BEGIN(P.ctl_() + CTL_Q0 + 64 * (layer * 2), 128 + 2048 + 128)
            if (item < 128) unit_s5(P, layer, item, lds);
            else if (item < 2176) unit_dsa_index(P, item - 128, lds);
            else gla_scan_slice(P, (item - 2176) * NTHR + TIDX());
        Q_LOOP_END
        xcd_barrier(bar);
        Q_LOOP_BEGIN(P.ctl_() + CTL_Q0 + 64 * (layer * 2 + 1), 256 + 256 + 128 + 256)
            if (item < 256) unit_dsa_attn(P, layer, item, lds);
            else if (item < 512) unit_gla_c4(P, layer, item - 256, lds);
            else if (item < 640) unit_glu(P, layer, item - 512, lds);
            else unit_mem_attn(P, layer, item - 640, lds);
        Q_LOOP_END
        xcd_barrier(bar);
        phase_gemm_out(P, layer, lds);
        xcd_barrier(bar);
    }
}

extern "C" void kernel_launch(void* const* d_in, const int* in_sizes, int n_in, void* d_out, int out_size, void* d_ws, size_t ws_size, hipStream_t stream) {
    if (n_in != 24 || ws_size < WS_END) { fprintf(stderr, "kernel_launch: unexpected n_in %d or ws_size %zu (< %zu)\n", n_in, ws_size, (size_t)WS_END); return; }
    Params P; memset(&P, 0, sizeof(P));
    P.x = (const float*)d_in[0]; P.mem = (const float*)d_in[1]; P.pos = (const int*)d_in[2]; P.ln_gain = (const float*)d_in[3]; P.w_in = (const float*)d_in[4];
    P.gla_w_up = (const float*)d_in[5]; P.gla_b_up = (const float*)d_in[6]; P.s5_a_re = (const float*)d_in[7]; P.s5_a_im = (const float*)d_in[8]; P.s5_log_step = (const float*)d_in[9];
    P.s5_b_re = (const float*)d_in[10]; P.s5_b_im = (const float*)d_in[11]; P.s5_c_re = (const float*)d_in[12]; P.s5_c_im = (const float*)d_in[13]; P.s5_d = (const float*)d_in[14];
    P.s5_w_glu = (const float*)d_in[15]; P.dsa_q_norm = (const float*)d_in[16]; P.dsa_k_norm = (const float*)d_in[17]; P.mem_norm = (const float*)d_in[18]; P.w_mem_kv = (const float*)d_in[19];
    P.mem_q_norm = (const float*)d_in[20]; P.mem_k_norm = (const float*)d_in[21]; P.out_norm = (const float*)d_in[22]; P.w_out = (const float*)d_in[23];
    P.out = (float*)d_out;
    char* ws = (char*)d_ws; P.ws = ws;
    static int grid = 0;
    if (!grid) {
        int dev = 0, cus = 0, per_cu = 0;
        (void)hipGetDevice(&dev); (void)hipDeviceGetAttribute(&cus, hipDeviceAttributeMultiprocessorCount, dev);
        (void)hipFuncSetAttribute((const void*)k_mega, hipFuncAttributeMaxDynamicSharedMemorySize, LDS_BYTES);
        (void)hipOccupancyMaxActiveBlocksPerMultiprocessor(&per_cu, (const void*)k_mega, NTHR, LDS_BYTES);
        if (per_cu < 1) fprintf(stderr, "kernel_launch: occupancy query reports %d blocks per CU\n", per_cu);
        grid = cus > 0 ? cus : 256;
    }
    (void)hipMemsetAsync(ws + WS_CTL, 0, CTL_BYTES, stream);
    hipLaunchKernelGGL(k_mega, dim3(grid), dim3(NTHR), LDS_BYTES, stream, P);
}
```
